# Optimizing an MI355X kernel written in HIP

```python
import math
import jax, jax.numpy as jnp
from jax import lax
import numpy as np

D_MODEL = 1024
BATCH = 8
SEQ = 2048
DEPTH = 1

CTX_LEN = 256
GRID_W = 64
H_A = 4
DK_A = 128
DV_A = 128
C_A = H_A * DV_A
SHORT_CONV = 5
CHUNK = 64
H_B = 8
N_B = 64
C_B = H_B * N_B
LORA_W = 64
LORA_A = 64
LORA_G = 128
A_COLS = 4 * C_A + 4 * H_A
B_COLS = 3 * C_B + 2 * LORA_W + 2 * LORA_A + LORA_G
IN_COLS = A_COLS + B_COLS + 2 * D_MODEL
N_GROUPS = 4
EXPERTS_PER_GROUP = 8
N_EXPERTS = N_GROUPS * EXPERTS_PER_GROUP
TOP_K = 2
D_EXPERT = 256
NORM_EPS = 1e-6
LNX_EPS = 1e-5 * N_B

kernel_name = 'hybrid_gdn_rwkv7_hmoe_dit_block'


def rmsnorm(x, g):
    xf = x.astype(jnp.float32)
    y = xf * lax.rsqrt(jnp.mean(xf * xf, axis=-1, keepdims=True) + NORM_EPS)
    return y.astype(x.dtype) * g


def l2norm(x):
    xf = x.astype(jnp.float32)
    return (xf * lax.rsqrt(jnp.sum(xf * xf, axis=-1, keepdims=True) + NORM_EPS)).astype(x.dtype)


def modulate(x, shift, scale):
    return x * (1 + scale) + shift


def both_dirs(t):
    return jnp.stack([t, jnp.flip(t, 1)], 0)


def per_dir(t):
    return jnp.stack([t[:, :, 0], jnp.flip(t[:, :, 1], 1)], 0)


def merge_dirs(y):
    return y[0] + jnp.flip(y[1], 1)


def to_col_major(x, rows):
    b, l, c = x.shape
    return x.reshape(b, rows, GRID_W, c).transpose(0, 2, 1, 3).reshape(b, l, c)


def to_row_major(x, rows):
    b, l, c = x.shape
    return x.reshape(b, GRID_W, rows, c).transpose(0, 2, 1, 3).reshape(b, l, c)


def depthwise_conv(x, w):
    pad = SHORT_CONV // 2
    return lax.conv_general_dilated(x, w[:, None, :], window_strides=(1,), padding=[(pad, pad)],
                                    dimension_numbers=('NWC', 'WIO', 'NWC'),
                                    feature_group_count=x.shape[-1])


def bidir_shift(x):
    xp = jnp.pad(x, ((0, 0), (1, 1), (0, 0)))
    return 0.5 * (xp[:, :-2] + xp[:, 2:])


def gated_delta_chunked(q, k, v, g, beta, s0):
    dtype = v.dtype
    q, k, v, g, beta = (t.astype(jnp.float32) for t in (q, k, v, g, beta))
    n = q.shape[-2] // CHUNK
    dv = v.shape[-1]

    def blk(t):
        return t.reshape(t.shape[:-2] + (n, CHUNK, t.shape[-1]))

    q, k, v = blk(q), blk(k), blk(v)
    g = g.reshape(g.shape[:-1] + (n, CHUNK))
    beta = beta.reshape(beta.shape[:-1] + (n, CHUNK))
    gc = jnp.cumsum(g, axis=-1)
    incl = jnp.tril(jnp.ones((CHUNK, CHUNK), bool))
    strict = jnp.tril(jnp.ones((CHUNK, CHUNK), bool), -1)
    decay = jnp.where(incl, jnp.exp(jnp.where(incl, gc[..., :, None] - gc[..., None, :], 0.0)), 0.0)
    k_beta = k * beta[..., None]
    lower = jnp.where(strict, jnp.einsum('...id,...jd->...ij', k_beta, k) * decay, 0.0)
    a_mat = jnp.eye(CHUNK, dtype=jnp.float32) + lower
    rhs = jnp.concatenate([v * beta[..., None], k_beta * jnp.exp(gc)[..., None]], axis=-1)
    sol = lax.linalg.triangular_solve(a_mat, rhs, left_side=True, lower=True, unit_diagonal=True)
    u, w = sol[..., :dv], sol[..., dv:]
    qk = jnp.where(incl, jnp.einsum('...id,...jd->...ij', q, k) * decay, 0.0)
    q_dec = q * jnp.exp(gc)[..., None]
    k_dec = k * jnp.exp(gc[..., -1:] - gc)[..., None]
    g_end = jnp.exp(gc[..., -1])
    xs = (jnp.moveaxis(u, -3, 0), jnp.moveaxis(w, -3, 0), jnp.moveaxis(qk, -3, 0),
          jnp.moveaxis(q_dec, -3, 0), jnp.moveaxis(k_dec, -3, 0), jnp.moveaxis(g_end, -1, 0))

    def step(s, inp):
        u_c, w_c, qk_c, qd_c, kd_c, ge_c = inp
        v_new = u_c - jnp.einsum('...ck,...kv->...cv', w_c, s)
        o_c = jnp.einsum('...ck,...kv->...cv', qd_c, s) + jnp.einsum('...ij,...jv->...iv', qk_c, v_new)
        s = s * ge_c[..., None, None] + jnp.einsum('...ck,...cv->...kv', kd_c, v_new)
        return s, o_c

    s_fin, o = lax.scan(step, s0.astype(jnp.float32), xs)
    o = jnp.moveaxis(o, 0, -3)
    return o.reshape(o.shape[:-3] + (n * CHUNK, dv)).astype(dtype), s_fin


def gdn_branch(cols, s0, conv_w, a_log, dt_bias, onorm_g):
    bsz, length, _ = cols.shape
    qkv, z, a, bt = jnp.split(cols, [3 * C_A, 4 * C_A, 4 * C_A + 2 * H_A], axis=-1)
    qkv = jax.nn.silu(depthwise_conv(qkv, conv_w))
    q, k, v = (t.reshape(bsz, length, H_A, DK_A) for t in jnp.split(qkv, 3, axis=-1))
    q = l2norm(q) * DK_A ** -0.5
    k = l2norm(k)
    g = -jnp.exp(a_log) * jax.nn.softplus(a.reshape(bsz, length, 2, H_A) + dt_bias)
    beta = jax.nn.sigmoid(bt.reshape(bsz, length, 2, H_A))
    sw = lambda t: jnp.swapaxes(t, 2, 3)
    o, s_fin = gated_delta_chunked(sw(both_dirs(q)), sw(both_dirs(k)), sw(both_dirs(v)),
                                   sw(per_dir(g)), sw(per_dir(beta)), s0)
    o = merge_dirs(sw(o))
    o = rmsnorm(o, onorm_g) * jax.nn.silu(z.reshape(bsz, length, H_A, DV_A))
    return o.reshape(bsz, length, C_A), s_fin


def rwkv7_scan(r, w, k, v, a, b, s0):
    dtype = r.dtype
    xs = tuple(jnp.moveaxis(t.astype(jnp.float32), 2, 0) for t in (r, w, k, v, a, b))

    def step(s, inp):
        r_t, w_t, k_t, v_t, a_t, b_t = inp
        sa = jnp.einsum('...vk,...k->...v', s, a_t)
        s = s * w_t[..., None, :] + sa[..., :, None] * b_t[..., None, :] + v_t[..., :, None] * k_t[..., None, :]
        return s, jnp.einsum('...vk,...k->...v', s, r_t)

    s_fin, y = lax.scan(step, s0.astype(jnp.float32), xs)
    return jnp.moveaxis(y, 0, 2).astype(dtype), s_fin


def rwkv_branch(cols, s0, mu, w0, w2, a0, a2, g2, k_k, k_a, r_k, lnx_g, lnx_b):
    bsz, length, _ = cols.shape
    cols = cols + (bidir_shift(cols) - cols) * mu
    r, k, v, w_lo, a_lo, g_lo = jnp.split(
        cols, [C_B, 2 * C_B, 3 * C_B, 3 * C_B + 2 * LORA_W, 3 * C_B + 2 * LORA_W + 2 * LORA_A], axis=-1)
    w_lo = w_lo.reshape(bsz, length, 2, LORA_W)
    a_lo = a_lo.reshape(bsz, length, 2, LORA_A)
    w_log = -jax.nn.softplus(-(w0 + jnp.einsum('bldr,drc->bldc', jnp.tanh(w_lo), w2))) - 0.5
    decay = jnp.exp(-jnp.exp(w_log.astype(jnp.float32))).astype(cols.dtype)
    iclr = jax.nn.sigmoid(a0 + jnp.einsum('bldr,drc->bldc', a_lo, a2))
    gate = jax.nn.sigmoid(g_lo) @ g2
    heads = lambda t: t.reshape(t.shape[:-1] + (H_B, N_B))
    kk = l2norm(heads(k * k_k))
    k_dir = heads(k[:, :, None, :] * (1 + (iclr - 1) * k_a))
    b_dir = kk[:, :, None] * heads(iclr)
    r_h, v_h = heads(r), heads(v)
    y, s_fin = rwkv7_scan(both_dirs(r_h), per_dir(heads(decay)), per_dir(k_dir), both_dirs(v_h),
                          both_dirs(-kk), per_dir(b_dir), s0)
    yf = merge_dirs(y).astype(jnp.float32)
    mean = jnp.mean(yf, axis=-1, keepdims=True)
    var = jnp.mean(jnp.square(yf - mean), axis=-1, keepdims=True)
    y = ((yf - mean) * lax.rsqrt(var + LNX_EPS)).astype(cols.dtype).reshape(bsz, length, C_B) * lnx_g + lnx_b
    bonus = jnp.einsum('blhn,bldhn,hn->blh', r_h, k_dir, r_k)[..., None] * v_h
    y = (y + bonus.reshape(bsz, length, C_B)) * gate
    return y, s_fin


def merge_branches(gates, o_a, o_b, w_o_a, w_o_b, w_out):
    g_a, g_b = jnp.split(gates, 2, axis=-1)
    y = jax.nn.sigmoid(g_a) * (o_a @ w_o_a) + jax.nn.sigmoid(g_b) * (o_b @ w_o_b)
    return y @ w_out


def mixing_sublayer(u_lat, u_ctx, rows, with_ctx_out, w_in, gdn_conv, gdn_a_log, gdn_dt_bias, gdn_onorm_g,
                    rwkv_mu, rwkv_w0, rwkv_w2, rwkv_a0, rwkv_a2, rwkv_g2, rwkv_k_k, rwkv_k_a, rwkv_r_k,
                    rwkv_lnx_g, rwkv_lnx_b, w_o_a, w_o_b, w_out):
    bsz = u_lat.shape[0]
    split_at = [A_COLS, A_COLS + B_COLS]
    a_lat, b_lat, gates_lat = jnp.split(u_lat @ w_in, split_at, axis=-1)
    a_ctx, b_ctx, gates_ctx = jnp.split(u_ctx @ w_in, split_at, axis=-1)

    def run_a(cols, s0):
        return gdn_branch(cols, s0, gdn_conv, gdn_a_log, gdn_dt_bias, gdn_onorm_g)

    def run_b(cols, s0):
        return rwkv_branch(cols, s0, rwkv_mu, rwkv_w0, rwkv_w2, rwkv_a0, rwkv_a2, rwkv_g2,
                           rwkv_k_k, rwkv_k_a, rwkv_r_k, rwkv_lnx_g, rwkv_lnx_b)

    zeros_a = jnp.zeros((2, bsz, H_A, DK_A, DV_A), jnp.float32)
    zeros_b = jnp.zeros((2, bsz, H_B, N_B, N_B), jnp.float32)
    oa_ctx, state_a = run_a(a_ctx, zeros_a)
    ob_ctx, state_b = run_b(b_ctx, zeros_b)
    oa_lat, _ = run_a(a_lat, state_a)
    ob_lat, _ = run_b(to_col_major(b_lat, rows), state_b)
    ob_lat = to_row_major(ob_lat, rows)
    y_lat = merge_branches(gates_lat, oa_lat, ob_lat, w_o_a, w_o_b, w_out)
    if not with_ctx_out:
        return y_lat, None
    return y_lat, merge_branches(gates_ctx, oa_ctx, ob_ctx, w_o_a, w_o_b, w_out)


def hier_moe(h, router_grp, router_grp_b, router_exp, router_exp_b, w_gate, w_up, w_down):
    shape = h.shape
    t = h.reshape(-1, shape[-1])
    grp_p = jax.nn.softmax((t @ router_grp + router_grp_b).astype(jnp.float32), axis=-1)
    p_grp, g_sel = lax.top_k(grp_p, 1)
    exp_logits = (t @ router_exp + router_exp_b).astype(jnp.float32).reshape(-1, N_GROUPS, EXPERTS_PER_GROUP)
    in_grp = jnp.take_along_axis(exp_logits, g_sel[:, :, None], axis=1)[:, 0]
    top_logit, top_idx = lax.top_k(in_grp, TOP_K)
    w_top = jax.nn.softmax(top_logit, axis=-1) * p_grp
    w_exp = jnp.einsum('tk,tke->te', w_top, jax.nn.one_hot(top_idx, EXPERTS_PER_GROUP, dtype=jnp.float32))
    combine = (jax.nn.one_hot(g_sel[:, 0], N_GROUPS, dtype=jnp.float32)[:, :, None]
               * w_exp[:, None, :]).astype(h.dtype)
    out = jnp.zeros_like(t)
    for grp in range(N_GROUPS):
        hid = jax.nn.silu(jnp.einsum('td,edf->tef', t, w_gate[grp])) * jnp.einsum('td,edf->tef', t, w_up[grp])
        out = out + jnp.einsum('tef,efd->td', hid * combine[:, grp, :, None], w_down[grp])
    return out.reshape(shape)


def setup_inputs(seed: int = 0) -> dict:
    key = jax.random.key(seed)
    ks = jax.random.split(key, 36)
    d = D_MODEL
    nl = DEPTH

    def nrm(k, shape, scale):
        return jax.random.normal(k, shape, jnp.float32) * scale

    dt = jnp.exp(jax.random.uniform(ks[11], (nl, 2, H_A), minval=math.log(1e-3), maxval=math.log(1e-1)))
    return {
        'x': nrm(ks[0], (BATCH, SEQ, d), 1.0),
        'c': nrm(ks[1], (BATCH, d), 1.0),
        'ctx': nrm(ks[2], (BATCH, CTX_LEN, d), 1.0),
        'c_ctx': nrm(ks[3], (d,), 1.0),
        'ada_w': nrm(ks[4], (nl, d, 6 * d), 0.5 * d ** -0.5),
        'ada_b': nrm(ks[5], (nl, 6 * d), 0.01),
        'norm_mix_g': 1.0 + nrm(ks[6], (nl, d), 0.05),
        'norm_ffn_g': 1.0 + nrm(ks[7], (nl, d), 0.05),
        'w_in': nrm(ks[8], (nl, d, IN_COLS), d ** -0.5),
        'gdn_conv': nrm(ks[9], (nl, SHORT_CONV, 3 * C_A), SHORT_CONV ** -0.5),
        'gdn_a_log': jnp.log(jax.random.uniform(ks[10], (nl, 2, H_A), minval=1.0, maxval=16.0)),
        'gdn_dt_bias': dt + jnp.log(-jnp.expm1(-dt)),
        'gdn_onorm_g': 1.0 + nrm(ks[12], (nl, DV_A), 0.05),
        'rwkv_mu': jax.random.uniform(ks[13], (nl, B_COLS)),
        'rwkv_w0': jax.random.uniform(ks[14], (nl, 2, C_B), minval=-6.0, maxval=-1.0),
        'rwkv_w2': nrm(ks[15], (nl, 2, LORA_W, C_B), 0.1),
        'rwkv_a0': nrm(ks[16], (nl, 2, C_B), 0.1),
        'rwkv_a2': nrm(ks[17], (nl, 2, LORA_A, C_B), 0.1),
        'rwkv_g2': nrm(ks[18], (nl, LORA_G, C_B), LORA_G ** -0.5),
        'rwkv_k_k': 0.85 + nrm(ks[19], (nl, C_B), 0.05),
        'rwkv_k_a': 1.0 + nrm(ks[20], (nl, C_B), 0.05),
        'rwkv_r_k': nrm(ks[21], (nl, H_B, N_B), 0.1),
        'rwkv_lnx_g': 1.0 + nrm(ks[22], (nl, C_B), 0.05),
        'rwkv_lnx_b': nrm(ks[23], (nl, C_B), 0.01),
        'w_o_a': nrm(ks[24], (nl, C_A, d), C_A ** -0.5),
        'w_o_b': nrm(ks[25], (nl, C_B, d), C_B ** -0.5),
        'w_out': nrm(ks[26], (nl, d, d), d ** -0.5),
        'router_grp': nrm(ks[27], (nl, d, N_GROUPS), d ** -0.5),
        'router_grp_b': nrm(ks[28], (nl, N_GROUPS), 0.01),
        'router_exp': nrm(ks[29], (nl, d, N_EXPERTS), d ** -0.5),
        'router_exp_b': nrm(ks[30], (nl, N_EXPERTS), 0.01),
        'moe_w_gate': nrm(ks[31], (nl, N_GROUPS, EXPERTS_PER_GROUP, d, D_EXPERT), d ** -0.5),
        'moe_w_up': nrm(ks[32], (nl, N_GROUPS, EXPERTS_PER_GROUP, d, D_EXPERT), d ** -0.5),
        'moe_w_down': nrm(ks[33], (nl, N_GROUPS, EXPERTS_PER_GROUP, D_EXPERT, d), D_EXPERT ** -0.5),
        'final_norm_g': 1.0 + nrm(ks[34], (d,), 0.05),
    }


def reference(x, c, ctx, c_ctx, ada_w, ada_b, norm_mix_g, norm_ffn_g, w_in, gdn_conv, gdn_a_log, gdn_dt_bias,
              gdn_onorm_g, rwkv_mu, rwkv_w0, rwkv_w2, rwkv_a0, rwkv_a2, rwkv_g2, rwkv_k_k, rwkv_k_a, rwkv_r_k,
              rwkv_lnx_g, rwkv_lnx_b, w_o_a, w_o_b, w_out, router_grp, router_grp_b, router_exp, router_exp_b,
              moe_w_gate, moe_w_up, moe_w_down, final_norm_g):
    rows = x.shape[1] // GRID_W
    s_lat = jax.nn.silu(c)[:, None, :]
    s_ctx = jax.nn.silu(c_ctx)
    h_lat, h_ctx = x, ctx
    for l in range(DEPTH):
        last = l == DEPTH - 1
        m_lat = jnp.split(s_lat @ ada_w[l] + ada_b[l], 6, axis=-1)
        m_ctx = jnp.split(s_ctx @ ada_w[l] + ada_b[l], 6, axis=-1)
        u_lat = modulate(rmsnorm(h_lat, norm_mix_g[l]), m_lat[0], m_lat[1])
        u_ctx = modulate(rmsnorm(h_ctx, norm_mix_g[l]), m_ctx[0], m_ctx[1])
        y_lat, y_ctx = mixing_sublayer(
            u_lat, u_ctx, rows, not last, w_in[l], gdn_conv[l], gdn_a_log[l], gdn_dt_bias[l], gdn_onorm_g[l],
            rwkv_mu[l], rwkv_w0[l], rwkv_w2[l], rwkv_a0[l], rwkv_a2[l], rwkv_g2[l], rwkv_k_k[l], rwkv_k_a[l],
            rwkv_r_k[l], rwkv_lnx_g[l], rwkv_lnx_b[l], w_o_a[l], w_o_b[l], w_out[l])
        h_lat = h_lat + m_lat[2] * y_lat
        h_lat = h_lat + m_lat[5] * hier_moe(
            modulate(rmsnorm(h_lat, norm_ffn_g[l]), m_lat[3], m_lat[4]), router_grp[l], router_grp_b[l],
            router_exp[l], router_exp_b[l], moe_w_gate[l], moe_w_up[l], moe_w_down[l])
        if not last:
            h_ctx = h_ctx + m_ctx[2] * y_ctx
            h_ctx = h_ctx + m_ctx[5] * hier_moe(
                modulate(rmsnorm(h_ctx, norm_ffn_g[l]), m_ctx[3], m_ctx[4]), router_grp[l], router_grp_b[l],
                router_exp[l], router_exp_b[l], moe_w_gate[l], moe_w_up[l], moe_w_down[l])
    return rmsnorm(h_lat, final_norm_g)
```

```cpp
#ifndef EMU
#include <hip/hip_runtime.h>
#include <hip/hip_cooperative_groups.h>
#include <cstdio>
#endif
#include <stdint.h>
#include <stddef.h>

#ifndef CFG_D
#define CFG_D 1024
#define CFG_B 8
#define CFG_S 2048
#define CFG_CTX 256
#endif
#ifndef MK_LAUNCHES
#define MK_LAUNCHES 1
#endif

typedef unsigned short bf16_t;
typedef short bf16x8 __attribute__((ext_vector_type(8)));
typedef float f32x4 __attribute__((ext_vector_type(4)));
typedef unsigned u32x4 __attribute__((ext_vector_type(4)));
typedef unsigned u32x2 __attribute__((ext_vector_type(2)));

#define DI __device__ __forceinline__

constexpr int D = CFG_D, NB = CFG_B, S = CFG_S, CTXL = CFG_CTX;
constexpr int GW = 64, ROWS = S / GW;
constexpr int T_CTX = NB * CTXL, T_LAT = NB * S, T_ALL = T_CTX + T_LAT;
constexpr int H_A = 4, H_B = 8;
constexpr int A_COLS = 2064, B_COLS = 1920;
constexpr int IN_COLS = A_COLS + B_COLS + 2 * D;
constexpr int COL_B0 = A_COLS, COL_G0 = A_COLS + B_COLS;
constexpr int CTX_COLS = COL_G0;
constexpr int NP = ((IN_COLS + 127) / 128) * 128;
constexpr int NEXP = 32, DE = 256;
constexpr int NV = NB + 1;
constexpr int NTHREADS = 512;
constexpr int MREP = (T_CTX % 256 == 0 && T_LAT % 256 == 0) ? 4 : 2;
constexpr int BM = 64 * MREP;
constexpr int NPHASES = 11;
constexpr int LDS_BYTES = 155648;
constexpr int CAP = T_LAT;

static_assert(D % 256 == 0 && S % 64 == 0 && CTXL % 64 == 0 && T_CTX % BM == 0 && T_LAT % BM == 0, "shape");

constexpr size_t al256(size_t x) { return (x + 255) & ~(size_t)255; }
constexpr size_t WS_CNT = 0;
constexpr size_t WS_MOD = 256;
constexpr size_t WS_AB = al256(WS_MOD + (size_t)NV * 6 * D * 4);
constexpr size_t WS_BONUS = al256(WS_AB + (size_t)T_ALL * 16 * 4);
constexpr size_t WS_PAIRW = al256(WS_BONUS + (size_t)2 * T_LAT * 8 * 4);
constexpr size_t WS_ROWLIST = al256(WS_PAIRW + (size_t)T_LAT * 2 * 4);
constexpr size_t WS_WOA = al256(WS_ROWLIST + (size_t)NEXP * CAP * 4);
constexpr size_t WS_WOB = al256(WS_WOA + (size_t)D * 512 * 2);
constexpr size_t WS_WOUT = al256(WS_WOB + (size_t)D * 512 * 2);
constexpr size_t WS_OA = al256(WS_WOUT + (size_t)D * D * 2);
constexpr size_t WS_OB = al256(WS_OA + (size_t)T_LAT * 512 * 2);
constexpr size_t WS_DNT = WS_OA;
constexpr size_t WS_SPARE_END = al256(WS_OB + (size_t)T_LAT * 512 * 2) > al256(WS_DNT + (size_t)NEXP * D * DE * 2) ? al256(WS_OB + (size_t)T_LAT * 512 * 2) : al256(WS_DNT + (size_t)NEXP * D * DE * 2);
constexpr size_t WS_P = WS_SPARE_END;
constexpr size_t WS_PLAT = WS_P;
constexpr size_t WS_PCTX = al256(WS_PLAT + (size_t)T_LAT * IN_COLS * 2);
constexpr size_t WS_P_END = al256(WS_PCTX + (size_t)T_CTX * CTX_COLS * 2);
constexpr size_t WS_H = WS_P;
constexpr size_t WS_T = al256(WS_H + (size_t)T_LAT * D * 4);
constexpr size_t WS_HID = al256(WS_T + (size_t)T_LAT * D * 2);
constexpr size_t WS_OPAIR = al256(WS_HID + (size_t)T_LAT * 2 * DE * 2);
constexpr size_t WS_P2_END = al256(WS_OPAIR + (size_t)T_LAT * 2 * D * 2);
constexpr size_t WS_END = WS_P_END > WS_P2_END ? WS_P_END : WS_P2_END;
constexpr size_t AUX_WINT = 0;
constexpr size_t AUX_U = al256((size_t)NP * D * 2);
constexpr size_t AUX_ODIR = 0;
constexpr size_t AUX_YDIR = (size_t)2 * T_LAT * 512 * 2;
constexpr size_t AUX_Y = 0;
constexpr size_t AUX_GUT = (size_t)T_LAT * D * 2;
constexpr size_t AUX_END1 = AUX_U + (size_t)T_ALL * D * 2;
constexpr size_t AUX_END2 = AUX_YDIR + (size_t)2 * T_LAT * 512 * 2;
constexpr size_t AUX_END3 = AUX_GUT + (size_t)NEXP * 512 * D * 2;
constexpr size_t AUX_END = (AUX_END1 > AUX_END2 ? (AUX_END1 > AUX_END3 ? AUX_END1 : AUX_END3) : (AUX_END2 > AUX_END3 ? AUX_END2 : AUX_END3));

struct Params {
    const float* in[35];
    float* out;
    char* ws;
    char* aux;
    int ph_lo, ph_hi;
};
enum { I_X = 0, I_C, I_CTX, I_CCTX, I_ADAW, I_ADAB, I_NMIX, I_NFFN, I_WIN, I_CONV, I_ALOG, I_DTB, I_ONORM, I_MU, I_W0, I_W2, I_A0, I_A2, I_G2, I_KK, I_KA, I_RK, I_LNG, I_LNB, I_WOA, I_WOB, I_WOUT, I_RG, I_RGB, I_RE, I_REB, I_MG, I_MU_UP, I_MD, I_FIN };

DI float bf2f(bf16_t v) { union { unsigned u; float f; } x; x.u = ((unsigned)v) << 16; return x.f; }
DI bf16_t f2bf(float f) { union { float f; unsigned u; } x; x.f = f; unsigned u = x.u; u += 0x7fffu + ((u >> 16) & 1u); return (bf16_t)(u >> 16); }
DI unsigned pk2(float lo, float hi) { return (unsigned)f2bf(lo) | ((unsigned)f2bf(hi) << 16); }
DI float sigmoidf_(float x) { return 1.0f / (1.0f + expf(-x)); }
DI float siluf_(float x) { return x / (1.0f + expf(-x)); }
DI float softplusf_(float x) { return x > 20.f ? x : log1pf(expf(x)); }
DI float wave_sum(float v) {
#pragma unroll
    for (int o = 1; o < 64; o <<= 1) v += __shfl_xor(v, o);
    return v;
}
#ifdef EMU
#define MFMA16(a, b, c) emu_mfma16((a), (b), (c))
#define WAVE_SYNC() emu::wave_bar()
#else
#define MFMA16(a, b, c) __builtin_amdgcn_mfma_f32_16x16x32_bf16((a), (b), (c), 0, 0, 0)
#define WAVE_SYNC() asm volatile("s_waitcnt lgkmcnt(0)" ::: "memory")
#endif

constexpr int LDS_ROW = 40;
constexpr int GEMM_A_BYTES = BM * LDS_ROW * 2, GEMM_B_BYTES = 128 * LDS_ROW * 2;
template <int MR, class ARow>
DI void gemm_kloop(f32x4 (&acc)[MR][4], char* smem, ARow arow, const bf16_t* Bt, int ldb, int K) {
    constexpr int BM = 64 * MR;
    const int tid = threadIdx.x, lane = tid & 63, wave = tid >> 6, wr = wave >> 1, wc = wave & 1, fr = lane & 15, fq = lane >> 4;
    bf16_t* As = (bf16_t*)smem;
    bf16_t* Bs = (bf16_t*)(smem + 2 * GEMM_A_BYTES);
    constexpr int ACH = BM * 4 / NTHREADS;
    static_assert(ACH >= 1, "tile");
    const bf16_t* ap[ACH];
#pragma unroll
    for (int i = 0; i < ACH; ++i) { const int q = tid + i * NTHREADS; ap[i] = arow(q >> 2) + (q & 3) * 8; }
    const bf16_t* bp = Bt + (size_t)(tid >> 2) * ldb + (tid & 3) * 8;
    u32x4 ra[ACH], rb;
#pragma unroll
    for (int i = 0; i < ACH; ++i) ra[i] = *(const u32x4*)(ap[i]);
    rb = *(const u32x4*)(bp);
    const int nk = K / 32;
    for (int kt = 0; kt < nk; ++kt) {
        const int buf = kt & 1;
#pragma unroll
        for (int i = 0; i < ACH; ++i) { const int q = tid + i * NTHREADS; *(u32x4*)(As + (buf * BM + (q >> 2)) * LDS_ROW + (q & 3) * 8) = ra[i]; }
        *(u32x4*)(Bs + (buf * 128 + (tid >> 2)) * LDS_ROW + (tid & 3) * 8) = rb;
        __syncthreads();
        if (kt + 1 < nk) {
#pragma unroll
            for (int i = 0; i < ACH; ++i) ra[i] = *(const u32x4*)(ap[i] + (kt + 1) * 32);
            rb = *(const u32x4*)(bp + (kt + 1) * 32);
        }
        bf16x8 af[MR], bfr[4];
#pragma unroll
        for (int m = 0; m < MR; ++m) af[m] = *(const bf16x8*)(As + (buf * BM + wr * 16 * MR + m * 16 + fr) * LDS_ROW + fq * 8);
#pragma unroll
        for (int n = 0; n < 4; ++n) bfr[n] = *(const bf16x8*)(Bs + (buf * 128 + wc * 64 + n * 16 + fr) * LDS_ROW + fq * 8);
#pragma unroll
        for (int m = 0; m < MR; ++m)
#pragma unroll
            for (int n = 0; n < 4; ++n) acc[m][n] = MFMA16(af[m], bfr[n], acc[m][n]);
    }
    __syncthreads();
}
template <int MR>
DI void acc_zero(f32x4 (&acc)[MR][4]) {
#pragma unroll
    for (int m = 0; m < MR; ++m)
#pragma unroll
        for (int n = 0; n < 4; ++n) acc[m][n] = (f32x4){0.f, 0.f, 0.f, 0.f};
}

DI int gu_row(int c, int up) { return (c >> 6) * 128 + ((c >> 5) & 1) * 64 + ((c >> 4) & 1) * 16 + (c & 15) + (up ? 32 : 0); }
DI void transpose_item(const float* W, int N, int Nvalid, int k0, int n0, bf16_t* WT, int ldt, int mode, float* scr, int lane) {
#pragma unroll 4
    for (int i = 0; i < 32; ++i) {
        const int kk = 2 * i + (lane >> 5), n = n0 + (lane & 31);
        scr[kk * 33 + (lane & 31)] = (n < Nvalid) ? W[(size_t)(k0 + kk) * N + n] : 0.f;
    }
    WAVE_SYNC();
    const int c = lane & 7;
#pragma unroll
    for (int j = 0; j < 4; ++j) {
        const int nl = (lane >> 3) + 8 * j; const float* s = scr + (8 * c) * 33 + nl;
        u32x4 o; o.x = pk2(s[0], s[33]); o.y = pk2(s[2 * 33], s[3 * 33]); o.z = pk2(s[4 * 33], s[5 * 33]); o.w = pk2(s[6 * 33], s[7 * 33]);
        const int n = n0 + nl; const int row = mode == 0 ? n : gu_row(n, mode == 2);
        *(u32x4*)(WT + (size_t)row * ldt + k0 + 8 * c) = o;
    }
    WAVE_SYNC();
}
DI void transpose_matrix(const float* W, int K, int N, int Npad, bf16_t* WT, int mode, char* smem, int gw, int ngw, int& base) {
    const int lane = threadIdx.x & 63, wave = threadIdx.x >> 6;
    float* scr = (float*)smem + wave * (64 * 33);
    const int nkb = K / 64, nnb = Npad / 32, nitems = nkb * nnb;
    int first = ((gw - base) % ngw + ngw) % ngw;
    for (int it = first; it < nitems; it += ngw) {
        const int kb = it / nnb, nb = it % nnb;
        transpose_item(W, N, N, kb * 64, nb * 32, WT, K, mode, scr, lane);
    }
    base = (base + nitems) % ngw;
}

DI void phase0(const Params& p, char* smem) {
    const int tid = threadIdx.x, lane = tid & 63, wave = tid >> 6;
    if (blockIdx.x == 0 && tid < NEXP) ((int*)(p.ws + WS_CNT))[tid] = 0;
    float* sil = (float*)smem;
    float* red = sil + NV * D;
    const int nitems = 6 * D / 32;
    bool did = false;
    for (int it = blockIdx.x; it < nitems; it += gridDim.x) {
        if (!did) {
            for (int i = tid; i < NV * D; i += NTHREADS) { const int v = i / D, k = i % D; const float cv = v < NB ? p.in[I_C][v * D + k] : p.in[I_CCTX][k]; sil[i] = siluf_(cv); }
            did = true;
        }
        __syncthreads();
        const int col = it * 32 + (lane & 31), rp = lane >> 5;
        float acc[NV];
#pragma unroll
        for (int v = 0; v < NV; ++v) acc[v] = 0.f;
        const int r0 = wave * (D / 8);
#pragma unroll 8
        for (int i = 0; i < D / 16; ++i) {
            const int row = r0 + 2 * i + rp; const float w = p.in[I_ADAW][(size_t)row * (6 * D) + col];
#pragma unroll
            for (int v = 0; v < NV; ++v) acc[v] += sil[v * D + row] * w;
        }
#pragma unroll
        for (int v = 0; v < NV; ++v) red[((wave * 2 + rp) * NV + v) * 32 + (lane & 31)] = acc[v];
        __syncthreads();
        if (tid < NV * 32) {
            const int v = tid / 32, cl = tid % 32; float s = p.in[I_ADAB][it * 32 + cl];
            for (int g = 0; g < 16; ++g) s += red[(g * NV + v) * 32 + cl];
            ((float*)(p.ws + WS_MOD))[(size_t)v * 6 * D + it * 32 + cl] = s;
        }
    }
    __syncthreads();
    const int gw = blockIdx.x * 8 + wave, ngw = gridDim.x * 8; int base = 0;
    {
        float* scr = (float*)smem + wave * (64 * 33);
        const int nkb = D / 64, nnb = NP / 32, nitems2 = nkb * nnb;
        for (int it = gw; it < nitems2; it += ngw) { const int kb = it / nnb, nb = it % nnb; transpose_item(p.in[I_WIN], IN_COLS, IN_COLS, kb * 64, nb * 32, (bf16_t*)(p.aux + AUX_WINT), D, 0, scr, lane); }
        base = nitems2 % ngw;
    }
    transpose_matrix(p.in[I_WOA], 512, D, D, (bf16_t*)(p.ws + WS_WOA), 0, smem, gw, ngw, base);
    transpose_matrix(p.in[I_WOB], 512, D, D, (bf16_t*)(p.ws + WS_WOB), 0, smem, gw, ngw, base);
    transpose_matrix(p.in[I_WOUT], D, D, D, (bf16_t*)(p.ws + WS_WOUT), 0, smem, gw, ngw, base);
}

DI void phase1(const Params& p, char* smem) {
    const int lane = threadIdx.x & 63, wave = threadIdx.x >> 6;
    const int gw = blockIdx.x * 8 + wave, ngw = gridDim.x * 8;
    const float* mod = (const float*)(p.ws + WS_MOD);
    bf16_t* U = (bf16_t*)(p.aux + AUX_U);
    for (int r = gw; r < T_ALL; r += ngw) {
        const float* src; int v;
        if (r < T_CTX) { src = p.in[I_CTX] + (size_t)r * D; v = NB; } else { src = p.in[I_X] + (size_t)(r - T_CTX) * D; v = (r - T_CTX) / S; }
        f32x4 x[D / 256]; float ss = 0.f;
#pragma unroll
        for (int j = 0; j < D / 256; ++j) { x[j] = *(const f32x4*)(src + j * 256 + lane * 4); ss += x[j].x * x[j].x + x[j].y * x[j].y + x[j].z * x[j].z + x[j].w * x[j].w; }
        ss = wave_sum(ss);
        const float rstd = 1.0f / sqrtf(ss * (1.0f / D) + 1e-6f);
#pragma unroll
        for (int j = 0; j < D / 256; ++j) {
            const int k = j * 256 + lane * 4;
            const f32x4 g = *(const f32x4*)(p.in[I_NMIX] + k), sh = *(const f32x4*)(mod + (size_t)v * 6 * D + k), sc = *(const f32x4*)(mod + (size_t)v * 6 * D + D + k);
            float o0 = x[j].x * rstd * g.x * (1.f + sc.x) + sh.x, o1 = x[j].y * rstd * g.y * (1.f + sc.y) + sh.y;
            float o2 = x[j].z * rstd * g.z * (1.f + sc.z) + sh.z, o3 = x[j].w * rstd * g.w * (1.f + sc.w) + sh.w;
            u32x2 o; o.x = pk2(o0, o1); o.y = pk2(o2, o3);
            *(u32x2*)(U + (size_t)r * D + k) = o;
        }
    }
}

DI void phase2(const Params& p, char* smem) {
    const int tid = threadIdx.x, lane = tid & 63, wave = tid >> 6, wr = wave >> 1, wc = wave & 1, fr = lane & 15, fq = lane >> 4;
    const bf16_t* U = (const bf16_t*)(p.aux + AUX_U); const bf16_t* WT = (const bf16_t*)(p.aux + AUX_WINT);
    bf16_t* PL = (bf16_t*)(p.ws + WS_PLAT); bf16_t* PC = (bf16_t*)(p.ws + WS_PCTX); float* AB = (float*)(p.ws + WS_AB);
    constexpr int NT = NP / 128, MT = T_ALL / BM, NT_CTX = (CTX_COLS + 127) / 128;
    for (int t = blockIdx.x; t < MT * NT; t += gridDim.x) {
        const int mt = t / NT, nt = t % NT; const int row0 = mt * BM; const bool isctx = row0 < T_CTX;
        if (isctx && nt >= NT_CTX) continue;
        f32x4 acc[MREP][4]; acc_zero(acc);
        gemm_kloop(acc, smem, [&](int i) { return U + (size_t)(row0 + i) * D; }, WT + (size_t)nt * 128 * D, D, D);
#pragma unroll
        for (int m = 0; m < MREP; ++m)
#pragma unroll
            for (int n = 0; n < 4; ++n)
#pragma unroll
                for (int j = 0; j < 4; ++j) {
                    const int row = row0 + wr * 16 * MREP + m * 16 + fq * 4 + j, col = nt * 128 + wc * 64 + n * 16 + fr; const float v = acc[m][n][j];
                    if (isctx) { if (col < CTX_COLS) PC[(size_t)row * CTX_COLS + col] = f2bf(v); }
                    else { if (col < IN_COLS) PL[(size_t)(row - T_CTX) * IN_COLS + col] = f2bf(v); }
                    if (col >= 2048 && col < 2064) AB[(size_t)row * 16 + (col - 2048)] = v;
                }
    }
}

DI void gdn_chain(const Params& p, char* smem, int item) {
    const int d = item / (NB * H_A), b = (item / H_A) % NB, h = item % H_A;
    const int tid = threadIdx.x, lane = tid & 63, wave = tid >> 6;
    bf16_t* raw = (bf16_t*)smem;
    float* qs = (float*)(smem + 68 * 384 * 2);
    float* ks = qs + 64 * 128; float* vs = ks + 64 * 128; float* gd = vs + 64 * 128; float* be = gd + 64;
    const float* conv_w = p.in[I_CONV];
    const float alog = p.in[I_ALOG][d * 4 + h], dtb = p.in[I_DTB][d * 4 + h];
    bf16_t* ODIR = (bf16_t*)(p.aux + AUX_ODIR);
    float st[32];
#pragma unroll
    for (int i = 0; i < 32; ++i) st[i] = 0.f;
    const int vcol = tid >> 2, kg = tid & 3;
    for (int seq = 0; seq < 2; ++seq) {
        const int L = seq ? S : CTXL, nch = L / 64, ldp = seq ? IN_COLS : CTX_COLS;
        const bf16_t* pbase = seq ? (const bf16_t*)(p.ws + WS_PLAT) + (size_t)b * S * IN_COLS : (const bf16_t*)(p.ws + WS_PCTX) + (size_t)b * CTXL * CTX_COLS;
        const float* abbase = (const float*)(p.ws + WS_AB) + (size_t)(seq ? T_CTX + b * S : b * CTXL) * 16;
        for (int ci = 0; ci < nch; ++ci) {
            const int c = d ? nch - 1 - ci : ci, j0 = c * 64;
            __syncthreads();
            for (int q = tid; q < 68 * 48; q += NTHREADS) {
                const int r = q / 48, cc = q % 48, j = j0 - 2 + r;
                u32x4 val = {0u, 0u, 0u, 0u};
                if (j >= 0 && j < L) { const int s = cc / 16, ch8 = cc % 16; val = *(const u32x4*)(pbase + (size_t)j * ldp + s * 512 + h * 128 + ch8 * 8); }
                *(u32x4*)(raw + r * 384 + cc * 8) = val;
            }
            if (tid < 64) {
                const int j = j0 + tid; const float a = abbase[(size_t)j * 16 + d * 4 + h], bt = abbase[(size_t)j * 16 + 8 + d * 4 + h];
                gd[tid] = expf(-expf(alog) * softplusf_(a + dtb)); be[tid] = sigmoidf_(bt);
            }
            __syncthreads();
            for (int idx = tid; idx < 64 * 384; idx += NTHREADS) {
                const int i = idx / 384, cc = idx % 384, s = cc >> 7, ch = cc & 127;
                float a = 0.f;
#pragma unroll
                for (int j = 0; j < 5; ++j) a += bf2f(raw[(i + j) * 384 + cc]) * conv_w[j * 1536 + s * 512 + h * 128 + ch];
                const float o = siluf_(a);
                (s == 0 ? qs : (s == 1 ? ks : vs))[i * 128 + ch] = o;
            }
            __syncthreads();
            for (int pi = wave * 16; pi < wave * 16 + 16; ++pi) {
                const int i = pi >> 1, s = pi & 1; float* base = (s ? ks : qs) + i * 128;
                const float x0 = base[lane], x1 = base[lane + 64];
                const float ss = wave_sum(x0 * x0 + x1 * x1);
                const float sc = (1.0f / sqrtf(ss + 1e-6f)) * (s ? 1.0f : 0.08838834764831845f);
                base[lane] = x0 * sc; base[lane + 64] = x1 * sc;
            }
            __syncthreads();
            for (int stp = 0; stp < 64; ++stp) {
                const int i = d ? 63 - stp : stp;
                const float* kr = ks + i * 128 + kg * 32; const float* qr = qs + i * 128 + kg * 32;
                const float a = gd[i], bb = be[i], vv = vs[i * 128 + vcol];
                float pp = 0.f;
#pragma unroll
                for (int k = 0; k < 32; ++k) pp += kr[k] * st[k];
                pp += __shfl_xor(pp, 1); pp += __shfl_xor(pp, 2);
                const float vn = bb * (vv - a * pp);
                float oo = 0.f;
#pragma unroll
                for (int k = 0; k < 32; ++k) { st[k] = a * st[k] + kr[k] * vn; oo += qr[k] * st[k]; }
                oo += __shfl_xor(oo, 1); oo += __shfl_xor(oo, 2);
                if (seq && kg == 0) ODIR[((size_t)d * T_LAT + (size_t)b * S + j0 + i) * 512 + h * 128 + vcol] = f2bf(oo);
            }
        }
    }
    __syncthreads();
}

DI void rwkv_chain(const Params& p, char* smem, int item) {
    const int d = item / (NB * H_B), b = (item / H_B) % NB, h = item % H_B;
    const int tid = threadIdx.x, lane = tid & 63, wave = tid >> 6;
    float* xs = (float*)smem;
    float* kk = xs + 64 * 5 * 64;
    float* w2s = kk + 64 * 64;
    float* a2s = w2s + 64 * 64;
    const float* mu = p.in[I_MU];
    bf16_t* YDIR = (bf16_t*)(p.aux + AUX_YDIR); float* BON = (float*)(p.ws + WS_BONUS);
    __syncthreads();
    for (int i = tid; i < 64 * 64; i += NTHREADS) { const int r = i >> 6, c = i & 63; w2s[i] = p.in[I_W2][((size_t)d * 64 + r) * 512 + h * 64 + c]; a2s[i] = p.in[I_A2][((size_t)d * 64 + r) * 512 + h * 64 + c]; }
    float st[8];
#pragma unroll
    for (int i = 0; i < 8; ++i) st[i] = 0.f;
    const int vrow = tid >> 3, cg = tid & 7;
    for (int seq = 0; seq < 2; ++seq) {
        const int L = seq ? S : CTXL, nch = L / 64, ldp = seq ? IN_COLS : CTX_COLS;
        const bf16_t* pbase = seq ? (const bf16_t*)(p.ws + WS_PLAT) + (size_t)b * S * IN_COLS : (const bf16_t*)(p.ws + WS_PCTX) + (size_t)b * CTXL * CTX_COLS;
        auto rowof = [&](int j) -> int { return seq ? (j % ROWS) * GW + j / ROWS : j; };
        for (int ci = 0; ci < nch; ++ci) {
            const int c = d ? nch - 1 - ci : ci, j0 = c * 64;
            __syncthreads();
            for (int q = tid; q < 64 * 40; q += NTHREADS) {
                const int i = q / 40, rem = q % 40, seg = rem >> 3, c8 = rem & 7, j = j0 + i;
                const int bcol = (seg < 3 ? seg * 512 + h * 64 : (seg == 3 ? 1536 + d * 64 : 1664 + d * 64)) + c8 * 8;
                const u32x4 cur = *(const u32x4*)(pbase + (size_t)rowof(j) * ldp + COL_B0 + bcol);
                u32x4 prv = {0u, 0u, 0u, 0u}, nxt = {0u, 0u, 0u, 0u};
                if (j > 0) prv = *(const u32x4*)(pbase + (size_t)rowof(j - 1) * ldp + COL_B0 + bcol);
                if (j < L - 1) nxt = *(const u32x4*)(pbase + (size_t)rowof(j + 1) * ldp + COL_B0 + bcol);
                const bf16_t* pc = (const bf16_t*)&cur; const bf16_t* pp = (const bf16_t*)&prv; const bf16_t* pn = (const bf16_t*)&nxt;
#pragma unroll
                for (int e = 0; e < 8; ++e) {
                    const float cu = bf2f(pc[e]); float x = cu + (0.5f * (bf2f(pp[e]) + bf2f(pn[e])) - cu) * mu[bcol + e];
                    if (seg == 3) x = tanhf(x);
                    xs[(i * 5 + seg) * 64 + c8 * 8 + e] = x;
                }
            }
            __syncthreads();
            for (int i = wave * 8; i < wave * 8 + 8; ++i) {
                const float kx = xs[(i * 5 + 1) * 64 + lane] * p.in[I_KK][h * 64 + lane];
                const float ss = wave_sum(kx * kx);
                kk[i * 64 + lane] = kx * (1.0f / sqrtf(ss + 1e-6f));
            }
            __syncthreads();
            {
                const int i = vrow;
                float accw[8], acca[8];
#pragma unroll
                for (int e = 0; e < 8; ++e) { accw[e] = 0.f; acca[e] = 0.f; }
                for (int r = 0; r < 64; ++r) {
                    const float tw = xs[(i * 5 + 3) * 64 + r], al = xs[(i * 5 + 4) * 64 + r];
#pragma unroll
                    for (int e = 0; e < 8; ++e) { accw[e] += tw * w2s[r * 64 + cg * 8 + e]; acca[e] += al * a2s[r * 64 + cg * 8 + e]; }
                }
                __syncthreads();
                float bon = 0.f;
#pragma unroll
                for (int e = 0; e < 8; ++e) {
                    const int cc = cg * 8 + e, gc = h * 64 + cc;
                    const float wl = -softplusf_(-(p.in[I_W0][d * 512 + gc] + accw[e])) - 0.5f;
                    const float dec = expf(-expf(wl));
                    const float ic = sigmoidf_(p.in[I_A0][d * 512 + gc] + acca[e]);
                    const float kv = xs[(i * 5 + 1) * 64 + cc];
                    const float kd = kv * (1.f + (ic - 1.f) * p.in[I_KA][gc]);
                    xs[(i * 5 + 1) * 64 + cc] = kd; xs[(i * 5 + 3) * 64 + cc] = dec; xs[(i * 5 + 4) * 64 + cc] = kk[i * 64 + cc] * ic;
                    bon += xs[(i * 5 + 0) * 64 + cc] * kd * p.in[I_RK][gc];
                }
                bon += __shfl_xor(bon, 1); bon += __shfl_xor(bon, 2); bon += __shfl_xor(bon, 4);
                if (seq && cg == 0) BON[((size_t)d * T_LAT + (size_t)b * S + rowof(j0 + i)) * 8 + h] = bon;
            }
            __syncthreads();
            for (int stp = 0; stp < 64; ++stp) {
                const int i = d ? 63 - stp : stp;
                const float* rr = xs + (i * 5 + 0) * 64 + cg * 8; const float* kr = xs + (i * 5 + 1) * 64 + cg * 8;
                const float* wr_ = xs + (i * 5 + 3) * 64 + cg * 8; const float* br = xs + (i * 5 + 4) * 64 + cg * 8; const float* ar = kk + i * 64 + cg * 8;
                const float vv = xs[(i * 5 + 2) * 64 + vrow];
                float sa = 0.f;
#pragma unroll
                for (int e = 0; e < 8; ++e) sa -= st[e] * ar[e];
                sa += __shfl_xor(sa, 1); sa += __shfl_xor(sa, 2); sa += __shfl_xor(sa, 4);
                float y = 0.f;
#pragma unroll
                for (int e = 0; e < 8; ++e) { st[e] = st[e] * wr_[e] + sa * br[e] + vv * kr[e]; y += st[e] * rr[e]; }
                y += __shfl_xor(y, 1); y += __shfl_xor(y, 2); y += __shfl_xor(y, 4);
                if (seq && cg == 0) YDIR[((size_t)d * T_LAT + (size_t)b * S + rowof(j0 + i)) * 512 + h * 64 + vrow] = f2bf(y);
            }
        }
    }
    __syncthreads();
}

DI void phase3(const Params& p, char* smem) {
    constexpr int NG = 2 * NB * H_A, NR = 2 * NB * H_B;
    for (int it = blockIdx.x; it < NG + NR; it += gridDim.x) {
        if (it < NG) gdn_chain(p, smem, it); else rwkv_chain(p, smem, it - NG);
    }
}

DI void phase4(const Params& p, char* smem) {
    const int tid = threadIdx.x, lane = tid & 63, wave = tid >> 6;
    const bf16_t* PL = (const bf16_t*)(p.ws + WS_PLAT);
    const bf16_t* ODIR = (const bf16_t*)(p.aux + AUX_ODIR); const bf16_t* YDIR = (const bf16_t*)(p.aux + AUX_YDIR);
    const float* BON = (const float*)(p.ws + WS_BONUS); const float* mu = p.in[I_MU];
    bf16_t* OA = (bf16_t*)(p.ws + WS_OA); bf16_t* OB = (bf16_t*)(p.ws + WS_OB);
    float* sg = (float*)smem;
    for (int it = blockIdx.x; it < T_LAT / 16; it += gridDim.x) {
        const int tok0 = it * 16, b = tok0 / S, l0 = tok0 % S;
        __syncthreads();
        for (int idx = tid; idx < 16 * 128; idx += NTHREADS) {
            const int t = idx >> 7, jj = idx & 127, l = l0 + t, j = (l % GW) * ROWS + l / GW, col = COL_B0 + 1792 + jj;
            const float cu = bf2f(PL[(size_t)(b * S + l) * IN_COLS + col]);
            float pv = 0.f, nx = 0.f;
            if (j > 0) { const int l2 = ((j - 1) % ROWS) * GW + (j - 1) / ROWS; pv = bf2f(PL[(size_t)(b * S + l2) * IN_COLS + col]); }
            if (j < S - 1) { const int l2 = ((j + 1) % ROWS) * GW + (j + 1) / ROWS; nx = bf2f(PL[(size_t)(b * S + l2) * IN_COLS + col]); }
            sg[idx] = sigmoidf_(cu + (0.5f * (pv + nx) - cu) * mu[1792 + jj]);
        }
        __syncthreads();
        {
            const int c = tid, h = wave;
            float gacc[16];
#pragma unroll
            for (int t = 0; t < 16; ++t) gacc[t] = 0.f;
            for (int jj = 0; jj < 128; ++jj) {
                const float g = p.in[I_G2][jj * 512 + c];
#pragma unroll
                for (int t = 0; t < 16; ++t) gacc[t] += sg[t * 128 + jj] * g;
            }
            const float lg = p.in[I_LNG][c], lb = p.in[I_LNB][c], muv = mu[1024 + c];
#pragma unroll
            for (int t = 0; t < 16; ++t) {
                const int l = l0 + t, tok = b * S + l, j = (l % GW) * ROWS + l / GW, col = COL_B0 + 1024 + c;
                const float yf = bf2f(YDIR[(size_t)tok * 512 + c]) + bf2f(YDIR[((size_t)T_LAT + tok) * 512 + c]);
                const float mean = wave_sum(yf) * (1.f / 64.f); const float dv = yf - mean;
                const float var = wave_sum(dv * dv) * (1.f / 64.f);
                const float yn = dv * (1.0f / sqrtf(var + 64e-5f)) * lg + lb;
                const float cu = bf2f(PL[(size_t)tok * IN_COLS + col]);
                float pv = 0.f, nx = 0.f;
                if (j > 0) { const int l2 = ((j - 1) % ROWS) * GW + (j - 1) / ROWS; pv = bf2f(PL[(size_t)(b * S + l2) * IN_COLS + col]); }
                if (j < S - 1) { const int l2 = ((j + 1) % ROWS) * GW + (j + 1) / ROWS; nx = bf2f(PL[(size_t)(b * S + l2) * IN_COLS + col]); }
                const float xv = cu + (0.5f * (pv + nx) - cu) * muv;
                const float bon = BON[(size_t)tok * 8 + h] + BON[((size_t)T_LAT + tok) * 8 + h];
                OB[(size_t)tok * 512 + c] = f2bf((yn + bon * xv) * gacc[t]);
            }
        }
        for (int pi = wave * 8; pi < wave * 8 + 8; ++pi) {
            const int t = pi >> 2, h = pi & 3, tok = tok0 + t;
            const size_t o0 = (size_t)tok * 512 + h * 128;
            const float a0 = bf2f(ODIR[o0 + lane]) + bf2f(ODIR[(size_t)T_LAT * 512 + o0 + lane]);
            const float a1 = bf2f(ODIR[o0 + lane + 64]) + bf2f(ODIR[(size_t)T_LAT * 512 + o0 + lane + 64]);
            const float ss = wave_sum(a0 * a0 + a1 * a1);
            const float rstd = 1.0f / sqrtf(ss * (1.f / 128.f) + 1e-6f);
            const float z0 = bf2f(PL[(size_t)tok * IN_COLS + 1536 + h * 128 + lane]), z1 = bf2f(PL[(size_t)tok * IN_COLS + 1536 + h * 128 + lane + 64]);
            OA[o0 + lane] = f2bf(a0 * rstd * p.in[I_ONORM][lane] * siluf_(z0));
            OA[o0 + lane + 64] = f2bf(a1 * rstd * p.in[I_ONORM][lane + 64] * siluf_(z1));
        }
    }
}

DI void phase5(const Params& p, char* smem) {
    const int tid = threadIdx.x, lane = tid & 63, wave = tid >> 6, wr = wave >> 1, wc = wave & 1, fr = lane & 15, fq = lane >> 4;
    const bf16_t* OA = (const bf16_t*)(p.ws + WS_OA); const bf16_t* OB = (const bf16_t*)(p.ws + WS_OB);
    const bf16_t* WA = (const bf16_t*)(p.ws + WS_WOA); const bf16_t* WB = (const bf16_t*)(p.ws + WS_WOB);
    const bf16_t* PL = (const bf16_t*)(p.ws + WS_PLAT); bf16_t* Y = (bf16_t*)(p.aux + AUX_Y);
    constexpr int MR5 = 2, BM5 = 64 * MR5; constexpr int NT = D / 128, MT = T_LAT / BM5;
    for (int t = blockIdx.x; t < MT * NT; t += gridDim.x) {
        const int mt = t / NT, nt = t % NT, row0 = mt * BM5;
        f32x4 acca[MR5][4], accb[MR5][4]; acc_zero(acca); acc_zero(accb);
        gemm_kloop(acca, smem, [&](int i) { return OA + (size_t)(row0 + i) * 512; }, WA + (size_t)nt * 128 * 512, 512, 512);
        gemm_kloop(accb, smem, [&](int i) { return OB + (size_t)(row0 + i) * 512; }, WB + (size_t)nt * 128 * 512, 512, 512);
#pragma unroll
        for (int m = 0; m < MR5; ++m)
#pragma unroll
            for (int n = 0; n < 4; ++n)
#pragma unroll
                for (int j = 0; j < 4; ++j) {
                    const int row = row0 + wr * 16 * MR5 + m * 16 + fq * 4 + j, col = nt * 128 + wc * 64 + n * 16 + fr;
                    const float ga = bf2f(PL[(size_t)row * IN_COLS + COL_G0 + col]), gb = bf2f(PL[(size_t)row * IN_COLS + COL_G0 + D + col]);
                    Y[(size_t)row * D + col] = f2bf(sigmoidf_(ga) * acca[m][n][j] + sigmoidf_(gb) * accb[m][n][j]);
                }
    }
}

DI void phase6(const Params& p, char* smem) {
    const int tid = threadIdx.x, lane = tid & 63, wave = tid >> 6, wr = wave >> 1, wc = wave & 1, fr = lane & 15, fq = lane >> 4;
    const bf16_t* Y = (const bf16_t*)(p.aux + AUX_Y); const bf16_t* WO = (const bf16_t*)(p.ws + WS_WOUT);
    const float* mod = (const float*)(p.ws + WS_MOD); float* Hh = (float*)(p.ws + WS_H);
    constexpr int NT = D / 128, MT = T_LAT / BM;
    for (int t = blockIdx.x; t < MT * NT; t += gridDim.x) {
        const int mt = t / NT, nt = t % NT, row0 = mt * BM;
        f32x4 acc[MREP][4]; acc_zero(acc);
        gemm_kloop(acc, smem, [&](int i) { return Y + (size_t)(row0 + i) * D; }, WO + (size_t)nt * 128 * D, D, D);
#pragma unroll
        for (int m = 0; m < MREP; ++m)
#pragma unroll
            for (int n = 0; n < 4; ++n)
#pragma unroll
                for (int j = 0; j < 4; ++j) {
                    const int row = row0 + wr * 16 * MREP + m * 16 + fq * 4 + j, col = nt * 128 + wc * 64 + n * 16 + fr, b = row / S;
                    Hh[(size_t)row * D + col] = p.in[I_X][(size_t)row * D + col] + mod[(size_t)b * 6 * D + 2 * D + col] * acc[m][n][j];
                }
    }
    __syncthreads();
    const int gw = blockIdx.x * 8 + wave, ngw = gridDim.x * 8;
    float* scr = (float*)smem + wave * (64 * 33);
    bf16_t* GUT = (bf16_t*)(p.aux + AUX_GUT); bf16_t* DNT = (bf16_t*)(p.ws + WS_DNT);
    {
        constexpr int nkb = D / 64, nnb = DE / 32, per = nkb * nnb;
        for (int it = gw; it < NEXP * 2 * per; it += ngw) {
            const int e = it / (2 * per), r = it % (2 * per), up = r / per, r2 = r % per, kb = r2 / nnb, nb = r2 % nnb;
            transpose_item((up ? p.in[I_MU_UP] : p.in[I_MG]) + (size_t)e * D * DE, DE, DE, kb * 64, nb * 32, GUT + (size_t)e * 512 * D, D, up ? 2 : 1, scr, lane);
        }
    }
    {
        constexpr int nkb = DE / 64, nnb = D / 32, per = nkb * nnb;
        for (int it = gw; it < NEXP * per; it += ngw) {
            const int e = it / per, r2 = it % per, kb = r2 / nnb, nb = r2 % nnb;
            transpose_item(p.in[I_MD] + (size_t)e * DE * D, D, D, kb * 64, nb * 32, DNT + (size_t)e * D * DE, DE, 0, scr, lane);
        }
    }
}

DI void phase7(const Params& p, char* smem) {
    const int tid = threadIdx.x, lane = tid & 63, wave = tid >> 6;
    const int gw = blockIdx.x * 8 + wave, ngw = gridDim.x * 8;
    const float* Hh = (const float*)(p.ws + WS_H); const float* mod = (const float*)(p.ws + WS_MOD);
    bf16_t* Tt = (bf16_t*)(p.ws + WS_T); int* cnt = (int*)(p.ws + WS_CNT); int* rowlist = (int*)(p.ws + WS_ROWLIST); float* pairw = (float*)(p.ws + WS_PAIRW);
    float* tb = (float*)smem + wave * (4 * D + 4 * 40);
    float* lgt = tb + 4 * D;
    for (int it = gw; it < T_LAT / 4; it += ngw) {
        const int tok0 = it * 4;
#pragma unroll
        for (int tt = 0; tt < 4; ++tt) {
            const int tok = tok0 + tt, b = tok / S; const float* src = Hh + (size_t)tok * D;
            f32x4 x[D / 256]; float ss = 0.f;
#pragma unroll
            for (int j = 0; j < D / 256; ++j) { x[j] = *(const f32x4*)(src + j * 256 + lane * 4); ss += x[j].x * x[j].x + x[j].y * x[j].y + x[j].z * x[j].z + x[j].w * x[j].w; }
            ss = wave_sum(ss);
            const float rstd = 1.0f / sqrtf(ss * (1.0f / D) + 1e-6f);
#pragma unroll
            for (int j = 0; j < D / 256; ++j) {
                const int k = j * 256 + lane * 4;
                const f32x4 g = *(const f32x4*)(p.in[I_NFFN] + k), sh = *(const f32x4*)(mod + (size_t)b * 6 * D + 3 * D + k), sc = *(const f32x4*)(mod + (size_t)b * 6 * D + 4 * D + k);
                f32x4 o; o.x = x[j].x * rstd * g.x * (1.f + sc.x) + sh.x; o.y = x[j].y * rstd * g.y * (1.f + sc.y) + sh.y;
                o.z = x[j].z * rstd * g.z * (1.f + sc.z) + sh.z; o.w = x[j].w * rstd * g.w * (1.f + sc.w) + sh.w;
                *(f32x4*)(tb + tt * D + k) = o;
                u32x2 ob; ob.x = pk2(o.x, o.y); ob.y = pk2(o.z, o.w);
                *(u32x2*)(Tt + (size_t)tok * D + k) = ob;
            }
        }
        WAVE_SYNC();
        {
            float a0 = 0.f, a1 = 0.f, a2 = 0.f, a3 = 0.f;
            const int col = lane < 36 ? lane : 35;
            const float* wp = col < 4 ? p.in[I_RG] + col : p.in[I_RE] + (col - 4); const int ldw = col < 4 ? 4 : 32;
            for (int k = 0; k < D; ++k) { const float w = wp[(size_t)k * ldw]; a0 += tb[k] * w; a1 += tb[D + k] * w; a2 += tb[2 * D + k] * w; a3 += tb[3 * D + k] * w; }
            const float bias = col < 4 ? p.in[I_RGB][col] : p.in[I_REB][col - 4];
            if (lane < 36) { lgt[0 * 40 + lane] = a0 + bias; lgt[1 * 40 + lane] = a1 + bias; lgt[2 * 40 + lane] = a2 + bias; lgt[3 * 40 + lane] = a3 + bias; }
        }
        WAVE_SYNC();
        if (lane < 4) {
            const float* L = lgt + lane * 40; const int tok = tok0 + lane;
            int g = 0; float mx = L[0];
            for (int i = 1; i < 4; ++i) if (L[i] > mx) { mx = L[i]; g = i; }
            float se = 0.f; for (int i = 0; i < 4; ++i) se += expf(L[i] - mx);
            const float pg = 1.0f / se;
            const float* E = L + 4 + g * 8;
            int i1 = 0; float l1 = E[0];
            for (int i = 1; i < 8; ++i) if (E[i] > l1) { l1 = E[i]; i1 = i; }
            int i2 = -1; float l2 = -3.0e38f;
            for (int i = 0; i < 8; ++i) if (i != i1 && E[i] > l2) { l2 = E[i]; i2 = i; }
            const float e2 = expf(l2 - l1); const float w1 = pg / (1.f + e2), w2 = pg * e2 / (1.f + e2);
            const int ex1 = g * 8 + i1, ex2 = g * 8 + i2;
            const int p1 = atomicAdd(&cnt[ex1], 1); rowlist[(size_t)ex1 * CAP + p1] = tok * 2; pairw[tok * 2] = w1;
            const int p2 = atomicAdd(&cnt[ex2], 1); rowlist[(size_t)ex2 * CAP + p2] = tok * 2 + 1; pairw[tok * 2 + 1] = w2;
        }
        WAVE_SYNC();
    }
}

DI void moe_tiles(const Params& p, char* smem, int* pre) {
    const int* cnt = (const int*)(p.ws + WS_CNT);
    __syncthreads();
    if (threadIdx.x == 0) { int s = 0; for (int e = 0; e < NEXP; ++e) { pre[e] = s; s += (cnt[e] + BM - 1) / BM; } pre[NEXP] = s; }
    __syncthreads();
}
DI void phase8(const Params& p, char* smem) {
    const int tid = threadIdx.x, lane = tid & 63, wave = tid >> 6, wr = wave >> 1, wc = wave & 1, fr = lane & 15, fq = lane >> 4;
    int* pre = (int*)(smem + LDS_BYTES - 256);
    moe_tiles(p, smem, pre);
    const int* cnt = (const int*)(p.ws + WS_CNT); const int* rowlist = (const int*)(p.ws + WS_ROWLIST);
    const bf16_t* Tt = (const bf16_t*)(p.ws + WS_T); const bf16_t* GUT = (const bf16_t*)(p.aux + AUX_GUT); bf16_t* HID = (bf16_t*)(p.ws + WS_HID);
    const int ntile = pre[NEXP] * 4;
    for (int t = blockIdx.x; t < ntile; t += gridDim.x) {
        const int mg = t >> 2, nt = t & 3; int e = 0;
        while (pre[e + 1] <= mg) ++e;
        const int mt = mg - pre[e], ce = cnt[e]; const int* rl = rowlist + (size_t)e * CAP;
        f32x4 acc[MREP][4]; acc_zero(acc);
        gemm_kloop(acc, smem, [&](int i) { int idx = mt * BM + i; idx = idx < ce ? idx : ce - 1; return Tt + (size_t)(rl[idx] >> 1) * D; }, GUT + ((size_t)e * 512 + nt * 128) * D, D, D);
#pragma unroll
        for (int m = 0; m < MREP; ++m)
#pragma unroll
            for (int j = 0; j < 4; ++j) {
                const int idx = mt * BM + wr * 16 * MREP + m * 16 + fq * 4 + j;
                if (idx < ce) {
                    const int pair = rl[idx];
#pragma unroll
                    for (int n = 0; n < 2; ++n) {
                        const float g = acc[m][n][j], u = acc[m][n + 2][j];
                        HID[(size_t)pair * DE + nt * 64 + wc * 32 + n * 16 + fr] = f2bf(siluf_(g) * u);
                    }
                }
            }
    }
}
DI void phase9(const Params& p, char* smem) {
    const int tid = threadIdx.x, lane = tid & 63, wave = tid >> 6, wr = wave >> 1, wc = wave & 1, fr = lane & 15, fq = lane >> 4;
    int* pre = (int*)(smem + LDS_BYTES - 256);
    moe_tiles(p, smem, pre);
    const int* cnt = (const int*)(p.ws + WS_CNT); const int* rowlist = (const int*)(p.ws + WS_ROWLIST); const float* pairw = (const float*)(p.ws + WS_PAIRW);
    const bf16_t* HID = (const bf16_t*)(p.ws + WS_HID); const bf16_t* DNT = (const bf16_t*)(p.ws + WS_DNT); bf16_t* OP = (bf16_t*)(p.ws + WS_OPAIR);
    constexpr int NT = D / 128;
    const int ntile = pre[NEXP] * NT;
    for (int t = blockIdx.x; t < ntile; t += gridDim.x) {
        const int mg = t / NT, nt = t % NT; int e = 0;
        while (pre[e + 1] <= mg) ++e;
        const int mt = mg - pre[e], ce = cnt[e]; const int* rl = rowlist + (size_t)e * CAP;
        f32x4 acc[MREP][4]; acc_zero(acc);
        gemm_kloop(acc, smem, [&](int i) { int idx = mt * BM + i; idx = idx < ce ? idx : ce - 1; return HID + (size_t)rl[idx] * DE; }, DNT + ((size_t)e * D + nt * 128) * DE, DE, DE);
#pragma unroll
        for (int m = 0; m < MREP; ++m)
#pragma unroll
            for (int j = 0; j < 4; ++j) {
                const int idx = mt * BM + wr * 16 * MREP + m * 16 + fq * 4 + j;
                if (idx < ce) {
                    const int pair = rl[idx]; const float w = pairw[pair];
#pragma unroll
                    for (int n = 0; n < 4; ++n) OP[(size_t)pair * D + nt * 128 + wc * 64 + n * 16 + fr] = f2bf(acc[m][n][j] * w);
                }
            }
    }
}

DI void phase10(const Params& p, char* smem) {
    const int lane = threadIdx.x & 63, wave = threadIdx.x >> 6;
    const int gw = blockIdx.x * 8 + wave, ngw = gridDim.x * 8;
    const float* Hh = (const float*)(p.ws + WS_H); const float* mod = (const float*)(p.ws + WS_MOD); const bf16_t* OP = (const bf16_t*)(p.ws + WS_OPAIR);
    for (int tok = gw; tok < T_LAT; tok += ngw) {
        const int b = tok / S;
        f32x4 x[D / 256]; float ss = 0.f;
#pragma unroll
        for (int j = 0; j < D / 256; ++j) {
            const int k = j * 256 + lane * 4;
            const f32x4 hv = *(const f32x4*)(Hh + (size_t)tok * D + k), g2 = *(const f32x4*)(mod + (size_t)b * 6 * D + 5 * D + k);
            const u32x2 p0 = *(const u32x2*)(OP + (size_t)(tok * 2) * D + k), p1 = *(const u32x2*)(OP + (size_t)(tok * 2 + 1) * D + k);
            f32x4 m;
            m.x = bf2f((bf16_t)(p0.x & 0xffffu)) + bf2f((bf16_t)(p1.x & 0xffffu)); m.y = bf2f((bf16_t)(p0.x >> 16)) + bf2f((bf16_t)(p1.x >> 16));
            m.z = bf2f((bf16_t)(p0.y & 0xffffu)) + bf2f((bf16_t)(p1.y & 0xffffu)); m.w = bf2f((bf16_t)(p0.y >> 16)) + bf2f((bf16_t)(p1.y >> 16));
            x[j].x = hv.x + g2.x * m.x; x[j].y = hv.y + g2.y * m.y; x[j].z = hv.z + g2.z * m.z; x[j].w = hv.w + g2.w * m.w;
            ss += x[j].x * x[j].x + x[j].y * x[j].y + x[j].z * x[j].z + x[j].w * x[j].w;
        }
        ss = wave_sum(ss);
        const float rstd = 1.0f / sqrtf(ss * (1.0f / D) + 1e-6f);
#pragma unroll
        for (int j = 0; j < D / 256; ++j) {
            const int k = j * 256 + lane * 4; const f32x4 g = *(const f32x4*)(p.in[I_FIN] + k);
            f32x4 o; o.x = x[j].x * rstd * g.x; o.y = x[j].y * rstd * g.y; o.z = x[j].z * rstd * g.z; o.w = x[j].w * rstd * g.w;
            *(f32x4*)(p.out + (size_t)tok * D + k) = o;
        }
    }
}

DI void run_phase(const Params& p, int ph, char* smem) {
    switch (ph) {
        case 0: phase0(p, smem); break;
        case 1: phase1(p, smem); break;
        case 2: phase2(p, smem); break;
        case 3: phase3(p, smem); break;
        case 4: phase4(p, smem); break;
        case 5: phase5(p, smem); break;
        case 6: phase6(p, smem); break;
        case 7: phase7(p, smem); break;
        case 8: phase8(p, smem); break;
        case 9: phase9(p, smem); break;
        default: phase10(p, smem); break;
    }
}

#ifndef EMU
namespace cg = cooperative_groups;
__global__ void __launch_bounds__(NTHREADS) mk_forward(Params p) {
    extern __shared__ __attribute__((aligned(16))) char smem[];
    cg::grid_group grid = cg::this_grid();
    const int lo = p.ph_lo, hi = p.ph_hi;
#define PHASE(k, fn) if (lo <= (k) && (k) < hi) { fn(p, smem); if ((k) + 1 < hi) grid.sync(); }
    PHASE(0, phase0) PHASE(1, phase1) PHASE(2, phase2) PHASE(3, phase3) PHASE(4, phase4) PHASE(5, phase5)
    PHASE(6, phase6) PHASE(7, phase7) PHASE(8, phase8) PHASE(9, phase9) PHASE(10, phase10)
#undef PHASE
}

extern "C" void kernel_launch(void* const* d_in, const int* in_sizes, int n_in, void* d_out, int out_size, void* d_ws, size_t ws_size, hipStream_t stream) {
    static int grid_blocks = 0;
    if (grid_blocks == 0) {
        if (n_in != 35 || out_size != T_LAT * D || ws_size < WS_END || (size_t)out_size * 4 < AUX_END) {
            fprintf(stderr, "kernel_launch: unexpected shapes (n_in %d out %d ws %zu need %zu aux need %zu)\n", n_in, out_size, ws_size, (size_t)WS_END, (size_t)AUX_END);
            grid_blocks = -1; return;
        }
        int dev = 0, cus = 0, per_cu = 0;
        hipGetDevice(&dev);
        hipDeviceGetAttribute(&cus, hipDeviceAttributeMultiprocessorCount, dev);
        hipFuncSetAttribute((const void*)mk_forward, hipFuncAttributeMaxDynamicSharedMemorySize, LDS_BYTES);
        hipOccupancyMaxActiveBlocksPerMultiprocessor(&per_cu, (const void*)mk_forward, NTHREADS, LDS_BYTES);
        if (per_cu < 1) { fprintf(stderr, "kernel_launch: occupancy query says %d blocks/CU\n", per_cu); per_cu = 1; }
        if (per_cu > 1) per_cu = 1;
        grid_blocks = cus * per_cu;
    }
    if (grid_blocks < 0) return;
    Params p{};
    for (int i = 0; i < 35; ++i) p.in[i] = (const float*)d_in[i];
    p.out = (float*)d_out; p.ws = (char*)d_ws; p.aux = (char*)d_out;
#if MK_LAUNCHES == 1
    p.ph_lo = 0; p.ph_hi = NPHASES;
    void* args[] = {&p};
    hipError_t e = hipLaunchCooperativeKernel((const void*)mk_forward, dim3(grid_blocks), dim3(NTHREADS), args, LDS_BYTES, stream);
    if (e != hipSuccess) fprintf(stderr, "cooperative launch failed: %s (grid %d)\n", hipGetErrorString(e), grid_blocks);
#else
    for (int ph = 0; ph < NPHASES; ++ph) {
        p.ph_lo = ph; p.ph_hi = ph + 1;
        void* args[] = {&p};
        hipError_t e = hipLaunchCooperativeKernel((const void*)mk_forward, dim3(grid_blocks), dim3(NTHREADS), args, LDS_BYTES, stream);
        if (e != hipSuccess) { fprintf(stderr, "cooperative launch %d failed: %s (grid %d)\n", ph, hipGetErrorString(e), grid_blocks); break; }
    }
#endif
}
#endif
```

```cpp
#ifndef EMU
#include <hip/hip_runtime.h>
#include <hip/hip_cooperative_groups.h>
#include <cstdio>
#endif
#include <stdint.h>
#include <stddef.h>

#ifndef CFG_D
#define CFG_D 1024
#define CFG_B 8
#define CFG_S 2048
#define CFG_CTX 256
#endif
#ifndef MK_LAUNCHES
#define MK_LAUNCHES 1
#endif

typedef unsigned short bf16_t;
typedef short bf16x8 __attribute__((ext_vector_type(8)));
typedef float f32x4 __attribute__((ext_vector_type(4)));
typedef unsigned u32x4 __attribute__((ext_vector_type(4)));
typedef unsigned u32x2 __attribute__((ext_vector_type(2)));

#define DI __device__ __forceinline__

constexpr int D = CFG_D, NB = CFG_B, S = CFG_S, CTXL = CFG_CTX;
constexpr int GW = 64, ROWS = S / GW;
constexpr int T_CTX = NB * CTXL, T_LAT = NB * S, T_ALL = T_CTX + T_LAT;
constexpr int H_A = 4, H_B = 8;
constexpr int A_COLS = 2064, B_COLS = 1920;
constexpr int IN_COLS = A_COLS + B_COLS + 2 * D;
constexpr int COL_B0 = A_COLS, COL_G0 = A_COLS + B_COLS;
constexpr int CTX_COLS = COL_G0;
constexpr int NP = ((IN_COLS + 127) / 128) * 128;
constexpr int NEXP = 32, DE = 256;
constexpr int NV = NB + 1;
constexpr int NTHREADS = 512;
constexpr int MREP = (T_CTX % 256 == 0 && T_LAT % 256 == 0) ? 4 : 2;
constexpr int BM = 64 * MREP;
constexpr int NPHASES = 11;
constexpr int LDS_BYTES = 155648;
constexpr int CAP = T_LAT;

static_assert(D % 256 == 0 && S % 64 == 0 && CTXL % 64 == 0 && T_CTX % BM == 0 && T_LAT % BM == 0, "shape");

constexpr size_t al256(size_t x) { return (x + 255) & ~(size_t)255; }
constexpr size_t WS_CNT = 0;
constexpr size_t WS_BAR = 256;
constexpr size_t WS_MOD = 512;
constexpr size_t WS_AB = al256(WS_MOD + (size_t)NV * 6 * D * 4);
constexpr size_t WS_BONUS = al256(WS_AB + (size_t)T_ALL * 16 * 4);
constexpr size_t WS_PAIRW = al256(WS_BONUS + (size_t)2 * T_LAT * 8 * 4);
constexpr size_t WS_ROWLIST = al256(WS_PAIRW + (size_t)T_LAT * 2 * 4);
constexpr size_t WS_WOA = al256(WS_ROWLIST + (size_t)NEXP * CAP * 4);
constexpr size_t WS_WOB = al256(WS_WOA + (size_t)D * 512 * 2);
constexpr size_t WS_WOUT = al256(WS_WOB + (size_t)D * 512 * 2);
constexpr size_t WS_OA = al256(WS_WOUT + (size_t)D * D * 2);
constexpr size_t WS_OB = al256(WS_OA + (size_t)T_LAT * 512 * 2);
constexpr size_t WS_DNT = WS_OA;
constexpr size_t WS_SPARE_END = al256(WS_OB + (size_t)T_LAT * 512 * 2) > al256(WS_DNT + (size_t)NEXP * D * DE * 2) ? al256(WS_OB + (size_t)T_LAT * 512 * 2) : al256(WS_DNT + (size_t)NEXP * D * DE * 2);
constexpr size_t WS_P = WS_SPARE_END;
constexpr size_t WS_PLAT = WS_P;
constexpr size_t WS_PCTX = al256(WS_PLAT + (size_t)T_LAT * IN_COLS * 2);
constexpr size_t WS_P_END = al256(WS_PCTX + (size_t)T_CTX * CTX_COLS * 2);
constexpr size_t WS_H = WS_P;
constexpr size_t WS_T = al256(WS_H + (size_t)T_LAT * D * 4);
constexpr size_t WS_HID = al256(WS_T + (size_t)T_LAT * D * 2);
constexpr size_t WS_OPAIR = al256(WS_HID + (size_t)T_LAT * 2 * DE * 2);
constexpr size_t WS_P2_END = al256(WS_OPAIR + (size_t)T_LAT * 2 * D * 2);
constexpr size_t WS_END = WS_P_END > WS_P2_END ? WS_P_END : WS_P2_END;
constexpr size_t AUX_WINT = 0;
constexpr size_t AUX_U = al256((size_t)NP * D * 2);
constexpr size_t AUX_ODIR = 0;
constexpr size_t AUX_YDIR = (size_t)2 * T_LAT * 512 * 2;
constexpr size_t AUX_Y = 0;
constexpr size_t AUX_GUT = (size_t)T_LAT * D * 2;
constexpr size_t AUX_END1 = AUX_U + (size_t)T_ALL * D * 2;
constexpr size_t AUX_END2 = AUX_YDIR + (size_t)2 * T_LAT * 512 * 2;
constexpr size_t AUX_END3 = AUX_GUT + (size_t)NEXP * 512 * D * 2;
constexpr size_t AUX_END = (AUX_END1 > AUX_END2 ? (AUX_END1 > AUX_END3 ? AUX_END1 : AUX_END3) : (AUX_END2 > AUX_END3 ? AUX_END2 : AUX_END3));

struct Params {
    const float* in[35];
    float* out;
    char* ws;
    char* aux;
    int ph_lo, ph_hi;
};
enum { I_X = 0, I_C, I_CTX, I_CCTX, I_ADAW, I_ADAB, I_NMIX, I_NFFN, I_WIN, I_CONV, I_ALOG, I_DTB, I_ONORM, I_MU, I_W0, I_W2, I_A0, I_A2, I_G2, I_KK, I_KA, I_RK, I_LNG, I_LNB, I_WOA, I_WOB, I_WOUT, I_RG, I_RGB, I_RE, I_REB, I_MG, I_MU_UP, I_MD, I_FIN };

DI float bf2f(bf16_t v) { union { unsigned u; float f; } x; x.u = ((unsigned)v) << 16; return x.f; }
DI bf16_t f2bf(float f) { union { float f; unsigned u; } x; x.f = f; unsigned u = x.u; u += 0x7fffu + ((u >> 16) & 1u); return (bf16_t)(u >> 16); }
DI unsigned pk2(float lo, float hi) { return (unsigned)f2bf(lo) | ((unsigned)f2bf(hi) << 16); }
DI float sigmoidf_(float x) { return 1.0f / (1.0f + expf(-x)); }
DI float siluf_(float x) { return x / (1.0f + expf(-x)); }
DI float softplusf_(float x) { return x > 20.f ? x : log1pf(expf(x)); }
DI float wave_sum(float v) {
#pragma unroll
    for (int o = 1; o < 64; o <<= 1) v += __shfl_xor(v, o);
    return v;
}
#ifdef EMU
#define MFMA16(a, b, c) emu_mfma16((a), (b), (c))
#define WAVE_SYNC() emu::wave_bar()
#else
#define MFMA16(a, b, c) __builtin_amdgcn_mfma_f32_16x16x32_bf16((a), (b), (c), 0, 0, 0)
#define WAVE_SYNC() asm volatile("s_waitcnt lgkmcnt(0)" ::: "memory")
#endif
#ifdef EMU
#define LDS_BARRIER() __syncthreads()
#else
#define LDS_BARRIER() do { asm volatile("s_waitcnt lgkmcnt(0)" ::: "memory"); __builtin_amdgcn_s_barrier(); asm volatile("" ::: "memory"); } while (0)
#endif

constexpr int LDS_ROW = 40;
constexpr int GEMM_A_BYTES = BM * LDS_ROW * 2, GEMM_B_BYTES = 128 * LDS_ROW * 2;
template <int MR, class ARow>
DI void gemm_kloop(f32x4 (&acc)[MR][4], char* smem, ARow arow, const bf16_t* Bt, int ldb, int K) {
    constexpr int BM = 64 * MR;
    const int tid = threadIdx.x, lane = tid & 63, wave = tid >> 6, wr = wave >> 1, wc = wave & 1, fr = lane & 15, fq = lane >> 4;
    bf16_t* As = (bf16_t*)smem;
    bf16_t* Bs = (bf16_t*)(smem + 2 * GEMM_A_BYTES);
    constexpr int ACH = BM * 4 / NTHREADS;
    static_assert(ACH >= 1, "tile");
    const bf16_t* ap[ACH];
#pragma unroll
    for (int i = 0; i < ACH; ++i) { const int q = tid + i * NTHREADS; ap[i] = arow(q >> 2) + (q & 3) * 8; }
    const bf16_t* bp = Bt + (size_t)(tid >> 2) * ldb + (tid & 3) * 8;
    u32x4 ra[ACH], rb;
#pragma unroll
    for (int i = 0; i < ACH; ++i) ra[i] = *(const u32x4*)(ap[i]);
    rb = *(const u32x4*)(bp);
    const int nk = K / 32;
    for (int kt = 0; kt < nk; ++kt) {
        const int buf = kt & 1;
#pragma unroll
        for (int i = 0; i < ACH; ++i) { const int q = tid + i * NTHREADS; *(u32x4*)(As + (buf * BM + (q >> 2)) * LDS_ROW + (q & 3) * 8) = ra[i]; }
        *(u32x4*)(Bs + (buf * 128 + (tid >> 2)) * LDS_ROW + (tid & 3) * 8) = rb;
        __syncthreads();
        if (kt + 1 < nk) {
#pragma unroll
            for (int i = 0; i < ACH; ++i) ra[i] = *(const u32x4*)(ap[i] + (kt + 1) * 32);
            rb = *(const u32x4*)(bp + (kt + 1) * 32);
        }
        bf16x8 af[MR], bfr[4];
#pragma unroll
        for (int m = 0; m < MR; ++m) af[m] = *(const bf16x8*)(As + (buf * BM + wr * 16 * MR + m * 16 + fr) * LDS_ROW + fq * 8);
#pragma unroll
        for (int n = 0; n < 4; ++n) bfr[n] = *(const bf16x8*)(Bs + (buf * 128 + wc * 64 + n * 16 + fr) * LDS_ROW + fq * 8);
#pragma unroll
        for (int m = 0; m < MR; ++m)
#pragma unroll
            for (int n = 0; n < 4; ++n) acc[m][n] = MFMA16(af[m], bfr[n], acc[m][n]);
    }
    __syncthreads();
}
template <int MR>
DI void acc_zero(f32x4 (&acc)[MR][4]) {
#pragma unroll
    for (int m = 0; m < MR; ++m)
#pragma unroll
        for (int n = 0; n < 4; ++n) acc[m][n] = (f32x4){0.f, 0.f, 0.f, 0.f};
}

DI int gu_row(int c, int up) { return (c >> 6) * 128 + ((c >> 5) & 1) * 64 + ((c >> 4) & 1) * 16 + (c & 15) + (up ? 32 : 0); }
DI void transpose_item(const float* W, int N, int Nvalid, int k0, int n0, bf16_t* WT, int ldt, int mode, float* scr, int lane) {
#pragma unroll 4
    for (int i = 0; i < 32; ++i) {
        const int kk = 2 * i + (lane >> 5), n = n0 + (lane & 31);
        scr[kk * 33 + (lane & 31)] = (n < Nvalid) ? W[(size_t)(k0 + kk) * N + n] : 0.f;
    }
    WAVE_SYNC();
    const int c = lane & 7;
#pragma unroll
    for (int j = 0; j < 4; ++j) {
        const int nl = (lane >> 3) + 8 * j; const float* s = scr + (8 * c) * 33 + nl;
        u32x4 o; o.x = pk2(s[0], s[33]); o.y = pk2(s[2 * 33], s[3 * 33]); o.z = pk2(s[4 * 33], s[5 * 33]); o.w = pk2(s[6 * 33], s[7 * 33]);
        const int n = n0 + nl; const int row = mode == 0 ? n : gu_row(n, mode == 2);
        *(u32x4*)(WT + (size_t)row * ldt + k0 + 8 * c) = o;
    }
    WAVE_SYNC();
}
DI void transpose_matrix(const float* W, int K, int N, int Npad, bf16_t* WT, int mode, char* smem, int gw, int ngw, int& base) {
    const int lane = threadIdx.x & 63, wave = threadIdx.x >> 6;
    float* scr = (float*)smem + wave * (64 * 33);
    const int nkb = K / 64, nnb = Npad / 32, nitems = nkb * nnb;
    int first = ((gw - base) % ngw + ngw) % ngw;
    for (int it = first; it < nitems; it += ngw) {
        const int kb = it / nnb, nb = it % nnb;
        transpose_item(W, N, N, kb * 64, nb * 32, WT, K, mode, scr, lane);
    }
    base = (base + nitems) % ngw;
}

DI void phase0(const Params& p, char* smem) {
    const int tid = threadIdx.x, lane = tid & 63, wave = tid >> 6;
    if (blockIdx.x == 0 && tid < NEXP) ((int*)(p.ws + WS_CNT))[tid] = 0;
    if (blockIdx.x == 0 && tid == 0) *(unsigned*)(p.ws + WS_BAR) = 0u;
    float* sil = (float*)smem;
    float* red = sil + NV * D;
    const int nitems = 6 * D / 32;
    bool did = false;
    for (int it = blockIdx.x; it < nitems; it += gridDim.x) {
        if (!did) {
            for (int i = tid; i < NV * D; i += NTHREADS) { const int v = i / D, k = i % D; const float cv = v < NB ? p.in[I_C][v * D + k] : p.in[I_CCTX][k]; sil[i] = siluf_(cv); }
            did = true;
        }
        __syncthreads();
        const int col = it * 32 + (lane & 31), rp = lane >> 5;
        float acc[NV];
#pragma unroll
        for (int v = 0; v < NV; ++v) acc[v] = 0.f;
        const int r0 = wave * (D / 8);
#pragma unroll 8
        for (int i = 0; i < D / 16; ++i) {
            const int row = r0 + 2 * i + rp; const float w = p.in[I_ADAW][(size_t)row * (6 * D) + col];
#pragma unroll
            for (int v = 0; v < NV; ++v) acc[v] += sil[v * D + row] * w;
        }
#pragma unroll
        for (int v = 0; v < NV; ++v) red[((wave * 2 + rp) * NV + v) * 32 + (lane & 31)] = acc[v];
        __syncthreads();
        if (tid < NV * 32) {
            const int v = tid / 32, cl = tid % 32; float s = p.in[I_ADAB][it * 32 + cl];
            for (int g = 0; g < 16; ++g) s += red[(g * NV + v) * 32 + cl];
            ((float*)(p.ws + WS_MOD))[(size_t)v * 6 * D + it * 32 + cl] = s;
        }
    }
    __syncthreads();
    const int gw = blockIdx.x * 8 + wave, ngw = gridDim.x * 8; int base = 0;
    {
        float* scr = (float*)smem + wave * (64 * 33);
        const int nkb = D / 64, nnb = NP / 32, nitems2 = nkb * nnb;
        for (int it = gw; it < nitems2; it += ngw) { const int kb = it / nnb, nb = it % nnb; transpose_item(p.in[I_WIN], IN_COLS, IN_COLS, kb * 64, nb * 32, (bf16_t*)(p.aux + AUX_WINT), D, 0, scr, lane); }
        base = nitems2 % ngw;
    }
    transpose_matrix(p.in[I_WOA], 512, D, D, (bf16_t*)(p.ws + WS_WOA), 0, smem, gw, ngw, base);
    transpose_matrix(p.in[I_WOB], 512, D, D, (bf16_t*)(p.ws + WS_WOB), 0, smem, gw, ngw, base);
    transpose_matrix(p.in[I_WOUT], D, D, D, (bf16_t*)(p.ws + WS_WOUT), 0, smem, gw, ngw, base);
}

DI void phase1(const Params& p, char* smem) {
    const int lane = threadIdx.x & 63, wave = threadIdx.x >> 6;
    const int gw = blockIdx.x * 8 + wave, ngw = gridDim.x * 8;
    const float* mod = (const float*)(p.ws + WS_MOD);
    bf16_t* U = (bf16_t*)(p.aux + AUX_U);
    for (int r = gw; r < T_ALL; r += ngw) {
        const float* src; int v;
        if (r < T_CTX) { src = p.in[I_CTX] + (size_t)r * D; v = NB; } else { src = p.in[I_X] + (size_t)(r - T_CTX) * D; v = (r - T_CTX) / S; }
        f32x4 x[D / 256]; float ss = 0.f;
#pragma unroll
        for (int j = 0; j < D / 256; ++j) { x[j] = *(const f32x4*)(src + j * 256 + lane * 4); ss += x[j].x * x[j].x + x[j].y * x[j].y + x[j].z * x[j].z + x[j].w * x[j].w; }
        ss = wave_sum(ss);
        const float rstd = 1.0f / sqrtf(ss * (1.0f / D) + 1e-6f);
#pragma unroll
        for (int j = 0; j < D / 256; ++j) {
            const int k = j * 256 + lane * 4;
            const f32x4 g = *(const f32x4*)(p.in[I_NMIX] + k), sh = *(const f32x4*)(mod + (size_t)v * 6 * D + k), sc = *(const f32x4*)(mod + (size_t)v * 6 * D + D + k);
            float o0 = x[j].x * rstd * g.x * (1.f + sc.x) + sh.x, o1 = x[j].y * rstd * g.y * (1.f + sc.y) + sh.y;
            float o2 = x[j].z * rstd * g.z * (1.f + sc.z) + sh.z, o3 = x[j].w * rstd * g.w * (1.f + sc.w) + sh.w;
            u32x2 o; o.x = pk2(o0, o1); o.y = pk2(o2, o3);
            *(u32x2*)(U + (size_t)r * D + k) = o;
        }
    }
}

DI void phase2(const Params& p, char* smem) {
    const int tid = threadIdx.x, lane = tid & 63, wave = tid >> 6, wr = wave >> 1, wc = wave & 1, fr = lane & 15, fq = lane >> 4;
    const bf16_t* U = (const bf16_t*)(p.aux + AUX_U); const bf16_t* WT = (const bf16_t*)(p.aux + AUX_WINT);
    bf16_t* PL = (bf16_t*)(p.ws + WS_PLAT); bf16_t* PC = (bf16_t*)(p.ws + WS_PCTX); float* AB = (float*)(p.ws + WS_AB);
    constexpr int NT = NP / 128, MT = T_ALL / BM, NT_CTX = (CTX_COLS + 127) / 128;
    for (int t = blockIdx.x; t < MT * NT; t += gridDim.x) {
        const int mt = t / NT, nt = t % NT; const int row0 = mt * BM; const bool isctx = row0 < T_CTX;
        if (isctx && nt >= NT_CTX) continue;
        f32x4 acc[MREP][4]; acc_zero(acc);
        gemm_kloop(acc, smem, [&](int i) { return U + (size_t)(row0 + i) * D; }, WT + (size_t)nt * 128 * D, D, D);
#pragma unroll
        for (int m = 0; m < MREP; ++m)
#pragma unroll
            for (int n = 0; n < 4; ++n)
#pragma unroll
                for (int j = 0; j < 4; ++j) {
                    const int row = row0 + wr * 16 * MREP + m * 16 + fq * 4 + j, col = nt * 128 + wc * 64 + n * 16 + fr; const float v = acc[m][n][j];
                    if (isctx) { if (col < CTX_COLS) PC[(size_t)row * CTX_COLS + col] = f2bf(v); }
                    else { if (col < IN_COLS) PL[(size_t)(row - T_CTX) * IN_COLS + col] = f2bf(v); }
                    if (col >= 2048 && col < 2064) AB[(size_t)row * 16 + (col - 2048)] = v;
                }
    }
}

typedef float f32x16 __attribute__((ext_vector_type(16)));
typedef short bf16x4 __attribute__((ext_vector_type(4)));
#ifdef EMU
#define MFMA32(a, b, c) emu_mfma32((a), (b), (c))
DI float fexp(float x) { return expf(x); }
DI float flog(float x) { return logf(x); }
DI float frcp(float x) { return 1.0f / x; }
DI float frsq(float x) { return 1.0f / sqrtf(x); }
DI float wave_sum_fast(float v) { return wave_sum(v); }
#else
#define MFMA32(a, b, c) __builtin_amdgcn_mfma_f32_32x32x16_bf16((a), (b), (c), 0, 0, 0)
DI float fexp(float x) { return __expf(x); }
DI float flog(float x) { return __logf(x); }
DI float frcp(float x) { return __builtin_amdgcn_rcpf(x); }
DI float frsq(float x) { return __builtin_amdgcn_rsqf(x); }
#define DPP_ADD(v, ctrl) ((v) + __builtin_bit_cast(float, __builtin_amdgcn_update_dpp(0, __builtin_bit_cast(int, (v)), (ctrl), 0xf, 0xf, false)))
DI float wave_sum_fast(float v) {
    v = DPP_ADD(v, 0xB1); v = DPP_ADD(v, 0x4E); v = DPP_ADD(v, 0x141); v = DPP_ADD(v, 0x140);
    const int iv = __builtin_bit_cast(int, v);
    return (__builtin_bit_cast(float, __builtin_amdgcn_readlane(iv, 0)) + __builtin_bit_cast(float, __builtin_amdgcn_readlane(iv, 16))) +
           (__builtin_bit_cast(float, __builtin_amdgcn_readlane(iv, 32)) + __builtin_bit_cast(float, __builtin_amdgcn_readlane(iv, 48)));
}
#endif
DI float fsigmoid(float x) { return frcp(1.0f + fexp(-x)); }
DI float fsilu(float x) { return x * fsigmoid(x); }
DI float fsoftplus(float x) { return fmaxf(x, 0.f) + flog(1.f + fexp(-fabsf(x))); }
DI float ftanh(float x) { return 1.0f - 2.0f * frcp(1.0f + fexp(2.0f * x)); }

DI int crow(int g, int h) { return (g & 3) + 8 * (g >> 2) + 4 * h; }
template <int S_> DI bf16x8 pack_acc(const f32x16& x) {
    bf16x8 r;
#pragma unroll
    for (int j = 0; j < 8; ++j) r[j] = (short)f2bf(x[8 * S_ + j]);
    return r;
}
DI bf16x8 ld_nat(const bf16_t* row, int s, int h) { return *(const bf16x8*)(row + 16 * s + 8 * h); }
DI bf16x8 ld_perm(const bf16_t* row, int s, int h) {
    const bf16x4 lo = *(const bf16x4*)(row + 16 * s + 4 * h), hi = *(const bf16x4*)(row + 16 * s + 8 + 4 * h);
    return __builtin_shufflevector(lo, hi, 0, 1, 2, 3, 4, 5, 6, 7);
}
DI f32x16 zero16() { f32x16 z;
#pragma unroll
    for (int i = 0; i < 16; ++i) z[i] = 0.f;
    return z; }
#define TGET(i) ((i) < 16 ? t0[(i) & 15] : t1[(i) & 15])
DI void invert32_col(const float* Lf, f32x16& t0, f32x16& t1, int c) {
#pragma unroll
    for (int i = 0; i < 32; ++i) {
        float s0 = 0.f, s1 = 0.f, s2 = 0.f, s3 = 0.f;
#pragma unroll
        for (int j4 = 0; j4 < (i + 3) / 4; ++j4) {
            const f32x4 l = *(const f32x4*)(Lf + i * 32 + 4 * j4);
            if (4 * j4 + 0 < i) s0 += l.x * TGET(4 * j4 + 0);
            if (4 * j4 + 1 < i) s1 += l.y * TGET(4 * j4 + 1);
            if (4 * j4 + 2 < i) s2 += l.z * TGET(4 * j4 + 2);
            if (4 * j4 + 3 < i) s3 += l.w * TGET(4 * j4 + 3);
        }
        float sm = -((s0 + s1) + (s2 + s3));
#ifndef EMU
        asm volatile("" : "+v"(sm));
#endif
        const float v = (i > c) ? sm : (i == c ? 1.f : 0.f);
        if (i < 16) t0[i & 15] = v; else t1[i & 15] = v;
    }
}

constexpr int GC = 32;
constexpr int G_NT = (CTXL + S) / GC;
constexpr int LD128 = 136, LD64 = 72, LD32 = 40;
DI void chunk_pos(int x, int d, int& seg, int& j0) {
    constexpr int n0 = CTXL / GC, n1 = S / GC;
    if (x < n0) { seg = 0; j0 = (d ? n0 - 1 - x : x) * GC; } else { seg = 1; const int xx = x - n0; j0 = (d ? n1 - 1 - xx : xx) * GC; }
}

constexpr int GL_Q = 0;
constexpr int GL_KT = GL_Q + 2 * 32 * LD128 * 2;
constexpr int GL_VT = GL_KT + 2 * 128 * LD32 * 2;
constexpr int GL_K = GL_VT + 2 * 128 * LD32 * 2;
constexpr int GL_QKM = GL_K + 32 * LD128 * 2;
constexpr int GL_LF = GL_QKM + 2 * 32 * LD32 * 2;
constexpr int GL_TP = GL_LF + 32 * 32 * 4;
constexpr int GL_TPP = GL_TP + 32 * LD32 * 2;
constexpr int GL_WN = GL_TPP + 2 * 32 * LD32 * 2;
constexpr int GL_SC = GL_WN + 32 * LD128 * 2;
constexpr int GL_GC = GL_SC + 2 * 8 * 32 * 4;
constexpr int GL_CW = GL_GC + 3 * 32 * 4;
constexpr int GL_END = GL_CW + 5 * 3 * 128 * 4;
static_assert(GL_END <= LDS_BYTES, "gdn lds");

DI void gdn_chain2(const Params& p, char* smem, int item) {
    const int d = item / (NB * H_A), b = (item / H_A) % NB, h = item % H_A;
    const int tid = threadIdx.x, lane = tid & 63, wave = tid >> 6;
    bf16_t* Qs = (bf16_t*)(smem + GL_Q); bf16_t* KTs = (bf16_t*)(smem + GL_KT); bf16_t* VTs = (bf16_t*)(smem + GL_VT); bf16_t* Ks = (bf16_t*)(smem + GL_K);
    bf16_t* QKMs = (bf16_t*)(smem + GL_QKM); float* Lf = (float*)(smem + GL_LF); bf16_t* Tp = (bf16_t*)(smem + GL_TP); bf16_t* Tpp = (bf16_t*)(smem + GL_TPP);
    bf16_t* Wn = (bf16_t*)(smem + GL_WN); float* SC = (float*)(smem + GL_SC); float* GCs = (float*)(smem + GL_GC); float* CW = (float*)(smem + GL_CW);
    const float alog = p.in[I_ALOG][d * 4 + h], dtb = p.in[I_DTB][d * 4 + h], negea = -expf(alog);
    bf16_t* ODIR = (bf16_t*)(p.aux + AUX_ODIR);
    __syncthreads();
    for (int i = tid; i < 5 * 3 * 128; i += NTHREADS) { const int t = i / 384, s = (i % 384) / 128, c = i % 128; CW[i] = p.in[I_CONV][t * 1536 + s * 512 + h * 128 + c]; }
    f32x16 St[4];
#pragma unroll
    for (int ct = 0; ct < 4; ++ct) St[ct] = zero16();
    unsigned raw[8][3]; float pa = 0.f, pbt = 0.f;
    auto prefetch = [&](int x) {
        int seg, j0; chunk_pos(x, d, seg, j0);
        const int L = seg ? S : CTXL, ldp = seg ? IN_COLS : CTX_COLS;
        const bf16_t* pbase = seg ? (const bf16_t*)(p.ws + WS_PLAT) + (size_t)b * S * IN_COLS : (const bf16_t*)(p.ws + WS_PCTX) + (size_t)b * CTXL * CTX_COLS;
        const float* abbase = (const float*)(p.ws + WS_AB) + (size_t)(seg ? T_CTX + b * S : b * CTXL) * 16;
        const int jw = j0 + 4 * wave;
#pragma unroll
        for (int rr = 0; rr < 8; ++rr) {
            const int j = jw - 2 + rr;
#pragma unroll
            for (int s = 0; s < 3; ++s) raw[rr][s] = (j >= 0 && j < L) ? *(const unsigned*)(pbase + (size_t)j * ldp + s * 512 + h * 128 + 2 * lane) : 0u;
        }
        if (lane < 4) { pa = abbase[(size_t)(jw + lane) * 16 + d * 4 + h]; pbt = abbase[(size_t)(jw + lane) * 16 + 8 + d * 4 + h]; }
    };
    prefetch(0);
    const int r0_ = lane & 31, hh0_ = lane >> 5;
    __syncthreads();
    for (int it = -1; it < G_NT; ++it) {
        int r = r0_, hh = hh0_;
#ifndef EMU
        asm volatile("" : "+v"(r), "+v"(hh));
#endif
        const int xn = it + 1, par = xn & 1;
        int segn = 0, j0n = 0; if (xn < G_NT) chunk_pos(xn, d, segn, j0n);
        if (xn < G_NT) {
            const int i0 = d ? (GC - 4 - 4 * wave) : 4 * wave;
            bf16_t kt[2][4], vt[2][4];
#pragma unroll
            for (int t = 0; t < 4; ++t) {
                const int e = d ? 3 - t : t, i = i0 + e;
                float o[6];
#pragma unroll
                for (int s = 0; s < 3; ++s) {
                    float a0 = 0.f, a1 = 0.f;
#pragma unroll
                    for (int tp = 0; tp < 5; ++tp) { const unsigned w = raw[t + tp][s]; a0 += bf2f((bf16_t)(w & 0xffffu)) * CW[(tp * 3 + s) * 128 + 2 * lane]; a1 += bf2f((bf16_t)(w >> 16)) * CW[(tp * 3 + s) * 128 + 2 * lane + 1]; }
                    o[2 * s] = fsilu(a0); o[2 * s + 1] = fsilu(a1);
                }
                const float sq = wave_sum_fast(o[0] * o[0] + o[1] * o[1]), sk = wave_sum_fast(o[2] * o[2] + o[3] * o[3]);
                const float scq = frsq(sq + 1e-6f) * 0.08838834764831845f, sck = frsq(sk + 1e-6f);
                *(unsigned*)(Qs + (par * 32 + i) * LD128 + 2 * lane) = pk2(o[0] * scq, o[1] * scq);
                kt[0][e] = f2bf(o[2] * sck); kt[1][e] = f2bf(o[3] * sck); vt[0][e] = f2bf(o[4]); vt[1][e] = f2bf(o[5]);
                *(unsigned*)(Ks + i * LD128 + 2 * lane) = (unsigned)kt[0][e] | ((unsigned)kt[1][e] << 16);
            }
#pragma unroll
            for (int q = 0; q < 2; ++q) {
                u32x2 o; o.x = (unsigned)kt[q][0] | ((unsigned)kt[q][1] << 16); o.y = (unsigned)kt[q][2] | ((unsigned)kt[q][3] << 16);
                *(u32x2*)(KTs + (par * 128 + 2 * lane + q) * LD32 + i0) = o;
                u32x2 o2; o2.x = (unsigned)vt[q][0] | ((unsigned)vt[q][1] << 16); o2.y = (unsigned)vt[q][2] | ((unsigned)vt[q][3] << 16);
                *(u32x2*)(VTs + (par * 128 + 2 * lane + q) * LD32 + i0) = o2;
            }
            if (lane < 4) { const int i = d ? (GC - 1 - 4 * wave - lane) : (4 * wave + lane);
                SC[(par * 8 + 0) * 32 + i] = negea * fsoftplus(pa + dtb); SC[(par * 8 + 1) * 32 + i] = fsigmoid(pbt); }
            if (xn + 1 < G_NT) prefetch(xn + 1);
        }
        LDS_BARRIER();
        if (xn < G_NT && wave < 3) {
            const float* graw = SC + (par * 8 + 0) * 32;
            float gcv = 0.f;
#pragma unroll
            for (int s4 = 0; s4 < 8; ++s4) { const f32x4 g4 = *(const f32x4*)(graw + 4 * s4);
                gcv += (4 * s4 + 0 <= r ? g4.x : 0.f) + (4 * s4 + 1 <= r ? g4.y : 0.f) + (4 * s4 + 2 <= r ? g4.z : 0.f) + (4 * s4 + 3 <= r ? g4.w : 0.f); }
            if (wave == 2) {
                const float glast = graw[0] + 0.f; (void)glast;
                float gl = 0.f;
#pragma unroll
                for (int s4 = 0; s4 < 8; ++s4) { const f32x4 g4 = *(const f32x4*)(graw + 4 * s4); gl += (g4.x + g4.y) + (g4.z + g4.w); }
                const float be = SC[(par * 8 + 1) * 32 + r];
                if (lane < 32) { SC[(par * 8 + 3) * 32 + r] = fexp(gcv); SC[(par * 8 + 4) * 32 + r] = fexp(gl - gcv); SC[(par * 8 + 5) * 32 + r] = be * fexp(gcv); SC[(par * 8 + 6) * 32 + r] = fexp(gl); }
            } else {
                if (lane < 32) GCs[wave * 32 + r] = gcv;
                f32x16 acc = zero16();
                const bf16_t* arow = (wave == 0 ? Ks : Qs + par * 32 * LD128) + r * LD128; const bf16_t* brow = Ks + r * LD128;
#pragma unroll
                for (int s = 0; s < 8; ++s) acc = MFMA32(ld_nat(arow, s, hh), ld_nat(brow, s, hh), acc);
                WAVE_SYNC();
#pragma unroll
                for (int g = 0; g < 16; ++g) {
                    const int i = crow(g, hh); const float dec = fexp(GCs[wave * 32 + i] - gcv);
                    if (wave == 0) Lf[i * 32 + r] = (r < i) ? SC[(par * 8 + 1) * 32 + i] * acc[g] * dec : 0.f;
                    else QKMs[(par * 32 + i) * LD32 + r] = f2bf((r <= i) ? acc[g] * dec : 0.f);
                }
            }
        }
        LDS_BARRIER();
        if (wave == 7 && xn < G_NT) {
            f32x16 t0, t1; const int c = r; invert32_col(Lf, t0, t1, c);
            if (lane < 32) {
                const float b1 = SC[(par * 8 + 5) * 32 + c], b0 = SC[(par * 8 + 1) * 32 + c];
#pragma unroll
                for (int i = 0; i < 32; ++i) { const float tv = TGET(i); Tp[i * LD32 + c] = f2bf(tv * b1); Tpp[(par * 32 + i) * LD32 + c] = f2bf(tv * b0); }
            }
        }
        if (wave < 4 && it >= 0) {
            const int pc = it & 1; int seg = 0, j0 = 0; chunk_pos(it, d, seg, j0);
            const bf16_t* Qc = Qs + pc * 32 * LD128; const bf16_t* KTc = KTs + pc * 128 * LD32; const bf16_t* VTc = VTs + pc * 128 * LD32;
            const bf16_t* QKc = QKMs + pc * 32 * LD32; const bf16_t* Tc = Tpp + pc * 32 * LD32; const float* sc = SC + pc * 8 * 32;
            f32x16 vn = zero16();
#pragma unroll
            for (int s = 0; s < 2; ++s) vn = MFMA32(ld_nat(Tc + r * LD32, s, hh), ld_nat(VTc + (32 * wave + r) * LD32, s, hh), vn);
            f32x16 oacc = zero16();
#define GDN_KSTEP(s) { const bf16x8 sb = pack_acc<(s) & 1>(St[(s) >> 1]); vn = MFMA32(ld_perm(Wn + r * LD128, (s), hh), sb, vn); oacc = MFMA32(ld_perm(Qc + r * LD128, (s), hh), sb, oacc); }
            GDN_KSTEP(0) GDN_KSTEP(1) GDN_KSTEP(2) GDN_KSTEP(3) GDN_KSTEP(4) GDN_KSTEP(5) GDN_KSTEP(6) GDN_KSTEP(7)
#undef GDN_KSTEP
#pragma unroll
            for (int g = 0; g < 16; ++g) oacc[g] *= sc[3 * 32 + crow(g, hh)];
            { const bf16x8 v0 = pack_acc<0>(vn), v1 = pack_acc<1>(vn);
              oacc = MFMA32(ld_perm(QKc + r * LD32, 0, hh), v0, oacc); oacc = MFMA32(ld_perm(QKc + r * LD32, 1, hh), v1, oacc); }
            f32x16 vs = vn;
#pragma unroll
            for (int g = 0; g < 16; ++g) vs[g] *= sc[4 * 32 + crow(g, hh)];
            const float ge = sc[6 * 32];
            { const bf16x8 v0 = pack_acc<0>(vs), v1 = pack_acc<1>(vs);
#pragma unroll
              for (int ct = 0; ct < 4; ++ct) {
#pragma unroll
                  for (int g = 0; g < 16; ++g) St[ct][g] *= ge;
                  St[ct] = MFMA32(ld_perm(KTc + (32 * ct + r) * LD32, 0, hh), v0, St[ct]);
                  St[ct] = MFMA32(ld_perm(KTc + (32 * ct + r) * LD32, 1, hh), v1, St[ct]);
              } }
            if (seg) {
#pragma unroll
                for (int g = 0; g < 16; ++g) {
                    const int i = crow(g, hh), j = d ? j0 + GC - 1 - i : j0 + i;
                    ODIR[((size_t)d * T_LAT + (size_t)b * S + j) * 512 + h * 128 + 32 * wave + r] = f2bf(oacc[g]);
                }
            }
        }
        LDS_BARRIER();
        if (xn < G_NT && wave < 4) {
            f32x16 acc = zero16();
#pragma unroll
            for (int s = 0; s < 2; ++s) acc = MFMA32(ld_nat(KTs + (par * 128 + 32 * wave + r) * LD32, s, hh), ld_nat(Tp + r * LD32, s, hh), acc);
#pragma unroll
            for (int q = 0; q < 4; ++q) {
                u32x2 o; o.x = pk2(-acc[4 * q], -acc[4 * q + 1]); o.y = pk2(-acc[4 * q + 2], -acc[4 * q + 3]);
                *(u32x2*)(Wn + r * LD128 + 32 * wave + 8 * q + 4 * hh) = o;
            }
        }
        LDS_BARRIER();
    }
}

constexpr int RL_RX = 0;
constexpr int RL_KX = RL_RX + 32 * 64 * 4;
constexpr int RL_VX = RL_KX + 32 * 64 * 4;
constexpr int RL_KK = RL_VX + 32 * 64 * 4;
constexpr int RL_LW = RL_KK + 32 * 64 * 4;
constexpr int RL_IC = RL_LW + 32 * 64 * 4;
constexpr int RL_PC = RL_IC + 32 * 64 * 4;
constexpr int RL_CST = RL_PC + 2 * 64 * 4;
constexpr int RL_TW = RL_CST + 4 * 64 * 4;
constexpr int RL_AL = RL_TW + 32 * LD64 * 2;
constexpr int RL_LF = RL_TW;
constexpr int RL_LAKT = RL_LF + 32 * 32 * 4;
constexpr int RL_TB = RL_LAKT + 32 * LD32 * 2;
static_assert(RL_TB + 32 * LD32 * 2 <= RL_AL + 32 * LD64 * 2, "overlay");
constexpr int RL_W2T = RL_AL + 32 * LD64 * 2;
constexpr int RL_A2T = RL_W2T + 64 * LD64 * 2;
constexpr int RL_AR = RL_A2T + 64 * LD64 * 2;
constexpr int RL_BR = RL_AR + 32 * LD64 * 2;
constexpr int RL_KR = RL_BR + 32 * LD64 * 2;
constexpr int RL_RR = RL_KR + 32 * LD64 * 2;
constexpr int RL_AT = RL_RR + 2 * 32 * LD64 * 2;
constexpr int RL_BHT = RL_AT + 64 * LD32 * 2;
constexpr int RL_KHT = RL_BHT + 2 * 64 * LD32 * 2;
constexpr int RL_VT = RL_KHT + 2 * 64 * LD32 * 2;
constexpr int RL_MRB = RL_VT + 2 * 64 * LD32 * 2;
constexpr int RL_MRK = RL_MRB + 2 * 32 * LD32 * 2;
constexpr int RL_WM = RL_MRK + 2 * 32 * LD32 * 2;
constexpr int RL_TL = RL_WM + 32 * LD64 * 2;
constexpr int RL_END = RL_TL + 32 * LD32 * 2;
static_assert(RL_END <= LDS_BYTES, "rwkv lds");

DI void rwkv_chain2(const Params& p, char* smem, int item) {
    const int d = item / (NB * H_B), b = (item / H_B) % NB, h = item % H_B;
    const int tid = threadIdx.x, lane = tid & 63, wave = tid >> 6;
    float* RX = (float*)(smem + RL_RX); float* KX = (float*)(smem + RL_KX); float* VX = (float*)(smem + RL_VX); float* KKs = (float*)(smem + RL_KK);
    float* LW = (float*)(smem + RL_LW); float* IC = (float*)(smem + RL_IC); float* Lf = (float*)(smem + RL_LF); float* PC = (float*)(smem + RL_PC); float* CST = (float*)(smem + RL_CST);
    bf16_t* TW = (bf16_t*)(smem + RL_TW); bf16_t* AL = (bf16_t*)(smem + RL_AL); bf16_t* W2T = (bf16_t*)(smem + RL_W2T); bf16_t* A2T = (bf16_t*)(smem + RL_A2T);
    bf16_t* Ar = (bf16_t*)(smem + RL_AR); bf16_t* Br = (bf16_t*)(smem + RL_BR); bf16_t* Kr = (bf16_t*)(smem + RL_KR); bf16_t* Rr = (bf16_t*)(smem + RL_RR);
    bf16_t* AT = (bf16_t*)(smem + RL_AT); bf16_t* BhT = (bf16_t*)(smem + RL_BHT); bf16_t* KhT = (bf16_t*)(smem + RL_KHT); bf16_t* VT = (bf16_t*)(smem + RL_VT);
    bf16_t* LakT = (bf16_t*)(smem + RL_LAKT); bf16_t* Mrb = (bf16_t*)(smem + RL_MRB); bf16_t* Mrk = (bf16_t*)(smem + RL_MRK); bf16_t* Tb = (bf16_t*)(smem + RL_TB);
    bf16_t* Wm = (bf16_t*)(smem + RL_WM); bf16_t* TLm = (bf16_t*)(smem + RL_TL);
    bf16_t* YDIR = (bf16_t*)(p.aux + AUX_YDIR); float* BON = (float*)(p.ws + WS_BONUS);
    __syncthreads();
    for (int i = tid; i < 64 * 64; i += NTHREADS) {
        const int c = i >> 6, rr = i & 63;
        W2T[c * LD64 + rr] = f2bf(p.in[I_W2][((size_t)d * 64 + rr) * 512 + h * 64 + c]); A2T[c * LD64 + rr] = f2bf(p.in[I_A2][((size_t)d * 64 + rr) * 512 + h * 64 + c]);
    }
    if (tid < 256) { const int w = tid >> 6, c = tid & 63, gc = h * 64 + c;
        CST[tid] = w == 0 ? p.in[I_W0][d * 512 + gc] : (w == 1 ? p.in[I_A0][d * 512 + gc] : (w == 2 ? p.in[I_KA][gc] : p.in[I_RK][gc])); }
    float muv[5];
#pragma unroll
    for (int s = 0; s < 5; ++s) muv[s] = p.in[I_MU][(s < 3 ? s * 512 + h * 64 : (s == 3 ? 1536 + d * 64 : 1664 + d * 64)) + lane];
    const float kkw = p.in[I_KK][h * 64 + lane];
    f32x16 Xt[2]; Xt[0] = zero16(); Xt[1] = zero16();
    bf16_t rawv[6][5];
    auto prefetch = [&](int x) {
        int seg, j0; chunk_pos(x, d, seg, j0);
        const int L = seg ? S : CTXL, ldp = seg ? IN_COLS : CTX_COLS;
        const bf16_t* pb = seg ? (const bf16_t*)(p.ws + WS_PLAT) + (size_t)b * S * IN_COLS : (const bf16_t*)(p.ws + WS_PCTX) + (size_t)b * CTXL * CTX_COLS;
        const int jw = j0 + 4 * wave;
#pragma unroll
        for (int rr = 0; rr < 6; ++rr) {
            const int j = jw - 1 + rr; const bool ok = (j >= 0 && j < L);
            const int row = ok ? (seg ? (j % ROWS) * GW + j / ROWS : j) : 0;
#pragma unroll
            for (int s = 0; s < 5; ++s) {
                const int bcol = (s < 3 ? s * 512 + h * 64 : (s == 3 ? 1536 + d * 64 : 1664 + d * 64)) + lane;
                rawv[rr][s] = ok ? pb[(size_t)row * ldp + COL_B0 + bcol] : (bf16_t)0;
            }
        }
    };
    prefetch(0);
    const int r0_ = lane & 31, hh0_ = lane >> 5;
    __syncthreads();
    for (int it = -1; it < G_NT; ++it) {
        int r = r0_, hh = hh0_;
#ifndef EMU
        asm volatile("" : "+v"(r), "+v"(hh));
#endif
        const int xn = it + 1, par = xn & 1;
        int segn = 0, j0n = 0; if (xn < G_NT) chunk_pos(xn, d, segn, j0n);
        if (xn < G_NT) {
#pragma unroll
            for (int t = 0; t < 4; ++t) {
                const int i = d ? (GC - 1 - 4 * wave - t) : (4 * wave + t);
                float xs[5];
#pragma unroll
                for (int s = 0; s < 5; ++s) { const float cu = bf2f(rawv[t + 1][s]); xs[s] = cu + (0.5f * (bf2f(rawv[t][s]) + bf2f(rawv[t + 2][s])) - cu) * muv[s]; }
                const float kxk = xs[1] * kkw; const float ss = wave_sum_fast(kxk * kxk);
                RX[i * 64 + lane] = xs[0]; KX[i * 64 + lane] = xs[1]; VX[i * 64 + lane] = xs[2]; KKs[i * 64 + lane] = kxk * frsq(ss + 1e-6f);
                TW[i * LD64 + lane] = f2bf(ftanh(xs[3])); AL[i * LD64 + lane] = f2bf(xs[4]);
            }
            if (xn + 1 < G_NT) prefetch(xn + 1);
        }
        LDS_BARRIER();
        if (xn < G_NT && wave < 4) {
            const int which = wave >> 1, ct = wave & 1;
            const bf16_t* arow = (which ? AL : TW) + r * LD64; const bf16_t* brow = (which ? A2T : W2T) + (32 * ct + r) * LD64;
            f32x16 acc = zero16();
#pragma unroll
            for (int s = 0; s < 4; ++s) acc = MFMA32(ld_nat(arow, s, hh), ld_nat(brow, s, hh), acc);
            const int c = 32 * ct + r;
            const float bias = CST[which * 64 + c];
#pragma unroll
            for (int g = 0; g < 16; ++g) {
                const int i = crow(g, hh); const float z = bias + acc[g];
                if (which) IC[i * 64 + c] = fsigmoid(z);
                else { const float wl = -fsoftplus(-z) - 0.5f; LW[i * 64 + c] = -fexp(wl); }
            }
        }
        LDS_BARRIER();
        if (xn < G_NT) {
            const int c = lane, i0 = 4 * wave;
            const float ka = CST[2 * 64 + c], rk = CST[3 * 64 + c];
            float lpb = 0.f, lpc = 0.f; float lw4[4];
#pragma unroll
            for (int s2 = 0; s2 < 32; ++s2) { const float w = LW[s2 * 64 + c]; lpc += w; if (s2 < i0) lpb += w; }
#pragma unroll
            for (int e = 0; e < 4; ++e) lw4[e] = LW[(i0 + e) * 64 + c];
            bf16_t ta[4], tb[4], tk[4], tv[4]; float bon[4];
            float lprun = lpb;
#pragma unroll
            for (int e = 0; e < 4; ++e) {
                const int i = i0 + e;
                const float lpm = lprun; lprun += lw4[e]; const float lp = lprun;
                const float Pi = fexp(lp), Pm = fexp(lpm), invP = fexp(-lp), PCi = fexp(lpc - lp);
                const float ic = IC[i * 64 + c], kxv = KX[i * 64 + c], kkv = KKs[i * 64 + c], rxv = RX[i * 64 + c], vxv = VX[i * 64 + c];
                const float kd = kxv * (1.f + (ic - 1.f) * ka), bb = kkv * ic, aa = -kkv;
                ta[e] = f2bf(aa * Pm); tb[e] = f2bf(bb * PCi); tk[e] = f2bf(kd * PCi); tv[e] = f2bf(vxv);
                Ar[i * LD64 + c] = ta[e]; Br[i * LD64 + c] = f2bf(bb * invP); Kr[i * LD64 + c] = f2bf(kd * invP); Rr[(par * 32 + i) * LD64 + c] = f2bf(rxv * Pi);
                bon[e] = wave_sum_fast(rxv * kd * rk);
            }
            { u32x2 o; o.x = (unsigned)ta[0] | ((unsigned)ta[1] << 16); o.y = (unsigned)ta[2] | ((unsigned)ta[3] << 16); *(u32x2*)(AT + c * LD32 + i0) = o; }
            { u32x2 o; o.x = (unsigned)tb[0] | ((unsigned)tb[1] << 16); o.y = (unsigned)tb[2] | ((unsigned)tb[3] << 16); *(u32x2*)(BhT + (par * 64 + c) * LD32 + i0) = o; }
            { u32x2 o; o.x = (unsigned)tk[0] | ((unsigned)tk[1] << 16); o.y = (unsigned)tk[2] | ((unsigned)tk[3] << 16); *(u32x2*)(KhT + (par * 64 + c) * LD32 + i0) = o; }
            { u32x2 o; o.x = (unsigned)tv[0] | ((unsigned)tv[1] << 16); o.y = (unsigned)tv[2] | ((unsigned)tv[3] << 16); *(u32x2*)(VT + (par * 64 + c) * LD32 + i0) = o; }
            if (wave == 7) PC[par * 64 + c] = fexp(lpc);
            if (segn && lane < 4) { const int i = i0 + lane, jj = d ? j0n + GC - 1 - i : j0n + i;
                const float bv = lane == 0 ? bon[0] : (lane == 1 ? bon[1] : (lane == 2 ? bon[2] : bon[3]));
                BON[((size_t)d * T_LAT + (size_t)b * S + (jj % ROWS) * GW + jj / ROWS) * 8 + h] = bv; }
        }
        LDS_BARRIER();
        if (xn < G_NT && wave < 4) {
            const bf16_t* arow = ((wave < 2) ? Ar : Rr + par * 32 * LD64) + r * LD64; const bf16_t* brow = ((wave & 1) ? Kr : Br) + r * LD64;
            f32x16 acc = zero16();
#pragma unroll
            for (int s = 0; s < 4; ++s) acc = MFMA32(ld_nat(arow, s, hh), ld_nat(brow, s, hh), acc);
            if (wave == 0) {
#pragma unroll
                for (int g = 0; g < 16; ++g) { const int t = crow(g, hh); Lf[t * 32 + r] = (r < t) ? -acc[g] : 0.f; }
            } else if (wave == 1) {
#pragma unroll
                for (int q = 0; q < 4; ++q) {
                    f32x4 v;
#pragma unroll
                    for (int e = 0; e < 4; ++e) { const int t = 8 * q + 4 * hh + e; v[e] = (r < t) ? acc[4 * q + e] : 0.f; }
                    u32x2 o; o.x = pk2(v[0], v[1]); o.y = pk2(v[2], v[3]); *(u32x2*)(LakT + r * LD32 + 8 * q + 4 * hh) = o;
                }
            } else {
                bf16_t* M = (wave == 2 ? Mrb : Mrk) + par * 32 * LD32;
#pragma unroll
                for (int g = 0; g < 16; ++g) { const int t = crow(g, hh); M[t * LD32 + r] = f2bf((r <= t) ? acc[g] : 0.f); }
            }
        }
        LDS_BARRIER();
        if (wave == 7 && xn < G_NT) {
            f32x16 t0, t1; invert32_col(Lf, t0, t1, r);
            if (lane < 32) {
#pragma unroll
                for (int i = 0; i < 32; ++i) Tb[i * LD32 + r] = f2bf(TGET(i));
            }
        }
        if (wave < 2 && it >= 0) {
            const int pc = it & 1; int seg = 0, j0 = 0; chunk_pos(it, d, seg, j0);
            const bf16_t* Rc = Rr + pc * 32 * LD64; const bf16_t* BhTc = BhT + pc * 64 * LD32; const bf16_t* KhTc = KhT + pc * 64 * LD32; const bf16_t* VTc = VT + (pc * 64 + 32 * wave + r) * LD32;
            const bf16_t* Mrbc = Mrb + pc * 32 * LD32; const bf16_t* Mrkc = Mrk + pc * 32 * LD32; const float* PCc = PC + pc * 64;
            const bf16x8 vf0 = ld_nat(VTc, 0, hh), vf1 = ld_nat(VTc, 1, hh);
            f32x16 u = zero16(), y = zero16();
            u = MFMA32(ld_nat(TLm + r * LD32, 0, hh), vf0, u); u = MFMA32(ld_nat(TLm + r * LD32, 1, hh), vf1, u);
            y = MFMA32(ld_nat(Mrkc + r * LD32, 0, hh), vf0, y); y = MFMA32(ld_nat(Mrkc + r * LD32, 1, hh), vf1, y);
#define RW_KSTEP(s) { const bf16x8 xb = pack_acc<(s) & 1>(Xt[(s) >> 1]); u = MFMA32(ld_perm(Wm + r * LD64, (s), hh), xb, u); y = MFMA32(ld_perm(Rc + r * LD64, (s), hh), xb, y); }
            RW_KSTEP(0) RW_KSTEP(1) RW_KSTEP(2) RW_KSTEP(3)
#undef RW_KSTEP
            const bf16x8 ub0 = pack_acc<0>(u), ub1 = pack_acc<1>(u);
            y = MFMA32(ld_perm(Mrbc + r * LD32, 0, hh), ub0, y); y = MFMA32(ld_perm(Mrbc + r * LD32, 1, hh), ub1, y);
#pragma unroll
            for (int kt = 0; kt < 2; ++kt) {
#pragma unroll
                for (int g = 0; g < 16; ++g) Xt[kt][g] *= PCc[32 * kt + crow(g, hh)];
                Xt[kt] = MFMA32(ld_perm(BhTc + (32 * kt + r) * LD32, 0, hh), ub0, Xt[kt]); Xt[kt] = MFMA32(ld_perm(BhTc + (32 * kt + r) * LD32, 1, hh), ub1, Xt[kt]);
                Xt[kt] = MFMA32(ld_nat(KhTc + (32 * kt + r) * LD32, 0, hh), vf0, Xt[kt]); Xt[kt] = MFMA32(ld_nat(KhTc + (32 * kt + r) * LD32, 1, hh), vf1, Xt[kt]);
            }
            if (seg) {
#pragma unroll
                for (int g = 0; g < 16; ++g) {
                    const int i = crow(g, hh), jj = d ? j0 + GC - 1 - i : j0 + i;
                    YDIR[((size_t)d * T_LAT + (size_t)b * S + (jj % ROWS) * GW + jj / ROWS) * 512 + h * 64 + 32 * wave + r] = f2bf(y[g]);
                }
            }
        }
        LDS_BARRIER();
        if (xn < G_NT && wave < 3) {
            const bf16_t* arow = (wave < 2) ? AT + (32 * wave + r) * LD32 : LakT + r * LD32;
            f32x16 acc = zero16();
#pragma unroll
            for (int s = 0; s < 2; ++s) acc = MFMA32(ld_nat(arow, s, hh), ld_nat(Tb + r * LD32, s, hh), acc);
#pragma unroll
            for (int q = 0; q < 4; ++q) {
                u32x2 o; o.x = pk2(acc[4 * q], acc[4 * q + 1]); o.y = pk2(acc[4 * q + 2], acc[4 * q + 3]);
                if (wave < 2) *(u32x2*)(Wm + r * LD64 + 32 * wave + 8 * q + 4 * hh) = o; else *(u32x2*)(TLm + r * LD32 + 8 * q + 4 * hh) = o;
            }
        }
        LDS_BARRIER();
    }
}

DI void phase3(const Params& p, char* smem) {
    constexpr int NG = 2 * NB * H_A, NR = 2 * NB * H_B;
    for (int it = blockIdx.x; it < NG; it += gridDim.x) gdn_chain2(p, smem, it);
    for (int it = blockIdx.x; it < NG + NR; it += gridDim.x) if (it >= NG) rwkv_chain2(p, smem, it - NG);
}

DI void phase4(const Params& p, char* smem) {
    const int tid = threadIdx.x, lane = tid & 63, wave = tid >> 6;
    const bf16_t* PL = (const bf16_t*)(p.ws + WS_PLAT);
    const bf16_t* ODIR = (const bf16_t*)(p.aux + AUX_ODIR); const bf16_t* YDIR = (const bf16_t*)(p.aux + AUX_YDIR);
    const float* BON = (const float*)(p.ws + WS_BONUS); const float* mu = p.in[I_MU];
    bf16_t* OA = (bf16_t*)(p.ws + WS_OA); bf16_t* OB = (bf16_t*)(p.ws + WS_OB);
    float* sg = (float*)smem;
    for (int it = blockIdx.x; it < T_LAT / 16; it += gridDim.x) {
        const int tok0 = it * 16, b = tok0 / S, l0 = tok0 % S;
        __syncthreads();
        for (int idx = tid; idx < 16 * 128; idx += NTHREADS) {
            const int t = idx >> 7, jj = idx & 127, l = l0 + t, j = (l % GW) * ROWS + l / GW, col = COL_B0 + 1792 + jj;
            const float cu = bf2f(PL[(size_t)(b * S + l) * IN_COLS + col]);
            float pv = 0.f, nx = 0.f;
            if (j > 0) { const int l2 = ((j - 1) % ROWS) * GW + (j - 1) / ROWS; pv = bf2f(PL[(size_t)(b * S + l2) * IN_COLS + col]); }
            if (j < S - 1) { const int l2 = ((j + 1) % ROWS) * GW + (j + 1) / ROWS; nx = bf2f(PL[(size_t)(b * S + l2) * IN_COLS + col]); }
            sg[idx] = sigmoidf_(cu + (0.5f * (pv + nx) - cu) * mu[1792 + jj]);
        }
        __syncthreads();
        {
            const int c = tid, h = wave;
            float gacc[16];
#pragma unroll
            for (int t = 0; t < 16; ++t) gacc[t] = 0.f;
            for (int jj = 0; jj < 128; ++jj) {
                const float g = p.in[I_G2][jj * 512 + c];
#pragma unroll
                for (int t = 0; t < 16; ++t) gacc[t] += sg[t * 128 + jj] * g;
            }
            const float lg = p.in[I_LNG][c], lb = p.in[I_LNB][c], muv = mu[1024 + c];
#pragma unroll
            for (int t = 0; t < 16; ++t) {
                const int l = l0 + t, tok = b * S + l, j = (l % GW) * ROWS + l / GW, col = COL_B0 + 1024 + c;
                const float yf = bf2f(YDIR[(size_t)tok * 512 + c]) + bf2f(YDIR[((size_t)T_LAT + tok) * 512 + c]);
                const float mean = wave_sum(yf) * (1.f / 64.f); const float dv = yf - mean;
                const float var = wave_sum(dv * dv) * (1.f / 64.f);
                const float yn = dv * (1.0f / sqrtf(var + 64e-5f)) * lg + lb;
                const float cu = bf2f(PL[(size_t)tok * IN_COLS + col]);
                float pv = 0.f, nx = 0.f;
                if (j > 0) { const int l2 = ((j - 1) % ROWS) * GW + (j - 1) / ROWS; pv = bf2f(PL[(size_t)(b * S + l2) * IN_COLS + col]); }
                if (j < S - 1) { const int l2 = ((j + 1) % ROWS) * GW + (j + 1) / ROWS; nx = bf2f(PL[(size_t)(b * S + l2) * IN_COLS + col]); }
                const float xv = cu + (0.5f * (pv + nx) - cu) * muv;
                const float bon = BON[(size_t)tok * 8 + h] + BON[((size_t)T_LAT + tok) * 8 + h];
                OB[(size_t)tok * 512 + c] = f2bf((yn + bon * xv) * gacc[t]);
            }
        }
        for (int pi = wave * 8; pi < wave * 8 + 8; ++pi) {
            const int t = pi >> 2, h = pi & 3, tok = tok0 + t;
            const size_t o0 = (size_t)tok * 512 + h * 128;
            const float a0 = bf2f(ODIR[o0 + lane]) + bf2f(ODIR[(size_t)T_LAT * 512 + o0 + lane]);
            const float a1 = bf2f(ODIR[o0 + lane + 64]) + bf2f(ODIR[(size_t)T_LAT * 512 + o0 + lane + 64]);
            const float ss = wave_sum(a0 * a0 + a1 * a1);
            const float rstd = 1.0f / sqrtf(ss * (1.f / 128.f) + 1e-6f);
            const float z0 = bf2f(PL[(size_t)tok * IN_COLS + 1536 + h * 128 + lane]), z1 = bf2f(PL[(size_t)tok * IN_COLS + 1536 + h * 128 + lane + 64]);
            OA[o0 + lane] = f2bf(a0 * rstd * p.in[I_ONORM][lane] * siluf_(z0));
            OA[o0 + lane + 64] = f2bf(a1 * rstd * p.in[I_ONORM][lane + 64] * siluf_(z1));
        }
    }
}

DI void phase5(const Params& p, char* smem) {
    const int tid = threadIdx.x, lane = tid & 63, wave = tid >> 6, wr = wave >> 1, wc = wave & 1, fr = lane & 15, fq = lane >> 4;
    const bf16_t* OA = (const bf16_t*)(p.ws + WS_OA); const bf16_t* OB = (const bf16_t*)(p.ws + WS_OB);
    const bf16_t* WA = (const bf16_t*)(p.ws + WS_WOA); const bf16_t* WB = (const bf16_t*)(p.ws + WS_WOB);
    const bf16_t* PL = (const bf16_t*)(p.ws + WS_PLAT); bf16_t* Y = (bf16_t*)(p.aux + AUX_Y);
    constexpr int MR5 = 2, BM5 = 64 * MR5; constexpr int NT = D / 128, MT = T_LAT / BM5;
    for (int t = blockIdx.x; t < MT * NT; t += gridDim.x) {
        const int mt = t / NT, nt = t % NT, row0 = mt * BM5;
        f32x4 acca[MR5][4], accb[MR5][4]; acc_zero(acca); acc_zero(accb);
        gemm_kloop(acca, smem, [&](int i) { return OA + (size_t)(row0 + i) * 512; }, WA + (size_t)nt * 128 * 512, 512, 512);
        gemm_kloop(accb, smem, [&](int i) { return OB + (size_t)(row0 + i) * 512; }, WB + (size_t)nt * 128 * 512, 512, 512);
#pragma unroll
        for (int m = 0; m < MR5; ++m)
#pragma unroll
            for (int n = 0; n < 4; ++n)
#pragma unroll
                for (int j = 0; j < 4; ++j) {
                    const int row = row0 + wr * 16 * MR5 + m * 16 + fq * 4 + j, col = nt * 128 + wc * 64 + n * 16 + fr;
                    const float ga = bf2f(PL[(size_t)row * IN_COLS + COL_G0 + col]), gb = bf2f(PL[(size_t)row * IN_COLS + COL_G0 + D + col]);
                    Y[(size_t)row * D + col] = f2bf(sigmoidf_(ga) * acca[m][n][j] + sigmoidf_(gb) * accb[m][n][j]);
                }
    }
}

DI void phase6(const Params& p, char* smem) {
    const int tid = threadIdx.x, lane = tid & 63, wave = tid >> 6, wr = wave >> 1, wc = wave & 1, fr = lane & 15, fq = lane >> 4;
    const bf16_t* Y = (const bf16_t*)(p.aux + AUX_Y); const bf16_t* WO = (const bf16_t*)(p.ws + WS_WOUT);
    const float* mod = (const float*)(p.ws + WS_MOD); float* Hh = (float*)(p.ws + WS_H);
    constexpr int NT = D / 128, MT = T_LAT / BM;
    for (int t = blockIdx.x; t < MT * NT; t += gridDim.x) {
        const int mt = t / NT, nt = t % NT, row0 = mt * BM;
        f32x4 acc[MREP][4]; acc_zero(acc);
        gemm_kloop(acc, smem, [&](int i) { return Y + (size_t)(row0 + i) * D; }, WO + (size_t)nt * 128 * D, D, D);
#pragma unroll
        for (int m = 0; m < MREP; ++m)
#pragma unroll
            for (int n = 0; n < 4; ++n)
#pragma unroll
                for (int j = 0; j < 4; ++j) {
                    const int row = row0 + wr * 16 * MREP + m * 16 + fq * 4 + j, col = nt * 128 + wc * 64 + n * 16 + fr, b = row / S;
                    Hh[(size_t)row * D + col] = p.in[I_X][(size_t)row * D + col] + mod[(size_t)b * 6 * D + 2 * D + col] * acc[m][n][j];
                }
    }
    __syncthreads();
    const int gw = blockIdx.x * 8 + wave, ngw = gridDim.x * 8;
    float* scr = (float*)smem + wave * (64 * 33);
    bf16_t* GUT = (bf16_t*)(p.aux + AUX_GUT); bf16_t* DNT = (bf16_t*)(p.ws + WS_DNT);
    {
        constexpr int nkb = D / 64, nnb = DE / 32, per = nkb * nnb;
        for (int it = gw; it < NEXP * 2 * per; it += ngw) {
            const int e = it / (2 * per), r = it % (2 * per), up = r / per, r2 = r % per, kb = r2 / nnb, nb = r2 % nnb;
            transpose_item((up ? p.in[I_MU_UP] : p.in[I_MG]) + (size_t)e * D * DE, DE, DE, kb * 64, nb * 32, GUT + (size_t)e * 512 * D, D, up ? 2 : 1, scr, lane);
        }
    }
    {
        constexpr int nkb = DE / 64, nnb = D / 32, per = nkb * nnb;
        for (int it = gw; it < NEXP * per; it += ngw) {
            const int e = it / per, r2 = it % per, kb = r2 / nnb, nb = r2 % nnb;
            transpose_item(p.in[I_MD] + (size_t)e * DE * D, D, D, kb * 64, nb * 32, DNT + (size_t)e * D * DE, DE, 0, scr, lane);
        }
    }
}

DI void phase7(const Params& p, char* smem) {
    const int tid = threadIdx.x, lane = tid & 63, wave = tid >> 6;
    const int gw = blockIdx.x * 8 + wave, ngw = gridDim.x * 8;
    const float* Hh = (const float*)(p.ws + WS_H); const float* mod = (const float*)(p.ws + WS_MOD);
    bf16_t* Tt = (bf16_t*)(p.ws + WS_T); int* cnt = (int*)(p.ws + WS_CNT); int* rowlist = (int*)(p.ws + WS_ROWLIST); float* pairw = (float*)(p.ws + WS_PAIRW);
    float* tb = (float*)smem + wave * (4 * D + 4 * 40);
    float* lgt = tb + 4 * D;
    for (int it = gw; it < T_LAT / 4; it += ngw) {
        const int tok0 = it * 4;
#pragma unroll
        for (int tt = 0; tt < 4; ++tt) {
            const int tok = tok0 + tt, b = tok / S; const float* src = Hh + (size_t)tok * D;
            f32x4 x[D / 256]; float ss = 0.f;
#pragma unroll
            for (int j = 0; j < D / 256; ++j) { x[j] = *(const f32x4*)(src + j * 256 + lane * 4); ss += x[j].x * x[j].x + x[j].y * x[j].y + x[j].z * x[j].z + x[j].w * x[j].w; }
            ss = wave_sum(ss);
            const float rstd = 1.0f / sqrtf(ss * (1.0f / D) + 1e-6f);
#pragma unroll
            for (int j = 0; j < D / 256; ++j) {
                const int k = j * 256 + lane * 4;
                const f32x4 g = *(const f32x4*)(p.in[I_NFFN] + k), sh = *(const f32x4*)(mod + (size_t)b * 6 * D + 3 * D + k), sc = *(const f32x4*)(mod + (size_t)b * 6 * D + 4 * D + k);
                f32x4 o; o.x = x[j].x * rstd * g.x * (1.f + sc.x) + sh.x; o.y = x[j].y * rstd * g.y * (1.f + sc.y) + sh.y;
                o.z = x[j].z * rstd * g.z * (1.f + sc.z) + sh.z; o.w = x[j].w * rstd * g.w * (1.f + sc.w) + sh.w;
                *(f32x4*)(tb + tt * D + k) = o;
                u32x2 ob; ob.x = pk2(o.x, o.y); ob.y = pk2(o.z, o.w);
                *(u32x2*)(Tt + (size_t)tok * D + k) = ob;
            }
        }
        WAVE_SYNC();
        {
            float a0 = 0.f, a1 = 0.f, a2 = 0.f, a3 = 0.f;
            const int col = lane < 36 ? lane : 35;
            const float* wp = col < 4 ? p.in[I_RG] + col : p.in[I_RE] + (col - 4); const int ldw = col < 4 ? 4 : 32;
            for (int k = 0; k < D; ++k) { const float w = wp[(size_t)k * ldw]; a0 += tb[k] * w; a1 += tb[D + k] * w; a2 += tb[2 * D + k] * w; a3 += tb[3 * D + k] * w; }
            const float bias = col < 4 ? p.in[I_RGB][col] : p.in[I_REB][col - 4];
            if (lane < 36) { lgt[0 * 40 + lane] = a0 + bias; lgt[1 * 40 + lane] = a1 + bias; lgt[2 * 40 + lane] = a2 + bias; lgt[3 * 40 + lane] = a3 + bias; }
        }
        WAVE_SYNC();
        if (lane < 4) {
            const float* L = lgt + lane * 40; const int tok = tok0 + lane;
            int g = 0; float mx = L[0];
            for (int i = 1; i < 4; ++i) if (L[i] > mx) { mx = L[i]; g = i; }
            float se = 0.f; for (int i = 0; i < 4; ++i) se += expf(L[i] - mx);
            const float pg = 1.0f / se;
            const float* E = L + 4 + g * 8;
            int i1 = 0; float l1 = E[0];
            for (int i = 1; i < 8; ++i) if (E[i] > l1) { l1 = E[i]; i1 = i; }
            int i2 = -1; float l2 = -3.0e38f;
            for (int i = 0; i < 8; ++i) if (i != i1 && E[i] > l2) { l2 = E[i]; i2 = i; }
            const float e2 = expf(l2 - l1); const float w1 = pg / (1.f + e2), w2 = pg * e2 / (1.f + e2);
            const int ex1 = g * 8 + i1, ex2 = g * 8 + i2;
            const int p1 = atomicAdd(&cnt[ex1], 1); rowlist[(size_t)ex1 * CAP + p1] = tok * 2; pairw[tok * 2] = w1;
            const int p2 = atomicAdd(&cnt[ex2], 1); rowlist[(size_t)ex2 * CAP + p2] = tok * 2 + 1; pairw[tok * 2 + 1] = w2;
        }
        WAVE_SYNC();
    }
}

DI void moe_tiles(const Params& p, char* smem, int* pre) {
    const int* cnt = (const int*)(p.ws + WS_CNT);
    __syncthreads();
    if (threadIdx.x == 0) { int s = 0; for (int e = 0; e < NEXP; ++e) { pre[e] = s; s += (cnt[e] + BM - 1) / BM; } pre[NEXP] = s; }
    __syncthreads();
}
DI void phase8(const Params& p, char* smem) {
    const int tid = threadIdx.x, lane = tid & 63, wave = tid >> 6, wr = wave >> 1, wc = wave & 1, fr = lane & 15, fq = lane >> 4;
    int* pre = (int*)(smem + LDS_BYTES - 256);
    moe_tiles(p, smem, pre);
    const int* cnt = (const int*)(p.ws + WS_CNT); const int* rowlist = (const int*)(p.ws + WS_ROWLIST);
    const bf16_t* Tt = (const bf16_t*)(p.ws + WS_T); const bf16_t* GUT = (const bf16_t*)(p.aux + AUX_GUT); bf16_t* HID = (bf16_t*)(p.ws + WS_HID);
    const int ntile = pre[NEXP] * 4;
    for (int t = blockIdx.x; t < ntile; t += gridDim.x) {
        const int mg = t >> 2, nt = t & 3; int e = 0;
        while (pre[e + 1] <= mg) ++e;
        const int mt = mg - pre[e], ce = cnt[e]; const int* rl = rowlist + (size_t)e * CAP;
        f32x4 acc[MREP][4]; acc_zero(acc);
        gemm_kloop(acc, smem, [&](int i) { int idx = mt * BM + i; idx = idx < ce ? idx : ce - 1; return Tt + (size_t)(rl[idx] >> 1) * D; }, GUT + ((size_t)e * 512 + nt * 128) * D, D, D);
#pragma unroll
        for (int m = 0; m < MREP; ++m)
#pragma unroll
            for (int j = 0; j < 4; ++j) {
                const int idx = mt * BM + wr * 16 * MREP + m * 16 + fq * 4 + j;
                if (idx < ce) {
                    const int pair = rl[idx];
#pragma unroll
                    for (int n = 0; n < 2; ++n) {
                        const float g = acc[m][n][j], u = acc[m][n + 2][j];
                        HID[(size_t)pair * DE + nt * 64 + wc * 32 + n * 16 + fr] = f2bf(siluf_(g) * u);
                    }
                }
            }
    }
}
DI void phase9(const Params& p, char* smem) {
    const int tid = threadIdx.x, lane = tid & 63, wave = tid >> 6, wr = wave >> 1, wc = wave & 1, fr = lane & 15, fq = lane >> 4;
    int* pre = (int*)(smem + LDS_BYTES - 256);
    moe_tiles(p, smem, pre);
    const int* cnt = (const int*)(p.ws + WS_CNT); const int* rowlist = (const int*)(p.ws + WS_ROWLIST); const float* pairw = (const float*)(p.ws + WS_PAIRW);
    const bf16_t* HID = (const bf16_t*)(p.ws + WS_HID); const bf16_t* DNT = (const bf16_t*)(p.ws + WS_DNT); bf16_t* OP = (bf16_t*)(p.ws + WS_OPAIR);
    constexpr int NT = D / 128;
    const int ntile = pre[NEXP] * NT;
    for (int t = blockIdx.x; t < ntile; t += gridDim.x) {
        const int mg = t / NT, nt = t % NT; int e = 0;
        while (pre[e + 1] <= mg) ++e;
        const int mt = mg - pre[e], ce = cnt[e]; const int* rl = rowlist + (size_t)e * CAP;
        f32x4 acc[MREP][4]; acc_zero(acc);
        gemm_kloop(acc, smem, [&](int i) { int idx = mt * BM + i; idx = idx < ce ? idx : ce - 1; return HID + (size_t)rl[idx] * DE; }, DNT + ((size_t)e * D + nt * 128) * DE, DE, DE);
#pragma unroll
        for (int m = 0; m < MREP; ++m)
#pragma unroll
            for (int j = 0; j < 4; ++j) {
                const int idx = mt * BM + wr * 16 * MREP + m * 16 + fq * 4 + j;
                if (idx < ce) {
                    const int pair = rl[idx]; const float w = pairw[pair];
#pragma unroll
                    for (int n = 0; n < 4; ++n) OP[(size_t)pair * D + nt * 128 + wc * 64 + n * 16 + fr] = f2bf(acc[m][n][j] * w);
                }
            }
    }
}

DI void phase10(const Params& p, char* smem) {
    const int lane = threadIdx.x & 63, wave = threadIdx.x >> 6;
    const int gw = blockIdx.x * 8 + wave, ngw = gridDim.x * 8;
    const float* Hh = (const float*)(p.ws + WS_H); const float* mod = (const float*)(p.ws + WS_MOD); const bf16_t* OP = (const bf16_t*)(p.ws + WS_OPAIR);
    for (int tok = gw; tok < T_LAT; tok += ngw) {
        const int b = tok / S;
        f32x4 x[D / 256]; float ss = 0.f;
#pragma unroll
        for (int j = 0; j < D / 256; ++j) {
            const int k = j * 256 + lane * 4;
            const f32x4 hv = *(const f32x4*)(Hh + (size_t)tok * D + k), g2 = *(const f32x4*)(mod + (size_t)b * 6 * D + 5 * D + k);
            const u32x2 p0 = *(const u32x2*)(OP + (size_t)(tok * 2) * D + k), p1 = *(const u32x2*)(OP + (size_t)(tok * 2 + 1) * D + k);
            f32x4 m;
            m.x = bf2f((bf16_t)(p0.x & 0xffffu)) + bf2f((bf16_t)(p1.x & 0xffffu)); m.y = bf2f((bf16_t)(p0.x >> 16)) + bf2f((bf16_t)(p1.x >> 16));
            m.z = bf2f((bf16_t)(p0.y & 0xffffu)) + bf2f((bf16_t)(p1.y & 0xffffu)); m.w = bf2f((bf16_t)(p0.y >> 16)) + bf2f((bf16_t)(p1.y >> 16));
            x[j].x = hv.x + g2.x * m.x; x[j].y = hv.y + g2.y * m.y; x[j].z = hv.z + g2.z * m.z; x[j].w = hv.w + g2.w * m.w;
            ss += x[j].x * x[j].x + x[j].y * x[j].y + x[j].z * x[j].z + x[j].w * x[j].w;
        }
        ss = wave_sum(ss);
        const float rstd = 1.0f / sqrtf(ss * (1.0f / D) + 1e-6f);
#pragma unroll
        for (int j = 0; j < D / 256; ++j) {
            const int k = j * 256 + lane * 4; const f32x4 g = *(const f32x4*)(p.in[I_FIN] + k);
            f32x4 o; o.x = x[j].x * rstd * g.x; o.y = x[j].y * rstd * g.y; o.z = x[j].z * rstd * g.z; o.w = x[j].w * rstd * g.w;
            *(f32x4*)(p.out + (size_t)tok * D + k) = o;
        }
    }
}

DI void run_phase(const Params& p, int ph, char* smem) {
    switch (ph) {
        case 0: phase0(p, smem); break;
        case 1: phase1(p, smem); break;
        case 2: phase2(p, smem); break;
        case 3: phase3(p, smem); break;
        case 4: phase4(p, smem); break;
        case 5: phase5(p, smem); break;
        case 6: phase6(p, smem); break;
        case 7: phase7(p, smem); break;
        case 8: phase8(p, smem); break;
        case 9: phase9(p, smem); break;
        default: phase10(p, smem); break;
    }
}

#ifndef EMU
namespace cg = cooperative_groups;
DI void grid_barrier_fast(unsigned* ctr, unsigned target) {
    asm volatile("s_waitcnt vmcnt(0)" ::: "memory");
    __syncthreads();
    if (threadIdx.x == 0) {
        __builtin_amdgcn_fence(__ATOMIC_RELEASE, "agent");
        asm volatile("s_waitcnt vmcnt(0)" ::: "memory");
        __hip_atomic_fetch_add(ctr, 1u, __ATOMIC_RELAXED, __HIP_MEMORY_SCOPE_AGENT);
        unsigned spins = 0;
        while (__hip_atomic_load(ctr, __ATOMIC_RELAXED, __HIP_MEMORY_SCOPE_AGENT) < target) { __builtin_amdgcn_s_sleep(1); if (++spins > (1u << 24)) break; }
        __builtin_amdgcn_fence(__ATOMIC_ACQUIRE, "agent");
        asm volatile("s_waitcnt vmcnt(0)" ::: "memory");
    }
    __syncthreads();
}
__global__ void __launch_bounds__(NTHREADS) mk_forward(Params p) {
    extern __shared__ __attribute__((aligned(16))) char smem[];
    cg::grid_group grid = cg::this_grid();
    unsigned* bar = (unsigned*)(p.ws + WS_BAR);
    const unsigned G = gridDim.x;
#define PHASE(k, fn) { fn(p, smem); if ((k) == 0) grid.sync(); else if ((k) + 1 < NPHASES) grid_barrier_fast(bar, (unsigned)(k) * G); }
    PHASE(0, phase0) PHASE(1, phase1) PHASE(2, phase2) PHASE(3, phase3) PHASE(4, phase4) PHASE(5, phase5)
    PHASE(6, phase6) PHASE(7, phase7) PHASE(8, phase8) PHASE(9, phase9) PHASE(10, phase10)
#undef PHASE
}

extern "C" void kernel_launch(void* const* d_in, const int* in_sizes, int n_in, void* d_out, int out_size, void* d_ws, size_t ws_size, hipStream_t stream) {
    static int grid_blocks = 0;
    if (grid_blocks == 0) {
        if (n_in != 35 || out_size != T_LAT * D || ws_size < WS_END || (size_t)out_size * 4 < AUX_END) {
            fprintf(stderr, "kernel_launch: unexpected shapes (n_in %d out %d ws %zu need %zu aux need %zu)\n", n_in, out_size, ws_size, (size_t)WS_END, (size_t)AUX_END);
            grid_blocks = -1; return;
        }
        int dev = 0, cus = 0, per_cu = 0;
        hipGetDevice(&dev);
        hipDeviceGetAttribute(&cus, hipDeviceAttributeMultiprocessorCount, dev);
        hipFuncSetAttribute((const void*)mk_forward, hipFuncAttributeMaxDynamicSharedMemorySize, LDS_BYTES);
        hipOccupancyMaxActiveBlocksPerMultiprocessor(&per_cu, (const void*)mk_forward, NTHREADS, LDS_BYTES);
        if (per_cu < 1) { fprintf(stderr, "kernel_launch: occupancy query says %d blocks/CU\n", per_cu); per_cu = 1; }
        if (per_cu > 1) per_cu = 1;
        grid_blocks = cus * per_cu;
    }
    if (grid_blocks < 0) return;
    Params p{};
    for (int i = 0; i < 35; ++i) p.in[i] = (const float*)d_in[i];
    p.out = (float*)d_out; p.ws = (char*)d_ws; p.aux = (char*)d_out;
    p.ph_lo = 0; p.ph_hi = NPHASES;
    void* args[] = {&p};
    hipError_t e = hipLaunchCooperativeKernel((const void*)mk_forward, dim3(grid_blocks), dim3(NTHREADS), args, LDS_BYTES, stream);
    if (e != hipSuccess) fprintf(stderr, "cooperative launch failed: %s (grid %d)\n", hipGetErrorString(e), grid_blocks);
}
#endif
```

```cpp
#ifndef EMU
#include <hip/hip_runtime.h>
#include <hip/hip_cooperative_groups.h>
#include <cstdio>
#endif
#include <stdint.h>
#include <stddef.h>

#ifndef CFG_D
#define CFG_D 1024
#define CFG_B 8
#define CFG_S 2048
#define CFG_CTX 256
#endif
#ifndef MK_LAUNCHES
#define MK_LAUNCHES 1
#endif

typedef unsigned short bf16_t;
typedef short bf16x8 __attribute__((ext_vector_type(8)));
typedef float f32x4 __attribute__((ext_vector_type(4)));
typedef unsigned u32x4 __attribute__((ext_vector_type(4)));
typedef unsigned u32x2 __attribute__((ext_vector_type(2)));

#define DI __device__ __forceinline__
DI int tid_x() { int t = (int)threadIdx.x;
#ifndef EMU
    asm volatile("" : "+v"(t));
#endif
    return t; }

constexpr int D = CFG_D, NB = CFG_B, S = CFG_S, CTXL = CFG_CTX;
constexpr int GW = 64, ROWS = S / GW;
constexpr int T_CTX = NB * CTXL, T_LAT = NB * S, T_ALL = T_CTX + T_LAT;
constexpr int H_A = 4, H_B = 8;
constexpr int A_COLS = 2064, B_COLS = 1920;
constexpr int IN_COLS = A_COLS + B_COLS + 2 * D;
constexpr int COL_B0 = A_COLS, COL_G0 = A_COLS + B_COLS;
constexpr int CTX_COLS = COL_G0;
constexpr int NP = ((IN_COLS + 127) / 128) * 128;
constexpr int NEXP = 32, DE = 256;
constexpr int NV = NB + 1;
constexpr int NTHREADS = 512;
constexpr int MREP = (T_CTX % 256 == 0 && T_LAT % 256 == 0) ? 4 : 2;
constexpr int BM = 64 * MREP;
constexpr int NPHASES = 11;
constexpr int LDS_BYTES = 155648;
constexpr int CAP = T_LAT;

static_assert(D % 256 == 0 && S % 64 == 0 && CTXL % 64 == 0 && T_CTX % BM == 0 && T_LAT % BM == 0, "shape");

constexpr size_t al256(size_t x) { return (x + 255) & ~(size_t)255; }
constexpr size_t WS_CNT = 0;
constexpr size_t WS_BAR = 256;
constexpr size_t WS_MOD = 512;
constexpr size_t WS_AB = al256(WS_MOD + (size_t)NV * 6 * D * 4);
constexpr size_t WS_BONUS = al256(WS_AB + (size_t)T_ALL * 16 * 4);
constexpr size_t WS_PAIRW = al256(WS_BONUS + (size_t)2 * T_LAT * 8 * 4);
constexpr size_t WS_ROWLIST = al256(WS_PAIRW + (size_t)T_LAT * 2 * 4);
constexpr size_t WS_WRT = al256(WS_ROWLIST + (size_t)NEXP * CAP * 4);
constexpr size_t WS_WOA = al256(WS_WRT + (size_t)36 * D * 4);
constexpr size_t WS_WOB = al256(WS_WOA + (size_t)D * 512 * 2);
constexpr size_t WS_WOUT = al256(WS_WOB + (size_t)D * 512 * 2);
constexpr size_t WS_OA = al256(WS_WOUT + (size_t)D * D * 2);
constexpr size_t WS_OB = al256(WS_OA + (size_t)T_LAT * 512 * 2);
constexpr size_t WS_DNT = WS_OA;
constexpr size_t WS_SPARE_END = al256(WS_OB + (size_t)T_LAT * 512 * 2) > al256(WS_DNT + (size_t)NEXP * D * DE * 2) ? al256(WS_OB + (size_t)T_LAT * 512 * 2) : al256(WS_DNT + (size_t)NEXP * D * DE * 2);
constexpr size_t WS_P = WS_SPARE_END;
constexpr size_t WS_PLAT = WS_P;
constexpr size_t WS_PCTX = al256(WS_PLAT + (size_t)T_LAT * IN_COLS * 2);
constexpr size_t WS_P_END = al256(WS_PCTX + (size_t)T_CTX * CTX_COLS * 2);
constexpr size_t WS_H = WS_P;
constexpr size_t WS_T = al256(WS_H + (size_t)T_LAT * D * 4);
constexpr size_t WS_HID = al256(WS_T + (size_t)T_LAT * D * 2);
constexpr size_t WS_OPAIR = al256(WS_HID + (size_t)T_LAT * 2 * DE * 2);
constexpr size_t WS_P2_END = al256(WS_OPAIR + (size_t)T_LAT * 2 * D * 2);
constexpr size_t WS_END = WS_P_END > WS_P2_END ? WS_P_END : WS_P2_END;
constexpr size_t AUX_WINT = 0;
constexpr size_t AUX_U = al256((size_t)NP * D * 2);
constexpr size_t AUX_ODIR = 0;
constexpr size_t AUX_YDIR = (size_t)2 * T_LAT * 512 * 2;
constexpr size_t AUX_Y = 0;
constexpr size_t AUX_GUT = (size_t)T_LAT * D * 2;
constexpr size_t AUX_END1 = AUX_U + (size_t)T_ALL * D * 2;
constexpr size_t AUX_END2 = AUX_YDIR + (size_t)2 * T_LAT * 512 * 2;
constexpr size_t AUX_END3 = AUX_GUT + (size_t)NEXP * 512 * D * 2;
constexpr size_t AUX_END = (AUX_END1 > AUX_END2 ? (AUX_END1 > AUX_END3 ? AUX_END1 : AUX_END3) : (AUX_END2 > AUX_END3 ? AUX_END2 : AUX_END3));

struct Params {
    const float* in[35];
    float* out;
    char* ws;
    char* aux;
    int ph_lo, ph_hi;
};
enum { I_X = 0, I_C, I_CTX, I_CCTX, I_ADAW, I_ADAB, I_NMIX, I_NFFN, I_WIN, I_CONV, I_ALOG, I_DTB, I_ONORM, I_MU, I_W0, I_W2, I_A0, I_A2, I_G2, I_KK, I_KA, I_RK, I_LNG, I_LNB, I_WOA, I_WOB, I_WOUT, I_RG, I_RGB, I_RE, I_REB, I_MG, I_MU_UP, I_MD, I_FIN };

DI float bf2f(bf16_t v) { union { unsigned u; float f; } x; x.u = ((unsigned)v) << 16; return x.f; }
#ifdef EMU
DI bf16_t f2bf(float f) { union { float f; unsigned u; } x; x.f = f; unsigned u = x.u; u += 0x7fffu + ((u >> 16) & 1u); return (bf16_t)(u >> 16); }
DI unsigned pk2(float lo, float hi) { return (unsigned)f2bf(lo) | ((unsigned)f2bf(hi) << 16); }
#else
typedef __bf16 hbf16x2 __attribute__((ext_vector_type(2)));
typedef float f32x2_ __attribute__((ext_vector_type(2)));
DI bf16_t f2bf(float f) { return __builtin_bit_cast(unsigned short, (__bf16)f); }
DI unsigned pk2(float lo, float hi) { const f32x2_ v = {lo, hi}; return __builtin_bit_cast(unsigned, __builtin_convertvector(v, hbf16x2)); }
#endif
DI float sigmoidf_(float x) { return 1.0f / (1.0f + expf(-x)); }
DI float siluf_(float x) { return x / (1.0f + expf(-x)); }
DI float softplusf_(float x) { return x > 20.f ? x : log1pf(expf(x)); }
DI float wave_sum(float v) {
#pragma unroll
    for (int o = 1; o < 64; o <<= 1) v += __shfl_xor(v, o);
    return v;
}
#ifdef EMU
#define MFMA16(a, b, c) emu_mfma16((a), (b), (c))
#define WAVE_SYNC() emu::wave_bar()
#else
#define MFMA16(a, b, c) __builtin_amdgcn_mfma_f32_16x16x32_bf16((a), (b), (c), 0, 0, 0)
#define WAVE_SYNC() asm volatile("s_waitcnt lgkmcnt(0)" ::: "memory")
#endif
#ifdef EMU
#define LDS_BARRIER() __syncthreads()
#else
#define LDS_BARRIER() do { asm volatile("s_waitcnt lgkmcnt(0)" ::: "memory"); __builtin_amdgcn_s_barrier(); asm volatile("" ::: "memory"); } while (0)
#endif

constexpr int LDS_ROW = 40;
constexpr int GEMM_A_BYTES = BM * LDS_ROW * 2, GEMM_B_BYTES = 128 * LDS_ROW * 2;
template <int MR, class ARow>
DI void gemm_kloop(f32x4 (&acc)[MR][4], char* smem, ARow arow, const bf16_t* Bt, int ldb, int K) {
    constexpr int BM = 64 * MR;
    const int tid = tid_x(), lane = tid & 63, wave = tid >> 6, wr = wave >> 1, wc = wave & 1, fr = lane & 15, fq = lane >> 4;
    bf16_t* As = (bf16_t*)smem;
    bf16_t* Bs = (bf16_t*)(smem + 2 * GEMM_A_BYTES);
    constexpr int ACH = BM * 4 / NTHREADS;
    static_assert(ACH >= 1, "tile");
    const bf16_t* ap[ACH];
#pragma unroll
    for (int i = 0; i < ACH; ++i) { const int q = tid + i * NTHREADS; ap[i] = arow(q >> 2) + (q & 3) * 8; }
    const bf16_t* bp = Bt + (size_t)(tid >> 2) * ldb + (tid & 3) * 8;
    u32x4 ra[ACH], rb;
#pragma unroll
    for (int i = 0; i < ACH; ++i) ra[i] = *(const u32x4*)(ap[i]);
    rb = *(const u32x4*)(bp);
    const int nk = K / 32;
    for (int kt = 0; kt < nk; ++kt) {
        const int buf = kt & 1;
#pragma unroll
        for (int i = 0; i < ACH; ++i) { const int q = tid + i * NTHREADS; *(u32x4*)(As + (buf * BM + (q >> 2)) * LDS_ROW + (q & 3) * 8) = ra[i]; }
        *(u32x4*)(Bs + (buf * 128 + (tid >> 2)) * LDS_ROW + (tid & 3) * 8) = rb;
        __syncthreads();
        if (kt + 1 < nk) {
#pragma unroll
            for (int i = 0; i < ACH; ++i) ra[i] = *(const u32x4*)(ap[i] + (kt + 1) * 32);
            rb = *(const u32x4*)(bp + (kt + 1) * 32);
        }
        bf16x8 af[MR], bfr[4];
#pragma unroll
        for (int m = 0; m < MR; ++m) af[m] = *(const bf16x8*)(As + (buf * BM + wr * 16 * MR + m * 16 + fr) * LDS_ROW + fq * 8);
#pragma unroll
        for (int n = 0; n < 4; ++n) bfr[n] = *(const bf16x8*)(Bs + (buf * 128 + wc * 64 + n * 16 + fr) * LDS_ROW + fq * 8);
#pragma unroll
        for (int m = 0; m < MR; ++m)
#pragma unroll
            for (int n = 0; n < 4; ++n) acc[m][n] = MFMA16(af[m], bfr[n], acc[m][n]);
    }
    __syncthreads();
}
template <int MR>
DI void acc_zero(f32x4 (&acc)[MR][4]) {
#pragma unroll
    for (int m = 0; m < MR; ++m)
#pragma unroll
        for (int n = 0; n < 4; ++n) acc[m][n] = (f32x4){0.f, 0.f, 0.f, 0.f};
}

namespace g8 {
constexpr int BM = 256, BK = 64, HALF = 128, HT = HALF * BK;
constexpr int LDS_NEED = 8 * HT * 2;
DI int lds_byte(int r, int c) { const int st = (r >> 4) * 2 + (c >> 5), rr = r & 15, cc = c & 31, ob = rr * 64 + cc * 2; return st * 1024 + (ob ^ (((ob >> 9) & 1) << 5)); }
DI void stage_rc(int b, int& R, int& C) { const int st = b / 1024, sb = b % 1024, swz = sb ^ (((sb >> 9) & 1) << 5); R = (st >> 1) * 16 + swz / 64; C = (st & 1) * 32 + (swz % 64) / 2; }
#ifdef EMU
#define G8_GLDS(src, dst) emu_global_load_lds16((src), (dst))
#define G8_WAIT_V(n)
#define G8_WAIT_L(n)
#define G8_BAR __syncthreads()
#define G8_SCHED
#define G8_PRIO(x)
#else
#define G8_GLDS(src, dst) __builtin_amdgcn_global_load_lds((const unsigned*)(src), (__attribute__((address_space(3))) unsigned*)(dst), 16, 0, 0)
#define G8_WAIT_V(n) asm volatile("s_waitcnt vmcnt(" #n ")" ::: "memory")
#define G8_WAIT_L(n) asm volatile("s_waitcnt lgkmcnt(" #n ")" ::: "memory")
#define G8_BAR __builtin_amdgcn_s_barrier()
#define G8_SCHED __builtin_amdgcn_sched_barrier(0)
#define G8_PRIO(x) __builtin_amdgcn_s_setprio(x)
#endif
typedef f32x4 Acc[2][2][4][2];
template <class AOff>
DI void kloop_g(Acc& acc, char* smem, const bf16_t* A, AOff aoff, const bf16_t* Bt, int ldb, int K, int bcol) {
    bf16_t* shm = (bf16_t*)smem;
    const int tid = tid_x(), wid = tid >> 6, lane = tid & 63, wr = wid >> 2, wc = wid & 3, fr = lane & 15, fq = lane >> 4;
    int ao[2][2];
#pragma unroll
    for (int h = 0; h < 2; ++h)
#pragma unroll
        for (int i = 0; i < 2; ++i) { int R, C; stage_rc(tid * 16 + i * 8192, R, C); ao[h][i] = aoff(h * HALF + R) + C; }
#define G8_STAGE_A(P, h, kt) do { for (int _i = 0; _i < 2; ++_i) { const int _b = tid * 16 + _i * 8192; G8_GLDS(A + (size_t)ao[h][_i] + (size_t)(kt) * BK, (char*)(P) + _b); } } while (0)
#define G8_SA(b, h) (shm + ((b) * 2 + (h)) * HT)
#define G8_SB(b, h) (shm + (4 + (b) * 2 + (h)) * HT)
#define G8_STAGE(P, BASE, LD, br, kt) do { const bf16_t* _g = (BASE) + (size_t)(br) * (LD) + (size_t)(kt) * BK; \
    for (int _i = 0; _i < 2; ++_i) { const int _b = tid * 16 + _i * 8192; int _r, _c; stage_rc(_b, _r, _c); G8_GLDS(_g + (size_t)_r * (LD) + _c, (char*)(P) + _b); } } while (0)
#define G8_LDA(dst, b, h) for (int m = 0; m < 4; ++m) for (int k = 0; k < 2; ++k) dst[m][k] = *(const bf16x8*)((const char*)G8_SA(b, h) + lds_byte(wr * 64 + m * 16 + fr, k * 32 + fq * 8))
#define G8_LDB(dst, b, h) for (int n = 0; n < 2; ++n) for (int k = 0; k < 2; ++k) dst[n][k] = *(const bf16x8*)((const char*)G8_SB(b, h) + lds_byte(wc * 32 + n * 16 + fr, k * 32 + fq * 8))
#define G8_MMA(ai, bj, At_, Bt_) do { G8_PRIO(1); for (int m = 0; m < 4; ++m) for (int n = 0; n < 2; ++n) for (int k = 0; k < 2; ++k) \
    acc[ai][bj][m][n] = MFMA16(Bt_[n][k], At_[m][k], acc[ai][bj][m][n]); G8_PRIO(0); } while (0)
    bf16x8 At[4][2], B0[2][2], B1[2][2];
    const int nt = K / BK;
    G8_STAGE(G8_SB(0, 0), Bt, ldb, bcol, 0); G8_STAGE_A(G8_SA(0, 0), 0, 0);
    G8_STAGE(G8_SB(0, 1), Bt, ldb, bcol + HALF, 0); G8_STAGE_A(G8_SA(0, 1), 1, 0);
    if (wr == 1) G8_BAR;
    G8_WAIT_V(4); G8_BAR;
    G8_STAGE(G8_SB(1, 0), Bt, ldb, bcol, 1); G8_STAGE_A(G8_SA(1, 0), 0, 1); G8_STAGE(G8_SB(1, 1), Bt, ldb, bcol + HALF, 1);
    G8_WAIT_V(6); G8_BAR;
    for (int t = 0; t < nt - 2; t += 2) {
        G8_LDB(B0, 0, 0); G8_SCHED; G8_LDA(At, 0, 0); G8_STAGE_A(G8_SA(1, 1), 1, t + 1);
        G8_WAIT_L(8); G8_BAR; G8_WAIT_L(0); G8_MMA(0, 0, At, B0); G8_BAR; G8_SCHED;
        G8_LDB(B1, 0, 1); G8_STAGE(G8_SB(0, 0), Bt, ldb, bcol, t + 2);
        G8_BAR; G8_WAIT_L(0); G8_MMA(0, 1, At, B1); G8_BAR;
        G8_LDA(At, 0, 1); G8_STAGE_A(G8_SA(0, 0), 0, t + 2);
        G8_BAR; G8_WAIT_L(0); G8_MMA(1, 0, At, B0); G8_BAR; G8_SCHED;
        G8_STAGE(G8_SB(0, 1), Bt, ldb, bcol + HALF, t + 2);
        G8_WAIT_V(6); G8_BAR; G8_MMA(1, 1, At, B1); G8_BAR;
        G8_LDB(B0, 1, 0); G8_SCHED; G8_LDA(At, 1, 0); G8_STAGE_A(G8_SA(0, 1), 1, t + 2);
        G8_WAIT_L(8); G8_BAR; G8_WAIT_L(0); G8_MMA(0, 0, At, B0); G8_BAR; G8_SCHED;
        G8_LDB(B1, 1, 1); G8_STAGE(G8_SB(1, 0), Bt, ldb, bcol, t + 3);
        G8_BAR; G8_WAIT_L(0); G8_MMA(0, 1, At, B1); G8_BAR;
        G8_LDA(At, 1, 1); G8_STAGE_A(G8_SA(1, 0), 0, t + 3);
        G8_BAR; G8_WAIT_L(0); G8_MMA(1, 0, At, B0); G8_BAR; G8_SCHED;
        G8_STAGE(G8_SB(1, 1), Bt, ldb, bcol + HALF, t + 3);
        G8_WAIT_V(6); G8_BAR; G8_MMA(1, 1, At, B1); G8_BAR;
    }
    { G8_LDB(B0, 0, 0); G8_LDA(At, 0, 0); G8_STAGE_A(G8_SA(1, 1), 1, nt - 1);
      G8_BAR; G8_WAIT_L(0); G8_MMA(0, 0, At, B0); G8_BAR;
      G8_LDB(B1, 0, 1); G8_BAR; G8_WAIT_L(0); G8_MMA(0, 1, At, B1); G8_BAR;
      G8_LDA(At, 0, 1); G8_WAIT_V(4); G8_BAR; G8_WAIT_L(0); G8_MMA(1, 0, At, B0); G8_MMA(1, 1, At, B1); G8_BAR; }
    { G8_LDB(B0, 1, 0); G8_LDA(At, 1, 0); G8_WAIT_V(2); G8_BAR; G8_WAIT_L(0); G8_MMA(0, 0, At, B0); G8_BAR;
      G8_LDB(B1, 1, 1); G8_WAIT_V(0); G8_BAR; G8_WAIT_L(0); G8_MMA(0, 1, At, B1); G8_BAR;
      G8_LDA(At, 1, 1); G8_BAR; G8_WAIT_L(0); G8_MMA(1, 0, At, B0); G8_MMA(1, 1, At, B1); G8_BAR; }
    if (wr == 0) G8_BAR;
#undef G8_SA
#undef G8_SB
#undef G8_STAGE
#undef G8_STAGE_A
#undef G8_LDA
#undef G8_LDB
#undef G8_MMA
}
DI void kloop(Acc& acc, char* smem, const bf16_t* A, int lda, const bf16_t* Bt, int ldb, int K, int brow, int bcol) {
    kloop_g(acc, smem, A, [&](int r) { return (brow + r) * lda; }, Bt, ldb, K, bcol);
}
DI void acc_zero(Acc& acc) {
#pragma unroll
    for (int a = 0; a < 2; ++a)
#pragma unroll
        for (int b = 0; b < 2; ++b)
#pragma unroll
            for (int m = 0; m < 4; ++m)
#pragma unroll
                for (int n = 0; n < 2; ++n) acc[a][b][m][n] = (f32x4){0.f, 0.f, 0.f, 0.f};
}
template <class F> DI void for_each_quad(const Acc& acc, int brow, int bcol, F f) {
    const int tid = tid_x(), wid = tid >> 6, lane = tid & 63, wr = wid >> 2, wc = wid & 3, fr = lane & 15, fq = lane >> 4;
#pragma unroll
    for (int ai = 0; ai < 2; ++ai)
#pragma unroll
        for (int m = 0; m < 4; ++m)
#pragma unroll
            for (int bj = 0; bj < 2; ++bj)
#pragma unroll
                for (int n = 0; n < 2; ++n) f(brow + ai * HALF + wr * 64 + m * 16 + fr, bcol + bj * HALF + wc * 32 + n * 16 + fq * 4, acc[ai][bj][m][n]);
}
}

constexpr bool USE_G8 = ((NB * CTXL) % 256 == 0) && ((NB * S) % 256 == 0) && (NP % 256 == 0) && (D % 256 == 0) && (D >= 256);
DI int gu_row(int c, int up) {
    if (USE_G8) return (c >> 7) * 256 + ((c >> 6) & 1) * 128 + ((c >> 4) & 3) * 32 + (up ? 16 : 0) + (c & 15);
    return (c >> 6) * 128 + ((c >> 5) & 1) * 64 + ((c >> 4) & 1) * 16 + (c & 15) + (up ? 32 : 0);
}
DI void transpose_item(const float* W, int N, int Nvalid, int k0, int n0, bf16_t* WT, int ldt, int mode, float* scr, int lane) {
#pragma unroll 4
    for (int i = 0; i < 32; ++i) {
        const int kk = 2 * i + (lane >> 5), n = n0 + (lane & 31);
        scr[kk * 33 + (lane & 31)] = (n < Nvalid) ? W[(size_t)(k0 + kk) * N + n] : 0.f;
    }
    WAVE_SYNC();
    const int c = lane & 7;
#pragma unroll
    for (int j = 0; j < 4; ++j) {
        const int nl = (lane >> 3) + 8 * j; const float* s = scr + (8 * c) * 33 + nl;
        u32x4 o; o.x = pk2(s[0], s[33]); o.y = pk2(s[2 * 33], s[3 * 33]); o.z = pk2(s[4 * 33], s[5 * 33]); o.w = pk2(s[6 * 33], s[7 * 33]);
        const int n = n0 + nl; const int row = mode == 0 ? n : gu_row(n, mode == 2);
        *(u32x4*)(WT + (size_t)row * ldt + k0 + 8 * c) = o;
    }
    WAVE_SYNC();
}
DI void transpose_matrix(const float* W, int K, int N, int Npad, bf16_t* WT, int mode, char* smem, int gw, int ngw, int& base) {
    const int lane = tid_x() & 63, wave = tid_x() >> 6;
    float* scr = (float*)smem + wave * (64 * 33);
    const int nkb = K / 64, nnb = Npad / 32, nitems = nkb * nnb;
    int first = ((gw - base) % ngw + ngw) % ngw;
    for (int it = first; it < nitems; it += ngw) {
        const int kb = it / nnb, nb = it % nnb;
        transpose_item(W, N, N, kb * 64, nb * 32, WT, K, mode, scr, lane);
    }
    base = (base + nitems) % ngw;
}

DI void phase0(const Params& p, char* smem) {
    const int tid = tid_x(), lane = tid & 63, wave = tid >> 6;
    if (blockIdx.x == 0 && tid < NEXP) ((int*)(p.ws + WS_CNT))[tid] = 0;
    if (blockIdx.x == 0 && tid == 0) *(unsigned*)(p.ws + WS_BAR) = 0u;
    float* sil = (float*)smem;
    float* red = sil + NV * D;
    const int nitems = 6 * D / 32;
    bool did = false;
    for (int it = blockIdx.x; it < nitems; it += gridDim.x) {
        if (!did) {
            for (int i = tid; i < NV * D; i += NTHREADS) { const int v = i / D, k = i % D; const float cv = v < NB ? p.in[I_C][v * D + k] : p.in[I_CCTX][k]; sil[i] = siluf_(cv); }
            did = true;
        }
        __syncthreads();
        const int col = it * 32 + (lane & 31), rp = lane >> 5;
        float acc[NV];
#pragma unroll
        for (int v = 0; v < NV; ++v) acc[v] = 0.f;
        const int r0 = wave * (D / 8);
#pragma unroll 8
        for (int i = 0; i < D / 16; ++i) {
            const int row = r0 + 2 * i + rp; const float w = p.in[I_ADAW][(size_t)row * (6 * D) + col];
#pragma unroll
            for (int v = 0; v < NV; ++v) acc[v] += sil[v * D + row] * w;
        }
#pragma unroll
        for (int v = 0; v < NV; ++v) red[((wave * 2 + rp) * NV + v) * 32 + (lane & 31)] = acc[v];
        __syncthreads();
        if (tid < NV * 32) {
            const int v = tid / 32, cl = tid % 32; float s = p.in[I_ADAB][it * 32 + cl];
            for (int g = 0; g < 16; ++g) s += red[(g * NV + v) * 32 + cl];
            ((float*)(p.ws + WS_MOD))[(size_t)v * 6 * D + it * 32 + cl] = s;
        }
    }
    __syncthreads();
    const int gw = blockIdx.x * 8 + wave, ngw = gridDim.x * 8; int base = 0;
    {
        float* scr = (float*)smem + wave * (64 * 33);
        const int nkb = D / 64, nnb = NP / 32, nitems2 = nkb * nnb;
        for (int it = gw; it < nitems2; it += ngw) { const int kb = it / nnb, nb = it % nnb; transpose_item(p.in[I_WIN], IN_COLS, IN_COLS, kb * 64, nb * 32, (bf16_t*)(p.aux + AUX_WINT), D, 0, scr, lane); }
        base = nitems2 % ngw;
    }
    { float* WRT = (float*)(p.ws + WS_WRT);
      for (int i = blockIdx.x * NTHREADS + tid; i < 36 * D; i += gridDim.x * NTHREADS) { const int j = i / D, k = i % D; WRT[i] = j < 4 ? p.in[I_RG][(size_t)k * 4 + j] : p.in[I_RE][(size_t)k * 32 + (j - 4)]; } }
    transpose_matrix(p.in[I_WOA], 512, D, D, (bf16_t*)(p.ws + WS_WOA), 0, smem, gw, ngw, base);
    transpose_matrix(p.in[I_WOB], 512, D, D, (bf16_t*)(p.ws + WS_WOB), 0, smem, gw, ngw, base);
    transpose_matrix(p.in[I_WOUT], D, D, D, (bf16_t*)(p.ws + WS_WOUT), 0, smem, gw, ngw, base);
}

DI void phase1(const Params& p, char* smem) {
    const int lane = tid_x() & 63, wave = tid_x() >> 6;
    const int gw = blockIdx.x * 8 + wave, ngw = gridDim.x * 8;
    const float* mod = (const float*)(p.ws + WS_MOD);
    bf16_t* U = (bf16_t*)(p.aux + AUX_U);
    for (int r = gw; r < T_ALL; r += ngw) {
        const float* src; int v;
        if (r < T_CTX) { src = p.in[I_CTX] + (size_t)r * D; v = NB; } else { src = p.in[I_X] + (size_t)(r - T_CTX) * D; v = (r - T_CTX) / S; }
        f32x4 x[D / 256]; float ss = 0.f;
#pragma unroll
        for (int j = 0; j < D / 256; ++j) { x[j] = *(const f32x4*)(src + j * 256 + lane * 4); ss += x[j].x * x[j].x + x[j].y * x[j].y + x[j].z * x[j].z + x[j].w * x[j].w; }
        ss = wave_sum(ss);
        const float rstd = 1.0f / sqrtf(ss * (1.0f / D) + 1e-6f);
#pragma unroll
        for (int j = 0; j < D / 256; ++j) {
            const int k = j * 256 + lane * 4;
            const f32x4 g = *(const f32x4*)(p.in[I_NMIX] + k), sh = *(const f32x4*)(mod + (size_t)v * 6 * D + k), sc = *(const f32x4*)(mod + (size_t)v * 6 * D + D + k);
            float o0 = x[j].x * rstd * g.x * (1.f + sc.x) + sh.x, o1 = x[j].y * rstd * g.y * (1.f + sc.y) + sh.y;
            float o2 = x[j].z * rstd * g.z * (1.f + sc.z) + sh.z, o3 = x[j].w * rstd * g.w * (1.f + sc.w) + sh.w;
            u32x2 o; o.x = pk2(o0, o1); o.y = pk2(o2, o3);
            *(u32x2*)(U + (size_t)r * D + k) = o;
        }
    }
}

DI void phase2(const Params& p, char* smem) {
    const bf16_t* U = (const bf16_t*)(p.aux + AUX_U); const bf16_t* WT = (const bf16_t*)(p.aux + AUX_WINT);
    bf16_t* PL = (bf16_t*)(p.ws + WS_PLAT); bf16_t* PC = (bf16_t*)(p.ws + WS_PCTX); float* AB = (float*)(p.ws + WS_AB);
    if (USE_G8) {
        constexpr int NT = NP / 256, MT = T_ALL / 256, NT_CTX = (CTX_COLS + 255) / 256;
        for (int t = blockIdx.x; t < MT * NT; t += gridDim.x) {
            const int mt = t / NT, nt = t % NT, brow = mt * 256, bcol = nt * 256; const bool isctx = brow < T_CTX;
            if (isctx && nt >= NT_CTX) continue;
            g8::Acc acc; g8::acc_zero(acc);
            g8::kloop(acc, smem, U, D, WT, D, D, brow, bcol);
            g8::for_each_quad(acc, brow, bcol, [&](int row, int col, const f32x4& v) {
                u32x2 o; o.x = pk2(v.x, v.y); o.y = pk2(v.z, v.w);
                if (isctx) { if (col < CTX_COLS) *(u32x2*)(PC + (size_t)row * CTX_COLS + col) = o; }
                else { if (col < IN_COLS) *(u32x2*)(PL + (size_t)(row - T_CTX) * IN_COLS + col) = o; }
                if (col >= 2048 && col < 2064) *(f32x4*)(AB + (size_t)row * 16 + (col - 2048)) = v;
            });
        }
        return;
    }
    const int tid = tid_x(), lane = tid & 63, wave = tid >> 6, wr = wave >> 1, wc = wave & 1, fr = lane & 15, fq = lane >> 4;
    constexpr int NT = NP / 128, MT = T_ALL / BM, NT_CTX = (CTX_COLS + 127) / 128;
    for (int t = blockIdx.x; t < MT * NT; t += gridDim.x) {
        const int mt = t / NT, nt = t % NT; const int row0 = mt * BM; const bool isctx = row0 < T_CTX;
        if (isctx && nt >= NT_CTX) continue;
        f32x4 acc[MREP][4]; acc_zero(acc);
        gemm_kloop(acc, smem, [&](int i) { return U + (size_t)(row0 + i) * D; }, WT + (size_t)nt * 128 * D, D, D);
#pragma unroll
        for (int m = 0; m < MREP; ++m)
#pragma unroll
            for (int n = 0; n < 4; ++n)
#pragma unroll
                for (int j = 0; j < 4; ++j) {
                    const int row = row0 + wr * 16 * MREP + m * 16 + fq * 4 + j, col = nt * 128 + wc * 64 + n * 16 + fr; const float v = acc[m][n][j];
                    if (isctx) { if (col < CTX_COLS) PC[(size_t)row * CTX_COLS + col] = f2bf(v); }
                    else { if (col < IN_COLS) PL[(size_t)(row - T_CTX) * IN_COLS + col] = f2bf(v); }
                    if (col >= 2048 && col < 2064) AB[(size_t)row * 16 + (col - 2048)] = v;
                }
    }
}

typedef float f32x16 __attribute__((ext_vector_type(16)));
typedef short bf16x4 __attribute__((ext_vector_type(4)));
#ifdef EMU
#define MFMA32(a, b, c) emu_mfma32((a), (b), (c))
DI float fexp(float x) { return expf(x); }
DI float flog(float x) { return logf(x); }
DI float frcp(float x) { return 1.0f / x; }
DI float frsq(float x) { return 1.0f / sqrtf(x); }
DI float wave_sum_fast(float v) { return wave_sum(v); }
#else
#define MFMA32(a, b, c) __builtin_amdgcn_mfma_f32_32x32x16_bf16((a), (b), (c), 0, 0, 0)
DI float fexp(float x) { return __expf(x); }
DI float flog(float x) { return __logf(x); }
DI float frcp(float x) { return __builtin_amdgcn_rcpf(x); }
DI float frsq(float x) { return __builtin_amdgcn_rsqf(x); }
#define DPP_ADD(v, ctrl) ((v) + __builtin_bit_cast(float, __builtin_amdgcn_update_dpp(0, __builtin_bit_cast(int, (v)), (ctrl), 0xf, 0xf, false)))
DI float wave_sum_fast(float v) {
    v = DPP_ADD(v, 0xB1); v = DPP_ADD(v, 0x4E); v = DPP_ADD(v, 0x141); v = DPP_ADD(v, 0x140);
    const int iv = __builtin_bit_cast(int, v);
    return (__builtin_bit_cast(float, __builtin_amdgcn_readlane(iv, 0)) + __builtin_bit_cast(float, __builtin_amdgcn_readlane(iv, 16))) +
           (__builtin_bit_cast(float, __builtin_amdgcn_readlane(iv, 32)) + __builtin_bit_cast(float, __builtin_amdgcn_readlane(iv, 48)));
}
#endif
DI float fsigmoid(float x) { return frcp(1.0f + fexp(-x)); }
DI float fsilu(float x) { return x * fsigmoid(x); }
DI float fsoftplus(float x) { return fmaxf(x, 0.f) + flog(1.f + fexp(-fabsf(x))); }
DI float ftanh(float x) { return 1.0f - 2.0f * frcp(1.0f + fexp(2.0f * x)); }

DI int crow(int g, int h) { return (g & 3) + 8 * (g >> 2) + 4 * h; }
template <int S_> DI bf16x8 pack_acc(const f32x16& x) {
    u32x4 r;
    r.x = pk2(x[8 * S_ + 0], x[8 * S_ + 1]); r.y = pk2(x[8 * S_ + 2], x[8 * S_ + 3]); r.z = pk2(x[8 * S_ + 4], x[8 * S_ + 5]); r.w = pk2(x[8 * S_ + 6], x[8 * S_ + 7]);
    return __builtin_bit_cast(bf16x8, r);
}
DI bf16x8 ld_nat(const bf16_t* row, int s, int h) { return *(const bf16x8*)(row + 16 * s + 8 * h); }
DI bf16x8 ld_perm(const bf16_t* row, int s, int h) {
    const bf16x4 lo = *(const bf16x4*)(row + 16 * s + 4 * h), hi = *(const bf16x4*)(row + 16 * s + 8 + 4 * h);
    return __builtin_shufflevector(lo, hi, 0, 1, 2, 3, 4, 5, 6, 7);
}
DI f32x16 zero16() { f32x16 z;
#pragma unroll
    for (int i = 0; i < 16; ++i) z[i] = 0.f;
    return z; }
#define TGET(i) ((i) < 16 ? t0[(i) & 15] : t1[(i) & 15])
DI void invert32_col(const float* Lf, f32x16& t0, f32x16& t1, int c) {
#pragma unroll
    for (int i = 0; i < 32; ++i) {
        float s0 = 0.f, s1 = 0.f, s2 = 0.f, s3 = 0.f;
#pragma unroll
        for (int j4 = 0; j4 < (i + 3) / 4; ++j4) {
            const f32x4 l = *(const f32x4*)(Lf + i * 32 + 4 * j4);
            if (4 * j4 + 0 < i) s0 += l.x * TGET(4 * j4 + 0);
            if (4 * j4 + 1 < i) s1 += l.y * TGET(4 * j4 + 1);
            if (4 * j4 + 2 < i) s2 += l.z * TGET(4 * j4 + 2);
            if (4 * j4 + 3 < i) s3 += l.w * TGET(4 * j4 + 3);
        }
        float sm = -((s0 + s1) + (s2 + s3));
#ifndef EMU
        asm volatile("" : "+v"(sm));
#endif
        const float v = (i > c) ? sm : (i == c ? 1.f : 0.f);
        if (i < 16) t0[i & 15] = v; else t1[i & 15] = v;
    }
}

constexpr int GC = 32;
constexpr int G_NT = (CTXL + S) / GC;
constexpr int LD128 = 136, LD64 = 72, LD32 = 40;
DI void chunk_pos(int x, int d, int& seg, int& j0) {
    constexpr int n0 = CTXL / GC, n1 = S / GC;
    if (x < n0) { seg = 0; j0 = (d ? n0 - 1 - x : x) * GC; } else { seg = 1; const int xx = x - n0; j0 = (d ? n1 - 1 - xx : xx) * GC; }
}

DI f32x16 invert32_blocked(const float* Lf, bf16_t* scr, int lane) {
    bf16_t* TD = scr; bf16_t* TDT = scr + 32 * LD32; bf16_t* LO = scr + 2 * 32 * LD32; bf16_t* P1T = scr + 3 * 32 * LD32;
    const int blk = lane >> 5, c = lane & 15, r = lane & 31, h = lane >> 5;
    f32x16 t;
    const float* Lb = Lf + (16 * blk) * 32 + 16 * blk;
#pragma unroll
    for (int i = 0; i < 16; ++i) {
        float s0 = 0.f, s1 = 0.f, s2 = 0.f, s3 = 0.f;
#pragma unroll
        for (int j4 = 0; j4 < (i + 3) / 4; ++j4) {
            const f32x4 l = *(const f32x4*)(Lb + i * 32 + 4 * j4);
            if (4 * j4 + 0 < i) s0 += l.x * t[4 * j4 + 0];
            if (4 * j4 + 1 < i) s1 += l.y * t[4 * j4 + 1];
            if (4 * j4 + 2 < i) s2 += l.z * t[4 * j4 + 2];
            if (4 * j4 + 3 < i) s3 += l.w * t[4 * j4 + 3];
        }
        float sm = -((s0 + s1) + (s2 + s3));
#ifndef EMU
        asm volatile("" : "+v"(sm));
#endif
        t[i] = (i > c) ? sm : (i == c ? 1.f : 0.f);
    }
    if (r < 16) {
#pragma unroll
        for (int i = 0; i < 16; ++i) { TD[(16 * blk + i) * LD32 + 16 * blk + c] = f2bf(t[i]); TD[(16 * blk + i) * LD32 + 16 * (1 - blk) + c] = 0; }
#pragma unroll
        for (int q = 0; q < 4; ++q) {
            u32x2 o; o.x = pk2(t[4 * q], t[4 * q + 1]); o.y = pk2(t[4 * q + 2], t[4 * q + 3]);
            *(u32x2*)(TDT + (16 * blk + c) * LD32 + 16 * blk + 4 * q) = o;
            *(u32x2*)(TDT + (16 * blk + c) * LD32 + 16 * (1 - blk) + 4 * q) = (u32x2){0u, 0u};
        }
    }
    {
        const int row = lane >> 1, half = lane & 1;
#pragma unroll
        for (int q = 0; q < 4; ++q) {
            u32x2 o = {0u, 0u};
            if (row >= 16 && half == 0) { const f32x4 l = *(const f32x4*)(Lf + row * 32 + 4 * q); o.x = pk2(l.x, l.y); o.y = pk2(l.z, l.w); }
            *(u32x2*)(LO + row * LD32 + 16 * half + 4 * q) = o;
        }
    }
    WAVE_SYNC();
    f32x16 p1 = zero16();
#pragma unroll
    for (int s = 0; s < 2; ++s) p1 = MFMA32(ld_nat(LO + r * LD32, s, h), ld_nat(TDT + r * LD32, s, h), p1);
#pragma unroll
    for (int q = 0; q < 4; ++q) { u32x2 o; o.x = pk2(p1[4 * q], p1[4 * q + 1]); o.y = pk2(p1[4 * q + 2], p1[4 * q + 3]); *(u32x2*)(P1T + r * LD32 + 8 * q + 4 * h) = o; }
    WAVE_SYNC();
    f32x16 p2 = zero16();
#pragma unroll
    for (int s = 0; s < 2; ++s) p2 = MFMA32(ld_nat(TD + r * LD32, s, h), ld_nat(P1T + r * LD32, s, h), p2);
    f32x16 tf;
#pragma unroll
    for (int g = 0; g < 16; ++g) tf[g] = bf2f(TD[crow(g, h) * LD32 + r]) - p2[g];
    return tf;
}
constexpr int GL_Q = 0;
constexpr int GL_KT = GL_Q + 2 * 32 * LD128 * 2;
constexpr int GL_VT = GL_KT + 2 * 128 * LD32 * 2;
constexpr int GL_K = GL_VT + 2 * 128 * LD32 * 2;
constexpr int GL_QKM = GL_K + 32 * LD128 * 2;
constexpr int GL_LF = GL_QKM + 2 * 32 * LD32 * 2;
constexpr int GL_TP = GL_LF + 32 * 32 * 4;
constexpr int GL_TPP = GL_TP + 32 * LD32 * 2;
constexpr int GL_WN = GL_TPP + 2 * 32 * LD32 * 2;
constexpr int GL_SC = GL_WN + 32 * LD128 * 2;
constexpr int GL_GC = GL_SC + 2 * 8 * 32 * 4;
constexpr int GL_CW = GL_GC + 3 * 32 * 4;
constexpr int GL_INV = GL_CW + 5 * 3 * 128 * 4;
constexpr int GL_END = GL_INV + 4 * 32 * LD32 * 2;
static_assert(GL_END <= LDS_BYTES, "gdn lds");

DI void gdn_chain2(const Params& p, char* smem, int item) {
    const int d = item / (NB * H_A), b = (item / H_A) % NB, h = item % H_A;
    const int tid = tid_x(), lane = tid & 63, wave0_ = tid >> 6;
    bf16_t* Qs = (bf16_t*)(smem + GL_Q); bf16_t* KTs = (bf16_t*)(smem + GL_KT); bf16_t* VTs = (bf16_t*)(smem + GL_VT); bf16_t* Ks = (bf16_t*)(smem + GL_K);
    bf16_t* QKMs = (bf16_t*)(smem + GL_QKM); float* Lf = (float*)(smem + GL_LF); bf16_t* Tp = (bf16_t*)(smem + GL_TP); bf16_t* Tpp = (bf16_t*)(smem + GL_TPP);
    bf16_t* Wn = (bf16_t*)(smem + GL_WN); float* SC = (float*)(smem + GL_SC); float* GCs = (float*)(smem + GL_GC); float* CW = (float*)(smem + GL_CW);
    const float alog = p.in[I_ALOG][d * 4 + h], dtb = p.in[I_DTB][d * 4 + h], negea = -expf(alog);
    bf16_t* ODIR = (bf16_t*)(p.aux + AUX_ODIR);
    __syncthreads();
    for (int i = tid; i < 5 * 3 * 128; i += NTHREADS) { const int t = i / 384, s = (i % 384) / 128, c = i % 128; CW[i] = p.in[I_CONV][t * 1536 + s * 512 + h * 128 + c]; }
    f32x16 St[4];
#pragma unroll
    for (int ct = 0; ct < 4; ++ct) St[ct] = zero16();
    unsigned raw[8][3]; float pa = 0.f, pbt = 0.f;
    auto prefetch = [&](int x) {
        int seg, j0; chunk_pos(x, d, seg, j0);
        const int L = seg ? S : CTXL, ldp = seg ? IN_COLS : CTX_COLS;
        const bf16_t* pbase = seg ? (const bf16_t*)(p.ws + WS_PLAT) + (size_t)b * S * IN_COLS : (const bf16_t*)(p.ws + WS_PCTX) + (size_t)b * CTXL * CTX_COLS;
        const float* abbase = (const float*)(p.ws + WS_AB) + (size_t)(seg ? T_CTX + b * S : b * CTXL) * 16;
        const int jw = j0 + 4 * wave0_;
#pragma unroll
        for (int rr = 0; rr < 8; ++rr) {
            const int j = jw - 2 + rr;
#pragma unroll
            for (int s = 0; s < 3; ++s) raw[rr][s] = (j >= 0 && j < L) ? *(const unsigned*)(pbase + (size_t)j * ldp + s * 512 + h * 128 + 2 * lane) : 0u;
        }
        if (lane < 4) { pa = abbase[(size_t)(jw + lane) * 16 + d * 4 + h]; pbt = abbase[(size_t)(jw + lane) * 16 + 8 + d * 4 + h]; }
    };
    prefetch(0);
    const int r0_ = lane & 31, hh0_ = lane >> 5;
    __syncthreads();
    for (int it = -1; it < G_NT; ++it) {
        int r = r0_, hh = hh0_, wave = wave0_;
#ifndef EMU
        asm volatile("" : "+v"(r), "+v"(hh), "+v"(wave));
#endif
        const int xn = it + 1, par = xn & 1;
        int segn = 0, j0n = 0; if (xn < G_NT) chunk_pos(xn, d, segn, j0n);
        if (xn < G_NT) {
            const int i0 = d ? (GC - 4 - 4 * wave) : 4 * wave;
            bf16_t kt[2][4], vt[2][4];
#pragma unroll
            for (int t = 0; t < 4; ++t) {
                const int e = d ? 3 - t : t, i = i0 + e;
                float o[6];
#pragma unroll
                for (int s = 0; s < 3; ++s) {
                    float a0 = 0.f, a1 = 0.f;
#pragma unroll
                    for (int tp = 0; tp < 5; ++tp) { const unsigned w = raw[t + tp][s]; a0 += bf2f((bf16_t)(w & 0xffffu)) * CW[(tp * 3 + s) * 128 + 2 * lane]; a1 += bf2f((bf16_t)(w >> 16)) * CW[(tp * 3 + s) * 128 + 2 * lane + 1]; }
                    o[2 * s] = fsilu(a0); o[2 * s + 1] = fsilu(a1);
                }
                const float sq = wave_sum_fast(o[0] * o[0] + o[1] * o[1]), sk = wave_sum_fast(o[2] * o[2] + o[3] * o[3]);
                const float scq = frsq(sq + 1e-6f) * 0.08838834764831845f, sck = frsq(sk + 1e-6f);
                *(unsigned*)(Qs + (par * 32 + i) * LD128 + 2 * lane) = pk2(o[0] * scq, o[1] * scq);
                kt[0][e] = f2bf(o[2] * sck); kt[1][e] = f2bf(o[3] * sck); vt[0][e] = f2bf(o[4]); vt[1][e] = f2bf(o[5]);
                *(unsigned*)(Ks + i * LD128 + 2 * lane) = (unsigned)kt[0][e] | ((unsigned)kt[1][e] << 16);
            }
#pragma unroll
            for (int q = 0; q < 2; ++q) {
                u32x2 o; o.x = (unsigned)kt[q][0] | ((unsigned)kt[q][1] << 16); o.y = (unsigned)kt[q][2] | ((unsigned)kt[q][3] << 16);
                *(u32x2*)(KTs + (par * 128 + 2 * lane + q) * LD32 + i0) = o;
                u32x2 o2; o2.x = (unsigned)vt[q][0] | ((unsigned)vt[q][1] << 16); o2.y = (unsigned)vt[q][2] | ((unsigned)vt[q][3] << 16);
                *(u32x2*)(VTs + (par * 128 + 2 * lane + q) * LD32 + i0) = o2;
            }
            if (lane < 4) { const int i = d ? (GC - 1 - 4 * wave - lane) : (4 * wave + lane);
                SC[(par * 8 + 0) * 32 + i] = negea * fsoftplus(pa + dtb); SC[(par * 8 + 1) * 32 + i] = fsigmoid(pbt); }
            if (xn + 1 < G_NT) prefetch(xn + 1);
        }
        LDS_BARRIER();
        if (xn < G_NT && wave < 3) {
            const float* graw = SC + (par * 8 + 0) * 32;
            float gcv = 0.f;
#pragma unroll
            for (int s4 = 0; s4 < 8; ++s4) { const f32x4 g4 = *(const f32x4*)(graw + 4 * s4);
                gcv += (4 * s4 + 0 <= r ? g4.x : 0.f) + (4 * s4 + 1 <= r ? g4.y : 0.f) + (4 * s4 + 2 <= r ? g4.z : 0.f) + (4 * s4 + 3 <= r ? g4.w : 0.f); }
            if (wave == 2) {
                const float glast = graw[0] + 0.f; (void)glast;
                float gl = 0.f;
#pragma unroll
                for (int s4 = 0; s4 < 8; ++s4) { const f32x4 g4 = *(const f32x4*)(graw + 4 * s4); gl += (g4.x + g4.y) + (g4.z + g4.w); }
                const float be = SC[(par * 8 + 1) * 32 + r];
                if (lane < 32) { SC[(par * 8 + 3) * 32 + r] = fexp(gcv); SC[(par * 8 + 4) * 32 + r] = fexp(gl - gcv); SC[(par * 8 + 5) * 32 + r] = be * fexp(gcv); SC[(par * 8 + 6) * 32 + r] = fexp(gl); }
            } else {
                if (lane < 32) GCs[wave * 32 + r] = gcv;
                f32x16 acc = zero16();
                const bf16_t* arow = (wave == 0 ? Ks : Qs + par * 32 * LD128) + r * LD128; const bf16_t* brow = Ks + r * LD128;
#pragma unroll
                for (int s = 0; s < 8; ++s) acc = MFMA32(ld_nat(arow, s, hh), ld_nat(brow, s, hh), acc);
                WAVE_SYNC();
#pragma unroll
                for (int g = 0; g < 16; ++g) {
                    const int i = crow(g, hh); const float dec = fexp(GCs[wave * 32 + i] - gcv);
                    if (wave == 0) Lf[i * 32 + r] = (r < i) ? SC[(par * 8 + 1) * 32 + i] * acc[g] * dec : 0.f;
                    else QKMs[(par * 32 + i) * LD32 + r] = f2bf((r <= i) ? acc[g] * dec : 0.f);
                }
            }
        }
        LDS_BARRIER();
        if (wave == 7 && xn < G_NT) {
            const f32x16 tf = invert32_blocked(Lf, (bf16_t*)(smem + GL_INV), lane);
            const int c = r; const float b1 = SC[(par * 8 + 5) * 32 + c], b0 = SC[(par * 8 + 1) * 32 + c];
#pragma unroll
            for (int g = 0; g < 16; ++g) { const int i = crow(g, hh); Tp[i * LD32 + c] = f2bf(tf[g] * b1); Tpp[(par * 32 + i) * LD32 + c] = f2bf(tf[g] * b0); }
        }
        if (wave < 4 && it >= 0) {
            const int pc = it & 1; int seg = 0, j0 = 0; chunk_pos(it, d, seg, j0);
            const bf16_t* Qc = Qs + pc * 32 * LD128; const bf16_t* KTc = KTs + pc * 128 * LD32; const bf16_t* VTc = VTs + pc * 128 * LD32;
            const bf16_t* QKc = QKMs + pc * 32 * LD32; const bf16_t* Tc = Tpp + pc * 32 * LD32; const float* sc = SC + pc * 8 * 32;
            f32x16 vn = zero16();
#pragma unroll
            for (int s = 0; s < 2; ++s) vn = MFMA32(ld_nat(Tc + r * LD32, s, hh), ld_nat(VTc + (32 * wave + r) * LD32, s, hh), vn);
            f32x16 oacc = zero16();
#define GDN_KSTEP(s) { const bf16x8 sb = pack_acc<(s) & 1>(St[(s) >> 1]); vn = MFMA32(ld_perm(Wn + r * LD128, (s), hh), sb, vn); oacc = MFMA32(ld_perm(Qc + r * LD128, (s), hh), sb, oacc); }
            GDN_KSTEP(0) GDN_KSTEP(1) GDN_KSTEP(2) GDN_KSTEP(3) GDN_KSTEP(4) GDN_KSTEP(5) GDN_KSTEP(6) GDN_KSTEP(7)
#undef GDN_KSTEP
#pragma unroll
            for (int g = 0; g < 16; ++g) oacc[g] *= sc[3 * 32 + crow(g, hh)];
            { const bf16x8 v0 = pack_acc<0>(vn), v1 = pack_acc<1>(vn);
              oacc = MFMA32(ld_perm(QKc + r * LD32, 0, hh), v0, oacc); oacc = MFMA32(ld_perm(QKc + r * LD32, 1, hh), v1, oacc); }
#pragma unroll
            for (int g = 0; g < 16; ++g) vn[g] *= sc[4 * 32 + crow(g, hh)];
            const float ge = sc[6 * 32];
            { const bf16x8 v0 = pack_acc<0>(vn), v1 = pack_acc<1>(vn);
#pragma unroll
              for (int ct = 0; ct < 4; ++ct) {
#pragma unroll
                  for (int g = 0; g < 16; ++g) St[ct][g] *= ge;
                  St[ct] = MFMA32(ld_perm(KTc + (32 * ct + r) * LD32, 0, hh), v0, St[ct]);
                  St[ct] = MFMA32(ld_perm(KTc + (32 * ct + r) * LD32, 1, hh), v1, St[ct]);
              } }
            if (seg) {
#pragma unroll
                for (int g = 0; g < 16; ++g) {
                    const int i = crow(g, hh), j = d ? j0 + GC - 1 - i : j0 + i;
                    ODIR[((size_t)d * T_LAT + (size_t)b * S + j) * 512 + h * 128 + 32 * wave + r] = f2bf(oacc[g]);
                }
            }
        }
        LDS_BARRIER();
        if (xn < G_NT && wave < 4) {
            f32x16 acc = zero16();
#pragma unroll
            for (int s = 0; s < 2; ++s) acc = MFMA32(ld_nat(KTs + (par * 128 + 32 * wave + r) * LD32, s, hh), ld_nat(Tp + r * LD32, s, hh), acc);
#pragma unroll
            for (int q = 0; q < 4; ++q) {
                u32x2 o; o.x = pk2(-acc[4 * q], -acc[4 * q + 1]); o.y = pk2(-acc[4 * q + 2], -acc[4 * q + 3]);
                *(u32x2*)(Wn + r * LD128 + 32 * wave + 8 * q + 4 * hh) = o;
            }
        }
        LDS_BARRIER();
    }
}

constexpr int RL_RX = 0;
constexpr int RL_KX = RL_RX + 32 * 64 * 4;
constexpr int RL_VX = RL_KX + 32 * 64 * 4;
constexpr int RL_KK = RL_VX + 32 * 64 * 4;
constexpr int RL_LW = RL_KK + 32 * 64 * 4;
constexpr int RL_IC = RL_LW + 32 * 64 * 4;
constexpr int RL_PC = RL_IC + 32 * 64 * 4;
constexpr int RL_CST = RL_PC + 2 * 64 * 4;
constexpr int RL_TW = RL_CST + 4 * 64 * 4;
constexpr int RL_AL = RL_TW + 32 * LD64 * 2;
constexpr int RL_LF = RL_TW;
constexpr int RL_LAKT = RL_LF + 32 * 32 * 4;
constexpr int RL_TB = RL_LAKT + 32 * LD32 * 2;
static_assert(RL_TB + 32 * LD32 * 2 <= RL_AL + 32 * LD64 * 2, "overlay");
constexpr int RL_W2T = RL_AL + 32 * LD64 * 2;
constexpr int RL_A2T = RL_W2T + 64 * LD64 * 2;
constexpr int RL_AR = RL_A2T + 64 * LD64 * 2;
constexpr int RL_BR = RL_AR + 32 * LD64 * 2;
constexpr int RL_KR = RL_BR + 32 * LD64 * 2;
constexpr int RL_RR = RL_KR + 32 * LD64 * 2;
constexpr int RL_AT = RL_RR + 2 * 32 * LD64 * 2;
constexpr int RL_BHT = RL_AT + 64 * LD32 * 2;
constexpr int RL_KHT = RL_BHT + 2 * 64 * LD32 * 2;
constexpr int RL_VT = RL_KHT + 2 * 64 * LD32 * 2;
constexpr int RL_MRB = RL_VT + 2 * 64 * LD32 * 2;
constexpr int RL_MRK = RL_MRB + 2 * 32 * LD32 * 2;
constexpr int RL_WM = RL_MRK + 2 * 32 * LD32 * 2;
constexpr int RL_TL = RL_WM + 32 * LD64 * 2;
constexpr int RL_END = RL_TL + 32 * LD32 * 2;
static_assert(RL_END <= LDS_BYTES, "rwkv lds");

DI void rwkv_chain2(const Params& p, char* smem, int item) {
    const int d = item / (NB * H_B), b = (item / H_B) % NB, h = item % H_B;
    const int tid = tid_x(), lane = tid & 63, wave = tid >> 6;
    float* RX = (float*)(smem + RL_RX); float* KX = (float*)(smem + RL_KX); float* VX = (float*)(smem + RL_VX); float* KKs = (float*)(smem + RL_KK);
    float* LW = (float*)(smem + RL_LW); float* IC = (float*)(smem + RL_IC); float* Lf = (float*)(smem + RL_LF); float* PC = (float*)(smem + RL_PC); float* CST = (float*)(smem + RL_CST);
    bf16_t* TW = (bf16_t*)(smem + RL_TW); bf16_t* AL = (bf16_t*)(smem + RL_AL); bf16_t* W2T = (bf16_t*)(smem + RL_W2T); bf16_t* A2T = (bf16_t*)(smem + RL_A2T);
    bf16_t* Ar = (bf16_t*)(smem + RL_AR); bf16_t* Br = (bf16_t*)(smem + RL_BR); bf16_t* Kr = (bf16_t*)(smem + RL_KR); bf16_t* Rr = (bf16_t*)(smem + RL_RR);
    bf16_t* AT = (bf16_t*)(smem + RL_AT); bf16_t* BhT = (bf16_t*)(smem + RL_BHT); bf16_t* KhT = (bf16_t*)(smem + RL_KHT); bf16_t* VT = (bf16_t*)(smem + RL_VT);
    bf16_t* LakT = (bf16_t*)(smem + RL_LAKT); bf16_t* Mrb = (bf16_t*)(smem + RL_MRB); bf16_t* Mrk = (bf16_t*)(smem + RL_MRK); bf16_t* Tb = (bf16_t*)(smem + RL_TB);
    bf16_t* Wm = (bf16_t*)(smem + RL_WM); bf16_t* TLm = (bf16_t*)(smem + RL_TL);
    bf16_t* YDIR = (bf16_t*)(p.aux + AUX_YDIR); float* BON = (float*)(p.ws + WS_BONUS);
    __syncthreads();
    for (int i = tid; i < 64 * 64; i += NTHREADS) {
        const int c = i >> 6, rr = i & 63;
        W2T[c * LD64 + rr] = f2bf(p.in[I_W2][((size_t)d * 64 + rr) * 512 + h * 64 + c]); A2T[c * LD64 + rr] = f2bf(p.in[I_A2][((size_t)d * 64 + rr) * 512 + h * 64 + c]);
    }
    if (tid < 256) { const int w = tid >> 6, c = tid & 63, gc = h * 64 + c;
        CST[tid] = w == 0 ? p.in[I_W0][d * 512 + gc] : (w == 1 ? p.in[I_A0][d * 512 + gc] : (w == 2 ? p.in[I_KA][gc] : p.in[I_RK][gc])); }
    float muv[5];
#pragma unroll
    for (int s = 0; s < 5; ++s) muv[s] = p.in[I_MU][(s < 3 ? s * 512 + h * 64 : (s == 3 ? 1536 + d * 64 : 1664 + d * 64)) + lane];
    const float kkw = p.in[I_KK][h * 64 + lane];
    f32x16 Xt[2]; Xt[0] = zero16(); Xt[1] = zero16();
    bf16_t rawv[6][5];
    auto prefetch = [&](int x) {
        int seg, j0; chunk_pos(x, d, seg, j0);
        const int L = seg ? S : CTXL, ldp = seg ? IN_COLS : CTX_COLS;
        const bf16_t* pb = seg ? (const bf16_t*)(p.ws + WS_PLAT) + (size_t)b * S * IN_COLS : (const bf16_t*)(p.ws + WS_PCTX) + (size_t)b * CTXL * CTX_COLS;
        const int jw = j0 + 4 * wave;
#pragma unroll
        for (int rr = 0; rr < 6; ++rr) {
            const int j = jw - 1 + rr; const bool ok = (j >= 0 && j < L);
            const int row = ok ? (seg ? (j % ROWS) * GW + j / ROWS : j) : 0;
#pragma unroll
            for (int s = 0; s < 5; ++s) {
                const int bcol = (s < 3 ? s * 512 + h * 64 : (s == 3 ? 1536 + d * 64 : 1664 + d * 64)) + lane;
                rawv[rr][s] = ok ? pb[(size_t)row * ldp + COL_B0 + bcol] : (bf16_t)0;
            }
        }
    };
    prefetch(0);
    const int r0_ = lane & 31, hh0_ = lane >> 5;
    __syncthreads();
    for (int it = -1; it < G_NT; ++it) {
        int r = r0_, hh = hh0_;
#ifndef EMU
        asm volatile("" : "+v"(r), "+v"(hh));
#endif
        const int xn = it + 1, par = xn & 1;
        int segn = 0, j0n = 0; if (xn < G_NT) chunk_pos(xn, d, segn, j0n);
        if (xn < G_NT) {
#pragma unroll
            for (int t = 0; t < 4; ++t) {
                const int i = d ? (GC - 1 - 4 * wave - t) : (4 * wave + t);
                float xs[5];
#pragma unroll
                for (int s = 0; s < 5; ++s) { const float cu = bf2f(rawv[t + 1][s]); xs[s] = cu + (0.5f * (bf2f(rawv[t][s]) + bf2f(rawv[t + 2][s])) - cu) * muv[s]; }
                const float kxk = xs[1] * kkw; const float ss = wave_sum_fast(kxk * kxk);
                RX[i * 64 + lane] = xs[0]; KX[i * 64 + lane] = xs[1]; VX[i * 64 + lane] = xs[2]; KKs[i * 64 + lane] = kxk * frsq(ss + 1e-6f);
                TW[i * LD64 + lane] = f2bf(ftanh(xs[3])); AL[i * LD64 + lane] = f2bf(xs[4]);
            }
            if (xn + 1 < G_NT) prefetch(xn + 1);
        }
        LDS_BARRIER();
        if (xn < G_NT && wave < 4) {
            const int which = wave >> 1, ct = wave & 1;
            const bf16_t* arow = (which ? AL : TW) + r * LD64; const bf16_t* brow = (which ? A2T : W2T) + (32 * ct + r) * LD64;
            f32x16 acc = zero16();
#pragma unroll
            for (int s = 0; s < 4; ++s) acc = MFMA32(ld_nat(arow, s, hh), ld_nat(brow, s, hh), acc);
            const int c = 32 * ct + r;
            const float bias = CST[which * 64 + c];
#pragma unroll
            for (int g = 0; g < 16; ++g) {
                const int i = crow(g, hh); const float z = bias + acc[g];
                if (which) IC[i * 64 + c] = fsigmoid(z);
                else { const float wl = -fsoftplus(-z) - 0.5f; LW[i * 64 + c] = -fexp(wl); }
            }
        }
        LDS_BARRIER();
        if (xn < G_NT) {
            const int c = lane, i0 = 4 * wave;
            const float ka = CST[2 * 64 + c], rk = CST[3 * 64 + c];
            float lpb = 0.f, lpc = 0.f; float lw4[4];
#pragma unroll
            for (int s2 = 0; s2 < 32; ++s2) { const float w = LW[s2 * 64 + c]; lpc += w; if (s2 < i0) lpb += w; }
#pragma unroll
            for (int e = 0; e < 4; ++e) lw4[e] = LW[(i0 + e) * 64 + c];
            bf16_t ta[4], tb[4], tk[4], tv[4]; float bon[4];
            float lprun = lpb;
#pragma unroll
            for (int e = 0; e < 4; ++e) {
                const int i = i0 + e;
                const float lpm = lprun; lprun += lw4[e]; const float lp = lprun;
                const float Pi = fexp(lp), Pm = fexp(lpm), invP = fexp(-lp), PCi = fexp(lpc - lp);
                const float ic = IC[i * 64 + c], kxv = KX[i * 64 + c], kkv = KKs[i * 64 + c], rxv = RX[i * 64 + c], vxv = VX[i * 64 + c];
                const float kd = kxv * (1.f + (ic - 1.f) * ka), bb = kkv * ic, aa = -kkv;
                ta[e] = f2bf(aa * Pm); tb[e] = f2bf(bb * PCi); tk[e] = f2bf(kd * PCi); tv[e] = f2bf(vxv);
                Ar[i * LD64 + c] = ta[e]; Br[i * LD64 + c] = f2bf(bb * invP); Kr[i * LD64 + c] = f2bf(kd * invP); Rr[(par * 32 + i) * LD64 + c] = f2bf(rxv * Pi);
                bon[e] = wave_sum_fast(rxv * kd * rk);
            }
            { u32x2 o; o.x = (unsigned)ta[0] | ((unsigned)ta[1] << 16); o.y = (unsigned)ta[2] | ((unsigned)ta[3] << 16); *(u32x2*)(AT + c * LD32 + i0) = o; }
            { u32x2 o; o.x = (unsigned)tb[0] | ((unsigned)tb[1] << 16); o.y = (unsigned)tb[2] | ((unsigned)tb[3] << 16); *(u32x2*)(BhT + (par * 64 + c) * LD32 + i0) = o; }
            { u32x2 o; o.x = (unsigned)tk[0] | ((unsigned)tk[1] << 16); o.y = (unsigned)tk[2] | ((unsigned)tk[3] << 16); *(u32x2*)(KhT + (par * 64 + c) * LD32 + i0) = o; }
            { u32x2 o; o.x = (unsigned)tv[0] | ((unsigned)tv[1] << 16); o.y = (unsigned)tv[2] | ((unsigned)tv[3] << 16); *(u32x2*)(VT + (par * 64 + c) * LD32 + i0) = o; }
            if (wave == 7) PC[par * 64 + c] = fexp(lpc);
            if (segn && lane < 4) { const int i = i0 + lane, jj = d ? j0n + GC - 1 - i : j0n + i;
                const float bv = lane == 0 ? bon[0] : (lane == 1 ? bon[1] : (lane == 2 ? bon[2] : bon[3]));
                BON[((size_t)d * T_LAT + (size_t)b * S + (jj % ROWS) * GW + jj / ROWS) * 8 + h] = bv; }
        }
        LDS_BARRIER();
        if (xn < G_NT && wave < 4) {
            const bf16_t* arow = ((wave < 2) ? Ar : Rr + par * 32 * LD64) + r * LD64; const bf16_t* brow = ((wave & 1) ? Kr : Br) + r * LD64;
            f32x16 acc = zero16();
#pragma unroll
            for (int s = 0; s < 4; ++s) acc = MFMA32(ld_nat(arow, s, hh), ld_nat(brow, s, hh), acc);
            if (wave == 0) {
#pragma unroll
                for (int g = 0; g < 16; ++g) { const int t = crow(g, hh); Lf[t * 32 + r] = (r < t) ? -acc[g] : 0.f; }
            } else if (wave == 1) {
#pragma unroll
                for (int q = 0; q < 4; ++q) {
                    f32x4 v;
#pragma unroll
                    for (int e = 0; e < 4; ++e) { const int t = 8 * q + 4 * hh + e; v[e] = (r < t) ? acc[4 * q + e] : 0.f; }
                    u32x2 o; o.x = pk2(v[0], v[1]); o.y = pk2(v[2], v[3]); *(u32x2*)(LakT + r * LD32 + 8 * q + 4 * hh) = o;
                }
            } else {
                bf16_t* M = (wave == 2 ? Mrb : Mrk) + par * 32 * LD32;
#pragma unroll
                for (int g = 0; g < 16; ++g) { const int t = crow(g, hh); M[t * LD32 + r] = f2bf((r <= t) ? acc[g] : 0.f); }
            }
        }
        LDS_BARRIER();
        if (wave == 7 && xn < G_NT) {
            const f32x16 tf = invert32_blocked(Lf, (bf16_t*)(smem + RL_RX), lane);
#pragma unroll
            for (int g = 0; g < 16; ++g) Tb[crow(g, hh) * LD32 + r] = f2bf(tf[g]);
        }
        if (wave < 2 && it >= 0) {
            const int pc = it & 1; int seg = 0, j0 = 0; chunk_pos(it, d, seg, j0);
            const bf16_t* Rc = Rr + pc * 32 * LD64; const bf16_t* BhTc = BhT + pc * 64 * LD32; const bf16_t* KhTc = KhT + pc * 64 * LD32; const bf16_t* VTc = VT + (pc * 64 + 32 * wave + r) * LD32;
            const bf16_t* Mrbc = Mrb + pc * 32 * LD32; const bf16_t* Mrkc = Mrk + pc * 32 * LD32; const float* PCc = PC + pc * 64;
            const bf16x8 vf0 = ld_nat(VTc, 0, hh), vf1 = ld_nat(VTc, 1, hh);
            f32x16 u = zero16(), y = zero16();
            u = MFMA32(ld_nat(TLm + r * LD32, 0, hh), vf0, u); u = MFMA32(ld_nat(TLm + r * LD32, 1, hh), vf1, u);
            y = MFMA32(ld_nat(Mrkc + r * LD32, 0, hh), vf0, y); y = MFMA32(ld_nat(Mrkc + r * LD32, 1, hh), vf1, y);
#define RW_KSTEP(s) { const bf16x8 xb = pack_acc<(s) & 1>(Xt[(s) >> 1]); u = MFMA32(ld_perm(Wm + r * LD64, (s), hh), xb, u); y = MFMA32(ld_perm(Rc + r * LD64, (s), hh), xb, y); }
            RW_KSTEP(0) RW_KSTEP(1) RW_KSTEP(2) RW_KSTEP(3)
#undef RW_KSTEP
            const bf16x8 ub0 = pack_acc<0>(u), ub1 = pack_acc<1>(u);
            y = MFMA32(ld_perm(Mrbc + r * LD32, 0, hh), ub0, y); y = MFMA32(ld_perm(Mrbc + r * LD32, 1, hh), ub1, y);
#pragma unroll
            for (int kt = 0; kt < 2; ++kt) {
#pragma unroll
                for (int g = 0; g < 16; ++g) Xt[kt][g] *= PCc[32 * kt + crow(g, hh)];
                Xt[kt] = MFMA32(ld_perm(BhTc + (32 * kt + r) * LD32, 0, hh), ub0, Xt[kt]); Xt[kt] = MFMA32(ld_perm(BhTc + (32 * kt + r) * LD32, 1, hh), ub1, Xt[kt]);
                Xt[kt] = MFMA32(ld_nat(KhTc + (32 * kt + r) * LD32, 0, hh), vf0, Xt[kt]); Xt[kt] = MFMA32(ld_nat(KhTc + (32 * kt + r) * LD32, 1, hh), vf1, Xt[kt]);
            }
            if (seg) {
#pragma unroll
                for (int g = 0; g < 16; ++g) {
                    const int i = crow(g, hh), jj = d ? j0 + GC - 1 - i : j0 + i;
                    YDIR[((size_t)d * T_LAT + (size_t)b * S + (jj % ROWS) * GW + jj / ROWS) * 512 + h * 64 + 32 * wave + r] = f2bf(y[g]);
                }
            }
        }
        LDS_BARRIER();
        if (xn < G_NT && wave < 3) {
            const bf16_t* arow = (wave < 2) ? AT + (32 * wave + r) * LD32 : LakT + r * LD32;
            f32x16 acc = zero16();
#pragma unroll
            for (int s = 0; s < 2; ++s) acc = MFMA32(ld_nat(arow, s, hh), ld_nat(Tb + r * LD32, s, hh), acc);
#pragma unroll
            for (int q = 0; q < 4; ++q) {
                u32x2 o; o.x = pk2(acc[4 * q], acc[4 * q + 1]); o.y = pk2(acc[4 * q + 2], acc[4 * q + 3]);
                if (wave < 2) *(u32x2*)(Wm + r * LD64 + 32 * wave + 8 * q + 4 * hh) = o; else *(u32x2*)(TLm + r * LD32 + 8 * q + 4 * hh) = o;
            }
        }
        LDS_BARRIER();
    }
}

DI void phase3(const Params& p, char* smem) {
    constexpr int NG = 2 * NB * H_A, NR = 2 * NB * H_B;
    for (int it = blockIdx.x; it < NG; it += gridDim.x) gdn_chain2(p, smem, it);
    for (int it = blockIdx.x; it < NG + NR; it += gridDim.x) if (it >= NG) rwkv_chain2(p, smem, it - NG);
}

DI void phase4(const Params& p, char* smem) {
    const int tid = tid_x(), lane = tid & 63, wave = tid >> 6;
    const bf16_t* PL = (const bf16_t*)(p.ws + WS_PLAT);
    const bf16_t* ODIR = (const bf16_t*)(p.aux + AUX_ODIR); const bf16_t* YDIR = (const bf16_t*)(p.aux + AUX_YDIR);
    const float* BON = (const float*)(p.ws + WS_BONUS); const float* mu = p.in[I_MU];
    bf16_t* OA = (bf16_t*)(p.ws + WS_OA); bf16_t* OB = (bf16_t*)(p.ws + WS_OB);
    float* sg = (float*)smem;
    for (int it = blockIdx.x; it < T_LAT / 16; it += gridDim.x) {
        const int tok0 = it * 16, b = tok0 / S, l0 = tok0 % S;
        __syncthreads();
        for (int idx = tid; idx < 16 * 128; idx += NTHREADS) {
            const int t = idx >> 7, jj = idx & 127, l = l0 + t, j = (l % GW) * ROWS + l / GW, col = COL_B0 + 1792 + jj;
            const float cu = bf2f(PL[(size_t)(b * S + l) * IN_COLS + col]);
            float pv = 0.f, nx = 0.f;
            if (j > 0) { const int l2 = ((j - 1) % ROWS) * GW + (j - 1) / ROWS; pv = bf2f(PL[(size_t)(b * S + l2) * IN_COLS + col]); }
            if (j < S - 1) { const int l2 = ((j + 1) % ROWS) * GW + (j + 1) / ROWS; nx = bf2f(PL[(size_t)(b * S + l2) * IN_COLS + col]); }
            sg[idx] = sigmoidf_(cu + (0.5f * (pv + nx) - cu) * mu[1792 + jj]);
        }
        __syncthreads();
        {
            const int c = tid, h = wave;
            float gacc[16];
#pragma unroll
            for (int t = 0; t < 16; ++t) gacc[t] = 0.f;
            for (int jj = 0; jj < 128; ++jj) {
                const float g = p.in[I_G2][jj * 512 + c];
#pragma unroll
                for (int t = 0; t < 16; ++t) gacc[t] += sg[t * 128 + jj] * g;
            }
            const float lg = p.in[I_LNG][c], lb = p.in[I_LNB][c], muv = mu[1024 + c];
#pragma unroll
            for (int t = 0; t < 16; ++t) {
                const int l = l0 + t, tok = b * S + l, j = (l % GW) * ROWS + l / GW, col = COL_B0 + 1024 + c;
                const float yf = bf2f(YDIR[(size_t)tok * 512 + c]) + bf2f(YDIR[((size_t)T_LAT + tok) * 512 + c]);
                const float mean = wave_sum(yf) * (1.f / 64.f); const float dv = yf - mean;
                const float var = wave_sum(dv * dv) * (1.f / 64.f);
                const float yn = dv * (1.0f / sqrtf(var + 64e-5f)) * lg + lb;
                const float cu = bf2f(PL[(size_t)tok * IN_COLS + col]);
                float pv = 0.f, nx = 0.f;
                if (j > 0) { const int l2 = ((j - 1) % ROWS) * GW + (j - 1) / ROWS; pv = bf2f(PL[(size_t)(b * S + l2) * IN_COLS + col]); }
                if (j < S - 1) { const int l2 = ((j + 1) % ROWS) * GW + (j + 1) / ROWS; nx = bf2f(PL[(size_t)(b * S + l2) * IN_COLS + col]); }
                const float xv = cu + (0.5f * (pv + nx) - cu) * muv;
                const float bon = BON[(size_t)tok * 8 + h] + BON[((size_t)T_LAT + tok) * 8 + h];
                OB[(size_t)tok * 512 + c] = f2bf((yn + bon * xv) * gacc[t]);
            }
        }
        for (int pi = wave * 8; pi < wave * 8 + 8; ++pi) {
            const int t = pi >> 2, h = pi & 3, tok = tok0 + t;
            const size_t o0 = (size_t)tok * 512 + h * 128;
            const float a0 = bf2f(ODIR[o0 + lane]) + bf2f(ODIR[(size_t)T_LAT * 512 + o0 + lane]);
            const float a1 = bf2f(ODIR[o0 + lane + 64]) + bf2f(ODIR[(size_t)T_LAT * 512 + o0 + lane + 64]);
            const float ss = wave_sum(a0 * a0 + a1 * a1);
            const float rstd = 1.0f / sqrtf(ss * (1.f / 128.f) + 1e-6f);
            const float z0 = bf2f(PL[(size_t)tok * IN_COLS + 1536 + h * 128 + lane]), z1 = bf2f(PL[(size_t)tok * IN_COLS + 1536 + h * 128 + lane + 64]);
            OA[o0 + lane] = f2bf(a0 * rstd * p.in[I_ONORM][lane] * siluf_(z0));
            OA[o0 + lane + 64] = f2bf(a1 * rstd * p.in[I_ONORM][lane + 64] * siluf_(z1));
        }
    }
}

DI void phase5(const Params& p, char* smem) {
    const bf16_t* OA = (const bf16_t*)(p.ws + WS_OA); const bf16_t* OB = (const bf16_t*)(p.ws + WS_OB);
    const bf16_t* WA = (const bf16_t*)(p.ws + WS_WOA); const bf16_t* WB = (const bf16_t*)(p.ws + WS_WOB);
    const bf16_t* PL = (const bf16_t*)(p.ws + WS_PLAT); bf16_t* Y = (bf16_t*)(p.aux + AUX_Y);
    constexpr int MR5 = 2, BM5 = 64 * MR5; constexpr int NT = D / 128, MT = T_LAT / BM5;
    for (int t = blockIdx.x; t < MT * NT; t += gridDim.x) {
        const int mt = t / NT, nt = t % NT, row0 = mt * BM5;
        f32x4 acca[MR5][4], accb[MR5][4]; acc_zero(acca); acc_zero(accb);
        gemm_kloop(acca, smem, [&](int i) { return OA + (size_t)(row0 + i) * 512; }, WA + (size_t)nt * 128 * 512, 512, 512);
        gemm_kloop(accb, smem, [&](int i) { return OB + (size_t)(row0 + i) * 512; }, WB + (size_t)nt * 128 * 512, 512, 512);
        const int t2 = tid_x(), l2 = t2 & 63, w2 = t2 >> 6; const int wr = w2 >> 1, wc = w2 & 1, fr = l2 & 15, fq = l2 >> 4;
#pragma unroll
        for (int m = 0; m < MR5; ++m)
#pragma unroll
            for (int n = 0; n < 4; ++n)
#pragma unroll
                for (int j = 0; j < 4; ++j) {
                    const int row = row0 + wr * 16 * MR5 + m * 16 + fq * 4 + j, col = nt * 128 + wc * 64 + n * 16 + fr;
                    const float ga = bf2f(PL[(size_t)row * IN_COLS + COL_G0 + col]), gb = bf2f(PL[(size_t)row * IN_COLS + COL_G0 + D + col]);
                    Y[(size_t)row * D + col] = f2bf(sigmoidf_(ga) * acca[m][n][j] + sigmoidf_(gb) * accb[m][n][j]);
                }
    }
}

DI void phase6(const Params& p, char* smem) {
    const bf16_t* Y = (const bf16_t*)(p.aux + AUX_Y); const bf16_t* WO = (const bf16_t*)(p.ws + WS_WOUT);
    const float* mod = (const float*)(p.ws + WS_MOD); float* Hh = (float*)(p.ws + WS_H);
    if (USE_G8) {
        constexpr int NT = D / 256, MT = T_LAT / 256;
        const float* X = p.in[I_X];
        for (int t = blockIdx.x; t < MT * NT; t += gridDim.x) {
            const int mt = t / NT, nt = t % NT, brow = mt * 256, bcol = nt * 256;
            g8::Acc acc; g8::acc_zero(acc);
            g8::kloop(acc, smem, Y, D, WO, D, D, brow, bcol);
            g8::for_each_quad(acc, brow, bcol, [&](int row, int col, const f32x4& v) {
                const int b = row / S; const f32x4 xv = *(const f32x4*)(X + (size_t)row * D + col), gv = *(const f32x4*)(mod + (size_t)b * 6 * D + 2 * D + col);
                f32x4 o; o.x = xv.x + gv.x * v.x; o.y = xv.y + gv.y * v.y; o.z = xv.z + gv.z * v.z; o.w = xv.w + gv.w * v.w;
                *(f32x4*)(Hh + (size_t)row * D + col) = o;
            });
        }
    } else {
        const int tid = tid_x(), lane = tid & 63, wave = tid >> 6, wr = wave >> 1, wc = wave & 1, fr = lane & 15, fq = lane >> 4;
        constexpr int NT = D / 128, MT = T_LAT / BM;
        for (int t = blockIdx.x; t < MT * NT; t += gridDim.x) {
            const int mt = t / NT, nt = t % NT, row0 = mt * BM;
            f32x4 acc[MREP][4]; acc_zero(acc);
            gemm_kloop(acc, smem, [&](int i) { return Y + (size_t)(row0 + i) * D; }, WO + (size_t)nt * 128 * D, D, D);
#pragma unroll
            for (int m = 0; m < MREP; ++m)
#pragma unroll
                for (int n = 0; n < 4; ++n)
#pragma unroll
                    for (int j = 0; j < 4; ++j) {
                        const int row = row0 + wr * 16 * MREP + m * 16 + fq * 4 + j, col = nt * 128 + wc * 64 + n * 16 + fr, b = row / S;
                        Hh[(size_t)row * D + col] = p.in[I_X][(size_t)row * D + col] + mod[(size_t)b * 6 * D + 2 * D + col] * acc[m][n][j];
                    }
        }
    }
    __syncthreads();
    const int tid6 = tid_x(), lane = tid6 & 63, wave = tid6 >> 6;
    const int gw = blockIdx.x * 8 + wave, ngw = gridDim.x * 8;
    float* scr = (float*)smem + wave * (64 * 33);
    bf16_t* GUT = (bf16_t*)(p.aux + AUX_GUT); bf16_t* DNT = (bf16_t*)(p.ws + WS_DNT);
    {
        constexpr int nkb = D / 64, nnb = DE / 32, per = nkb * nnb;
        for (int it = gw; it < NEXP * 2 * per; it += ngw) {
            const int e = it / (2 * per), r = it % (2 * per), up = r / per, r2 = r % per, kb = r2 / nnb, nb = r2 % nnb;
            transpose_item((up ? p.in[I_MU_UP] : p.in[I_MG]) + (size_t)e * D * DE, DE, DE, kb * 64, nb * 32, GUT + (size_t)e * 512 * D, D, up ? 2 : 1, scr, lane);
        }
    }
    {
        constexpr int nkb = DE / 64, nnb = D / 32, per = nkb * nnb;
        for (int it = gw; it < NEXP * per; it += ngw) {
            const int e = it / per, r2 = it % per, kb = r2 / nnb, nb = r2 % nnb;
            transpose_item(p.in[I_MD] + (size_t)e * DE * D, D, D, kb * 64, nb * 32, DNT + (size_t)e * D * DE, DE, 0, scr, lane);
        }
    }
}

#ifdef EMU
#define MFMA32F(a, b, c) emu_mfma32_f32((a), (b), (c))
#else
#define MFMA32F(a, b, c) __builtin_amdgcn_mfma_f32_32x32x2f32((a), (b), (c), 0, 0, 0)
#endif
constexpr int TB_LD = D + 4;
static_assert(32 * TB_LD * 4 <= LDS_BYTES && 8 * 32 * 64 * 4 <= LDS_BYTES, "phase7 lds");
DI void phase7(const Params& p, char* smem) {
    const int tid = tid_x(), lane = tid & 63, wave = tid >> 6, r = lane & 31, hh = lane >> 5;
    const float* Hh = (const float*)(p.ws + WS_H); const float* mod = (const float*)(p.ws + WS_MOD); const float* WRT = (const float*)(p.ws + WS_WRT);
    bf16_t* Tt = (bf16_t*)(p.ws + WS_T); int* cnt = (int*)(p.ws + WS_CNT); int* rowlist = (int*)(p.ws + WS_ROWLIST); float* pairw = (float*)(p.ws + WS_PAIRW);
    float* tb = (float*)smem;
    float* bias = (float*)(smem + LDS_BYTES - 1024);
    int* lcnt = (int*)(smem + LDS_BYTES - 768);
    int* lbase = lcnt + 32;
    if (tid < 36) bias[tid] = tid < 4 ? p.in[I_RGB][tid] : p.in[I_REB][tid - 4];
    f32x4 x[4][D / 256];
    int itn = blockIdx.x;
    if (itn < T_LAT / 32) {
#pragma unroll
        for (int tt = 0; tt < 4; ++tt)
#pragma unroll
            for (int j = 0; j < D / 256; ++j) x[tt][j] = *(const f32x4*)(Hh + (size_t)(itn * 32 + wave * 4 + tt) * D + j * 256 + lane * 4);
    }
    for (int it = blockIdx.x; it < T_LAT / 32; it += gridDim.x) {
        const int tok0 = it * 32;
        __syncthreads();
        if (tid < 32) lcnt[tid] = 0;
#pragma unroll
        for (int tt = 0; tt < 4; ++tt) {
            const int ti = wave * 4 + tt, tok = tok0 + ti, b = tok / S;
            float ss = 0.f;
#pragma unroll
            for (int j = 0; j < D / 256; ++j) ss += x[tt][j].x * x[tt][j].x + x[tt][j].y * x[tt][j].y + x[tt][j].z * x[tt][j].z + x[tt][j].w * x[tt][j].w;
            ss = wave_sum_fast(ss);
            const float rstd = frsq(ss * (1.0f / D) + 1e-6f);
#pragma unroll
            for (int j = 0; j < D / 256; ++j) {
                const int k = j * 256 + lane * 4;
                const f32x4 g = *(const f32x4*)(p.in[I_NFFN] + k), sh = *(const f32x4*)(mod + (size_t)b * 6 * D + 3 * D + k), sc = *(const f32x4*)(mod + (size_t)b * 6 * D + 4 * D + k);
                f32x4 o; o.x = x[tt][j].x * rstd * g.x * (1.f + sc.x) + sh.x; o.y = x[tt][j].y * rstd * g.y * (1.f + sc.y) + sh.y;
                o.z = x[tt][j].z * rstd * g.z * (1.f + sc.z) + sh.z; o.w = x[tt][j].w * rstd * g.w * (1.f + sc.w) + sh.w;
                *(f32x4*)(tb + ti * TB_LD + k) = o;
                u32x2 ob; ob.x = pk2(o.x, o.y); ob.y = pk2(o.z, o.w);
                *(u32x2*)(Tt + (size_t)tok * D + k) = ob;
            }
        }
        itn = it + gridDim.x;
        if (itn < T_LAT / 32) {
#pragma unroll
            for (int tt = 0; tt < 4; ++tt)
#pragma unroll
                for (int j = 0; j < D / 256; ++j) x[tt][j] = *(const f32x4*)(Hh + (size_t)(itn * 32 + wave * 4 + tt) * D + j * 256 + lane * 4);
        }
        LDS_BARRIER();
        f32x16 a0 = zero16(), a1 = zero16();
        {
            const int kbeg = wave * (D / 8);
            const float* arow = tb + r * TB_LD + kbeg + 4 * hh;
            const float* b0row = WRT + (size_t)(4 + r) * D + kbeg + 4 * hh;
            const float* b1row = WRT + (size_t)(r < 4 ? r : 0) * D + kbeg + 4 * hh;
            const float m1 = r < 4 ? 1.f : 0.f;
#pragma unroll 4
            for (int g = 0; g < D / 64; ++g) {
                const f32x4 av = *(const f32x4*)(arow + 8 * g), b0 = *(const f32x4*)(b0row + 8 * g); const f32x4 b1 = *(const f32x4*)(b1row + 8 * g) * m1;
                a0 = MFMA32F(av.x, b0.x, a0); a1 = MFMA32F(av.x, b1.x, a1); a0 = MFMA32F(av.y, b0.y, a0); a1 = MFMA32F(av.y, b1.y, a1);
                a0 = MFMA32F(av.z, b0.z, a0); a1 = MFMA32F(av.z, b1.z, a1); a0 = MFMA32F(av.w, b0.w, a0); a1 = MFMA32F(av.w, b1.w, a1);
            }
        }
        LDS_BARRIER();
        {
            float* part = tb + wave * (32 * 64);
#pragma unroll
            for (int g = 0; g < 16; ++g) { const int i = crow(g, hh); part[i * 64 + r] = a0[g]; part[i * 64 + 32 + r] = a1[g]; }
        }
        LDS_BARRIER();
        float lsum[4];
        {
            const int i = tid >> 4, c4 = (tid & 15) * 4;
#pragma unroll
            for (int e = 0; e < 4; ++e) { float sacc = 0.f;
#pragma unroll
                for (int w = 0; w < 8; ++w) sacc += tb[w * (32 * 64) + i * 64 + c4 + e];
                lsum[e] = sacc; }
        }
        LDS_BARRIER();
        { const int i = tid >> 4, c4 = (tid & 15) * 4;
#pragma unroll
          for (int e = 0; e < 4; ++e) tb[i * 64 + c4 + e] = lsum[e]; }
        LDS_BARRIER();
        int ex1 = 0, ex2 = 0, rk1 = 0, rk2 = 0; float w1 = 0.f, w2 = 0.f;
        if (tid < 32) {
            const float* L = tb + tid * 64;
            float gl[4];
#pragma unroll
            for (int i = 0; i < 4; ++i) gl[i] = L[32 + i] + bias[i];
            int g = 0; float mx = gl[0];
#pragma unroll
            for (int i = 1; i < 4; ++i) if (gl[i] > mx) { mx = gl[i]; g = i; }
            float se = 0.f;
#pragma unroll
            for (int i = 0; i < 4; ++i) se += expf(gl[i] - mx);
            const float pg = 1.0f / se;
            int i1 = 0; float l1 = L[g * 8] + bias[4 + g * 8];
            for (int i = 1; i < 8; ++i) { const float v = L[g * 8 + i] + bias[4 + g * 8 + i]; if (v > l1) { l1 = v; i1 = i; } }
            int i2 = -1; float l2 = -3.0e38f;
            for (int i = 0; i < 8; ++i) { const float v = L[g * 8 + i] + bias[4 + g * 8 + i]; if (i != i1 && v > l2) { l2 = v; i2 = i; } }
            const float e2 = expf(l2 - l1); w1 = pg / (1.f + e2); w2 = pg * e2 / (1.f + e2);
            ex1 = g * 8 + i1; ex2 = g * 8 + i2;
            rk1 = atomicAdd(&lcnt[ex1], 1); rk2 = atomicAdd(&lcnt[ex2], 1);
        }
        LDS_BARRIER();
        if (tid < 32) { const int c = lcnt[tid]; lbase[tid] = c ? atomicAdd(&cnt[tid], c) : 0; }
        __syncthreads();
        if (tid < 32) {
            const int tok = tok0 + tid;
            rowlist[(size_t)ex1 * CAP + lbase[ex1] + rk1] = tok * 2; pairw[tok * 2] = w1;
            rowlist[(size_t)ex2 * CAP + lbase[ex2] + rk2] = tok * 2 + 1; pairw[tok * 2 + 1] = w2;
        }
    }
}

constexpr int MOE_TM = USE_G8 ? 256 : BM;
DI void moe_tiles(const Params& p, char* smem, int* pre) {
    const int* cnt = (const int*)(p.ws + WS_CNT);
    __syncthreads();
    if (tid_x() == 0) { int s = 0; for (int e = 0; e < NEXP; ++e) { pre[e] = s; s += (cnt[e] + MOE_TM - 1) / MOE_TM; } pre[NEXP] = s; }
    __syncthreads();
}
DI void phase8(const Params& p, char* smem) {
    const int tid = tid_x(), lane = tid & 63, wave = tid >> 6, wr = wave >> 1, wc = wave & 1, fr = lane & 15, fq = lane >> 4;
    int* pre = (int*)(smem + LDS_BYTES - 256);
    moe_tiles(p, smem, pre);
    const int* cnt = (const int*)(p.ws + WS_CNT); const int* rowlist = (const int*)(p.ws + WS_ROWLIST);
    const bf16_t* Tt = (const bf16_t*)(p.ws + WS_T); const bf16_t* GUT = (const bf16_t*)(p.aux + AUX_GUT); bf16_t* HID = (bf16_t*)(p.ws + WS_HID);
    if (USE_G8) {
        const int ntile8 = pre[NEXP] * 2;
        for (int t = blockIdx.x; t < ntile8; t += gridDim.x) {
            const int mg = t >> 1, nt = t & 1; int e = 0;
            while (pre[e + 1] <= mg) ++e;
            const int mt = mg - pre[e], ce = cnt[e]; const int* rl = rowlist + (size_t)e * CAP;
            g8::Acc acc; g8::acc_zero(acc);
            g8::kloop_g(acc, smem, Tt, [&](int r) { int idx = mt * 256 + r; idx = idx < ce ? idx : ce - 1; return (rl[idx] >> 1) * D; }, GUT + ((size_t)e * 512 + nt * 256) * D, D, D, 0);
            const int t2 = tid_x(), wid = t2 >> 6, l2 = t2 & 63, wr2 = wid >> 2, wc2 = wid & 3, fr2 = l2 & 15, fq2 = l2 >> 4;
#pragma unroll
            for (int ai = 0; ai < 2; ++ai)
#pragma unroll
                for (int m = 0; m < 4; ++m) {
                    const int idx = mt * 256 + ai * 128 + wr2 * 64 + m * 16 + fr2;
                    if (idx < ce) {
                        const int pair = rl[idx];
#pragma unroll
                        for (int bj = 0; bj < 2; ++bj) {
                            const f32x4 g = acc[ai][bj][m][0], u = acc[ai][bj][m][1];
                            u32x2 o; o.x = pk2(fsilu(g.x) * u.x, fsilu(g.y) * u.y); o.y = pk2(fsilu(g.z) * u.z, fsilu(g.w) * u.w);
                            *(u32x2*)(HID + (size_t)pair * DE + nt * 128 + bj * 64 + wc2 * 16 + fq2 * 4) = o;
                        }
                    }
                }
        }
        return;
    }
    const int ntile = pre[NEXP] * 4;
    for (int t = blockIdx.x; t < ntile; t += gridDim.x) {
        const int mg = t >> 2, nt = t & 3; int e = 0;
        while (pre[e + 1] <= mg) ++e;
        const int mt = mg - pre[e], ce = cnt[e]; const int* rl = rowlist + (size_t)e * CAP;
        f32x4 acc[MREP][4]; acc_zero(acc);
        gemm_kloop(acc, smem, [&](int i) { int idx = mt * BM + i; idx = idx < ce ? idx : ce - 1; return Tt + (size_t)(rl[idx] >> 1) * D; }, GUT + ((size_t)e * 512 + nt * 128) * D, D, D);
#pragma unroll
        for (int m = 0; m < MREP; ++m)
#pragma unroll
            for (int j = 0; j < 4; ++j) {
                const int idx = mt * BM + wr * 16 * MREP + m * 16 + fq * 4 + j;
                if (idx < ce) {
                    const int pair = rl[idx];
#pragma unroll
                    for (int n = 0; n < 2; ++n) {
                        const float g = acc[m][n][j], u = acc[m][n + 2][j];
                        HID[(size_t)pair * DE + nt * 64 + wc * 32 + n * 16 + fr] = f2bf(siluf_(g) * u);
                    }
                }
            }
    }
}
DI void phase9(const Params& p, char* smem) {
    const int tid = tid_x(), lane = tid & 63, wave = tid >> 6, wr = wave >> 1, wc = wave & 1, fr = lane & 15, fq = lane >> 4;
    int* pre = (int*)(smem + LDS_BYTES - 256);
    moe_tiles(p, smem, pre);
    const int* cnt = (const int*)(p.ws + WS_CNT); const int* rowlist = (const int*)(p.ws + WS_ROWLIST); const float* pairw = (const float*)(p.ws + WS_PAIRW);
    const bf16_t* HID = (const bf16_t*)(p.ws + WS_HID); const bf16_t* DNT = (const bf16_t*)(p.ws + WS_DNT); bf16_t* OP = (bf16_t*)(p.ws + WS_OPAIR);
    if (USE_G8) {
        constexpr int NT8 = D / 256;
        const int ntile8 = pre[NEXP] * NT8;
        for (int t = blockIdx.x; t < ntile8; t += gridDim.x) {
            const int mg = t / NT8, nt = t % NT8; int e = 0;
            while (pre[e + 1] <= mg) ++e;
            const int mt = mg - pre[e], ce = cnt[e]; const int* rl = rowlist + (size_t)e * CAP;
            g8::Acc acc; g8::acc_zero(acc);
            g8::kloop_g(acc, smem, HID, [&](int r) { int idx = mt * 256 + r; idx = idx < ce ? idx : ce - 1; return rl[idx] * DE; }, DNT + ((size_t)e * D + nt * 256) * DE, DE, DE, 0);
            g8::for_each_quad(acc, 0, nt * 256, [&](int row, int col, const f32x4& v) {
                const int idx = mt * 256 + row;
                if (idx < ce) { const int pair = rl[idx]; const float w = pairw[pair];
                    u32x2 o; o.x = pk2(v.x * w, v.y * w); o.y = pk2(v.z * w, v.w * w); *(u32x2*)(OP + (size_t)pair * D + col) = o; }
            });
        }
        return;
    }
    constexpr int NT = D / 128;
    const int ntile = pre[NEXP] * NT;
    for (int t = blockIdx.x; t < ntile; t += gridDim.x) {
        const int mg = t / NT, nt = t % NT; int e = 0;
        while (pre[e + 1] <= mg) ++e;
        const int mt = mg - pre[e], ce = cnt[e]; const int* rl = rowlist + (size_t)e * CAP;
        f32x4 acc[MREP][4]; acc_zero(acc);
        gemm_kloop(acc, smem, [&](int i) { int idx = mt * BM + i; idx = idx < ce ? idx : ce - 1; return HID + (size_t)rl[idx] * DE; }, DNT + ((size_t)e * D + nt * 128) * DE, DE, DE);
#pragma unroll
        for (int m = 0; m < MREP; ++m)
#pragma unroll
            for (int j = 0; j < 4; ++j) {
                const int idx = mt * BM + wr * 16 * MREP + m * 16 + fq * 4 + j;
                if (idx < ce) {
                    const int pair = rl[idx]; const float w = pairw[pair];
#pragma unroll
                    for (int n = 0; n < 4; ++n) OP[(size_t)pair * D + nt * 128 + wc * 64 + n * 16 + fr] = f2bf(acc[m][n][j] * w);
                }
            }
    }
}

DI void phase10(const Params& p, char* smem) {
    const int lane = tid_x() & 63, wave = tid_x() >> 6;
    const int gw = blockIdx.x * 8 + wave, ngw = gridDim.x * 8;
    const float* Hh = (const float*)(p.ws + WS_H); const float* mod = (const float*)(p.ws + WS_MOD); const bf16_t* OP = (const bf16_t*)(p.ws + WS_OPAIR);
    for (int tok = gw; tok < T_LAT; tok += ngw) {
        const int b = tok / S;
        f32x4 x[D / 256]; float ss = 0.f;
#pragma unroll
        for (int j = 0; j < D / 256; ++j) {
            const int k = j * 256 + lane * 4;
            const f32x4 hv = *(const f32x4*)(Hh + (size_t)tok * D + k), g2 = *(const f32x4*)(mod + (size_t)b * 6 * D + 5 * D + k);
            const u32x2 p0 = *(const u32x2*)(OP + (size_t)(tok * 2) * D + k), p1 = *(const u32x2*)(OP + (size_t)(tok * 2 + 1) * D + k);
            f32x4 m;
            m.x = bf2f((bf16_t)(p0.x & 0xffffu)) + bf2f((bf16_t)(p1.x & 0xffffu)); m.y = bf2f((bf16_t)(p0.x >> 16)) + bf2f((bf16_t)(p1.x >> 16));
            m.z = bf2f((bf16_t)(p0.y & 0xffffu)) + bf2f((bf16_t)(p1.y & 0xffffu)); m.w = bf2f((bf16_t)(p0.y >> 16)) + bf2f((bf16_t)(p1.y >> 16));
            x[j].x = hv.x + g2.x * m.x; x[j].y = hv.y + g2.y * m.y; x[j].z = hv.z + g2.z * m.z; x[j].w = hv.w + g2.w * m.w;
            ss += x[j].x * x[j].x + x[j].y * x[j].y + x[j].z * x[j].z + x[j].w * x[j].w;
        }
        ss = wave_sum(ss);
        const float rstd = 1.0f / sqrtf(ss * (1.0f / D) + 1e-6f);
#pragma unroll
        for (int j = 0; j < D / 256; ++j) {
            const int k = j * 256 + lane * 4; const f32x4 g = *(const f32x4*)(p.in[I_FIN] + k);
            f32x4 o; o.x = x[j].x * rstd * g.x; o.y = x[j].y * rstd * g.y; o.z = x[j].z * rstd * g.z; o.w = x[j].w * rstd * g.w;
            *(f32x4*)(p.out + (size_t)tok * D + k) = o;
        }
    }
}

DI void run_phase(const Params& p, int ph, char* smem) {
    switch (ph) {
        case 0: phase0(p, smem); break;
        case 1: phase1(p, smem); break;
        case 2: phase2(p, smem); break;
        case 3: phase3(p, smem); break;
        case 4: phase4(p, smem); break;
        case 5: phase5(p, smem); break;
        case 6: phase6(p, smem); break;
        case 7: phase7(p, smem); break;
        case 8: phase8(p, smem); break;
        case 9: phase9(p, smem); break;
        default: phase10(p, smem); break;
    }
}

#ifndef EMU
namespace cg = cooperative_groups;
DI void grid_barrier_fast(unsigned* ctr, unsigned target) {
    asm volatile("s_waitcnt vmcnt(0)" ::: "memory");
    __syncthreads();
    if (tid_x() == 0) {
        __builtin_amdgcn_fence(__ATOMIC_RELEASE, "agent");
        asm volatile("s_waitcnt vmcnt(0)" ::: "memory");
        __hip_atomic_fetch_add(ctr, 1u, __ATOMIC_RELAXED, __HIP_MEMORY_SCOPE_AGENT);
        unsigned spins = 0;
        while (__hip_atomic_load(ctr, __ATOMIC_RELAXED, __HIP_MEMORY_SCOPE_AGENT) < target) { __builtin_amdgcn_s_sleep(1); if (++spins > (1u << 24)) break; }
        __builtin_amdgcn_fence(__ATOMIC_ACQUIRE, "agent");
        asm volatile("s_waitcnt vmcnt(0)" ::: "memory");
    }
    __syncthreads();
}
__global__ void __launch_bounds__(NTHREADS) mk_forward(Params p) {
    extern __shared__ __attribute__((aligned(16))) char smem[];
    cg::grid_group grid = cg::this_grid();
    typedef const Params __attribute__((address_space(4)))* KPtr;
#define PHASE(k, fn) { KPtr kp = (KPtr)__builtin_amdgcn_kernarg_segment_ptr(); asm volatile("" : "+s"(kp)); fn(*(const Params*)kp, smem); \
        if ((k) == 0) grid.sync(); else if ((k) + 1 < NPHASES) grid_barrier_fast((unsigned*)(((const Params*)kp)->ws + WS_BAR), (unsigned)(k) * gridDim.x); }
    PHASE(0, phase0) PHASE(1, phase1) PHASE(2, phase2) PHASE(3, phase3) PHASE(4, phase4) PHASE(5, phase5)
    PHASE(6, phase6) PHASE(7, phase7) PHASE(8, phase8) PHASE(9, phase9) PHASE(10, phase10)
#undef PHASE
}

extern "C" void kernel_launch(void* const* d_in, const int* in_sizes, int n_in, void* d_out, int out_size, void* d_ws, size_t ws_size, hipStream_t stream) {
    static int grid_blocks = 0;
    if (grid_blocks == 0) {
        if (n_in != 35 || out_size != T_LAT * D || ws_size < WS_END || (size_t)out_size * 4 < AUX_END) {
            fprintf(stderr, "kernel_launch: unexpected shapes (n_in %d out %d ws %zu need %zu aux need %zu)\n", n_in, out_size, ws_size, (size_t)WS_END, (size_t)AUX_END);
            grid_blocks = -1; return;
        }
        int dev = 0, cus = 0, per_cu = 0;
        hipGetDevice(&dev);
        hipDeviceGetAttribute(&cus, hipDeviceAttributeMultiprocessorCount, dev);
        hipFuncSetAttribute((const void*)mk_forward, hipFuncAttributeMaxDynamicSharedMemorySize, LDS_BYTES);
        hipOccupancyMaxActiveBlocksPerMultiprocessor(&per_cu, (const void*)mk_forward, NTHREADS, LDS_BYTES);
        if (per_cu < 1) { fprintf(stderr, "kernel_launch: occupancy query says %d blocks/CU\n", per_cu); per_cu = 1; }
        if (per_cu > 1) per_cu = 1;
        grid_blocks = cus * per_cu;
    }
    if (grid_blocks < 0) return;
    Params p{};
    for (int i = 0; i < 35; ++i) p.in[i] = (const float*)d_in[i];
    p.out = (float*)d_out; p.ws = (char*)d_ws; p.aux = (char*)d_out;
    p.ph_lo = 0; p.ph_hi = NPHASES;
    void* args[] = {&p};
    hipError_t e = hipLaunchCooperativeKernel((const void*)mk_forward, dim3(grid_blocks), dim3(NTHREADS), args, LDS_BYTES, stream);
    if (e != hipSuccess) fprintf(stderr, "cooperative launch failed: %s (grid %d)\n", hipGetErrorString(e), grid_blocks);
}
#endif
```

```cpp
#ifndef EMU
#include <hip/hip_runtime.h>
#include <hip/hip_cooperative_groups.h>
#include <cstdio>
#endif
#include <stdint.h>
#include <stddef.h>

#ifndef CFG_D
#define CFG_D 1024
#define CFG_B 8
#define CFG_S 2048
#define CFG_CTX 256
#endif
#ifndef MK_LAUNCHES
#define MK_LAUNCHES 1
#endif

typedef unsigned short bf16_t;
typedef short bf16x8 __attribute__((ext_vector_type(8)));
typedef float f32x4 __attribute__((ext_vector_type(4)));
typedef unsigned u32x4 __attribute__((ext_vector_type(4)));
typedef unsigned u32x2 __attribute__((ext_vector_type(2)));

#define DI __device__ __forceinline__
DI int tid_x() { int t = (int)threadIdx.x;
#ifndef EMU
    asm volatile("" : "+v"(t));
#endif
    return t; }

constexpr int D = CFG_D, NB = CFG_B, S = CFG_S, CTXL = CFG_CTX;
constexpr int GW = 64, ROWS = S / GW;
constexpr int T_CTX = NB * CTXL, T_LAT = NB * S, T_ALL = T_CTX + T_LAT;
constexpr int H_A = 4, H_B = 8;
constexpr int A_COLS = 2064, B_COLS = 1920;
constexpr int IN_COLS = A_COLS + B_COLS + 2 * D;
constexpr int COL_B0 = A_COLS, COL_G0 = A_COLS + B_COLS;
constexpr int CTX_COLS = COL_G0;
constexpr int NP = ((IN_COLS + 127) / 128) * 128;
constexpr int NEXP = 32, DE = 256;
constexpr int NV = NB + 1;
constexpr int NTHREADS = 512;
constexpr int MREP = (T_CTX % 256 == 0 && T_LAT % 256 == 0) ? 4 : 2;
constexpr int BM = 64 * MREP;
constexpr int NPHASES = 13;
enum { PH_MOD = 0, PH_U, PH_P, PH_HALO, PH_FIR, PH_CHAINS, PH_POST, PH_MERGE, PH_WOUT, PH_ROUTER, PH_UP, PH_DOWN, PH_FINAL };
constexpr int LDS_BYTES = 155648;
constexpr int CAP = T_LAT;

static_assert(D % 256 == 0 && S % 64 == 0 && CTXL % 64 == 0 && T_CTX % BM == 0 && T_LAT % BM == 0, "shape");

constexpr size_t al256(size_t x) { return (x + 255) & ~(size_t)255; }
constexpr size_t WS_CNT = 0;
constexpr size_t WS_BAR = 256;
constexpr size_t WS_MOD = 512;
constexpr size_t WS_AB = al256(WS_MOD + (size_t)NV * 6 * D * 4);
constexpr size_t WS_BONUS = al256(WS_AB + (size_t)T_ALL * 16 * 4);
constexpr size_t WS_PAIRW = al256(WS_BONUS + (size_t)2 * T_LAT * 8 * 4);
constexpr size_t WS_ROWLIST = al256(WS_PAIRW + (size_t)T_LAT * 2 * 4);
constexpr size_t WS_WRT = al256(WS_ROWLIST + (size_t)NEXP * CAP * 4);
constexpr size_t WS_G2T = al256(WS_WRT + (size_t)36 * D * 4);
constexpr size_t WS_WOA = al256(WS_G2T + (size_t)512 * 128 * 2);
constexpr size_t WS_WOB = al256(WS_WOA + (size_t)D * 512 * 2);
constexpr size_t WS_WOUT = al256(WS_WOB + (size_t)D * 512 * 2);
constexpr size_t WS_OA = al256(WS_WOUT + (size_t)D * D * 2);
constexpr size_t WS_OB = al256(WS_OA + (size_t)T_LAT * 512 * 2);
constexpr size_t WS_HALO_A = WS_OA;
constexpr size_t WS_HALO_B = WS_OA + al256((size_t)(T_ALL / 64) * 4 * 1536 * 2);
static_assert(WS_HALO_B + (size_t)(T_ALL / 64) * 2 * 1920 * 2 <= WS_OB + (size_t)T_LAT * 512 * 2, "halo buffers");
constexpr size_t WS_DNT = WS_OA;
constexpr size_t WS_SPARE_END = al256(WS_OB + (size_t)T_LAT * 512 * 2) > al256(WS_DNT + (size_t)NEXP * D * DE * 2) ? al256(WS_OB + (size_t)T_LAT * 512 * 2) : al256(WS_DNT + (size_t)NEXP * D * DE * 2);
constexpr size_t WS_P = WS_SPARE_END;
constexpr size_t WS_PLAT = WS_P;
constexpr size_t WS_PCTX = al256(WS_PLAT + (size_t)T_LAT * IN_COLS * 2);
constexpr size_t WS_P_END = al256(WS_PCTX + (size_t)T_CTX * CTX_COLS * 2);
constexpr size_t WS_H = WS_P;
constexpr size_t WS_T = al256(WS_H + (size_t)T_LAT * D * 4);
constexpr size_t WS_HID = al256(WS_T + (size_t)T_LAT * D * 2);
constexpr size_t WS_OPAIR = al256(WS_HID + (size_t)T_LAT * 2 * DE * 2);
constexpr size_t WS_P2_END = al256(WS_OPAIR + (size_t)T_LAT * 2 * D * 2);
constexpr size_t WS_END = WS_P_END > WS_P2_END ? WS_P_END : WS_P2_END;
constexpr size_t AUX_WINT = 0;
constexpr size_t AUX_U = al256((size_t)NP * D * 2);
constexpr size_t AUX_ODIR = 0;
constexpr size_t AUX_YDIR = (size_t)2 * T_LAT * 512 * 2;
constexpr size_t AUX_Y = 0;
constexpr size_t AUX_GUT = (size_t)T_LAT * D * 2;
constexpr size_t AUX_END1 = AUX_U + (size_t)T_ALL * D * 2;
constexpr size_t AUX_END2 = AUX_YDIR + (size_t)2 * T_LAT * 512 * 2;
constexpr size_t AUX_END3 = AUX_GUT + (size_t)NEXP * 512 * D * 2;
constexpr size_t AUX_END = (AUX_END1 > AUX_END2 ? (AUX_END1 > AUX_END3 ? AUX_END1 : AUX_END3) : (AUX_END2 > AUX_END3 ? AUX_END2 : AUX_END3));

struct Params {
    const float* in[35];
    float* out;
    char* ws;
    char* aux;
    int ph_lo, ph_hi;
};
enum { I_X = 0, I_C, I_CTX, I_CCTX, I_ADAW, I_ADAB, I_NMIX, I_NFFN, I_WIN, I_CONV, I_ALOG, I_DTB, I_ONORM, I_MU, I_W0, I_W2, I_A0, I_A2, I_G2, I_KK, I_KA, I_RK, I_LNG, I_LNB, I_WOA, I_WOB, I_WOUT, I_RG, I_RGB, I_RE, I_REB, I_MG, I_MU_UP, I_MD, I_FIN };

DI float bf2f(bf16_t v) { union { unsigned u; float f; } x; x.u = ((unsigned)v) << 16; return x.f; }
#ifdef EMU
DI bf16_t f2bf(float f) { union { float f; unsigned u; } x; x.f = f; unsigned u = x.u; u += 0x7fffu + ((u >> 16) & 1u); return (bf16_t)(u >> 16); }
DI unsigned pk2(float lo, float hi) { return (unsigned)f2bf(lo) | ((unsigned)f2bf(hi) << 16); }
#else
typedef __bf16 hbf16x2 __attribute__((ext_vector_type(2)));
typedef float f32x2_ __attribute__((ext_vector_type(2)));
DI bf16_t f2bf(float f) { return __builtin_bit_cast(unsigned short, (__bf16)f); }
DI unsigned pk2(float lo, float hi) { const f32x2_ v = {lo, hi}; return __builtin_bit_cast(unsigned, __builtin_convertvector(v, hbf16x2)); }
#endif
DI float sigmoidf_(float x) { return 1.0f / (1.0f + expf(-x)); }
DI float siluf_(float x) { return x / (1.0f + expf(-x)); }
DI float softplusf_(float x) { return x > 20.f ? x : log1pf(expf(x)); }
DI float wave_sum(float v) {
#pragma unroll
    for (int o = 1; o < 64; o <<= 1) v += __shfl_xor(v, o);
    return v;
}
#ifdef EMU
#define MFMA16(a, b, c) emu_mfma16((a), (b), (c))
#define WAVE_SYNC() emu::wave_bar()
#else
#define MFMA16(a, b, c) __builtin_amdgcn_mfma_f32_16x16x32_bf16((a), (b), (c), 0, 0, 0)
#define WAVE_SYNC() asm volatile("s_waitcnt lgkmcnt(0)" ::: "memory")
#endif
#ifdef EMU
#define LDS_BARRIER() __syncthreads()
#else
#define LDS_BARRIER() do { asm volatile("s_waitcnt lgkmcnt(0)" ::: "memory"); __builtin_amdgcn_s_barrier(); asm volatile("" ::: "memory"); } while (0)
#endif

constexpr int LDS_ROW = 40;
constexpr int GEMM_A_BYTES = BM * LDS_ROW * 2, GEMM_B_BYTES = 128 * LDS_ROW * 2;
template <int MR, class ARow>
DI void gemm_kloop(f32x4 (&acc)[MR][4], char* smem, ARow arow, const bf16_t* Bt, int ldb, int K) {
    constexpr int BM = 64 * MR;
    const int tid = tid_x(), lane = tid & 63, wave = tid >> 6, wr = wave >> 1, wc = wave & 1, fr = lane & 15, fq = lane >> 4;
    bf16_t* As = (bf16_t*)smem;
    bf16_t* Bs = (bf16_t*)(smem + 2 * GEMM_A_BYTES);
    constexpr int ACH = BM * 4 / NTHREADS;
    static_assert(ACH >= 1, "tile");
    const bf16_t* ap[ACH];
#pragma unroll
    for (int i = 0; i < ACH; ++i) { const int q = tid + i * NTHREADS; ap[i] = arow(q >> 2) + (q & 3) * 8; }
    const bf16_t* bp = Bt + (size_t)(tid >> 2) * ldb + (tid & 3) * 8;
    u32x4 ra[ACH], rb;
#pragma unroll
    for (int i = 0; i < ACH; ++i) ra[i] = *(const u32x4*)(ap[i]);
    rb = *(const u32x4*)(bp);
    const int nk = K / 32;
    for (int kt = 0; kt < nk; ++kt) {
        const int buf = kt & 1;
#pragma unroll
        for (int i = 0; i < ACH; ++i) { const int q = tid + i * NTHREADS; *(u32x4*)(As + (buf * BM + (q >> 2)) * LDS_ROW + (q & 3) * 8) = ra[i]; }
        *(u32x4*)(Bs + (buf * 128 + (tid >> 2)) * LDS_ROW + (tid & 3) * 8) = rb;
        __syncthreads();
        if (kt + 1 < nk) {
#pragma unroll
            for (int i = 0; i < ACH; ++i) ra[i] = *(const u32x4*)(ap[i] + (kt + 1) * 32);
            rb = *(const u32x4*)(bp + (kt + 1) * 32);
        }
        bf16x8 af[MR], bfr[4];
#pragma unroll
        for (int m = 0; m < MR; ++m) af[m] = *(const bf16x8*)(As + (buf * BM + wr * 16 * MR + m * 16 + fr) * LDS_ROW + fq * 8);
#pragma unroll
        for (int n = 0; n < 4; ++n) bfr[n] = *(const bf16x8*)(Bs + (buf * 128 + wc * 64 + n * 16 + fr) * LDS_ROW + fq * 8);
#pragma unroll
        for (int m = 0; m < MR; ++m)
#pragma unroll
            for (int n = 0; n < 4; ++n) acc[m][n] = MFMA16(af[m], bfr[n], acc[m][n]);
    }
    __syncthreads();
}
template <int MR>
DI void acc_zero(f32x4 (&acc)[MR][4]) {
#pragma unroll
    for (int m = 0; m < MR; ++m)
#pragma unroll
        for (int n = 0; n < 4; ++n) acc[m][n] = (f32x4){0.f, 0.f, 0.f, 0.f};
}

namespace g8 {
constexpr int BM = 256, BK = 64, HALF = 128, HT = HALF * BK;
constexpr int LDS_NEED = 8 * HT * 2;
DI int lds_byte(int r, int c) { const int st = (r >> 4) * 2 + (c >> 5), rr = r & 15, cc = c & 31, ob = rr * 64 + cc * 2; return st * 1024 + (ob ^ (((ob >> 9) & 1) << 5)); }
DI void stage_rc(int b, int& R, int& C) { const int st = b / 1024, sb = b % 1024, swz = sb ^ (((sb >> 9) & 1) << 5); R = (st >> 1) * 16 + swz / 64; C = (st & 1) * 32 + (swz % 64) / 2; }
#ifdef EMU
#define G8_GLDS(src, dst) emu_global_load_lds16((src), (dst))
#define G8_WAIT_V(n)
#define G8_WAIT_L(n)
#define G8_BAR __syncthreads()
#define G8_SCHED
#define G8_PRIO(x)
#else
#define G8_GLDS(src, dst) __builtin_amdgcn_global_load_lds((const unsigned*)(src), (__attribute__((address_space(3))) unsigned*)(dst), 16, 0, 0)
#define G8_WAIT_V(n) asm volatile("s_waitcnt vmcnt(" #n ")" ::: "memory")
#define G8_WAIT_L(n) asm volatile("s_waitcnt lgkmcnt(" #n ")" ::: "memory")
#define G8_BAR __builtin_amdgcn_s_barrier()
#define G8_SCHED __builtin_amdgcn_sched_barrier(0)
#define G8_PRIO(x) __builtin_amdgcn_s_setprio(x)
#endif
typedef f32x4 Acc[2][2][4][2];
template <class AOff>
DI void kloop_g(Acc& acc, char* smem, const bf16_t* A, AOff aoff, const bf16_t* Bt, int ldb, int K, int bcol) {
    bf16_t* shm = (bf16_t*)smem;
    const int tid = tid_x(), wid = tid >> 6, lane = tid & 63, wr = wid >> 2, wc = wid & 3, fr = lane & 15, fq = lane >> 4;
    int ao[2][2];
#pragma unroll
    for (int h = 0; h < 2; ++h)
#pragma unroll
        for (int i = 0; i < 2; ++i) { int R, C; stage_rc(tid * 16 + i * 8192, R, C); ao[h][i] = aoff(h * HALF + R) + C; }
#define G8_STAGE_A(P, h, kt) do { for (int _i = 0; _i < 2; ++_i) { const int _b = tid * 16 + _i * 8192; G8_GLDS(A + (size_t)ao[h][_i] + (size_t)(kt) * BK, (char*)(P) + _b); } } while (0)
#define G8_SA(b, h) (shm + ((b) * 2 + (h)) * HT)
#define G8_SB(b, h) (shm + (4 + (b) * 2 + (h)) * HT)
#define G8_STAGE(P, BASE, LD, br, kt) do { const bf16_t* _g = (BASE) + (size_t)(br) * (LD) + (size_t)(kt) * BK; \
    for (int _i = 0; _i < 2; ++_i) { const int _b = tid * 16 + _i * 8192; int _r, _c; stage_rc(_b, _r, _c); G8_GLDS(_g + (size_t)_r * (LD) + _c, (char*)(P) + _b); } } while (0)
#define G8_LDA(dst, b, h) for (int m = 0; m < 4; ++m) for (int k = 0; k < 2; ++k) dst[m][k] = *(const bf16x8*)((const char*)G8_SA(b, h) + lds_byte(wr * 64 + m * 16 + fr, k * 32 + fq * 8))
#define G8_LDB(dst, b, h) for (int n = 0; n < 2; ++n) for (int k = 0; k < 2; ++k) dst[n][k] = *(const bf16x8*)((const char*)G8_SB(b, h) + lds_byte(wc * 32 + n * 16 + fr, k * 32 + fq * 8))
#define G8_MMA(ai, bj, At_, Bt_) do { G8_PRIO(1); for (int m = 0; m < 4; ++m) for (int n = 0; n < 2; ++n) for (int k = 0; k < 2; ++k) \
    acc[ai][bj][m][n] = MFMA16(Bt_[n][k], At_[m][k], acc[ai][bj][m][n]); G8_PRIO(0); } while (0)
    bf16x8 At[4][2], B0[2][2], B1[2][2];
    const int nt = K / BK;
    G8_STAGE(G8_SB(0, 0), Bt, ldb, bcol, 0); G8_STAGE_A(G8_SA(0, 0), 0, 0);
    G8_STAGE(G8_SB(0, 1), Bt, ldb, bcol + HALF, 0); G8_STAGE_A(G8_SA(0, 1), 1, 0);
    if (wr == 1) G8_BAR;
    G8_WAIT_V(4); G8_BAR;
    G8_STAGE(G8_SB(1, 0), Bt, ldb, bcol, 1); G8_STAGE_A(G8_SA(1, 0), 0, 1); G8_STAGE(G8_SB(1, 1), Bt, ldb, bcol + HALF, 1);
    G8_WAIT_V(6); G8_BAR;
    for (int t = 0; t < nt - 2; t += 2) {
        G8_LDB(B0, 0, 0); G8_SCHED; G8_LDA(At, 0, 0); G8_STAGE_A(G8_SA(1, 1), 1, t + 1);
        G8_WAIT_L(8); G8_BAR; G8_WAIT_L(0); G8_MMA(0, 0, At, B0); G8_BAR; G8_SCHED;
        G8_LDB(B1, 0, 1); G8_STAGE(G8_SB(0, 0), Bt, ldb, bcol, t + 2);
        G8_BAR; G8_WAIT_L(0); G8_MMA(0, 1, At, B1); G8_BAR;
        G8_LDA(At, 0, 1); G8_STAGE_A(G8_SA(0, 0), 0, t + 2);
        G8_BAR; G8_WAIT_L(0); G8_MMA(1, 0, At, B0); G8_BAR; G8_SCHED;
        G8_STAGE(G8_SB(0, 1), Bt, ldb, bcol + HALF, t + 2);
        G8_WAIT_V(6); G8_BAR; G8_MMA(1, 1, At, B1); G8_BAR;
        G8_LDB(B0, 1, 0); G8_SCHED; G8_LDA(At, 1, 0); G8_STAGE_A(G8_SA(0, 1), 1, t + 2);
        G8_WAIT_L(8); G8_BAR; G8_WAIT_L(0); G8_MMA(0, 0, At, B0); G8_BAR; G8_SCHED;
        G8_LDB(B1, 1, 1); G8_STAGE(G8_SB(1, 0), Bt, ldb, bcol, t + 3);
        G8_BAR; G8_WAIT_L(0); G8_MMA(0, 1, At, B1); G8_BAR;
        G8_LDA(At, 1, 1); G8_STAGE_A(G8_SA(1, 0), 0, t + 3);
        G8_BAR; G8_WAIT_L(0); G8_MMA(1, 0, At, B0); G8_BAR; G8_SCHED;
        G8_STAGE(G8_SB(1, 1), Bt, ldb, bcol + HALF, t + 3);
        G8_WAIT_V(6); G8_BAR; G8_MMA(1, 1, At, B1); G8_BAR;
    }
    { G8_LDB(B0, 0, 0); G8_LDA(At, 0, 0); G8_STAGE_A(G8_SA(1, 1), 1, nt - 1);
      G8_BAR; G8_WAIT_L(0); G8_MMA(0, 0, At, B0); G8_BAR;
      G8_LDB(B1, 0, 1); G8_BAR; G8_WAIT_L(0); G8_MMA(0, 1, At, B1); G8_BAR;
      G8_LDA(At, 0, 1); G8_WAIT_V(4); G8_BAR; G8_WAIT_L(0); G8_MMA(1, 0, At, B0); G8_MMA(1, 1, At, B1); G8_BAR; }
    { G8_LDB(B0, 1, 0); G8_LDA(At, 1, 0); G8_WAIT_V(2); G8_BAR; G8_WAIT_L(0); G8_MMA(0, 0, At, B0); G8_BAR;
      G8_LDB(B1, 1, 1); G8_WAIT_V(0); G8_BAR; G8_WAIT_L(0); G8_MMA(0, 1, At, B1); G8_BAR;
      G8_LDA(At, 1, 1); G8_BAR; G8_WAIT_L(0); G8_MMA(1, 0, At, B0); G8_MMA(1, 1, At, B1); G8_BAR; }
    if (wr == 0) G8_BAR;
#undef G8_SA
#undef G8_SB
#undef G8_STAGE
#undef G8_STAGE_A
#undef G8_LDA
#undef G8_LDB
#undef G8_MMA
}
DI void kloop(Acc& acc, char* smem, const bf16_t* A, int lda, const bf16_t* Bt, int ldb, int K, int brow, int bcol) {
    kloop_g(acc, smem, A, [&](int r) { return (brow + r) * lda; }, Bt, ldb, K, bcol);
}
DI void acc_zero(Acc& acc) {
#pragma unroll
    for (int a = 0; a < 2; ++a)
#pragma unroll
        for (int b = 0; b < 2; ++b)
#pragma unroll
            for (int m = 0; m < 4; ++m)
#pragma unroll
                for (int n = 0; n < 2; ++n) acc[a][b][m][n] = (f32x4){0.f, 0.f, 0.f, 0.f};
}
template <class F> DI void for_each_quad(const Acc& acc, int brow, int bcol, F f) {
    const int tid = tid_x(), wid = tid >> 6, lane = tid & 63, wr = wid >> 2, wc = wid & 3, fr = lane & 15, fq = lane >> 4;
#pragma unroll
    for (int ai = 0; ai < 2; ++ai)
#pragma unroll
        for (int m = 0; m < 4; ++m)
#pragma unroll
            for (int bj = 0; bj < 2; ++bj)
#pragma unroll
                for (int n = 0; n < 2; ++n) f(brow + ai * HALF + wr * 64 + m * 16 + fr, bcol + bj * HALF + wc * 32 + n * 16 + fq * 4, acc[ai][bj][m][n]);
}
}

constexpr bool USE_G8 = ((NB * CTXL) % 256 == 0) && ((NB * S) % 256 == 0) && (NP % 256 == 0) && (D % 256 == 0) && (D >= 256);
DI int gu_row(int c, int up) {
    if (USE_G8) return (c >> 7) * 256 + ((c >> 6) & 1) * 128 + ((c >> 4) & 3) * 32 + (up ? 16 : 0) + (c & 15);
    return (c >> 6) * 128 + ((c >> 5) & 1) * 64 + ((c >> 4) & 1) * 16 + (c & 15) + (up ? 32 : 0);
}
DI void transpose_item(const float* W, int N, int Nvalid, int k0, int n0, bf16_t* WT, int ldt, int mode, float* scr, int lane) {
#pragma unroll 4
    for (int i = 0; i < 32; ++i) {
        const int kk = 2 * i + (lane >> 5), n = n0 + (lane & 31);
        scr[kk * 33 + (lane & 31)] = (n < Nvalid) ? W[(size_t)(k0 + kk) * N + n] : 0.f;
    }
    WAVE_SYNC();
    const int c = lane & 7;
#pragma unroll
    for (int j = 0; j < 4; ++j) {
        const int nl = (lane >> 3) + 8 * j; const float* s = scr + (8 * c) * 33 + nl;
        u32x4 o; o.x = pk2(s[0], s[33]); o.y = pk2(s[2 * 33], s[3 * 33]); o.z = pk2(s[4 * 33], s[5 * 33]); o.w = pk2(s[6 * 33], s[7 * 33]);
        const int n = n0 + nl; const int row = mode == 0 ? n : gu_row(n, mode == 2);
        *(u32x4*)(WT + (size_t)row * ldt + k0 + 8 * c) = o;
    }
    WAVE_SYNC();
}
DI void transpose_matrix(const float* W, int K, int N, int Npad, bf16_t* WT, int mode, char* smem, int gw, int ngw, int& base) {
    const int lane = tid_x() & 63, wave = tid_x() >> 6;
    float* scr = (float*)smem + wave * (64 * 33);
    const int nkb = K / 64, nnb = Npad / 32, nitems = nkb * nnb;
    int first = ((gw - base) % ngw + ngw) % ngw;
    for (int it = first; it < nitems; it += ngw) {
        const int kb = it / nnb, nb = it % nnb;
        transpose_item(W, N, N, kb * 64, nb * 32, WT, K, mode, scr, lane);
    }
    base = (base + nitems) % ngw;
}

DI void phase0(const Params& p, char* smem) {
    const int tid = tid_x(), lane = tid & 63, wave = tid >> 6;
    if (blockIdx.x == 0 && tid < NEXP) ((int*)(p.ws + WS_CNT))[tid] = 0;
    if (blockIdx.x == 0 && tid == 0) *(unsigned*)(p.ws + WS_BAR) = 0u;
    float* sil = (float*)smem;
    float* red = sil + NV * D;
    const int nitems = 6 * D / 32;
    bool did = false;
    for (int it = blockIdx.x; it < nitems; it += gridDim.x) {
        if (!did) {
            for (int i = tid; i < NV * D; i += NTHREADS) { const int v = i / D, k = i % D; const float cv = v < NB ? p.in[I_C][v * D + k] : p.in[I_CCTX][k]; sil[i] = siluf_(cv); }
            did = true;
        }
        __syncthreads();
        const int col = it * 32 + (lane & 31), rp = lane >> 5;
        float acc[NV];
#pragma unroll
        for (int v = 0; v < NV; ++v) acc[v] = 0.f;
        const int r0 = wave * (D / 8);
#pragma unroll 8
        for (int i = 0; i < D / 16; ++i) {
            const int row = r0 + 2 * i + rp; const float w = p.in[I_ADAW][(size_t)row * (6 * D) + col];
#pragma unroll
            for (int v = 0; v < NV; ++v) acc[v] += sil[v * D + row] * w;
        }
#pragma unroll
        for (int v = 0; v < NV; ++v) red[((wave * 2 + rp) * NV + v) * 32 + (lane & 31)] = acc[v];
        __syncthreads();
        if (tid < NV * 32) {
            const int v = tid / 32, cl = tid % 32; float s = p.in[I_ADAB][it * 32 + cl];
            for (int g = 0; g < 16; ++g) s += red[(g * NV + v) * 32 + cl];
            ((float*)(p.ws + WS_MOD))[(size_t)v * 6 * D + it * 32 + cl] = s;
        }
    }
    __syncthreads();
    const int gw = blockIdx.x * 8 + wave, ngw = gridDim.x * 8; int base = 0;
    {
        float* scr = (float*)smem + wave * (64 * 33);
        const int nkb = D / 64, nnb = NP / 32, nitems2 = nkb * nnb;
        for (int it = gw; it < nitems2; it += ngw) { const int kb = it / nnb, nb = it % nnb; transpose_item(p.in[I_WIN], IN_COLS, IN_COLS, kb * 64, nb * 32, (bf16_t*)(p.aux + AUX_WINT), D, 0, scr, lane); }
        base = nitems2 % ngw;
    }
    { float* WRT = (float*)(p.ws + WS_WRT);
      for (int i = blockIdx.x * NTHREADS + tid; i < 36 * D; i += gridDim.x * NTHREADS) { const int j = i / D, k = i % D; WRT[i] = j < 4 ? p.in[I_RG][(size_t)k * 4 + j] : p.in[I_RE][(size_t)k * 32 + (j - 4)]; } }
    transpose_matrix(p.in[I_WOA], 512, D, D, (bf16_t*)(p.ws + WS_WOA), 0, smem, gw, ngw, base);
    transpose_matrix(p.in[I_WOB], 512, D, D, (bf16_t*)(p.ws + WS_WOB), 0, smem, gw, ngw, base);
    transpose_matrix(p.in[I_WOUT], D, D, D, (bf16_t*)(p.ws + WS_WOUT), 0, smem, gw, ngw, base);
    transpose_matrix(p.in[I_G2], 128, 512, 512, (bf16_t*)(p.ws + WS_G2T), 0, smem, gw, ngw, base);
}

DI void phase1(const Params& p, char* smem) {
    const int lane = tid_x() & 63, wave = tid_x() >> 6;
    const int gw = blockIdx.x * 8 + wave, ngw = gridDim.x * 8;
    const float* mod = (const float*)(p.ws + WS_MOD);
    bf16_t* U = (bf16_t*)(p.aux + AUX_U);
    for (int r = gw; r < T_ALL; r += ngw) {
        const float* src; int v;
        if (r < T_CTX) { src = p.in[I_CTX] + (size_t)r * D; v = NB; } else { src = p.in[I_X] + (size_t)(r - T_CTX) * D; v = (r - T_CTX) / S; }
        f32x4 x[D / 256]; float ss = 0.f;
#pragma unroll
        for (int j = 0; j < D / 256; ++j) { x[j] = *(const f32x4*)(src + j * 256 + lane * 4); ss += x[j].x * x[j].x + x[j].y * x[j].y + x[j].z * x[j].z + x[j].w * x[j].w; }
        ss = wave_sum(ss);
        const float rstd = 1.0f / sqrtf(ss * (1.0f / D) + 1e-6f);
#pragma unroll
        for (int j = 0; j < D / 256; ++j) {
            const int k = j * 256 + lane * 4;
            const f32x4 g = *(const f32x4*)(p.in[I_NMIX] + k), sh = *(const f32x4*)(mod + (size_t)v * 6 * D + k), sc = *(const f32x4*)(mod + (size_t)v * 6 * D + D + k);
            float o0 = x[j].x * rstd * g.x * (1.f + sc.x) + sh.x, o1 = x[j].y * rstd * g.y * (1.f + sc.y) + sh.y;
            float o2 = x[j].z * rstd * g.z * (1.f + sc.z) + sh.z, o3 = x[j].w * rstd * g.w * (1.f + sc.w) + sh.w;
            u32x2 o; o.x = pk2(o0, o1); o.y = pk2(o2, o3);
            *(u32x2*)(U + (size_t)r * D + k) = o;
        }
    }
}

DI void phase2(const Params& p, char* smem) {
    const bf16_t* U = (const bf16_t*)(p.aux + AUX_U); const bf16_t* WT = (const bf16_t*)(p.aux + AUX_WINT);
    bf16_t* PL = (bf16_t*)(p.ws + WS_PLAT); bf16_t* PC = (bf16_t*)(p.ws + WS_PCTX); float* AB = (float*)(p.ws + WS_AB);
    if (USE_G8) {
        constexpr int NT = NP / 256, MT = T_ALL / 256, NT_CTX = (CTX_COLS + 255) / 256;
        for (int t = blockIdx.x; t < MT * NT; t += gridDim.x) {
            const int mt = t / NT, nt = t % NT, brow = mt * 256, bcol = nt * 256; const bool isctx = brow < T_CTX;
            if (isctx && nt >= NT_CTX) continue;
            g8::Acc acc; g8::acc_zero(acc);
            g8::kloop(acc, smem, U, D, WT, D, D, brow, bcol);
            g8::for_each_quad(acc, brow, bcol, [&](int row, int col, const f32x4& v) {
                u32x2 o; o.x = pk2(v.x, v.y); o.y = pk2(v.z, v.w);
                if (isctx) { if (col < CTX_COLS) *(u32x2*)(PC + (size_t)row * CTX_COLS + col) = o; }
                else { if (col < IN_COLS) *(u32x2*)(PL + (size_t)(row - T_CTX) * IN_COLS + col) = o; }
                if (col >= 2048 && col < 2064) *(f32x4*)(AB + (size_t)row * 16 + (col - 2048)) = v;
            });
        }
        return;
    }
    const int tid = tid_x(), lane = tid & 63, wave = tid >> 6, wr = wave >> 1, wc = wave & 1, fr = lane & 15, fq = lane >> 4;
    constexpr int NT = NP / 128, MT = T_ALL / BM, NT_CTX = (CTX_COLS + 127) / 128;
    for (int t = blockIdx.x; t < MT * NT; t += gridDim.x) {
        const int mt = t / NT, nt = t % NT; const int row0 = mt * BM; const bool isctx = row0 < T_CTX;
        if (isctx && nt >= NT_CTX) continue;
        f32x4 acc[MREP][4]; acc_zero(acc);
        gemm_kloop(acc, smem, [&](int i) { return U + (size_t)(row0 + i) * D; }, WT + (size_t)nt * 128 * D, D, D);
#pragma unroll
        for (int m = 0; m < MREP; ++m)
#pragma unroll
            for (int n = 0; n < 4; ++n)
#pragma unroll
                for (int j = 0; j < 4; ++j) {
                    const int row = row0 + wr * 16 * MREP + m * 16 + fq * 4 + j, col = nt * 128 + wc * 64 + n * 16 + fr; const float v = acc[m][n][j];
                    if (isctx) { if (col < CTX_COLS) PC[(size_t)row * CTX_COLS + col] = f2bf(v); }
                    else { if (col < IN_COLS) PL[(size_t)(row - T_CTX) * IN_COLS + col] = f2bf(v); }
                    if (col >= 2048 && col < 2064) AB[(size_t)row * 16 + (col - 2048)] = v;
                }
    }
}

typedef float f32x16 __attribute__((ext_vector_type(16)));
typedef float f32x2_ac __attribute__((ext_vector_type(2)));
typedef short bf16x4 __attribute__((ext_vector_type(4)));
#ifdef EMU
#define MFMA32(a, b, c) emu_mfma32((a), (b), (c))
DI float fexp(float x) { return expf(x); }
DI float flog(float x) { return logf(x); }
DI float frcp(float x) { return 1.0f / x; }
DI float frsq(float x) { return 1.0f / sqrtf(x); }
DI float wave_sum_fast(float v) { return wave_sum(v); }
#else
#define MFMA32(a, b, c) __builtin_amdgcn_mfma_f32_32x32x16_bf16((a), (b), (c), 0, 0, 0)
DI float fexp(float x) { return __expf(x); }
DI float flog(float x) { return __logf(x); }
DI float frcp(float x) { return __builtin_amdgcn_rcpf(x); }
DI float frsq(float x) { return __builtin_amdgcn_rsqf(x); }
#define DPP_ADD(v, ctrl) ((v) + __builtin_bit_cast(float, __builtin_amdgcn_update_dpp(0, __builtin_bit_cast(int, (v)), (ctrl), 0xf, 0xf, false)))
DI float wave_sum_fast(float v) {
    v = DPP_ADD(v, 0xB1); v = DPP_ADD(v, 0x4E); v = DPP_ADD(v, 0x141); v = DPP_ADD(v, 0x140);
    const int iv = __builtin_bit_cast(int, v);
    return (__builtin_bit_cast(float, __builtin_amdgcn_readlane(iv, 0)) + __builtin_bit_cast(float, __builtin_amdgcn_readlane(iv, 16))) +
           (__builtin_bit_cast(float, __builtin_amdgcn_readlane(iv, 32)) + __builtin_bit_cast(float, __builtin_amdgcn_readlane(iv, 48)));
}
#endif
DI float fsigmoid(float x) { return frcp(1.0f + fexp(-x)); }
DI float fsilu(float x) { return x * fsigmoid(x); }
DI float fsoftplus(float x) { return fmaxf(x, 0.f) + flog(1.f + fexp(-fabsf(x))); }
DI float ftanh(float x) { return 1.0f - 2.0f * frcp(1.0f + fexp(2.0f * x)); }

DI int crow(int g, int h) { return (g & 3) + 8 * (g >> 2) + 4 * h; }
template <int S_> DI bf16x8 pack_acc(const f32x16& x) {
    u32x4 r;
    r.x = pk2(x[8 * S_ + 0], x[8 * S_ + 1]); r.y = pk2(x[8 * S_ + 2], x[8 * S_ + 3]); r.z = pk2(x[8 * S_ + 4], x[8 * S_ + 5]); r.w = pk2(x[8 * S_ + 6], x[8 * S_ + 7]);
    return __builtin_bit_cast(bf16x8, r);
}
DI bf16x8 ld_nat(const bf16_t* row, int s, int h) { return *(const bf16x8*)(row + 16 * s + 8 * h); }
DI bf16x8 ld_perm(const bf16_t* row, int s, int h) {
    const bf16x4 lo = *(const bf16x4*)(row + 16 * s + 4 * h), hi = *(const bf16x4*)(row + 16 * s + 8 + 4 * h);
    return __builtin_shufflevector(lo, hi, 0, 1, 2, 3, 4, 5, 6, 7);
}
DI f32x16 zero16() { f32x16 z;
#pragma unroll
    for (int i = 0; i < 16; ++i) z[i] = 0.f;
    return z; }
#define TGET(i) ((i) < 16 ? t0[(i) & 15] : t1[(i) & 15])
DI void invert32_col(const float* Lf, f32x16& t0, f32x16& t1, int c) {
#pragma unroll
    for (int i = 0; i < 32; ++i) {
        float s0 = 0.f, s1 = 0.f, s2 = 0.f, s3 = 0.f;
#pragma unroll
        for (int j4 = 0; j4 < (i + 3) / 4; ++j4) {
            const f32x4 l = *(const f32x4*)(Lf + i * 32 + 4 * j4);
            if (4 * j4 + 0 < i) s0 += l.x * TGET(4 * j4 + 0);
            if (4 * j4 + 1 < i) s1 += l.y * TGET(4 * j4 + 1);
            if (4 * j4 + 2 < i) s2 += l.z * TGET(4 * j4 + 2);
            if (4 * j4 + 3 < i) s3 += l.w * TGET(4 * j4 + 3);
        }
        float sm = -((s0 + s1) + (s2 + s3));
#ifndef EMU
        asm volatile("" : "+v"(sm));
#endif
        const float v = (i > c) ? sm : (i == c ? 1.f : 0.f);
        if (i < 16) t0[i & 15] = v; else t1[i & 15] = v;
    }
}

constexpr int NSEG = T_ALL / 64, NSEG_CTX = T_CTX / 64;
DI void seg_info(int g, int& seq, int& b, int& j0) {
    if (g < NSEG_CTX) { seq = 0; b = g / (CTXL / 64); j0 = (g % (CTXL / 64)) * 64; } else { const int g2 = g - NSEG_CTX; seq = 1; b = g2 / (S / 64); j0 = (g2 % (S / 64)) * 64; }
}
DI const bf16_t* seq_row(const Params& p, int seq, int b, int j, bool scan_order) {
    if (seq) { const int l = scan_order ? (j % ROWS) * GW + j / ROWS : j; return (const bf16_t*)(p.ws + WS_PLAT) + (size_t)(b * S + l) * IN_COLS; }
    return (const bf16_t*)(p.ws + WS_PCTX) + (size_t)(b * CTXL + j) * CTX_COLS;
}
DI void phase_halo(const Params& p, char* smem) {
    const int tid = tid_x(), lane = tid & 63, wave = tid >> 6;
    const int gw = blockIdx.x * 8 + wave, ngw = gridDim.x * 8;
    bf16_t* HA = (bf16_t*)(p.ws + WS_HALO_A); bf16_t* HB = (bf16_t*)(p.ws + WS_HALO_B);
    for (int it = gw; it < NSEG * 6; it += ngw) {
        const int g = it / 6, hr = it % 6; int seq, b, j0; seg_info(g, seq, b, j0);
        const int L = seq ? S : CTXL;
        if (hr < 4) {
            const int j = hr < 2 ? j0 - 2 + hr : j0 + 62 + hr; const bool ok = j >= 0 && j < L;
            const bf16_t* src = seq_row(p, seq, b, ok ? j : 0, false);
            for (int c = lane; c < 192; c += 64) { u32x4 v = {0u, 0u, 0u, 0u}; if (ok) v = *(const u32x4*)(src + c * 8); *(u32x4*)(HA + ((size_t)g * 4 + hr) * 1536 + c * 8) = v; }
        } else {
            const int j = hr == 4 ? j0 - 1 : j0 + 64; const bool ok = j >= 0 && j < L;
            const bf16_t* src = seq_row(p, seq, b, ok ? j : 0, true) + COL_B0;
            for (int c = lane; c < 240; c += 64) { u32x4 v = {0u, 0u, 0u, 0u}; if (ok) v = *(const u32x4*)(src + c * 8); *(u32x4*)(HB + ((size_t)g * 2 + (hr - 4)) * 1920 + c * 8) = v; }
        }
    }
}
DI f32x2_ac unpk2(unsigned w) { return (f32x2_ac){bf2f((bf16_t)(w & 0xffffu)), bf2f((bf16_t)(w >> 16))}; }
DI void phase_fir(const Params& p, char* smem) {
    const int tid = tid_x(), lane = tid & 63, wave = tid >> 6;
    const int gw = blockIdx.x * 8 + wave, ngw = gridDim.x * 8;
    const bf16_t* HA = (const bf16_t*)(p.ws + WS_HALO_A); const bf16_t* HB = (const bf16_t*)(p.ws + WS_HALO_B);
    constexpr int NA = NSEG * 12, NBI = NSEG * 15;
    for (int it = gw; it < NA + NBI; it += ngw) {
        if (it < NA) {
            const int g = it / 12, sh = it % 12, s = sh >> 2, h = sh & 3; int seq, b, j0; seg_info(g, seq, b, j0);
            const int col = s * 512 + h * 128 + 2 * lane;
            const int ldp = seq ? IN_COLS : CTX_COLS;
            bf16_t* base = (bf16_t*)seq_row(p, seq, b, j0, false) + col;
            const bf16_t* hal = HA + (size_t)g * 4 * 1536 + col;
            f32x2_ac cw[5];
#pragma unroll
            for (int t = 0; t < 5; ++t) cw[t] = (f32x2_ac){p.in[I_CONV][t * 1536 + col], p.in[I_CONV][t * 1536 + col + 1]};
            unsigned win[20], nxt[16];
            win[0] = *(const unsigned*)(hal); win[1] = *(const unsigned*)(hal + 1536);
            win[2] = *(const unsigned*)(base); win[3] = *(const unsigned*)(base + ldp);
#pragma unroll
            for (int i = 0; i < 16; ++i) win[4 + i] = *(const unsigned*)(base + (size_t)(2 + i) * ldp);
#pragma unroll 1
            for (int blk = 0; blk < 4; ++blk) {
                if (blk < 3) {
#pragma unroll
                    for (int i = 0; i < 16; ++i) { const int t = 16 * blk + 18 + i; nxt[i] = t < 64 ? *(const unsigned*)(base + (size_t)t * ldp) : *(const unsigned*)(hal + (size_t)(2 + (t - 64)) * 1536); }
                }
#pragma unroll
                for (int i = 0; i < 16; ++i) {
                    f32x2_ac a = unpk2(win[i]) * cw[0];
#pragma unroll
                    for (int t = 1; t < 5; ++t) a += unpk2(win[i + t]) * cw[t];
                    float o0 = fsilu(a.x), o1 = fsilu(a.y);
                    if (s < 2) { const float sc = frsq(wave_sum_fast(o0 * o0 + o1 * o1) + 1e-6f) * (s == 0 ? 0.08838834764831845f : 1.0f); o0 *= sc; o1 *= sc; }
                    *(unsigned*)(base + (size_t)(16 * blk + i) * ldp) = pk2(o0, o1);
                }
#pragma unroll
                for (int i = 0; i < 4; ++i) win[i] = win[16 + i];
#pragma unroll
                for (int i = 0; i < 16; ++i) win[4 + i] = nxt[i];
            }
        } else {
            const int it2 = it - NA, g = it2 / 15, sl = it2 % 15; int seq, b, j0; seg_info(g, seq, b, j0);
            const int bcol = sl * 128 + 2 * lane, col = COL_B0 + bcol;
            const f32x2_ac mu2 = {p.in[I_MU][bcol], p.in[I_MU][bcol + 1]};
            const bf16_t* hal = HB + (size_t)g * 2 * 1920 + bcol;
            unsigned win[18], nxt[16];
            win[0] = *(const unsigned*)(hal); win[1] = *(const unsigned*)(seq_row(p, seq, b, j0, true) + col);
#pragma unroll
            for (int i = 0; i < 16; ++i) win[2 + i] = *(const unsigned*)(seq_row(p, seq, b, j0 + 1 + i, true) + col);
#pragma unroll 1
            for (int blk = 0; blk < 4; ++blk) {
                if (blk < 3) {
#pragma unroll
                    for (int i = 0; i < 16; ++i) { const int t = 16 * blk + 17 + i; nxt[i] = t < 64 ? *(const unsigned*)(seq_row(p, seq, b, j0 + t, true) + col) : *(const unsigned*)(hal + 1920); }
                }
#pragma unroll
                for (int i = 0; i < 16; ++i) {
                    const f32x2_ac cu = unpk2(win[i + 1]);
                    f32x2_ac x = cu + ((unpk2(win[i]) + unpk2(win[i + 2])) * 0.5f - cu) * mu2;
                    if (sl == 12) { x.x = ftanh(x.x); x.y = ftanh(x.y); }
                    *(unsigned*)((bf16_t*)seq_row(p, seq, b, j0 + 16 * blk + i, true) + col) = pk2(x.x, x.y);
                }
                win[0] = win[16]; win[1] = win[17];
#pragma unroll
                for (int i = 0; i < 16; ++i) win[2 + i] = nxt[i];
            }
        }
    }
}

constexpr int GC = 32;
constexpr int G_NT = (CTXL + S) / GC;
constexpr int LD128 = 136, LD64 = 72, LD32 = 40;
DI void chunk_pos(int x, int d, int& seg, int& j0) {
    constexpr int n0 = CTXL / GC, n1 = S / GC;
    if (x < n0) { seg = 0; j0 = (d ? n0 - 1 - x : x) * GC; } else { seg = 1; const int xx = x - n0; j0 = (d ? n1 - 1 - xx : xx) * GC; }
}

DI f32x16 invert32_blocked(const float* Lf, bf16_t* scr, int lane) {
    bf16_t* TD = scr; bf16_t* TDT = scr + 32 * LD32; bf16_t* LO = scr + 2 * 32 * LD32; bf16_t* P1T = scr + 3 * 32 * LD32;
    const int blk = lane >> 5, c = lane & 15, r = lane & 31, h = lane >> 5;
    f32x16 t;
    const float* Lb = Lf + (16 * blk) * 32 + 16 * blk;
#pragma unroll
    for (int i = 0; i < 16; ++i) {
        float s0 = 0.f, s1 = 0.f, s2 = 0.f, s3 = 0.f;
#pragma unroll
        for (int j4 = 0; j4 < (i + 3) / 4; ++j4) {
            const f32x4 l = *(const f32x4*)(Lb + i * 32 + 4 * j4);
            if (4 * j4 + 0 < i) s0 += l.x * t[4 * j4 + 0];
            if (4 * j4 + 1 < i) s1 += l.y * t[4 * j4 + 1];
            if (4 * j4 + 2 < i) s2 += l.z * t[4 * j4 + 2];
            if (4 * j4 + 3 < i) s3 += l.w * t[4 * j4 + 3];
        }
        float sm = -((s0 + s1) + (s2 + s3));
#ifndef EMU
        asm volatile("" : "+v"(sm));
#endif
        t[i] = (i > c) ? sm : (i == c ? 1.f : 0.f);
    }
    if (r < 16) {
#pragma unroll
        for (int i = 0; i < 16; ++i) { TD[(16 * blk + i) * LD32 + 16 * blk + c] = f2bf(t[i]); TD[(16 * blk + i) * LD32 + 16 * (1 - blk) + c] = 0; }
#pragma unroll
        for (int q = 0; q < 4; ++q) {
            u32x2 o; o.x = pk2(t[4 * q], t[4 * q + 1]); o.y = pk2(t[4 * q + 2], t[4 * q + 3]);
            *(u32x2*)(TDT + (16 * blk + c) * LD32 + 16 * blk + 4 * q) = o;
            *(u32x2*)(TDT + (16 * blk + c) * LD32 + 16 * (1 - blk) + 4 * q) = (u32x2){0u, 0u};
        }
    }
    {
        const int row = lane >> 1, half = lane & 1;
#pragma unroll
        for (int q = 0; q < 4; ++q) {
            u32x2 o = {0u, 0u};
            if (row >= 16 && half == 0) { const f32x4 l = *(const f32x4*)(Lf + row * 32 + 4 * q); o.x = pk2(l.x, l.y); o.y = pk2(l.z, l.w); }
            *(u32x2*)(LO + row * LD32 + 16 * half + 4 * q) = o;
        }
    }
    WAVE_SYNC();
    f32x16 p1 = zero16();
#pragma unroll
    for (int s = 0; s < 2; ++s) p1 = MFMA32(ld_nat(LO + r * LD32, s, h), ld_nat(TDT + r * LD32, s, h), p1);
#pragma unroll
    for (int q = 0; q < 4; ++q) { u32x2 o; o.x = pk2(p1[4 * q], p1[4 * q + 1]); o.y = pk2(p1[4 * q + 2], p1[4 * q + 3]); *(u32x2*)(P1T + r * LD32 + 8 * q + 4 * h) = o; }
    WAVE_SYNC();
    f32x16 p2 = zero16();
#pragma unroll
    for (int s = 0; s < 2; ++s) p2 = MFMA32(ld_nat(TD + r * LD32, s, h), ld_nat(P1T + r * LD32, s, h), p2);
    f32x16 tf;
#pragma unroll
    for (int g = 0; g < 16; ++g) tf[g] = bf2f(TD[crow(g, h) * LD32 + r]) - p2[g];
    return tf;
}
constexpr int GL_Q = 0;
constexpr int GL_KT = GL_Q + 2 * 32 * LD128 * 2;
constexpr int GL_VT = GL_KT + 2 * 128 * LD32 * 2;
constexpr int GL_K = GL_VT + 2 * 128 * LD32 * 2;
constexpr int GL_QKM = GL_K + 32 * LD128 * 2;
constexpr int GL_LF = GL_QKM + 2 * 32 * LD32 * 2;
constexpr int GL_TP = GL_LF + 32 * 32 * 4;
constexpr int GL_TPP = GL_TP + 32 * LD32 * 2;
constexpr int GL_WN = GL_TPP + 2 * 32 * LD32 * 2;
constexpr int GL_SC = GL_WN + 32 * LD128 * 2;
constexpr int GL_GC = GL_SC + 2 * 8 * 32 * 4;
constexpr int GL_CW = GL_GC + 8 * 32 * 4;
constexpr int GL_INV = GL_CW + 5 * 3 * 128 * 4;
constexpr int GL_RAW = GL_INV + 4 * 32 * LD32 * 2;
constexpr int GL_END = GL_RAW + 32 * 384 * 2;
static_assert(GL_END <= LDS_BYTES, "gdn lds");

DI void gdn_chain2(const Params& p, char* smem, int item) {
    const int d = item / (NB * H_A), b = (item / H_A) % NB, h = item % H_A;
    const int tid = tid_x(), lane = tid & 63, wave0_ = tid >> 6;
    bf16_t* Qs = (bf16_t*)(smem + GL_Q); bf16_t* KTs = (bf16_t*)(smem + GL_KT); bf16_t* VTs = (bf16_t*)(smem + GL_VT); bf16_t* Ks = (bf16_t*)(smem + GL_K);
    bf16_t* QKMs = (bf16_t*)(smem + GL_QKM); float* Lf = (float*)(smem + GL_LF); bf16_t* Tp = (bf16_t*)(smem + GL_TP); bf16_t* Tpp = (bf16_t*)(smem + GL_TPP);
    bf16_t* Wn = (bf16_t*)(smem + GL_WN); float* SC = (float*)(smem + GL_SC); float* GCs = (float*)(smem + GL_GC); float* CW = (float*)(smem + GL_CW);
    const float alog = p.in[I_ALOG][d * 4 + h], dtb = p.in[I_DTB][d * 4 + h], negea = -expf(alog);
    bf16_t* ODIR = (bf16_t*)(p.aux + AUX_ODIR);
    __syncthreads();
    f32x16 St[4];
#pragma unroll
    for (int ct = 0; ct < 4; ++ct) St[ct] = zero16();
    bf16_t* RAW = (bf16_t*)(smem + GL_RAW);
    float pa = 0.f, pbt = 0.f;
    auto prefetch = [&](int x, int wsel, int nw) {
        int seg, j0; chunk_pos(x, d, seg, j0);
        const int ldp = seg ? IN_COLS : CTX_COLS;
        const bf16_t* pbase = seg ? (const bf16_t*)(p.ws + WS_PLAT) + (size_t)b * S * IN_COLS : (const bf16_t*)(p.ws + WS_PCTX) + (size_t)b * CTXL * CTX_COLS;
        for (int inst = wsel; inst < 24; inst += nw) {
            const int q = inst * 64 + lane, row = q / 48, c16 = q % 48;
            const bf16_t* src = pbase + (size_t)(j0 + row) * ldp + (c16 >> 4) * 512 + h * 128 + (c16 & 15) * 8;
#ifdef EMU
            emu_global_load_lds16(src, (char*)RAW + q * 16);
#else
            __builtin_amdgcn_global_load_lds((const unsigned*)src, (__attribute__((address_space(3))) unsigned*)((char*)RAW + q * 16), 16, 0, 0);
#endif
        }
    };
    auto prefetch_ab = [&](int x) {
        int seg, j0; chunk_pos(x, d, seg, j0);
        const float* abbase = (const float*)(p.ws + WS_AB) + (size_t)(seg ? T_CTX + b * S : b * CTXL) * 16;
        const int jw = j0 + 4 * wave0_;
        if (lane < 4) { pa = abbase[(size_t)(jw + lane) * 16 + d * 4 + h]; pbt = abbase[(size_t)(jw + lane) * 16 + 8 + d * 4 + h]; }
    };
    prefetch(0, wave0_, 8); prefetch_ab(0);
#ifndef EMU
    asm volatile("s_waitcnt vmcnt(0)" ::: "memory");
#endif
    const int r0_ = lane & 31, hh0_ = lane >> 5;
    __syncthreads();
    for (int it = -1; it < G_NT; ++it) {
        int r = r0_, hh = hh0_, wave = wave0_;
#ifndef EMU
        asm volatile("" : "+v"(r), "+v"(hh), "+v"(wave));
#endif
        const int xn = it + 1, par = xn & 1;
        int segn = 0, j0n = 0; if (xn < G_NT) chunk_pos(xn, d, segn, j0n);
        if (xn < G_NT) {
            const int i0 = d ? (GC - 4 - 4 * wave) : 4 * wave;
            bf16_t kt[2][4], vt[2][4];
#pragma unroll
            for (int t = 0; t < 4; ++t) {
                const int e = d ? 3 - t : t, i = i0 + e;
                const unsigned wq = *(const unsigned*)(RAW + (4 * wave + t) * 384 + 2 * lane), wk = *(const unsigned*)(RAW + (4 * wave + t) * 384 + 128 + 2 * lane), wv = *(const unsigned*)(RAW + (4 * wave + t) * 384 + 256 + 2 * lane);
                *(unsigned*)(Qs + (par * 32 + i) * LD128 + 2 * lane) = wq;
                *(unsigned*)(Ks + i * LD128 + 2 * lane) = wk;
                kt[0][e] = (bf16_t)(wk & 0xffffu); kt[1][e] = (bf16_t)(wk >> 16); vt[0][e] = (bf16_t)(wv & 0xffffu); vt[1][e] = (bf16_t)(wv >> 16);
            }
#pragma unroll
            for (int q = 0; q < 2; ++q) {
                u32x2 o; o.x = (unsigned)kt[q][0] | ((unsigned)kt[q][1] << 16); o.y = (unsigned)kt[q][2] | ((unsigned)kt[q][3] << 16);
                *(u32x2*)(KTs + (par * 128 + 2 * lane + q) * LD32 + i0) = o;
                u32x2 o2; o2.x = (unsigned)vt[q][0] | ((unsigned)vt[q][1] << 16); o2.y = (unsigned)vt[q][2] | ((unsigned)vt[q][3] << 16);
                *(u32x2*)(VTs + (par * 128 + 2 * lane + q) * LD32 + i0) = o2;
            }
            if (lane < 4) { const int i = d ? (GC - 1 - 4 * wave - lane) : (4 * wave + lane);
                SC[(par * 8 + 0) * 32 + i] = negea * fsoftplus(pa + dtb); SC[(par * 8 + 1) * 32 + i] = fsigmoid(pbt); }
            if (xn + 1 < G_NT) prefetch_ab(xn + 1);
        }
        LDS_BARRIER();
        if (wave >= 4 && wave < 7 && xn + 1 < G_NT) {
            prefetch(xn + 1, wave - 4, 3);
#ifndef EMU
            asm volatile("s_waitcnt vmcnt(0)" ::: "memory");
#endif
        }
        if (xn < G_NT) {
            const float* graw = SC + (par * 8 + 0) * 32;
            float gcv = 0.f;
#pragma unroll
            for (int s4 = 0; s4 < 8; ++s4) { const f32x4 g4 = *(const f32x4*)(graw + 4 * s4);
                gcv += (4 * s4 + 0 <= r ? g4.x : 0.f) + (4 * s4 + 1 <= r ? g4.y : 0.f) + (4 * s4 + 2 <= r ? g4.z : 0.f) + (4 * s4 + 3 <= r ? g4.w : 0.f); }
            if (lane < 32) GCs[wave * 32 + r] = gcv;
            if (wave == 7 && lane < 32) {
                float gl = 0.f;
#pragma unroll
                for (int s4 = 0; s4 < 8; ++s4) { const f32x4 g4 = *(const f32x4*)(graw + 4 * s4); gl += (g4.x + g4.y) + (g4.z + g4.w); }
                const float be = SC[(par * 8 + 1) * 32 + r];
                SC[(par * 8 + 3) * 32 + r] = fexp(gcv); SC[(par * 8 + 4) * 32 + r] = fexp(gl - gcv); SC[(par * 8 + 5) * 32 + r] = be * fexp(gcv); SC[(par * 8 + 6) * 32 + r] = fexp(gl);
            }
            const int pr = wave >> 2, th = (wave >> 1) & 1, ch = wave & 1, fr = lane & 15, fq = lane >> 4;
            const bf16_t* arow = (pr == 0 ? Ks : Qs + par * 32 * LD128) + (16 * th + fr) * LD128 + 8 * fq; const bf16_t* brow = Ks + (16 * ch + fr) * LD128 + 8 * fq;
            f32x4 cc = {0.f, 0.f, 0.f, 0.f};
#pragma unroll
            for (int ks = 0; ks < 4; ++ks) cc = MFMA16(*(const bf16x8*)(arow + 32 * ks), *(const bf16x8*)(brow + 32 * ks), cc);
            WAVE_SYNC();
            const int jj = 16 * ch + fr; const float gj = GCs[wave * 32 + jj];
#pragma unroll
            for (int j = 0; j < 4; ++j) {
                const int i = 16 * th + 4 * fq + j; const float dec = fexp(GCs[wave * 32 + i] - gj);
                if (pr == 0) Lf[i * 32 + jj] = (jj < i) ? SC[(par * 8 + 1) * 32 + i] * cc[j] * dec : 0.f;
                else QKMs[(par * 32 + i) * LD32 + jj] = f2bf((jj <= i) ? cc[j] * dec : 0.f);
            }
        }
        LDS_BARRIER();
        if (wave == 7 && xn < G_NT) {
            const f32x16 tf = invert32_blocked(Lf, (bf16_t*)(smem + GL_INV), lane);
            const int c = r; const float b1 = SC[(par * 8 + 5) * 32 + c], b0 = SC[(par * 8 + 1) * 32 + c];
#pragma unroll
            for (int g = 0; g < 16; ++g) { const int i = crow(g, hh); Tp[i * LD32 + c] = f2bf(tf[g] * b1); Tpp[(par * 32 + i) * LD32 + c] = f2bf(tf[g] * b0); }
        }
        if (wave < 4 && it >= 0) {
            const int pc = it & 1; int seg = 0, j0 = 0; chunk_pos(it, d, seg, j0);
            const bf16_t* Qc = Qs + pc * 32 * LD128; const bf16_t* KTc = KTs + pc * 128 * LD32; const bf16_t* VTc = VTs + pc * 128 * LD32;
            const bf16_t* QKc = QKMs + pc * 32 * LD32; const bf16_t* Tc = Tpp + pc * 32 * LD32; const float* sc = SC + pc * 8 * 32;
            f32x16 vn = zero16();
#pragma unroll
            for (int s = 0; s < 2; ++s) vn = MFMA32(ld_nat(Tc + r * LD32, s, hh), ld_nat(VTc + (32 * wave + r) * LD32, s, hh), vn);
            f32x16 oacc = zero16();
#define GDN_KSTEP(s) { const bf16x8 sb = pack_acc<(s) & 1>(St[(s) >> 1]); vn = MFMA32(ld_perm(Wn + r * LD128, (s), hh), sb, vn); oacc = MFMA32(ld_perm(Qc + r * LD128, (s), hh), sb, oacc); }
            GDN_KSTEP(0) GDN_KSTEP(1) GDN_KSTEP(2) GDN_KSTEP(3) GDN_KSTEP(4) GDN_KSTEP(5) GDN_KSTEP(6) GDN_KSTEP(7)
#undef GDN_KSTEP
#pragma unroll
            for (int g = 0; g < 16; ++g) oacc[g] *= sc[3 * 32 + crow(g, hh)];
            { const bf16x8 v0 = pack_acc<0>(vn), v1 = pack_acc<1>(vn);
              oacc = MFMA32(ld_perm(QKc + r * LD32, 0, hh), v0, oacc); oacc = MFMA32(ld_perm(QKc + r * LD32, 1, hh), v1, oacc); }
#pragma unroll
            for (int g = 0; g < 16; ++g) vn[g] *= sc[4 * 32 + crow(g, hh)];
            const float ge = sc[6 * 32];
            { const bf16x8 v0 = pack_acc<0>(vn), v1 = pack_acc<1>(vn);
#pragma unroll
              for (int ct = 0; ct < 4; ++ct) {
#pragma unroll
                  for (int g = 0; g < 16; ++g) St[ct][g] *= ge;
                  St[ct] = MFMA32(ld_perm(KTc + (32 * ct + r) * LD32, 0, hh), v0, St[ct]);
                  St[ct] = MFMA32(ld_perm(KTc + (32 * ct + r) * LD32, 1, hh), v1, St[ct]);
              } }
            if (seg) {
#pragma unroll
                for (int g = 0; g < 16; ++g) {
                    const int i = crow(g, hh), j = d ? j0 + GC - 1 - i : j0 + i;
                    ODIR[((size_t)d * T_LAT + (size_t)b * S + j) * 512 + h * 128 + 32 * wave + r] = f2bf(oacc[g]);
                }
            }
        }
        LDS_BARRIER();
        if (xn < G_NT && wave < 4) {
            f32x16 acc = zero16();
#pragma unroll
            for (int s = 0; s < 2; ++s) acc = MFMA32(ld_nat(KTs + (par * 128 + 32 * wave + r) * LD32, s, hh), ld_nat(Tp + r * LD32, s, hh), acc);
#pragma unroll
            for (int q = 0; q < 4; ++q) {
                u32x2 o; o.x = pk2(-acc[4 * q], -acc[4 * q + 1]); o.y = pk2(-acc[4 * q + 2], -acc[4 * q + 3]);
                *(u32x2*)(Wn + r * LD128 + 32 * wave + 8 * q + 4 * hh) = o;
            }
        }
        LDS_BARRIER();
    }
}

constexpr int RL_RX = 0;
constexpr int RL_KX = RL_RX + 32 * 64 * 4;
constexpr int RL_VX = RL_KX + 32 * 64 * 4;
constexpr int RL_KK = RL_VX + 32 * 64 * 4;
constexpr int RL_LW = RL_KK + 32 * 64 * 4;
constexpr int RL_IC = RL_LW + 32 * 64 * 4;
constexpr int RL_PC = RL_IC + 32 * 64 * 4;
constexpr int RL_CST = RL_PC + 2 * 64 * 4;
constexpr int RL_TW = RL_CST + 4 * 64 * 4;
constexpr int RL_AL = RL_TW + 32 * LD64 * 2;
constexpr int RL_LF = RL_TW;
constexpr int RL_LAKT = RL_LF + 32 * 32 * 4;
constexpr int RL_TB = RL_LAKT + 32 * LD32 * 2;
static_assert(RL_TB + 32 * LD32 * 2 <= RL_AL + 32 * LD64 * 2, "overlay");
constexpr int RL_W2T = RL_AL + 32 * LD64 * 2;
constexpr int RL_A2T = RL_W2T + 64 * LD64 * 2;
constexpr int RL_AR = RL_A2T + 64 * LD64 * 2;
constexpr int RL_BR = RL_AR + 32 * LD64 * 2;
constexpr int RL_KR = RL_BR + 32 * LD64 * 2;
constexpr int RL_RR = RL_KR + 32 * LD64 * 2;
constexpr int RL_AT = RL_RR + 2 * 32 * LD64 * 2;
constexpr int RL_BHT = RL_AT + 64 * LD32 * 2;
constexpr int RL_KHT = RL_BHT + 2 * 64 * LD32 * 2;
constexpr int RL_VT = RL_KHT + 2 * 64 * LD32 * 2;
constexpr int RL_MRB = RL_VT + 2 * 64 * LD32 * 2;
constexpr int RL_MRK = RL_MRB + 2 * 32 * LD32 * 2;
constexpr int RL_WM = RL_MRK + 2 * 32 * LD32 * 2;
constexpr int RL_TL = RL_WM + 32 * LD64 * 2;
constexpr int RL_END = RL_TL + 32 * LD32 * 2;
static_assert(RL_END <= LDS_BYTES, "rwkv lds");

DI void rwkv_chain2(const Params& p, char* smem, int item) {
    const int d = item / (NB * H_B), b = (item / H_B) % NB, h = item % H_B;
    const int tid = tid_x(), lane = tid & 63, wave = tid >> 6;
    float* RX = (float*)(smem + RL_RX); float* KX = (float*)(smem + RL_KX); float* VX = (float*)(smem + RL_VX); float* KKs = (float*)(smem + RL_KK);
    float* LW = (float*)(smem + RL_LW); float* IC = (float*)(smem + RL_IC); float* Lf = (float*)(smem + RL_LF); float* PC = (float*)(smem + RL_PC); float* CST = (float*)(smem + RL_CST);
    bf16_t* TW = (bf16_t*)(smem + RL_TW); bf16_t* AL = (bf16_t*)(smem + RL_AL); bf16_t* W2T = (bf16_t*)(smem + RL_W2T); bf16_t* A2T = (bf16_t*)(smem + RL_A2T);
    bf16_t* Ar = (bf16_t*)(smem + RL_AR); bf16_t* Br = (bf16_t*)(smem + RL_BR); bf16_t* Kr = (bf16_t*)(smem + RL_KR); bf16_t* Rr = (bf16_t*)(smem + RL_RR);
    bf16_t* AT = (bf16_t*)(smem + RL_AT); bf16_t* BhT = (bf16_t*)(smem + RL_BHT); bf16_t* KhT = (bf16_t*)(smem + RL_KHT); bf16_t* VT = (bf16_t*)(smem + RL_VT);
    bf16_t* LakT = (bf16_t*)(smem + RL_LAKT); bf16_t* Mrb = (bf16_t*)(smem + RL_MRB); bf16_t* Mrk = (bf16_t*)(smem + RL_MRK); bf16_t* Tb = (bf16_t*)(smem + RL_TB);
    bf16_t* Wm = (bf16_t*)(smem + RL_WM); bf16_t* TLm = (bf16_t*)(smem + RL_TL);
    bf16_t* YDIR = (bf16_t*)(p.aux + AUX_YDIR); float* BON = (float*)(p.ws + WS_BONUS);
    __syncthreads();
    for (int i = tid; i < 64 * 64; i += NTHREADS) {
        const int c = i >> 6, rr = i & 63;
        W2T[c * LD64 + rr] = f2bf(p.in[I_W2][((size_t)d * 64 + rr) * 512 + h * 64 + c]); A2T[c * LD64 + rr] = f2bf(p.in[I_A2][((size_t)d * 64 + rr) * 512 + h * 64 + c]);
    }
    if (tid < 256) { const int w = tid >> 6, c = tid & 63, gc = h * 64 + c;
        CST[tid] = w == 0 ? p.in[I_W0][d * 512 + gc] : (w == 1 ? p.in[I_A0][d * 512 + gc] : (w == 2 ? p.in[I_KA][gc] : p.in[I_RK][gc])); }
    const float kkw = p.in[I_KK][h * 64 + lane];
    f32x16 Xt[2]; Xt[0] = zero16(); Xt[1] = zero16();
    bf16_t rawv[4][5];
    auto prefetch = [&](int x) {
        int seg, j0; chunk_pos(x, d, seg, j0);
        const int ldp = seg ? IN_COLS : CTX_COLS;
        const bf16_t* pb = seg ? (const bf16_t*)(p.ws + WS_PLAT) + (size_t)b * S * IN_COLS : (const bf16_t*)(p.ws + WS_PCTX) + (size_t)b * CTXL * CTX_COLS;
        const int jw = j0 + 4 * wave;
#pragma unroll
        for (int rr = 0; rr < 4; ++rr) {
            const int j = jw + rr; const int row = seg ? (j % ROWS) * GW + j / ROWS : j;
#pragma unroll
            for (int s = 0; s < 5; ++s) {
                const int bcol = (s < 3 ? s * 512 + h * 64 : (s == 3 ? 1536 + d * 64 : 1664 + d * 64)) + lane;
                rawv[rr][s] = pb[(size_t)row * ldp + COL_B0 + bcol];
            }
        }
    };
    prefetch(0);
    const int r0_ = lane & 31, hh0_ = lane >> 5;
    __syncthreads();
    for (int it = -1; it < G_NT; ++it) {
        int r = r0_, hh = hh0_;
#ifndef EMU
        asm volatile("" : "+v"(r), "+v"(hh));
#endif
        const int xn = it + 1, par = xn & 1;
        int segn = 0, j0n = 0; if (xn < G_NT) chunk_pos(xn, d, segn, j0n);
        if (xn < G_NT) {
#pragma unroll
            for (int t = 0; t < 4; ++t) {
                const int i = d ? (GC - 1 - 4 * wave - t) : (4 * wave + t);
                const float xr = bf2f(rawv[t][0]), xk = bf2f(rawv[t][1]), xv = bf2f(rawv[t][2]);
                const float kxk = xk * kkw; const float ss = wave_sum_fast(kxk * kxk);
                RX[i * 64 + lane] = xr; KX[i * 64 + lane] = xk; VX[i * 64 + lane] = xv; KKs[i * 64 + lane] = kxk * frsq(ss + 1e-6f);
                TW[i * LD64 + lane] = rawv[t][3]; AL[i * LD64 + lane] = rawv[t][4];
            }
            if (xn + 1 < G_NT) prefetch(xn + 1);
        }
        LDS_BARRIER();
        if (xn < G_NT) {
            const int which = wave >> 2, cg = wave & 3, fr = lane & 15, fq = lane >> 4;
            const bf16_t* arow0 = (which ? AL : TW) + fr * LD64 + 8 * fq; const bf16_t* brow = (which ? A2T : W2T) + (16 * cg + fr) * LD64 + 8 * fq;
            f32x4 c0 = {0.f, 0.f, 0.f, 0.f}, c1 = {0.f, 0.f, 0.f, 0.f};
#pragma unroll
            for (int ks = 0; ks < 2; ++ks) {
                const bf16x8 bfrag = *(const bf16x8*)(brow + 32 * ks);
                c0 = MFMA16(*(const bf16x8*)(arow0 + 32 * ks), bfrag, c0); c1 = MFMA16(*(const bf16x8*)(arow0 + 16 * LD64 + 32 * ks), bfrag, c1);
            }
            const int c = 16 * cg + fr; const float bias = CST[which * 64 + c];
#pragma unroll
            for (int th = 0; th < 2; ++th)
#pragma unroll
                for (int j = 0; j < 4; ++j) {
                    const int i = 16 * th + 4 * fq + j; const float z = bias + (th ? c1[j] : c0[j]);
                    if (which) IC[i * 64 + c] = fsigmoid(z);
                    else { const float wl = -fsoftplus(-z) - 0.5f; LW[i * 64 + c] = -fexp(wl); }
                }
        }
        LDS_BARRIER();
        if (xn < G_NT) {
            const int c = lane, i0 = 4 * wave;
            const float ka = CST[2 * 64 + c], rk = CST[3 * 64 + c];
            float lpb = 0.f, lpc = 0.f; float lw4[4];
#pragma unroll
            for (int s2 = 0; s2 < 32; ++s2) { const float w = LW[s2 * 64 + c]; lpc += w; if (s2 < i0) lpb += w; }
#pragma unroll
            for (int e = 0; e < 4; ++e) lw4[e] = LW[(i0 + e) * 64 + c];
            bf16_t ta[4], tb[4], tk[4], tv[4]; float bon[4];
            float lprun = lpb;
#pragma unroll
            for (int e = 0; e < 4; ++e) {
                const int i = i0 + e;
                const float lpm = lprun; lprun += lw4[e]; const float lp = lprun;
                const float Pi = fexp(lp), Pm = fexp(lpm), invP = fexp(-lp), PCi = fexp(lpc - lp);
                const float ic = IC[i * 64 + c], kxv = KX[i * 64 + c], kkv = KKs[i * 64 + c], rxv = RX[i * 64 + c], vxv = VX[i * 64 + c];
                const float kd = kxv * (1.f + (ic - 1.f) * ka), bb = kkv * ic, aa = -kkv;
                ta[e] = f2bf(aa * Pm); tb[e] = f2bf(bb * PCi); tk[e] = f2bf(kd * PCi); tv[e] = f2bf(vxv);
                Ar[i * LD64 + c] = ta[e]; Br[i * LD64 + c] = f2bf(bb * invP); Kr[i * LD64 + c] = f2bf(kd * invP); Rr[(par * 32 + i) * LD64 + c] = f2bf(rxv * Pi);
                bon[e] = wave_sum_fast(rxv * kd * rk);
            }
            { u32x2 o; o.x = (unsigned)ta[0] | ((unsigned)ta[1] << 16); o.y = (unsigned)ta[2] | ((unsigned)ta[3] << 16); *(u32x2*)(AT + c * LD32 + i0) = o; }
            { u32x2 o; o.x = (unsigned)tb[0] | ((unsigned)tb[1] << 16); o.y = (unsigned)tb[2] | ((unsigned)tb[3] << 16); *(u32x2*)(BhT + (par * 64 + c) * LD32 + i0) = o; }
            { u32x2 o; o.x = (unsigned)tk[0] | ((unsigned)tk[1] << 16); o.y = (unsigned)tk[2] | ((unsigned)tk[3] << 16); *(u32x2*)(KhT + (par * 64 + c) * LD32 + i0) = o; }
            { u32x2 o; o.x = (unsigned)tv[0] | ((unsigned)tv[1] << 16); o.y = (unsigned)tv[2] | ((unsigned)tv[3] << 16); *(u32x2*)(VT + (par * 64 + c) * LD32 + i0) = o; }
            if (wave == 7) PC[par * 64 + c] = fexp(lpc);
            if (segn && lane < 4) { const int i = i0 + lane, jj = d ? j0n + GC - 1 - i : j0n + i;
                const float bv = lane == 0 ? bon[0] : (lane == 1 ? bon[1] : (lane == 2 ? bon[2] : bon[3]));
                BON[((size_t)d * T_LAT + (size_t)b * S + (jj % ROWS) * GW + jj / ROWS) * 8 + h] = bv; }
        }
        LDS_BARRIER();
        if (xn < G_NT) {
            const int m = wave >> 1, th = wave & 1, fr = lane & 15, fq = lane >> 4;
            const bf16_t* arow = ((m < 2) ? Ar : Rr + par * 32 * LD64) + (16 * th + fr) * LD64 + 8 * fq; const bf16_t* brow = ((m & 1) ? Kr : Br) + fr * LD64 + 8 * fq;
            f32x4 c0 = {0.f, 0.f, 0.f, 0.f}, c1 = {0.f, 0.f, 0.f, 0.f};
#pragma unroll
            for (int ks = 0; ks < 2; ++ks) {
                const bf16x8 afrag = *(const bf16x8*)(arow + 32 * ks);
                c0 = MFMA16(afrag, *(const bf16x8*)(brow + 32 * ks), c0); c1 = MFMA16(afrag, *(const bf16x8*)(brow + 16 * LD64 + 32 * ks), c1);
            }
#pragma unroll
            for (int ch = 0; ch < 2; ++ch) {
                const f32x4 cc = ch ? c1 : c0; const int ic = 16 * ch + fr; const int t0 = 16 * th + 4 * fq;
                if (m == 0) {
#pragma unroll
                    for (int j = 0; j < 4; ++j) Lf[(t0 + j) * 32 + ic] = (ic < t0 + j) ? -cc[j] : 0.f;
                } else if (m == 1) {
                    u32x2 o; o.x = pk2((ic < t0) ? cc[0] : 0.f, (ic < t0 + 1) ? cc[1] : 0.f); o.y = pk2((ic < t0 + 2) ? cc[2] : 0.f, (ic < t0 + 3) ? cc[3] : 0.f);
                    *(u32x2*)(LakT + ic * LD32 + t0) = o;
                } else {
                    bf16_t* M = (m == 2 ? Mrb : Mrk) + par * 32 * LD32;
#pragma unroll
                    for (int j = 0; j < 4; ++j) M[(t0 + j) * LD32 + ic] = f2bf((ic <= t0 + j) ? cc[j] : 0.f);
                }
            }
        }
        LDS_BARRIER();
        if (wave == 7 && xn < G_NT) {
            const f32x16 tf = invert32_blocked(Lf, (bf16_t*)(smem + RL_RX), lane);
#pragma unroll
            for (int g = 0; g < 16; ++g) Tb[crow(g, hh) * LD32 + r] = f2bf(tf[g]);
        }
        if (wave < 2 && it >= 0) {
            const int pc = it & 1; int seg = 0, j0 = 0; chunk_pos(it, d, seg, j0);
            const bf16_t* Rc = Rr + pc * 32 * LD64; const bf16_t* BhTc = BhT + pc * 64 * LD32; const bf16_t* KhTc = KhT + pc * 64 * LD32; const bf16_t* VTc = VT + (pc * 64 + 32 * wave + r) * LD32;
            const bf16_t* Mrbc = Mrb + pc * 32 * LD32; const bf16_t* Mrkc = Mrk + pc * 32 * LD32; const float* PCc = PC + pc * 64;
            const bf16x8 vf0 = ld_nat(VTc, 0, hh), vf1 = ld_nat(VTc, 1, hh);
            f32x16 u = zero16(), y = zero16();
            u = MFMA32(ld_nat(TLm + r * LD32, 0, hh), vf0, u); u = MFMA32(ld_nat(TLm + r * LD32, 1, hh), vf1, u);
            y = MFMA32(ld_nat(Mrkc + r * LD32, 0, hh), vf0, y); y = MFMA32(ld_nat(Mrkc + r * LD32, 1, hh), vf1, y);
#define RW_KSTEP(s) { const bf16x8 xb = pack_acc<(s) & 1>(Xt[(s) >> 1]); u = MFMA32(ld_perm(Wm + r * LD64, (s), hh), xb, u); y = MFMA32(ld_perm(Rc + r * LD64, (s), hh), xb, y); }
            RW_KSTEP(0) RW_KSTEP(1) RW_KSTEP(2) RW_KSTEP(3)
#undef RW_KSTEP
            const bf16x8 ub0 = pack_acc<0>(u), ub1 = pack_acc<1>(u);
            y = MFMA32(ld_perm(Mrbc + r * LD32, 0, hh), ub0, y); y = MFMA32(ld_perm(Mrbc + r * LD32, 1, hh), ub1, y);
#pragma unroll
            for (int kt = 0; kt < 2; ++kt) {
#pragma unroll
                for (int g = 0; g < 16; ++g) Xt[kt][g] *= PCc[32 * kt + crow(g, hh)];
                Xt[kt] = MFMA32(ld_perm(BhTc + (32 * kt + r) * LD32, 0, hh), ub0, Xt[kt]); Xt[kt] = MFMA32(ld_perm(BhTc + (32 * kt + r) * LD32, 1, hh), ub1, Xt[kt]);
                Xt[kt] = MFMA32(ld_nat(KhTc + (32 * kt + r) * LD32, 0, hh), vf0, Xt[kt]); Xt[kt] = MFMA32(ld_nat(KhTc + (32 * kt + r) * LD32, 1, hh), vf1, Xt[kt]);
            }
            if (seg) {
#pragma unroll
                for (int g = 0; g < 16; ++g) {
                    const int i = crow(g, hh), jj = d ? j0 + GC - 1 - i : j0 + i;
                    YDIR[((size_t)d * T_LAT + (size_t)b * S + (jj % ROWS) * GW + jj / ROWS) * 512 + h * 64 + 32 * wave + r] = f2bf(y[g]);
                }
            }
        }
        LDS_BARRIER();
        if (xn < G_NT && wave < 3) {
            const bf16_t* arow = (wave < 2) ? AT + (32 * wave + r) * LD32 : LakT + r * LD32;
            f32x16 acc = zero16();
#pragma unroll
            for (int s = 0; s < 2; ++s) acc = MFMA32(ld_nat(arow, s, hh), ld_nat(Tb + r * LD32, s, hh), acc);
#pragma unroll
            for (int q = 0; q < 4; ++q) {
                u32x2 o; o.x = pk2(acc[4 * q], acc[4 * q + 1]); o.y = pk2(acc[4 * q + 2], acc[4 * q + 3]);
                if (wave < 2) *(u32x2*)(Wm + r * LD64 + 32 * wave + 8 * q + 4 * hh) = o; else *(u32x2*)(TLm + r * LD32 + 8 * q + 4 * hh) = o;
            }
        }
        LDS_BARRIER();
    }
}

DI void phase3(const Params& p, char* smem) {
    constexpr int NG = 2 * NB * H_A, NR = 2 * NB * H_B;
    for (int it = blockIdx.x; it < NG; it += gridDim.x) gdn_chain2(p, smem, it);
    for (int it = blockIdx.x; it < NG + NR; it += gridDim.x) if (it >= NG) rwkv_chain2(p, smem, it - NG);
}

constexpr int P4_SG = 0;
constexpr int P4_XV = P4_SG + 32 * LD128 * 2;
constexpr int P4_YF = P4_XV + 32 * 520 * 2;
static_assert(P4_YF + 32 * 516 * 4 <= LDS_BYTES, "phase4 lds");
DI void unpack8(const u32x4& q, float (&f)[8]) {
    f[0] = bf2f((bf16_t)(q.x & 0xffffu)); f[1] = bf2f((bf16_t)(q.x >> 16)); f[2] = bf2f((bf16_t)(q.y & 0xffffu)); f[3] = bf2f((bf16_t)(q.y >> 16));
    f[4] = bf2f((bf16_t)(q.z & 0xffffu)); f[5] = bf2f((bf16_t)(q.z >> 16)); f[6] = bf2f((bf16_t)(q.w & 0xffffu)); f[7] = bf2f((bf16_t)(q.w >> 16));
}
DI float half_sum(float v, int hh) {
#ifdef EMU
    v += __shfl_xor(v, 1); v += __shfl_xor(v, 2); v += __shfl_xor(v, 4); v += __shfl_xor(v, 8); v += __shfl_xor(v, 16); return v;
#else
    v = DPP_ADD(v, 0xB1); v = DPP_ADD(v, 0x4E); v = DPP_ADD(v, 0x141); v = DPP_ADD(v, 0x140);
    const int iv = __builtin_bit_cast(int, v);
    const float s0 = __builtin_bit_cast(float, __builtin_amdgcn_readlane(iv, 0)) + __builtin_bit_cast(float, __builtin_amdgcn_readlane(iv, 16));
    const float s1 = __builtin_bit_cast(float, __builtin_amdgcn_readlane(iv, 32)) + __builtin_bit_cast(float, __builtin_amdgcn_readlane(iv, 48));
    return hh ? s1 : s0;
#endif
}
DI void phase4(const Params& p, char* smem) {
    const int tid = tid_x(), lane = tid & 63, wave = tid >> 6, r = lane & 31, hh = lane >> 5;
    const bf16_t* PL = (const bf16_t*)(p.ws + WS_PLAT);
    const bf16_t* ODIR = (const bf16_t*)(p.aux + AUX_ODIR); const bf16_t* YDIR = (const bf16_t*)(p.aux + AUX_YDIR);
    const float* BON = (const float*)(p.ws + WS_BONUS); const float* mu = p.in[I_MU]; const bf16_t* G2T = (const bf16_t*)(p.ws + WS_G2T);
    bf16_t* OA = (bf16_t*)(p.ws + WS_OA); bf16_t* OB = (bf16_t*)(p.ws + WS_OB);
    bf16_t* SG = (bf16_t*)(smem + P4_SG); bf16_t* XV = (bf16_t*)(smem + P4_XV); float* YF = (float*)(smem + P4_YF);
    for (int it = blockIdx.x; it < T_LAT / 32; it += gridDim.x) {
        const int tok0 = it * 32, b = tok0 / S, l0 = tok0 % S;
        __syncthreads();
        for (int q = tid; q < 32 * 80; q += NTHREADS) {
            const int t = q / 80, c8 = q % 80;
            const int l = l0 + t;
            const int bcol = c8 < 16 ? 1792 + c8 * 8 : 1024 + (c8 - 16) * 8;
            float cu[8], o[8];
            unpack8(*(const u32x4*)(PL + (size_t)(b * S + l) * IN_COLS + COL_B0 + bcol), cu);
#pragma unroll
            for (int e = 0; e < 8; ++e) o[e] = c8 < 16 ? fsigmoid(cu[e]) : cu[e];
            u32x4 w; w.x = pk2(o[0], o[1]); w.y = pk2(o[2], o[3]); w.z = pk2(o[4], o[5]); w.w = pk2(o[6], o[7]);
            if (c8 < 16) *(u32x4*)(SG + t * LD128 + c8 * 8) = w; else *(u32x4*)(XV + t * 520 + (c8 - 16) * 8) = w;
        }
        for (int q = tid; q < 32 * 64; q += NTHREADS) {
            const int t = q >> 6, c8 = q & 63, tok = tok0 + t;
            float a0[8], a1[8];
            unpack8(*(const u32x4*)(YDIR + (size_t)tok * 512 + c8 * 8), a0); unpack8(*(const u32x4*)(YDIR + ((size_t)T_LAT + tok) * 512 + c8 * 8), a1);
            f32x4 s0 = {a0[0] + a1[0], a0[1] + a1[1], a0[2] + a1[2], a0[3] + a1[3]}, s1 = {a0[4] + a1[4], a0[5] + a1[5], a0[6] + a1[6], a0[7] + a1[7]};
            *(f32x4*)(YF + t * 516 + c8 * 8) = s0; *(f32x4*)(YF + t * 516 + c8 * 8 + 4) = s1;
        }
        __syncthreads();
        {
            const int h = wave;
            f32x16 acc0 = zero16(), acc1 = zero16();
#pragma unroll
            for (int s2 = 0; s2 < 8; ++s2) {
                const bf16x8 a = ld_nat(SG + r * LD128, s2, hh);
                const bf16x8 b0 = *(const bf16x8*)(G2T + (size_t)(64 * h + r) * 128 + 16 * s2 + 8 * hh), b1 = *(const bf16x8*)(G2T + (size_t)(64 * h + 32 + r) * 128 + 16 * s2 + 8 * hh);
                acc0 = MFMA32(a, b0, acc0); acc1 = MFMA32(a, b1, acc1);
            }
            const int c0 = 64 * h + r, c1 = c0 + 32;
            const float lg0 = p.in[I_LNG][c0], lb0 = p.in[I_LNB][c0], lg1 = p.in[I_LNG][c1], lb1 = p.in[I_LNB][c1];
#pragma unroll
            for (int g = 0; g < 16; ++g) {
                const int i = crow(g, hh), tok = tok0 + i;
                const float y0 = YF[i * 516 + c0], y1 = YF[i * 516 + c1];
                const float mean = half_sum(y0 + y1, hh) * (1.f / 64.f); const float d0 = y0 - mean, d1 = y1 - mean;
                const float var = half_sum(d0 * d0 + d1 * d1, hh) * (1.f / 64.f); const float rs = frsq(var + 64e-5f);
                const float bon = BON[(size_t)tok * 8 + h] + BON[((size_t)T_LAT + tok) * 8 + h];
                const float o0 = (d0 * rs * lg0 + lb0 + bon * bf2f(XV[i * 520 + c0])) * acc0[g], o1 = (d1 * rs * lg1 + lb1 + bon * bf2f(XV[i * 520 + c1])) * acc1[g];
                OB[(size_t)tok * 512 + c0] = f2bf(o0); OB[(size_t)tok * 512 + c1] = f2bf(o1);
            }
        }
        for (int pi = wave * 16; pi < wave * 16 + 16; ++pi) {
            const int t = pi >> 2, h = pi & 3, tok = tok0 + t;
            const size_t o0 = (size_t)tok * 512 + h * 128 + 2 * lane;
            const unsigned q0 = *(const unsigned*)(ODIR + o0), q1 = *(const unsigned*)(ODIR + (size_t)T_LAT * 512 + o0), zq = *(const unsigned*)(PL + (size_t)tok * IN_COLS + 1536 + h * 128 + 2 * lane);
            const float a0 = bf2f((bf16_t)(q0 & 0xffffu)) + bf2f((bf16_t)(q1 & 0xffffu)), a1 = bf2f((bf16_t)(q0 >> 16)) + bf2f((bf16_t)(q1 >> 16));
            const float ss = wave_sum_fast(a0 * a0 + a1 * a1);
            const float rstd = frsq(ss * (1.f / 128.f) + 1e-6f);
            const float z0 = bf2f((bf16_t)(zq & 0xffffu)), z1 = bf2f((bf16_t)(zq >> 16));
            *(unsigned*)(OA + o0) = pk2(a0 * rstd * p.in[I_ONORM][2 * lane] * fsilu(z0), a1 * rstd * p.in[I_ONORM][2 * lane + 1] * fsilu(z1));
        }
    }
}

DI void phase5(const Params& p, char* smem) {
    const bf16_t* OA = (const bf16_t*)(p.ws + WS_OA); const bf16_t* OB = (const bf16_t*)(p.ws + WS_OB);
    const bf16_t* WA = (const bf16_t*)(p.ws + WS_WOA); const bf16_t* WB = (const bf16_t*)(p.ws + WS_WOB);
    const bf16_t* PL = (const bf16_t*)(p.ws + WS_PLAT); bf16_t* Y = (bf16_t*)(p.aux + AUX_Y);
    if (USE_G8) {
        constexpr int NT8 = D / 256, MT8 = T_LAT / 256;
        for (int t = blockIdx.x; t < MT8 * NT8; t += gridDim.x) {
            const int mt = t / NT8, nt = t % NT8, brow = mt * 256, bcol = nt * 256;
            g8::Acc acc; g8::acc_zero(acc);
            g8::kloop(acc, smem, OA, 512, WA, 512, 512, brow, bcol);
            g8::for_each_quad(acc, brow, bcol, [&](int row, int col, const f32x4& v) {
                const u32x2 gq = *(const u32x2*)(PL + (size_t)row * IN_COLS + COL_G0 + col);
                const float g0 = bf2f((bf16_t)(gq.x & 0xffffu)), g1 = bf2f((bf16_t)(gq.x >> 16)), g2 = bf2f((bf16_t)(gq.y & 0xffffu)), g3 = bf2f((bf16_t)(gq.y >> 16));
                u32x2 o; o.x = pk2(fsigmoid(g0) * v.x, fsigmoid(g1) * v.y); o.y = pk2(fsigmoid(g2) * v.z, fsigmoid(g3) * v.w);
                *(u32x2*)(Y + (size_t)row * D + col) = o;
            });
            g8::acc_zero(acc);
            g8::kloop(acc, smem, OB, 512, WB, 512, 512, brow, bcol);
            g8::for_each_quad(acc, brow, bcol, [&](int row, int col, const f32x4& v) {
                const u32x2 gq = *(const u32x2*)(PL + (size_t)row * IN_COLS + COL_G0 + D + col);
                const float g0 = bf2f((bf16_t)(gq.x & 0xffffu)), g1 = bf2f((bf16_t)(gq.x >> 16)), g2 = bf2f((bf16_t)(gq.y & 0xffffu)), g3 = bf2f((bf16_t)(gq.y >> 16));
#ifdef EMU
                const unsigned long long tq = *(const unsigned long long*)(Y + (size_t)row * D + col);
#else
                const unsigned long long tq = __hip_atomic_load((const unsigned long long*)(Y + (size_t)row * D + col), __ATOMIC_RELAXED, __HIP_MEMORY_SCOPE_AGENT);
#endif
                const unsigned tlo = (unsigned)tq, thi = (unsigned)(tq >> 32);
                const float t0 = bf2f((bf16_t)(tlo & 0xffffu)), t1 = bf2f((bf16_t)(tlo >> 16)), t2 = bf2f((bf16_t)(thi & 0xffffu)), t3 = bf2f((bf16_t)(thi >> 16));
                u32x2 o; o.x = pk2(t0 + fsigmoid(g0) * v.x, t1 + fsigmoid(g1) * v.y); o.y = pk2(t2 + fsigmoid(g2) * v.z, t3 + fsigmoid(g3) * v.w);
                *(u32x2*)(Y + (size_t)row * D + col) = o;
            });
        }
        return;
    }
    constexpr int MR5 = 2, BM5 = 64 * MR5; constexpr int NT = D / 128, MT = T_LAT / BM5;
    for (int t = blockIdx.x; t < MT * NT; t += gridDim.x) {
        const int mt = t / NT, nt = t % NT, row0 = mt * BM5;
        f32x4 acca[MR5][4], accb[MR5][4]; acc_zero(acca); acc_zero(accb);
        gemm_kloop(acca, smem, [&](int i) { return OA + (size_t)(row0 + i) * 512; }, WA + (size_t)nt * 128 * 512, 512, 512);
        gemm_kloop(accb, smem, [&](int i) { return OB + (size_t)(row0 + i) * 512; }, WB + (size_t)nt * 128 * 512, 512, 512);
        const int t2 = tid_x(), l2 = t2 & 63, w2 = t2 >> 6; const int wr = w2 >> 1, wc = w2 & 1, fr = l2 & 15, fq = l2 >> 4;
#pragma unroll
        for (int m = 0; m < MR5; ++m)
#pragma unroll
            for (int n = 0; n < 4; ++n)
#pragma unroll
                for (int j = 0; j < 4; ++j) {
                    const int row = row0 + wr * 16 * MR5 + m * 16 + fq * 4 + j, col = nt * 128 + wc * 64 + n * 16 + fr;
                    const float ga = bf2f(PL[(size_t)row * IN_COLS + COL_G0 + col]), gb = bf2f(PL[(size_t)row * IN_COLS + COL_G0 + D + col]);
                    Y[(size_t)row * D + col] = f2bf(sigmoidf_(ga) * acca[m][n][j] + sigmoidf_(gb) * accb[m][n][j]);
                }
    }
}

DI void phase6(const Params& p, char* smem) {
    const bf16_t* Y = (const bf16_t*)(p.aux + AUX_Y); const bf16_t* WO = (const bf16_t*)(p.ws + WS_WOUT);
    const float* mod = (const float*)(p.ws + WS_MOD); float* Hh = (float*)(p.ws + WS_H);
    if (USE_G8) {
        constexpr int NT = D / 256, MT = T_LAT / 256;
        const float* X = p.in[I_X];
        for (int t = blockIdx.x; t < MT * NT; t += gridDim.x) {
            const int mt = t / NT, nt = t % NT, brow = mt * 256, bcol = nt * 256;
            g8::Acc acc; g8::acc_zero(acc);
            g8::kloop(acc, smem, Y, D, WO, D, D, brow, bcol);
            g8::for_each_quad(acc, brow, bcol, [&](int row, int col, const f32x4& v) {
                const int b = row / S; const f32x4 xv = *(const f32x4*)(X + (size_t)row * D + col), gv = *(const f32x4*)(mod + (size_t)b * 6 * D + 2 * D + col);
                f32x4 o; o.x = xv.x + gv.x * v.x; o.y = xv.y + gv.y * v.y; o.z = xv.z + gv.z * v.z; o.w = xv.w + gv.w * v.w;
                *(f32x4*)(Hh + (size_t)row * D + col) = o;
            });
        }
    } else {
        const int tid = tid_x(), lane = tid & 63, wave = tid >> 6, wr = wave >> 1, wc = wave & 1, fr = lane & 15, fq = lane >> 4;
        constexpr int NT = D / 128, MT = T_LAT / BM;
        for (int t = blockIdx.x; t < MT * NT; t += gridDim.x) {
            const int mt = t / NT, nt = t % NT, row0 = mt * BM;
            f32x4 acc[MREP][4]; acc_zero(acc);
            gemm_kloop(acc, smem, [&](int i) { return Y + (size_t)(row0 + i) * D; }, WO + (size_t)nt * 128 * D, D, D);
#pragma unroll
            for (int m = 0; m < MREP; ++m)
#pragma unroll
                for (int n = 0; n < 4; ++n)
#pragma unroll
                    for (int j = 0; j < 4; ++j) {
                        const int row = row0 + wr * 16 * MREP + m * 16 + fq * 4 + j, col = nt * 128 + wc * 64 + n * 16 + fr, b = row / S;
                        Hh[(size_t)row * D + col] = p.in[I_X][(size_t)row * D + col] + mod[(size_t)b * 6 * D + 2 * D + col] * acc[m][n][j];
                    }
        }
    }
    __syncthreads();
    const int tid6 = tid_x(), lane = tid6 & 63, wave = tid6 >> 6;
    const int gw = blockIdx.x * 8 + wave, ngw = gridDim.x * 8;
    float* scr = (float*)smem + wave * (64 * 33);
    bf16_t* GUT = (bf16_t*)(p.aux + AUX_GUT); bf16_t* DNT = (bf16_t*)(p.ws + WS_DNT);
    {
        constexpr int nkb = D / 64, nnb = DE / 32, per = nkb * nnb;
        for (int it = gw; it < NEXP * 2 * per; it += ngw) {
            const int e = it / (2 * per), r = it % (2 * per), up = r / per, r2 = r % per, kb = r2 / nnb, nb = r2 % nnb;
            transpose_item((up ? p.in[I_MU_UP] : p.in[I_MG]) + (size_t)e * D * DE, DE, DE, kb * 64, nb * 32, GUT + (size_t)e * 512 * D, D, up ? 2 : 1, scr, lane);
        }
    }
    {
        constexpr int nkb = DE / 64, nnb = D / 32, per = nkb * nnb;
        for (int it = gw; it < NEXP * per; it += ngw) {
            const int e = it / per, r2 = it % per, kb = r2 / nnb, nb = r2 % nnb;
            transpose_item(p.in[I_MD] + (size_t)e * DE * D, D, D, kb * 64, nb * 32, DNT + (size_t)e * D * DE, DE, 0, scr, lane);
        }
    }
}

#ifdef EMU
#define MFMA32F(a, b, c) emu_mfma32_f32((a), (b), (c))
#else
#define MFMA32F(a, b, c) __builtin_amdgcn_mfma_f32_32x32x2f32((a), (b), (c), 0, 0, 0)
#endif
constexpr int TB_LD = D + 4;
static_assert(32 * TB_LD * 4 <= LDS_BYTES && 8 * 32 * 64 * 4 <= LDS_BYTES, "phase7 lds");
DI void phase7(const Params& p, char* smem) {
    const int tid = tid_x(), lane = tid & 63, wave = tid >> 6, r = lane & 31, hh = lane >> 5;
    const float* Hh = (const float*)(p.ws + WS_H); const float* mod = (const float*)(p.ws + WS_MOD); const float* WRT = (const float*)(p.ws + WS_WRT);
    bf16_t* Tt = (bf16_t*)(p.ws + WS_T); int* cnt = (int*)(p.ws + WS_CNT); int* rowlist = (int*)(p.ws + WS_ROWLIST); float* pairw = (float*)(p.ws + WS_PAIRW);
    float* tb = (float*)smem;
    float* bias = (float*)(smem + LDS_BYTES - 1024);
    int* lcnt = (int*)(smem + LDS_BYTES - 768);
    int* lbase = lcnt + 32;
    if (tid < 36) bias[tid] = tid < 4 ? p.in[I_RGB][tid] : p.in[I_REB][tid - 4];
    f32x4 x[4][D / 256];
    int itn = blockIdx.x;
    if (itn < T_LAT / 32) {
#pragma unroll
        for (int tt = 0; tt < 4; ++tt)
#pragma unroll
            for (int j = 0; j < D / 256; ++j) x[tt][j] = *(const f32x4*)(Hh + (size_t)(itn * 32 + wave * 4 + tt) * D + j * 256 + lane * 4);
    }
    for (int it = blockIdx.x; it < T_LAT / 32; it += gridDim.x) {
        const int tok0 = it * 32;
        __syncthreads();
        if (tid < 32) lcnt[tid] = 0;
#pragma unroll
        for (int tt = 0; tt < 4; ++tt) {
            const int ti = wave * 4 + tt, tok = tok0 + ti, b = tok / S;
            float ss = 0.f;
#pragma unroll
            for (int j = 0; j < D / 256; ++j) ss += x[tt][j].x * x[tt][j].x + x[tt][j].y * x[tt][j].y + x[tt][j].z * x[tt][j].z + x[tt][j].w * x[tt][j].w;
            ss = wave_sum_fast(ss);
            const float rstd = frsq(ss * (1.0f / D) + 1e-6f);
#pragma unroll
            for (int j = 0; j < D / 256; ++j) {
                const int k = j * 256 + lane * 4;
                const f32x4 g = *(const f32x4*)(p.in[I_NFFN] + k), sh = *(const f32x4*)(mod + (size_t)b * 6 * D + 3 * D + k), sc = *(const f32x4*)(mod + (size_t)b * 6 * D + 4 * D + k);
                f32x4 o; o.x = x[tt][j].x * rstd * g.x * (1.f + sc.x) + sh.x; o.y = x[tt][j].y * rstd * g.y * (1.f + sc.y) + sh.y;
                o.z = x[tt][j].z * rstd * g.z * (1.f + sc.z) + sh.z; o.w = x[tt][j].w * rstd * g.w * (1.f + sc.w) + sh.w;
                *(f32x4*)(tb + ti * TB_LD + k) = o;
                u32x2 ob; ob.x = pk2(o.x, o.y); ob.y = pk2(o.z, o.w);
                *(u32x2*)(Tt + (size_t)tok * D + k) = ob;
            }
        }
        itn = it + gridDim.x;
        if (itn < T_LAT / 32) {
#pragma unroll
            for (int tt = 0; tt < 4; ++tt)
#pragma unroll
                for (int j = 0; j < D / 256; ++j) x[tt][j] = *(const f32x4*)(Hh + (size_t)(itn * 32 + wave * 4 + tt) * D + j * 256 + lane * 4);
        }
        LDS_BARRIER();
        f32x16 a0 = zero16(), a1 = zero16();
        {
            const int kbeg = wave * (D / 8);
            const float* arow = tb + r * TB_LD + kbeg + 4 * hh;
            const float* b0row = WRT + (size_t)(4 + r) * D + kbeg + 4 * hh;
            const float* b1row = WRT + (size_t)(r < 4 ? r : 0) * D + kbeg + 4 * hh;
            const float m1 = r < 4 ? 1.f : 0.f;
#pragma unroll 4
            for (int g = 0; g < D / 64; ++g) {
                const f32x4 av = *(const f32x4*)(arow + 8 * g), b0 = *(const f32x4*)(b0row + 8 * g); const f32x4 b1 = *(const f32x4*)(b1row + 8 * g) * m1;
                a0 = MFMA32F(av.x, b0.x, a0); a1 = MFMA32F(av.x, b1.x, a1); a0 = MFMA32F(av.y, b0.y, a0); a1 = MFMA32F(av.y, b1.y, a1);
                a0 = MFMA32F(av.z, b0.z, a0); a1 = MFMA32F(av.z, b1.z, a1); a0 = MFMA32F(av.w, b0.w, a0); a1 = MFMA32F(av.w, b1.w, a1);
            }
        }
        LDS_BARRIER();
        {
            float* part = tb + wave * (32 * 64);
#pragma unroll
            for (int g = 0; g < 16; ++g) { const int i = crow(g, hh); part[i * 64 + r] = a0[g]; part[i * 64 + 32 + r] = a1[g]; }
        }
        LDS_BARRIER();
        float lsum[4];
        {
            const int i = tid >> 4, c4 = (tid & 15) * 4;
#pragma unroll
            for (int e = 0; e < 4; ++e) { float sacc = 0.f;
#pragma unroll
                for (int w = 0; w < 8; ++w) sacc += tb[w * (32 * 64) + i * 64 + c4 + e];
                lsum[e] = sacc; }
        }
        LDS_BARRIER();
        { const int i = tid >> 4, c4 = (tid & 15) * 4;
#pragma unroll
          for (int e = 0; e < 4; ++e) tb[i * 64 + c4 + e] = lsum[e]; }
        LDS_BARRIER();
        int ex1 = 0, ex2 = 0, rk1 = 0, rk2 = 0; float w1 = 0.f, w2 = 0.f;
        if (tid < 32) {
            const float* L = tb + tid * 64;
            float gl[4];
#pragma unroll
            for (int i = 0; i < 4; ++i) gl[i] = L[32 + i] + bias[i];
            int g = 0; float mx = gl[0];
#pragma unroll
            for (int i = 1; i < 4; ++i) if (gl[i] > mx) { mx = gl[i]; g = i; }
            float se = 0.f;
#pragma unroll
            for (int i = 0; i < 4; ++i) se += expf(gl[i] - mx);
            const float pg = 1.0f / se;
            int i1 = 0; float l1 = L[g * 8] + bias[4 + g * 8];
            for (int i = 1; i < 8; ++i) { const float v = L[g * 8 + i] + bias[4 + g * 8 + i]; if (v > l1) { l1 = v; i1 = i; } }
            int i2 = -1; float l2 = -3.0e38f;
            for (int i = 0; i < 8; ++i) { const float v = L[g * 8 + i] + bias[4 + g * 8 + i]; if (i != i1 && v > l2) { l2 = v; i2 = i; } }
            const float e2 = expf(l2 - l1); w1 = pg / (1.f + e2); w2 = pg * e2 / (1.f + e2);
            ex1 = g * 8 + i1; ex2 = g * 8 + i2;
            rk1 = atomicAdd(&lcnt[ex1], 1); rk2 = atomicAdd(&lcnt[ex2], 1);
        }
        LDS_BARRIER();
        if (tid < 32) { const int c = lcnt[tid]; lbase[tid] = c ? atomicAdd(&cnt[tid], c) : 0; }
        __syncthreads();
        if (tid < 32) {
            const int tok = tok0 + tid;
            rowlist[(size_t)ex1 * CAP + lbase[ex1] + rk1] = tok * 2; pairw[tok * 2] = w1;
            rowlist[(size_t)ex2 * CAP + lbase[ex2] + rk2] = tok * 2 + 1; pairw[tok * 2 + 1] = w2;
        }
    }
}

constexpr int MOE_TM = USE_G8 ? 256 : BM;
DI void moe_tiles(const Params& p, char* smem, int* pre) {
    const int* cnt = (const int*)(p.ws + WS_CNT);
    __syncthreads();
    if (tid_x() == 0) { int s = 0; for (int e = 0; e < NEXP; ++e) { pre[e] = s; s += (cnt[e] + MOE_TM - 1) / MOE_TM; } pre[NEXP] = s; }
    __syncthreads();
}
DI void phase8(const Params& p, char* smem) {
    const int tid = tid_x(), lane = tid & 63, wave = tid >> 6, wr = wave >> 1, wc = wave & 1, fr = lane & 15, fq = lane >> 4;
    int* pre = (int*)(smem + LDS_BYTES - 256);
    moe_tiles(p, smem, pre);
    const int* cnt = (const int*)(p.ws + WS_CNT); const int* rowlist = (const int*)(p.ws + WS_ROWLIST);
    const bf16_t* Tt = (const bf16_t*)(p.ws + WS_T); const bf16_t* GUT = (const bf16_t*)(p.aux + AUX_GUT); bf16_t* HID = (bf16_t*)(p.ws + WS_HID);
    if (USE_G8) {
        const int ntile8 = pre[NEXP] * 2;
        for (int t = blockIdx.x; t < ntile8; t += gridDim.x) {
            const int mg = t >> 1, nt = t & 1; int e = 0;
            while (pre[e + 1] <= mg) ++e;
            const int mt = mg - pre[e], ce = cnt[e]; const int* rl = rowlist + (size_t)e * CAP;
            g8::Acc acc; g8::acc_zero(acc);
            g8::kloop_g(acc, smem, Tt, [&](int r) { int idx = mt * 256 + r; idx = idx < ce ? idx : ce - 1; return (rl[idx] >> 1) * D; }, GUT + ((size_t)e * 512 + nt * 256) * D, D, D, 0);
            const int t2 = tid_x(), wid = t2 >> 6, l2 = t2 & 63, wr2 = wid >> 2, wc2 = wid & 3, fr2 = l2 & 15, fq2 = l2 >> 4;
#pragma unroll
            for (int ai = 0; ai < 2; ++ai)
#pragma unroll
                for (int m = 0; m < 4; ++m) {
                    const int idx = mt * 256 + ai * 128 + wr2 * 64 + m * 16 + fr2;
                    if (idx < ce) {
                        const int pair = rl[idx];
#pragma unroll
                        for (int bj = 0; bj < 2; ++bj) {
                            const f32x4 g = acc[ai][bj][m][0], u = acc[ai][bj][m][1];
                            u32x2 o; o.x = pk2(fsilu(g.x) * u.x, fsilu(g.y) * u.y); o.y = pk2(fsilu(g.z) * u.z, fsilu(g.w) * u.w);
                            *(u32x2*)(HID + (size_t)pair * DE + nt * 128 + bj * 64 + wc2 * 16 + fq2 * 4) = o;
                        }
                    }
                }
        }
        return;
    }
    const int ntile = pre[NEXP] * 4;
    for (int t = blockIdx.x; t < ntile; t += gridDim.x) {
        const int mg = t >> 2, nt = t & 3; int e = 0;
        while (pre[e + 1] <= mg) ++e;
        const int mt = mg - pre[e], ce = cnt[e]; const int* rl = rowlist + (size_t)e * CAP;
        f32x4 acc[MREP][4]; acc_zero(acc);
        gemm_kloop(acc, smem, [&](int i) { int idx = mt * BM + i; idx = idx < ce ? idx : ce - 1; return Tt + (size_t)(rl[idx] >> 1) * D; }, GUT + ((size_t)e * 512 + nt * 128) * D, D, D);
#pragma unroll
        for (int m = 0; m < MREP; ++m)
#pragma unroll
            for (int j = 0; j < 4; ++j) {
                const int idx = mt * BM + wr * 16 * MREP + m * 16 + fq * 4 + j;
                if (idx < ce) {
                    const int pair = rl[idx];
#pragma unroll
                    for (int n = 0; n < 2; ++n) {
                        const float g = acc[m][n][j], u = acc[m][n + 2][j];
                        HID[(size_t)pair * DE + nt * 64 + wc * 32 + n * 16 + fr] = f2bf(siluf_(g) * u);
                    }
                }
            }
    }
}
DI void phase9(const Params& p, char* smem) {
    const int tid = tid_x(), lane = tid & 63, wave = tid >> 6, wr = wave >> 1, wc = wave & 1, fr = lane & 15, fq = lane >> 4;
    int* pre = (int*)(smem + LDS_BYTES - 256);
    moe_tiles(p, smem, pre);
    const int* cnt = (const int*)(p.ws + WS_CNT); const int* rowlist = (const int*)(p.ws + WS_ROWLIST); const float* pairw = (const float*)(p.ws + WS_PAIRW);
    const bf16_t* HID = (const bf16_t*)(p.ws + WS_HID); const bf16_t* DNT = (const bf16_t*)(p.ws + WS_DNT); bf16_t* OP = (bf16_t*)(p.ws + WS_OPAIR);
    if (USE_G8) {
        constexpr int NT8 = D / 256;
        const int ntile8 = pre[NEXP] * NT8;
        for (int t = blockIdx.x; t < ntile8; t += gridDim.x) {
            const int mg = t / NT8, nt = t % NT8; int e = 0;
            while (pre[e + 1] <= mg) ++e;
            const int mt = mg - pre[e], ce = cnt[e]; const int* rl = rowlist + (size_t)e * CAP;
            g8::Acc acc; g8::acc_zero(acc);
            g8::kloop_g(acc, smem, HID, [&](int r) { int idx = mt * 256 + r; idx = idx < ce ? idx : ce - 1; return rl[idx] * DE; }, DNT + ((size_t)e * D + nt * 256) * DE, DE, DE, 0);
            g8::for_each_quad(acc, 0, nt * 256, [&](int row, int col, const f32x4& v) {
                const int idx = mt * 256 + row;
                if (idx < ce) { const int pair = rl[idx]; const float w = pairw[pair];
                    u32x2 o; o.x = pk2(v.x * w, v.y * w); o.y = pk2(v.z * w, v.w * w); *(u32x2*)(OP + (size_t)pair * D + col) = o; }
            });
        }
        return;
    }
    constexpr int NT = D / 128;
    const int ntile = pre[NEXP] * NT;
    for (int t = blockIdx.x; t < ntile; t += gridDim.x) {
        const int mg = t / NT, nt = t % NT; int e = 0;
        while (pre[e + 1] <= mg) ++e;
        const int mt = mg - pre[e], ce = cnt[e]; const int* rl = rowlist + (size_t)e * CAP;
        f32x4 acc[MREP][4]; acc_zero(acc);
        gemm_kloop(acc, smem, [&](int i) { int idx = mt * BM + i; idx = idx < ce ? idx : ce - 1; return HID + (size_t)rl[idx] * DE; }, DNT + ((size_t)e * D + nt * 128) * DE, DE, DE);
#pragma unroll
        for (int m = 0; m < MREP; ++m)
#pragma unroll
            for (int j = 0; j < 4; ++j) {
                const int idx = mt * BM + wr * 16 * MREP + m * 16 + fq * 4 + j;
                if (idx < ce) {
                    const int pair = rl[idx]; const float w = pairw[pair];
#pragma unroll
                    for (int n = 0; n < 4; ++n) OP[(size_t)pair * D + nt * 128 + wc * 64 + n * 16 + fr] = f2bf(acc[m][n][j] * w);
                }
            }
    }
}

DI void phase10(const Params& p, char* smem) {
    const int lane = tid_x() & 63, wave = tid_x() >> 6;
    const int gw = blockIdx.x * 8 + wave, ngw = gridDim.x * 8;
    const float* Hh = (const float*)(p.ws + WS_H); const float* mod = (const float*)(p.ws + WS_MOD); const bf16_t* OP = (const bf16_t*)(p.ws + WS_OPAIR);
    for (int tok = gw; tok < T_LAT; tok += ngw) {
        const int b = tok / S;
        f32x4 x[D / 256]; float ss = 0.f;
#pragma unroll
        for (int j = 0; j < D / 256; ++j) {
            const int k = j * 256 + lane * 4;
            const f32x4 hv = *(const f32x4*)(Hh + (size_t)tok * D + k), g2 = *(const f32x4*)(mod + (size_t)b * 6 * D + 5 * D + k);
            const u32x2 p0 = *(const u32x2*)(OP + (size_t)(tok * 2) * D + k), p1 = *(const u32x2*)(OP + (size_t)(tok * 2 + 1) * D + k);
            f32x4 m;
            m.x = bf2f((bf16_t)(p0.x & 0xffffu)) + bf2f((bf16_t)(p1.x & 0xffffu)); m.y = bf2f((bf16_t)(p0.x >> 16)) + bf2f((bf16_t)(p1.x >> 16));
            m.z = bf2f((bf16_t)(p0.y & 0xffffu)) + bf2f((bf16_t)(p1.y & 0xffffu)); m.w = bf2f((bf16_t)(p0.y >> 16)) + bf2f((bf16_t)(p1.y >> 16));
            x[j].x = hv.x + g2.x * m.x; x[j].y = hv.y + g2.y * m.y; x[j].z = hv.z + g2.z * m.z; x[j].w = hv.w + g2.w * m.w;
            ss += x[j].x * x[j].x + x[j].y * x[j].y + x[j].z * x[j].z + x[j].w * x[j].w;
        }
        ss = wave_sum(ss);
        const float rstd = 1.0f / sqrtf(ss * (1.0f / D) + 1e-6f);
#pragma unroll
        for (int j = 0; j < D / 256; ++j) {
            const int k = j * 256 + lane * 4; const f32x4 g = *(const f32x4*)(p.in[I_FIN] + k);
            f32x4 o; o.x = x[j].x * rstd * g.x; o.y = x[j].y * rstd * g.y; o.z = x[j].z * rstd * g.z; o.w = x[j].w * rstd * g.w;
            *(f32x4*)(p.out + (size_t)tok * D + k) = o;
        }
    }
}

DI void run_phase(const Params& p, int ph, char* smem) {
    switch (ph) {
        case PH_MOD: phase0(p, smem); break;
        case PH_U: phase1(p, smem); break;
        case PH_P: phase2(p, smem); break;
        case PH_HALO: phase_halo(p, smem); break;
        case PH_FIR: phase_fir(p, smem); break;
        case PH_CHAINS: phase3(p, smem); break;
        case PH_POST: phase4(p, smem); break;
        case PH_MERGE: phase5(p, smem); break;
        case PH_WOUT: phase6(p, smem); break;
        case PH_ROUTER: phase7(p, smem); break;
        case PH_UP: phase8(p, smem); break;
        case PH_DOWN: phase9(p, smem); break;
        default: phase10(p, smem); break;
    }
}

#ifndef EMU
namespace cg = cooperative_groups;
DI void grid_barrier_fast(unsigned* ctr, unsigned target) {
    asm volatile("s_waitcnt vmcnt(0)" ::: "memory");
    __syncthreads();
    if (tid_x() == 0) {
        __builtin_amdgcn_fence(__ATOMIC_RELEASE, "agent");
        asm volatile("s_waitcnt vmcnt(0)" ::: "memory");
        __hip_atomic_fetch_add(ctr, 1u, __ATOMIC_RELAXED, __HIP_MEMORY_SCOPE_AGENT);
        unsigned spins = 0;
        while (__hip_atomic_load(ctr, __ATOMIC_RELAXED, __HIP_MEMORY_SCOPE_AGENT) < target) { __builtin_amdgcn_s_sleep(1); if (++spins > (1u << 24)) break; }
        __builtin_amdgcn_fence(__ATOMIC_ACQUIRE, "agent");
        asm volatile("s_waitcnt vmcnt(0)" ::: "memory");
    }
    __syncthreads();
}
__global__ void __launch_bounds__(NTHREADS) mk_forward(Params p) {
    extern __shared__ __attribute__((aligned(16))) char smem[];
    cg::grid_group grid = cg::this_grid();
    typedef const Params __attribute__((address_space(4)))* KPtr;
#define PHASE(k, fn) { KPtr kp = (KPtr)__builtin_amdgcn_kernarg_segment_ptr(); asm volatile("" : "+s"(kp)); fn(*(const Params*)kp, smem); \
        if ((k) == 0) grid.sync(); else if ((k) + 1 < NPHASES) grid_barrier_fast((unsigned*)(((const Params*)kp)->ws + WS_BAR), (unsigned)(k) * gridDim.x); }
    PHASE(0, phase0) PHASE(1, phase1) PHASE(2, phase2) PHASE(3, phase_halo) PHASE(4, phase_fir) PHASE(5, phase3) PHASE(6, phase4)
    PHASE(7, phase5) PHASE(8, phase6) PHASE(9, phase7) PHASE(10, phase8) PHASE(11, phase9) PHASE(12, phase10)
#undef PHASE
}

extern "C" void kernel_launch(void* const* d_in, const int* in_sizes, int n_in, void* d_out, int out_size, void* d_ws, size_t ws_size, hipStream_t stream) {
    static int grid_blocks = 0;
    if (grid_blocks == 0) {
        if (n_in != 35 || out_size != T_LAT * D || ws_size < WS_END || (size_t)out_size * 4 < AUX_END) {
            fprintf(stderr, "kernel_launch: unexpected shapes (n_in %d out %d ws %zu need %zu aux need %zu)\n", n_in, out_size, ws_size, (size_t)WS_END, (size_t)AUX_END);
            grid_blocks = -1; return;
        }
        int dev = 0, cus = 0, per_cu = 0;
        hipGetDevice(&dev);
        hipDeviceGetAttribute(&cus, hipDeviceAttributeMultiprocessorCount, dev);
        hipFuncSetAttribute((const void*)mk_forward, hipFuncAttributeMaxDynamicSharedMemorySize, LDS_BYTES);
        hipOccupancyMaxActiveBlocksPerMultiprocessor(&per_cu, (const void*)mk_forward, NTHREADS, LDS_BYTES);
        if (per_cu < 1) { fprintf(stderr, "kernel_launch: occupancy query says %d blocks/CU\n", per_cu); per_cu = 1; }
        if (per_cu > 1) per_cu = 1;
        grid_blocks = cus * per_cu;
    }
    if (grid_blocks < 0) return;
    Params p{};
    for (int i = 0; i < 35; ++i) p.in[i] = (const float*)d_in[i];
    p.out = (float*)d_out; p.ws = (char*)d_ws; p.aux = (char*)d_out;
    p.ph_lo = 0; p.ph_hi = NPHASES;
    void* args[] = {&p};
    hipError_t e = hipLaunchCooperativeKernel((const void*)mk_forward, dim3(grid_blocks), dim3(NTHREADS), args, LDS_BYTES, stream);
    if (e != hipSuccess) fprintf(stderr, "cooperative launch failed: %s (grid %d)\n", hipGetErrorString(e), grid_blocks);
}
#endif
```

```cpp
#ifndef EMU
#include <hip/hip_runtime.h>
#include <hip/hip_cooperative_groups.h>
#include <cstdio>
#endif
#include <stdint.h>
#include <stddef.h>

#ifndef CFG_D
#define CFG_D 1024
#define CFG_B 8
#define CFG_S 2048
#define CFG_CTX 256
#endif
#ifndef MK_LAUNCHES
#define MK_LAUNCHES 1
#endif

typedef unsigned short bf16_t;
typedef short bf16x8 __attribute__((ext_vector_type(8)));
typedef float f32x4 __attribute__((ext_vector_type(4)));
typedef unsigned u32x4 __attribute__((ext_vector_type(4)));
typedef unsigned u32x2 __attribute__((ext_vector_type(2)));

#define DI __device__ __forceinline__
DI int tid_x() { int t = (int)threadIdx.x;
#ifndef EMU
    asm volatile("" : "+v"(t));
#endif
    return t; }

constexpr int D = CFG_D, NB = CFG_B, S = CFG_S, CTXL = CFG_CTX;
constexpr int GW = 64, ROWS = S / GW;
constexpr int T_CTX = NB * CTXL, T_LAT = NB * S, T_ALL = T_CTX + T_LAT;
constexpr int H_A = 4, H_B = 8;
constexpr int A_COLS = 2064, B_COLS = 1920;
constexpr int IN_COLS = A_COLS + B_COLS + 2 * D;
constexpr int COL_B0 = A_COLS, COL_G0 = A_COLS + B_COLS;
constexpr int CTX_COLS = COL_G0;
constexpr int NP = ((IN_COLS + 127) / 128) * 128;
constexpr int NEXP = 32, DE = 256;
constexpr int NV = NB + 1;
constexpr int NTHREADS = 512;
constexpr int MREP = (T_CTX % 256 == 0 && T_LAT % 256 == 0) ? 4 : 2;
constexpr int BM = 64 * MREP;
constexpr int NPHASES = 13;
enum { PH_MOD = 0, PH_U, PH_P, PH_HALO, PH_FIR, PH_CHAINS, PH_POST, PH_MERGE, PH_WOUT, PH_ROUTER, PH_UP, PH_DOWN, PH_FINAL };
constexpr int LDS_BYTES = 155648;
constexpr int CAP = T_LAT;

static_assert(D % 256 == 0 && S % 64 == 0 && CTXL % 64 == 0 && T_CTX % BM == 0 && T_LAT % BM == 0, "shape");

constexpr size_t al256(size_t x) { return (x + 255) & ~(size_t)255; }
constexpr size_t WS_CNT = 0;
constexpr size_t WS_BAR = 256;
constexpr size_t WS_XBAR = 512;
constexpr size_t WS_MOD = 512 + 3456 * 4 + 256;
constexpr size_t WS_AB = al256(WS_MOD + (size_t)NV * 6 * D * 4);
constexpr size_t WS_BONUS = al256(WS_AB + (size_t)T_ALL * 16 * 4);
constexpr size_t WS_PAIRW = al256(WS_BONUS + (size_t)2 * T_LAT * 8 * 4);
constexpr size_t WS_ROWLIST = al256(WS_PAIRW + (size_t)T_LAT * 2 * 4);
constexpr size_t WS_WRT = al256(WS_ROWLIST + (size_t)NEXP * CAP * 4);
constexpr size_t WS_G2T = al256(WS_WRT + (size_t)36 * D * 4);
constexpr size_t WS_WOA = al256(WS_G2T + (size_t)512 * 128 * 2);
constexpr size_t WS_WOB = al256(WS_WOA + (size_t)D * 512 * 2);
constexpr size_t WS_WOUT = al256(WS_WOB + (size_t)D * 512 * 2);
constexpr size_t WS_OA = al256(WS_WOUT + (size_t)D * D * 2);
constexpr size_t WS_OB = al256(WS_OA + (size_t)T_LAT * 512 * 2);
constexpr size_t WS_HALO_A = WS_OA;
constexpr size_t WS_HALO_B = WS_OA + al256((size_t)(T_ALL / 64) * 4 * 1536 * 2);
static_assert(WS_HALO_B + (size_t)(T_ALL / 64) * 2 * 1920 * 2 <= WS_OB + (size_t)T_LAT * 512 * 2, "halo buffers");
constexpr size_t WS_DNT = WS_OA;
constexpr size_t WS_SPARE_END = al256(WS_OB + (size_t)T_LAT * 512 * 2) > al256(WS_DNT + (size_t)NEXP * D * DE * 2) ? al256(WS_OB + (size_t)T_LAT * 512 * 2) : al256(WS_DNT + (size_t)NEXP * D * DE * 2);
constexpr size_t WS_P = WS_SPARE_END;
constexpr size_t WS_PLAT = WS_P;
constexpr size_t WS_PCTX = al256(WS_PLAT + (size_t)T_LAT * IN_COLS * 2);
constexpr size_t WS_P_END = al256(WS_PCTX + (size_t)T_CTX * CTX_COLS * 2);
constexpr size_t WS_H = WS_P;
constexpr size_t WS_T = al256(WS_H + (size_t)T_LAT * D * 4);
constexpr size_t WS_HID = al256(WS_T + (size_t)T_LAT * D * 2);
constexpr size_t WS_OPAIR = al256(WS_HID + (size_t)T_LAT * 2 * DE * 2);
constexpr size_t WS_P2_END = al256(WS_OPAIR + (size_t)T_LAT * 2 * D * 2);
constexpr size_t WS_END = WS_P_END > WS_P2_END ? WS_P_END : WS_P2_END;
constexpr size_t AUX_WINT = 0;
constexpr size_t AUX_U = al256((size_t)NP * D * 2);
constexpr size_t AUX_ODIR = 0;
constexpr size_t AUX_YDIR = (size_t)2 * T_LAT * 512 * 2;
constexpr size_t AUX_Y = 0;
constexpr size_t AUX_GUT = (size_t)T_LAT * D * 2;
constexpr size_t AUX_END1 = AUX_U + (size_t)T_ALL * D * 2;
constexpr size_t AUX_END2 = AUX_YDIR + (size_t)2 * T_LAT * 512 * 2;
constexpr size_t AUX_END3 = AUX_GUT + (size_t)NEXP * 512 * D * 2;
constexpr size_t AUX_END = (AUX_END1 > AUX_END2 ? (AUX_END1 > AUX_END3 ? AUX_END1 : AUX_END3) : (AUX_END2 > AUX_END3 ? AUX_END2 : AUX_END3));

struct Params {
    const float* in[35];
    float* out;
    char* ws;
    char* aux;
    int ph_lo, ph_hi;
};
enum { I_X = 0, I_C, I_CTX, I_CCTX, I_ADAW, I_ADAB, I_NMIX, I_NFFN, I_WIN, I_CONV, I_ALOG, I_DTB, I_ONORM, I_MU, I_W0, I_W2, I_A0, I_A2, I_G2, I_KK, I_KA, I_RK, I_LNG, I_LNB, I_WOA, I_WOB, I_WOUT, I_RG, I_RGB, I_RE, I_REB, I_MG, I_MU_UP, I_MD, I_FIN };

DI float bf2f(bf16_t v) { union { unsigned u; float f; } x; x.u = ((unsigned)v) << 16; return x.f; }
#ifdef EMU
DI bf16_t f2bf(float f) { union { float f; unsigned u; } x; x.f = f; unsigned u = x.u; u += 0x7fffu + ((u >> 16) & 1u); return (bf16_t)(u >> 16); }
DI unsigned pk2(float lo, float hi) { return (unsigned)f2bf(lo) | ((unsigned)f2bf(hi) << 16); }
#else
typedef __bf16 hbf16x2 __attribute__((ext_vector_type(2)));
typedef float f32x2_ __attribute__((ext_vector_type(2)));
DI bf16_t f2bf(float f) { return __builtin_bit_cast(unsigned short, (__bf16)f); }
DI unsigned pk2(float lo, float hi) { const f32x2_ v = {lo, hi}; return __builtin_bit_cast(unsigned, __builtin_convertvector(v, hbf16x2)); }
#endif
DI float sigmoidf_(float x) { return 1.0f / (1.0f + expf(-x)); }
DI float siluf_(float x) { return x / (1.0f + expf(-x)); }
DI float softplusf_(float x) { return x > 20.f ? x : log1pf(expf(x)); }
DI float wave_sum(float v) {
#pragma unroll
    for (int o = 1; o < 64; o <<= 1) v += __shfl_xor(v, o);
    return v;
}
#ifdef EMU
#define MFMA16(a, b, c) emu_mfma16((a), (b), (c))
#define WAVE_SYNC() emu::wave_bar()
#else
#define MFMA16(a, b, c) __builtin_amdgcn_mfma_f32_16x16x32_bf16((a), (b), (c), 0, 0, 0)
#define WAVE_SYNC() asm volatile("s_waitcnt lgkmcnt(0)" ::: "memory")
#endif
#ifdef EMU
#define LDS_BARRIER() __syncthreads()
#else
#define LDS_BARRIER() do { asm volatile("s_waitcnt lgkmcnt(0)" ::: "memory"); __builtin_amdgcn_s_barrier(); asm volatile("" ::: "memory"); } while (0)
#endif

constexpr int LDS_ROW = 40;
constexpr int GEMM_A_BYTES = BM * LDS_ROW * 2, GEMM_B_BYTES = 128 * LDS_ROW * 2;
template <int MR, class ARow>
DI void gemm_kloop(f32x4 (&acc)[MR][4], char* smem, ARow arow, const bf16_t* Bt, int ldb, int K) {
    constexpr int BM = 64 * MR;
    const int tid = tid_x(), lane = tid & 63, wave = tid >> 6, wr = wave >> 1, wc = wave & 1, fr = lane & 15, fq = lane >> 4;
    bf16_t* As = (bf16_t*)smem;
    bf16_t* Bs = (bf16_t*)(smem + 2 * GEMM_A_BYTES);
    constexpr int ACH = BM * 4 / NTHREADS;
    static_assert(ACH >= 1, "tile");
    const bf16_t* ap[ACH];
#pragma unroll
    for (int i = 0; i < ACH; ++i) { const int q = tid + i * NTHREADS; ap[i] = arow(q >> 2) + (q & 3) * 8; }
    const bf16_t* bp = Bt + (size_t)(tid >> 2) * ldb + (tid & 3) * 8;
    u32x4 ra[ACH], rb;
#pragma unroll
    for (int i = 0; i < ACH; ++i) ra[i] = *(const u32x4*)(ap[i]);
    rb = *(const u32x4*)(bp);
    const int nk = K / 32;
    for (int kt = 0; kt < nk; ++kt) {
        const int buf = kt & 1;
#pragma unroll
        for (int i = 0; i < ACH; ++i) { const int q = tid + i * NTHREADS; *(u32x4*)(As + (buf * BM + (q >> 2)) * LDS_ROW + (q & 3) * 8) = ra[i]; }
        *(u32x4*)(Bs + (buf * 128 + (tid >> 2)) * LDS_ROW + (tid & 3) * 8) = rb;
        __syncthreads();
        if (kt + 1 < nk) {
#pragma unroll
            for (int i = 0; i < ACH; ++i) ra[i] = *(const u32x4*)(ap[i] + (kt + 1) * 32);
            rb = *(const u32x4*)(bp + (kt + 1) * 32);
        }
        bf16x8 af[MR], bfr[4];
#pragma unroll
        for (int m = 0; m < MR; ++m) af[m] = *(const bf16x8*)(As + (buf * BM + wr * 16 * MR + m * 16 + fr) * LDS_ROW + fq * 8);
#pragma unroll
        for (int n = 0; n < 4; ++n) bfr[n] = *(const bf16x8*)(Bs + (buf * 128 + wc * 64 + n * 16 + fr) * LDS_ROW + fq * 8);
#pragma unroll
        for (int m = 0; m < MR; ++m)
#pragma unroll
            for (int n = 0; n < 4; ++n) acc[m][n] = MFMA16(af[m], bfr[n], acc[m][n]);
    }
    __syncthreads();
}
template <int MR>
DI void acc_zero(f32x4 (&acc)[MR][4]) {
#pragma unroll
    for (int m = 0; m < MR; ++m)
#pragma unroll
        for (int n = 0; n < 4; ++n) acc[m][n] = (f32x4){0.f, 0.f, 0.f, 0.f};
}

namespace g8 {
constexpr int BM = 256, BK = 64, HALF = 128, HT = HALF * BK;
constexpr int LDS_NEED = 8 * HT * 2;
DI int lds_byte(int r, int c) { const int st = (r >> 4) * 2 + (c >> 5), rr = r & 15, cc = c & 31, ob = rr * 64 + cc * 2; return st * 1024 + (ob ^ (((ob >> 9) & 1) << 5)); }
DI void stage_rc(int b, int& R, int& C) { const int st = b / 1024, sb = b % 1024, swz = sb ^ (((sb >> 9) & 1) << 5); R = (st >> 1) * 16 + swz / 64; C = (st & 1) * 32 + (swz % 64) / 2; }
#ifdef EMU
#define G8_GLDS(src, dst) emu_global_load_lds16((src), (dst))
#define G8_WAIT_V(n)
#define G8_WAIT_L(n)
#define G8_BAR __syncthreads()
#define G8_SCHED
#define G8_PRIO(x)
#else
#define G8_GLDS(src, dst) __builtin_amdgcn_global_load_lds((const unsigned*)(src), (__attribute__((address_space(3))) unsigned*)(dst), 16, 0, 0)
#define G8_WAIT_V(n) asm volatile("s_waitcnt vmcnt(" #n ")" ::: "memory")
#define G8_WAIT_L(n) asm volatile("s_waitcnt lgkmcnt(" #n ")" ::: "memory")
#define G8_BAR __builtin_amdgcn_s_barrier()
#define G8_SCHED __builtin_amdgcn_sched_barrier(0)
#define G8_PRIO(x) __builtin_amdgcn_s_setprio(x)
#endif
typedef f32x4 Acc[2][2][4][2];
template <class AOff>
DI void kloop_g(Acc& acc, char* smem, const bf16_t* A, AOff aoff, const bf16_t* Bt, int ldb, int K, int bcol) {
    bf16_t* shm = (bf16_t*)smem;
    const int tid = tid_x(), wid = tid >> 6, lane = tid & 63, wr = wid >> 2, wc = wid & 3, fr = lane & 15, fq = lane >> 4;
    int ao[2][2];
#pragma unroll
    for (int h = 0; h < 2; ++h)
#pragma unroll
        for (int i = 0; i < 2; ++i) { int R, C; stage_rc(tid * 16 + i * 8192, R, C); ao[h][i] = aoff(h * HALF + R) + C; }
#define G8_STAGE_A(P, h, kt) do { for (int _i = 0; _i < 2; ++_i) { const int _b = tid * 16 + _i * 8192; G8_GLDS(A + (size_t)ao[h][_i] + (size_t)(kt) * BK, (char*)(P) + _b); } } while (0)
#define G8_SA(b, h) (shm + ((b) * 2 + (h)) * HT)
#define G8_SB(b, h) (shm + (4 + (b) * 2 + (h)) * HT)
#define G8_STAGE(P, BASE, LD, br, kt) do { const bf16_t* _g = (BASE) + (size_t)(br) * (LD) + (size_t)(kt) * BK; \
    for (int _i = 0; _i < 2; ++_i) { const int _b = tid * 16 + _i * 8192; int _r, _c; stage_rc(_b, _r, _c); G8_GLDS(_g + (size_t)_r * (LD) + _c, (char*)(P) + _b); } } while (0)
#define G8_LDA(dst, b, h) for (int m = 0; m < 4; ++m) for (int k = 0; k < 2; ++k) dst[m][k] = *(const bf16x8*)((const char*)G8_SA(b, h) + lds_byte(wr * 64 + m * 16 + fr, k * 32 + fq * 8))
#define G8_LDB(dst, b, h) for (int n = 0; n < 2; ++n) for (int k = 0; k < 2; ++k) dst[n][k] = *(const bf16x8*)((const char*)G8_SB(b, h) + lds_byte(wc * 32 + n * 16 + fr, k * 32 + fq * 8))
#define G8_MMA(ai, bj, At_, Bt_) do { G8_PRIO(1); for (int m = 0; m < 4; ++m) for (int n = 0; n < 2; ++n) for (int k = 0; k < 2; ++k) \
    acc[ai][bj][m][n] = MFMA16(Bt_[n][k], At_[m][k], acc[ai][bj][m][n]); G8_PRIO(0); } while (0)
    bf16x8 At[4][2], B0[2][2], B1[2][2];
    const int nt = K / BK;
    G8_STAGE(G8_SB(0, 0), Bt, ldb, bcol, 0); G8_STAGE_A(G8_SA(0, 0), 0, 0);
    G8_STAGE(G8_SB(0, 1), Bt, ldb, bcol + HALF, 0); G8_STAGE_A(G8_SA(0, 1), 1, 0);
    if (wr == 1) G8_BAR;
    G8_WAIT_V(4); G8_BAR;
    G8_STAGE(G8_SB(1, 0), Bt, ldb, bcol, 1); G8_STAGE_A(G8_SA(1, 0), 0, 1); G8_STAGE(G8_SB(1, 1), Bt, ldb, bcol + HALF, 1);
    G8_WAIT_V(6); G8_BAR;
    for (int t = 0; t < nt - 2; t += 2) {
        G8_LDB(B0, 0, 0); G8_SCHED; G8_LDA(At, 0, 0); G8_STAGE_A(G8_SA(1, 1), 1, t + 1);
        G8_WAIT_L(8); G8_BAR; G8_WAIT_L(0); G8_MMA(0, 0, At, B0); G8_BAR; G8_SCHED;
        G8_LDB(B1, 0, 1); G8_STAGE(G8_SB(0, 0), Bt, ldb, bcol, t + 2);
        G8_BAR; G8_WAIT_L(0); G8_MMA(0, 1, At, B1); G8_BAR;
        G8_LDA(At, 0, 1); G8_STAGE_A(G8_SA(0, 0), 0, t + 2);
        G8_BAR; G8_WAIT_L(0); G8_MMA(1, 0, At, B0); G8_BAR; G8_SCHED;
        G8_STAGE(G8_SB(0, 1), Bt, ldb, bcol + HALF, t + 2);
        G8_WAIT_V(6); G8_BAR; G8_MMA(1, 1, At, B1); G8_BAR;
        G8_LDB(B0, 1, 0); G8_SCHED; G8_LDA(At, 1, 0); G8_STAGE_A(G8_SA(0, 1), 1, t + 2);
        G8_WAIT_L(8); G8_BAR; G8_WAIT_L(0); G8_MMA(0, 0, At, B0); G8_BAR; G8_SCHED;
        G8_LDB(B1, 1, 1); G8_STAGE(G8_SB(1, 0), Bt, ldb, bcol, t + 3);
        G8_BAR; G8_WAIT_L(0); G8_MMA(0, 1, At, B1); G8_BAR;
        G8_LDA(At, 1, 1); G8_STAGE_A(G8_SA(1, 0), 0, t + 3);
        G8_BAR; G8_WAIT_L(0); G8_MMA(1, 0, At, B0); G8_BAR; G8_SCHED;
        G8_STAGE(G8_SB(1, 1), Bt, ldb, bcol + HALF, t + 3);
        G8_WAIT_V(6); G8_BAR; G8_MMA(1, 1, At, B1); G8_BAR;
    }
    { G8_LDB(B0, 0, 0); G8_LDA(At, 0, 0); G8_STAGE_A(G8_SA(1, 1), 1, nt - 1);
      G8_BAR; G8_WAIT_L(0); G8_MMA(0, 0, At, B0); G8_BAR;
      G8_LDB(B1, 0, 1); G8_BAR; G8_WAIT_L(0); G8_MMA(0, 1, At, B1); G8_BAR;
      G8_LDA(At, 0, 1); G8_WAIT_V(4); G8_BAR; G8_WAIT_L(0); G8_MMA(1, 0, At, B0); G8_MMA(1, 1, At, B1); G8_BAR; }
    { G8_LDB(B0, 1, 0); G8_LDA(At, 1, 0); G8_WAIT_V(2); G8_BAR; G8_WAIT_L(0); G8_MMA(0, 0, At, B0); G8_BAR;
      G8_LDB(B1, 1, 1); G8_WAIT_V(0); G8_BAR; G8_WAIT_L(0); G8_MMA(0, 1, At, B1); G8_BAR;
      G8_LDA(At, 1, 1); G8_BAR; G8_WAIT_L(0); G8_MMA(1, 0, At, B0); G8_MMA(1, 1, At, B1); G8_BAR; }
    if (wr == 0) G8_BAR;
#undef G8_SA
#undef G8_SB
#undef G8_STAGE
#undef G8_STAGE_A
#undef G8_LDA
#undef G8_LDB
#undef G8_MMA
}
DI void kloop(Acc& acc, char* smem, const bf16_t* A, int lda, const bf16_t* Bt, int ldb, int K, int brow, int bcol) {
    kloop_g(acc, smem, A, [&](int r) { return (brow + r) * lda; }, Bt, ldb, K, bcol);
}
DI void acc_zero(Acc& acc) {
#pragma unroll
    for (int a = 0; a < 2; ++a)
#pragma unroll
        for (int b = 0; b < 2; ++b)
#pragma unroll
            for (int m = 0; m < 4; ++m)
#pragma unroll
                for (int n = 0; n < 2; ++n) acc[a][b][m][n] = (f32x4){0.f, 0.f, 0.f, 0.f};
}
template <class F> DI void for_each_quad(const Acc& acc, int brow, int bcol, F f) {
    const int tid = tid_x(), wid = tid >> 6, lane = tid & 63, wr = wid >> 2, wc = wid & 3, fr = lane & 15, fq = lane >> 4;
#pragma unroll
    for (int ai = 0; ai < 2; ++ai)
#pragma unroll
        for (int m = 0; m < 4; ++m)
#pragma unroll
            for (int bj = 0; bj < 2; ++bj)
#pragma unroll
                for (int n = 0; n < 2; ++n) f(brow + ai * HALF + wr * 64 + m * 16 + fr, bcol + bj * HALF + wc * 32 + n * 16 + fq * 4, acc[ai][bj][m][n]);
}
}

constexpr bool USE_G8 = ((NB * CTXL) % 256 == 0) && ((NB * S) % 256 == 0) && (NP % 256 == 0) && (D % 256 == 0) && (D >= 256);
DI int gu_row(int c, int up) {
    if (USE_G8) return (c >> 7) * 256 + ((c >> 6) & 1) * 128 + ((c >> 4) & 3) * 32 + (up ? 16 : 0) + (c & 15);
    return (c >> 6) * 128 + ((c >> 5) & 1) * 64 + ((c >> 4) & 1) * 16 + (c & 15) + (up ? 32 : 0);
}
DI void transpose_item(const float* W, int N, int Nvalid, int k0, int n0, bf16_t* WT, int ldt, int mode, float* scr, int lane) {
#pragma unroll 4
    for (int i = 0; i < 32; ++i) {
        const int kk = 2 * i + (lane >> 5), n = n0 + (lane & 31);
        scr[kk * 33 + (lane & 31)] = (n < Nvalid) ? W[(size_t)(k0 + kk) * N + n] : 0.f;
    }
    WAVE_SYNC();
    const int c = lane & 7;
#pragma unroll
    for (int j = 0; j < 4; ++j) {
        const int nl = (lane >> 3) + 8 * j; const float* s = scr + (8 * c) * 33 + nl;
        u32x4 o; o.x = pk2(s[0], s[33]); o.y = pk2(s[2 * 33], s[3 * 33]); o.z = pk2(s[4 * 33], s[5 * 33]); o.w = pk2(s[6 * 33], s[7 * 33]);
        const int n = n0 + nl; const int row = mode == 0 ? n : gu_row(n, mode == 2);
        *(u32x4*)(WT + (size_t)row * ldt + k0 + 8 * c) = o;
    }
    WAVE_SYNC();
}
DI void transpose_matrix(const float* W, int K, int N, int Npad, bf16_t* WT, int mode, char* smem, int gw, int ngw, int& base) {
    const int lane = tid_x() & 63, wave = tid_x() >> 6;
    float* scr = (float*)smem + wave * (64 * 33);
    const int nkb = K / 64, nnb = Npad / 32, nitems = nkb * nnb;
    int first = ((gw - base) % ngw + ngw) % ngw;
    for (int it = first; it < nitems; it += ngw) {
        const int kb = it / nnb, nb = it % nnb;
        transpose_item(W, N, N, kb * 64, nb * 32, WT, K, mode, scr, lane);
    }
    base = (base + nitems) % ngw;
}

DI void phase0(const Params& p, char* smem) {
    const int tid = tid_x(), lane = tid & 63, wave = tid >> 6;
    if (blockIdx.x == 0 && tid < NEXP) ((int*)(p.ws + WS_CNT))[tid] = 0;
    if (blockIdx.x == 0 && tid == 0) *(unsigned*)(p.ws + WS_BAR) = 0u;
    if (blockIdx.x == 0) for (int i = tid; i < 3456; i += NTHREADS) ((unsigned*)(p.ws + WS_XBAR))[i] = 0u;
    float* sil = (float*)smem;
    float* red = sil + NV * D;
    const int nitems = 6 * D / 32;
    bool did = false;
    for (int it = blockIdx.x; it < nitems; it += gridDim.x) {
        if (!did) {
            for (int i = tid; i < NV * D; i += NTHREADS) { const int v = i / D, k = i % D; const float cv = v < NB ? p.in[I_C][v * D + k] : p.in[I_CCTX][k]; sil[i] = siluf_(cv); }
            did = true;
        }
        __syncthreads();
        const int col = it * 32 + (lane & 31), rp = lane >> 5;
        float acc[NV];
#pragma unroll
        for (int v = 0; v < NV; ++v) acc[v] = 0.f;
        const int r0 = wave * (D / 8);
#pragma unroll 8
        for (int i = 0; i < D / 16; ++i) {
            const int row = r0 + 2 * i + rp; const float w = p.in[I_ADAW][(size_t)row * (6 * D) + col];
#pragma unroll
            for (int v = 0; v < NV; ++v) acc[v] += sil[v * D + row] * w;
        }
#pragma unroll
        for (int v = 0; v < NV; ++v) red[((wave * 2 + rp) * NV + v) * 32 + (lane & 31)] = acc[v];
        __syncthreads();
        if (tid < NV * 32) {
            const int v = tid / 32, cl = tid % 32; float s = p.in[I_ADAB][it * 32 + cl];
            for (int g = 0; g < 16; ++g) s += red[(g * NV + v) * 32 + cl];
            ((float*)(p.ws + WS_MOD))[(size_t)v * 6 * D + it * 32 + cl] = s;
        }
    }
    __syncthreads();
    const int gw = blockIdx.x * 8 + wave, ngw = gridDim.x * 8; int base = 0;
    {
        float* scr = (float*)smem + wave * (64 * 33);
        const int nkb = D / 64, nnb = NP / 32, nitems2 = nkb * nnb;
        for (int it = gw; it < nitems2; it += ngw) { const int kb = it / nnb, nb = it % nnb; transpose_item(p.in[I_WIN], IN_COLS, IN_COLS, kb * 64, nb * 32, (bf16_t*)(p.aux + AUX_WINT), D, 0, scr, lane); }
        base = nitems2 % ngw;
    }
    { float* WRT = (float*)(p.ws + WS_WRT);
      for (int i = blockIdx.x * NTHREADS + tid; i < 36 * D; i += gridDim.x * NTHREADS) { const int j = i / D, k = i % D; WRT[i] = j < 4 ? p.in[I_RG][(size_t)k * 4 + j] : p.in[I_RE][(size_t)k * 32 + (j - 4)]; } }
    transpose_matrix(p.in[I_WOA], 512, D, D, (bf16_t*)(p.ws + WS_WOA), 0, smem, gw, ngw, base);
    transpose_matrix(p.in[I_WOB], 512, D, D, (bf16_t*)(p.ws + WS_WOB), 0, smem, gw, ngw, base);
    transpose_matrix(p.in[I_WOUT], D, D, D, (bf16_t*)(p.ws + WS_WOUT), 0, smem, gw, ngw, base);
    transpose_matrix(p.in[I_G2], 128, 512, 512, (bf16_t*)(p.ws + WS_G2T), 0, smem, gw, ngw, base);
}

constexpr int NSEG = T_ALL / 64, NSEG_CTX = T_CTX / 64;
DI void halo_store(const Params& p, int row, int col, const u32x2& o) {
    int seq, b, j;
    if (row < T_CTX) { seq = 0; b = row / CTXL; j = row % CTXL; } else { seq = 1; const int rr = row - T_CTX; b = rr / S; j = rr % S; }
    const int L = seq ? S : CTXL; const int segbase = seq ? NSEG_CTX + b * (S / 64) : b * (CTXL / 64);
    if (col < 1536) {
        const int jm = j & 63;
        if (jm >= 62 && j + 2 < L) { const int g = segbase + (j >> 6) + 1; *(u32x2*)((bf16_t*)(p.ws + WS_HALO_A) + ((size_t)g * 4 + (jm - 62)) * 1536 + col) = o; }
        if (jm < 2 && j >= 64) { const int g = segbase + (j >> 6) - 1; *(u32x2*)((bf16_t*)(p.ws + WS_HALO_A) + ((size_t)g * 4 + 2 + jm) * 1536 + col) = o; }
    } else if (col >= COL_B0 && col < COL_B0 + 1920) {
        const int js = seq ? (j % GW) * ROWS + j / GW : j; const int jm = js & 63;
        if (jm == 63 && js + 1 < L) { const int g = segbase + (js >> 6) + 1; *(u32x2*)((bf16_t*)(p.ws + WS_HALO_B) + ((size_t)g * 2 + 0) * 1920 + (col - COL_B0)) = o; }
        if (jm == 0 && js >= 64) { const int g = segbase + (js >> 6) - 1; *(u32x2*)((bf16_t*)(p.ws + WS_HALO_B) + ((size_t)g * 2 + 1) * 1920 + (col - COL_B0)) = o; }
    }
}
DI void halo_zero_fill(const Params& p) {
    const int tid = tid_x(), lane = tid & 63, wave = tid >> 6; const int gw = blockIdx.x * 8 + wave, ngw = gridDim.x * 8;
    bf16_t* HA = (bf16_t*)(p.ws + WS_HALO_A); bf16_t* HB = (bf16_t*)(p.ws + WS_HALO_B);
    for (int it = gw; it < NSEG * 2; it += ngw) {
        const int g = it >> 1, side = it & 1;
        const bool ctx = g < NSEG_CTX; const int sg = ctx ? g % (CTXL / 64) : (g - NSEG_CTX) % (S / 64); const int nsg = ctx ? CTXL / 64 : S / 64;
        const bool edge = side ? (sg == nsg - 1) : (sg == 0);
        if (!edge) continue;
        for (int c = lane; c < 384; c += 64) *(u32x4*)(HA + ((size_t)g * 4 + 2 * side) * 1536 + c * 8) = (u32x4){0u, 0u, 0u, 0u};
        for (int c = lane; c < 240; c += 64) *(u32x4*)(HB + ((size_t)g * 2 + side) * 1920 + c * 8) = (u32x4){0u, 0u, 0u, 0u};
    }
}
DI void phase1(const Params& p, char* smem) {
    if (USE_G8) halo_zero_fill(p);
    const int lane = tid_x() & 63, wave = tid_x() >> 6;
    const int gw = blockIdx.x * 8 + wave, ngw = gridDim.x * 8;
    const float* mod = (const float*)(p.ws + WS_MOD);
    bf16_t* U = (bf16_t*)(p.aux + AUX_U);
    for (int r = gw; r < T_ALL; r += ngw) {
        const float* src; int v;
        if (r < T_CTX) { src = p.in[I_CTX] + (size_t)r * D; v = NB; } else { src = p.in[I_X] + (size_t)(r - T_CTX) * D; v = (r - T_CTX) / S; }
        f32x4 x[D / 256]; float ss = 0.f;
#pragma unroll
        for (int j = 0; j < D / 256; ++j) { x[j] = *(const f32x4*)(src + j * 256 + lane * 4); ss += x[j].x * x[j].x + x[j].y * x[j].y + x[j].z * x[j].z + x[j].w * x[j].w; }
        ss = wave_sum(ss);
        const float rstd = 1.0f / sqrtf(ss * (1.0f / D) + 1e-6f);
#pragma unroll
        for (int j = 0; j < D / 256; ++j) {
            const int k = j * 256 + lane * 4;
            const f32x4 g = *(const f32x4*)(p.in[I_NMIX] + k), sh = *(const f32x4*)(mod + (size_t)v * 6 * D + k), sc = *(const f32x4*)(mod + (size_t)v * 6 * D + D + k);
            float o0 = x[j].x * rstd * g.x * (1.f + sc.x) + sh.x, o1 = x[j].y * rstd * g.y * (1.f + sc.y) + sh.y;
            float o2 = x[j].z * rstd * g.z * (1.f + sc.z) + sh.z, o3 = x[j].w * rstd * g.w * (1.f + sc.w) + sh.w;
            u32x2 o; o.x = pk2(o0, o1); o.y = pk2(o2, o3);
            *(u32x2*)(U + (size_t)r * D + k) = o;
        }
    }
}

DI void phase2(const Params& p, char* smem) {
    const bf16_t* U = (const bf16_t*)(p.aux + AUX_U); const bf16_t* WT = (const bf16_t*)(p.aux + AUX_WINT);
    bf16_t* PL = (bf16_t*)(p.ws + WS_PLAT); bf16_t* PC = (bf16_t*)(p.ws + WS_PCTX); float* AB = (float*)(p.ws + WS_AB);
    if (USE_G8) {
        constexpr int NT = NP / 256, MT = T_ALL / 256, NT_CTX = (CTX_COLS + 255) / 256;
        for (int t = blockIdx.x; t < MT * NT; t += gridDim.x) {
            const int mt = t / NT, nt = t % NT, brow = mt * 256, bcol = nt * 256; const bool isctx = brow < T_CTX;
            if (isctx && nt >= NT_CTX) continue;
            g8::Acc acc; g8::acc_zero(acc);
            g8::kloop(acc, smem, U, D, WT, D, D, brow, bcol);
            g8::for_each_quad(acc, brow, bcol, [&](int row, int col, const f32x4& v) {
                u32x2 o; o.x = pk2(v.x, v.y); o.y = pk2(v.z, v.w);
                if (isctx) { if (col < CTX_COLS) *(u32x2*)(PC + (size_t)row * CTX_COLS + col) = o; }
                else { if (col < IN_COLS) *(u32x2*)(PL + (size_t)(row - T_CTX) * IN_COLS + col) = o; }
                if (col >= 2048 && col < 2064) *(f32x4*)(AB + (size_t)row * 16 + (col - 2048)) = v;
                halo_store(p, row, col, o);
            });
        }
        return;
    }
    const int tid = tid_x(), lane = tid & 63, wave = tid >> 6, wr = wave >> 1, wc = wave & 1, fr = lane & 15, fq = lane >> 4;
    constexpr int NT = NP / 128, MT = T_ALL / BM, NT_CTX = (CTX_COLS + 127) / 128;
    for (int t = blockIdx.x; t < MT * NT; t += gridDim.x) {
        const int mt = t / NT, nt = t % NT; const int row0 = mt * BM; const bool isctx = row0 < T_CTX;
        if (isctx && nt >= NT_CTX) continue;
        f32x4 acc[MREP][4]; acc_zero(acc);
        gemm_kloop(acc, smem, [&](int i) { return U + (size_t)(row0 + i) * D; }, WT + (size_t)nt * 128 * D, D, D);
#pragma unroll
        for (int m = 0; m < MREP; ++m)
#pragma unroll
            for (int n = 0; n < 4; ++n)
#pragma unroll
                for (int j = 0; j < 4; ++j) {
                    const int row = row0 + wr * 16 * MREP + m * 16 + fq * 4 + j, col = nt * 128 + wc * 64 + n * 16 + fr; const float v = acc[m][n][j];
                    if (isctx) { if (col < CTX_COLS) PC[(size_t)row * CTX_COLS + col] = f2bf(v); }
                    else { if (col < IN_COLS) PL[(size_t)(row - T_CTX) * IN_COLS + col] = f2bf(v); }
                    if (col >= 2048 && col < 2064) AB[(size_t)row * 16 + (col - 2048)] = v;
                }
    }
}

typedef float f32x16 __attribute__((ext_vector_type(16)));
typedef float f32x2_ac __attribute__((ext_vector_type(2)));
typedef short bf16x4 __attribute__((ext_vector_type(4)));
#ifdef EMU
#define MFMA32(a, b, c) emu_mfma32((a), (b), (c))
DI float fexp(float x) { return expf(x); }
DI float flog(float x) { return logf(x); }
DI float frcp(float x) { return 1.0f / x; }
DI float frsq(float x) { return 1.0f / sqrtf(x); }
DI float wave_sum_fast(float v) { return wave_sum(v); }
#else
#define MFMA32(a, b, c) __builtin_amdgcn_mfma_f32_32x32x16_bf16((a), (b), (c), 0, 0, 0)
DI float fexp(float x) { return __expf(x); }
DI float flog(float x) { return __logf(x); }
DI float frcp(float x) { return __builtin_amdgcn_rcpf(x); }
DI float frsq(float x) { return __builtin_amdgcn_rsqf(x); }
#define DPP_ADD(v, ctrl) ((v) + __builtin_bit_cast(float, __builtin_amdgcn_update_dpp(0, __builtin_bit_cast(int, (v)), (ctrl), 0xf, 0xf, false)))
DI float wave_sum_fast(float v) {
    v = DPP_ADD(v, 0xB1); v = DPP_ADD(v, 0x4E); v = DPP_ADD(v, 0x141); v = DPP_ADD(v, 0x140);
    const int iv = __builtin_bit_cast(int, v);
    return (__builtin_bit_cast(float, __builtin_amdgcn_readlane(iv, 0)) + __builtin_bit_cast(float, __builtin_amdgcn_readlane(iv, 16))) +
           (__builtin_bit_cast(float, __builtin_amdgcn_readlane(iv, 32)) + __builtin_bit_cast(float, __builtin_amdgcn_readlane(iv, 48)));
}
#endif
DI float fsigmoid(float x) { return frcp(1.0f + fexp(-x)); }
DI float fsilu(float x) { return x * fsigmoid(x); }
DI float fsoftplus(float x) { return fmaxf(x, 0.f) + flog(1.f + fexp(-fabsf(x))); }
DI float ftanh(float x) { return 1.0f - 2.0f * frcp(1.0f + fexp(2.0f * x)); }

DI int crow(int g, int h) { return (g & 3) + 8 * (g >> 2) + 4 * h; }
template <int S_> DI bf16x8 pack_acc(const f32x16& x) {
    u32x4 r;
    r.x = pk2(x[8 * S_ + 0], x[8 * S_ + 1]); r.y = pk2(x[8 * S_ + 2], x[8 * S_ + 3]); r.z = pk2(x[8 * S_ + 4], x[8 * S_ + 5]); r.w = pk2(x[8 * S_ + 6], x[8 * S_ + 7]);
    return __builtin_bit_cast(bf16x8, r);
}
DI bf16x8 ld_nat(const bf16_t* row, int s, int h) { return *(const bf16x8*)(row + 16 * s + 8 * h); }
DI bf16x8 ld_perm(const bf16_t* row, int s, int h) {
    const bf16x4 lo = *(const bf16x4*)(row + 16 * s + 4 * h), hi = *(const bf16x4*)(row + 16 * s + 8 + 4 * h);
    return __builtin_shufflevector(lo, hi, 0, 1, 2, 3, 4, 5, 6, 7);
}
DI f32x16 zero16() { f32x16 z;
#pragma unroll
    for (int i = 0; i < 16; ++i) z[i] = 0.f;
    return z; }
#define TGET(i) ((i) < 16 ? t0[(i) & 15] : t1[(i) & 15])
DI void invert32_col(const float* Lf, f32x16& t0, f32x16& t1, int c) {
#pragma unroll
    for (int i = 0; i < 32; ++i) {
        float s0 = 0.f, s1 = 0.f, s2 = 0.f, s3 = 0.f;
#pragma unroll
        for (int j4 = 0; j4 < (i + 3) / 4; ++j4) {
            const f32x4 l = *(const f32x4*)(Lf + i * 32 + 4 * j4);
            if (4 * j4 + 0 < i) s0 += l.x * TGET(4 * j4 + 0);
            if (4 * j4 + 1 < i) s1 += l.y * TGET(4 * j4 + 1);
            if (4 * j4 + 2 < i) s2 += l.z * TGET(4 * j4 + 2);
            if (4 * j4 + 3 < i) s3 += l.w * TGET(4 * j4 + 3);
        }
        float sm = -((s0 + s1) + (s2 + s3));
#ifndef EMU
        asm volatile("" : "+v"(sm));
#endif
        const float v = (i > c) ? sm : (i == c ? 1.f : 0.f);
        if (i < 16) t0[i & 15] = v; else t1[i & 15] = v;
    }
}

DI void seg_info(int g, int& seq, int& b, int& j0) {
    if (g < NSEG_CTX) { seq = 0; b = g / (CTXL / 64); j0 = (g % (CTXL / 64)) * 64; } else { const int g2 = g - NSEG_CTX; seq = 1; b = g2 / (S / 64); j0 = (g2 % (S / 64)) * 64; }
}
DI const bf16_t* seq_row(const Params& p, int seq, int b, int j, bool scan_order) {
    if (seq) { const int l = scan_order ? (j % ROWS) * GW + j / ROWS : j; return (const bf16_t*)(p.ws + WS_PLAT) + (size_t)(b * S + l) * IN_COLS; }
    return (const bf16_t*)(p.ws + WS_PCTX) + (size_t)(b * CTXL + j) * CTX_COLS;
}
DI void phase_halo(const Params& p, char* smem) {
    if (USE_G8) return;
    const int tid = tid_x(), lane = tid & 63, wave = tid >> 6;
    const int gw = blockIdx.x * 8 + wave, ngw = gridDim.x * 8;
    bf16_t* HA = (bf16_t*)(p.ws + WS_HALO_A); bf16_t* HB = (bf16_t*)(p.ws + WS_HALO_B);
    for (int it = gw; it < NSEG * 6; it += ngw) {
        const int g = it / 6, hr = it % 6; int seq, b, j0; seg_info(g, seq, b, j0);
        const int L = seq ? S : CTXL;
        if (hr < 4) {
            const int j = hr < 2 ? j0 - 2 + hr : j0 + 62 + hr; const bool ok = j >= 0 && j < L;
            const bf16_t* src = seq_row(p, seq, b, ok ? j : 0, false);
            for (int c = lane; c < 192; c += 64) { u32x4 v = {0u, 0u, 0u, 0u}; if (ok) v = *(const u32x4*)(src + c * 8); *(u32x4*)(HA + ((size_t)g * 4 + hr) * 1536 + c * 8) = v; }
        } else {
            const int j = hr == 4 ? j0 - 1 : j0 + 64; const bool ok = j >= 0 && j < L;
            const bf16_t* src = seq_row(p, seq, b, ok ? j : 0, true) + COL_B0;
            for (int c = lane; c < 240; c += 64) { u32x4 v = {0u, 0u, 0u, 0u}; if (ok) v = *(const u32x4*)(src + c * 8); *(u32x4*)(HB + ((size_t)g * 2 + (hr - 4)) * 1920 + c * 8) = v; }
        }
    }
}
DI f32x2_ac unpk2(unsigned w) { return (f32x2_ac){bf2f((bf16_t)(w & 0xffffu)), bf2f((bf16_t)(w >> 16))}; }
DI void phase_fir(const Params& p, char* smem) {
    const int tid = tid_x(), lane = tid & 63, wave = tid >> 6;
    const int gw = blockIdx.x * 8 + wave, ngw = gridDim.x * 8;
    const bf16_t* HA = (const bf16_t*)(p.ws + WS_HALO_A); const bf16_t* HB = (const bf16_t*)(p.ws + WS_HALO_B);
    constexpr int NA = NSEG * 12, NBI = NSEG * 15;
    for (int it = gw; it < NA + NBI; it += ngw) {
        if (it < NA) {
            const int g = it / 12, sh = it % 12, s = sh >> 2, h = sh & 3; int seq, b, j0; seg_info(g, seq, b, j0);
            const int col = s * 512 + h * 128 + 2 * lane;
            const int ldp = seq ? IN_COLS : CTX_COLS;
            bf16_t* base = (bf16_t*)seq_row(p, seq, b, j0, false) + col;
            const bf16_t* hal = HA + (size_t)g * 4 * 1536 + col;
            f32x2_ac cw[5];
#pragma unroll
            for (int t = 0; t < 5; ++t) cw[t] = (f32x2_ac){p.in[I_CONV][t * 1536 + col], p.in[I_CONV][t * 1536 + col + 1]};
            unsigned win[20], nxt[16];
            win[0] = *(const unsigned*)(hal); win[1] = *(const unsigned*)(hal + 1536);
            win[2] = *(const unsigned*)(base); win[3] = *(const unsigned*)(base + ldp);
#pragma unroll
            for (int i = 0; i < 16; ++i) win[4 + i] = *(const unsigned*)(base + (size_t)(2 + i) * ldp);
#pragma unroll 1
            for (int blk = 0; blk < 4; ++blk) {
                if (blk < 3) {
#pragma unroll
                    for (int i = 0; i < 16; ++i) { const int t = 16 * blk + 18 + i; nxt[i] = t < 64 ? *(const unsigned*)(base + (size_t)t * ldp) : *(const unsigned*)(hal + (size_t)(2 + (t - 64)) * 1536); }
                }
#pragma unroll
                for (int i = 0; i < 16; ++i) {
                    f32x2_ac a = unpk2(win[i]) * cw[0];
#pragma unroll
                    for (int t = 1; t < 5; ++t) a += unpk2(win[i + t]) * cw[t];
                    float o0 = fsilu(a.x), o1 = fsilu(a.y);
                    if (s < 2) { const float sc = frsq(wave_sum_fast(o0 * o0 + o1 * o1) + 1e-6f) * (s == 0 ? 0.08838834764831845f : 1.0f); o0 *= sc; o1 *= sc; }
                    *(unsigned*)(base + (size_t)(16 * blk + i) * ldp) = pk2(o0, o1);
                }
#pragma unroll
                for (int i = 0; i < 4; ++i) win[i] = win[16 + i];
#pragma unroll
                for (int i = 0; i < 16; ++i) win[4 + i] = nxt[i];
            }
        } else {
            const int it2 = it - NA, g = it2 / 15, sl = it2 % 15; int seq, b, j0; seg_info(g, seq, b, j0);
            const int bcol = sl * 128 + 2 * lane, col = COL_B0 + bcol;
            const f32x2_ac mu2 = {p.in[I_MU][bcol], p.in[I_MU][bcol + 1]};
            const bf16_t* hal = HB + (size_t)g * 2 * 1920 + bcol;
            unsigned win[18], nxt[16];
            win[0] = *(const unsigned*)(hal); win[1] = *(const unsigned*)(seq_row(p, seq, b, j0, true) + col);
#pragma unroll
            for (int i = 0; i < 16; ++i) win[2 + i] = *(const unsigned*)(seq_row(p, seq, b, j0 + 1 + i, true) + col);
#pragma unroll 1
            for (int blk = 0; blk < 4; ++blk) {
                if (blk < 3) {
#pragma unroll
                    for (int i = 0; i < 16; ++i) { const int t = 16 * blk + 17 + i; nxt[i] = t < 64 ? *(const unsigned*)(seq_row(p, seq, b, j0 + t, true) + col) : *(const unsigned*)(hal + 1920); }
                }
#pragma unroll
                for (int i = 0; i < 16; ++i) {
                    const f32x2_ac cu = unpk2(win[i + 1]);
                    f32x2_ac x = cu + ((unpk2(win[i]) + unpk2(win[i + 2])) * 0.5f - cu) * mu2;
                    if (sl == 12) { x.x = ftanh(x.x); x.y = ftanh(x.y); }
                    *(unsigned*)((bf16_t*)seq_row(p, seq, b, j0 + 16 * blk + i, true) + col) = pk2(x.x, x.y);
                }
                win[0] = win[16]; win[1] = win[17];
#pragma unroll
                for (int i = 0; i < 16; ++i) win[2 + i] = nxt[i];
            }
        }
    }
}

constexpr int GC = 32;
constexpr int G_NT = (CTXL + S) / GC;
constexpr int LD128 = 136, LD64 = 72, LD32 = 40;
DI void chunk_pos(int x, int d, int& seg, int& j0) {
    constexpr int n0 = CTXL / GC, n1 = S / GC;
    if (x < n0) { seg = 0; j0 = (d ? n0 - 1 - x : x) * GC; } else { seg = 1; const int xx = x - n0; j0 = (d ? n1 - 1 - xx : xx) * GC; }
}

DI f32x16 invert32_blocked(const float* Lf, bf16_t* scr, int lane) {
    bf16_t* TD = scr; bf16_t* TDT = scr + 32 * LD32; bf16_t* LO = scr + 2 * 32 * LD32; bf16_t* P1T = scr + 3 * 32 * LD32;
    const int blk = lane >> 5, c = lane & 15, r = lane & 31, h = lane >> 5;
    f32x16 t;
    const float* Lb = Lf + (16 * blk) * 32 + 16 * blk;
#pragma unroll
    for (int i = 0; i < 16; ++i) {
        float s0 = 0.f, s1 = 0.f, s2 = 0.f, s3 = 0.f;
#pragma unroll
        for (int j4 = 0; j4 < (i + 3) / 4; ++j4) {
            const f32x4 l = *(const f32x4*)(Lb + i * 32 + 4 * j4);
            if (4 * j4 + 0 < i) s0 += l.x * t[4 * j4 + 0];
            if (4 * j4 + 1 < i) s1 += l.y * t[4 * j4 + 1];
            if (4 * j4 + 2 < i) s2 += l.z * t[4 * j4 + 2];
            if (4 * j4 + 3 < i) s3 += l.w * t[4 * j4 + 3];
        }
        float sm = -((s0 + s1) + (s2 + s3));
#ifndef EMU
        asm volatile("" : "+v"(sm));
#endif
        t[i] = (i > c) ? sm : (i == c ? 1.f : 0.f);
    }
    if (r < 16) {
#pragma unroll
        for (int i = 0; i < 16; ++i) { TD[(16 * blk + i) * LD32 + 16 * blk + c] = f2bf(t[i]); TD[(16 * blk + i) * LD32 + 16 * (1 - blk) + c] = 0; }
#pragma unroll
        for (int q = 0; q < 4; ++q) {
            u32x2 o; o.x = pk2(t[4 * q], t[4 * q + 1]); o.y = pk2(t[4 * q + 2], t[4 * q + 3]);
            *(u32x2*)(TDT + (16 * blk + c) * LD32 + 16 * blk + 4 * q) = o;
            *(u32x2*)(TDT + (16 * blk + c) * LD32 + 16 * (1 - blk) + 4 * q) = (u32x2){0u, 0u};
        }
    }
    {
        const int row = lane >> 1, half = lane & 1;
#pragma unroll
        for (int q = 0; q < 4; ++q) {
            u32x2 o = {0u, 0u};
            if (row >= 16 && half == 0) { const f32x4 l = *(const f32x4*)(Lf + row * 32 + 4 * q); o.x = pk2(l.x, l.y); o.y = pk2(l.z, l.w); }
            *(u32x2*)(LO + row * LD32 + 16 * half + 4 * q) = o;
        }
    }
    WAVE_SYNC();
    f32x16 p1 = zero16();
#pragma unroll
    for (int s = 0; s < 2; ++s) p1 = MFMA32(ld_nat(LO + r * LD32, s, h), ld_nat(TDT + r * LD32, s, h), p1);
#pragma unroll
    for (int q = 0; q < 4; ++q) { u32x2 o; o.x = pk2(p1[4 * q], p1[4 * q + 1]); o.y = pk2(p1[4 * q + 2], p1[4 * q + 3]); *(u32x2*)(P1T + r * LD32 + 8 * q + 4 * h) = o; }
    WAVE_SYNC();
    f32x16 p2 = zero16();
#pragma unroll
    for (int s = 0; s < 2; ++s) p2 = MFMA32(ld_nat(TD + r * LD32, s, h), ld_nat(P1T + r * LD32, s, h), p2);
    f32x16 tf;
#pragma unroll
    for (int g = 0; g < 16; ++g) tf[g] = bf2f(TD[crow(g, h) * LD32 + r]) - p2[g];
    return tf;
}
constexpr int GL_Q = 0;
constexpr int GL_KT = GL_Q + 2 * 32 * LD128 * 2;
constexpr int GL_VT = GL_KT + 2 * 128 * LD32 * 2;
constexpr int GL_K = GL_VT + 2 * 128 * LD32 * 2;
constexpr int GL_QKM = GL_K + 32 * LD128 * 2;
constexpr int GL_LF = GL_QKM + 2 * 32 * LD32 * 2;
constexpr int GL_TP = GL_LF + 32 * 32 * 4;
constexpr int GL_TPP = GL_TP + 32 * LD32 * 2;
constexpr int GL_WN = GL_TPP + 2 * 32 * LD32 * 2;
constexpr int GL_SC = GL_WN + 32 * LD128 * 2;
constexpr int GL_GC = GL_SC + 2 * 8 * 32 * 4;
constexpr int GL_CW = GL_GC + 8 * 32 * 4;
constexpr int GL_INV = GL_CW + 5 * 3 * 128 * 4;
constexpr int GL_RAW = GL_INV + 4 * 32 * LD32 * 2;
constexpr int GL_END = GL_RAW + 32 * 384 * 2;
static_assert(GL_END <= LDS_BYTES, "gdn lds");

DI void gdn_chain2(const Params& p, char* smem, int item) {
    const int d = item / (NB * H_A), b = (item / H_A) % NB, h = item % H_A;
    const int tid = tid_x(), lane = tid & 63, wave0_ = tid >> 6;
    bf16_t* Qs = (bf16_t*)(smem + GL_Q); bf16_t* KTs = (bf16_t*)(smem + GL_KT); bf16_t* VTs = (bf16_t*)(smem + GL_VT); bf16_t* Ks = (bf16_t*)(smem + GL_K);
    bf16_t* QKMs = (bf16_t*)(smem + GL_QKM); float* Lf = (float*)(smem + GL_LF); bf16_t* Tp = (bf16_t*)(smem + GL_TP); bf16_t* Tpp = (bf16_t*)(smem + GL_TPP);
    bf16_t* Wn = (bf16_t*)(smem + GL_WN); float* SC = (float*)(smem + GL_SC); float* GCs = (float*)(smem + GL_GC); float* CW = (float*)(smem + GL_CW);
    const float alog = p.in[I_ALOG][d * 4 + h], dtb = p.in[I_DTB][d * 4 + h], negea = -expf(alog);
    bf16_t* ODIR = (bf16_t*)(p.aux + AUX_ODIR);
    __syncthreads();
    f32x16 St[4];
#pragma unroll
    for (int ct = 0; ct < 4; ++ct) St[ct] = zero16();
    bf16_t* RAW = (bf16_t*)(smem + GL_RAW);
    float pa = 0.f, pbt = 0.f;
    auto prefetch = [&](int x, int wsel, int nw) {
        int seg, j0; chunk_pos(x, d, seg, j0);
        const int ldp = seg ? IN_COLS : CTX_COLS;
        const bf16_t* pbase = seg ? (const bf16_t*)(p.ws + WS_PLAT) + (size_t)b * S * IN_COLS : (const bf16_t*)(p.ws + WS_PCTX) + (size_t)b * CTXL * CTX_COLS;
        for (int inst = wsel; inst < 24; inst += nw) {
            const int q = inst * 64 + lane, row = q / 48, c16 = q % 48;
            const bf16_t* src = pbase + (size_t)(j0 + row) * ldp + (c16 >> 4) * 512 + h * 128 + (c16 & 15) * 8;
#ifdef EMU
            emu_global_load_lds16(src, (char*)RAW + q * 16);
#else
            __builtin_amdgcn_global_load_lds((const unsigned*)src, (__attribute__((address_space(3))) unsigned*)((char*)RAW + q * 16), 16, 0, 0);
#endif
        }
    };
    auto prefetch_ab = [&](int x) {
        int seg, j0; chunk_pos(x, d, seg, j0);
        const float* abbase = (const float*)(p.ws + WS_AB) + (size_t)(seg ? T_CTX + b * S : b * CTXL) * 16;
        const int jw = j0 + 4 * wave0_;
        if (lane < 4) { pa = abbase[(size_t)(jw + lane) * 16 + d * 4 + h]; pbt = abbase[(size_t)(jw + lane) * 16 + 8 + d * 4 + h]; }
    };
    prefetch(0, wave0_, 8); prefetch_ab(0);
#ifndef EMU
    asm volatile("s_waitcnt vmcnt(0)" ::: "memory");
#endif
    const int r0_ = lane & 31, hh0_ = lane >> 5;
    __syncthreads();
    for (int it = -1; it < G_NT; ++it) {
        int r = r0_, hh = hh0_, wave = wave0_;
#ifndef EMU
        asm volatile("" : "+v"(r), "+v"(hh), "+v"(wave));
#endif
        const int xn = it + 1, par = xn & 1;
        int segn = 0, j0n = 0; if (xn < G_NT) chunk_pos(xn, d, segn, j0n);
        if (xn < G_NT) {
            const int i0 = d ? (GC - 4 - 4 * wave) : 4 * wave;
            bf16_t kt[2][4], vt[2][4];
#pragma unroll
            for (int t = 0; t < 4; ++t) {
                const int e = d ? 3 - t : t, i = i0 + e;
                const unsigned wq = *(const unsigned*)(RAW + (4 * wave + t) * 384 + 2 * lane), wk = *(const unsigned*)(RAW + (4 * wave + t) * 384 + 128 + 2 * lane), wv = *(const unsigned*)(RAW + (4 * wave + t) * 384 + 256 + 2 * lane);
                *(unsigned*)(Qs + (par * 32 + i) * LD128 + 2 * lane) = wq;
                *(unsigned*)(Ks + i * LD128 + 2 * lane) = wk;
                kt[0][e] = (bf16_t)(wk & 0xffffu); kt[1][e] = (bf16_t)(wk >> 16); vt[0][e] = (bf16_t)(wv & 0xffffu); vt[1][e] = (bf16_t)(wv >> 16);
            }
#pragma unroll
            for (int q = 0; q < 2; ++q) {
                u32x2 o; o.x = (unsigned)kt[q][0] | ((unsigned)kt[q][1] << 16); o.y = (unsigned)kt[q][2] | ((unsigned)kt[q][3] << 16);
                *(u32x2*)(KTs + (par * 128 + 2 * lane + q) * LD32 + i0) = o;
                u32x2 o2; o2.x = (unsigned)vt[q][0] | ((unsigned)vt[q][1] << 16); o2.y = (unsigned)vt[q][2] | ((unsigned)vt[q][3] << 16);
                *(u32x2*)(VTs + (par * 128 + 2 * lane + q) * LD32 + i0) = o2;
            }
            if (lane < 4) { const int i = d ? (GC - 1 - 4 * wave - lane) : (4 * wave + lane);
                SC[(par * 8 + 0) * 32 + i] = negea * fsoftplus(pa + dtb); SC[(par * 8 + 1) * 32 + i] = fsigmoid(pbt); }
            if (xn + 1 < G_NT) prefetch_ab(xn + 1);
        }
        LDS_BARRIER();
        if (wave >= 4 && wave < 7 && xn + 1 < G_NT) {
            prefetch(xn + 1, wave - 4, 3);
#ifndef EMU
            asm volatile("s_waitcnt vmcnt(0)" ::: "memory");
#endif
        }
        if (xn < G_NT) {
            const float* graw = SC + (par * 8 + 0) * 32;
            float gcv = 0.f;
#pragma unroll
            for (int s4 = 0; s4 < 8; ++s4) { const f32x4 g4 = *(const f32x4*)(graw + 4 * s4);
                gcv += (4 * s4 + 0 <= r ? g4.x : 0.f) + (4 * s4 + 1 <= r ? g4.y : 0.f) + (4 * s4 + 2 <= r ? g4.z : 0.f) + (4 * s4 + 3 <= r ? g4.w : 0.f); }
            if (lane < 32) GCs[wave * 32 + r] = gcv;
            if (wave == 7 && lane < 32) {
                float gl = 0.f;
#pragma unroll
                for (int s4 = 0; s4 < 8; ++s4) { const f32x4 g4 = *(const f32x4*)(graw + 4 * s4); gl += (g4.x + g4.y) + (g4.z + g4.w); }
                const float be = SC[(par * 8 + 1) * 32 + r];
                SC[(par * 8 + 3) * 32 + r] = fexp(gcv); SC[(par * 8 + 4) * 32 + r] = fexp(gl - gcv); SC[(par * 8 + 5) * 32 + r] = be * fexp(gcv); SC[(par * 8 + 6) * 32 + r] = fexp(gl);
            }
            const int pr = wave >> 2, th = (wave >> 1) & 1, ch = wave & 1, fr = lane & 15, fq = lane >> 4;
            const bf16_t* arow = (pr == 0 ? Ks : Qs + par * 32 * LD128) + (16 * th + fr) * LD128 + 8 * fq; const bf16_t* brow = Ks + (16 * ch + fr) * LD128 + 8 * fq;
            f32x4 cc = {0.f, 0.f, 0.f, 0.f};
#pragma unroll
            for (int ks = 0; ks < 4; ++ks) cc = MFMA16(*(const bf16x8*)(arow + 32 * ks), *(const bf16x8*)(brow + 32 * ks), cc);
            WAVE_SYNC();
            const int jj = 16 * ch + fr; const float gj = GCs[wave * 32 + jj];
#pragma unroll
            for (int j = 0; j < 4; ++j) {
                const int i = 16 * th + 4 * fq + j; const float dec = fexp(GCs[wave * 32 + i] - gj);
                if (pr == 0) Lf[i * 32 + jj] = (jj < i) ? SC[(par * 8 + 1) * 32 + i] * cc[j] * dec : 0.f;
                else QKMs[(par * 32 + i) * LD32 + jj] = f2bf((jj <= i) ? cc[j] * dec : 0.f);
            }
        }
        LDS_BARRIER();
        if (wave == 7 && xn < G_NT) {
            const f32x16 tf = invert32_blocked(Lf, (bf16_t*)(smem + GL_INV), lane);
            const int c = r; const float b1 = SC[(par * 8 + 5) * 32 + c], b0 = SC[(par * 8 + 1) * 32 + c];
#pragma unroll
            for (int g = 0; g < 16; ++g) { const int i = crow(g, hh); Tp[i * LD32 + c] = f2bf(tf[g] * b1); Tpp[(par * 32 + i) * LD32 + c] = f2bf(tf[g] * b0); }
        }
        if (wave < 4 && it >= 0) {
            const int pc = it & 1; int seg = 0, j0 = 0; chunk_pos(it, d, seg, j0);
            const bf16_t* Qc = Qs + pc * 32 * LD128; const bf16_t* KTc = KTs + pc * 128 * LD32; const bf16_t* VTc = VTs + pc * 128 * LD32;
            const bf16_t* QKc = QKMs + pc * 32 * LD32; const bf16_t* Tc = Tpp + pc * 32 * LD32; const float* sc = SC + pc * 8 * 32;
            f32x16 vn = zero16();
#pragma unroll
            for (int s = 0; s < 2; ++s) vn = MFMA32(ld_nat(Tc + r * LD32, s, hh), ld_nat(VTc + (32 * wave + r) * LD32, s, hh), vn);
            f32x16 oacc = zero16();
#define GDN_KSTEP(s) { const bf16x8 sb = pack_acc<(s) & 1>(St[(s) >> 1]); vn = MFMA32(ld_perm(Wn + r * LD128, (s), hh), sb, vn); oacc = MFMA32(ld_perm(Qc + r * LD128, (s), hh), sb, oacc); }
            GDN_KSTEP(0) GDN_KSTEP(1) GDN_KSTEP(2) GDN_KSTEP(3) GDN_KSTEP(4) GDN_KSTEP(5) GDN_KSTEP(6) GDN_KSTEP(7)
#undef GDN_KSTEP
#pragma unroll
            for (int g = 0; g < 16; ++g) oacc[g] *= sc[3 * 32 + crow(g, hh)];
            { const bf16x8 v0 = pack_acc<0>(vn), v1 = pack_acc<1>(vn);
              oacc = MFMA32(ld_perm(QKc + r * LD32, 0, hh), v0, oacc); oacc = MFMA32(ld_perm(QKc + r * LD32, 1, hh), v1, oacc); }
#pragma unroll
            for (int g = 0; g < 16; ++g) vn[g] *= sc[4 * 32 + crow(g, hh)];
            const float ge = sc[6 * 32];
            { const bf16x8 v0 = pack_acc<0>(vn), v1 = pack_acc<1>(vn);
#pragma unroll
              for (int ct = 0; ct < 4; ++ct) {
#pragma unroll
                  for (int g = 0; g < 16; ++g) St[ct][g] *= ge;
                  St[ct] = MFMA32(ld_perm(KTc + (32 * ct + r) * LD32, 0, hh), v0, St[ct]);
                  St[ct] = MFMA32(ld_perm(KTc + (32 * ct + r) * LD32, 1, hh), v1, St[ct]);
              } }
            if (seg) {
#pragma unroll
                for (int g = 0; g < 16; ++g) {
                    const int i = crow(g, hh), j = d ? j0 + GC - 1 - i : j0 + i;
                    ODIR[((size_t)d * T_LAT + (size_t)b * S + j) * 512 + h * 128 + 32 * wave + r] = f2bf(oacc[g]);
                }
            }
        }
        LDS_BARRIER();
        if (xn < G_NT && wave < 4) {
            f32x16 acc = zero16();
#pragma unroll
            for (int s = 0; s < 2; ++s) acc = MFMA32(ld_nat(KTs + (par * 128 + 32 * wave + r) * LD32, s, hh), ld_nat(Tp + r * LD32, s, hh), acc);
#pragma unroll
            for (int q = 0; q < 4; ++q) {
                u32x2 o; o.x = pk2(-acc[4 * q], -acc[4 * q + 1]); o.y = pk2(-acc[4 * q + 2], -acc[4 * q + 3]);
                *(u32x2*)(Wn + r * LD128 + 32 * wave + 8 * q + 4 * hh) = o;
            }
        }
        LDS_BARRIER();
    }
}

constexpr int RL_RX = 0;
constexpr int RL_KX = RL_RX + 32 * 64 * 4;
constexpr int RL_VX = RL_KX + 32 * 64 * 4;
constexpr int RL_KK = RL_VX + 32 * 64 * 4;
constexpr int RL_LW = RL_KK + 32 * 64 * 4;
constexpr int RL_IC = RL_LW + 32 * 64 * 4;
constexpr int RL_PC = RL_IC + 32 * 64 * 4;
constexpr int RL_CST = RL_PC + 2 * 64 * 4;
constexpr int RL_TW = RL_CST + 4 * 64 * 4;
constexpr int RL_AL = RL_TW + 32 * LD64 * 2;
constexpr int RL_LF = RL_TW;
constexpr int RL_LAKT = RL_LF + 32 * 32 * 4;
constexpr int RL_TB = RL_LAKT + 32 * LD32 * 2;
static_assert(RL_TB + 32 * LD32 * 2 <= RL_AL + 32 * LD64 * 2, "overlay");
constexpr int RL_W2T = RL_AL + 32 * LD64 * 2;
constexpr int RL_A2T = RL_W2T + 64 * LD64 * 2;
constexpr int RL_AR = RL_A2T + 64 * LD64 * 2;
constexpr int RL_BR = RL_AR + 32 * LD64 * 2;
constexpr int RL_KR = RL_BR + 32 * LD64 * 2;
constexpr int RL_RR = RL_KR + 32 * LD64 * 2;
constexpr int RL_AT = RL_RR + 2 * 32 * LD64 * 2;
constexpr int RL_BHT = RL_AT + 64 * LD32 * 2;
constexpr int RL_KHT = RL_BHT + 2 * 64 * LD32 * 2;
constexpr int RL_VT = RL_KHT + 2 * 64 * LD32 * 2;
constexpr int RL_MRB = RL_VT + 2 * 64 * LD32 * 2;
constexpr int RL_MRK = RL_MRB + 2 * 32 * LD32 * 2;
constexpr int RL_WM = RL_MRK + 2 * 32 * LD32 * 2;
constexpr int RL_TL = RL_WM + 32 * LD64 * 2;
constexpr int RL_END = RL_TL + 32 * LD32 * 2;
static_assert(RL_END <= LDS_BYTES, "rwkv lds");

DI void rwkv_chain2(const Params& p, char* smem, int item) {
    const int d = item / (NB * H_B), b = (item / H_B) % NB, h = item % H_B;
    const int tid = tid_x(), lane = tid & 63, wave = tid >> 6;
    float* RX = (float*)(smem + RL_RX); float* KX = (float*)(smem + RL_KX); float* VX = (float*)(smem + RL_VX); float* KKs = (float*)(smem + RL_KK);
    float* LW = (float*)(smem + RL_LW); float* IC = (float*)(smem + RL_IC); float* Lf = (float*)(smem + RL_LF); float* PC = (float*)(smem + RL_PC); float* CST = (float*)(smem + RL_CST);
    bf16_t* TW = (bf16_t*)(smem + RL_TW); bf16_t* AL = (bf16_t*)(smem + RL_AL); bf16_t* W2T = (bf16_t*)(smem + RL_W2T); bf16_t* A2T = (bf16_t*)(smem + RL_A2T);
    bf16_t* Ar = (bf16_t*)(smem + RL_AR); bf16_t* Br = (bf16_t*)(smem + RL_BR); bf16_t* Kr = (bf16_t*)(smem + RL_KR); bf16_t* Rr = (bf16_t*)(smem + RL_RR);
    bf16_t* AT = (bf16_t*)(smem + RL_AT); bf16_t* BhT = (bf16_t*)(smem + RL_BHT); bf16_t* KhT = (bf16_t*)(smem + RL_KHT); bf16_t* VT = (bf16_t*)(smem + RL_VT);
    bf16_t* LakT = (bf16_t*)(smem + RL_LAKT); bf16_t* Mrb = (bf16_t*)(smem + RL_MRB); bf16_t* Mrk = (bf16_t*)(smem + RL_MRK); bf16_t* Tb = (bf16_t*)(smem + RL_TB);
    bf16_t* Wm = (bf16_t*)(smem + RL_WM); bf16_t* TLm = (bf16_t*)(smem + RL_TL);
    bf16_t* YDIR = (bf16_t*)(p.aux + AUX_YDIR); float* BON = (float*)(p.ws + WS_BONUS);
    __syncthreads();
    for (int i = tid; i < 64 * 64; i += NTHREADS) {
        const int c = i >> 6, rr = i & 63;
        W2T[c * LD64 + rr] = f2bf(p.in[I_W2][((size_t)d * 64 + rr) * 512 + h * 64 + c]); A2T[c * LD64 + rr] = f2bf(p.in[I_A2][((size_t)d * 64 + rr) * 512 + h * 64 + c]);
    }
    if (tid < 256) { const int w = tid >> 6, c = tid & 63, gc = h * 64 + c;
        CST[tid] = w == 0 ? p.in[I_W0][d * 512 + gc] : (w == 1 ? p.in[I_A0][d * 512 + gc] : (w == 2 ? p.in[I_KA][gc] : p.in[I_RK][gc])); }
    const float kkw = p.in[I_KK][h * 64 + lane];
    f32x16 Xt[2]; Xt[0] = zero16(); Xt[1] = zero16();
    bf16_t rawv[4][5];
    auto prefetch = [&](int x) {
        int seg, j0; chunk_pos(x, d, seg, j0);
        const int ldp = seg ? IN_COLS : CTX_COLS;
        const bf16_t* pb = seg ? (const bf16_t*)(p.ws + WS_PLAT) + (size_t)b * S * IN_COLS : (const bf16_t*)(p.ws + WS_PCTX) + (size_t)b * CTXL * CTX_COLS;
        const int jw = j0 + 4 * wave;
#pragma unroll
        for (int rr = 0; rr < 4; ++rr) {
            const int j = jw + rr; const int row = seg ? (j % ROWS) * GW + j / ROWS : j;
#pragma unroll
            for (int s = 0; s < 5; ++s) {
                const int bcol = (s < 3 ? s * 512 + h * 64 : (s == 3 ? 1536 + d * 64 : 1664 + d * 64)) + lane;
                rawv[rr][s] = pb[(size_t)row * ldp + COL_B0 + bcol];
            }
        }
    };
    prefetch(0);
    const int r0_ = lane & 31, hh0_ = lane >> 5;
    __syncthreads();
    for (int it = -1; it < G_NT; ++it) {
        int r = r0_, hh = hh0_;
#ifndef EMU
        asm volatile("" : "+v"(r), "+v"(hh));
#endif
        const int xn = it + 1, par = xn & 1;
        int segn = 0, j0n = 0; if (xn < G_NT) chunk_pos(xn, d, segn, j0n);
        if (xn < G_NT) {
#pragma unroll
            for (int t = 0; t < 4; ++t) {
                const int i = d ? (GC - 1 - 4 * wave - t) : (4 * wave + t);
                const float xr = bf2f(rawv[t][0]), xk = bf2f(rawv[t][1]), xv = bf2f(rawv[t][2]);
                const float kxk = xk * kkw; const float ss = wave_sum_fast(kxk * kxk);
                RX[i * 64 + lane] = xr; KX[i * 64 + lane] = xk; VX[i * 64 + lane] = xv; KKs[i * 64 + lane] = kxk * frsq(ss + 1e-6f);
                TW[i * LD64 + lane] = rawv[t][3]; AL[i * LD64 + lane] = rawv[t][4];
            }
            if (xn + 1 < G_NT) prefetch(xn + 1);
        }
        LDS_BARRIER();
        if (xn < G_NT) {
            const int which = wave >> 2, cg = wave & 3, fr = lane & 15, fq = lane >> 4;
            const bf16_t* arow0 = (which ? AL : TW) + fr * LD64 + 8 * fq; const bf16_t* brow = (which ? A2T : W2T) + (16 * cg + fr) * LD64 + 8 * fq;
            f32x4 c0 = {0.f, 0.f, 0.f, 0.f}, c1 = {0.f, 0.f, 0.f, 0.f};
#pragma unroll
            for (int ks = 0; ks < 2; ++ks) {
                const bf16x8 bfrag = *(const bf16x8*)(brow + 32 * ks);
                c0 = MFMA16(*(const bf16x8*)(arow0 + 32 * ks), bfrag, c0); c1 = MFMA16(*(const bf16x8*)(arow0 + 16 * LD64 + 32 * ks), bfrag, c1);
            }
            const int c = 16 * cg + fr; const float bias = CST[which * 64 + c];
#pragma unroll
            for (int th = 0; th < 2; ++th)
#pragma unroll
                for (int j = 0; j < 4; ++j) {
                    const int i = 16 * th + 4 * fq + j; const float z = bias + (th ? c1[j] : c0[j]);
                    if (which) IC[i * 64 + c] = fsigmoid(z);
                    else { const float wl = -fsoftplus(-z) - 0.5f; LW[i * 64 + c] = -fexp(wl); }
                }
        }
        LDS_BARRIER();
        if (xn < G_NT) {
            const int c = lane, i0 = 4 * wave;
            const float ka = CST[2 * 64 + c], rk = CST[3 * 64 + c];
            float lpb = 0.f, lpc = 0.f; float lw4[4];
#pragma unroll
            for (int s2 = 0; s2 < 32; ++s2) { const float w = LW[s2 * 64 + c]; lpc += w; if (s2 < i0) lpb += w; }
#pragma unroll
            for (int e = 0; e < 4; ++e) lw4[e] = LW[(i0 + e) * 64 + c];
            bf16_t ta[4], tb[4], tk[4], tv[4]; float bon[4];
            float lprun = lpb;
#pragma unroll
            for (int e = 0; e < 4; ++e) {
                const int i = i0 + e;
                const float lpm = lprun; lprun += lw4[e]; const float lp = lprun;
                const float Pi = fexp(lp), Pm = fexp(lpm), invP = fexp(-lp), PCi = fexp(lpc - lp);
                const float ic = IC[i * 64 + c], kxv = KX[i * 64 + c], kkv = KKs[i * 64 + c], rxv = RX[i * 64 + c], vxv = VX[i * 64 + c];
                const float kd = kxv * (1.f + (ic - 1.f) * ka), bb = kkv * ic, aa = -kkv;
                ta[e] = f2bf(aa * Pm); tb[e] = f2bf(bb * PCi); tk[e] = f2bf(kd * PCi); tv[e] = f2bf(vxv);
                Ar[i * LD64 + c] = ta[e]; Br[i * LD64 + c] = f2bf(bb * invP); Kr[i * LD64 + c] = f2bf(kd * invP); Rr[(par * 32 + i) * LD64 + c] = f2bf(rxv * Pi);
                bon[e] = wave_sum_fast(rxv * kd * rk);
            }
            { u32x2 o; o.x = (unsigned)ta[0] | ((unsigned)ta[1] << 16); o.y = (unsigned)ta[2] | ((unsigned)ta[3] << 16); *(u32x2*)(AT + c * LD32 + i0) = o; }
            { u32x2 o; o.x = (unsigned)tb[0] | ((unsigned)tb[1] << 16); o.y = (unsigned)tb[2] | ((unsigned)tb[3] << 16); *(u32x2*)(BhT + (par * 64 + c) * LD32 + i0) = o; }
            { u32x2 o; o.x = (unsigned)tk[0] | ((unsigned)tk[1] << 16); o.y = (unsigned)tk[2] | ((unsigned)tk[3] << 16); *(u32x2*)(KhT + (par * 64 + c) * LD32 + i0) = o; }
            { u32x2 o; o.x = (unsigned)tv[0] | ((unsigned)tv[1] << 16); o.y = (unsigned)tv[2] | ((unsigned)tv[3] << 16); *(u32x2*)(VT + (par * 64 + c) * LD32 + i0) = o; }
            if (wave == 7) PC[par * 64 + c] = fexp(lpc);
            if (segn && lane < 4) { const int i = i0 + lane, jj = d ? j0n + GC - 1 - i : j0n + i;
                const float bv = lane == 0 ? bon[0] : (lane == 1 ? bon[1] : (lane == 2 ? bon[2] : bon[3]));
                BON[((size_t)d * T_LAT + (size_t)b * S + (jj % ROWS) * GW + jj / ROWS) * 8 + h] = bv; }
        }
        LDS_BARRIER();
        if (xn < G_NT) {
            const int m = wave >> 1, th = wave & 1, fr = lane & 15, fq = lane >> 4;
            const bf16_t* arow = ((m < 2) ? Ar : Rr + par * 32 * LD64) + (16 * th + fr) * LD64 + 8 * fq; const bf16_t* brow = ((m & 1) ? Kr : Br) + fr * LD64 + 8 * fq;
            f32x4 c0 = {0.f, 0.f, 0.f, 0.f}, c1 = {0.f, 0.f, 0.f, 0.f};
#pragma unroll
            for (int ks = 0; ks < 2; ++ks) {
                const bf16x8 afrag = *(const bf16x8*)(arow + 32 * ks);
                c0 = MFMA16(afrag, *(const bf16x8*)(brow + 32 * ks), c0); c1 = MFMA16(afrag, *(const bf16x8*)(brow + 16 * LD64 + 32 * ks), c1);
            }
#pragma unroll
            for (int ch = 0; ch < 2; ++ch) {
                const f32x4 cc = ch ? c1 : c0; const int ic = 16 * ch + fr; const int t0 = 16 * th + 4 * fq;
                if (m == 0) {
#pragma unroll
                    for (int j = 0; j < 4; ++j) Lf[(t0 + j) * 32 + ic] = (ic < t0 + j) ? -cc[j] : 0.f;
                } else if (m == 1) {
                    u32x2 o; o.x = pk2((ic < t0) ? cc[0] : 0.f, (ic < t0 + 1) ? cc[1] : 0.f); o.y = pk2((ic < t0 + 2) ? cc[2] : 0.f, (ic < t0 + 3) ? cc[3] : 0.f);
                    *(u32x2*)(LakT + ic * LD32 + t0) = o;
                } else {
                    bf16_t* M = (m == 2 ? Mrb : Mrk) + par * 32 * LD32;
#pragma unroll
                    for (int j = 0; j < 4; ++j) M[(t0 + j) * LD32 + ic] = f2bf((ic <= t0 + j) ? cc[j] : 0.f);
                }
            }
        }
        LDS_BARRIER();
        if (wave == 7 && xn < G_NT) {
            const f32x16 tf = invert32_blocked(Lf, (bf16_t*)(smem + RL_RX), lane);
#pragma unroll
            for (int g = 0; g < 16; ++g) Tb[crow(g, hh) * LD32 + r] = f2bf(tf[g]);
        }
        if (wave < 2 && it >= 0) {
            const int pc = it & 1; int seg = 0, j0 = 0; chunk_pos(it, d, seg, j0);
            const bf16_t* Rc = Rr + pc * 32 * LD64; const bf16_t* BhTc = BhT + pc * 64 * LD32; const bf16_t* KhTc = KhT + pc * 64 * LD32; const bf16_t* VTc = VT + (pc * 64 + 32 * wave + r) * LD32;
            const bf16_t* Mrbc = Mrb + pc * 32 * LD32; const bf16_t* Mrkc = Mrk + pc * 32 * LD32; const float* PCc = PC + pc * 64;
            const bf16x8 vf0 = ld_nat(VTc, 0, hh), vf1 = ld_nat(VTc, 1, hh);
            f32x16 u = zero16(), y = zero16();
            u = MFMA32(ld_nat(TLm + r * LD32, 0, hh), vf0, u); u = MFMA32(ld_nat(TLm + r * LD32, 1, hh), vf1, u);
            y = MFMA32(ld_nat(Mrkc + r * LD32, 0, hh), vf0, y); y = MFMA32(ld_nat(Mrkc + r * LD32, 1, hh), vf1, y);
#define RW_KSTEP(s) { const bf16x8 xb = pack_acc<(s) & 1>(Xt[(s) >> 1]); u = MFMA32(ld_perm(Wm + r * LD64, (s), hh), xb, u); y = MFMA32(ld_perm(Rc + r * LD64, (s), hh), xb, y); }
            RW_KSTEP(0) RW_KSTEP(1) RW_KSTEP(2) RW_KSTEP(3)
#undef RW_KSTEP
            const bf16x8 ub0 = pack_acc<0>(u), ub1 = pack_acc<1>(u);
            y = MFMA32(ld_perm(Mrbc + r * LD32, 0, hh), ub0, y); y = MFMA32(ld_perm(Mrbc + r * LD32, 1, hh), ub1, y);
#pragma unroll
            for (int kt = 0; kt < 2; ++kt) {
#pragma unroll
                for (int g = 0; g < 16; ++g) Xt[kt][g] *= PCc[32 * kt + crow(g, hh)];
                Xt[kt] = MFMA32(ld_perm(BhTc + (32 * kt + r) * LD32, 0, hh), ub0, Xt[kt]); Xt[kt] = MFMA32(ld_perm(BhTc + (32 * kt + r) * LD32, 1, hh), ub1, Xt[kt]);
                Xt[kt] = MFMA32(ld_nat(KhTc + (32 * kt + r) * LD32, 0, hh), vf0, Xt[kt]); Xt[kt] = MFMA32(ld_nat(KhTc + (32 * kt + r) * LD32, 1, hh), vf1, Xt[kt]);
            }
            if (seg) {
#pragma unroll
                for (int g = 0; g < 16; ++g) {
                    const int i = crow(g, hh), jj = d ? j0 + GC - 1 - i : j0 + i;
                    YDIR[((size_t)d * T_LAT + (size_t)b * S + (jj % ROWS) * GW + jj / ROWS) * 512 + h * 64 + 32 * wave + r] = f2bf(y[g]);
                }
            }
        }
        LDS_BARRIER();
        if (xn < G_NT && wave < 3) {
            const bf16_t* arow = (wave < 2) ? AT + (32 * wave + r) * LD32 : LakT + r * LD32;
            f32x16 acc = zero16();
#pragma unroll
            for (int s = 0; s < 2; ++s) acc = MFMA32(ld_nat(arow, s, hh), ld_nat(Tb + r * LD32, s, hh), acc);
#pragma unroll
            for (int q = 0; q < 4; ++q) {
                u32x2 o; o.x = pk2(acc[4 * q], acc[4 * q + 1]); o.y = pk2(acc[4 * q + 2], acc[4 * q + 3]);
                if (wave < 2) *(u32x2*)(Wm + r * LD64 + 32 * wave + 8 * q + 4 * hh) = o; else *(u32x2*)(TLm + r * LD32 + 8 * q + 4 * hh) = o;
            }
        }
        LDS_BARRIER();
    }
}

DI void phase3(const Params& p, char* smem) {
    constexpr int NG = 2 * NB * H_A, NR = 2 * NB * H_B;
    for (int it = blockIdx.x; it < NG; it += gridDim.x) gdn_chain2(p, smem, it);
    for (int it = blockIdx.x; it < NG + NR; it += gridDim.x) if (it >= NG) rwkv_chain2(p, smem, it - NG);
}

constexpr int P4_SG = 0;
constexpr int P4_XV = P4_SG + 32 * LD128 * 2;
constexpr int P4_YF = P4_XV + 32 * 520 * 2;
static_assert(P4_YF + 32 * 516 * 4 <= LDS_BYTES, "phase4 lds");
DI void unpack8(const u32x4& q, float (&f)[8]) {
    f[0] = bf2f((bf16_t)(q.x & 0xffffu)); f[1] = bf2f((bf16_t)(q.x >> 16)); f[2] = bf2f((bf16_t)(q.y & 0xffffu)); f[3] = bf2f((bf16_t)(q.y >> 16));
    f[4] = bf2f((bf16_t)(q.z & 0xffffu)); f[5] = bf2f((bf16_t)(q.z >> 16)); f[6] = bf2f((bf16_t)(q.w & 0xffffu)); f[7] = bf2f((bf16_t)(q.w >> 16));
}
DI float half_sum(float v, int hh) {
#ifdef EMU
    v += __shfl_xor(v, 1); v += __shfl_xor(v, 2); v += __shfl_xor(v, 4); v += __shfl_xor(v, 8); v += __shfl_xor(v, 16); return v;
#else
    v = DPP_ADD(v, 0xB1); v = DPP_ADD(v, 0x4E); v = DPP_ADD(v, 0x141); v = DPP_ADD(v, 0x140);
    const int iv = __builtin_bit_cast(int, v);
    const float s0 = __builtin_bit_cast(float, __builtin_amdgcn_readlane(iv, 0)) + __builtin_bit_cast(float, __builtin_amdgcn_readlane(iv, 16));
    const float s1 = __builtin_bit_cast(float, __builtin_amdgcn_readlane(iv, 32)) + __builtin_bit_cast(float, __builtin_amdgcn_readlane(iv, 48));
    return hh ? s1 : s0;
#endif
}
DI void phase4(const Params& p, char* smem) {
    const int tid = tid_x(), lane = tid & 63, wave = tid >> 6, r = lane & 31, hh = lane >> 5;
    const bf16_t* PL = (const bf16_t*)(p.ws + WS_PLAT);
    const bf16_t* ODIR = (const bf16_t*)(p.aux + AUX_ODIR); const bf16_t* YDIR = (const bf16_t*)(p.aux + AUX_YDIR);
    const float* BON = (const float*)(p.ws + WS_BONUS); const float* mu = p.in[I_MU]; const bf16_t* G2T = (const bf16_t*)(p.ws + WS_G2T);
    bf16_t* OA = (bf16_t*)(p.ws + WS_OA); bf16_t* OB = (bf16_t*)(p.ws + WS_OB);
    bf16_t* SG = (bf16_t*)(smem + P4_SG); bf16_t* XV = (bf16_t*)(smem + P4_XV); float* YF = (float*)(smem + P4_YF);
    for (int it = blockIdx.x; it < T_LAT / 32; it += gridDim.x) {
        const int tok0 = it * 32, b = tok0 / S, l0 = tok0 % S;
        __syncthreads();
        for (int q = tid; q < 32 * 80; q += NTHREADS) {
            const int t = q / 80, c8 = q % 80;
            const int l = l0 + t;
            const int bcol = c8 < 16 ? 1792 + c8 * 8 : 1024 + (c8 - 16) * 8;
            float cu[8], o[8];
            unpack8(*(const u32x4*)(PL + (size_t)(b * S + l) * IN_COLS + COL_B0 + bcol), cu);
#pragma unroll
            for (int e = 0; e < 8; ++e) o[e] = c8 < 16 ? fsigmoid(cu[e]) : cu[e];
            u32x4 w; w.x = pk2(o[0], o[1]); w.y = pk2(o[2], o[3]); w.z = pk2(o[4], o[5]); w.w = pk2(o[6], o[7]);
            if (c8 < 16) *(u32x4*)(SG + t * LD128 + c8 * 8) = w; else *(u32x4*)(XV + t * 520 + (c8 - 16) * 8) = w;
        }
        for (int q = tid; q < 32 * 64; q += NTHREADS) {
            const int t = q >> 6, c8 = q & 63, tok = tok0 + t;
            float a0[8], a1[8];
            unpack8(*(const u32x4*)(YDIR + (size_t)tok * 512 + c8 * 8), a0); unpack8(*(const u32x4*)(YDIR + ((size_t)T_LAT + tok) * 512 + c8 * 8), a1);
            f32x4 s0 = {a0[0] + a1[0], a0[1] + a1[1], a0[2] + a1[2], a0[3] + a1[3]}, s1 = {a0[4] + a1[4], a0[5] + a1[5], a0[6] + a1[6], a0[7] + a1[7]};
            *(f32x4*)(YF + t * 516 + c8 * 8) = s0; *(f32x4*)(YF + t * 516 + c8 * 8 + 4) = s1;
        }
        __syncthreads();
        {
            const int h = wave;
            f32x16 acc0 = zero16(), acc1 = zero16();
#pragma unroll
            for (int s2 = 0; s2 < 8; ++s2) {
                const bf16x8 a = ld_nat(SG + r * LD128, s2, hh);
                const bf16x8 b0 = *(const bf16x8*)(G2T + (size_t)(64 * h + r) * 128 + 16 * s2 + 8 * hh), b1 = *(const bf16x8*)(G2T + (size_t)(64 * h + 32 + r) * 128 + 16 * s2 + 8 * hh);
                acc0 = MFMA32(a, b0, acc0); acc1 = MFMA32(a, b1, acc1);
            }
            const int c0 = 64 * h + r, c1 = c0 + 32;
            const float lg0 = p.in[I_LNG][c0], lb0 = p.in[I_LNB][c0], lg1 = p.in[I_LNG][c1], lb1 = p.in[I_LNB][c1];
#pragma unroll
            for (int g = 0; g < 16; ++g) {
                const int i = crow(g, hh), tok = tok0 + i;
                const float y0 = YF[i * 516 + c0], y1 = YF[i * 516 + c1];
                const float mean = half_sum(y0 + y1, hh) * (1.f / 64.f); const float d0 = y0 - mean, d1 = y1 - mean;
                const float var = half_sum(d0 * d0 + d1 * d1, hh) * (1.f / 64.f); const float rs = frsq(var + 64e-5f);
                const float bon = BON[(size_t)tok * 8 + h] + BON[((size_t)T_LAT + tok) * 8 + h];
                const float o0 = (d0 * rs * lg0 + lb0 + bon * bf2f(XV[i * 520 + c0])) * acc0[g], o1 = (d1 * rs * lg1 + lb1 + bon * bf2f(XV[i * 520 + c1])) * acc1[g];
                OB[(size_t)tok * 512 + c0] = f2bf(o0); OB[(size_t)tok * 512 + c1] = f2bf(o1);
            }
        }
        for (int pi = wave * 16; pi < wave * 16 + 16; ++pi) {
            const int t = pi >> 2, h = pi & 3, tok = tok0 + t;
            const size_t o0 = (size_t)tok * 512 + h * 128 + 2 * lane;
            const unsigned q0 = *(const unsigned*)(ODIR + o0), q1 = *(const unsigned*)(ODIR + (size_t)T_LAT * 512 + o0), zq = *(const unsigned*)(PL + (size_t)tok * IN_COLS + 1536 + h * 128 + 2 * lane);
            const float a0 = bf2f((bf16_t)(q0 & 0xffffu)) + bf2f((bf16_t)(q1 & 0xffffu)), a1 = bf2f((bf16_t)(q0 >> 16)) + bf2f((bf16_t)(q1 >> 16));
            const float ss = wave_sum_fast(a0 * a0 + a1 * a1);
            const float rstd = frsq(ss * (1.f / 128.f) + 1e-6f);
            const float z0 = bf2f((bf16_t)(zq & 0xffffu)), z1 = bf2f((bf16_t)(zq >> 16));
            *(unsigned*)(OA + o0) = pk2(a0 * rstd * p.in[I_ONORM][2 * lane] * fsilu(z0), a1 * rstd * p.in[I_ONORM][2 * lane + 1] * fsilu(z1));
        }
    }
}

DI void phase5(const Params& p, char* smem) {
    const bf16_t* OA = (const bf16_t*)(p.ws + WS_OA); const bf16_t* OB = (const bf16_t*)(p.ws + WS_OB);
    const bf16_t* WA = (const bf16_t*)(p.ws + WS_WOA); const bf16_t* WB = (const bf16_t*)(p.ws + WS_WOB);
    const bf16_t* PL = (const bf16_t*)(p.ws + WS_PLAT); bf16_t* Y = (bf16_t*)(p.aux + AUX_Y);
    if (USE_G8) {
        constexpr int NT8 = D / 256, MT8 = T_LAT / 256;
        for (int t = blockIdx.x; t < MT8 * NT8; t += gridDim.x) {
            const int mt = t / NT8, nt = t % NT8, brow = mt * 256, bcol = nt * 256;
            g8::Acc acc; g8::acc_zero(acc);
            g8::kloop(acc, smem, OA, 512, WA, 512, 512, brow, bcol);
            g8::for_each_quad(acc, brow, bcol, [&](int row, int col, const f32x4& v) {
                const u32x2 gq = *(const u32x2*)(PL + (size_t)row * IN_COLS + COL_G0 + col);
                const float g0 = bf2f((bf16_t)(gq.x & 0xffffu)), g1 = bf2f((bf16_t)(gq.x >> 16)), g2 = bf2f((bf16_t)(gq.y & 0xffffu)), g3 = bf2f((bf16_t)(gq.y >> 16));
                u32x2 o; o.x = pk2(fsigmoid(g0) * v.x, fsigmoid(g1) * v.y); o.y = pk2(fsigmoid(g2) * v.z, fsigmoid(g3) * v.w);
                *(u32x2*)(Y + (size_t)row * D + col) = o;
            });
            g8::acc_zero(acc);
            g8::kloop(acc, smem, OB, 512, WB, 512, 512, brow, bcol);
            g8::for_each_quad(acc, brow, bcol, [&](int row, int col, const f32x4& v) {
                const u32x2 gq = *(const u32x2*)(PL + (size_t)row * IN_COLS + COL_G0 + D + col);
                const float g0 = bf2f((bf16_t)(gq.x & 0xffffu)), g1 = bf2f((bf16_t)(gq.x >> 16)), g2 = bf2f((bf16_t)(gq.y & 0xffffu)), g3 = bf2f((bf16_t)(gq.y >> 16));
#ifdef EMU
                const unsigned long long tq = *(const unsigned long long*)(Y + (size_t)row * D + col);
#else
                const unsigned long long tq = __hip_atomic_load((const unsigned long long*)(Y + (size_t)row * D + col), __ATOMIC_RELAXED, __HIP_MEMORY_SCOPE_AGENT);
#endif
                const unsigned tlo = (unsigned)tq, thi = (unsigned)(tq >> 32);
                const float t0 = bf2f((bf16_t)(tlo & 0xffffu)), t1 = bf2f((bf16_t)(tlo >> 16)), t2 = bf2f((bf16_t)(thi & 0xffffu)), t3 = bf2f((bf16_t)(thi >> 16));
                u32x2 o; o.x = pk2(t0 + fsigmoid(g0) * v.x, t1 + fsigmoid(g1) * v.y); o.y = pk2(t2 + fsigmoid(g2) * v.z, t3 + fsigmoid(g3) * v.w);
                *(u32x2*)(Y + (size_t)row * D + col) = o;
            });
        }
        return;
    }
    constexpr int MR5 = 2, BM5 = 64 * MR5; constexpr int NT = D / 128, MT = T_LAT / BM5;
    for (int t = blockIdx.x; t < MT * NT; t += gridDim.x) {
        const int mt = t / NT, nt = t % NT, row0 = mt * BM5;
        f32x4 acca[MR5][4], accb[MR5][4]; acc_zero(acca); acc_zero(accb);
        gemm_kloop(acca, smem, [&](int i) { return OA + (size_t)(row0 + i) * 512; }, WA + (size_t)nt * 128 * 512, 512, 512);
        gemm_kloop(accb, smem, [&](int i) { return OB + (size_t)(row0 + i) * 512; }, WB + (size_t)nt * 128 * 512, 512, 512);
        const int t2 = tid_x(), l2 = t2 & 63, w2 = t2 >> 6; const int wr = w2 >> 1, wc = w2 & 1, fr = l2 & 15, fq = l2 >> 4;
#pragma unroll
        for (int m = 0; m < MR5; ++m)
#pragma unroll
            for (int n = 0; n < 4; ++n)
#pragma unroll
                for (int j = 0; j < 4; ++j) {
                    const int row = row0 + wr * 16 * MR5 + m * 16 + fq * 4 + j, col = nt * 128 + wc * 64 + n * 16 + fr;
                    const float ga = bf2f(PL[(size_t)row * IN_COLS + COL_G0 + col]), gb = bf2f(PL[(size_t)row * IN_COLS + COL_G0 + D + col]);
                    Y[(size_t)row * D + col] = f2bf(sigmoidf_(ga) * acca[m][n][j] + sigmoidf_(gb) * accb[m][n][j]);
                }
    }
}

DI void phase6(const Params& p, char* smem) {
    const bf16_t* Y = (const bf16_t*)(p.aux + AUX_Y); const bf16_t* WO = (const bf16_t*)(p.ws + WS_WOUT);
    const float* mod = (const float*)(p.ws + WS_MOD); float* Hh = (float*)(p.ws + WS_H);
    if (USE_G8) {
        constexpr int NT = D / 256, MT = T_LAT / 256;
        const float* X = p.in[I_X];
        for (int t = blockIdx.x; t < MT * NT; t += gridDim.x) {
            const int mt = t / NT, nt = t % NT, brow = mt * 256, bcol = nt * 256;
            g8::Acc acc; g8::acc_zero(acc);
            g8::kloop(acc, smem, Y, D, WO, D, D, brow, bcol);
            g8::for_each_quad(acc, brow, bcol, [&](int row, int col, const f32x4& v) {
                const int b = row / S; const f32x4 xv = *(const f32x4*)(X + (size_t)row * D + col), gv = *(const f32x4*)(mod + (size_t)b * 6 * D + 2 * D + col);
                f32x4 o; o.x = xv.x + gv.x * v.x; o.y = xv.y + gv.y * v.y; o.z = xv.z + gv.z * v.z; o.w = xv.w + gv.w * v.w;
                *(f32x4*)(Hh + (size_t)row * D + col) = o;
            });
        }
    } else {
        const int tid = tid_x(), lane = tid & 63, wave = tid >> 6, wr = wave >> 1, wc = wave & 1, fr = lane & 15, fq = lane >> 4;
        constexpr int NT = D / 128, MT = T_LAT / BM;
        for (int t = blockIdx.x; t < MT * NT; t += gridDim.x) {
            const int mt = t / NT, nt = t % NT, row0 = mt * BM;
            f32x4 acc[MREP][4]; acc_zero(acc);
            gemm_kloop(acc, smem, [&](int i) { return Y + (size_t)(row0 + i) * D; }, WO + (size_t)nt * 128 * D, D, D);
#pragma unroll
            for (int m = 0; m < MREP; ++m)
#pragma unroll
                for (int n = 0; n < 4; ++n)
#pragma unroll
                    for (int j = 0; j < 4; ++j) {
                        const int row = row0 + wr * 16 * MREP + m * 16 + fq * 4 + j, col = nt * 128 + wc * 64 + n * 16 + fr, b = row / S;
                        Hh[(size_t)row * D + col] = p.in[I_X][(size_t)row * D + col] + mod[(size_t)b * 6 * D + 2 * D + col] * acc[m][n][j];
                    }
        }
    }
    __syncthreads();
    const int tid6 = tid_x(), lane = tid6 & 63, wave = tid6 >> 6;
    const int gw = blockIdx.x * 8 + wave, ngw = gridDim.x * 8;
    float* scr = (float*)smem + wave * (64 * 33);
    bf16_t* GUT = (bf16_t*)(p.aux + AUX_GUT); bf16_t* DNT = (bf16_t*)(p.ws + WS_DNT);
    {
        constexpr int nkb = D / 64, nnb = DE / 32, per = nkb * nnb;
        for (int it = gw; it < NEXP * 2 * per; it += ngw) {
            const int e = it / (2 * per), r = it % (2 * per), up = r / per, r2 = r % per, kb = r2 / nnb, nb = r2 % nnb;
            transpose_item((up ? p.in[I_MU_UP] : p.in[I_MG]) + (size_t)e * D * DE, DE, DE, kb * 64, nb * 32, GUT + (size_t)e * 512 * D, D, up ? 2 : 1, scr, lane);
        }
    }
    {
        constexpr int nkb = DE / 64, nnb = D / 32, per = nkb * nnb;
        for (int it = gw; it < NEXP * per; it += ngw) {
            const int e = it / per, r2 = it % per, kb = r2 / nnb, nb = r2 % nnb;
            transpose_item(p.in[I_MD] + (size_t)e * DE * D, D, D, kb * 64, nb * 32, DNT + (size_t)e * D * DE, DE, 0, scr, lane);
        }
    }
}

#ifdef EMU
#define MFMA32F(a, b, c) emu_mfma32_f32((a), (b), (c))
#else
#define MFMA32F(a, b, c) __builtin_amdgcn_mfma_f32_32x32x2f32((a), (b), (c), 0, 0, 0)
#endif
constexpr int TB_LD = D + 4;
static_assert(32 * TB_LD * 4 <= LDS_BYTES && 8 * 32 * 64 * 4 <= LDS_BYTES, "phase7 lds");
DI void phase7(const Params& p, char* smem) {
    const int tid = tid_x(), lane = tid & 63, wave = tid >> 6, r = lane & 31, hh = lane >> 5;
    const float* Hh = (const float*)(p.ws + WS_H); const float* mod = (const float*)(p.ws + WS_MOD); const float* WRT = (const float*)(p.ws + WS_WRT);
    bf16_t* Tt = (bf16_t*)(p.ws + WS_T); int* cnt = (int*)(p.ws + WS_CNT); int* rowlist = (int*)(p.ws + WS_ROWLIST); float* pairw = (float*)(p.ws + WS_PAIRW);
    float* tb = (float*)smem;
    float* bias = (float*)(smem + LDS_BYTES - 1024);
    int* lcnt = (int*)(smem + LDS_BYTES - 768);
    int* lbase = lcnt + 32;
    if (tid < 36) bias[tid] = tid < 4 ? p.in[I_RGB][tid] : p.in[I_REB][tid - 4];
    f32x4 x[4][D / 256];
    int itn = blockIdx.x;
    if (itn < T_LAT / 32) {
#pragma unroll
        for (int tt = 0; tt < 4; ++tt)
#pragma unroll
            for (int j = 0; j < D / 256; ++j) x[tt][j] = *(const f32x4*)(Hh + (size_t)(itn * 32 + wave * 4 + tt) * D + j * 256 + lane * 4);
    }
    for (int it = blockIdx.x; it < T_LAT / 32; it += gridDim.x) {
        const int tok0 = it * 32;
        __syncthreads();
        if (tid < 32) lcnt[tid] = 0;
#pragma unroll
        for (int tt = 0; tt < 4; ++tt) {
            const int ti = wave * 4 + tt, tok = tok0 + ti, b = tok / S;
            float ss = 0.f;
#pragma unroll
            for (int j = 0; j < D / 256; ++j) ss += x[tt][j].x * x[tt][j].x + x[tt][j].y * x[tt][j].y + x[tt][j].z * x[tt][j].z + x[tt][j].w * x[tt][j].w;
            ss = wave_sum_fast(ss);
            const float rstd = frsq(ss * (1.0f / D) + 1e-6f);
#pragma unroll
            for (int j = 0; j < D / 256; ++j) {
                const int k = j * 256 + lane * 4;
                const f32x4 g = *(const f32x4*)(p.in[I_NFFN] + k), sh = *(const f32x4*)(mod + (size_t)b * 6 * D + 3 * D + k), sc = *(const f32x4*)(mod + (size_t)b * 6 * D + 4 * D + k);
                f32x4 o; o.x = x[tt][j].x * rstd * g.x * (1.f + sc.x) + sh.x; o.y = x[tt][j].y * rstd * g.y * (1.f + sc.y) + sh.y;
                o.z = x[tt][j].z * rstd * g.z * (1.f + sc.z) + sh.z; o.w = x[tt][j].w * rstd * g.w * (1.f + sc.w) + sh.w;
                *(f32x4*)(tb + ti * TB_LD + k) = o;
                u32x2 ob; ob.x = pk2(o.x, o.y); ob.y = pk2(o.z, o.w);
                *(u32x2*)(Tt + (size_t)tok * D + k) = ob;
            }
        }
        itn = it + gridDim.x;
        if (itn < T_LAT / 32) {
#pragma unroll
            for (int tt = 0; tt < 4; ++tt)
#pragma unroll
                for (int j = 0; j < D / 256; ++j) x[tt][j] = *(const f32x4*)(Hh + (size_t)(itn * 32 + wave * 4 + tt) * D + j * 256 + lane * 4);
        }
        LDS_BARRIER();
        f32x16 a0 = zero16(), a1 = zero16();
        {
            const int kbeg = wave * (D / 8);
            const float* arow = tb + r * TB_LD + kbeg + 4 * hh;
            const float* b0row = WRT + (size_t)(4 + r) * D + kbeg + 4 * hh;
            const float* b1row = WRT + (size_t)(r < 4 ? r : 0) * D + kbeg + 4 * hh;
            const float m1 = r < 4 ? 1.f : 0.f;
#pragma unroll 4
            for (int g = 0; g < D / 64; ++g) {
                const f32x4 av = *(const f32x4*)(arow + 8 * g), b0 = *(const f32x4*)(b0row + 8 * g); const f32x4 b1 = *(const f32x4*)(b1row + 8 * g) * m1;
                a0 = MFMA32F(av.x, b0.x, a0); a1 = MFMA32F(av.x, b1.x, a1); a0 = MFMA32F(av.y, b0.y, a0); a1 = MFMA32F(av.y, b1.y, a1);
                a0 = MFMA32F(av.z, b0.z, a0); a1 = MFMA32F(av.z, b1.z, a1); a0 = MFMA32F(av.w, b0.w, a0); a1 = MFMA32F(av.w, b1.w, a1);
            }
        }
        LDS_BARRIER();
        {
            float* part = tb + wave * (32 * 64);
#pragma unroll
            for (int g = 0; g < 16; ++g) { const int i = crow(g, hh); part[i * 64 + r] = a0[g]; part[i * 64 + 32 + r] = a1[g]; }
        }
        LDS_BARRIER();
        float lsum[4];
        {
            const int i = tid >> 4, c4 = (tid & 15) * 4;
#pragma unroll
            for (int e = 0; e < 4; ++e) { float sacc = 0.f;
#pragma unroll
                for (int w = 0; w < 8; ++w) sacc += tb[w * (32 * 64) + i * 64 + c4 + e];
                lsum[e] = sacc; }
        }
        LDS_BARRIER();
        { const int i = tid >> 4, c4 = (tid & 15) * 4;
#pragma unroll
          for (int e = 0; e < 4; ++e) tb[i * 64 + c4 + e] = lsum[e]; }
        LDS_BARRIER();
        int ex1 = 0, ex2 = 0, rk1 = 0, rk2 = 0; float w1 = 0.f, w2 = 0.f;
        if (tid < 32) {
            const float* L = tb + tid * 64;
            float gl[4];
#pragma unroll
            for (int i = 0; i < 4; ++i) gl[i] = L[32 + i] + bias[i];
            int g = 0; float mx = gl[0];
#pragma unroll
            for (int i = 1; i < 4; ++i) if (gl[i] > mx) { mx = gl[i]; g = i; }
            float se = 0.f;
#pragma unroll
            for (int i = 0; i < 4; ++i) se += expf(gl[i] - mx);
            const float pg = 1.0f / se;
            int i1 = 0; float l1 = L[g * 8] + bias[4 + g * 8];
            for (int i = 1; i < 8; ++i) { const float v = L[g * 8 + i] + bias[4 + g * 8 + i]; if (v > l1) { l1 = v; i1 = i; } }
            int i2 = -1; float l2 = -3.0e38f;
            for (int i = 0; i < 8; ++i) { const float v = L[g * 8 + i] + bias[4 + g * 8 + i]; if (i != i1 && v > l2) { l2 = v; i2 = i; } }
            const float e2 = expf(l2 - l1); w1 = pg / (1.f + e2); w2 = pg * e2 / (1.f + e2);
            ex1 = g * 8 + i1; ex2 = g * 8 + i2;
            rk1 = atomicAdd(&lcnt[ex1], 1); rk2 = atomicAdd(&lcnt[ex2], 1);
        }
        LDS_BARRIER();
        if (tid < 32) { const int c = lcnt[tid]; lbase[tid] = c ? atomicAdd(&cnt[tid], c) : 0; }
        __syncthreads();
        if (tid < 32) {
            const int tok = tok0 + tid;
            rowlist[(size_t)ex1 * CAP + lbase[ex1] + rk1] = tok * 2; pairw[tok * 2] = w1;
            rowlist[(size_t)ex2 * CAP + lbase[ex2] + rk2] = tok * 2 + 1; pairw[tok * 2 + 1] = w2;
        }
    }
}

constexpr int MOE_TM = USE_G8 ? 256 : BM;
DI void moe_tiles(const Params& p, char* smem, int* pre) {
    const int* cnt = (const int*)(p.ws + WS_CNT);
    __syncthreads();
    if (tid_x() == 0) { int s = 0; for (int e = 0; e < NEXP; ++e) { pre[e] = s; s += (cnt[e] + MOE_TM - 1) / MOE_TM; } pre[NEXP] = s; }
    __syncthreads();
}
DI void phase8(const Params& p, char* smem) {
    const int tid = tid_x(), lane = tid & 63, wave = tid >> 6, wr = wave >> 1, wc = wave & 1, fr = lane & 15, fq = lane >> 4;
    int* pre = (int*)(smem + LDS_BYTES - 256);
    moe_tiles(p, smem, pre);
    const int* cnt = (const int*)(p.ws + WS_CNT); const int* rowlist = (const int*)(p.ws + WS_ROWLIST);
    const bf16_t* Tt = (const bf16_t*)(p.ws + WS_T); const bf16_t* GUT = (const bf16_t*)(p.aux + AUX_GUT); bf16_t* HID = (bf16_t*)(p.ws + WS_HID);
    if (USE_G8) {
        const int ntile8 = pre[NEXP] * 2;
        for (int t = blockIdx.x; t < ntile8; t += gridDim.x) {
            const int mg = t >> 1, nt = t & 1; int e = 0;
            while (pre[e + 1] <= mg) ++e;
            const int mt = mg - pre[e], ce = cnt[e]; const int* rl = rowlist + (size_t)e * CAP;
            g8::Acc acc; g8::acc_zero(acc);
            g8::kloop_g(acc, smem, Tt, [&](int r) { int idx = mt * 256 + r; idx = idx < ce ? idx : ce - 1; return (rl[idx] >> 1) * D; }, GUT + ((size_t)e * 512 + nt * 256) * D, D, D, 0);
            const int t2 = tid_x(), wid = t2 >> 6, l2 = t2 & 63, wr2 = wid >> 2, wc2 = wid & 3, fr2 = l2 & 15, fq2 = l2 >> 4;
#pragma unroll
            for (int ai = 0; ai < 2; ++ai)
#pragma unroll
                for (int m = 0; m < 4; ++m) {
                    const int idx = mt * 256 + ai * 128 + wr2 * 64 + m * 16 + fr2;
                    if (idx < ce) {
                        const int pair = rl[idx];
#pragma unroll
                        for (int bj = 0; bj < 2; ++bj) {
                            const f32x4 g = acc[ai][bj][m][0], u = acc[ai][bj][m][1];
                            u32x2 o; o.x = pk2(fsilu(g.x) * u.x, fsilu(g.y) * u.y); o.y = pk2(fsilu(g.z) * u.z, fsilu(g.w) * u.w);
                            *(u32x2*)(HID + (size_t)pair * DE + nt * 128 + bj * 64 + wc2 * 16 + fq2 * 4) = o;
                        }
                    }
                }
        }
        return;
    }
    const int ntile = pre[NEXP] * 4;
    for (int t = blockIdx.x; t < ntile; t += gridDim.x) {
        const int mg = t >> 2, nt = t & 3; int e = 0;
        while (pre[e + 1] <= mg) ++e;
        const int mt = mg - pre[e], ce = cnt[e]; const int* rl = rowlist + (size_t)e * CAP;
        f32x4 acc[MREP][4]; acc_zero(acc);
        gemm_kloop(acc, smem, [&](int i) { int idx = mt * BM + i; idx = idx < ce ? idx : ce - 1; return Tt + (size_t)(rl[idx] >> 1) * D; }, GUT + ((size_t)e * 512 + nt * 128) * D, D, D);
#pragma unroll
        for (int m = 0; m < MREP; ++m)
#pragma unroll
            for (int j = 0; j < 4; ++j) {
                const int idx = mt * BM + wr * 16 * MREP + m * 16 + fq * 4 + j;
                if (idx < ce) {
                    const int pair = rl[idx];
#pragma unroll
                    for (int n = 0; n < 2; ++n) {
                        const float g = acc[m][n][j], u = acc[m][n + 2][j];
                        HID[(size_t)pair * DE + nt * 64 + wc * 32 + n * 16 + fr] = f2bf(siluf_(g) * u);
                    }
                }
            }
    }
}
DI void phase9(const Params& p, char* smem) {
    const int tid = tid_x(), lane = tid & 63, wave = tid >> 6, wr = wave >> 1, wc = wave & 1, fr = lane & 15, fq = lane >> 4;
    int* pre = (int*)(smem + LDS_BYTES - 256);
    moe_tiles(p, smem, pre);
    const int* cnt = (const int*)(p.ws + WS_CNT); const int* rowlist = (const int*)(p.ws + WS_ROWLIST); const float* pairw = (const float*)(p.ws + WS_PAIRW);
    const bf16_t* HID = (const bf16_t*)(p.ws + WS_HID); const bf16_t* DNT = (const bf16_t*)(p.ws + WS_DNT); bf16_t* OP = (bf16_t*)(p.ws + WS_OPAIR);
    if (USE_G8) {
        constexpr int NT8 = D / 256;
        const int ntile8 = pre[NEXP] * NT8;
        for (int t = blockIdx.x; t < ntile8; t += gridDim.x) {
            const int mg = t / NT8, nt = t % NT8; int e = 0;
            while (pre[e + 1] <= mg) ++e;
            const int mt = mg - pre[e], ce = cnt[e]; const int* rl = rowlist + (size_t)e * CAP;
            g8::Acc acc; g8::acc_zero(acc);
            g8::kloop_g(acc, smem, HID, [&](int r) { int idx = mt * 256 + r; idx = idx < ce ? idx : ce - 1; return rl[idx] * DE; }, DNT + ((size_t)e * D + nt * 256) * DE, DE, DE, 0);
            g8::for_each_quad(acc, 0, nt * 256, [&](int row, int col, const f32x4& v) {
                const int idx = mt * 256 + row;
                if (idx < ce) { const int pair = rl[idx]; const float w = pairw[pair];
                    u32x2 o; o.x = pk2(v.x * w, v.y * w); o.y = pk2(v.z * w, v.w * w); *(u32x2*)(OP + (size_t)pair * D + col) = o; }
            });
        }
        return;
    }
    constexpr int NT = D / 128;
    const int ntile = pre[NEXP] * NT;
    for (int t = blockIdx.x; t < ntile; t += gridDim.x) {
        const int mg = t / NT, nt = t % NT; int e = 0;
        while (pre[e + 1] <= mg) ++e;
        const int mt = mg - pre[e], ce = cnt[e]; const int* rl = rowlist + (size_t)e * CAP;
        f32x4 acc[MREP][4]; acc_zero(acc);
        gemm_kloop(acc, smem, [&](int i) { int idx = mt * BM + i; idx = idx < ce ? idx : ce - 1; return HID + (size_t)rl[idx] * DE; }, DNT + ((size_t)e * D + nt * 128) * DE, DE, DE);
#pragma unroll
        for (int m = 0; m < MREP; ++m)
#pragma unroll
            for (int j = 0; j < 4; ++j) {
                const int idx = mt * BM + wr * 16 * MREP + m * 16 + fq * 4 + j;
                if (idx < ce) {
                    const int pair = rl[idx]; const float w = pairw[pair];
#pragma unroll
                    for (int n = 0; n < 4; ++n) OP[(size_t)pair * D + nt * 128 + wc * 64 + n * 16 + fr] = f2bf(acc[m][n][j] * w);
                }
            }
    }
}

DI void phase10(const Params& p, char* smem) {
    const int lane = tid_x() & 63, wave = tid_x() >> 6;
    const int gw = blockIdx.x * 8 + wave, ngw = gridDim.x * 8;
    const float* Hh = (const float*)(p.ws + WS_H); const float* mod = (const float*)(p.ws + WS_MOD); const bf16_t* OP = (const bf16_t*)(p.ws + WS_OPAIR);
    for (int tok = gw; tok < T_LAT; tok += ngw) {
        const int b = tok / S;
        f32x4 x[D / 256]; float ss = 0.f;
#pragma unroll
        for (int j = 0; j < D / 256; ++j) {
            const int k = j * 256 + lane * 4;
            const f32x4 hv = *(const f32x4*)(Hh + (size_t)tok * D + k), g2 = *(const f32x4*)(mod + (size_t)b * 6 * D + 5 * D + k);
            const u32x2 p0 = *(const u32x2*)(OP + (size_t)(tok * 2) * D + k), p1 = *(const u32x2*)(OP + (size_t)(tok * 2 + 1) * D + k);
            f32x4 m;
            m.x = bf2f((bf16_t)(p0.x & 0xffffu)) + bf2f((bf16_t)(p1.x & 0xffffu)); m.y = bf2f((bf16_t)(p0.x >> 16)) + bf2f((bf16_t)(p1.x >> 16));
            m.z = bf2f((bf16_t)(p0.y & 0xffffu)) + bf2f((bf16_t)(p1.y & 0xffffu)); m.w = bf2f((bf16_t)(p0.y >> 16)) + bf2f((bf16_t)(p1.y >> 16));
            x[j].x = hv.x + g2.x * m.x; x[j].y = hv.y + g2.y * m.y; x[j].z = hv.z + g2.z * m.z; x[j].w = hv.w + g2.w * m.w;
            ss += x[j].x * x[j].x + x[j].y * x[j].y + x[j].z * x[j].z + x[j].w * x[j].w;
        }
        ss = wave_sum(ss);
        const float rstd = 1.0f / sqrtf(ss * (1.0f / D) + 1e-6f);
#pragma unroll
        for (int j = 0; j < D / 256; ++j) {
            const int k = j * 256 + lane * 4; const f32x4 g = *(const f32x4*)(p.in[I_FIN] + k);
            f32x4 o; o.x = x[j].x * rstd * g.x; o.y = x[j].y * rstd * g.y; o.z = x[j].z * rstd * g.z; o.w = x[j].w * rstd * g.w;
            *(f32x4*)(p.out + (size_t)tok * D + k) = o;
        }
    }
}

DI void run_phase(const Params& p, int ph, char* smem) {
    switch (ph) {
        case PH_MOD: phase0(p, smem); break;
        case PH_U: phase1(p, smem); break;
        case PH_P: phase2(p, smem); break;
        case PH_HALO: phase_halo(p, smem); break;
        case PH_FIR: phase_fir(p, smem); break;
        case PH_CHAINS: phase3(p, smem); break;
        case PH_POST: phase4(p, smem); break;
        case PH_MERGE: phase5(p, smem); break;
        case PH_WOUT: phase6(p, smem); break;
        case PH_ROUTER: phase7(p, smem); break;
        case PH_UP: phase8(p, smem); break;
        case PH_DOWN: phase9(p, smem); break;
        default: phase10(p, smem); break;
    }
}

#ifndef EMU
namespace cg = cooperative_groups;
#define XB_TMO      128
#define XB_XCNT(j)  (256  + 64 * (j))
#define XB_XSUB(j)  (1280 + 64 * (j))
#define XB_XGEN(j)  (2304 + 64 * (j))
#define XB_TOP      3328
#define XB_TOPGEN   3392
#define XB_SPIN_CAP (1u << 20)
DI unsigned xb_ld(unsigned* p) { return __hip_atomic_load(p, __ATOMIC_RELAXED, __HIP_MEMORY_SCOPE_AGENT); }
DI unsigned xb_add(unsigned* p, unsigned v) { return __hip_atomic_fetch_add(p, v, __ATOMIC_RELAXED, __HIP_MEMORY_SCOPE_AGENT); }
DI unsigned xb_xcc_id() { return (unsigned)__builtin_amdgcn_s_getreg((3 << 11) | 20) & 0xFu; }
#define XB_SPIN(cond, bar) do { unsigned _sp = 0; while (cond) { __builtin_amdgcn_s_sleep(1); \
    if ((++_sp & 255u) == 0u) { if (xb_ld(&(bar)[XB_TMO])) break; if (_sp > XB_SPIN_CAP) { atomicAdd(&(bar)[XB_TMO], 1u); break; } } } } while (0)
DI void xcd_barrier_post(unsigned* bar) { if (threadIdx.x == 0) (void)xb_add(&bar[XB_XCNT(xb_xcc_id())], 1u); }
DI void xcd_barrier_complete(unsigned* bar, unsigned x, unsigned& nloc, unsigned& nx) {
    const unsigned G = gridDim.x;
    unsigned sum, cnt, mine, sp = 0u;
    for (;;) {
        sum = 0u; cnt = 0u; mine = 0u;
#pragma unroll
        for (unsigned j = 0; j < 16; ++j) { const unsigned c = xb_ld(&bar[XB_XCNT(j)]); sum += c; cnt += (c > 0u) ? 1u : 0u; mine = (j == x) ? c : mine; }
        if (sum == G) break;
        __builtin_amdgcn_s_sleep(1);
        if ((++sp & 255u) == 0u) { if (xb_ld(&bar[XB_TMO])) break; if (sp > XB_SPIN_CAP) { atomicAdd(&bar[XB_TMO], 1u); break; } }
    }
    nloc = mine > 0u ? mine : 1u; nx = cnt > 0u ? cnt : 1u;
}
DI void xcd_barrier(unsigned* bar, volatile unsigned* st) {
    asm volatile("s_waitcnt vmcnt(0)" ::: "memory");
    __syncthreads();
    if (threadIdx.x == 0) {
        __builtin_amdgcn_s_waitcnt(0);
        const unsigned x = xb_xcc_id();
        unsigned nloc = st[0], nx = st[1];
        if (nloc == 0u) { xcd_barrier_complete(bar, x, nloc, nx); st[0] = nloc; st[1] = nx; }
        const unsigned old = xb_add(&bar[XB_XSUB(x)], 1u);
        const unsigned gen = old / nloc;
        if (old + 1u == (gen + 1u) * nloc) {
            __builtin_amdgcn_fence(__ATOMIC_RELEASE, "agent");
            asm volatile("s_waitcnt vmcnt(0)" ::: "memory");
            const unsigned og = xb_add(&bar[XB_TOP], 1u);
            const unsigned tg = og / nx;
            if (og + 1u == (tg + 1u) * nx) xb_add(&bar[XB_TOPGEN], 1u);
            else XB_SPIN(xb_ld(&bar[XB_TOPGEN]) == tg, bar);
            __builtin_amdgcn_fence(__ATOMIC_ACQUIRE, "agent");
            xb_add(&bar[XB_XGEN(x)], 1u);
            asm volatile("s_waitcnt vmcnt(0)" ::: "memory");
        } else {
            XB_SPIN(xb_ld(&bar[XB_XGEN(x)]) == gen, bar);
            __builtin_amdgcn_fence(__ATOMIC_ACQUIRE, "agent");
            asm volatile("s_waitcnt vmcnt(0)" ::: "memory");
        }
    }
    __syncthreads();
}
__global__ void __launch_bounds__(NTHREADS) mk_forward(Params p) {
    extern __shared__ __attribute__((aligned(16))) char smem[];
    cg::grid_group grid = cg::this_grid();
    typedef const Params __attribute__((address_space(4)))* KPtr;
    volatile unsigned* xst = (volatile unsigned*)(smem + LDS_BYTES);
    if (threadIdx.x < 2) xst[threadIdx.x] = 0u;
#define PHASE(k, fn) { KPtr kp = (KPtr)__builtin_amdgcn_kernarg_segment_ptr(); asm volatile("" : "+s"(kp)); fn(*(const Params*)kp, smem); \
        unsigned* xbar = (unsigned*)(((const Params*)kp)->ws + WS_XBAR); \
        if ((k) == 0) { grid.sync(); xcd_barrier_post(xbar); } else if ((k) + 1 < NPHASES) xcd_barrier(xbar, xst); }
    PHASE(0, phase0) PHASE(1, phase1) PHASE(2, phase2)
    if (!USE_G8) PHASE(3, phase_halo)
    PHASE(4, phase_fir) PHASE(5, phase3) PHASE(6, phase4)
    PHASE(7, phase5) PHASE(8, phase6) PHASE(9, phase7) PHASE(10, phase8) PHASE(11, phase9) PHASE(12, phase10)
#undef PHASE
}

extern "C" void kernel_launch(void* const* d_in, const int* in_sizes, int n_in, void* d_out, int out_size, void* d_ws, size_t ws_size, hipStream_t stream) {
    static int grid_blocks = 0;
    if (grid_blocks == 0) {
        if (n_in != 35 || out_size != T_LAT * D || ws_size < WS_END || (size_t)out_size * 4 < AUX_END) {
            fprintf(stderr, "kernel_launch: unexpected shapes (n_in %d out %d ws %zu need %zu aux need %zu)\n", n_in, out_size, ws_size, (size_t)WS_END, (size_t)AUX_END);
            grid_blocks = -1; return;
        }
        int dev = 0, cus = 0, per_cu = 0;
        hipGetDevice(&dev);
        hipDeviceGetAttribute(&cus, hipDeviceAttributeMultiprocessorCount, dev);
        hipFuncSetAttribute((const void*)mk_forward, hipFuncAttributeMaxDynamicSharedMemorySize, LDS_BYTES + 256);
        hipOccupancyMaxActiveBlocksPerMultiprocessor(&per_cu, (const void*)mk_forward, NTHREADS, LDS_BYTES + 256);
        if (per_cu < 1) { fprintf(stderr, "kernel_launch: occupancy query says %d blocks/CU\n", per_cu); per_cu = 1; }
        if (per_cu > 1) per_cu = 1;
        grid_blocks = cus * per_cu;
    }
    if (grid_blocks < 0) return;
    Params p{};
    for (int i = 0; i < 35; ++i) p.in[i] = (const float*)d_in[i];
    p.out = (float*)d_out; p.ws = (char*)d_ws; p.aux = (char*)d_out;
    p.ph_lo = 0; p.ph_hi = NPHASES;
    void* args[] = {&p};
    hipError_t e = hipLaunchCooperativeKernel((const void*)mk_forward, dim3(grid_blocks), dim3(NTHREADS), args, LDS_BYTES + 256, stream);
    if (e != hipSuccess) fprintf(stderr, "cooperative launch failed: %s (grid %d)\n", hipGetErrorString(e), grid_blocks);
}
#endif
```

```cpp
#ifndef EMU
#include <hip/hip_runtime.h>
#include <hip/hip_cooperative_groups.h>
#include <cstdio>
#endif
#include <stdint.h>
#include <stddef.h>

#ifndef CFG_D
#define CFG_D 1024
#define CFG_B 8
#define CFG_S 2048
#define CFG_CTX 256
#endif
#ifndef MK_LAUNCHES
#define MK_LAUNCHES 1
#endif

typedef unsigned short bf16_t;
typedef short bf16x8 __attribute__((ext_vector_type(8)));
typedef float f32x4 __attribute__((ext_vector_type(4)));
typedef unsigned u32x4 __attribute__((ext_vector_type(4)));
typedef unsigned u32x2 __attribute__((ext_vector_type(2)));

#define DI __device__ __forceinline__
DI int tid_x() { int t = (int)threadIdx.x;
#ifndef EMU
    asm volatile("" : "+v"(t));
#endif
    return t; }

constexpr int D = CFG_D, NB = CFG_B, S = CFG_S, CTXL = CFG_CTX;
constexpr int GW = 64, ROWS = S / GW;
constexpr int T_CTX = NB * CTXL, T_LAT = NB * S, T_ALL = T_CTX + T_LAT;
constexpr int H_A = 4, H_B = 8;
constexpr int A_COLS = 2064, B_COLS = 1920;
constexpr int IN_COLS = A_COLS + B_COLS + 2 * D;
constexpr int COL_B0 = A_COLS, COL_G0 = A_COLS + B_COLS;
constexpr int CTX_COLS = COL_G0;
constexpr int NP = ((IN_COLS + 127) / 128) * 128;
constexpr int NEXP = 32, DE = 256;
constexpr int NV = NB + 1;
constexpr int NTHREADS = 512;
constexpr int MREP = (T_CTX % 256 == 0 && T_LAT % 256 == 0) ? 4 : 2;
constexpr int BM = 64 * MREP;
constexpr int NPHASES = 13;
enum { PH_MOD = 0, PH_U, PH_P, PH_HALO, PH_FIR, PH_CHAINS, PH_POST, PH_MERGE, PH_WOUT, PH_ROUTER, PH_UP, PH_DOWN, PH_FINAL };
constexpr int LDS_BYTES = 155648;
constexpr int CAP = T_LAT;

static_assert(D % 256 == 0 && S % 64 == 0 && CTXL % 64 == 0 && T_CTX % BM == 0 && T_LAT % BM == 0, "shape");

constexpr size_t al256(size_t x) { return (x + 255) & ~(size_t)255; }
constexpr size_t WS_CNT = 0;
constexpr size_t WS_BAR = 256;
constexpr size_t WS_XBAR = 512;
constexpr size_t WS_MOD = 512 + 3456 * 4 + 256;
constexpr size_t WS_AB = al256(WS_MOD + (size_t)NV * 6 * D * 4);
constexpr size_t WS_BONUS = al256(WS_AB + (size_t)T_ALL * 16 * 4);
constexpr size_t WS_PAIRW = al256(WS_BONUS + (size_t)2 * T_LAT * 8 * 4);
constexpr size_t WS_ROWLIST = al256(WS_PAIRW + (size_t)T_LAT * 2 * 4);
constexpr size_t WS_WRT = al256(WS_ROWLIST + (size_t)NEXP * CAP * 4);
constexpr size_t WS_G2T = al256(WS_WRT + (size_t)36 * D * 4);
constexpr size_t WS_WOA = al256(WS_G2T + (size_t)512 * 128 * 2);
constexpr size_t WS_WOB = al256(WS_WOA + (size_t)D * 512 * 2);
constexpr size_t WS_WOUT = al256(WS_WOB + (size_t)D * 512 * 2);
constexpr size_t WS_OA = al256(WS_WOUT + (size_t)D * D * 2);
constexpr size_t WS_OB = al256(WS_OA + (size_t)T_LAT * 512 * 2);
constexpr size_t WS_HALO_A = WS_OA;
constexpr size_t WS_HALO_B = WS_OA + al256((size_t)(T_ALL / 64) * 4 * 1536 * 2);
static_assert(WS_HALO_B + (size_t)(T_ALL / 64) * 2 * 1920 * 2 <= WS_OB + (size_t)T_LAT * 512 * 2, "halo buffers");
constexpr size_t WS_DNT = WS_OA;
constexpr size_t WS_SPARE_END = al256(WS_OB + (size_t)T_LAT * 512 * 2) > al256(WS_DNT + (size_t)NEXP * D * DE * 2) ? al256(WS_OB + (size_t)T_LAT * 512 * 2) : al256(WS_DNT + (size_t)NEXP * D * DE * 2);
constexpr size_t WS_P = WS_SPARE_END;
constexpr size_t WS_PLAT = WS_P;
constexpr size_t WS_PCTX = al256(WS_PLAT + (size_t)T_LAT * IN_COLS * 2);
constexpr size_t WS_P_END = al256(WS_PCTX + (size_t)T_CTX * CTX_COLS * 2);
constexpr size_t WS_H = WS_P;
constexpr size_t WS_T = al256(WS_H + (size_t)T_LAT * D * 4);
constexpr size_t WS_HID = al256(WS_T + (size_t)T_LAT * D * 2);
constexpr size_t WS_OPAIR = al256(WS_HID + (size_t)T_LAT * 2 * DE * 2);
constexpr size_t WS_P2_END = al256(WS_OPAIR + (size_t)T_LAT * 2 * D * 2);
constexpr size_t WS_END = WS_P_END > WS_P2_END ? WS_P_END : WS_P2_END;
constexpr size_t AUX_WINT = 0;
constexpr size_t AUX_U = al256((size_t)NP * D * 2);
constexpr size_t AUX_ODIR = 0;
constexpr size_t AUX_YDIR = (size_t)2 * T_LAT * 512 * 2;
constexpr size_t AUX_Y = 0;
constexpr size_t AUX_GUT = (size_t)T_LAT * D * 2;
constexpr size_t AUX_END1 = AUX_U + (size_t)T_ALL * D * 2;
constexpr size_t AUX_END2 = AUX_YDIR + (size_t)2 * T_LAT * 512 * 2;
constexpr size_t AUX_END3 = AUX_GUT + (size_t)NEXP * 512 * D * 2;
constexpr size_t AUX_END = (AUX_END1 > AUX_END2 ? (AUX_END1 > AUX_END3 ? AUX_END1 : AUX_END3) : (AUX_END2 > AUX_END3 ? AUX_END2 : AUX_END3));

struct Params {
    const float* in[35];
    float* out;
    char* ws;
    char* aux;
    int ph_lo, ph_hi;
};
enum { I_X = 0, I_C, I_CTX, I_CCTX, I_ADAW, I_ADAB, I_NMIX, I_NFFN, I_WIN, I_CONV, I_ALOG, I_DTB, I_ONORM, I_MU, I_W0, I_W2, I_A0, I_A2, I_G2, I_KK, I_KA, I_RK, I_LNG, I_LNB, I_WOA, I_WOB, I_WOUT, I_RG, I_RGB, I_RE, I_REB, I_MG, I_MU_UP, I_MD, I_FIN };

DI float bf2f(bf16_t v) { union { unsigned u; float f; } x; x.u = ((unsigned)v) << 16; return x.f; }
#ifdef EMU
DI bf16_t f2bf(float f) { union { float f; unsigned u; } x; x.f = f; unsigned u = x.u; u += 0x7fffu + ((u >> 16) & 1u); return (bf16_t)(u >> 16); }
DI unsigned pk2(float lo, float hi) { return (unsigned)f2bf(lo) | ((unsigned)f2bf(hi) << 16); }
#else
typedef __bf16 hbf16x2 __attribute__((ext_vector_type(2)));
typedef float f32x2_ __attribute__((ext_vector_type(2)));
DI bf16_t f2bf(float f) { return __builtin_bit_cast(unsigned short, (__bf16)f); }
DI unsigned pk2(float lo, float hi) { const f32x2_ v = {lo, hi}; return __builtin_bit_cast(unsigned, __builtin_convertvector(v, hbf16x2)); }
#endif
DI float sigmoidf_(float x) { return 1.0f / (1.0f + expf(-x)); }
DI float siluf_(float x) { return x / (1.0f + expf(-x)); }
DI float softplusf_(float x) { return x > 20.f ? x : log1pf(expf(x)); }
DI float wave_sum(float v) {
#pragma unroll
    for (int o = 1; o < 64; o <<= 1) v += __shfl_xor(v, o);
    return v;
}
#ifdef EMU
#define MFMA16(a, b, c) emu_mfma16((a), (b), (c))
#define WAVE_SYNC() emu::wave_bar()
#else
#define MFMA16(a, b, c) __builtin_amdgcn_mfma_f32_16x16x32_bf16((a), (b), (c), 0, 0, 0)
#define WAVE_SYNC() asm volatile("s_waitcnt lgkmcnt(0)" ::: "memory")
#endif
#ifdef EMU
#define LDS_BARRIER() __syncthreads()
#else
#define LDS_BARRIER() do { asm volatile("s_waitcnt lgkmcnt(0)" ::: "memory"); __builtin_amdgcn_s_barrier(); asm volatile("" ::: "memory"); } while (0)
#endif

typedef float f32x16 __attribute__((ext_vector_type(16)));
typedef float f32x2_ac __attribute__((ext_vector_type(2)));
typedef short bf16x4 __attribute__((ext_vector_type(4)));
#ifdef EMU
#define MFMA32(a, b, c) emu_mfma32((a), (b), (c))
DI float fexp(float x) { return expf(x); }
DI float flog(float x) { return logf(x); }
DI float frcp(float x) { return 1.0f / x; }
DI float frsq(float x) { return 1.0f / sqrtf(x); }
DI float wave_sum_fast(float v) { return wave_sum(v); }
#else
#define MFMA32(a, b, c) __builtin_amdgcn_mfma_f32_32x32x16_bf16((a), (b), (c), 0, 0, 0)
DI float fexp(float x) { return __expf(x); }
DI float flog(float x) { return __logf(x); }
DI float frcp(float x) { return __builtin_amdgcn_rcpf(x); }
DI float frsq(float x) { return __builtin_amdgcn_rsqf(x); }
#define DPP_ADD(v, ctrl) ((v) + __builtin_bit_cast(float, __builtin_amdgcn_update_dpp(0, __builtin_bit_cast(int, (v)), (ctrl), 0xf, 0xf, false)))
DI float wave_sum_fast(float v) {
    v = DPP_ADD(v, 0xB1); v = DPP_ADD(v, 0x4E); v = DPP_ADD(v, 0x141); v = DPP_ADD(v, 0x140);
    const int iv = __builtin_bit_cast(int, v);
    return (__builtin_bit_cast(float, __builtin_amdgcn_readlane(iv, 0)) + __builtin_bit_cast(float, __builtin_amdgcn_readlane(iv, 16))) +
           (__builtin_bit_cast(float, __builtin_amdgcn_readlane(iv, 32)) + __builtin_bit_cast(float, __builtin_amdgcn_readlane(iv, 48)));
}
#endif
DI float fsigmoid(float x) { return frcp(1.0f + fexp(-x)); }
DI float fsilu(float x) { return x * fsigmoid(x); }
DI float fsoftplus(float x) { return fmaxf(x, 0.f) + flog(1.f + fexp(-fabsf(x))); }
DI float ftanh(float x) { return 1.0f - 2.0f * frcp(1.0f + fexp(2.0f * x)); }

constexpr int LDS_ROW = 40;
constexpr int GEMM_A_BYTES = BM * LDS_ROW * 2, GEMM_B_BYTES = 128 * LDS_ROW * 2;
template <int MR, class ARow>
DI void gemm_kloop(f32x4 (&acc)[MR][4], char* smem, ARow arow, const bf16_t* Bt, int ldb, int K) {
    constexpr int BM = 64 * MR;
    const int tid = tid_x(), lane = tid & 63, wave = tid >> 6, wr = wave >> 1, wc = wave & 1, fr = lane & 15, fq = lane >> 4;
    bf16_t* As = (bf16_t*)smem;
    bf16_t* Bs = (bf16_t*)(smem + 2 * GEMM_A_BYTES);
    constexpr int ACH = BM * 4 / NTHREADS;
    static_assert(ACH >= 1, "tile");
    const bf16_t* ap[ACH];
#pragma unroll
    for (int i = 0; i < ACH; ++i) { const int q = tid + i * NTHREADS; ap[i] = arow(q >> 2) + (q & 3) * 8; }
    const bf16_t* bp = Bt + (size_t)(tid >> 2) * ldb + (tid & 3) * 8;
    u32x4 ra[ACH], rb;
#pragma unroll
    for (int i = 0; i < ACH; ++i) ra[i] = *(const u32x4*)(ap[i]);
    rb = *(const u32x4*)(bp);
    const int nk = K / 32;
    for (int kt = 0; kt < nk; ++kt) {
        const int buf = kt & 1;
#pragma unroll
        for (int i = 0; i < ACH; ++i) { const int q = tid + i * NTHREADS; *(u32x4*)(As + (buf * BM + (q >> 2)) * LDS_ROW + (q & 3) * 8) = ra[i]; }
        *(u32x4*)(Bs + (buf * 128 + (tid >> 2)) * LDS_ROW + (tid & 3) * 8) = rb;
        __syncthreads();
        if (kt + 1 < nk) {
#pragma unroll
            for (int i = 0; i < ACH; ++i) ra[i] = *(const u32x4*)(ap[i] + (kt + 1) * 32);
            rb = *(const u32x4*)(bp + (kt + 1) * 32);
        }
        bf16x8 af[MR], bfr[4];
#pragma unroll
        for (int m = 0; m < MR; ++m) af[m] = *(const bf16x8*)(As + (buf * BM + wr * 16 * MR + m * 16 + fr) * LDS_ROW + fq * 8);
#pragma unroll
        for (int n = 0; n < 4; ++n) bfr[n] = *(const bf16x8*)(Bs + (buf * 128 + wc * 64 + n * 16 + fr) * LDS_ROW + fq * 8);
#pragma unroll
        for (int m = 0; m < MR; ++m)
#pragma unroll
            for (int n = 0; n < 4; ++n) acc[m][n] = MFMA16(af[m], bfr[n], acc[m][n]);
    }
    __syncthreads();
}
template <int MR>
DI void acc_zero(f32x4 (&acc)[MR][4]) {
#pragma unroll
    for (int m = 0; m < MR; ++m)
#pragma unroll
        for (int n = 0; n < 4; ++n) acc[m][n] = (f32x4){0.f, 0.f, 0.f, 0.f};
}

namespace g8 {
constexpr int BM = 256, BK = 64, HALF = 128, HT = HALF * BK;
constexpr int LDS_NEED = 8 * HT * 2;
DI int lds_byte(int r, int c) { const int st = (r >> 4) * 2 + (c >> 5), rr = r & 15, cc = c & 31, ob = rr * 64 + cc * 2; return st * 1024 + (ob ^ (((ob >> 9) & 1) << 5)); }
DI void stage_rc(int b, int& R, int& C) { const int st = b / 1024, sb = b % 1024, swz = sb ^ (((sb >> 9) & 1) << 5); R = (st >> 1) * 16 + swz / 64; C = (st & 1) * 32 + (swz % 64) / 2; }
#ifdef EMU
#define G8_GLDS(src, dst) emu_global_load_lds16((src), (dst))
#define G8_WAIT_V(n)
#define G8_WAIT_L(n)
#define G8_BAR __syncthreads()
#define G8_SCHED
#define G8_PRIO(x)
#else
#define G8_GLDS(src, dst) __builtin_amdgcn_global_load_lds((const unsigned*)(src), (__attribute__((address_space(3))) unsigned*)(dst), 16, 0, 0)
#define G8_WAIT_V(n) asm volatile("s_waitcnt vmcnt(" #n ")" ::: "memory")
#define G8_WAIT_L(n) asm volatile("s_waitcnt lgkmcnt(" #n ")" ::: "memory")
#define G8_BAR __builtin_amdgcn_s_barrier()
#define G8_SCHED __builtin_amdgcn_sched_barrier(0)
#define G8_PRIO(x) __builtin_amdgcn_s_setprio(x)
#endif
typedef f32x4 Acc[2][2][4][2];
template <class AOff>
DI void kloop_g(Acc& acc, char* smem, const bf16_t* A, AOff aoff, const bf16_t* Bt, int ldb, int K, int bcol) {
    bf16_t* shm = (bf16_t*)smem;
    const int tid = tid_x(), wid = tid >> 6, lane = tid & 63, wr = wid >> 2, wc = wid & 3, fr = lane & 15, fq = lane >> 4;
    int ao[2][2];
#pragma unroll
    for (int h = 0; h < 2; ++h)
#pragma unroll
        for (int i = 0; i < 2; ++i) { int R, C; stage_rc(tid * 16 + i * 8192, R, C); ao[h][i] = aoff(h * HALF + R) + C; }
#define G8_STAGE_A(P, h, kt) do { for (int _i = 0; _i < 2; ++_i) { const int _b = tid * 16 + _i * 8192; G8_GLDS(A + (size_t)ao[h][_i] + (size_t)(kt) * BK, (char*)(P) + _b); } } while (0)
#define G8_SA(b, h) (shm + ((b) * 2 + (h)) * HT)
#define G8_SB(b, h) (shm + (4 + (b) * 2 + (h)) * HT)
#define G8_STAGE(P, BASE, LD, br, kt) do { const bf16_t* _g = (BASE) + (size_t)(br) * (LD) + (size_t)(kt) * BK; \
    for (int _i = 0; _i < 2; ++_i) { const int _b = tid * 16 + _i * 8192; int _r, _c; stage_rc(_b, _r, _c); G8_GLDS(_g + (size_t)_r * (LD) + _c, (char*)(P) + _b); } } while (0)
#define G8_LDA(dst, b, h) for (int m = 0; m < 4; ++m) for (int k = 0; k < 2; ++k) dst[m][k] = *(const bf16x8*)((const char*)G8_SA(b, h) + lds_byte(wr * 64 + m * 16 + fr, k * 32 + fq * 8))
#define G8_LDB(dst, b, h) for (int n = 0; n < 2; ++n) for (int k = 0; k < 2; ++k) dst[n][k] = *(const bf16x8*)((const char*)G8_SB(b, h) + lds_byte(wc * 32 + n * 16 + fr, k * 32 + fq * 8))
#define G8_MMA(ai, bj, At_, Bt_) do { G8_PRIO(1); for (int m = 0; m < 4; ++m) for (int n = 0; n < 2; ++n) for (int k = 0; k < 2; ++k) \
    acc[ai][bj][m][n] = MFMA16(Bt_[n][k], At_[m][k], acc[ai][bj][m][n]); G8_PRIO(0); } while (0)
    bf16x8 At[4][2], B0[2][2], B1[2][2];
    const int nt = K / BK;
    G8_STAGE(G8_SB(0, 0), Bt, ldb, bcol, 0); G8_STAGE_A(G8_SA(0, 0), 0, 0);
    G8_STAGE(G8_SB(0, 1), Bt, ldb, bcol + HALF, 0); G8_STAGE_A(G8_SA(0, 1), 1, 0);
    if (wr == 1) G8_BAR;
    G8_WAIT_V(4); G8_BAR;
    G8_STAGE(G8_SB(1, 0), Bt, ldb, bcol, 1); G8_STAGE_A(G8_SA(1, 0), 0, 1); G8_STAGE(G8_SB(1, 1), Bt, ldb, bcol + HALF, 1);
    G8_WAIT_V(6); G8_BAR;
    for (int t = 0; t < nt - 2; t += 2) {
        G8_LDB(B0, 0, 0); G8_SCHED; G8_LDA(At, 0, 0); G8_STAGE_A(G8_SA(1, 1), 1, t + 1);
        G8_WAIT_L(8); G8_BAR; G8_WAIT_L(0); G8_MMA(0, 0, At, B0); G8_BAR; G8_SCHED;
        G8_LDB(B1, 0, 1); G8_STAGE(G8_SB(0, 0), Bt, ldb, bcol, t + 2);
        G8_BAR; G8_WAIT_L(0); G8_MMA(0, 1, At, B1); G8_BAR;
        G8_LDA(At, 0, 1); G8_STAGE_A(G8_SA(0, 0), 0, t + 2);
        G8_BAR; G8_WAIT_L(0); G8_MMA(1, 0, At, B0); G8_BAR; G8_SCHED;
        G8_STAGE(G8_SB(0, 1), Bt, ldb, bcol + HALF, t + 2);
        G8_WAIT_V(6); G8_BAR; G8_MMA(1, 1, At, B1); G8_BAR;
        G8_LDB(B0, 1, 0); G8_SCHED; G8_LDA(At, 1, 0); G8_STAGE_A(G8_SA(0, 1), 1, t + 2);
        G8_WAIT_L(8); G8_BAR; G8_WAIT_L(0); G8_MMA(0, 0, At, B0); G8_BAR; G8_SCHED;
        G8_LDB(B1, 1, 1); G8_STAGE(G8_SB(1, 0), Bt, ldb, bcol, t + 3);
        G8_BAR; G8_WAIT_L(0); G8_MMA(0, 1, At, B1); G8_BAR;
        G8_LDA(At, 1, 1); G8_STAGE_A(G8_SA(1, 0), 0, t + 3);
        G8_BAR; G8_WAIT_L(0); G8_MMA(1, 0, At, B0); G8_BAR; G8_SCHED;
        G8_STAGE(G8_SB(1, 1), Bt, ldb, bcol + HALF, t + 3);
        G8_WAIT_V(6); G8_BAR; G8_MMA(1, 1, At, B1); G8_BAR;
    }
    { G8_LDB(B0, 0, 0); G8_LDA(At, 0, 0); G8_STAGE_A(G8_SA(1, 1), 1, nt - 1);
      G8_BAR; G8_WAIT_L(0); G8_MMA(0, 0, At, B0); G8_BAR;
      G8_LDB(B1, 0, 1); G8_BAR; G8_WAIT_L(0); G8_MMA(0, 1, At, B1); G8_BAR;
      G8_LDA(At, 0, 1); G8_WAIT_V(4); G8_BAR; G8_WAIT_L(0); G8_MMA(1, 0, At, B0); G8_MMA(1, 1, At, B1); G8_BAR; }
    { G8_LDB(B0, 1, 0); G8_LDA(At, 1, 0); G8_WAIT_V(2); G8_BAR; G8_WAIT_L(0); G8_MMA(0, 0, At, B0); G8_BAR;
      G8_LDB(B1, 1, 1); G8_WAIT_V(0); G8_BAR; G8_WAIT_L(0); G8_MMA(0, 1, At, B1); G8_BAR;
      G8_LDA(At, 1, 1); G8_BAR; G8_WAIT_L(0); G8_MMA(1, 0, At, B0); G8_MMA(1, 1, At, B1); G8_BAR; }
    if (wr == 0) G8_BAR;
#undef G8_SA
#undef G8_SB
#undef G8_STAGE
#undef G8_STAGE_A
#undef G8_LDA
#undef G8_LDB
#undef G8_MMA
}
DI void kloop(Acc& acc, char* smem, const bf16_t* A, int lda, const bf16_t* Bt, int ldb, int K, int brow, int bcol) {
    kloop_g(acc, smem, A, [&](int r) { return (brow + r) * lda; }, Bt, ldb, K, bcol);
}
DI bool tile_order(int L, int nM, int nN, int& pm, int& pn) {
    constexpr int NXCD = 8, WGM = 8;
    const int nwg = nM * nN; if (L >= nwg) return false;
    int wgid = L; { const int q = nwg / NXCD, r = nwg % NXCD, xcd = wgid % NXCD, off = wgid / NXCD; wgid = (xcd < r ? xcd * (q + 1) : r * (q + 1) + (xcd - r) * q) + off; }
    const int nig = WGM * nN, gid = wgid / nig, fm = gid * WGM, gsz = (nM - fm) < WGM ? (nM - fm) : WGM;
    pm = fm + ((wgid % nig) % gsz); pn = (wgid % nig) / gsz; return true;
}
DI void acc_zero(Acc& acc) {
#pragma unroll
    for (int a = 0; a < 2; ++a)
#pragma unroll
        for (int b = 0; b < 2; ++b)
#pragma unroll
            for (int m = 0; m < 4; ++m)
#pragma unroll
                for (int n = 0; n < 2; ++n) acc[a][b][m][n] = (f32x4){0.f, 0.f, 0.f, 0.f};
}
template <class F> DI void for_each_quad(const Acc& acc, int brow, int bcol, F f) {
    const int tid = tid_x(), wid = tid >> 6, lane = tid & 63, wr = wid >> 2, wc = wid & 3, fr = lane & 15, fq = lane >> 4;
#pragma unroll
    for (int ai = 0; ai < 2; ++ai)
#pragma unroll
        for (int m = 0; m < 4; ++m)
#pragma unroll
            for (int bj = 0; bj < 2; ++bj)
#pragma unroll
                for (int n = 0; n < 2; ++n) f(brow + ai * HALF + wr * 64 + m * 16 + fr, bcol + bj * HALF + wc * 32 + n * 16 + fq * 4, acc[ai][bj][m][n]);
}
}

constexpr bool USE_G8 = ((NB * CTXL) % 256 == 0) && ((NB * S) % 256 == 0) && (NP % 256 == 0) && (D % 256 == 0) && (D >= 256);
DI int gu_row(int c, int up) {
    if (USE_G8) return (c >> 7) * 256 + ((c >> 6) & 1) * 128 + ((c >> 4) & 3) * 32 + (up ? 16 : 0) + (c & 15);
    return (c >> 6) * 128 + ((c >> 5) & 1) * 64 + ((c >> 4) & 1) * 16 + (c & 15) + (up ? 32 : 0);
}
DI void transpose_item(const float* W, int N, int Nvalid, int k0, int n0, bf16_t* WT, int ldt, int mode, float* scr, int lane) {
    float tv[32];
#pragma unroll
    for (int i = 0; i < 32; ++i) {
        const int kk = 2 * i + (lane >> 5), n = n0 + (lane & 31);
        tv[i] = (n < Nvalid) ? W[(size_t)(k0 + kk) * N + n] : 0.f;
    }
#pragma unroll
    for (int i = 0; i < 32; ++i) scr[(2 * i + (lane >> 5)) * 33 + (lane & 31)] = tv[i];
    WAVE_SYNC();
    const int c = lane & 7;
#pragma unroll
    for (int j = 0; j < 4; ++j) {
        const int nl = (lane >> 3) + 8 * j; const float* s = scr + (8 * c) * 33 + nl;
        u32x4 o; o.x = pk2(s[0], s[33]); o.y = pk2(s[2 * 33], s[3 * 33]); o.z = pk2(s[4 * 33], s[5 * 33]); o.w = pk2(s[6 * 33], s[7 * 33]);
        const int n = n0 + nl; const int row = mode == 0 ? n : gu_row(n, mode == 2);
        *(u32x4*)(WT + (size_t)row * ldt + k0 + 8 * c) = o;
    }
    WAVE_SYNC();
}
DI void transpose_matrix(const float* W, int K, int N, int Npad, bf16_t* WT, int mode, char* smem, int gw, int ngw, int& base) {
    const int lane = tid_x() & 63, wave = tid_x() >> 6;
    float* scr = (float*)smem + wave * (64 * 33);
    const int nkb = K / 64, nnb = Npad / 32, nitems = nkb * nnb;
    int first = ((gw - base) % ngw + ngw) % ngw;
    for (int it = first; it < nitems; it += ngw) {
        const int kb = it / nnb, nb = it % nnb;
        transpose_item(W, N, N, kb * 64, nb * 32, WT, K, mode, scr, lane);
    }
    base = (base + nitems) % ngw;
}

DI void phase0(const Params& p, char* smem) {
    const int tid = tid_x(), lane = tid & 63, wave = tid >> 6;
    if (blockIdx.x == 0 && tid < NEXP) ((int*)(p.ws + WS_CNT))[tid] = 0;
    if (blockIdx.x == 0 && tid == 0) *(unsigned*)(p.ws + WS_BAR) = 0u;
    float* sil = (float*)smem;
    float* red = sil + NV * D;
    const int nitems = 6 * D / 32;
    bool did = false;
    for (int it = blockIdx.x; it < nitems; it += gridDim.x) {
        if (!did) {
            for (int i = tid; i < NV * D; i += NTHREADS) { const int v = i / D, k = i % D; const float cv = v < NB ? p.in[I_C][v * D + k] : p.in[I_CCTX][k]; sil[i] = siluf_(cv); }
            did = true;
        }
        __syncthreads();
        const int col = it * 32 + (lane & 31), rp = lane >> 5;
        float acc[NV];
#pragma unroll
        for (int v = 0; v < NV; ++v) acc[v] = 0.f;
        const int r0 = wave * (D / 8);
        float wv[D / 16];
#pragma unroll
        for (int i = 0; i < D / 16; ++i) wv[i] = p.in[I_ADAW][(size_t)(r0 + 2 * i + rp) * (6 * D) + col];
#pragma unroll
        for (int i = 0; i < D / 16; ++i) {
            const int row = r0 + 2 * i + rp;
#pragma unroll
            for (int v = 0; v < NV; ++v) acc[v] += sil[v * D + row] * wv[i];
        }
#pragma unroll
        for (int v = 0; v < NV; ++v) red[((wave * 2 + rp) * NV + v) * 32 + (lane & 31)] = acc[v];
        __syncthreads();
        if (tid < NV * 32) {
            const int v = tid / 32, cl = tid % 32; float s = p.in[I_ADAB][it * 32 + cl];
            for (int g = 0; g < 16; ++g) s += red[(g * NV + v) * 32 + cl];
            ((float*)(p.ws + WS_MOD))[(size_t)v * 6 * D + it * 32 + cl] = s;
        }
    }
    __syncthreads();
    const int gw = blockIdx.x * 8 + wave, ngw = gridDim.x * 8; int base = 0;
    {
        float* scr = (float*)smem + wave * (64 * 33);
        const int nkb = D / 64, nnb = NP / 32, nitems2 = nkb * nnb;
        for (int it = gw; it < nitems2; it += ngw) { const int kb = it / nnb, nb = it % nnb; transpose_item(p.in[I_WIN], IN_COLS, IN_COLS, kb * 64, nb * 32, (bf16_t*)(p.aux + AUX_WINT), D, 0, scr, lane); }
        base = nitems2 % ngw;
    }
    { float* WRT = (float*)(p.ws + WS_WRT);
      for (int i = blockIdx.x * NTHREADS + tid; i < 36 * D; i += gridDim.x * NTHREADS) { const int j = i / D, k = i % D; WRT[i] = j < 4 ? p.in[I_RG][(size_t)k * 4 + j] : p.in[I_RE][(size_t)k * 32 + (j - 4)]; } }
    transpose_matrix(p.in[I_WOA], 512, D, D, (bf16_t*)(p.ws + WS_WOA), 0, smem, gw, ngw, base);
    transpose_matrix(p.in[I_WOB], 512, D, D, (bf16_t*)(p.ws + WS_WOB), 0, smem, gw, ngw, base);
    transpose_matrix(p.in[I_WOUT], D, D, D, (bf16_t*)(p.ws + WS_WOUT), 0, smem, gw, ngw, base);
    transpose_matrix(p.in[I_G2], 128, 512, 512, (bf16_t*)(p.ws + WS_G2T), 0, smem, gw, ngw, base);
}

constexpr int NSEG = T_ALL / 64, NSEG_CTX = T_CTX / 64;
DI void halo_store(const Params& p, int row, int col, const u32x2& o) {
    int seq, b, j;
    if (row < T_CTX) { seq = 0; b = row / CTXL; j = row % CTXL; } else { seq = 1; const int rr = row - T_CTX; b = rr / S; j = rr % S; }
    const int L = seq ? S : CTXL; const int segbase = seq ? NSEG_CTX + b * (S / 64) : b * (CTXL / 64);
    if (col < 1536) {
        const int jm = j & 63;
        if (jm >= 62 && j + 2 < L) { const int g = segbase + (j >> 6) + 1; *(u32x2*)((bf16_t*)(p.ws + WS_HALO_A) + ((size_t)g * 4 + (jm - 62)) * 1536 + col) = o; }
        if (jm < 2 && j >= 64) { const int g = segbase + (j >> 6) - 1; *(u32x2*)((bf16_t*)(p.ws + WS_HALO_A) + ((size_t)g * 4 + 2 + jm) * 1536 + col) = o; }
    } else if (col >= COL_B0 && col < COL_B0 + 1920) {
        const int js = seq ? (j % GW) * ROWS + j / GW : j; const int jm = js & 63;
        if (jm == 63 && js + 1 < L) { const int g = segbase + (js >> 6) + 1; *(u32x2*)((bf16_t*)(p.ws + WS_HALO_B) + ((size_t)g * 2 + 0) * 1920 + (col - COL_B0)) = o; }
        if (jm == 0 && js >= 64) { const int g = segbase + (js >> 6) - 1; *(u32x2*)((bf16_t*)(p.ws + WS_HALO_B) + ((size_t)g * 2 + 1) * 1920 + (col - COL_B0)) = o; }
    }
}
DI void halo_zero_fill(const Params& p) {
    const int tid = tid_x(), lane = tid & 63, wave = tid >> 6; const int gw = blockIdx.x * 8 + wave, ngw = gridDim.x * 8;
    bf16_t* HA = (bf16_t*)(p.ws + WS_HALO_A); bf16_t* HB = (bf16_t*)(p.ws + WS_HALO_B);
    for (int it = gw; it < NSEG * 2; it += ngw) {
        const int g = it >> 1, side = it & 1;
        const bool ctx = g < NSEG_CTX; const int sg = ctx ? g % (CTXL / 64) : (g - NSEG_CTX) % (S / 64); const int nsg = ctx ? CTXL / 64 : S / 64;
        const bool edge = side ? (sg == nsg - 1) : (sg == 0);
        if (!edge) continue;
        for (int c = lane; c < 384; c += 64) *(u32x4*)(HA + ((size_t)g * 4 + 2 * side) * 1536 + c * 8) = (u32x4){0u, 0u, 0u, 0u};
        for (int c = lane; c < 240; c += 64) *(u32x4*)(HB + ((size_t)g * 2 + side) * 1920 + c * 8) = (u32x4){0u, 0u, 0u, 0u};
    }
}
DI void phase1(const Params& p, char* smem) {
    if (USE_G8) halo_zero_fill(p);
    const int lane = tid_x() & 63, wave = tid_x() >> 6;
    const int gw = blockIdx.x * 8 + wave, ngw = gridDim.x * 8;
    const float* mod = (const float*)(p.ws + WS_MOD);
    bf16_t* U = (bf16_t*)(p.aux + AUX_U);
    auto rowsrc = [&](int r) -> const float* { return r < T_CTX ? p.in[I_CTX] + (size_t)r * D : p.in[I_X] + (size_t)(r - T_CTX) * D; };
    f32x4 xn[D / 256];
    if (gw < T_ALL) {
#pragma unroll
        for (int j = 0; j < D / 256; ++j) xn[j] = *(const f32x4*)(rowsrc(gw) + j * 256 + lane * 4);
    }
    for (int r = gw; r < T_ALL; r += ngw) {
        const int v = r < T_CTX ? NB : (r - T_CTX) / S;
        f32x4 x[D / 256]; float ss = 0.f;
#pragma unroll
        for (int j = 0; j < D / 256; ++j) { x[j] = xn[j]; ss += x[j].x * x[j].x + x[j].y * x[j].y + x[j].z * x[j].z + x[j].w * x[j].w; }
        if (r + ngw < T_ALL) {
#pragma unroll
            for (int j = 0; j < D / 256; ++j) xn[j] = *(const f32x4*)(rowsrc(r + ngw) + j * 256 + lane * 4);
        }
        ss = wave_sum_fast(ss);
        const float rstd = frsq(ss * (1.0f / D) + 1e-6f);
#pragma unroll
        for (int j = 0; j < D / 256; ++j) {
            const int k = j * 256 + lane * 4;
            const f32x4 g = *(const f32x4*)(p.in[I_NMIX] + k), sh = *(const f32x4*)(mod + (size_t)v * 6 * D + k), sc = *(const f32x4*)(mod + (size_t)v * 6 * D + D + k);
            float o0 = x[j].x * rstd * g.x * (1.f + sc.x) + sh.x, o1 = x[j].y * rstd * g.y * (1.f + sc.y) + sh.y;
            float o2 = x[j].z * rstd * g.z * (1.f + sc.z) + sh.z, o3 = x[j].w * rstd * g.w * (1.f + sc.w) + sh.w;
            u32x2 o; o.x = pk2(o0, o1); o.y = pk2(o2, o3);
            *(u32x2*)(U + (size_t)r * D + k) = o;
        }
    }
}

DI void phase2(const Params& p, char* smem) {
    const bf16_t* U = (const bf16_t*)(p.aux + AUX_U); const bf16_t* WT = (const bf16_t*)(p.aux + AUX_WINT);
    bf16_t* PL = (bf16_t*)(p.ws + WS_PLAT); bf16_t* PC = (bf16_t*)(p.ws + WS_PCTX); float* AB = (float*)(p.ws + WS_AB);
    if (USE_G8) {
        constexpr int NT = NP / 256, MT = T_ALL / 256, NT_CTX = (CTX_COLS + 255) / 256;
        for (int t = blockIdx.x; t < MT * NT; t += gridDim.x) {
            int mt, nt; if (!g8::tile_order(t, MT, NT, mt, nt)) break;
            const int brow = mt * 256, bcol = nt * 256; const bool isctx = brow < T_CTX;
            if (isctx && nt >= NT_CTX) continue;
            g8::Acc acc; g8::acc_zero(acc);
            g8::kloop(acc, smem, U, D, WT, D, D, brow, bcol);
            g8::for_each_quad(acc, brow, bcol, [&](int row, int col, const f32x4& v) {
                u32x2 o; o.x = pk2(v.x, v.y); o.y = pk2(v.z, v.w);
                if (isctx) { if (col < CTX_COLS) *(u32x2*)(PC + (size_t)row * CTX_COLS + col) = o; }
                else { if (col < IN_COLS) *(u32x2*)(PL + (size_t)(row - T_CTX) * IN_COLS + col) = o; }
                if (col >= 2048 && col < 2064) *(f32x4*)(AB + (size_t)row * 16 + (col - 2048)) = v;
                halo_store(p, row, col, o);
            });
        }
        return;
    }
    const int tid = tid_x(), lane = tid & 63, wave = tid >> 6, wr = wave >> 1, wc = wave & 1, fr = lane & 15, fq = lane >> 4;
    constexpr int NT = NP / 128, MT = T_ALL / BM, NT_CTX = (CTX_COLS + 127) / 128;
    for (int t = blockIdx.x; t < MT * NT; t += gridDim.x) {
        const int mt = t / NT, nt = t % NT; const int row0 = mt * BM; const bool isctx = row0 < T_CTX;
        if (isctx && nt >= NT_CTX) continue;
        f32x4 acc[MREP][4]; acc_zero(acc);
        gemm_kloop(acc, smem, [&](int i) { return U + (size_t)(row0 + i) * D; }, WT + (size_t)nt * 128 * D, D, D);
#pragma unroll
        for (int m = 0; m < MREP; ++m)
#pragma unroll
            for (int n = 0; n < 4; ++n)
#pragma unroll
                for (int j = 0; j < 4; ++j) {
                    const int row = row0 + wr * 16 * MREP + m * 16 + fq * 4 + j, col = nt * 128 + wc * 64 + n * 16 + fr; const float v = acc[m][n][j];
                    if (isctx) { if (col < CTX_COLS) PC[(size_t)row * CTX_COLS + col] = f2bf(v); }
                    else { if (col < IN_COLS) PL[(size_t)(row - T_CTX) * IN_COLS + col] = f2bf(v); }
                    if (col >= 2048 && col < 2064) AB[(size_t)row * 16 + (col - 2048)] = v;
                }
    }
}


DI int crow(int g, int h) { return (g & 3) + 8 * (g >> 2) + 4 * h; }
template <int S_> DI bf16x8 pack_acc(const f32x16& x) {
    u32x4 r;
    r.x = pk2(x[8 * S_ + 0], x[8 * S_ + 1]); r.y = pk2(x[8 * S_ + 2], x[8 * S_ + 3]); r.z = pk2(x[8 * S_ + 4], x[8 * S_ + 5]); r.w = pk2(x[8 * S_ + 6], x[8 * S_ + 7]);
    return __builtin_bit_cast(bf16x8, r);
}
DI bf16x8 ld_nat(const bf16_t* row, int s, int h) { return *(const bf16x8*)(row + 16 * s + 8 * h); }
DI bf16x8 ld_perm(const bf16_t* row, int s, int h) {
    const bf16x4 lo = *(const bf16x4*)(row + 16 * s + 4 * h), hi = *(const bf16x4*)(row + 16 * s + 8 + 4 * h);
    return __builtin_shufflevector(lo, hi, 0, 1, 2, 3, 4, 5, 6, 7);
}
DI f32x16 zero16() { f32x16 z;
#pragma unroll
    for (int i = 0; i < 16; ++i) z[i] = 0.f;
    return z; }
#define TGET(i) ((i) < 16 ? t0[(i) & 15] : t1[(i) & 15])
DI void invert32_col(const float* Lf, f32x16& t0, f32x16& t1, int c) {
#pragma unroll
    for (int i = 0; i < 32; ++i) {
        float s0 = 0.f, s1 = 0.f, s2 = 0.f, s3 = 0.f;
#pragma unroll
        for (int j4 = 0; j4 < (i + 3) / 4; ++j4) {
            const f32x4 l = *(const f32x4*)(Lf + i * 32 + 4 * j4);
            if (4 * j4 + 0 < i) s0 += l.x * TGET(4 * j4 + 0);
            if (4 * j4 + 1 < i) s1 += l.y * TGET(4 * j4 + 1);
            if (4 * j4 + 2 < i) s2 += l.z * TGET(4 * j4 + 2);
            if (4 * j4 + 3 < i) s3 += l.w * TGET(4 * j4 + 3);
        }
        float sm = -((s0 + s1) + (s2 + s3));
#ifndef EMU
        asm volatile("" : "+v"(sm));
#endif
        const float v = (i > c) ? sm : (i == c ? 1.f : 0.f);
        if (i < 16) t0[i & 15] = v; else t1[i & 15] = v;
    }
}

DI void seg_info(int g, int& seq, int& b, int& j0) {
    if (g < NSEG_CTX) { seq = 0; b = g / (CTXL / 64); j0 = (g % (CTXL / 64)) * 64; } else { const int g2 = g - NSEG_CTX; seq = 1; b = g2 / (S / 64); j0 = (g2 % (S / 64)) * 64; }
}
DI const bf16_t* seq_row(const Params& p, int seq, int b, int j, bool scan_order) {
    if (seq) { const int l = scan_order ? (j % ROWS) * GW + j / ROWS : j; return (const bf16_t*)(p.ws + WS_PLAT) + (size_t)(b * S + l) * IN_COLS; }
    return (const bf16_t*)(p.ws + WS_PCTX) + (size_t)(b * CTXL + j) * CTX_COLS;
}
DI void phase_halo(const Params& p, char* smem) {
    if (USE_G8) return;
    const int tid = tid_x(), lane = tid & 63, wave = tid >> 6;
    const int gw = blockIdx.x * 8 + wave, ngw = gridDim.x * 8;
    bf16_t* HA = (bf16_t*)(p.ws + WS_HALO_A); bf16_t* HB = (bf16_t*)(p.ws + WS_HALO_B);
    for (int it = gw; it < NSEG * 6; it += ngw) {
        const int g = it / 6, hr = it % 6; int seq, b, j0; seg_info(g, seq, b, j0);
        const int L = seq ? S : CTXL;
        if (hr < 4) {
            const int j = hr < 2 ? j0 - 2 + hr : j0 + 62 + hr; const bool ok = j >= 0 && j < L;
            const bf16_t* src = seq_row(p, seq, b, ok ? j : 0, false);
            for (int c = lane; c < 192; c += 64) { u32x4 v = {0u, 0u, 0u, 0u}; if (ok) v = *(const u32x4*)(src + c * 8); *(u32x4*)(HA + ((size_t)g * 4 + hr) * 1536 + c * 8) = v; }
        } else {
            const int j = hr == 4 ? j0 - 1 : j0 + 64; const bool ok = j >= 0 && j < L;
            const bf16_t* src = seq_row(p, seq, b, ok ? j : 0, true) + COL_B0;
            for (int c = lane; c < 240; c += 64) { u32x4 v = {0u, 0u, 0u, 0u}; if (ok) v = *(const u32x4*)(src + c * 8); *(u32x4*)(HB + ((size_t)g * 2 + (hr - 4)) * 1920 + c * 8) = v; }
        }
    }
}
DI f32x2_ac unpk2(unsigned w) { return (f32x2_ac){bf2f((bf16_t)(w & 0xffffu)), bf2f((bf16_t)(w >> 16))}; }
DI void unpack8(const u32x4& q, float (&f)[8]) {
    f[0] = bf2f((bf16_t)(q.x & 0xffffu)); f[1] = bf2f((bf16_t)(q.x >> 16)); f[2] = bf2f((bf16_t)(q.y & 0xffffu)); f[3] = bf2f((bf16_t)(q.y >> 16));
    f[4] = bf2f((bf16_t)(q.z & 0xffffu)); f[5] = bf2f((bf16_t)(q.z >> 16)); f[6] = bf2f((bf16_t)(q.w & 0xffffu)); f[7] = bf2f((bf16_t)(q.w >> 16));
}
DI float row16_sum(float v) {
#ifdef EMU
    v += __shfl_xor(v, 1); v += __shfl_xor(v, 2); v += __shfl_xor(v, 4); v += __shfl_xor(v, 8); return v;
#else
    v = DPP_ADD(v, 0xB1); v = DPP_ADD(v, 0x4E); v = DPP_ADD(v, 0x141); v = DPP_ADD(v, 0x140); return v;
#endif
}
DI void phase_fir(const Params& p, char* smem) {
    const int tid = tid_x(), lane = tid & 63, wave = tid >> 6;
    const int gw = blockIdx.x * 8 + wave, ngw = gridDim.x * 8;
    const bf16_t* HA = (const bf16_t*)(p.ws + WS_HALO_A); const bf16_t* HB = (const bf16_t*)(p.ws + WS_HALO_B);
    constexpr int NA = NSEG * 3, NBI = NSEG * 4;
    const u32x4 z4 = {0u, 0u, 0u, 0u};
    for (int it = gw; it < NA + NBI; it += ngw) {
        if (it < NA) {
            const int g = it / 3, s = it % 3; int seq, b, j0; seg_info(g, seq, b, j0);
            const int col = s * 512 + 8 * lane, ldp = seq ? IN_COLS : CTX_COLS;
            bf16_t* base = (bf16_t*)seq_row(p, seq, b, j0, false) + col;
            const bf16_t* hal = HA + (size_t)g * 4 * 1536 + col;
            float cw[5][8];
#pragma unroll
            for (int t = 0; t < 5; ++t) { const f32x4 w0 = *(const f32x4*)(p.in[I_CONV] + t * 1536 + col), w1 = *(const f32x4*)(p.in[I_CONV] + t * 1536 + col + 4);
                cw[t][0] = w0.x; cw[t][1] = w0.y; cw[t][2] = w0.z; cw[t][3] = w0.w; cw[t][4] = w1.x; cw[t][5] = w1.y; cw[t][6] = w1.z; cw[t][7] = w1.w; }
            u32x4 win[12], nxt[8];
            win[0] = *(const u32x4*)(hal); win[1] = *(const u32x4*)(hal + 1536);
            win[2] = *(const u32x4*)(base); win[3] = *(const u32x4*)(base + ldp);
#pragma unroll
            for (int i = 0; i < 8; ++i) win[4 + i] = *(const u32x4*)(base + (size_t)(2 + i) * ldp);
#pragma unroll 1
            for (int blk = 0; blk < 8; ++blk) {
                if (blk < 7) {
#pragma unroll
                    for (int i = 0; i < 8; ++i) { const int t = 8 * blk + 10 + i; nxt[i] = t < 64 ? *(const u32x4*)(base + (size_t)t * ldp) : *(const u32x4*)(hal + (size_t)(2 + (t - 64)) * 1536); }
                }
#pragma unroll
                for (int i = 0; i < 8; ++i) {
                    float a[8];
#pragma unroll
                    for (int e = 0; e < 8; ++e) a[e] = 0.f;
#pragma unroll
                    for (int t = 0; t < 5; ++t) { float x[8]; unpack8(win[i + t], x);
#pragma unroll
                        for (int e = 0; e < 8; ++e) a[e] += x[e] * cw[t][e]; }
                    float ss = 0.f;
#pragma unroll
                    for (int e = 0; e < 8; ++e) { a[e] = fsilu(a[e]); ss += a[e] * a[e]; }
                    if (s < 2) { const float sc = frsq(row16_sum(ss) + 1e-6f) * (s == 0 ? 0.08838834764831845f : 1.0f);
#pragma unroll
                        for (int e = 0; e < 8; ++e) a[e] *= sc; }
                    u32x4 o; o.x = pk2(a[0], a[1]); o.y = pk2(a[2], a[3]); o.z = pk2(a[4], a[5]); o.w = pk2(a[6], a[7]);
                    *(u32x4*)(base + (size_t)(8 * blk + i) * ldp) = o;
                }
#pragma unroll
                for (int i = 0; i < 4; ++i) win[i] = win[8 + i];
#pragma unroll
                for (int i = 0; i < 8; ++i) win[4 + i] = nxt[i];
            }
        } else {
            const int it2 = it - NA, g = it2 / 4, sl = it2 % 4; int seq, b, j0; seg_info(g, seq, b, j0);
            const int bcol = sl * 512 + 8 * lane; const bool act = bcol < 1920;
            const int bc = act ? bcol : 0, col = COL_B0 + bc;
            float mu8[8];
            { const f32x4 m0 = *(const f32x4*)(p.in[I_MU] + bc), m1 = *(const f32x4*)(p.in[I_MU] + bc + 4); mu8[0] = m0.x; mu8[1] = m0.y; mu8[2] = m0.z; mu8[3] = m0.w; mu8[4] = m1.x; mu8[5] = m1.y; mu8[6] = m1.z; mu8[7] = m1.w; }
            const bool th = (bc >= 1536 && bc < 1664);
            const bf16_t* hal = HB + (size_t)g * 2 * 1920 + bc;
            u32x4 win[10], nxt[8];
            win[0] = *(const u32x4*)(hal); win[1] = *(const u32x4*)(seq_row(p, seq, b, j0, true) + col);
#pragma unroll
            for (int i = 0; i < 8; ++i) win[2 + i] = *(const u32x4*)(seq_row(p, seq, b, j0 + 1 + i, true) + col);
#pragma unroll 1
            for (int blk = 0; blk < 8; ++blk) {
                if (blk < 7) {
#pragma unroll
                    for (int i = 0; i < 8; ++i) { const int t = 8 * blk + 9 + i; nxt[i] = t < 64 ? *(const u32x4*)(seq_row(p, seq, b, j0 + t, true) + col) : *(const u32x4*)(hal + 1920); }
                }
#pragma unroll
                for (int i = 0; i < 8; ++i) {
                    float pv[8], cu[8], nx[8], x[8]; unpack8(win[i], pv); unpack8(win[i + 1], cu); unpack8(win[i + 2], nx);
#pragma unroll
                    for (int e = 0; e < 8; ++e) { x[e] = cu[e] + (0.5f * (pv[e] + nx[e]) - cu[e]) * mu8[e]; if (th) x[e] = ftanh(x[e]); }
                    u32x4 o; o.x = pk2(x[0], x[1]); o.y = pk2(x[2], x[3]); o.z = pk2(x[4], x[5]); o.w = pk2(x[6], x[7]);
                    if (act) *(u32x4*)((bf16_t*)seq_row(p, seq, b, j0 + 8 * blk + i, true) + col) = o;
                }
                win[0] = win[8]; win[1] = win[9];
#pragma unroll
                for (int i = 0; i < 8; ++i) win[2 + i] = nxt[i];
            }
        }
    }
}

constexpr int GC = 32;
constexpr int G_NT = (CTXL + S) / GC;
constexpr int LD128 = 136, LD64 = 72, LD32 = 40;
DI void chunk_pos(int x, int d, int& seg, int& j0) {
    constexpr int n0 = CTXL / GC, n1 = S / GC;
    if (x < n0) { seg = 0; j0 = (d ? n0 - 1 - x : x) * GC; } else { seg = 1; const int xx = x - n0; j0 = (d ? n1 - 1 - xx : xx) * GC; }
}

template <class Emit>
DI void invert32_blocked(const float* Lf, bf16_t* scr, int lane, Emit emit) {
    bf16_t* T00T = scr; bf16_t* T11R = scr + 16 * LD32; bf16_t* L10R = scr + 2 * 16 * LD32; bf16_t* P1T = scr + 3 * 16 * LD32;
    const int blk = lane >> 5, c = lane & 15, r = lane & 31, fr = lane & 15, fq = lane >> 4;
    f32x16 t;
    const float* Lb = Lf + (16 * blk) * 32 + 16 * blk;
#pragma unroll
    for (int i = 0; i < 16; ++i) {
        float s0 = 0.f, s1 = 0.f, s2 = 0.f, s3 = 0.f;
#pragma unroll
        for (int j4 = 0; j4 < (i + 3) / 4; ++j4) {
            const f32x4 l = *(const f32x4*)(Lb + i * 32 + 4 * j4);
            if (4 * j4 + 0 < i) s0 += l.x * t[4 * j4 + 0];
            if (4 * j4 + 1 < i) s1 += l.y * t[4 * j4 + 1];
            if (4 * j4 + 2 < i) s2 += l.z * t[4 * j4 + 2];
            if (4 * j4 + 3 < i) s3 += l.w * t[4 * j4 + 3];
        }
        float sm = -((s0 + s1) + (s2 + s3));
#ifndef EMU
        asm volatile("" : "+v"(sm));
#endif
        t[i] = (i > c) ? sm : (i == c ? 1.f : 0.f);
    }
    if (r < 16) {
        if (blk == 0) {
#pragma unroll
            for (int q = 0; q < 4; ++q) { u32x2 o; o.x = pk2(t[4 * q], t[4 * q + 1]); o.y = pk2(t[4 * q + 2], t[4 * q + 3]); *(u32x2*)(T00T + c * LD32 + 4 * q) = o; }
        } else {
#pragma unroll
            for (int i = 0; i < 16; ++i) T11R[i * LD32 + c] = f2bf(t[i]);
        }
    }
    { const int i = lane >> 2, j4 = (lane & 3) * 4; const f32x4 l = *(const f32x4*)(Lf + (16 + i) * 32 + j4);
      u32x2 o; o.x = pk2(l.x, l.y); o.y = pk2(l.z, l.w); *(u32x2*)(L10R + i * LD32 + j4) = o; }
    WAVE_SYNC();
    const bf16x8 zf = {0, 0, 0, 0, 0, 0, 0, 0};
    f32x4 p1 = {0.f, 0.f, 0.f, 0.f};
    {
        const bf16x8 af = fq < 2 ? *(const bf16x8*)(L10R + fr * LD32 + 8 * fq) : zf, bfm = fq < 2 ? *(const bf16x8*)(T00T + fr * LD32 + 8 * fq) : zf;
        p1 = MFMA16(af, bfm, p1);
    }
    { u32x2 o; o.x = pk2(p1[0], p1[1]); o.y = pk2(p1[2], p1[3]); *(u32x2*)(P1T + fr * LD32 + 4 * fq) = o; }
    WAVE_SYNC();
    f32x4 p2 = {0.f, 0.f, 0.f, 0.f};
    {
        const bf16x8 af = fq < 2 ? *(const bf16x8*)(T11R + fr * LD32 + 8 * fq) : zf, bfm = fq < 2 ? *(const bf16x8*)(P1T + fr * LD32 + 8 * fq) : zf;
        p2 = MFMA16(af, bfm, p2);
    }
#pragma unroll
    for (int j = 0; j < 4; ++j) emit(16 + 4 * fq + j, fr, -p2[j]);
    if (r < 16) {
#pragma unroll
        for (int i = 0; i < 16; ++i) { emit(16 * blk + i, 16 * blk + c, t[i]); if (blk == 0) emit(i, 16 + c, 0.f); }
    }
}
constexpr int GL_Q = 0;
constexpr int GL_KT = GL_Q + 2 * 32 * LD128 * 2;
constexpr int GL_VT = GL_KT + 2 * 128 * LD32 * 2;
constexpr int GL_K = GL_VT + 2 * 128 * LD32 * 2;
constexpr int GL_QKM = GL_K + 32 * LD128 * 2;
constexpr int GL_LF = GL_QKM + 2 * 32 * LD32 * 2;
constexpr int GL_TP = GL_LF + 32 * 32 * 4;
constexpr int GL_TPP = GL_TP + 32 * LD32 * 2;
constexpr int GL_WN = GL_TPP + 2 * 32 * LD32 * 2;
constexpr int GL_SC = GL_WN + 32 * LD128 * 2;
constexpr int GL_GC = GL_SC + 2 * 8 * 32 * 4;
constexpr int GL_CW = GL_GC + 8 * 32 * 4;
constexpr int GL_INV = GL_CW + 5 * 3 * 128 * 4;
constexpr int GL_RAW = GL_INV + 4 * 32 * LD32 * 2;
constexpr int GL_END = GL_RAW + 32 * 384 * 2;
static_assert(GL_END <= LDS_BYTES, "gdn lds");

DI void gdn_chain2(const Params& p, char* smem, int item) {
    const int d = item / (NB * H_A), b = (item / H_A) % NB, h = item % H_A;
    const int tid = tid_x(), lane = tid & 63, wave0_ = tid >> 6;
    bf16_t* Qs = (bf16_t*)(smem + GL_Q); bf16_t* KTs = (bf16_t*)(smem + GL_KT); bf16_t* VTs = (bf16_t*)(smem + GL_VT); bf16_t* Ks = (bf16_t*)(smem + GL_K);
    bf16_t* QKMs = (bf16_t*)(smem + GL_QKM); float* Lf = (float*)(smem + GL_LF); bf16_t* Tp = (bf16_t*)(smem + GL_TP); bf16_t* Tpp = (bf16_t*)(smem + GL_TPP);
    bf16_t* Wn = (bf16_t*)(smem + GL_WN); float* SC = (float*)(smem + GL_SC); float* GCs = (float*)(smem + GL_GC); float* CW = (float*)(smem + GL_CW);
    const float alog = p.in[I_ALOG][d * 4 + h], dtb = p.in[I_DTB][d * 4 + h], negea = -expf(alog);
    bf16_t* ODIR = (bf16_t*)(p.aux + AUX_ODIR);
    __syncthreads();
    f32x16 St[4];
#pragma unroll
    for (int ct = 0; ct < 4; ++ct) St[ct] = zero16();
    bf16_t* RAW = (bf16_t*)(smem + GL_RAW);
    float pa = 0.f, pbt = 0.f;
    auto prefetch = [&](int x, int wsel, int nw) {
        int seg, j0; chunk_pos(x, d, seg, j0);
        const int ldp = seg ? IN_COLS : CTX_COLS;
        const bf16_t* pbase = seg ? (const bf16_t*)(p.ws + WS_PLAT) + (size_t)b * S * IN_COLS : (const bf16_t*)(p.ws + WS_PCTX) + (size_t)b * CTXL * CTX_COLS;
        for (int inst = wsel; inst < 24; inst += nw) {
            const int q = inst * 64 + lane, row = q / 48, c16 = q % 48;
            const bf16_t* src = pbase + (size_t)(j0 + row) * ldp + (c16 >> 4) * 512 + h * 128 + (c16 & 15) * 8;
#ifdef EMU
            emu_global_load_lds16(src, (char*)RAW + q * 16);
#else
            __builtin_amdgcn_global_load_lds((const unsigned*)src, (__attribute__((address_space(3))) unsigned*)((char*)RAW + q * 16), 16, 0, 0);
#endif
        }
    };
    auto prefetch_ab = [&](int x) {
        int seg, j0; chunk_pos(x, d, seg, j0);
        const float* abbase = (const float*)(p.ws + WS_AB) + (size_t)(seg ? T_CTX + b * S : b * CTXL) * 16;
        const int jw = j0 + 4 * wave0_;
        if (lane < 4) { pa = abbase[(size_t)(jw + lane) * 16 + d * 4 + h]; pbt = abbase[(size_t)(jw + lane) * 16 + 8 + d * 4 + h]; }
    };
    prefetch(0, wave0_, 8); prefetch_ab(0);
#ifndef EMU
    asm volatile("s_waitcnt vmcnt(0)" ::: "memory");
#endif
    const int r0_ = lane & 31, hh0_ = lane >> 5;
    __syncthreads();
    for (int it = -1; it < G_NT; ++it) {
        int r = r0_, hh = hh0_, wave = wave0_;
#ifndef EMU
        asm volatile("" : "+v"(r), "+v"(hh), "+v"(wave));
#endif
        const int xn = it + 1, par = xn & 1;
        int segn = 0, j0n = 0; if (xn < G_NT) chunk_pos(xn, d, segn, j0n);
        if (xn < G_NT) {
            const int i0 = d ? (GC - 4 - 4 * wave) : 4 * wave;
            bf16_t kt[2][4], vt[2][4];
#pragma unroll
            for (int t = 0; t < 4; ++t) {
                const int e = d ? 3 - t : t, i = i0 + e;
                const unsigned wq = *(const unsigned*)(RAW + (4 * wave + t) * 384 + 2 * lane), wk = *(const unsigned*)(RAW + (4 * wave + t) * 384 + 128 + 2 * lane), wv = *(const unsigned*)(RAW + (4 * wave + t) * 384 + 256 + 2 * lane);
                *(unsigned*)(Qs + (par * 32 + i) * LD128 + 2 * lane) = wq;
                *(unsigned*)(Ks + i * LD128 + 2 * lane) = wk;
                kt[0][e] = (bf16_t)(wk & 0xffffu); kt[1][e] = (bf16_t)(wk >> 16); vt[0][e] = (bf16_t)(wv & 0xffffu); vt[1][e] = (bf16_t)(wv >> 16);
            }
#pragma unroll
            for (int q = 0; q < 2; ++q) {
                u32x2 o; o.x = (unsigned)kt[q][0] | ((unsigned)kt[q][1] << 16); o.y = (unsigned)kt[q][2] | ((unsigned)kt[q][3] << 16);
                *(u32x2*)(KTs + (par * 128 + 2 * lane + q) * LD32 + i0) = o;
                u32x2 o2; o2.x = (unsigned)vt[q][0] | ((unsigned)vt[q][1] << 16); o2.y = (unsigned)vt[q][2] | ((unsigned)vt[q][3] << 16);
                *(u32x2*)(VTs + (par * 128 + 2 * lane + q) * LD32 + i0) = o2;
            }
            if (lane < 4) { const int i = d ? (GC - 1 - 4 * wave - lane) : (4 * wave + lane);
                SC[(par * 8 + 0) * 32 + i] = negea * fsoftplus(pa + dtb); SC[(par * 8 + 1) * 32 + i] = fsigmoid(pbt); }
            if (xn + 1 < G_NT) prefetch_ab(xn + 1);
        }
        LDS_BARRIER();
        if (wave >= 4 && wave < 7 && xn + 1 < G_NT) {
            prefetch(xn + 1, wave - 4, 3);
#ifndef EMU
            asm volatile("s_waitcnt vmcnt(0)" ::: "memory");
#endif
        }
        if (xn < G_NT) {
            const float* graw = SC + (par * 8 + 0) * 32;
            float gcv = 0.f;
#pragma unroll
            for (int s4 = 0; s4 < 8; ++s4) { const f32x4 g4 = *(const f32x4*)(graw + 4 * s4);
                gcv += (4 * s4 + 0 <= r ? g4.x : 0.f) + (4 * s4 + 1 <= r ? g4.y : 0.f) + (4 * s4 + 2 <= r ? g4.z : 0.f) + (4 * s4 + 3 <= r ? g4.w : 0.f); }
            if (lane < 32) GCs[wave * 32 + r] = gcv;
            if (wave == 7 && lane < 32) {
                float gl = 0.f;
#pragma unroll
                for (int s4 = 0; s4 < 8; ++s4) { const f32x4 g4 = *(const f32x4*)(graw + 4 * s4); gl += (g4.x + g4.y) + (g4.z + g4.w); }
                const float be = SC[(par * 8 + 1) * 32 + r];
                SC[(par * 8 + 3) * 32 + r] = fexp(gcv); SC[(par * 8 + 4) * 32 + r] = fexp(gl - gcv); SC[(par * 8 + 5) * 32 + r] = be * fexp(gcv); SC[(par * 8 + 6) * 32 + r] = fexp(gl);
            }
            const int pr = wave >> 2, th = (wave >> 1) & 1, ch = wave & 1, fr = lane & 15, fq = lane >> 4;
            const bf16_t* arow = (pr == 0 ? Ks : Qs + par * 32 * LD128) + (16 * th + fr) * LD128 + 8 * fq; const bf16_t* brow = Ks + (16 * ch + fr) * LD128 + 8 * fq;
            f32x4 cc = {0.f, 0.f, 0.f, 0.f};
#pragma unroll
            for (int ks = 0; ks < 4; ++ks) cc = MFMA16(*(const bf16x8*)(arow + 32 * ks), *(const bf16x8*)(brow + 32 * ks), cc);
            WAVE_SYNC();
            const int jj = 16 * ch + fr; const float gj = GCs[wave * 32 + jj];
#pragma unroll
            for (int j = 0; j < 4; ++j) {
                const int i = 16 * th + 4 * fq + j; const float dec = fexp(GCs[wave * 32 + i] - gj);
                if (pr == 0) Lf[i * 32 + jj] = (jj < i) ? SC[(par * 8 + 1) * 32 + i] * cc[j] * dec : 0.f;
                else QKMs[(par * 32 + i) * LD32 + jj] = f2bf((jj <= i) ? cc[j] * dec : 0.f);
            }
        }
        LDS_BARRIER();
        if (wave == 7 && xn < G_NT) {
            const float* sb1 = SC + (par * 8 + 5) * 32; const float* sb0 = SC + (par * 8 + 1) * 32; bf16_t* Tppw = Tpp + par * 32 * LD32;
            invert32_blocked(Lf, (bf16_t*)(smem + GL_INV), lane, [&](int i, int c, float v) { Tp[i * LD32 + c] = f2bf(v * sb1[c]); Tppw[i * LD32 + c] = f2bf(v * sb0[c]); });
        }
        if (wave < 4 && it >= 0) {
            const int pc = it & 1; int seg = 0, j0 = 0; chunk_pos(it, d, seg, j0);
            const bf16_t* Qc = Qs + pc * 32 * LD128; const bf16_t* KTc = KTs + pc * 128 * LD32; const bf16_t* VTc = VTs + pc * 128 * LD32;
            const bf16_t* QKc = QKMs + pc * 32 * LD32; const bf16_t* Tc = Tpp + pc * 32 * LD32; const float* sc = SC + pc * 8 * 32;
            f32x16 vn = zero16();
#pragma unroll
            for (int s = 0; s < 2; ++s) vn = MFMA32(ld_nat(Tc + r * LD32, s, hh), ld_nat(VTc + (32 * wave + r) * LD32, s, hh), vn);
            f32x16 oacc = zero16();
#define GDN_KSTEP(s) { const bf16x8 sb = pack_acc<(s) & 1>(St[(s) >> 1]); vn = MFMA32(ld_perm(Wn + r * LD128, (s), hh), sb, vn); oacc = MFMA32(ld_perm(Qc + r * LD128, (s), hh), sb, oacc); }
            GDN_KSTEP(0) GDN_KSTEP(1) GDN_KSTEP(2) GDN_KSTEP(3) GDN_KSTEP(4) GDN_KSTEP(5) GDN_KSTEP(6) GDN_KSTEP(7)
#undef GDN_KSTEP
#pragma unroll
            for (int g = 0; g < 16; ++g) oacc[g] *= sc[3 * 32 + crow(g, hh)];
            { const bf16x8 v0 = pack_acc<0>(vn), v1 = pack_acc<1>(vn);
              oacc = MFMA32(ld_perm(QKc + r * LD32, 0, hh), v0, oacc); oacc = MFMA32(ld_perm(QKc + r * LD32, 1, hh), v1, oacc); }
#pragma unroll
            for (int g = 0; g < 16; ++g) vn[g] *= sc[4 * 32 + crow(g, hh)];
            const float ge = sc[6 * 32];
            { const bf16x8 v0 = pack_acc<0>(vn), v1 = pack_acc<1>(vn);
#pragma unroll
              for (int ct = 0; ct < 4; ++ct) {
#pragma unroll
                  for (int g = 0; g < 16; ++g) St[ct][g] *= ge;
                  St[ct] = MFMA32(ld_perm(KTc + (32 * ct + r) * LD32, 0, hh), v0, St[ct]);
                  St[ct] = MFMA32(ld_perm(KTc + (32 * ct + r) * LD32, 1, hh), v1, St[ct]);
              } }
            if (seg) {
#pragma unroll
                for (int g = 0; g < 16; ++g) {
                    const int i = crow(g, hh), j = d ? j0 + GC - 1 - i : j0 + i;
                    ODIR[((size_t)d * T_LAT + (size_t)b * S + j) * 512 + h * 128 + 32 * wave + r] = f2bf(oacc[g]);
                }
            }
        }
        LDS_BARRIER();
        if (xn < G_NT && wave < 4) {
            f32x16 acc = zero16();
#pragma unroll
            for (int s = 0; s < 2; ++s) acc = MFMA32(ld_nat(KTs + (par * 128 + 32 * wave + r) * LD32, s, hh), ld_nat(Tp + r * LD32, s, hh), acc);
#pragma unroll
            for (int q = 0; q < 4; ++q) {
                u32x2 o; o.x = pk2(-acc[4 * q], -acc[4 * q + 1]); o.y = pk2(-acc[4 * q + 2], -acc[4 * q + 3]);
                *(u32x2*)(Wn + r * LD128 + 32 * wave + 8 * q + 4 * hh) = o;
            }
        }
        LDS_BARRIER();
    }
}

constexpr int RL_RX = 0;
constexpr int RL_KX = RL_RX + 32 * 64 * 4;
constexpr int RL_VX = RL_KX + 32 * 64 * 4;
constexpr int RL_KK = RL_VX + 32 * 64 * 4;
constexpr int RL_LW = RL_KK + 32 * 64 * 4;
constexpr int RL_IC = RL_LW + 32 * 64 * 4;
constexpr int RL_PC = RL_IC + 32 * 64 * 4;
constexpr int RL_CST = RL_PC + 2 * 64 * 4;
constexpr int RL_TW = RL_CST + 4 * 64 * 4;
constexpr int RL_AL = RL_TW + 32 * LD64 * 2;
constexpr int RL_LF = RL_TW;
constexpr int RL_LAKT = RL_LF + 32 * 32 * 4;
constexpr int RL_TB = RL_LAKT + 32 * LD32 * 2;
static_assert(RL_TB + 32 * LD32 * 2 <= RL_AL + 32 * LD64 * 2, "overlay");
constexpr int RL_W2T = RL_AL + 32 * LD64 * 2;
constexpr int RL_A2T = RL_W2T + 64 * LD64 * 2;
constexpr int RL_AR = RL_A2T + 64 * LD64 * 2;
constexpr int RL_BR = RL_AR + 32 * LD64 * 2;
constexpr int RL_KR = RL_BR + 32 * LD64 * 2;
constexpr int RL_RR = RL_KR + 32 * LD64 * 2;
constexpr int RL_AT = RL_RR + 2 * 32 * LD64 * 2;
constexpr int RL_BHT = RL_AT + 64 * LD32 * 2;
constexpr int RL_KHT = RL_BHT + 2 * 64 * LD32 * 2;
constexpr int RL_VT = RL_KHT + 2 * 64 * LD32 * 2;
constexpr int RL_MRB = RL_VT + 2 * 64 * LD32 * 2;
constexpr int RL_MRK = RL_MRB + 2 * 32 * LD32 * 2;
constexpr int RL_WM = RL_MRK + 2 * 32 * LD32 * 2;
constexpr int RL_TL = RL_WM + 32 * LD64 * 2;
constexpr int RL_END = RL_TL + 32 * LD32 * 2;
static_assert(RL_END <= LDS_BYTES, "rwkv lds");

DI void rwkv_chain2(const Params& p, char* smem, int item) {
    const int d = item / (NB * H_B), b = (item / H_B) % NB, h = item % H_B;
    const int tid = tid_x(), lane = tid & 63, wave = tid >> 6;
    float* RX = (float*)(smem + RL_RX); float* KX = (float*)(smem + RL_KX); float* VX = (float*)(smem + RL_VX); float* KKs = (float*)(smem + RL_KK);
    float* LW = (float*)(smem + RL_LW); float* IC = (float*)(smem + RL_IC); float* Lf = (float*)(smem + RL_LF); float* PC = (float*)(smem + RL_PC); float* CST = (float*)(smem + RL_CST);
    bf16_t* TW = (bf16_t*)(smem + RL_TW); bf16_t* AL = (bf16_t*)(smem + RL_AL); bf16_t* W2T = (bf16_t*)(smem + RL_W2T); bf16_t* A2T = (bf16_t*)(smem + RL_A2T);
    bf16_t* Ar = (bf16_t*)(smem + RL_AR); bf16_t* Br = (bf16_t*)(smem + RL_BR); bf16_t* Kr = (bf16_t*)(smem + RL_KR); bf16_t* Rr = (bf16_t*)(smem + RL_RR);
    bf16_t* AT = (bf16_t*)(smem + RL_AT); bf16_t* BhT = (bf16_t*)(smem + RL_BHT); bf16_t* KhT = (bf16_t*)(smem + RL_KHT); bf16_t* VT = (bf16_t*)(smem + RL_VT);
    bf16_t* LakT = (bf16_t*)(smem + RL_LAKT); bf16_t* Mrb = (bf16_t*)(smem + RL_MRB); bf16_t* Mrk = (bf16_t*)(smem + RL_MRK); bf16_t* Tb = (bf16_t*)(smem + RL_TB);
    bf16_t* Wm = (bf16_t*)(smem + RL_WM); bf16_t* TLm = (bf16_t*)(smem + RL_TL);
    bf16_t* YDIR = (bf16_t*)(p.aux + AUX_YDIR); float* BON = (float*)(p.ws + WS_BONUS);
    __syncthreads();
    for (int i = tid; i < 64 * 64; i += NTHREADS) {
        const int c = i >> 6, rr = i & 63;
        W2T[c * LD64 + rr] = f2bf(p.in[I_W2][((size_t)d * 64 + rr) * 512 + h * 64 + c]); A2T[c * LD64 + rr] = f2bf(p.in[I_A2][((size_t)d * 64 + rr) * 512 + h * 64 + c]);
    }
    if (tid < 256) { const int w = tid >> 6, c = tid & 63, gc = h * 64 + c;
        CST[tid] = w == 0 ? p.in[I_W0][d * 512 + gc] : (w == 1 ? p.in[I_A0][d * 512 + gc] : (w == 2 ? p.in[I_KA][gc] : p.in[I_RK][gc])); }
    const float kkw = p.in[I_KK][h * 64 + lane];
    f32x16 Xt[2]; Xt[0] = zero16(); Xt[1] = zero16();
    bf16_t rawv[4][5];
    auto prefetch = [&](int x) {
        int seg, j0; chunk_pos(x, d, seg, j0);
        const int ldp = seg ? IN_COLS : CTX_COLS;
        const bf16_t* pb = seg ? (const bf16_t*)(p.ws + WS_PLAT) + (size_t)b * S * IN_COLS : (const bf16_t*)(p.ws + WS_PCTX) + (size_t)b * CTXL * CTX_COLS;
        const int jw = j0 + 4 * wave;
#pragma unroll
        for (int rr = 0; rr < 4; ++rr) {
            const int j = jw + rr; const int row = seg ? (j % ROWS) * GW + j / ROWS : j;
#pragma unroll
            for (int s = 0; s < 5; ++s) {
                const int bcol = (s < 3 ? s * 512 + h * 64 : (s == 3 ? 1536 + d * 64 : 1664 + d * 64)) + lane;
                rawv[rr][s] = pb[(size_t)row * ldp + COL_B0 + bcol];
            }
        }
    };
    prefetch(0);
    const int r0_ = lane & 31, hh0_ = lane >> 5;
    __syncthreads();
    for (int it = -1; it < G_NT; ++it) {
        int r = r0_, hh = hh0_;
#ifndef EMU
        asm volatile("" : "+v"(r), "+v"(hh));
#endif
        const int xn = it + 1, par = xn & 1;
        int segn = 0, j0n = 0; if (xn < G_NT) chunk_pos(xn, d, segn, j0n);
        if (xn < G_NT) {
#pragma unroll
            for (int t = 0; t < 4; ++t) {
                const int i = d ? (GC - 1 - 4 * wave - t) : (4 * wave + t);
                const float xr = bf2f(rawv[t][0]), xk = bf2f(rawv[t][1]), xv = bf2f(rawv[t][2]);
                const float kxk = xk * kkw; const float ss = wave_sum_fast(kxk * kxk);
                RX[i * 64 + lane] = xr; KX[i * 64 + lane] = xk; VX[i * 64 + lane] = xv; KKs[i * 64 + lane] = kxk * frsq(ss + 1e-6f);
                TW[i * LD64 + lane] = rawv[t][3]; AL[i * LD64 + lane] = rawv[t][4];
            }
            if (xn + 1 < G_NT) prefetch(xn + 1);
        }
        LDS_BARRIER();
        if (xn < G_NT) {
            const int which = wave >> 2, cg = wave & 3, fr = lane & 15, fq = lane >> 4;
            const bf16_t* arow0 = (which ? AL : TW) + fr * LD64 + 8 * fq; const bf16_t* brow = (which ? A2T : W2T) + (16 * cg + fr) * LD64 + 8 * fq;
            f32x4 c0 = {0.f, 0.f, 0.f, 0.f}, c1 = {0.f, 0.f, 0.f, 0.f};
#pragma unroll
            for (int ks = 0; ks < 2; ++ks) {
                const bf16x8 bfrag = *(const bf16x8*)(brow + 32 * ks);
                c0 = MFMA16(*(const bf16x8*)(arow0 + 32 * ks), bfrag, c0); c1 = MFMA16(*(const bf16x8*)(arow0 + 16 * LD64 + 32 * ks), bfrag, c1);
            }
            const int c = 16 * cg + fr; const float bias = CST[which * 64 + c];
#pragma unroll
            for (int th = 0; th < 2; ++th)
#pragma unroll
                for (int j = 0; j < 4; ++j) {
                    const int i = 16 * th + 4 * fq + j; const float z = bias + (th ? c1[j] : c0[j]);
                    if (which) IC[i * 64 + c] = fsigmoid(z);
                    else { const float wl = -fsoftplus(-z) - 0.5f; LW[i * 64 + c] = -fexp(wl); }
                }
        }
        LDS_BARRIER();
        if (xn < G_NT) {
            const int c = lane, i0 = 4 * wave;
            const float ka = CST[2 * 64 + c], rk = CST[3 * 64 + c];
            float lpb = 0.f, lpc = 0.f; float lw4[4];
#pragma unroll
            for (int s2 = 0; s2 < 32; ++s2) { const float w = LW[s2 * 64 + c]; lpc += w; if (s2 < i0) lpb += w; }
#pragma unroll
            for (int e = 0; e < 4; ++e) lw4[e] = LW[(i0 + e) * 64 + c];
            bf16_t ta[4], tb[4], tk[4], tv[4]; float bon[4];
            float lprun = lpb;
#pragma unroll
            for (int e = 0; e < 4; ++e) {
                const int i = i0 + e;
                const float lpm = lprun; lprun += lw4[e]; const float lp = lprun;
                const float Pi = fexp(lp), Pm = fexp(lpm), invP = fexp(-lp), PCi = fexp(lpc - lp);
                const float ic = IC[i * 64 + c], kxv = KX[i * 64 + c], kkv = KKs[i * 64 + c], rxv = RX[i * 64 + c], vxv = VX[i * 64 + c];
                const float kd = kxv * (1.f + (ic - 1.f) * ka), bb = kkv * ic, aa = -kkv;
                ta[e] = f2bf(aa * Pm); tb[e] = f2bf(bb * PCi); tk[e] = f2bf(kd * PCi); tv[e] = f2bf(vxv);
                Ar[i * LD64 + c] = ta[e]; Br[i * LD64 + c] = f2bf(bb * invP); Kr[i * LD64 + c] = f2bf(kd * invP); Rr[(par * 32 + i) * LD64 + c] = f2bf(rxv * Pi);
                bon[e] = wave_sum_fast(rxv * kd * rk);
            }
            { u32x2 o; o.x = (unsigned)ta[0] | ((unsigned)ta[1] << 16); o.y = (unsigned)ta[2] | ((unsigned)ta[3] << 16); *(u32x2*)(AT + c * LD32 + i0) = o; }
            { u32x2 o; o.x = (unsigned)tb[0] | ((unsigned)tb[1] << 16); o.y = (unsigned)tb[2] | ((unsigned)tb[3] << 16); *(u32x2*)(BhT + (par * 64 + c) * LD32 + i0) = o; }
            { u32x2 o; o.x = (unsigned)tk[0] | ((unsigned)tk[1] << 16); o.y = (unsigned)tk[2] | ((unsigned)tk[3] << 16); *(u32x2*)(KhT + (par * 64 + c) * LD32 + i0) = o; }
            { u32x2 o; o.x = (unsigned)tv[0] | ((unsigned)tv[1] << 16); o.y = (unsigned)tv[2] | ((unsigned)tv[3] << 16); *(u32x2*)(VT + (par * 64 + c) * LD32 + i0) = o; }
            if (wave == 7) PC[par * 64 + c] = fexp(lpc);
            if (segn && lane < 4) { const int i = i0 + lane, jj = d ? j0n + GC - 1 - i : j0n + i;
                const float bv = lane == 0 ? bon[0] : (lane == 1 ? bon[1] : (lane == 2 ? bon[2] : bon[3]));
                BON[((size_t)d * T_LAT + (size_t)b * S + (jj % ROWS) * GW + jj / ROWS) * 8 + h] = bv; }
        }
        LDS_BARRIER();
        if (xn < G_NT) {
            const int m = wave >> 1, th = wave & 1, fr = lane & 15, fq = lane >> 4;
            const bf16_t* arow = ((m < 2) ? Ar : Rr + par * 32 * LD64) + (16 * th + fr) * LD64 + 8 * fq; const bf16_t* brow = ((m & 1) ? Kr : Br) + fr * LD64 + 8 * fq;
            f32x4 c0 = {0.f, 0.f, 0.f, 0.f}, c1 = {0.f, 0.f, 0.f, 0.f};
#pragma unroll
            for (int ks = 0; ks < 2; ++ks) {
                const bf16x8 afrag = *(const bf16x8*)(arow + 32 * ks);
                c0 = MFMA16(afrag, *(const bf16x8*)(brow + 32 * ks), c0); c1 = MFMA16(afrag, *(const bf16x8*)(brow + 16 * LD64 + 32 * ks), c1);
            }
#pragma unroll
            for (int ch = 0; ch < 2; ++ch) {
                const f32x4 cc = ch ? c1 : c0; const int ic = 16 * ch + fr; const int t0 = 16 * th + 4 * fq;
                if (m == 0) {
#pragma unroll
                    for (int j = 0; j < 4; ++j) Lf[(t0 + j) * 32 + ic] = (ic < t0 + j) ? -cc[j] : 0.f;
                } else if (m == 1) {
                    u32x2 o; o.x = pk2((ic < t0) ? cc[0] : 0.f, (ic < t0 + 1) ? cc[1] : 0.f); o.y = pk2((ic < t0 + 2) ? cc[2] : 0.f, (ic < t0 + 3) ? cc[3] : 0.f);
                    *(u32x2*)(LakT + ic * LD32 + t0) = o;
                } else {
                    bf16_t* M = (m == 2 ? Mrb : Mrk) + par * 32 * LD32;
#pragma unroll
                    for (int j = 0; j < 4; ++j) M[(t0 + j) * LD32 + ic] = f2bf((ic <= t0 + j) ? cc[j] : 0.f);
                }
            }
        }
        LDS_BARRIER();
        if (wave == 7 && xn < G_NT) {
            invert32_blocked(Lf, (bf16_t*)(smem + RL_RX), lane, [&](int i, int c, float v) { Tb[i * LD32 + c] = f2bf(v); });
        }
        if (wave < 2 && it >= 0) {
            const int pc = it & 1; int seg = 0, j0 = 0; chunk_pos(it, d, seg, j0);
            const bf16_t* Rc = Rr + pc * 32 * LD64; const bf16_t* BhTc = BhT + pc * 64 * LD32; const bf16_t* KhTc = KhT + pc * 64 * LD32; const bf16_t* VTc = VT + (pc * 64 + 32 * wave + r) * LD32;
            const bf16_t* Mrbc = Mrb + pc * 32 * LD32; const bf16_t* Mrkc = Mrk + pc * 32 * LD32; const float* PCc = PC + pc * 64;
            const bf16x8 vf0 = ld_nat(VTc, 0, hh), vf1 = ld_nat(VTc, 1, hh);
            f32x16 u = zero16(), y = zero16();
            u = MFMA32(ld_nat(TLm + r * LD32, 0, hh), vf0, u); u = MFMA32(ld_nat(TLm + r * LD32, 1, hh), vf1, u);
            y = MFMA32(ld_nat(Mrkc + r * LD32, 0, hh), vf0, y); y = MFMA32(ld_nat(Mrkc + r * LD32, 1, hh), vf1, y);
#define RW_KSTEP(s) { const bf16x8 xb = pack_acc<(s) & 1>(Xt[(s) >> 1]); u = MFMA32(ld_perm(Wm + r * LD64, (s), hh), xb, u); y = MFMA32(ld_perm(Rc + r * LD64, (s), hh), xb, y); }
            RW_KSTEP(0) RW_KSTEP(1) RW_KSTEP(2) RW_KSTEP(3)
#undef RW_KSTEP
            const bf16x8 ub0 = pack_acc<0>(u), ub1 = pack_acc<1>(u);
            y = MFMA32(ld_perm(Mrbc + r * LD32, 0, hh), ub0, y); y = MFMA32(ld_perm(Mrbc + r * LD32, 1, hh), ub1, y);
#pragma unroll
            for (int kt = 0; kt < 2; ++kt) {
#pragma unroll
                for (int g = 0; g < 16; ++g) Xt[kt][g] *= PCc[32 * kt + crow(g, hh)];
                Xt[kt] = MFMA32(ld_perm(BhTc + (32 * kt + r) * LD32, 0, hh), ub0, Xt[kt]); Xt[kt] = MFMA32(ld_perm(BhTc + (32 * kt + r) * LD32, 1, hh), ub1, Xt[kt]);
                Xt[kt] = MFMA32(ld_nat(KhTc + (32 * kt + r) * LD32, 0, hh), vf0, Xt[kt]); Xt[kt] = MFMA32(ld_nat(KhTc + (32 * kt + r) * LD32, 1, hh), vf1, Xt[kt]);
            }
            if (seg) {
#pragma unroll
                for (int g = 0; g < 16; ++g) {
                    const int i = crow(g, hh), jj = d ? j0 + GC - 1 - i : j0 + i;
                    YDIR[((size_t)d * T_LAT + (size_t)b * S + (jj % ROWS) * GW + jj / ROWS) * 512 + h * 64 + 32 * wave + r] = f2bf(y[g]);
                }
            }
        }
        LDS_BARRIER();
        if (xn < G_NT && wave < 3) {
            const bf16_t* arow = (wave < 2) ? AT + (32 * wave + r) * LD32 : LakT + r * LD32;
            f32x16 acc = zero16();
#pragma unroll
            for (int s = 0; s < 2; ++s) acc = MFMA32(ld_nat(arow, s, hh), ld_nat(Tb + r * LD32, s, hh), acc);
#pragma unroll
            for (int q = 0; q < 4; ++q) {
                u32x2 o; o.x = pk2(acc[4 * q], acc[4 * q + 1]); o.y = pk2(acc[4 * q + 2], acc[4 * q + 3]);
                if (wave < 2) *(u32x2*)(Wm + r * LD64 + 32 * wave + 8 * q + 4 * hh) = o; else *(u32x2*)(TLm + r * LD32 + 8 * q + 4 * hh) = o;
            }
        }
        LDS_BARRIER();
    }
}

DI void phase3(const Params& p, char* smem) {
    constexpr int NG = 2 * NB * H_A, NR = 2 * NB * H_B;
    for (int it = blockIdx.x; it < NG; it += gridDim.x) gdn_chain2(p, smem, it);
    for (int it = blockIdx.x; it < NG + NR; it += gridDim.x) if (it >= NG) rwkv_chain2(p, smem, it - NG);
}

constexpr int P4_SG = 0;
constexpr int P4_XV = P4_SG + 32 * LD128 * 2;
constexpr int P4_YF = P4_XV + 32 * 520 * 2;
static_assert(P4_YF + 32 * 516 * 4 <= LDS_BYTES, "phase4 lds");
DI float half_sum(float v, int hh) {
#ifdef EMU
    v += __shfl_xor(v, 1); v += __shfl_xor(v, 2); v += __shfl_xor(v, 4); v += __shfl_xor(v, 8); v += __shfl_xor(v, 16); return v;
#else
    v = DPP_ADD(v, 0xB1); v = DPP_ADD(v, 0x4E); v = DPP_ADD(v, 0x141); v = DPP_ADD(v, 0x140);
    const int iv = __builtin_bit_cast(int, v);
    const float s0 = __builtin_bit_cast(float, __builtin_amdgcn_readlane(iv, 0)) + __builtin_bit_cast(float, __builtin_amdgcn_readlane(iv, 16));
    const float s1 = __builtin_bit_cast(float, __builtin_amdgcn_readlane(iv, 32)) + __builtin_bit_cast(float, __builtin_amdgcn_readlane(iv, 48));
    return hh ? s1 : s0;
#endif
}
DI void phase4(const Params& p, char* smem) {
    const int tid = tid_x(), lane = tid & 63, wave = tid >> 6, r = lane & 31, hh = lane >> 5;
    const bf16_t* PL = (const bf16_t*)(p.ws + WS_PLAT);
    const bf16_t* ODIR = (const bf16_t*)(p.aux + AUX_ODIR); const bf16_t* YDIR = (const bf16_t*)(p.aux + AUX_YDIR);
    const float* BON = (const float*)(p.ws + WS_BONUS); const float* mu = p.in[I_MU]; const bf16_t* G2T = (const bf16_t*)(p.ws + WS_G2T);
    bf16_t* OA = (bf16_t*)(p.ws + WS_OA); bf16_t* OB = (bf16_t*)(p.ws + WS_OB);
    bf16_t* SG = (bf16_t*)(smem + P4_SG); bf16_t* XV = (bf16_t*)(smem + P4_XV); float* YF = (float*)(smem + P4_YF);
    for (int it = blockIdx.x; it < T_LAT / 32; it += gridDim.x) {
        const int tok0 = it * 32, b = tok0 / S, l0 = tok0 % S;
        __syncthreads();
        for (int q = tid; q < 32 * 80; q += NTHREADS) {
            const int t = q / 80, c8 = q % 80;
            const int l = l0 + t;
            const int bcol = c8 < 16 ? 1792 + c8 * 8 : 1024 + (c8 - 16) * 8;
            float cu[8], o[8];
            unpack8(*(const u32x4*)(PL + (size_t)(b * S + l) * IN_COLS + COL_B0 + bcol), cu);
#pragma unroll
            for (int e = 0; e < 8; ++e) o[e] = c8 < 16 ? fsigmoid(cu[e]) : cu[e];
            u32x4 w; w.x = pk2(o[0], o[1]); w.y = pk2(o[2], o[3]); w.z = pk2(o[4], o[5]); w.w = pk2(o[6], o[7]);
            if (c8 < 16) *(u32x4*)(SG + t * LD128 + c8 * 8) = w; else *(u32x4*)(XV + t * 520 + (c8 - 16) * 8) = w;
        }
        for (int q = tid; q < 32 * 64; q += NTHREADS) {
            const int t = q >> 6, c8 = q & 63, tok = tok0 + t;
            float a0[8], a1[8];
            unpack8(*(const u32x4*)(YDIR + (size_t)tok * 512 + c8 * 8), a0); unpack8(*(const u32x4*)(YDIR + ((size_t)T_LAT + tok) * 512 + c8 * 8), a1);
            f32x4 s0 = {a0[0] + a1[0], a0[1] + a1[1], a0[2] + a1[2], a0[3] + a1[3]}, s1 = {a0[4] + a1[4], a0[5] + a1[5], a0[6] + a1[6], a0[7] + a1[7]};
            *(f32x4*)(YF + t * 516 + c8 * 8) = s0; *(f32x4*)(YF + t * 516 + c8 * 8 + 4) = s1;
        }
        __syncthreads();
        {
            const int h = wave;
            f32x16 acc0 = zero16(), acc1 = zero16();
#pragma unroll
            for (int s2 = 0; s2 < 8; ++s2) {
                const bf16x8 a = ld_nat(SG + r * LD128, s2, hh);
                const bf16x8 b0 = *(const bf16x8*)(G2T + (size_t)(64 * h + r) * 128 + 16 * s2 + 8 * hh), b1 = *(const bf16x8*)(G2T + (size_t)(64 * h + 32 + r) * 128 + 16 * s2 + 8 * hh);
                acc0 = MFMA32(a, b0, acc0); acc1 = MFMA32(a, b1, acc1);
            }
            const int c0 = 64 * h + r, c1 = c0 + 32;
            const float lg0 = p.in[I_LNG][c0], lb0 = p.in[I_LNB][c0], lg1 = p.in[I_LNG][c1], lb1 = p.in[I_LNB][c1];
#pragma unroll
            for (int g = 0; g < 16; ++g) {
                const int i = crow(g, hh), tok = tok0 + i;
                const float y0 = YF[i * 516 + c0], y1 = YF[i * 516 + c1];
                const float mean = half_sum(y0 + y1, hh) * (1.f / 64.f); const float d0 = y0 - mean, d1 = y1 - mean;
                const float var = half_sum(d0 * d0 + d1 * d1, hh) * (1.f / 64.f); const float rs = frsq(var + 64e-5f);
                const float bon = BON[(size_t)tok * 8 + h] + BON[((size_t)T_LAT + tok) * 8 + h];
                const float o0 = (d0 * rs * lg0 + lb0 + bon * bf2f(XV[i * 520 + c0])) * acc0[g], o1 = (d1 * rs * lg1 + lb1 + bon * bf2f(XV[i * 520 + c1])) * acc1[g];
                OB[(size_t)tok * 512 + c0] = f2bf(o0); OB[(size_t)tok * 512 + c1] = f2bf(o1);
            }
        }
        for (int pi = wave * 16; pi < wave * 16 + 16; ++pi) {
            const int t = pi >> 2, h = pi & 3, tok = tok0 + t;
            const size_t o0 = (size_t)tok * 512 + h * 128 + 2 * lane;
            const unsigned q0 = *(const unsigned*)(ODIR + o0), q1 = *(const unsigned*)(ODIR + (size_t)T_LAT * 512 + o0), zq = *(const unsigned*)(PL + (size_t)tok * IN_COLS + 1536 + h * 128 + 2 * lane);
            const float a0 = bf2f((bf16_t)(q0 & 0xffffu)) + bf2f((bf16_t)(q1 & 0xffffu)), a1 = bf2f((bf16_t)(q0 >> 16)) + bf2f((bf16_t)(q1 >> 16));
            const float ss = wave_sum_fast(a0 * a0 + a1 * a1);
            const float rstd = frsq(ss * (1.f / 128.f) + 1e-6f);
            const float z0 = bf2f((bf16_t)(zq & 0xffffu)), z1 = bf2f((bf16_t)(zq >> 16));
            *(unsigned*)(OA + o0) = pk2(a0 * rstd * p.in[I_ONORM][2 * lane] * fsilu(z0), a1 * rstd * p.in[I_ONORM][2 * lane + 1] * fsilu(z1));
        }
    }
}

DI void phase5(const Params& p, char* smem) {
    const bf16_t* OA = (const bf16_t*)(p.ws + WS_OA); const bf16_t* OB = (const bf16_t*)(p.ws + WS_OB);
    const bf16_t* WA = (const bf16_t*)(p.ws + WS_WOA); const bf16_t* WB = (const bf16_t*)(p.ws + WS_WOB);
    const bf16_t* PL = (const bf16_t*)(p.ws + WS_PLAT); bf16_t* Y = (bf16_t*)(p.aux + AUX_Y);
    if (USE_G8) {
        constexpr int NT8 = D / 256, MT8 = T_LAT / 256;
        for (int t = blockIdx.x; t < MT8 * NT8; t += gridDim.x) {
            int mt, nt; if (!g8::tile_order(t, MT8, NT8, mt, nt)) break;
            const int brow = mt * 256, bcol = nt * 256;
            g8::Acc acc; g8::acc_zero(acc);
            g8::kloop(acc, smem, OA, 512, WA, 512, 512, brow, bcol);
            g8::for_each_quad(acc, brow, bcol, [&](int row, int col, const f32x4& v) {
                const u32x2 gq = *(const u32x2*)(PL + (size_t)row * IN_COLS + COL_G0 + col);
                const float g0 = bf2f((bf16_t)(gq.x & 0xffffu)), g1 = bf2f((bf16_t)(gq.x >> 16)), g2 = bf2f((bf16_t)(gq.y & 0xffffu)), g3 = bf2f((bf16_t)(gq.y >> 16));
                u32x2 o; o.x = pk2(fsigmoid(g0) * v.x, fsigmoid(g1) * v.y); o.y = pk2(fsigmoid(g2) * v.z, fsigmoid(g3) * v.w);
                *(u32x2*)(Y + (size_t)row * D + col) = o;
            });
            g8::acc_zero(acc);
            g8::kloop(acc, smem, OB, 512, WB, 512, 512, brow, bcol);
            g8::for_each_quad(acc, brow, bcol, [&](int row, int col, const f32x4& v) {
                const u32x2 gq = *(const u32x2*)(PL + (size_t)row * IN_COLS + COL_G0 + D + col);
                const float g0 = bf2f((bf16_t)(gq.x & 0xffffu)), g1 = bf2f((bf16_t)(gq.x >> 16)), g2 = bf2f((bf16_t)(gq.y & 0xffffu)), g3 = bf2f((bf16_t)(gq.y >> 16));
#ifdef EMU
                const unsigned long long tq = *(const unsigned long long*)(Y + (size_t)row * D + col);
#else
                const unsigned long long tq = __hip_atomic_load((const unsigned long long*)(Y + (size_t)row * D + col), __ATOMIC_RELAXED, __HIP_MEMORY_SCOPE_AGENT);
#endif
                const unsigned tlo = (unsigned)tq, thi = (unsigned)(tq >> 32);
                const float t0 = bf2f((bf16_t)(tlo & 0xffffu)), t1 = bf2f((bf16_t)(tlo >> 16)), t2 = bf2f((bf16_t)(thi & 0xffffu)), t3 = bf2f((bf16_t)(thi >> 16));
                u32x2 o; o.x = pk2(t0 + fsigmoid(g0) * v.x, t1 + fsigmoid(g1) * v.y); o.y = pk2(t2 + fsigmoid(g2) * v.z, t3 + fsigmoid(g3) * v.w);
                *(u32x2*)(Y + (size_t)row * D + col) = o;
            });
        }
        return;
    }
    constexpr int MR5 = 2, BM5 = 64 * MR5; constexpr int NT = D / 128, MT = T_LAT / BM5;
    for (int t = blockIdx.x; t < MT * NT; t += gridDim.x) {
        const int mt = t / NT, nt = t % NT, row0 = mt * BM5;
        f32x4 acca[MR5][4], accb[MR5][4]; acc_zero(acca); acc_zero(accb);
        gemm_kloop(acca, smem, [&](int i) { return OA + (size_t)(row0 + i) * 512; }, WA + (size_t)nt * 128 * 512, 512, 512);
        gemm_kloop(accb, smem, [&](int i) { return OB + (size_t)(row0 + i) * 512; }, WB + (size_t)nt * 128 * 512, 512, 512);
        const int t2 = tid_x(), l2 = t2 & 63, w2 = t2 >> 6; const int wr = w2 >> 1, wc = w2 & 1, fr = l2 & 15, fq = l2 >> 4;
#pragma unroll
        for (int m = 0; m < MR5; ++m)
#pragma unroll
            for (int n = 0; n < 4; ++n)
#pragma unroll
                for (int j = 0; j < 4; ++j) {
                    const int row = row0 + wr * 16 * MR5 + m * 16 + fq * 4 + j, col = nt * 128 + wc * 64 + n * 16 + fr;
                    const float ga = bf2f(PL[(size_t)row * IN_COLS + COL_G0 + col]), gb = bf2f(PL[(size_t)row * IN_COLS + COL_G0 + D + col]);
                    Y[(size_t)row * D + col] = f2bf(sigmoidf_(ga) * acca[m][n][j] + sigmoidf_(gb) * accb[m][n][j]);
                }
    }
}

DI void phase6(const Params& p, char* smem) {
    const bf16_t* Y = (const bf16_t*)(p.aux + AUX_Y); const bf16_t* WO = (const bf16_t*)(p.ws + WS_WOUT);
    const float* mod = (const float*)(p.ws + WS_MOD); float* Hh = (float*)(p.ws + WS_H);
    if (USE_G8) {
        constexpr int NT = D / 256, MT = T_LAT / 256;
        const float* X = p.in[I_X];
        for (int t = blockIdx.x; t < MT * NT; t += gridDim.x) {
            int mt, nt; if (!g8::tile_order(t, MT, NT, mt, nt)) break;
            const int brow = mt * 256, bcol = nt * 256;
            g8::Acc acc; g8::acc_zero(acc);
            g8::kloop(acc, smem, Y, D, WO, D, D, brow, bcol);
            g8::for_each_quad(acc, brow, bcol, [&](int row, int col, const f32x4& v) {
                const int b = row / S; const f32x4 xv = *(const f32x4*)(X + (size_t)row * D + col), gv = *(const f32x4*)(mod + (size_t)b * 6 * D + 2 * D + col);
                f32x4 o; o.x = xv.x + gv.x * v.x; o.y = xv.y + gv.y * v.y; o.z = xv.z + gv.z * v.z; o.w = xv.w + gv.w * v.w;
                *(f32x4*)(Hh + (size_t)row * D + col) = o;
            });
        }
    } else {
        const int tid = tid_x(), lane = tid & 63, wave = tid >> 6, wr = wave >> 1, wc = wave & 1, fr = lane & 15, fq = lane >> 4;
        constexpr int NT = D / 128, MT = T_LAT / BM;
        for (int t = blockIdx.x; t < MT * NT; t += gridDim.x) {
            const int mt = t / NT, nt = t % NT, row0 = mt * BM;
            f32x4 acc[MREP][4]; acc_zero(acc);
            gemm_kloop(acc, smem, [&](int i) { return Y + (size_t)(row0 + i) * D; }, WO + (size_t)nt * 128 * D, D, D);
#pragma unroll
            for (int m = 0; m < MREP; ++m)
#pragma unroll
                for (int n = 0; n < 4; ++n)
#pragma unroll
                    for (int j = 0; j < 4; ++j) {
                        const int row = row0 + wr * 16 * MREP + m * 16 + fq * 4 + j, col = nt * 128 + wc * 64 + n * 16 + fr, b = row / S;
                        Hh[(size_t)row * D + col] = p.in[I_X][(size_t)row * D + col] + mod[(size_t)b * 6 * D + 2 * D + col] * acc[m][n][j];
                    }
        }
    }
    __syncthreads();
    const int tid6 = tid_x(), lane = tid6 & 63, wave = tid6 >> 6;
    const int gw = blockIdx.x * 8 + wave, ngw = gridDim.x * 8;
    float* scr = (float*)smem + wave * (64 * 33);
    bf16_t* GUT = (bf16_t*)(p.aux + AUX_GUT); bf16_t* DNT = (bf16_t*)(p.ws + WS_DNT);
    {
        constexpr int nkb = D / 64, nnb = DE / 32, per = nkb * nnb;
        for (int it = gw; it < NEXP * 2 * per; it += ngw) {
            const int e = it / (2 * per), r = it % (2 * per), up = r / per, r2 = r % per, kb = r2 / nnb, nb = r2 % nnb;
            transpose_item((up ? p.in[I_MU_UP] : p.in[I_MG]) + (size_t)e * D * DE, DE, DE, kb * 64, nb * 32, GUT + (size_t)e * 512 * D, D, up ? 2 : 1, scr, lane);
        }
    }
    {
        constexpr int nkb = DE / 64, nnb = D / 32, per = nkb * nnb;
        for (int it = gw; it < NEXP * per; it += ngw) {
            const int e = it / per, r2 = it % per, kb = r2 / nnb, nb = r2 % nnb;
            transpose_item(p.in[I_MD] + (size_t)e * DE * D, D, D, kb * 64, nb * 32, DNT + (size_t)e * D * DE, DE, 0, scr, lane);
        }
    }
}

#ifdef EMU
#define MFMA32F(a, b, c) emu_mfma32_f32((a), (b), (c))
#else
#define MFMA32F(a, b, c) __builtin_amdgcn_mfma_f32_32x32x2f32((a), (b), (c), 0, 0, 0)
#endif
constexpr int TB_LD = D + 4;
static_assert(32 * TB_LD * 4 <= LDS_BYTES && 8 * 32 * 64 * 4 <= LDS_BYTES, "phase7 lds");
DI void phase7(const Params& p, char* smem) {
    const int tid = tid_x(), lane = tid & 63, wave = tid >> 6, r = lane & 31, hh = lane >> 5;
    const float* Hh = (const float*)(p.ws + WS_H); const float* mod = (const float*)(p.ws + WS_MOD); const float* WRT = (const float*)(p.ws + WS_WRT);
    bf16_t* Tt = (bf16_t*)(p.ws + WS_T); int* cnt = (int*)(p.ws + WS_CNT); int* rowlist = (int*)(p.ws + WS_ROWLIST); float* pairw = (float*)(p.ws + WS_PAIRW);
    float* tb = (float*)smem;
    float* bias = (float*)(smem + LDS_BYTES - 1024);
    int* lcnt = (int*)(smem + LDS_BYTES - 768);
    int* lbase = lcnt + 32;
    if (tid < 36) bias[tid] = tid < 4 ? p.in[I_RGB][tid] : p.in[I_REB][tid - 4];
    f32x4 x[4][D / 256];
    int itn = blockIdx.x;
    if (itn < T_LAT / 32) {
#pragma unroll
        for (int tt = 0; tt < 4; ++tt)
#pragma unroll
            for (int j = 0; j < D / 256; ++j) x[tt][j] = *(const f32x4*)(Hh + (size_t)(itn * 32 + wave * 4 + tt) * D + j * 256 + lane * 4);
    }
    for (int it = blockIdx.x; it < T_LAT / 32; it += gridDim.x) {
        const int tok0 = it * 32;
        __syncthreads();
        if (tid < 32) lcnt[tid] = 0;
#pragma unroll
        for (int tt = 0; tt < 4; ++tt) {
            const int ti = wave * 4 + tt, tok = tok0 + ti, b = tok / S;
            float ss = 0.f;
#pragma unroll
            for (int j = 0; j < D / 256; ++j) ss += x[tt][j].x * x[tt][j].x + x[tt][j].y * x[tt][j].y + x[tt][j].z * x[tt][j].z + x[tt][j].w * x[tt][j].w;
            ss = wave_sum_fast(ss);
            const float rstd = frsq(ss * (1.0f / D) + 1e-6f);
#pragma unroll
            for (int j = 0; j < D / 256; ++j) {
                const int k = j * 256 + lane * 4;
                const f32x4 g = *(const f32x4*)(p.in[I_NFFN] + k), sh = *(const f32x4*)(mod + (size_t)b * 6 * D + 3 * D + k), sc = *(const f32x4*)(mod + (size_t)b * 6 * D + 4 * D + k);
                f32x4 o; o.x = x[tt][j].x * rstd * g.x * (1.f + sc.x) + sh.x; o.y = x[tt][j].y * rstd * g.y * (1.f + sc.y) + sh.y;
                o.z = x[tt][j].z * rstd * g.z * (1.f + sc.z) + sh.z; o.w = x[tt][j].w * rstd * g.w * (1.f + sc.w) + sh.w;
                *(f32x4*)(tb + ti * TB_LD + k) = o;
                u32x2 ob; ob.x = pk2(o.x, o.y); ob.y = pk2(o.z, o.w);
                *(u32x2*)(Tt + (size_t)tok * D + k) = ob;
            }
        }
        itn = it + gridDim.x;
        if (itn < T_LAT / 32) {
#pragma unroll
            for (int tt = 0; tt < 4; ++tt)
#pragma unroll
                for (int j = 0; j < D / 256; ++j) x[tt][j] = *(const f32x4*)(Hh + (size_t)(itn * 32 + wave * 4 + tt) * D + j * 256 + lane * 4);
        }
        LDS_BARRIER();
        f32x16 a0 = zero16(), a1 = zero16();
        {
            const int kbeg = wave * (D / 8);
            const float* arow = tb + r * TB_LD + kbeg + 4 * hh;
            const float* b0row = WRT + (size_t)(4 + r) * D + kbeg + 4 * hh;
            const float* b1row = WRT + (size_t)(r < 4 ? r : 0) * D + kbeg + 4 * hh;
            const float m1 = r < 4 ? 1.f : 0.f;
#pragma unroll 4
            for (int g = 0; g < D / 64; ++g) {
                const f32x4 av = *(const f32x4*)(arow + 8 * g), b0 = *(const f32x4*)(b0row + 8 * g); const f32x4 b1 = *(const f32x4*)(b1row + 8 * g) * m1;
                a0 = MFMA32F(av.x, b0.x, a0); a1 = MFMA32F(av.x, b1.x, a1); a0 = MFMA32F(av.y, b0.y, a0); a1 = MFMA32F(av.y, b1.y, a1);
                a0 = MFMA32F(av.z, b0.z, a0); a1 = MFMA32F(av.z, b1.z, a1); a0 = MFMA32F(av.w, b0.w, a0); a1 = MFMA32F(av.w, b1.w, a1);
            }
        }
        LDS_BARRIER();
        {
            float* part = tb + wave * (32 * 64);
#pragma unroll
            for (int g = 0; g < 16; ++g) { const int i = crow(g, hh); part[i * 64 + r] = a0[g]; part[i * 64 + 32 + r] = a1[g]; }
        }
        LDS_BARRIER();
        float lsum[4];
        {
            const int i = tid >> 4, c4 = (tid & 15) * 4;
#pragma unroll
            for (int e = 0; e < 4; ++e) { float sacc = 0.f;
#pragma unroll
                for (int w = 0; w < 8; ++w) sacc += tb[w * (32 * 64) + i * 64 + c4 + e];
                lsum[e] = sacc; }
        }
        LDS_BARRIER();
        { const int i = tid >> 4, c4 = (tid & 15) * 4;
#pragma unroll
          for (int e = 0; e < 4; ++e) tb[i * 64 + c4 + e] = lsum[e]; }
        LDS_BARRIER();
        int ex1 = 0, ex2 = 0, rk1 = 0, rk2 = 0; float w1 = 0.f, w2 = 0.f;
        if (tid < 32) {
            const float* L = tb + tid * 64;
            float gl[4];
#pragma unroll
            for (int i = 0; i < 4; ++i) gl[i] = L[32 + i] + bias[i];
            int g = 0; float mx = gl[0];
#pragma unroll
            for (int i = 1; i < 4; ++i) if (gl[i] > mx) { mx = gl[i]; g = i; }
            float se = 0.f;
#pragma unroll
            for (int i = 0; i < 4; ++i) se += expf(gl[i] - mx);
            const float pg = 1.0f / se;
            int i1 = 0; float l1 = L[g * 8] + bias[4 + g * 8];
            for (int i = 1; i < 8; ++i) { const float v = L[g * 8 + i] + bias[4 + g * 8 + i]; if (v > l1) { l1 = v; i1 = i; } }
            int i2 = -1; float l2 = -3.0e38f;
            for (int i = 0; i < 8; ++i) { const float v = L[g * 8 + i] + bias[4 + g * 8 + i]; if (i != i1 && v > l2) { l2 = v; i2 = i; } }
            const float e2 = expf(l2 - l1); w1 = pg / (1.f + e2); w2 = pg * e2 / (1.f + e2);
            ex1 = g * 8 + i1; ex2 = g * 8 + i2;
            rk1 = atomicAdd(&lcnt[ex1], 1); rk2 = atomicAdd(&lcnt[ex2], 1);
        }
        LDS_BARRIER();
        if (tid < 32) { const int c = lcnt[tid]; lbase[tid] = c ? atomicAdd(&cnt[tid], c) : 0; }
        __syncthreads();
        if (tid < 32) {
            const int tok = tok0 + tid;
            rowlist[(size_t)ex1 * CAP + lbase[ex1] + rk1] = tok * 2; pairw[tok * 2] = w1;
            rowlist[(size_t)ex2 * CAP + lbase[ex2] + rk2] = tok * 2 + 1; pairw[tok * 2 + 1] = w2;
        }
    }
}

constexpr int MOE_TM = USE_G8 ? 256 : BM;
DI void moe_tiles(const Params& p, char* smem, int* pre) {
    const int* cnt = (const int*)(p.ws + WS_CNT);
    __syncthreads();
    if (tid_x() == 0) { int s = 0; for (int e = 0; e < NEXP; ++e) { pre[e] = s; s += (cnt[e] + MOE_TM - 1) / MOE_TM; } pre[NEXP] = s; }
    __syncthreads();
}
DI void phase8(const Params& p, char* smem) {
    const int tid = tid_x(), lane = tid & 63, wave = tid >> 6, wr = wave >> 1, wc = wave & 1, fr = lane & 15, fq = lane >> 4;
    int* pre = (int*)(smem + LDS_BYTES - 256);
    moe_tiles(p, smem, pre);
    const int* cnt = (const int*)(p.ws + WS_CNT); const int* rowlist = (const int*)(p.ws + WS_ROWLIST);
    const bf16_t* Tt = (const bf16_t*)(p.ws + WS_T); const bf16_t* GUT = (const bf16_t*)(p.aux + AUX_GUT); bf16_t* HID = (bf16_t*)(p.ws + WS_HID);
    if (USE_G8) {
        const int ntile8 = pre[NEXP] * 2;
        for (int t = blockIdx.x; t < ntile8; t += gridDim.x) {
            const int mg = t >> 1, nt = t & 1; int e = 0;
            while (pre[e + 1] <= mg) ++e;
            const int mt = mg - pre[e], ce = cnt[e]; const int* rl = rowlist + (size_t)e * CAP;
            g8::Acc acc; g8::acc_zero(acc);
            g8::kloop_g(acc, smem, Tt, [&](int r) { int idx = mt * 256 + r; idx = idx < ce ? idx : ce - 1; return (rl[idx] >> 1) * D; }, GUT + ((size_t)e * 512 + nt * 256) * D, D, D, 0);
            const int t2 = tid_x(), wid = t2 >> 6, l2 = t2 & 63, wr2 = wid >> 2, wc2 = wid & 3, fr2 = l2 & 15, fq2 = l2 >> 4;
#pragma unroll
            for (int ai = 0; ai < 2; ++ai)
#pragma unroll
                for (int m = 0; m < 4; ++m) {
                    const int idx = mt * 256 + ai * 128 + wr2 * 64 + m * 16 + fr2;
                    if (idx < ce) {
                        const int pair = rl[idx];
#pragma unroll
                        for (int bj = 0; bj < 2; ++bj) {
                            const f32x4 g = acc[ai][bj][m][0], u = acc[ai][bj][m][1];
                            u32x2 o; o.x = pk2(fsilu(g.x) * u.x, fsilu(g.y) * u.y); o.y = pk2(fsilu(g.z) * u.z, fsilu(g.w) * u.w);
                            *(u32x2*)(HID + (size_t)pair * DE + nt * 128 + bj * 64 + wc2 * 16 + fq2 * 4) = o;
                        }
                    }
                }
        }
        return;
    }
    const int ntile = pre[NEXP] * 4;
    for (int t = blockIdx.x; t < ntile; t += gridDim.x) {
        const int mg = t >> 2, nt = t & 3; int e = 0;
        while (pre[e + 1] <= mg) ++e;
        const int mt = mg - pre[e], ce = cnt[e]; const int* rl = rowlist + (size_t)e * CAP;
        f32x4 acc[MREP][4]; acc_zero(acc);
        gemm_kloop(acc, smem, [&](int i) { int idx = mt * BM + i; idx = idx < ce ? idx : ce - 1; return Tt + (size_t)(rl[idx] >> 1) * D; }, GUT + ((size_t)e * 512 + nt * 128) * D, D, D);
#pragma unroll
        for (int m = 0; m < MREP; ++m)
#pragma unroll
            for (int j = 0; j < 4; ++j) {
                const int idx = mt * BM + wr * 16 * MREP + m * 16 + fq * 4 + j;
                if (idx < ce) {
                    const int pair = rl[idx];
#pragma unroll
                    for (int n = 0; n < 2; ++n) {
                        const float g = acc[m][n][j], u = acc[m][n + 2][j];
                        HID[(size_t)pair * DE + nt * 64 + wc * 32 + n * 16 + fr] = f2bf(siluf_(g) * u);
                    }
                }
            }
    }
}
DI void phase9(const Params& p, char* smem) {
    const int tid = tid_x(), lane = tid & 63, wave = tid >> 6, wr = wave >> 1, wc = wave & 1, fr = lane & 15, fq = lane >> 4;
    int* pre = (int*)(smem + LDS_BYTES - 256);
    moe_tiles(p, smem, pre);
    const int* cnt = (const int*)(p.ws + WS_CNT); const int* rowlist = (const int*)(p.ws + WS_ROWLIST); const float* pairw = (const float*)(p.ws + WS_PAIRW);
    const bf16_t* HID = (const bf16_t*)(p.ws + WS_HID); const bf16_t* DNT = (const bf16_t*)(p.ws + WS_DNT); bf16_t* OP = (bf16_t*)(p.ws + WS_OPAIR);
    if (USE_G8) {
        constexpr int NT8 = D / 256;
        const int ntile8 = pre[NEXP] * NT8;
        for (int t = blockIdx.x; t < ntile8; t += gridDim.x) {
            const int mg = t / NT8, nt = t % NT8; int e = 0;
            while (pre[e + 1] <= mg) ++e;
            const int mt = mg - pre[e], ce = cnt[e]; const int* rl = rowlist + (size_t)e * CAP;
            g8::Acc acc; g8::acc_zero(acc);
            g8::kloop_g(acc, smem, HID, [&](int r) { int idx = mt * 256 + r; idx = idx < ce ? idx : ce - 1; return rl[idx] * DE; }, DNT + ((size_t)e * D + nt * 256) * DE, DE, DE, 0);
            g8::for_each_quad(acc, 0, nt * 256, [&](int row, int col, const f32x4& v) {
                const int idx = mt * 256 + row;
                if (idx < ce) { const int pair = rl[idx]; const float w = pairw[pair];
                    u32x2 o; o.x = pk2(v.x * w, v.y * w); o.y = pk2(v.z * w, v.w * w); *(u32x2*)(OP + (size_t)pair * D + col) = o; }
            });
        }
        return;
    }
    constexpr int NT = D / 128;
    const int ntile = pre[NEXP] * NT;
    for (int t = blockIdx.x; t < ntile; t += gridDim.x) {
        const int mg = t / NT, nt = t % NT; int e = 0;
        while (pre[e + 1] <= mg) ++e;
        const int mt = mg - pre[e], ce = cnt[e]; const int* rl = rowlist + (size_t)e * CAP;
        f32x4 acc[MREP][4]; acc_zero(acc);
        gemm_kloop(acc, smem, [&](int i) { int idx = mt * BM + i; idx = idx < ce ? idx : ce - 1; return HID + (size_t)rl[idx] * DE; }, DNT + ((size_t)e * D + nt * 128) * DE, DE, DE);
#pragma unroll
        for (int m = 0; m < MREP; ++m)
#pragma unroll
            for (int j = 0; j < 4; ++j) {
                const int idx = mt * BM + wr * 16 * MREP + m * 16 + fq * 4 + j;
                if (idx < ce) {
                    const int pair = rl[idx]; const float w = pairw[pair];
#pragma unroll
                    for (int n = 0; n < 4; ++n) OP[(size_t)pair * D + nt * 128 + wc * 64 + n * 16 + fr] = f2bf(acc[m][n][j] * w);
                }
            }
    }
}

DI void phase10(const Params& p, char* smem) {
    const int lane = tid_x() & 63, wave = tid_x() >> 6;
    const int gw = blockIdx.x * 8 + wave, ngw = gridDim.x * 8;
    const float* Hh = (const float*)(p.ws + WS_H); const float* mod = (const float*)(p.ws + WS_MOD); const bf16_t* OP = (const bf16_t*)(p.ws + WS_OPAIR);
    for (int tok = gw; tok < T_LAT; tok += ngw) {
        const int b = tok / S;
        f32x4 x[D / 256]; float ss = 0.f;
#pragma unroll
        for (int j = 0; j < D / 256; ++j) {
            const int k = j * 256 + lane * 4;
            const f32x4 hv = *(const f32x4*)(Hh + (size_t)tok * D + k), g2 = *(const f32x4*)(mod + (size_t)b * 6 * D + 5 * D + k);
            const u32x2 p0 = *(const u32x2*)(OP + (size_t)(tok * 2) * D + k), p1 = *(const u32x2*)(OP + (size_t)(tok * 2 + 1) * D + k);
            f32x4 m;
            m.x = bf2f((bf16_t)(p0.x & 0xffffu)) + bf2f((bf16_t)(p1.x & 0xffffu)); m.y = bf2f((bf16_t)(p0.x >> 16)) + bf2f((bf16_t)(p1.x >> 16));
            m.z = bf2f((bf16_t)(p0.y & 0xffffu)) + bf2f((bf16_t)(p1.y & 0xffffu)); m.w = bf2f((bf16_t)(p0.y >> 16)) + bf2f((bf16_t)(p1.y >> 16));
            x[j].x = hv.x + g2.x * m.x; x[j].y = hv.y + g2.y * m.y; x[j].z = hv.z + g2.z * m.z; x[j].w = hv.w + g2.w * m.w;
            ss += x[j].x * x[j].x + x[j].y * x[j].y + x[j].z * x[j].z + x[j].w * x[j].w;
        }
        ss = wave_sum(ss);
        const float rstd = 1.0f / sqrtf(ss * (1.0f / D) + 1e-6f);
#pragma unroll
        for (int j = 0; j < D / 256; ++j) {
            const int k = j * 256 + lane * 4; const f32x4 g = *(const f32x4*)(p.in[I_FIN] + k);
            f32x4 o; o.x = x[j].x * rstd * g.x; o.y = x[j].y * rstd * g.y; o.z = x[j].z * rstd * g.z; o.w = x[j].w * rstd * g.w;
            *(f32x4*)(p.out + (size_t)tok * D + k) = o;
        }
    }
}

DI void run_phase(const Params& p, int ph, char* smem) {
    switch (ph) {
        case PH_MOD: phase0(p, smem); break;
        case PH_U: phase1(p, smem); break;
        case PH_P: phase2(p, smem); break;
        case PH_HALO: phase_halo(p, smem); break;
        case PH_FIR: phase_fir(p, smem); break;
        case PH_CHAINS: phase3(p, smem); break;
        case PH_POST: phase4(p, smem); break;
        case PH_MERGE: phase5(p, smem); break;
        case PH_WOUT: phase6(p, smem); break;
        case PH_ROUTER: phase7(p, smem); break;
        case PH_UP: phase8(p, smem); break;
        case PH_DOWN: phase9(p, smem); break;
        default: phase10(p, smem); break;
    }
}

#ifndef EMU
namespace cg = cooperative_groups;
#define XB_TMO      128
#define XB_XCNT(j)  (256  + 64 * (j))
#define XB_XSUB(j)  (1280 + 64 * (j))
#define XB_XGEN(j)  (2304 + 64 * (j))
#define XB_TOP      3328
#define XB_TOPGEN   3392
#define XB_SPIN_CAP (1u << 20)
DI unsigned xb_ld(unsigned* p) { return __hip_atomic_load(p, __ATOMIC_RELAXED, __HIP_MEMORY_SCOPE_AGENT); }
DI unsigned xb_add(unsigned* p, unsigned v) { return __hip_atomic_fetch_add(p, v, __ATOMIC_RELAXED, __HIP_MEMORY_SCOPE_AGENT); }
DI unsigned xb_xcc_id() { return (unsigned)__builtin_amdgcn_s_getreg((3 << 11) | 20) & 0xFu; }
#define XB_SPIN(cond, bar) do { unsigned _sp = 0; while (cond) { __builtin_amdgcn_s_sleep(1); \
    if ((++_sp & 255u) == 0u) { if (xb_ld(&(bar)[XB_TMO])) break; if (_sp > XB_SPIN_CAP) { atomicAdd(&(bar)[XB_TMO], 1u); break; } } } } while (0)
DI void xcd_barrier_post(unsigned* bar) { if (threadIdx.x == 0) (void)xb_add(&bar[XB_XCNT(xb_xcc_id())], 1u); }
DI void xcd_barrier_complete(unsigned* bar, unsigned x, unsigned& nloc, unsigned& nx) {
    const unsigned G = gridDim.x;
    unsigned sum, cnt, mine, sp = 0u;
    for (;;) {
        sum = 0u; cnt = 0u; mine = 0u;
#pragma unroll
        for (unsigned j = 0; j < 16; ++j) { const unsigned c = xb_ld(&bar[XB_XCNT(j)]); sum += c; cnt += (c > 0u) ? 1u : 0u; mine = (j == x) ? c : mine; }
        if (sum == G) break;
        __builtin_amdgcn_s_sleep(1);
        if ((++sp & 255u) == 0u) { if (xb_ld(&bar[XB_TMO])) break; if (sp > XB_SPIN_CAP) { atomicAdd(&bar[XB_TMO], 1u); break; } }
    }
    nloc = mine > 0u ? mine : 1u; nx = cnt > 0u ? cnt : 1u;
}
DI void xcd_barrier(unsigned* bar, volatile unsigned* st) {
    asm volatile("s_waitcnt vmcnt(0)" ::: "memory");
    __syncthreads();
    if (threadIdx.x == 0) {
        __builtin_amdgcn_s_waitcnt(0);
        const unsigned x = xb_xcc_id();
        unsigned nloc = st[0], nx = st[1];
        if (nloc == 0u) { xcd_barrier_complete(bar, x, nloc, nx); st[0] = nloc; st[1] = nx; }
        const unsigned old = xb_add(&bar[XB_XSUB(x)], 1u);
        const unsigned gen = old / nloc;
        if (old + 1u == (gen + 1u) * nloc) {
            __builtin_amdgcn_fence(__ATOMIC_RELEASE, "agent");
            asm volatile("s_waitcnt vmcnt(0)" ::: "memory");
            const unsigned og = xb_add(&bar[XB_TOP], 1u);
            const unsigned tg = og / nx;
            if (og + 1u == (tg + 1u) * nx) xb_add(&bar[XB_TOPGEN], 1u);
            else XB_SPIN(xb_ld(&bar[XB_TOPGEN]) == tg, bar);
            __builtin_amdgcn_fence(__ATOMIC_ACQUIRE, "agent");
            xb_add(&bar[XB_XGEN(x)], 1u);
            asm volatile("s_waitcnt vmcnt(0)" ::: "memory");
        } else {
            XB_SPIN(xb_ld(&bar[XB_XGEN(x)]) == gen, bar);
            __builtin_amdgcn_fence(__ATOMIC_ACQUIRE, "agent");
            asm volatile("s_waitcnt vmcnt(0)" ::: "memory");
        }
    }
    __syncthreads();
}
__global__ void __launch_bounds__(NTHREADS) mk_forward(Params p) {
    extern __shared__ __attribute__((aligned(16))) char smem[];
    cg::grid_group grid = cg::this_grid();
    typedef const Params __attribute__((address_space(4)))* KPtr;
    volatile unsigned* xst = (volatile unsigned*)(smem + LDS_BYTES);
    if (threadIdx.x < 2) xst[threadIdx.x] = 0u;
    if (p.ph_lo == 0x7fffffff) grid.sync();
    xcd_barrier_post((unsigned*)(p.ws + WS_XBAR));
#define PHASE(k, fn) { KPtr kp = (KPtr)__builtin_amdgcn_kernarg_segment_ptr(); asm volatile("" : "+s"(kp)); fn(*(const Params*)kp, smem); \
        unsigned* xbar = (unsigned*)(((const Params*)kp)->ws + WS_XBAR); \
        if ((k) + 1 < NPHASES) xcd_barrier(xbar, xst); }
    PHASE(0, phase0) PHASE(1, phase1) PHASE(2, phase2)
    if (!USE_G8) PHASE(3, phase_halo)
    PHASE(4, phase_fir) PHASE(5, phase3) PHASE(6, phase4)
    PHASE(7, phase5) PHASE(8, phase6) PHASE(9, phase7) PHASE(10, phase8) PHASE(11, phase9) PHASE(12, phase10)
#undef PHASE
}

extern "C" void kernel_launch(void* const* d_in, const int* in_sizes, int n_in, void* d_out, int out_size, void* d_ws, size_t ws_size, hipStream_t stream) {
    static int grid_blocks = 0;
    if (grid_blocks == 0) {
        if (n_in != 35 || out_size != T_LAT * D || ws_size < WS_END || (size_t)out_size * 4 < AUX_END) {
            fprintf(stderr, "kernel_launch: unexpected shapes (n_in %d out %d ws %zu need %zu aux need %zu)\n", n_in, out_size, ws_size, (size_t)WS_END, (size_t)AUX_END);
            grid_blocks = -1; return;
        }
        int dev = 0, cus = 0, per_cu = 0;
        hipGetDevice(&dev);
        hipDeviceGetAttribute(&cus, hipDeviceAttributeMultiprocessorCount, dev);
        hipFuncSetAttribute((const void*)mk_forward, hipFuncAttributeMaxDynamicSharedMemorySize, LDS_BYTES + 256);
        hipOccupancyMaxActiveBlocksPerMultiprocessor(&per_cu, (const void*)mk_forward, NTHREADS, LDS_BYTES + 256);
        if (per_cu < 1) { fprintf(stderr, "kernel_launch: occupancy query says %d blocks/CU\n", per_cu); per_cu = 1; }
        if (per_cu > 1) per_cu = 1;
        grid_blocks = cus * per_cu;
    }
    if (grid_blocks < 0) return;
    Params p{};
    for (int i = 0; i < 35; ++i) p.in[i] = (const float*)d_in[i];
    p.out = (float*)d_out; p.ws = (char*)d_ws; p.aux = (char*)d_out;
    p.ph_lo = 0; p.ph_hi = NPHASES;
    (void)hipMemsetAsync((char*)d_ws + WS_XBAR, 0, 3456 * 4, stream);
    void* args[] = {&p};
    hipError_t e = hipLaunchCooperativeKernel((const void*)mk_forward, dim3(grid_blocks), dim3(NTHREADS), args, LDS_BYTES + 256, stream);
    if (e != hipSuccess) fprintf(stderr, "cooperative launch failed: %s (grid %d)\n", hipGetErrorString(e), grid_blocks);
}
#endif
```

```cpp
#ifndef EMU
#include <hip/hip_runtime.h>
#include <hip/hip_cooperative_groups.h>
#include <cstdio>
#endif
#include <stdint.h>
#include <stddef.h>

#ifndef CFG_D
#define CFG_D 1024
#define CFG_B 8
#define CFG_S 2048
#define CFG_CTX 256
#endif
#ifndef MK_LAUNCHES
#define MK_LAUNCHES 1
#endif

typedef unsigned short bf16_t;
typedef short bf16x8 __attribute__((ext_vector_type(8)));
typedef float f32x4 __attribute__((ext_vector_type(4)));
typedef unsigned u32x4 __attribute__((ext_vector_type(4)));
typedef unsigned u32x2 __attribute__((ext_vector_type(2)));

#define DI __device__ __forceinline__
DI int tid_x() { int t = (int)threadIdx.x;
#ifndef EMU
    asm volatile("" : "+v"(t));
#endif
    return t; }

constexpr int D = CFG_D, NB = CFG_B, S = CFG_S, CTXL = CFG_CTX;
constexpr int GW = 64, ROWS = S / GW;
constexpr int T_CTX = NB * CTXL, T_LAT = NB * S, T_ALL = T_CTX + T_LAT;
constexpr int H_A = 4, H_B = 8;
constexpr int A_COLS = 2064, B_COLS = 1920;
constexpr int IN_COLS = A_COLS + B_COLS + 2 * D;
constexpr int COL_B0 = A_COLS, COL_G0 = A_COLS + B_COLS;
constexpr int CTX_COLS = COL_G0;
constexpr int NP = ((IN_COLS + 127) / 128) * 128;
constexpr int NEXP = 32, DE = 256;
constexpr int NV = NB + 1;
constexpr int NTHREADS = 512;
constexpr int MREP = (T_CTX % 256 == 0 && T_LAT % 256 == 0) ? 4 : 2;
constexpr int BM = 64 * MREP;
constexpr int NPHASES = 13;
enum { PH_MOD = 0, PH_U, PH_P, PH_HALO, PH_FIR, PH_CHAINS, PH_POST, PH_MERGE, PH_WOUT, PH_ROUTER, PH_UP, PH_DOWN, PH_FINAL };
constexpr int LDS_BYTES = 155648;
constexpr int CAP = T_LAT;

static_assert(D % 256 == 0 && S % 64 == 0 && CTXL % 64 == 0 && T_CTX % BM == 0 && T_LAT % BM == 0, "shape");

constexpr size_t al256(size_t x) { return (x + 255) & ~(size_t)255; }
constexpr int CNT_STRIDE = 64;
constexpr size_t WS_CNT = 512 + 3456 * 4 + 256;
constexpr size_t WS_BAR = 256;
constexpr size_t WS_XBAR = 512;
constexpr size_t WS_MOD = 512 + 3456 * 4 + 256 + 32 * 64 * 4;
constexpr size_t WS_AB = al256(WS_MOD + (size_t)NV * 6 * D * 4);
constexpr size_t WS_BONUS = al256(WS_AB + (size_t)T_ALL * 16 * 4);
constexpr size_t WS_PAIRW = al256(WS_BONUS + (size_t)2 * T_LAT * 8 * 4);
constexpr size_t WS_ROWLIST = al256(WS_PAIRW + (size_t)T_LAT * 2 * 4);
constexpr size_t WS_WRT = al256(WS_ROWLIST + (size_t)NEXP * CAP * 4);
constexpr size_t WS_G2T = al256(WS_WRT + (size_t)36 * D * 4);
constexpr size_t WS_WOA = al256(WS_G2T + (size_t)512 * 128 * 2);
constexpr size_t WS_WOB = al256(WS_WOA + (size_t)D * 512 * 2);
constexpr size_t WS_WOUT = al256(WS_WOB + (size_t)D * 512 * 2);
constexpr size_t WS_OA = al256(WS_WOUT + (size_t)D * D * 2);
constexpr size_t WS_OB = al256(WS_OA + (size_t)T_LAT * 512 * 2);
constexpr size_t WS_HALO_A = WS_OA;
constexpr size_t WS_HALO_B = WS_OA + al256((size_t)(T_ALL / 64) * 4 * 1536 * 2);
static_assert(WS_HALO_B + (size_t)(T_ALL / 64) * 2 * 1920 * 2 <= WS_OB + (size_t)T_LAT * 512 * 2, "halo buffers");
constexpr size_t WS_DNT = WS_OA;
constexpr size_t WS_SPARE_END = al256(WS_OB + (size_t)T_LAT * 512 * 2) > al256(WS_DNT + (size_t)NEXP * D * DE * 2) ? al256(WS_OB + (size_t)T_LAT * 512 * 2) : al256(WS_DNT + (size_t)NEXP * D * DE * 2);
constexpr size_t WS_P = WS_SPARE_END;
constexpr size_t WS_PLAT = WS_P;
constexpr size_t WS_PCTX = al256(WS_PLAT + (size_t)T_LAT * IN_COLS * 2);
constexpr size_t WS_P_END = al256(WS_PCTX + (size_t)T_CTX * CTX_COLS * 2);
constexpr size_t WS_H = WS_P;
constexpr size_t WS_T = al256(WS_H + (size_t)T_LAT * D * 4);
constexpr size_t WS_HID = al256(WS_T + (size_t)T_LAT * D * 2);
constexpr size_t WS_OPAIR = al256(WS_HID + (size_t)T_LAT * 2 * DE * 2);
constexpr size_t WS_P2_END = al256(WS_OPAIR + (size_t)T_LAT * 2 * D * 2);
constexpr size_t WS_END = WS_P_END > WS_P2_END ? WS_P_END : WS_P2_END;
constexpr size_t AUX_WINT = 0;
constexpr size_t AUX_U = al256((size_t)NP * D * 2);
constexpr size_t AUX_ODIR = 0;
constexpr size_t AUX_YDIR = (size_t)2 * T_LAT * 512 * 2;
constexpr size_t AUX_Y = 0;
constexpr size_t AUX_GUT = (size_t)T_LAT * D * 2;
constexpr size_t AUX_END1 = AUX_U + (size_t)T_ALL * D * 2;
constexpr size_t AUX_END2 = AUX_YDIR + (size_t)2 * T_LAT * 512 * 2;
constexpr size_t AUX_END3 = AUX_GUT + (size_t)NEXP * 512 * D * 2;
constexpr size_t AUX_END = (AUX_END1 > AUX_END2 ? (AUX_END1 > AUX_END3 ? AUX_END1 : AUX_END3) : (AUX_END2 > AUX_END3 ? AUX_END2 : AUX_END3));

struct Params {
    const float* in[35];
    float* out;
    char* ws;
    char* aux;
    int ph_lo, ph_hi;
};
enum { I_X = 0, I_C, I_CTX, I_CCTX, I_ADAW, I_ADAB, I_NMIX, I_NFFN, I_WIN, I_CONV, I_ALOG, I_DTB, I_ONORM, I_MU, I_W0, I_W2, I_A0, I_A2, I_G2, I_KK, I_KA, I_RK, I_LNG, I_LNB, I_WOA, I_WOB, I_WOUT, I_RG, I_RGB, I_RE, I_REB, I_MG, I_MU_UP, I_MD, I_FIN };

DI float bf2f(bf16_t v) { union { unsigned u; float f; } x; x.u = ((unsigned)v) << 16; return x.f; }
#ifdef EMU
DI bf16_t f2bf(float f) { union { float f; unsigned u; } x; x.f = f; unsigned u = x.u; u += 0x7fffu + ((u >> 16) & 1u); return (bf16_t)(u >> 16); }
DI unsigned pk2(float lo, float hi) { return (unsigned)f2bf(lo) | ((unsigned)f2bf(hi) << 16); }
#else
typedef __bf16 hbf16x2 __attribute__((ext_vector_type(2)));
typedef float f32x2_ __attribute__((ext_vector_type(2)));
DI bf16_t f2bf(float f) { return __builtin_bit_cast(unsigned short, (__bf16)f); }
DI unsigned pk2(float lo, float hi) { const f32x2_ v = {lo, hi}; return __builtin_bit_cast(unsigned, __builtin_convertvector(v, hbf16x2)); }
#endif
DI float sigmoidf_(float x) { return 1.0f / (1.0f + expf(-x)); }
DI float siluf_(float x) { return x / (1.0f + expf(-x)); }
DI float softplusf_(float x) { return x > 20.f ? x : log1pf(expf(x)); }
DI float wave_sum(float v) {
#pragma unroll
    for (int o = 1; o < 64; o <<= 1) v += __shfl_xor(v, o);
    return v;
}
#ifdef EMU
#define MFMA16(a, b, c) emu_mfma16((a), (b), (c))
#define WAVE_SYNC() emu::wave_bar()
#else
#define MFMA16(a, b, c) __builtin_amdgcn_mfma_f32_16x16x32_bf16((a), (b), (c), 0, 0, 0)
#define WAVE_SYNC() asm volatile("s_waitcnt lgkmcnt(0)" ::: "memory")
#endif
#ifdef EMU
#define LDS_BARRIER() __syncthreads()
#else
#define LDS_BARRIER() do { asm volatile("s_waitcnt lgkmcnt(0)" ::: "memory"); __builtin_amdgcn_s_barrier(); asm volatile("" ::: "memory"); } while (0)
#endif

typedef float f32x16 __attribute__((ext_vector_type(16)));
typedef float f32x2_ac __attribute__((ext_vector_type(2)));
typedef short bf16x4 __attribute__((ext_vector_type(4)));
#ifdef EMU
#define MFMA32(a, b, c) emu_mfma32((a), (b), (c))
DI float fexp(float x) { return expf(x); }
DI float flog(float x) { return logf(x); }
DI float frcp(float x) { return 1.0f / x; }
DI float frsq(float x) { return 1.0f / sqrtf(x); }
DI float wave_sum_fast(float v) { return wave_sum(v); }
#else
#define MFMA32(a, b, c) __builtin_amdgcn_mfma_f32_32x32x16_bf16((a), (b), (c), 0, 0, 0)
DI float fexp(float x) { return __expf(x); }
DI float flog(float x) { return __logf(x); }
DI float frcp(float x) { return __builtin_amdgcn_rcpf(x); }
DI float frsq(float x) { return __builtin_amdgcn_rsqf(x); }
#define DPP_ADD(v, ctrl) ((v) + __builtin_bit_cast(float, __builtin_amdgcn_update_dpp(0, __builtin_bit_cast(int, (v)), (ctrl), 0xf, 0xf, false)))
DI float wave_sum_fast(float v) {
    v = DPP_ADD(v, 0xB1); v = DPP_ADD(v, 0x4E); v = DPP_ADD(v, 0x141); v = DPP_ADD(v, 0x140);
    const int iv = __builtin_bit_cast(int, v);
    return (__builtin_bit_cast(float, __builtin_amdgcn_readlane(iv, 0)) + __builtin_bit_cast(float, __builtin_amdgcn_readlane(iv, 16))) +
           (__builtin_bit_cast(float, __builtin_amdgcn_readlane(iv, 32)) + __builtin_bit_cast(float, __builtin_amdgcn_readlane(iv, 48)));
}
#endif
DI float fsigmoid(float x) { return frcp(1.0f + fexp(-x)); }
DI float fsilu(float x) { return x * fsigmoid(x); }
DI float fsoftplus(float x) { return fmaxf(x, 0.f) + flog(1.f + fexp(-fabsf(x))); }
DI float ftanh(float x) { return 1.0f - 2.0f * frcp(1.0f + fexp(2.0f * x)); }

constexpr int LDS_ROW = 40;
constexpr int GEMM_A_BYTES = BM * LDS_ROW * 2, GEMM_B_BYTES = 128 * LDS_ROW * 2;
template <int MR, class ARow>
DI void gemm_kloop(f32x4 (&acc)[MR][4], char* smem, ARow arow, const bf16_t* Bt, int ldb, int K) {
    constexpr int BM = 64 * MR;
    const int tid = tid_x(), lane = tid & 63, wave = tid >> 6, wr = wave >> 1, wc = wave & 1, fr = lane & 15, fq = lane >> 4;
    bf16_t* As = (bf16_t*)smem;
    bf16_t* Bs = (bf16_t*)(smem + 2 * GEMM_A_BYTES);
    constexpr int ACH = BM * 4 / NTHREADS;
    static_assert(ACH >= 1, "tile");
    const bf16_t* ap[ACH];
#pragma unroll
    for (int i = 0; i < ACH; ++i) { const int q = tid + i * NTHREADS; ap[i] = arow(q >> 2) + (q & 3) * 8; }
    const bf16_t* bp = Bt + (size_t)(tid >> 2) * ldb + (tid & 3) * 8;
    u32x4 ra[ACH], rb;
#pragma unroll
    for (int i = 0; i < ACH; ++i) ra[i] = *(const u32x4*)(ap[i]);
    rb = *(const u32x4*)(bp);
    const int nk = K / 32;
    for (int kt = 0; kt < nk; ++kt) {
        const int buf = kt & 1;
#pragma unroll
        for (int i = 0; i < ACH; ++i) { const int q = tid + i * NTHREADS; *(u32x4*)(As + (buf * BM + (q >> 2)) * LDS_ROW + (q & 3) * 8) = ra[i]; }
        *(u32x4*)(Bs + (buf * 128 + (tid >> 2)) * LDS_ROW + (tid & 3) * 8) = rb;
        __syncthreads();
        if (kt + 1 < nk) {
#pragma unroll
            for (int i = 0; i < ACH; ++i) ra[i] = *(const u32x4*)(ap[i] + (kt + 1) * 32);
            rb = *(const u32x4*)(bp + (kt + 1) * 32);
        }
        bf16x8 af[MR], bfr[4];
#pragma unroll
        for (int m = 0; m < MR; ++m) af[m] = *(const bf16x8*)(As + (buf * BM + wr * 16 * MR + m * 16 + fr) * LDS_ROW + fq * 8);
#pragma unroll
        for (int n = 0; n < 4; ++n) bfr[n] = *(const bf16x8*)(Bs + (buf * 128 + wc * 64 + n * 16 + fr) * LDS_ROW + fq * 8);
#pragma unroll
        for (int m = 0; m < MR; ++m)
#pragma unroll
            for (int n = 0; n < 4; ++n) acc[m][n] = MFMA16(af[m], bfr[n], acc[m][n]);
    }
    __syncthreads();
}
template <int MR>
DI void acc_zero(f32x4 (&acc)[MR][4]) {
#pragma unroll
    for (int m = 0; m < MR; ++m)
#pragma unroll
        for (int n = 0; n < 4; ++n) acc[m][n] = (f32x4){0.f, 0.f, 0.f, 0.f};
}

namespace g8 {
constexpr int BM = 256, BK = 64, HALF = 128, HT = HALF * BK;
constexpr int LDS_NEED = 8 * HT * 2;
DI int lds_byte(int r, int c) { const int st = (r >> 4) * 2 + (c >> 5), rr = r & 15, cc = c & 31, ob = rr * 64 + cc * 2; return st * 1024 + (ob ^ (((ob >> 9) & 1) << 5)); }
DI void stage_rc(int b, int& R, int& C) { const int st = b / 1024, sb = b % 1024, swz = sb ^ (((sb >> 9) & 1) << 5); R = (st >> 1) * 16 + swz / 64; C = (st & 1) * 32 + (swz % 64) / 2; }
#ifdef EMU
#define G8_GLDS(src, dst) emu_global_load_lds16((src), (dst))
#define G8_WAIT_V(n)
#define G8_WAIT_L(n)
#define G8_BAR __syncthreads()
#define G8_SCHED
#define G8_PRIO(x)
#else
#define G8_GLDS(src, dst) __builtin_amdgcn_global_load_lds((const unsigned*)(src), (__attribute__((address_space(3))) unsigned*)(dst), 16, 0, 0)
#define G8_WAIT_V(n) asm volatile("s_waitcnt vmcnt(" #n ")" ::: "memory")
#define G8_WAIT_L(n) asm volatile("s_waitcnt lgkmcnt(" #n ")" ::: "memory")
#define G8_BAR __builtin_amdgcn_s_barrier()
#define G8_SCHED __builtin_amdgcn_sched_barrier(0)
#define G8_PRIO(x) __builtin_amdgcn_s_setprio(x)
#endif
typedef f32x4 Acc[2][2][4][2];
template <class AOff>
DI void kloop_g(Acc& acc, char* smem, const bf16_t* A, AOff aoff, const bf16_t* Bt, int ldb, int K, int bcol) {
    bf16_t* shm = (bf16_t*)smem;
    const int tid = tid_x(), wid = tid >> 6, lane = tid & 63, wr = wid >> 2, wc = wid & 3, fr = lane & 15, fq = lane >> 4;
    int ao[2][2];
#pragma unroll
    for (int h = 0; h < 2; ++h)
#pragma unroll
        for (int i = 0; i < 2; ++i) { int R, C; stage_rc(tid * 16 + i * 8192, R, C); ao[h][i] = aoff(h * HALF + R) + C; }
#define G8_STAGE_A(P, h, kt) do { for (int _i = 0; _i < 2; ++_i) { const int _b = tid * 16 + _i * 8192; G8_GLDS(A + (size_t)ao[h][_i] + (size_t)(kt) * BK, (char*)(P) + _b); } } while (0)
#define G8_SA(b, h) (shm + ((b) * 2 + (h)) * HT)
#define G8_SB(b, h) (shm + (4 + (b) * 2 + (h)) * HT)
#define G8_STAGE(P, BASE, LD, br, kt) do { const bf16_t* _g = (BASE) + (size_t)(br) * (LD) + (size_t)(kt) * BK; \
    for (int _i = 0; _i < 2; ++_i) { const int _b = tid * 16 + _i * 8192; int _r, _c; stage_rc(_b, _r, _c); G8_GLDS(_g + (size_t)_r * (LD) + _c, (char*)(P) + _b); } } while (0)
#define G8_LDA(dst, b, h) for (int m = 0; m < 4; ++m) for (int k = 0; k < 2; ++k) dst[m][k] = *(const bf16x8*)((const char*)G8_SA(b, h) + lds_byte(wr * 64 + m * 16 + fr, k * 32 + fq * 8))
#define G8_LDB(dst, b, h) for (int n = 0; n < 2; ++n) for (int k = 0; k < 2; ++k) dst[n][k] = *(const bf16x8*)((const char*)G8_SB(b, h) + lds_byte(wc * 32 + n * 16 + fr, k * 32 + fq * 8))
#define G8_MMA(ai, bj, At_, Bt_) do { G8_PRIO(1); for (int m = 0; m < 4; ++m) for (int n = 0; n < 2; ++n) for (int k = 0; k < 2; ++k) \
    acc[ai][bj][m][n] = MFMA16(Bt_[n][k], At_[m][k], acc[ai][bj][m][n]); G8_PRIO(0); } while (0)
    bf16x8 At[4][2], B0[2][2], B1[2][2];
    const int nt = K / BK;
    G8_STAGE(G8_SB(0, 0), Bt, ldb, bcol, 0); G8_STAGE_A(G8_SA(0, 0), 0, 0);
    G8_STAGE(G8_SB(0, 1), Bt, ldb, bcol + HALF, 0); G8_STAGE_A(G8_SA(0, 1), 1, 0);
    if (wr == 1) G8_BAR;
    G8_WAIT_V(4); G8_BAR;
    G8_STAGE(G8_SB(1, 0), Bt, ldb, bcol, 1); G8_STAGE_A(G8_SA(1, 0), 0, 1); G8_STAGE(G8_SB(1, 1), Bt, ldb, bcol + HALF, 1);
    G8_WAIT_V(6); G8_BAR;
    for (int t = 0; t < nt - 2; t += 2) {
        G8_LDB(B0, 0, 0); G8_SCHED; G8_LDA(At, 0, 0); G8_STAGE_A(G8_SA(1, 1), 1, t + 1);
        G8_WAIT_L(8); G8_BAR; G8_WAIT_L(0); G8_MMA(0, 0, At, B0); G8_BAR; G8_SCHED;
        G8_LDB(B1, 0, 1); G8_STAGE(G8_SB(0, 0), Bt, ldb, bcol, t + 2);
        G8_BAR; G8_WAIT_L(0); G8_MMA(0, 1, At, B1); G8_BAR;
        G8_LDA(At, 0, 1); G8_STAGE_A(G8_SA(0, 0), 0, t + 2);
        G8_BAR; G8_WAIT_L(0); G8_MMA(1, 0, At, B0); G8_BAR; G8_SCHED;
        G8_STAGE(G8_SB(0, 1), Bt, ldb, bcol + HALF, t + 2);
        G8_WAIT_V(6); G8_BAR; G8_MMA(1, 1, At, B1); G8_BAR;
        G8_LDB(B0, 1, 0); G8_SCHED; G8_LDA(At, 1, 0); G8_STAGE_A(G8_SA(0, 1), 1, t + 2);
        G8_WAIT_L(8); G8_BAR; G8_WAIT_L(0); G8_MMA(0, 0, At, B0); G8_BAR; G8_SCHED;
        G8_LDB(B1, 1, 1); G8_STAGE(G8_SB(1, 0), Bt, ldb, bcol, t + 3);
        G8_BAR; G8_WAIT_L(0); G8_MMA(0, 1, At, B1); G8_BAR;
        G8_LDA(At, 1, 1); G8_STAGE_A(G8_SA(1, 0), 0, t + 3);
        G8_BAR; G8_WAIT_L(0); G8_MMA(1, 0, At, B0); G8_BAR; G8_SCHED;
        G8_STAGE(G8_SB(1, 1), Bt, ldb, bcol + HALF, t + 3);
        G8_WAIT_V(6); G8_BAR; G8_MMA(1, 1, At, B1); G8_BAR;
    }
    { G8_LDB(B0, 0, 0); G8_LDA(At, 0, 0); G8_STAGE_A(G8_SA(1, 1), 1, nt - 1);
      G8_BAR; G8_WAIT_L(0); G8_MMA(0, 0, At, B0); G8_BAR;
      G8_LDB(B1, 0, 1); G8_BAR; G8_WAIT_L(0); G8_MMA(0, 1, At, B1); G8_BAR;
      G8_LDA(At, 0, 1); G8_WAIT_V(4); G8_BAR; G8_WAIT_L(0); G8_MMA(1, 0, At, B0); G8_MMA(1, 1, At, B1); G8_BAR; }
    { G8_LDB(B0, 1, 0); G8_LDA(At, 1, 0); G8_WAIT_V(2); G8_BAR; G8_WAIT_L(0); G8_MMA(0, 0, At, B0); G8_BAR;
      G8_LDB(B1, 1, 1); G8_WAIT_V(0); G8_BAR; G8_WAIT_L(0); G8_MMA(0, 1, At, B1); G8_BAR;
      G8_LDA(At, 1, 1); G8_BAR; G8_WAIT_L(0); G8_MMA(1, 0, At, B0); G8_MMA(1, 1, At, B1); G8_BAR; }
    if (wr == 0) G8_BAR;
#undef G8_SA
#undef G8_SB
#undef G8_STAGE
#undef G8_STAGE_A
#undef G8_LDA
#undef G8_LDB
#undef G8_MMA
}
DI void kloop(Acc& acc, char* smem, const bf16_t* A, int lda, const bf16_t* Bt, int ldb, int K, int brow, int bcol) {
    kloop_g(acc, smem, A, [&](int r) { return (brow + r) * lda; }, Bt, ldb, K, bcol);
}
DI bool tile_order(int L, int nM, int nN, int& pm, int& pn) {
    constexpr int NXCD = 8, WGM = 8;
    const int nwg = nM * nN; if (L >= nwg) return false;
    int wgid = L; { const int q = nwg / NXCD, r = nwg % NXCD, xcd = wgid % NXCD, off = wgid / NXCD; wgid = (xcd < r ? xcd * (q + 1) : r * (q + 1) + (xcd - r) * q) + off; }
    const int nig = WGM * nN, gid = wgid / nig, fm = gid * WGM, gsz = (nM - fm) < WGM ? (nM - fm) : WGM;
    pm = fm + ((wgid % nig) % gsz); pn = (wgid % nig) / gsz; return true;
}
DI void acc_zero(Acc& acc) {
#pragma unroll
    for (int a = 0; a < 2; ++a)
#pragma unroll
        for (int b = 0; b < 2; ++b)
#pragma unroll
            for (int m = 0; m < 4; ++m)
#pragma unroll
                for (int n = 0; n < 2; ++n) acc[a][b][m][n] = (f32x4){0.f, 0.f, 0.f, 0.f};
}
template <class F> DI void for_each_quad(const Acc& acc, int brow, int bcol, F f) {
    const int tid = tid_x(), wid = tid >> 6, lane = tid & 63, wr = wid >> 2, wc = wid & 3, fr = lane & 15, fq = lane >> 4;
#pragma unroll
    for (int ai = 0; ai < 2; ++ai)
#pragma unroll
        for (int m = 0; m < 4; ++m)
#pragma unroll
            for (int bj = 0; bj < 2; ++bj)
#pragma unroll
                for (int n = 0; n < 2; ++n) f(brow + ai * HALF + wr * 64 + m * 16 + fr, bcol + bj * HALF + wc * 32 + n * 16 + fq * 4, acc[ai][bj][m][n]);
}
}

constexpr bool USE_G8 = ((NB * CTXL) % 256 == 0) && ((NB * S) % 256 == 0) && (NP % 256 == 0) && (D % 256 == 0) && (D >= 256);
DI int gu_row(int c, int up) {
    if (USE_G8) return (c >> 7) * 256 + ((c >> 6) & 1) * 128 + ((c >> 4) & 3) * 32 + (up ? 16 : 0) + (c & 15);
    return (c >> 6) * 128 + ((c >> 5) & 1) * 64 + ((c >> 4) & 1) * 16 + (c & 15) + (up ? 32 : 0);
}
DI void transpose_item(const float* W, int N, int Nvalid, int k0, int n0, bf16_t* WT, int ldt, int mode, float* scr, int lane) {
    float tv[32];
#pragma unroll
    for (int i = 0; i < 32; ++i) {
        const int kk = 2 * i + (lane >> 5), n = n0 + (lane & 31);
        tv[i] = (n < Nvalid) ? W[(size_t)(k0 + kk) * N + n] : 0.f;
    }
#pragma unroll
    for (int i = 0; i < 32; ++i) scr[(2 * i + (lane >> 5)) * 33 + (lane & 31)] = tv[i];
    WAVE_SYNC();
    const int c = lane & 7;
#pragma unroll
    for (int j = 0; j < 4; ++j) {
        const int nl = (lane >> 3) + 8 * j; const float* s = scr + (8 * c) * 33 + nl;
        u32x4 o; o.x = pk2(s[0], s[33]); o.y = pk2(s[2 * 33], s[3 * 33]); o.z = pk2(s[4 * 33], s[5 * 33]); o.w = pk2(s[6 * 33], s[7 * 33]);
        const int n = n0 + nl; const int row = mode == 0 ? n : gu_row(n, mode == 2);
        *(u32x4*)(WT + (size_t)row * ldt + k0 + 8 * c) = o;
    }
    WAVE_SYNC();
}
DI void transpose_matrix(const float* W, int K, int N, int Npad, bf16_t* WT, int mode, char* smem, int gw, int ngw, int& base) {
    const int lane = tid_x() & 63, wave = tid_x() >> 6;
    float* scr = (float*)smem + wave * (64 * 33);
    const int nkb = K / 64, nnb = Npad / 32, nitems = nkb * nnb;
    int first = ((gw - base) % ngw + ngw) % ngw;
    for (int it = first; it < nitems; it += ngw) {
        const int kb = it / nnb, nb = it % nnb;
        transpose_item(W, N, N, kb * 64, nb * 32, WT, K, mode, scr, lane);
    }
    base = (base + nitems) % ngw;
}

DI void phase0(const Params& p, char* smem) {
    const int tid = tid_x(), lane = tid & 63, wave = tid >> 6;
    if (blockIdx.x == 0 && tid < NEXP) ((int*)(p.ws + WS_CNT))[tid * CNT_STRIDE] = 0;
    if (blockIdx.x == 0 && tid == 0) *(unsigned*)(p.ws + WS_BAR) = 0u;
    float* sil = (float*)smem;
    float* red = sil + NV * D;
    const int nitems = 6 * D / 32;
    bool did = false;
    for (int it = blockIdx.x; it < nitems; it += gridDim.x) {
        if (!did) {
            for (int i = tid; i < NV * D; i += NTHREADS) { const int v = i / D, k = i % D; const float cv = v < NB ? p.in[I_C][v * D + k] : p.in[I_CCTX][k]; sil[i] = siluf_(cv); }
            did = true;
        }
        __syncthreads();
        const int col = it * 32 + (lane & 31), rp = lane >> 5;
        float acc[NV];
#pragma unroll
        for (int v = 0; v < NV; ++v) acc[v] = 0.f;
        const int r0 = wave * (D / 8);
        float wv[D / 16];
#pragma unroll
        for (int i = 0; i < D / 16; ++i) wv[i] = p.in[I_ADAW][(size_t)(r0 + 2 * i + rp) * (6 * D) + col];
#pragma unroll
        for (int i = 0; i < D / 16; ++i) {
            const int row = r0 + 2 * i + rp;
#pragma unroll
            for (int v = 0; v < NV; ++v) acc[v] += sil[v * D + row] * wv[i];
        }
#pragma unroll
        for (int v = 0; v < NV; ++v) red[((wave * 2 + rp) * NV + v) * 32 + (lane & 31)] = acc[v];
        __syncthreads();
        if (tid < NV * 32) {
            const int v = tid / 32, cl = tid % 32; float s = p.in[I_ADAB][it * 32 + cl];
            for (int g = 0; g < 16; ++g) s += red[(g * NV + v) * 32 + cl];
            ((float*)(p.ws + WS_MOD))[(size_t)v * 6 * D + it * 32 + cl] = s;
        }
    }
    __syncthreads();
    const int gw = blockIdx.x * 8 + wave, ngw = gridDim.x * 8; int base = 0;
    {
        float* scr = (float*)smem + wave * (64 * 33);
        const int nkb = D / 64, nnb = NP / 32, nitems2 = nkb * nnb;
        for (int it = gw; it < nitems2; it += ngw) { const int kb = it / nnb, nb = it % nnb; transpose_item(p.in[I_WIN], IN_COLS, IN_COLS, kb * 64, nb * 32, (bf16_t*)(p.aux + AUX_WINT), D, 0, scr, lane); }
        base = nitems2 % ngw;
    }
    { float* WRT = (float*)(p.ws + WS_WRT);
      for (int i = blockIdx.x * NTHREADS + tid; i < 36 * D; i += gridDim.x * NTHREADS) { const int j = i / D, k = i % D; WRT[i] = j < 4 ? p.in[I_RG][(size_t)k * 4 + j] : p.in[I_RE][(size_t)k * 32 + (j - 4)]; } }
    transpose_matrix(p.in[I_WOA], 512, D, D, (bf16_t*)(p.ws + WS_WOA), 0, smem, gw, ngw, base);
    transpose_matrix(p.in[I_WOB], 512, D, D, (bf16_t*)(p.ws + WS_WOB), 0, smem, gw, ngw, base);
    transpose_matrix(p.in[I_WOUT], D, D, D, (bf16_t*)(p.ws + WS_WOUT), 0, smem, gw, ngw, base);
    transpose_matrix(p.in[I_G2], 128, 512, 512, (bf16_t*)(p.ws + WS_G2T), 0, smem, gw, ngw, base);
}

constexpr int NSEG = T_ALL / 64, NSEG_CTX = T_CTX / 64;
DI void halo_store(const Params& p, int row, int col, const u32x2& o) {
    int seq, b, j;
    if (row < T_CTX) { seq = 0; b = row / CTXL; j = row % CTXL; } else { seq = 1; const int rr = row - T_CTX; b = rr / S; j = rr % S; }
    const int L = seq ? S : CTXL; const int segbase = seq ? NSEG_CTX + b * (S / 64) : b * (CTXL / 64);
    if (col < 1536) {
        const int jm = j & 63;
        if (jm >= 62 && j + 2 < L) { const int g = segbase + (j >> 6) + 1; *(u32x2*)((bf16_t*)(p.ws + WS_HALO_A) + ((size_t)g * 4 + (jm - 62)) * 1536 + col) = o; }
        if (jm < 2 && j >= 64) { const int g = segbase + (j >> 6) - 1; *(u32x2*)((bf16_t*)(p.ws + WS_HALO_A) + ((size_t)g * 4 + 2 + jm) * 1536 + col) = o; }
    } else if (col >= COL_B0 && col < COL_B0 + 1920) {
        const int js = seq ? (j % GW) * ROWS + j / GW : j; const int jm = js & 63;
        if (jm == 63 && js + 1 < L) { const int g = segbase + (js >> 6) + 1; *(u32x2*)((bf16_t*)(p.ws + WS_HALO_B) + ((size_t)g * 2 + 0) * 1920 + (col - COL_B0)) = o; }
        if (jm == 0 && js >= 64) { const int g = segbase + (js >> 6) - 1; *(u32x2*)((bf16_t*)(p.ws + WS_HALO_B) + ((size_t)g * 2 + 1) * 1920 + (col - COL_B0)) = o; }
    }
}
DI void halo_zero_fill(const Params& p) {
    const int tid = tid_x(), lane = tid & 63, wave = tid >> 6; const int gw = blockIdx.x * 8 + wave, ngw = gridDim.x * 8;
    bf16_t* HA = (bf16_t*)(p.ws + WS_HALO_A); bf16_t* HB = (bf16_t*)(p.ws + WS_HALO_B);
    for (int it = gw; it < NSEG * 2; it += ngw) {
        const int g = it >> 1, side = it & 1;
        const bool ctx = g < NSEG_CTX; const int sg = ctx ? g % (CTXL / 64) : (g - NSEG_CTX) % (S / 64); const int nsg = ctx ? CTXL / 64 : S / 64;
        const bool edge = side ? (sg == nsg - 1) : (sg == 0);
        if (!edge) continue;
        for (int c = lane; c < 384; c += 64) *(u32x4*)(HA + ((size_t)g * 4 + 2 * side) * 1536 + c * 8) = (u32x4){0u, 0u, 0u, 0u};
        for (int c = lane; c < 240; c += 64) *(u32x4*)(HB + ((size_t)g * 2 + side) * 1920 + c * 8) = (u32x4){0u, 0u, 0u, 0u};
    }
}
DI void phase1(const Params& p, char* smem) {
    if (USE_G8) halo_zero_fill(p);
    const int lane = tid_x() & 63, wave = tid_x() >> 6;
    const int gw = blockIdx.x * 8 + wave, ngw = gridDim.x * 8;
    const float* mod = (const float*)(p.ws + WS_MOD);
    bf16_t* U = (bf16_t*)(p.aux + AUX_U);
    auto rowsrc = [&](int r) -> const float* { return r < T_CTX ? p.in[I_CTX] + (size_t)r * D : p.in[I_X] + (size_t)(r - T_CTX) * D; };
    f32x4 xn[D / 256];
    if (gw < T_ALL) {
#pragma unroll
        for (int j = 0; j < D / 256; ++j) xn[j] = *(const f32x4*)(rowsrc(gw) + j * 256 + lane * 4);
    }
    for (int r = gw; r < T_ALL; r += ngw) {
        const int v = r < T_CTX ? NB : (r - T_CTX) / S;
        f32x4 x[D / 256]; float ss = 0.f;
#pragma unroll
        for (int j = 0; j < D / 256; ++j) { x[j] = xn[j]; ss += x[j].x * x[j].x + x[j].y * x[j].y + x[j].z * x[j].z + x[j].w * x[j].w; }
        if (r + ngw < T_ALL) {
#pragma unroll
            for (int j = 0; j < D / 256; ++j) xn[j] = *(const f32x4*)(rowsrc(r + ngw) + j * 256 + lane * 4);
        }
        ss = wave_sum_fast(ss);
        const float rstd = frsq(ss * (1.0f / D) + 1e-6f);
#pragma unroll
        for (int j = 0; j < D / 256; ++j) {
            const int k = j * 256 + lane * 4;
            const f32x4 g = *(const f32x4*)(p.in[I_NMIX] + k), sh = *(const f32x4*)(mod + (size_t)v * 6 * D + k), sc = *(const f32x4*)(mod + (size_t)v * 6 * D + D + k);
            float o0 = x[j].x * rstd * g.x * (1.f + sc.x) + sh.x, o1 = x[j].y * rstd * g.y * (1.f + sc.y) + sh.y;
            float o2 = x[j].z * rstd * g.z * (1.f + sc.z) + sh.z, o3 = x[j].w * rstd * g.w * (1.f + sc.w) + sh.w;
            u32x2 o; o.x = pk2(o0, o1); o.y = pk2(o2, o3);
            *(u32x2*)(U + (size_t)r * D + k) = o;
        }
    }
}

DI void phase2(const Params& p, char* smem) {
    const bf16_t* U = (const bf16_t*)(p.aux + AUX_U); const bf16_t* WT = (const bf16_t*)(p.aux + AUX_WINT);
    bf16_t* PL = (bf16_t*)(p.ws + WS_PLAT); bf16_t* PC = (bf16_t*)(p.ws + WS_PCTX); float* AB = (float*)(p.ws + WS_AB);
    if (USE_G8) {
        constexpr int NT = NP / 256, MT = T_ALL / 256, NT_CTX = (CTX_COLS + 255) / 256;
        for (int t = blockIdx.x; t < MT * NT; t += gridDim.x) {
            int mt, nt; if (!g8::tile_order(t, MT, NT, mt, nt)) break;
            const int brow = mt * 256, bcol = nt * 256; const bool isctx = brow < T_CTX;
            if (isctx && nt >= NT_CTX) continue;
            g8::Acc acc; g8::acc_zero(acc);
            g8::kloop(acc, smem, U, D, WT, D, D, brow, bcol);
            g8::for_each_quad(acc, brow, bcol, [&](int row, int col, const f32x4& v) {
                u32x2 o; o.x = pk2(v.x, v.y); o.y = pk2(v.z, v.w);
                if (isctx) { if (col < CTX_COLS) *(u32x2*)(PC + (size_t)row * CTX_COLS + col) = o; }
                else { if (col < IN_COLS) *(u32x2*)(PL + (size_t)(row - T_CTX) * IN_COLS + col) = o; }
                if (col >= 2048 && col < 2064) *(f32x4*)(AB + (size_t)row * 16 + (col - 2048)) = v;
                halo_store(p, row, col, o);
            });
        }
        return;
    }
    const int tid = tid_x(), lane = tid & 63, wave = tid >> 6, wr = wave >> 1, wc = wave & 1, fr = lane & 15, fq = lane >> 4;
    constexpr int NT = NP / 128, MT = T_ALL / BM, NT_CTX = (CTX_COLS + 127) / 128;
    for (int t = blockIdx.x; t < MT * NT; t += gridDim.x) {
        const int mt = t / NT, nt = t % NT; const int row0 = mt * BM; const bool isctx = row0 < T_CTX;
        if (isctx && nt >= NT_CTX) continue;
        f32x4 acc[MREP][4]; acc_zero(acc);
        gemm_kloop(acc, smem, [&](int i) { return U + (size_t)(row0 + i) * D; }, WT + (size_t)nt * 128 * D, D, D);
#pragma unroll
        for (int m = 0; m < MREP; ++m)
#pragma unroll
            for (int n = 0; n < 4; ++n)
#pragma unroll
                for (int j = 0; j < 4; ++j) {
                    const int row = row0 + wr * 16 * MREP + m * 16 + fq * 4 + j, col = nt * 128 + wc * 64 + n * 16 + fr; const float v = acc[m][n][j];
                    if (isctx) { if (col < CTX_COLS) PC[(size_t)row * CTX_COLS + col] = f2bf(v); }
                    else { if (col < IN_COLS) PL[(size_t)(row - T_CTX) * IN_COLS + col] = f2bf(v); }
                    if (col >= 2048 && col < 2064) AB[(size_t)row * 16 + (col - 2048)] = v;
                }
    }
}


DI int crow(int g, int h) { return (g & 3) + 8 * (g >> 2) + 4 * h; }
template <int S_> DI bf16x8 pack_acc(const f32x16& x) {
    u32x4 r;
    r.x = pk2(x[8 * S_ + 0], x[8 * S_ + 1]); r.y = pk2(x[8 * S_ + 2], x[8 * S_ + 3]); r.z = pk2(x[8 * S_ + 4], x[8 * S_ + 5]); r.w = pk2(x[8 * S_ + 6], x[8 * S_ + 7]);
    return __builtin_bit_cast(bf16x8, r);
}
DI bf16x8 ld_nat(const bf16_t* row, int s, int h) { return *(const bf16x8*)(row + 16 * s + 8 * h); }
DI bf16x8 ld_perm(const bf16_t* row, int s, int h) {
    const bf16x4 lo = *(const bf16x4*)(row + 16 * s + 4 * h), hi = *(const bf16x4*)(row + 16 * s + 8 + 4 * h);
    return __builtin_shufflevector(lo, hi, 0, 1, 2, 3, 4, 5, 6, 7);
}
DI f32x16 zero16() { f32x16 z;
#pragma unroll
    for (int i = 0; i < 16; ++i) z[i] = 0.f;
    return z; }
#define TGET(i) ((i) < 16 ? t0[(i) & 15] : t1[(i) & 15])
DI void invert32_col(const float* Lf, f32x16& t0, f32x16& t1, int c) {
#pragma unroll
    for (int i = 0; i < 32; ++i) {
        float s0 = 0.f, s1 = 0.f, s2 = 0.f, s3 = 0.f;
#pragma unroll
        for (int j4 = 0; j4 < (i + 3) / 4; ++j4) {
            const f32x4 l = *(const f32x4*)(Lf + i * 32 + 4 * j4);
            if (4 * j4 + 0 < i) s0 += l.x * TGET(4 * j4 + 0);
            if (4 * j4 + 1 < i) s1 += l.y * TGET(4 * j4 + 1);
            if (4 * j4 + 2 < i) s2 += l.z * TGET(4 * j4 + 2);
            if (4 * j4 + 3 < i) s3 += l.w * TGET(4 * j4 + 3);
        }
        float sm = -((s0 + s1) + (s2 + s3));
#ifndef EMU
        asm volatile("" : "+v"(sm));
#endif
        const float v = (i > c) ? sm : (i == c ? 1.f : 0.f);
        if (i < 16) t0[i & 15] = v; else t1[i & 15] = v;
    }
}

DI void seg_info(int g, int& seq, int& b, int& j0) {
    if (g < NSEG_CTX) { seq = 0; b = g / (CTXL / 64); j0 = (g % (CTXL / 64)) * 64; } else { const int g2 = g - NSEG_CTX; seq = 1; b = g2 / (S / 64); j0 = (g2 % (S / 64)) * 64; }
}
DI const bf16_t* seq_row(const Params& p, int seq, int b, int j, bool scan_order) {
    if (seq) { const int l = scan_order ? (j % ROWS) * GW + j / ROWS : j; return (const bf16_t*)(p.ws + WS_PLAT) + (size_t)(b * S + l) * IN_COLS; }
    return (const bf16_t*)(p.ws + WS_PCTX) + (size_t)(b * CTXL + j) * CTX_COLS;
}
DI void phase_halo(const Params& p, char* smem) {
    if (USE_G8) return;
    const int tid = tid_x(), lane = tid & 63, wave = tid >> 6;
    const int gw = blockIdx.x * 8 + wave, ngw = gridDim.x * 8;
    bf16_t* HA = (bf16_t*)(p.ws + WS_HALO_A); bf16_t* HB = (bf16_t*)(p.ws + WS_HALO_B);
    for (int it = gw; it < NSEG * 6; it += ngw) {
        const int g = it / 6, hr = it % 6; int seq, b, j0; seg_info(g, seq, b, j0);
        const int L = seq ? S : CTXL;
        if (hr < 4) {
            const int j = hr < 2 ? j0 - 2 + hr : j0 + 62 + hr; const bool ok = j >= 0 && j < L;
            const bf16_t* src = seq_row(p, seq, b, ok ? j : 0, false);
            for (int c = lane; c < 192; c += 64) { u32x4 v = {0u, 0u, 0u, 0u}; if (ok) v = *(const u32x4*)(src + c * 8); *(u32x4*)(HA + ((size_t)g * 4 + hr) * 1536 + c * 8) = v; }
        } else {
            const int j = hr == 4 ? j0 - 1 : j0 + 64; const bool ok = j >= 0 && j < L;
            const bf16_t* src = seq_row(p, seq, b, ok ? j : 0, true) + COL_B0;
            for (int c = lane; c < 240; c += 64) { u32x4 v = {0u, 0u, 0u, 0u}; if (ok) v = *(const u32x4*)(src + c * 8); *(u32x4*)(HB + ((size_t)g * 2 + (hr - 4)) * 1920 + c * 8) = v; }
        }
    }
}
DI f32x2_ac unpk2(unsigned w) { return (f32x2_ac){bf2f((bf16_t)(w & 0xffffu)), bf2f((bf16_t)(w >> 16))}; }
DI void unpack8(const u32x4& q, float (&f)[8]) {
    f[0] = bf2f((bf16_t)(q.x & 0xffffu)); f[1] = bf2f((bf16_t)(q.x >> 16)); f[2] = bf2f((bf16_t)(q.y & 0xffffu)); f[3] = bf2f((bf16_t)(q.y >> 16));
    f[4] = bf2f((bf16_t)(q.z & 0xffffu)); f[5] = bf2f((bf16_t)(q.z >> 16)); f[6] = bf2f((bf16_t)(q.w & 0xffffu)); f[7] = bf2f((bf16_t)(q.w >> 16));
}
DI float row16_sum(float v) {
#ifdef EMU
    v += __shfl_xor(v, 1); v += __shfl_xor(v, 2); v += __shfl_xor(v, 4); v += __shfl_xor(v, 8); return v;
#else
    v = DPP_ADD(v, 0xB1); v = DPP_ADD(v, 0x4E); v = DPP_ADD(v, 0x141); v = DPP_ADD(v, 0x140); return v;
#endif
}
DI void phase_fir(const Params& p, char* smem) {
    const int tid = tid_x(), lane = tid & 63, wave = tid >> 6;
    const int gw = blockIdx.x * 8 + wave, ngw = gridDim.x * 8;
    const bf16_t* HA = (const bf16_t*)(p.ws + WS_HALO_A); const bf16_t* HB = (const bf16_t*)(p.ws + WS_HALO_B);
    constexpr int NA = NSEG * 3, NBI = NSEG * 4;
    const u32x4 z4 = {0u, 0u, 0u, 0u};
    for (int it = gw; it < NA + NBI; it += ngw) {
        if (it < NA) {
            const int g = it / 3, s = it % 3; int seq, b, j0; seg_info(g, seq, b, j0);
            const int col = s * 512 + 8 * lane, ldp = seq ? IN_COLS : CTX_COLS;
            bf16_t* base = (bf16_t*)seq_row(p, seq, b, j0, false) + col;
            const bf16_t* hal = HA + (size_t)g * 4 * 1536 + col;
            float cw[5][8];
#pragma unroll
            for (int t = 0; t < 5; ++t) { const f32x4 w0 = *(const f32x4*)(p.in[I_CONV] + t * 1536 + col), w1 = *(const f32x4*)(p.in[I_CONV] + t * 1536 + col + 4);
                cw[t][0] = w0.x; cw[t][1] = w0.y; cw[t][2] = w0.z; cw[t][3] = w0.w; cw[t][4] = w1.x; cw[t][5] = w1.y; cw[t][6] = w1.z; cw[t][7] = w1.w; }
            u32x4 win[12], nxt[8];
            win[0] = *(const u32x4*)(hal); win[1] = *(const u32x4*)(hal + 1536);
            win[2] = *(const u32x4*)(base); win[3] = *(const u32x4*)(base + ldp);
#pragma unroll
            for (int i = 0; i < 8; ++i) win[4 + i] = *(const u32x4*)(base + (size_t)(2 + i) * ldp);
#pragma unroll 1
            for (int blk = 0; blk < 8; ++blk) {
                if (blk < 7) {
#pragma unroll
                    for (int i = 0; i < 8; ++i) { const int t = 8 * blk + 10 + i; nxt[i] = t < 64 ? *(const u32x4*)(base + (size_t)t * ldp) : *(const u32x4*)(hal + (size_t)(2 + (t - 64)) * 1536); }
                }
#pragma unroll
                for (int i = 0; i < 8; ++i) {
                    float a[8];
#pragma unroll
                    for (int e = 0; e < 8; ++e) a[e] = 0.f;
#pragma unroll
                    for (int t = 0; t < 5; ++t) { float x[8]; unpack8(win[i + t], x);
#pragma unroll
                        for (int e = 0; e < 8; ++e) a[e] += x[e] * cw[t][e]; }
                    float ss = 0.f;
#pragma unroll
                    for (int e = 0; e < 8; ++e) { a[e] = fsilu(a[e]); ss += a[e] * a[e]; }
                    if (s < 2) { const float sc = frsq(row16_sum(ss) + 1e-6f) * (s == 0 ? 0.08838834764831845f : 1.0f);
#pragma unroll
                        for (int e = 0; e < 8; ++e) a[e] *= sc; }
                    u32x4 o; o.x = pk2(a[0], a[1]); o.y = pk2(a[2], a[3]); o.z = pk2(a[4], a[5]); o.w = pk2(a[6], a[7]);
                    *(u32x4*)(base + (size_t)(8 * blk + i) * ldp) = o;
                }
#pragma unroll
                for (int i = 0; i < 4; ++i) win[i] = win[8 + i];
#pragma unroll
                for (int i = 0; i < 8; ++i) win[4 + i] = nxt[i];
            }
        } else {
            const int it2 = it - NA, g = it2 / 4, sl = it2 % 4; int seq, b, j0; seg_info(g, seq, b, j0);
            const int bcol = sl * 512 + 8 * lane; const bool act = bcol < 1920;
            const int bc = act ? bcol : 0, col = COL_B0 + bc;
            float mu8[8];
            { const f32x4 m0 = *(const f32x4*)(p.in[I_MU] + bc), m1 = *(const f32x4*)(p.in[I_MU] + bc + 4); mu8[0] = m0.x; mu8[1] = m0.y; mu8[2] = m0.z; mu8[3] = m0.w; mu8[4] = m1.x; mu8[5] = m1.y; mu8[6] = m1.z; mu8[7] = m1.w; }
            const bool th = (bc >= 1536 && bc < 1664);
            const bf16_t* hal = HB + (size_t)g * 2 * 1920 + bc;
            u32x4 win[10], nxt[8];
            win[0] = *(const u32x4*)(hal); win[1] = *(const u32x4*)(seq_row(p, seq, b, j0, true) + col);
#pragma unroll
            for (int i = 0; i < 8; ++i) win[2 + i] = *(const u32x4*)(seq_row(p, seq, b, j0 + 1 + i, true) + col);
#pragma unroll 1
            for (int blk = 0; blk < 8; ++blk) {
                if (blk < 7) {
#pragma unroll
                    for (int i = 0; i < 8; ++i) { const int t = 8 * blk + 9 + i; nxt[i] = t < 64 ? *(const u32x4*)(seq_row(p, seq, b, j0 + t, true) + col) : *(const u32x4*)(hal + 1920); }
                }
#pragma unroll
                for (int i = 0; i < 8; ++i) {
                    float pv[8], cu[8], nx[8], x[8]; unpack8(win[i], pv); unpack8(win[i + 1], cu); unpack8(win[i + 2], nx);
#pragma unroll
                    for (int e = 0; e < 8; ++e) { x[e] = cu[e] + (0.5f * (pv[e] + nx[e]) - cu[e]) * mu8[e]; if (th) x[e] = ftanh(x[e]); }
                    u32x4 o; o.x = pk2(x[0], x[1]); o.y = pk2(x[2], x[3]); o.z = pk2(x[4], x[5]); o.w = pk2(x[6], x[7]);
                    if (act) *(u32x4*)((bf16_t*)seq_row(p, seq, b, j0 + 8 * blk + i, true) + col) = o;
                }
                win[0] = win[8]; win[1] = win[9];
#pragma unroll
                for (int i = 0; i < 8; ++i) win[2 + i] = nxt[i];
            }
        }
    }
}

constexpr int GC = 32;
constexpr int G_NT = (CTXL + S) / GC;
constexpr int LD128 = 136, LD64 = 72, LD32 = 40;
DI void chunk_pos(int x, int d, int& seg, int& j0) {
    constexpr int n0 = CTXL / GC, n1 = S / GC;
    if (x < n0) { seg = 0; j0 = (d ? n0 - 1 - x : x) * GC; } else { seg = 1; const int xx = x - n0; j0 = (d ? n1 - 1 - xx : xx) * GC; }
}

template <class Emit>
DI void invert32_blocked(const float* Lf, bf16_t* scr, int lane, Emit emit) {
    bf16_t* T00T = scr; bf16_t* T11R = scr + 16 * LD32; bf16_t* L10R = scr + 2 * 16 * LD32; bf16_t* P1T = scr + 3 * 16 * LD32;
    const int blk = lane >> 5, c = lane & 15, r = lane & 31, fr = lane & 15, fq = lane >> 4;
    f32x16 t;
    const float* Lb = Lf + (16 * blk) * 32 + 16 * blk;
#pragma unroll
    for (int i = 0; i < 16; ++i) {
        float s0 = 0.f, s1 = 0.f, s2 = 0.f, s3 = 0.f;
#pragma unroll
        for (int j4 = 0; j4 < (i + 3) / 4; ++j4) {
            const f32x4 l = *(const f32x4*)(Lb + i * 32 + 4 * j4);
            if (4 * j4 + 0 < i) s0 += l.x * t[4 * j4 + 0];
            if (4 * j4 + 1 < i) s1 += l.y * t[4 * j4 + 1];
            if (4 * j4 + 2 < i) s2 += l.z * t[4 * j4 + 2];
            if (4 * j4 + 3 < i) s3 += l.w * t[4 * j4 + 3];
        }
        float sm = -((s0 + s1) + (s2 + s3));
#ifndef EMU
        asm volatile("" : "+v"(sm));
#endif
        t[i] = (i > c) ? sm : (i == c ? 1.f : 0.f);
    }
    if (r < 16) {
        if (blk == 0) {
#pragma unroll
            for (int q = 0; q < 4; ++q) { u32x2 o; o.x = pk2(t[4 * q], t[4 * q + 1]); o.y = pk2(t[4 * q + 2], t[4 * q + 3]); *(u32x2*)(T00T + c * LD32 + 4 * q) = o; }
        } else {
#pragma unroll
            for (int i = 0; i < 16; ++i) T11R[i * LD32 + c] = f2bf(t[i]);
        }
    }
    { const int i = lane >> 2, j4 = (lane & 3) * 4; const f32x4 l = *(const f32x4*)(Lf + (16 + i) * 32 + j4);
      u32x2 o; o.x = pk2(l.x, l.y); o.y = pk2(l.z, l.w); *(u32x2*)(L10R + i * LD32 + j4) = o; }
    WAVE_SYNC();
    const bf16x8 zf = {0, 0, 0, 0, 0, 0, 0, 0};
    f32x4 p1 = {0.f, 0.f, 0.f, 0.f};
    {
        const bf16x8 af = fq < 2 ? *(const bf16x8*)(L10R + fr * LD32 + 8 * fq) : zf, bfm = fq < 2 ? *(const bf16x8*)(T00T + fr * LD32 + 8 * fq) : zf;
        p1 = MFMA16(af, bfm, p1);
    }
    { u32x2 o; o.x = pk2(p1[0], p1[1]); o.y = pk2(p1[2], p1[3]); *(u32x2*)(P1T + fr * LD32 + 4 * fq) = o; }
    WAVE_SYNC();
    f32x4 p2 = {0.f, 0.f, 0.f, 0.f};
    {
        const bf16x8 af = fq < 2 ? *(const bf16x8*)(T11R + fr * LD32 + 8 * fq) : zf, bfm = fq < 2 ? *(const bf16x8*)(P1T + fr * LD32 + 8 * fq) : zf;
        p2 = MFMA16(af, bfm, p2);
    }
#pragma unroll
    for (int j = 0; j < 4; ++j) emit(16 + 4 * fq + j, fr, -p2[j]);
    if (r < 16) {
#pragma unroll
        for (int i = 0; i < 16; ++i) { emit(16 * blk + i, 16 * blk + c, t[i]); if (blk == 0) emit(i, 16 + c, 0.f); }
    }
}
constexpr int GL_Q = 0;
constexpr int GL_KT = GL_Q + 2 * 32 * LD128 * 2;
constexpr int GL_VT = GL_KT + 2 * 128 * LD32 * 2;
constexpr int GL_K = GL_VT + 2 * 128 * LD32 * 2;
constexpr int GL_QKM = GL_K + 32 * LD128 * 2;
constexpr int GL_LF = GL_QKM + 2 * 32 * LD32 * 2;
constexpr int GL_TP = GL_LF + 32 * 32 * 4;
constexpr int GL_TPP = GL_TP + 32 * LD32 * 2;
constexpr int GL_WN = GL_TPP + 2 * 32 * LD32 * 2;
constexpr int GL_SC = GL_WN + 32 * LD128 * 2;
constexpr int GL_GC = GL_SC + 2 * 8 * 32 * 4;
constexpr int GL_CW = GL_GC + 8 * 32 * 4;
constexpr int GL_INV = GL_CW + 5 * 3 * 128 * 4;
constexpr int GL_RAW = GL_INV + 4 * 32 * LD32 * 2;
constexpr int GL_END = GL_RAW + 32 * 384 * 2;
static_assert(GL_END <= LDS_BYTES, "gdn lds");

DI void gdn_chain2(const Params& p, char* smem, int item) {
    const int d = item / (NB * H_A), b = (item / H_A) % NB, h = item % H_A;
    const int tid = tid_x(), lane = tid & 63, wave0_ = tid >> 6;
    bf16_t* Qs = (bf16_t*)(smem + GL_Q); bf16_t* KTs = (bf16_t*)(smem + GL_KT); bf16_t* VTs = (bf16_t*)(smem + GL_VT); bf16_t* Ks = (bf16_t*)(smem + GL_K);
    bf16_t* QKMs = (bf16_t*)(smem + GL_QKM); float* Lf = (float*)(smem + GL_LF); bf16_t* Tp = (bf16_t*)(smem + GL_TP); bf16_t* Tpp = (bf16_t*)(smem + GL_TPP);
    bf16_t* Wn = (bf16_t*)(smem + GL_WN); float* SC = (float*)(smem + GL_SC); float* GCs = (float*)(smem + GL_GC); float* CW = (float*)(smem + GL_CW);
    const float alog = p.in[I_ALOG][d * 4 + h], dtb = p.in[I_DTB][d * 4 + h], negea = -expf(alog);
    bf16_t* ODIR = (bf16_t*)(p.aux + AUX_ODIR);
    __syncthreads();
    f32x16 St[4];
#pragma unroll
    for (int ct = 0; ct < 4; ++ct) St[ct] = zero16();
    bf16_t* RAW = (bf16_t*)(smem + GL_RAW);
    float pa = 0.f, pbt = 0.f;
    auto prefetch = [&](int x, int wsel, int nw) {
        int seg, j0; chunk_pos(x, d, seg, j0);
        const int ldp = seg ? IN_COLS : CTX_COLS;
        const bf16_t* pbase = seg ? (const bf16_t*)(p.ws + WS_PLAT) + (size_t)b * S * IN_COLS : (const bf16_t*)(p.ws + WS_PCTX) + (size_t)b * CTXL * CTX_COLS;
        for (int inst = wsel; inst < 24; inst += nw) {
            const int q = inst * 64 + lane, row = q / 48, c16 = q % 48;
            const bf16_t* src = pbase + (size_t)(j0 + row) * ldp + (c16 >> 4) * 512 + h * 128 + (c16 & 15) * 8;
#ifdef EMU
            emu_global_load_lds16(src, (char*)RAW + q * 16);
#else
            __builtin_amdgcn_global_load_lds((const unsigned*)src, (__attribute__((address_space(3))) unsigned*)((char*)RAW + q * 16), 16, 0, 0);
#endif
        }
    };
    auto prefetch_ab = [&](int x) {
        int seg, j0; chunk_pos(x, d, seg, j0);
        const float* abbase = (const float*)(p.ws + WS_AB) + (size_t)(seg ? T_CTX + b * S : b * CTXL) * 16;
        const int jw = j0 + 4 * wave0_;
        if (lane < 4) { pa = abbase[(size_t)(jw + lane) * 16 + d * 4 + h]; pbt = abbase[(size_t)(jw + lane) * 16 + 8 + d * 4 + h]; }
    };
    prefetch(0, wave0_, 8); prefetch_ab(0);
#ifndef EMU
    asm volatile("s_waitcnt vmcnt(0)" ::: "memory");
#endif
    const int r0_ = lane & 31, hh0_ = lane >> 5;
    __syncthreads();
    for (int it = -1; it < G_NT; ++it) {
        int r = r0_, hh = hh0_, wave = wave0_;
#ifndef EMU
        asm volatile("" : "+v"(r), "+v"(hh), "+v"(wave));
#endif
        const int xn = it + 1, par = xn & 1;
        int segn = 0, j0n = 0; if (xn < G_NT) chunk_pos(xn, d, segn, j0n);
        if (xn < G_NT) {
            const int i0 = d ? (GC - 4 - 4 * wave) : 4 * wave;
            bf16_t kt[2][4], vt[2][4];
#pragma unroll
            for (int t = 0; t < 4; ++t) {
                const int e = d ? 3 - t : t, i = i0 + e;
                const unsigned wq = *(const unsigned*)(RAW + (4 * wave + t) * 384 + 2 * lane), wk = *(const unsigned*)(RAW + (4 * wave + t) * 384 + 128 + 2 * lane), wv = *(const unsigned*)(RAW + (4 * wave + t) * 384 + 256 + 2 * lane);
                *(unsigned*)(Qs + (par * 32 + i) * LD128 + 2 * lane) = wq;
                *(unsigned*)(Ks + i * LD128 + 2 * lane) = wk;
                kt[0][e] = (bf16_t)(wk & 0xffffu); kt[1][e] = (bf16_t)(wk >> 16); vt[0][e] = (bf16_t)(wv & 0xffffu); vt[1][e] = (bf16_t)(wv >> 16);
            }
#pragma unroll
            for (int q = 0; q < 2; ++q) {
                u32x2 o; o.x = (unsigned)kt[q][0] | ((unsigned)kt[q][1] << 16); o.y = (unsigned)kt[q][2] | ((unsigned)kt[q][3] << 16);
                *(u32x2*)(KTs + (par * 128 + 2 * lane + q) * LD32 + i0) = o;
                u32x2 o2; o2.x = (unsigned)vt[q][0] | ((unsigned)vt[q][1] << 16); o2.y = (unsigned)vt[q][2] | ((unsigned)vt[q][3] << 16);
                *(u32x2*)(VTs + (par * 128 + 2 * lane + q) * LD32 + i0) = o2;
            }
            if (lane < 4) { const int i = d ? (GC - 1 - 4 * wave - lane) : (4 * wave + lane);
                SC[(par * 8 + 0) * 32 + i] = negea * fsoftplus(pa + dtb); SC[(par * 8 + 1) * 32 + i] = fsigmoid(pbt); }
            if (xn + 1 < G_NT) prefetch_ab(xn + 1);
        }
        LDS_BARRIER();
        if (wave >= 4 && wave < 7 && xn + 1 < G_NT) {
            prefetch(xn + 1, wave - 4, 3);
#ifndef EMU
            asm volatile("s_waitcnt vmcnt(0)" ::: "memory");
#endif
        }
        if (xn < G_NT) {
            const float* graw = SC + (par * 8 + 0) * 32;
            float gcv = 0.f;
#pragma unroll
            for (int s4 = 0; s4 < 8; ++s4) { const f32x4 g4 = *(const f32x4*)(graw + 4 * s4);
                gcv += (4 * s4 + 0 <= r ? g4.x : 0.f) + (4 * s4 + 1 <= r ? g4.y : 0.f) + (4 * s4 + 2 <= r ? g4.z : 0.f) + (4 * s4 + 3 <= r ? g4.w : 0.f); }
            if (lane < 32) GCs[wave * 32 + r] = gcv;
            if (wave == 7 && lane < 32) {
                float gl = 0.f;
#pragma unroll
                for (int s4 = 0; s4 < 8; ++s4) { const f32x4 g4 = *(const f32x4*)(graw + 4 * s4); gl += (g4.x + g4.y) + (g4.z + g4.w); }
                const float be = SC[(par * 8 + 1) * 32 + r];
                SC[(par * 8 + 3) * 32 + r] = fexp(gcv); SC[(par * 8 + 4) * 32 + r] = fexp(gl - gcv); SC[(par * 8 + 5) * 32 + r] = be * fexp(gcv); SC[(par * 8 + 6) * 32 + r] = fexp(gl);
            }
            const int pr = wave >> 2, th = (wave >> 1) & 1, ch = wave & 1, fr = lane & 15, fq = lane >> 4;
            const bf16_t* arow = (pr == 0 ? Ks : Qs + par * 32 * LD128) + (16 * th + fr) * LD128 + 8 * fq; const bf16_t* brow = Ks + (16 * ch + fr) * LD128 + 8 * fq;
            f32x4 cc = {0.f, 0.f, 0.f, 0.f};
#pragma unroll
            for (int ks = 0; ks < 4; ++ks) cc = MFMA16(*(const bf16x8*)(arow + 32 * ks), *(const bf16x8*)(brow + 32 * ks), cc);
            WAVE_SYNC();
            const int jj = 16 * ch + fr; const float gj = GCs[wave * 32 + jj];
#pragma unroll
            for (int j = 0; j < 4; ++j) {
                const int i = 16 * th + 4 * fq + j; const float dec = fexp(GCs[wave * 32 + i] - gj);
                if (pr == 0) Lf[i * 32 + jj] = (jj < i) ? SC[(par * 8 + 1) * 32 + i] * cc[j] * dec : 0.f;
                else QKMs[(par * 32 + i) * LD32 + jj] = f2bf((jj <= i) ? cc[j] * dec : 0.f);
            }
        }
        LDS_BARRIER();
        if (wave == 7 && xn < G_NT) {
            const float* sb1 = SC + (par * 8 + 5) * 32; const float* sb0 = SC + (par * 8 + 1) * 32; bf16_t* Tppw = Tpp + par * 32 * LD32;
            invert32_blocked(Lf, (bf16_t*)(smem + GL_INV), lane, [&](int i, int c, float v) { Tp[i * LD32 + c] = f2bf(v * sb1[c]); Tppw[i * LD32 + c] = f2bf(v * sb0[c]); });
        }
        if (wave < 4 && it >= 0) {
            const int pc = it & 1; int seg = 0, j0 = 0; chunk_pos(it, d, seg, j0);
            const bf16_t* Qc = Qs + pc * 32 * LD128; const bf16_t* KTc = KTs + pc * 128 * LD32; const bf16_t* VTc = VTs + pc * 128 * LD32;
            const bf16_t* QKc = QKMs + pc * 32 * LD32; const bf16_t* Tc = Tpp + pc * 32 * LD32; const float* sc = SC + pc * 8 * 32;
            f32x16 vn = zero16();
#pragma unroll
            for (int s = 0; s < 2; ++s) vn = MFMA32(ld_nat(Tc + r * LD32, s, hh), ld_nat(VTc + (32 * wave + r) * LD32, s, hh), vn);
            f32x16 oacc = zero16();
#define GDN_KSTEP(s) { const bf16x8 sb = pack_acc<(s) & 1>(St[(s) >> 1]); vn = MFMA32(ld_perm(Wn + r * LD128, (s), hh), sb, vn); oacc = MFMA32(ld_perm(Qc + r * LD128, (s), hh), sb, oacc); }
            GDN_KSTEP(0) GDN_KSTEP(1) GDN_KSTEP(2) GDN_KSTEP(3) GDN_KSTEP(4) GDN_KSTEP(5) GDN_KSTEP(6) GDN_KSTEP(7)
#undef GDN_KSTEP
#pragma unroll
            for (int g = 0; g < 16; ++g) oacc[g] *= sc[3 * 32 + crow(g, hh)];
            { const bf16x8 v0 = pack_acc<0>(vn), v1 = pack_acc<1>(vn);
              oacc = MFMA32(ld_perm(QKc + r * LD32, 0, hh), v0, oacc); oacc = MFMA32(ld_perm(QKc + r * LD32, 1, hh), v1, oacc); }
#pragma unroll
            for (int g = 0; g < 16; ++g) vn[g] *= sc[4 * 32 + crow(g, hh)];
            const float ge = sc[6 * 32];
            { const bf16x8 v0 = pack_acc<0>(vn), v1 = pack_acc<1>(vn);
#pragma unroll
              for (int ct = 0; ct < 4; ++ct) {
#pragma unroll
                  for (int g = 0; g < 16; ++g) St[ct][g] *= ge;
                  St[ct] = MFMA32(ld_perm(KTc + (32 * ct + r) * LD32, 0, hh), v0, St[ct]);
                  St[ct] = MFMA32(ld_perm(KTc + (32 * ct + r) * LD32, 1, hh), v1, St[ct]);
              } }
            if (seg) {
#pragma unroll
                for (int g = 0; g < 16; ++g) {
                    const int i = crow(g, hh), j = d ? j0 + GC - 1 - i : j0 + i;
                    ODIR[((size_t)d * T_LAT + (size_t)b * S + j) * 512 + h * 128 + 32 * wave + r] = f2bf(oacc[g]);
                }
            }
        }
        LDS_BARRIER();
        if (xn < G_NT && wave < 4) {
            f32x16 acc = zero16();
#pragma unroll
            for (int s = 0; s < 2; ++s) acc = MFMA32(ld_nat(KTs + (par * 128 + 32 * wave + r) * LD32, s, hh), ld_nat(Tp + r * LD32, s, hh), acc);
#pragma unroll
            for (int q = 0; q < 4; ++q) {
                u32x2 o; o.x = pk2(-acc[4 * q], -acc[4 * q + 1]); o.y = pk2(-acc[4 * q + 2], -acc[4 * q + 3]);
                *(u32x2*)(Wn + r * LD128 + 32 * wave + 8 * q + 4 * hh) = o;
            }
        }
        LDS_BARRIER();
    }
}

constexpr int RL_RX = 0;
constexpr int RL_KX = RL_RX + 32 * 64 * 4;
constexpr int RL_VX = RL_KX + 32 * 64 * 4;
constexpr int RL_KK = RL_VX + 32 * 64 * 4;
constexpr int RL_LW = RL_KK + 32 * 64 * 4;
constexpr int RL_IC = RL_LW + 32 * 64 * 4;
constexpr int RL_PC = RL_IC + 32 * 64 * 4;
constexpr int RL_CST = RL_PC + 2 * 64 * 4;
constexpr int RL_TW = RL_CST + 4 * 64 * 4;
constexpr int RL_AL = RL_TW + 32 * LD64 * 2;
constexpr int RL_LF = RL_TW;
constexpr int RL_LAKT = RL_LF + 32 * 32 * 4;
constexpr int RL_TB = RL_LAKT + 32 * LD32 * 2;
static_assert(RL_TB + 32 * LD32 * 2 <= RL_AL + 32 * LD64 * 2, "overlay");
constexpr int RL_W2T = RL_AL + 32 * LD64 * 2;
constexpr int RL_A2T = RL_W2T + 64 * LD64 * 2;
constexpr int RL_AR = RL_A2T + 64 * LD64 * 2;
constexpr int RL_BR = RL_AR + 32 * LD64 * 2;
constexpr int RL_KR = RL_BR + 32 * LD64 * 2;
constexpr int RL_RR = RL_KR + 32 * LD64 * 2;
constexpr int RL_AT = RL_RR + 2 * 32 * LD64 * 2;
constexpr int RL_BHT = RL_AT + 64 * LD32 * 2;
constexpr int RL_KHT = RL_BHT + 2 * 64 * LD32 * 2;
constexpr int RL_VT = RL_KHT + 2 * 64 * LD32 * 2;
constexpr int RL_MRB = RL_VT + 2 * 64 * LD32 * 2;
constexpr int RL_MRK = RL_MRB + 2 * 32 * LD32 * 2;
constexpr int RL_WM = RL_MRK + 2 * 32 * LD32 * 2;
constexpr int RL_TL = RL_WM + 32 * LD64 * 2;
constexpr int RL_END = RL_TL + 32 * LD32 * 2;
static_assert(RL_END <= LDS_BYTES, "rwkv lds");

DI void rwkv_chain2(const Params& p, char* smem, int item) {
    const int d = item / (NB * H_B), b = (item / H_B) % NB, h = item % H_B;
    const int tid = tid_x(), lane = tid & 63, wave = tid >> 6;
    float* RX = (float*)(smem + RL_RX); float* KX = (float*)(smem + RL_KX); float* VX = (float*)(smem + RL_VX); float* KKs = (float*)(smem + RL_KK);
    float* LW = (float*)(smem + RL_LW); float* IC = (float*)(smem + RL_IC); float* Lf = (float*)(smem + RL_LF); float* PC = (float*)(smem + RL_PC); float* CST = (float*)(smem + RL_CST);
    bf16_t* TW = (bf16_t*)(smem + RL_TW); bf16_t* AL = (bf16_t*)(smem + RL_AL); bf16_t* W2T = (bf16_t*)(smem + RL_W2T); bf16_t* A2T = (bf16_t*)(smem + RL_A2T);
    bf16_t* Ar = (bf16_t*)(smem + RL_AR); bf16_t* Br = (bf16_t*)(smem + RL_BR); bf16_t* Kr = (bf16_t*)(smem + RL_KR); bf16_t* Rr = (bf16_t*)(smem + RL_RR);
    bf16_t* AT = (bf16_t*)(smem + RL_AT); bf16_t* BhT = (bf16_t*)(smem + RL_BHT); bf16_t* KhT = (bf16_t*)(smem + RL_KHT); bf16_t* VT = (bf16_t*)(smem + RL_VT);
    bf16_t* LakT = (bf16_t*)(smem + RL_LAKT); bf16_t* Mrb = (bf16_t*)(smem + RL_MRB); bf16_t* Mrk = (bf16_t*)(smem + RL_MRK); bf16_t* Tb = (bf16_t*)(smem + RL_TB);
    bf16_t* Wm = (bf16_t*)(smem + RL_WM); bf16_t* TLm = (bf16_t*)(smem + RL_TL);
    bf16_t* YDIR = (bf16_t*)(p.aux + AUX_YDIR); float* BON = (float*)(p.ws + WS_BONUS);
    __syncthreads();
    for (int i = tid; i < 64 * 64; i += NTHREADS) {
        const int c = i >> 6, rr = i & 63;
        W2T[c * LD64 + rr] = f2bf(p.in[I_W2][((size_t)d * 64 + rr) * 512 + h * 64 + c]); A2T[c * LD64 + rr] = f2bf(p.in[I_A2][((size_t)d * 64 + rr) * 512 + h * 64 + c]);
    }
    if (tid < 256) { const int w = tid >> 6, c = tid & 63, gc = h * 64 + c;
        CST[tid] = w == 0 ? p.in[I_W0][d * 512 + gc] : (w == 1 ? p.in[I_A0][d * 512 + gc] : (w == 2 ? p.in[I_KA][gc] : p.in[I_RK][gc])); }
    const float kkw = p.in[I_KK][h * 64 + lane];
    f32x16 Xt[2]; Xt[0] = zero16(); Xt[1] = zero16();
    bf16_t rawv[4][5];
    auto prefetch = [&](int x) {
        int seg, j0; chunk_pos(x, d, seg, j0);
        const int ldp = seg ? IN_COLS : CTX_COLS;
        const bf16_t* pb = seg ? (const bf16_t*)(p.ws + WS_PLAT) + (size_t)b * S * IN_COLS : (const bf16_t*)(p.ws + WS_PCTX) + (size_t)b * CTXL * CTX_COLS;
        const int jw = j0 + 4 * wave;
#pragma unroll
        for (int rr = 0; rr < 4; ++rr) {
            const int j = jw + rr; const int row = seg ? (j % ROWS) * GW + j / ROWS : j;
#pragma unroll
            for (int s = 0; s < 5; ++s) {
                const int bcol = (s < 3 ? s * 512 + h * 64 : (s == 3 ? 1536 + d * 64 : 1664 + d * 64)) + lane;
                rawv[rr][s] = pb[(size_t)row * ldp + COL_B0 + bcol];
            }
        }
    };
    prefetch(0);
    const int r0_ = lane & 31, hh0_ = lane >> 5;
    __syncthreads();
    for (int it = -1; it < G_NT; ++it) {
        int r = r0_, hh = hh0_;
#ifndef EMU
        asm volatile("" : "+v"(r), "+v"(hh));
#endif
        const int xn = it + 1, par = xn & 1;
        int segn = 0, j0n = 0; if (xn < G_NT) chunk_pos(xn, d, segn, j0n);
        if (xn < G_NT) {
#pragma unroll
            for (int t = 0; t < 4; ++t) {
                const int i = d ? (GC - 1 - 4 * wave - t) : (4 * wave + t);
                const float xr = bf2f(rawv[t][0]), xk = bf2f(rawv[t][1]), xv = bf2f(rawv[t][2]);
                const float kxk = xk * kkw; const float ss = wave_sum_fast(kxk * kxk);
                RX[i * 64 + lane] = xr; KX[i * 64 + lane] = xk; VX[i * 64 + lane] = xv; KKs[i * 64 + lane] = kxk * frsq(ss + 1e-6f);
                TW[i * LD64 + lane] = rawv[t][3]; AL[i * LD64 + lane] = rawv[t][4];
            }
            if (xn + 1 < G_NT) prefetch(xn + 1);
        }
        LDS_BARRIER();
        if (xn < G_NT) {
            const int which = wave >> 2, cg = wave & 3, fr = lane & 15, fq = lane >> 4;
            const bf16_t* arow0 = (which ? AL : TW) + fr * LD64 + 8 * fq; const bf16_t* brow = (which ? A2T : W2T) + (16 * cg + fr) * LD64 + 8 * fq;
            f32x4 c0 = {0.f, 0.f, 0.f, 0.f}, c1 = {0.f, 0.f, 0.f, 0.f};
#pragma unroll
            for (int ks = 0; ks < 2; ++ks) {
                const bf16x8 bfrag = *(const bf16x8*)(brow + 32 * ks);
                c0 = MFMA16(*(const bf16x8*)(arow0 + 32 * ks), bfrag, c0); c1 = MFMA16(*(const bf16x8*)(arow0 + 16 * LD64 + 32 * ks), bfrag, c1);
            }
            const int c = 16 * cg + fr; const float bias = CST[which * 64 + c];
#pragma unroll
            for (int th = 0; th < 2; ++th)
#pragma unroll
                for (int j = 0; j < 4; ++j) {
                    const int i = 16 * th + 4 * fq + j; const float z = bias + (th ? c1[j] : c0[j]);
                    if (which) IC[i * 64 + c] = fsigmoid(z);
                    else { const float wl = -fsoftplus(-z) - 0.5f; LW[i * 64 + c] = -fexp(wl); }
                }
        }
        LDS_BARRIER();
        if (xn < G_NT) {
            const int c = lane, i0 = 4 * wave;
            const float ka = CST[2 * 64 + c], rk = CST[3 * 64 + c];
            float lpb = 0.f, lpc = 0.f; float lw4[4];
#pragma unroll
            for (int s2 = 0; s2 < 32; ++s2) { const float w = LW[s2 * 64 + c]; lpc += w; if (s2 < i0) lpb += w; }
#pragma unroll
            for (int e = 0; e < 4; ++e) lw4[e] = LW[(i0 + e) * 64 + c];
            bf16_t ta[4], tb[4], tk[4], tv[4]; float bon[4];
            float lprun = lpb;
#pragma unroll
            for (int e = 0; e < 4; ++e) {
                const int i = i0 + e;
                const float lpm = lprun; lprun += lw4[e]; const float lp = lprun;
                const float Pi = fexp(lp), Pm = fexp(lpm), invP = fexp(-lp), PCi = fexp(lpc - lp);
                const float ic = IC[i * 64 + c], kxv = KX[i * 64 + c], kkv = KKs[i * 64 + c], rxv = RX[i * 64 + c], vxv = VX[i * 64 + c];
                const float kd = kxv * (1.f + (ic - 1.f) * ka), bb = kkv * ic, aa = -kkv;
                ta[e] = f2bf(aa * Pm); tb[e] = f2bf(bb * PCi); tk[e] = f2bf(kd * PCi); tv[e] = f2bf(vxv);
                Ar[i * LD64 + c] = ta[e]; Br[i * LD64 + c] = f2bf(bb * invP); Kr[i * LD64 + c] = f2bf(kd * invP); Rr[(par * 32 + i) * LD64 + c] = f2bf(rxv * Pi);
                bon[e] = wave_sum_fast(rxv * kd * rk);
            }
            { u32x2 o; o.x = (unsigned)ta[0] | ((unsigned)ta[1] << 16); o.y = (unsigned)ta[2] | ((unsigned)ta[3] << 16); *(u32x2*)(AT + c * LD32 + i0) = o; }
            { u32x2 o; o.x = (unsigned)tb[0] | ((unsigned)tb[1] << 16); o.y = (unsigned)tb[2] | ((unsigned)tb[3] << 16); *(u32x2*)(BhT + (par * 64 + c) * LD32 + i0) = o; }
            { u32x2 o; o.x = (unsigned)tk[0] | ((unsigned)tk[1] << 16); o.y = (unsigned)tk[2] | ((unsigned)tk[3] << 16); *(u32x2*)(KhT + (par * 64 + c) * LD32 + i0) = o; }
            { u32x2 o; o.x = (unsigned)tv[0] | ((unsigned)tv[1] << 16); o.y = (unsigned)tv[2] | ((unsigned)tv[3] << 16); *(u32x2*)(VT + (par * 64 + c) * LD32 + i0) = o; }
            if (wave == 7) PC[par * 64 + c] = fexp(lpc);
            if (segn && lane < 4) { const int i = i0 + lane, jj = d ? j0n + GC - 1 - i : j0n + i;
                const float bv = lane == 0 ? bon[0] : (lane == 1 ? bon[1] : (lane == 2 ? bon[2] : bon[3]));
                BON[((size_t)d * T_LAT + (size_t)b * S + (jj % ROWS) * GW + jj / ROWS) * 8 + h] = bv; }
        }
        LDS_BARRIER();
        if (xn < G_NT) {
            const int m = wave >> 1, th = wave & 1, fr = lane & 15, fq = lane >> 4;
            const bf16_t* arow = ((m < 2) ? Ar : Rr + par * 32 * LD64) + (16 * th + fr) * LD64 + 8 * fq; const bf16_t* brow = ((m & 1) ? Kr : Br) + fr * LD64 + 8 * fq;
            f32x4 c0 = {0.f, 0.f, 0.f, 0.f}, c1 = {0.f, 0.f, 0.f, 0.f};
#pragma unroll
            for (int ks = 0; ks < 2; ++ks) {
                const bf16x8 afrag = *(const bf16x8*)(arow + 32 * ks);
                c0 = MFMA16(afrag, *(const bf16x8*)(brow + 32 * ks), c0); c1 = MFMA16(afrag, *(const bf16x8*)(brow + 16 * LD64 + 32 * ks), c1);
            }
#pragma unroll
            for (int ch = 0; ch < 2; ++ch) {
                const f32x4 cc = ch ? c1 : c0; const int ic = 16 * ch + fr; const int t0 = 16 * th + 4 * fq;
                if (m == 0) {
#pragma unroll
                    for (int j = 0; j < 4; ++j) Lf[(t0 + j) * 32 + ic] = (ic < t0 + j) ? -cc[j] : 0.f;
                } else if (m == 1) {
                    u32x2 o; o.x = pk2((ic < t0) ? cc[0] : 0.f, (ic < t0 + 1) ? cc[1] : 0.f); o.y = pk2((ic < t0 + 2) ? cc[2] : 0.f, (ic < t0 + 3) ? cc[3] : 0.f);
                    *(u32x2*)(LakT + ic * LD32 + t0) = o;
                } else {
                    bf16_t* M = (m == 2 ? Mrb : Mrk) + par * 32 * LD32;
#pragma unroll
                    for (int j = 0; j < 4; ++j) M[(t0 + j) * LD32 + ic] = f2bf((ic <= t0 + j) ? cc[j] : 0.f);
                }
            }
        }
        LDS_BARRIER();
        if (wave == 7 && xn < G_NT) {
            invert32_blocked(Lf, (bf16_t*)(smem + RL_RX), lane, [&](int i, int c, float v) { Tb[i * LD32 + c] = f2bf(v); });
        }
        if (wave < 2 && it >= 0) {
            const int pc = it & 1; int seg = 0, j0 = 0; chunk_pos(it, d, seg, j0);
            const bf16_t* Rc = Rr + pc * 32 * LD64; const bf16_t* BhTc = BhT + pc * 64 * LD32; const bf16_t* KhTc = KhT + pc * 64 * LD32; const bf16_t* VTc = VT + (pc * 64 + 32 * wave + r) * LD32;
            const bf16_t* Mrbc = Mrb + pc * 32 * LD32; const bf16_t* Mrkc = Mrk + pc * 32 * LD32; const float* PCc = PC + pc * 64;
            const bf16x8 vf0 = ld_nat(VTc, 0, hh), vf1 = ld_nat(VTc, 1, hh);
            f32x16 u = zero16(), y = zero16();
            u = MFMA32(ld_nat(TLm + r * LD32, 0, hh), vf0, u); u = MFMA32(ld_nat(TLm + r * LD32, 1, hh), vf1, u);
            y = MFMA32(ld_nat(Mrkc + r * LD32, 0, hh), vf0, y); y = MFMA32(ld_nat(Mrkc + r * LD32, 1, hh), vf1, y);
#define RW_KSTEP(s) { const bf16x8 xb = pack_acc<(s) & 1>(Xt[(s) >> 1]); u = MFMA32(ld_perm(Wm + r * LD64, (s), hh), xb, u); y = MFMA32(ld_perm(Rc + r * LD64, (s), hh), xb, y); }
            RW_KSTEP(0) RW_KSTEP(1) RW_KSTEP(2) RW_KSTEP(3)
#undef RW_KSTEP
            const bf16x8 ub0 = pack_acc<0>(u), ub1 = pack_acc<1>(u);
            y = MFMA32(ld_perm(Mrbc + r * LD32, 0, hh), ub0, y); y = MFMA32(ld_perm(Mrbc + r * LD32, 1, hh), ub1, y);
#pragma unroll
            for (int kt = 0; kt < 2; ++kt) {
#pragma unroll
                for (int g = 0; g < 16; ++g) Xt[kt][g] *= PCc[32 * kt + crow(g, hh)];
                Xt[kt] = MFMA32(ld_perm(BhTc + (32 * kt + r) * LD32, 0, hh), ub0, Xt[kt]); Xt[kt] = MFMA32(ld_perm(BhTc + (32 * kt + r) * LD32, 1, hh), ub1, Xt[kt]);
                Xt[kt] = MFMA32(ld_nat(KhTc + (32 * kt + r) * LD32, 0, hh), vf0, Xt[kt]); Xt[kt] = MFMA32(ld_nat(KhTc + (32 * kt + r) * LD32, 1, hh), vf1, Xt[kt]);
            }
            if (seg) {
#pragma unroll
                for (int g = 0; g < 16; ++g) {
                    const int i = crow(g, hh), jj = d ? j0 + GC - 1 - i : j0 + i;
                    YDIR[((size_t)d * T_LAT + (size_t)b * S + (jj % ROWS) * GW + jj / ROWS) * 512 + h * 64 + 32 * wave + r] = f2bf(y[g]);
                }
            }
        }
        LDS_BARRIER();
        if (xn < G_NT && wave < 3) {
            const bf16_t* arow = (wave < 2) ? AT + (32 * wave + r) * LD32 : LakT + r * LD32;
            f32x16 acc = zero16();
#pragma unroll
            for (int s = 0; s < 2; ++s) acc = MFMA32(ld_nat(arow, s, hh), ld_nat(Tb + r * LD32, s, hh), acc);
#pragma unroll
            for (int q = 0; q < 4; ++q) {
                u32x2 o; o.x = pk2(acc[4 * q], acc[4 * q + 1]); o.y = pk2(acc[4 * q + 2], acc[4 * q + 3]);
                if (wave < 2) *(u32x2*)(Wm + r * LD64 + 32 * wave + 8 * q + 4 * hh) = o; else *(u32x2*)(TLm + r * LD32 + 8 * q + 4 * hh) = o;
            }
        }
        LDS_BARRIER();
    }
}

DI void phase3(const Params& p, char* smem) {
    constexpr int NG = 2 * NB * H_A, NR = 2 * NB * H_B;
    for (int it = blockIdx.x; it < NG; it += gridDim.x) gdn_chain2(p, smem, it);
    for (int it = blockIdx.x; it < NG + NR; it += gridDim.x) if (it >= NG) rwkv_chain2(p, smem, it - NG);
}

constexpr int P4_SG = 0;
constexpr int P4_XV = P4_SG + 32 * LD128 * 2;
constexpr int P4_YF = P4_XV + 32 * 520 * 2;
static_assert(P4_YF + 32 * 516 * 4 <= LDS_BYTES, "phase4 lds");
DI float half_sum(float v, int hh) {
#ifdef EMU
    v += __shfl_xor(v, 1); v += __shfl_xor(v, 2); v += __shfl_xor(v, 4); v += __shfl_xor(v, 8); v += __shfl_xor(v, 16); return v;
#else
    v = DPP_ADD(v, 0xB1); v = DPP_ADD(v, 0x4E); v = DPP_ADD(v, 0x141); v = DPP_ADD(v, 0x140);
    const int iv = __builtin_bit_cast(int, v);
    const float s0 = __builtin_bit_cast(float, __builtin_amdgcn_readlane(iv, 0)) + __builtin_bit_cast(float, __builtin_amdgcn_readlane(iv, 16));
    const float s1 = __builtin_bit_cast(float, __builtin_amdgcn_readlane(iv, 32)) + __builtin_bit_cast(float, __builtin_amdgcn_readlane(iv, 48));
    return hh ? s1 : s0;
#endif
}
DI void phase4(const Params& p, char* smem) {
    const int tid = tid_x(), lane = tid & 63, wave = tid >> 6, r = lane & 31, hh = lane >> 5;
    const bf16_t* PL = (const bf16_t*)(p.ws + WS_PLAT);
    const bf16_t* ODIR = (const bf16_t*)(p.aux + AUX_ODIR); const bf16_t* YDIR = (const bf16_t*)(p.aux + AUX_YDIR);
    const float* BON = (const float*)(p.ws + WS_BONUS); const float* mu = p.in[I_MU]; const bf16_t* G2T = (const bf16_t*)(p.ws + WS_G2T);
    bf16_t* OA = (bf16_t*)(p.ws + WS_OA); bf16_t* OB = (bf16_t*)(p.ws + WS_OB);
    bf16_t* SG = (bf16_t*)(smem + P4_SG); bf16_t* XV = (bf16_t*)(smem + P4_XV); float* YF = (float*)(smem + P4_YF);
    for (int it = blockIdx.x; it < T_LAT / 32; it += gridDim.x) {
        const int tok0 = it * 32, b = tok0 / S, l0 = tok0 % S;
        __syncthreads();
        for (int q = tid; q < 32 * 80; q += NTHREADS) {
            const int t = q / 80, c8 = q % 80;
            const int l = l0 + t;
            const int bcol = c8 < 16 ? 1792 + c8 * 8 : 1024 + (c8 - 16) * 8;
            float cu[8], o[8];
            unpack8(*(const u32x4*)(PL + (size_t)(b * S + l) * IN_COLS + COL_B0 + bcol), cu);
#pragma unroll
            for (int e = 0; e < 8; ++e) o[e] = c8 < 16 ? fsigmoid(cu[e]) : cu[e];
            u32x4 w; w.x = pk2(o[0], o[1]); w.y = pk2(o[2], o[3]); w.z = pk2(o[4], o[5]); w.w = pk2(o[6], o[7]);
            if (c8 < 16) *(u32x4*)(SG + t * LD128 + c8 * 8) = w; else *(u32x4*)(XV + t * 520 + (c8 - 16) * 8) = w;
        }
        for (int q = tid; q < 32 * 64; q += NTHREADS) {
            const int t = q >> 6, c8 = q & 63, tok = tok0 + t;
            float a0[8], a1[8];
            unpack8(*(const u32x4*)(YDIR + (size_t)tok * 512 + c8 * 8), a0); unpack8(*(const u32x4*)(YDIR + ((size_t)T_LAT + tok) * 512 + c8 * 8), a1);
            f32x4 s0 = {a0[0] + a1[0], a0[1] + a1[1], a0[2] + a1[2], a0[3] + a1[3]}, s1 = {a0[4] + a1[4], a0[5] + a1[5], a0[6] + a1[6], a0[7] + a1[7]};
            *(f32x4*)(YF + t * 516 + c8 * 8) = s0; *(f32x4*)(YF + t * 516 + c8 * 8 + 4) = s1;
        }
        __syncthreads();
        {
            const int h = wave;
            f32x16 acc0 = zero16(), acc1 = zero16();
#pragma unroll
            for (int s2 = 0; s2 < 8; ++s2) {
                const bf16x8 a = ld_nat(SG + r * LD128, s2, hh);
                const bf16x8 b0 = *(const bf16x8*)(G2T + (size_t)(64 * h + r) * 128 + 16 * s2 + 8 * hh), b1 = *(const bf16x8*)(G2T + (size_t)(64 * h + 32 + r) * 128 + 16 * s2 + 8 * hh);
                acc0 = MFMA32(a, b0, acc0); acc1 = MFMA32(a, b1, acc1);
            }
            const int c0 = 64 * h + r, c1 = c0 + 32;
            const float lg0 = p.in[I_LNG][c0], lb0 = p.in[I_LNB][c0], lg1 = p.in[I_LNG][c1], lb1 = p.in[I_LNB][c1];
            float bonv[16];
#pragma unroll
            for (int g = 0; g < 16; ++g) { const int tok = tok0 + crow(g, hh); bonv[g] = BON[(size_t)tok * 8 + h] + BON[((size_t)T_LAT + tok) * 8 + h]; }
#pragma unroll
            for (int g = 0; g < 16; ++g) {
                const int i = crow(g, hh), tok = tok0 + i;
                const float y0 = YF[i * 516 + c0], y1 = YF[i * 516 + c1];
                const float mean = half_sum(y0 + y1, hh) * (1.f / 64.f); const float d0 = y0 - mean, d1 = y1 - mean;
                const float var = half_sum(d0 * d0 + d1 * d1, hh) * (1.f / 64.f); const float rs = frsq(var + 64e-5f);
                const float bon = bonv[g];
                const float o0 = (d0 * rs * lg0 + lb0 + bon * bf2f(XV[i * 520 + c0])) * acc0[g], o1 = (d1 * rs * lg1 + lb1 + bon * bf2f(XV[i * 520 + c1])) * acc1[g];
                OB[(size_t)tok * 512 + c0] = f2bf(o0); OB[(size_t)tok * 512 + c1] = f2bf(o1);
            }
        }
        {
            unsigned q0[16], q1[16], zq[16];
#pragma unroll
            for (int k = 0; k < 16; ++k) {
                const int pi = wave * 16 + k, t = pi >> 2, h = pi & 3, tok = tok0 + t;
                const size_t o0 = (size_t)tok * 512 + h * 128 + 2 * lane;
                q0[k] = *(const unsigned*)(ODIR + o0); q1[k] = *(const unsigned*)(ODIR + (size_t)T_LAT * 512 + o0); zq[k] = *(const unsigned*)(PL + (size_t)tok * IN_COLS + 1536 + h * 128 + 2 * lane);
            }
            const float on0 = p.in[I_ONORM][2 * lane], on1 = p.in[I_ONORM][2 * lane + 1];
#pragma unroll
            for (int k = 0; k < 16; ++k) {
                const int pi = wave * 16 + k, t = pi >> 2, h = pi & 3, tok = tok0 + t;
                const size_t o0 = (size_t)tok * 512 + h * 128 + 2 * lane;
                const float a0 = bf2f((bf16_t)(q0[k] & 0xffffu)) + bf2f((bf16_t)(q1[k] & 0xffffu)), a1 = bf2f((bf16_t)(q0[k] >> 16)) + bf2f((bf16_t)(q1[k] >> 16));
                const float ss = wave_sum_fast(a0 * a0 + a1 * a1);
                const float rstd = frsq(ss * (1.f / 128.f) + 1e-6f);
                const float z0 = bf2f((bf16_t)(zq[k] & 0xffffu)), z1 = bf2f((bf16_t)(zq[k] >> 16));
                *(unsigned*)(OA + o0) = pk2(a0 * rstd * on0 * fsilu(z0), a1 * rstd * on1 * fsilu(z1));
            }
        }
    }
}

DI void phase5(const Params& p, char* smem) {
    const bf16_t* OA = (const bf16_t*)(p.ws + WS_OA); const bf16_t* OB = (const bf16_t*)(p.ws + WS_OB);
    const bf16_t* WA = (const bf16_t*)(p.ws + WS_WOA); const bf16_t* WB = (const bf16_t*)(p.ws + WS_WOB);
    const bf16_t* PL = (const bf16_t*)(p.ws + WS_PLAT); bf16_t* Y = (bf16_t*)(p.aux + AUX_Y);
    if (USE_G8) {
        constexpr int NT8 = D / 256, MT8 = T_LAT / 256;
        for (int t = blockIdx.x; t < MT8 * NT8; t += gridDim.x) {
            int mt, nt; if (!g8::tile_order(t, MT8, NT8, mt, nt)) break;
            const int brow = mt * 256, bcol = nt * 256;
            g8::Acc acc; g8::acc_zero(acc);
            g8::kloop(acc, smem, OA, 512, WA, 512, 512, brow, bcol);
            g8::for_each_quad(acc, brow, bcol, [&](int row, int col, const f32x4& v) {
                const u32x2 gq = *(const u32x2*)(PL + (size_t)row * IN_COLS + COL_G0 + col);
                const float g0 = bf2f((bf16_t)(gq.x & 0xffffu)), g1 = bf2f((bf16_t)(gq.x >> 16)), g2 = bf2f((bf16_t)(gq.y & 0xffffu)), g3 = bf2f((bf16_t)(gq.y >> 16));
                u32x2 o; o.x = pk2(fsigmoid(g0) * v.x, fsigmoid(g1) * v.y); o.y = pk2(fsigmoid(g2) * v.z, fsigmoid(g3) * v.w);
                *(u32x2*)(Y + (size_t)row * D + col) = o;
            });
            g8::acc_zero(acc);
            g8::kloop(acc, smem, OB, 512, WB, 512, 512, brow, bcol);
            g8::for_each_quad(acc, brow, bcol, [&](int row, int col, const f32x4& v) {
                const u32x2 gq = *(const u32x2*)(PL + (size_t)row * IN_COLS + COL_G0 + D + col);
                const float g0 = bf2f((bf16_t)(gq.x & 0xffffu)), g1 = bf2f((bf16_t)(gq.x >> 16)), g2 = bf2f((bf16_t)(gq.y & 0xffffu)), g3 = bf2f((bf16_t)(gq.y >> 16));
#ifdef EMU
                const unsigned long long tq = *(const unsigned long long*)(Y + (size_t)row * D + col);
#else
                const unsigned long long tq = __hip_atomic_load((const unsigned long long*)(Y + (size_t)row * D + col), __ATOMIC_RELAXED, __HIP_MEMORY_SCOPE_AGENT);
#endif
                const unsigned tlo = (unsigned)tq, thi = (unsigned)(tq >> 32);
                const float t0 = bf2f((bf16_t)(tlo & 0xffffu)), t1 = bf2f((bf16_t)(tlo >> 16)), t2 = bf2f((bf16_t)(thi & 0xffffu)), t3 = bf2f((bf16_t)(thi >> 16));
                u32x2 o; o.x = pk2(t0 + fsigmoid(g0) * v.x, t1 + fsigmoid(g1) * v.y); o.y = pk2(t2 + fsigmoid(g2) * v.z, t3 + fsigmoid(g3) * v.w);
                *(u32x2*)(Y + (size_t)row * D + col) = o;
            });
        }
        return;
    }
    constexpr int MR5 = 2, BM5 = 64 * MR5; constexpr int NT = D / 128, MT = T_LAT / BM5;
    for (int t = blockIdx.x; t < MT * NT; t += gridDim.x) {
        const int mt = t / NT, nt = t % NT, row0 = mt * BM5;
        f32x4 acca[MR5][4], accb[MR5][4]; acc_zero(acca); acc_zero(accb);
        gemm_kloop(acca, smem, [&](int i) { return OA + (size_t)(row0 + i) * 512; }, WA + (size_t)nt * 128 * 512, 512, 512);
        gemm_kloop(accb, smem, [&](int i) { return OB + (size_t)(row0 + i) * 512; }, WB + (size_t)nt * 128 * 512, 512, 512);
        const int t2 = tid_x(), l2 = t2 & 63, w2 = t2 >> 6; const int wr = w2 >> 1, wc = w2 & 1, fr = l2 & 15, fq = l2 >> 4;
#pragma unroll
        for (int m = 0; m < MR5; ++m)
#pragma unroll
            for (int n = 0; n < 4; ++n)
#pragma unroll
                for (int j = 0; j < 4; ++j) {
                    const int row = row0 + wr * 16 * MR5 + m * 16 + fq * 4 + j, col = nt * 128 + wc * 64 + n * 16 + fr;
                    const float ga = bf2f(PL[(size_t)row * IN_COLS + COL_G0 + col]), gb = bf2f(PL[(size_t)row * IN_COLS + COL_G0 + D + col]);
                    Y[(size_t)row * D + col] = f2bf(sigmoidf_(ga) * acca[m][n][j] + sigmoidf_(gb) * accb[m][n][j]);
                }
    }
}

DI void phase6(const Params& p, char* smem) {
    const bf16_t* Y = (const bf16_t*)(p.aux + AUX_Y); const bf16_t* WO = (const bf16_t*)(p.ws + WS_WOUT);
    const float* mod = (const float*)(p.ws + WS_MOD); float* Hh = (float*)(p.ws + WS_H);
    if (USE_G8) {
        constexpr int NT = D / 256, MT = T_LAT / 256;
        const float* X = p.in[I_X];
        for (int t = blockIdx.x; t < MT * NT; t += gridDim.x) {
            int mt, nt; if (!g8::tile_order(t, MT, NT, mt, nt)) break;
            const int brow = mt * 256, bcol = nt * 256;
            g8::Acc acc; g8::acc_zero(acc);
            g8::kloop(acc, smem, Y, D, WO, D, D, brow, bcol);
            g8::for_each_quad(acc, brow, bcol, [&](int row, int col, const f32x4& v) {
                const int b = row / S; const f32x4 xv = *(const f32x4*)(X + (size_t)row * D + col), gv = *(const f32x4*)(mod + (size_t)b * 6 * D + 2 * D + col);
                f32x4 o; o.x = xv.x + gv.x * v.x; o.y = xv.y + gv.y * v.y; o.z = xv.z + gv.z * v.z; o.w = xv.w + gv.w * v.w;
                *(f32x4*)(Hh + (size_t)row * D + col) = o;
            });
        }
    } else {
        const int tid = tid_x(), lane = tid & 63, wave = tid >> 6, wr = wave >> 1, wc = wave & 1, fr = lane & 15, fq = lane >> 4;
        constexpr int NT = D / 128, MT = T_LAT / BM;
        for (int t = blockIdx.x; t < MT * NT; t += gridDim.x) {
            const int mt = t / NT, nt = t % NT, row0 = mt * BM;
            f32x4 acc[MREP][4]; acc_zero(acc);
            gemm_kloop(acc, smem, [&](int i) { return Y + (size_t)(row0 + i) * D; }, WO + (size_t)nt * 128 * D, D, D);
#pragma unroll
            for (int m = 0; m < MREP; ++m)
#pragma unroll
                for (int n = 0; n < 4; ++n)
#pragma unroll
                    for (int j = 0; j < 4; ++j) {
                        const int row = row0 + wr * 16 * MREP + m * 16 + fq * 4 + j, col = nt * 128 + wc * 64 + n * 16 + fr, b = row / S;
                        Hh[(size_t)row * D + col] = p.in[I_X][(size_t)row * D + col] + mod[(size_t)b * 6 * D + 2 * D + col] * acc[m][n][j];
                    }
        }
    }
    __syncthreads();
    const int tid6 = tid_x(), lane = tid6 & 63, wave = tid6 >> 6;
    const int gw = blockIdx.x * 8 + wave, ngw = gridDim.x * 8;
    float* scr = (float*)smem + wave * (64 * 33);
    bf16_t* GUT = (bf16_t*)(p.aux + AUX_GUT); bf16_t* DNT = (bf16_t*)(p.ws + WS_DNT);
    {
        constexpr int nkb = D / 64, nnb = DE / 32, per = nkb * nnb;
        for (int it = gw; it < NEXP * 2 * per; it += ngw) {
            const int e = it / (2 * per), r = it % (2 * per), up = r / per, r2 = r % per, kb = r2 / nnb, nb = r2 % nnb;
            transpose_item((up ? p.in[I_MU_UP] : p.in[I_MG]) + (size_t)e * D * DE, DE, DE, kb * 64, nb * 32, GUT + (size_t)e * 512 * D, D, up ? 2 : 1, scr, lane);
        }
    }
    {
        constexpr int nkb = DE / 64, nnb = D / 32, per = nkb * nnb;
        for (int it = gw; it < NEXP * per; it += ngw) {
            const int e = it / per, r2 = it % per, kb = r2 / nnb, nb = r2 % nnb;
            transpose_item(p.in[I_MD] + (size_t)e * DE * D, D, D, kb * 64, nb * 32, DNT + (size_t)e * D * DE, DE, 0, scr, lane);
        }
    }
}

#ifdef EMU
#define MFMA32F(a, b, c) emu_mfma32_f32((a), (b), (c))
#else
#define MFMA32F(a, b, c) __builtin_amdgcn_mfma_f32_32x32x2f32((a), (b), (c), 0, 0, 0)
#endif
constexpr int TB_LD = D + 4;
static_assert(32 * TB_LD * 4 <= LDS_BYTES && 8 * 32 * 64 * 4 <= LDS_BYTES, "phase7 lds");
DI void phase7(const Params& p, char* smem) {
    const int tid = tid_x(), lane = tid & 63, wave = tid >> 6, r = lane & 31, hh = lane >> 5;
    const float* Hh = (const float*)(p.ws + WS_H); const float* mod = (const float*)(p.ws + WS_MOD); const float* WRT = (const float*)(p.ws + WS_WRT);
    bf16_t* Tt = (bf16_t*)(p.ws + WS_T); int* cnt = (int*)(p.ws + WS_CNT); int* rowlist = (int*)(p.ws + WS_ROWLIST); float* pairw = (float*)(p.ws + WS_PAIRW);
    float* tb = (float*)smem;
    float* bias = (float*)(smem + LDS_BYTES - 1024);
    int* lcnt = (int*)(smem + LDS_BYTES - 768);
    int* lbase = lcnt + 32;
    if (tid < 36) bias[tid] = tid < 4 ? p.in[I_RGB][tid] : p.in[I_REB][tid - 4];
    f32x4 x[4][D / 256];
    int itn = blockIdx.x;
    if (itn < T_LAT / 32) {
#pragma unroll
        for (int tt = 0; tt < 4; ++tt)
#pragma unroll
            for (int j = 0; j < D / 256; ++j) x[tt][j] = *(const f32x4*)(Hh + (size_t)(itn * 32 + wave * 4 + tt) * D + j * 256 + lane * 4);
    }
    for (int it = blockIdx.x; it < T_LAT / 32; it += gridDim.x) {
        const int tok0 = it * 32;
        __syncthreads();
        if (tid < 32) lcnt[tid] = 0;
#pragma unroll
        for (int tt = 0; tt < 4; ++tt) {
            const int ti = wave * 4 + tt, tok = tok0 + ti, b = tok / S;
            float ss = 0.f;
#pragma unroll
            for (int j = 0; j < D / 256; ++j) ss += x[tt][j].x * x[tt][j].x + x[tt][j].y * x[tt][j].y + x[tt][j].z * x[tt][j].z + x[tt][j].w * x[tt][j].w;
            ss = wave_sum_fast(ss);
            const float rstd = frsq(ss * (1.0f / D) + 1e-6f);
#pragma unroll
            for (int j = 0; j < D / 256; ++j) {
                const int k = j * 256 + lane * 4;
                const f32x4 g = *(const f32x4*)(p.in[I_NFFN] + k), sh = *(const f32x4*)(mod + (size_t)b * 6 * D + 3 * D + k), sc = *(const f32x4*)(mod + (size_t)b * 6 * D + 4 * D + k);
                f32x4 o; o.x = x[tt][j].x * rstd * g.x * (1.f + sc.x) + sh.x; o.y = x[tt][j].y * rstd * g.y * (1.f + sc.y) + sh.y;
                o.z = x[tt][j].z * rstd * g.z * (1.f + sc.z) + sh.z; o.w = x[tt][j].w * rstd * g.w * (1.f + sc.w) + sh.w;
                *(f32x4*)(tb + ti * TB_LD + k) = o;
                u32x2 ob; ob.x = pk2(o.x, o.y); ob.y = pk2(o.z, o.w);
                *(u32x2*)(Tt + (size_t)tok * D + k) = ob;
            }
        }
        itn = it + gridDim.x;
        if (itn < T_LAT / 32) {
#pragma unroll
            for (int tt = 0; tt < 4; ++tt)
#pragma unroll
                for (int j = 0; j < D / 256; ++j) x[tt][j] = *(const f32x4*)(Hh + (size_t)(itn * 32 + wave * 4 + tt) * D + j * 256 + lane * 4);
        }
        LDS_BARRIER();
        f32x16 a0 = zero16(), a1 = zero16();
        {
            const int kbeg = wave * (D / 8);
            const float* arow = tb + r * TB_LD + kbeg + 4 * hh;
            const float* b0row = WRT + (size_t)(4 + r) * D + kbeg + 4 * hh;
            const float* b1row = WRT + (size_t)(r < 4 ? r : 0) * D + kbeg + 4 * hh;
            const float m1 = r < 4 ? 1.f : 0.f;
#pragma unroll 4
            for (int g = 0; g < D / 64; ++g) {
                const f32x4 av = *(const f32x4*)(arow + 8 * g), b0 = *(const f32x4*)(b0row + 8 * g); const f32x4 b1 = *(const f32x4*)(b1row + 8 * g) * m1;
                a0 = MFMA32F(av.x, b0.x, a0); a1 = MFMA32F(av.x, b1.x, a1); a0 = MFMA32F(av.y, b0.y, a0); a1 = MFMA32F(av.y, b1.y, a1);
                a0 = MFMA32F(av.z, b0.z, a0); a1 = MFMA32F(av.z, b1.z, a1); a0 = MFMA32F(av.w, b0.w, a0); a1 = MFMA32F(av.w, b1.w, a1);
            }
        }
        LDS_BARRIER();
        {
            float* part = tb + wave * (32 * 64);
#pragma unroll
            for (int g = 0; g < 16; ++g) { const int i = crow(g, hh); part[i * 64 + r] = a0[g]; part[i * 64 + 32 + r] = a1[g]; }
        }
        LDS_BARRIER();
        float lsum[4];
        {
            const int i = tid >> 4, c4 = (tid & 15) * 4;
#pragma unroll
            for (int e = 0; e < 4; ++e) { float sacc = 0.f;
#pragma unroll
                for (int w = 0; w < 8; ++w) sacc += tb[w * (32 * 64) + i * 64 + c4 + e];
                lsum[e] = sacc; }
        }
        LDS_BARRIER();
        { const int i = tid >> 4, c4 = (tid & 15) * 4;
#pragma unroll
          for (int e = 0; e < 4; ++e) tb[i * 64 + c4 + e] = lsum[e]; }
        LDS_BARRIER();
        int ex1 = 0, ex2 = 0, rk1 = 0, rk2 = 0; float w1 = 0.f, w2 = 0.f;
        if (tid < 32) {
            const float* L = tb + tid * 64;
            float gl[4];
#pragma unroll
            for (int i = 0; i < 4; ++i) gl[i] = L[32 + i] + bias[i];
            int g = 0; float mx = gl[0];
#pragma unroll
            for (int i = 1; i < 4; ++i) if (gl[i] > mx) { mx = gl[i]; g = i; }
            float se = 0.f;
#pragma unroll
            for (int i = 0; i < 4; ++i) se += fexp(gl[i] - mx);
            const float pg = 1.0f / se;
            int i1 = 0; float l1 = L[g * 8] + bias[4 + g * 8];
            for (int i = 1; i < 8; ++i) { const float v = L[g * 8 + i] + bias[4 + g * 8 + i]; if (v > l1) { l1 = v; i1 = i; } }
            int i2 = -1; float l2 = -3.0e38f;
            for (int i = 0; i < 8; ++i) { const float v = L[g * 8 + i] + bias[4 + g * 8 + i]; if (i != i1 && v > l2) { l2 = v; i2 = i; } }
            const float e2 = fexp(l2 - l1); w1 = pg / (1.f + e2); w2 = pg * e2 / (1.f + e2);
            ex1 = g * 8 + i1; ex2 = g * 8 + i2;
            rk1 = atomicAdd(&lcnt[ex1], 1); rk2 = atomicAdd(&lcnt[ex2], 1);
        }
        LDS_BARRIER();
        if (tid < 32) { const int c = lcnt[tid]; lbase[tid] = c ? atomicAdd(&cnt[tid * CNT_STRIDE], c) : 0; }
        __syncthreads();
        if (tid < 32) {
            const int tok = tok0 + tid;
            rowlist[(size_t)ex1 * CAP + lbase[ex1] + rk1] = tok * 2; pairw[tok * 2] = w1;
            rowlist[(size_t)ex2 * CAP + lbase[ex2] + rk2] = tok * 2 + 1; pairw[tok * 2 + 1] = w2;
        }
    }
}

constexpr int MOE_TM = USE_G8 ? 256 : BM;
DI void moe_tiles(const Params& p, char* smem, int* pre) {
    const int* cnt = (const int*)(p.ws + WS_CNT);
    __syncthreads();
    if (tid_x() == 0) { int s = 0; for (int e = 0; e < NEXP; ++e) { pre[e] = s; s += (cnt[e * CNT_STRIDE] + MOE_TM - 1) / MOE_TM; } pre[NEXP] = s; }
    __syncthreads();
}
DI void phase8(const Params& p, char* smem) {
    const int tid = tid_x(), lane = tid & 63, wave = tid >> 6, wr = wave >> 1, wc = wave & 1, fr = lane & 15, fq = lane >> 4;
    int* pre = (int*)(smem + LDS_BYTES - 256);
    moe_tiles(p, smem, pre);
    const int* cnt = (const int*)(p.ws + WS_CNT); const int* rowlist = (const int*)(p.ws + WS_ROWLIST);
    const bf16_t* Tt = (const bf16_t*)(p.ws + WS_T); const bf16_t* GUT = (const bf16_t*)(p.aux + AUX_GUT); bf16_t* HID = (bf16_t*)(p.ws + WS_HID);
    if (USE_G8) {
        const int ntile8 = pre[NEXP] * 2;
        for (int t = blockIdx.x; t < ntile8; t += gridDim.x) {
            const int mg = t >> 1, nt = t & 1; int e = 0;
            while (pre[e + 1] <= mg) ++e;
            const int mt = mg - pre[e], ce = cnt[e * CNT_STRIDE]; const int* rl = rowlist + (size_t)e * CAP;
            g8::Acc acc; g8::acc_zero(acc);
            g8::kloop_g(acc, smem, Tt, [&](int r) { int idx = mt * 256 + r; idx = idx < ce ? idx : ce - 1; return (rl[idx] >> 1) * D; }, GUT + ((size_t)e * 512 + nt * 256) * D, D, D, 0);
            const int t2 = tid_x(), wid = t2 >> 6, l2 = t2 & 63, wr2 = wid >> 2, wc2 = wid & 3, fr2 = l2 & 15, fq2 = l2 >> 4;
            int prs[2][4];
#pragma unroll
            for (int ai = 0; ai < 2; ++ai)
#pragma unroll
                for (int m = 0; m < 4; ++m) { const int idx = mt * 256 + ai * 128 + wr2 * 64 + m * 16 + fr2; prs[ai][m] = idx < ce ? rl[idx] : -1; }
#pragma unroll
            for (int ai = 0; ai < 2; ++ai)
#pragma unroll
                for (int m = 0; m < 4; ++m) {
                    if (prs[ai][m] >= 0) {
                        const int pair = prs[ai][m];
#pragma unroll
                        for (int bj = 0; bj < 2; ++bj) {
                            const f32x4 g = acc[ai][bj][m][0], u = acc[ai][bj][m][1];
                            u32x2 o; o.x = pk2(fsilu(g.x) * u.x, fsilu(g.y) * u.y); o.y = pk2(fsilu(g.z) * u.z, fsilu(g.w) * u.w);
                            *(u32x2*)(HID + (size_t)pair * DE + nt * 128 + bj * 64 + wc2 * 16 + fq2 * 4) = o;
                        }
                    }
                }
        }
        return;
    }
    const int ntile = pre[NEXP] * 4;
    for (int t = blockIdx.x; t < ntile; t += gridDim.x) {
        const int mg = t >> 2, nt = t & 3; int e = 0;
        while (pre[e + 1] <= mg) ++e;
        const int mt = mg - pre[e], ce = cnt[e * CNT_STRIDE]; const int* rl = rowlist + (size_t)e * CAP;
        f32x4 acc[MREP][4]; acc_zero(acc);
        gemm_kloop(acc, smem, [&](int i) { int idx = mt * BM + i; idx = idx < ce ? idx : ce - 1; return Tt + (size_t)(rl[idx] >> 1) * D; }, GUT + ((size_t)e * 512 + nt * 128) * D, D, D);
#pragma unroll
        for (int m = 0; m < MREP; ++m)
#pragma unroll
            for (int j = 0; j < 4; ++j) {
                const int idx = mt * BM + wr * 16 * MREP + m * 16 + fq * 4 + j;
                if (idx < ce) {
                    const int pair = rl[idx];
#pragma unroll
                    for (int n = 0; n < 2; ++n) {
                        const float g = acc[m][n][j], u = acc[m][n + 2][j];
                        HID[(size_t)pair * DE + nt * 64 + wc * 32 + n * 16 + fr] = f2bf(siluf_(g) * u);
                    }
                }
            }
    }
}
DI void phase9(const Params& p, char* smem) {
    const int tid = tid_x(), lane = tid & 63, wave = tid >> 6, wr = wave >> 1, wc = wave & 1, fr = lane & 15, fq = lane >> 4;
    int* pre = (int*)(smem + LDS_BYTES - 256);
    moe_tiles(p, smem, pre);
    const int* cnt = (const int*)(p.ws + WS_CNT); const int* rowlist = (const int*)(p.ws + WS_ROWLIST); const float* pairw = (const float*)(p.ws + WS_PAIRW);
    const bf16_t* HID = (const bf16_t*)(p.ws + WS_HID); const bf16_t* DNT = (const bf16_t*)(p.ws + WS_DNT); bf16_t* OP = (bf16_t*)(p.ws + WS_OPAIR);
    if (USE_G8) {
        constexpr int NT8 = D / 256;
        const int ntile8 = pre[NEXP] * NT8;
        for (int t = blockIdx.x; t < ntile8; t += gridDim.x) {
            const int mg = t / NT8, nt = t % NT8; int e = 0;
            while (pre[e + 1] <= mg) ++e;
            const int mt = mg - pre[e], ce = cnt[e * CNT_STRIDE]; const int* rl = rowlist + (size_t)e * CAP;
            g8::Acc acc; g8::acc_zero(acc);
            g8::kloop_g(acc, smem, HID, [&](int r) { int idx = mt * 256 + r; idx = idx < ce ? idx : ce - 1; return rl[idx] * DE; }, DNT + ((size_t)e * D + nt * 256) * DE, DE, DE, 0);
            {
                const int t2 = tid_x(), wid = t2 >> 6, l2 = t2 & 63, wr2 = wid >> 2, wc2 = wid & 3, fr2 = l2 & 15, fq2 = l2 >> 4;
                int prs[2][4]; float pws[2][4];
#pragma unroll
                for (int ai = 0; ai < 2; ++ai)
#pragma unroll
                    for (int m = 0; m < 4; ++m) { const int idx = mt * 256 + ai * 128 + wr2 * 64 + m * 16 + fr2; prs[ai][m] = idx < ce ? rl[idx] : -1; }
#pragma unroll
                for (int ai = 0; ai < 2; ++ai)
#pragma unroll
                    for (int m = 0; m < 4; ++m) pws[ai][m] = prs[ai][m] >= 0 ? pairw[prs[ai][m]] : 0.f;
#pragma unroll
                for (int ai = 0; ai < 2; ++ai)
#pragma unroll
                    for (int m = 0; m < 4; ++m) {
                        if (prs[ai][m] >= 0) {
                            const float w = pws[ai][m]; bf16_t* orow = OP + (size_t)prs[ai][m] * D + nt * 256 + wc2 * 32 + fq2 * 4;
#pragma unroll
                            for (int bj = 0; bj < 2; ++bj)
#pragma unroll
                                for (int n = 0; n < 2; ++n) { const f32x4 v = acc[ai][bj][m][n];
                                    u32x2 o; o.x = pk2(v.x * w, v.y * w); o.y = pk2(v.z * w, v.w * w); *(u32x2*)(orow + bj * 128 + n * 16) = o; }
                        }
                    }
            }
        }
        return;
    }
    constexpr int NT = D / 128;
    const int ntile = pre[NEXP] * NT;
    for (int t = blockIdx.x; t < ntile; t += gridDim.x) {
        const int mg = t / NT, nt = t % NT; int e = 0;
        while (pre[e + 1] <= mg) ++e;
        const int mt = mg - pre[e], ce = cnt[e * CNT_STRIDE]; const int* rl = rowlist + (size_t)e * CAP;
        f32x4 acc[MREP][4]; acc_zero(acc);
        gemm_kloop(acc, smem, [&](int i) { int idx = mt * BM + i; idx = idx < ce ? idx : ce - 1; return HID + (size_t)rl[idx] * DE; }, DNT + ((size_t)e * D + nt * 128) * DE, DE, DE);
#pragma unroll
        for (int m = 0; m < MREP; ++m)
#pragma unroll
            for (int j = 0; j < 4; ++j) {
                const int idx = mt * BM + wr * 16 * MREP + m * 16 + fq * 4 + j;
                if (idx < ce) {
                    const int pair = rl[idx]; const float w = pairw[pair];
#pragma unroll
                    for (int n = 0; n < 4; ++n) OP[(size_t)pair * D + nt * 128 + wc * 64 + n * 16 + fr] = f2bf(acc[m][n][j] * w);
                }
            }
    }
}

DI void phase10(const Params& p, char* smem) {
    const int lane = tid_x() & 63, wave = tid_x() >> 6;
    const int gw = blockIdx.x * 8 + wave, ngw = gridDim.x * 8;
    const float* Hh = (const float*)(p.ws + WS_H); const float* mod = (const float*)(p.ws + WS_MOD); const bf16_t* OP = (const bf16_t*)(p.ws + WS_OPAIR);
    for (int tok = gw; tok < T_LAT; tok += ngw) {
        const int b = tok / S;
        f32x4 x[D / 256]; float ss = 0.f;
#pragma unroll
        for (int j = 0; j < D / 256; ++j) {
            const int k = j * 256 + lane * 4;
            const f32x4 hv = *(const f32x4*)(Hh + (size_t)tok * D + k), g2 = *(const f32x4*)(mod + (size_t)b * 6 * D + 5 * D + k);
            const u32x2 p0 = *(const u32x2*)(OP + (size_t)(tok * 2) * D + k), p1 = *(const u32x2*)(OP + (size_t)(tok * 2 + 1) * D + k);
            f32x4 m;
            m.x = bf2f((bf16_t)(p0.x & 0xffffu)) + bf2f((bf16_t)(p1.x & 0xffffu)); m.y = bf2f((bf16_t)(p0.x >> 16)) + bf2f((bf16_t)(p1.x >> 16));
            m.z = bf2f((bf16_t)(p0.y & 0xffffu)) + bf2f((bf16_t)(p1.y & 0xffffu)); m.w = bf2f((bf16_t)(p0.y >> 16)) + bf2f((bf16_t)(p1.y >> 16));
            x[j].x = hv.x + g2.x * m.x; x[j].y = hv.y + g2.y * m.y; x[j].z = hv.z + g2.z * m.z; x[j].w = hv.w + g2.w * m.w;
            ss += x[j].x * x[j].x + x[j].y * x[j].y + x[j].z * x[j].z + x[j].w * x[j].w;
        }
        ss = wave_sum(ss);
        const float rstd = 1.0f / sqrtf(ss * (1.0f / D) + 1e-6f);
#pragma unroll
        for (int j = 0; j < D / 256; ++j) {
            const int k = j * 256 + lane * 4; const f32x4 g = *(const f32x4*)(p.in[I_FIN] + k);
            f32x4 o; o.x = x[j].x * rstd * g.x; o.y = x[j].y * rstd * g.y; o.z = x[j].z * rstd * g.z; o.w = x[j].w * rstd * g.w;
            *(f32x4*)(p.out + (size_t)tok * D + k) = o;
        }
    }
}

DI void run_phase(const Params& p, int ph, char* smem) {
    switch (ph) {
        case PH_MOD: phase0(p, smem); break;
        case PH_U: phase1(p, smem); break;
        case PH_P: phase2(p, smem); break;
        case PH_HALO: phase_halo(p, smem); break;
        case PH_FIR: phase_fir(p, smem); break;
        case PH_CHAINS: phase3(p, smem); break;
        case PH_POST: phase4(p, smem); break;
        case PH_MERGE: phase5(p, smem); break;
        case PH_WOUT: phase6(p, smem); break;
        case PH_ROUTER: phase7(p, smem); break;
        case PH_UP: phase8(p, smem); break;
        case PH_DOWN: phase9(p, smem); break;
        default: phase10(p, smem); break;
    }
}

#ifndef EMU
namespace cg = cooperative_groups;
#define XB_TMO      128
#define XB_XCNT(j)  (256  + 64 * (j))
#define XB_XSUB(j)  (1280 + 64 * (j))
#define XB_XGEN(j)  (2304 + 64 * (j))
#define XB_TOP      3328
#define XB_TOPGEN   3392
#define XB_SPIN_CAP (1u << 20)
DI unsigned xb_ld(unsigned* p) { return __hip_atomic_load(p, __ATOMIC_RELAXED, __HIP_MEMORY_SCOPE_AGENT); }
DI unsigned xb_add(unsigned* p, unsigned v) { return __hip_atomic_fetch_add(p, v, __ATOMIC_RELAXED, __HIP_MEMORY_SCOPE_AGENT); }
DI unsigned xb_xcc_id() { return (unsigned)__builtin_amdgcn_s_getreg((3 << 11) | 20) & 0xFu; }
#define XB_SPIN(cond, bar) do { unsigned _sp = 0; while (cond) { __builtin_amdgcn_s_sleep(1); \
    if ((++_sp & 255u) == 0u) { if (xb_ld(&(bar)[XB_TMO])) break; if (_sp > XB_SPIN_CAP) { atomicAdd(&(bar)[XB_TMO], 1u); break; } } } } while (0)
DI void xcd_barrier_post(unsigned* bar) { if (threadIdx.x == 0) (void)xb_add(&bar[XB_XCNT(xb_xcc_id())], 1u); }
DI void xcd_barrier_complete(unsigned* bar, unsigned x, unsigned& nloc, unsigned& nx) {
    const unsigned G = gridDim.x;
    unsigned sum, cnt, mine, sp = 0u;
    for (;;) {
        sum = 0u; cnt = 0u; mine = 0u;
#pragma unroll
        for (unsigned j = 0; j < 16; ++j) { const unsigned c = xb_ld(&bar[XB_XCNT(j)]); sum += c; cnt += (c > 0u) ? 1u : 0u; mine = (j == x) ? c : mine; }
        if (sum == G) break;
        __builtin_amdgcn_s_sleep(1);
        if ((++sp & 255u) == 0u) { if (xb_ld(&bar[XB_TMO])) break; if (sp > XB_SPIN_CAP) { atomicAdd(&bar[XB_TMO], 1u); break; } }
    }
    nloc = mine > 0u ? mine : 1u; nx = cnt > 0u ? cnt : 1u;
}
DI void xcd_barrier(unsigned* bar, volatile unsigned* st) {
    asm volatile("s_waitcnt vmcnt(0)" ::: "memory");
    __syncthreads();
    if (threadIdx.x == 0) {
        __builtin_amdgcn_s_waitcnt(0);
        const unsigned x = xb_xcc_id();
        unsigned nloc = st[0], nx = st[1];
        if (nloc == 0u) { xcd_barrier_complete(bar, x, nloc, nx); st[0] = nloc; st[1] = nx; }
        const unsigned old = xb_add(&bar[XB_XSUB(x)], 1u);
        const unsigned gen = old / nloc;
        if (old + 1u == (gen + 1u) * nloc) {
            __builtin_amdgcn_fence(__ATOMIC_RELEASE, "agent");
            asm volatile("s_waitcnt vmcnt(0)" ::: "memory");
            const unsigned og = xb_add(&bar[XB_TOP], 1u);
            const unsigned tg = og / nx;
            if (og + 1u == (tg + 1u) * nx) xb_add(&bar[XB_TOPGEN], 1u);
            else XB_SPIN(xb_ld(&bar[XB_TOPGEN]) == tg, bar);
            __builtin_amdgcn_fence(__ATOMIC_ACQUIRE, "agent");
            xb_add(&bar[XB_XGEN(x)], 1u);
            asm volatile("s_waitcnt vmcnt(0)" ::: "memory");
        } else {
            XB_SPIN(xb_ld(&bar[XB_XGEN(x)]) == gen, bar);
            __builtin_amdgcn_fence(__ATOMIC_ACQUIRE, "agent");
            asm volatile("s_waitcnt vmcnt(0)" ::: "memory");
        }
    }
    __syncthreads();
}
__global__ void __launch_bounds__(NTHREADS) mk_forward(Params p) {
    extern __shared__ __attribute__((aligned(16))) char smem[];
    cg::grid_group grid = cg::this_grid();
    typedef const Params __attribute__((address_space(4)))* KPtr;
    volatile unsigned* xst = (volatile unsigned*)(smem + LDS_BYTES);
    if (threadIdx.x < 2) xst[threadIdx.x] = 0u;
    if (p.ph_lo == 0x7fffffff) grid.sync();
    xcd_barrier_post((unsigned*)(p.ws + WS_XBAR));
#define PHASE(k, fn) { KPtr kp = (KPtr)__builtin_amdgcn_kernarg_segment_ptr(); asm volatile("" : "+s"(kp)); fn(*(const Params*)kp, smem); \
        unsigned* xbar = (unsigned*)(((const Params*)kp)->ws + WS_XBAR); \
        if ((k) + 1 < NPHASES) xcd_barrier(xbar, xst); }
    PHASE(0, phase0) PHASE(1, phase1) PHASE(2, phase2)
    if (!USE_G8) PHASE(3, phase_halo)
    PHASE(4, phase_fir) PHASE(5, phase3) PHASE(6, phase4)
    PHASE(7, phase5) PHASE(8, phase6) PHASE(9, phase7) PHASE(10, phase8) PHASE(11, phase9) PHASE(12, phase10)
#undef PHASE
}

extern "C" void kernel_launch(void* const* d_in, const int* in_sizes, int n_in, void* d_out, int out_size, void* d_ws, size_t ws_size, hipStream_t stream) {
    static int grid_blocks = 0;
    if (grid_blocks == 0) {
        if (n_in != 35 || out_size != T_LAT * D || ws_size < WS_END || (size_t)out_size * 4 < AUX_END) {
            fprintf(stderr, "kernel_launch: unexpected shapes (n_in %d out %d ws %zu need %zu aux need %zu)\n", n_in, out_size, ws_size, (size_t)WS_END, (size_t)AUX_END);
            grid_blocks = -1; return;
        }
        int dev = 0, cus = 0, per_cu = 0;
        hipGetDevice(&dev);
        hipDeviceGetAttribute(&cus, hipDeviceAttributeMultiprocessorCount, dev);
        hipFuncSetAttribute((const void*)mk_forward, hipFuncAttributeMaxDynamicSharedMemorySize, LDS_BYTES + 256);
        hipOccupancyMaxActiveBlocksPerMultiprocessor(&per_cu, (const void*)mk_forward, NTHREADS, LDS_BYTES + 256);
        if (per_cu < 1) { fprintf(stderr, "kernel_launch: occupancy query says %d blocks/CU\n", per_cu); per_cu = 1; }
        if (per_cu > 1) per_cu = 1;
        grid_blocks = cus * per_cu;
    }
    if (grid_blocks < 0) return;
    Params p{};
    for (int i = 0; i < 35; ++i) p.in[i] = (const float*)d_in[i];
    p.out = (float*)d_out; p.ws = (char*)d_ws; p.aux = (char*)d_out;
    p.ph_lo = 0; p.ph_hi = NPHASES;
    (void)hipMemsetAsync((char*)d_ws + WS_XBAR, 0, 3456 * 4, stream);
    void* args[] = {&p};
    hipError_t e = hipLaunchCooperativeKernel((const void*)mk_forward, dim3(grid_blocks), dim3(NTHREADS), args, LDS_BYTES + 256, stream);
    if (e != hipSuccess) fprintf(stderr, "cooperative launch failed: %s (grid %d)\n", hipGetErrorString(e), grid_blocks);
}
#endif
```

```cpp
#ifndef EMU
#include <hip/hip_runtime.h>
#include <hip/hip_cooperative_groups.h>
#include <cstdio>
#endif
#include <stdint.h>
#include <stddef.h>

#ifndef CFG_D
#define CFG_D 1024
#define CFG_B 8
#define CFG_S 2048
#define CFG_CTX 256
#endif
#ifndef MK_LAUNCHES
#define MK_LAUNCHES 1
#endif

typedef unsigned short bf16_t;
typedef short bf16x8 __attribute__((ext_vector_type(8)));
typedef float f32x4 __attribute__((ext_vector_type(4)));
typedef unsigned u32x4 __attribute__((ext_vector_type(4)));
typedef unsigned u32x2 __attribute__((ext_vector_type(2)));

#define DI __device__ __forceinline__
DI int tid_x() { int t = (int)threadIdx.x;
#ifndef EMU
    asm volatile("" : "+v"(t));
#endif
    return t; }

constexpr int D = CFG_D, NB = CFG_B, S = CFG_S, CTXL = CFG_CTX;
constexpr int GW = 64, ROWS = S / GW;
constexpr int T_CTX = NB * CTXL, T_LAT = NB * S, T_ALL = T_CTX + T_LAT;
constexpr int H_A = 4, H_B = 8;
constexpr int A_COLS = 2064, B_COLS = 1920;
constexpr int IN_COLS = A_COLS + B_COLS + 2 * D;
constexpr int COL_B0 = A_COLS, COL_G0 = A_COLS + B_COLS;
constexpr int CTX_COLS = COL_G0;
constexpr int NP = ((IN_COLS + 127) / 128) * 128;
constexpr int NEXP = 32, DE = 256;
constexpr int NV = NB + 1;
constexpr int NTHREADS = 512;
constexpr int MREP = (T_CTX % 256 == 0 && T_LAT % 256 == 0) ? 4 : 2;
constexpr int BM = 64 * MREP;
constexpr int NPHASES = 13;
enum { PH_MOD = 0, PH_U, PH_P, PH_HALO, PH_FIR, PH_CHAINS, PH_POST, PH_MERGE, PH_WOUT, PH_ROUTER, PH_UP, PH_DOWN, PH_FINAL };
constexpr int LDS_BYTES = 155648;
constexpr int CAP = T_LAT;

static_assert(D % 256 == 0 && S % 64 == 0 && CTXL % 64 == 0 && T_CTX % BM == 0 && T_LAT % BM == 0, "shape");

constexpr size_t al256(size_t x) { return (x + 255) & ~(size_t)255; }
constexpr int CNT_STRIDE = 64;
constexpr size_t WS_CNT = 512 + 3456 * 4 + 256;
constexpr size_t WS_BAR = 256;
constexpr size_t WS_XBAR = 512;
constexpr size_t WS_MOD = 512 + 3456 * 4 + 256 + 32 * 64 * 4;
constexpr size_t WS_AB = al256(WS_MOD + (size_t)NV * 6 * D * 4);
constexpr size_t WS_BONUS = al256(WS_AB + (size_t)T_ALL * 16 * 4);
constexpr size_t WS_PAIRW = al256(WS_BONUS + (size_t)2 * T_LAT * 8 * 4);
constexpr size_t WS_ROWLIST = al256(WS_PAIRW + (size_t)T_LAT * 2 * 4);
constexpr size_t WS_WRT = al256(WS_ROWLIST + (size_t)NEXP * CAP * 4);
constexpr size_t WS_G2T = al256(WS_WRT + (size_t)36 * D * 4);
constexpr size_t WS_WOA = al256(WS_G2T + (size_t)512 * 128 * 2);
constexpr size_t WS_WOB = al256(WS_WOA + (size_t)D * 512 * 2);
constexpr size_t WS_WOUT = al256(WS_WOB + (size_t)D * 512 * 2);
constexpr size_t WS_OA = al256(WS_WOUT + (size_t)D * D * 2);
constexpr size_t WS_OB = al256(WS_OA + (size_t)T_LAT * 512 * 2);
constexpr size_t WS_HALO_A = WS_OA;
constexpr size_t WS_HALO_B = WS_OA + al256((size_t)(T_ALL / 64) * 4 * 1536 * 2);
static_assert(WS_HALO_B + (size_t)(T_ALL / 64) * 2 * 1920 * 2 <= WS_OB + (size_t)T_LAT * 512 * 2, "halo buffers");
constexpr size_t WS_DNT = WS_OA;
constexpr size_t WS_SPARE_END = al256(WS_OB + (size_t)T_LAT * 512 * 2) > al256(WS_DNT + (size_t)NEXP * D * DE * 2) ? al256(WS_OB + (size_t)T_LAT * 512 * 2) : al256(WS_DNT + (size_t)NEXP * D * DE * 2);
constexpr size_t WS_P = WS_SPARE_END;
constexpr size_t WS_PLAT = WS_P;
constexpr size_t WS_PCTX = al256(WS_PLAT + (size_t)T_LAT * IN_COLS * 2);
constexpr size_t WS_P_END = al256(WS_PCTX + (size_t)T_CTX * CTX_COLS * 2);
constexpr size_t WS_H = WS_P;
constexpr size_t WS_T = al256(WS_H + (size_t)T_LAT * D * 4);
constexpr size_t WS_HID = al256(WS_T + (size_t)T_LAT * D * 2);
constexpr size_t WS_OPAIR = al256(WS_HID + (size_t)T_LAT * 2 * DE * 2);
constexpr size_t WS_P2_END = al256(WS_OPAIR + (size_t)T_LAT * 2 * D * 2);
constexpr size_t WS_END = WS_P_END > WS_P2_END ? WS_P_END : WS_P2_END;
constexpr size_t AUX_WINT = 0;
constexpr size_t AUX_U = al256((size_t)NP * D * 2);
constexpr size_t AUX_ODIR = 0;
constexpr size_t AUX_YDIR = (size_t)2 * T_LAT * 512 * 2;
constexpr size_t AUX_Y = 0;
constexpr size_t AUX_GUT = (size_t)T_LAT * D * 2;
constexpr size_t AUX_END1 = AUX_U + (size_t)T_ALL * D * 2;
constexpr size_t AUX_END2 = AUX_YDIR + (size_t)2 * T_LAT * 512 * 2;
constexpr size_t AUX_END3 = AUX_GUT + (size_t)NEXP * 512 * D * 2;
constexpr size_t AUX_END = (AUX_END1 > AUX_END2 ? (AUX_END1 > AUX_END3 ? AUX_END1 : AUX_END3) : (AUX_END2 > AUX_END3 ? AUX_END2 : AUX_END3));

struct Params {
    const float* in[35];
    float* out;
    char* ws;
    char* aux;
    int ph_lo, ph_hi;
};
enum { I_X = 0, I_C, I_CTX, I_CCTX, I_ADAW, I_ADAB, I_NMIX, I_NFFN, I_WIN, I_CONV, I_ALOG, I_DTB, I_ONORM, I_MU, I_W0, I_W2, I_A0, I_A2, I_G2, I_KK, I_KA, I_RK, I_LNG, I_LNB, I_WOA, I_WOB, I_WOUT, I_RG, I_RGB, I_RE, I_REB, I_MG, I_MU_UP, I_MD, I_FIN };

DI float bf2f(bf16_t v) { union { unsigned u; float f; } x; x.u = ((unsigned)v) << 16; return x.f; }
#ifdef EMU
DI bf16_t f2bf(float f) { union { float f; unsigned u; } x; x.f = f; unsigned u = x.u; u += 0x7fffu + ((u >> 16) & 1u); return (bf16_t)(u >> 16); }
DI unsigned pk2(float lo, float hi) { return (unsigned)f2bf(lo) | ((unsigned)f2bf(hi) << 16); }
#else
typedef __bf16 hbf16x2 __attribute__((ext_vector_type(2)));
typedef float f32x2_ __attribute__((ext_vector_type(2)));
DI bf16_t f2bf(float f) { return __builtin_bit_cast(unsigned short, (__bf16)f); }
DI unsigned pk2(float lo, float hi) { const f32x2_ v = {lo, hi}; return __builtin_bit_cast(unsigned, __builtin_convertvector(v, hbf16x2)); }
#endif
DI float sigmoidf_(float x) { return 1.0f / (1.0f + expf(-x)); }
DI float siluf_(float x) { return x / (1.0f + expf(-x)); }
DI float softplusf_(float x) { return x > 20.f ? x : log1pf(expf(x)); }
DI float wave_sum(float v) {
#pragma unroll
    for (int o = 1; o < 64; o <<= 1) v += __shfl_xor(v, o);
    return v;
}
#ifdef EMU
#define MFMA16(a, b, c) emu_mfma16((a), (b), (c))
#define WAVE_SYNC() emu::wave_bar()
#else
#define MFMA16(a, b, c) __builtin_amdgcn_mfma_f32_16x16x32_bf16((a), (b), (c), 0, 0, 0)
#define WAVE_SYNC() asm volatile("s_waitcnt lgkmcnt(0)" ::: "memory")
#endif
#ifdef EMU
#define LDS_BARRIER() __syncthreads()
#else
#define LDS_BARRIER() do { asm volatile("s_waitcnt lgkmcnt(0)" ::: "memory"); __builtin_amdgcn_s_barrier(); asm volatile("" ::: "memory"); } while (0)
#endif

typedef float f32x16 __attribute__((ext_vector_type(16)));
typedef float f32x2_ac __attribute__((ext_vector_type(2)));
typedef short bf16x4 __attribute__((ext_vector_type(4)));
#ifdef EMU
#define MFMA32(a, b, c) emu_mfma32((a), (b), (c))
DI float fexp(float x) { return expf(x); }
DI float flog(float x) { return logf(x); }
DI float frcp(float x) { return 1.0f / x; }
DI float frsq(float x) { return 1.0f / sqrtf(x); }
DI float wave_sum_fast(float v) { return wave_sum(v); }
#else
#define MFMA32(a, b, c) __builtin_amdgcn_mfma_f32_32x32x16_bf16((a), (b), (c), 0, 0, 0)
DI float fexp(float x) { return __expf(x); }
DI float flog(float x) { return __logf(x); }
DI float frcp(float x) { return __builtin_amdgcn_rcpf(x); }
DI float frsq(float x) { return __builtin_amdgcn_rsqf(x); }
#define DPP_ADD(v, ctrl) ((v) + __builtin_bit_cast(float, __builtin_amdgcn_update_dpp(0, __builtin_bit_cast(int, (v)), (ctrl), 0xf, 0xf, false)))
DI float wave_sum_fast(float v) {
    v = DPP_ADD(v, 0xB1); v = DPP_ADD(v, 0x4E); v = DPP_ADD(v, 0x141); v = DPP_ADD(v, 0x140);
    const int iv = __builtin_bit_cast(int, v);
    return (__builtin_bit_cast(float, __builtin_amdgcn_readlane(iv, 0)) + __builtin_bit_cast(float, __builtin_amdgcn_readlane(iv, 16))) +
           (__builtin_bit_cast(float, __builtin_amdgcn_readlane(iv, 32)) + __builtin_bit_cast(float, __builtin_amdgcn_readlane(iv, 48)));
}
#endif
DI float fsigmoid(float x) { return frcp(1.0f + fexp(-x)); }
DI float fsilu(float x) { return x * fsigmoid(x); }
DI float fsoftplus(float x) { return fmaxf(x, 0.f) + flog(1.f + fexp(-fabsf(x))); }
DI float ftanh(float x) { return 1.0f - 2.0f * frcp(1.0f + fexp(2.0f * x)); }

constexpr int LDS_ROW = 40;
constexpr int GEMM_A_BYTES = BM * LDS_ROW * 2, GEMM_B_BYTES = 128 * LDS_ROW * 2;
template <int MR, class ARow>
DI void gemm_kloop(f32x4 (&acc)[MR][4], char* smem, ARow arow, const bf16_t* Bt, int ldb, int K) {
    constexpr int BM = 64 * MR;
    const int tid = tid_x(), lane = tid & 63, wave = tid >> 6, wr = wave >> 1, wc = wave & 1, fr = lane & 15, fq = lane >> 4;
    bf16_t* As = (bf16_t*)smem;
    bf16_t* Bs = (bf16_t*)(smem + 2 * GEMM_A_BYTES);
    constexpr int ACH = BM * 4 / NTHREADS;
    static_assert(ACH >= 1, "tile");
    const bf16_t* ap[ACH];
#pragma unroll
    for (int i = 0; i < ACH; ++i) { const int q = tid + i * NTHREADS; ap[i] = arow(q >> 2) + (q & 3) * 8; }
    const bf16_t* bp = Bt + (size_t)(tid >> 2) * ldb + (tid & 3) * 8;
    u32x4 ra[ACH], rb;
#pragma unroll
    for (int i = 0; i < ACH; ++i) ra[i] = *(const u32x4*)(ap[i]);
    rb = *(const u32x4*)(bp);
    const int nk = K / 32;
    for (int kt = 0; kt < nk; ++kt) {
        const int buf = kt & 1;
#pragma unroll
        for (int i = 0; i < ACH; ++i) { const int q = tid + i * NTHREADS; *(u32x4*)(As + (buf * BM + (q >> 2)) * LDS_ROW + (q & 3) * 8) = ra[i]; }
        *(u32x4*)(Bs + (buf * 128 + (tid >> 2)) * LDS_ROW + (tid & 3) * 8) = rb;
        __syncthreads();
        if (kt + 1 < nk) {
#pragma unroll
            for (int i = 0; i < ACH; ++i) ra[i] = *(const u32x4*)(ap[i] + (kt + 1) * 32);
            rb = *(const u32x4*)(bp + (kt + 1) * 32);
        }
        bf16x8 af[MR], bfr[4];
#pragma unroll
        for (int m = 0; m < MR; ++m) af[m] = *(const bf16x8*)(As + (buf * BM + wr * 16 * MR + m * 16 + fr) * LDS_ROW + fq * 8);
#pragma unroll
        for (int n = 0; n < 4; ++n) bfr[n] = *(const bf16x8*)(Bs + (buf * 128 + wc * 64 + n * 16 + fr) * LDS_ROW + fq * 8);
#pragma unroll
        for (int m = 0; m < MR; ++m)
#pragma unroll
            for (int n = 0; n < 4; ++n) acc[m][n] = MFMA16(af[m], bfr[n], acc[m][n]);
    }
    __syncthreads();
}
template <int MR>
DI void acc_zero(f32x4 (&acc)[MR][4]) {
#pragma unroll
    for (int m = 0; m < MR; ++m)
#pragma unroll
        for (int n = 0; n < 4; ++n) acc[m][n] = (f32x4){0.f, 0.f, 0.f, 0.f};
}

namespace g8 {
constexpr int BM = 256, BK = 64, HALF = 128, HT = HALF * BK;
constexpr int LDS_NEED = 8 * HT * 2;
DI int lds_byte(int r, int c) { const int st = (r >> 4) * 2 + (c >> 5), rr = r & 15, cc = c & 31, ob = rr * 64 + cc * 2; return st * 1024 + (ob ^ (((ob >> 9) & 1) << 5)); }
DI void stage_rc(int b, int& R, int& C) { const int st = b / 1024, sb = b % 1024, swz = sb ^ (((sb >> 9) & 1) << 5); R = (st >> 1) * 16 + swz / 64; C = (st & 1) * 32 + (swz % 64) / 2; }
#ifdef EMU
#define G8_GLDS(src, dst) emu_global_load_lds16((src), (dst))
#define G8_WAIT_V(n)
#define G8_WAIT_L(n)
#define G8_BAR __syncthreads()
#define G8_SCHED
#define G8_PRIO(x)
#else
#define G8_GLDS(src, dst) __builtin_amdgcn_global_load_lds((const unsigned*)(src), (__attribute__((address_space(3))) unsigned*)(dst), 16, 0, 0)
#define G8_WAIT_V(n) asm volatile("s_waitcnt vmcnt(" #n ")" ::: "memory")
#define G8_WAIT_L(n) asm volatile("s_waitcnt lgkmcnt(" #n ")" ::: "memory")
#define G8_BAR __builtin_amdgcn_s_barrier()
#define G8_SCHED __builtin_amdgcn_sched_barrier(0)
#define G8_PRIO(x) __builtin_amdgcn_s_setprio(x)
#endif
typedef f32x4 Acc[2][2][4][2];
template <class AOff>
DI void kloop_g(Acc& acc, char* smem, const bf16_t* A, AOff aoff, const bf16_t* Bt, int ldb, int K, int bcol) {
    bf16_t* shm = (bf16_t*)smem;
    const int tid = tid_x(), wid = tid >> 6, lane = tid & 63, wr = wid >> 2, wc = wid & 3, fr = lane & 15, fq = lane >> 4;
    int ao[2][2];
#pragma unroll
    for (int h = 0; h < 2; ++h)
#pragma unroll
        for (int i = 0; i < 2; ++i) { int R, C; stage_rc(tid * 16 + i * 8192, R, C); ao[h][i] = aoff(h * HALF + R) + C; }
#define G8_STAGE_A(P, h, kt) do { for (int _i = 0; _i < 2; ++_i) { const int _b = tid * 16 + _i * 8192; G8_GLDS(A + (size_t)ao[h][_i] + (size_t)(kt) * BK, (char*)(P) + _b); } } while (0)
#define G8_SA(b, h) (shm + ((b) * 2 + (h)) * HT)
#define G8_SB(b, h) (shm + (4 + (b) * 2 + (h)) * HT)
#define G8_STAGE(P, BASE, LD, br, kt) do { const bf16_t* _g = (BASE) + (size_t)(br) * (LD) + (size_t)(kt) * BK; \
    for (int _i = 0; _i < 2; ++_i) { const int _b = tid * 16 + _i * 8192; int _r, _c; stage_rc(_b, _r, _c); G8_GLDS(_g + (size_t)_r * (LD) + _c, (char*)(P) + _b); } } while (0)
#define G8_LDA(dst, b, h) for (int m = 0; m < 4; ++m) for (int k = 0; k < 2; ++k) dst[m][k] = *(const bf16x8*)((const char*)G8_SA(b, h) + lds_byte(wr * 64 + m * 16 + fr, k * 32 + fq * 8))
#define G8_LDB(dst, b, h) for (int n = 0; n < 2; ++n) for (int k = 0; k < 2; ++k) dst[n][k] = *(const bf16x8*)((const char*)G8_SB(b, h) + lds_byte(wc * 32 + n * 16 + fr, k * 32 + fq * 8))
#define G8_MMA(ai, bj, At_, Bt_) do { G8_PRIO(1); for (int m = 0; m < 4; ++m) for (int n = 0; n < 2; ++n) for (int k = 0; k < 2; ++k) \
    acc[ai][bj][m][n] = MFMA16(Bt_[n][k], At_[m][k], acc[ai][bj][m][n]); G8_PRIO(0); } while (0)
    bf16x8 At[4][2], B0[2][2], B1[2][2];
    const int nt = K / BK;
    G8_STAGE(G8_SB(0, 0), Bt, ldb, bcol, 0); G8_STAGE_A(G8_SA(0, 0), 0, 0);
    G8_STAGE(G8_SB(0, 1), Bt, ldb, bcol + HALF, 0); G8_STAGE_A(G8_SA(0, 1), 1, 0);
    if (wr == 1) G8_BAR;
    G8_WAIT_V(4); G8_BAR;
    G8_STAGE(G8_SB(1, 0), Bt, ldb, bcol, 1); G8_STAGE_A(G8_SA(1, 0), 0, 1); G8_STAGE(G8_SB(1, 1), Bt, ldb, bcol + HALF, 1);
    G8_WAIT_V(6); G8_BAR;
    for (int t = 0; t < nt - 2; t += 2) {
        G8_LDB(B0, 0, 0); G8_SCHED; G8_LDA(At, 0, 0); G8_STAGE_A(G8_SA(1, 1), 1, t + 1);
        G8_WAIT_L(8); G8_BAR; G8_WAIT_L(0); G8_MMA(0, 0, At, B0); G8_BAR; G8_SCHED;
        G8_LDB(B1, 0, 1); G8_STAGE(G8_SB(0, 0), Bt, ldb, bcol, t + 2);
        G8_BAR; G8_WAIT_L(0); G8_MMA(0, 1, At, B1); G8_BAR;
        G8_LDA(At, 0, 1); G8_STAGE_A(G8_SA(0, 0), 0, t + 2);
        G8_BAR; G8_WAIT_L(0); G8_MMA(1, 0, At, B0); G8_BAR; G8_SCHED;
        G8_STAGE(G8_SB(0, 1), Bt, ldb, bcol + HALF, t + 2);
        G8_WAIT_V(6); G8_BAR; G8_MMA(1, 1, At, B1); G8_BAR;
        G8_LDB(B0, 1, 0); G8_SCHED; G8_LDA(At, 1, 0); G8_STAGE_A(G8_SA(0, 1), 1, t + 2);
        G8_WAIT_L(8); G8_BAR; G8_WAIT_L(0); G8_MMA(0, 0, At, B0); G8_BAR; G8_SCHED;
        G8_LDB(B1, 1, 1); G8_STAGE(G8_SB(1, 0), Bt, ldb, bcol, t + 3);
        G8_BAR; G8_WAIT_L(0); G8_MMA(0, 1, At, B1); G8_BAR;
        G8_LDA(At, 1, 1); G8_STAGE_A(G8_SA(1, 0), 0, t + 3);
        G8_BAR; G8_WAIT_L(0); G8_MMA(1, 0, At, B0); G8_BAR; G8_SCHED;
        G8_STAGE(G8_SB(1, 1), Bt, ldb, bcol + HALF, t + 3);
        G8_WAIT_V(6); G8_BAR; G8_MMA(1, 1, At, B1); G8_BAR;
    }
    { G8_LDB(B0, 0, 0); G8_LDA(At, 0, 0); G8_STAGE_A(G8_SA(1, 1), 1, nt - 1);
      G8_BAR; G8_WAIT_L(0); G8_MMA(0, 0, At, B0); G8_BAR;
      G8_LDB(B1, 0, 1); G8_BAR; G8_WAIT_L(0); G8_MMA(0, 1, At, B1); G8_BAR;
      G8_LDA(At, 0, 1); G8_WAIT_V(4); G8_BAR; G8_WAIT_L(0); G8_MMA(1, 0, At, B0); G8_MMA(1, 1, At, B1); G8_BAR; }
    { G8_LDB(B0, 1, 0); G8_LDA(At, 1, 0); G8_WAIT_V(2); G8_BAR; G8_WAIT_L(0); G8_MMA(0, 0, At, B0); G8_BAR;
      G8_LDB(B1, 1, 1); G8_WAIT_V(0); G8_BAR; G8_WAIT_L(0); G8_MMA(0, 1, At, B1); G8_BAR;
      G8_LDA(At, 1, 1); G8_BAR; G8_WAIT_L(0); G8_MMA(1, 0, At, B0); G8_MMA(1, 1, At, B1); G8_BAR; }
    if (wr == 0) G8_BAR;
#undef G8_SA
#undef G8_SB
#undef G8_STAGE
#undef G8_STAGE_A
#undef G8_LDA
#undef G8_LDB
#undef G8_MMA
}
DI void kloop(Acc& acc, char* smem, const bf16_t* A, int lda, const bf16_t* Bt, int ldb, int K, int brow, int bcol) {
    kloop_g(acc, smem, A, [&](int r) { return (brow + r) * lda; }, Bt, ldb, K, bcol);
}
DI bool tile_order(int L, int nM, int nN, int& pm, int& pn) {
    constexpr int NXCD = 8, WGM = 8;
    const int nwg = nM * nN; if (L >= nwg) return false;
    int wgid = L; { const int q = nwg / NXCD, r = nwg % NXCD, xcd = wgid % NXCD, off = wgid / NXCD; wgid = (xcd < r ? xcd * (q + 1) : r * (q + 1) + (xcd - r) * q) + off; }
    const int nig = WGM * nN, gid = wgid / nig, fm = gid * WGM, gsz = (nM - fm) < WGM ? (nM - fm) : WGM;
    pm = fm + ((wgid % nig) % gsz); pn = (wgid % nig) / gsz; return true;
}
DI void acc_zero(Acc& acc) {
#pragma unroll
    for (int a = 0; a < 2; ++a)
#pragma unroll
        for (int b = 0; b < 2; ++b)
#pragma unroll
            for (int m = 0; m < 4; ++m)
#pragma unroll
                for (int n = 0; n < 2; ++n) acc[a][b][m][n] = (f32x4){0.f, 0.f, 0.f, 0.f};
}
template <class F> DI void for_each_quad(const Acc& acc, int brow, int bcol, F f) {
    const int tid = tid_x(), wid = tid >> 6, lane = tid & 63, wr = wid >> 2, wc = wid & 3, fr = lane & 15, fq = lane >> 4;
#pragma unroll
    for (int ai = 0; ai < 2; ++ai)
#pragma unroll
        for (int m = 0; m < 4; ++m)
#pragma unroll
            for (int bj = 0; bj < 2; ++bj)
#pragma unroll
                for (int n = 0; n < 2; ++n) f(brow + ai * HALF + wr * 64 + m * 16 + fr, bcol + bj * HALF + wc * 32 + n * 16 + fq * 4, acc[ai][bj][m][n]);
}
}

constexpr bool USE_G8 = ((NB * CTXL) % 256 == 0) && ((NB * S) % 256 == 0) && (NP % 256 == 0) && (D % 256 == 0) && (D >= 256);
DI int gu_row(int c, int up) {
    if (USE_G8) return (c >> 7) * 256 + ((c >> 6) & 1) * 128 + ((c >> 4) & 3) * 32 + (up ? 16 : 0) + (c & 15);
    return (c >> 6) * 128 + ((c >> 5) & 1) * 64 + ((c >> 4) & 1) * 16 + (c & 15) + (up ? 32 : 0);
}
DI void transpose_item(const float* W, int N, int Nvalid, int k0, int n0, bf16_t* WT, int ldt, int mode, float* scr, int lane) {
    float tv[32];
#pragma unroll
    for (int i = 0; i < 32; ++i) {
        const int kk = 2 * i + (lane >> 5), n = n0 + (lane & 31);
        tv[i] = (n < Nvalid) ? W[(size_t)(k0 + kk) * N + n] : 0.f;
    }
#pragma unroll
    for (int i = 0; i < 32; ++i) scr[(2 * i + (lane >> 5)) * 33 + (lane & 31)] = tv[i];
    WAVE_SYNC();
    const int c = lane & 7;
#pragma unroll
    for (int j = 0; j < 4; ++j) {
        const int nl = (lane >> 3) + 8 * j; const float* s = scr + (8 * c) * 33 + nl;
        u32x4 o; o.x = pk2(s[0], s[33]); o.y = pk2(s[2 * 33], s[3 * 33]); o.z = pk2(s[4 * 33], s[5 * 33]); o.w = pk2(s[6 * 33], s[7 * 33]);
        const int n = n0 + nl; const int row = mode == 0 ? n : gu_row(n, mode == 2);
        *(u32x4*)(WT + (size_t)row * ldt + k0 + 8 * c) = o;
    }
    WAVE_SYNC();
}
DI void transpose_matrix(const float* W, int K, int N, int Npad, bf16_t* WT, int mode, char* smem, int gw, int ngw, int& base) {
    const int lane = tid_x() & 63, wave = tid_x() >> 6;
    float* scr = (float*)smem + wave * (64 * 33);
    const int nkb = K / 64, nnb = Npad / 32, nitems = nkb * nnb;
    int first = ((gw - base) % ngw + ngw) % ngw;
    for (int it = first; it < nitems; it += ngw) {
        const int kb = it / nnb, nb = it % nnb;
        transpose_item(W, N, N, kb * 64, nb * 32, WT, K, mode, scr, lane);
    }
    base = (base + nitems) % ngw;
}

DI void phase0(const Params& p, char* smem) {
    const int tid = tid_x(), lane = tid & 63, wave = tid >> 6;
    if (blockIdx.x == 0 && tid < NEXP) ((int*)(p.ws + WS_CNT))[tid * CNT_STRIDE] = 0;
    if (blockIdx.x == 0 && tid == 0) *(unsigned*)(p.ws + WS_BAR) = 0u;
    float* sil = (float*)smem;
    float* red = sil + NV * D;
    const int nitems = 6 * D / 32;
    bool did = false;
    for (int it = blockIdx.x; it < nitems; it += gridDim.x) {
        if (!did) {
            for (int i = tid; i < NV * D; i += NTHREADS) { const int v = i / D, k = i % D; const float cv = v < NB ? p.in[I_C][v * D + k] : p.in[I_CCTX][k]; sil[i] = siluf_(cv); }
            did = true;
        }
        __syncthreads();
        const int col = it * 32 + (lane & 31), rp = lane >> 5;
        float acc[NV];
#pragma unroll
        for (int v = 0; v < NV; ++v) acc[v] = 0.f;
        const int r0 = wave * (D / 8);
        float wv[D / 16];
#pragma unroll
        for (int i = 0; i < D / 16; ++i) wv[i] = p.in[I_ADAW][(size_t)(r0 + 2 * i + rp) * (6 * D) + col];
#pragma unroll
        for (int i = 0; i < D / 16; ++i) {
            const int row = r0 + 2 * i + rp;
#pragma unroll
            for (int v = 0; v < NV; ++v) acc[v] += sil[v * D + row] * wv[i];
        }
#pragma unroll
        for (int v = 0; v < NV; ++v) red[((wave * 2 + rp) * NV + v) * 32 + (lane & 31)] = acc[v];
        __syncthreads();
        if (tid < NV * 32) {
            const int v = tid / 32, cl = tid % 32; float s = p.in[I_ADAB][it * 32 + cl];
            for (int g = 0; g < 16; ++g) s += red[(g * NV + v) * 32 + cl];
            ((float*)(p.ws + WS_MOD))[(size_t)v * 6 * D + it * 32 + cl] = s;
        }
    }
    __syncthreads();
    const int gw = blockIdx.x * 8 + wave, ngw = gridDim.x * 8; int base = 0;
    {
        float* scr = (float*)smem + wave * (64 * 33);
        const int nkb = D / 64, nnb = NP / 32, nitems2 = nkb * nnb;
        for (int it = gw; it < nitems2; it += ngw) { const int kb = it / nnb, nb = it % nnb; transpose_item(p.in[I_WIN], IN_COLS, IN_COLS, kb * 64, nb * 32, (bf16_t*)(p.aux + AUX_WINT), D, 0, scr, lane); }
        base = nitems2 % ngw;
    }
    { float* WRT = (float*)(p.ws + WS_WRT);
      for (int i = blockIdx.x * NTHREADS + tid; i < 36 * D; i += gridDim.x * NTHREADS) { const int j = i / D, k = i % D; WRT[i] = j < 4 ? p.in[I_RG][(size_t)k * 4 + j] : p.in[I_RE][(size_t)k * 32 + (j - 4)]; } }
    transpose_matrix(p.in[I_WOA], 512, D, D, (bf16_t*)(p.ws + WS_WOA), 0, smem, gw, ngw, base);
    transpose_matrix(p.in[I_WOB], 512, D, D, (bf16_t*)(p.ws + WS_WOB), 0, smem, gw, ngw, base);
    transpose_matrix(p.in[I_WOUT], D, D, D, (bf16_t*)(p.ws + WS_WOUT), 0, smem, gw, ngw, base);
    transpose_matrix(p.in[I_G2], 128, 512, 512, (bf16_t*)(p.ws + WS_G2T), 0, smem, gw, ngw, base);
}

constexpr int NSEG = T_ALL / 64, NSEG_CTX = T_CTX / 64;
DI void halo_store(const Params& p, int row, int col, const u32x2& o) {
    int seq, b, j;
    if (row < T_CTX) { seq = 0; b = row / CTXL; j = row % CTXL; } else { seq = 1; const int rr = row - T_CTX; b = rr / S; j = rr % S; }
    const int L = seq ? S : CTXL; const int segbase = seq ? NSEG_CTX + b * (S / 64) : b * (CTXL / 64);
    if (col < 1536) {
        const int jm = j & 63;
        if (jm >= 62 && j + 2 < L) { const int g = segbase + (j >> 6) + 1; *(u32x2*)((bf16_t*)(p.ws + WS_HALO_A) + ((size_t)g * 4 + (jm - 62)) * 1536 + col) = o; }
        if (jm < 2 && j >= 64) { const int g = segbase + (j >> 6) - 1; *(u32x2*)((bf16_t*)(p.ws + WS_HALO_A) + ((size_t)g * 4 + 2 + jm) * 1536 + col) = o; }
    } else if (col >= COL_B0 && col < COL_B0 + 1920) {
        const int js = seq ? (j % GW) * ROWS + j / GW : j; const int jm = js & 63;
        if (jm == 63 && js + 1 < L) { const int g = segbase + (js >> 6) + 1; *(u32x2*)((bf16_t*)(p.ws + WS_HALO_B) + ((size_t)g * 2 + 0) * 1920 + (col - COL_B0)) = o; }
        if (jm == 0 && js >= 64) { const int g = segbase + (js >> 6) - 1; *(u32x2*)((bf16_t*)(p.ws + WS_HALO_B) + ((size_t)g * 2 + 1) * 1920 + (col - COL_B0)) = o; }
    }
}
DI void halo_zero_fill(const Params& p) {
    const int tid = tid_x(), lane = tid & 63, wave = tid >> 6; const int gw = blockIdx.x * 8 + wave, ngw = gridDim.x * 8;
    bf16_t* HA = (bf16_t*)(p.ws + WS_HALO_A); bf16_t* HB = (bf16_t*)(p.ws + WS_HALO_B);
    for (int it = gw; it < NSEG * 2; it += ngw) {
        const int g = it >> 1, side = it & 1;
        const bool ctx = g < NSEG_CTX; const int sg = ctx ? g % (CTXL / 64) : (g - NSEG_CTX) % (S / 64); const int nsg = ctx ? CTXL / 64 : S / 64;
        const bool edge = side ? (sg == nsg - 1) : (sg == 0);
        if (!edge) continue;
        for (int c = lane; c < 384; c += 64) *(u32x4*)(HA + ((size_t)g * 4 + 2 * side) * 1536 + c * 8) = (u32x4){0u, 0u, 0u, 0u};
        for (int c = lane; c < 240; c += 64) *(u32x4*)(HB + ((size_t)g * 2 + side) * 1920 + c * 8) = (u32x4){0u, 0u, 0u, 0u};
    }
}
DI void phase1(const Params& p, char* smem) {
    if (USE_G8) halo_zero_fill(p);
    const int lane = tid_x() & 63, wave = tid_x() >> 6;
    const int gw = blockIdx.x * 8 + wave, ngw = gridDim.x * 8;
    const float* mod = (const float*)(p.ws + WS_MOD);
    bf16_t* U = (bf16_t*)(p.aux + AUX_U);
    auto rowsrc = [&](int r) -> const float* { return r < T_CTX ? p.in[I_CTX] + (size_t)r * D : p.in[I_X] + (size_t)(r - T_CTX) * D; };
    f32x4 xn[D / 256];
    if (gw < T_ALL) {
#pragma unroll
        for (int j = 0; j < D / 256; ++j) xn[j] = *(const f32x4*)(rowsrc(gw) + j * 256 + lane * 4);
    }
    for (int r = gw; r < T_ALL; r += ngw) {
        const int v = r < T_CTX ? NB : (r - T_CTX) / S;
        f32x4 x[D / 256]; float ss = 0.f;
#pragma unroll
        for (int j = 0; j < D / 256; ++j) { x[j] = xn[j]; ss += x[j].x * x[j].x + x[j].y * x[j].y + x[j].z * x[j].z + x[j].w * x[j].w; }
        if (r + ngw < T_ALL) {
#pragma unroll
            for (int j = 0; j < D / 256; ++j) xn[j] = *(const f32x4*)(rowsrc(r + ngw) + j * 256 + lane * 4);
        }
        ss = wave_sum_fast(ss);
        const float rstd = frsq(ss * (1.0f / D) + 1e-6f);
#pragma unroll
        for (int j = 0; j < D / 256; ++j) {
            const int k = j * 256 + lane * 4;
            const f32x4 g = *(const f32x4*)(p.in[I_NMIX] + k), sh = *(const f32x4*)(mod + (size_t)v * 6 * D + k), sc = *(const f32x4*)(mod + (size_t)v * 6 * D + D + k);
            float o0 = x[j].x * rstd * g.x * (1.f + sc.x) + sh.x, o1 = x[j].y * rstd * g.y * (1.f + sc.y) + sh.y;
            float o2 = x[j].z * rstd * g.z * (1.f + sc.z) + sh.z, o3 = x[j].w * rstd * g.w * (1.f + sc.w) + sh.w;
            u32x2 o; o.x = pk2(o0, o1); o.y = pk2(o2, o3);
            *(u32x2*)(U + (size_t)r * D + k) = o;
        }
    }
}

DI void phase2(const Params& p, char* smem) {
    const bf16_t* U = (const bf16_t*)(p.aux + AUX_U); const bf16_t* WT = (const bf16_t*)(p.aux + AUX_WINT);
    bf16_t* PL = (bf16_t*)(p.ws + WS_PLAT); bf16_t* PC = (bf16_t*)(p.ws + WS_PCTX); float* AB = (float*)(p.ws + WS_AB);
    if (USE_G8) {
        constexpr int NT = NP / 256, MT = T_ALL / 256, NT_CTX = (CTX_COLS + 255) / 256;
        for (int t = blockIdx.x; t < MT * NT; t += gridDim.x) {
            int mt, nt; if (!g8::tile_order(t, MT, NT, mt, nt)) break;
            const int brow = mt * 256, bcol = nt * 256; const bool isctx = brow < T_CTX;
            if (isctx && nt >= NT_CTX) continue;
            g8::Acc acc; g8::acc_zero(acc);
            g8::kloop(acc, smem, U, D, WT, D, D, brow, bcol);
            constexpr int OLD_ = 264; bf16_t* OT = (bf16_t*)smem;
            g8::for_each_quad(acc, brow, bcol, [&](int row, int col, const f32x4& v) {
                u32x2 o; o.x = pk2(v.x, v.y); o.y = pk2(v.z, v.w);
                *(u32x2*)(OT + (row - brow) * OLD_ + (col - bcol)) = o;
                if (col >= 2048 && col < 2064) *(f32x4*)(AB + (size_t)row * 16 + (col - 2048)) = v;
                halo_store(p, row, col, o);
            });
            __syncthreads();
            {
                const int tid = tid_x(); const int ncols = isctx ? CTX_COLS : IN_COLS;
                bf16_t* dst = isctx ? PC + (size_t)brow * CTX_COLS : PL + (size_t)(brow - T_CTX) * IN_COLS;
#pragma unroll
                for (int i = 0; i < 16; ++i) {
                    const int ch = tid + i * NTHREADS, row = ch >> 5, c8 = (ch & 31) * 8, col = bcol + c8;
                    if (col < ncols) *(u32x4*)(dst + (size_t)row * ncols + col) = *(const u32x4*)(OT + row * OLD_ + c8);
                }
            }
            __syncthreads();
        }
        return;
    }
    const int tid = tid_x(), lane = tid & 63, wave = tid >> 6, wr = wave >> 1, wc = wave & 1, fr = lane & 15, fq = lane >> 4;
    constexpr int NT = NP / 128, MT = T_ALL / BM, NT_CTX = (CTX_COLS + 127) / 128;
    for (int t = blockIdx.x; t < MT * NT; t += gridDim.x) {
        const int mt = t / NT, nt = t % NT; const int row0 = mt * BM; const bool isctx = row0 < T_CTX;
        if (isctx && nt >= NT_CTX) continue;
        f32x4 acc[MREP][4]; acc_zero(acc);
        gemm_kloop(acc, smem, [&](int i) { return U + (size_t)(row0 + i) * D; }, WT + (size_t)nt * 128 * D, D, D);
#pragma unroll
        for (int m = 0; m < MREP; ++m)
#pragma unroll
            for (int n = 0; n < 4; ++n)
#pragma unroll
                for (int j = 0; j < 4; ++j) {
                    const int row = row0 + wr * 16 * MREP + m * 16 + fq * 4 + j, col = nt * 128 + wc * 64 + n * 16 + fr; const float v = acc[m][n][j];
                    if (isctx) { if (col < CTX_COLS) PC[(size_t)row * CTX_COLS + col] = f2bf(v); }
                    else { if (col < IN_COLS) PL[(size_t)(row - T_CTX) * IN_COLS + col] = f2bf(v); }
                    if (col >= 2048 && col < 2064) AB[(size_t)row * 16 + (col - 2048)] = v;
                }
    }
}


DI int crow(int g, int h) { return (g & 3) + 8 * (g >> 2) + 4 * h; }
template <int S_> DI bf16x8 pack_acc(const f32x16& x) {
    u32x4 r;
    r.x = pk2(x[8 * S_ + 0], x[8 * S_ + 1]); r.y = pk2(x[8 * S_ + 2], x[8 * S_ + 3]); r.z = pk2(x[8 * S_ + 4], x[8 * S_ + 5]); r.w = pk2(x[8 * S_ + 6], x[8 * S_ + 7]);
    return __builtin_bit_cast(bf16x8, r);
}
DI bf16x8 ld_nat(const bf16_t* row, int s, int h) { return *(const bf16x8*)(row + 16 * s + 8 * h); }
DI bf16x8 ld_perm(const bf16_t* row, int s, int h) {
    const bf16x4 lo = *(const bf16x4*)(row + 16 * s + 4 * h), hi = *(const bf16x4*)(row + 16 * s + 8 + 4 * h);
    return __builtin_shufflevector(lo, hi, 0, 1, 2, 3, 4, 5, 6, 7);
}
DI f32x16 zero16() { f32x16 z;
#pragma unroll
    for (int i = 0; i < 16; ++i) z[i] = 0.f;
    return z; }
#define TGET(i) ((i) < 16 ? t0[(i) & 15] : t1[(i) & 15])
DI void invert32_col(const float* Lf, f32x16& t0, f32x16& t1, int c) {
#pragma unroll
    for (int i = 0; i < 32; ++i) {
        float s0 = 0.f, s1 = 0.f, s2 = 0.f, s3 = 0.f;
#pragma unroll
        for (int j4 = 0; j4 < (i + 3) / 4; ++j4) {
            const f32x4 l = *(const f32x4*)(Lf + i * 32 + 4 * j4);
            if (4 * j4 + 0 < i) s0 += l.x * TGET(4 * j4 + 0);
            if (4 * j4 + 1 < i) s1 += l.y * TGET(4 * j4 + 1);
            if (4 * j4 + 2 < i) s2 += l.z * TGET(4 * j4 + 2);
            if (4 * j4 + 3 < i) s3 += l.w * TGET(4 * j4 + 3);
        }
        float sm = -((s0 + s1) + (s2 + s3));
#ifndef EMU
        asm volatile("" : "+v"(sm));
#endif
        const float v = (i > c) ? sm : (i == c ? 1.f : 0.f);
        if (i < 16) t0[i & 15] = v; else t1[i & 15] = v;
    }
}

DI void seg_info(int g, int& seq, int& b, int& j0) {
    if (g < NSEG_CTX) { seq = 0; b = g / (CTXL / 64); j0 = (g % (CTXL / 64)) * 64; } else { const int g2 = g - NSEG_CTX; seq = 1; b = g2 / (S / 64); j0 = (g2 % (S / 64)) * 64; }
}
DI const bf16_t* seq_row(const Params& p, int seq, int b, int j, bool scan_order) {
    if (seq) { const int l = scan_order ? (j % ROWS) * GW + j / ROWS : j; return (const bf16_t*)(p.ws + WS_PLAT) + (size_t)(b * S + l) * IN_COLS; }
    return (const bf16_t*)(p.ws + WS_PCTX) + (size_t)(b * CTXL + j) * CTX_COLS;
}
DI void phase_halo(const Params& p, char* smem) {
    if (USE_G8) return;
    const int tid = tid_x(), lane = tid & 63, wave = tid >> 6;
    const int gw = blockIdx.x * 8 + wave, ngw = gridDim.x * 8;
    bf16_t* HA = (bf16_t*)(p.ws + WS_HALO_A); bf16_t* HB = (bf16_t*)(p.ws + WS_HALO_B);
    for (int it = gw; it < NSEG * 6; it += ngw) {
        const int g = it / 6, hr = it % 6; int seq, b, j0; seg_info(g, seq, b, j0);
        const int L = seq ? S : CTXL;
        if (hr < 4) {
            const int j = hr < 2 ? j0 - 2 + hr : j0 + 62 + hr; const bool ok = j >= 0 && j < L;
            const bf16_t* src = seq_row(p, seq, b, ok ? j : 0, false);
            for (int c = lane; c < 192; c += 64) { u32x4 v = {0u, 0u, 0u, 0u}; if (ok) v = *(const u32x4*)(src + c * 8); *(u32x4*)(HA + ((size_t)g * 4 + hr) * 1536 + c * 8) = v; }
        } else {
            const int j = hr == 4 ? j0 - 1 : j0 + 64; const bool ok = j >= 0 && j < L;
            const bf16_t* src = seq_row(p, seq, b, ok ? j : 0, true) + COL_B0;
            for (int c = lane; c < 240; c += 64) { u32x4 v = {0u, 0u, 0u, 0u}; if (ok) v = *(const u32x4*)(src + c * 8); *(u32x4*)(HB + ((size_t)g * 2 + (hr - 4)) * 1920 + c * 8) = v; }
        }
    }
}
DI f32x2_ac unpk2(unsigned w) { return (f32x2_ac){bf2f((bf16_t)(w & 0xffffu)), bf2f((bf16_t)(w >> 16))}; }
DI void unpack8(const u32x4& q, float (&f)[8]) {
    f[0] = bf2f((bf16_t)(q.x & 0xffffu)); f[1] = bf2f((bf16_t)(q.x >> 16)); f[2] = bf2f((bf16_t)(q.y & 0xffffu)); f[3] = bf2f((bf16_t)(q.y >> 16));
    f[4] = bf2f((bf16_t)(q.z & 0xffffu)); f[5] = bf2f((bf16_t)(q.z >> 16)); f[6] = bf2f((bf16_t)(q.w & 0xffffu)); f[7] = bf2f((bf16_t)(q.w >> 16));
}
DI float row16_sum(float v) {
#ifdef EMU
    v += __shfl_xor(v, 1); v += __shfl_xor(v, 2); v += __shfl_xor(v, 4); v += __shfl_xor(v, 8); return v;
#else
    v = DPP_ADD(v, 0xB1); v = DPP_ADD(v, 0x4E); v = DPP_ADD(v, 0x141); v = DPP_ADD(v, 0x140); return v;
#endif
}
DI void phase_fir(const Params& p, char* smem) {
    const int tid = tid_x(), lane = tid & 63, wave = tid >> 6;
    const int gw = blockIdx.x * 8 + wave, ngw = gridDim.x * 8;
    const bf16_t* HA = (const bf16_t*)(p.ws + WS_HALO_A); const bf16_t* HB = (const bf16_t*)(p.ws + WS_HALO_B);
    constexpr int NA = NSEG * 3, NBI = NSEG * 4;
    const u32x4 z4 = {0u, 0u, 0u, 0u};
    for (int it = gw; it < NA + NBI; it += ngw) {
        if (it < NA) {
            const int g = it / 3, s = it % 3; int seq, b, j0; seg_info(g, seq, b, j0);
            const int col = s * 512 + 8 * lane, ldp = seq ? IN_COLS : CTX_COLS;
            bf16_t* base = (bf16_t*)seq_row(p, seq, b, j0, false) + col;
            const bf16_t* hal = HA + (size_t)g * 4 * 1536 + col;
            float cw[5][8];
#pragma unroll
            for (int t = 0; t < 5; ++t) { const f32x4 w0 = *(const f32x4*)(p.in[I_CONV] + t * 1536 + col), w1 = *(const f32x4*)(p.in[I_CONV] + t * 1536 + col + 4);
                cw[t][0] = w0.x; cw[t][1] = w0.y; cw[t][2] = w0.z; cw[t][3] = w0.w; cw[t][4] = w1.x; cw[t][5] = w1.y; cw[t][6] = w1.z; cw[t][7] = w1.w; }
            u32x4 win[12], nxt[8];
            win[0] = *(const u32x4*)(hal); win[1] = *(const u32x4*)(hal + 1536);
            win[2] = *(const u32x4*)(base); win[3] = *(const u32x4*)(base + ldp);
#pragma unroll
            for (int i = 0; i < 8; ++i) win[4 + i] = *(const u32x4*)(base + (size_t)(2 + i) * ldp);
#pragma unroll 1
            for (int blk = 0; blk < 8; ++blk) {
                if (blk < 7) {
#pragma unroll
                    for (int i = 0; i < 8; ++i) { const int t = 8 * blk + 10 + i; nxt[i] = t < 64 ? *(const u32x4*)(base + (size_t)t * ldp) : *(const u32x4*)(hal + (size_t)(2 + (t - 64)) * 1536); }
                }
#pragma unroll
                for (int i = 0; i < 8; ++i) {
                    float a[8];
#pragma unroll
                    for (int e = 0; e < 8; ++e) a[e] = 0.f;
#pragma unroll
                    for (int t = 0; t < 5; ++t) { float x[8]; unpack8(win[i + t], x);
#pragma unroll
                        for (int e = 0; e < 8; ++e) a[e] += x[e] * cw[t][e]; }
                    float ss = 0.f;
#pragma unroll
                    for (int e = 0; e < 8; ++e) { a[e] = fsilu(a[e]); ss += a[e] * a[e]; }
                    if (s < 2) { const float sc = frsq(row16_sum(ss) + 1e-6f) * (s == 0 ? 0.08838834764831845f : 1.0f);
#pragma unroll
                        for (int e = 0; e < 8; ++e) a[e] *= sc; }
                    u32x4 o; o.x = pk2(a[0], a[1]); o.y = pk2(a[2], a[3]); o.z = pk2(a[4], a[5]); o.w = pk2(a[6], a[7]);
                    *(u32x4*)(base + (size_t)(8 * blk + i) * ldp) = o;
                }
#pragma unroll
                for (int i = 0; i < 4; ++i) win[i] = win[8 + i];
#pragma unroll
                for (int i = 0; i < 8; ++i) win[4 + i] = nxt[i];
            }
        } else {
            const int it2 = it - NA, g = it2 / 4, sl = it2 % 4; int seq, b, j0; seg_info(g, seq, b, j0);
            const int bcol = sl * 512 + 8 * lane; const bool act = bcol < 1920;
            const int bc = act ? bcol : 0, col = COL_B0 + bc;
            float mu8[8];
            { const f32x4 m0 = *(const f32x4*)(p.in[I_MU] + bc), m1 = *(const f32x4*)(p.in[I_MU] + bc + 4); mu8[0] = m0.x; mu8[1] = m0.y; mu8[2] = m0.z; mu8[3] = m0.w; mu8[4] = m1.x; mu8[5] = m1.y; mu8[6] = m1.z; mu8[7] = m1.w; }
            const bool th = (bc >= 1536 && bc < 1664);
            const bf16_t* hal = HB + (size_t)g * 2 * 1920 + bc;
            u32x4 win[10], nxt[8];
            win[0] = *(const u32x4*)(hal); win[1] = *(const u32x4*)(seq_row(p, seq, b, j0, true) + col);
#pragma unroll
            for (int i = 0; i < 8; ++i) win[2 + i] = *(const u32x4*)(seq_row(p, seq, b, j0 + 1 + i, true) + col);
#pragma unroll 1
            for (int blk = 0; blk < 8; ++blk) {
                if (blk < 7) {
#pragma unroll
                    for (int i = 0; i < 8; ++i) { const int t = 8 * blk + 9 + i; nxt[i] = t < 64 ? *(const u32x4*)(seq_row(p, seq, b, j0 + t, true) + col) : *(const u32x4*)(hal + 1920); }
                }
#pragma unroll
                for (int i = 0; i < 8; ++i) {
                    float pv[8], cu[8], nx[8], x[8]; unpack8(win[i], pv); unpack8(win[i + 1], cu); unpack8(win[i + 2], nx);
#pragma unroll
                    for (int e = 0; e < 8; ++e) { x[e] = cu[e] + (0.5f * (pv[e] + nx[e]) - cu[e]) * mu8[e]; if (th) x[e] = ftanh(x[e]); }
                    u32x4 o; o.x = pk2(x[0], x[1]); o.y = pk2(x[2], x[3]); o.z = pk2(x[4], x[5]); o.w = pk2(x[6], x[7]);
                    if (act) *(u32x4*)((bf16_t*)seq_row(p, seq, b, j0 + 8 * blk + i, true) + col) = o;
                }
                win[0] = win[8]; win[1] = win[9];
#pragma unroll
                for (int i = 0; i < 8; ++i) win[2 + i] = nxt[i];
            }
        }
    }
}

constexpr int GC = 32;
constexpr int G_NT = (CTXL + S) / GC;
constexpr int LD128 = 136, LD64 = 72, LD32 = 40;
DI void chunk_pos(int x, int d, int& seg, int& j0) {
    constexpr int n0 = CTXL / GC, n1 = S / GC;
    if (x < n0) { seg = 0; j0 = (d ? n0 - 1 - x : x) * GC; } else { seg = 1; const int xx = x - n0; j0 = (d ? n1 - 1 - xx : xx) * GC; }
}

template <class Emit>
DI void invert32_blocked(const float* Lf, bf16_t* scr, int lane, Emit emit) {
    bf16_t* T00T = scr; bf16_t* T11R = scr + 16 * LD32; bf16_t* L10R = scr + 2 * 16 * LD32; bf16_t* P1T = scr + 3 * 16 * LD32;
    const int blk = lane >> 5, c = lane & 15, r = lane & 31, fr = lane & 15, fq = lane >> 4;
    f32x16 t;
    const float* Lb = Lf + (16 * blk) * 32 + 16 * blk;
#pragma unroll
    for (int i = 0; i < 16; ++i) {
        float s0 = 0.f, s1 = 0.f, s2 = 0.f, s3 = 0.f;
#pragma unroll
        for (int j4 = 0; j4 < (i + 3) / 4; ++j4) {
            const f32x4 l = *(const f32x4*)(Lb + i * 32 + 4 * j4);
            if (4 * j4 + 0 < i) s0 += l.x * t[4 * j4 + 0];
            if (4 * j4 + 1 < i) s1 += l.y * t[4 * j4 + 1];
            if (4 * j4 + 2 < i) s2 += l.z * t[4 * j4 + 2];
            if (4 * j4 + 3 < i) s3 += l.w * t[4 * j4 + 3];
        }
        float sm = -((s0 + s1) + (s2 + s3));
#ifndef EMU
        asm volatile("" : "+v"(sm));
#endif
        t[i] = (i > c) ? sm : (i == c ? 1.f : 0.f);
    }
    if (r < 16) {
        if (blk == 0) {
#pragma unroll
            for (int q = 0; q < 4; ++q) { u32x2 o; o.x = pk2(t[4 * q], t[4 * q + 1]); o.y = pk2(t[4 * q + 2], t[4 * q + 3]); *(u32x2*)(T00T + c * LD32 + 4 * q) = o; }
        } else {
#pragma unroll
            for (int i = 0; i < 16; ++i) T11R[i * LD32 + c] = f2bf(t[i]);
        }
    }
    { const int i = lane >> 2, j4 = (lane & 3) * 4; const f32x4 l = *(const f32x4*)(Lf + (16 + i) * 32 + j4);
      u32x2 o; o.x = pk2(l.x, l.y); o.y = pk2(l.z, l.w); *(u32x2*)(L10R + i * LD32 + j4) = o; }
    WAVE_SYNC();
    const bf16x8 zf = {0, 0, 0, 0, 0, 0, 0, 0};
    f32x4 p1 = {0.f, 0.f, 0.f, 0.f};
    {
        const bf16x8 af = fq < 2 ? *(const bf16x8*)(L10R + fr * LD32 + 8 * fq) : zf, bfm = fq < 2 ? *(const bf16x8*)(T00T + fr * LD32 + 8 * fq) : zf;
        p1 = MFMA16(af, bfm, p1);
    }
    { u32x2 o; o.x = pk2(p1[0], p1[1]); o.y = pk2(p1[2], p1[3]); *(u32x2*)(P1T + fr * LD32 + 4 * fq) = o; }
    WAVE_SYNC();
    f32x4 p2 = {0.f, 0.f, 0.f, 0.f};
    {
        const bf16x8 af = fq < 2 ? *(const bf16x8*)(T11R + fr * LD32 + 8 * fq) : zf, bfm = fq < 2 ? *(const bf16x8*)(P1T + fr * LD32 + 8 * fq) : zf;
        p2 = MFMA16(af, bfm, p2);
    }
#pragma unroll
    for (int j = 0; j < 4; ++j) emit(16 + 4 * fq + j, fr, -p2[j]);
    if (r < 16) {
#pragma unroll
        for (int i = 0; i < 16; ++i) { emit(16 * blk + i, 16 * blk + c, t[i]); if (blk == 0) emit(i, 16 + c, 0.f); }
    }
}
constexpr int GL_Q = 0;
constexpr int GL_KT = GL_Q + 2 * 32 * LD128 * 2;
constexpr int GL_VT = GL_KT + 2 * 128 * LD32 * 2;
constexpr int GL_K = GL_VT + 2 * 128 * LD32 * 2;
constexpr int GL_QKM = GL_K + 32 * LD128 * 2;
constexpr int GL_LF = GL_QKM + 2 * 32 * LD32 * 2;
constexpr int GL_TP = GL_LF + 32 * 32 * 4;
constexpr int GL_TPP = GL_TP + 32 * LD32 * 2;
constexpr int GL_WN = GL_TPP + 2 * 32 * LD32 * 2;
constexpr int GL_SC = GL_WN + 32 * LD128 * 2;
constexpr int GL_GC = GL_SC + 2 * 8 * 32 * 4;
constexpr int GL_CW = GL_GC + 8 * 32 * 4;
constexpr int GL_INV = GL_CW + 5 * 3 * 128 * 4;
constexpr int GL_RAW = GL_INV + 4 * 32 * LD32 * 2;
constexpr int GL_END = GL_RAW + 32 * 384 * 2;
static_assert(GL_END <= LDS_BYTES, "gdn lds");

DI void gdn_chain2(const Params& p, char* smem, int item) {
    const int d = item / (NB * H_A), b = (item / H_A) % NB, h = item % H_A;
    const int tid = tid_x(), lane = tid & 63, wave0_ = tid >> 6;
    bf16_t* Qs = (bf16_t*)(smem + GL_Q); bf16_t* KTs = (bf16_t*)(smem + GL_KT); bf16_t* VTs = (bf16_t*)(smem + GL_VT); bf16_t* Ks = (bf16_t*)(smem + GL_K);
    bf16_t* QKMs = (bf16_t*)(smem + GL_QKM); float* Lf = (float*)(smem + GL_LF); bf16_t* Tp = (bf16_t*)(smem + GL_TP); bf16_t* Tpp = (bf16_t*)(smem + GL_TPP);
    bf16_t* Wn = (bf16_t*)(smem + GL_WN); float* SC = (float*)(smem + GL_SC); float* GCs = (float*)(smem + GL_GC); float* CW = (float*)(smem + GL_CW);
    const float alog = p.in[I_ALOG][d * 4 + h], dtb = p.in[I_DTB][d * 4 + h], negea = -expf(alog);
    bf16_t* ODIR = (bf16_t*)(p.aux + AUX_ODIR);
    __syncthreads();
    f32x16 St[4];
#pragma unroll
    for (int ct = 0; ct < 4; ++ct) St[ct] = zero16();
    bf16_t* RAW = (bf16_t*)(smem + GL_RAW);
    float pa = 0.f, pbt = 0.f;
    auto prefetch = [&](int x, int wsel, int nw) {
        int seg, j0; chunk_pos(x, d, seg, j0);
        const int ldp = seg ? IN_COLS : CTX_COLS;
        const bf16_t* pbase = seg ? (const bf16_t*)(p.ws + WS_PLAT) + (size_t)b * S * IN_COLS : (const bf16_t*)(p.ws + WS_PCTX) + (size_t)b * CTXL * CTX_COLS;
        for (int inst = wsel; inst < 24; inst += nw) {
            const int q = inst * 64 + lane, row = q / 48, c16 = q % 48;
            const bf16_t* src = pbase + (size_t)(j0 + row) * ldp + (c16 >> 4) * 512 + h * 128 + (c16 & 15) * 8;
#ifdef EMU
            emu_global_load_lds16(src, (char*)RAW + q * 16);
#else
            __builtin_amdgcn_global_load_lds((const unsigned*)src, (__attribute__((address_space(3))) unsigned*)((char*)RAW + q * 16), 16, 0, 0);
#endif
        }
    };
    auto prefetch_ab = [&](int x) {
        int seg, j0; chunk_pos(x, d, seg, j0);
        const float* abbase = (const float*)(p.ws + WS_AB) + (size_t)(seg ? T_CTX + b * S : b * CTXL) * 16;
        const int jw = j0 + 4 * wave0_;
        if (lane < 4) { pa = abbase[(size_t)(jw + lane) * 16 + d * 4 + h]; pbt = abbase[(size_t)(jw + lane) * 16 + 8 + d * 4 + h]; }
    };
    prefetch(0, wave0_, 8); prefetch_ab(0);
#ifndef EMU
    asm volatile("s_waitcnt vmcnt(0)" ::: "memory");
#endif
    const int r0_ = lane & 31, hh0_ = lane >> 5;
    __syncthreads();
    for (int it = -1; it < G_NT; ++it) {
        int r = r0_, hh = hh0_, wave = wave0_;
#ifndef EMU
        asm volatile("" : "+v"(r), "+v"(hh), "+v"(wave));
#endif
        const int xn = it + 1, par = xn & 1;
        int segn = 0, j0n = 0; if (xn < G_NT) chunk_pos(xn, d, segn, j0n);
        if (xn < G_NT) {
            const int i0 = d ? (GC - 4 - 4 * wave) : 4 * wave;
            bf16_t kt[2][4], vt[2][4];
#pragma unroll
            for (int t = 0; t < 4; ++t) {
                const int e = d ? 3 - t : t, i = i0 + e;
                const unsigned wq = *(const unsigned*)(RAW + (4 * wave + t) * 384 + 2 * lane), wk = *(const unsigned*)(RAW + (4 * wave + t) * 384 + 128 + 2 * lane), wv = *(const unsigned*)(RAW + (4 * wave + t) * 384 + 256 + 2 * lane);
                *(unsigned*)(Qs + (par * 32 + i) * LD128 + 2 * lane) = wq;
                *(unsigned*)(Ks + i * LD128 + 2 * lane) = wk;
                kt[0][e] = (bf16_t)(wk & 0xffffu); kt[1][e] = (bf16_t)(wk >> 16); vt[0][e] = (bf16_t)(wv & 0xffffu); vt[1][e] = (bf16_t)(wv >> 16);
            }
#pragma unroll
            for (int q = 0; q < 2; ++q) {
                u32x2 o; o.x = (unsigned)kt[q][0] | ((unsigned)kt[q][1] << 16); o.y = (unsigned)kt[q][2] | ((unsigned)kt[q][3] << 16);
                *(u32x2*)(KTs + (par * 128 + 2 * lane + q) * LD32 + i0) = o;
                u32x2 o2; o2.x = (unsigned)vt[q][0] | ((unsigned)vt[q][1] << 16); o2.y = (unsigned)vt[q][2] | ((unsigned)vt[q][3] << 16);
                *(u32x2*)(VTs + (par * 128 + 2 * lane + q) * LD32 + i0) = o2;
            }
            if (lane < 4) { const int i = d ? (GC - 1 - 4 * wave - lane) : (4 * wave + lane);
                SC[(par * 8 + 0) * 32 + i] = negea * fsoftplus(pa + dtb); SC[(par * 8 + 1) * 32 + i] = fsigmoid(pbt); }
            if (xn + 1 < G_NT) prefetch_ab(xn + 1);
        }
        LDS_BARRIER();
        if (wave >= 4 && wave < 7 && xn + 1 < G_NT) {
            prefetch(xn + 1, wave - 4, 3);
#ifndef EMU
            asm volatile("s_waitcnt vmcnt(0)" ::: "memory");
#endif
        }
        if (xn < G_NT) {
            const float* graw = SC + (par * 8 + 0) * 32;
            float gcv = 0.f;
#pragma unroll
            for (int s4 = 0; s4 < 8; ++s4) { const f32x4 g4 = *(const f32x4*)(graw + 4 * s4);
                gcv += (4 * s4 + 0 <= r ? g4.x : 0.f) + (4 * s4 + 1 <= r ? g4.y : 0.f) + (4 * s4 + 2 <= r ? g4.z : 0.f) + (4 * s4 + 3 <= r ? g4.w : 0.f); }
            if (lane < 32) GCs[wave * 32 + r] = gcv;
            if (wave == 7 && lane < 32) {
                float gl = 0.f;
#pragma unroll
                for (int s4 = 0; s4 < 8; ++s4) { const f32x4 g4 = *(const f32x4*)(graw + 4 * s4); gl += (g4.x + g4.y) + (g4.z + g4.w); }
                const float be = SC[(par * 8 + 1) * 32 + r];
                SC[(par * 8 + 3) * 32 + r] = fexp(gcv); SC[(par * 8 + 4) * 32 + r] = fexp(gl - gcv); SC[(par * 8 + 5) * 32 + r] = be * fexp(gcv); SC[(par * 8 + 6) * 32 + r] = fexp(gl);
            }
            const int pr = wave >> 2, th = (wave >> 1) & 1, ch = wave & 1, fr = lane & 15, fq = lane >> 4;
            const bf16_t* arow = (pr == 0 ? Ks : Qs + par * 32 * LD128) + (16 * th + fr) * LD128 + 8 * fq; const bf16_t* brow = Ks + (16 * ch + fr) * LD128 + 8 * fq;
            f32x4 cc = {0.f, 0.f, 0.f, 0.f};
#pragma unroll
            for (int ks = 0; ks < 4; ++ks) cc = MFMA16(*(const bf16x8*)(arow + 32 * ks), *(const bf16x8*)(brow + 32 * ks), cc);
            WAVE_SYNC();
            const int jj = 16 * ch + fr; const float gj = GCs[wave * 32 + jj];
#pragma unroll
            for (int j = 0; j < 4; ++j) {
                const int i = 16 * th + 4 * fq + j; const float dec = fexp(GCs[wave * 32 + i] - gj);
                if (pr == 0) Lf[i * 32 + jj] = (jj < i) ? SC[(par * 8 + 1) * 32 + i] * cc[j] * dec : 0.f;
                else QKMs[(par * 32 + i) * LD32 + jj] = f2bf((jj <= i) ? cc[j] * dec : 0.f);
            }
        }
        LDS_BARRIER();
        if (wave == 7 && xn < G_NT) {
            const float* sb1 = SC + (par * 8 + 5) * 32; const float* sb0 = SC + (par * 8 + 1) * 32; bf16_t* Tppw = Tpp + par * 32 * LD32;
            invert32_blocked(Lf, (bf16_t*)(smem + GL_INV), lane, [&](int i, int c, float v) { Tp[i * LD32 + c] = f2bf(v * sb1[c]); Tppw[i * LD32 + c] = f2bf(v * sb0[c]); });
        }
        if (wave < 4 && it >= 0) {
            const int pc = it & 1; int seg = 0, j0 = 0; chunk_pos(it, d, seg, j0);
            const bf16_t* Qc = Qs + pc * 32 * LD128; const bf16_t* KTc = KTs + pc * 128 * LD32; const bf16_t* VTc = VTs + pc * 128 * LD32;
            const bf16_t* QKc = QKMs + pc * 32 * LD32; const bf16_t* Tc = Tpp + pc * 32 * LD32; const float* sc = SC + pc * 8 * 32;
            f32x16 vn = zero16();
#pragma unroll
            for (int s = 0; s < 2; ++s) vn = MFMA32(ld_nat(Tc + r * LD32, s, hh), ld_nat(VTc + (32 * wave + r) * LD32, s, hh), vn);
            f32x16 oacc = zero16();
#define GDN_KSTEP(s) { const bf16x8 sb = pack_acc<(s) & 1>(St[(s) >> 1]); vn = MFMA32(ld_perm(Wn + r * LD128, (s), hh), sb, vn); oacc = MFMA32(ld_perm(Qc + r * LD128, (s), hh), sb, oacc); }
            GDN_KSTEP(0) GDN_KSTEP(1) GDN_KSTEP(2) GDN_KSTEP(3) GDN_KSTEP(4) GDN_KSTEP(5) GDN_KSTEP(6) GDN_KSTEP(7)
#undef GDN_KSTEP
#pragma unroll
            for (int g = 0; g < 16; ++g) oacc[g] *= sc[3 * 32 + crow(g, hh)];
            { const bf16x8 v0 = pack_acc<0>(vn), v1 = pack_acc<1>(vn);
              oacc = MFMA32(ld_perm(QKc + r * LD32, 0, hh), v0, oacc); oacc = MFMA32(ld_perm(QKc + r * LD32, 1, hh), v1, oacc); }
#pragma unroll
            for (int g = 0; g < 16; ++g) vn[g] *= sc[4 * 32 + crow(g, hh)];
            const float ge = sc[6 * 32];
            { const bf16x8 v0 = pack_acc<0>(vn), v1 = pack_acc<1>(vn);
#pragma unroll
              for (int ct = 0; ct < 4; ++ct) {
#pragma unroll
                  for (int g = 0; g < 16; ++g) St[ct][g] *= ge;
                  St[ct] = MFMA32(ld_perm(KTc + (32 * ct + r) * LD32, 0, hh), v0, St[ct]);
                  St[ct] = MFMA32(ld_perm(KTc + (32 * ct + r) * LD32, 1, hh), v1, St[ct]);
              } }
            if (seg) {
#pragma unroll
                for (int g = 0; g < 16; ++g) {
                    const int i = crow(g, hh), j = d ? j0 + GC - 1 - i : j0 + i;
                    ODIR[((size_t)d * T_LAT + (size_t)b * S + j) * 512 + h * 128 + 32 * wave + r] = f2bf(oacc[g]);
                }
            }
        }
        LDS_BARRIER();
        if (xn < G_NT && wave < 4) {
            f32x16 acc = zero16();
#pragma unroll
            for (int s = 0; s < 2; ++s) acc = MFMA32(ld_nat(KTs + (par * 128 + 32 * wave + r) * LD32, s, hh), ld_nat(Tp + r * LD32, s, hh), acc);
#pragma unroll
            for (int q = 0; q < 4; ++q) {
                u32x2 o; o.x = pk2(-acc[4 * q], -acc[4 * q + 1]); o.y = pk2(-acc[4 * q + 2], -acc[4 * q + 3]);
                *(u32x2*)(Wn + r * LD128 + 32 * wave + 8 * q + 4 * hh) = o;
            }
        }
        LDS_BARRIER();
    }
}

constexpr int RL_RX = 0;
constexpr int RL_KX = RL_RX + 32 * 64 * 4;
constexpr int RL_VX = RL_KX + 32 * 64 * 4;
constexpr int RL_KK = RL_VX + 32 * 64 * 4;
constexpr int RL_LW = RL_KK + 32 * 64 * 4;
constexpr int RL_IC = RL_LW + 32 * 64 * 4;
constexpr int RL_PC = RL_IC + 32 * 64 * 4;
constexpr int RL_CST = RL_PC + 2 * 64 * 4;
constexpr int RL_TW = RL_CST + 4 * 64 * 4;
constexpr int RL_AL = RL_TW + 32 * LD64 * 2;
constexpr int RL_LF = RL_TW;
constexpr int RL_LAKT = RL_LF + 32 * 32 * 4;
constexpr int RL_TB = RL_LAKT + 32 * LD32 * 2;
static_assert(RL_TB + 32 * LD32 * 2 <= RL_AL + 32 * LD64 * 2, "overlay");
constexpr int RL_W2T = RL_AL + 32 * LD64 * 2;
constexpr int RL_A2T = RL_W2T + 64 * LD64 * 2;
constexpr int RL_AR = RL_A2T + 64 * LD64 * 2;
constexpr int RL_BR = RL_AR + 32 * LD64 * 2;
constexpr int RL_KR = RL_BR + 32 * LD64 * 2;
constexpr int RL_RR = RL_KR + 32 * LD64 * 2;
constexpr int RL_AT = RL_RR + 2 * 32 * LD64 * 2;
constexpr int RL_BHT = RL_AT + 64 * LD32 * 2;
constexpr int RL_KHT = RL_BHT + 2 * 64 * LD32 * 2;
constexpr int RL_VT = RL_KHT + 2 * 64 * LD32 * 2;
constexpr int RL_MRB = RL_VT + 2 * 64 * LD32 * 2;
constexpr int RL_MRK = RL_MRB + 2 * 32 * LD32 * 2;
constexpr int RL_WM = RL_MRK + 2 * 32 * LD32 * 2;
constexpr int RL_TL = RL_WM + 32 * LD64 * 2;
constexpr int RL_END = RL_TL + 32 * LD32 * 2;
static_assert(RL_END <= LDS_BYTES, "rwkv lds");

DI void rwkv_chain2(const Params& p, char* smem, int item) {
    const int d = item / (NB * H_B), b = (item / H_B) % NB, h = item % H_B;
    const int tid = tid_x(), lane = tid & 63, wave = tid >> 6;
    float* RX = (float*)(smem + RL_RX); float* KX = (float*)(smem + RL_KX); float* VX = (float*)(smem + RL_VX); float* KKs = (float*)(smem + RL_KK);
    float* LW = (float*)(smem + RL_LW); float* IC = (float*)(smem + RL_IC); float* Lf = (float*)(smem + RL_LF); float* PC = (float*)(smem + RL_PC); float* CST = (float*)(smem + RL_CST);
    bf16_t* TW = (bf16_t*)(smem + RL_TW); bf16_t* AL = (bf16_t*)(smem + RL_AL); bf16_t* W2T = (bf16_t*)(smem + RL_W2T); bf16_t* A2T = (bf16_t*)(smem + RL_A2T);
    bf16_t* Ar = (bf16_t*)(smem + RL_AR); bf16_t* Br = (bf16_t*)(smem + RL_BR); bf16_t* Kr = (bf16_t*)(smem + RL_KR); bf16_t* Rr = (bf16_t*)(smem + RL_RR);
    bf16_t* AT = (bf16_t*)(smem + RL_AT); bf16_t* BhT = (bf16_t*)(smem + RL_BHT); bf16_t* KhT = (bf16_t*)(smem + RL_KHT); bf16_t* VT = (bf16_t*)(smem + RL_VT);
    bf16_t* LakT = (bf16_t*)(smem + RL_LAKT); bf16_t* Mrb = (bf16_t*)(smem + RL_MRB); bf16_t* Mrk = (bf16_t*)(smem + RL_MRK); bf16_t* Tb = (bf16_t*)(smem + RL_TB);
    bf16_t* Wm = (bf16_t*)(smem + RL_WM); bf16_t* TLm = (bf16_t*)(smem + RL_TL);
    bf16_t* YDIR = (bf16_t*)(p.aux + AUX_YDIR); float* BON = (float*)(p.ws + WS_BONUS);
    __syncthreads();
    for (int i = tid; i < 64 * 64; i += NTHREADS) {
        const int c = i >> 6, rr = i & 63;
        W2T[c * LD64 + rr] = f2bf(p.in[I_W2][((size_t)d * 64 + rr) * 512 + h * 64 + c]); A2T[c * LD64 + rr] = f2bf(p.in[I_A2][((size_t)d * 64 + rr) * 512 + h * 64 + c]);
    }
    if (tid < 256) { const int w = tid >> 6, c = tid & 63, gc = h * 64 + c;
        CST[tid] = w == 0 ? p.in[I_W0][d * 512 + gc] : (w == 1 ? p.in[I_A0][d * 512 + gc] : (w == 2 ? p.in[I_KA][gc] : p.in[I_RK][gc])); }
    const float kkw = p.in[I_KK][h * 64 + lane];
    f32x16 Xt[2]; Xt[0] = zero16(); Xt[1] = zero16();
    bf16_t rawv[4][5];
    auto prefetch = [&](int x) {
        int seg, j0; chunk_pos(x, d, seg, j0);
        const int ldp = seg ? IN_COLS : CTX_COLS;
        const bf16_t* pb = seg ? (const bf16_t*)(p.ws + WS_PLAT) + (size_t)b * S * IN_COLS : (const bf16_t*)(p.ws + WS_PCTX) + (size_t)b * CTXL * CTX_COLS;
        const int jw = j0 + 4 * wave;
#pragma unroll
        for (int rr = 0; rr < 4; ++rr) {
            const int j = jw + rr; const int row = seg ? (j % ROWS) * GW + j / ROWS : j;
#pragma unroll
            for (int s = 0; s < 5; ++s) {
                const int bcol = (s < 3 ? s * 512 + h * 64 : (s == 3 ? 1536 + d * 64 : 1664 + d * 64)) + lane;
                rawv[rr][s] = pb[(size_t)row * ldp + COL_B0 + bcol];
            }
        }
    };
    prefetch(0);
    const int r0_ = lane & 31, hh0_ = lane >> 5;
    __syncthreads();
    for (int it = -1; it < G_NT; ++it) {
        int r = r0_, hh = hh0_;
#ifndef EMU
        asm volatile("" : "+v"(r), "+v"(hh));
#endif
        const int xn = it + 1, par = xn & 1;
        int segn = 0, j0n = 0; if (xn < G_NT) chunk_pos(xn, d, segn, j0n);
        if (xn < G_NT) {
#pragma unroll
            for (int t = 0; t < 4; ++t) {
                const int i = d ? (GC - 1 - 4 * wave - t) : (4 * wave + t);
                const float xr = bf2f(rawv[t][0]), xk = bf2f(rawv[t][1]), xv = bf2f(rawv[t][2]);
                const float kxk = xk * kkw; const float ss = wave_sum_fast(kxk * kxk);
                RX[i * 64 + lane] = xr; KX[i * 64 + lane] = xk; VX[i * 64 + lane] = xv; KKs[i * 64 + lane] = kxk * frsq(ss + 1e-6f);
                TW[i * LD64 + lane] = rawv[t][3]; AL[i * LD64 + lane] = rawv[t][4];
            }
            if (xn + 1 < G_NT) prefetch(xn + 1);
        }
        LDS_BARRIER();
        if (xn < G_NT) {
            const int which = wave >> 2, cg = wave & 3, fr = lane & 15, fq = lane >> 4;
            const bf16_t* arow0 = (which ? AL : TW) + fr * LD64 + 8 * fq; const bf16_t* brow = (which ? A2T : W2T) + (16 * cg + fr) * LD64 + 8 * fq;
            f32x4 c0 = {0.f, 0.f, 0.f, 0.f}, c1 = {0.f, 0.f, 0.f, 0.f};
#pragma unroll
            for (int ks = 0; ks < 2; ++ks) {
                const bf16x8 bfrag = *(const bf16x8*)(brow + 32 * ks);
                c0 = MFMA16(*(const bf16x8*)(arow0 + 32 * ks), bfrag, c0); c1 = MFMA16(*(const bf16x8*)(arow0 + 16 * LD64 + 32 * ks), bfrag, c1);
            }
            const int c = 16 * cg + fr; const float bias = CST[which * 64 + c];
#pragma unroll
            for (int th = 0; th < 2; ++th)
#pragma unroll
                for (int j = 0; j < 4; ++j) {
                    const int i = 16 * th + 4 * fq + j; const float z = bias + (th ? c1[j] : c0[j]);
                    if (which) IC[i * 64 + c] = fsigmoid(z);
                    else { const float wl = -fsoftplus(-z) - 0.5f; LW[i * 64 + c] = -fexp(wl); }
                }
        }
        LDS_BARRIER();
        if (xn < G_NT) {
            const int c = lane, i0 = 4 * wave;
            const float ka = CST[2 * 64 + c], rk = CST[3 * 64 + c];
            float lpb = 0.f, lpc = 0.f; float lw4[4];
#pragma unroll
            for (int s2 = 0; s2 < 32; ++s2) { const float w = LW[s2 * 64 + c]; lpc += w; if (s2 < i0) lpb += w; }
#pragma unroll
            for (int e = 0; e < 4; ++e) lw4[e] = LW[(i0 + e) * 64 + c];
            bf16_t ta[4], tb[4], tk[4], tv[4]; float bon[4];
            float lprun = lpb;
#pragma unroll
            for (int e = 0; e < 4; ++e) {
                const int i = i0 + e;
                const float lpm = lprun; lprun += lw4[e]; const float lp = lprun;
                const float Pi = fexp(lp), Pm = fexp(lpm), invP = fexp(-lp), PCi = fexp(lpc - lp);
                const float ic = IC[i * 64 + c], kxv = KX[i * 64 + c], kkv = KKs[i * 64 + c], rxv = RX[i * 64 + c], vxv = VX[i * 64 + c];
                const float kd = kxv * (1.f + (ic - 1.f) * ka), bb = kkv * ic, aa = -kkv;
                ta[e] = f2bf(aa * Pm); tb[e] = f2bf(bb * PCi); tk[e] = f2bf(kd * PCi); tv[e] = f2bf(vxv);
                Ar[i * LD64 + c] = ta[e]; Br[i * LD64 + c] = f2bf(bb * invP); Kr[i * LD64 + c] = f2bf(kd * invP); Rr[(par * 32 + i) * LD64 + c] = f2bf(rxv * Pi);
                bon[e] = wave_sum_fast(rxv * kd * rk);
            }
            { u32x2 o; o.x = (unsigned)ta[0] | ((unsigned)ta[1] << 16); o.y = (unsigned)ta[2] | ((unsigned)ta[3] << 16); *(u32x2*)(AT + c * LD32 + i0) = o; }
            { u32x2 o; o.x = (unsigned)tb[0] | ((unsigned)tb[1] << 16); o.y = (unsigned)tb[2] | ((unsigned)tb[3] << 16); *(u32x2*)(BhT + (par * 64 + c) * LD32 + i0) = o; }
            { u32x2 o; o.x = (unsigned)tk[0] | ((unsigned)tk[1] << 16); o.y = (unsigned)tk[2] | ((unsigned)tk[3] << 16); *(u32x2*)(KhT + (par * 64 + c) * LD32 + i0) = o; }
            { u32x2 o; o.x = (unsigned)tv[0] | ((unsigned)tv[1] << 16); o.y = (unsigned)tv[2] | ((unsigned)tv[3] << 16); *(u32x2*)(VT + (par * 64 + c) * LD32 + i0) = o; }
            if (wave == 7) PC[par * 64 + c] = fexp(lpc);
            if (segn && lane < 4) { const int i = i0 + lane, jj = d ? j0n + GC - 1 - i : j0n + i;
                const float bv = lane == 0 ? bon[0] : (lane == 1 ? bon[1] : (lane == 2 ? bon[2] : bon[3]));
                BON[((size_t)d * T_LAT + (size_t)b * S + (jj % ROWS) * GW + jj / ROWS) * 8 + h] = bv; }
        }
        LDS_BARRIER();
        if (xn < G_NT) {
            const int m = wave >> 1, th = wave & 1, fr = lane & 15, fq = lane >> 4;
            const bf16_t* arow = ((m < 2) ? Ar : Rr + par * 32 * LD64) + (16 * th + fr) * LD64 + 8 * fq; const bf16_t* brow = ((m & 1) ? Kr : Br) + fr * LD64 + 8 * fq;
            f32x4 c0 = {0.f, 0.f, 0.f, 0.f}, c1 = {0.f, 0.f, 0.f, 0.f};
#pragma unroll
            for (int ks = 0; ks < 2; ++ks) {
                const bf16x8 afrag = *(const bf16x8*)(arow + 32 * ks);
                c0 = MFMA16(afrag, *(const bf16x8*)(brow + 32 * ks), c0); c1 = MFMA16(afrag, *(const bf16x8*)(brow + 16 * LD64 + 32 * ks), c1);
            }
#pragma unroll
            for (int ch = 0; ch < 2; ++ch) {
                const f32x4 cc = ch ? c1 : c0; const int ic = 16 * ch + fr; const int t0 = 16 * th + 4 * fq;
                if (m == 0) {
#pragma unroll
                    for (int j = 0; j < 4; ++j) Lf[(t0 + j) * 32 + ic] = (ic < t0 + j) ? -cc[j] : 0.f;
                } else if (m == 1) {
                    u32x2 o; o.x = pk2((ic < t0) ? cc[0] : 0.f, (ic < t0 + 1) ? cc[1] : 0.f); o.y = pk2((ic < t0 + 2) ? cc[2] : 0.f, (ic < t0 + 3) ? cc[3] : 0.f);
                    *(u32x2*)(LakT + ic * LD32 + t0) = o;
                } else {
                    bf16_t* M = (m == 2 ? Mrb : Mrk) + par * 32 * LD32;
#pragma unroll
                    for (int j = 0; j < 4; ++j) M[(t0 + j) * LD32 + ic] = f2bf((ic <= t0 + j) ? cc[j] : 0.f);
                }
            }
        }
        LDS_BARRIER();
        if (wave == 7 && xn < G_NT) {
            invert32_blocked(Lf, (bf16_t*)(smem + RL_RX), lane, [&](int i, int c, float v) { Tb[i * LD32 + c] = f2bf(v); });
        }
        if (wave < 2 && it >= 0) {
            const int pc = it & 1; int seg = 0, j0 = 0; chunk_pos(it, d, seg, j0);
            const bf16_t* Rc = Rr + pc * 32 * LD64; const bf16_t* BhTc = BhT + pc * 64 * LD32; const bf16_t* KhTc = KhT + pc * 64 * LD32; const bf16_t* VTc = VT + (pc * 64 + 32 * wave + r) * LD32;
            const bf16_t* Mrbc = Mrb + pc * 32 * LD32; const bf16_t* Mrkc = Mrk + pc * 32 * LD32; const float* PCc = PC + pc * 64;
            const bf16x8 vf0 = ld_nat(VTc, 0, hh), vf1 = ld_nat(VTc, 1, hh);
            f32x16 u = zero16(), y = zero16();
            u = MFMA32(ld_nat(TLm + r * LD32, 0, hh), vf0, u); u = MFMA32(ld_nat(TLm + r * LD32, 1, hh), vf1, u);
            y = MFMA32(ld_nat(Mrkc + r * LD32, 0, hh), vf0, y); y = MFMA32(ld_nat(Mrkc + r * LD32, 1, hh), vf1, y);
#define RW_KSTEP(s) { const bf16x8 xb = pack_acc<(s) & 1>(Xt[(s) >> 1]); u = MFMA32(ld_perm(Wm + r * LD64, (s), hh), xb, u); y = MFMA32(ld_perm(Rc + r * LD64, (s), hh), xb, y); }
            RW_KSTEP(0) RW_KSTEP(1) RW_KSTEP(2) RW_KSTEP(3)
#undef RW_KSTEP
            const bf16x8 ub0 = pack_acc<0>(u), ub1 = pack_acc<1>(u);
            y = MFMA32(ld_perm(Mrbc + r * LD32, 0, hh), ub0, y); y = MFMA32(ld_perm(Mrbc + r * LD32, 1, hh), ub1, y);
#pragma unroll
            for (int kt = 0; kt < 2; ++kt) {
#pragma unroll
                for (int g = 0; g < 16; ++g) Xt[kt][g] *= PCc[32 * kt + crow(g, hh)];
                Xt[kt] = MFMA32(ld_perm(BhTc + (32 * kt + r) * LD32, 0, hh), ub0, Xt[kt]); Xt[kt] = MFMA32(ld_perm(BhTc + (32 * kt + r) * LD32, 1, hh), ub1, Xt[kt]);
                Xt[kt] = MFMA32(ld_nat(KhTc + (32 * kt + r) * LD32, 0, hh), vf0, Xt[kt]); Xt[kt] = MFMA32(ld_nat(KhTc + (32 * kt + r) * LD32, 1, hh), vf1, Xt[kt]);
            }
            if (seg) {
#pragma unroll
                for (int g = 0; g < 16; ++g) {
                    const int i = crow(g, hh), jj = d ? j0 + GC - 1 - i : j0 + i;
                    YDIR[((size_t)d * T_LAT + (size_t)b * S + (jj % ROWS) * GW + jj / ROWS) * 512 + h * 64 + 32 * wave + r] = f2bf(y[g]);
                }
            }
        }
        LDS_BARRIER();
        if (xn < G_NT && wave < 3) {
            const bf16_t* arow = (wave < 2) ? AT + (32 * wave + r) * LD32 : LakT + r * LD32;
            f32x16 acc = zero16();
#pragma unroll
            for (int s = 0; s < 2; ++s) acc = MFMA32(ld_nat(arow, s, hh), ld_nat(Tb + r * LD32, s, hh), acc);
#pragma unroll
            for (int q = 0; q < 4; ++q) {
                u32x2 o; o.x = pk2(acc[4 * q], acc[4 * q + 1]); o.y = pk2(acc[4 * q + 2], acc[4 * q + 3]);
                if (wave < 2) *(u32x2*)(Wm + r * LD64 + 32 * wave + 8 * q + 4 * hh) = o; else *(u32x2*)(TLm + r * LD32 + 8 * q + 4 * hh) = o;
            }
        }
        LDS_BARRIER();
    }
}

DI void phase3(const Params& p, char* smem) {
    constexpr int NG = 2 * NB * H_A, NR = 2 * NB * H_B;
    for (int it = blockIdx.x; it < NG; it += gridDim.x) gdn_chain2(p, smem, it);
    for (int it = blockIdx.x; it < NG + NR; it += gridDim.x) if (it >= NG) rwkv_chain2(p, smem, it - NG);
}

constexpr int P4_SG = 0;
constexpr int P4_XV = P4_SG + 32 * LD128 * 2;
constexpr int P4_YF = P4_XV + 32 * 520 * 2;
static_assert(P4_YF + 32 * 516 * 4 <= LDS_BYTES, "phase4 lds");
DI float half_sum(float v, int hh) {
#ifdef EMU
    v += __shfl_xor(v, 1); v += __shfl_xor(v, 2); v += __shfl_xor(v, 4); v += __shfl_xor(v, 8); v += __shfl_xor(v, 16); return v;
#else
    v = DPP_ADD(v, 0xB1); v = DPP_ADD(v, 0x4E); v = DPP_ADD(v, 0x141); v = DPP_ADD(v, 0x140);
    const int iv = __builtin_bit_cast(int, v);
    const float s0 = __builtin_bit_cast(float, __builtin_amdgcn_readlane(iv, 0)) + __builtin_bit_cast(float, __builtin_amdgcn_readlane(iv, 16));
    const float s1 = __builtin_bit_cast(float, __builtin_amdgcn_readlane(iv, 32)) + __builtin_bit_cast(float, __builtin_amdgcn_readlane(iv, 48));
    return hh ? s1 : s0;
#endif
}
DI void phase4(const Params& p, char* smem) {
    const int tid = tid_x(), lane = tid & 63, wave = tid >> 6, r = lane & 31, hh = lane >> 5;
    const bf16_t* PL = (const bf16_t*)(p.ws + WS_PLAT);
    const bf16_t* ODIR = (const bf16_t*)(p.aux + AUX_ODIR); const bf16_t* YDIR = (const bf16_t*)(p.aux + AUX_YDIR);
    const float* BON = (const float*)(p.ws + WS_BONUS); const float* mu = p.in[I_MU]; const bf16_t* G2T = (const bf16_t*)(p.ws + WS_G2T);
    bf16_t* OA = (bf16_t*)(p.ws + WS_OA); bf16_t* OB = (bf16_t*)(p.ws + WS_OB);
    bf16_t* SG = (bf16_t*)(smem + P4_SG); bf16_t* XV = (bf16_t*)(smem + P4_XV); float* YF = (float*)(smem + P4_YF);
    for (int it = blockIdx.x; it < T_LAT / 32; it += gridDim.x) {
        const int tok0 = it * 32, b = tok0 / S, l0 = tok0 % S;
        __syncthreads();
        for (int q = tid; q < 32 * 80; q += NTHREADS) {
            const int t = q / 80, c8 = q % 80;
            const int l = l0 + t;
            const int bcol = c8 < 16 ? 1792 + c8 * 8 : 1024 + (c8 - 16) * 8;
            float cu[8], o[8];
            unpack8(*(const u32x4*)(PL + (size_t)(b * S + l) * IN_COLS + COL_B0 + bcol), cu);
#pragma unroll
            for (int e = 0; e < 8; ++e) o[e] = c8 < 16 ? fsigmoid(cu[e]) : cu[e];
            u32x4 w; w.x = pk2(o[0], o[1]); w.y = pk2(o[2], o[3]); w.z = pk2(o[4], o[5]); w.w = pk2(o[6], o[7]);
            if (c8 < 16) *(u32x4*)(SG + t * LD128 + c8 * 8) = w; else *(u32x4*)(XV + t * 520 + (c8 - 16) * 8) = w;
        }
        for (int q = tid; q < 32 * 64; q += NTHREADS) {
            const int t = q >> 6, c8 = q & 63, tok = tok0 + t;
            float a0[8], a1[8];
            unpack8(*(const u32x4*)(YDIR + (size_t)tok * 512 + c8 * 8), a0); unpack8(*(const u32x4*)(YDIR + ((size_t)T_LAT + tok) * 512 + c8 * 8), a1);
            f32x4 s0 = {a0[0] + a1[0], a0[1] + a1[1], a0[2] + a1[2], a0[3] + a1[3]}, s1 = {a0[4] + a1[4], a0[5] + a1[5], a0[6] + a1[6], a0[7] + a1[7]};
            *(f32x4*)(YF + t * 516 + c8 * 8) = s0; *(f32x4*)(YF + t * 516 + c8 * 8 + 4) = s1;
        }
        __syncthreads();
        {
            const int h = wave;
            f32x16 acc0 = zero16(), acc1 = zero16();
#pragma unroll
            for (int s2 = 0; s2 < 8; ++s2) {
                const bf16x8 a = ld_nat(SG + r * LD128, s2, hh);
                const bf16x8 b0 = *(const bf16x8*)(G2T + (size_t)(64 * h + r) * 128 + 16 * s2 + 8 * hh), b1 = *(const bf16x8*)(G2T + (size_t)(64 * h + 32 + r) * 128 + 16 * s2 + 8 * hh);
                acc0 = MFMA32(a, b0, acc0); acc1 = MFMA32(a, b1, acc1);
            }
            const int c0 = 64 * h + r, c1 = c0 + 32;
            const float lg0 = p.in[I_LNG][c0], lb0 = p.in[I_LNB][c0], lg1 = p.in[I_LNG][c1], lb1 = p.in[I_LNB][c1];
            float bonv[16];
#pragma unroll
            for (int g = 0; g < 16; ++g) { const int tok = tok0 + crow(g, hh); bonv[g] = BON[(size_t)tok * 8 + h] + BON[((size_t)T_LAT + tok) * 8 + h]; }
#pragma unroll
            for (int g = 0; g < 16; ++g) {
                const int i = crow(g, hh), tok = tok0 + i;
                const float y0 = YF[i * 516 + c0], y1 = YF[i * 516 + c1];
                const float mean = half_sum(y0 + y1, hh) * (1.f / 64.f); const float d0 = y0 - mean, d1 = y1 - mean;
                const float var = half_sum(d0 * d0 + d1 * d1, hh) * (1.f / 64.f); const float rs = frsq(var + 64e-5f);
                const float bon = bonv[g];
                const float o0 = (d0 * rs * lg0 + lb0 + bon * bf2f(XV[i * 520 + c0])) * acc0[g], o1 = (d1 * rs * lg1 + lb1 + bon * bf2f(XV[i * 520 + c1])) * acc1[g];
                OB[(size_t)tok * 512 + c0] = f2bf(o0); OB[(size_t)tok * 512 + c1] = f2bf(o1);
            }
        }
        {
            unsigned q0[16], q1[16], zq[16];
#pragma unroll
            for (int k = 0; k < 16; ++k) {
                const int pi = wave * 16 + k, t = pi >> 2, h = pi & 3, tok = tok0 + t;
                const size_t o0 = (size_t)tok * 512 + h * 128 + 2 * lane;
                q0[k] = *(const unsigned*)(ODIR + o0); q1[k] = *(const unsigned*)(ODIR + (size_t)T_LAT * 512 + o0); zq[k] = *(const unsigned*)(PL + (size_t)tok * IN_COLS + 1536 + h * 128 + 2 * lane);
            }
            const float on0 = p.in[I_ONORM][2 * lane], on1 = p.in[I_ONORM][2 * lane + 1];
#pragma unroll
            for (int k = 0; k < 16; ++k) {
                const int pi = wave * 16 + k, t = pi >> 2, h = pi & 3, tok = tok0 + t;
                const size_t o0 = (size_t)tok * 512 + h * 128 + 2 * lane;
                const float a0 = bf2f((bf16_t)(q0[k] & 0xffffu)) + bf2f((bf16_t)(q1[k] & 0xffffu)), a1 = bf2f((bf16_t)(q0[k] >> 16)) + bf2f((bf16_t)(q1[k] >> 16));
                const float ss = wave_sum_fast(a0 * a0 + a1 * a1);
                const float rstd = frsq(ss * (1.f / 128.f) + 1e-6f);
                const float z0 = bf2f((bf16_t)(zq[k] & 0xffffu)), z1 = bf2f((bf16_t)(zq[k] >> 16));
                *(unsigned*)(OA + o0) = pk2(a0 * rstd * on0 * fsilu(z0), a1 * rstd * on1 * fsilu(z1));
            }
        }
    }
}

DI void phase5(const Params& p, char* smem) {
    const bf16_t* OA = (const bf16_t*)(p.ws + WS_OA); const bf16_t* OB = (const bf16_t*)(p.ws + WS_OB);
    const bf16_t* WA = (const bf16_t*)(p.ws + WS_WOA); const bf16_t* WB = (const bf16_t*)(p.ws + WS_WOB);
    const bf16_t* PL = (const bf16_t*)(p.ws + WS_PLAT); bf16_t* Y = (bf16_t*)(p.aux + AUX_Y);
    if (USE_G8) {
        constexpr int NT8 = D / 256, MT8 = T_LAT / 256;
        constexpr int GLD = 264;
        static_assert(256 * GLD * 2 <= LDS_BYTES, "gate tile lds");
        bf16_t* GT = (bf16_t*)smem;
        auto stage_gates = [&](int brow, int gcol0) {
            const int tid = tid_x();
            u32x4 gv[16];
#pragma unroll
            for (int i = 0; i < 16; ++i) { const int ch = tid + i * NTHREADS, row = ch >> 5, c16 = ch & 31; gv[i] = *(const u32x4*)(PL + (size_t)(brow + row) * IN_COLS + gcol0 + c16 * 8); }
#pragma unroll
            for (int i = 0; i < 16; ++i) { const int ch = tid + i * NTHREADS, row = ch >> 5, c16 = ch & 31; *(u32x4*)(GT + row * GLD + c16 * 8) = gv[i]; }
            __syncthreads();
        };
        for (int t = blockIdx.x; t < MT8 * NT8; t += gridDim.x) {
            int mt, nt; if (!g8::tile_order(t, MT8, NT8, mt, nt)) break;
            const int brow = mt * 256, bcol = nt * 256;
            g8::Acc acc; g8::acc_zero(acc);
            g8::kloop(acc, smem, OA, 512, WA, 512, 512, brow, bcol);
            stage_gates(brow, COL_G0 + bcol);
            g8::for_each_quad(acc, brow, bcol, [&](int row, int col, const f32x4& v) {
                const u32x2 gq = *(const u32x2*)(GT + (row - brow) * GLD + (col - bcol));
                const float g0 = bf2f((bf16_t)(gq.x & 0xffffu)), g1 = bf2f((bf16_t)(gq.x >> 16)), g2 = bf2f((bf16_t)(gq.y & 0xffffu)), g3 = bf2f((bf16_t)(gq.y >> 16));
                u32x2 o; o.x = pk2(fsigmoid(g0) * v.x, fsigmoid(g1) * v.y); o.y = pk2(fsigmoid(g2) * v.z, fsigmoid(g3) * v.w);
                *(u32x2*)(Y + (size_t)row * D + col) = o;
            });
            __syncthreads();
            g8::acc_zero(acc);
            g8::kloop(acc, smem, OB, 512, WB, 512, 512, brow, bcol);
            stage_gates(brow, COL_G0 + D + bcol);
            g8::for_each_quad(acc, brow, bcol, [&](int row, int col, const f32x4& v) {
                const u32x2 gq = *(const u32x2*)(GT + (row - brow) * GLD + (col - bcol));
                const float g0 = bf2f((bf16_t)(gq.x & 0xffffu)), g1 = bf2f((bf16_t)(gq.x >> 16)), g2 = bf2f((bf16_t)(gq.y & 0xffffu)), g3 = bf2f((bf16_t)(gq.y >> 16));
#ifdef EMU
                const unsigned long long tq = *(const unsigned long long*)(Y + (size_t)row * D + col);
#else
                const unsigned long long tq = __hip_atomic_load((const unsigned long long*)(Y + (size_t)row * D + col), __ATOMIC_RELAXED, __HIP_MEMORY_SCOPE_AGENT);
#endif
                const unsigned tlo = (unsigned)tq, thi = (unsigned)(tq >> 32);
                const float t0 = bf2f((bf16_t)(tlo & 0xffffu)), t1 = bf2f((bf16_t)(tlo >> 16)), t2 = bf2f((bf16_t)(thi & 0xffffu)), t3 = bf2f((bf16_t)(thi >> 16));
                u32x2 o; o.x = pk2(t0 + fsigmoid(g0) * v.x, t1 + fsigmoid(g1) * v.y); o.y = pk2(t2 + fsigmoid(g2) * v.z, t3 + fsigmoid(g3) * v.w);
                *(u32x2*)(Y + (size_t)row * D + col) = o;
            });
            __syncthreads();
        }
        return;
    }
    constexpr int MR5 = 2, BM5 = 64 * MR5; constexpr int NT = D / 128, MT = T_LAT / BM5;
    for (int t = blockIdx.x; t < MT * NT; t += gridDim.x) {
        const int mt = t / NT, nt = t % NT, row0 = mt * BM5;
        f32x4 acca[MR5][4], accb[MR5][4]; acc_zero(acca); acc_zero(accb);
        gemm_kloop(acca, smem, [&](int i) { return OA + (size_t)(row0 + i) * 512; }, WA + (size_t)nt * 128 * 512, 512, 512);
        gemm_kloop(accb, smem, [&](int i) { return OB + (size_t)(row0 + i) * 512; }, WB + (size_t)nt * 128 * 512, 512, 512);
        const int t2 = tid_x(), l2 = t2 & 63, w2 = t2 >> 6; const int wr = w2 >> 1, wc = w2 & 1, fr = l2 & 15, fq = l2 >> 4;
#pragma unroll
        for (int m = 0; m < MR5; ++m)
#pragma unroll
            for (int n = 0; n < 4; ++n)
#pragma unroll
                for (int j = 0; j < 4; ++j) {
                    const int row = row0 + wr * 16 * MR5 + m * 16 + fq * 4 + j, col = nt * 128 + wc * 64 + n * 16 + fr;
                    const float ga = bf2f(PL[(size_t)row * IN_COLS + COL_G0 + col]), gb = bf2f(PL[(size_t)row * IN_COLS + COL_G0 + D + col]);
                    Y[(size_t)row * D + col] = f2bf(sigmoidf_(ga) * acca[m][n][j] + sigmoidf_(gb) * accb[m][n][j]);
                }
    }
}

DI void phase6(const Params& p, char* smem) {
    const bf16_t* Y = (const bf16_t*)(p.aux + AUX_Y); const bf16_t* WO = (const bf16_t*)(p.ws + WS_WOUT);
    const float* mod = (const float*)(p.ws + WS_MOD); float* Hh = (float*)(p.ws + WS_H);
    if (USE_G8) {
        constexpr int NT = D / 256, MT = T_LAT / 256;
        const float* X = p.in[I_X];
        for (int t = blockIdx.x; t < MT * NT; t += gridDim.x) {
            int mt, nt; if (!g8::tile_order(t, MT, NT, mt, nt)) break;
            const int brow = mt * 256, bcol = nt * 256;
            g8::Acc acc; g8::acc_zero(acc);
            g8::kloop(acc, smem, Y, D, WO, D, D, brow, bcol);
            g8::for_each_quad(acc, brow, bcol, [&](int row, int col, const f32x4& v) {
                const int b = row / S; const f32x4 xv = *(const f32x4*)(X + (size_t)row * D + col), gv = *(const f32x4*)(mod + (size_t)b * 6 * D + 2 * D + col);
                f32x4 o; o.x = xv.x + gv.x * v.x; o.y = xv.y + gv.y * v.y; o.z = xv.z + gv.z * v.z; o.w = xv.w + gv.w * v.w;
                *(f32x4*)(Hh + (size_t)row * D + col) = o;
            });
        }
    } else {
        const int tid = tid_x(), lane = tid & 63, wave = tid >> 6, wr = wave >> 1, wc = wave & 1, fr = lane & 15, fq = lane >> 4;
        constexpr int NT = D / 128, MT = T_LAT / BM;
        for (int t = blockIdx.x; t < MT * NT; t += gridDim.x) {
            const int mt = t / NT, nt = t % NT, row0 = mt * BM;
            f32x4 acc[MREP][4]; acc_zero(acc);
            gemm_kloop(acc, smem, [&](int i) { return Y + (size_t)(row0 + i) * D; }, WO + (size_t)nt * 128 * D, D, D);
#pragma unroll
            for (int m = 0; m < MREP; ++m)
#pragma unroll
                for (int n = 0; n < 4; ++n)
#pragma unroll
                    for (int j = 0; j < 4; ++j) {
                        const int row = row0 + wr * 16 * MREP + m * 16 + fq * 4 + j, col = nt * 128 + wc * 64 + n * 16 + fr, b = row / S;
                        Hh[(size_t)row * D + col] = p.in[I_X][(size_t)row * D + col] + mod[(size_t)b * 6 * D + 2 * D + col] * acc[m][n][j];
                    }
        }
    }
    __syncthreads();
    const int tid6 = tid_x(), lane = tid6 & 63, wave = tid6 >> 6;
    const int gw = blockIdx.x * 8 + wave, ngw = gridDim.x * 8;
    float* scr = (float*)smem + wave * (64 * 33);
    bf16_t* GUT = (bf16_t*)(p.aux + AUX_GUT); bf16_t* DNT = (bf16_t*)(p.ws + WS_DNT);
    {
        constexpr int nkb = D / 64, nnb = DE / 32, per = nkb * nnb;
        for (int it = gw; it < NEXP * 2 * per; it += ngw) {
            const int e = it / (2 * per), r = it % (2 * per), up = r / per, r2 = r % per, kb = r2 / nnb, nb = r2 % nnb;
            transpose_item((up ? p.in[I_MU_UP] : p.in[I_MG]) + (size_t)e * D * DE, DE, DE, kb * 64, nb * 32, GUT + (size_t)e * 512 * D, D, up ? 2 : 1, scr, lane);
        }
    }
    {
        constexpr int nkb = DE / 64, nnb = D / 32, per = nkb * nnb;
        for (int it = gw; it < NEXP * per; it += ngw) {
            const int e = it / per, r2 = it % per, kb = r2 / nnb, nb = r2 % nnb;
            transpose_item(p.in[I_MD] + (size_t)e * DE * D, D, D, kb * 64, nb * 32, DNT + (size_t)e * D * DE, DE, 0, scr, lane);
        }
    }
}

#ifdef EMU
#define MFMA32F(a, b, c) emu_mfma32_f32((a), (b), (c))
#else
#define MFMA32F(a, b, c) __builtin_amdgcn_mfma_f32_32x32x2f32((a), (b), (c), 0, 0, 0)
#endif
constexpr int TB_LD = D + 4;
static_assert(32 * TB_LD * 4 <= LDS_BYTES && 8 * 32 * 64 * 4 <= LDS_BYTES, "phase7 lds");
DI void phase7(const Params& p, char* smem) {
    const int tid = tid_x(), lane = tid & 63, wave = tid >> 6, r = lane & 31, hh = lane >> 5;
    const float* Hh = (const float*)(p.ws + WS_H); const float* mod = (const float*)(p.ws + WS_MOD); const float* WRT = (const float*)(p.ws + WS_WRT);
    bf16_t* Tt = (bf16_t*)(p.ws + WS_T); int* cnt = (int*)(p.ws + WS_CNT); int* rowlist = (int*)(p.ws + WS_ROWLIST); float* pairw = (float*)(p.ws + WS_PAIRW);
    float* tb = (float*)smem;
    float* bias = (float*)(smem + LDS_BYTES - 1024);
    int* lcnt = (int*)(smem + LDS_BYTES - 768);
    int* lbase = lcnt + 32;
    if (tid < 36) bias[tid] = tid < 4 ? p.in[I_RGB][tid] : p.in[I_REB][tid - 4];
    f32x4 x[4][D / 256];
    int itn = blockIdx.x;
    if (itn < T_LAT / 32) {
#pragma unroll
        for (int tt = 0; tt < 4; ++tt)
#pragma unroll
            for (int j = 0; j < D / 256; ++j) x[tt][j] = *(const f32x4*)(Hh + (size_t)(itn * 32 + wave * 4 + tt) * D + j * 256 + lane * 4);
    }
    for (int it = blockIdx.x; it < T_LAT / 32; it += gridDim.x) {
        const int tok0 = it * 32;
        __syncthreads();
        if (tid < 32) lcnt[tid] = 0;
#pragma unroll
        for (int tt = 0; tt < 4; ++tt) {
            const int ti = wave * 4 + tt, tok = tok0 + ti, b = tok / S;
            float ss = 0.f;
#pragma unroll
            for (int j = 0; j < D / 256; ++j) ss += x[tt][j].x * x[tt][j].x + x[tt][j].y * x[tt][j].y + x[tt][j].z * x[tt][j].z + x[tt][j].w * x[tt][j].w;
            ss = wave_sum_fast(ss);
            const float rstd = frsq(ss * (1.0f / D) + 1e-6f);
#pragma unroll
            for (int j = 0; j < D / 256; ++j) {
                const int k = j * 256 + lane * 4;
                const f32x4 g = *(const f32x4*)(p.in[I_NFFN] + k), sh = *(const f32x4*)(mod + (size_t)b * 6 * D + 3 * D + k), sc = *(const f32x4*)(mod + (size_t)b * 6 * D + 4 * D + k);
                f32x4 o; o.x = x[tt][j].x * rstd * g.x * (1.f + sc.x) + sh.x; o.y = x[tt][j].y * rstd * g.y * (1.f + sc.y) + sh.y;
                o.z = x[tt][j].z * rstd * g.z * (1.f + sc.z) + sh.z; o.w = x[tt][j].w * rstd * g.w * (1.f + sc.w) + sh.w;
                *(f32x4*)(tb + ti * TB_LD + k) = o;
                u32x2 ob; ob.x = pk2(o.x, o.y); ob.y = pk2(o.z, o.w);
                *(u32x2*)(Tt + (size_t)tok * D + k) = ob;
            }
        }
        itn = it + gridDim.x;
        if (itn < T_LAT / 32) {
#pragma unroll
            for (int tt = 0; tt < 4; ++tt)
#pragma unroll
                for (int j = 0; j < D / 256; ++j) x[tt][j] = *(const f32x4*)(Hh + (size_t)(itn * 32 + wave * 4 + tt) * D + j * 256 + lane * 4);
        }
        LDS_BARRIER();
        f32x16 a0 = zero16(), a1 = zero16();
        {
            const int kbeg = wave * (D / 8);
            const float* arow = tb + r * TB_LD + kbeg + 4 * hh;
            const float* b0row = WRT + (size_t)(4 + r) * D + kbeg + 4 * hh;
            const float* b1row = WRT + (size_t)(r < 4 ? r : 0) * D + kbeg + 4 * hh;
            const float m1 = r < 4 ? 1.f : 0.f;
#pragma unroll 4
            for (int g = 0; g < D / 64; ++g) {
                const f32x4 av = *(const f32x4*)(arow + 8 * g), b0 = *(const f32x4*)(b0row + 8 * g); const f32x4 b1 = *(const f32x4*)(b1row + 8 * g) * m1;
                a0 = MFMA32F(av.x, b0.x, a0); a1 = MFMA32F(av.x, b1.x, a1); a0 = MFMA32F(av.y, b0.y, a0); a1 = MFMA32F(av.y, b1.y, a1);
                a0 = MFMA32F(av.z, b0.z, a0); a1 = MFMA32F(av.z, b1.z, a1); a0 = MFMA32F(av.w, b0.w, a0); a1 = MFMA32F(av.w, b1.w, a1);
            }
        }
        LDS_BARRIER();
        {
            float* part = tb + wave * (32 * 64);
#pragma unroll
            for (int g = 0; g < 16; ++g) { const int i = crow(g, hh); part[i * 64 + r] = a0[g]; part[i * 64 + 32 + r] = a1[g]; }
        }
        LDS_BARRIER();
        float lsum[4];
        {
            const int i = tid >> 4, c4 = (tid & 15) * 4;
#pragma unroll
            for (int e = 0; e < 4; ++e) { float sacc = 0.f;
#pragma unroll
                for (int w = 0; w < 8; ++w) sacc += tb[w * (32 * 64) + i * 64 + c4 + e];
                lsum[e] = sacc; }
        }
        LDS_BARRIER();
        { const int i = tid >> 4, c4 = (tid & 15) * 4;
#pragma unroll
          for (int e = 0; e < 4; ++e) tb[i * 64 + c4 + e] = lsum[e]; }
        LDS_BARRIER();
        int ex1 = 0, ex2 = 0, rk1 = 0, rk2 = 0; float w1 = 0.f, w2 = 0.f;
        if (tid < 32) {
            const float* L = tb + tid * 64;
            float gl[4];
#pragma unroll
            for (int i = 0; i < 4; ++i) gl[i] = L[32 + i] + bias[i];
            int g = 0; float mx = gl[0];
#pragma unroll
            for (int i = 1; i < 4; ++i) if (gl[i] > mx) { mx = gl[i]; g = i; }
            float se = 0.f;
#pragma unroll
            for (int i = 0; i < 4; ++i) se += fexp(gl[i] - mx);
            const float pg = 1.0f / se;
            int i1 = 0; float l1 = L[g * 8] + bias[4 + g * 8];
            for (int i = 1; i < 8; ++i) { const float v = L[g * 8 + i] + bias[4 + g * 8 + i]; if (v > l1) { l1 = v; i1 = i; } }
            int i2 = -1; float l2 = -3.0e38f;
            for (int i = 0; i < 8; ++i) { const float v = L[g * 8 + i] + bias[4 + g * 8 + i]; if (i != i1 && v > l2) { l2 = v; i2 = i; } }
            const float e2 = fexp(l2 - l1); w1 = pg / (1.f + e2); w2 = pg * e2 / (1.f + e2);
            ex1 = g * 8 + i1; ex2 = g * 8 + i2;
            rk1 = atomicAdd(&lcnt[ex1], 1); rk2 = atomicAdd(&lcnt[ex2], 1);
        }
        LDS_BARRIER();
        if (tid < 32) { const int c = lcnt[tid]; lbase[tid] = c ? atomicAdd(&cnt[tid * CNT_STRIDE], c) : 0; }
        __syncthreads();
        if (tid < 32) {
            const int tok = tok0 + tid;
            rowlist[(size_t)ex1 * CAP + lbase[ex1] + rk1] = tok * 2; pairw[tok * 2] = w1;
            rowlist[(size_t)ex2 * CAP + lbase[ex2] + rk2] = tok * 2 + 1; pairw[tok * 2 + 1] = w2;
        }
    }
}

constexpr int MOE_TM = USE_G8 ? 256 : BM;
DI void moe_tiles(const Params& p, char* smem, int* pre) {
    const int* cnt = (const int*)(p.ws + WS_CNT);
    __syncthreads();
    if (tid_x() == 0) { int s = 0; for (int e = 0; e < NEXP; ++e) { pre[e] = s; s += (cnt[e * CNT_STRIDE] + MOE_TM - 1) / MOE_TM; } pre[NEXP] = s; }
    __syncthreads();
}
DI void phase8(const Params& p, char* smem) {
    const int tid = tid_x(), lane = tid & 63, wave = tid >> 6, wr = wave >> 1, wc = wave & 1, fr = lane & 15, fq = lane >> 4;
    int* pre = (int*)(smem + LDS_BYTES - 256);
    moe_tiles(p, smem, pre);
    const int* cnt = (const int*)(p.ws + WS_CNT); const int* rowlist = (const int*)(p.ws + WS_ROWLIST);
    const bf16_t* Tt = (const bf16_t*)(p.ws + WS_T); const bf16_t* GUT = (const bf16_t*)(p.aux + AUX_GUT); bf16_t* HID = (bf16_t*)(p.ws + WS_HID);
    if (USE_G8) {
        const int ntile8 = pre[NEXP] * 2;
        for (int t = blockIdx.x; t < ntile8; t += gridDim.x) {
            const int mg = t >> 1, nt = t & 1; int e = 0;
            while (pre[e + 1] <= mg) ++e;
            const int mt = mg - pre[e], ce = cnt[e * CNT_STRIDE]; const int* rl = rowlist + (size_t)e * CAP;
            g8::Acc acc; g8::acc_zero(acc);
            g8::kloop_g(acc, smem, Tt, [&](int r) { int idx = mt * 256 + r; idx = idx < ce ? idx : ce - 1; return (rl[idx] >> 1) * D; }, GUT + ((size_t)e * 512 + nt * 256) * D, D, D, 0);
            const int t2 = tid_x(), wid = t2 >> 6, l2 = t2 & 63, wr2 = wid >> 2, wc2 = wid & 3, fr2 = l2 & 15, fq2 = l2 >> 4;
            int prs[2][4];
#pragma unroll
            for (int ai = 0; ai < 2; ++ai)
#pragma unroll
                for (int m = 0; m < 4; ++m) { const int idx = mt * 256 + ai * 128 + wr2 * 64 + m * 16 + fr2; prs[ai][m] = idx < ce ? rl[idx] : -1; }
#pragma unroll
            for (int ai = 0; ai < 2; ++ai)
#pragma unroll
                for (int m = 0; m < 4; ++m) {
                    if (prs[ai][m] >= 0) {
                        const int pair = prs[ai][m];
#pragma unroll
                        for (int bj = 0; bj < 2; ++bj) {
                            const f32x4 g = acc[ai][bj][m][0], u = acc[ai][bj][m][1];
                            u32x2 o; o.x = pk2(fsilu(g.x) * u.x, fsilu(g.y) * u.y); o.y = pk2(fsilu(g.z) * u.z, fsilu(g.w) * u.w);
                            *(u32x2*)(HID + (size_t)pair * DE + nt * 128 + bj * 64 + wc2 * 16 + fq2 * 4) = o;
                        }
                    }
                }
        }
        return;
    }
    const int ntile = pre[NEXP] * 4;
    for (int t = blockIdx.x; t < ntile; t += gridDim.x) {
        const int mg = t >> 2, nt = t & 3; int e = 0;
        while (pre[e + 1] <= mg) ++e;
        const int mt = mg - pre[e], ce = cnt[e * CNT_STRIDE]; const int* rl = rowlist + (size_t)e * CAP;
        f32x4 acc[MREP][4]; acc_zero(acc);
        gemm_kloop(acc, smem, [&](int i) { int idx = mt * BM + i; idx = idx < ce ? idx : ce - 1; return Tt + (size_t)(rl[idx] >> 1) * D; }, GUT + ((size_t)e * 512 + nt * 128) * D, D, D);
#pragma unroll
        for (int m = 0; m < MREP; ++m)
#pragma unroll
            for (int j = 0; j < 4; ++j) {
                const int idx = mt * BM + wr * 16 * MREP + m * 16 + fq * 4 + j;
                if (idx < ce) {
                    const int pair = rl[idx];
#pragma unroll
                    for (int n = 0; n < 2; ++n) {
                        const float g = acc[m][n][j], u = acc[m][n + 2][j];
                        HID[(size_t)pair * DE + nt * 64 + wc * 32 + n * 16 + fr] = f2bf(siluf_(g) * u);
                    }
                }
            }
    }
}
DI void phase9(const Params& p, char* smem) {
    const int tid = tid_x(), lane = tid & 63, wave = tid >> 6, wr = wave >> 1, wc = wave & 1, fr = lane & 15, fq = lane >> 4;
    int* pre = (int*)(smem + LDS_BYTES - 256);
    moe_tiles(p, smem, pre);
    const int* cnt = (const int*)(p.ws + WS_CNT); const int* rowlist = (const int*)(p.ws + WS_ROWLIST); const float* pairw = (const float*)(p.ws + WS_PAIRW);
    const bf16_t* HID = (const bf16_t*)(p.ws + WS_HID); const bf16_t* DNT = (const bf16_t*)(p.ws + WS_DNT); bf16_t* OP = (bf16_t*)(p.ws + WS_OPAIR);
    if (USE_G8) {
        constexpr int NT8 = D / 256;
        const int ntile8 = pre[NEXP] * NT8;
        for (int t = blockIdx.x; t < ntile8; t += gridDim.x) {
            const int mg = t / NT8, nt = t % NT8; int e = 0;
            while (pre[e + 1] <= mg) ++e;
            const int mt = mg - pre[e], ce = cnt[e * CNT_STRIDE]; const int* rl = rowlist + (size_t)e * CAP;
            g8::Acc acc; g8::acc_zero(acc);
            g8::kloop_g(acc, smem, HID, [&](int r) { int idx = mt * 256 + r; idx = idx < ce ? idx : ce - 1; return rl[idx] * DE; }, DNT + ((size_t)e * D + nt * 256) * DE, DE, DE, 0);
            {
                const int t2 = tid_x(), wid = t2 >> 6, l2 = t2 & 63, wr2 = wid >> 2, wc2 = wid & 3, fr2 = l2 & 15, fq2 = l2 >> 4;
                int prs[2][4]; float pws[2][4];
#pragma unroll
                for (int ai = 0; ai < 2; ++ai)
#pragma unroll
                    for (int m = 0; m < 4; ++m) { const int idx = mt * 256 + ai * 128 + wr2 * 64 + m * 16 + fr2; prs[ai][m] = idx < ce ? rl[idx] : -1; }
#pragma unroll
                for (int ai = 0; ai < 2; ++ai)
#pragma unroll
                    for (int m = 0; m < 4; ++m) pws[ai][m] = prs[ai][m] >= 0 ? pairw[prs[ai][m]] : 0.f;
#pragma unroll
                for (int ai = 0; ai < 2; ++ai)
#pragma unroll
                    for (int m = 0; m < 4; ++m) {
                        if (prs[ai][m] >= 0) {
                            const float w = pws[ai][m]; bf16_t* orow = OP + (size_t)prs[ai][m] * D + nt * 256 + wc2 * 32 + fq2 * 4;
#pragma unroll
                            for (int bj = 0; bj < 2; ++bj)
#pragma unroll
                                for (int n = 0; n < 2; ++n) { const f32x4 v = acc[ai][bj][m][n];
                                    u32x2 o; o.x = pk2(v.x * w, v.y * w); o.y = pk2(v.z * w, v.w * w); *(u32x2*)(orow + bj * 128 + n * 16) = o; }
                        }
                    }
            }
        }
        return;
    }
    constexpr int NT = D / 128;
    const int ntile = pre[NEXP] * NT;
    for (int t = blockIdx.x; t < ntile; t += gridDim.x) {
        const int mg = t / NT, nt = t % NT; int e = 0;
        while (pre[e + 1] <= mg) ++e;
        const int mt = mg - pre[e], ce = cnt[e * CNT_STRIDE]; const int* rl = rowlist + (size_t)e * CAP;
        f32x4 acc[MREP][4]; acc_zero(acc);
        gemm_kloop(acc, smem, [&](int i) { int idx = mt * BM + i; idx = idx < ce ? idx : ce - 1; return HID + (size_t)rl[idx] * DE; }, DNT + ((size_t)e * D + nt * 128) * DE, DE, DE);
#pragma unroll
        for (int m = 0; m < MREP; ++m)
#pragma unroll
            for (int j = 0; j < 4; ++j) {
                const int idx = mt * BM + wr * 16 * MREP + m * 16 + fq * 4 + j;
                if (idx < ce) {
                    const int pair = rl[idx]; const float w = pairw[pair];
#pragma unroll
                    for (int n = 0; n < 4; ++n) OP[(size_t)pair * D + nt * 128 + wc * 64 + n * 16 + fr] = f2bf(acc[m][n][j] * w);
                }
            }
    }
}

DI void phase10(const Params& p, char* smem) {
    const int lane = tid_x() & 63, wave = tid_x() >> 6;
    const int gw = blockIdx.x * 8 + wave, ngw = gridDim.x * 8;
    const float* Hh = (const float*)(p.ws + WS_H); const float* mod = (const float*)(p.ws + WS_MOD); const bf16_t* OP = (const bf16_t*)(p.ws + WS_OPAIR);
    for (int tok = gw; tok < T_LAT; tok += ngw) {
        const int b = tok / S;
        f32x4 x[D / 256]; float ss = 0.f;
#pragma unroll
        for (int j = 0; j < D / 256; ++j) {
            const int k = j * 256 + lane * 4;
            const f32x4 hv = *(const f32x4*)(Hh + (size_t)tok * D + k), g2 = *(const f32x4*)(mod + (size_t)b * 6 * D + 5 * D + k);
            const u32x2 p0 = *(const u32x2*)(OP + (size_t)(tok * 2) * D + k), p1 = *(const u32x2*)(OP + (size_t)(tok * 2 + 1) * D + k);
            f32x4 m;
            m.x = bf2f((bf16_t)(p0.x & 0xffffu)) + bf2f((bf16_t)(p1.x & 0xffffu)); m.y = bf2f((bf16_t)(p0.x >> 16)) + bf2f((bf16_t)(p1.x >> 16));
            m.z = bf2f((bf16_t)(p0.y & 0xffffu)) + bf2f((bf16_t)(p1.y & 0xffffu)); m.w = bf2f((bf16_t)(p0.y >> 16)) + bf2f((bf16_t)(p1.y >> 16));
            x[j].x = hv.x + g2.x * m.x; x[j].y = hv.y + g2.y * m.y; x[j].z = hv.z + g2.z * m.z; x[j].w = hv.w + g2.w * m.w;
            ss += x[j].x * x[j].x + x[j].y * x[j].y + x[j].z * x[j].z + x[j].w * x[j].w;
        }
        ss = wave_sum(ss);
        const float rstd = 1.0f / sqrtf(ss * (1.0f / D) + 1e-6f);
#pragma unroll
        for (int j = 0; j < D / 256; ++j) {
            const int k = j * 256 + lane * 4; const f32x4 g = *(const f32x4*)(p.in[I_FIN] + k);
            f32x4 o; o.x = x[j].x * rstd * g.x; o.y = x[j].y * rstd * g.y; o.z = x[j].z * rstd * g.z; o.w = x[j].w * rstd * g.w;
            *(f32x4*)(p.out + (size_t)tok * D + k) = o;
        }
    }
}

DI void run_phase(const Params& p, int ph, char* smem) {
    switch (ph) {
        case PH_MOD: phase0(p, smem); break;
        case PH_U: phase1(p, smem); break;
        case PH_P: phase2(p, smem); break;
        case PH_HALO: phase_halo(p, smem); break;
        case PH_FIR: phase_fir(p, smem); break;
        case PH_CHAINS: phase3(p, smem); break;
        case PH_POST: phase4(p, smem); break;
        case PH_MERGE: phase5(p, smem); break;
        case PH_WOUT: phase6(p, smem); break;
        case PH_ROUTER: phase7(p, smem); break;
        case PH_UP: phase8(p, smem); break;
        case PH_DOWN: phase9(p, smem); break;
        default: phase10(p, smem); break;
    }
}

#ifndef EMU
namespace cg = cooperative_groups;
#define XB_TMO      128
#define XB_XCNT(j)  (256  + 64 * (j))
#define XB_XSUB(j)  (1280 + 64 * (j))
#define XB_XGEN(j)  (2304 + 64 * (j))
#define XB_TOP      3328
#define XB_TOPGEN   3392
#define XB_SPIN_CAP (1u << 20)
DI unsigned xb_ld(unsigned* p) { return __hip_atomic_load(p, __ATOMIC_RELAXED, __HIP_MEMORY_SCOPE_AGENT); }
DI unsigned xb_add(unsigned* p, unsigned v) { return __hip_atomic_fetch_add(p, v, __ATOMIC_RELAXED, __HIP_MEMORY_SCOPE_AGENT); }
DI unsigned xb_xcc_id() { return (unsigned)__builtin_amdgcn_s_getreg((3 << 11) | 20) & 0xFu; }
#define XB_SPIN(cond, bar) do { unsigned _sp = 0; while (cond) { __builtin_amdgcn_s_sleep(1); \
    if ((++_sp & 255u) == 0u) { if (xb_ld(&(bar)[XB_TMO])) break; if (_sp > XB_SPIN_CAP) { atomicAdd(&(bar)[XB_TMO], 1u); break; } } } } while (0)
DI void xcd_barrier_post(unsigned* bar) { if (threadIdx.x == 0) (void)xb_add(&bar[XB_XCNT(xb_xcc_id())], 1u); }
DI void xcd_barrier_complete(unsigned* bar, unsigned x, unsigned& nloc, unsigned& nx) {
    const unsigned G = gridDim.x;
    unsigned sum, cnt, mine, sp = 0u;
    for (;;) {
        sum = 0u; cnt = 0u; mine = 0u;
#pragma unroll
        for (unsigned j = 0; j < 16; ++j) { const unsigned c = xb_ld(&bar[XB_XCNT(j)]); sum += c; cnt += (c > 0u) ? 1u : 0u; mine = (j == x) ? c : mine; }
        if (sum == G) break;
        __builtin_amdgcn_s_sleep(1);
        if ((++sp & 255u) == 0u) { if (xb_ld(&bar[XB_TMO])) break; if (sp > XB_SPIN_CAP) { atomicAdd(&bar[XB_TMO], 1u); break; } }
    }
    nloc = mine > 0u ? mine : 1u; nx = cnt > 0u ? cnt : 1u;
}
DI void xcd_barrier(unsigned* bar, volatile unsigned* st) {
    asm volatile("s_waitcnt vmcnt(0)" ::: "memory");
    __syncthreads();
    if (threadIdx.x == 0) {
        __builtin_amdgcn_s_waitcnt(0);
        const unsigned x = xb_xcc_id();
        unsigned nloc = st[0], nx = st[1];
        if (nloc == 0u) { xcd_barrier_complete(bar, x, nloc, nx); st[0] = nloc; st[1] = nx; }
        const unsigned old = xb_add(&bar[XB_XSUB(x)], 1u);
        const unsigned gen = old / nloc;
        if (old + 1u == (gen + 1u) * nloc) {
            __builtin_amdgcn_fence(__ATOMIC_RELEASE, "agent");
            asm volatile("s_waitcnt vmcnt(0)" ::: "memory");
            const unsigned og = xb_add(&bar[XB_TOP], 1u);
            const unsigned tg = og / nx;
            if (og + 1u == (tg + 1u) * nx) xb_add(&bar[XB_TOPGEN], 1u);
            else XB_SPIN(xb_ld(&bar[XB_TOPGEN]) == tg, bar);
            __builtin_amdgcn_fence(__ATOMIC_ACQUIRE, "agent");
            xb_add(&bar[XB_XGEN(x)], 1u);
            asm volatile("s_waitcnt vmcnt(0)" ::: "memory");
        } else {
            XB_SPIN(xb_ld(&bar[XB_XGEN(x)]) == gen, bar);
            __builtin_amdgcn_fence(__ATOMIC_ACQUIRE, "agent");
            asm volatile("s_waitcnt vmcnt(0)" ::: "memory");
        }
    }
    __syncthreads();
}
__global__ void __launch_bounds__(NTHREADS) mk_forward(Params p) {
    extern __shared__ __attribute__((aligned(16))) char smem[];
    cg::grid_group grid = cg::this_grid();
    typedef const Params __attribute__((address_space(4)))* KPtr;
    volatile unsigned* xst = (volatile unsigned*)(smem + LDS_BYTES);
    if (threadIdx.x < 2) xst[threadIdx.x] = 0u;
    if (p.ph_lo == 0x7fffffff) grid.sync();
    xcd_barrier_post((unsigned*)(p.ws + WS_XBAR));
#define PHASE(k, fn) { KPtr kp = (KPtr)__builtin_amdgcn_kernarg_segment_ptr(); asm volatile("" : "+s"(kp)); fn(*(const Params*)kp, smem); \
        unsigned* xbar = (unsigned*)(((const Params*)kp)->ws + WS_XBAR); \
        if ((k) + 1 < NPHASES) xcd_barrier(xbar, xst); }
    PHASE(0, phase0) PHASE(1, phase1) PHASE(2, phase2)
    if (!USE_G8) PHASE(3, phase_halo)
    PHASE(4, phase_fir) PHASE(5, phase3) PHASE(6, phase4)
    PHASE(7, phase5) PHASE(8, phase6) PHASE(9, phase7) PHASE(10, phase8) PHASE(11, phase9) PHASE(12, phase10)
#undef PHASE
}

extern "C" void kernel_launch(void* const* d_in, const int* in_sizes, int n_in, void* d_out, int out_size, void* d_ws, size_t ws_size, hipStream_t stream) {
    static int grid_blocks = 0;
    if (grid_blocks == 0) {
        if (n_in != 35 || out_size != T_LAT * D || ws_size < WS_END || (size_t)out_size * 4 < AUX_END) {
            fprintf(stderr, "kernel_launch: unexpected shapes (n_in %d out %d ws %zu need %zu aux need %zu)\n", n_in, out_size, ws_size, (size_t)WS_END, (size_t)AUX_END);
            grid_blocks = -1; return;
        }
        int dev = 0, cus = 0, per_cu = 0;
        hipGetDevice(&dev);
        hipDeviceGetAttribute(&cus, hipDeviceAttributeMultiprocessorCount, dev);
        hipFuncSetAttribute((const void*)mk_forward, hipFuncAttributeMaxDynamicSharedMemorySize, LDS_BYTES + 256);
        hipOccupancyMaxActiveBlocksPerMultiprocessor(&per_cu, (const void*)mk_forward, NTHREADS, LDS_BYTES + 256);
        if (per_cu < 1) { fprintf(stderr, "kernel_launch: occupancy query says %d blocks/CU\n", per_cu); per_cu = 1; }
        if (per_cu > 1) per_cu = 1;
        grid_blocks = cus * per_cu;
    }
    if (grid_blocks < 0) return;
    Params p{};
    for (int i = 0; i < 35; ++i) p.in[i] = (const float*)d_in[i];
    p.out = (float*)d_out; p.ws = (char*)d_ws; p.aux = (char*)d_out;
    p.ph_lo = 0; p.ph_hi = NPHASES;
    (void)hipMemsetAsync((char*)d_ws + WS_XBAR, 0, 3456 * 4, stream);
    void* args[] = {&p};
    hipError_t e = hipLaunchCooperativeKernel((const void*)mk_forward, dim3(grid_blocks), dim3(NTHREADS), args, LDS_BYTES + 256, stream);
    if (e != hipSuccess) fprintf(stderr, "cooperative launch failed: %s (grid %d)\n", hipGetErrorString(e), grid_blocks);
}
#endif
```

```cpp
#ifndef EMU
#include <hip/hip_runtime.h>
#include <hip/hip_cooperative_groups.h>
#include <cstdio>
#endif
#include <stdint.h>
#include <stddef.h>

#ifndef CFG_D
#define CFG_D 1024
#define CFG_B 8
#define CFG_S 2048
#define CFG_CTX 256
#endif
#ifndef MK_LAUNCHES
#define MK_LAUNCHES 1
#endif

typedef unsigned short bf16_t;
typedef short bf16x8 __attribute__((ext_vector_type(8)));
typedef float f32x4 __attribute__((ext_vector_type(4)));
typedef unsigned u32x4 __attribute__((ext_vector_type(4)));
typedef unsigned u32x2 __attribute__((ext_vector_type(2)));

#define DI __device__ __forceinline__
DI int tid_x() { int t = (int)threadIdx.x;
#ifndef EMU
    asm volatile("" : "+v"(t));
#endif
    return t; }

constexpr int D = CFG_D, NB = CFG_B, S = CFG_S, CTXL = CFG_CTX;
constexpr int GW = 64, ROWS = S / GW;
constexpr int T_CTX = NB * CTXL, T_LAT = NB * S, T_ALL = T_CTX + T_LAT;
constexpr int H_A = 4, H_B = 8;
constexpr int A_COLS = 2064, B_COLS = 1920;
constexpr int IN_COLS = A_COLS + B_COLS + 2 * D;
constexpr int COL_B0 = A_COLS, COL_G0 = A_COLS + B_COLS;
constexpr int CTX_COLS = COL_G0;
constexpr int NP = ((IN_COLS + 127) / 128) * 128;
constexpr int NEXP = 32, DE = 256;
constexpr int NV = NB + 1;
constexpr int NTHREADS = 512;
constexpr int MREP = (T_CTX % 256 == 0 && T_LAT % 256 == 0) ? 4 : 2;
constexpr int BM = 64 * MREP;
constexpr int NPHASES = 13;
enum { PH_MOD = 0, PH_U, PH_P, PH_HALO, PH_FIR, PH_CHAINS, PH_POST, PH_MERGE, PH_WOUT, PH_ROUTER, PH_UP, PH_DOWN, PH_FINAL };
constexpr int LDS_BYTES = 155648;
constexpr int CAP = T_LAT;

static_assert(D % 256 == 0 && S % 64 == 0 && CTXL % 64 == 0 && T_CTX % BM == 0 && T_LAT % BM == 0, "shape");

constexpr size_t al256(size_t x) { return (x + 255) & ~(size_t)255; }
constexpr int CNT_STRIDE = 64;
constexpr size_t WS_CNT = 512 + 3456 * 4 + 256;
constexpr size_t WS_BAR = 256;
constexpr size_t WS_XBAR = 512;
constexpr size_t WS_MOD = 512 + 3456 * 4 + 256 + 32 * 64 * 4;
constexpr size_t WS_AB = al256(WS_MOD + (size_t)NV * 6 * D * 4);
constexpr size_t WS_BONUS = al256(WS_AB + (size_t)T_ALL * 16 * 4);
constexpr size_t WS_PAIRW = al256(WS_BONUS + (size_t)2 * T_LAT * 8 * 4);
constexpr size_t WS_ROWLIST = al256(WS_PAIRW + (size_t)T_LAT * 2 * 4);
constexpr size_t WS_WRT = al256(WS_ROWLIST + (size_t)NEXP * CAP * 4);
constexpr size_t WS_G2T = al256(WS_WRT + (size_t)36 * D * 4);
constexpr size_t WS_WOA = al256(WS_G2T + (size_t)512 * 128 * 2);
constexpr size_t WS_WOB = al256(WS_WOA + (size_t)D * 512 * 2);
constexpr size_t WS_WOUT = al256(WS_WOB + (size_t)D * 512 * 2);
constexpr size_t WS_OA = al256(WS_WOUT + (size_t)D * D * 2);
constexpr size_t WS_OB = al256(WS_OA + (size_t)T_LAT * 512 * 2);
constexpr size_t WS_HALO_A = WS_OA;
constexpr size_t WS_HALO_B = WS_OA + al256((size_t)(T_ALL / 64) * 4 * 1536 * 2);
static_assert(WS_HALO_B + (size_t)(T_ALL / 64) * 2 * 1920 * 2 <= WS_OB + (size_t)T_LAT * 512 * 2, "halo buffers");
constexpr size_t WS_DNT = WS_OA;
constexpr size_t WS_SPARE_END = al256(WS_OB + (size_t)T_LAT * 512 * 2) > al256(WS_DNT + (size_t)NEXP * D * DE * 2) ? al256(WS_OB + (size_t)T_LAT * 512 * 2) : al256(WS_DNT + (size_t)NEXP * D * DE * 2);
constexpr size_t WS_P = WS_SPARE_END;
constexpr size_t WS_PLAT = WS_P;
constexpr size_t WS_PCTX = al256(WS_PLAT + (size_t)T_LAT * IN_COLS * 2);
constexpr size_t WS_P_END = al256(WS_PCTX + (size_t)T_CTX * CTX_COLS * 2);
constexpr size_t WS_H = WS_P;
constexpr size_t WS_T = al256(WS_H + (size_t)T_LAT * D * 4);
constexpr size_t WS_HID = al256(WS_T + (size_t)T_LAT * D * 2);
constexpr size_t WS_OPAIR = al256(WS_HID + (size_t)T_LAT * 2 * DE * 2);
constexpr size_t WS_P2_END = al256(WS_OPAIR + (size_t)T_LAT * 2 * D * 2);
constexpr size_t WS_END = WS_P_END > WS_P2_END ? WS_P_END : WS_P2_END;
constexpr size_t AUX_WINT = 0;
constexpr size_t AUX_U = al256((size_t)NP * D * 2);
constexpr size_t AUX_YDIR = 0;
constexpr size_t AUX_Y = 0;
constexpr size_t AUX_GUT = (size_t)T_LAT * D * 2 > (size_t)2 * T_LAT * 512 * 2 ? (size_t)T_LAT * D * 2 : (size_t)2 * T_LAT * 512 * 2;
constexpr size_t AUX_END1 = AUX_U + (size_t)T_ALL * D * 2;
constexpr size_t AUX_END2 = AUX_YDIR + (size_t)2 * T_LAT * 512 * 2;
static_assert(AUX_YDIR + (size_t)2 * T_LAT * 512 * 2 <= AUX_GUT && AUX_Y + (size_t)T_LAT * D * 2 <= AUX_GUT, "aux overlap");
constexpr size_t AUX_END3 = AUX_GUT + (size_t)NEXP * 512 * D * 2;
constexpr size_t AUX_END = (AUX_END1 > AUX_END2 ? (AUX_END1 > AUX_END3 ? AUX_END1 : AUX_END3) : (AUX_END2 > AUX_END3 ? AUX_END2 : AUX_END3));

struct Params {
    const float* in[35];
    float* out;
    char* ws;
    char* aux;
    int ph_lo, ph_hi;
};
enum { I_X = 0, I_C, I_CTX, I_CCTX, I_ADAW, I_ADAB, I_NMIX, I_NFFN, I_WIN, I_CONV, I_ALOG, I_DTB, I_ONORM, I_MU, I_W0, I_W2, I_A0, I_A2, I_G2, I_KK, I_KA, I_RK, I_LNG, I_LNB, I_WOA, I_WOB, I_WOUT, I_RG, I_RGB, I_RE, I_REB, I_MG, I_MU_UP, I_MD, I_FIN };

DI float bf2f(bf16_t v) { union { unsigned u; float f; } x; x.u = ((unsigned)v) << 16; return x.f; }
#ifdef EMU
DI bf16_t f2bf(float f) { union { float f; unsigned u; } x; x.f = f; unsigned u = x.u; u += 0x7fffu + ((u >> 16) & 1u); return (bf16_t)(u >> 16); }
DI unsigned pk2(float lo, float hi) { return (unsigned)f2bf(lo) | ((unsigned)f2bf(hi) << 16); }
#else
typedef __bf16 hbf16x2 __attribute__((ext_vector_type(2)));
typedef float f32x2_ __attribute__((ext_vector_type(2)));
DI bf16_t f2bf(float f) { return __builtin_bit_cast(unsigned short, (__bf16)f); }
DI unsigned pk2(float lo, float hi) { const f32x2_ v = {lo, hi}; return __builtin_bit_cast(unsigned, __builtin_convertvector(v, hbf16x2)); }
#endif
DI float sigmoidf_(float x) { return 1.0f / (1.0f + expf(-x)); }
DI float siluf_(float x) { return x / (1.0f + expf(-x)); }
DI float softplusf_(float x) { return x > 20.f ? x : log1pf(expf(x)); }
DI float wave_sum(float v) {
#pragma unroll
    for (int o = 1; o < 64; o <<= 1) v += __shfl_xor(v, o);
    return v;
}
#ifdef EMU
#define MFMA16(a, b, c) emu_mfma16((a), (b), (c))
#define WAVE_SYNC() emu::wave_bar()
#else
#define MFMA16(a, b, c) __builtin_amdgcn_mfma_f32_16x16x32_bf16((a), (b), (c), 0, 0, 0)
#define WAVE_SYNC() asm volatile("s_waitcnt lgkmcnt(0)" ::: "memory")
#endif
#ifdef EMU
#define LDS_BARRIER() __syncthreads()
#else
#define LDS_BARRIER() do { asm volatile("s_waitcnt lgkmcnt(0)" ::: "memory"); __builtin_amdgcn_s_barrier(); asm volatile("" ::: "memory"); } while (0)
#endif

typedef float f32x16 __attribute__((ext_vector_type(16)));
typedef float f32x2_ac __attribute__((ext_vector_type(2)));
typedef short bf16x4 __attribute__((ext_vector_type(4)));
#ifdef EMU
#define MFMA32(a, b, c) emu_mfma32((a), (b), (c))
DI float fexp(float x) { return expf(x); }
DI float flog(float x) { return logf(x); }
DI float frcp(float x) { return 1.0f / x; }
DI float frsq(float x) { return 1.0f / sqrtf(x); }
DI float wave_sum_fast(float v) { return wave_sum(v); }
#else
#define MFMA32(a, b, c) __builtin_amdgcn_mfma_f32_32x32x16_bf16((a), (b), (c), 0, 0, 0)
DI float fexp(float x) { return __expf(x); }
DI float flog(float x) { return __logf(x); }
DI float frcp(float x) { return __builtin_amdgcn_rcpf(x); }
DI float frsq(float x) { return __builtin_amdgcn_rsqf(x); }
#define DPP_ADD(v, ctrl) ((v) + __builtin_bit_cast(float, __builtin_amdgcn_update_dpp(0, __builtin_bit_cast(int, (v)), (ctrl), 0xf, 0xf, false)))
DI float wave_sum_fast(float v) {
    v = DPP_ADD(v, 0xB1); v = DPP_ADD(v, 0x4E); v = DPP_ADD(v, 0x141); v = DPP_ADD(v, 0x140);
    const int iv = __builtin_bit_cast(int, v);
    return (__builtin_bit_cast(float, __builtin_amdgcn_readlane(iv, 0)) + __builtin_bit_cast(float, __builtin_amdgcn_readlane(iv, 16))) +
           (__builtin_bit_cast(float, __builtin_amdgcn_readlane(iv, 32)) + __builtin_bit_cast(float, __builtin_amdgcn_readlane(iv, 48)));
}
#endif
DI float fsigmoid(float x) { return frcp(1.0f + fexp(-x)); }
DI float fsilu(float x) { return x * fsigmoid(x); }
DI float fsoftplus(float x) { return fmaxf(x, 0.f) + flog(1.f + fexp(-fabsf(x))); }
DI float ftanh(float x) { return 1.0f - 2.0f * frcp(1.0f + fexp(2.0f * x)); }

constexpr int LDS_ROW = 40;
constexpr int GEMM_A_BYTES = BM * LDS_ROW * 2, GEMM_B_BYTES = 128 * LDS_ROW * 2;
template <int MR, class ARow>
DI void gemm_kloop(f32x4 (&acc)[MR][4], char* smem, ARow arow, const bf16_t* Bt, int ldb, int K) {
    constexpr int BM = 64 * MR;
    const int tid = tid_x(), lane = tid & 63, wave = tid >> 6, wr = wave >> 1, wc = wave & 1, fr = lane & 15, fq = lane >> 4;
    bf16_t* As = (bf16_t*)smem;
    bf16_t* Bs = (bf16_t*)(smem + 2 * GEMM_A_BYTES);
    constexpr int ACH = BM * 4 / NTHREADS;
    static_assert(ACH >= 1, "tile");
    const bf16_t* ap[ACH];
#pragma unroll
    for (int i = 0; i < ACH; ++i) { const int q = tid + i * NTHREADS; ap[i] = arow(q >> 2) + (q & 3) * 8; }
    const bf16_t* bp = Bt + (size_t)(tid >> 2) * ldb + (tid & 3) * 8;
    u32x4 ra[ACH], rb;
#pragma unroll
    for (int i = 0; i < ACH; ++i) ra[i] = *(const u32x4*)(ap[i]);
    rb = *(const u32x4*)(bp);
    const int nk = K / 32;
    for (int kt = 0; kt < nk; ++kt) {
        const int buf = kt & 1;
#pragma unroll
        for (int i = 0; i < ACH; ++i) { const int q = tid + i * NTHREADS; *(u32x4*)(As + (buf * BM + (q >> 2)) * LDS_ROW + (q & 3) * 8) = ra[i]; }
        *(u32x4*)(Bs + (buf * 128 + (tid >> 2)) * LDS_ROW + (tid & 3) * 8) = rb;
        __syncthreads();
        if (kt + 1 < nk) {
#pragma unroll
            for (int i = 0; i < ACH; ++i) ra[i] = *(const u32x4*)(ap[i] + (kt + 1) * 32);
            rb = *(const u32x4*)(bp + (kt + 1) * 32);
        }
        bf16x8 af[MR], bfr[4];
#pragma unroll
        for (int m = 0; m < MR; ++m) af[m] = *(const bf16x8*)(As + (buf * BM + wr * 16 * MR + m * 16 + fr) * LDS_ROW + fq * 8);
#pragma unroll
        for (int n = 0; n < 4; ++n) bfr[n] = *(const bf16x8*)(Bs + (buf * 128 + wc * 64 + n * 16 + fr) * LDS_ROW + fq * 8);
#pragma unroll
        for (int m = 0; m < MR; ++m)
#pragma unroll
            for (int n = 0; n < 4; ++n) acc[m][n] = MFMA16(af[m], bfr[n], acc[m][n]);
    }
    __syncthreads();
}
template <int MR>
DI void acc_zero(f32x4 (&acc)[MR][4]) {
#pragma unroll
    for (int m = 0; m < MR; ++m)
#pragma unroll
        for (int n = 0; n < 4; ++n) acc[m][n] = (f32x4){0.f, 0.f, 0.f, 0.f};
}

namespace g8 {
constexpr int BM = 256, BK = 64, HALF = 128, HT = HALF * BK;
constexpr int LDS_NEED = 8 * HT * 2;
DI int lds_byte(int r, int c) { const int st = (r >> 4) * 2 + (c >> 5), rr = r & 15, cc = c & 31, ob = rr * 64 + cc * 2; return st * 1024 + (ob ^ (((ob >> 9) & 1) << 5)); }
DI void stage_rc(int b, int& R, int& C) { const int st = b / 1024, sb = b % 1024, swz = sb ^ (((sb >> 9) & 1) << 5); R = (st >> 1) * 16 + swz / 64; C = (st & 1) * 32 + (swz % 64) / 2; }
#ifdef EMU
#define G8_GLDS(src, dst) emu_global_load_lds16((src), (dst))
#define G8_WAIT_V(n)
#define G8_WAIT_L(n)
#define G8_BAR __syncthreads()
#define G8_SCHED
#define G8_PRIO(x)
#else
#define G8_GLDS(src, dst) __builtin_amdgcn_global_load_lds((const unsigned*)(src), (__attribute__((address_space(3))) unsigned*)(dst), 16, 0, 0)
#define G8_WAIT_V(n) asm volatile("s_waitcnt vmcnt(" #n ")" ::: "memory")
#define G8_WAIT_L(n) asm volatile("s_waitcnt lgkmcnt(" #n ")" ::: "memory")
#define G8_BAR __builtin_amdgcn_s_barrier()
#define G8_SCHED __builtin_amdgcn_sched_barrier(0)
#define G8_PRIO(x) __builtin_amdgcn_s_setprio(x)
#endif
typedef f32x4 Acc[2][2][4][2];
template <class AOff>
DI void kloop_g(Acc& acc, char* smem, const bf16_t* A, AOff aoff, const bf16_t* Bt, int ldb, int K, int bcol) {
    bf16_t* shm = (bf16_t*)smem;
    const int tid = tid_x(), wid = tid >> 6, lane = tid & 63, wr = wid >> 2, wc = wid & 3, fr = lane & 15, fq = lane >> 4;
    int ao[2][2];
#pragma unroll
    for (int h = 0; h < 2; ++h)
#pragma unroll
        for (int i = 0; i < 2; ++i) { int R, C; stage_rc(tid * 16 + i * 8192, R, C); ao[h][i] = aoff(h * HALF + R) + C; }
#define G8_STAGE_A(P, h, kt) do { for (int _i = 0; _i < 2; ++_i) { const int _b = tid * 16 + _i * 8192; G8_GLDS(A + (size_t)ao[h][_i] + (size_t)(kt) * BK, (char*)(P) + _b); } } while (0)
#define G8_SA(b, h) (shm + ((b) * 2 + (h)) * HT)
#define G8_SB(b, h) (shm + (4 + (b) * 2 + (h)) * HT)
#define G8_STAGE(P, BASE, LD, br, kt) do { const bf16_t* _g = (BASE) + (size_t)(br) * (LD) + (size_t)(kt) * BK; \
    for (int _i = 0; _i < 2; ++_i) { const int _b = tid * 16 + _i * 8192; int _r, _c; stage_rc(_b, _r, _c); G8_GLDS(_g + (size_t)_r * (LD) + _c, (char*)(P) + _b); } } while (0)
#define G8_LDA(dst, b, h) for (int m = 0; m < 4; ++m) for (int k = 0; k < 2; ++k) dst[m][k] = *(const bf16x8*)((const char*)G8_SA(b, h) + lds_byte(wr * 64 + m * 16 + fr, k * 32 + fq * 8))
#define G8_LDB(dst, b, h) for (int n = 0; n < 2; ++n) for (int k = 0; k < 2; ++k) dst[n][k] = *(const bf16x8*)((const char*)G8_SB(b, h) + lds_byte(wc * 32 + n * 16 + fr, k * 32 + fq * 8))
#define G8_MMA(ai, bj, At_, Bt_) do { G8_PRIO(1); for (int m = 0; m < 4; ++m) for (int n = 0; n < 2; ++n) for (int k = 0; k < 2; ++k) \
    acc[ai][bj][m][n] = MFMA16(Bt_[n][k], At_[m][k], acc[ai][bj][m][n]); G8_PRIO(0); } while (0)
    bf16x8 At[4][2], B0[2][2], B1[2][2];
    const int nt = K / BK;
    G8_STAGE(G8_SB(0, 0), Bt, ldb, bcol, 0); G8_STAGE_A(G8_SA(0, 0), 0, 0);
    G8_STAGE(G8_SB(0, 1), Bt, ldb, bcol + HALF, 0); G8_STAGE_A(G8_SA(0, 1), 1, 0);
    if (wr == 1) G8_BAR;
    G8_WAIT_V(4); G8_BAR;
    G8_STAGE(G8_SB(1, 0), Bt, ldb, bcol, 1); G8_STAGE_A(G8_SA(1, 0), 0, 1); G8_STAGE(G8_SB(1, 1), Bt, ldb, bcol + HALF, 1);
    G8_WAIT_V(6); G8_BAR;
    for (int t = 0; t < nt - 2; t += 2) {
        G8_LDB(B0, 0, 0); G8_SCHED; G8_LDA(At, 0, 0); G8_STAGE_A(G8_SA(1, 1), 1, t + 1);
        G8_WAIT_L(8); G8_BAR; G8_WAIT_L(0); G8_MMA(0, 0, At, B0); G8_BAR; G8_SCHED;
        G8_LDB(B1, 0, 1); G8_STAGE(G8_SB(0, 0), Bt, ldb, bcol, t + 2);
        G8_BAR; G8_WAIT_L(0); G8_MMA(0, 1, At, B1); G8_BAR;
        G8_LDA(At, 0, 1); G8_STAGE_A(G8_SA(0, 0), 0, t + 2);
        G8_BAR; G8_WAIT_L(0); G8_MMA(1, 0, At, B0); G8_BAR; G8_SCHED;
        G8_STAGE(G8_SB(0, 1), Bt, ldb, bcol + HALF, t + 2);
        G8_WAIT_V(6); G8_BAR; G8_MMA(1, 1, At, B1); G8_BAR;
        G8_LDB(B0, 1, 0); G8_SCHED; G8_LDA(At, 1, 0); G8_STAGE_A(G8_SA(0, 1), 1, t + 2);
        G8_WAIT_L(8); G8_BAR; G8_WAIT_L(0); G8_MMA(0, 0, At, B0); G8_BAR; G8_SCHED;
        G8_LDB(B1, 1, 1); G8_STAGE(G8_SB(1, 0), Bt, ldb, bcol, t + 3);
        G8_BAR; G8_WAIT_L(0); G8_MMA(0, 1, At, B1); G8_BAR;
        G8_LDA(At, 1, 1); G8_STAGE_A(G8_SA(1, 0), 0, t + 3);
        G8_BAR; G8_WAIT_L(0); G8_MMA(1, 0, At, B0); G8_BAR; G8_SCHED;
        G8_STAGE(G8_SB(1, 1), Bt, ldb, bcol + HALF, t + 3);
        G8_WAIT_V(6); G8_BAR; G8_MMA(1, 1, At, B1); G8_BAR;
    }
    { G8_LDB(B0, 0, 0); G8_LDA(At, 0, 0); G8_STAGE_A(G8_SA(1, 1), 1, nt - 1);
      G8_BAR; G8_WAIT_L(0); G8_MMA(0, 0, At, B0); G8_BAR;
      G8_LDB(B1, 0, 1); G8_BAR; G8_WAIT_L(0); G8_MMA(0, 1, At, B1); G8_BAR;
      G8_LDA(At, 0, 1); G8_WAIT_V(4); G8_BAR; G8_WAIT_L(0); G8_MMA(1, 0, At, B0); G8_MMA(1, 1, At, B1); G8_BAR; }
    { G8_LDB(B0, 1, 0); G8_LDA(At, 1, 0); G8_WAIT_V(2); G8_BAR; G8_WAIT_L(0); G8_MMA(0, 0, At, B0); G8_BAR;
      G8_LDB(B1, 1, 1); G8_WAIT_V(0); G8_BAR; G8_WAIT_L(0); G8_MMA(0, 1, At, B1); G8_BAR;
      G8_LDA(At, 1, 1); G8_BAR; G8_WAIT_L(0); G8_MMA(1, 0, At, B0); G8_MMA(1, 1, At, B1); G8_BAR; }
    if (wr == 0) G8_BAR;
#undef G8_SA
#undef G8_SB
#undef G8_STAGE
#undef G8_STAGE_A
#undef G8_LDA
#undef G8_LDB
#undef G8_MMA
}
DI void kloop(Acc& acc, char* smem, const bf16_t* A, int lda, const bf16_t* Bt, int ldb, int K, int brow, int bcol) {
    kloop_g(acc, smem, A, [&](int r) { return (brow + r) * lda; }, Bt, ldb, K, bcol);
}
DI bool tile_order(int L, int nM, int nN, int& pm, int& pn) {
    constexpr int NXCD = 8, WGM = 8;
    const int nwg = nM * nN; if (L >= nwg) return false;
    int wgid = L; { const int q = nwg / NXCD, r = nwg % NXCD, xcd = wgid % NXCD, off = wgid / NXCD; wgid = (xcd < r ? xcd * (q + 1) : r * (q + 1) + (xcd - r) * q) + off; }
    const int nig = WGM * nN, gid = wgid / nig, fm = gid * WGM, gsz = (nM - fm) < WGM ? (nM - fm) : WGM;
    pm = fm + ((wgid % nig) % gsz); pn = (wgid % nig) / gsz; return true;
}
DI void acc_zero(Acc& acc) {
#pragma unroll
    for (int a = 0; a < 2; ++a)
#pragma unroll
        for (int b = 0; b < 2; ++b)
#pragma unroll
            for (int m = 0; m < 4; ++m)
#pragma unroll
                for (int n = 0; n < 2; ++n) acc[a][b][m][n] = (f32x4){0.f, 0.f, 0.f, 0.f};
}
template <class F> DI void for_each_quad(const Acc& acc, int brow, int bcol, F f) {
    const int tid = tid_x(), wid = tid >> 6, lane = tid & 63, wr = wid >> 2, wc = wid & 3, fr = lane & 15, fq = lane >> 4;
#pragma unroll
    for (int ai = 0; ai < 2; ++ai)
#pragma unroll
        for (int m = 0; m < 4; ++m)
#pragma unroll
            for (int bj = 0; bj < 2; ++bj)
#pragma unroll
                for (int n = 0; n < 2; ++n) f(brow + ai * HALF + wr * 64 + m * 16 + fr, bcol + bj * HALF + wc * 32 + n * 16 + fq * 4, acc[ai][bj][m][n]);
}
}

constexpr bool USE_G8 = ((NB * CTXL) % 256 == 0) && ((NB * S) % 256 == 0) && (NP % 256 == 0) && (D % 256 == 0) && (D >= 256);
DI int gu_row(int c, int up) {
    if (USE_G8) return (c >> 7) * 256 + ((c >> 6) & 1) * 128 + ((c >> 4) & 3) * 32 + (up ? 16 : 0) + (c & 15);
    return (c >> 6) * 128 + ((c >> 5) & 1) * 64 + ((c >> 4) & 1) * 16 + (c & 15) + (up ? 32 : 0);
}
DI void transpose_item(const float* W, int N, int Nvalid, int k0, int n0, bf16_t* WT, int ldt, int mode, float* scr, int lane) {
    float tv[32];
#pragma unroll
    for (int i = 0; i < 32; ++i) {
        const int kk = 2 * i + (lane >> 5), n = n0 + (lane & 31);
        tv[i] = (n < Nvalid) ? W[(size_t)(k0 + kk) * N + n] : 0.f;
    }
#pragma unroll
    for (int i = 0; i < 32; ++i) scr[(2 * i + (lane >> 5)) * 33 + (lane & 31)] = tv[i];
    WAVE_SYNC();
    const int c = lane & 7;
#pragma unroll
    for (int j = 0; j < 4; ++j) {
        const int nl = (lane >> 3) + 8 * j; const float* s = scr + (8 * c) * 33 + nl;
        u32x4 o; o.x = pk2(s[0], s[33]); o.y = pk2(s[2 * 33], s[3 * 33]); o.z = pk2(s[4 * 33], s[5 * 33]); o.w = pk2(s[6 * 33], s[7 * 33]);
        const int n = n0 + nl; const int row = mode == 0 ? n : gu_row(n, mode == 2);
        *(u32x4*)(WT + (size_t)row * ldt + k0 + 8 * c) = o;
    }
    WAVE_SYNC();
}
DI void transpose_matrix(const float* W, int K, int N, int Npad, bf16_t* WT, int mode, char* smem, int gw, int ngw, int& base) {
    const int lane = tid_x() & 63, wave = tid_x() >> 6;
    float* scr = (float*)smem + wave * (64 * 33);
    const int nkb = K / 64, nnb = Npad / 32, nitems = nkb * nnb;
    int first = ((gw - base) % ngw + ngw) % ngw;
    for (int it = first; it < nitems; it += ngw) {
        const int kb = it / nnb, nb = it % nnb;
        transpose_item(W, N, N, kb * 64, nb * 32, WT, K, mode, scr, lane);
    }
    base = (base + nitems) % ngw;
}

DI void phase0(const Params& p, char* smem) {
    const int tid = tid_x(), lane = tid & 63, wave = tid >> 6;
    if (blockIdx.x == 0 && tid < NEXP) ((int*)(p.ws + WS_CNT))[tid * CNT_STRIDE] = 0;
    if (blockIdx.x == 0 && tid == 0) *(unsigned*)(p.ws + WS_BAR) = 0u;
    float* sil = (float*)smem;
    float* red = sil + NV * D;
    const int nitems = 6 * D / 32;
    bool did = false;
    for (int it = blockIdx.x; it < nitems; it += gridDim.x) {
        if (!did) {
            for (int i = tid; i < NV * D; i += NTHREADS) { const int v = i / D, k = i % D; const float cv = v < NB ? p.in[I_C][v * D + k] : p.in[I_CCTX][k]; sil[i] = siluf_(cv); }
            did = true;
        }
        __syncthreads();
        const int col = it * 32 + (lane & 31), rp = lane >> 5;
        float acc[NV];
#pragma unroll
        for (int v = 0; v < NV; ++v) acc[v] = 0.f;
        const int r0 = wave * (D / 8);
        float wv[D / 16];
#pragma unroll
        for (int i = 0; i < D / 16; ++i) wv[i] = p.in[I_ADAW][(size_t)(r0 + 2 * i + rp) * (6 * D) + col];
#pragma unroll
        for (int i = 0; i < D / 16; ++i) {
            const int row = r0 + 2 * i + rp;
#pragma unroll
            for (int v = 0; v < NV; ++v) acc[v] += sil[v * D + row] * wv[i];
        }
#pragma unroll
        for (int v = 0; v < NV; ++v) red[((wave * 2 + rp) * NV + v) * 32 + (lane & 31)] = acc[v];
        __syncthreads();
        if (tid < NV * 32) {
            const int v = tid / 32, cl = tid % 32; float s = p.in[I_ADAB][it * 32 + cl];
            for (int g = 0; g < 16; ++g) s += red[(g * NV + v) * 32 + cl];
            ((float*)(p.ws + WS_MOD))[(size_t)v * 6 * D + it * 32 + cl] = s;
        }
    }
    __syncthreads();
    const int gw = blockIdx.x * 8 + wave, ngw = gridDim.x * 8; int base = 0;
    {
        float* scr = (float*)smem + wave * (64 * 33);
        const int nkb = D / 64, nnb = NP / 32, nitems2 = nkb * nnb;
        for (int it = gw; it < nitems2; it += ngw) { const int kb = it / nnb, nb = it % nnb; transpose_item(p.in[I_WIN], IN_COLS, IN_COLS, kb * 64, nb * 32, (bf16_t*)(p.aux + AUX_WINT), D, 0, scr, lane); }
        base = nitems2 % ngw;
    }
    { float* WRT = (float*)(p.ws + WS_WRT);
      for (int i = blockIdx.x * NTHREADS + tid; i < 36 * D; i += gridDim.x * NTHREADS) { const int j = i / D, k = i % D; WRT[i] = j < 4 ? p.in[I_RG][(size_t)k * 4 + j] : p.in[I_RE][(size_t)k * 32 + (j - 4)]; } }
    transpose_matrix(p.in[I_WOA], 512, D, D, (bf16_t*)(p.ws + WS_WOA), 0, smem, gw, ngw, base);
    transpose_matrix(p.in[I_WOB], 512, D, D, (bf16_t*)(p.ws + WS_WOB), 0, smem, gw, ngw, base);
    transpose_matrix(p.in[I_WOUT], D, D, D, (bf16_t*)(p.ws + WS_WOUT), 0, smem, gw, ngw, base);
    transpose_matrix(p.in[I_G2], 128, 512, 512, (bf16_t*)(p.ws + WS_G2T), 0, smem, gw, ngw, base);
}

constexpr int NSEG = T_ALL / 64, NSEG_CTX = T_CTX / 64;
DI void halo_store(const Params& p, int row, int col, const u32x2& o) {
    int seq, b, j;
    if (row < T_CTX) { seq = 0; b = row / CTXL; j = row % CTXL; } else { seq = 1; const int rr = row - T_CTX; b = rr / S; j = rr % S; }
    const int L = seq ? S : CTXL; const int segbase = seq ? NSEG_CTX + b * (S / 64) : b * (CTXL / 64);
    if (col < 1536) {
        const int jm = j & 63;
        if (jm >= 62 && j + 2 < L) { const int g = segbase + (j >> 6) + 1; *(u32x2*)((bf16_t*)(p.ws + WS_HALO_A) + ((size_t)g * 4 + (jm - 62)) * 1536 + col) = o; }
        if (jm < 2 && j >= 64) { const int g = segbase + (j >> 6) - 1; *(u32x2*)((bf16_t*)(p.ws + WS_HALO_A) + ((size_t)g * 4 + 2 + jm) * 1536 + col) = o; }
    } else if (col >= COL_B0 && col < COL_B0 + 1920) {
        const int js = seq ? (j % GW) * ROWS + j / GW : j; const int jm = js & 63;
        if (jm == 63 && js + 1 < L) { const int g = segbase + (js >> 6) + 1; *(u32x2*)((bf16_t*)(p.ws + WS_HALO_B) + ((size_t)g * 2 + 0) * 1920 + (col - COL_B0)) = o; }
        if (jm == 0 && js >= 64) { const int g = segbase + (js >> 6) - 1; *(u32x2*)((bf16_t*)(p.ws + WS_HALO_B) + ((size_t)g * 2 + 1) * 1920 + (col - COL_B0)) = o; }
    }
}
DI void halo_zero_fill(const Params& p) {
    const int tid = tid_x(), lane = tid & 63, wave = tid >> 6; const int gw = blockIdx.x * 8 + wave, ngw = gridDim.x * 8;
    bf16_t* HA = (bf16_t*)(p.ws + WS_HALO_A); bf16_t* HB = (bf16_t*)(p.ws + WS_HALO_B);
    for (int it = gw; it < NSEG * 2; it += ngw) {
        const int g = it >> 1, side = it & 1;
        const bool ctx = g < NSEG_CTX; const int sg = ctx ? g % (CTXL / 64) : (g - NSEG_CTX) % (S / 64); const int nsg = ctx ? CTXL / 64 : S / 64;
        const bool edge = side ? (sg == nsg - 1) : (sg == 0);
        if (!edge) continue;
        for (int c = lane; c < 384; c += 64) *(u32x4*)(HA + ((size_t)g * 4 + 2 * side) * 1536 + c * 8) = (u32x4){0u, 0u, 0u, 0u};
        for (int c = lane; c < 240; c += 64) *(u32x4*)(HB + ((size_t)g * 2 + side) * 1920 + c * 8) = (u32x4){0u, 0u, 0u, 0u};
    }
}
DI void phase1(const Params& p, char* smem) {
    if (USE_G8) halo_zero_fill(p);
    const int lane = tid_x() & 63, wave = tid_x() >> 6;
    const int gw = blockIdx.x * 8 + wave, ngw = gridDim.x * 8;
    const float* mod = (const float*)(p.ws + WS_MOD);
    bf16_t* U = (bf16_t*)(p.aux + AUX_U);
    auto rowsrc = [&](int r) -> const float* { return r < T_CTX ? p.in[I_CTX] + (size_t)r * D : p.in[I_X] + (size_t)(r - T_CTX) * D; };
    f32x4 xn[D / 256];
    if (gw < T_ALL) {
#pragma unroll
        for (int j = 0; j < D / 256; ++j) xn[j] = *(const f32x4*)(rowsrc(gw) + j * 256 + lane * 4);
    }
    for (int r = gw; r < T_ALL; r += ngw) {
        const int v = r < T_CTX ? NB : (r - T_CTX) / S;
        f32x4 x[D / 256]; float ss = 0.f;
#pragma unroll
        for (int j = 0; j < D / 256; ++j) { x[j] = xn[j]; ss += x[j].x * x[j].x + x[j].y * x[j].y + x[j].z * x[j].z + x[j].w * x[j].w; }
        if (r + ngw < T_ALL) {
#pragma unroll
            for (int j = 0; j < D / 256; ++j) xn[j] = *(const f32x4*)(rowsrc(r + ngw) + j * 256 + lane * 4);
        }
        ss = wave_sum_fast(ss);
        const float rstd = frsq(ss * (1.0f / D) + 1e-6f);
#pragma unroll
        for (int j = 0; j < D / 256; ++j) {
            const int k = j * 256 + lane * 4;
            const f32x4 g = *(const f32x4*)(p.in[I_NMIX] + k), sh = *(const f32x4*)(mod + (size_t)v * 6 * D + k), sc = *(const f32x4*)(mod + (size_t)v * 6 * D + D + k);
            float o0 = x[j].x * rstd * g.x * (1.f + sc.x) + sh.x, o1 = x[j].y * rstd * g.y * (1.f + sc.y) + sh.y;
            float o2 = x[j].z * rstd * g.z * (1.f + sc.z) + sh.z, o3 = x[j].w * rstd * g.w * (1.f + sc.w) + sh.w;
            u32x2 o; o.x = pk2(o0, o1); o.y = pk2(o2, o3);
            *(u32x2*)(U + (size_t)r * D + k) = o;
        }
    }
}

DI void phase2(const Params& p, char* smem) {
    const bf16_t* U = (const bf16_t*)(p.aux + AUX_U); const bf16_t* WT = (const bf16_t*)(p.aux + AUX_WINT);
    bf16_t* PL = (bf16_t*)(p.ws + WS_PLAT); bf16_t* PC = (bf16_t*)(p.ws + WS_PCTX); float* AB = (float*)(p.ws + WS_AB);
    if (USE_G8) {
        constexpr int NT = NP / 256, MT = T_ALL / 256, NT_CTX = (CTX_COLS + 255) / 256;
        for (int t = blockIdx.x; t < MT * NT; t += gridDim.x) {
            int mt, nt; if (!g8::tile_order(t, MT, NT, mt, nt)) break;
            const int brow = mt * 256, bcol = nt * 256; const bool isctx = brow < T_CTX;
            if (isctx && nt >= NT_CTX) continue;
            g8::Acc acc; g8::acc_zero(acc);
            g8::kloop(acc, smem, U, D, WT, D, D, brow, bcol);
            constexpr int OLD_ = 264; bf16_t* OT = (bf16_t*)smem;
            g8::for_each_quad(acc, brow, bcol, [&](int row, int col, const f32x4& v) {
                u32x2 o; o.x = pk2(v.x, v.y); o.y = pk2(v.z, v.w);
                *(u32x2*)(OT + (row - brow) * OLD_ + (col - bcol)) = o;
                if (col >= 2048 && col < 2064) *(f32x4*)(AB + (size_t)row * 16 + (col - 2048)) = v;
                halo_store(p, row, col, o);
            });
            __syncthreads();
            {
                const int tid = tid_x(); const int ncols = isctx ? CTX_COLS : IN_COLS;
                bf16_t* dst = isctx ? PC + (size_t)brow * CTX_COLS : PL + (size_t)(brow - T_CTX) * IN_COLS;
#pragma unroll
                for (int i = 0; i < 16; ++i) {
                    const int ch = tid + i * NTHREADS, row = ch >> 5, c8 = (ch & 31) * 8, col = bcol + c8;
                    if (col < ncols) *(u32x4*)(dst + (size_t)row * ncols + col) = *(const u32x4*)(OT + row * OLD_ + c8);
                }
            }
            __syncthreads();
        }
        return;
    }
    const int tid = tid_x(), lane = tid & 63, wave = tid >> 6, wr = wave >> 1, wc = wave & 1, fr = lane & 15, fq = lane >> 4;
    constexpr int NT = NP / 128, MT = T_ALL / BM, NT_CTX = (CTX_COLS + 127) / 128;
    for (int t = blockIdx.x; t < MT * NT; t += gridDim.x) {
        const int mt = t / NT, nt = t % NT; const int row0 = mt * BM; const bool isctx = row0 < T_CTX;
        if (isctx && nt >= NT_CTX) continue;
        f32x4 acc[MREP][4]; acc_zero(acc);
        gemm_kloop(acc, smem, [&](int i) { return U + (size_t)(row0 + i) * D; }, WT + (size_t)nt * 128 * D, D, D);
#pragma unroll
        for (int m = 0; m < MREP; ++m)
#pragma unroll
            for (int n = 0; n < 4; ++n)
#pragma unroll
                for (int j = 0; j < 4; ++j) {
                    const int row = row0 + wr * 16 * MREP + m * 16 + fq * 4 + j, col = nt * 128 + wc * 64 + n * 16 + fr; const float v = acc[m][n][j];
                    if (isctx) { if (col < CTX_COLS) PC[(size_t)row * CTX_COLS + col] = f2bf(v); }
                    else { if (col < IN_COLS) PL[(size_t)(row - T_CTX) * IN_COLS + col] = f2bf(v); }
                    if (col >= 2048 && col < 2064) AB[(size_t)row * 16 + (col - 2048)] = v;
                }
    }
}


DI int crow(int g, int h) { return (g & 3) + 8 * (g >> 2) + 4 * h; }
template <int S_> DI bf16x8 pack_acc(const f32x16& x) {
    u32x4 r;
    r.x = pk2(x[8 * S_ + 0], x[8 * S_ + 1]); r.y = pk2(x[8 * S_ + 2], x[8 * S_ + 3]); r.z = pk2(x[8 * S_ + 4], x[8 * S_ + 5]); r.w = pk2(x[8 * S_ + 6], x[8 * S_ + 7]);
    return __builtin_bit_cast(bf16x8, r);
}
DI bf16x8 ld_nat(const bf16_t* row, int s, int h) { return *(const bf16x8*)(row + 16 * s + 8 * h); }
DI bf16x8 ld_perm(const bf16_t* row, int s, int h) {
    const bf16x4 lo = *(const bf16x4*)(row + 16 * s + 4 * h), hi = *(const bf16x4*)(row + 16 * s + 8 + 4 * h);
    return __builtin_shufflevector(lo, hi, 0, 1, 2, 3, 4, 5, 6, 7);
}
DI f32x16 zero16() { f32x16 z;
#pragma unroll
    for (int i = 0; i < 16; ++i) z[i] = 0.f;
    return z; }
#define TGET(i) ((i) < 16 ? t0[(i) & 15] : t1[(i) & 15])
DI void invert32_col(const float* Lf, f32x16& t0, f32x16& t1, int c) {
#pragma unroll
    for (int i = 0; i < 32; ++i) {
        float s0 = 0.f, s1 = 0.f, s2 = 0.f, s3 = 0.f;
#pragma unroll
        for (int j4 = 0; j4 < (i + 3) / 4; ++j4) {
            const f32x4 l = *(const f32x4*)(Lf + i * 32 + 4 * j4);
            if (4 * j4 + 0 < i) s0 += l.x * TGET(4 * j4 + 0);
            if (4 * j4 + 1 < i) s1 += l.y * TGET(4 * j4 + 1);
            if (4 * j4 + 2 < i) s2 += l.z * TGET(4 * j4 + 2);
            if (4 * j4 + 3 < i) s3 += l.w * TGET(4 * j4 + 3);
        }
        float sm = -((s0 + s1) + (s2 + s3));
#ifndef EMU
        asm volatile("" : "+v"(sm));
#endif
        const float v = (i > c) ? sm : (i == c ? 1.f : 0.f);
        if (i < 16) t0[i & 15] = v; else t1[i & 15] = v;
    }
}

DI void seg_info(int g, int& seq, int& b, int& j0) {
    if (g < NSEG_CTX) { seq = 0; b = g / (CTXL / 64); j0 = (g % (CTXL / 64)) * 64; } else { const int g2 = g - NSEG_CTX; seq = 1; b = g2 / (S / 64); j0 = (g2 % (S / 64)) * 64; }
}
DI const bf16_t* seq_row(const Params& p, int seq, int b, int j, bool scan_order) {
    if (seq) { const int l = scan_order ? (j % ROWS) * GW + j / ROWS : j; return (const bf16_t*)(p.ws + WS_PLAT) + (size_t)(b * S + l) * IN_COLS; }
    return (const bf16_t*)(p.ws + WS_PCTX) + (size_t)(b * CTXL + j) * CTX_COLS;
}
DI void phase_halo(const Params& p, char* smem) {
    if (USE_G8) return;
    const int tid = tid_x(), lane = tid & 63, wave = tid >> 6;
    const int gw = blockIdx.x * 8 + wave, ngw = gridDim.x * 8;
    bf16_t* HA = (bf16_t*)(p.ws + WS_HALO_A); bf16_t* HB = (bf16_t*)(p.ws + WS_HALO_B);
    for (int it = gw; it < NSEG * 6; it += ngw) {
        const int g = it / 6, hr = it % 6; int seq, b, j0; seg_info(g, seq, b, j0);
        const int L = seq ? S : CTXL;
        if (hr < 4) {
            const int j = hr < 2 ? j0 - 2 + hr : j0 + 62 + hr; const bool ok = j >= 0 && j < L;
            const bf16_t* src = seq_row(p, seq, b, ok ? j : 0, false);
            for (int c = lane; c < 192; c += 64) { u32x4 v = {0u, 0u, 0u, 0u}; if (ok) v = *(const u32x4*)(src + c * 8); *(u32x4*)(HA + ((size_t)g * 4 + hr) * 1536 + c * 8) = v; }
        } else {
            const int j = hr == 4 ? j0 - 1 : j0 + 64; const bool ok = j >= 0 && j < L;
            const bf16_t* src = seq_row(p, seq, b, ok ? j : 0, true) + COL_B0;
            for (int c = lane; c < 240; c += 64) { u32x4 v = {0u, 0u, 0u, 0u}; if (ok) v = *(const u32x4*)(src + c * 8); *(u32x4*)(HB + ((size_t)g * 2 + (hr - 4)) * 1920 + c * 8) = v; }
        }
    }
}
DI f32x2_ac unpk2(unsigned w) { return (f32x2_ac){bf2f((bf16_t)(w & 0xffffu)), bf2f((bf16_t)(w >> 16))}; }
DI void unpack8(const u32x4& q, float (&f)[8]) {
    f[0] = bf2f((bf16_t)(q.x & 0xffffu)); f[1] = bf2f((bf16_t)(q.x >> 16)); f[2] = bf2f((bf16_t)(q.y & 0xffffu)); f[3] = bf2f((bf16_t)(q.y >> 16));
    f[4] = bf2f((bf16_t)(q.z & 0xffffu)); f[5] = bf2f((bf16_t)(q.z >> 16)); f[6] = bf2f((bf16_t)(q.w & 0xffffu)); f[7] = bf2f((bf16_t)(q.w >> 16));
}
DI float row16_sum(float v) {
#ifdef EMU
    v += __shfl_xor(v, 1); v += __shfl_xor(v, 2); v += __shfl_xor(v, 4); v += __shfl_xor(v, 8); return v;
#else
    v = DPP_ADD(v, 0xB1); v = DPP_ADD(v, 0x4E); v = DPP_ADD(v, 0x141); v = DPP_ADD(v, 0x140); return v;
#endif
}
DI void phase_fir(const Params& p, char* smem) {
    const int tid = tid_x(), lane = tid & 63, wave = tid >> 6;
    const int gw = blockIdx.x * 8 + wave, ngw = gridDim.x * 8;
    const bf16_t* HA = (const bf16_t*)(p.ws + WS_HALO_A); const bf16_t* HB = (const bf16_t*)(p.ws + WS_HALO_B);
    constexpr int NA = NSEG * 3, NBI = NSEG * 4;
    const u32x4 z4 = {0u, 0u, 0u, 0u};
    for (int it = gw; it < NA + NBI; it += ngw) {
        if (it < NA) {
            const int g = it / 3, s = it % 3; int seq, b, j0; seg_info(g, seq, b, j0);
            const int col = s * 512 + 8 * lane, ldp = seq ? IN_COLS : CTX_COLS;
            bf16_t* base = (bf16_t*)seq_row(p, seq, b, j0, false) + col;
            const bf16_t* hal = HA + (size_t)g * 4 * 1536 + col;
            float cw[5][8];
#pragma unroll
            for (int t = 0; t < 5; ++t) { const f32x4 w0 = *(const f32x4*)(p.in[I_CONV] + t * 1536 + col), w1 = *(const f32x4*)(p.in[I_CONV] + t * 1536 + col + 4);
                cw[t][0] = w0.x; cw[t][1] = w0.y; cw[t][2] = w0.z; cw[t][3] = w0.w; cw[t][4] = w1.x; cw[t][5] = w1.y; cw[t][6] = w1.z; cw[t][7] = w1.w; }
            u32x4 win[12], nxt[8];
            win[0] = *(const u32x4*)(hal); win[1] = *(const u32x4*)(hal + 1536);
            win[2] = *(const u32x4*)(base); win[3] = *(const u32x4*)(base + ldp);
#pragma unroll
            for (int i = 0; i < 8; ++i) win[4 + i] = *(const u32x4*)(base + (size_t)(2 + i) * ldp);
#pragma unroll 1
            for (int blk = 0; blk < 8; ++blk) {
                if (blk < 7) {
#pragma unroll
                    for (int i = 0; i < 8; ++i) { const int t = 8 * blk + 10 + i; nxt[i] = t < 64 ? *(const u32x4*)(base + (size_t)t * ldp) : *(const u32x4*)(hal + (size_t)(2 + (t - 64)) * 1536); }
                }
#pragma unroll
                for (int i = 0; i < 8; ++i) {
                    float a[8];
#pragma unroll
                    for (int e = 0; e < 8; ++e) a[e] = 0.f;
#pragma unroll
                    for (int t = 0; t < 5; ++t) { float x[8]; unpack8(win[i + t], x);
#pragma unroll
                        for (int e = 0; e < 8; ++e) a[e] += x[e] * cw[t][e]; }
                    float ss = 0.f;
#pragma unroll
                    for (int e = 0; e < 8; ++e) { a[e] = fsilu(a[e]); ss += a[e] * a[e]; }
                    if (s < 2) { const float sc = frsq(row16_sum(ss) + 1e-6f) * (s == 0 ? 0.08838834764831845f : 1.0f);
#pragma unroll
                        for (int e = 0; e < 8; ++e) a[e] *= sc; }
                    u32x4 o; o.x = pk2(a[0], a[1]); o.y = pk2(a[2], a[3]); o.z = pk2(a[4], a[5]); o.w = pk2(a[6], a[7]);
                    *(u32x4*)(base + (size_t)(8 * blk + i) * ldp) = o;
                }
#pragma unroll
                for (int i = 0; i < 4; ++i) win[i] = win[8 + i];
#pragma unroll
                for (int i = 0; i < 8; ++i) win[4 + i] = nxt[i];
            }
        } else {
            const int it2 = it - NA, g = it2 / 4, sl = it2 % 4; int seq, b, j0; seg_info(g, seq, b, j0);
            const int bcol = sl * 512 + 8 * lane; const bool act = bcol < 1920;
            const int bc = act ? bcol : 0, col = COL_B0 + bc;
            float mu8[8];
            { const f32x4 m0 = *(const f32x4*)(p.in[I_MU] + bc), m1 = *(const f32x4*)(p.in[I_MU] + bc + 4); mu8[0] = m0.x; mu8[1] = m0.y; mu8[2] = m0.z; mu8[3] = m0.w; mu8[4] = m1.x; mu8[5] = m1.y; mu8[6] = m1.z; mu8[7] = m1.w; }
            const bool th = (bc >= 1536 && bc < 1664);
            const bf16_t* hal = HB + (size_t)g * 2 * 1920 + bc;
            u32x4 win[10], nxt[8];
            win[0] = *(const u32x4*)(hal); win[1] = *(const u32x4*)(seq_row(p, seq, b, j0, true) + col);
#pragma unroll
            for (int i = 0; i < 8; ++i) win[2 + i] = *(const u32x4*)(seq_row(p, seq, b, j0 + 1 + i, true) + col);
#pragma unroll 1
            for (int blk = 0; blk < 8; ++blk) {
                if (blk < 7) {
#pragma unroll
                    for (int i = 0; i < 8; ++i) { const int t = 8 * blk + 9 + i; nxt[i] = t < 64 ? *(const u32x4*)(seq_row(p, seq, b, j0 + t, true) + col) : *(const u32x4*)(hal + 1920); }
                }
#pragma unroll
                for (int i = 0; i < 8; ++i) {
                    float pv[8], cu[8], nx[8], x[8]; unpack8(win[i], pv); unpack8(win[i + 1], cu); unpack8(win[i + 2], nx);
#pragma unroll
                    for (int e = 0; e < 8; ++e) { x[e] = cu[e] + (0.5f * (pv[e] + nx[e]) - cu[e]) * mu8[e]; if (th) x[e] = ftanh(x[e]); }
                    u32x4 o; o.x = pk2(x[0], x[1]); o.y = pk2(x[2], x[3]); o.z = pk2(x[4], x[5]); o.w = pk2(x[6], x[7]);
                    if (act) *(u32x4*)((bf16_t*)seq_row(p, seq, b, j0 + 8 * blk + i, true) + col) = o;
                }
                win[0] = win[8]; win[1] = win[9];
#pragma unroll
                for (int i = 0; i < 8; ++i) win[2 + i] = nxt[i];
            }
        }
    }
}

constexpr int GC = 32;
constexpr int G_NT = (CTXL + S) / GC;
constexpr int LD128 = 136, LD64 = 72, LD32 = 40;
DI void chunk_pos(int x, int d, int& seg, int& j0) {
    constexpr int n0 = CTXL / GC, n1 = S / GC;
    if (x < n0) { seg = 0; j0 = (d ? n0 - 1 - x : x) * GC; } else { seg = 1; const int xx = x - n0; j0 = (d ? n1 - 1 - xx : xx) * GC; }
}

template <class Emit>
DI void invert32_blocked(const float* Lf, bf16_t* scr, int lane, Emit emit) {
    bf16_t* T00T = scr; bf16_t* T11R = scr + 16 * LD32; bf16_t* L10R = scr + 2 * 16 * LD32; bf16_t* P1T = scr + 3 * 16 * LD32;
    const int blk = lane >> 5, c = lane & 15, r = lane & 31, fr = lane & 15, fq = lane >> 4;
    f32x16 t;
    const float* Lb = Lf + (16 * blk) * 32 + 16 * blk;
#pragma unroll
    for (int i = 0; i < 16; ++i) {
        float s0 = 0.f, s1 = 0.f, s2 = 0.f, s3 = 0.f;
#pragma unroll
        for (int j4 = 0; j4 < (i + 3) / 4; ++j4) {
            const f32x4 l = *(const f32x4*)(Lb + i * 32 + 4 * j4);
            if (4 * j4 + 0 < i) s0 += l.x * t[4 * j4 + 0];
            if (4 * j4 + 1 < i) s1 += l.y * t[4 * j4 + 1];
            if (4 * j4 + 2 < i) s2 += l.z * t[4 * j4 + 2];
            if (4 * j4 + 3 < i) s3 += l.w * t[4 * j4 + 3];
        }
        float sm = -((s0 + s1) + (s2 + s3));
#ifndef EMU
        asm volatile("" : "+v"(sm));
#endif
        t[i] = (i > c) ? sm : (i == c ? 1.f : 0.f);
    }
    if (r < 16) {
        if (blk == 0) {
#pragma unroll
            for (int q = 0; q < 4; ++q) { u32x2 o; o.x = pk2(t[4 * q], t[4 * q + 1]); o.y = pk2(t[4 * q + 2], t[4 * q + 3]); *(u32x2*)(T00T + c * LD32 + 4 * q) = o; }
        } else {
#pragma unroll
            for (int i = 0; i < 16; ++i) T11R[i * LD32 + c] = f2bf(t[i]);
        }
    }
    { const int i = lane >> 2, j4 = (lane & 3) * 4; const f32x4 l = *(const f32x4*)(Lf + (16 + i) * 32 + j4);
      u32x2 o; o.x = pk2(l.x, l.y); o.y = pk2(l.z, l.w); *(u32x2*)(L10R + i * LD32 + j4) = o; }
    WAVE_SYNC();
    const bf16x8 zf = {0, 0, 0, 0, 0, 0, 0, 0};
    f32x4 p1 = {0.f, 0.f, 0.f, 0.f};
    {
        const bf16x8 af = fq < 2 ? *(const bf16x8*)(L10R + fr * LD32 + 8 * fq) : zf, bfm = fq < 2 ? *(const bf16x8*)(T00T + fr * LD32 + 8 * fq) : zf;
        p1 = MFMA16(af, bfm, p1);
    }
    { u32x2 o; o.x = pk2(p1[0], p1[1]); o.y = pk2(p1[2], p1[3]); *(u32x2*)(P1T + fr * LD32 + 4 * fq) = o; }
    WAVE_SYNC();
    f32x4 p2 = {0.f, 0.f, 0.f, 0.f};
    {
        const bf16x8 af = fq < 2 ? *(const bf16x8*)(T11R + fr * LD32 + 8 * fq) : zf, bfm = fq < 2 ? *(const bf16x8*)(P1T + fr * LD32 + 8 * fq) : zf;
        p2 = MFMA16(af, bfm, p2);
    }
#pragma unroll
    for (int j = 0; j < 4; ++j) emit(16 + 4 * fq + j, fr, -p2[j]);
    if (r < 16) {
#pragma unroll
        for (int i = 0; i < 16; ++i) { emit(16 * blk + i, 16 * blk + c, t[i]); if (blk == 0) emit(i, 16 + c, 0.f); }
    }
}
constexpr int GL_Q = 0;
constexpr int GL_KT = GL_Q + 2 * 32 * LD128 * 2;
constexpr int GL_VT = GL_KT + 2 * 128 * LD32 * 2;
constexpr int GL_K = GL_VT + 2 * 128 * LD32 * 2;
constexpr int GL_QKM = GL_K + 32 * LD128 * 2;
constexpr int GL_LF = GL_QKM + 2 * 32 * LD32 * 2;
constexpr int GL_TP = GL_LF + 32 * 32 * 4;
constexpr int GL_TPP = GL_TP + 32 * LD32 * 2;
constexpr int GL_WN = GL_TPP + 2 * 32 * LD32 * 2;
constexpr int GL_SC = GL_WN + 32 * LD128 * 2;
constexpr int GL_GC = GL_SC + 2 * 8 * 32 * 4;
constexpr int GL_CW = GL_GC + 8 * 32 * 4;
constexpr int GL_INV = GL_CW + 5 * 3 * 128 * 4;
constexpr int GL_RAW = GL_INV + 4 * 32 * LD32 * 2;
constexpr int GL_END = GL_RAW + 32 * 384 * 2;
static_assert(GL_END <= LDS_BYTES, "gdn lds");

DI void gdn_chain2(const Params& p, char* smem, int item) {
    const int d = item / (NB * H_A), b = (item / H_A) % NB, h = item % H_A;
    const int tid = tid_x(), lane = tid & 63, wave0_ = tid >> 6;
    bf16_t* Qs = (bf16_t*)(smem + GL_Q); bf16_t* KTs = (bf16_t*)(smem + GL_KT); bf16_t* VTs = (bf16_t*)(smem + GL_VT); bf16_t* Ks = (bf16_t*)(smem + GL_K);
    bf16_t* QKMs = (bf16_t*)(smem + GL_QKM); float* Lf = (float*)(smem + GL_LF); bf16_t* Tp = (bf16_t*)(smem + GL_TP); bf16_t* Tpp = (bf16_t*)(smem + GL_TPP);
    bf16_t* Wn = (bf16_t*)(smem + GL_WN); float* SC = (float*)(smem + GL_SC); float* GCs = (float*)(smem + GL_GC); float* CW = (float*)(smem + GL_CW);
    const float alog = p.in[I_ALOG][d * 4 + h], dtb = p.in[I_DTB][d * 4 + h], negea = -expf(alog);
    bf16_t* ODIR = (bf16_t*)(p.ws + WS_OA);
    __syncthreads();
    f32x16 St[4];
#pragma unroll
    for (int ct = 0; ct < 4; ++ct) St[ct] = zero16();
    bf16_t* RAW = (bf16_t*)(smem + GL_RAW);
    float pa = 0.f, pbt = 0.f;
    auto prefetch = [&](int x, int wsel, int nw) {
        int seg, j0; chunk_pos(x, d, seg, j0);
        const int ldp = seg ? IN_COLS : CTX_COLS;
        const bf16_t* pbase = seg ? (const bf16_t*)(p.ws + WS_PLAT) + (size_t)b * S * IN_COLS : (const bf16_t*)(p.ws + WS_PCTX) + (size_t)b * CTXL * CTX_COLS;
        for (int inst = wsel; inst < 24; inst += nw) {
            const int q = inst * 64 + lane, row = q / 48, c16 = q % 48;
            const bf16_t* src = pbase + (size_t)(j0 + row) * ldp + (c16 >> 4) * 512 + h * 128 + (c16 & 15) * 8;
#ifdef EMU
            emu_global_load_lds16(src, (char*)RAW + q * 16);
#else
            __builtin_amdgcn_global_load_lds((const unsigned*)src, (__attribute__((address_space(3))) unsigned*)((char*)RAW + q * 16), 16, 0, 0);
#endif
        }
    };
    auto prefetch_ab = [&](int x) {
        int seg, j0; chunk_pos(x, d, seg, j0);
        const float* abbase = (const float*)(p.ws + WS_AB) + (size_t)(seg ? T_CTX + b * S : b * CTXL) * 16;
        const int jw = j0 + 4 * wave0_;
        if (lane < 4) { pa = abbase[(size_t)(jw + lane) * 16 + d * 4 + h]; pbt = abbase[(size_t)(jw + lane) * 16 + 8 + d * 4 + h]; }
    };
    prefetch(0, wave0_, 8); prefetch_ab(0);
#ifndef EMU
    asm volatile("s_waitcnt vmcnt(0)" ::: "memory");
#endif
    const int r0_ = lane & 31, hh0_ = lane >> 5;
    __syncthreads();
    for (int it = -1; it < G_NT; ++it) {
        int r = r0_, hh = hh0_, wave = wave0_;
#ifndef EMU
        asm volatile("" : "+v"(r), "+v"(hh), "+v"(wave));
#endif
        const int xn = it + 1, par = xn & 1;
        int segn = 0, j0n = 0; if (xn < G_NT) chunk_pos(xn, d, segn, j0n);
        if (xn < G_NT) {
            const int i0 = d ? (GC - 4 - 4 * wave) : 4 * wave;
            bf16_t kt[2][4], vt[2][4];
#pragma unroll
            for (int t = 0; t < 4; ++t) {
                const int e = d ? 3 - t : t, i = i0 + e;
                const unsigned wq = *(const unsigned*)(RAW + (4 * wave + t) * 384 + 2 * lane), wk = *(const unsigned*)(RAW + (4 * wave + t) * 384 + 128 + 2 * lane), wv = *(const unsigned*)(RAW + (4 * wave + t) * 384 + 256 + 2 * lane);
                *(unsigned*)(Qs + (par * 32 + i) * LD128 + 2 * lane) = wq;
                *(unsigned*)(Ks + i * LD128 + 2 * lane) = wk;
                kt[0][e] = (bf16_t)(wk & 0xffffu); kt[1][e] = (bf16_t)(wk >> 16); vt[0][e] = (bf16_t)(wv & 0xffffu); vt[1][e] = (bf16_t)(wv >> 16);
            }
#pragma unroll
            for (int q = 0; q < 2; ++q) {
                u32x2 o; o.x = (unsigned)kt[q][0] | ((unsigned)kt[q][1] << 16); o.y = (unsigned)kt[q][2] | ((unsigned)kt[q][3] << 16);
                *(u32x2*)(KTs + (par * 128 + 2 * lane + q) * LD32 + i0) = o;
                u32x2 o2; o2.x = (unsigned)vt[q][0] | ((unsigned)vt[q][1] << 16); o2.y = (unsigned)vt[q][2] | ((unsigned)vt[q][3] << 16);
                *(u32x2*)(VTs + (par * 128 + 2 * lane + q) * LD32 + i0) = o2;
            }
            if (lane < 4) { const int i = d ? (GC - 1 - 4 * wave - lane) : (4 * wave + lane);
                SC[(par * 8 + 0) * 32 + i] = negea * fsoftplus(pa + dtb); SC[(par * 8 + 1) * 32 + i] = fsigmoid(pbt); }
            if (xn + 1 < G_NT) prefetch_ab(xn + 1);
        }
        LDS_BARRIER();
        if (wave >= 4 && wave < 7 && xn + 1 < G_NT) {
            prefetch(xn + 1, wave - 4, 3);
#ifndef EMU
            asm volatile("s_waitcnt vmcnt(0)" ::: "memory");
#endif
        }
        if (xn < G_NT) {
            const float* graw = SC + (par * 8 + 0) * 32;
            float gcv = 0.f;
#pragma unroll
            for (int s4 = 0; s4 < 8; ++s4) { const f32x4 g4 = *(const f32x4*)(graw + 4 * s4);
                gcv += (4 * s4 + 0 <= r ? g4.x : 0.f) + (4 * s4 + 1 <= r ? g4.y : 0.f) + (4 * s4 + 2 <= r ? g4.z : 0.f) + (4 * s4 + 3 <= r ? g4.w : 0.f); }
            if (lane < 32) GCs[wave * 32 + r] = gcv;
            if (wave == 7 && lane < 32) {
                float gl = 0.f;
#pragma unroll
                for (int s4 = 0; s4 < 8; ++s4) { const f32x4 g4 = *(const f32x4*)(graw + 4 * s4); gl += (g4.x + g4.y) + (g4.z + g4.w); }
                const float be = SC[(par * 8 + 1) * 32 + r];
                SC[(par * 8 + 3) * 32 + r] = fexp(gcv); SC[(par * 8 + 4) * 32 + r] = fexp(gl - gcv); SC[(par * 8 + 5) * 32 + r] = be * fexp(gcv); SC[(par * 8 + 6) * 32 + r] = fexp(gl);
            }
            const int pr = wave >> 2, th = (wave >> 1) & 1, ch = wave & 1, fr = lane & 15, fq = lane >> 4;
            const bf16_t* arow = (pr == 0 ? Ks : Qs + par * 32 * LD128) + (16 * th + fr) * LD128 + 8 * fq; const bf16_t* brow = Ks + (16 * ch + fr) * LD128 + 8 * fq;
            f32x4 cc = {0.f, 0.f, 0.f, 0.f};
#pragma unroll
            for (int ks = 0; ks < 4; ++ks) cc = MFMA16(*(const bf16x8*)(arow + 32 * ks), *(const bf16x8*)(brow + 32 * ks), cc);
            WAVE_SYNC();
            const int jj = 16 * ch + fr; const float gj = GCs[wave * 32 + jj];
#pragma unroll
            for (int j = 0; j < 4; ++j) {
                const int i = 16 * th + 4 * fq + j; const float dec = fexp(GCs[wave * 32 + i] - gj);
                if (pr == 0) Lf[i * 32 + jj] = (jj < i) ? SC[(par * 8 + 1) * 32 + i] * cc[j] * dec : 0.f;
                else QKMs[(par * 32 + i) * LD32 + jj] = f2bf((jj <= i) ? cc[j] * dec : 0.f);
            }
        }
        LDS_BARRIER();
        if (wave == 7 && xn < G_NT) {
            const float* sb1 = SC + (par * 8 + 5) * 32; const float* sb0 = SC + (par * 8 + 1) * 32; bf16_t* Tppw = Tpp + par * 32 * LD32;
            invert32_blocked(Lf, (bf16_t*)(smem + GL_INV), lane, [&](int i, int c, float v) { Tp[i * LD32 + c] = f2bf(v * sb1[c]); Tppw[i * LD32 + c] = f2bf(v * sb0[c]); });
        }
        if (wave < 4 && it >= 0) {
            const int pc = it & 1; int seg = 0, j0 = 0; chunk_pos(it, d, seg, j0);
            const bf16_t* Qc = Qs + pc * 32 * LD128; const bf16_t* KTc = KTs + pc * 128 * LD32; const bf16_t* VTc = VTs + pc * 128 * LD32;
            const bf16_t* QKc = QKMs + pc * 32 * LD32; const bf16_t* Tc = Tpp + pc * 32 * LD32; const float* sc = SC + pc * 8 * 32;
            f32x16 vn = zero16();
#pragma unroll
            for (int s = 0; s < 2; ++s) vn = MFMA32(ld_nat(Tc + r * LD32, s, hh), ld_nat(VTc + (32 * wave + r) * LD32, s, hh), vn);
            f32x16 oacc = zero16();
#define GDN_KSTEP(s) { const bf16x8 sb = pack_acc<(s) & 1>(St[(s) >> 1]); vn = MFMA32(ld_perm(Wn + r * LD128, (s), hh), sb, vn); oacc = MFMA32(ld_perm(Qc + r * LD128, (s), hh), sb, oacc); }
            GDN_KSTEP(0) GDN_KSTEP(1) GDN_KSTEP(2) GDN_KSTEP(3) GDN_KSTEP(4) GDN_KSTEP(5) GDN_KSTEP(6) GDN_KSTEP(7)
#undef GDN_KSTEP
#pragma unroll
            for (int g = 0; g < 16; ++g) oacc[g] *= sc[3 * 32 + crow(g, hh)];
            { const bf16x8 v0 = pack_acc<0>(vn), v1 = pack_acc<1>(vn);
              oacc = MFMA32(ld_perm(QKc + r * LD32, 0, hh), v0, oacc); oacc = MFMA32(ld_perm(QKc + r * LD32, 1, hh), v1, oacc); }
#pragma unroll
            for (int g = 0; g < 16; ++g) vn[g] *= sc[4 * 32 + crow(g, hh)];
            const float ge = sc[6 * 32];
            { const bf16x8 v0 = pack_acc<0>(vn), v1 = pack_acc<1>(vn);
#pragma unroll
              for (int ct = 0; ct < 4; ++ct) {
#pragma unroll
                  for (int g = 0; g < 16; ++g) St[ct][g] *= ge;
                  St[ct] = MFMA32(ld_perm(KTc + (32 * ct + r) * LD32, 0, hh), v0, St[ct]);
                  St[ct] = MFMA32(ld_perm(KTc + (32 * ct + r) * LD32, 1, hh), v1, St[ct]);
              } }
            if (seg) {
#pragma unroll
                for (int g = 0; g < 16; ++g) {
                    const int i = crow(g, hh), j = d ? j0 + GC - 1 - i : j0 + i;
                    ODIR[((size_t)d * T_LAT + (size_t)b * S + j) * 512 + h * 128 + 32 * wave + r] = f2bf(oacc[g]);
                }
            }
        }
        LDS_BARRIER();
        if (xn < G_NT && wave < 4) {
            f32x16 acc = zero16();
#pragma unroll
            for (int s = 0; s < 2; ++s) acc = MFMA32(ld_nat(KTs + (par * 128 + 32 * wave + r) * LD32, s, hh), ld_nat(Tp + r * LD32, s, hh), acc);
#pragma unroll
            for (int q = 0; q < 4; ++q) {
                u32x2 o; o.x = pk2(-acc[4 * q], -acc[4 * q + 1]); o.y = pk2(-acc[4 * q + 2], -acc[4 * q + 3]);
                *(u32x2*)(Wn + r * LD128 + 32 * wave + 8 * q + 4 * hh) = o;
            }
        }
        LDS_BARRIER();
    }
}

constexpr int RL_RX = 0;
constexpr int RL_KX = RL_RX + 32 * 64 * 4;
constexpr int RL_VX = RL_KX + 32 * 64 * 4;
constexpr int RL_KK = RL_VX + 32 * 64 * 4;
constexpr int RL_LW = RL_KK + 32 * 64 * 4;
constexpr int RL_IC = RL_LW + 32 * 64 * 4;
constexpr int RL_PC = RL_IC + 32 * 64 * 4;
constexpr int RL_CST = RL_PC + 2 * 64 * 4;
constexpr int RL_TW = RL_CST + 4 * 64 * 4;
constexpr int RL_AL = RL_TW + 32 * LD64 * 2;
constexpr int RL_LF = RL_TW;
constexpr int RL_LAKT = RL_LF + 32 * 32 * 4;
constexpr int RL_TB = RL_LAKT + 32 * LD32 * 2;
static_assert(RL_TB + 32 * LD32 * 2 <= RL_AL + 32 * LD64 * 2, "overlay");
constexpr int RL_W2T = RL_AL + 32 * LD64 * 2;
constexpr int RL_A2T = RL_W2T + 64 * LD64 * 2;
constexpr int RL_AR = RL_A2T + 64 * LD64 * 2;
constexpr int RL_BR = RL_AR + 32 * LD64 * 2;
constexpr int RL_KR = RL_BR + 32 * LD64 * 2;
constexpr int RL_RR = RL_KR + 32 * LD64 * 2;
constexpr int RL_AT = RL_RR + 2 * 32 * LD64 * 2;
constexpr int RL_BHT = RL_AT + 64 * LD32 * 2;
constexpr int RL_KHT = RL_BHT + 2 * 64 * LD32 * 2;
constexpr int RL_VT = RL_KHT + 2 * 64 * LD32 * 2;
constexpr int RL_MRB = RL_VT + 2 * 64 * LD32 * 2;
constexpr int RL_MRK = RL_MRB + 2 * 32 * LD32 * 2;
constexpr int RL_WM = RL_MRK + 2 * 32 * LD32 * 2;
constexpr int RL_TL = RL_WM + 32 * LD64 * 2;
constexpr int RL_END = RL_TL + 32 * LD32 * 2;
static_assert(RL_END <= LDS_BYTES, "rwkv lds");

DI void rwkv_chain2(const Params& p, char* smem, int item) {
    const int d = item / (NB * H_B), b = (item / H_B) % NB, h = item % H_B;
    const int tid = tid_x(), lane = tid & 63, wave = tid >> 6;
    float* RX = (float*)(smem + RL_RX); float* KX = (float*)(smem + RL_KX); float* VX = (float*)(smem + RL_VX); float* KKs = (float*)(smem + RL_KK);
    float* LW = (float*)(smem + RL_LW); float* IC = (float*)(smem + RL_IC); float* Lf = (float*)(smem + RL_LF); float* PC = (float*)(smem + RL_PC); float* CST = (float*)(smem + RL_CST);
    bf16_t* TW = (bf16_t*)(smem + RL_TW); bf16_t* AL = (bf16_t*)(smem + RL_AL); bf16_t* W2T = (bf16_t*)(smem + RL_W2T); bf16_t* A2T = (bf16_t*)(smem + RL_A2T);
    bf16_t* Ar = (bf16_t*)(smem + RL_AR); bf16_t* Br = (bf16_t*)(smem + RL_BR); bf16_t* Kr = (bf16_t*)(smem + RL_KR); bf16_t* Rr = (bf16_t*)(smem + RL_RR);
    bf16_t* AT = (bf16_t*)(smem + RL_AT); bf16_t* BhT = (bf16_t*)(smem + RL_BHT); bf16_t* KhT = (bf16_t*)(smem + RL_KHT); bf16_t* VT = (bf16_t*)(smem + RL_VT);
    bf16_t* LakT = (bf16_t*)(smem + RL_LAKT); bf16_t* Mrb = (bf16_t*)(smem + RL_MRB); bf16_t* Mrk = (bf16_t*)(smem + RL_MRK); bf16_t* Tb = (bf16_t*)(smem + RL_TB);
    bf16_t* Wm = (bf16_t*)(smem + RL_WM); bf16_t* TLm = (bf16_t*)(smem + RL_TL);
    bf16_t* YDIR = (bf16_t*)(p.aux + AUX_YDIR); float* BON = (float*)(p.ws + WS_BONUS);
    __syncthreads();
    for (int i = tid; i < 64 * 64; i += NTHREADS) {
        const int c = i >> 6, rr = i & 63;
        W2T[c * LD64 + rr] = f2bf(p.in[I_W2][((size_t)d * 64 + rr) * 512 + h * 64 + c]); A2T[c * LD64 + rr] = f2bf(p.in[I_A2][((size_t)d * 64 + rr) * 512 + h * 64 + c]);
    }
    if (tid < 256) { const int w = tid >> 6, c = tid & 63, gc = h * 64 + c;
        CST[tid] = w == 0 ? p.in[I_W0][d * 512 + gc] : (w == 1 ? p.in[I_A0][d * 512 + gc] : (w == 2 ? p.in[I_KA][gc] : p.in[I_RK][gc])); }
    const float kkw = p.in[I_KK][h * 64 + lane];
    f32x16 Xt[2]; Xt[0] = zero16(); Xt[1] = zero16();
    bf16_t rawv[4][5];
    auto prefetch = [&](int x) {
        int seg, j0; chunk_pos(x, d, seg, j0);
        const int ldp = seg ? IN_COLS : CTX_COLS;
        const bf16_t* pb = seg ? (const bf16_t*)(p.ws + WS_PLAT) + (size_t)b * S * IN_COLS : (const bf16_t*)(p.ws + WS_PCTX) + (size_t)b * CTXL * CTX_COLS;
        const int jw = j0 + 4 * wave;
#pragma unroll
        for (int rr = 0; rr < 4; ++rr) {
            const int j = jw + rr; const int row = seg ? (j % ROWS) * GW + j / ROWS : j;
#pragma unroll
            for (int s = 0; s < 5; ++s) {
                const int bcol = (s < 3 ? s * 512 + h * 64 : (s == 3 ? 1536 + d * 64 : 1664 + d * 64)) + lane;
                rawv[rr][s] = pb[(size_t)row * ldp + COL_B0 + bcol];
            }
        }
    };
    prefetch(0);
    const int r0_ = lane & 31, hh0_ = lane >> 5;
    __syncthreads();
    for (int it = -1; it < G_NT; ++it) {
        int r = r0_, hh = hh0_;
#ifndef EMU
        asm volatile("" : "+v"(r), "+v"(hh));
#endif
        const int xn = it + 1, par = xn & 1;
        int segn = 0, j0n = 0; if (xn < G_NT) chunk_pos(xn, d, segn, j0n);
        if (xn < G_NT) {
#pragma unroll
            for (int t = 0; t < 4; ++t) {
                const int i = d ? (GC - 1 - 4 * wave - t) : (4 * wave + t);
                const float xr = bf2f(rawv[t][0]), xk = bf2f(rawv[t][1]), xv = bf2f(rawv[t][2]);
                const float kxk = xk * kkw; const float ss = wave_sum_fast(kxk * kxk);
                RX[i * 64 + lane] = xr; KX[i * 64 + lane] = xk; VX[i * 64 + lane] = xv; KKs[i * 64 + lane] = kxk * frsq(ss + 1e-6f);
                TW[i * LD64 + lane] = rawv[t][3]; AL[i * LD64 + lane] = rawv[t][4];
            }
            if (xn + 1 < G_NT) prefetch(xn + 1);
        }
        LDS_BARRIER();
        if (xn < G_NT) {
            const int which = wave >> 2, cg = wave & 3, fr = lane & 15, fq = lane >> 4;
            const bf16_t* arow0 = (which ? AL : TW) + fr * LD64 + 8 * fq; const bf16_t* brow = (which ? A2T : W2T) + (16 * cg + fr) * LD64 + 8 * fq;
            f32x4 c0 = {0.f, 0.f, 0.f, 0.f}, c1 = {0.f, 0.f, 0.f, 0.f};
#pragma unroll
            for (int ks = 0; ks < 2; ++ks) {
                const bf16x8 bfrag = *(const bf16x8*)(brow + 32 * ks);
                c0 = MFMA16(*(const bf16x8*)(arow0 + 32 * ks), bfrag, c0); c1 = MFMA16(*(const bf16x8*)(arow0 + 16 * LD64 + 32 * ks), bfrag, c1);
            }
            const int c = 16 * cg + fr; const float bias = CST[which * 64 + c];
#pragma unroll
            for (int th = 0; th < 2; ++th)
#pragma unroll
                for (int j = 0; j < 4; ++j) {
                    const int i = 16 * th + 4 * fq + j; const float z = bias + (th ? c1[j] : c0[j]);
                    if (which) IC[i * 64 + c] = fsigmoid(z);
                    else { const float wl = -fsoftplus(-z) - 0.5f; LW[i * 64 + c] = -fexp(wl); }
                }
        }
        LDS_BARRIER();
        if (xn < G_NT) {
            const int c = lane, i0 = 4 * wave;
            const float ka = CST[2 * 64 + c], rk = CST[3 * 64 + c];
            float lpb = 0.f, lpc = 0.f; float lw4[4];
#pragma unroll
            for (int s2 = 0; s2 < 32; ++s2) { const float w = LW[s2 * 64 + c]; lpc += w; if (s2 < i0) lpb += w; }
#pragma unroll
            for (int e = 0; e < 4; ++e) lw4[e] = LW[(i0 + e) * 64 + c];
            bf16_t ta[4], tb[4], tk[4], tv[4]; float bon[4];
            float lprun = lpb;
#pragma unroll
            for (int e = 0; e < 4; ++e) {
                const int i = i0 + e;
                const float lpm = lprun; lprun += lw4[e]; const float lp = lprun;
                const float Pi = fexp(lp), Pm = fexp(lpm), invP = fexp(-lp), PCi = fexp(lpc - lp);
                const float ic = IC[i * 64 + c], kxv = KX[i * 64 + c], kkv = KKs[i * 64 + c], rxv = RX[i * 64 + c], vxv = VX[i * 64 + c];
                const float kd = kxv * (1.f + (ic - 1.f) * ka), bb = kkv * ic, aa = -kkv;
                ta[e] = f2bf(aa * Pm); tb[e] = f2bf(bb * PCi); tk[e] = f2bf(kd * PCi); tv[e] = f2bf(vxv);
                Ar[i * LD64 + c] = ta[e]; Br[i * LD64 + c] = f2bf(bb * invP); Kr[i * LD64 + c] = f2bf(kd * invP); Rr[(par * 32 + i) * LD64 + c] = f2bf(rxv * Pi);
                bon[e] = wave_sum_fast(rxv * kd * rk);
            }
            { u32x2 o; o.x = (unsigned)ta[0] | ((unsigned)ta[1] << 16); o.y = (unsigned)ta[2] | ((unsigned)ta[3] << 16); *(u32x2*)(AT + c * LD32 + i0) = o; }
            { u32x2 o; o.x = (unsigned)tb[0] | ((unsigned)tb[1] << 16); o.y = (unsigned)tb[2] | ((unsigned)tb[3] << 16); *(u32x2*)(BhT + (par * 64 + c) * LD32 + i0) = o; }
            { u32x2 o; o.x = (unsigned)tk[0] | ((unsigned)tk[1] << 16); o.y = (unsigned)tk[2] | ((unsigned)tk[3] << 16); *(u32x2*)(KhT + (par * 64 + c) * LD32 + i0) = o; }
            { u32x2 o; o.x = (unsigned)tv[0] | ((unsigned)tv[1] << 16); o.y = (unsigned)tv[2] | ((unsigned)tv[3] << 16); *(u32x2*)(VT + (par * 64 + c) * LD32 + i0) = o; }
            if (wave == 7) PC[par * 64 + c] = fexp(lpc);
            if (segn && lane < 4) { const int i = i0 + lane, jj = d ? j0n + GC - 1 - i : j0n + i;
                const float bv = lane == 0 ? bon[0] : (lane == 1 ? bon[1] : (lane == 2 ? bon[2] : bon[3]));
                BON[((size_t)d * T_LAT + (size_t)b * S + (jj % ROWS) * GW + jj / ROWS) * 8 + h] = bv; }
        }
        LDS_BARRIER();
        if (xn < G_NT) {
            const int m = wave >> 1, th = wave & 1, fr = lane & 15, fq = lane >> 4;
            const bf16_t* arow = ((m < 2) ? Ar : Rr + par * 32 * LD64) + (16 * th + fr) * LD64 + 8 * fq; const bf16_t* brow = ((m & 1) ? Kr : Br) + fr * LD64 + 8 * fq;
            f32x4 c0 = {0.f, 0.f, 0.f, 0.f}, c1 = {0.f, 0.f, 0.f, 0.f};
#pragma unroll
            for (int ks = 0; ks < 2; ++ks) {
                const bf16x8 afrag = *(const bf16x8*)(arow + 32 * ks);
                c0 = MFMA16(afrag, *(const bf16x8*)(brow + 32 * ks), c0); c1 = MFMA16(afrag, *(const bf16x8*)(brow + 16 * LD64 + 32 * ks), c1);
            }
#pragma unroll
            for (int ch = 0; ch < 2; ++ch) {
                const f32x4 cc = ch ? c1 : c0; const int ic = 16 * ch + fr; const int t0 = 16 * th + 4 * fq;
                if (m == 0) {
#pragma unroll
                    for (int j = 0; j < 4; ++j) Lf[(t0 + j) * 32 + ic] = (ic < t0 + j) ? -cc[j] : 0.f;
                } else if (m == 1) {
                    u32x2 o; o.x = pk2((ic < t0) ? cc[0] : 0.f, (ic < t0 + 1) ? cc[1] : 0.f); o.y = pk2((ic < t0 + 2) ? cc[2] : 0.f, (ic < t0 + 3) ? cc[3] : 0.f);
                    *(u32x2*)(LakT + ic * LD32 + t0) = o;
                } else {
                    bf16_t* M = (m == 2 ? Mrb : Mrk) + par * 32 * LD32;
#pragma unroll
                    for (int j = 0; j < 4; ++j) M[(t0 + j) * LD32 + ic] = f2bf((ic <= t0 + j) ? cc[j] : 0.f);
                }
            }
        }
        LDS_BARRIER();
        if (wave == 7 && xn < G_NT) {
            invert32_blocked(Lf, (bf16_t*)(smem + RL_RX), lane, [&](int i, int c, float v) { Tb[i * LD32 + c] = f2bf(v); });
        }
        if (wave < 2 && it >= 0) {
            const int pc = it & 1; int seg = 0, j0 = 0; chunk_pos(it, d, seg, j0);
            const bf16_t* Rc = Rr + pc * 32 * LD64; const bf16_t* BhTc = BhT + pc * 64 * LD32; const bf16_t* KhTc = KhT + pc * 64 * LD32; const bf16_t* VTc = VT + (pc * 64 + 32 * wave + r) * LD32;
            const bf16_t* Mrbc = Mrb + pc * 32 * LD32; const bf16_t* Mrkc = Mrk + pc * 32 * LD32; const float* PCc = PC + pc * 64;
            const bf16x8 vf0 = ld_nat(VTc, 0, hh), vf1 = ld_nat(VTc, 1, hh);
            f32x16 u = zero16(), y = zero16();
            u = MFMA32(ld_nat(TLm + r * LD32, 0, hh), vf0, u); u = MFMA32(ld_nat(TLm + r * LD32, 1, hh), vf1, u);
            y = MFMA32(ld_nat(Mrkc + r * LD32, 0, hh), vf0, y); y = MFMA32(ld_nat(Mrkc + r * LD32, 1, hh), vf1, y);
#define RW_KSTEP(s) { const bf16x8 xb = pack_acc<(s) & 1>(Xt[(s) >> 1]); u = MFMA32(ld_perm(Wm + r * LD64, (s), hh), xb, u); y = MFMA32(ld_perm(Rc + r * LD64, (s), hh), xb, y); }
            RW_KSTEP(0) RW_KSTEP(1) RW_KSTEP(2) RW_KSTEP(3)
#undef RW_KSTEP
            const bf16x8 ub0 = pack_acc<0>(u), ub1 = pack_acc<1>(u);
            y = MFMA32(ld_perm(Mrbc + r * LD32, 0, hh), ub0, y); y = MFMA32(ld_perm(Mrbc + r * LD32, 1, hh), ub1, y);
#pragma unroll
            for (int kt = 0; kt < 2; ++kt) {
#pragma unroll
                for (int g = 0; g < 16; ++g) Xt[kt][g] *= PCc[32 * kt + crow(g, hh)];
                Xt[kt] = MFMA32(ld_perm(BhTc + (32 * kt + r) * LD32, 0, hh), ub0, Xt[kt]); Xt[kt] = MFMA32(ld_perm(BhTc + (32 * kt + r) * LD32, 1, hh), ub1, Xt[kt]);
                Xt[kt] = MFMA32(ld_nat(KhTc + (32 * kt + r) * LD32, 0, hh), vf0, Xt[kt]); Xt[kt] = MFMA32(ld_nat(KhTc + (32 * kt + r) * LD32, 1, hh), vf1, Xt[kt]);
            }
            if (seg) {
#pragma unroll
                for (int g = 0; g < 16; ++g) {
                    const int i = crow(g, hh), jj = d ? j0 + GC - 1 - i : j0 + i;
                    YDIR[((size_t)d * T_LAT + (size_t)b * S + (jj % ROWS) * GW + jj / ROWS) * 512 + h * 64 + 32 * wave + r] = f2bf(y[g]);
                }
            }
        }
        LDS_BARRIER();
        if (xn < G_NT && wave < 3) {
            const bf16_t* arow = (wave < 2) ? AT + (32 * wave + r) * LD32 : LakT + r * LD32;
            f32x16 acc = zero16();
#pragma unroll
            for (int s = 0; s < 2; ++s) acc = MFMA32(ld_nat(arow, s, hh), ld_nat(Tb + r * LD32, s, hh), acc);
#pragma unroll
            for (int q = 0; q < 4; ++q) {
                u32x2 o; o.x = pk2(acc[4 * q], acc[4 * q + 1]); o.y = pk2(acc[4 * q + 2], acc[4 * q + 3]);
                if (wave < 2) *(u32x2*)(Wm + r * LD64 + 32 * wave + 8 * q + 4 * hh) = o; else *(u32x2*)(TLm + r * LD32 + 8 * q + 4 * hh) = o;
            }
        }
        LDS_BARRIER();
    }
}

DI void phase3(const Params& p, char* smem) {
    constexpr int NG = 2 * NB * H_A, NR = 2 * NB * H_B;
    for (int it = blockIdx.x; it < NG; it += gridDim.x) gdn_chain2(p, smem, it);
    for (int it = blockIdx.x; it < NG + NR; it += gridDim.x) if (it >= NG) rwkv_chain2(p, smem, it - NG);
    const int nchain = NG + NR, G = (int)gridDim.x;
    const int tb = G > nchain ? (int)blockIdx.x - nchain : (int)blockIdx.x, ntb = G > nchain ? G - nchain : G;
    if (tb >= 0) {
        __syncthreads();
        const int tid3 = tid_x(), lane = tid3 & 63, wave = tid3 >> 6;
        float* scr = (float*)smem + wave * (64 * 33);
        bf16_t* GUT = (bf16_t*)(p.aux + AUX_GUT);
        constexpr int nkb = D / 64, nnb = DE / 32, per = nkb * nnb;
        for (int it = tb * 8 + wave; it < NEXP * 2 * per; it += ntb * 8) {
            const int e = it / (2 * per), r = it % (2 * per), up = r / per, r2 = r % per, kb = r2 / nnb, nb = r2 % nnb;
            transpose_item((up ? p.in[I_MU_UP] : p.in[I_MG]) + (size_t)e * D * DE, DE, DE, kb * 64, nb * 32, GUT + (size_t)e * 512 * D, D, up ? 2 : 1, scr, lane);
        }
    }
}

constexpr int P4_SG = 0;
constexpr int P4_XV = P4_SG + 32 * LD128 * 2;
constexpr int P4_YF = P4_XV + 32 * 520 * 2;
static_assert(P4_YF + 32 * 516 * 4 <= LDS_BYTES, "phase4 lds");
DI float half_sum(float v, int hh) {
#ifdef EMU
    v += __shfl_xor(v, 1); v += __shfl_xor(v, 2); v += __shfl_xor(v, 4); v += __shfl_xor(v, 8); v += __shfl_xor(v, 16); return v;
#else
    v = DPP_ADD(v, 0xB1); v = DPP_ADD(v, 0x4E); v = DPP_ADD(v, 0x141); v = DPP_ADD(v, 0x140);
    const int iv = __builtin_bit_cast(int, v);
    const float s0 = __builtin_bit_cast(float, __builtin_amdgcn_readlane(iv, 0)) + __builtin_bit_cast(float, __builtin_amdgcn_readlane(iv, 16));
    const float s1 = __builtin_bit_cast(float, __builtin_amdgcn_readlane(iv, 32)) + __builtin_bit_cast(float, __builtin_amdgcn_readlane(iv, 48));
    return hh ? s1 : s0;
#endif
}
DI void phase4(const Params& p, char* smem) {
    const int tid = tid_x(), lane = tid & 63, wave = tid >> 6, r = lane & 31, hh = lane >> 5;
    const bf16_t* PL = (const bf16_t*)(p.ws + WS_PLAT);
    const bf16_t* ODIR = (const bf16_t*)(p.ws + WS_OA); const bf16_t* YDIR = (const bf16_t*)(p.aux + AUX_YDIR);
    const float* BON = (const float*)(p.ws + WS_BONUS); const float* mu = p.in[I_MU]; const bf16_t* G2T = (const bf16_t*)(p.ws + WS_G2T);
    bf16_t* OA = (bf16_t*)(p.ws + WS_OA); bf16_t* OB = (bf16_t*)(p.ws + WS_OB);
    bf16_t* SG = (bf16_t*)(smem + P4_SG); bf16_t* XV = (bf16_t*)(smem + P4_XV); float* YF = (float*)(smem + P4_YF);
    for (int it = blockIdx.x; it < T_LAT / 32; it += gridDim.x) {
        const int tok0 = it * 32, b = tok0 / S, l0 = tok0 % S;
        __syncthreads();
        for (int q = tid; q < 32 * 80; q += NTHREADS) {
            const int t = q / 80, c8 = q % 80;
            const int l = l0 + t;
            const int bcol = c8 < 16 ? 1792 + c8 * 8 : 1024 + (c8 - 16) * 8;
            float cu[8], o[8];
            unpack8(*(const u32x4*)(PL + (size_t)(b * S + l) * IN_COLS + COL_B0 + bcol), cu);
#pragma unroll
            for (int e = 0; e < 8; ++e) o[e] = c8 < 16 ? fsigmoid(cu[e]) : cu[e];
            u32x4 w; w.x = pk2(o[0], o[1]); w.y = pk2(o[2], o[3]); w.z = pk2(o[4], o[5]); w.w = pk2(o[6], o[7]);
            if (c8 < 16) *(u32x4*)(SG + t * LD128 + c8 * 8) = w; else *(u32x4*)(XV + t * 520 + (c8 - 16) * 8) = w;
        }
        for (int q = tid; q < 32 * 64; q += NTHREADS) {
            const int t = q >> 6, c8 = q & 63, tok = tok0 + t;
            float a0[8], a1[8];
            unpack8(*(const u32x4*)(YDIR + (size_t)tok * 512 + c8 * 8), a0); unpack8(*(const u32x4*)(YDIR + ((size_t)T_LAT + tok) * 512 + c8 * 8), a1);
            f32x4 s0 = {a0[0] + a1[0], a0[1] + a1[1], a0[2] + a1[2], a0[3] + a1[3]}, s1 = {a0[4] + a1[4], a0[5] + a1[5], a0[6] + a1[6], a0[7] + a1[7]};
            *(f32x4*)(YF + t * 516 + c8 * 8) = s0; *(f32x4*)(YF + t * 516 + c8 * 8 + 4) = s1;
        }
        __syncthreads();
        {
            unsigned q0[16], q1[16], zq[16];
#pragma unroll
            for (int k = 0; k < 16; ++k) {
                const int pi = wave * 16 + k, t = pi >> 2, h = pi & 3, tok = tok0 + t;
                const size_t o0 = (size_t)tok * 512 + h * 128 + 2 * lane;
                q0[k] = *(const unsigned*)(ODIR + o0); q1[k] = *(const unsigned*)(ODIR + (size_t)T_LAT * 512 + o0); zq[k] = *(const unsigned*)(PL + (size_t)tok * IN_COLS + 1536 + h * 128 + 2 * lane);
            }
            const float on0 = p.in[I_ONORM][2 * lane], on1 = p.in[I_ONORM][2 * lane + 1];
#pragma unroll
            for (int k = 0; k < 16; ++k) {
                const int pi = wave * 16 + k, t = pi >> 2, h = pi & 3, tok = tok0 + t;
                const size_t o0 = (size_t)tok * 512 + h * 128 + 2 * lane;
                const float a0 = bf2f((bf16_t)(q0[k] & 0xffffu)) + bf2f((bf16_t)(q1[k] & 0xffffu)), a1 = bf2f((bf16_t)(q0[k] >> 16)) + bf2f((bf16_t)(q1[k] >> 16));
                const float ss = wave_sum_fast(a0 * a0 + a1 * a1);
                const float rstd = frsq(ss * (1.f / 128.f) + 1e-6f);
                const float z0 = bf2f((bf16_t)(zq[k] & 0xffffu)), z1 = bf2f((bf16_t)(zq[k] >> 16));
                *(unsigned*)(OA + o0) = pk2(a0 * rstd * on0 * fsilu(z0), a1 * rstd * on1 * fsilu(z1));
            }
        }
        __syncthreads();
        {
            const int h = wave;
            f32x16 acc0 = zero16(), acc1 = zero16();
#pragma unroll
            for (int s2 = 0; s2 < 8; ++s2) {
                const bf16x8 a = ld_nat(SG + r * LD128, s2, hh);
                const bf16x8 b0 = *(const bf16x8*)(G2T + (size_t)(64 * h + r) * 128 + 16 * s2 + 8 * hh), b1 = *(const bf16x8*)(G2T + (size_t)(64 * h + 32 + r) * 128 + 16 * s2 + 8 * hh);
                acc0 = MFMA32(a, b0, acc0); acc1 = MFMA32(a, b1, acc1);
            }
            const int c0 = 64 * h + r, c1 = c0 + 32;
            const float lg0 = p.in[I_LNG][c0], lb0 = p.in[I_LNB][c0], lg1 = p.in[I_LNG][c1], lb1 = p.in[I_LNB][c1];
            float bonv[16];
#pragma unroll
            for (int g = 0; g < 16; ++g) { const int tok = tok0 + crow(g, hh); bonv[g] = BON[(size_t)tok * 8 + h] + BON[((size_t)T_LAT + tok) * 8 + h]; }
#pragma unroll
            for (int g = 0; g < 16; ++g) {
                const int i = crow(g, hh), tok = tok0 + i;
                const float y0 = YF[i * 516 + c0], y1 = YF[i * 516 + c1];
                const float mean = half_sum(y0 + y1, hh) * (1.f / 64.f); const float d0 = y0 - mean, d1 = y1 - mean;
                const float var = half_sum(d0 * d0 + d1 * d1, hh) * (1.f / 64.f); const float rs = frsq(var + 64e-5f);
                const float bon = bonv[g];
                const float o0 = (d0 * rs * lg0 + lb0 + bon * bf2f(XV[i * 520 + c0])) * acc0[g], o1 = (d1 * rs * lg1 + lb1 + bon * bf2f(XV[i * 520 + c1])) * acc1[g];
                OB[(size_t)tok * 512 + c0] = f2bf(o0); OB[(size_t)tok * 512 + c1] = f2bf(o1);
            }
        }
    }
}

DI void phase5(const Params& p, char* smem) {
    const bf16_t* OA = (const bf16_t*)(p.ws + WS_OA); const bf16_t* OB = (const bf16_t*)(p.ws + WS_OB);
    const bf16_t* WA = (const bf16_t*)(p.ws + WS_WOA); const bf16_t* WB = (const bf16_t*)(p.ws + WS_WOB);
    const bf16_t* PL = (const bf16_t*)(p.ws + WS_PLAT); bf16_t* Y = (bf16_t*)(p.aux + AUX_Y);
    if (USE_G8) {
        constexpr int NT8 = D / 256, MT8 = T_LAT / 256;
        constexpr int GLD = 264;
        static_assert(256 * GLD * 2 <= LDS_BYTES, "gate tile lds");
        bf16_t* GT = (bf16_t*)smem;
        auto stage_gates = [&](int brow, int gcol0) {
            const int tid = tid_x();
            u32x4 gv[16];
#pragma unroll
            for (int i = 0; i < 16; ++i) { const int ch = tid + i * NTHREADS, row = ch >> 5, c16 = ch & 31; gv[i] = *(const u32x4*)(PL + (size_t)(brow + row) * IN_COLS + gcol0 + c16 * 8); }
#pragma unroll
            for (int i = 0; i < 16; ++i) { const int ch = tid + i * NTHREADS, row = ch >> 5, c16 = ch & 31; *(u32x4*)(GT + row * GLD + c16 * 8) = gv[i]; }
            __syncthreads();
        };
        for (int t = blockIdx.x; t < MT8 * NT8; t += gridDim.x) {
            int mt, nt; if (!g8::tile_order(t, MT8, NT8, mt, nt)) break;
            const int brow = mt * 256, bcol = nt * 256;
            g8::Acc acc; g8::acc_zero(acc);
            g8::kloop(acc, smem, OA, 512, WA, 512, 512, brow, bcol);
            stage_gates(brow, COL_G0 + bcol);
            g8::for_each_quad(acc, brow, bcol, [&](int row, int col, const f32x4& v) {
                const u32x2 gq = *(const u32x2*)(GT + (row - brow) * GLD + (col - bcol));
                const float g0 = bf2f((bf16_t)(gq.x & 0xffffu)), g1 = bf2f((bf16_t)(gq.x >> 16)), g2 = bf2f((bf16_t)(gq.y & 0xffffu)), g3 = bf2f((bf16_t)(gq.y >> 16));
                u32x2 o; o.x = pk2(fsigmoid(g0) * v.x, fsigmoid(g1) * v.y); o.y = pk2(fsigmoid(g2) * v.z, fsigmoid(g3) * v.w);
                *(u32x2*)(Y + (size_t)row * D + col) = o;
            });
            __syncthreads();
            g8::acc_zero(acc);
            g8::kloop(acc, smem, OB, 512, WB, 512, 512, brow, bcol);
            stage_gates(brow, COL_G0 + D + bcol);
            g8::for_each_quad(acc, brow, bcol, [&](int row, int col, const f32x4& v) {
                const u32x2 gq = *(const u32x2*)(GT + (row - brow) * GLD + (col - bcol));
                const float g0 = bf2f((bf16_t)(gq.x & 0xffffu)), g1 = bf2f((bf16_t)(gq.x >> 16)), g2 = bf2f((bf16_t)(gq.y & 0xffffu)), g3 = bf2f((bf16_t)(gq.y >> 16));
#ifdef EMU
                const unsigned long long tq = *(const unsigned long long*)(Y + (size_t)row * D + col);
#else
                const unsigned long long tq = __hip_atomic_load((const unsigned long long*)(Y + (size_t)row * D + col), __ATOMIC_RELAXED, __HIP_MEMORY_SCOPE_AGENT);
#endif
                const unsigned tlo = (unsigned)tq, thi = (unsigned)(tq >> 32);
                const float t0 = bf2f((bf16_t)(tlo & 0xffffu)), t1 = bf2f((bf16_t)(tlo >> 16)), t2 = bf2f((bf16_t)(thi & 0xffffu)), t3 = bf2f((bf16_t)(thi >> 16));
                u32x2 o; o.x = pk2(t0 + fsigmoid(g0) * v.x, t1 + fsigmoid(g1) * v.y); o.y = pk2(t2 + fsigmoid(g2) * v.z, t3 + fsigmoid(g3) * v.w);
                *(u32x2*)(Y + (size_t)row * D + col) = o;
            });
            __syncthreads();
        }
        return;
    }
    constexpr int MR5 = 2, BM5 = 64 * MR5; constexpr int NT = D / 128, MT = T_LAT / BM5;
    for (int t = blockIdx.x; t < MT * NT; t += gridDim.x) {
        const int mt = t / NT, nt = t % NT, row0 = mt * BM5;
        f32x4 acca[MR5][4], accb[MR5][4]; acc_zero(acca); acc_zero(accb);
        gemm_kloop(acca, smem, [&](int i) { return OA + (size_t)(row0 + i) * 512; }, WA + (size_t)nt * 128 * 512, 512, 512);
        gemm_kloop(accb, smem, [&](int i) { return OB + (size_t)(row0 + i) * 512; }, WB + (size_t)nt * 128 * 512, 512, 512);
        const int t2 = tid_x(), l2 = t2 & 63, w2 = t2 >> 6; const int wr = w2 >> 1, wc = w2 & 1, fr = l2 & 15, fq = l2 >> 4;
#pragma unroll
        for (int m = 0; m < MR5; ++m)
#pragma unroll
            for (int n = 0; n < 4; ++n)
#pragma unroll
                for (int j = 0; j < 4; ++j) {
                    const int row = row0 + wr * 16 * MR5 + m * 16 + fq * 4 + j, col = nt * 128 + wc * 64 + n * 16 + fr;
                    const float ga = bf2f(PL[(size_t)row * IN_COLS + COL_G0 + col]), gb = bf2f(PL[(size_t)row * IN_COLS + COL_G0 + D + col]);
                    Y[(size_t)row * D + col] = f2bf(sigmoidf_(ga) * acca[m][n][j] + sigmoidf_(gb) * accb[m][n][j]);
                }
    }
}

DI void phase6(const Params& p, char* smem) {
    const bf16_t* Y = (const bf16_t*)(p.aux + AUX_Y); const bf16_t* WO = (const bf16_t*)(p.ws + WS_WOUT);
    const float* mod = (const float*)(p.ws + WS_MOD); float* Hh = (float*)(p.ws + WS_H);
    if (USE_G8) {
        constexpr int NT = D / 256, MT = T_LAT / 256;
        const float* X = p.in[I_X];
        for (int t = blockIdx.x; t < MT * NT; t += gridDim.x) {
            int mt, nt; if (!g8::tile_order(t, MT, NT, mt, nt)) break;
            const int brow = mt * 256, bcol = nt * 256;
            g8::Acc acc; g8::acc_zero(acc);
            g8::kloop(acc, smem, Y, D, WO, D, D, brow, bcol);
            g8::for_each_quad(acc, brow, bcol, [&](int row, int col, const f32x4& v) {
                const int b = row / S; const f32x4 xv = *(const f32x4*)(X + (size_t)row * D + col), gv = *(const f32x4*)(mod + (size_t)b * 6 * D + 2 * D + col);
                f32x4 o; o.x = xv.x + gv.x * v.x; o.y = xv.y + gv.y * v.y; o.z = xv.z + gv.z * v.z; o.w = xv.w + gv.w * v.w;
                *(f32x4*)(Hh + (size_t)row * D + col) = o;
            });
        }
    } else {
        const int tid = tid_x(), lane = tid & 63, wave = tid >> 6, wr = wave >> 1, wc = wave & 1, fr = lane & 15, fq = lane >> 4;
        constexpr int NT = D / 128, MT = T_LAT / BM;
        for (int t = blockIdx.x; t < MT * NT; t += gridDim.x) {
            const int mt = t / NT, nt = t % NT, row0 = mt * BM;
            f32x4 acc[MREP][4]; acc_zero(acc);
            gemm_kloop(acc, smem, [&](int i) { return Y + (size_t)(row0 + i) * D; }, WO + (size_t)nt * 128 * D, D, D);
#pragma unroll
            for (int m = 0; m < MREP; ++m)
#pragma unroll
                for (int n = 0; n < 4; ++n)
#pragma unroll
                    for (int j = 0; j < 4; ++j) {
                        const int row = row0 + wr * 16 * MREP + m * 16 + fq * 4 + j, col = nt * 128 + wc * 64 + n * 16 + fr, b = row / S;
                        Hh[(size_t)row * D + col] = p.in[I_X][(size_t)row * D + col] + mod[(size_t)b * 6 * D + 2 * D + col] * acc[m][n][j];
                    }
        }
    }
    __syncthreads();
    const int tid6 = tid_x(), lane = tid6 & 63, wave = tid6 >> 6;
    const int gw = blockIdx.x * 8 + wave, ngw = gridDim.x * 8;
    float* scr = (float*)smem + wave * (64 * 33);
    bf16_t* DNT = (bf16_t*)(p.ws + WS_DNT);
    {
        constexpr int nkb = DE / 64, nnb = D / 32, per = nkb * nnb;
        for (int it = gw; it < NEXP * per; it += ngw) {
            const int e = it / per, r2 = it % per, kb = r2 / nnb, nb = r2 % nnb;
            transpose_item(p.in[I_MD] + (size_t)e * DE * D, D, D, kb * 64, nb * 32, DNT + (size_t)e * D * DE, DE, 0, scr, lane);
        }
    }
}

#ifdef EMU
#define MFMA32F(a, b, c) emu_mfma32_f32((a), (b), (c))
#else
#define MFMA32F(a, b, c) __builtin_amdgcn_mfma_f32_32x32x2f32((a), (b), (c), 0, 0, 0)
#endif
constexpr int TB_LD = D + 4;
static_assert(32 * TB_LD * 4 <= LDS_BYTES && 8 * 32 * 64 * 4 <= LDS_BYTES, "phase7 lds");
DI void phase7(const Params& p, char* smem) {
    const int tid = tid_x(), lane = tid & 63, wave = tid >> 6, r = lane & 31, hh = lane >> 5;
    const float* Hh = (const float*)(p.ws + WS_H); const float* mod = (const float*)(p.ws + WS_MOD); const float* WRT = (const float*)(p.ws + WS_WRT);
    bf16_t* Tt = (bf16_t*)(p.ws + WS_T); int* cnt = (int*)(p.ws + WS_CNT); int* rowlist = (int*)(p.ws + WS_ROWLIST); float* pairw = (float*)(p.ws + WS_PAIRW);
    float* tb = (float*)smem;
    float* bias = (float*)(smem + LDS_BYTES - 1024);
    int* lcnt = (int*)(smem + LDS_BYTES - 768);
    int* lbase = lcnt + 32;
    if (tid < 36) bias[tid] = tid < 4 ? p.in[I_RGB][tid] : p.in[I_REB][tid - 4];
    f32x4 x[4][D / 256];
    int itn = blockIdx.x;
    if (itn < T_LAT / 32) {
#pragma unroll
        for (int tt = 0; tt < 4; ++tt)
#pragma unroll
            for (int j = 0; j < D / 256; ++j) x[tt][j] = *(const f32x4*)(Hh + (size_t)(itn * 32 + wave * 4 + tt) * D + j * 256 + lane * 4);
    }
    for (int it = blockIdx.x; it < T_LAT / 32; it += gridDim.x) {
        const int tok0 = it * 32;
        __syncthreads();
        if (tid < 32) lcnt[tid] = 0;
#pragma unroll
        for (int tt = 0; tt < 4; ++tt) {
            const int ti = wave * 4 + tt, tok = tok0 + ti, b = tok / S;
            float ss = 0.f;
#pragma unroll
            for (int j = 0; j < D / 256; ++j) ss += x[tt][j].x * x[tt][j].x + x[tt][j].y * x[tt][j].y + x[tt][j].z * x[tt][j].z + x[tt][j].w * x[tt][j].w;
            ss = wave_sum_fast(ss);
            const float rstd = frsq(ss * (1.0f / D) + 1e-6f);
#pragma unroll
            for (int j = 0; j < D / 256; ++j) {
                const int k = j * 256 + lane * 4;
                const f32x4 g = *(const f32x4*)(p.in[I_NFFN] + k), sh = *(const f32x4*)(mod + (size_t)b * 6 * D + 3 * D + k), sc = *(const f32x4*)(mod + (size_t)b * 6 * D + 4 * D + k);
                f32x4 o; o.x = x[tt][j].x * rstd * g.x * (1.f + sc.x) + sh.x; o.y = x[tt][j].y * rstd * g.y * (1.f + sc.y) + sh.y;
                o.z = x[tt][j].z * rstd * g.z * (1.f + sc.z) + sh.z; o.w = x[tt][j].w * rstd * g.w * (1.f + sc.w) + sh.w;
                *(f32x4*)(tb + ti * TB_LD + k) = o;
                u32x2 ob; ob.x = pk2(o.x, o.y); ob.y = pk2(o.z, o.w);
                *(u32x2*)(Tt + (size_t)tok * D + k) = ob;
            }
        }
        itn = it + gridDim.x;
        if (itn < T_LAT / 32) {
#pragma unroll
            for (int tt = 0; tt < 4; ++tt)
#pragma unroll
                for (int j = 0; j < D / 256; ++j) x[tt][j] = *(const f32x4*)(Hh + (size_t)(itn * 32 + wave * 4 + tt) * D + j * 256 + lane * 4);
        }
        LDS_BARRIER();
        f32x16 a0 = zero16(), a1 = zero16();
        {
            const int kbeg = wave * (D / 8);
            const float* arow = tb + r * TB_LD + kbeg + 4 * hh;
            const float* b0row = WRT + (size_t)(4 + r) * D + kbeg + 4 * hh;
            const float* b1row = WRT + (size_t)(r < 4 ? r : 0) * D + kbeg + 4 * hh;
            const float m1 = r < 4 ? 1.f : 0.f;
#pragma unroll 4
            for (int g = 0; g < D / 64; ++g) {
                const f32x4 av = *(const f32x4*)(arow + 8 * g), b0 = *(const f32x4*)(b0row + 8 * g); const f32x4 b1 = *(const f32x4*)(b1row + 8 * g) * m1;
                a0 = MFMA32F(av.x, b0.x, a0); a1 = MFMA32F(av.x, b1.x, a1); a0 = MFMA32F(av.y, b0.y, a0); a1 = MFMA32F(av.y, b1.y, a1);
                a0 = MFMA32F(av.z, b0.z, a0); a1 = MFMA32F(av.z, b1.z, a1); a0 = MFMA32F(av.w, b0.w, a0); a1 = MFMA32F(av.w, b1.w, a1);
            }
        }
        LDS_BARRIER();
        {
            float* part = tb + wave * (32 * 64);
#pragma unroll
            for (int g = 0; g < 16; ++g) { const int i = crow(g, hh); part[i * 64 + r] = a0[g]; part[i * 64 + 32 + r] = a1[g]; }
        }
        LDS_BARRIER();
        float lsum[4];
        {
            const int i = tid >> 4, c4 = (tid & 15) * 4;
#pragma unroll
            for (int e = 0; e < 4; ++e) { float sacc = 0.f;
#pragma unroll
                for (int w = 0; w < 8; ++w) sacc += tb[w * (32 * 64) + i * 64 + c4 + e];
                lsum[e] = sacc; }
        }
        LDS_BARRIER();
        { const int i = tid >> 4, c4 = (tid & 15) * 4;
#pragma unroll
          for (int e = 0; e < 4; ++e) tb[i * 64 + c4 + e] = lsum[e]; }
        LDS_BARRIER();
        int ex1 = 0, ex2 = 0, rk1 = 0, rk2 = 0; float w1 = 0.f, w2 = 0.f;
        if (tid < 32) {
            const float* L = tb + tid * 64;
            float gl[4];
#pragma unroll
            for (int i = 0; i < 4; ++i) gl[i] = L[32 + i] + bias[i];
            int g = 0; float mx = gl[0];
#pragma unroll
            for (int i = 1; i < 4; ++i) if (gl[i] > mx) { mx = gl[i]; g = i; }
            float se = 0.f;
#pragma unroll
            for (int i = 0; i < 4; ++i) se += fexp(gl[i] - mx);
            const float pg = 1.0f / se;
            int i1 = 0; float l1 = L[g * 8] + bias[4 + g * 8];
            for (int i = 1; i < 8; ++i) { const float v = L[g * 8 + i] + bias[4 + g * 8 + i]; if (v > l1) { l1 = v; i1 = i; } }
            int i2 = -1; float l2 = -3.0e38f;
            for (int i = 0; i < 8; ++i) { const float v = L[g * 8 + i] + bias[4 + g * 8 + i]; if (i != i1 && v > l2) { l2 = v; i2 = i; } }
            const float e2 = fexp(l2 - l1); w1 = pg / (1.f + e2); w2 = pg * e2 / (1.f + e2);
            ex1 = g * 8 + i1; ex2 = g * 8 + i2;
            rk1 = atomicAdd(&lcnt[ex1], 1); rk2 = atomicAdd(&lcnt[ex2], 1);
        }
        LDS_BARRIER();
        if (tid < 32) { const int c = lcnt[tid]; lbase[tid] = c ? atomicAdd(&cnt[tid * CNT_STRIDE], c) : 0; }
        __syncthreads();
        if (tid < 32) {
            const int tok = tok0 + tid;
            rowlist[(size_t)ex1 * CAP + lbase[ex1] + rk1] = tok * 2; pairw[tok * 2] = w1;
            rowlist[(size_t)ex2 * CAP + lbase[ex2] + rk2] = tok * 2 + 1; pairw[tok * 2 + 1] = w2;
        }
    }
}

constexpr int MOE_TM = USE_G8 ? 256 : BM;
DI void moe_tiles(const Params& p, char* smem, int* pre) {
    const int* cnt = (const int*)(p.ws + WS_CNT);
    __syncthreads();
    if (tid_x() == 0) { int s = 0; for (int e = 0; e < NEXP; ++e) { pre[e] = s; s += (cnt[e * CNT_STRIDE] + MOE_TM - 1) / MOE_TM; } pre[NEXP] = s; }
    __syncthreads();
}
DI void phase8(const Params& p, char* smem) {
    const int tid = tid_x(), lane = tid & 63, wave = tid >> 6, wr = wave >> 1, wc = wave & 1, fr = lane & 15, fq = lane >> 4;
    int* pre = (int*)(smem + LDS_BYTES - 256);
    moe_tiles(p, smem, pre);
    const int* cnt = (const int*)(p.ws + WS_CNT); const int* rowlist = (const int*)(p.ws + WS_ROWLIST);
    const bf16_t* Tt = (const bf16_t*)(p.ws + WS_T); const bf16_t* GUT = (const bf16_t*)(p.aux + AUX_GUT); bf16_t* HID = (bf16_t*)(p.ws + WS_HID);
    if (USE_G8) {
        const int ntile8 = pre[NEXP] * 2;
        for (int t = blockIdx.x; t < ntile8; t += gridDim.x) {
            const int mg = t >> 1, nt = t & 1; int e = 0;
            while (pre[e + 1] <= mg) ++e;
            const int mt = mg - pre[e], ce = cnt[e * CNT_STRIDE]; const int* rl = rowlist + (size_t)e * CAP;
            g8::Acc acc; g8::acc_zero(acc);
            g8::kloop_g(acc, smem, Tt, [&](int r) { int idx = mt * 256 + r; idx = idx < ce ? idx : ce - 1; return (rl[idx] >> 1) * D; }, GUT + ((size_t)e * 512 + nt * 256) * D, D, D, 0);
            const int t2 = tid_x(), wid = t2 >> 6, l2 = t2 & 63, wr2 = wid >> 2, wc2 = wid & 3, fr2 = l2 & 15, fq2 = l2 >> 4;
            int prs[2][4];
#pragma unroll
            for (int ai = 0; ai < 2; ++ai)
#pragma unroll
                for (int m = 0; m < 4; ++m) { const int idx = mt * 256 + ai * 128 + wr2 * 64 + m * 16 + fr2; prs[ai][m] = idx < ce ? rl[idx] : -1; }
#pragma unroll
            for (int ai = 0; ai < 2; ++ai)
#pragma unroll
                for (int m = 0; m < 4; ++m) {
                    if (prs[ai][m] >= 0) {
                        const int pair = prs[ai][m];
#pragma unroll
                        for (int bj = 0; bj < 2; ++bj) {
                            const f32x4 g = acc[ai][bj][m][0], u = acc[ai][bj][m][1];
                            u32x2 o; o.x = pk2(fsilu(g.x) * u.x, fsilu(g.y) * u.y); o.y = pk2(fsilu(g.z) * u.z, fsilu(g.w) * u.w);
                            *(u32x2*)(HID + (size_t)pair * DE + nt * 128 + bj * 64 + wc2 * 16 + fq2 * 4) = o;
                        }
                    }
                }
        }
        return;
    }
    const int ntile = pre[NEXP] * 4;
    for (int t = blockIdx.x; t < ntile; t += gridDim.x) {
        const int mg = t >> 2, nt = t & 3; int e = 0;
        while (pre[e + 1] <= mg) ++e;
        const int mt = mg - pre[e], ce = cnt[e * CNT_STRIDE]; const int* rl = rowlist + (size_t)e * CAP;
        f32x4 acc[MREP][4]; acc_zero(acc);
        gemm_kloop(acc, smem, [&](int i) { int idx = mt * BM + i; idx = idx < ce ? idx : ce - 1; return Tt + (size_t)(rl[idx] >> 1) * D; }, GUT + ((size_t)e * 512 + nt * 128) * D, D, D);
#pragma unroll
        for (int m = 0; m < MREP; ++m)
#pragma unroll
            for (int j = 0; j < 4; ++j) {
                const int idx = mt * BM + wr * 16 * MREP + m * 16 + fq * 4 + j;
                if (idx < ce) {
                    const int pair = rl[idx];
#pragma unroll
                    for (int n = 0; n < 2; ++n) {
                        const float g = acc[m][n][j], u = acc[m][n + 2][j];
                        HID[(size_t)pair * DE + nt * 64 + wc * 32 + n * 16 + fr] = f2bf(siluf_(g) * u);
                    }
                }
            }
    }
}
DI void phase9(const Params& p, char* smem) {
    const int tid = tid_x(), lane = tid & 63, wave = tid >> 6, wr = wave >> 1, wc = wave & 1, fr = lane & 15, fq = lane >> 4;
    int* pre = (int*)(smem + LDS_BYTES - 256);
    moe_tiles(p, smem, pre);
    const int* cnt = (const int*)(p.ws + WS_CNT); const int* rowlist = (const int*)(p.ws + WS_ROWLIST); const float* pairw = (const float*)(p.ws + WS_PAIRW);
    const bf16_t* HID = (const bf16_t*)(p.ws + WS_HID); const bf16_t* DNT = (const bf16_t*)(p.ws + WS_DNT); bf16_t* OP = (bf16_t*)(p.ws + WS_OPAIR);
    if (USE_G8) {
        constexpr int NT8 = D / 256;
        const int ntile8 = pre[NEXP] * NT8;
        for (int t = blockIdx.x; t < ntile8; t += gridDim.x) {
            const int mg = t / NT8, nt = t % NT8; int e = 0;
            while (pre[e + 1] <= mg) ++e;
            const int mt = mg - pre[e], ce = cnt[e * CNT_STRIDE]; const int* rl = rowlist + (size_t)e * CAP;
            g8::Acc acc; g8::acc_zero(acc);
            g8::kloop_g(acc, smem, HID, [&](int r) { int idx = mt * 256 + r; idx = idx < ce ? idx : ce - 1; return rl[idx] * DE; }, DNT + ((size_t)e * D + nt * 256) * DE, DE, DE, 0);
            {
                const int t2 = tid_x(), wid = t2 >> 6, l2 = t2 & 63, wr2 = wid >> 2, wc2 = wid & 3, fr2 = l2 & 15, fq2 = l2 >> 4;
                int prs[2][4]; float pws[2][4];
#pragma unroll
                for (int ai = 0; ai < 2; ++ai)
#pragma unroll
                    for (int m = 0; m < 4; ++m) { const int idx = mt * 256 + ai * 128 + wr2 * 64 + m * 16 + fr2; prs[ai][m] = idx < ce ? rl[idx] : -1; }
#pragma unroll
                for (int ai = 0; ai < 2; ++ai)
#pragma unroll
                    for (int m = 0; m < 4; ++m) pws[ai][m] = prs[ai][m] >= 0 ? pairw[prs[ai][m]] : 0.f;
#pragma unroll
                for (int ai = 0; ai < 2; ++ai)
#pragma unroll
                    for (int m = 0; m < 4; ++m) {
                        if (prs[ai][m] >= 0) {
                            const float w = pws[ai][m]; bf16_t* orow = OP + (size_t)prs[ai][m] * D + nt * 256 + wc2 * 32 + fq2 * 4;
#pragma unroll
                            for (int bj = 0; bj < 2; ++bj)
#pragma unroll
                                for (int n = 0; n < 2; ++n) { const f32x4 v = acc[ai][bj][m][n];
                                    u32x2 o; o.x = pk2(v.x * w, v.y * w); o.y = pk2(v.z * w, v.w * w); *(u32x2*)(orow + bj * 128 + n * 16) = o; }
                        }
                    }
            }
        }
        return;
    }
    constexpr int NT = D / 128;
    const int ntile = pre[NEXP] * NT;
    for (int t = blockIdx.x; t < ntile; t += gridDim.x) {
        const int mg = t / NT, nt = t % NT; int e = 0;
        while (pre[e + 1] <= mg) ++e;
        const int mt = mg - pre[e], ce = cnt[e * CNT_STRIDE]; const int* rl = rowlist + (size_t)e * CAP;
        f32x4 acc[MREP][4]; acc_zero(acc);
        gemm_kloop(acc, smem, [&](int i) { int idx = mt * BM + i; idx = idx < ce ? idx : ce - 1; return HID + (size_t)rl[idx] * DE; }, DNT + ((size_t)e * D + nt * 128) * DE, DE, DE);
#pragma unroll
        for (int m = 0; m < MREP; ++m)
#pragma unroll
            for (int j = 0; j < 4; ++j) {
                const int idx = mt * BM + wr * 16 * MREP + m * 16 + fq * 4 + j;
                if (idx < ce) {
                    const int pair = rl[idx]; const float w = pairw[pair];
#pragma unroll
                    for (int n = 0; n < 4; ++n) OP[(size_t)pair * D + nt * 128 + wc * 64 + n * 16 + fr] = f2bf(acc[m][n][j] * w);
                }
            }
    }
}

DI void phase10(const Params& p, char* smem) {
    const int lane = tid_x() & 63, wave = tid_x() >> 6;
    const int gw = blockIdx.x * 8 + wave, ngw = gridDim.x * 8;
    const float* Hh = (const float*)(p.ws + WS_H); const float* mod = (const float*)(p.ws + WS_MOD); const bf16_t* OP = (const bf16_t*)(p.ws + WS_OPAIR);
    for (int tok = gw; tok < T_LAT; tok += ngw) {
        const int b = tok / S;
        f32x4 x[D / 256]; float ss = 0.f;
#pragma unroll
        for (int j = 0; j < D / 256; ++j) {
            const int k = j * 256 + lane * 4;
            const f32x4 hv = *(const f32x4*)(Hh + (size_t)tok * D + k), g2 = *(const f32x4*)(mod + (size_t)b * 6 * D + 5 * D + k);
            const u32x2 p0 = *(const u32x2*)(OP + (size_t)(tok * 2) * D + k), p1 = *(const u32x2*)(OP + (size_t)(tok * 2 + 1) * D + k);
            f32x4 m;
            m.x = bf2f((bf16_t)(p0.x & 0xffffu)) + bf2f((bf16_t)(p1.x & 0xffffu)); m.y = bf2f((bf16_t)(p0.x >> 16)) + bf2f((bf16_t)(p1.x >> 16));
            m.z = bf2f((bf16_t)(p0.y & 0xffffu)) + bf2f((bf16_t)(p1.y & 0xffffu)); m.w = bf2f((bf16_t)(p0.y >> 16)) + bf2f((bf16_t)(p1.y >> 16));
            x[j].x = hv.x + g2.x * m.x; x[j].y = hv.y + g2.y * m.y; x[j].z = hv.z + g2.z * m.z; x[j].w = hv.w + g2.w * m.w;
            ss += x[j].x * x[j].x + x[j].y * x[j].y + x[j].z * x[j].z + x[j].w * x[j].w;
        }
        ss = wave_sum(ss);
        const float rstd = 1.0f / sqrtf(ss * (1.0f / D) + 1e-6f);
#pragma unroll
        for (int j = 0; j < D / 256; ++j) {
            const int k = j * 256 + lane * 4; const f32x4 g = *(const f32x4*)(p.in[I_FIN] + k);
            f32x4 o; o.x = x[j].x * rstd * g.x; o.y = x[j].y * rstd * g.y; o.z = x[j].z * rstd * g.z; o.w = x[j].w * rstd * g.w;
            *(f32x4*)(p.out + (size_t)tok * D + k) = o;
        }
    }
}

DI void run_phase(const Params& p, int ph, char* smem) {
    switch (ph) {
        case PH_MOD: phase0(p, smem); break;
        case PH_U: phase1(p, smem); break;
        case PH_P: phase2(p, smem); break;
        case PH_HALO: phase_halo(p, smem); break;
        case PH_FIR: phase_fir(p, smem); break;
        case PH_CHAINS: phase3(p, smem); break;
        case PH_POST: phase4(p, smem); break;
        case PH_MERGE: phase5(p, smem); break;
        case PH_WOUT: phase6(p, smem); break;
        case PH_ROUTER: phase7(p, smem); break;
        case PH_UP: phase8(p, smem); break;
        case PH_DOWN: phase9(p, smem); break;
        default: phase10(p, smem); break;
    }
}

#ifndef EMU
namespace cg = cooperative_groups;
#define XB_TMO      128
#define XB_XCNT(j)  (256  + 64 * (j))
#define XB_XSUB(j)  (1280 + 64 * (j))
#define XB_XGEN(j)  (2304 + 64 * (j))
#define XB_TOP      3328
#define XB_TOPGEN   3392
#define XB_SPIN_CAP (1u << 20)
DI unsigned xb_ld(unsigned* p) { return __hip_atomic_load(p, __ATOMIC_RELAXED, __HIP_MEMORY_SCOPE_AGENT); }
DI unsigned xb_add(unsigned* p, unsigned v) { return __hip_atomic_fetch_add(p, v, __ATOMIC_RELAXED, __HIP_MEMORY_SCOPE_AGENT); }
DI unsigned xb_xcc_id() { return (unsigned)__builtin_amdgcn_s_getreg((3 << 11) | 20) & 0xFu; }
#define XB_SPIN(cond, bar) do { unsigned _sp = 0; while (cond) { __builtin_amdgcn_s_sleep(1); \
    if ((++_sp & 255u) == 0u) { if (xb_ld(&(bar)[XB_TMO])) break; if (_sp > XB_SPIN_CAP) { atomicAdd(&(bar)[XB_TMO], 1u); break; } } } } while (0)
DI void xcd_barrier_post(unsigned* bar) { if (threadIdx.x == 0) (void)xb_add(&bar[XB_XCNT(xb_xcc_id())], 1u); }
DI void xcd_barrier_complete(unsigned* bar, unsigned x, unsigned& nloc, unsigned& nx) {
    const unsigned G = gridDim.x;
    unsigned sum, cnt, mine, sp = 0u;
    for (;;) {
        sum = 0u; cnt = 0u; mine = 0u;
#pragma unroll
        for (unsigned j = 0; j < 16; ++j) { const unsigned c = xb_ld(&bar[XB_XCNT(j)]); sum += c; cnt += (c > 0u) ? 1u : 0u; mine = (j == x) ? c : mine; }
        if (sum == G) break;
        __builtin_amdgcn_s_sleep(1);
        if ((++sp & 255u) == 0u) { if (xb_ld(&bar[XB_TMO])) break; if (sp > XB_SPIN_CAP) { atomicAdd(&bar[XB_TMO], 1u); break; } }
    }
    nloc = mine > 0u ? mine : 1u; nx = cnt > 0u ? cnt : 1u;
}
DI void xcd_barrier(unsigned* bar, volatile unsigned* st) {
    asm volatile("s_waitcnt vmcnt(0)" ::: "memory");
    __syncthreads();
    if (threadIdx.x == 0) {
        __builtin_amdgcn_s_waitcnt(0);
        const unsigned x = xb_xcc_id();
        unsigned nloc = st[0], nx = st[1];
        if (nloc == 0u) { xcd_barrier_complete(bar, x, nloc, nx); st[0] = nloc; st[1] = nx; }
        const unsigned old = xb_add(&bar[XB_XSUB(x)], 1u);
        const unsigned gen = old / nloc;
        if (old + 1u == (gen + 1u) * nloc) {
            __builtin_amdgcn_fence(__ATOMIC_RELEASE, "agent");
            asm volatile("s_waitcnt vmcnt(0)" ::: "memory");
            const unsigned og = xb_add(&bar[XB_TOP], 1u);
            const unsigned tg = og / nx;
            if (og + 1u == (tg + 1u) * nx) xb_add(&bar[XB_TOPGEN], 1u);
            else XB_SPIN(xb_ld(&bar[XB_TOPGEN]) == tg, bar);
            __builtin_amdgcn_fence(__ATOMIC_ACQUIRE, "agent");
            xb_add(&bar[XB_XGEN(x)], 1u);
            asm volatile("s_waitcnt vmcnt(0)" ::: "memory");
        } else {
            XB_SPIN(xb_ld(&bar[XB_XGEN(x)]) == gen, bar);
            __builtin_amdgcn_fence(__ATOMIC_ACQUIRE, "agent");
            asm volatile("s_waitcnt vmcnt(0)" ::: "memory");
        }
    }
    __syncthreads();
}
__global__ void __launch_bounds__(NTHREADS) mk_forward(Params p) {
    extern __shared__ __attribute__((aligned(16))) char smem[];
    cg::grid_group grid = cg::this_grid();
    typedef const Params __attribute__((address_space(4)))* KPtr;
    volatile unsigned* xst = (volatile unsigned*)(smem + LDS_BYTES);
    if (threadIdx.x < 2) xst[threadIdx.x] = 0u;
    if (p.ph_lo == 0x7fffffff) grid.sync();
    xcd_barrier_post((unsigned*)(p.ws + WS_XBAR));
#define PHASE(k, fn) { KPtr kp = (KPtr)__builtin_amdgcn_kernarg_segment_ptr(); asm volatile("" : "+s"(kp)); fn(*(const Params*)kp, smem); \
        unsigned* xbar = (unsigned*)(((const Params*)kp)->ws + WS_XBAR); \
        if ((k) + 1 < NPHASES) xcd_barrier(xbar, xst); }
    PHASE(0, phase0) PHASE(1, phase1) PHASE(2, phase2)
    if (!USE_G8) PHASE(3, phase_halo)
    PHASE(4, phase_fir) PHASE(5, phase3) PHASE(6, phase4)
    PHASE(7, phase5) PHASE(8, phase6) PHASE(9, phase7) PHASE(10, phase8) PHASE(11, phase9) PHASE(12, phase10)
#undef PHASE
}

extern "C" void kernel_launch(void* const* d_in, const int* in_sizes, int n_in, void* d_out, int out_size, void* d_ws, size_t ws_size, hipStream_t stream) {
    static int grid_blocks = 0;
    if (grid_blocks == 0) {
        if (n_in != 35 || out_size != T_LAT * D || ws_size < WS_END || (size_t)out_size * 4 < AUX_END) {
            fprintf(stderr, "kernel_launch: unexpected shapes (n_in %d out %d ws %zu need %zu aux need %zu)\n", n_in, out_size, ws_size, (size_t)WS_END, (size_t)AUX_END);
            grid_blocks = -1; return;
        }
        int dev = 0, cus = 0, per_cu = 0;
        hipGetDevice(&dev);
        hipDeviceGetAttribute(&cus, hipDeviceAttributeMultiprocessorCount, dev);
        hipFuncSetAttribute((const void*)mk_forward, hipFuncAttributeMaxDynamicSharedMemorySize, LDS_BYTES + 256);
        hipOccupancyMaxActiveBlocksPerMultiprocessor(&per_cu, (const void*)mk_forward, NTHREADS, LDS_BYTES + 256);
        if (per_cu < 1) { fprintf(stderr, "kernel_launch: occupancy query says %d blocks/CU\n", per_cu); per_cu = 1; }
        if (per_cu > 1) per_cu = 1;
        grid_blocks = cus * per_cu;
    }
    if (grid_blocks < 0) return;
    Params p{};
    for (int i = 0; i < 35; ++i) p.in[i] = (const float*)d_in[i];
    p.out = (float*)d_out; p.ws = (char*)d_ws; p.aux = (char*)d_out;
    p.ph_lo = 0; p.ph_hi = NPHASES;
    (void)hipMemsetAsync((char*)d_ws + WS_XBAR, 0, 3456 * 4, stream);
    void* args[] = {&p};
    hipError_t e = hipLaunchCooperativeKernel((const void*)mk_forward, dim3(grid_blocks), dim3(NTHREADS), args, LDS_BYTES + 256, stream);
    if (e != hipSuccess) fprintf(stderr, "cooperative launch failed: %s (grid %d)\n", hipGetErrorString(e), grid_blocks);
}
#endif
```

```cpp
#ifndef EMU
#include <hip/hip_runtime.h>
#include <hip/hip_cooperative_groups.h>
#include <cstdio>
#endif
#include <stdint.h>
#include <stddef.h>

#ifndef CFG_D
#define CFG_D 1024
#define CFG_B 8
#define CFG_S 2048
#define CFG_CTX 256
#endif
#ifndef MK_LAUNCHES
#define MK_LAUNCHES 1
#endif

typedef unsigned short bf16_t;
typedef short bf16x8 __attribute__((ext_vector_type(8)));
typedef float f32x4 __attribute__((ext_vector_type(4)));
typedef unsigned u32x4 __attribute__((ext_vector_type(4)));
typedef unsigned u32x2 __attribute__((ext_vector_type(2)));

#define DI __device__ __forceinline__
DI int tid_x() { int t = (int)threadIdx.x;
#ifndef EMU
    asm volatile("" : "+v"(t));
#endif
    return t; }

constexpr int D = CFG_D, NB = CFG_B, S = CFG_S, CTXL = CFG_CTX;
constexpr int GW = 64, ROWS = S / GW;
constexpr int T_CTX = NB * CTXL, T_LAT = NB * S, T_ALL = T_CTX + T_LAT;
constexpr int H_A = 4, H_B = 8;
constexpr int A_COLS = 2064, B_COLS = 1920;
constexpr int IN_COLS = A_COLS + B_COLS + 2 * D;
constexpr int COL_B0 = A_COLS, COL_G0 = A_COLS + B_COLS;
constexpr int CTX_COLS = COL_G0;
constexpr int NP = ((IN_COLS + 127) / 128) * 128;
constexpr int NEXP = 32, DE = 256;
constexpr int NV = NB + 1;
constexpr int NTHREADS = 512;
constexpr int MREP = (T_CTX % 256 == 0 && T_LAT % 256 == 0) ? 4 : 2;
constexpr int BM = 64 * MREP;
constexpr int NPHASES = 13;
enum { PH_MOD = 0, PH_U, PH_P, PH_HALO, PH_FIR, PH_CHAINS, PH_POST, PH_MERGE, PH_WOUT, PH_ROUTER, PH_UP, PH_DOWN, PH_FINAL };
constexpr int LDS_BYTES = 155648;
constexpr int CAP = T_LAT;

static_assert(D % 256 == 0 && S % 64 == 0 && CTXL % 64 == 0 && T_CTX % BM == 0 && T_LAT % BM == 0, "shape");

constexpr size_t al256(size_t x) { return (x + 255) & ~(size_t)255; }
constexpr int CNT_STRIDE = 64;
constexpr size_t WS_CNT = 512 + 3456 * 4 + 256;
constexpr int CNT_TICKET = 2 * CNT_STRIDE + 16, CNT_U2DONE = 3 * CNT_STRIDE + 16;
constexpr size_t WS_BAR = 256;
constexpr size_t WS_XBAR = 512;
constexpr size_t WS_MOD = 512 + 3456 * 4 + 256 + 32 * 64 * 4;
constexpr size_t WS_AB = al256(WS_MOD + (size_t)NV * 6 * D * 4);
constexpr size_t WS_BONUS = al256(WS_AB + (size_t)T_ALL * 16 * 4);
constexpr size_t WS_PAIRW = al256(WS_BONUS + (size_t)2 * T_LAT * 8 * 4);
constexpr size_t WS_ROWLIST = al256(WS_PAIRW + (size_t)T_LAT * 2 * 4);
constexpr size_t WS_WRT = al256(WS_ROWLIST + (size_t)NEXP * CAP * 4);
constexpr size_t WS_G2T = al256(WS_WRT + (size_t)36 * D * 4);
constexpr size_t WS_WOA = al256(WS_G2T + (size_t)512 * 128 * 2);
constexpr size_t WS_WOB = al256(WS_WOA + (size_t)D * 512 * 2);
constexpr size_t WS_WOUT = al256(WS_WOB + (size_t)D * 512 * 2);
constexpr size_t WS_OA = al256(WS_WOUT + (size_t)D * D * 2);
constexpr size_t WS_OB = al256(WS_OA + (size_t)T_LAT * 512 * 2);
constexpr size_t WS_HALO_A = WS_OA;
constexpr size_t WS_HALO_B = WS_OA + al256((size_t)(T_ALL / 64) * 4 * 1536 * 2);
static_assert(WS_HALO_B + (size_t)(T_ALL / 64) * 2 * 1920 * 2 <= WS_OB + (size_t)T_LAT * 512 * 2, "halo buffers");
constexpr size_t WS_DNT = WS_OA;
constexpr size_t WS_SPARE_END = al256(WS_OB + (size_t)T_LAT * 512 * 2) > al256(WS_DNT + (size_t)NEXP * D * DE * 2) ? al256(WS_OB + (size_t)T_LAT * 512 * 2) : al256(WS_DNT + (size_t)NEXP * D * DE * 2);
constexpr size_t WS_P = WS_SPARE_END;
constexpr size_t WS_PLAT = WS_P;
constexpr size_t WS_PCTX = al256(WS_PLAT + (size_t)T_LAT * IN_COLS * 2);
constexpr size_t WS_P_END = al256(WS_PCTX + (size_t)T_CTX * CTX_COLS * 2);
constexpr size_t WS_H = WS_P;
constexpr size_t WS_T = al256(WS_H + (size_t)T_LAT * D * 4);
constexpr size_t WS_HID = al256(WS_T + (size_t)T_LAT * D * 2);
constexpr size_t WS_OPAIR = al256(WS_HID + (size_t)T_LAT * 2 * DE * 2);
constexpr size_t WS_P2_END = al256(WS_OPAIR + (size_t)T_LAT * 2 * D * 2);
constexpr size_t WS_END = WS_P_END > WS_P2_END ? WS_P_END : WS_P2_END;
constexpr size_t AUX_WINT = 0;
constexpr size_t AUX_U = al256((size_t)NP * D * 2);
constexpr size_t AUX_YDIR = 0;
constexpr size_t AUX_Y = 0;
constexpr size_t AUX_GUT = (size_t)T_LAT * D * 2 > (size_t)2 * T_LAT * 512 * 2 ? (size_t)T_LAT * D * 2 : (size_t)2 * T_LAT * 512 * 2;
constexpr size_t AUX_END1 = AUX_U + (size_t)T_ALL * D * 2;
constexpr size_t AUX_END2 = AUX_YDIR + (size_t)2 * T_LAT * 512 * 2;
static_assert(AUX_YDIR + (size_t)2 * T_LAT * 512 * 2 <= AUX_GUT && AUX_Y + (size_t)T_LAT * D * 2 <= AUX_GUT, "aux overlap");
constexpr size_t AUX_END3 = AUX_GUT + (size_t)NEXP * 512 * D * 2;
constexpr size_t AUX_END = (AUX_END1 > AUX_END2 ? (AUX_END1 > AUX_END3 ? AUX_END1 : AUX_END3) : (AUX_END2 > AUX_END3 ? AUX_END2 : AUX_END3));

struct Params {
    const float* in[35];
    float* out;
    char* ws;
    char* aux;
    int ph_lo, ph_hi;
};
enum { I_X = 0, I_C, I_CTX, I_CCTX, I_ADAW, I_ADAB, I_NMIX, I_NFFN, I_WIN, I_CONV, I_ALOG, I_DTB, I_ONORM, I_MU, I_W0, I_W2, I_A0, I_A2, I_G2, I_KK, I_KA, I_RK, I_LNG, I_LNB, I_WOA, I_WOB, I_WOUT, I_RG, I_RGB, I_RE, I_REB, I_MG, I_MU_UP, I_MD, I_FIN };

DI float bf2f(bf16_t v) { union { unsigned u; float f; } x; x.u = ((unsigned)v) << 16; return x.f; }
#ifdef EMU
DI bf16_t f2bf(float f) { union { float f; unsigned u; } x; x.f = f; unsigned u = x.u; u += 0x7fffu + ((u >> 16) & 1u); return (bf16_t)(u >> 16); }
DI unsigned pk2(float lo, float hi) { return (unsigned)f2bf(lo) | ((unsigned)f2bf(hi) << 16); }
#else
typedef __bf16 hbf16x2 __attribute__((ext_vector_type(2)));
typedef float f32x2_ __attribute__((ext_vector_type(2)));
DI bf16_t f2bf(float f) { return __builtin_bit_cast(unsigned short, (__bf16)f); }
DI unsigned pk2(float lo, float hi) { const f32x2_ v = {lo, hi}; return __builtin_bit_cast(unsigned, __builtin_convertvector(v, hbf16x2)); }
#endif
DI float sigmoidf_(float x) { return 1.0f / (1.0f + expf(-x)); }
DI float siluf_(float x) { return x / (1.0f + expf(-x)); }
DI float softplusf_(float x) { return x > 20.f ? x : log1pf(expf(x)); }
DI float wave_sum(float v) {
#pragma unroll
    for (int o = 1; o < 64; o <<= 1) v += __shfl_xor(v, o);
    return v;
}
#ifdef EMU
#define MFMA16(a, b, c) emu_mfma16((a), (b), (c))
#define WAVE_SYNC() emu::wave_bar()
#else
#define MFMA16(a, b, c) __builtin_amdgcn_mfma_f32_16x16x32_bf16((a), (b), (c), 0, 0, 0)
#define WAVE_SYNC() asm volatile("s_waitcnt lgkmcnt(0)" ::: "memory")
#endif
#ifdef EMU
#define LDS_BARRIER() __syncthreads()
#else
#define LDS_BARRIER() do { asm volatile("s_waitcnt lgkmcnt(0)" ::: "memory"); __builtin_amdgcn_s_barrier(); asm volatile("" ::: "memory"); } while (0)
#endif

typedef float f32x16 __attribute__((ext_vector_type(16)));
typedef float f32x2_ac __attribute__((ext_vector_type(2)));
typedef short bf16x4 __attribute__((ext_vector_type(4)));
#ifdef EMU
#define MFMA32(a, b, c) emu_mfma32((a), (b), (c))
DI float fexp(float x) { return expf(x); }
DI float flog(float x) { return logf(x); }
DI float frcp(float x) { return 1.0f / x; }
DI float frsq(float x) { return 1.0f / sqrtf(x); }
DI float wave_sum_fast(float v) { return wave_sum(v); }
#else
#define MFMA32(a, b, c) __builtin_amdgcn_mfma_f32_32x32x16_bf16((a), (b), (c), 0, 0, 0)
DI float fexp(float x) { return __expf(x); }
DI float flog(float x) { return __logf(x); }
DI float frcp(float x) { return __builtin_amdgcn_rcpf(x); }
DI float frsq(float x) { return __builtin_amdgcn_rsqf(x); }
#define DPP_ADD(v, ctrl) ((v) + __builtin_bit_cast(float, __builtin_amdgcn_update_dpp(0, __builtin_bit_cast(int, (v)), (ctrl), 0xf, 0xf, false)))
DI float wave_sum_fast(float v) {
    v = DPP_ADD(v, 0xB1); v = DPP_ADD(v, 0x4E); v = DPP_ADD(v, 0x141); v = DPP_ADD(v, 0x140);
    const int iv = __builtin_bit_cast(int, v);
    return (__builtin_bit_cast(float, __builtin_amdgcn_readlane(iv, 0)) + __builtin_bit_cast(float, __builtin_amdgcn_readlane(iv, 16))) +
           (__builtin_bit_cast(float, __builtin_amdgcn_readlane(iv, 32)) + __builtin_bit_cast(float, __builtin_amdgcn_readlane(iv, 48)));
}
#endif
DI float fsigmoid(float x) { return frcp(1.0f + fexp(-x)); }
DI float fsilu(float x) { return x * fsigmoid(x); }
DI float fsoftplus(float x) { return fmaxf(x, 0.f) + flog(1.f + fexp(-fabsf(x))); }
DI float ftanh(float x) { return 1.0f - 2.0f * frcp(1.0f + fexp(2.0f * x)); }

constexpr int LDS_ROW = 40;
constexpr int GEMM_A_BYTES = BM * LDS_ROW * 2, GEMM_B_BYTES = 128 * LDS_ROW * 2;
template <int MR, class ARow>
DI void gemm_kloop(f32x4 (&acc)[MR][4], char* smem, ARow arow, const bf16_t* Bt, int ldb, int K) {
    constexpr int BM = 64 * MR;
    const int tid = tid_x(), lane = tid & 63, wave = tid >> 6, wr = wave >> 1, wc = wave & 1, fr = lane & 15, fq = lane >> 4;
    bf16_t* As = (bf16_t*)smem;
    bf16_t* Bs = (bf16_t*)(smem + 2 * GEMM_A_BYTES);
    constexpr int ACH = BM * 4 / NTHREADS;
    static_assert(ACH >= 1, "tile");
    const bf16_t* ap[ACH];
#pragma unroll
    for (int i = 0; i < ACH; ++i) { const int q = tid + i * NTHREADS; ap[i] = arow(q >> 2) + (q & 3) * 8; }
    const bf16_t* bp = Bt + (size_t)(tid >> 2) * ldb + (tid & 3) * 8;
    u32x4 ra[ACH], rb;
#pragma unroll
    for (int i = 0; i < ACH; ++i) ra[i] = *(const u32x4*)(ap[i]);
    rb = *(const u32x4*)(bp);
    const int nk = K / 32;
    for (int kt = 0; kt < nk; ++kt) {
        const int buf = kt & 1;
#pragma unroll
        for (int i = 0; i < ACH; ++i) { const int q = tid + i * NTHREADS; *(u32x4*)(As + (buf * BM + (q >> 2)) * LDS_ROW + (q & 3) * 8) = ra[i]; }
        *(u32x4*)(Bs + (buf * 128 + (tid >> 2)) * LDS_ROW + (tid & 3) * 8) = rb;
        __syncthreads();
        if (kt + 1 < nk) {
#pragma unroll
            for (int i = 0; i < ACH; ++i) ra[i] = *(const u32x4*)(ap[i] + (kt + 1) * 32);
            rb = *(const u32x4*)(bp + (kt + 1) * 32);
        }
        bf16x8 af[MR], bfr[4];
#pragma unroll
        for (int m = 0; m < MR; ++m) af[m] = *(const bf16x8*)(As + (buf * BM + wr * 16 * MR + m * 16 + fr) * LDS_ROW + fq * 8);
#pragma unroll
        for (int n = 0; n < 4; ++n) bfr[n] = *(const bf16x8*)(Bs + (buf * 128 + wc * 64 + n * 16 + fr) * LDS_ROW + fq * 8);
#pragma unroll
        for (int m = 0; m < MR; ++m)
#pragma unroll
            for (int n = 0; n < 4; ++n) acc[m][n] = MFMA16(af[m], bfr[n], acc[m][n]);
    }
    __syncthreads();
}
template <int MR>
DI void acc_zero(f32x4 (&acc)[MR][4]) {
#pragma unroll
    for (int m = 0; m < MR; ++m)
#pragma unroll
        for (int n = 0; n < 4; ++n) acc[m][n] = (f32x4){0.f, 0.f, 0.f, 0.f};
}

namespace g8 {
constexpr int BM = 256, BK = 64, HALF = 128, HT = HALF * BK;
constexpr int LDS_NEED = 8 * HT * 2;
DI int lds_byte(int r, int c) { const int st = (r >> 4) * 2 + (c >> 5), rr = r & 15, cc = c & 31, ob = rr * 64 + cc * 2; return st * 1024 + (ob ^ (((ob >> 9) & 1) << 5)); }
DI void stage_rc(int b, int& R, int& C) { const int st = b / 1024, sb = b % 1024, swz = sb ^ (((sb >> 9) & 1) << 5); R = (st >> 1) * 16 + swz / 64; C = (st & 1) * 32 + (swz % 64) / 2; }
#ifdef EMU
#define G8_GLDS(src, dst) emu_global_load_lds16((src), (dst))
#define G8_WAIT_V(n)
#define G8_WAIT_L(n)
#define G8_BAR __syncthreads()
#define G8_SCHED
#define G8_PRIO(x)
#else
#define G8_GLDS(src, dst) __builtin_amdgcn_global_load_lds((const unsigned*)(src), (__attribute__((address_space(3))) unsigned*)(dst), 16, 0, 0)
#define G8_WAIT_V(n) asm volatile("s_waitcnt vmcnt(" #n ")" ::: "memory")
#define G8_WAIT_L(n) asm volatile("s_waitcnt lgkmcnt(" #n ")" ::: "memory")
#define G8_BAR __builtin_amdgcn_s_barrier()
#define G8_SCHED __builtin_amdgcn_sched_barrier(0)
#define G8_PRIO(x) __builtin_amdgcn_s_setprio(x)
#endif
typedef f32x4 Acc[2][2][4][2];
template <class AOff>
DI void kloop_g(Acc& acc, char* smem, const bf16_t* A, AOff aoff, const bf16_t* Bt, int ldb, int K, int bcol) {
    bf16_t* shm = (bf16_t*)smem;
    const int tid = tid_x(), wid = tid >> 6, lane = tid & 63, wr = wid >> 2, wc = wid & 3, fr = lane & 15, fq = lane >> 4;
    int ao[2][2];
#pragma unroll
    for (int h = 0; h < 2; ++h)
#pragma unroll
        for (int i = 0; i < 2; ++i) { int R, C; stage_rc(tid * 16 + i * 8192, R, C); ao[h][i] = aoff(h * HALF + R) + C; }
#define G8_STAGE_A(P, h, kt) do { for (int _i = 0; _i < 2; ++_i) { const int _b = tid * 16 + _i * 8192; G8_GLDS(A + (size_t)ao[h][_i] + (size_t)(kt) * BK, (char*)(P) + _b); } } while (0)
#define G8_SA(b, h) (shm + ((b) * 2 + (h)) * HT)
#define G8_SB(b, h) (shm + (4 + (b) * 2 + (h)) * HT)
#define G8_STAGE(P, BASE, LD, br, kt) do { const bf16_t* _g = (BASE) + (size_t)(br) * (LD) + (size_t)(kt) * BK; \
    for (int _i = 0; _i < 2; ++_i) { const int _b = tid * 16 + _i * 8192; int _r, _c; stage_rc(_b, _r, _c); G8_GLDS(_g + (size_t)_r * (LD) + _c, (char*)(P) + _b); } } while (0)
#define G8_LDA(dst, b, h) for (int m = 0; m < 4; ++m) for (int k = 0; k < 2; ++k) dst[m][k] = *(const bf16x8*)((const char*)G8_SA(b, h) + lds_byte(wr * 64 + m * 16 + fr, k * 32 + fq * 8))
#define G8_LDB(dst, b, h) for (int n = 0; n < 2; ++n) for (int k = 0; k < 2; ++k) dst[n][k] = *(const bf16x8*)((const char*)G8_SB(b, h) + lds_byte(wc * 32 + n * 16 + fr, k * 32 + fq * 8))
#define G8_MMA(ai, bj, At_, Bt_) do { G8_PRIO(1); for (int m = 0; m < 4; ++m) for (int n = 0; n < 2; ++n) for (int k = 0; k < 2; ++k) \
    acc[ai][bj][m][n] = MFMA16(Bt_[n][k], At_[m][k], acc[ai][bj][m][n]); G8_PRIO(0); } while (0)
    bf16x8 At[4][2], B0[2][2], B1[2][2];
    const int nt = K / BK;
    G8_STAGE(G8_SB(0, 0), Bt, ldb, bcol, 0); G8_STAGE_A(G8_SA(0, 0), 0, 0);
    G8_STAGE(G8_SB(0, 1), Bt, ldb, bcol + HALF, 0); G8_STAGE_A(G8_SA(0, 1), 1, 0);
    if (wr == 1) G8_BAR;
    G8_WAIT_V(4); G8_BAR;
    G8_STAGE(G8_SB(1, 0), Bt, ldb, bcol, 1); G8_STAGE_A(G8_SA(1, 0), 0, 1); G8_STAGE(G8_SB(1, 1), Bt, ldb, bcol + HALF, 1);
    G8_WAIT_V(6); G8_BAR;
    for (int t = 0; t < nt - 2; t += 2) {
        G8_LDB(B0, 0, 0); G8_SCHED; G8_LDA(At, 0, 0); G8_STAGE_A(G8_SA(1, 1), 1, t + 1);
        G8_WAIT_L(8); G8_BAR; G8_WAIT_L(0); G8_MMA(0, 0, At, B0); G8_BAR; G8_SCHED;
        G8_LDB(B1, 0, 1); G8_STAGE(G8_SB(0, 0), Bt, ldb, bcol, t + 2);
        G8_BAR; G8_WAIT_L(0); G8_MMA(0, 1, At, B1); G8_BAR;
        G8_LDA(At, 0, 1); G8_STAGE_A(G8_SA(0, 0), 0, t + 2);
        G8_BAR; G8_WAIT_L(0); G8_MMA(1, 0, At, B0); G8_BAR; G8_SCHED;
        G8_STAGE(G8_SB(0, 1), Bt, ldb, bcol + HALF, t + 2);
        G8_WAIT_V(6); G8_BAR; G8_MMA(1, 1, At, B1); G8_BAR;
        G8_LDB(B0, 1, 0); G8_SCHED; G8_LDA(At, 1, 0); G8_STAGE_A(G8_SA(0, 1), 1, t + 2);
        G8_WAIT_L(8); G8_BAR; G8_WAIT_L(0); G8_MMA(0, 0, At, B0); G8_BAR; G8_SCHED;
        G8_LDB(B1, 1, 1); G8_STAGE(G8_SB(1, 0), Bt, ldb, bcol, t + 3);
        G8_BAR; G8_WAIT_L(0); G8_MMA(0, 1, At, B1); G8_BAR;
        G8_LDA(At, 1, 1); G8_STAGE_A(G8_SA(1, 0), 0, t + 3);
        G8_BAR; G8_WAIT_L(0); G8_MMA(1, 0, At, B0); G8_BAR; G8_SCHED;
        G8_STAGE(G8_SB(1, 1), Bt, ldb, bcol + HALF, t + 3);
        G8_WAIT_V(6); G8_BAR; G8_MMA(1, 1, At, B1); G8_BAR;
    }
    { G8_LDB(B0, 0, 0); G8_LDA(At, 0, 0); G8_STAGE_A(G8_SA(1, 1), 1, nt - 1);
      G8_BAR; G8_WAIT_L(0); G8_MMA(0, 0, At, B0); G8_BAR;
      G8_LDB(B1, 0, 1); G8_BAR; G8_WAIT_L(0); G8_MMA(0, 1, At, B1); G8_BAR;
      G8_LDA(At, 0, 1); G8_WAIT_V(4); G8_BAR; G8_WAIT_L(0); G8_MMA(1, 0, At, B0); G8_MMA(1, 1, At, B1); G8_BAR; }
    { G8_LDB(B0, 1, 0); G8_LDA(At, 1, 0); G8_WAIT_V(2); G8_BAR; G8_WAIT_L(0); G8_MMA(0, 0, At, B0); G8_BAR;
      G8_LDB(B1, 1, 1); G8_WAIT_V(0); G8_BAR; G8_WAIT_L(0); G8_MMA(0, 1, At, B1); G8_BAR;
      G8_LDA(At, 1, 1); G8_BAR; G8_WAIT_L(0); G8_MMA(1, 0, At, B0); G8_MMA(1, 1, At, B1); G8_BAR; }
    if (wr == 0) G8_BAR;
#undef G8_SA
#undef G8_SB
#undef G8_STAGE
#undef G8_STAGE_A
#undef G8_LDA
#undef G8_LDB
#undef G8_MMA
}
DI void kloop(Acc& acc, char* smem, const bf16_t* A, int lda, const bf16_t* Bt, int ldb, int K, int brow, int bcol) {
    kloop_g(acc, smem, A, [&](int r) { return (brow + r) * lda; }, Bt, ldb, K, bcol);
}
DI bool tile_order(int L, int nM, int nN, int& pm, int& pn) {
    constexpr int NXCD = 8, WGM = 8;
    const int nwg = nM * nN; if (L >= nwg) return false;
    int wgid = L; { const int q = nwg / NXCD, r = nwg % NXCD, xcd = wgid % NXCD, off = wgid / NXCD; wgid = (xcd < r ? xcd * (q + 1) : r * (q + 1) + (xcd - r) * q) + off; }
    const int nig = WGM * nN, gid = wgid / nig, fm = gid * WGM, gsz = (nM - fm) < WGM ? (nM - fm) : WGM;
    pm = fm + ((wgid % nig) % gsz); pn = (wgid % nig) / gsz; return true;
}
DI void acc_zero(Acc& acc) {
#pragma unroll
    for (int a = 0; a < 2; ++a)
#pragma unroll
        for (int b = 0; b < 2; ++b)
#pragma unroll
            for (int m = 0; m < 4; ++m)
#pragma unroll
                for (int n = 0; n < 2; ++n) acc[a][b][m][n] = (f32x4){0.f, 0.f, 0.f, 0.f};
}
template <class F> DI void for_each_quad(const Acc& acc, int brow, int bcol, F f) {
    const int tid = tid_x(), wid = tid >> 6, lane = tid & 63, wr = wid >> 2, wc = wid & 3, fr = lane & 15, fq = lane >> 4;
#pragma unroll
    for (int ai = 0; ai < 2; ++ai)
#pragma unroll
        for (int m = 0; m < 4; ++m)
#pragma unroll
            for (int bj = 0; bj < 2; ++bj)
#pragma unroll
                for (int n = 0; n < 2; ++n) f(brow + ai * HALF + wr * 64 + m * 16 + fr, bcol + bj * HALF + wc * 32 + n * 16 + fq * 4, acc[ai][bj][m][n]);
}
}

constexpr bool USE_G8 = ((NB * CTXL) % 256 == 0) && ((NB * S) % 256 == 0) && (NP % 256 == 0) && (D % 256 == 0) && (D >= 256);
DI int gu_row(int c, int up) {
    if (USE_G8) return (c >> 7) * 256 + ((c >> 6) & 1) * 128 + ((c >> 4) & 3) * 32 + (up ? 16 : 0) + (c & 15);
    return (c >> 6) * 128 + ((c >> 5) & 1) * 64 + ((c >> 4) & 1) * 16 + (c & 15) + (up ? 32 : 0);
}
DI void transpose_item(const float* W, int N, int Nvalid, int k0, int n0, bf16_t* WT, int ldt, int mode, float* scr, int lane) {
    float tv[32];
#pragma unroll
    for (int i = 0; i < 32; ++i) {
        const int kk = 2 * i + (lane >> 5), n = n0 + (lane & 31);
        tv[i] = (n < Nvalid) ? W[(size_t)(k0 + kk) * N + n] : 0.f;
    }
#pragma unroll
    for (int i = 0; i < 32; ++i) scr[(2 * i + (lane >> 5)) * 33 + (lane & 31)] = tv[i];
    WAVE_SYNC();
    const int c = lane & 7;
#pragma unroll
    for (int j = 0; j < 4; ++j) {
        const int nl = (lane >> 3) + 8 * j; const float* s = scr + (8 * c) * 33 + nl;
        u32x4 o; o.x = pk2(s[0], s[33]); o.y = pk2(s[2 * 33], s[3 * 33]); o.z = pk2(s[4 * 33], s[5 * 33]); o.w = pk2(s[6 * 33], s[7 * 33]);
        const int n = n0 + nl; const int row = mode == 0 ? n : gu_row(n, mode == 2);
        *(u32x4*)(WT + (size_t)row * ldt + k0 + 8 * c) = o;
    }
    WAVE_SYNC();
}
DI void transpose_matrix(const float* W, int K, int N, int Npad, bf16_t* WT, int mode, char* smem, int gw, int ngw, int& base) {
    const int lane = tid_x() & 63, wave = tid_x() >> 6;
    float* scr = (float*)smem + wave * (64 * 33);
    const int nkb = K / 64, nnb = Npad / 32, nitems = nkb * nnb;
    int first = ((gw - base) % ngw + ngw) % ngw;
    for (int it = first; it < nitems; it += ngw) {
        const int kb = it / nnb, nb = it % nnb;
        transpose_item(W, N, N, kb * 64, nb * 32, WT, K, mode, scr, lane);
    }
    base = (base + nitems) % ngw;
}

DI void phase0(const Params& p, char* smem) {
    const int tid = tid_x(), lane = tid & 63, wave = tid >> 6;
    if (blockIdx.x == 0 && tid < NEXP) ((int*)(p.ws + WS_CNT))[tid * CNT_STRIDE] = 0;
    if (blockIdx.x == 0 && tid < 2) ((int*)(p.ws + WS_CNT))[tid ? CNT_U2DONE : CNT_TICKET] = 0;
    if (blockIdx.x == 0 && tid == 0) *(unsigned*)(p.ws + WS_BAR) = 0u;
    float* sil = (float*)smem;
    float* red = sil + NV * D;
    const int nitems = 6 * D / 32;
    bool did = false;
    for (int it = blockIdx.x; it < nitems; it += gridDim.x) {
        if (!did) {
            for (int i = tid; i < NV * D; i += NTHREADS) { const int v = i / D, k = i % D; const float cv = v < NB ? p.in[I_C][v * D + k] : p.in[I_CCTX][k]; sil[i] = siluf_(cv); }
            did = true;
        }
        __syncthreads();
        const int col = it * 32 + (lane & 31), rp = lane >> 5;
        float acc[NV];
#pragma unroll
        for (int v = 0; v < NV; ++v) acc[v] = 0.f;
        const int r0 = wave * (D / 8);
        float wv[D / 16];
#pragma unroll
        for (int i = 0; i < D / 16; ++i) wv[i] = p.in[I_ADAW][(size_t)(r0 + 2 * i + rp) * (6 * D) + col];
#pragma unroll
        for (int i = 0; i < D / 16; ++i) {
            const int row = r0 + 2 * i + rp;
#pragma unroll
            for (int v = 0; v < NV; ++v) acc[v] += sil[v * D + row] * wv[i];
        }
#pragma unroll
        for (int v = 0; v < NV; ++v) red[((wave * 2 + rp) * NV + v) * 32 + (lane & 31)] = acc[v];
        __syncthreads();
        if (tid < NV * 32) {
            const int v = tid / 32, cl = tid % 32; float s = p.in[I_ADAB][it * 32 + cl];
            for (int g = 0; g < 16; ++g) s += red[(g * NV + v) * 32 + cl];
            ((float*)(p.ws + WS_MOD))[(size_t)v * 6 * D + it * 32 + cl] = s;
        }
    }
    __syncthreads();
    const int gw = blockIdx.x * 8 + wave, ngw = gridDim.x * 8; int base = 0;
    {
        float* scr = (float*)smem + wave * (64 * 33);
        const int nkb = D / 64, nnb = NP / 32, nitems2 = nkb * nnb;
        for (int it = gw; it < nitems2; it += ngw) { const int kb = it / nnb, nb = it % nnb; transpose_item(p.in[I_WIN], IN_COLS, IN_COLS, kb * 64, nb * 32, (bf16_t*)(p.aux + AUX_WINT), D, 0, scr, lane); }
        base = nitems2 % ngw;
    }
    { float* WRT = (float*)(p.ws + WS_WRT);
      for (int i = blockIdx.x * NTHREADS + tid; i < 36 * D; i += gridDim.x * NTHREADS) { const int j = i / D, k = i % D; WRT[i] = j < 4 ? p.in[I_RG][(size_t)k * 4 + j] : p.in[I_RE][(size_t)k * 32 + (j - 4)]; } }
    transpose_matrix(p.in[I_WOA], 512, D, D, (bf16_t*)(p.ws + WS_WOA), 0, smem, gw, ngw, base);
    transpose_matrix(p.in[I_WOB], 512, D, D, (bf16_t*)(p.ws + WS_WOB), 0, smem, gw, ngw, base);
    transpose_matrix(p.in[I_WOUT], D, D, D, (bf16_t*)(p.ws + WS_WOUT), 0, smem, gw, ngw, base);
    transpose_matrix(p.in[I_G2], 128, 512, 512, (bf16_t*)(p.ws + WS_G2T), 0, smem, gw, ngw, base);
}

constexpr int NSEG = T_ALL / 64, NSEG_CTX = T_CTX / 64;
DI void halo_store(const Params& p, int row, int col, const u32x2& o) {
    int seq, b, j;
    if (row < T_CTX) { seq = 0; b = row / CTXL; j = row % CTXL; } else { seq = 1; const int rr = row - T_CTX; b = rr / S; j = rr % S; }
    const int L = seq ? S : CTXL; const int segbase = seq ? NSEG_CTX + b * (S / 64) : b * (CTXL / 64);
    if (col < 1536) {
        const int jm = j & 63;
        if (jm >= 62 && j + 2 < L) { const int g = segbase + (j >> 6) + 1; *(u32x2*)((bf16_t*)(p.ws + WS_HALO_A) + ((size_t)g * 4 + (jm - 62)) * 1536 + col) = o; }
        if (jm < 2 && j >= 64) { const int g = segbase + (j >> 6) - 1; *(u32x2*)((bf16_t*)(p.ws + WS_HALO_A) + ((size_t)g * 4 + 2 + jm) * 1536 + col) = o; }
    } else if (col >= COL_B0 && col < COL_B0 + 1920) {
        const int js = seq ? (j % GW) * ROWS + j / GW : j; const int jm = js & 63;
        if (jm == 63 && js + 1 < L) { const int g = segbase + (js >> 6) + 1; *(u32x2*)((bf16_t*)(p.ws + WS_HALO_B) + ((size_t)g * 2 + 0) * 1920 + (col - COL_B0)) = o; }
        if (jm == 0 && js >= 64) { const int g = segbase + (js >> 6) - 1; *(u32x2*)((bf16_t*)(p.ws + WS_HALO_B) + ((size_t)g * 2 + 1) * 1920 + (col - COL_B0)) = o; }
    }
}
DI void halo_zero_fill(const Params& p) {
    const int tid = tid_x(), lane = tid & 63, wave = tid >> 6; const int gw = blockIdx.x * 8 + wave, ngw = gridDim.x * 8;
    bf16_t* HA = (bf16_t*)(p.ws + WS_HALO_A); bf16_t* HB = (bf16_t*)(p.ws + WS_HALO_B);
    for (int it = gw; it < NSEG * 2; it += ngw) {
        const int g = it >> 1, side = it & 1;
        const bool ctx = g < NSEG_CTX; const int sg = ctx ? g % (CTXL / 64) : (g - NSEG_CTX) % (S / 64); const int nsg = ctx ? CTXL / 64 : S / 64;
        const bool edge = side ? (sg == nsg - 1) : (sg == 0);
        if (!edge) continue;
        for (int c = lane; c < 384; c += 64) *(u32x4*)(HA + ((size_t)g * 4 + 2 * side) * 1536 + c * 8) = (u32x4){0u, 0u, 0u, 0u};
        for (int c = lane; c < 240; c += 64) *(u32x4*)(HB + ((size_t)g * 2 + side) * 1920 + c * 8) = (u32x4){0u, 0u, 0u, 0u};
    }
}
DI void phase1(const Params& p, char* smem) {
    if (USE_G8) halo_zero_fill(p);
    const int lane = tid_x() & 63, wave = tid_x() >> 6;
    const int gw = blockIdx.x * 8 + wave, ngw = gridDim.x * 8;
    const float* mod = (const float*)(p.ws + WS_MOD);
    bf16_t* U = (bf16_t*)(p.aux + AUX_U);
    auto rowsrc = [&](int r) -> const float* { return r < T_CTX ? p.in[I_CTX] + (size_t)r * D : p.in[I_X] + (size_t)(r - T_CTX) * D; };
    f32x4 xn[D / 256];
    if (gw < T_ALL) {
#pragma unroll
        for (int j = 0; j < D / 256; ++j) xn[j] = *(const f32x4*)(rowsrc(gw) + j * 256 + lane * 4);
    }
    for (int r = gw; r < T_ALL; r += ngw) {
        const int v = r < T_CTX ? NB : (r - T_CTX) / S;
        f32x4 x[D / 256]; float ss = 0.f;
#pragma unroll
        for (int j = 0; j < D / 256; ++j) { x[j] = xn[j]; ss += x[j].x * x[j].x + x[j].y * x[j].y + x[j].z * x[j].z + x[j].w * x[j].w; }
        if (r + ngw < T_ALL) {
#pragma unroll
            for (int j = 0; j < D / 256; ++j) xn[j] = *(const f32x4*)(rowsrc(r + ngw) + j * 256 + lane * 4);
        }
        ss = wave_sum_fast(ss);
        const float rstd = frsq(ss * (1.0f / D) + 1e-6f);
#pragma unroll
        for (int j = 0; j < D / 256; ++j) {
            const int k = j * 256 + lane * 4;
            const f32x4 g = *(const f32x4*)(p.in[I_NMIX] + k), sh = *(const f32x4*)(mod + (size_t)v * 6 * D + k), sc = *(const f32x4*)(mod + (size_t)v * 6 * D + D + k);
            float o0 = x[j].x * rstd * g.x * (1.f + sc.x) + sh.x, o1 = x[j].y * rstd * g.y * (1.f + sc.y) + sh.y;
            float o2 = x[j].z * rstd * g.z * (1.f + sc.z) + sh.z, o3 = x[j].w * rstd * g.w * (1.f + sc.w) + sh.w;
            u32x2 o; o.x = pk2(o0, o1); o.y = pk2(o2, o3);
            *(u32x2*)(U + (size_t)r * D + k) = o;
        }
    }
}

DI void phase2(const Params& p, char* smem) {
    const bf16_t* U = (const bf16_t*)(p.aux + AUX_U); const bf16_t* WT = (const bf16_t*)(p.aux + AUX_WINT);
    bf16_t* PL = (bf16_t*)(p.ws + WS_PLAT); bf16_t* PC = (bf16_t*)(p.ws + WS_PCTX); float* AB = (float*)(p.ws + WS_AB);
    if (USE_G8) {
        constexpr int NT = NP / 256, MT = T_ALL / 256, NT_CTX = (CTX_COLS + 255) / 256;
        for (int t = blockIdx.x; t < MT * NT; t += gridDim.x) {
            int mt, nt; if (!g8::tile_order(t, MT, NT, mt, nt)) break;
            const int brow = mt * 256, bcol = nt * 256; const bool isctx = brow < T_CTX;
            if (isctx && nt >= NT_CTX) continue;
            g8::Acc acc; g8::acc_zero(acc);
            g8::kloop(acc, smem, U, D, WT, D, D, brow, bcol);
            constexpr int OLD_ = 264; bf16_t* OT = (bf16_t*)smem;
            g8::for_each_quad(acc, brow, bcol, [&](int row, int col, const f32x4& v) {
                u32x2 o; o.x = pk2(v.x, v.y); o.y = pk2(v.z, v.w);
                *(u32x2*)(OT + (row - brow) * OLD_ + (col - bcol)) = o;
                if (col >= 2048 && col < 2064) *(f32x4*)(AB + (size_t)row * 16 + (col - 2048)) = v;
                halo_store(p, row, col, o);
            });
            __syncthreads();
            {
                const int tid = tid_x(); const int ncols = isctx ? CTX_COLS : IN_COLS;
                bf16_t* dst = isctx ? PC + (size_t)brow * CTX_COLS : PL + (size_t)(brow - T_CTX) * IN_COLS;
#pragma unroll
                for (int i = 0; i < 16; ++i) {
                    const int ch = tid + i * NTHREADS, row = ch >> 5, c8 = (ch & 31) * 8, col = bcol + c8;
                    if (col < ncols) *(u32x4*)(dst + (size_t)row * ncols + col) = *(const u32x4*)(OT + row * OLD_ + c8);
                }
            }
            __syncthreads();
        }
        return;
    }
    const int tid = tid_x(), lane = tid & 63, wave = tid >> 6, wr = wave >> 1, wc = wave & 1, fr = lane & 15, fq = lane >> 4;
    constexpr int NT = NP / 128, MT = T_ALL / BM, NT_CTX = (CTX_COLS + 127) / 128;
    for (int t = blockIdx.x; t < MT * NT; t += gridDim.x) {
        const int mt = t / NT, nt = t % NT; const int row0 = mt * BM; const bool isctx = row0 < T_CTX;
        if (isctx && nt >= NT_CTX) continue;
        f32x4 acc[MREP][4]; acc_zero(acc);
        gemm_kloop(acc, smem, [&](int i) { return U + (size_t)(row0 + i) * D; }, WT + (size_t)nt * 128 * D, D, D);
#pragma unroll
        for (int m = 0; m < MREP; ++m)
#pragma unroll
            for (int n = 0; n < 4; ++n)
#pragma unroll
                for (int j = 0; j < 4; ++j) {
                    const int row = row0 + wr * 16 * MREP + m * 16 + fq * 4 + j, col = nt * 128 + wc * 64 + n * 16 + fr; const float v = acc[m][n][j];
                    if (isctx) { if (col < CTX_COLS) PC[(size_t)row * CTX_COLS + col] = f2bf(v); }
                    else { if (col < IN_COLS) PL[(size_t)(row - T_CTX) * IN_COLS + col] = f2bf(v); }
                    if (col >= 2048 && col < 2064) AB[(size_t)row * 16 + (col - 2048)] = v;
                }
    }
}


DI int crow(int g, int h) { return (g & 3) + 8 * (g >> 2) + 4 * h; }
template <int S_> DI bf16x8 pack_acc(const f32x16& x) {
    u32x4 r;
    r.x = pk2(x[8 * S_ + 0], x[8 * S_ + 1]); r.y = pk2(x[8 * S_ + 2], x[8 * S_ + 3]); r.z = pk2(x[8 * S_ + 4], x[8 * S_ + 5]); r.w = pk2(x[8 * S_ + 6], x[8 * S_ + 7]);
    return __builtin_bit_cast(bf16x8, r);
}
DI bf16x8 ld_nat(const bf16_t* row, int s, int h) { return *(const bf16x8*)(row + 16 * s + 8 * h); }
DI bf16x8 ld_perm(const bf16_t* row, int s, int h) {
    const bf16x4 lo = *(const bf16x4*)(row + 16 * s + 4 * h), hi = *(const bf16x4*)(row + 16 * s + 8 + 4 * h);
    return __builtin_shufflevector(lo, hi, 0, 1, 2, 3, 4, 5, 6, 7);
}
DI f32x16 zero16() { f32x16 z;
#pragma unroll
    for (int i = 0; i < 16; ++i) z[i] = 0.f;
    return z; }
#define TGET(i) ((i) < 16 ? t0[(i) & 15] : t1[(i) & 15])
DI void invert32_col(const float* Lf, f32x16& t0, f32x16& t1, int c) {
#pragma unroll
    for (int i = 0; i < 32; ++i) {
        float s0 = 0.f, s1 = 0.f, s2 = 0.f, s3 = 0.f;
#pragma unroll
        for (int j4 = 0; j4 < (i + 3) / 4; ++j4) {
            const f32x4 l = *(const f32x4*)(Lf + i * 32 + 4 * j4);
            if (4 * j4 + 0 < i) s0 += l.x * TGET(4 * j4 + 0);
            if (4 * j4 + 1 < i) s1 += l.y * TGET(4 * j4 + 1);
            if (4 * j4 + 2 < i) s2 += l.z * TGET(4 * j4 + 2);
            if (4 * j4 + 3 < i) s3 += l.w * TGET(4 * j4 + 3);
        }
        float sm = -((s0 + s1) + (s2 + s3));
#ifndef EMU
        asm volatile("" : "+v"(sm));
#endif
        const float v = (i > c) ? sm : (i == c ? 1.f : 0.f);
        if (i < 16) t0[i & 15] = v; else t1[i & 15] = v;
    }
}

DI void seg_info(int g, int& seq, int& b, int& j0) {
    if (g < NSEG_CTX) { seq = 0; b = g / (CTXL / 64); j0 = (g % (CTXL / 64)) * 64; } else { const int g2 = g - NSEG_CTX; seq = 1; b = g2 / (S / 64); j0 = (g2 % (S / 64)) * 64; }
}
DI const bf16_t* seq_row(const Params& p, int seq, int b, int j, bool scan_order) {
    if (seq) { const int l = scan_order ? (j % ROWS) * GW + j / ROWS : j; return (const bf16_t*)(p.ws + WS_PLAT) + (size_t)(b * S + l) * IN_COLS; }
    return (const bf16_t*)(p.ws + WS_PCTX) + (size_t)(b * CTXL + j) * CTX_COLS;
}
DI void phase_halo(const Params& p, char* smem) {
    if (USE_G8) return;
    const int tid = tid_x(), lane = tid & 63, wave = tid >> 6;
    const int gw = blockIdx.x * 8 + wave, ngw = gridDim.x * 8;
    bf16_t* HA = (bf16_t*)(p.ws + WS_HALO_A); bf16_t* HB = (bf16_t*)(p.ws + WS_HALO_B);
    for (int it = gw; it < NSEG * 6; it += ngw) {
        const int g = it / 6, hr = it % 6; int seq, b, j0; seg_info(g, seq, b, j0);
        const int L = seq ? S : CTXL;
        if (hr < 4) {
            const int j = hr < 2 ? j0 - 2 + hr : j0 + 62 + hr; const bool ok = j >= 0 && j < L;
            const bf16_t* src = seq_row(p, seq, b, ok ? j : 0, false);
            for (int c = lane; c < 192; c += 64) { u32x4 v = {0u, 0u, 0u, 0u}; if (ok) v = *(const u32x4*)(src + c * 8); *(u32x4*)(HA + ((size_t)g * 4 + hr) * 1536 + c * 8) = v; }
        } else {
            const int j = hr == 4 ? j0 - 1 : j0 + 64; const bool ok = j >= 0 && j < L;
            const bf16_t* src = seq_row(p, seq, b, ok ? j : 0, true) + COL_B0;
            for (int c = lane; c < 240; c += 64) { u32x4 v = {0u, 0u, 0u, 0u}; if (ok) v = *(const u32x4*)(src + c * 8); *(u32x4*)(HB + ((size_t)g * 2 + (hr - 4)) * 1920 + c * 8) = v; }
        }
    }
}
DI f32x2_ac unpk2(unsigned w) { return (f32x2_ac){bf2f((bf16_t)(w & 0xffffu)), bf2f((bf16_t)(w >> 16))}; }
DI void unpack8(const u32x4& q, float (&f)[8]) {
    f[0] = bf2f((bf16_t)(q.x & 0xffffu)); f[1] = bf2f((bf16_t)(q.x >> 16)); f[2] = bf2f((bf16_t)(q.y & 0xffffu)); f[3] = bf2f((bf16_t)(q.y >> 16));
    f[4] = bf2f((bf16_t)(q.z & 0xffffu)); f[5] = bf2f((bf16_t)(q.z >> 16)); f[6] = bf2f((bf16_t)(q.w & 0xffffu)); f[7] = bf2f((bf16_t)(q.w >> 16));
}
DI float row16_sum(float v) {
#ifdef EMU
    v += __shfl_xor(v, 1); v += __shfl_xor(v, 2); v += __shfl_xor(v, 4); v += __shfl_xor(v, 8); return v;
#else
    v = DPP_ADD(v, 0xB1); v = DPP_ADD(v, 0x4E); v = DPP_ADD(v, 0x141); v = DPP_ADD(v, 0x140); return v;
#endif
}
DI void phase_fir(const Params& p, char* smem) {
    const int tid = tid_x(), lane = tid & 63, wave = tid >> 6;
    const int gw = blockIdx.x * 8 + wave, ngw = gridDim.x * 8;
    const bf16_t* HA = (const bf16_t*)(p.ws + WS_HALO_A); const bf16_t* HB = (const bf16_t*)(p.ws + WS_HALO_B);
    constexpr int NA = NSEG * 3, NBI = NSEG * 4;
    const u32x4 z4 = {0u, 0u, 0u, 0u};
    for (int it = gw; it < NA + NBI; it += ngw) {
        if (it < NA) {
            const int g = it / 3, s = it % 3; int seq, b, j0; seg_info(g, seq, b, j0);
            const int col = s * 512 + 8 * lane, ldp = seq ? IN_COLS : CTX_COLS;
            bf16_t* base = (bf16_t*)seq_row(p, seq, b, j0, false) + col;
            const bf16_t* hal = HA + (size_t)g * 4 * 1536 + col;
            float cw[5][8];
#pragma unroll
            for (int t = 0; t < 5; ++t) { const f32x4 w0 = *(const f32x4*)(p.in[I_CONV] + t * 1536 + col), w1 = *(const f32x4*)(p.in[I_CONV] + t * 1536 + col + 4);
                cw[t][0] = w0.x; cw[t][1] = w0.y; cw[t][2] = w0.z; cw[t][3] = w0.w; cw[t][4] = w1.x; cw[t][5] = w1.y; cw[t][6] = w1.z; cw[t][7] = w1.w; }
            u32x4 win[12], nxt[8];
            win[0] = *(const u32x4*)(hal); win[1] = *(const u32x4*)(hal + 1536);
            win[2] = *(const u32x4*)(base); win[3] = *(const u32x4*)(base + ldp);
#pragma unroll
            for (int i = 0; i < 8; ++i) win[4 + i] = *(const u32x4*)(base + (size_t)(2 + i) * ldp);
#pragma unroll 1
            for (int blk = 0; blk < 8; ++blk) {
                if (blk < 7) {
#pragma unroll
                    for (int i = 0; i < 8; ++i) { const int t = 8 * blk + 10 + i; nxt[i] = t < 64 ? *(const u32x4*)(base + (size_t)t * ldp) : *(const u32x4*)(hal + (size_t)(2 + (t - 64)) * 1536); }
                }
#pragma unroll
                for (int i = 0; i < 8; ++i) {
                    float a[8];
#pragma unroll
                    for (int e = 0; e < 8; ++e) a[e] = 0.f;
#pragma unroll
                    for (int t = 0; t < 5; ++t) { float x[8]; unpack8(win[i + t], x);
#pragma unroll
                        for (int e = 0; e < 8; ++e) a[e] += x[e] * cw[t][e]; }
                    float ss = 0.f;
#pragma unroll
                    for (int e = 0; e < 8; ++e) { a[e] = fsilu(a[e]); ss += a[e] * a[e]; }
                    if (s < 2) { const float sc = frsq(row16_sum(ss) + 1e-6f) * (s == 0 ? 0.08838834764831845f : 1.0f);
#pragma unroll
                        for (int e = 0; e < 8; ++e) a[e] *= sc; }
                    u32x4 o; o.x = pk2(a[0], a[1]); o.y = pk2(a[2], a[3]); o.z = pk2(a[4], a[5]); o.w = pk2(a[6], a[7]);
                    *(u32x4*)(base + (size_t)(8 * blk + i) * ldp) = o;
                }
#pragma unroll
                for (int i = 0; i < 4; ++i) win[i] = win[8 + i];
#pragma unroll
                for (int i = 0; i < 8; ++i) win[4 + i] = nxt[i];
            }
        } else {
            const int it2 = it - NA, g = it2 / 4, sl = it2 % 4; int seq, b, j0; seg_info(g, seq, b, j0);
            const int bcol = sl * 512 + 8 * lane; const bool act = bcol < 1920;
            const int bc = act ? bcol : 0, col = COL_B0 + bc;
            float mu8[8];
            { const f32x4 m0 = *(const f32x4*)(p.in[I_MU] + bc), m1 = *(const f32x4*)(p.in[I_MU] + bc + 4); mu8[0] = m0.x; mu8[1] = m0.y; mu8[2] = m0.z; mu8[3] = m0.w; mu8[4] = m1.x; mu8[5] = m1.y; mu8[6] = m1.z; mu8[7] = m1.w; }
            const bool th = (bc >= 1536 && bc < 1664);
            const bf16_t* hal = HB + (size_t)g * 2 * 1920 + bc;
            u32x4 win[10], nxt[8];
            win[0] = *(const u32x4*)(hal); win[1] = *(const u32x4*)(seq_row(p, seq, b, j0, true) + col);
#pragma unroll
            for (int i = 0; i < 8; ++i) win[2 + i] = *(const u32x4*)(seq_row(p, seq, b, j0 + 1 + i, true) + col);
#pragma unroll 1
            for (int blk = 0; blk < 8; ++blk) {
                if (blk < 7) {
#pragma unroll
                    for (int i = 0; i < 8; ++i) { const int t = 8 * blk + 9 + i; nxt[i] = t < 64 ? *(const u32x4*)(seq_row(p, seq, b, j0 + t, true) + col) : *(const u32x4*)(hal + 1920); }
                }
#pragma unroll
                for (int i = 0; i < 8; ++i) {
                    float pv[8], cu[8], nx[8], x[8]; unpack8(win[i], pv); unpack8(win[i + 1], cu); unpack8(win[i + 2], nx);
#pragma unroll
                    for (int e = 0; e < 8; ++e) { x[e] = cu[e] + (0.5f * (pv[e] + nx[e]) - cu[e]) * mu8[e]; if (th) x[e] = ftanh(x[e]); }
                    u32x4 o; o.x = pk2(x[0], x[1]); o.y = pk2(x[2], x[3]); o.z = pk2(x[4], x[5]); o.w = pk2(x[6], x[7]);
                    if (act) *(u32x4*)((bf16_t*)seq_row(p, seq, b, j0 + 8 * blk + i, true) + col) = o;
                }
                win[0] = win[8]; win[1] = win[9];
#pragma unroll
                for (int i = 0; i < 8; ++i) win[2 + i] = nxt[i];
            }
        }
    }
}

constexpr int GC = 32;
constexpr int G_NT = (CTXL + S) / GC;
constexpr int LD128 = 136, LD64 = 72, LD32 = 40;
DI void chunk_pos(int x, int d, int& seg, int& j0) {
    constexpr int n0 = CTXL / GC, n1 = S / GC;
    if (x < n0) { seg = 0; j0 = (d ? n0 - 1 - x : x) * GC; } else { seg = 1; const int xx = x - n0; j0 = (d ? n1 - 1 - xx : xx) * GC; }
}

template <class Emit>
DI void invert32_blocked(const float* Lf, bf16_t* scr, int lane, Emit emit) {
    bf16_t* T00T = scr; bf16_t* T11R = scr + 16 * LD32; bf16_t* L10R = scr + 2 * 16 * LD32; bf16_t* P1T = scr + 3 * 16 * LD32;
    const int blk = lane >> 5, c = lane & 15, r = lane & 31, fr = lane & 15, fq = lane >> 4;
    f32x16 t;
    const float* Lb = Lf + (16 * blk) * 32 + 16 * blk;
#pragma unroll
    for (int i = 0; i < 16; ++i) {
        float s0 = 0.f, s1 = 0.f, s2 = 0.f, s3 = 0.f;
#pragma unroll
        for (int j4 = 0; j4 < (i + 3) / 4; ++j4) {
            const f32x4 l = *(const f32x4*)(Lb + i * 32 + 4 * j4);
            if (4 * j4 + 0 < i) s0 += l.x * t[4 * j4 + 0];
            if (4 * j4 + 1 < i) s1 += l.y * t[4 * j4 + 1];
            if (4 * j4 + 2 < i) s2 += l.z * t[4 * j4 + 2];
            if (4 * j4 + 3 < i) s3 += l.w * t[4 * j4 + 3];
        }
        float sm = -((s0 + s1) + (s2 + s3));
#ifndef EMU
        asm volatile("" : "+v"(sm));
#endif
        t[i] = (i > c) ? sm : (i == c ? 1.f : 0.f);
    }
    if (r < 16) {
        if (blk == 0) {
#pragma unroll
            for (int q = 0; q < 4; ++q) { u32x2 o; o.x = pk2(t[4 * q], t[4 * q + 1]); o.y = pk2(t[4 * q + 2], t[4 * q + 3]); *(u32x2*)(T00T + c * LD32 + 4 * q) = o; }
        } else {
#pragma unroll
            for (int i = 0; i < 16; ++i) T11R[i * LD32 + c] = f2bf(t[i]);
        }
    }
    { const int i = lane >> 2, j4 = (lane & 3) * 4; const f32x4 l = *(const f32x4*)(Lf + (16 + i) * 32 + j4);
      u32x2 o; o.x = pk2(l.x, l.y); o.y = pk2(l.z, l.w); *(u32x2*)(L10R + i * LD32 + j4) = o; }
    WAVE_SYNC();
    const bf16x8 zf = {0, 0, 0, 0, 0, 0, 0, 0};
    f32x4 p1 = {0.f, 0.f, 0.f, 0.f};
    {
        const bf16x8 af = fq < 2 ? *(const bf16x8*)(L10R + fr * LD32 + 8 * fq) : zf, bfm = fq < 2 ? *(const bf16x8*)(T00T + fr * LD32 + 8 * fq) : zf;
        p1 = MFMA16(af, bfm, p1);
    }
    { u32x2 o; o.x = pk2(p1[0], p1[1]); o.y = pk2(p1[2], p1[3]); *(u32x2*)(P1T + fr * LD32 + 4 * fq) = o; }
    WAVE_SYNC();
    f32x4 p2 = {0.f, 0.f, 0.f, 0.f};
    {
        const bf16x8 af = fq < 2 ? *(const bf16x8*)(T11R + fr * LD32 + 8 * fq) : zf, bfm = fq < 2 ? *(const bf16x8*)(P1T + fr * LD32 + 8 * fq) : zf;
        p2 = MFMA16(af, bfm, p2);
    }
#pragma unroll
    for (int j = 0; j < 4; ++j) emit(16 + 4 * fq + j, fr, -p2[j]);
    if (r < 16) {
#pragma unroll
        for (int i = 0; i < 16; ++i) { emit(16 * blk + i, 16 * blk + c, t[i]); if (blk == 0) emit(i, 16 + c, 0.f); }
    }
}
constexpr int GL_Q = 0;
constexpr int GL_KT = GL_Q + 2 * 32 * LD128 * 2;
constexpr int GL_VT = GL_KT + 2 * 128 * LD32 * 2;
constexpr int GL_K = GL_VT + 2 * 128 * LD32 * 2;
constexpr int GL_QKM = GL_K + 32 * LD128 * 2;
constexpr int GL_LF = GL_QKM + 2 * 32 * LD32 * 2;
constexpr int GL_TP = GL_LF + 32 * 32 * 4;
constexpr int GL_TPP = GL_TP + 32 * LD32 * 2;
constexpr int GL_WN = GL_TPP + 2 * 32 * LD32 * 2;
constexpr int GL_SC = GL_WN + 32 * LD128 * 2;
constexpr int GL_GC = GL_SC + 2 * 8 * 32 * 4;
constexpr int GL_CW = GL_GC + 8 * 32 * 4;
constexpr int GL_INV = GL_CW + 5 * 3 * 128 * 4;
constexpr int GL_RAW = GL_INV + 4 * 32 * LD32 * 2;
constexpr int GL_END = GL_RAW + 32 * 384 * 2;
static_assert(GL_END <= LDS_BYTES, "gdn lds");

DI void gdn_chain2(const Params& p, char* smem, int item) {
    const int d = item / (NB * H_A), b = (item / H_A) % NB, h = item % H_A;
    const int tid = tid_x(), lane = tid & 63, wave0_ = tid >> 6;
    bf16_t* Qs = (bf16_t*)(smem + GL_Q); bf16_t* KTs = (bf16_t*)(smem + GL_KT); bf16_t* VTs = (bf16_t*)(smem + GL_VT); bf16_t* Ks = (bf16_t*)(smem + GL_K);
    bf16_t* QKMs = (bf16_t*)(smem + GL_QKM); float* Lf = (float*)(smem + GL_LF); bf16_t* Tp = (bf16_t*)(smem + GL_TP); bf16_t* Tpp = (bf16_t*)(smem + GL_TPP);
    bf16_t* Wn = (bf16_t*)(smem + GL_WN); float* SC = (float*)(smem + GL_SC); float* GCs = (float*)(smem + GL_GC); float* CW = (float*)(smem + GL_CW);
    const float alog = p.in[I_ALOG][d * 4 + h], dtb = p.in[I_DTB][d * 4 + h], negea = -expf(alog);
    bf16_t* ODIR = (bf16_t*)(p.ws + WS_OA);
    __syncthreads();
    f32x16 St[4];
#pragma unroll
    for (int ct = 0; ct < 4; ++ct) St[ct] = zero16();
    bf16_t* RAW = (bf16_t*)(smem + GL_RAW);
    float pa = 0.f, pbt = 0.f;
    auto prefetch = [&](int x, int wsel, int nw) {
        int seg, j0; chunk_pos(x, d, seg, j0);
        const int ldp = seg ? IN_COLS : CTX_COLS;
        const bf16_t* pbase = seg ? (const bf16_t*)(p.ws + WS_PLAT) + (size_t)b * S * IN_COLS : (const bf16_t*)(p.ws + WS_PCTX) + (size_t)b * CTXL * CTX_COLS;
        for (int inst = wsel; inst < 24; inst += nw) {
            const int q = inst * 64 + lane, row = q / 48, c16 = q % 48;
            const bf16_t* src = pbase + (size_t)(j0 + row) * ldp + (c16 >> 4) * 512 + h * 128 + (c16 & 15) * 8;
#ifdef EMU
            emu_global_load_lds16(src, (char*)RAW + q * 16);
#else
            __builtin_amdgcn_global_load_lds((const unsigned*)src, (__attribute__((address_space(3))) unsigned*)((char*)RAW + q * 16), 16, 0, 0);
#endif
        }
    };
    auto prefetch_ab = [&](int x) {
        int seg, j0; chunk_pos(x, d, seg, j0);
        const float* abbase = (const float*)(p.ws + WS_AB) + (size_t)(seg ? T_CTX + b * S : b * CTXL) * 16;
        const int jw = j0 + 4 * wave0_;
        if (lane < 4) { pa = abbase[(size_t)(jw + lane) * 16 + d * 4 + h]; pbt = abbase[(size_t)(jw + lane) * 16 + 8 + d * 4 + h]; }
    };
    prefetch(0, wave0_, 8); prefetch_ab(0);
#ifndef EMU
    asm volatile("s_waitcnt vmcnt(0)" ::: "memory");
#endif
    const int r0_ = lane & 31, hh0_ = lane >> 5;
    __syncthreads();
    for (int it = -1; it < G_NT; ++it) {
        int r = r0_, hh = hh0_, wave = wave0_;
#ifndef EMU
        asm volatile("" : "+v"(r), "+v"(hh), "+v"(wave));
#endif
        const int xn = it + 1, par = xn & 1;
        int segn = 0, j0n = 0; if (xn < G_NT) chunk_pos(xn, d, segn, j0n);
        if (xn < G_NT) {
            const int i0 = d ? (GC - 4 - 4 * wave) : 4 * wave;
            bf16_t kt[2][4], vt[2][4];
#pragma unroll
            for (int t = 0; t < 4; ++t) {
                const int e = d ? 3 - t : t, i = i0 + e;
                const unsigned wq = *(const unsigned*)(RAW + (4 * wave + t) * 384 + 2 * lane), wk = *(const unsigned*)(RAW + (4 * wave + t) * 384 + 128 + 2 * lane), wv = *(const unsigned*)(RAW + (4 * wave + t) * 384 + 256 + 2 * lane);
                *(unsigned*)(Qs + (par * 32 + i) * LD128 + 2 * lane) = wq;
                *(unsigned*)(Ks + i * LD128 + 2 * lane) = wk;
                kt[0][e] = (bf16_t)(wk & 0xffffu); kt[1][e] = (bf16_t)(wk >> 16); vt[0][e] = (bf16_t)(wv & 0xffffu); vt[1][e] = (bf16_t)(wv >> 16);
            }
#pragma unroll
            for (int q = 0; q < 2; ++q) {
                u32x2 o; o.x = (unsigned)kt[q][0] | ((unsigned)kt[q][1] << 16); o.y = (unsigned)kt[q][2] | ((unsigned)kt[q][3] << 16);
                *(u32x2*)(KTs + (par * 128 + 2 * lane + q) * LD32 + i0) = o;
                u32x2 o2; o2.x = (unsigned)vt[q][0] | ((unsigned)vt[q][1] << 16); o2.y = (unsigned)vt[q][2] | ((unsigned)vt[q][3] << 16);
                *(u32x2*)(VTs + (par * 128 + 2 * lane + q) * LD32 + i0) = o2;
            }
            if (lane < 4) { const int i = d ? (GC - 1 - 4 * wave - lane) : (4 * wave + lane);
                SC[(par * 8 + 0) * 32 + i] = negea * fsoftplus(pa + dtb); SC[(par * 8 + 1) * 32 + i] = fsigmoid(pbt); }
            if (xn + 1 < G_NT) prefetch_ab(xn + 1);
        }
        LDS_BARRIER();
        if (wave >= 4 && wave < 7 && xn + 1 < G_NT) {
            prefetch(xn + 1, wave - 4, 3);
#ifndef EMU
            asm volatile("s_waitcnt vmcnt(0)" ::: "memory");
#endif
        }
        if (xn < G_NT) {
            const float* graw = SC + (par * 8 + 0) * 32;
            float gcv = 0.f;
#pragma unroll
            for (int s4 = 0; s4 < 8; ++s4) { const f32x4 g4 = *(const f32x4*)(graw + 4 * s4);
                gcv += (4 * s4 + 0 <= r ? g4.x : 0.f) + (4 * s4 + 1 <= r ? g4.y : 0.f) + (4 * s4 + 2 <= r ? g4.z : 0.f) + (4 * s4 + 3 <= r ? g4.w : 0.f); }
            if (lane < 32) GCs[wave * 32 + r] = gcv;
            if (wave == 7 && lane < 32) {
                float gl = 0.f;
#pragma unroll
                for (int s4 = 0; s4 < 8; ++s4) { const f32x4 g4 = *(const f32x4*)(graw + 4 * s4); gl += (g4.x + g4.y) + (g4.z + g4.w); }
                const float be = SC[(par * 8 + 1) * 32 + r];
                SC[(par * 8 + 3) * 32 + r] = fexp(gcv); SC[(par * 8 + 4) * 32 + r] = fexp(gl - gcv); SC[(par * 8 + 5) * 32 + r] = be * fexp(gcv); SC[(par * 8 + 6) * 32 + r] = fexp(gl);
            }
            const int pr = wave >> 2, th = (wave >> 1) & 1, ch = wave & 1, fr = lane & 15, fq = lane >> 4;
            const bf16_t* arow = (pr == 0 ? Ks : Qs + par * 32 * LD128) + (16 * th + fr) * LD128 + 8 * fq; const bf16_t* brow = Ks + (16 * ch + fr) * LD128 + 8 * fq;
            f32x4 cc = {0.f, 0.f, 0.f, 0.f};
#pragma unroll
            for (int ks = 0; ks < 4; ++ks) cc = MFMA16(*(const bf16x8*)(arow + 32 * ks), *(const bf16x8*)(brow + 32 * ks), cc);
            WAVE_SYNC();
            const int jj = 16 * ch + fr; const float gj = GCs[wave * 32 + jj];
#pragma unroll
            for (int j = 0; j < 4; ++j) {
                const int i = 16 * th + 4 * fq + j; const float dec = fexp(GCs[wave * 32 + i] - gj);
                if (pr == 0) Lf[i * 32 + jj] = (jj < i) ? SC[(par * 8 + 1) * 32 + i] * cc[j] * dec : 0.f;
                else QKMs[(par * 32 + i) * LD32 + jj] = f2bf((jj <= i) ? cc[j] * dec : 0.f);
            }
        }
        LDS_BARRIER();
        if (wave == 7 && xn < G_NT) {
            const float* sb1 = SC + (par * 8 + 5) * 32; const float* sb0 = SC + (par * 8 + 1) * 32; bf16_t* Tppw = Tpp + par * 32 * LD32;
            invert32_blocked(Lf, (bf16_t*)(smem + GL_INV), lane, [&](int i, int c, float v) { Tp[i * LD32 + c] = f2bf(v * sb1[c]); Tppw[i * LD32 + c] = f2bf(v * sb0[c]); });
        }
        if (wave < 4 && it >= 0) {
            const int pc = it & 1; int seg = 0, j0 = 0; chunk_pos(it, d, seg, j0);
            const bf16_t* Qc = Qs + pc * 32 * LD128; const bf16_t* KTc = KTs + pc * 128 * LD32; const bf16_t* VTc = VTs + pc * 128 * LD32;
            const bf16_t* QKc = QKMs + pc * 32 * LD32; const bf16_t* Tc = Tpp + pc * 32 * LD32; const float* sc = SC + pc * 8 * 32;
            f32x16 vn = zero16();
#pragma unroll
            for (int s = 0; s < 2; ++s) vn = MFMA32(ld_nat(Tc + r * LD32, s, hh), ld_nat(VTc + (32 * wave + r) * LD32, s, hh), vn);
            f32x16 oacc = zero16();
#define GDN_KSTEP(s) { const bf16x8 sb = pack_acc<(s) & 1>(St[(s) >> 1]); vn = MFMA32(ld_perm(Wn + r * LD128, (s), hh), sb, vn); oacc = MFMA32(ld_perm(Qc + r * LD128, (s), hh), sb, oacc); }
            GDN_KSTEP(0) GDN_KSTEP(1) GDN_KSTEP(2) GDN_KSTEP(3) GDN_KSTEP(4) GDN_KSTEP(5) GDN_KSTEP(6) GDN_KSTEP(7)
#undef GDN_KSTEP
#pragma unroll
            for (int g = 0; g < 16; ++g) oacc[g] *= sc[3 * 32 + crow(g, hh)];
            { const bf16x8 v0 = pack_acc<0>(vn), v1 = pack_acc<1>(vn);
              oacc = MFMA32(ld_perm(QKc + r * LD32, 0, hh), v0, oacc); oacc = MFMA32(ld_perm(QKc + r * LD32, 1, hh), v1, oacc); }
#pragma unroll
            for (int g = 0; g < 16; ++g) vn[g] *= sc[4 * 32 + crow(g, hh)];
            const float ge = sc[6 * 32];
            { const bf16x8 v0 = pack_acc<0>(vn), v1 = pack_acc<1>(vn);
#pragma unroll
              for (int ct = 0; ct < 4; ++ct) {
#pragma unroll
                  for (int g = 0; g < 16; ++g) St[ct][g] *= ge;
                  St[ct] = MFMA32(ld_perm(KTc + (32 * ct + r) * LD32, 0, hh), v0, St[ct]);
                  St[ct] = MFMA32(ld_perm(KTc + (32 * ct + r) * LD32, 1, hh), v1, St[ct]);
              } }
            if (seg) {
#pragma unroll
                for (int g = 0; g < 16; ++g) {
                    const int i = crow(g, hh), j = d ? j0 + GC - 1 - i : j0 + i;
                    ODIR[((size_t)d * T_LAT + (size_t)b * S + j) * 512 + h * 128 + 32 * wave + r] = f2bf(oacc[g]);
                }
            }
        }
        LDS_BARRIER();
        if (xn < G_NT && wave < 4) {
            f32x16 acc = zero16();
#pragma unroll
            for (int s = 0; s < 2; ++s) acc = MFMA32(ld_nat(KTs + (par * 128 + 32 * wave + r) * LD32, s, hh), ld_nat(Tp + r * LD32, s, hh), acc);
#pragma unroll
            for (int q = 0; q < 4; ++q) {
                u32x2 o; o.x = pk2(-acc[4 * q], -acc[4 * q + 1]); o.y = pk2(-acc[4 * q + 2], -acc[4 * q + 3]);
                *(u32x2*)(Wn + r * LD128 + 32 * wave + 8 * q + 4 * hh) = o;
            }
        }
        LDS_BARRIER();
    }
}

constexpr int RL_RX = 0;
constexpr int RL_KX = RL_RX + 32 * 64 * 4;
constexpr int RL_VX = RL_KX + 32 * 64 * 4;
constexpr int RL_KK = RL_VX + 32 * 64 * 4;
constexpr int RL_LW = RL_KK + 32 * 64 * 4;
constexpr int RL_IC = RL_LW + 32 * 64 * 4;
constexpr int RL_PC = RL_IC + 32 * 64 * 4;
constexpr int RL_CST = RL_PC + 2 * 64 * 4;
constexpr int RL_TW = RL_CST + 4 * 64 * 4;
constexpr int RL_AL = RL_TW + 32 * LD64 * 2;
constexpr int RL_LF = RL_TW;
constexpr int RL_LAKT = RL_LF + 32 * 32 * 4;
constexpr int RL_TB = RL_LAKT + 32 * LD32 * 2;
static_assert(RL_TB + 32 * LD32 * 2 <= RL_AL + 32 * LD64 * 2, "overlay");
constexpr int RL_W2T = RL_AL + 32 * LD64 * 2;
constexpr int RL_A2T = RL_W2T + 64 * LD64 * 2;
constexpr int RL_AR = RL_A2T + 64 * LD64 * 2;
constexpr int RL_BR = RL_AR + 32 * LD64 * 2;
constexpr int RL_KR = RL_BR + 32 * LD64 * 2;
constexpr int RL_RR = RL_KR + 32 * LD64 * 2;
constexpr int RL_AT = RL_RR + 2 * 32 * LD64 * 2;
constexpr int RL_BHT = RL_AT + 64 * LD32 * 2;
constexpr int RL_KHT = RL_BHT + 2 * 64 * LD32 * 2;
constexpr int RL_VT = RL_KHT + 2 * 64 * LD32 * 2;
constexpr int RL_MRB = RL_VT + 2 * 64 * LD32 * 2;
constexpr int RL_MRK = RL_MRB + 2 * 32 * LD32 * 2;
constexpr int RL_WM = RL_MRK + 2 * 32 * LD32 * 2;
constexpr int RL_TL = RL_WM + 32 * LD64 * 2;
constexpr int RL_END = RL_TL + 32 * LD32 * 2;
static_assert(RL_END <= LDS_BYTES, "rwkv lds");

DI void rwkv_chain2(const Params& p, char* smem, int item) {
    const int d = item / (NB * H_B), b = (item / H_B) % NB, h = item % H_B;
    const int tid = tid_x(), lane = tid & 63, wave = tid >> 6;
    float* RX = (float*)(smem + RL_RX); float* KX = (float*)(smem + RL_KX); float* VX = (float*)(smem + RL_VX); float* KKs = (float*)(smem + RL_KK);
    float* LW = (float*)(smem + RL_LW); float* IC = (float*)(smem + RL_IC); float* Lf = (float*)(smem + RL_LF); float* PC = (float*)(smem + RL_PC); float* CST = (float*)(smem + RL_CST);
    bf16_t* TW = (bf16_t*)(smem + RL_TW); bf16_t* AL = (bf16_t*)(smem + RL_AL); bf16_t* W2T = (bf16_t*)(smem + RL_W2T); bf16_t* A2T = (bf16_t*)(smem + RL_A2T);
    bf16_t* Ar = (bf16_t*)(smem + RL_AR); bf16_t* Br = (bf16_t*)(smem + RL_BR); bf16_t* Kr = (bf16_t*)(smem + RL_KR); bf16_t* Rr = (bf16_t*)(smem + RL_RR);
    bf16_t* AT = (bf16_t*)(smem + RL_AT); bf16_t* BhT = (bf16_t*)(smem + RL_BHT); bf16_t* KhT = (bf16_t*)(smem + RL_KHT); bf16_t* VT = (bf16_t*)(smem + RL_VT);
    bf16_t* LakT = (bf16_t*)(smem + RL_LAKT); bf16_t* Mrb = (bf16_t*)(smem + RL_MRB); bf16_t* Mrk = (bf16_t*)(smem + RL_MRK); bf16_t* Tb = (bf16_t*)(smem + RL_TB);
    bf16_t* Wm = (bf16_t*)(smem + RL_WM); bf16_t* TLm = (bf16_t*)(smem + RL_TL);
    bf16_t* YDIR = (bf16_t*)(p.aux + AUX_YDIR); float* BON = (float*)(p.ws + WS_BONUS);
    __syncthreads();
    for (int i = tid; i < 64 * 64; i += NTHREADS) {
        const int c = i >> 6, rr = i & 63;
        W2T[c * LD64 + rr] = f2bf(p.in[I_W2][((size_t)d * 64 + rr) * 512 + h * 64 + c]); A2T[c * LD64 + rr] = f2bf(p.in[I_A2][((size_t)d * 64 + rr) * 512 + h * 64 + c]);
    }
    if (tid < 256) { const int w = tid >> 6, c = tid & 63, gc = h * 64 + c;
        CST[tid] = w == 0 ? p.in[I_W0][d * 512 + gc] : (w == 1 ? p.in[I_A0][d * 512 + gc] : (w == 2 ? p.in[I_KA][gc] : p.in[I_RK][gc])); }
    const float kkw = p.in[I_KK][h * 64 + lane];
    f32x16 Xt[2]; Xt[0] = zero16(); Xt[1] = zero16();
    bf16_t rawv[4][5];
    auto prefetch = [&](int x) {
        int seg, j0; chunk_pos(x, d, seg, j0);
        const int ldp = seg ? IN_COLS : CTX_COLS;
        const bf16_t* pb = seg ? (const bf16_t*)(p.ws + WS_PLAT) + (size_t)b * S * IN_COLS : (const bf16_t*)(p.ws + WS_PCTX) + (size_t)b * CTXL * CTX_COLS;
        const int jw = j0 + 4 * wave;
#pragma unroll
        for (int rr = 0; rr < 4; ++rr) {
            const int j = jw + rr; const int row = seg ? (j % ROWS) * GW + j / ROWS : j;
#pragma unroll
            for (int s = 0; s < 5; ++s) {
                const int bcol = (s < 3 ? s * 512 + h * 64 : (s == 3 ? 1536 + d * 64 : 1664 + d * 64)) + lane;
                rawv[rr][s] = pb[(size_t)row * ldp + COL_B0 + bcol];
            }
        }
    };
    prefetch(0);
    const int r0_ = lane & 31, hh0_ = lane >> 5;
    __syncthreads();
    for (int it = -1; it < G_NT; ++it) {
        int r = r0_, hh = hh0_;
#ifndef EMU
        asm volatile("" : "+v"(r), "+v"(hh));
#endif
        const int xn = it + 1, par = xn & 1;
        int segn = 0, j0n = 0; if (xn < G_NT) chunk_pos(xn, d, segn, j0n);
        if (xn < G_NT) {
#pragma unroll
            for (int t = 0; t < 4; ++t) {
                const int i = d ? (GC - 1 - 4 * wave - t) : (4 * wave + t);
                const float xr = bf2f(rawv[t][0]), xk = bf2f(rawv[t][1]), xv = bf2f(rawv[t][2]);
                const float kxk = xk * kkw; const float ss = wave_sum_fast(kxk * kxk);
                RX[i * 64 + lane] = xr; KX[i * 64 + lane] = xk; VX[i * 64 + lane] = xv; KKs[i * 64 + lane] = kxk * frsq(ss + 1e-6f);
                TW[i * LD64 + lane] = rawv[t][3]; AL[i * LD64 + lane] = rawv[t][4];
            }
            if (xn + 1 < G_NT) prefetch(xn + 1);
        }
        LDS_BARRIER();
        if (xn < G_NT) {
            const int which = wave >> 2, cg = wave & 3, fr = lane & 15, fq = lane >> 4;
            const bf16_t* arow0 = (which ? AL : TW) + fr * LD64 + 8 * fq; const bf16_t* brow = (which ? A2T : W2T) + (16 * cg + fr) * LD64 + 8 * fq;
            f32x4 c0 = {0.f, 0.f, 0.f, 0.f}, c1 = {0.f, 0.f, 0.f, 0.f};
#pragma unroll
            for (int ks = 0; ks < 2; ++ks) {
                const bf16x8 bfrag = *(const bf16x8*)(brow + 32 * ks);
                c0 = MFMA16(*(const bf16x8*)(arow0 + 32 * ks), bfrag, c0); c1 = MFMA16(*(const bf16x8*)(arow0 + 16 * LD64 + 32 * ks), bfrag, c1);
            }
            const int c = 16 * cg + fr; const float bias = CST[which * 64 + c];
#pragma unroll
            for (int th = 0; th < 2; ++th)
#pragma unroll
                for (int j = 0; j < 4; ++j) {
                    const int i = 16 * th + 4 * fq + j; const float z = bias + (th ? c1[j] : c0[j]);
                    if (which) IC[i * 64 + c] = fsigmoid(z);
                    else { const float wl = -fsoftplus(-z) - 0.5f; LW[i * 64 + c] = -fexp(wl); }
                }
        }
        LDS_BARRIER();
        if (xn < G_NT) {
            const int c = lane, i0 = 4 * wave;
            const float ka = CST[2 * 64 + c], rk = CST[3 * 64 + c];
            float lpb = 0.f, lpc = 0.f; float lw4[4];
#pragma unroll
            for (int s2 = 0; s2 < 32; ++s2) { const float w = LW[s2 * 64 + c]; lpc += w; if (s2 < i0) lpb += w; }
#pragma unroll
            for (int e = 0; e < 4; ++e) lw4[e] = LW[(i0 + e) * 64 + c];
            bf16_t ta[4], tb[4], tk[4], tv[4]; float bon[4];
            float lprun = lpb;
#pragma unroll
            for (int e = 0; e < 4; ++e) {
                const int i = i0 + e;
                const float lpm = lprun; lprun += lw4[e]; const float lp = lprun;
                const float Pi = fexp(lp), Pm = fexp(lpm), invP = fexp(-lp), PCi = fexp(lpc - lp);
                const float ic = IC[i * 64 + c], kxv = KX[i * 64 + c], kkv = KKs[i * 64 + c], rxv = RX[i * 64 + c], vxv = VX[i * 64 + c];
                const float kd = kxv * (1.f + (ic - 1.f) * ka), bb = kkv * ic, aa = -kkv;
                ta[e] = f2bf(aa * Pm); tb[e] = f2bf(bb * PCi); tk[e] = f2bf(kd * PCi); tv[e] = f2bf(vxv);
                Ar[i * LD64 + c] = ta[e]; Br[i * LD64 + c] = f2bf(bb * invP); Kr[i * LD64 + c] = f2bf(kd * invP); Rr[(par * 32 + i) * LD64 + c] = f2bf(rxv * Pi);
                bon[e] = wave_sum_fast(rxv * kd * rk);
            }
            { u32x2 o; o.x = (unsigned)ta[0] | ((unsigned)ta[1] << 16); o.y = (unsigned)ta[2] | ((unsigned)ta[3] << 16); *(u32x2*)(AT + c * LD32 + i0) = o; }
            { u32x2 o; o.x = (unsigned)tb[0] | ((unsigned)tb[1] << 16); o.y = (unsigned)tb[2] | ((unsigned)tb[3] << 16); *(u32x2*)(BhT + (par * 64 + c) * LD32 + i0) = o; }
            { u32x2 o; o.x = (unsigned)tk[0] | ((unsigned)tk[1] << 16); o.y = (unsigned)tk[2] | ((unsigned)tk[3] << 16); *(u32x2*)(KhT + (par * 64 + c) * LD32 + i0) = o; }
            { u32x2 o; o.x = (unsigned)tv[0] | ((unsigned)tv[1] << 16); o.y = (unsigned)tv[2] | ((unsigned)tv[3] << 16); *(u32x2*)(VT + (par * 64 + c) * LD32 + i0) = o; }
            if (wave == 7) PC[par * 64 + c] = fexp(lpc);
            if (segn && lane < 4) { const int i = i0 + lane, jj = d ? j0n + GC - 1 - i : j0n + i;
                const float bv = lane == 0 ? bon[0] : (lane == 1 ? bon[1] : (lane == 2 ? bon[2] : bon[3]));
                BON[((size_t)d * T_LAT + (size_t)b * S + (jj % ROWS) * GW + jj / ROWS) * 8 + h] = bv; }
        }
        LDS_BARRIER();
        if (xn < G_NT) {
            const int m = wave >> 1, th = wave & 1, fr = lane & 15, fq = lane >> 4;
            const bf16_t* arow = ((m < 2) ? Ar : Rr + par * 32 * LD64) + (16 * th + fr) * LD64 + 8 * fq; const bf16_t* brow = ((m & 1) ? Kr : Br) + fr * LD64 + 8 * fq;
            f32x4 c0 = {0.f, 0.f, 0.f, 0.f}, c1 = {0.f, 0.f, 0.f, 0.f};
#pragma unroll
            for (int ks = 0; ks < 2; ++ks) {
                const bf16x8 afrag = *(const bf16x8*)(arow + 32 * ks);
                c0 = MFMA16(afrag, *(const bf16x8*)(brow + 32 * ks), c0); c1 = MFMA16(afrag, *(const bf16x8*)(brow + 16 * LD64 + 32 * ks), c1);
            }
#pragma unroll
            for (int ch = 0; ch < 2; ++ch) {
                const f32x4 cc = ch ? c1 : c0; const int ic = 16 * ch + fr; const int t0 = 16 * th + 4 * fq;
                if (m == 0) {
#pragma unroll
                    for (int j = 0; j < 4; ++j) Lf[(t0 + j) * 32 + ic] = (ic < t0 + j) ? -cc[j] : 0.f;
                } else if (m == 1) {
                    u32x2 o; o.x = pk2((ic < t0) ? cc[0] : 0.f, (ic < t0 + 1) ? cc[1] : 0.f); o.y = pk2((ic < t0 + 2) ? cc[2] : 0.f, (ic < t0 + 3) ? cc[3] : 0.f);
                    *(u32x2*)(LakT + ic * LD32 + t0) = o;
                } else {
                    bf16_t* M = (m == 2 ? Mrb : Mrk) + par * 32 * LD32;
#pragma unroll
                    for (int j = 0; j < 4; ++j) M[(t0 + j) * LD32 + ic] = f2bf((ic <= t0 + j) ? cc[j] : 0.f);
                }
            }
        }
        LDS_BARRIER();
        if (wave == 7 && xn < G_NT) {
            invert32_blocked(Lf, (bf16_t*)(smem + RL_RX), lane, [&](int i, int c, float v) { Tb[i * LD32 + c] = f2bf(v); });
        }
        if (wave < 2 && it >= 0) {
            const int pc = it & 1; int seg = 0, j0 = 0; chunk_pos(it, d, seg, j0);
            const bf16_t* Rc = Rr + pc * 32 * LD64; const bf16_t* BhTc = BhT + pc * 64 * LD32; const bf16_t* KhTc = KhT + pc * 64 * LD32; const bf16_t* VTc = VT + (pc * 64 + 32 * wave + r) * LD32;
            const bf16_t* Mrbc = Mrb + pc * 32 * LD32; const bf16_t* Mrkc = Mrk + pc * 32 * LD32; const float* PCc = PC + pc * 64;
            const bf16x8 vf0 = ld_nat(VTc, 0, hh), vf1 = ld_nat(VTc, 1, hh);
            f32x16 u = zero16(), y = zero16();
            u = MFMA32(ld_nat(TLm + r * LD32, 0, hh), vf0, u); u = MFMA32(ld_nat(TLm + r * LD32, 1, hh), vf1, u);
            y = MFMA32(ld_nat(Mrkc + r * LD32, 0, hh), vf0, y); y = MFMA32(ld_nat(Mrkc + r * LD32, 1, hh), vf1, y);
#define RW_KSTEP(s) { const bf16x8 xb = pack_acc<(s) & 1>(Xt[(s) >> 1]); u = MFMA32(ld_perm(Wm + r * LD64, (s), hh), xb, u); y = MFMA32(ld_perm(Rc + r * LD64, (s), hh), xb, y); }
            RW_KSTEP(0) RW_KSTEP(1) RW_KSTEP(2) RW_KSTEP(3)
#undef RW_KSTEP
            const bf16x8 ub0 = pack_acc<0>(u), ub1 = pack_acc<1>(u);
            y = MFMA32(ld_perm(Mrbc + r * LD32, 0, hh), ub0, y); y = MFMA32(ld_perm(Mrbc + r * LD32, 1, hh), ub1, y);
#pragma unroll
            for (int kt = 0; kt < 2; ++kt) {
#pragma unroll
                for (int g = 0; g < 16; ++g) Xt[kt][g] *= PCc[32 * kt + crow(g, hh)];
                Xt[kt] = MFMA32(ld_perm(BhTc + (32 * kt + r) * LD32, 0, hh), ub0, Xt[kt]); Xt[kt] = MFMA32(ld_perm(BhTc + (32 * kt + r) * LD32, 1, hh), ub1, Xt[kt]);
                Xt[kt] = MFMA32(ld_nat(KhTc + (32 * kt + r) * LD32, 0, hh), vf0, Xt[kt]); Xt[kt] = MFMA32(ld_nat(KhTc + (32 * kt + r) * LD32, 1, hh), vf1, Xt[kt]);
            }
            if (seg) {
#pragma unroll
                for (int g = 0; g < 16; ++g) {
                    const int i = crow(g, hh), jj = d ? j0 + GC - 1 - i : j0 + i;
                    YDIR[((size_t)d * T_LAT + (size_t)b * S + (jj % ROWS) * GW + jj / ROWS) * 512 + h * 64 + 32 * wave + r] = f2bf(y[g]);
                }
            }
        }
        LDS_BARRIER();
        if (xn < G_NT && wave < 3) {
            const bf16_t* arow = (wave < 2) ? AT + (32 * wave + r) * LD32 : LakT + r * LD32;
            f32x16 acc = zero16();
#pragma unroll
            for (int s = 0; s < 2; ++s) acc = MFMA32(ld_nat(arow, s, hh), ld_nat(Tb + r * LD32, s, hh), acc);
#pragma unroll
            for (int q = 0; q < 4; ++q) {
                u32x2 o; o.x = pk2(acc[4 * q], acc[4 * q + 1]); o.y = pk2(acc[4 * q + 2], acc[4 * q + 3]);
                if (wave < 2) *(u32x2*)(Wm + r * LD64 + 32 * wave + 8 * q + 4 * hh) = o; else *(u32x2*)(TLm + r * LD32 + 8 * q + 4 * hh) = o;
            }
        }
        LDS_BARRIER();
    }
}

DI void phase3(const Params& p, char* smem) {
    constexpr int NG = 2 * NB * H_A, NR = 2 * NB * H_B;
    for (int it = blockIdx.x; it < NG; it += gridDim.x) gdn_chain2(p, smem, it);
    for (int it = blockIdx.x; it < NG + NR; it += gridDim.x) if (it >= NG) rwkv_chain2(p, smem, it - NG);
    const int nchain = NG + NR, G = (int)gridDim.x;
    const int tb = G > nchain ? (int)blockIdx.x - nchain : (int)blockIdx.x, ntb = G > nchain ? G - nchain : G;
    if (tb >= 0) {
        __syncthreads();
        const int tid3 = tid_x(), lane = tid3 & 63, wave = tid3 >> 6;
        float* scr = (float*)smem + wave * (64 * 33);
        bf16_t* GUT = (bf16_t*)(p.aux + AUX_GUT);
        constexpr int nkb = D / 64, nnb = DE / 32, per = nkb * nnb;
        for (int it = tb * 8 + wave; it < NEXP * 2 * per; it += ntb * 8) {
            const int e = it / (2 * per), r = it % (2 * per), up = r / per, r2 = r % per, kb = r2 / nnb, nb = r2 % nnb;
            transpose_item((up ? p.in[I_MU_UP] : p.in[I_MG]) + (size_t)e * D * DE, DE, DE, kb * 64, nb * 32, GUT + (size_t)e * 512 * D, D, up ? 2 : 1, scr, lane);
        }
    }
}

constexpr int P4_SG = 0;
constexpr int P4_XV = P4_SG + 32 * LD128 * 2;
constexpr int P4_YF = P4_XV + 32 * 520 * 2;
static_assert(P4_YF + 32 * 516 * 4 <= LDS_BYTES, "phase4 lds");
DI float half_sum(float v, int hh) {
#ifdef EMU
    v += __shfl_xor(v, 1); v += __shfl_xor(v, 2); v += __shfl_xor(v, 4); v += __shfl_xor(v, 8); v += __shfl_xor(v, 16); return v;
#else
    v = DPP_ADD(v, 0xB1); v = DPP_ADD(v, 0x4E); v = DPP_ADD(v, 0x141); v = DPP_ADD(v, 0x140);
    const int iv = __builtin_bit_cast(int, v);
    const float s0 = __builtin_bit_cast(float, __builtin_amdgcn_readlane(iv, 0)) + __builtin_bit_cast(float, __builtin_amdgcn_readlane(iv, 16));
    const float s1 = __builtin_bit_cast(float, __builtin_amdgcn_readlane(iv, 32)) + __builtin_bit_cast(float, __builtin_amdgcn_readlane(iv, 48));
    return hh ? s1 : s0;
#endif
}
DI void phase4(const Params& p, char* smem) {
    const int tid = tid_x(), lane = tid & 63, wave = tid >> 6, r = lane & 31, hh = lane >> 5;
    const bf16_t* PL = (const bf16_t*)(p.ws + WS_PLAT);
    const bf16_t* ODIR = (const bf16_t*)(p.ws + WS_OA); const bf16_t* YDIR = (const bf16_t*)(p.aux + AUX_YDIR);
    const float* BON = (const float*)(p.ws + WS_BONUS); const float* mu = p.in[I_MU]; const bf16_t* G2T = (const bf16_t*)(p.ws + WS_G2T);
    bf16_t* OA = (bf16_t*)(p.ws + WS_OA); bf16_t* OB = (bf16_t*)(p.ws + WS_OB);
    bf16_t* SG = (bf16_t*)(smem + P4_SG); bf16_t* XV = (bf16_t*)(smem + P4_XV); float* YF = (float*)(smem + P4_YF);
    for (int it = blockIdx.x; it < T_LAT / 32; it += gridDim.x) {
        const int tok0 = it * 32, b = tok0 / S, l0 = tok0 % S;
        __syncthreads();
        for (int q = tid; q < 32 * 80; q += NTHREADS) {
            const int t = q / 80, c8 = q % 80;
            const int l = l0 + t;
            const int bcol = c8 < 16 ? 1792 + c8 * 8 : 1024 + (c8 - 16) * 8;
            float cu[8], o[8];
            unpack8(*(const u32x4*)(PL + (size_t)(b * S + l) * IN_COLS + COL_B0 + bcol), cu);
#pragma unroll
            for (int e = 0; e < 8; ++e) o[e] = c8 < 16 ? fsigmoid(cu[e]) : cu[e];
            u32x4 w; w.x = pk2(o[0], o[1]); w.y = pk2(o[2], o[3]); w.z = pk2(o[4], o[5]); w.w = pk2(o[6], o[7]);
            if (c8 < 16) *(u32x4*)(SG + t * LD128 + c8 * 8) = w; else *(u32x4*)(XV + t * 520 + (c8 - 16) * 8) = w;
        }
        for (int q = tid; q < 32 * 64; q += NTHREADS) {
            const int t = q >> 6, c8 = q & 63, tok = tok0 + t;
            float a0[8], a1[8];
            unpack8(*(const u32x4*)(YDIR + (size_t)tok * 512 + c8 * 8), a0); unpack8(*(const u32x4*)(YDIR + ((size_t)T_LAT + tok) * 512 + c8 * 8), a1);
            f32x4 s0 = {a0[0] + a1[0], a0[1] + a1[1], a0[2] + a1[2], a0[3] + a1[3]}, s1 = {a0[4] + a1[4], a0[5] + a1[5], a0[6] + a1[6], a0[7] + a1[7]};
            *(f32x4*)(YF + t * 516 + c8 * 8) = s0; *(f32x4*)(YF + t * 516 + c8 * 8 + 4) = s1;
        }
        __syncthreads();
        {
            unsigned q0[16], q1[16], zq[16];
#pragma unroll
            for (int k = 0; k < 16; ++k) {
                const int pi = wave * 16 + k, t = pi >> 2, h = pi & 3, tok = tok0 + t;
                const size_t o0 = (size_t)tok * 512 + h * 128 + 2 * lane;
                q0[k] = *(const unsigned*)(ODIR + o0); q1[k] = *(const unsigned*)(ODIR + (size_t)T_LAT * 512 + o0); zq[k] = *(const unsigned*)(PL + (size_t)tok * IN_COLS + 1536 + h * 128 + 2 * lane);
            }
            const float on0 = p.in[I_ONORM][2 * lane], on1 = p.in[I_ONORM][2 * lane + 1];
#pragma unroll
            for (int k = 0; k < 16; ++k) {
                const int pi = wave * 16 + k, t = pi >> 2, h = pi & 3, tok = tok0 + t;
                const size_t o0 = (size_t)tok * 512 + h * 128 + 2 * lane;
                const float a0 = bf2f((bf16_t)(q0[k] & 0xffffu)) + bf2f((bf16_t)(q1[k] & 0xffffu)), a1 = bf2f((bf16_t)(q0[k] >> 16)) + bf2f((bf16_t)(q1[k] >> 16));
                const float ss = wave_sum_fast(a0 * a0 + a1 * a1);
                const float rstd = frsq(ss * (1.f / 128.f) + 1e-6f);
                const float z0 = bf2f((bf16_t)(zq[k] & 0xffffu)), z1 = bf2f((bf16_t)(zq[k] >> 16));
                *(unsigned*)(OA + o0) = pk2(a0 * rstd * on0 * fsilu(z0), a1 * rstd * on1 * fsilu(z1));
            }
        }
        __syncthreads();
        {
            const int h = wave;
            f32x16 acc0 = zero16(), acc1 = zero16();
#pragma unroll
            for (int s2 = 0; s2 < 8; ++s2) {
                const bf16x8 a = ld_nat(SG + r * LD128, s2, hh);
                const bf16x8 b0 = *(const bf16x8*)(G2T + (size_t)(64 * h + r) * 128 + 16 * s2 + 8 * hh), b1 = *(const bf16x8*)(G2T + (size_t)(64 * h + 32 + r) * 128 + 16 * s2 + 8 * hh);
                acc0 = MFMA32(a, b0, acc0); acc1 = MFMA32(a, b1, acc1);
            }
            const int c0 = 64 * h + r, c1 = c0 + 32;
            const float lg0 = p.in[I_LNG][c0], lb0 = p.in[I_LNB][c0], lg1 = p.in[I_LNG][c1], lb1 = p.in[I_LNB][c1];
            float bonv[16];
#pragma unroll
            for (int g = 0; g < 16; ++g) { const int tok = tok0 + crow(g, hh); bonv[g] = BON[(size_t)tok * 8 + h] + BON[((size_t)T_LAT + tok) * 8 + h]; }
#pragma unroll
            for (int g = 0; g < 16; ++g) {
                const int i = crow(g, hh), tok = tok0 + i;
                const float y0 = YF[i * 516 + c0], y1 = YF[i * 516 + c1];
                const float mean = half_sum(y0 + y1, hh) * (1.f / 64.f); const float d0 = y0 - mean, d1 = y1 - mean;
                const float var = half_sum(d0 * d0 + d1 * d1, hh) * (1.f / 64.f); const float rs = frsq(var + 64e-5f);
                const float bon = bonv[g];
                const float o0 = (d0 * rs * lg0 + lb0 + bon * bf2f(XV[i * 520 + c0])) * acc0[g], o1 = (d1 * rs * lg1 + lb1 + bon * bf2f(XV[i * 520 + c1])) * acc1[g];
                OB[(size_t)tok * 512 + c0] = f2bf(o0); OB[(size_t)tok * 512 + c1] = f2bf(o1);
            }
        }
    }
}

DI void phase5(const Params& p, char* smem) {
    const bf16_t* OA = (const bf16_t*)(p.ws + WS_OA); const bf16_t* OB = (const bf16_t*)(p.ws + WS_OB);
    const bf16_t* WA = (const bf16_t*)(p.ws + WS_WOA); const bf16_t* WB = (const bf16_t*)(p.ws + WS_WOB);
    const bf16_t* PL = (const bf16_t*)(p.ws + WS_PLAT); bf16_t* Y = (bf16_t*)(p.aux + AUX_Y);
    if (USE_G8) {
        constexpr int NT8 = D / 256, MT8 = T_LAT / 256;
        constexpr int GLD = 264;
        static_assert(256 * GLD * 2 <= LDS_BYTES, "gate tile lds");
        bf16_t* GT = (bf16_t*)smem;
        auto stage_gates = [&](int brow, int gcol0) {
            const int tid = tid_x();
            u32x4 gv[16];
#pragma unroll
            for (int i = 0; i < 16; ++i) { const int ch = tid + i * NTHREADS, row = ch >> 5, c16 = ch & 31; gv[i] = *(const u32x4*)(PL + (size_t)(brow + row) * IN_COLS + gcol0 + c16 * 8); }
#pragma unroll
            for (int i = 0; i < 16; ++i) { const int ch = tid + i * NTHREADS, row = ch >> 5, c16 = ch & 31; *(u32x4*)(GT + row * GLD + c16 * 8) = gv[i]; }
            __syncthreads();
        };
        for (int t = blockIdx.x; t < MT8 * NT8; t += gridDim.x) {
            int mt, nt; if (!g8::tile_order(t, MT8, NT8, mt, nt)) break;
            const int brow = mt * 256, bcol = nt * 256;
            g8::Acc acc; g8::acc_zero(acc);
            g8::kloop(acc, smem, OA, 512, WA, 512, 512, brow, bcol);
            stage_gates(brow, COL_G0 + bcol);
            g8::for_each_quad(acc, brow, bcol, [&](int row, int col, const f32x4& v) {
                const u32x2 gq = *(const u32x2*)(GT + (row - brow) * GLD + (col - bcol));
                const float g0 = bf2f((bf16_t)(gq.x & 0xffffu)), g1 = bf2f((bf16_t)(gq.x >> 16)), g2 = bf2f((bf16_t)(gq.y & 0xffffu)), g3 = bf2f((bf16_t)(gq.y >> 16));
                u32x2 o; o.x = pk2(fsigmoid(g0) * v.x, fsigmoid(g1) * v.y); o.y = pk2(fsigmoid(g2) * v.z, fsigmoid(g3) * v.w);
                *(u32x2*)(Y + (size_t)row * D + col) = o;
            });
            __syncthreads();
            g8::acc_zero(acc);
            g8::kloop(acc, smem, OB, 512, WB, 512, 512, brow, bcol);
            stage_gates(brow, COL_G0 + D + bcol);
            g8::for_each_quad(acc, brow, bcol, [&](int row, int col, const f32x4& v) {
                const u32x2 gq = *(const u32x2*)(GT + (row - brow) * GLD + (col - bcol));
                const float g0 = bf2f((bf16_t)(gq.x & 0xffffu)), g1 = bf2f((bf16_t)(gq.x >> 16)), g2 = bf2f((bf16_t)(gq.y & 0xffffu)), g3 = bf2f((bf16_t)(gq.y >> 16));
#ifdef EMU
                const unsigned long long tq = *(const unsigned long long*)(Y + (size_t)row * D + col);
#else
                const unsigned long long tq = __hip_atomic_load((const unsigned long long*)(Y + (size_t)row * D + col), __ATOMIC_RELAXED, __HIP_MEMORY_SCOPE_AGENT);
#endif
                const unsigned tlo = (unsigned)tq, thi = (unsigned)(tq >> 32);
                const float t0 = bf2f((bf16_t)(tlo & 0xffffu)), t1 = bf2f((bf16_t)(tlo >> 16)), t2 = bf2f((bf16_t)(thi & 0xffffu)), t3 = bf2f((bf16_t)(thi >> 16));
                u32x2 o; o.x = pk2(t0 + fsigmoid(g0) * v.x, t1 + fsigmoid(g1) * v.y); o.y = pk2(t2 + fsigmoid(g2) * v.z, t3 + fsigmoid(g3) * v.w);
                *(u32x2*)(Y + (size_t)row * D + col) = o;
            });
            __syncthreads();
        }
        return;
    }
    constexpr int MR5 = 2, BM5 = 64 * MR5; constexpr int NT = D / 128, MT = T_LAT / BM5;
    for (int t = blockIdx.x; t < MT * NT; t += gridDim.x) {
        const int mt = t / NT, nt = t % NT, row0 = mt * BM5;
        f32x4 acca[MR5][4], accb[MR5][4]; acc_zero(acca); acc_zero(accb);
        gemm_kloop(acca, smem, [&](int i) { return OA + (size_t)(row0 + i) * 512; }, WA + (size_t)nt * 128 * 512, 512, 512);
        gemm_kloop(accb, smem, [&](int i) { return OB + (size_t)(row0 + i) * 512; }, WB + (size_t)nt * 128 * 512, 512, 512);
        const int t2 = tid_x(), l2 = t2 & 63, w2 = t2 >> 6; const int wr = w2 >> 1, wc = w2 & 1, fr = l2 & 15, fq = l2 >> 4;
#pragma unroll
        for (int m = 0; m < MR5; ++m)
#pragma unroll
            for (int n = 0; n < 4; ++n)
#pragma unroll
                for (int j = 0; j < 4; ++j) {
                    const int row = row0 + wr * 16 * MR5 + m * 16 + fq * 4 + j, col = nt * 128 + wc * 64 + n * 16 + fr;
                    const float ga = bf2f(PL[(size_t)row * IN_COLS + COL_G0 + col]), gb = bf2f(PL[(size_t)row * IN_COLS + COL_G0 + D + col]);
                    Y[(size_t)row * D + col] = f2bf(sigmoidf_(ga) * acca[m][n][j] + sigmoidf_(gb) * accb[m][n][j]);
                }
    }
}

DI void phase6(const Params& p, char* smem) {
    const bf16_t* Y = (const bf16_t*)(p.aux + AUX_Y); const bf16_t* WO = (const bf16_t*)(p.ws + WS_WOUT);
    const float* mod = (const float*)(p.ws + WS_MOD); float* Hh = (float*)(p.ws + WS_H);
    if (USE_G8) {
        constexpr int NT = D / 256, MT = T_LAT / 256;
        const float* X = p.in[I_X];
        for (int t = blockIdx.x; t < MT * NT; t += gridDim.x) {
            int mt, nt; if (!g8::tile_order(t, MT, NT, mt, nt)) break;
            const int brow = mt * 256, bcol = nt * 256;
            g8::Acc acc; g8::acc_zero(acc);
            g8::kloop(acc, smem, Y, D, WO, D, D, brow, bcol);
            g8::for_each_quad(acc, brow, bcol, [&](int row, int col, const f32x4& v) {
                const int b = row / S; const f32x4 xv = *(const f32x4*)(X + (size_t)row * D + col), gv = *(const f32x4*)(mod + (size_t)b * 6 * D + 2 * D + col);
                f32x4 o; o.x = xv.x + gv.x * v.x; o.y = xv.y + gv.y * v.y; o.z = xv.z + gv.z * v.z; o.w = xv.w + gv.w * v.w;
                *(f32x4*)(Hh + (size_t)row * D + col) = o;
            });
        }
    } else {
        const int tid = tid_x(), lane = tid & 63, wave = tid >> 6, wr = wave >> 1, wc = wave & 1, fr = lane & 15, fq = lane >> 4;
        constexpr int NT = D / 128, MT = T_LAT / BM;
        for (int t = blockIdx.x; t < MT * NT; t += gridDim.x) {
            const int mt = t / NT, nt = t % NT, row0 = mt * BM;
            f32x4 acc[MREP][4]; acc_zero(acc);
            gemm_kloop(acc, smem, [&](int i) { return Y + (size_t)(row0 + i) * D; }, WO + (size_t)nt * 128 * D, D, D);
#pragma unroll
            for (int m = 0; m < MREP; ++m)
#pragma unroll
                for (int n = 0; n < 4; ++n)
#pragma unroll
                    for (int j = 0; j < 4; ++j) {
                        const int row = row0 + wr * 16 * MREP + m * 16 + fq * 4 + j, col = nt * 128 + wc * 64 + n * 16 + fr, b = row / S;
                        Hh[(size_t)row * D + col] = p.in[I_X][(size_t)row * D + col] + mod[(size_t)b * 6 * D + 2 * D + col] * acc[m][n][j];
                    }
        }
    }
    __syncthreads();
    const int tid6 = tid_x(), lane = tid6 & 63, wave = tid6 >> 6;
    const int gw = blockIdx.x * 8 + wave, ngw = gridDim.x * 8;
    float* scr = (float*)smem + wave * (64 * 33);
    bf16_t* DNT = (bf16_t*)(p.ws + WS_DNT);
    {
        constexpr int nkb = DE / 64, nnb = D / 32, per = nkb * nnb;
        for (int it = gw; it < NEXP * per; it += ngw) {
            const int e = it / per, r2 = it % per, kb = r2 / nnb, nb = r2 % nnb;
            transpose_item(p.in[I_MD] + (size_t)e * DE * D, D, D, kb * 64, nb * 32, DNT + (size_t)e * D * DE, DE, 0, scr, lane);
        }
    }
}

#ifdef EMU
#define MFMA32F(a, b, c) emu_mfma32_f32((a), (b), (c))
#else
#define MFMA32F(a, b, c) __builtin_amdgcn_mfma_f32_32x32x2f32((a), (b), (c), 0, 0, 0)
#endif
constexpr int TB_LD = D + 4;
static_assert(32 * TB_LD * 4 <= LDS_BYTES && 8 * 32 * 64 * 4 <= LDS_BYTES, "phase7 lds");
DI void phase7(const Params& p, char* smem) {
    const int tid = tid_x(), lane = tid & 63, wave = tid >> 6, r = lane & 31, hh = lane >> 5;
    const float* Hh = (const float*)(p.ws + WS_H); const float* mod = (const float*)(p.ws + WS_MOD); const float* WRT = (const float*)(p.ws + WS_WRT);
    bf16_t* Tt = (bf16_t*)(p.ws + WS_T); int* cnt = (int*)(p.ws + WS_CNT); int* rowlist = (int*)(p.ws + WS_ROWLIST); float* pairw = (float*)(p.ws + WS_PAIRW);
    float* tb = (float*)smem;
    float* bias = (float*)(smem + LDS_BYTES - 1024);
    int* lcnt = (int*)(smem + LDS_BYTES - 768);
    int* lbase = lcnt + 32;
    if (tid < 36) bias[tid] = tid < 4 ? p.in[I_RGB][tid] : p.in[I_REB][tid - 4];
    f32x4 x[4][D / 256];
    int itn = blockIdx.x;
    if (itn < T_LAT / 32) {
#pragma unroll
        for (int tt = 0; tt < 4; ++tt)
#pragma unroll
            for (int j = 0; j < D / 256; ++j) x[tt][j] = *(const f32x4*)(Hh + (size_t)(itn * 32 + wave * 4 + tt) * D + j * 256 + lane * 4);
    }
    for (int it = blockIdx.x; it < T_LAT / 32; it += gridDim.x) {
        const int tok0 = it * 32;
        __syncthreads();
        if (tid < 32) lcnt[tid] = 0;
#pragma unroll
        for (int tt = 0; tt < 4; ++tt) {
            const int ti = wave * 4 + tt, tok = tok0 + ti, b = tok / S;
            float ss = 0.f;
#pragma unroll
            for (int j = 0; j < D / 256; ++j) ss += x[tt][j].x * x[tt][j].x + x[tt][j].y * x[tt][j].y + x[tt][j].z * x[tt][j].z + x[tt][j].w * x[tt][j].w;
            ss = wave_sum_fast(ss);
            const float rstd = frsq(ss * (1.0f / D) + 1e-6f);
#pragma unroll
            for (int j = 0; j < D / 256; ++j) {
                const int k = j * 256 + lane * 4;
                const f32x4 g = *(const f32x4*)(p.in[I_NFFN] + k), sh = *(const f32x4*)(mod + (size_t)b * 6 * D + 3 * D + k), sc = *(const f32x4*)(mod + (size_t)b * 6 * D + 4 * D + k);
                f32x4 o; o.x = x[tt][j].x * rstd * g.x * (1.f + sc.x) + sh.x; o.y = x[tt][j].y * rstd * g.y * (1.f + sc.y) + sh.y;
                o.z = x[tt][j].z * rstd * g.z * (1.f + sc.z) + sh.z; o.w = x[tt][j].w * rstd * g.w * (1.f + sc.w) + sh.w;
                *(f32x4*)(tb + ti * TB_LD + k) = o;
                u32x2 ob; ob.x = pk2(o.x, o.y); ob.y = pk2(o.z, o.w);
                *(u32x2*)(Tt + (size_t)tok * D + k) = ob;
            }
        }
        itn = it + gridDim.x;
        if (itn < T_LAT / 32) {
#pragma unroll
            for (int tt = 0; tt < 4; ++tt)
#pragma unroll
                for (int j = 0; j < D / 256; ++j) x[tt][j] = *(const f32x4*)(Hh + (size_t)(itn * 32 + wave * 4 + tt) * D + j * 256 + lane * 4);
        }
        LDS_BARRIER();
        f32x16 a0 = zero16(), a1 = zero16();
        {
            const int kbeg = wave * (D / 8);
            const float* arow = tb + r * TB_LD + kbeg + 4 * hh;
            const float* b0row = WRT + (size_t)(4 + r) * D + kbeg + 4 * hh;
            const float* b1row = WRT + (size_t)(r < 4 ? r : 0) * D + kbeg + 4 * hh;
            const float m1 = r < 4 ? 1.f : 0.f;
#pragma unroll 4
            for (int g = 0; g < D / 64; ++g) {
                const f32x4 av = *(const f32x4*)(arow + 8 * g), b0 = *(const f32x4*)(b0row + 8 * g); const f32x4 b1 = *(const f32x4*)(b1row + 8 * g) * m1;
                a0 = MFMA32F(av.x, b0.x, a0); a1 = MFMA32F(av.x, b1.x, a1); a0 = MFMA32F(av.y, b0.y, a0); a1 = MFMA32F(av.y, b1.y, a1);
                a0 = MFMA32F(av.z, b0.z, a0); a1 = MFMA32F(av.z, b1.z, a1); a0 = MFMA32F(av.w, b0.w, a0); a1 = MFMA32F(av.w, b1.w, a1);
            }
        }
        LDS_BARRIER();
        {
            float* part = tb + wave * (32 * 64);
#pragma unroll
            for (int g = 0; g < 16; ++g) { const int i = crow(g, hh); part[i * 64 + r] = a0[g]; part[i * 64 + 32 + r] = a1[g]; }
        }
        LDS_BARRIER();
        float lsum[4];
        {
            const int i = tid >> 4, c4 = (tid & 15) * 4;
#pragma unroll
            for (int e = 0; e < 4; ++e) { float sacc = 0.f;
#pragma unroll
                for (int w = 0; w < 8; ++w) sacc += tb[w * (32 * 64) + i * 64 + c4 + e];
                lsum[e] = sacc; }
        }
        LDS_BARRIER();
        { const int i = tid >> 4, c4 = (tid & 15) * 4;
#pragma unroll
          for (int e = 0; e < 4; ++e) tb[i * 64 + c4 + e] = lsum[e]; }
        LDS_BARRIER();
        int ex1 = 0, ex2 = 0, rk1 = 0, rk2 = 0; float w1 = 0.f, w2 = 0.f;
        if (tid < 32) {
            const float* L = tb + tid * 64;
            float gl[4];
#pragma unroll
            for (int i = 0; i < 4; ++i) gl[i] = L[32 + i] + bias[i];
            int g = 0; float mx = gl[0];
#pragma unroll
            for (int i = 1; i < 4; ++i) if (gl[i] > mx) { mx = gl[i]; g = i; }
            float se = 0.f;
#pragma unroll
            for (int i = 0; i < 4; ++i) se += fexp(gl[i] - mx);
            const float pg = 1.0f / se;
            int i1 = 0; float l1 = L[g * 8] + bias[4 + g * 8];
            for (int i = 1; i < 8; ++i) { const float v = L[g * 8 + i] + bias[4 + g * 8 + i]; if (v > l1) { l1 = v; i1 = i; } }
            int i2 = -1; float l2 = -3.0e38f;
            for (int i = 0; i < 8; ++i) { const float v = L[g * 8 + i] + bias[4 + g * 8 + i]; if (i != i1 && v > l2) { l2 = v; i2 = i; } }
            const float e2 = fexp(l2 - l1); w1 = pg / (1.f + e2); w2 = pg * e2 / (1.f + e2);
            ex1 = g * 8 + i1; ex2 = g * 8 + i2;
            rk1 = atomicAdd(&lcnt[ex1], 1); rk2 = atomicAdd(&lcnt[ex2], 1);
        }
        LDS_BARRIER();
        if (tid < 32) { const int c = lcnt[tid]; lbase[tid] = c ? atomicAdd(&cnt[tid * CNT_STRIDE], c) : 0; }
        __syncthreads();
        if (tid < 32) {
            const int tok = tok0 + tid;
            rowlist[(size_t)ex1 * CAP + lbase[ex1] + rk1] = tok * 2; pairw[tok * 2] = w1;
            rowlist[(size_t)ex2 * CAP + lbase[ex2] + rk2] = tok * 2 + 1; pairw[tok * 2 + 1] = w2;
        }
    }
}

constexpr int MOE_TM = USE_G8 ? 256 : BM;
DI void moe_tiles(const Params& p, char* smem, int* pre) {
    const int* cnt = (const int*)(p.ws + WS_CNT);
    __syncthreads();
    if (tid_x() == 0) { int s = 0; for (int e = 0; e < NEXP; ++e) { pre[e] = s; s += (cnt[e * CNT_STRIDE] + MOE_TM - 1) / MOE_TM; } pre[NEXP] = s; }
    __syncthreads();
}
DI void moe_up_tile(const Params& p, char* smem, const int* pre, int t) {
    const int* cnt = (const int*)(p.ws + WS_CNT); const int* rowlist = (const int*)(p.ws + WS_ROWLIST);
    const bf16_t* Tt = (const bf16_t*)(p.ws + WS_T); const bf16_t* GUT = (const bf16_t*)(p.aux + AUX_GUT); bf16_t* HID = (bf16_t*)(p.ws + WS_HID);
    const int mg = t >> 1, nt = t & 1; int e = 0;
    while (pre[e + 1] <= mg) ++e;
    const int mt = mg - pre[e], ce = cnt[e * CNT_STRIDE]; const int* rl = rowlist + (size_t)e * CAP;
    g8::Acc acc; g8::acc_zero(acc);
    g8::kloop_g(acc, smem, Tt, [&](int r) { int idx = mt * 256 + r; idx = idx < ce ? idx : ce - 1; return (rl[idx] >> 1) * D; }, GUT + ((size_t)e * 512 + nt * 256) * D, D, D, 0);
    const int t2 = tid_x(), wid = t2 >> 6, l2 = t2 & 63, wr2 = wid >> 2, wc2 = wid & 3, fr2 = l2 & 15, fq2 = l2 >> 4;
    int prs[2][4];
#pragma unroll
    for (int ai = 0; ai < 2; ++ai)
#pragma unroll
        for (int m = 0; m < 4; ++m) { const int idx = mt * 256 + ai * 128 + wr2 * 64 + m * 16 + fr2; prs[ai][m] = idx < ce ? rl[idx] : -1; }
#pragma unroll
    for (int ai = 0; ai < 2; ++ai)
#pragma unroll
        for (int m = 0; m < 4; ++m) {
            if (prs[ai][m] >= 0) {
                const int pair = prs[ai][m];
#pragma unroll
                for (int bj = 0; bj < 2; ++bj) {
                    const f32x4 g = acc[ai][bj][m][0], u = acc[ai][bj][m][1];
                    u32x2 o; o.x = pk2(fsilu(g.x) * u.x, fsilu(g.y) * u.y); o.y = pk2(fsilu(g.z) * u.z, fsilu(g.w) * u.w);
                    *(u32x2*)(HID + (size_t)pair * DE + nt * 128 + bj * 64 + wc2 * 16 + fq2 * 4) = o;
                }
            }
        }
}
DI void moe_down_tile(const Params& p, char* smem, const int* pre, int t) {
    constexpr int NT8 = D / 256;
    const int* cnt = (const int*)(p.ws + WS_CNT); const int* rowlist = (const int*)(p.ws + WS_ROWLIST); const float* pairw = (const float*)(p.ws + WS_PAIRW);
    const bf16_t* HID = (const bf16_t*)(p.ws + WS_HID); const bf16_t* DNT = (const bf16_t*)(p.ws + WS_DNT); bf16_t* OP = (bf16_t*)(p.ws + WS_OPAIR);
    const int mg = t / NT8, nt = t % NT8; int e = 0;
    while (pre[e + 1] <= mg) ++e;
    const int mt = mg - pre[e], ce = cnt[e * CNT_STRIDE]; const int* rl = rowlist + (size_t)e * CAP;
    g8::Acc acc; g8::acc_zero(acc);
    g8::kloop_g(acc, smem, HID, [&](int r) { int idx = mt * 256 + r; idx = idx < ce ? idx : ce - 1; return rl[idx] * DE; }, DNT + ((size_t)e * D + nt * 256) * DE, DE, DE, 0);
    {
        const int t2 = tid_x(), wid = t2 >> 6, l2 = t2 & 63, wr2 = wid >> 2, wc2 = wid & 3, fr2 = l2 & 15, fq2 = l2 >> 4;
        int prs[2][4]; float pws[2][4];
#pragma unroll
        for (int ai = 0; ai < 2; ++ai)
#pragma unroll
            for (int m = 0; m < 4; ++m) { const int idx = mt * 256 + ai * 128 + wr2 * 64 + m * 16 + fr2; prs[ai][m] = idx < ce ? rl[idx] : -1; }
#pragma unroll
        for (int ai = 0; ai < 2; ++ai)
#pragma unroll
            for (int m = 0; m < 4; ++m) pws[ai][m] = prs[ai][m] >= 0 ? pairw[prs[ai][m]] : 0.f;
#pragma unroll
        for (int ai = 0; ai < 2; ++ai)
#pragma unroll
            for (int m = 0; m < 4; ++m) {
                if (prs[ai][m] >= 0) {
                    const float w = pws[ai][m]; bf16_t* orow = OP + (size_t)prs[ai][m] * D + nt * 256 + wc2 * 32 + fq2 * 4;
#pragma unroll
                    for (int bj = 0; bj < 2; ++bj)
#pragma unroll
                        for (int n = 0; n < 2; ++n) { const f32x4 v = acc[ai][bj][m][n];
                            u32x2 o; o.x = pk2(v.x * w, v.y * w); o.y = pk2(v.z * w, v.w * w); *(u32x2*)(orow + bj * 128 + n * 16) = o; }
                }
            }
    }
}
DI void phase8(const Params& p, char* smem) {
    const int tid = tid_x(), lane = tid & 63, wave = tid >> 6, wr = wave >> 1, wc = wave & 1, fr = lane & 15, fq = lane >> 4;
    int* pre = (int*)(smem + LDS_BYTES - 256);
    moe_tiles(p, smem, pre);
    const int* cnt = (const int*)(p.ws + WS_CNT); const int* rowlist = (const int*)(p.ws + WS_ROWLIST);
    const bf16_t* Tt = (const bf16_t*)(p.ws + WS_T); const bf16_t* GUT = (const bf16_t*)(p.aux + AUX_GUT); bf16_t* HID = (bf16_t*)(p.ws + WS_HID);
    if (USE_G8) {
        if ((int)blockIdx.x < pre[NEXP] * 2) moe_up_tile(p, smem, pre, (int)blockIdx.x);
        return;
    }
    const int ntile = pre[NEXP] * 4;
    for (int t = blockIdx.x; t < ntile; t += gridDim.x) {
        const int mg = t >> 2, nt = t & 3; int e = 0;
        while (pre[e + 1] <= mg) ++e;
        const int mt = mg - pre[e], ce = cnt[e * CNT_STRIDE]; const int* rl = rowlist + (size_t)e * CAP;
        f32x4 acc[MREP][4]; acc_zero(acc);
        gemm_kloop(acc, smem, [&](int i) { int idx = mt * BM + i; idx = idx < ce ? idx : ce - 1; return Tt + (size_t)(rl[idx] >> 1) * D; }, GUT + ((size_t)e * 512 + nt * 128) * D, D, D);
#pragma unroll
        for (int m = 0; m < MREP; ++m)
#pragma unroll
            for (int j = 0; j < 4; ++j) {
                const int idx = mt * BM + wr * 16 * MREP + m * 16 + fq * 4 + j;
                if (idx < ce) {
                    const int pair = rl[idx];
#pragma unroll
                    for (int n = 0; n < 2; ++n) {
                        const float g = acc[m][n][j], u = acc[m][n + 2][j];
                        HID[(size_t)pair * DE + nt * 64 + wc * 32 + n * 16 + fr] = f2bf(siluf_(g) * u);
                    }
                }
            }
    }
}
DI void phase9(const Params& p, char* smem) {
    const int tid = tid_x(), lane = tid & 63, wave = tid >> 6, wr = wave >> 1, wc = wave & 1, fr = lane & 15, fq = lane >> 4;
    int* pre = (int*)(smem + LDS_BYTES - 256);
    moe_tiles(p, smem, pre);
    const int* cnt = (const int*)(p.ws + WS_CNT); const int* rowlist = (const int*)(p.ws + WS_ROWLIST); const float* pairw = (const float*)(p.ws + WS_PAIRW);
    const bf16_t* HID = (const bf16_t*)(p.ws + WS_HID); const bf16_t* DNT = (const bf16_t*)(p.ws + WS_DNT); bf16_t* OP = (bf16_t*)(p.ws + WS_OPAIR);
    if (USE_G8) {
        constexpr int NT8 = D / 256;
        const int G = (int)gridDim.x, NU = pre[NEXP] * 2, NU2 = NU > G ? NU - G : 0, ND = pre[NEXP] * NT8;
        int* cntw = (int*)(p.ws + WS_CNT);
        int* tk = (int*)(smem + LDS_BYTES - 512);
        for (;;) {
            __syncthreads();
            if (tid_x() == 0) *tk = atomicAdd(&cntw[CNT_TICKET], 1);
            __syncthreads();
            const int j = *tk;
            if (j >= NU2 + ND) break;
            if (j < NU2) {
                moe_up_tile(p, smem, pre, G + j);
#ifndef EMU
                asm volatile("s_waitcnt vmcnt(0)" ::: "memory");
#endif
                __syncthreads();
                if (tid_x() == 0) {
#ifndef EMU
                    __builtin_amdgcn_fence(__ATOMIC_RELEASE, "agent");
                    asm volatile("s_waitcnt vmcnt(0)" ::: "memory");
#endif
                    (void)atomicAdd(&cntw[CNT_U2DONE], 1);
                }
            } else {
                const int dt = j - NU2;
                if (2 * (dt / NT8) + 1 >= G) {
                    if (tid_x() == 0) {
#ifndef EMU
                        while (__hip_atomic_load(&cntw[CNT_U2DONE], __ATOMIC_RELAXED, __HIP_MEMORY_SCOPE_AGENT) < NU2) __builtin_amdgcn_s_sleep(2);
                        __builtin_amdgcn_fence(__ATOMIC_ACQUIRE, "agent");
                        asm volatile("s_waitcnt vmcnt(0)" ::: "memory");
#endif
                    }
                    __syncthreads();
                }
                moe_down_tile(p, smem, pre, dt);
            }
        }
        return;
    }
    constexpr int NT = D / 128;
    const int ntile = pre[NEXP] * NT;
    for (int t = blockIdx.x; t < ntile; t += gridDim.x) {
        const int mg = t / NT, nt = t % NT; int e = 0;
        while (pre[e + 1] <= mg) ++e;
        const int mt = mg - pre[e], ce = cnt[e * CNT_STRIDE]; const int* rl = rowlist + (size_t)e * CAP;
        f32x4 acc[MREP][4]; acc_zero(acc);
        gemm_kloop(acc, smem, [&](int i) { int idx = mt * BM + i; idx = idx < ce ? idx : ce - 1; return HID + (size_t)rl[idx] * DE; }, DNT + ((size_t)e * D + nt * 128) * DE, DE, DE);
#pragma unroll
        for (int m = 0; m < MREP; ++m)
#pragma unroll
            for (int j = 0; j < 4; ++j) {
                const int idx = mt * BM + wr * 16 * MREP + m * 16 + fq * 4 + j;
                if (idx < ce) {
                    const int pair = rl[idx]; const float w = pairw[pair];
#pragma unroll
                    for (int n = 0; n < 4; ++n) OP[(size_t)pair * D + nt * 128 + wc * 64 + n * 16 + fr] = f2bf(acc[m][n][j] * w);
                }
            }
    }
}

DI void phase10(const Params& p, char* smem) {
    const int lane = tid_x() & 63, wave = tid_x() >> 6;
    const int gw = blockIdx.x * 8 + wave, ngw = gridDim.x * 8;
    const float* Hh = (const float*)(p.ws + WS_H); const float* mod = (const float*)(p.ws + WS_MOD); const bf16_t* OP = (const bf16_t*)(p.ws + WS_OPAIR);
    for (int tok = gw; tok < T_LAT; tok += ngw) {
        const int b = tok / S;
        f32x4 x[D / 256]; float ss = 0.f;
#pragma unroll
        for (int j = 0; j < D / 256; ++j) {
            const int k = j * 256 + lane * 4;
            const f32x4 hv = *(const f32x4*)(Hh + (size_t)tok * D + k), g2 = *(const f32x4*)(mod + (size_t)b * 6 * D + 5 * D + k);
            const u32x2 p0 = *(const u32x2*)(OP + (size_t)(tok * 2) * D + k), p1 = *(const u32x2*)(OP + (size_t)(tok * 2 + 1) * D + k);
            f32x4 m;
            m.x = bf2f((bf16_t)(p0.x & 0xffffu)) + bf2f((bf16_t)(p1.x & 0xffffu)); m.y = bf2f((bf16_t)(p0.x >> 16)) + bf2f((bf16_t)(p1.x >> 16));
            m.z = bf2f((bf16_t)(p0.y & 0xffffu)) + bf2f((bf16_t)(p1.y & 0xffffu)); m.w = bf2f((bf16_t)(p0.y >> 16)) + bf2f((bf16_t)(p1.y >> 16));
            x[j].x = hv.x + g2.x * m.x; x[j].y = hv.y + g2.y * m.y; x[j].z = hv.z + g2.z * m.z; x[j].w = hv.w + g2.w * m.w;
            ss += x[j].x * x[j].x + x[j].y * x[j].y + x[j].z * x[j].z + x[j].w * x[j].w;
        }
        ss = wave_sum(ss);
        const float rstd = 1.0f / sqrtf(ss * (1.0f / D) + 1e-6f);
#pragma unroll
        for (int j = 0; j < D / 256; ++j) {
            const int k = j * 256 + lane * 4; const f32x4 g = *(const f32x4*)(p.in[I_FIN] + k);
            f32x4 o; o.x = x[j].x * rstd * g.x; o.y = x[j].y * rstd * g.y; o.z = x[j].z * rstd * g.z; o.w = x[j].w * rstd * g.w;
            *(f32x4*)(p.out + (size_t)tok * D + k) = o;
        }
    }
}

DI void run_phase(const Params& p, int ph, char* smem) {
    switch (ph) {
        case PH_MOD: phase0(p, smem); break;
        case PH_U: phase1(p, smem); break;
        case PH_P: phase2(p, smem); break;
        case PH_HALO: phase_halo(p, smem); break;
        case PH_FIR: phase_fir(p, smem); break;
        case PH_CHAINS: phase3(p, smem); break;
        case PH_POST: phase4(p, smem); break;
        case PH_MERGE: phase5(p, smem); break;
        case PH_WOUT: phase6(p, smem); break;
        case PH_ROUTER: phase7(p, smem); break;
        case PH_UP: phase8(p, smem); break;
        case PH_DOWN: phase9(p, smem); break;
        default: phase10(p, smem); break;
    }
}

#ifndef EMU
namespace cg = cooperative_groups;
#define XB_TMO      128
#define XB_XCNT(j)  (256  + 64 * (j))
#define XB_XSUB(j)  (1280 + 64 * (j))
#define XB_XGEN(j)  (2304 + 64 * (j))
#define XB_TOP      3328
#define XB_TOPGEN   3392
#define XB_SPIN_CAP (1u << 20)
DI unsigned xb_ld(unsigned* p) { return __hip_atomic_load(p, __ATOMIC_RELAXED, __HIP_MEMORY_SCOPE_AGENT); }
DI unsigned xb_add(unsigned* p, unsigned v) { return __hip_atomic_fetch_add(p, v, __ATOMIC_RELAXED, __HIP_MEMORY_SCOPE_AGENT); }
DI unsigned xb_xcc_id() { return (unsigned)__builtin_amdgcn_s_getreg((3 << 11) | 20) & 0xFu; }
#define XB_SPIN(cond, bar) do { unsigned _sp = 0; while (cond) { __builtin_amdgcn_s_sleep(1); \
    if ((++_sp & 255u) == 0u) { if (xb_ld(&(bar)[XB_TMO])) break; if (_sp > XB_SPIN_CAP) { atomicAdd(&(bar)[XB_TMO], 1u); break; } } } } while (0)
DI void xcd_barrier_post(unsigned* bar) { if (threadIdx.x == 0) (void)xb_add(&bar[XB_XCNT(xb_xcc_id())], 1u); }
DI void xcd_barrier_complete(unsigned* bar, unsigned x, unsigned& nloc, unsigned& nx) {
    const unsigned G = gridDim.x;
    unsigned sum, cnt, mine, sp = 0u;
    for (;;) {
        sum = 0u; cnt = 0u; mine = 0u;
#pragma unroll
        for (unsigned j = 0; j < 16; ++j) { const unsigned c = xb_ld(&bar[XB_XCNT(j)]); sum += c; cnt += (c > 0u) ? 1u : 0u; mine = (j == x) ? c : mine; }
        if (sum == G) break;
        __builtin_amdgcn_s_sleep(1);
        if ((++sp & 255u) == 0u) { if (xb_ld(&bar[XB_TMO])) break; if (sp > XB_SPIN_CAP) { atomicAdd(&bar[XB_TMO], 1u); break; } }
    }
    nloc = mine > 0u ? mine : 1u; nx = cnt > 0u ? cnt : 1u;
}
DI void xcd_barrier(unsigned* bar, volatile unsigned* st) {
    asm volatile("s_waitcnt vmcnt(0)" ::: "memory");
    __syncthreads();
    if (threadIdx.x == 0) {
        __builtin_amdgcn_s_waitcnt(0);
        const unsigned x = xb_xcc_id();
        unsigned nloc = st[0], nx = st[1];
        if (nloc == 0u) { xcd_barrier_complete(bar, x, nloc, nx); st[0] = nloc; st[1] = nx; }
        const unsigned old = xb_add(&bar[XB_XSUB(x)], 1u);
        const unsigned gen = old / nloc;
        if (old + 1u == (gen + 1u) * nloc) {
            __builtin_amdgcn_fence(__ATOMIC_RELEASE, "agent");
            asm volatile("s_waitcnt vmcnt(0)" ::: "memory");
            const unsigned og = xb_add(&bar[XB_TOP], 1u);
            const unsigned tg = og / nx;
            if (og + 1u == (tg + 1u) * nx) xb_add(&bar[XB_TOPGEN], 1u);
            else XB_SPIN(xb_ld(&bar[XB_TOPGEN]) == tg, bar);
            __builtin_amdgcn_fence(__ATOMIC_ACQUIRE, "agent");
            xb_add(&bar[XB_XGEN(x)], 1u);
            asm volatile("s_waitcnt vmcnt(0)" ::: "memory");
        } else {
            XB_SPIN(xb_ld(&bar[XB_XGEN(x)]) == gen, bar);
            __builtin_amdgcn_fence(__ATOMIC_ACQUIRE, "agent");
            asm volatile("s_waitcnt vmcnt(0)" ::: "memory");
        }
    }
    __syncthreads();
}
__global__ void __launch_bounds__(NTHREADS) mk_forward(Params p) {
    extern __shared__ __attribute__((aligned(16))) char smem[];
    cg::grid_group grid = cg::this_grid();
    typedef const Params __attribute__((address_space(4)))* KPtr;
    volatile unsigned* xst = (volatile unsigned*)(smem + LDS_BYTES);
    if (threadIdx.x < 2) xst[threadIdx.x] = 0u;
    if (p.ph_lo == 0x7fffffff) grid.sync();
    xcd_barrier_post((unsigned*)(p.ws + WS_XBAR));
#define PHASE(k, fn) { KPtr kp = (KPtr)__builtin_amdgcn_kernarg_segment_ptr(); asm volatile("" : "+s"(kp)); fn(*(const Params*)kp, smem); \
        unsigned* xbar = (unsigned*)(((const Params*)kp)->ws + WS_XBAR); \
        if ((k) + 1 < NPHASES) xcd_barrier(xbar, xst); }
    PHASE(0, phase0) PHASE(1, phase1) PHASE(2, phase2)
    if (!USE_G8) PHASE(3, phase_halo)
    PHASE(4, phase_fir) PHASE(5, phase3) PHASE(6, phase4)
    PHASE(7, phase5) PHASE(8, phase6) PHASE(9, phase7) PHASE(10, phase8) PHASE(11, phase9) PHASE(12, phase10)
#undef PHASE
}

extern "C" void kernel_launch(void* const* d_in, const int* in_sizes, int n_in, void* d_out, int out_size, void* d_ws, size_t ws_size, hipStream_t stream) {
    static int grid_blocks = 0;
    if (grid_blocks == 0) {
        if (n_in != 35 || out_size != T_LAT * D || ws_size < WS_END || (size_t)out_size * 4 < AUX_END) {
            fprintf(stderr, "kernel_launch: unexpected shapes (n_in %d out %d ws %zu need %zu aux need %zu)\n", n_in, out_size, ws_size, (size_t)WS_END, (size_t)AUX_END);
            grid_blocks = -1; return;
        }
        int dev = 0, cus = 0, per_cu = 0;
        hipGetDevice(&dev);
        hipDeviceGetAttribute(&cus, hipDeviceAttributeMultiprocessorCount, dev);
        hipFuncSetAttribute((const void*)mk_forward, hipFuncAttributeMaxDynamicSharedMemorySize, LDS_BYTES + 256);
        hipOccupancyMaxActiveBlocksPerMultiprocessor(&per_cu, (const void*)mk_forward, NTHREADS, LDS_BYTES + 256);
        if (per_cu < 1) { fprintf(stderr, "kernel_launch: occupancy query says %d blocks/CU\n", per_cu); per_cu = 1; }
        if (per_cu > 1) per_cu = 1;
        grid_blocks = cus * per_cu;
    }
    if (grid_blocks < 0) return;
    Params p{};
    for (int i = 0; i < 35; ++i) p.in[i] = (const float*)d_in[i];
    p.out = (float*)d_out; p.ws = (char*)d_ws; p.aux = (char*)d_out;
    p.ph_lo = 0; p.ph_hi = NPHASES;
    (void)hipMemsetAsync((char*)d_ws + WS_XBAR, 0, 3456 * 4, stream);
    void* args[] = {&p};
    hipError_t e = hipLaunchCooperativeKernel((const void*)mk_forward, dim3(grid_blocks), dim3(NTHREADS), args, LDS_BYTES + 256, stream);
    if (e != hipSuccess) fprintf(stderr, "cooperative launch failed: %s (grid %d)\n", hipGetErrorString(e), grid_blocks);
}
#endif
```

```cpp
#ifndef EMU
#include <hip/hip_runtime.h>
#include <hip/hip_cooperative_groups.h>
#include <cstdio>
#endif
#include <stdint.h>
#include <stddef.h>

#ifndef CFG_D
#define CFG_D 1024
#define CFG_B 8
#define CFG_S 2048
#define CFG_CTX 256
#endif
#ifndef MK_LAUNCHES
#define MK_LAUNCHES 1
#endif

typedef unsigned short bf16_t;
typedef short bf16x8 __attribute__((ext_vector_type(8)));
typedef float f32x4 __attribute__((ext_vector_type(4)));
typedef unsigned u32x4 __attribute__((ext_vector_type(4)));
typedef unsigned u32x2 __attribute__((ext_vector_type(2)));

#define DI __device__ __forceinline__
DI int tid_x() { int t = (int)threadIdx.x;
#ifndef EMU
    asm volatile("" : "+v"(t));
#endif
    return t; }

constexpr int D = CFG_D, NB = CFG_B, S = CFG_S, CTXL = CFG_CTX;
constexpr int GW = 64, ROWS = S / GW;
constexpr int T_CTX = NB * CTXL, T_LAT = NB * S, T_ALL = T_CTX + T_LAT;
constexpr int H_A = 4, H_B = 8;
constexpr int A_COLS = 2064, B_COLS = 1920;
constexpr int IN_COLS = A_COLS + B_COLS + 2 * D;
constexpr int COL_B0 = A_COLS, COL_G0 = A_COLS + B_COLS;
constexpr int CTX_COLS = COL_G0;
constexpr int NP = ((IN_COLS + 127) / 128) * 128;
constexpr int NEXP = 32, DE = 256;
constexpr int NV = NB + 1;
constexpr int NTHREADS = 512;
constexpr int MREP = (T_CTX % 256 == 0 && T_LAT % 256 == 0) ? 4 : 2;
constexpr int BM = 64 * MREP;
constexpr int NPHASES = 13;
enum { PH_MOD = 0, PH_U, PH_P, PH_HALO, PH_FIR, PH_CHAINS, PH_POST, PH_MERGE, PH_WOUT, PH_ROUTER, PH_UP, PH_DOWN, PH_FINAL };
constexpr int LDS_BYTES = 155648;
constexpr int CAP = T_LAT;

static_assert(D % 256 == 0 && S % 64 == 0 && CTXL % 64 == 0 && T_CTX % BM == 0 && T_LAT % BM == 0, "shape");

constexpr size_t al256(size_t x) { return (x + 255) & ~(size_t)255; }
constexpr int CNT_STRIDE = 64;
constexpr size_t WS_CNT = 512 + 3456 * 4 + 256;
constexpr int CNT_TICKET = 2 * CNT_STRIDE + 16, CNT_U2DONE = 3 * CNT_STRIDE + 16;
constexpr size_t WS_BAR = 256;
constexpr size_t WS_XBAR = 512;
constexpr size_t WS_MOD = 512 + 3456 * 4 + 256 + 32 * 64 * 4;
constexpr size_t WS_AB = al256(WS_MOD + (size_t)NV * 6 * D * 4);
constexpr size_t WS_BONUS = al256(WS_AB + (size_t)T_ALL * 16 * 4);
constexpr size_t WS_PAIRW = al256(WS_BONUS + (size_t)2 * T_LAT * 8 * 4);
constexpr size_t WS_ROWLIST = al256(WS_PAIRW + (size_t)T_LAT * 2 * 4);
constexpr size_t WS_WRT = al256(WS_ROWLIST + (size_t)NEXP * CAP * 4);
constexpr size_t WS_G2T = al256(WS_WRT + (size_t)36 * D * 4);
constexpr size_t WS_WOA = al256(WS_G2T + (size_t)512 * 128 * 2);
constexpr size_t WS_WOB = al256(WS_WOA + (size_t)D * 512 * 2);
constexpr size_t WS_WOUT = al256(WS_WOB + (size_t)D * 512 * 2);
constexpr size_t WS_OA = al256(WS_WOUT + (size_t)D * D * 2);
constexpr size_t WS_OB = al256(WS_OA + (size_t)T_LAT * 512 * 2);
constexpr size_t WS_HALO_A = WS_OA;
constexpr size_t WS_HALO_B = WS_OA + al256((size_t)(T_ALL / 64) * 4 * 1536 * 2);
static_assert(WS_HALO_B + (size_t)(T_ALL / 64) * 2 * 1920 * 2 <= WS_OB + (size_t)T_LAT * 512 * 2, "halo buffers");
constexpr size_t WS_DNT = WS_OA;
constexpr size_t WS_SPARE_END = al256(WS_OB + (size_t)T_LAT * 512 * 2) > al256(WS_DNT + (size_t)NEXP * D * DE * 2) ? al256(WS_OB + (size_t)T_LAT * 512 * 2) : al256(WS_DNT + (size_t)NEXP * D * DE * 2);
constexpr size_t WS_P = WS_SPARE_END;
constexpr size_t WS_PLAT = WS_P;
constexpr size_t WS_PCTX = al256(WS_PLAT + (size_t)T_LAT * IN_COLS * 2);
constexpr size_t WS_P_END = al256(WS_PCTX + (size_t)T_CTX * CTX_COLS * 2);
constexpr size_t WS_H = WS_P;
constexpr size_t WS_T = al256(WS_H + (size_t)T_LAT * D * 4);
constexpr size_t WS_HID = al256(WS_T + (size_t)T_LAT * D * 2);
constexpr size_t WS_OPAIR = al256(WS_HID + (size_t)T_LAT * 2 * DE * 2);
constexpr size_t WS_P2_END = al256(WS_OPAIR + (size_t)T_LAT * 2 * D * 2);
constexpr size_t WS_END = WS_P_END > WS_P2_END ? WS_P_END : WS_P2_END;
constexpr size_t AUX_WINT = 0;
constexpr size_t AUX_U = al256((size_t)NP * D * 2);
constexpr size_t AUX_YDIR = 0;
constexpr size_t AUX_Y = 0;
constexpr size_t AUX_GUT = (size_t)T_LAT * D * 2 > (size_t)2 * T_LAT * 512 * 2 ? (size_t)T_LAT * D * 2 : (size_t)2 * T_LAT * 512 * 2;
constexpr size_t AUX_END1 = AUX_U + (size_t)T_ALL * D * 2;
constexpr size_t AUX_END2 = AUX_YDIR + (size_t)2 * T_LAT * 512 * 2;
static_assert(AUX_YDIR + (size_t)2 * T_LAT * 512 * 2 <= AUX_GUT && AUX_Y + (size_t)T_LAT * D * 2 <= AUX_GUT, "aux overlap");
constexpr size_t AUX_END3 = AUX_GUT + (size_t)NEXP * 512 * D * 2;
constexpr size_t AUX_END = (AUX_END1 > AUX_END2 ? (AUX_END1 > AUX_END3 ? AUX_END1 : AUX_END3) : (AUX_END2 > AUX_END3 ? AUX_END2 : AUX_END3));

struct Params {
    const float* in[35];
    float* out;
    char* ws;
    char* aux;
    int ph_lo, ph_hi;
};
enum { I_X = 0, I_C, I_CTX, I_CCTX, I_ADAW, I_ADAB, I_NMIX, I_NFFN, I_WIN, I_CONV, I_ALOG, I_DTB, I_ONORM, I_MU, I_W0, I_W2, I_A0, I_A2, I_G2, I_KK, I_KA, I_RK, I_LNG, I_LNB, I_WOA, I_WOB, I_WOUT, I_RG, I_RGB, I_RE, I_REB, I_MG, I_MU_UP, I_MD, I_FIN };

DI float bf2f(bf16_t v) { union { unsigned u; float f; } x; x.u = ((unsigned)v) << 16; return x.f; }
#ifdef EMU
DI bf16_t f2bf(float f) { union { float f; unsigned u; } x; x.f = f; unsigned u = x.u; u += 0x7fffu + ((u >> 16) & 1u); return (bf16_t)(u >> 16); }
DI unsigned pk2(float lo, float hi) { return (unsigned)f2bf(lo) | ((unsigned)f2bf(hi) << 16); }
#else
typedef __bf16 hbf16x2 __attribute__((ext_vector_type(2)));
typedef float f32x2_ __attribute__((ext_vector_type(2)));
DI bf16_t f2bf(float f) { return __builtin_bit_cast(unsigned short, (__bf16)f); }
DI unsigned pk2(float lo, float hi) { const f32x2_ v = {lo, hi}; return __builtin_bit_cast(unsigned, __builtin_convertvector(v, hbf16x2)); }
#endif
DI float sigmoidf_(float x) { return 1.0f / (1.0f + expf(-x)); }
DI float siluf_(float x) { return x / (1.0f + expf(-x)); }
DI float softplusf_(float x) { return x > 20.f ? x : log1pf(expf(x)); }
DI float wave_sum(float v) {
#pragma unroll
    for (int o = 1; o < 64; o <<= 1) v += __shfl_xor(v, o);
    return v;
}
#ifdef EMU
#define MFMA16(a, b, c) emu_mfma16((a), (b), (c))
#define WAVE_SYNC() emu::wave_bar()
#else
#define MFMA16(a, b, c) __builtin_amdgcn_mfma_f32_16x16x32_bf16((a), (b), (c), 0, 0, 0)
#define WAVE_SYNC() asm volatile("s_waitcnt lgkmcnt(0)" ::: "memory")
#endif
#ifdef EMU
#define LDS_BARRIER() __syncthreads()
#else
#define LDS_BARRIER() do { asm volatile("s_waitcnt lgkmcnt(0)" ::: "memory"); __builtin_amdgcn_s_barrier(); asm volatile("" ::: "memory"); } while (0)
#endif

typedef float f32x16 __attribute__((ext_vector_type(16)));
typedef float f32x2_ac __attribute__((ext_vector_type(2)));
typedef short bf16x4 __attribute__((ext_vector_type(4)));
#ifdef EMU
#define MFMA32(a, b, c) emu_mfma32((a), (b), (c))
DI float fexp(float x) { return expf(x); }
DI float flog(float x) { return logf(x); }
DI float frcp(float x) { return 1.0f / x; }
DI float frsq(float x) { return 1.0f / sqrtf(x); }
DI float wave_sum_fast(float v) { return wave_sum(v); }
#else
#define MFMA32(a, b, c) __builtin_amdgcn_mfma_f32_32x32x16_bf16((a), (b), (c), 0, 0, 0)
DI float fexp(float x) { return __expf(x); }
DI float flog(float x) { return __logf(x); }
DI float frcp(float x) { return __builtin_amdgcn_rcpf(x); }
DI float frsq(float x) { return __builtin_amdgcn_rsqf(x); }
#define DPP_ADD(v, ctrl) ((v) + __builtin_bit_cast(float, __builtin_amdgcn_update_dpp(0, __builtin_bit_cast(int, (v)), (ctrl), 0xf, 0xf, false)))
DI float wave_sum_fast(float v) {
    v = DPP_ADD(v, 0xB1); v = DPP_ADD(v, 0x4E); v = DPP_ADD(v, 0x141); v = DPP_ADD(v, 0x140);
    const int iv = __builtin_bit_cast(int, v);
    return (__builtin_bit_cast(float, __builtin_amdgcn_readlane(iv, 0)) + __builtin_bit_cast(float, __builtin_amdgcn_readlane(iv, 16))) +
           (__builtin_bit_cast(float, __builtin_amdgcn_readlane(iv, 32)) + __builtin_bit_cast(float, __builtin_amdgcn_readlane(iv, 48)));
}
#endif
DI float fsigmoid(float x) { return frcp(1.0f + fexp(-x)); }
DI float fsilu(float x) { return x * fsigmoid(x); }
DI float fsoftplus(float x) { return fmaxf(x, 0.f) + flog(1.f + fexp(-fabsf(x))); }
DI float ftanh(float x) { return 1.0f - 2.0f * frcp(1.0f + fexp(2.0f * x)); }

constexpr int LDS_ROW = 40;
constexpr int GEMM_A_BYTES = BM * LDS_ROW * 2, GEMM_B_BYTES = 128 * LDS_ROW * 2;
template <int MR, class ARow>
DI void gemm_kloop(f32x4 (&acc)[MR][4], char* smem, ARow arow, const bf16_t* Bt, int ldb, int K) {
    constexpr int BM = 64 * MR;
    const int tid = tid_x(), lane = tid & 63, wave = tid >> 6, wr = wave >> 1, wc = wave & 1, fr = lane & 15, fq = lane >> 4;
    bf16_t* As = (bf16_t*)smem;
    bf16_t* Bs = (bf16_t*)(smem + 2 * GEMM_A_BYTES);
    constexpr int ACH = BM * 4 / NTHREADS;
    static_assert(ACH >= 1, "tile");
    const bf16_t* ap[ACH];
#pragma unroll
    for (int i = 0; i < ACH; ++i) { const int q = tid + i * NTHREADS; ap[i] = arow(q >> 2) + (q & 3) * 8; }
    const bf16_t* bp = Bt + (size_t)(tid >> 2) * ldb + (tid & 3) * 8;
    u32x4 ra[ACH], rb;
#pragma unroll
    for (int i = 0; i < ACH; ++i) ra[i] = *(const u32x4*)(ap[i]);
    rb = *(const u32x4*)(bp);
    const int nk = K / 32;
    for (int kt = 0; kt < nk; ++kt) {
        const int buf = kt & 1;
#pragma unroll
        for (int i = 0; i < ACH; ++i) { const int q = tid + i * NTHREADS; *(u32x4*)(As + (buf * BM + (q >> 2)) * LDS_ROW + (q & 3) * 8) = ra[i]; }
        *(u32x4*)(Bs + (buf * 128 + (tid >> 2)) * LDS_ROW + (tid & 3) * 8) = rb;
        __syncthreads();
        if (kt + 1 < nk) {
#pragma unroll
            for (int i = 0; i < ACH; ++i) ra[i] = *(const u32x4*)(ap[i] + (kt + 1) * 32);
            rb = *(const u32x4*)(bp + (kt + 1) * 32);
        }
        bf16x8 af[MR], bfr[4];
#pragma unroll
        for (int m = 0; m < MR; ++m) af[m] = *(const bf16x8*)(As + (buf * BM + wr * 16 * MR + m * 16 + fr) * LDS_ROW + fq * 8);
#pragma unroll
        for (int n = 0; n < 4; ++n) bfr[n] = *(const bf16x8*)(Bs + (buf * 128 + wc * 64 + n * 16 + fr) * LDS_ROW + fq * 8);
#pragma unroll
        for (int m = 0; m < MR; ++m)
#pragma unroll
            for (int n = 0; n < 4; ++n) acc[m][n] = MFMA16(af[m], bfr[n], acc[m][n]);
    }
    __syncthreads();
}
template <int MR>
DI void acc_zero(f32x4 (&acc)[MR][4]) {
#pragma unroll
    for (int m = 0; m < MR; ++m)
#pragma unroll
        for (int n = 0; n < 4; ++n) acc[m][n] = (f32x4){0.f, 0.f, 0.f, 0.f};
}

namespace g8 {
constexpr int BM = 256, BK = 64, HALF = 128, HT = HALF * BK;
constexpr int LDS_NEED = 8 * HT * 2;
DI int lds_byte(int r, int c) { const int st = (r >> 4) * 2 + (c >> 5), rr = r & 15, cc = c & 31, ob = rr * 64 + cc * 2; return st * 1024 + (ob ^ (((ob >> 9) & 1) << 5)); }
DI void stage_rc(int b, int& R, int& C) { const int st = b / 1024, sb = b % 1024, swz = sb ^ (((sb >> 9) & 1) << 5); R = (st >> 1) * 16 + swz / 64; C = (st & 1) * 32 + (swz % 64) / 2; }
#ifdef EMU
#define G8_GLDS(src, dst) emu_global_load_lds16((src), (dst))
#define G8_WAIT_V(n)
#define G8_WAIT_L(n)
#define G8_BAR __syncthreads()
#define G8_SCHED
#define G8_PRIO(x)
#else
#define G8_GLDS(src, dst) __builtin_amdgcn_global_load_lds((const unsigned*)(src), (__attribute__((address_space(3))) unsigned*)(dst), 16, 0, 0)
#define G8_WAIT_V(n) asm volatile("s_waitcnt vmcnt(" #n ")" ::: "memory")
#define G8_WAIT_L(n) asm volatile("s_waitcnt lgkmcnt(" #n ")" ::: "memory")
#define G8_BAR __builtin_amdgcn_s_barrier()
#define G8_SCHED __builtin_amdgcn_sched_barrier(0)
#define G8_PRIO(x) __builtin_amdgcn_s_setprio(x)
#endif
typedef f32x4 Acc[2][2][4][2];
template <class AOff>
DI void kloop_g(Acc& acc, char* smem, const bf16_t* A, AOff aoff, const bf16_t* Bt, int ldb, int K, int bcol) {
    bf16_t* shm = (bf16_t*)smem;
    const int tid = tid_x(), wid = tid >> 6, lane = tid & 63, wr = wid >> 2, wc = wid & 3, fr = lane & 15, fq = lane >> 4;
    int ao[2][2];
#pragma unroll
    for (int h = 0; h < 2; ++h)
#pragma unroll
        for (int i = 0; i < 2; ++i) { int R, C; stage_rc(tid * 16 + i * 8192, R, C); ao[h][i] = aoff(h * HALF + R) + C; }
#define G8_STAGE_A(P, h, kt) do { for (int _i = 0; _i < 2; ++_i) { const int _b = tid * 16 + _i * 8192; G8_GLDS(A + (size_t)ao[h][_i] + (size_t)(kt) * BK, (char*)(P) + _b); } } while (0)
#define G8_SA(b, h) (shm + ((b) * 2 + (h)) * HT)
#define G8_SB(b, h) (shm + (4 + (b) * 2 + (h)) * HT)
#define G8_STAGE(P, BASE, LD, br, kt) do { const bf16_t* _g = (BASE) + (size_t)(br) * (LD) + (size_t)(kt) * BK; \
    for (int _i = 0; _i < 2; ++_i) { const int _b = tid * 16 + _i * 8192; int _r, _c; stage_rc(_b, _r, _c); G8_GLDS(_g + (size_t)_r * (LD) + _c, (char*)(P) + _b); } } while (0)
#define G8_LDA(dst, b, h) for (int m = 0; m < 4; ++m) for (int k = 0; k < 2; ++k) dst[m][k] = *(const bf16x8*)((const char*)G8_SA(b, h) + lds_byte(wr * 64 + m * 16 + fr, k * 32 + fq * 8))
#define G8_LDB(dst, b, h) for (int n = 0; n < 2; ++n) for (int k = 0; k < 2; ++k) dst[n][k] = *(const bf16x8*)((const char*)G8_SB(b, h) + lds_byte(wc * 32 + n * 16 + fr, k * 32 + fq * 8))
#define G8_MMA(ai, bj, At_, Bt_) do { G8_PRIO(1); for (int m = 0; m < 4; ++m) for (int n = 0; n < 2; ++n) for (int k = 0; k < 2; ++k) \
    acc[ai][bj][m][n] = MFMA16(Bt_[n][k], At_[m][k], acc[ai][bj][m][n]); G8_PRIO(0); } while (0)
    bf16x8 At[4][2], B0[2][2], B1[2][2];
    const int nt = K / BK;
    G8_STAGE(G8_SB(0, 0), Bt, ldb, bcol, 0); G8_STAGE_A(G8_SA(0, 0), 0, 0);
    G8_STAGE(G8_SB(0, 1), Bt, ldb, bcol + HALF, 0); G8_STAGE_A(G8_SA(0, 1), 1, 0);
    if (wr == 1) G8_BAR;
    G8_WAIT_V(4); G8_BAR;
    G8_STAGE(G8_SB(1, 0), Bt, ldb, bcol, 1); G8_STAGE_A(G8_SA(1, 0), 0, 1); G8_STAGE(G8_SB(1, 1), Bt, ldb, bcol + HALF, 1);
    G8_WAIT_V(6); G8_BAR;
    for (int t = 0; t < nt - 2; t += 2) {
        G8_LDB(B0, 0, 0); G8_SCHED; G8_LDA(At, 0, 0); G8_STAGE_A(G8_SA(1, 1), 1, t + 1);
        G8_WAIT_L(8); G8_BAR; G8_WAIT_L(0); G8_MMA(0, 0, At, B0); G8_BAR; G8_SCHED;
        G8_LDB(B1, 0, 1); G8_STAGE(G8_SB(0, 0), Bt, ldb, bcol, t + 2);
        G8_BAR; G8_WAIT_L(0); G8_MMA(0, 1, At, B1); G8_BAR;
        G8_LDA(At, 0, 1); G8_STAGE_A(G8_SA(0, 0), 0, t + 2);
        G8_BAR; G8_WAIT_L(0); G8_MMA(1, 0, At, B0); G8_BAR; G8_SCHED;
        G8_STAGE(G8_SB(0, 1), Bt, ldb, bcol + HALF, t + 2);
        G8_WAIT_V(6); G8_BAR; G8_MMA(1, 1, At, B1); G8_BAR;
        G8_LDB(B0, 1, 0); G8_SCHED; G8_LDA(At, 1, 0); G8_STAGE_A(G8_SA(0, 1), 1, t + 2);
        G8_WAIT_L(8); G8_BAR; G8_WAIT_L(0); G8_MMA(0, 0, At, B0); G8_BAR; G8_SCHED;
        G8_LDB(B1, 1, 1); G8_STAGE(G8_SB(1, 0), Bt, ldb, bcol, t + 3);
        G8_BAR; G8_WAIT_L(0); G8_MMA(0, 1, At, B1); G8_BAR;
        G8_LDA(At, 1, 1); G8_STAGE_A(G8_SA(1, 0), 0, t + 3);
        G8_BAR; G8_WAIT_L(0); G8_MMA(1, 0, At, B0); G8_BAR; G8_SCHED;
        G8_STAGE(G8_SB(1, 1), Bt, ldb, bcol + HALF, t + 3);
        G8_WAIT_V(6); G8_BAR; G8_MMA(1, 1, At, B1); G8_BAR;
    }
    { G8_LDB(B0, 0, 0); G8_LDA(At, 0, 0); G8_STAGE_A(G8_SA(1, 1), 1, nt - 1);
      G8_BAR; G8_WAIT_L(0); G8_MMA(0, 0, At, B0); G8_BAR;
      G8_LDB(B1, 0, 1); G8_BAR; G8_WAIT_L(0); G8_MMA(0, 1, At, B1); G8_BAR;
      G8_LDA(At, 0, 1); G8_WAIT_V(4); G8_BAR; G8_WAIT_L(0); G8_MMA(1, 0, At, B0); G8_MMA(1, 1, At, B1); G8_BAR; }
    { G8_LDB(B0, 1, 0); G8_LDA(At, 1, 0); G8_WAIT_V(2); G8_BAR; G8_WAIT_L(0); G8_MMA(0, 0, At, B0); G8_BAR;
      G8_LDB(B1, 1, 1); G8_WAIT_V(0); G8_BAR; G8_WAIT_L(0); G8_MMA(0, 1, At, B1); G8_BAR;
      G8_LDA(At, 1, 1); G8_BAR; G8_WAIT_L(0); G8_MMA(1, 0, At, B0); G8_MMA(1, 1, At, B1); G8_BAR; }
    if (wr == 0) G8_BAR;
#undef G8_SA
#undef G8_SB
#undef G8_STAGE
#undef G8_STAGE_A
#undef G8_LDA
#undef G8_LDB
#undef G8_MMA
}
DI void kloop(Acc& acc, char* smem, const bf16_t* A, int lda, const bf16_t* Bt, int ldb, int K, int brow, int bcol) {
    kloop_g(acc, smem, A, [&](int r) { return (brow + r) * lda; }, Bt, ldb, K, bcol);
}
DI bool tile_order(int L, int nM, int nN, int& pm, int& pn) {
    constexpr int NXCD = 8, WGM = 8;
    const int nwg = nM * nN; if (L >= nwg) return false;
    int wgid = L; { const int q = nwg / NXCD, r = nwg % NXCD, xcd = wgid % NXCD, off = wgid / NXCD; wgid = (xcd < r ? xcd * (q + 1) : r * (q + 1) + (xcd - r) * q) + off; }
    const int nig = WGM * nN, gid = wgid / nig, fm = gid * WGM, gsz = (nM - fm) < WGM ? (nM - fm) : WGM;
    pm = fm + ((wgid % nig) % gsz); pn = (wgid % nig) / gsz; return true;
}
DI void acc_zero(Acc& acc) {
#pragma unroll
    for (int a = 0; a < 2; ++a)
#pragma unroll
        for (int b = 0; b < 2; ++b)
#pragma unroll
            for (int m = 0; m < 4; ++m)
#pragma unroll
                for (int n = 0; n < 2; ++n) acc[a][b][m][n] = (f32x4){0.f, 0.f, 0.f, 0.f};
}
template <class F> DI void for_each_quad(const Acc& acc, int brow, int bcol, F f) {
    const int tid = tid_x(), wid = tid >> 6, lane = tid & 63, wr = wid >> 2, wc = wid & 3, fr = lane & 15, fq = lane >> 4;
#pragma unroll
    for (int ai = 0; ai < 2; ++ai)
#pragma unroll
        for (int m = 0; m < 4; ++m)
#pragma unroll
            for (int bj = 0; bj < 2; ++bj)
#pragma unroll
                for (int n = 0; n < 2; ++n) f(brow + ai * HALF + wr * 64 + m * 16 + fr, bcol + bj * HALF + wc * 32 + n * 16 + fq * 4, acc[ai][bj][m][n]);
}
}

constexpr bool USE_G8 = ((NB * CTXL) % 256 == 0) && ((NB * S) % 256 == 0) && (NP % 256 == 0) && (D % 256 == 0) && (D >= 256);
DI int gu_row(int c, int up) {
    if (USE_G8) return (c >> 7) * 256 + ((c >> 6) & 1) * 128 + ((c >> 4) & 3) * 32 + (up ? 16 : 0) + (c & 15);
    return (c >> 6) * 128 + ((c >> 5) & 1) * 64 + ((c >> 4) & 1) * 16 + (c & 15) + (up ? 32 : 0);
}
DI void transpose_item(const float* W, int N, int Nvalid, int k0, int n0, bf16_t* WT, int ldt, int mode, float* scr, int lane) {
    float tv[32];
#pragma unroll
    for (int i = 0; i < 32; ++i) {
        const int kk = 2 * i + (lane >> 5), n = n0 + (lane & 31);
        tv[i] = (n < Nvalid) ? W[(size_t)(k0 + kk) * N + n] : 0.f;
    }
#pragma unroll
    for (int i = 0; i < 32; ++i) scr[(2 * i + (lane >> 5)) * 33 + (lane & 31)] = tv[i];
    WAVE_SYNC();
    const int c = lane & 7;
#pragma unroll
    for (int j = 0; j < 4; ++j) {
        const int nl = (lane >> 3) + 8 * j; const float* s = scr + (8 * c) * 33 + nl;
        u32x4 o; o.x = pk2(s[0], s[33]); o.y = pk2(s[2 * 33], s[3 * 33]); o.z = pk2(s[4 * 33], s[5 * 33]); o.w = pk2(s[6 * 33], s[7 * 33]);
        const int n = n0 + nl; const int row = mode == 0 ? n : gu_row(n, mode == 2);
        *(u32x4*)(WT + (size_t)row * ldt + k0 + 8 * c) = o;
    }
    WAVE_SYNC();
}
DI void transpose_matrix(const float* W, int K, int N, int Npad, bf16_t* WT, int mode, char* smem, int gw, int ngw, int& base) {
    const int lane = tid_x() & 63, wave = tid_x() >> 6;
    float* scr = (float*)smem + wave * (64 * 33);
    const int nkb = K / 64, nnb = Npad / 32, nitems = nkb * nnb;
    int first = ((gw - base) % ngw + ngw) % ngw;
    for (int it = first; it < nitems; it += ngw) {
        const int kb = it / nnb, nb = it % nnb;
        transpose_item(W, N, N, kb * 64, nb * 32, WT, K, mode, scr, lane);
    }
    base = (base + nitems) % ngw;
}

DI void phase0(const Params& p, char* smem) {
    const int tid = tid_x(), lane = tid & 63, wave = tid >> 6;
    if (blockIdx.x == 0 && tid < NEXP) ((int*)(p.ws + WS_CNT))[tid * CNT_STRIDE] = 0;
    if (blockIdx.x == 0 && tid < 2) ((int*)(p.ws + WS_CNT))[tid ? CNT_U2DONE : CNT_TICKET] = 0;
    if (blockIdx.x == 0 && tid == 0) *(unsigned*)(p.ws + WS_BAR) = 0u;
    float* sil = (float*)smem;
    float* red = sil + NV * D;
    const int nitems = 6 * D / 32;
    bool did = false;
    for (int it = blockIdx.x; it < nitems; it += gridDim.x) {
        if (!did) {
            for (int i = tid; i < NV * D; i += NTHREADS) { const int v = i / D, k = i % D; const float cv = v < NB ? p.in[I_C][v * D + k] : p.in[I_CCTX][k]; sil[i] = siluf_(cv); }
            did = true;
        }
        __syncthreads();
        const int col = it * 32 + (lane & 31), rp = lane >> 5;
        float acc[NV];
#pragma unroll
        for (int v = 0; v < NV; ++v) acc[v] = 0.f;
        const int r0 = wave * (D / 8);
        float wv[D / 16];
#pragma unroll
        for (int i = 0; i < D / 16; ++i) wv[i] = p.in[I_ADAW][(size_t)(r0 + 2 * i + rp) * (6 * D) + col];
#pragma unroll
        for (int i = 0; i < D / 16; ++i) {
            const int row = r0 + 2 * i + rp;
#pragma unroll
            for (int v = 0; v < NV; ++v) acc[v] += sil[v * D + row] * wv[i];
        }
#pragma unroll
        for (int v = 0; v < NV; ++v) red[((wave * 2 + rp) * NV + v) * 32 + (lane & 31)] = acc[v];
        __syncthreads();
        if (tid < NV * 32) {
            const int v = tid / 32, cl = tid % 32; float s = p.in[I_ADAB][it * 32 + cl];
            for (int g = 0; g < 16; ++g) s += red[(g * NV + v) * 32 + cl];
            ((float*)(p.ws + WS_MOD))[(size_t)v * 6 * D + it * 32 + cl] = s;
        }
    }
    __syncthreads();
    const int gw = blockIdx.x * 8 + wave, ngw = gridDim.x * 8; int base = 0;
    {
        float* scr = (float*)smem + wave * (64 * 33);
        const int nkb = D / 64, nnb = NP / 32, nitems2 = nkb * nnb;
        for (int it = gw; it < nitems2; it += ngw) { const int kb = it / nnb, nb = it % nnb; transpose_item(p.in[I_WIN], IN_COLS, IN_COLS, kb * 64, nb * 32, (bf16_t*)(p.aux + AUX_WINT), D, 0, scr, lane); }
        base = nitems2 % ngw;
    }
    { float* WRT = (float*)(p.ws + WS_WRT);
      for (int i = blockIdx.x * NTHREADS + tid; i < 36 * D; i += gridDim.x * NTHREADS) { const int j = i / D, k = i % D; WRT[i] = j < 4 ? p.in[I_RG][(size_t)k * 4 + j] : p.in[I_RE][(size_t)k * 32 + (j - 4)]; } }
    transpose_matrix(p.in[I_WOA], 512, D, D, (bf16_t*)(p.ws + WS_WOA), 0, smem, gw, ngw, base);
    transpose_matrix(p.in[I_WOB], 512, D, D, (bf16_t*)(p.ws + WS_WOB), 0, smem, gw, ngw, base);
    transpose_matrix(p.in[I_WOUT], D, D, D, (bf16_t*)(p.ws + WS_WOUT), 0, smem, gw, ngw, base);
    transpose_matrix(p.in[I_G2], 128, 512, 512, (bf16_t*)(p.ws + WS_G2T), 0, smem, gw, ngw, base);
}

constexpr int NSEG = T_ALL / 64, NSEG_CTX = T_CTX / 64;
DI void halo_store(const Params& p, int row, int col, const u32x2& o) {
    int seq, b, j;
    if (row < T_CTX) { seq = 0; b = row / CTXL; j = row % CTXL; } else { seq = 1; const int rr = row - T_CTX; b = rr / S; j = rr % S; }
    const int L = seq ? S : CTXL; const int segbase = seq ? NSEG_CTX + b * (S / 64) : b * (CTXL / 64);
    if (col < 1536) {
        const int jm = j & 63;
        if (jm >= 62 && j + 2 < L) { const int g = segbase + (j >> 6) + 1; *(u32x2*)((bf16_t*)(p.ws + WS_HALO_A) + ((size_t)g * 4 + (jm - 62)) * 1536 + col) = o; }
        if (jm < 2 && j >= 64) { const int g = segbase + (j >> 6) - 1; *(u32x2*)((bf16_t*)(p.ws + WS_HALO_A) + ((size_t)g * 4 + 2 + jm) * 1536 + col) = o; }
    } else if (col >= COL_B0 && col < COL_B0 + 1920) {
        const int js = seq ? (j % GW) * ROWS + j / GW : j; const int jm = js & 63;
        if (jm == 63 && js + 1 < L) { const int g = segbase + (js >> 6) + 1; *(u32x2*)((bf16_t*)(p.ws + WS_HALO_B) + ((size_t)g * 2 + 0) * 1920 + (col - COL_B0)) = o; }
        if (jm == 0 && js >= 64) { const int g = segbase + (js >> 6) - 1; *(u32x2*)((bf16_t*)(p.ws + WS_HALO_B) + ((size_t)g * 2 + 1) * 1920 + (col - COL_B0)) = o; }
    }
}
DI void halo_zero_fill(const Params& p) {
    const int tid = tid_x(), lane = tid & 63, wave = tid >> 6; const int gw = blockIdx.x * 8 + wave, ngw = gridDim.x * 8;
    bf16_t* HA = (bf16_t*)(p.ws + WS_HALO_A); bf16_t* HB = (bf16_t*)(p.ws + WS_HALO_B);
    for (int it = gw; it < NSEG * 2; it += ngw) {
        const int g = it >> 1, side = it & 1;
        const bool ctx = g < NSEG_CTX; const int sg = ctx ? g % (CTXL / 64) : (g - NSEG_CTX) % (S / 64); const int nsg = ctx ? CTXL / 64 : S / 64;
        const bool edge = side ? (sg == nsg - 1) : (sg == 0);
        if (!edge) continue;
        for (int c = lane; c < 384; c += 64) *(u32x4*)(HA + ((size_t)g * 4 + 2 * side) * 1536 + c * 8) = (u32x4){0u, 0u, 0u, 0u};
        for (int c = lane; c < 240; c += 64) *(u32x4*)(HB + ((size_t)g * 2 + side) * 1920 + c * 8) = (u32x4){0u, 0u, 0u, 0u};
    }
}
DI void phase1(const Params& p, char* smem) {
    if (USE_G8) halo_zero_fill(p);
    const int lane = tid_x() & 63, wave = tid_x() >> 6;
    const int gw = blockIdx.x * 8 + wave, ngw = gridDim.x * 8;
    const float* mod = (const float*)(p.ws + WS_MOD);
    bf16_t* U = (bf16_t*)(p.aux + AUX_U);
    auto rowsrc = [&](int r) -> const float* { return r < T_CTX ? p.in[I_CTX] + (size_t)r * D : p.in[I_X] + (size_t)(r - T_CTX) * D; };
    f32x4 xn[D / 256];
    if (gw < T_ALL) {
#pragma unroll
        for (int j = 0; j < D / 256; ++j) xn[j] = *(const f32x4*)(rowsrc(gw) + j * 256 + lane * 4);
    }
    for (int r = gw; r < T_ALL; r += ngw) {
        const int v = r < T_CTX ? NB : (r - T_CTX) / S;
        f32x4 x[D / 256]; float ss = 0.f;
#pragma unroll
        for (int j = 0; j < D / 256; ++j) { x[j] = xn[j]; ss += x[j].x * x[j].x + x[j].y * x[j].y + x[j].z * x[j].z + x[j].w * x[j].w; }
        if (r + ngw < T_ALL) {
#pragma unroll
            for (int j = 0; j < D / 256; ++j) xn[j] = *(const f32x4*)(rowsrc(r + ngw) + j * 256 + lane * 4);
        }
        ss = wave_sum_fast(ss);
        const float rstd = frsq(ss * (1.0f / D) + 1e-6f);
#pragma unroll
        for (int j = 0; j < D / 256; ++j) {
            const int k = j * 256 + lane * 4;
            const f32x4 g = *(const f32x4*)(p.in[I_NMIX] + k), sh = *(const f32x4*)(mod + (size_t)v * 6 * D + k), sc = *(const f32x4*)(mod + (size_t)v * 6 * D + D + k);
            float o0 = x[j].x * rstd * g.x * (1.f + sc.x) + sh.x, o1 = x[j].y * rstd * g.y * (1.f + sc.y) + sh.y;
            float o2 = x[j].z * rstd * g.z * (1.f + sc.z) + sh.z, o3 = x[j].w * rstd * g.w * (1.f + sc.w) + sh.w;
            u32x2 o; o.x = pk2(o0, o1); o.y = pk2(o2, o3);
            *(u32x2*)(U + (size_t)r * D + k) = o;
        }
    }
}

DI void phase2(const Params& p, char* smem) {
    const bf16_t* U = (const bf16_t*)(p.aux + AUX_U); const bf16_t* WT = (const bf16_t*)(p.aux + AUX_WINT);
    bf16_t* PL = (bf16_t*)(p.ws + WS_PLAT); bf16_t* PC = (bf16_t*)(p.ws + WS_PCTX); float* AB = (float*)(p.ws + WS_AB);
    if (USE_G8) {
        constexpr int NT = NP / 256, MT = T_ALL / 256, NT_CTX = (CTX_COLS + 255) / 256;
        for (int t = blockIdx.x; t < MT * NT; t += gridDim.x) {
            int mt, nt; if (!g8::tile_order(t, MT, NT, mt, nt)) break;
            const int brow = mt * 256, bcol = nt * 256; const bool isctx = brow < T_CTX;
            if (isctx && nt >= NT_CTX) continue;
            g8::Acc acc; g8::acc_zero(acc);
            g8::kloop(acc, smem, U, D, WT, D, D, brow, bcol);
            constexpr int OLD_ = 264; bf16_t* OT = (bf16_t*)smem;
            g8::for_each_quad(acc, brow, bcol, [&](int row, int col, const f32x4& v) {
                u32x2 o; o.x = pk2(v.x, v.y); o.y = pk2(v.z, v.w);
                *(u32x2*)(OT + (row - brow) * OLD_ + (col - bcol)) = o;
                if (col >= 2048 && col < 2064) *(f32x4*)(AB + (size_t)row * 16 + (col - 2048)) = v;
                halo_store(p, row, col, o);
            });
            __syncthreads();
            {
                const int tid = tid_x(); const int ncols = isctx ? CTX_COLS : IN_COLS;
                bf16_t* dst = isctx ? PC + (size_t)brow * CTX_COLS : PL + (size_t)(brow - T_CTX) * IN_COLS;
#pragma unroll
                for (int i = 0; i < 16; ++i) {
                    const int ch = tid + i * NTHREADS, row = ch >> 5, c8 = (ch & 31) * 8, col = bcol + c8;
                    if (col < ncols) *(u32x4*)(dst + (size_t)row * ncols + col) = *(const u32x4*)(OT + row * OLD_ + c8);
                }
            }
            __syncthreads();
        }
        return;
    }
    const int tid = tid_x(), lane = tid & 63, wave = tid >> 6, wr = wave >> 1, wc = wave & 1, fr = lane & 15, fq = lane >> 4;
    constexpr int NT = NP / 128, MT = T_ALL / BM, NT_CTX = (CTX_COLS + 127) / 128;
    for (int t = blockIdx.x; t < MT * NT; t += gridDim.x) {
        const int mt = t / NT, nt = t % NT; const int row0 = mt * BM; const bool isctx = row0 < T_CTX;
        if (isctx && nt >= NT_CTX) continue;
        f32x4 acc[MREP][4]; acc_zero(acc);
        gemm_kloop(acc, smem, [&](int i) { return U + (size_t)(row0 + i) * D; }, WT + (size_t)nt * 128 * D, D, D);
#pragma unroll
        for (int m = 0; m < MREP; ++m)
#pragma unroll
            for (int n = 0; n < 4; ++n)
#pragma unroll
                for (int j = 0; j < 4; ++j) {
                    const int row = row0 + wr * 16 * MREP + m * 16 + fq * 4 + j, col = nt * 128 + wc * 64 + n * 16 + fr; const float v = acc[m][n][j];
                    if (isctx) { if (col < CTX_COLS) PC[(size_t)row * CTX_COLS + col] = f2bf(v); }
                    else { if (col < IN_COLS) PL[(size_t)(row - T_CTX) * IN_COLS + col] = f2bf(v); }
                    if (col >= 2048 && col < 2064) AB[(size_t)row * 16 + (col - 2048)] = v;
                }
    }
}


DI int crow(int g, int h) { return (g & 3) + 8 * (g >> 2) + 4 * h; }
template <int S_> DI bf16x8 pack_acc(const f32x16& x) {
    u32x4 r;
    r.x = pk2(x[8 * S_ + 0], x[8 * S_ + 1]); r.y = pk2(x[8 * S_ + 2], x[8 * S_ + 3]); r.z = pk2(x[8 * S_ + 4], x[8 * S_ + 5]); r.w = pk2(x[8 * S_ + 6], x[8 * S_ + 7]);
    return __builtin_bit_cast(bf16x8, r);
}
DI bf16x8 ld_nat(const bf16_t* row, int s, int h) { return *(const bf16x8*)(row + 16 * s + 8 * h); }
DI bf16x8 ld_perm(const bf16_t* row, int s, int h) {
    const bf16x4 lo = *(const bf16x4*)(row + 16 * s + 4 * h), hi = *(const bf16x4*)(row + 16 * s + 8 + 4 * h);
    return __builtin_shufflevector(lo, hi, 0, 1, 2, 3, 4, 5, 6, 7);
}
DI f32x16 zero16() { f32x16 z;
#pragma unroll
    for (int i = 0; i < 16; ++i) z[i] = 0.f;
    return z; }
#define TGET(i) ((i) < 16 ? t0[(i) & 15] : t1[(i) & 15])
DI void invert32_col(const float* Lf, f32x16& t0, f32x16& t1, int c) {
#pragma unroll
    for (int i = 0; i < 32; ++i) {
        float s0 = 0.f, s1 = 0.f, s2 = 0.f, s3 = 0.f;
#pragma unroll
        for (int j4 = 0; j4 < (i + 3) / 4; ++j4) {
            const f32x4 l = *(const f32x4*)(Lf + i * 32 + 4 * j4);
            if (4 * j4 + 0 < i) s0 += l.x * TGET(4 * j4 + 0);
            if (4 * j4 + 1 < i) s1 += l.y * TGET(4 * j4 + 1);
            if (4 * j4 + 2 < i) s2 += l.z * TGET(4 * j4 + 2);
            if (4 * j4 + 3 < i) s3 += l.w * TGET(4 * j4 + 3);
        }
        float sm = -((s0 + s1) + (s2 + s3));
#ifndef EMU
        asm volatile("" : "+v"(sm));
#endif
        const float v = (i > c) ? sm : (i == c ? 1.f : 0.f);
        if (i < 16) t0[i & 15] = v; else t1[i & 15] = v;
    }
}

DI void seg_info(int g, int& seq, int& b, int& j0) {
    if (g < NSEG_CTX) { seq = 0; b = g / (CTXL / 64); j0 = (g % (CTXL / 64)) * 64; } else { const int g2 = g - NSEG_CTX; seq = 1; b = g2 / (S / 64); j0 = (g2 % (S / 64)) * 64; }
}
DI const bf16_t* seq_row(const Params& p, int seq, int b, int j, bool scan_order) {
    if (seq) { const int l = scan_order ? (j % ROWS) * GW + j / ROWS : j; return (const bf16_t*)(p.ws + WS_PLAT) + (size_t)(b * S + l) * IN_COLS; }
    return (const bf16_t*)(p.ws + WS_PCTX) + (size_t)(b * CTXL + j) * CTX_COLS;
}
DI void phase_halo(const Params& p, char* smem) {
    if (USE_G8) return;
    const int tid = tid_x(), lane = tid & 63, wave = tid >> 6;
    const int gw = blockIdx.x * 8 + wave, ngw = gridDim.x * 8;
    bf16_t* HA = (bf16_t*)(p.ws + WS_HALO_A); bf16_t* HB = (bf16_t*)(p.ws + WS_HALO_B);
    for (int it = gw; it < NSEG * 6; it += ngw) {
        const int g = it / 6, hr = it % 6; int seq, b, j0; seg_info(g, seq, b, j0);
        const int L = seq ? S : CTXL;
        if (hr < 4) {
            const int j = hr < 2 ? j0 - 2 + hr : j0 + 62 + hr; const bool ok = j >= 0 && j < L;
            const bf16_t* src = seq_row(p, seq, b, ok ? j : 0, false);
            for (int c = lane; c < 192; c += 64) { u32x4 v = {0u, 0u, 0u, 0u}; if (ok) v = *(const u32x4*)(src + c * 8); *(u32x4*)(HA + ((size_t)g * 4 + hr) * 1536 + c * 8) = v; }
        } else {
            const int j = hr == 4 ? j0 - 1 : j0 + 64; const bool ok = j >= 0 && j < L;
            const bf16_t* src = seq_row(p, seq, b, ok ? j : 0, true) + COL_B0;
            for (int c = lane; c < 240; c += 64) { u32x4 v = {0u, 0u, 0u, 0u}; if (ok) v = *(const u32x4*)(src + c * 8); *(u32x4*)(HB + ((size_t)g * 2 + (hr - 4)) * 1920 + c * 8) = v; }
        }
    }
}
DI f32x2_ac unpk2(unsigned w) { return (f32x2_ac){bf2f((bf16_t)(w & 0xffffu)), bf2f((bf16_t)(w >> 16))}; }
DI void unpack8(const u32x4& q, float (&f)[8]) {
    f[0] = bf2f((bf16_t)(q.x & 0xffffu)); f[1] = bf2f((bf16_t)(q.x >> 16)); f[2] = bf2f((bf16_t)(q.y & 0xffffu)); f[3] = bf2f((bf16_t)(q.y >> 16));
    f[4] = bf2f((bf16_t)(q.z & 0xffffu)); f[5] = bf2f((bf16_t)(q.z >> 16)); f[6] = bf2f((bf16_t)(q.w & 0xffffu)); f[7] = bf2f((bf16_t)(q.w >> 16));
}
DI float row16_sum(float v) {
#ifdef EMU
    v += __shfl_xor(v, 1); v += __shfl_xor(v, 2); v += __shfl_xor(v, 4); v += __shfl_xor(v, 8); return v;
#else
    v = DPP_ADD(v, 0xB1); v = DPP_ADD(v, 0x4E); v = DPP_ADD(v, 0x141); v = DPP_ADD(v, 0x140); return v;
#endif
}
DI void phase_fir(const Params& p, char* smem) {
    const int tid = tid_x(), lane = tid & 63, wave = tid >> 6;
    const int gw = blockIdx.x * 8 + wave, ngw = gridDim.x * 8;
    const bf16_t* HA = (const bf16_t*)(p.ws + WS_HALO_A); const bf16_t* HB = (const bf16_t*)(p.ws + WS_HALO_B);
    constexpr int NA = NSEG * 3, NBI = NSEG * 4;
    const u32x4 z4 = {0u, 0u, 0u, 0u};
    for (int it = gw; it < NA + NBI; it += ngw) {
        if (it < NA) {
            const int g = it / 3, s = it % 3; int seq, b, j0; seg_info(g, seq, b, j0);
            const int col = s * 512 + 8 * lane, ldp = seq ? IN_COLS : CTX_COLS;
            bf16_t* base = (bf16_t*)seq_row(p, seq, b, j0, false) + col;
            const bf16_t* hal = HA + (size_t)g * 4 * 1536 + col;
            float cw[5][8];
#pragma unroll
            for (int t = 0; t < 5; ++t) { const f32x4 w0 = *(const f32x4*)(p.in[I_CONV] + t * 1536 + col), w1 = *(const f32x4*)(p.in[I_CONV] + t * 1536 + col + 4);
                cw[t][0] = w0.x; cw[t][1] = w0.y; cw[t][2] = w0.z; cw[t][3] = w0.w; cw[t][4] = w1.x; cw[t][5] = w1.y; cw[t][6] = w1.z; cw[t][7] = w1.w; }
            u32x4 win[12], nxt[8];
            win[0] = *(const u32x4*)(hal); win[1] = *(const u32x4*)(hal + 1536);
            win[2] = *(const u32x4*)(base); win[3] = *(const u32x4*)(base + ldp);
#pragma unroll
            for (int i = 0; i < 8; ++i) win[4 + i] = *(const u32x4*)(base + (size_t)(2 + i) * ldp);
#pragma unroll 1
            for (int blk = 0; blk < 8; ++blk) {
                if (blk < 7) {
#pragma unroll
                    for (int i = 0; i < 8; ++i) { const int t = 8 * blk + 10 + i; nxt[i] = t < 64 ? *(const u32x4*)(base + (size_t)t * ldp) : *(const u32x4*)(hal + (size_t)(2 + (t - 64)) * 1536); }
                }
#pragma unroll
                for (int i = 0; i < 8; ++i) {
                    float a[8];
#pragma unroll
                    for (int e = 0; e < 8; ++e) a[e] = 0.f;
#pragma unroll
                    for (int t = 0; t < 5; ++t) { float x[8]; unpack8(win[i + t], x);
#pragma unroll
                        for (int e = 0; e < 8; ++e) a[e] += x[e] * cw[t][e]; }
                    float ss = 0.f;
#pragma unroll
                    for (int e = 0; e < 8; ++e) { a[e] = fsilu(a[e]); ss += a[e] * a[e]; }
                    if (s < 2) { const float sc = frsq(row16_sum(ss) + 1e-6f) * (s == 0 ? 0.08838834764831845f : 1.0f);
#pragma unroll
                        for (int e = 0; e < 8; ++e) a[e] *= sc; }
                    u32x4 o; o.x = pk2(a[0], a[1]); o.y = pk2(a[2], a[3]); o.z = pk2(a[4], a[5]); o.w = pk2(a[6], a[7]);
                    *(u32x4*)(base + (size_t)(8 * blk + i) * ldp) = o;
                }
#pragma unroll
                for (int i = 0; i < 4; ++i) win[i] = win[8 + i];
#pragma unroll
                for (int i = 0; i < 8; ++i) win[4 + i] = nxt[i];
            }
        } else {
            const int it2 = it - NA, g = it2 / 4, sl = it2 % 4; int seq, b, j0; seg_info(g, seq, b, j0);
            const int bcol = sl * 512 + 8 * lane; const bool act = bcol < 1920;
            const int bc = act ? bcol : 0, col = COL_B0 + bc;
            float mu8[8];
            { const f32x4 m0 = *(const f32x4*)(p.in[I_MU] + bc), m1 = *(const f32x4*)(p.in[I_MU] + bc + 4); mu8[0] = m0.x; mu8[1] = m0.y; mu8[2] = m0.z; mu8[3] = m0.w; mu8[4] = m1.x; mu8[5] = m1.y; mu8[6] = m1.z; mu8[7] = m1.w; }
            const bool th = (bc >= 1536 && bc < 1664);
            const bf16_t* hal = HB + (size_t)g * 2 * 1920 + bc;
            u32x4 win[10], nxt[8];
            win[0] = *(const u32x4*)(hal); win[1] = *(const u32x4*)(seq_row(p, seq, b, j0, true) + col);
#pragma unroll
            for (int i = 0; i < 8; ++i) win[2 + i] = *(const u32x4*)(seq_row(p, seq, b, j0 + 1 + i, true) + col);
#pragma unroll 1
            for (int blk = 0; blk < 8; ++blk) {
                if (blk < 7) {
#pragma unroll
                    for (int i = 0; i < 8; ++i) { const int t = 8 * blk + 9 + i; nxt[i] = t < 64 ? *(const u32x4*)(seq_row(p, seq, b, j0 + t, true) + col) : *(const u32x4*)(hal + 1920); }
                }
#pragma unroll
                for (int i = 0; i < 8; ++i) {
                    float pv[8], cu[8], nx[8], x[8]; unpack8(win[i], pv); unpack8(win[i + 1], cu); unpack8(win[i + 2], nx);
#pragma unroll
                    for (int e = 0; e < 8; ++e) { x[e] = cu[e] + (0.5f * (pv[e] + nx[e]) - cu[e]) * mu8[e]; if (th) x[e] = ftanh(x[e]); }
                    u32x4 o; o.x = pk2(x[0], x[1]); o.y = pk2(x[2], x[3]); o.z = pk2(x[4], x[5]); o.w = pk2(x[6], x[7]);
                    if (act) *(u32x4*)((bf16_t*)seq_row(p, seq, b, j0 + 8 * blk + i, true) + col) = o;
                }
                win[0] = win[8]; win[1] = win[9];
#pragma unroll
                for (int i = 0; i < 8; ++i) win[2 + i] = nxt[i];
            }
        }
    }
}

constexpr int GC = 32;
constexpr int G_NT = (CTXL + S) / GC;
constexpr int LD128 = 136, LD64 = 72, LD32 = 40;
DI void chunk_pos(int x, int d, int& seg, int& j0) {
    constexpr int n0 = CTXL / GC, n1 = S / GC;
    if (x < n0) { seg = 0; j0 = (d ? n0 - 1 - x : x) * GC; } else { seg = 1; const int xx = x - n0; j0 = (d ? n1 - 1 - xx : xx) * GC; }
}

template <class Emit>
DI void invert32_blocked(const float* Lf, bf16_t* scr, int lane, Emit emit) {
    bf16_t* T00T = scr; bf16_t* T11R = scr + 16 * LD32; bf16_t* L10R = scr + 2 * 16 * LD32; bf16_t* P1T = scr + 3 * 16 * LD32;
    const int blk = lane >> 5, c = lane & 15, r = lane & 31, fr = lane & 15, fq = lane >> 4;
    f32x16 t;
    const float* Lb = Lf + (16 * blk) * 32 + 16 * blk;
#pragma unroll
    for (int i = 0; i < 16; ++i) {
        float s0 = 0.f, s1 = 0.f, s2 = 0.f, s3 = 0.f;
#pragma unroll
        for (int j4 = 0; j4 < (i + 3) / 4; ++j4) {
            const f32x4 l = *(const f32x4*)(Lb + i * 32 + 4 * j4);
            if (4 * j4 + 0 < i) s0 += l.x * t[4 * j4 + 0];
            if (4 * j4 + 1 < i) s1 += l.y * t[4 * j4 + 1];
            if (4 * j4 + 2 < i) s2 += l.z * t[4 * j4 + 2];
            if (4 * j4 + 3 < i) s3 += l.w * t[4 * j4 + 3];
        }
        float sm = -((s0 + s1) + (s2 + s3));
#ifndef EMU
        asm volatile("" : "+v"(sm));
#endif
        t[i] = (i > c) ? sm : (i == c ? 1.f : 0.f);
    }
    if (r < 16) {
        if (blk == 0) {
#pragma unroll
            for (int q = 0; q < 4; ++q) { u32x2 o; o.x = pk2(t[4 * q], t[4 * q + 1]); o.y = pk2(t[4 * q + 2], t[4 * q + 3]); *(u32x2*)(T00T + c * LD32 + 4 * q) = o; }
        } else {
#pragma unroll
            for (int i = 0; i < 16; ++i) T11R[i * LD32 + c] = f2bf(t[i]);
        }
    }
    { const int i = lane >> 2, j4 = (lane & 3) * 4; const f32x4 l = *(const f32x4*)(Lf + (16 + i) * 32 + j4);
      u32x2 o; o.x = pk2(l.x, l.y); o.y = pk2(l.z, l.w); *(u32x2*)(L10R + i * LD32 + j4) = o; }
    WAVE_SYNC();
    const bf16x8 zf = {0, 0, 0, 0, 0, 0, 0, 0};
    f32x4 p1 = {0.f, 0.f, 0.f, 0.f};
    {
        const bf16x8 af = fq < 2 ? *(const bf16x8*)(L10R + fr * LD32 + 8 * fq) : zf, bfm = fq < 2 ? *(const bf16x8*)(T00T + fr * LD32 + 8 * fq) : zf;
        p1 = MFMA16(af, bfm, p1);
    }
    { u32x2 o; o.x = pk2(p1[0], p1[1]); o.y = pk2(p1[2], p1[3]); *(u32x2*)(P1T + fr * LD32 + 4 * fq) = o; }
    WAVE_SYNC();
    f32x4 p2 = {0.f, 0.f, 0.f, 0.f};
    {
        const bf16x8 af = fq < 2 ? *(const bf16x8*)(T11R + fr * LD32 + 8 * fq) : zf, bfm = fq < 2 ? *(const bf16x8*)(P1T + fr * LD32 + 8 * fq) : zf;
        p2 = MFMA16(af, bfm, p2);
    }
#pragma unroll
    for (int j = 0; j < 4; ++j) emit(16 + 4 * fq + j, fr, -p2[j]);
    if (r < 16) {
#pragma unroll
        for (int i = 0; i < 16; ++i) { emit(16 * blk + i, 16 * blk + c, t[i]); if (blk == 0) emit(i, 16 + c, 0.f); }
    }
}
constexpr int GL_Q = 0;
constexpr int GL_KT = GL_Q + 2 * 32 * LD128 * 2;
constexpr int GL_VT = GL_KT + 2 * 128 * LD32 * 2;
constexpr int GL_K = GL_VT + 2 * 128 * LD32 * 2;
constexpr int GL_QKM = GL_K + 32 * LD128 * 2;
constexpr int GL_LF = GL_QKM + 2 * 32 * LD32 * 2;
constexpr int GL_TP = GL_LF + 32 * 32 * 4;
constexpr int GL_TPP = GL_TP + 32 * LD32 * 2;
constexpr int GL_WN = GL_TPP + 2 * 32 * LD32 * 2;
constexpr int GL_SC = GL_WN + 32 * LD128 * 2;
constexpr int GL_GC = GL_SC + 2 * 8 * 32 * 4;
constexpr int GL_CW = GL_GC + 8 * 32 * 4;
constexpr int GL_INV = GL_CW + 5 * 3 * 128 * 4;
constexpr int GL_RAW = GL_INV + 4 * 32 * LD32 * 2;
constexpr int GL_END = GL_RAW + 32 * 384 * 2;
static_assert(GL_END <= LDS_BYTES, "gdn lds");

DI void gdn_chain2(const Params& p, char* smem, int item) {
    const int d = item / (NB * H_A), b = (item / H_A) % NB, h = item % H_A;
    const int tid = tid_x(), lane = tid & 63, wave0_ = tid >> 6;
    bf16_t* Qs = (bf16_t*)(smem + GL_Q); bf16_t* KTs = (bf16_t*)(smem + GL_KT); bf16_t* VTs = (bf16_t*)(smem + GL_VT); bf16_t* Ks = (bf16_t*)(smem + GL_K);
    bf16_t* QKMs = (bf16_t*)(smem + GL_QKM); float* Lf = (float*)(smem + GL_LF); bf16_t* Tp = (bf16_t*)(smem + GL_TP); bf16_t* Tpp = (bf16_t*)(smem + GL_TPP);
    bf16_t* Wn = (bf16_t*)(smem + GL_WN); float* SC = (float*)(smem + GL_SC); float* GCs = (float*)(smem + GL_GC); float* CW = (float*)(smem + GL_CW);
    const float alog = p.in[I_ALOG][d * 4 + h], dtb = p.in[I_DTB][d * 4 + h], negea = -expf(alog);
    bf16_t* ODIR = (bf16_t*)(p.ws + WS_OA);
    __syncthreads();
    f32x16 St[4];
#pragma unroll
    for (int ct = 0; ct < 4; ++ct) St[ct] = zero16();
    bf16_t* RAW = (bf16_t*)(smem + GL_RAW);
    float pa = 0.f, pbt = 0.f;
    auto prefetch = [&](int x, int wsel, int nw) {
        int seg, j0; chunk_pos(x, d, seg, j0);
        const int ldp = seg ? IN_COLS : CTX_COLS;
        const bf16_t* pbase = seg ? (const bf16_t*)(p.ws + WS_PLAT) + (size_t)b * S * IN_COLS : (const bf16_t*)(p.ws + WS_PCTX) + (size_t)b * CTXL * CTX_COLS;
        for (int inst = wsel; inst < 24; inst += nw) {
            const int q = inst * 64 + lane, row = q / 48, c16 = q % 48;
            const bf16_t* src = pbase + (size_t)(j0 + row) * ldp + (c16 >> 4) * 512 + h * 128 + (c16 & 15) * 8;
#ifdef EMU
            emu_global_load_lds16(src, (char*)RAW + q * 16);
#else
            __builtin_amdgcn_global_load_lds((const unsigned*)src, (__attribute__((address_space(3))) unsigned*)((char*)RAW + q * 16), 16, 0, 0);
#endif
        }
    };
    auto prefetch_ab = [&](int x) {
        int seg, j0; chunk_pos(x, d, seg, j0);
        const float* abbase = (const float*)(p.ws + WS_AB) + (size_t)(seg ? T_CTX + b * S : b * CTXL) * 16;
        const int jw = j0 + 4 * wave0_;
        if (lane < 4) { pa = abbase[(size_t)(jw + lane) * 16 + d * 4 + h]; pbt = abbase[(size_t)(jw + lane) * 16 + 8 + d * 4 + h]; }
    };
    prefetch(0, wave0_, 8); prefetch_ab(0);
#ifndef EMU
    asm volatile("s_waitcnt vmcnt(0)" ::: "memory");
#endif
    const int r0_ = lane & 31, hh0_ = lane >> 5;
    __syncthreads();
    for (int it = -1; it < G_NT; ++it) {
        int r = r0_, hh = hh0_, wave = wave0_;
#ifndef EMU
        asm volatile("" : "+v"(r), "+v"(hh), "+v"(wave));
#endif
        const int xn = it + 1, par = xn & 1;
        int segn = 0, j0n = 0; if (xn < G_NT) chunk_pos(xn, d, segn, j0n);
        if (xn < G_NT) {
            const int i0 = d ? (GC - 4 - 4 * wave) : 4 * wave;
            bf16_t kt[2][4], vt[2][4];
#pragma unroll
            for (int t = 0; t < 4; ++t) {
                const int e = d ? 3 - t : t, i = i0 + e;
                const unsigned wq = *(const unsigned*)(RAW + (4 * wave + t) * 384 + 2 * lane), wk = *(const unsigned*)(RAW + (4 * wave + t) * 384 + 128 + 2 * lane), wv = *(const unsigned*)(RAW + (4 * wave + t) * 384 + 256 + 2 * lane);
                *(unsigned*)(Qs + (par * 32 + i) * LD128 + 2 * lane) = wq;
                *(unsigned*)(Ks + i * LD128 + 2 * lane) = wk;
                kt[0][e] = (bf16_t)(wk & 0xffffu); kt[1][e] = (bf16_t)(wk >> 16); vt[0][e] = (bf16_t)(wv & 0xffffu); vt[1][e] = (bf16_t)(wv >> 16);
            }
#pragma unroll
            for (int q = 0; q < 2; ++q) {
                u32x2 o; o.x = (unsigned)kt[q][0] | ((unsigned)kt[q][1] << 16); o.y = (unsigned)kt[q][2] | ((unsigned)kt[q][3] << 16);
                *(u32x2*)(KTs + (par * 128 + 2 * lane + q) * LD32 + i0) = o;
                u32x2 o2; o2.x = (unsigned)vt[q][0] | ((unsigned)vt[q][1] << 16); o2.y = (unsigned)vt[q][2] | ((unsigned)vt[q][3] << 16);
                *(u32x2*)(VTs + (par * 128 + 2 * lane + q) * LD32 + i0) = o2;
            }
            if (lane < 4) { const int i = d ? (GC - 1 - 4 * wave - lane) : (4 * wave + lane);
                SC[(par * 8 + 0) * 32 + i] = negea * fsoftplus(pa + dtb); SC[(par * 8 + 1) * 32 + i] = fsigmoid(pbt); }
            if (xn + 1 < G_NT) prefetch_ab(xn + 1);
        }
        LDS_BARRIER();
        if (wave >= 4 && wave < 7 && xn + 1 < G_NT) {
            prefetch(xn + 1, wave - 4, 3);
#ifndef EMU
            asm volatile("s_waitcnt vmcnt(0)" ::: "memory");
#endif
        }
        if (xn < G_NT) {
            const float* graw = SC + (par * 8 + 0) * 32;
            float gcv = 0.f;
#pragma unroll
            for (int s4 = 0; s4 < 8; ++s4) { const f32x4 g4 = *(const f32x4*)(graw + 4 * s4);
                gcv += (4 * s4 + 0 <= r ? g4.x : 0.f) + (4 * s4 + 1 <= r ? g4.y : 0.f) + (4 * s4 + 2 <= r ? g4.z : 0.f) + (4 * s4 + 3 <= r ? g4.w : 0.f); }
            if (lane < 32) GCs[wave * 32 + r] = gcv;
            if (wave == 7 && lane < 32) {
                float gl = 0.f;
#pragma unroll
                for (int s4 = 0; s4 < 8; ++s4) { const f32x4 g4 = *(const f32x4*)(graw + 4 * s4); gl += (g4.x + g4.y) + (g4.z + g4.w); }
                const float be = SC[(par * 8 + 1) * 32 + r];
                SC[(par * 8 + 3) * 32 + r] = fexp(gcv); SC[(par * 8 + 4) * 32 + r] = fexp(gl - gcv); SC[(par * 8 + 5) * 32 + r] = be * fexp(gcv); SC[(par * 8 + 6) * 32 + r] = fexp(gl);
            }
            const int pr = wave >> 2, th = (wave >> 1) & 1, ch = wave & 1, fr = lane & 15, fq = lane >> 4;
            const bf16_t* arow = (pr == 0 ? Ks : Qs + par * 32 * LD128) + (16 * th + fr) * LD128 + 8 * fq; const bf16_t* brow = Ks + (16 * ch + fr) * LD128 + 8 * fq;
            f32x4 cc = {0.f, 0.f, 0.f, 0.f};
#pragma unroll
            for (int ks = 0; ks < 4; ++ks) cc = MFMA16(*(const bf16x8*)(arow + 32 * ks), *(const bf16x8*)(brow + 32 * ks), cc);
            WAVE_SYNC();
            const int jj = 16 * ch + fr; const float gj = GCs[wave * 32 + jj];
#pragma unroll
            for (int j = 0; j < 4; ++j) {
                const int i = 16 * th + 4 * fq + j; const float dec = fexp(GCs[wave * 32 + i] - gj);
                if (pr == 0) Lf[i * 32 + jj] = (jj < i) ? SC[(par * 8 + 1) * 32 + i] * cc[j] * dec : 0.f;
                else QKMs[(par * 32 + i) * LD32 + jj] = f2bf((jj <= i) ? cc[j] * dec : 0.f);
            }
        }
        LDS_BARRIER();
        if (wave == 7 && xn < G_NT) {
            const float* sb1 = SC + (par * 8 + 5) * 32; const float* sb0 = SC + (par * 8 + 1) * 32; bf16_t* Tppw = Tpp + par * 32 * LD32;
            invert32_blocked(Lf, (bf16_t*)(smem + GL_INV), lane, [&](int i, int c, float v) { Tp[i * LD32 + c] = f2bf(v * sb1[c]); Tppw[i * LD32 + c] = f2bf(v * sb0[c]); });
        }
        if (wave < 4 && it >= 0) {
            const int pc = it & 1; int seg = 0, j0 = 0; chunk_pos(it, d, seg, j0);
            const bf16_t* Qc = Qs + pc * 32 * LD128; const bf16_t* KTc = KTs + pc * 128 * LD32; const bf16_t* VTc = VTs + pc * 128 * LD32;
            const bf16_t* QKc = QKMs + pc * 32 * LD32; const bf16_t* Tc = Tpp + pc * 32 * LD32; const float* sc = SC + pc * 8 * 32;
            f32x16 vn = zero16();
#pragma unroll
            for (int s = 0; s < 2; ++s) vn = MFMA32(ld_nat(Tc + r * LD32, s, hh), ld_nat(VTc + (32 * wave + r) * LD32, s, hh), vn);
            f32x16 oacc = zero16();
#define GDN_KSTEP(s) { const bf16x8 sb = pack_acc<(s) & 1>(St[(s) >> 1]); vn = MFMA32(ld_perm(Wn + r * LD128, (s), hh), sb, vn); oacc = MFMA32(ld_perm(Qc + r * LD128, (s), hh), sb, oacc); }
            GDN_KSTEP(0) GDN_KSTEP(1) GDN_KSTEP(2) GDN_KSTEP(3) GDN_KSTEP(4) GDN_KSTEP(5) GDN_KSTEP(6) GDN_KSTEP(7)
#undef GDN_KSTEP
#pragma unroll
            for (int g = 0; g < 16; ++g) oacc[g] *= sc[3 * 32 + crow(g, hh)];
            { const bf16x8 v0 = pack_acc<0>(vn), v1 = pack_acc<1>(vn);
              oacc = MFMA32(ld_perm(QKc + r * LD32, 0, hh), v0, oacc); oacc = MFMA32(ld_perm(QKc + r * LD32, 1, hh), v1, oacc); }
#pragma unroll
            for (int g = 0; g < 16; ++g) vn[g] *= sc[4 * 32 + crow(g, hh)];
            const float ge = sc[6 * 32];
            { const bf16x8 v0 = pack_acc<0>(vn), v1 = pack_acc<1>(vn);
#pragma unroll
              for (int ct = 0; ct < 4; ++ct) {
#pragma unroll
                  for (int g = 0; g < 16; ++g) St[ct][g] *= ge;
                  St[ct] = MFMA32(ld_perm(KTc + (32 * ct + r) * LD32, 0, hh), v0, St[ct]);
                  St[ct] = MFMA32(ld_perm(KTc + (32 * ct + r) * LD32, 1, hh), v1, St[ct]);
              } }
            if (seg) {
#pragma unroll
                for (int g = 0; g < 16; ++g) {
                    const int i = crow(g, hh), j = d ? j0 + GC - 1 - i : j0 + i;
                    ODIR[((size_t)d * T_LAT + (size_t)b * S + j) * 512 + h * 128 + 32 * wave + r] = f2bf(oacc[g]);
                }
            }
        }
        LDS_BARRIER();
        if (xn < G_NT && wave < 4) {
            f32x16 acc = zero16();
#pragma unroll
            for (int s = 0; s < 2; ++s) acc = MFMA32(ld_nat(KTs + (par * 128 + 32 * wave + r) * LD32, s, hh), ld_nat(Tp + r * LD32, s, hh), acc);
#pragma unroll
            for (int q = 0; q < 4; ++q) {
                u32x2 o; o.x = pk2(-acc[4 * q], -acc[4 * q + 1]); o.y = pk2(-acc[4 * q + 2], -acc[4 * q + 3]);
                *(u32x2*)(Wn + r * LD128 + 32 * wave + 8 * q + 4 * hh) = o;
            }
        }
        LDS_BARRIER();
    }
}

constexpr int RL_RX = 0;
constexpr int RL_KX = RL_RX + 32 * 64 * 4;
constexpr int RL_VX = RL_KX + 32 * 64 * 4;
constexpr int RL_KK = RL_VX + 32 * 64 * 4;
constexpr int RL_LW = RL_KK + 32 * 64 * 4;
constexpr int RL_IC = RL_LW + 32 * 64 * 4;
constexpr int RL_PC = RL_IC + 32 * 64 * 4;
constexpr int RL_CST = RL_PC + 2 * 64 * 4;
constexpr int RL_TW = RL_CST + 4 * 64 * 4;
constexpr int RL_AL = RL_TW + 32 * LD64 * 2;
constexpr int RL_LF = RL_TW;
constexpr int RL_LAKT = RL_LF + 32 * 32 * 4;
constexpr int RL_TB = RL_LAKT + 32 * LD32 * 2;
static_assert(RL_TB + 32 * LD32 * 2 <= RL_AL + 32 * LD64 * 2, "overlay");
constexpr int RL_W2T = RL_AL + 32 * LD64 * 2;
constexpr int RL_A2T = RL_W2T + 64 * LD64 * 2;
constexpr int RL_AR = RL_A2T + 64 * LD64 * 2;
constexpr int RL_BR = RL_AR + 32 * LD64 * 2;
constexpr int RL_KR = RL_BR + 32 * LD64 * 2;
constexpr int RL_RR = RL_KR + 32 * LD64 * 2;
constexpr int RL_AT = RL_RR + 2 * 32 * LD64 * 2;
constexpr int RL_BHT = RL_AT + 64 * LD32 * 2;
constexpr int RL_KHT = RL_BHT + 2 * 64 * LD32 * 2;
constexpr int RL_VT = RL_KHT + 2 * 64 * LD32 * 2;
constexpr int RL_MRB = RL_VT + 2 * 64 * LD32 * 2;
constexpr int RL_MRK = RL_MRB + 2 * 32 * LD32 * 2;
constexpr int RL_WM = RL_MRK + 2 * 32 * LD32 * 2;
constexpr int RL_TL = RL_WM + 32 * LD64 * 2;
constexpr int RL_END = RL_TL + 32 * LD32 * 2;
static_assert(RL_END <= LDS_BYTES, "rwkv lds");

DI void rwkv_chain2(const Params& p, char* smem, int item) {
    const int d = item / (NB * H_B), b = (item / H_B) % NB, h = item % H_B;
    const int tid = tid_x(), lane = tid & 63, wave = tid >> 6;
    float* RX = (float*)(smem + RL_RX); float* KX = (float*)(smem + RL_KX); float* VX = (float*)(smem + RL_VX); float* KKs = (float*)(smem + RL_KK);
    float* LW = (float*)(smem + RL_LW); float* IC = (float*)(smem + RL_IC); float* Lf = (float*)(smem + RL_LF); float* PC = (float*)(smem + RL_PC); float* CST = (float*)(smem + RL_CST);
    bf16_t* TW = (bf16_t*)(smem + RL_TW); bf16_t* AL = (bf16_t*)(smem + RL_AL); bf16_t* W2T = (bf16_t*)(smem + RL_W2T); bf16_t* A2T = (bf16_t*)(smem + RL_A2T);
    bf16_t* Ar = (bf16_t*)(smem + RL_AR); bf16_t* Br = (bf16_t*)(smem + RL_BR); bf16_t* Kr = (bf16_t*)(smem + RL_KR); bf16_t* Rr = (bf16_t*)(smem + RL_RR);
    bf16_t* AT = (bf16_t*)(smem + RL_AT); bf16_t* BhT = (bf16_t*)(smem + RL_BHT); bf16_t* KhT = (bf16_t*)(smem + RL_KHT); bf16_t* VT = (bf16_t*)(smem + RL_VT);
    bf16_t* LakT = (bf16_t*)(smem + RL_LAKT); bf16_t* Mrb = (bf16_t*)(smem + RL_MRB); bf16_t* Mrk = (bf16_t*)(smem + RL_MRK); bf16_t* Tb = (bf16_t*)(smem + RL_TB);
    bf16_t* Wm = (bf16_t*)(smem + RL_WM); bf16_t* TLm = (bf16_t*)(smem + RL_TL);
    bf16_t* YDIR = (bf16_t*)(p.aux + AUX_YDIR); float* BON = (float*)(p.ws + WS_BONUS);
    __syncthreads();
    for (int i = tid; i < 64 * 64; i += NTHREADS) {
        const int c = i >> 6, rr = i & 63;
        W2T[c * LD64 + rr] = f2bf(p.in[I_W2][((size_t)d * 64 + rr) * 512 + h * 64 + c]); A2T[c * LD64 + rr] = f2bf(p.in[I_A2][((size_t)d * 64 + rr) * 512 + h * 64 + c]);
    }
    if (tid < 256) { const int w = tid >> 6, c = tid & 63, gc = h * 64 + c;
        CST[tid] = w == 0 ? p.in[I_W0][d * 512 + gc] : (w == 1 ? p.in[I_A0][d * 512 + gc] : (w == 2 ? p.in[I_KA][gc] : p.in[I_RK][gc])); }
    const float kkw = p.in[I_KK][h * 64 + lane];
    f32x16 Xt[2]; Xt[0] = zero16(); Xt[1] = zero16();
    bf16_t rawv[4][5];
    auto prefetch = [&](int x) {
        int seg, j0; chunk_pos(x, d, seg, j0);
        const int ldp = seg ? IN_COLS : CTX_COLS;
        const bf16_t* pb = seg ? (const bf16_t*)(p.ws + WS_PLAT) + (size_t)b * S * IN_COLS : (const bf16_t*)(p.ws + WS_PCTX) + (size_t)b * CTXL * CTX_COLS;
        const int jw = j0 + 4 * wave;
#pragma unroll
        for (int rr = 0; rr < 4; ++rr) {
            const int j = jw + rr; const int row = seg ? (j % ROWS) * GW + j / ROWS : j;
#pragma unroll
            for (int s = 0; s < 5; ++s) {
                const int bcol = (s < 3 ? s * 512 + h * 64 : (s == 3 ? 1536 + d * 64 : 1664 + d * 64)) + lane;
                rawv[rr][s] = pb[(size_t)row * ldp + COL_B0 + bcol];
            }
        }
    };
    prefetch(0);
    const int r0_ = lane & 31, hh0_ = lane >> 5;
    __syncthreads();
    for (int it = -1; it < G_NT; ++it) {
        int r = r0_, hh = hh0_;
#ifndef EMU
        asm volatile("" : "+v"(r), "+v"(hh));
#endif
        const int xn = it + 1, par = xn & 1;
        int segn = 0, j0n = 0; if (xn < G_NT) chunk_pos(xn, d, segn, j0n);
        if (xn < G_NT) {
#pragma unroll
            for (int t = 0; t < 4; ++t) {
                const int i = d ? (GC - 1 - 4 * wave - t) : (4 * wave + t);
                const float xr = bf2f(rawv[t][0]), xk = bf2f(rawv[t][1]), xv = bf2f(rawv[t][2]);
                const float kxk = xk * kkw; const float ss = wave_sum_fast(kxk * kxk);
                RX[i * 64 + lane] = xr; KX[i * 64 + lane] = xk; VX[i * 64 + lane] = xv; KKs[i * 64 + lane] = kxk * frsq(ss + 1e-6f);
                TW[i * LD64 + lane] = rawv[t][3]; AL[i * LD64 + lane] = rawv[t][4];
            }
            if (xn + 1 < G_NT) prefetch(xn + 1);
        }
        LDS_BARRIER();
        if (xn < G_NT) {
            const int which = wave >> 2, cg = wave & 3, fr = lane & 15, fq = lane >> 4;
            const bf16_t* arow0 = (which ? AL : TW) + fr * LD64 + 8 * fq; const bf16_t* brow = (which ? A2T : W2T) + (16 * cg + fr) * LD64 + 8 * fq;
            f32x4 c0 = {0.f, 0.f, 0.f, 0.f}, c1 = {0.f, 0.f, 0.f, 0.f};
#pragma unroll
            for (int ks = 0; ks < 2; ++ks) {
                const bf16x8 bfrag = *(const bf16x8*)(brow + 32 * ks);
                c0 = MFMA16(*(const bf16x8*)(arow0 + 32 * ks), bfrag, c0); c1 = MFMA16(*(const bf16x8*)(arow0 + 16 * LD64 + 32 * ks), bfrag, c1);
            }
            const int c = 16 * cg + fr; const float bias = CST[which * 64 + c];
#pragma unroll
            for (int th = 0; th < 2; ++th)
#pragma unroll
                for (int j = 0; j < 4; ++j) {
                    const int i = 16 * th + 4 * fq + j; const float z = bias + (th ? c1[j] : c0[j]);
                    if (which) IC[i * 64 + c] = fsigmoid(z);
                    else { const float wl = -fsoftplus(-z) - 0.5f; LW[i * 64 + c] = -fexp(wl); }
                }
        }
        LDS_BARRIER();
        if (xn < G_NT) {
            const int c = lane, i0 = 4 * wave;
            const float ka = CST[2 * 64 + c], rk = CST[3 * 64 + c];
            float lpb = 0.f, lpc = 0.f; float lw4[4];
#pragma unroll
            for (int s2 = 0; s2 < 32; ++s2) { const float w = LW[s2 * 64 + c]; lpc += w; if (s2 < i0) lpb += w; }
#pragma unroll
            for (int e = 0; e < 4; ++e) lw4[e] = LW[(i0 + e) * 64 + c];
            bf16_t ta[4], tb[4], tk[4], tv[4]; float bon[4];
            float lprun = lpb;
#pragma unroll
            for (int e = 0; e < 4; ++e) {
                const int i = i0 + e;
                const float lpm = lprun; lprun += lw4[e]; const float lp = lprun;
                const float Pi = fexp(lp), Pm = fexp(lpm), invP = fexp(-lp), PCi = fexp(lpc - lp);
                const float ic = IC[i * 64 + c], kxv = KX[i * 64 + c], kkv = KKs[i * 64 + c], rxv = RX[i * 64 + c], vxv = VX[i * 64 + c];
                const float kd = kxv * (1.f + (ic - 1.f) * ka), bb = kkv * ic, aa = -kkv;
                ta[e] = f2bf(aa * Pm); tb[e] = f2bf(bb * PCi); tk[e] = f2bf(kd * PCi); tv[e] = f2bf(vxv);
                Ar[i * LD64 + c] = ta[e]; Br[i * LD64 + c] = f2bf(bb * invP); Kr[i * LD64 + c] = f2bf(kd * invP); Rr[(par * 32 + i) * LD64 + c] = f2bf(rxv * Pi);
                bon[e] = wave_sum_fast(rxv * kd * rk);
            }
            { u32x2 o; o.x = (unsigned)ta[0] | ((unsigned)ta[1] << 16); o.y = (unsigned)ta[2] | ((unsigned)ta[3] << 16); *(u32x2*)(AT + c * LD32 + i0) = o; }
            { u32x2 o; o.x = (unsigned)tb[0] | ((unsigned)tb[1] << 16); o.y = (unsigned)tb[2] | ((unsigned)tb[3] << 16); *(u32x2*)(BhT + (par * 64 + c) * LD32 + i0) = o; }
            { u32x2 o; o.x = (unsigned)tk[0] | ((unsigned)tk[1] << 16); o.y = (unsigned)tk[2] | ((unsigned)tk[3] << 16); *(u32x2*)(KhT + (par * 64 + c) * LD32 + i0) = o; }
            { u32x2 o; o.x = (unsigned)tv[0] | ((unsigned)tv[1] << 16); o.y = (unsigned)tv[2] | ((unsigned)tv[3] << 16); *(u32x2*)(VT + (par * 64 + c) * LD32 + i0) = o; }
            if (wave == 7) PC[par * 64 + c] = fexp(lpc);
            if (segn && lane < 4) { const int i = i0 + lane, jj = d ? j0n + GC - 1 - i : j0n + i;
                const float bv = lane == 0 ? bon[0] : (lane == 1 ? bon[1] : (lane == 2 ? bon[2] : bon[3]));
                BON[((size_t)d * T_LAT + (size_t)b * S + (jj % ROWS) * GW + jj / ROWS) * 8 + h] = bv; }
        }
        LDS_BARRIER();
        if (xn < G_NT) {
            const int m = wave >> 1, th = wave & 1, fr = lane & 15, fq = lane >> 4;
            const bf16_t* arow = ((m < 2) ? Ar : Rr + par * 32 * LD64) + (16 * th + fr) * LD64 + 8 * fq; const bf16_t* brow = ((m & 1) ? Kr : Br) + fr * LD64 + 8 * fq;
            f32x4 c0 = {0.f, 0.f, 0.f, 0.f}, c1 = {0.f, 0.f, 0.f, 0.f};
#pragma unroll
            for (int ks = 0; ks < 2; ++ks) {
                const bf16x8 afrag = *(const bf16x8*)(arow + 32 * ks);
                c0 = MFMA16(afrag, *(const bf16x8*)(brow + 32 * ks), c0); c1 = MFMA16(afrag, *(const bf16x8*)(brow + 16 * LD64 + 32 * ks), c1);
            }
#pragma unroll
            for (int ch = 0; ch < 2; ++ch) {
                const f32x4 cc = ch ? c1 : c0; const int ic = 16 * ch + fr; const int t0 = 16 * th + 4 * fq;
                if (m == 0) {
#pragma unroll
                    for (int j = 0; j < 4; ++j) Lf[(t0 + j) * 32 + ic] = (ic < t0 + j) ? -cc[j] : 0.f;
                } else if (m == 1) {
                    u32x2 o; o.x = pk2((ic < t0) ? cc[0] : 0.f, (ic < t0 + 1) ? cc[1] : 0.f); o.y = pk2((ic < t0 + 2) ? cc[2] : 0.f, (ic < t0 + 3) ? cc[3] : 0.f);
                    *(u32x2*)(LakT + ic * LD32 + t0) = o;
                } else {
                    bf16_t* M = (m == 2 ? Mrb : Mrk) + par * 32 * LD32;
#pragma unroll
                    for (int j = 0; j < 4; ++j) M[(t0 + j) * LD32 + ic] = f2bf((ic <= t0 + j) ? cc[j] : 0.f);
                }
            }
        }
        LDS_BARRIER();
        if (wave == 7 && xn < G_NT) {
            invert32_blocked(Lf, (bf16_t*)(smem + RL_RX), lane, [&](int i, int c, float v) { Tb[i * LD32 + c] = f2bf(v); });
        }
        if (wave < 2 && it >= 0) {
            const int pc = it & 1; int seg = 0, j0 = 0; chunk_pos(it, d, seg, j0);
            const bf16_t* Rc = Rr + pc * 32 * LD64; const bf16_t* BhTc = BhT + pc * 64 * LD32; const bf16_t* KhTc = KhT + pc * 64 * LD32; const bf16_t* VTc = VT + (pc * 64 + 32 * wave + r) * LD32;
            const bf16_t* Mrbc = Mrb + pc * 32 * LD32; const bf16_t* Mrkc = Mrk + pc * 32 * LD32; const float* PCc = PC + pc * 64;
            const bf16x8 vf0 = ld_nat(VTc, 0, hh), vf1 = ld_nat(VTc, 1, hh);
            f32x16 u = zero16(), y = zero16();
            u = MFMA32(ld_nat(TLm + r * LD32, 0, hh), vf0, u); u = MFMA32(ld_nat(TLm + r * LD32, 1, hh), vf1, u);
            y = MFMA32(ld_nat(Mrkc + r * LD32, 0, hh), vf0, y); y = MFMA32(ld_nat(Mrkc + r * LD32, 1, hh), vf1, y);
#define RW_KSTEP(s) { const bf16x8 xb = pack_acc<(s) & 1>(Xt[(s) >> 1]); u = MFMA32(ld_perm(Wm + r * LD64, (s), hh), xb, u); y = MFMA32(ld_perm(Rc + r * LD64, (s), hh), xb, y); }
            RW_KSTEP(0) RW_KSTEP(1) RW_KSTEP(2) RW_KSTEP(3)
#undef RW_KSTEP
            const bf16x8 ub0 = pack_acc<0>(u), ub1 = pack_acc<1>(u);
            y = MFMA32(ld_perm(Mrbc + r * LD32, 0, hh), ub0, y); y = MFMA32(ld_perm(Mrbc + r * LD32, 1, hh), ub1, y);
#pragma unroll
            for (int kt = 0; kt < 2; ++kt) {
#pragma unroll
                for (int g = 0; g < 16; ++g) Xt[kt][g] *= PCc[32 * kt + crow(g, hh)];
                Xt[kt] = MFMA32(ld_perm(BhTc + (32 * kt + r) * LD32, 0, hh), ub0, Xt[kt]); Xt[kt] = MFMA32(ld_perm(BhTc + (32 * kt + r) * LD32, 1, hh), ub1, Xt[kt]);
                Xt[kt] = MFMA32(ld_nat(KhTc + (32 * kt + r) * LD32, 0, hh), vf0, Xt[kt]); Xt[kt] = MFMA32(ld_nat(KhTc + (32 * kt + r) * LD32, 1, hh), vf1, Xt[kt]);
            }
            if (seg) {
#pragma unroll
                for (int g = 0; g < 16; ++g) {
                    const int i = crow(g, hh), jj = d ? j0 + GC - 1 - i : j0 + i;
                    YDIR[((size_t)d * T_LAT + (size_t)b * S + (jj % ROWS) * GW + jj / ROWS) * 512 + h * 64 + 32 * wave + r] = f2bf(y[g]);
                }
            }
        }
        LDS_BARRIER();
        if (xn < G_NT && wave < 3) {
            const bf16_t* arow = (wave < 2) ? AT + (32 * wave + r) * LD32 : LakT + r * LD32;
            f32x16 acc = zero16();
#pragma unroll
            for (int s = 0; s < 2; ++s) acc = MFMA32(ld_nat(arow, s, hh), ld_nat(Tb + r * LD32, s, hh), acc);
#pragma unroll
            for (int q = 0; q < 4; ++q) {
                u32x2 o; o.x = pk2(acc[4 * q], acc[4 * q + 1]); o.y = pk2(acc[4 * q + 2], acc[4 * q + 3]);
                if (wave < 2) *(u32x2*)(Wm + r * LD64 + 32 * wave + 8 * q + 4 * hh) = o; else *(u32x2*)(TLm + r * LD32 + 8 * q + 4 * hh) = o;
            }
        }
        LDS_BARRIER();
    }
}

DI void phase3(const Params& p, char* smem) {
    constexpr int NG = 2 * NB * H_A, NR = 2 * NB * H_B;
    for (int it = blockIdx.x; it < NG; it += gridDim.x) gdn_chain2(p, smem, it);
    for (int it = blockIdx.x; it < NG + NR; it += gridDim.x) if (it >= NG) rwkv_chain2(p, smem, it - NG);
    const int nchain = NG + NR, G = (int)gridDim.x;
    const int tb = G > nchain ? (int)blockIdx.x - nchain : (int)blockIdx.x, ntb = G > nchain ? G - nchain : G;
    if (tb >= 0) {
        __syncthreads();
        const int tid3 = tid_x(), lane = tid3 & 63, wave = tid3 >> 6;
        float* scr = (float*)smem + wave * (64 * 33);
        bf16_t* GUT = (bf16_t*)(p.aux + AUX_GUT);
        constexpr int nkb = D / 64, nnb = DE / 32, per = nkb * nnb;
        for (int it = tb * 8 + wave; it < NEXP * 2 * per; it += ntb * 8) {
            const int e = it / (2 * per), r = it % (2 * per), up = r / per, r2 = r % per, kb = r2 / nnb, nb = r2 % nnb;
            transpose_item((up ? p.in[I_MU_UP] : p.in[I_MG]) + (size_t)e * D * DE, DE, DE, kb * 64, nb * 32, GUT + (size_t)e * 512 * D, D, up ? 2 : 1, scr, lane);
        }
    }
}

constexpr int P4_SG = 0;
constexpr int P4_XV = P4_SG + 32 * LD128 * 2;
constexpr int P4_YF = P4_XV + 32 * 520 * 2;
static_assert(P4_YF + 32 * 516 * 4 <= LDS_BYTES, "phase4 lds");
DI float half_sum(float v, int hh) {
#ifdef EMU
    v += __shfl_xor(v, 1); v += __shfl_xor(v, 2); v += __shfl_xor(v, 4); v += __shfl_xor(v, 8); v += __shfl_xor(v, 16); return v;
#else
    v = DPP_ADD(v, 0xB1); v = DPP_ADD(v, 0x4E); v = DPP_ADD(v, 0x141); v = DPP_ADD(v, 0x140);
    const int iv = __builtin_bit_cast(int, v);
    const float s0 = __builtin_bit_cast(float, __builtin_amdgcn_readlane(iv, 0)) + __builtin_bit_cast(float, __builtin_amdgcn_readlane(iv, 16));
    const float s1 = __builtin_bit_cast(float, __builtin_amdgcn_readlane(iv, 32)) + __builtin_bit_cast(float, __builtin_amdgcn_readlane(iv, 48));
    return hh ? s1 : s0;
#endif
}
DI void phase4(const Params& p, char* smem) {
    const int tid = tid_x(), lane = tid & 63, wave = tid >> 6, r = lane & 31, hh = lane >> 5;
    const bf16_t* PL = (const bf16_t*)(p.ws + WS_PLAT);
    const bf16_t* ODIR = (const bf16_t*)(p.ws + WS_OA); const bf16_t* YDIR = (const bf16_t*)(p.aux + AUX_YDIR);
    const float* BON = (const float*)(p.ws + WS_BONUS); const float* mu = p.in[I_MU]; const bf16_t* G2T = (const bf16_t*)(p.ws + WS_G2T);
    bf16_t* OA = (bf16_t*)(p.ws + WS_OA); bf16_t* OB = (bf16_t*)(p.ws + WS_OB);
    bf16_t* SG = (bf16_t*)(smem + P4_SG); bf16_t* XV = (bf16_t*)(smem + P4_XV); float* YF = (float*)(smem + P4_YF);
    for (int it = blockIdx.x; it < T_LAT / 32; it += gridDim.x) {
        const int tok0 = it * 32, b = tok0 / S, l0 = tok0 % S;
        __syncthreads();
        for (int q = tid; q < 32 * 80; q += NTHREADS) {
            const int t = q / 80, c8 = q % 80;
            const int l = l0 + t;
            const int bcol = c8 < 16 ? 1792 + c8 * 8 : 1024 + (c8 - 16) * 8;
            float cu[8], o[8];
            unpack8(*(const u32x4*)(PL + (size_t)(b * S + l) * IN_COLS + COL_B0 + bcol), cu);
#pragma unroll
            for (int e = 0; e < 8; ++e) o[e] = c8 < 16 ? fsigmoid(cu[e]) : cu[e];
            u32x4 w; w.x = pk2(o[0], o[1]); w.y = pk2(o[2], o[3]); w.z = pk2(o[4], o[5]); w.w = pk2(o[6], o[7]);
            if (c8 < 16) *(u32x4*)(SG + t * LD128 + c8 * 8) = w; else *(u32x4*)(XV + t * 520 + (c8 - 16) * 8) = w;
        }
        for (int q = tid; q < 32 * 64; q += NTHREADS) {
            const int t = q >> 6, c8 = q & 63, tok = tok0 + t;
            float a0[8], a1[8];
            unpack8(*(const u32x4*)(YDIR + (size_t)tok * 512 + c8 * 8), a0); unpack8(*(const u32x4*)(YDIR + ((size_t)T_LAT + tok) * 512 + c8 * 8), a1);
            f32x4 s0 = {a0[0] + a1[0], a0[1] + a1[1], a0[2] + a1[2], a0[3] + a1[3]}, s1 = {a0[4] + a1[4], a0[5] + a1[5], a0[6] + a1[6], a0[7] + a1[7]};
            *(f32x4*)(YF + t * 516 + c8 * 8) = s0; *(f32x4*)(YF + t * 516 + c8 * 8 + 4) = s1;
        }
        __syncthreads();
        {
            unsigned q0[16], q1[16], zq[16];
#pragma unroll
            for (int k = 0; k < 16; ++k) {
                const int pi = wave * 16 + k, t = pi >> 2, h = pi & 3, tok = tok0 + t;
                const size_t o0 = (size_t)tok * 512 + h * 128 + 2 * lane;
                q0[k] = *(const unsigned*)(ODIR + o0); q1[k] = *(const unsigned*)(ODIR + (size_t)T_LAT * 512 + o0); zq[k] = *(const unsigned*)(PL + (size_t)tok * IN_COLS + 1536 + h * 128 + 2 * lane);
            }
            const float on0 = p.in[I_ONORM][2 * lane], on1 = p.in[I_ONORM][2 * lane + 1];
#pragma unroll
            for (int k = 0; k < 16; ++k) {
                const int pi = wave * 16 + k, t = pi >> 2, h = pi & 3, tok = tok0 + t;
                const size_t o0 = (size_t)tok * 512 + h * 128 + 2 * lane;
                const float a0 = bf2f((bf16_t)(q0[k] & 0xffffu)) + bf2f((bf16_t)(q1[k] & 0xffffu)), a1 = bf2f((bf16_t)(q0[k] >> 16)) + bf2f((bf16_t)(q1[k] >> 16));
                const float ss = wave_sum_fast(a0 * a0 + a1 * a1);
                const float rstd = frsq(ss * (1.f / 128.f) + 1e-6f);
                const float z0 = bf2f((bf16_t)(zq[k] & 0xffffu)), z1 = bf2f((bf16_t)(zq[k] >> 16));
                *(unsigned*)(OA + o0) = pk2(a0 * rstd * on0 * fsilu(z0), a1 * rstd * on1 * fsilu(z1));
            }
        }
        __syncthreads();
        {
            const int h = wave;
            f32x16 acc0 = zero16(), acc1 = zero16();
#pragma unroll
            for (int s2 = 0; s2 < 8; ++s2) {
                const bf16x8 a = ld_nat(SG + r * LD128, s2, hh);
                const bf16x8 b0 = *(const bf16x8*)(G2T + (size_t)(64 * h + r) * 128 + 16 * s2 + 8 * hh), b1 = *(const bf16x8*)(G2T + (size_t)(64 * h + 32 + r) * 128 + 16 * s2 + 8 * hh);
                acc0 = MFMA32(a, b0, acc0); acc1 = MFMA32(a, b1, acc1);
            }
            const int c0 = 64 * h + r, c1 = c0 + 32;
            const float lg0 = p.in[I_LNG][c0], lb0 = p.in[I_LNB][c0], lg1 = p.in[I_LNG][c1], lb1 = p.in[I_LNB][c1];
            float bonv[16];
#pragma unroll
            for (int g = 0; g < 16; ++g) { const int tok = tok0 + crow(g, hh); bonv[g] = BON[(size_t)tok * 8 + h] + BON[((size_t)T_LAT + tok) * 8 + h]; }
#pragma unroll
            for (int g = 0; g < 16; ++g) {
                const int i = crow(g, hh), tok = tok0 + i;
                const float y0 = YF[i * 516 + c0], y1 = YF[i * 516 + c1];
                const float mean = half_sum(y0 + y1, hh) * (1.f / 64.f); const float d0 = y0 - mean, d1 = y1 - mean;
                const float var = half_sum(d0 * d0 + d1 * d1, hh) * (1.f / 64.f); const float rs = frsq(var + 64e-5f);
                const float bon = bonv[g];
                const float o0 = (d0 * rs * lg0 + lb0 + bon * bf2f(XV[i * 520 + c0])) * acc0[g], o1 = (d1 * rs * lg1 + lb1 + bon * bf2f(XV[i * 520 + c1])) * acc1[g];
                OB[(size_t)tok * 512 + c0] = f2bf(o0); OB[(size_t)tok * 512 + c1] = f2bf(o1);
            }
        }
    }
}

DI void phase5(const Params& p, char* smem) {
    const bf16_t* OA = (const bf16_t*)(p.ws + WS_OA); const bf16_t* OB = (const bf16_t*)(p.ws + WS_OB);
    const bf16_t* WA = (const bf16_t*)(p.ws + WS_WOA); const bf16_t* WB = (const bf16_t*)(p.ws + WS_WOB);
    const bf16_t* PL = (const bf16_t*)(p.ws + WS_PLAT); bf16_t* Y = (bf16_t*)(p.aux + AUX_Y);
    if (USE_G8) {
        constexpr int NT8 = D / 256, MT8 = T_LAT / 256;
        constexpr int GLD = 264;
        static_assert(256 * GLD * 2 <= LDS_BYTES, "gate tile lds");
        bf16_t* GT = (bf16_t*)smem;
        auto stage_gates = [&](int brow, int gcol0) {
            const int tid = tid_x();
            u32x4 gv[16];
#pragma unroll
            for (int i = 0; i < 16; ++i) { const int ch = tid + i * NTHREADS, row = ch >> 5, c16 = ch & 31; gv[i] = *(const u32x4*)(PL + (size_t)(brow + row) * IN_COLS + gcol0 + c16 * 8); }
#pragma unroll
            for (int i = 0; i < 16; ++i) { const int ch = tid + i * NTHREADS, row = ch >> 5, c16 = ch & 31; *(u32x4*)(GT + row * GLD + c16 * 8) = gv[i]; }
            __syncthreads();
        };
        for (int t = blockIdx.x; t < MT8 * NT8; t += gridDim.x) {
            int mt, nt; if (!g8::tile_order(t, MT8, NT8, mt, nt)) break;
            const int brow = mt * 256, bcol = nt * 256;
            g8::Acc acc; g8::acc_zero(acc);
            g8::kloop(acc, smem, OA, 512, WA, 512, 512, brow, bcol);
            stage_gates(brow, COL_G0 + bcol);
            g8::for_each_quad(acc, brow, bcol, [&](int row, int col, const f32x4& v) {
                const u32x2 gq = *(const u32x2*)(GT + (row - brow) * GLD + (col - bcol));
                const float g0 = bf2f((bf16_t)(gq.x & 0xffffu)), g1 = bf2f((bf16_t)(gq.x >> 16)), g2 = bf2f((bf16_t)(gq.y & 0xffffu)), g3 = bf2f((bf16_t)(gq.y >> 16));
                u32x2 o; o.x = pk2(fsigmoid(g0) * v.x, fsigmoid(g1) * v.y); o.y = pk2(fsigmoid(g2) * v.z, fsigmoid(g3) * v.w);
                *(u32x2*)(Y + (size_t)row * D + col) = o;
            });
            __syncthreads();
            g8::acc_zero(acc);
            g8::kloop(acc, smem, OB, 512, WB, 512, 512, brow, bcol);
            stage_gates(brow, COL_G0 + D + bcol);
            g8::for_each_quad(acc, brow, bcol, [&](int row, int col, const f32x4& v) {
                const u32x2 gq = *(const u32x2*)(GT + (row - brow) * GLD + (col - bcol));
                const float g0 = bf2f((bf16_t)(gq.x & 0xffffu)), g1 = bf2f((bf16_t)(gq.x >> 16)), g2 = bf2f((bf16_t)(gq.y & 0xffffu)), g3 = bf2f((bf16_t)(gq.y >> 16));
#ifdef EMU
                const unsigned long long tq = *(const unsigned long long*)(Y + (size_t)row * D + col);
#else
                const unsigned long long tq = __hip_atomic_load((const unsigned long long*)(Y + (size_t)row * D + col), __ATOMIC_RELAXED, __HIP_MEMORY_SCOPE_AGENT);
#endif
                const unsigned tlo = (unsigned)tq, thi = (unsigned)(tq >> 32);
                const float t0 = bf2f((bf16_t)(tlo & 0xffffu)), t1 = bf2f((bf16_t)(tlo >> 16)), t2 = bf2f((bf16_t)(thi & 0xffffu)), t3 = bf2f((bf16_t)(thi >> 16));
                u32x2 o; o.x = pk2(t0 + fsigmoid(g0) * v.x, t1 + fsigmoid(g1) * v.y); o.y = pk2(t2 + fsigmoid(g2) * v.z, t3 + fsigmoid(g3) * v.w);
                *(u32x2*)(Y + (size_t)row * D + col) = o;
            });
            __syncthreads();
        }
        return;
    }
    constexpr int MR5 = 2, BM5 = 64 * MR5; constexpr int NT = D / 128, MT = T_LAT / BM5;
    for (int t = blockIdx.x; t < MT * NT; t += gridDim.x) {
        const int mt = t / NT, nt = t % NT, row0 = mt * BM5;
        f32x4 acca[MR5][4], accb[MR5][4]; acc_zero(acca); acc_zero(accb);
        gemm_kloop(acca, smem, [&](int i) { return OA + (size_t)(row0 + i) * 512; }, WA + (size_t)nt * 128 * 512, 512, 512);
        gemm_kloop(accb, smem, [&](int i) { return OB + (size_t)(row0 + i) * 512; }, WB + (size_t)nt * 128 * 512, 512, 512);
        const int t2 = tid_x(), l2 = t2 & 63, w2 = t2 >> 6; const int wr = w2 >> 1, wc = w2 & 1, fr = l2 & 15, fq = l2 >> 4;
#pragma unroll
        for (int m = 0; m < MR5; ++m)
#pragma unroll
            for (int n = 0; n < 4; ++n)
#pragma unroll
                for (int j = 0; j < 4; ++j) {
                    const int row = row0 + wr * 16 * MR5 + m * 16 + fq * 4 + j, col = nt * 128 + wc * 64 + n * 16 + fr;
                    const float ga = bf2f(PL[(size_t)row * IN_COLS + COL_G0 + col]), gb = bf2f(PL[(size_t)row * IN_COLS + COL_G0 + D + col]);
                    Y[(size_t)row * D + col] = f2bf(sigmoidf_(ga) * acca[m][n][j] + sigmoidf_(gb) * accb[m][n][j]);
                }
    }
}

DI void phase6(const Params& p, char* smem) {
    const bf16_t* Y = (const bf16_t*)(p.aux + AUX_Y); const bf16_t* WO = (const bf16_t*)(p.ws + WS_WOUT);
    const float* mod = (const float*)(p.ws + WS_MOD); float* Hh = (float*)(p.ws + WS_H);
    if (USE_G8) {
        constexpr int NT = D / 256, MT = T_LAT / 256;
        const float* X = p.in[I_X];
        for (int t = blockIdx.x; t < MT * NT; t += gridDim.x) {
            int mt, nt; if (!g8::tile_order(t, MT, NT, mt, nt)) break;
            const int brow = mt * 256, bcol = nt * 256;
            g8::Acc acc; g8::acc_zero(acc);
            g8::kloop(acc, smem, Y, D, WO, D, D, brow, bcol);
            g8::for_each_quad(acc, brow, bcol, [&](int row, int col, const f32x4& v) {
                const int b = row / S; const f32x4 xv = *(const f32x4*)(X + (size_t)row * D + col), gv = *(const f32x4*)(mod + (size_t)b * 6 * D + 2 * D + col);
                f32x4 o; o.x = xv.x + gv.x * v.x; o.y = xv.y + gv.y * v.y; o.z = xv.z + gv.z * v.z; o.w = xv.w + gv.w * v.w;
                *(f32x4*)(Hh + (size_t)row * D + col) = o;
            });
        }
    } else {
        const int tid = tid_x(), lane = tid & 63, wave = tid >> 6, wr = wave >> 1, wc = wave & 1, fr = lane & 15, fq = lane >> 4;
        constexpr int NT = D / 128, MT = T_LAT / BM;
        for (int t = blockIdx.x; t < MT * NT; t += gridDim.x) {
            const int mt = t / NT, nt = t % NT, row0 = mt * BM;
            f32x4 acc[MREP][4]; acc_zero(acc);
            gemm_kloop(acc, smem, [&](int i) { return Y + (size_t)(row0 + i) * D; }, WO + (size_t)nt * 128 * D, D, D);
#pragma unroll
            for (int m = 0; m < MREP; ++m)
#pragma unroll
                for (int n = 0; n < 4; ++n)
#pragma unroll
                    for (int j = 0; j < 4; ++j) {
                        const int row = row0 + wr * 16 * MREP + m * 16 + fq * 4 + j, col = nt * 128 + wc * 64 + n * 16 + fr, b = row / S;
                        Hh[(size_t)row * D + col] = p.in[I_X][(size_t)row * D + col] + mod[(size_t)b * 6 * D + 2 * D + col] * acc[m][n][j];
                    }
        }
    }
    __syncthreads();
    const int tid6 = tid_x(), lane = tid6 & 63, wave = tid6 >> 6;
    const int gw = blockIdx.x * 8 + wave, ngw = gridDim.x * 8;
    float* scr = (float*)smem + wave * (64 * 33);
    bf16_t* DNT = (bf16_t*)(p.ws + WS_DNT);
    {
        constexpr int nkb = DE / 64, nnb = D / 32, per = nkb * nnb;
        for (int it = gw; it < NEXP * per; it += ngw) {
            const int e = it / per, r2 = it % per, kb = r2 / nnb, nb = r2 % nnb;
            transpose_item(p.in[I_MD] + (size_t)e * DE * D, D, D, kb * 64, nb * 32, DNT + (size_t)e * D * DE, DE, 0, scr, lane);
        }
    }
}

#ifdef EMU
#define MFMA32F(a, b, c) emu_mfma32_f32((a), (b), (c))
#else
#define MFMA32F(a, b, c) __builtin_amdgcn_mfma_f32_32x32x2f32((a), (b), (c), 0, 0, 0)
#endif
constexpr int TB_LD = D + 4;
static_assert(32 * TB_LD * 4 <= LDS_BYTES && 8 * 32 * 64 * 4 <= LDS_BYTES, "phase7 lds");
DI void phase7(const Params& p, char* smem) {
    const int tid = tid_x(), lane = tid & 63, wave = tid >> 6, r = lane & 31, hh = lane >> 5;
    const float* Hh = (const float*)(p.ws + WS_H); const float* mod = (const float*)(p.ws + WS_MOD); const float* WRT = (const float*)(p.ws + WS_WRT);
    bf16_t* Tt = (bf16_t*)(p.ws + WS_T); int* cnt = (int*)(p.ws + WS_CNT); int* rowlist = (int*)(p.ws + WS_ROWLIST); float* pairw = (float*)(p.ws + WS_PAIRW);
    float* tb = (float*)smem;
    float* bias = (float*)(smem + LDS_BYTES - 1024);
    int* lcnt = (int*)(smem + LDS_BYTES - 768);
    int* lbase = lcnt + 32;
    if (tid < 36) bias[tid] = tid < 4 ? p.in[I_RGB][tid] : p.in[I_REB][tid - 4];
    f32x4 x[4][D / 256];
    int itn = blockIdx.x;
    if (itn < T_LAT / 32) {
#pragma unroll
        for (int tt = 0; tt < 4; ++tt)
#pragma unroll
            for (int j = 0; j < D / 256; ++j) x[tt][j] = *(const f32x4*)(Hh + (size_t)(itn * 32 + wave * 4 + tt) * D + j * 256 + lane * 4);
    }
    for (int it = blockIdx.x; it < T_LAT / 32; it += gridDim.x) {
        const int tok0 = it * 32;
        __syncthreads();
        if (tid < 32) lcnt[tid] = 0;
#pragma unroll
        for (int tt = 0; tt < 4; ++tt) {
            const int ti = wave * 4 + tt, tok = tok0 + ti, b = tok / S;
            float ss = 0.f;
#pragma unroll
            for (int j = 0; j < D / 256; ++j) ss += x[tt][j].x * x[tt][j].x + x[tt][j].y * x[tt][j].y + x[tt][j].z * x[tt][j].z + x[tt][j].w * x[tt][j].w;
            ss = wave_sum_fast(ss);
            const float rstd = frsq(ss * (1.0f / D) + 1e-6f);
#pragma unroll
            for (int j = 0; j < D / 256; ++j) {
                const int k = j * 256 + lane * 4;
                const f32x4 g = *(const f32x4*)(p.in[I_NFFN] + k), sh = *(const f32x4*)(mod + (size_t)b * 6 * D + 3 * D + k), sc = *(const f32x4*)(mod + (size_t)b * 6 * D + 4 * D + k);
                f32x4 o; o.x = x[tt][j].x * rstd * g.x * (1.f + sc.x) + sh.x; o.y = x[tt][j].y * rstd * g.y * (1.f + sc.y) + sh.y;
                o.z = x[tt][j].z * rstd * g.z * (1.f + sc.z) + sh.z; o.w = x[tt][j].w * rstd * g.w * (1.f + sc.w) + sh.w;
                *(f32x4*)(tb + ti * TB_LD + k) = o;
                u32x2 ob; ob.x = pk2(o.x, o.y); ob.y = pk2(o.z, o.w);
                *(u32x2*)(Tt + (size_t)tok * D + k) = ob;
            }
        }
        itn = it + gridDim.x;
        if (itn < T_LAT / 32) {
#pragma unroll
            for (int tt = 0; tt < 4; ++tt)
#pragma unroll
                for (int j = 0; j < D / 256; ++j) x[tt][j] = *(const f32x4*)(Hh + (size_t)(itn * 32 + wave * 4 + tt) * D + j * 256 + lane * 4);
        }
        LDS_BARRIER();
        f32x16 a0 = zero16(), a1 = zero16();
        {
            const int kbeg = wave * (D / 8);
            const float* arow = tb + r * TB_LD + kbeg + 4 * hh;
            const float* b0row = WRT + (size_t)(4 + r) * D + kbeg + 4 * hh;
            const float* b1row = WRT + (size_t)(r < 4 ? r : 0) * D + kbeg + 4 * hh;
            const float m1 = r < 4 ? 1.f : 0.f;
#pragma unroll 4
            for (int g = 0; g < D / 64; ++g) {
                const f32x4 av = *(const f32x4*)(arow + 8 * g), b0 = *(const f32x4*)(b0row + 8 * g); const f32x4 b1 = *(const f32x4*)(b1row + 8 * g) * m1;
                a0 = MFMA32F(av.x, b0.x, a0); a1 = MFMA32F(av.x, b1.x, a1); a0 = MFMA32F(av.y, b0.y, a0); a1 = MFMA32F(av.y, b1.y, a1);
                a0 = MFMA32F(av.z, b0.z, a0); a1 = MFMA32F(av.z, b1.z, a1); a0 = MFMA32F(av.w, b0.w, a0); a1 = MFMA32F(av.w, b1.w, a1);
            }
        }
        LDS_BARRIER();
        {
            float* part = tb + wave * (32 * 64);
#pragma unroll
            for (int g = 0; g < 16; ++g) { const int i = crow(g, hh); part[i * 64 + r] = a0[g]; part[i * 64 + 32 + r] = a1[g]; }
        }
        LDS_BARRIER();
        float lsum[4];
        {
            const int i = tid >> 4, c4 = (tid & 15) * 4;
#pragma unroll
            for (int e = 0; e < 4; ++e) { float sacc = 0.f;
#pragma unroll
                for (int w = 0; w < 8; ++w) sacc += tb[w * (32 * 64) + i * 64 + c4 + e];
                lsum[e] = sacc; }
        }
        LDS_BARRIER();
        { const int i = tid >> 4, c4 = (tid & 15) * 4;
#pragma unroll
          for (int e = 0; e < 4; ++e) tb[i * 64 + c4 + e] = lsum[e]; }
        LDS_BARRIER();
        int ex1 = 0, ex2 = 0, rk1 = 0, rk2 = 0; float w1 = 0.f, w2 = 0.f;
        if (tid < 32) {
            const float* L = tb + tid * 64;
            float gl[4];
#pragma unroll
            for (int i = 0; i < 4; ++i) gl[i] = L[32 + i] + bias[i];
            int g = 0; float mx = gl[0];
#pragma unroll
            for (int i = 1; i < 4; ++i) if (gl[i] > mx) { mx = gl[i]; g = i; }
            float se = 0.f;
#pragma unroll
            for (int i = 0; i < 4; ++i) se += fexp(gl[i] - mx);
            const float pg = 1.0f / se;
            int i1 = 0; float l1 = L[g * 8] + bias[4 + g * 8];
            for (int i = 1; i < 8; ++i) { const float v = L[g * 8 + i] + bias[4 + g * 8 + i]; if (v > l1) { l1 = v; i1 = i; } }
            int i2 = -1; float l2 = -3.0e38f;
            for (int i = 0; i < 8; ++i) { const float v = L[g * 8 + i] + bias[4 + g * 8 + i]; if (i != i1 && v > l2) { l2 = v; i2 = i; } }
            const float e2 = fexp(l2 - l1); w1 = pg / (1.f + e2); w2 = pg * e2 / (1.f + e2);
            ex1 = g * 8 + i1; ex2 = g * 8 + i2;
            rk1 = atomicAdd(&lcnt[ex1], 1); rk2 = atomicAdd(&lcnt[ex2], 1);
        }
        LDS_BARRIER();
        if (tid < 32) { const int c = lcnt[tid]; lbase[tid] = c ? atomicAdd(&cnt[tid * CNT_STRIDE], c) : 0; }
        __syncthreads();
        if (tid < 32) {
            const int tok = tok0 + tid;
            rowlist[(size_t)ex1 * CAP + lbase[ex1] + rk1] = tok * 2; pairw[tok * 2] = w1;
            rowlist[(size_t)ex2 * CAP + lbase[ex2] + rk2] = tok * 2 + 1; pairw[tok * 2 + 1] = w2;
        }
    }
}

constexpr int MOE_TM = USE_G8 ? 256 : BM;
DI void moe_tiles(const Params& p, char* smem, int* pre) {
    const int* cnt = (const int*)(p.ws + WS_CNT);
    __syncthreads();
    if (tid_x() == 0) { int s = 0; for (int e = 0; e < NEXP; ++e) { pre[e] = s; s += (cnt[e * CNT_STRIDE] + MOE_TM - 1) / MOE_TM; } pre[NEXP] = s; }
    __syncthreads();
}
DI void moe_up_tile(const Params& p, char* smem, const int* pre, int t) {
    const int* cnt = (const int*)(p.ws + WS_CNT); const int* rowlist = (const int*)(p.ws + WS_ROWLIST);
    const bf16_t* Tt = (const bf16_t*)(p.ws + WS_T); const bf16_t* GUT = (const bf16_t*)(p.aux + AUX_GUT); bf16_t* HID = (bf16_t*)(p.ws + WS_HID);
    const int mg = t >> 1, nt = t & 1; int e = 0;
    while (pre[e + 1] <= mg) ++e;
    const int mt = mg - pre[e], ce = cnt[e * CNT_STRIDE]; const int* rl = rowlist + (size_t)e * CAP;
    g8::Acc acc; g8::acc_zero(acc);
    g8::kloop_g(acc, smem, Tt, [&](int r) { int idx = mt * 256 + r; idx = idx < ce ? idx : ce - 1; return (rl[idx] >> 1) * D; }, GUT + ((size_t)e * 512 + nt * 256) * D, D, D, 0);
    const int t2 = tid_x(), wid = t2 >> 6, l2 = t2 & 63, wr2 = wid >> 2, wc2 = wid & 3, fr2 = l2 & 15, fq2 = l2 >> 4;
    int prs[2][4];
#pragma unroll
    for (int ai = 0; ai < 2; ++ai)
#pragma unroll
        for (int m = 0; m < 4; ++m) { const int idx = mt * 256 + ai * 128 + wr2 * 64 + m * 16 + fr2; prs[ai][m] = idx < ce ? rl[idx] : -1; }
#pragma unroll
    for (int ai = 0; ai < 2; ++ai)
#pragma unroll
        for (int m = 0; m < 4; ++m) {
            if (prs[ai][m] >= 0) {
                const int pair = prs[ai][m];
#pragma unroll
                for (int bj = 0; bj < 2; ++bj) {
                    const f32x4 g = acc[ai][bj][m][0], u = acc[ai][bj][m][1];
                    u32x2 o; o.x = pk2(fsilu(g.x) * u.x, fsilu(g.y) * u.y); o.y = pk2(fsilu(g.z) * u.z, fsilu(g.w) * u.w);
                    *(u32x2*)(HID + (size_t)pair * DE + nt * 128 + bj * 64 + wc2 * 16 + fq2 * 4) = o;
                }
            }
        }
}
DI void moe_down_tile(const Params& p, char* smem, const int* pre, int t) {
    constexpr int NT8 = D / 256;
    const int* cnt = (const int*)(p.ws + WS_CNT); const int* rowlist = (const int*)(p.ws + WS_ROWLIST); const float* pairw = (const float*)(p.ws + WS_PAIRW);
    const bf16_t* HID = (const bf16_t*)(p.ws + WS_HID); const bf16_t* DNT = (const bf16_t*)(p.ws + WS_DNT); bf16_t* OP = (bf16_t*)(p.ws + WS_OPAIR);
    const int mg = t / NT8, nt = t % NT8; int e = 0;
    while (pre[e + 1] <= mg) ++e;
    const int mt = mg - pre[e], ce = cnt[e * CNT_STRIDE]; const int* rl = rowlist + (size_t)e * CAP;
    g8::Acc acc; g8::acc_zero(acc);
    g8::kloop_g(acc, smem, HID, [&](int r) { int idx = mt * 256 + r; idx = idx < ce ? idx : ce - 1; return rl[idx] * DE; }, DNT + ((size_t)e * D + nt * 256) * DE, DE, DE, 0);
    {
        const int t2 = tid_x(), wid = t2 >> 6, l2 = t2 & 63, wr2 = wid >> 2, wc2 = wid & 3, fr2 = l2 & 15, fq2 = l2 >> 4;
        int prs[2][4]; float pws[2][4];
#pragma unroll
        for (int ai = 0; ai < 2; ++ai)
#pragma unroll
            for (int m = 0; m < 4; ++m) { const int idx = mt * 256 + ai * 128 + wr2 * 64 + m * 16 + fr2; prs[ai][m] = idx < ce ? rl[idx] : -1; }
#pragma unroll
        for (int ai = 0; ai < 2; ++ai)
#pragma unroll
            for (int m = 0; m < 4; ++m) pws[ai][m] = prs[ai][m] >= 0 ? pairw[prs[ai][m]] : 0.f;
#pragma unroll
        for (int ai = 0; ai < 2; ++ai)
#pragma unroll
            for (int m = 0; m < 4; ++m) {
                if (prs[ai][m] >= 0) {
                    const float w = pws[ai][m]; bf16_t* orow = OP + (size_t)prs[ai][m] * D + nt * 256 + wc2 * 32 + fq2 * 4;
#pragma unroll
                    for (int bj = 0; bj < 2; ++bj)
#pragma unroll
                        for (int n = 0; n < 2; ++n) { const f32x4 v = acc[ai][bj][m][n];
                            u32x2 o; o.x = pk2(v.x * w, v.y * w); o.y = pk2(v.z * w, v.w * w); *(u32x2*)(orow + bj * 128 + n * 16) = o; }
                }
            }
    }
}
DI void phase8(const Params& p, char* smem) {
    const int tid = tid_x(), lane = tid & 63, wave = tid >> 6, wr = wave >> 1, wc = wave & 1, fr = lane & 15, fq = lane >> 4;
    int* pre = (int*)(smem + LDS_BYTES - 256);
    moe_tiles(p, smem, pre);
    const int* cnt = (const int*)(p.ws + WS_CNT); const int* rowlist = (const int*)(p.ws + WS_ROWLIST);
    const bf16_t* Tt = (const bf16_t*)(p.ws + WS_T); const bf16_t* GUT = (const bf16_t*)(p.aux + AUX_GUT); bf16_t* HID = (bf16_t*)(p.ws + WS_HID);
    if (USE_G8) {
        if ((int)blockIdx.x < pre[NEXP] * 2) moe_up_tile(p, smem, pre, (int)blockIdx.x);
        return;
    }
    const int ntile = pre[NEXP] * 4;
    for (int t = blockIdx.x; t < ntile; t += gridDim.x) {
        const int mg = t >> 2, nt = t & 3; int e = 0;
        while (pre[e + 1] <= mg) ++e;
        const int mt = mg - pre[e], ce = cnt[e * CNT_STRIDE]; const int* rl = rowlist + (size_t)e * CAP;
        f32x4 acc[MREP][4]; acc_zero(acc);
        gemm_kloop(acc, smem, [&](int i) { int idx = mt * BM + i; idx = idx < ce ? idx : ce - 1; return Tt + (size_t)(rl[idx] >> 1) * D; }, GUT + ((size_t)e * 512 + nt * 128) * D, D, D);
#pragma unroll
        for (int m = 0; m < MREP; ++m)
#pragma unroll
            for (int j = 0; j < 4; ++j) {
                const int idx = mt * BM + wr * 16 * MREP + m * 16 + fq * 4 + j;
                if (idx < ce) {
                    const int pair = rl[idx];
#pragma unroll
                    for (int n = 0; n < 2; ++n) {
                        const float g = acc[m][n][j], u = acc[m][n + 2][j];
                        HID[(size_t)pair * DE + nt * 64 + wc * 32 + n * 16 + fr] = f2bf(siluf_(g) * u);
                    }
                }
            }
    }
}
DI void phase9(const Params& p, char* smem) {
    const int tid = tid_x(), lane = tid & 63, wave = tid >> 6, wr = wave >> 1, wc = wave & 1, fr = lane & 15, fq = lane >> 4;
    int* pre = (int*)(smem + LDS_BYTES - 256);
    moe_tiles(p, smem, pre);
    const int* cnt = (const int*)(p.ws + WS_CNT); const int* rowlist = (const int*)(p.ws + WS_ROWLIST); const float* pairw = (const float*)(p.ws + WS_PAIRW);
    const bf16_t* HID = (const bf16_t*)(p.ws + WS_HID); const bf16_t* DNT = (const bf16_t*)(p.ws + WS_DNT); bf16_t* OP = (bf16_t*)(p.ws + WS_OPAIR);
    if (USE_G8) {
        constexpr int NT8 = D / 256;
        const int G = (int)gridDim.x, NU = pre[NEXP] * 2, NU2 = NU > G ? NU - G : 0, ND = pre[NEXP] * NT8;
        int* cntw = (int*)(p.ws + WS_CNT);
        int* tk = (int*)(smem + LDS_BYTES - 512);
        for (;;) {
            __syncthreads();
            if (tid_x() == 0) *tk = atomicAdd(&cntw[CNT_TICKET], 1);
            __syncthreads();
            const int j = *tk;
            if (j >= NU2 + ND) break;
            if (j < NU2) {
                moe_up_tile(p, smem, pre, G + j);
#ifndef EMU
                asm volatile("s_waitcnt vmcnt(0)" ::: "memory");
#endif
                __syncthreads();
                if (tid_x() == 0) {
#ifndef EMU
                    __builtin_amdgcn_fence(__ATOMIC_RELEASE, "agent");
                    asm volatile("s_waitcnt vmcnt(0)" ::: "memory");
#endif
                    (void)atomicAdd(&cntw[CNT_U2DONE], 1);
                }
            } else {
                const int dt = j - NU2;
                if (2 * (dt / NT8) + 1 >= G) {
                    if (tid_x() == 0) {
#ifndef EMU
                        while (__hip_atomic_load(&cntw[CNT_U2DONE], __ATOMIC_RELAXED, __HIP_MEMORY_SCOPE_AGENT) < NU2) __builtin_amdgcn_s_sleep(2);
                        __builtin_amdgcn_fence(__ATOMIC_ACQUIRE, "agent");
                        asm volatile("s_waitcnt vmcnt(0)" ::: "memory");
#endif
                    }
                    __syncthreads();
                }
                moe_down_tile(p, smem, pre, dt);
            }
        }
        return;
    }
    constexpr int NT = D / 128;
    const int ntile = pre[NEXP] * NT;
    for (int t = blockIdx.x; t < ntile; t += gridDim.x) {
        const int mg = t / NT, nt = t % NT; int e = 0;
        while (pre[e + 1] <= mg) ++e;
        const int mt = mg - pre[e], ce = cnt[e * CNT_STRIDE]; const int* rl = rowlist + (size_t)e * CAP;
        f32x4 acc[MREP][4]; acc_zero(acc);
        gemm_kloop(acc, smem, [&](int i) { int idx = mt * BM + i; idx = idx < ce ? idx : ce - 1; return HID + (size_t)rl[idx] * DE; }, DNT + ((size_t)e * D + nt * 128) * DE, DE, DE);
#pragma unroll
        for (int m = 0; m < MREP; ++m)
#pragma unroll
            for (int j = 0; j < 4; ++j) {
                const int idx = mt * BM + wr * 16 * MREP + m * 16 + fq * 4 + j;
                if (idx < ce) {
                    const int pair = rl[idx]; const float w = pairw[pair];
#pragma unroll
                    for (int n = 0; n < 4; ++n) OP[(size_t)pair * D + nt * 128 + wc * 64 + n * 16 + fr] = f2bf(acc[m][n][j] * w);
                }
            }
    }
}

DI void phase10(const Params& p, char* smem) {
    const int lane = tid_x() & 63, wave = tid_x() >> 6;
    const int gw = blockIdx.x * 8 + wave, ngw = gridDim.x * 8;
    const float* Hh = (const float*)(p.ws + WS_H); const float* mod = (const float*)(p.ws + WS_MOD); const bf16_t* OP = (const bf16_t*)(p.ws + WS_OPAIR);
    for (int tok = gw; tok < T_LAT; tok += ngw) {
        const int b = tok / S;
        f32x4 x[D / 256]; float ss = 0.f;
#pragma unroll
        for (int j = 0; j < D / 256; ++j) {
            const int k = j * 256 + lane * 4;
            const f32x4 hv = *(const f32x4*)(Hh + (size_t)tok * D + k), g2 = *(const f32x4*)(mod + (size_t)b * 6 * D + 5 * D + k);
            const u32x2 p0 = *(const u32x2*)(OP + (size_t)(tok * 2) * D + k), p1 = *(const u32x2*)(OP + (size_t)(tok * 2 + 1) * D + k);
            f32x4 m;
            m.x = bf2f((bf16_t)(p0.x & 0xffffu)) + bf2f((bf16_t)(p1.x & 0xffffu)); m.y = bf2f((bf16_t)(p0.x >> 16)) + bf2f((bf16_t)(p1.x >> 16));
            m.z = bf2f((bf16_t)(p0.y & 0xffffu)) + bf2f((bf16_t)(p1.y & 0xffffu)); m.w = bf2f((bf16_t)(p0.y >> 16)) + bf2f((bf16_t)(p1.y >> 16));
            x[j].x = hv.x + g2.x * m.x; x[j].y = hv.y + g2.y * m.y; x[j].z = hv.z + g2.z * m.z; x[j].w = hv.w + g2.w * m.w;
            ss += x[j].x * x[j].x + x[j].y * x[j].y + x[j].z * x[j].z + x[j].w * x[j].w;
        }
        ss = wave_sum(ss);
        const float rstd = 1.0f / sqrtf(ss * (1.0f / D) + 1e-6f);
#pragma unroll
        for (int j = 0; j < D / 256; ++j) {
            const int k = j * 256 + lane * 4; const f32x4 g = *(const f32x4*)(p.in[I_FIN] + k);
            f32x4 o; o.x = x[j].x * rstd * g.x; o.y = x[j].y * rstd * g.y; o.z = x[j].z * rstd * g.z; o.w = x[j].w * rstd * g.w;
            *(f32x4*)(p.out + (size_t)tok * D + k) = o;
        }
    }
}

DI void run_phase(const Params& p, int ph, char* smem) {
    switch (ph) {
        case PH_MOD: phase0(p, smem); break;
        case PH_U: phase1(p, smem); break;
        case PH_P: phase2(p, smem); break;
        case PH_HALO: phase_halo(p, smem); break;
        case PH_FIR: phase_fir(p, smem); break;
        case PH_CHAINS: phase3(p, smem); break;
        case PH_POST: phase4(p, smem); break;
        case PH_MERGE: phase5(p, smem); break;
        case PH_WOUT: phase6(p, smem); break;
        case PH_ROUTER: phase7(p, smem); break;
        case PH_UP: phase8(p, smem); break;
        case PH_DOWN: phase9(p, smem); break;
        default: phase10(p, smem); break;
    }
}

#ifndef EMU
namespace cg = cooperative_groups;
#define XB_TMO      128
#define XB_XCNT(j)  (256  + 64 * (j))
#define XB_XSUB(j)  (1280 + 64 * (j))
#define XB_XGEN(j)  (2304 + 64 * (j))
#define XB_TOP      3328
#define XB_TOPGEN   3392
#define XB_SPIN_CAP (1u << 20)
DI unsigned xb_ld(unsigned* p) { return __hip_atomic_load(p, __ATOMIC_RELAXED, __HIP_MEMORY_SCOPE_AGENT); }
DI unsigned xb_add(unsigned* p, unsigned v) { return __hip_atomic_fetch_add(p, v, __ATOMIC_RELAXED, __HIP_MEMORY_SCOPE_AGENT); }
DI unsigned xb_xcc_id() { return (unsigned)__builtin_amdgcn_s_getreg((3 << 11) | 20) & 0xFu; }
#define XB_SPIN(cond, bar) do { unsigned _sp = 0; while (cond) { __builtin_amdgcn_s_sleep(1); \
    if ((++_sp & 255u) == 0u) { if (xb_ld(&(bar)[XB_TMO])) break; if (_sp > XB_SPIN_CAP) { atomicAdd(&(bar)[XB_TMO], 1u); break; } } } } while (0)
DI void xcd_barrier_post(unsigned* bar) { if (threadIdx.x == 0) (void)xb_add(&bar[XB_XCNT(xb_xcc_id())], 1u); }
DI void xcd_barrier_complete(unsigned* bar, unsigned x, unsigned& nloc, unsigned& nx) {
    const unsigned G = gridDim.x;
    unsigned sum, cnt, mine, sp = 0u;
    for (;;) {
        sum = 0u; cnt = 0u; mine = 0u;
#pragma unroll
        for (unsigned j = 0; j < 16; ++j) { const unsigned c = xb_ld(&bar[XB_XCNT(j)]); sum += c; cnt += (c > 0u) ? 1u : 0u; mine = (j == x) ? c : mine; }
        if (sum == G) break;
        __builtin_amdgcn_s_sleep(1);
        if ((++sp & 255u) == 0u) { if (xb_ld(&bar[XB_TMO])) break; if (sp > XB_SPIN_CAP) { atomicAdd(&bar[XB_TMO], 1u); break; } }
    }
    nloc = mine > 0u ? mine : 1u; nx = cnt > 0u ? cnt : 1u;
}
DI void xcd_barrier(unsigned* bar, volatile unsigned* st) {
    asm volatile("s_waitcnt vmcnt(0)" ::: "memory");
    __syncthreads();
    if (threadIdx.x == 0) {
        __builtin_amdgcn_s_waitcnt(0);
        const unsigned x = xb_xcc_id();
        unsigned nloc = st[0], nx = st[1];
        if (nloc == 0u) { xcd_barrier_complete(bar, x, nloc, nx); st[0] = nloc; st[1] = nx; }
        const unsigned old = xb_add(&bar[XB_XSUB(x)], 1u);
        const unsigned gen = old / nloc;
        if (old + 1u == (gen + 1u) * nloc) {
            __builtin_amdgcn_fence(__ATOMIC_RELEASE, "agent");
            asm volatile("s_waitcnt vmcnt(0)" ::: "memory");
            const unsigned og = xb_add(&bar[XB_TOP], 1u);
            const unsigned tg = og / nx;
            if (og + 1u == (tg + 1u) * nx) xb_add(&bar[XB_TOPGEN], 1u);
            else XB_SPIN(xb_ld(&bar[XB_TOPGEN]) == tg, bar);
            __builtin_amdgcn_fence(__ATOMIC_ACQUIRE, "agent");
            xb_add(&bar[XB_XGEN(x)], 1u);
            asm volatile("s_waitcnt vmcnt(0)" ::: "memory");
        } else {
            XB_SPIN(xb_ld(&bar[XB_XGEN(x)]) == gen, bar);
            __builtin_amdgcn_fence(__ATOMIC_ACQUIRE, "agent");
            asm volatile("s_waitcnt vmcnt(0)" ::: "memory");
        }
    }
    __syncthreads();
}
__global__ void __launch_bounds__(NTHREADS) mk_forward(Params p) {
    extern __shared__ __attribute__((aligned(16))) char smem[];
    typedef const Params __attribute__((address_space(4)))* KPtr;
    volatile unsigned* xst = (volatile unsigned*)(smem + LDS_BYTES);
    if (threadIdx.x < 2) xst[threadIdx.x] = 0u;
    xcd_barrier_post((unsigned*)(p.ws + WS_XBAR));
#define PHASE(k, fn) { KPtr kp = (KPtr)__builtin_amdgcn_kernarg_segment_ptr(); asm volatile("" : "+s"(kp)); fn(*(const Params*)kp, smem); \
        unsigned* xbar = (unsigned*)(((const Params*)kp)->ws + WS_XBAR); \
        if ((k) + 1 < NPHASES) xcd_barrier(xbar, xst); }
    PHASE(0, phase0) PHASE(1, phase1) PHASE(2, phase2)
    if (!USE_G8) PHASE(3, phase_halo)
    PHASE(4, phase_fir) PHASE(5, phase3) PHASE(6, phase4)
    PHASE(7, phase5) PHASE(8, phase6) PHASE(9, phase7) PHASE(10, phase8) PHASE(11, phase9) PHASE(12, phase10)
#undef PHASE
}

extern "C" void kernel_launch(void* const* d_in, const int* in_sizes, int n_in, void* d_out, int out_size, void* d_ws, size_t ws_size, hipStream_t stream) {
    static int grid_blocks = 0;
    if (grid_blocks == 0) {
        if (n_in != 35 || out_size != T_LAT * D || ws_size < WS_END || (size_t)out_size * 4 < AUX_END) {
            fprintf(stderr, "kernel_launch: unexpected shapes (n_in %d out %d ws %zu need %zu aux need %zu)\n", n_in, out_size, ws_size, (size_t)WS_END, (size_t)AUX_END);
            grid_blocks = -1; return;
        }
        int dev = 0, cus = 0, per_cu = 0;
        hipGetDevice(&dev);
        hipDeviceGetAttribute(&cus, hipDeviceAttributeMultiprocessorCount, dev);
        hipFuncSetAttribute((const void*)mk_forward, hipFuncAttributeMaxDynamicSharedMemorySize, LDS_BYTES + 256);
        hipOccupancyMaxActiveBlocksPerMultiprocessor(&per_cu, (const void*)mk_forward, NTHREADS, LDS_BYTES + 256);
        if (per_cu < 1) { fprintf(stderr, "kernel_launch: occupancy query says %d blocks/CU\n", per_cu); per_cu = 1; }
        if (per_cu > 1) per_cu = 1;
        grid_blocks = cus * per_cu;
    }
    if (grid_blocks < 0) return;
    Params p{};
    for (int i = 0; i < 35; ++i) p.in[i] = (const float*)d_in[i];
    p.out = (float*)d_out; p.ws = (char*)d_ws; p.aux = (char*)d_out;
    p.ph_lo = 0; p.ph_hi = NPHASES;
    (void)hipMemsetAsync((char*)d_ws + WS_XBAR, 0, 3456 * 4, stream);
    void* args[] = {&p};
    hipError_t e = hipLaunchCooperativeKernel((const void*)mk_forward, dim3(grid_blocks), dim3(NTHREADS), args, LDS_BYTES + 256, stream);
    if (e != hipSuccess) fprintf(stderr, "cooperative launch failed: %s (grid %d)\n", hipGetErrorString(e), grid_blocks);
}
#endif
```

```cpp
#ifndef EMU
#include <hip/hip_runtime.h>
#include <hip/hip_cooperative_groups.h>
#include <cstdio>
#endif
#include <stdint.h>
#include <stddef.h>

#ifndef CFG_D
#define CFG_D 1024
#define CFG_B 8
#define CFG_S 2048
#define CFG_CTX 256
#endif
#ifndef MK_LAUNCHES
#define MK_LAUNCHES 1
#endif

typedef unsigned short bf16_t;
typedef short bf16x8 __attribute__((ext_vector_type(8)));
typedef float f32x4 __attribute__((ext_vector_type(4)));
typedef unsigned u32x4 __attribute__((ext_vector_type(4)));
typedef unsigned u32x2 __attribute__((ext_vector_type(2)));

#define DI __device__ __forceinline__
DI int tid_x() { int t = (int)threadIdx.x;
#ifndef EMU
    asm volatile("" : "+v"(t));
#endif
    return t; }

constexpr int D = CFG_D, NB = CFG_B, S = CFG_S, CTXL = CFG_CTX;
constexpr int GW = 64, ROWS = S / GW;
constexpr int T_CTX = NB * CTXL, T_LAT = NB * S, T_ALL = T_CTX + T_LAT;
constexpr int H_A = 4, H_B = 8;
constexpr int A_COLS = 2064, B_COLS = 1920;
constexpr int IN_COLS = A_COLS + B_COLS + 2 * D;
constexpr int COL_B0 = A_COLS, COL_G0 = A_COLS + B_COLS;
constexpr int CTX_COLS = COL_G0;
constexpr int NP = ((IN_COLS + 127) / 128) * 128;
constexpr int NEXP = 32, DE = 256;
constexpr int NV = NB + 1;
constexpr int NTHREADS = 512;
constexpr int MREP = (T_CTX % 256 == 0 && T_LAT % 256 == 0) ? 4 : 2;
constexpr int BM = 64 * MREP;
constexpr int NPHASES = 13;
enum { PH_MOD = 0, PH_U, PH_P, PH_HALO, PH_FIR, PH_CHAINS, PH_POST, PH_MERGE, PH_WOUT, PH_ROUTER, PH_UP, PH_DOWN, PH_FINAL };
constexpr int LDS_BYTES = 155648;
constexpr int CAP = T_LAT;

static_assert(D % 256 == 0 && S % 64 == 0 && CTXL % 64 == 0 && T_CTX % BM == 0 && T_LAT % BM == 0, "shape");

constexpr size_t al256(size_t x) { return (x + 255) & ~(size_t)255; }
constexpr int CNT_STRIDE = 64;
constexpr size_t WS_CNT = 512 + 3456 * 4 + 256;
constexpr int CNT_TICKET = 2 * CNT_STRIDE + 16, CNT_U2DONE = 3 * CNT_STRIDE + 16;
constexpr size_t WS_BAR = 256;
constexpr size_t WS_XBAR = 512;
constexpr size_t WS_MOD = 512 + 3456 * 4 + 256 + 32 * 64 * 4;
constexpr size_t WS_AB = al256(WS_MOD + (size_t)NV * 6 * D * 4);
constexpr size_t WS_BONUS = al256(WS_AB + (size_t)T_ALL * 16 * 4);
constexpr size_t WS_PAIRW = al256(WS_BONUS + (size_t)2 * T_LAT * 8 * 4);
constexpr size_t WS_ROWLIST = al256(WS_PAIRW + (size_t)T_LAT * 2 * 4);
constexpr size_t WS_WRT = al256(WS_ROWLIST + (size_t)NEXP * CAP * 4);
constexpr size_t WS_G2T = al256(WS_WRT + (size_t)36 * D * 4);
constexpr size_t WS_WOA = al256(WS_G2T + (size_t)512 * 128 * 2);
constexpr size_t WS_WOB = al256(WS_WOA + (size_t)D * 512 * 2);
constexpr size_t WS_WOUT = al256(WS_WOB + (size_t)D * 512 * 2);
constexpr size_t WS_OA = al256(WS_WOUT + (size_t)D * D * 2);
constexpr size_t WS_OB = al256(WS_OA + (size_t)T_LAT * 512 * 2);
constexpr size_t WS_HALO_A = WS_OA;
constexpr size_t WS_HALO_B = WS_OA + al256((size_t)(T_ALL / 64) * 4 * 1536 * 2);
static_assert(WS_HALO_B + (size_t)(T_ALL / 64) * 2 * 1920 * 2 <= WS_OB + (size_t)T_LAT * 512 * 2, "halo buffers");
constexpr size_t WS_DNT = WS_OA;
constexpr size_t WS_SPARE_END = al256(WS_OB + (size_t)T_LAT * 512 * 2) > al256(WS_DNT + (size_t)NEXP * D * DE * 2) ? al256(WS_OB + (size_t)T_LAT * 512 * 2) : al256(WS_DNT + (size_t)NEXP * D * DE * 2);
constexpr size_t WS_P = WS_SPARE_END;
constexpr size_t WS_PLAT = WS_P;
constexpr size_t WS_PCTX = al256(WS_PLAT + (size_t)T_LAT * IN_COLS * 2);
constexpr size_t WS_P_END = al256(WS_PCTX + (size_t)T_CTX * CTX_COLS * 2);
constexpr size_t WS_H = WS_P;
constexpr size_t WS_T = al256(WS_H + (size_t)T_LAT * D * 4);
constexpr size_t WS_HID = al256(WS_T + (size_t)T_LAT * D * 2);
constexpr size_t WS_OPAIR = al256(WS_HID + (size_t)T_LAT * 2 * DE * 2);
constexpr size_t WS_P2_END = al256(WS_OPAIR + (size_t)T_LAT * 2 * D * 2);
constexpr size_t WS_END0 = WS_P_END > WS_P2_END ? WS_P_END : WS_P2_END;
constexpr size_t WS_GUARANTEED = (size_t)256 << 20;
constexpr int NE_EARLY = WS_END0 >= WS_GUARANTEED ? 0 : ((WS_GUARANTEED - WS_END0) / ((size_t)D * DE * 2) >= (size_t)NEXP ? NEXP : (int)((WS_GUARANTEED - WS_END0) / ((size_t)D * DE * 2)));
constexpr size_t WS_DNT2 = WS_END0;
constexpr size_t WS_END = WS_DNT2 + (size_t)NE_EARLY * D * DE * 2;
constexpr size_t AUX_WINT = 0;
constexpr size_t AUX_U = al256((size_t)NP * D * 2);
constexpr size_t AUX_YDIR = 0;
constexpr size_t AUX_Y = 0;
constexpr size_t AUX_GUT = (size_t)T_LAT * D * 2 > (size_t)2 * T_LAT * 512 * 2 ? (size_t)T_LAT * D * 2 : (size_t)2 * T_LAT * 512 * 2;
constexpr size_t AUX_END1 = AUX_U + (size_t)T_ALL * D * 2;
constexpr size_t AUX_END2 = AUX_YDIR + (size_t)2 * T_LAT * 512 * 2;
static_assert(AUX_YDIR + (size_t)2 * T_LAT * 512 * 2 <= AUX_GUT && AUX_Y + (size_t)T_LAT * D * 2 <= AUX_GUT, "aux overlap");
constexpr size_t AUX_END3 = AUX_GUT + (size_t)NEXP * 512 * D * 2;
constexpr size_t AUX_END = (AUX_END1 > AUX_END2 ? (AUX_END1 > AUX_END3 ? AUX_END1 : AUX_END3) : (AUX_END2 > AUX_END3 ? AUX_END2 : AUX_END3));

#define DNT_PTR(ws, e) ((bf16_t*)((ws) + ((e) < NE_EARLY ? WS_DNT2 : WS_DNT)) + (size_t)(e) * D * DE)
struct Params {
    const float* in[35];
    float* out;
    char* ws;
    char* aux;
    int ph_lo, ph_hi;
};
enum { I_X = 0, I_C, I_CTX, I_CCTX, I_ADAW, I_ADAB, I_NMIX, I_NFFN, I_WIN, I_CONV, I_ALOG, I_DTB, I_ONORM, I_MU, I_W0, I_W2, I_A0, I_A2, I_G2, I_KK, I_KA, I_RK, I_LNG, I_LNB, I_WOA, I_WOB, I_WOUT, I_RG, I_RGB, I_RE, I_REB, I_MG, I_MU_UP, I_MD, I_FIN };

DI float bf2f(bf16_t v) { union { unsigned u; float f; } x; x.u = ((unsigned)v) << 16; return x.f; }
#ifdef EMU
DI bf16_t f2bf(float f) { union { float f; unsigned u; } x; x.f = f; unsigned u = x.u; u += 0x7fffu + ((u >> 16) & 1u); return (bf16_t)(u >> 16); }
DI unsigned pk2(float lo, float hi) { return (unsigned)f2bf(lo) | ((unsigned)f2bf(hi) << 16); }
#else
typedef __bf16 hbf16x2 __attribute__((ext_vector_type(2)));
typedef float f32x2_ __attribute__((ext_vector_type(2)));
DI bf16_t f2bf(float f) { return __builtin_bit_cast(unsigned short, (__bf16)f); }
DI unsigned pk2(float lo, float hi) { const f32x2_ v = {lo, hi}; return __builtin_bit_cast(unsigned, __builtin_convertvector(v, hbf16x2)); }
#endif
DI float sigmoidf_(float x) { return 1.0f / (1.0f + expf(-x)); }
DI float siluf_(float x) { return x / (1.0f + expf(-x)); }
DI float softplusf_(float x) { return x > 20.f ? x : log1pf(expf(x)); }
DI float wave_sum(float v) {
#pragma unroll
    for (int o = 1; o < 64; o <<= 1) v += __shfl_xor(v, o);
    return v;
}
#ifdef EMU
#define MFMA16(a, b, c) emu_mfma16((a), (b), (c))
#define WAVE_SYNC() emu::wave_bar()
#else
#define MFMA16(a, b, c) __builtin_amdgcn_mfma_f32_16x16x32_bf16((a), (b), (c), 0, 0, 0)
#define WAVE_SYNC() asm volatile("s_waitcnt lgkmcnt(0)" ::: "memory")
#endif
#ifdef EMU
#define LDS_BARRIER() __syncthreads()
#else
#define LDS_BARRIER() do { asm volatile("s_waitcnt lgkmcnt(0)" ::: "memory"); __builtin_amdgcn_s_barrier(); asm volatile("" ::: "memory"); } while (0)
#endif

typedef float f32x16 __attribute__((ext_vector_type(16)));
typedef float f32x2_ac __attribute__((ext_vector_type(2)));
typedef short bf16x4 __attribute__((ext_vector_type(4)));
#ifdef EMU
#define MFMA32(a, b, c) emu_mfma32((a), (b), (c))
DI float fexp(float x) { return expf(x); }
DI float flog(float x) { return logf(x); }
DI float frcp(float x) { return 1.0f / x; }
DI float frsq(float x) { return 1.0f / sqrtf(x); }
DI float wave_sum_fast(float v) { return wave_sum(v); }
#else
#define MFMA32(a, b, c) __builtin_amdgcn_mfma_f32_32x32x16_bf16((a), (b), (c), 0, 0, 0)
DI float fexp(float x) { return __expf(x); }
DI float flog(float x) { return __logf(x); }
DI float frcp(float x) { return __builtin_amdgcn_rcpf(x); }
DI float frsq(float x) { return __builtin_amdgcn_rsqf(x); }
#define DPP_ADD(v, ctrl) ((v) + __builtin_bit_cast(float, __builtin_amdgcn_update_dpp(0, __builtin_bit_cast(int, (v)), (ctrl), 0xf, 0xf, false)))
DI float wave_sum_fast(float v) {
    v = DPP_ADD(v, 0xB1); v = DPP_ADD(v, 0x4E); v = DPP_ADD(v, 0x141); v = DPP_ADD(v, 0x140);
    const int iv = __builtin_bit_cast(int, v);
    return (__builtin_bit_cast(float, __builtin_amdgcn_readlane(iv, 0)) + __builtin_bit_cast(float, __builtin_amdgcn_readlane(iv, 16))) +
           (__builtin_bit_cast(float, __builtin_amdgcn_readlane(iv, 32)) + __builtin_bit_cast(float, __builtin_amdgcn_readlane(iv, 48)));
}
#endif
DI float fsigmoid(float x) { return frcp(1.0f + fexp(-x)); }
DI float fsilu(float x) { return x * fsigmoid(x); }
DI float fsoftplus(float x) { return fmaxf(x, 0.f) + flog(1.f + fexp(-fabsf(x))); }
DI float ftanh(float x) { return 1.0f - 2.0f * frcp(1.0f + fexp(2.0f * x)); }

constexpr int LDS_ROW = 40;
constexpr int GEMM_A_BYTES = BM * LDS_ROW * 2, GEMM_B_BYTES = 128 * LDS_ROW * 2;
template <int MR, class ARow>
DI void gemm_kloop(f32x4 (&acc)[MR][4], char* smem, ARow arow, const bf16_t* Bt, int ldb, int K) {
    constexpr int BM = 64 * MR;
    const int tid = tid_x(), lane = tid & 63, wave = tid >> 6, wr = wave >> 1, wc = wave & 1, fr = lane & 15, fq = lane >> 4;
    bf16_t* As = (bf16_t*)smem;
    bf16_t* Bs = (bf16_t*)(smem + 2 * GEMM_A_BYTES);
    constexpr int ACH = BM * 4 / NTHREADS;
    static_assert(ACH >= 1, "tile");
    const bf16_t* ap[ACH];
#pragma unroll
    for (int i = 0; i < ACH; ++i) { const int q = tid + i * NTHREADS; ap[i] = arow(q >> 2) + (q & 3) * 8; }
    const bf16_t* bp = Bt + (size_t)(tid >> 2) * ldb + (tid & 3) * 8;
    u32x4 ra[ACH], rb;
#pragma unroll
    for (int i = 0; i < ACH; ++i) ra[i] = *(const u32x4*)(ap[i]);
    rb = *(const u32x4*)(bp);
    const int nk = K / 32;
    for (int kt = 0; kt < nk; ++kt) {
        const int buf = kt & 1;
#pragma unroll
        for (int i = 0; i < ACH; ++i) { const int q = tid + i * NTHREADS; *(u32x4*)(As + (buf * BM + (q >> 2)) * LDS_ROW + (q & 3) * 8) = ra[i]; }
        *(u32x4*)(Bs + (buf * 128 + (tid >> 2)) * LDS_ROW + (tid & 3) * 8) = rb;
        __syncthreads();
        if (kt + 1 < nk) {
#pragma unroll
            for (int i = 0; i < ACH; ++i) ra[i] = *(const u32x4*)(ap[i] + (kt + 1) * 32);
            rb = *(const u32x4*)(bp + (kt + 1) * 32);
        }
        bf16x8 af[MR], bfr[4];
#pragma unroll
        for (int m = 0; m < MR; ++m) af[m] = *(const bf16x8*)(As + (buf * BM + wr * 16 * MR + m * 16 + fr) * LDS_ROW + fq * 8);
#pragma unroll
        for (int n = 0; n < 4; ++n) bfr[n] = *(const bf16x8*)(Bs + (buf * 128 + wc * 64 + n * 16 + fr) * LDS_ROW + fq * 8);
#pragma unroll
        for (int m = 0; m < MR; ++m)
#pragma unroll
            for (int n = 0; n < 4; ++n) acc[m][n] = MFMA16(af[m], bfr[n], acc[m][n]);
    }
    __syncthreads();
}
template <int MR>
DI void acc_zero(f32x4 (&acc)[MR][4]) {
#pragma unroll
    for (int m = 0; m < MR; ++m)
#pragma unroll
        for (int n = 0; n < 4; ++n) acc[m][n] = (f32x4){0.f, 0.f, 0.f, 0.f};
}

namespace g8 {
constexpr int BM = 256, BK = 64, HALF = 128, HT = HALF * BK;
constexpr int LDS_NEED = 8 * HT * 2;
DI int lds_byte(int r, int c) { const int st = (r >> 4) * 2 + (c >> 5), rr = r & 15, cc = c & 31, ob = rr * 64 + cc * 2; return st * 1024 + (ob ^ (((ob >> 9) & 1) << 5)); }
DI void stage_rc(int b, int& R, int& C) { const int st = b / 1024, sb = b % 1024, swz = sb ^ (((sb >> 9) & 1) << 5); R = (st >> 1) * 16 + swz / 64; C = (st & 1) * 32 + (swz % 64) / 2; }
#ifdef EMU
#define G8_GLDS(src, dst) emu_global_load_lds16((src), (dst))
#define G8_WAIT_V(n)
#define G8_WAIT_L(n)
#define G8_BAR __syncthreads()
#define G8_SCHED
#define G8_PRIO(x)
#else
#define G8_GLDS(src, dst) __builtin_amdgcn_global_load_lds((const unsigned*)(src), (__attribute__((address_space(3))) unsigned*)(dst), 16, 0, 0)
#define G8_WAIT_V(n) asm volatile("s_waitcnt vmcnt(" #n ")" ::: "memory")
#define G8_WAIT_L(n) asm volatile("s_waitcnt lgkmcnt(" #n ")" ::: "memory")
#define G8_BAR __builtin_amdgcn_s_barrier()
#define G8_SCHED __builtin_amdgcn_sched_barrier(0)
#define G8_PRIO(x) __builtin_amdgcn_s_setprio(x)
#endif
typedef f32x4 Acc[2][2][4][2];
template <class AOff>
DI void kloop_g(Acc& acc, char* smem, const bf16_t* A, AOff aoff, const bf16_t* Bt, int ldb, int K, int bcol) {
    bf16_t* shm = (bf16_t*)smem;
    const int tid = tid_x(), wid = tid >> 6, lane = tid & 63, wr = wid >> 2, wc = wid & 3, fr = lane & 15, fq = lane >> 4;
    int ao[2][2];
#pragma unroll
    for (int h = 0; h < 2; ++h)
#pragma unroll
        for (int i = 0; i < 2; ++i) { int R, C; stage_rc(tid * 16 + i * 8192, R, C); ao[h][i] = aoff(h * HALF + R) + C; }
#define G8_STAGE_A(P, h, kt) do { for (int _i = 0; _i < 2; ++_i) { const int _b = tid * 16 + _i * 8192; G8_GLDS(A + (size_t)ao[h][_i] + (size_t)(kt) * BK, (char*)(P) + _b); } } while (0)
#define G8_SA(b, h) (shm + ((b) * 2 + (h)) * HT)
#define G8_SB(b, h) (shm + (4 + (b) * 2 + (h)) * HT)
#define G8_STAGE(P, BASE, LD, br, kt) do { const bf16_t* _g = (BASE) + (size_t)(br) * (LD) + (size_t)(kt) * BK; \
    for (int _i = 0; _i < 2; ++_i) { const int _b = tid * 16 + _i * 8192; int _r, _c; stage_rc(_b, _r, _c); G8_GLDS(_g + (size_t)_r * (LD) + _c, (char*)(P) + _b); } } while (0)
#define G8_LDA(dst, b, h) for (int m = 0; m < 4; ++m) for (int k = 0; k < 2; ++k) dst[m][k] = *(const bf16x8*)((const char*)G8_SA(b, h) + lds_byte(wr * 64 + m * 16 + fr, k * 32 + fq * 8))
#define G8_LDB(dst, b, h) for (int n = 0; n < 2; ++n) for (int k = 0; k < 2; ++k) dst[n][k] = *(const bf16x8*)((const char*)G8_SB(b, h) + lds_byte(wc * 32 + n * 16 + fr, k * 32 + fq * 8))
#define G8_MMA(ai, bj, At_, Bt_) do { G8_PRIO(1); for (int m = 0; m < 4; ++m) for (int n = 0; n < 2; ++n) for (int k = 0; k < 2; ++k) \
    acc[ai][bj][m][n] = MFMA16(Bt_[n][k], At_[m][k], acc[ai][bj][m][n]); G8_PRIO(0); } while (0)
    bf16x8 At[4][2], B0[2][2], B1[2][2];
    const int nt = K / BK;
    G8_STAGE(G8_SB(0, 0), Bt, ldb, bcol, 0); G8_STAGE_A(G8_SA(0, 0), 0, 0);
    G8_STAGE(G8_SB(0, 1), Bt, ldb, bcol + HALF, 0); G8_STAGE_A(G8_SA(0, 1), 1, 0);
    if (wr == 1) G8_BAR;
    G8_WAIT_V(4); G8_BAR;
    G8_STAGE(G8_SB(1, 0), Bt, ldb, bcol, 1); G8_STAGE_A(G8_SA(1, 0), 0, 1); G8_STAGE(G8_SB(1, 1), Bt, ldb, bcol + HALF, 1);
    G8_WAIT_V(6); G8_BAR;
    for (int t = 0; t < nt - 2; t += 2) {
        G8_LDB(B0, 0, 0); G8_SCHED; G8_LDA(At, 0, 0); G8_STAGE_A(G8_SA(1, 1), 1, t + 1);
        G8_WAIT_L(8); G8_BAR; G8_WAIT_L(0); G8_MMA(0, 0, At, B0); G8_BAR; G8_SCHED;
        G8_LDB(B1, 0, 1); G8_STAGE(G8_SB(0, 0), Bt, ldb, bcol, t + 2);
        G8_BAR; G8_WAIT_L(0); G8_MMA(0, 1, At, B1); G8_BAR;
        G8_LDA(At, 0, 1); G8_STAGE_A(G8_SA(0, 0), 0, t + 2);
        G8_BAR; G8_WAIT_L(0); G8_MMA(1, 0, At, B0); G8_BAR; G8_SCHED;
        G8_STAGE(G8_SB(0, 1), Bt, ldb, bcol + HALF, t + 2);
        G8_WAIT_V(6); G8_BAR; G8_MMA(1, 1, At, B1); G8_BAR;
        G8_LDB(B0, 1, 0); G8_SCHED; G8_LDA(At, 1, 0); G8_STAGE_A(G8_SA(0, 1), 1, t + 2);
        G8_WAIT_L(8); G8_BAR; G8_WAIT_L(0); G8_MMA(0, 0, At, B0); G8_BAR; G8_SCHED;
        G8_LDB(B1, 1, 1); G8_STAGE(G8_SB(1, 0), Bt, ldb, bcol, t + 3);
        G8_BAR; G8_WAIT_L(0); G8_MMA(0, 1, At, B1); G8_BAR;
        G8_LDA(At, 1, 1); G8_STAGE_A(G8_SA(1, 0), 0, t + 3);
        G8_BAR; G8_WAIT_L(0); G8_MMA(1, 0, At, B0); G8_BAR; G8_SCHED;
        G8_STAGE(G8_SB(1, 1), Bt, ldb, bcol + HALF, t + 3);
        G8_WAIT_V(6); G8_BAR; G8_MMA(1, 1, At, B1); G8_BAR;
    }
    { G8_LDB(B0, 0, 0); G8_LDA(At, 0, 0); G8_STAGE_A(G8_SA(1, 1), 1, nt - 1);
      G8_BAR; G8_WAIT_L(0); G8_MMA(0, 0, At, B0); G8_BAR;
      G8_LDB(B1, 0, 1); G8_BAR; G8_WAIT_L(0); G8_MMA(0, 1, At, B1); G8_BAR;
      G8_LDA(At, 0, 1); G8_WAIT_V(4); G8_BAR; G8_WAIT_L(0); G8_MMA(1, 0, At, B0); G8_MMA(1, 1, At, B1); G8_BAR; }
    { G8_LDB(B0, 1, 0); G8_LDA(At, 1, 0); G8_WAIT_V(2); G8_BAR; G8_WAIT_L(0); G8_MMA(0, 0, At, B0); G8_BAR;
      G8_LDB(B1, 1, 1); G8_WAIT_V(0); G8_BAR; G8_WAIT_L(0); G8_MMA(0, 1, At, B1); G8_BAR;
      G8_LDA(At, 1, 1); G8_BAR; G8_WAIT_L(0); G8_MMA(1, 0, At, B0); G8_MMA(1, 1, At, B1); G8_BAR; }
    if (wr == 0) G8_BAR;
#undef G8_SA
#undef G8_SB
#undef G8_STAGE
#undef G8_STAGE_A
#undef G8_LDA
#undef G8_LDB
#undef G8_MMA
}
DI void kloop(Acc& acc, char* smem, const bf16_t* A, int lda, const bf16_t* Bt, int ldb, int K, int brow, int bcol) {
    kloop_g(acc, smem, A, [&](int r) { return (brow + r) * lda; }, Bt, ldb, K, bcol);
}
DI bool tile_order(int L, int nM, int nN, int& pm, int& pn) {
    constexpr int NXCD = 8, WGM = 8;
    const int nwg = nM * nN; if (L >= nwg) return false;
    int wgid = L; { const int q = nwg / NXCD, r = nwg % NXCD, xcd = wgid % NXCD, off = wgid / NXCD; wgid = (xcd < r ? xcd * (q + 1) : r * (q + 1) + (xcd - r) * q) + off; }
    const int nig = WGM * nN, gid = wgid / nig, fm = gid * WGM, gsz = (nM - fm) < WGM ? (nM - fm) : WGM;
    pm = fm + ((wgid % nig) % gsz); pn = (wgid % nig) / gsz; return true;
}
DI void acc_zero(Acc& acc) {
#pragma unroll
    for (int a = 0; a < 2; ++a)
#pragma unroll
        for (int b = 0; b < 2; ++b)
#pragma unroll
            for (int m = 0; m < 4; ++m)
#pragma unroll
                for (int n = 0; n < 2; ++n) acc[a][b][m][n] = (f32x4){0.f, 0.f, 0.f, 0.f};
}
template <class F> DI void for_each_quad(const Acc& acc, int brow, int bcol, F f) {
    const int tid = tid_x(), wid = tid >> 6, lane = tid & 63, wr = wid >> 2, wc = wid & 3, fr = lane & 15, fq = lane >> 4;
#pragma unroll
    for (int ai = 0; ai < 2; ++ai)
#pragma unroll
        for (int m = 0; m < 4; ++m)
#pragma unroll
            for (int bj = 0; bj < 2; ++bj)
#pragma unroll
                for (int n = 0; n < 2; ++n) f(brow + ai * HALF + wr * 64 + m * 16 + fr, bcol + bj * HALF + wc * 32 + n * 16 + fq * 4, acc[ai][bj][m][n]);
}
}

constexpr bool USE_G8 = ((NB * CTXL) % 256 == 0) && ((NB * S) % 256 == 0) && (NP % 256 == 0) && (D % 256 == 0) && (D >= 256);
DI int gu_row(int c, int up) {
    if (USE_G8) return (c >> 7) * 256 + ((c >> 6) & 1) * 128 + ((c >> 4) & 3) * 32 + (up ? 16 : 0) + (c & 15);
    return (c >> 6) * 128 + ((c >> 5) & 1) * 64 + ((c >> 4) & 1) * 16 + (c & 15) + (up ? 32 : 0);
}
DI void transpose_item(const float* W, int N, int Nvalid, int k0, int n0, bf16_t* WT, int ldt, int mode, float* scr, int lane) {
    float tv[32];
#pragma unroll
    for (int i = 0; i < 32; ++i) {
        const int kk = 2 * i + (lane >> 5), n = n0 + (lane & 31);
        tv[i] = (n < Nvalid) ? W[(size_t)(k0 + kk) * N + n] : 0.f;
    }
#pragma unroll
    for (int i = 0; i < 32; ++i) scr[(2 * i + (lane >> 5)) * 33 + (lane & 31)] = tv[i];
    WAVE_SYNC();
    const int c = lane & 7;
#pragma unroll
    for (int j = 0; j < 4; ++j) {
        const int nl = (lane >> 3) + 8 * j; const float* s = scr + (8 * c) * 33 + nl;
        u32x4 o; o.x = pk2(s[0], s[33]); o.y = pk2(s[2 * 33], s[3 * 33]); o.z = pk2(s[4 * 33], s[5 * 33]); o.w = pk2(s[6 * 33], s[7 * 33]);
        const int n = n0 + nl; const int row = mode == 0 ? n : gu_row(n, mode == 2);
        *(u32x4*)(WT + (size_t)row * ldt + k0 + 8 * c) = o;
    }
    WAVE_SYNC();
}
DI void transpose_matrix(const float* W, int K, int N, int Npad, bf16_t* WT, int mode, char* smem, int gw, int ngw, int& base) {
    const int lane = tid_x() & 63, wave = tid_x() >> 6;
    float* scr = (float*)smem + wave * (64 * 33);
    const int nkb = K / 64, nnb = Npad / 32, nitems = nkb * nnb;
    int first = ((gw - base) % ngw + ngw) % ngw;
    for (int it = first; it < nitems; it += ngw) {
        const int kb = it / nnb, nb = it % nnb;
        transpose_item(W, N, N, kb * 64, nb * 32, WT, K, mode, scr, lane);
    }
    base = (base + nitems) % ngw;
}

DI void phase0(const Params& p, char* smem) {
    const int tid = tid_x(), lane = tid & 63, wave = tid >> 6;
    if (blockIdx.x == 0 && tid < NEXP) ((int*)(p.ws + WS_CNT))[tid * CNT_STRIDE] = 0;
    if (blockIdx.x == 0 && tid < 2) ((int*)(p.ws + WS_CNT))[tid ? CNT_U2DONE : CNT_TICKET] = 0;
    if (blockIdx.x == 0 && tid == 0) *(unsigned*)(p.ws + WS_BAR) = 0u;
    float* sil = (float*)smem;
    float* red = sil + NV * D;
    const int nitems = 6 * D / 32;
    bool did = false;
    for (int it = blockIdx.x; it < nitems; it += gridDim.x) {
        if (!did) {
            for (int i = tid; i < NV * D; i += NTHREADS) { const int v = i / D, k = i % D; const float cv = v < NB ? p.in[I_C][v * D + k] : p.in[I_CCTX][k]; sil[i] = siluf_(cv); }
            did = true;
        }
        __syncthreads();
        const int col = it * 32 + (lane & 31), rp = lane >> 5;
        float acc[NV];
#pragma unroll
        for (int v = 0; v < NV; ++v) acc[v] = 0.f;
        const int r0 = wave * (D / 8);
        float wv[D / 16];
#pragma unroll
        for (int i = 0; i < D / 16; ++i) wv[i] = p.in[I_ADAW][(size_t)(r0 + 2 * i + rp) * (6 * D) + col];
#pragma unroll
        for (int i = 0; i < D / 16; ++i) {
            const int row = r0 + 2 * i + rp;
#pragma unroll
            for (int v = 0; v < NV; ++v) acc[v] += sil[v * D + row] * wv[i];
        }
#pragma unroll
        for (int v = 0; v < NV; ++v) red[((wave * 2 + rp) * NV + v) * 32 + (lane & 31)] = acc[v];
        __syncthreads();
        if (tid < NV * 32) {
            const int v = tid / 32, cl = tid % 32; float s = p.in[I_ADAB][it * 32 + cl];
            for (int g = 0; g < 16; ++g) s += red[(g * NV + v) * 32 + cl];
            ((float*)(p.ws + WS_MOD))[(size_t)v * 6 * D + it * 32 + cl] = s;
        }
    }
    __syncthreads();
    const int gw = blockIdx.x * 8 + wave, ngw = gridDim.x * 8; int base = 0;
    {
        float* scr = (float*)smem + wave * (64 * 33);
        const int nkb = D / 64, nnb = NP / 32, nitems2 = nkb * nnb;
        for (int it = gw; it < nitems2; it += ngw) { const int kb = it / nnb, nb = it % nnb; transpose_item(p.in[I_WIN], IN_COLS, IN_COLS, kb * 64, nb * 32, (bf16_t*)(p.aux + AUX_WINT), D, 0, scr, lane); }
        base = nitems2 % ngw;
    }
    { float* WRT = (float*)(p.ws + WS_WRT);
      for (int i = blockIdx.x * NTHREADS + tid; i < 36 * D; i += gridDim.x * NTHREADS) { const int j = i / D, k = i % D; WRT[i] = j < 4 ? p.in[I_RG][(size_t)k * 4 + j] : p.in[I_RE][(size_t)k * 32 + (j - 4)]; } }
    transpose_matrix(p.in[I_WOA], 512, D, D, (bf16_t*)(p.ws + WS_WOA), 0, smem, gw, ngw, base);
    transpose_matrix(p.in[I_WOB], 512, D, D, (bf16_t*)(p.ws + WS_WOB), 0, smem, gw, ngw, base);
    transpose_matrix(p.in[I_WOUT], D, D, D, (bf16_t*)(p.ws + WS_WOUT), 0, smem, gw, ngw, base);
    transpose_matrix(p.in[I_G2], 128, 512, 512, (bf16_t*)(p.ws + WS_G2T), 0, smem, gw, ngw, base);
}

constexpr int NSEG = T_ALL / 64, NSEG_CTX = T_CTX / 64;
DI void halo_store(const Params& p, int row, int col, const u32x2& o) {
    int seq, b, j;
    if (row < T_CTX) { seq = 0; b = row / CTXL; j = row % CTXL; } else { seq = 1; const int rr = row - T_CTX; b = rr / S; j = rr % S; }
    const int L = seq ? S : CTXL; const int segbase = seq ? NSEG_CTX + b * (S / 64) : b * (CTXL / 64);
    if (col < 1536) {
        const int jm = j & 63;
        if (jm >= 62 && j + 2 < L) { const int g = segbase + (j >> 6) + 1; *(u32x2*)((bf16_t*)(p.ws + WS_HALO_A) + ((size_t)g * 4 + (jm - 62)) * 1536 + col) = o; }
        if (jm < 2 && j >= 64) { const int g = segbase + (j >> 6) - 1; *(u32x2*)((bf16_t*)(p.ws + WS_HALO_A) + ((size_t)g * 4 + 2 + jm) * 1536 + col) = o; }
    } else if (col >= COL_B0 && col < COL_B0 + 1920) {
        const int js = seq ? (j % GW) * ROWS + j / GW : j; const int jm = js & 63;
        if (jm == 63 && js + 1 < L) { const int g = segbase + (js >> 6) + 1; *(u32x2*)((bf16_t*)(p.ws + WS_HALO_B) + ((size_t)g * 2 + 0) * 1920 + (col - COL_B0)) = o; }
        if (jm == 0 && js >= 64) { const int g = segbase + (js >> 6) - 1; *(u32x2*)((bf16_t*)(p.ws + WS_HALO_B) + ((size_t)g * 2 + 1) * 1920 + (col - COL_B0)) = o; }
    }
}
DI void halo_zero_fill(const Params& p) {
    const int tid = tid_x(), lane = tid & 63, wave = tid >> 6; const int gw = blockIdx.x * 8 + wave, ngw = gridDim.x * 8;
    bf16_t* HA = (bf16_t*)(p.ws + WS_HALO_A); bf16_t* HB = (bf16_t*)(p.ws + WS_HALO_B);
    for (int it = gw; it < NSEG * 2; it += ngw) {
        const int g = it >> 1, side = it & 1;
        const bool ctx = g < NSEG_CTX; const int sg = ctx ? g % (CTXL / 64) : (g - NSEG_CTX) % (S / 64); const int nsg = ctx ? CTXL / 64 : S / 64;
        const bool edge = side ? (sg == nsg - 1) : (sg == 0);
        if (!edge) continue;
        for (int c = lane; c < 384; c += 64) *(u32x4*)(HA + ((size_t)g * 4 + 2 * side) * 1536 + c * 8) = (u32x4){0u, 0u, 0u, 0u};
        for (int c = lane; c < 240; c += 64) *(u32x4*)(HB + ((size_t)g * 2 + side) * 1920 + c * 8) = (u32x4){0u, 0u, 0u, 0u};
    }
}
DI void phase1(const Params& p, char* smem) {
    if (USE_G8) halo_zero_fill(p);
    const int lane = tid_x() & 63, wave = tid_x() >> 6;
    const int gw = blockIdx.x * 8 + wave, ngw = gridDim.x * 8;
    const float* mod = (const float*)(p.ws + WS_MOD);
    bf16_t* U = (bf16_t*)(p.aux + AUX_U);
    auto rowsrc = [&](int r) -> const float* { return r < T_CTX ? p.in[I_CTX] + (size_t)r * D : p.in[I_X] + (size_t)(r - T_CTX) * D; };
    f32x4 xn[D / 256];
    if (gw < T_ALL) {
#pragma unroll
        for (int j = 0; j < D / 256; ++j) xn[j] = *(const f32x4*)(rowsrc(gw) + j * 256 + lane * 4);
    }
    for (int r = gw; r < T_ALL; r += ngw) {
        const int v = r < T_CTX ? NB : (r - T_CTX) / S;
        f32x4 x[D / 256]; float ss = 0.f;
#pragma unroll
        for (int j = 0; j < D / 256; ++j) { x[j] = xn[j]; ss += x[j].x * x[j].x + x[j].y * x[j].y + x[j].z * x[j].z + x[j].w * x[j].w; }
        if (r + ngw < T_ALL) {
#pragma unroll
            for (int j = 0; j < D / 256; ++j) xn[j] = *(const f32x4*)(rowsrc(r + ngw) + j * 256 + lane * 4);
        }
        ss = wave_sum_fast(ss);
        const float rstd = frsq(ss * (1.0f / D) + 1e-6f);
#pragma unroll
        for (int j = 0; j < D / 256; ++j) {
            const int k = j * 256 + lane * 4;
            const f32x4 g = *(const f32x4*)(p.in[I_NMIX] + k), sh = *(const f32x4*)(mod + (size_t)v * 6 * D + k), sc = *(const f32x4*)(mod + (size_t)v * 6 * D + D + k);
            float o0 = x[j].x * rstd * g.x * (1.f + sc.x) + sh.x, o1 = x[j].y * rstd * g.y * (1.f + sc.y) + sh.y;
            float o2 = x[j].z * rstd * g.z * (1.f + sc.z) + sh.z, o3 = x[j].w * rstd * g.w * (1.f + sc.w) + sh.w;
            u32x2 o; o.x = pk2(o0, o1); o.y = pk2(o2, o3);
            *(u32x2*)(U + (size_t)r * D + k) = o;
        }
    }
}

DI void phase2(const Params& p, char* smem) {
    const bf16_t* U = (const bf16_t*)(p.aux + AUX_U); const bf16_t* WT = (const bf16_t*)(p.aux + AUX_WINT);
    bf16_t* PL = (bf16_t*)(p.ws + WS_PLAT); bf16_t* PC = (bf16_t*)(p.ws + WS_PCTX); float* AB = (float*)(p.ws + WS_AB);
    if (USE_G8) {
        constexpr int NT = NP / 256, MT = T_ALL / 256, NT_CTX = (CTX_COLS + 255) / 256;
        for (int t = blockIdx.x; t < MT * NT; t += gridDim.x) {
            int mt, nt; if (!g8::tile_order(t, MT, NT, mt, nt)) break;
            const int brow = mt * 256, bcol = nt * 256; const bool isctx = brow < T_CTX;
            if (isctx && nt >= NT_CTX) continue;
            g8::Acc acc; g8::acc_zero(acc);
            g8::kloop(acc, smem, U, D, WT, D, D, brow, bcol);
            constexpr int OLD_ = 264; bf16_t* OT = (bf16_t*)smem;
            g8::for_each_quad(acc, brow, bcol, [&](int row, int col, const f32x4& v) {
                u32x2 o; o.x = pk2(v.x, v.y); o.y = pk2(v.z, v.w);
                *(u32x2*)(OT + (row - brow) * OLD_ + (col - bcol)) = o;
                if (col >= 2048 && col < 2064) *(f32x4*)(AB + (size_t)row * 16 + (col - 2048)) = v;
                halo_store(p, row, col, o);
            });
            __syncthreads();
            {
                const int tid = tid_x(); const int ncols = isctx ? CTX_COLS : IN_COLS;
                bf16_t* dst = isctx ? PC + (size_t)brow * CTX_COLS : PL + (size_t)(brow - T_CTX) * IN_COLS;
#pragma unroll
                for (int i = 0; i < 16; ++i) {
                    const int ch = tid + i * NTHREADS, row = ch >> 5, c8 = (ch & 31) * 8, col = bcol + c8;
                    if (col < ncols) *(u32x4*)(dst + (size_t)row * ncols + col) = *(const u32x4*)(OT + row * OLD_ + c8);
                }
            }
            __syncthreads();
        }
        return;
    }
    const int tid = tid_x(), lane = tid & 63, wave = tid >> 6, wr = wave >> 1, wc = wave & 1, fr = lane & 15, fq = lane >> 4;
    constexpr int NT = NP / 128, MT = T_ALL / BM, NT_CTX = (CTX_COLS + 127) / 128;
    for (int t = blockIdx.x; t < MT * NT; t += gridDim.x) {
        const int mt = t / NT, nt = t % NT; const int row0 = mt * BM; const bool isctx = row0 < T_CTX;
        if (isctx && nt >= NT_CTX) continue;
        f32x4 acc[MREP][4]; acc_zero(acc);
        gemm_kloop(acc, smem, [&](int i) { return U + (size_t)(row0 + i) * D; }, WT + (size_t)nt * 128 * D, D, D);
#pragma unroll
        for (int m = 0; m < MREP; ++m)
#pragma unroll
            for (int n = 0; n < 4; ++n)
#pragma unroll
                for (int j = 0; j < 4; ++j) {
                    const int row = row0 + wr * 16 * MREP + m * 16 + fq * 4 + j, col = nt * 128 + wc * 64 + n * 16 + fr; const float v = acc[m][n][j];
                    if (isctx) { if (col < CTX_COLS) PC[(size_t)row * CTX_COLS + col] = f2bf(v); }
                    else { if (col < IN_COLS) PL[(size_t)(row - T_CTX) * IN_COLS + col] = f2bf(v); }
                    if (col >= 2048 && col < 2064) AB[(size_t)row * 16 + (col - 2048)] = v;
                }
    }
}


DI int crow(int g, int h) { return (g & 3) + 8 * (g >> 2) + 4 * h; }
template <int S_> DI bf16x8 pack_acc(const f32x16& x) {
    u32x4 r;
    r.x = pk2(x[8 * S_ + 0], x[8 * S_ + 1]); r.y = pk2(x[8 * S_ + 2], x[8 * S_ + 3]); r.z = pk2(x[8 * S_ + 4], x[8 * S_ + 5]); r.w = pk2(x[8 * S_ + 6], x[8 * S_ + 7]);
    return __builtin_bit_cast(bf16x8, r);
}
DI bf16x8 ld_nat(const bf16_t* row, int s, int h) { return *(const bf16x8*)(row + 16 * s + 8 * h); }
DI bf16x8 ld_perm(const bf16_t* row, int s, int h) {
    const bf16x4 lo = *(const bf16x4*)(row + 16 * s + 4 * h), hi = *(const bf16x4*)(row + 16 * s + 8 + 4 * h);
    return __builtin_shufflevector(lo, hi, 0, 1, 2, 3, 4, 5, 6, 7);
}
DI f32x16 zero16() { f32x16 z;
#pragma unroll
    for (int i = 0; i < 16; ++i) z[i] = 0.f;
    return z; }
#define TGET(i) ((i) < 16 ? t0[(i) & 15] : t1[(i) & 15])
DI void invert32_col(const float* Lf, f32x16& t0, f32x16& t1, int c) {
#pragma unroll
    for (int i = 0; i < 32; ++i) {
        float s0 = 0.f, s1 = 0.f, s2 = 0.f, s3 = 0.f;
#pragma unroll
        for (int j4 = 0; j4 < (i + 3) / 4; ++j4) {
            const f32x4 l = *(const f32x4*)(Lf + i * 32 + 4 * j4);
            if (4 * j4 + 0 < i) s0 += l.x * TGET(4 * j4 + 0);
            if (4 * j4 + 1 < i) s1 += l.y * TGET(4 * j4 + 1);
            if (4 * j4 + 2 < i) s2 += l.z * TGET(4 * j4 + 2);
            if (4 * j4 + 3 < i) s3 += l.w * TGET(4 * j4 + 3);
        }
        float sm = -((s0 + s1) + (s2 + s3));
#ifndef EMU
        asm volatile("" : "+v"(sm));
#endif
        const float v = (i > c) ? sm : (i == c ? 1.f : 0.f);
        if (i < 16) t0[i & 15] = v; else t1[i & 15] = v;
    }
}

DI void seg_info(int g, int& seq, int& b, int& j0) {
    if (g < NSEG_CTX) { seq = 0; b = g / (CTXL / 64); j0 = (g % (CTXL / 64)) * 64; } else { const int g2 = g - NSEG_CTX; seq = 1; b = g2 / (S / 64); j0 = (g2 % (S / 64)) * 64; }
}
DI const bf16_t* seq_row(const Params& p, int seq, int b, int j, bool scan_order) {
    if (seq) { const int l = scan_order ? (j % ROWS) * GW + j / ROWS : j; return (const bf16_t*)(p.ws + WS_PLAT) + (size_t)(b * S + l) * IN_COLS; }
    return (const bf16_t*)(p.ws + WS_PCTX) + (size_t)(b * CTXL + j) * CTX_COLS;
}
DI void phase_halo(const Params& p, char* smem) {
    if (USE_G8) return;
    const int tid = tid_x(), lane = tid & 63, wave = tid >> 6;
    const int gw = blockIdx.x * 8 + wave, ngw = gridDim.x * 8;
    bf16_t* HA = (bf16_t*)(p.ws + WS_HALO_A); bf16_t* HB = (bf16_t*)(p.ws + WS_HALO_B);
    for (int it = gw; it < NSEG * 6; it += ngw) {
        const int g = it / 6, hr = it % 6; int seq, b, j0; seg_info(g, seq, b, j0);
        const int L = seq ? S : CTXL;
        if (hr < 4) {
            const int j = hr < 2 ? j0 - 2 + hr : j0 + 62 + hr; const bool ok = j >= 0 && j < L;
            const bf16_t* src = seq_row(p, seq, b, ok ? j : 0, false);
            for (int c = lane; c < 192; c += 64) { u32x4 v = {0u, 0u, 0u, 0u}; if (ok) v = *(const u32x4*)(src + c * 8); *(u32x4*)(HA + ((size_t)g * 4 + hr) * 1536 + c * 8) = v; }
        } else {
            const int j = hr == 4 ? j0 - 1 : j0 + 64; const bool ok = j >= 0 && j < L;
            const bf16_t* src = seq_row(p, seq, b, ok ? j : 0, true) + COL_B0;
            for (int c = lane; c < 240; c += 64) { u32x4 v = {0u, 0u, 0u, 0u}; if (ok) v = *(const u32x4*)(src + c * 8); *(u32x4*)(HB + ((size_t)g * 2 + (hr - 4)) * 1920 + c * 8) = v; }
        }
    }
}
DI f32x2_ac unpk2(unsigned w) { return (f32x2_ac){bf2f((bf16_t)(w & 0xffffu)), bf2f((bf16_t)(w >> 16))}; }
DI void unpack8(const u32x4& q, float (&f)[8]) {
    f[0] = bf2f((bf16_t)(q.x & 0xffffu)); f[1] = bf2f((bf16_t)(q.x >> 16)); f[2] = bf2f((bf16_t)(q.y & 0xffffu)); f[3] = bf2f((bf16_t)(q.y >> 16));
    f[4] = bf2f((bf16_t)(q.z & 0xffffu)); f[5] = bf2f((bf16_t)(q.z >> 16)); f[6] = bf2f((bf16_t)(q.w & 0xffffu)); f[7] = bf2f((bf16_t)(q.w >> 16));
}
DI float row16_sum(float v) {
#ifdef EMU
    v += __shfl_xor(v, 1); v += __shfl_xor(v, 2); v += __shfl_xor(v, 4); v += __shfl_xor(v, 8); return v;
#else
    v = DPP_ADD(v, 0xB1); v = DPP_ADD(v, 0x4E); v = DPP_ADD(v, 0x141); v = DPP_ADD(v, 0x140); return v;
#endif
}
DI void phase_fir(const Params& p, char* smem) {
    const int tid = tid_x(), lane = tid & 63, wave = tid >> 6;
    const int gw = blockIdx.x * 8 + wave, ngw = gridDim.x * 8;
    const bf16_t* HA = (const bf16_t*)(p.ws + WS_HALO_A); const bf16_t* HB = (const bf16_t*)(p.ws + WS_HALO_B);
    constexpr int NA = NSEG * 3, NBI = NSEG * 4;
    const u32x4 z4 = {0u, 0u, 0u, 0u};
    for (int it = gw; it < NA + NBI; it += ngw) {
        if (it < NA) {
            const int g = it / 3, s = it % 3; int seq, b, j0; seg_info(g, seq, b, j0);
            const int col = s * 512 + 8 * lane, ldp = seq ? IN_COLS : CTX_COLS;
            bf16_t* base = (bf16_t*)seq_row(p, seq, b, j0, false) + col;
            const bf16_t* hal = HA + (size_t)g * 4 * 1536 + col;
            float cw[5][8];
#pragma unroll
            for (int t = 0; t < 5; ++t) { const f32x4 w0 = *(const f32x4*)(p.in[I_CONV] + t * 1536 + col), w1 = *(const f32x4*)(p.in[I_CONV] + t * 1536 + col + 4);
                cw[t][0] = w0.x; cw[t][1] = w0.y; cw[t][2] = w0.z; cw[t][3] = w0.w; cw[t][4] = w1.x; cw[t][5] = w1.y; cw[t][6] = w1.z; cw[t][7] = w1.w; }
            u32x4 win[12], nxt[8];
            win[0] = *(const u32x4*)(hal); win[1] = *(const u32x4*)(hal + 1536);
            win[2] = *(const u32x4*)(base); win[3] = *(const u32x4*)(base + ldp);
#pragma unroll
            for (int i = 0; i < 8; ++i) win[4 + i] = *(const u32x4*)(base + (size_t)(2 + i) * ldp);
#pragma unroll 1
            for (int blk = 0; blk < 8; ++blk) {
                if (blk < 7) {
#pragma unroll
                    for (int i = 0; i < 8; ++i) { const int t = 8 * blk + 10 + i; nxt[i] = t < 64 ? *(const u32x4*)(base + (size_t)t * ldp) : *(const u32x4*)(hal + (size_t)(2 + (t - 64)) * 1536); }
                }
#pragma unroll
                for (int i = 0; i < 8; ++i) {
                    float a[8];
#pragma unroll
                    for (int e = 0; e < 8; ++e) a[e] = 0.f;
#pragma unroll
                    for (int t = 0; t < 5; ++t) { float x[8]; unpack8(win[i + t], x);
#pragma unroll
                        for (int e = 0; e < 8; ++e) a[e] += x[e] * cw[t][e]; }
                    float ss = 0.f;
#pragma unroll
                    for (int e = 0; e < 8; ++e) { a[e] = fsilu(a[e]); ss += a[e] * a[e]; }
                    if (s < 2) { const float sc = frsq(row16_sum(ss) + 1e-6f) * (s == 0 ? 0.08838834764831845f : 1.0f);
#pragma unroll
                        for (int e = 0; e < 8; ++e) a[e] *= sc; }
                    u32x4 o; o.x = pk2(a[0], a[1]); o.y = pk2(a[2], a[3]); o.z = pk2(a[4], a[5]); o.w = pk2(a[6], a[7]);
                    *(u32x4*)(base + (size_t)(8 * blk + i) * ldp) = o;
                }
#pragma unroll
                for (int i = 0; i < 4; ++i) win[i] = win[8 + i];
#pragma unroll
                for (int i = 0; i < 8; ++i) win[4 + i] = nxt[i];
            }
        } else {
            const int it2 = it - NA, g = it2 / 4, sl = it2 % 4; int seq, b, j0; seg_info(g, seq, b, j0);
            const int bcol = sl * 512 + 8 * lane; const bool act = bcol < 1920;
            const int bc = act ? bcol : 0, col = COL_B0 + bc;
            float mu8[8];
            { const f32x4 m0 = *(const f32x4*)(p.in[I_MU] + bc), m1 = *(const f32x4*)(p.in[I_MU] + bc + 4); mu8[0] = m0.x; mu8[1] = m0.y; mu8[2] = m0.z; mu8[3] = m0.w; mu8[4] = m1.x; mu8[5] = m1.y; mu8[6] = m1.z; mu8[7] = m1.w; }
            const bool th = (bc >= 1536 && bc < 1664);
            const bf16_t* hal = HB + (size_t)g * 2 * 1920 + bc;
            u32x4 win[10], nxt[8];
            win[0] = *(const u32x4*)(hal); win[1] = *(const u32x4*)(seq_row(p, seq, b, j0, true) + col);
#pragma unroll
            for (int i = 0; i < 8; ++i) win[2 + i] = *(const u32x4*)(seq_row(p, seq, b, j0 + 1 + i, true) + col);
#pragma unroll 1
            for (int blk = 0; blk < 8; ++blk) {
                if (blk < 7) {
#pragma unroll
                    for (int i = 0; i < 8; ++i) { const int t = 8 * blk + 9 + i; nxt[i] = t < 64 ? *(const u32x4*)(seq_row(p, seq, b, j0 + t, true) + col) : *(const u32x4*)(hal + 1920); }
                }
#pragma unroll
                for (int i = 0; i < 8; ++i) {
                    float pv[8], cu[8], nx[8], x[8]; unpack8(win[i], pv); unpack8(win[i + 1], cu); unpack8(win[i + 2], nx);
#pragma unroll
                    for (int e = 0; e < 8; ++e) { x[e] = cu[e] + (0.5f * (pv[e] + nx[e]) - cu[e]) * mu8[e]; if (th) x[e] = ftanh(x[e]); }
                    u32x4 o; o.x = pk2(x[0], x[1]); o.y = pk2(x[2], x[3]); o.z = pk2(x[4], x[5]); o.w = pk2(x[6], x[7]);
                    if (act) *(u32x4*)((bf16_t*)seq_row(p, seq, b, j0 + 8 * blk + i, true) + col) = o;
                }
                win[0] = win[8]; win[1] = win[9];
#pragma unroll
                for (int i = 0; i < 8; ++i) win[2 + i] = nxt[i];
            }
        }
    }
}

constexpr int GC = 32;
constexpr int G_NT = (CTXL + S) / GC;
constexpr int LD128 = 136, LD64 = 72, LD32 = 40;
DI void chunk_pos(int x, int d, int& seg, int& j0) {
    constexpr int n0 = CTXL / GC, n1 = S / GC;
    if (x < n0) { seg = 0; j0 = (d ? n0 - 1 - x : x) * GC; } else { seg = 1; const int xx = x - n0; j0 = (d ? n1 - 1 - xx : xx) * GC; }
}

template <class Emit>
DI void invert32_blocked(const float* Lf, bf16_t* scr, int lane, Emit emit) {
    bf16_t* T00T = scr; bf16_t* T11R = scr + 16 * LD32; bf16_t* L10R = scr + 2 * 16 * LD32; bf16_t* P1T = scr + 3 * 16 * LD32;
    const int blk = lane >> 5, c = lane & 15, r = lane & 31, fr = lane & 15, fq = lane >> 4;
    f32x16 t;
    const float* Lb = Lf + (16 * blk) * 32 + 16 * blk;
#pragma unroll
    for (int i = 0; i < 16; ++i) {
        float s0 = 0.f, s1 = 0.f, s2 = 0.f, s3 = 0.f;
#pragma unroll
        for (int j4 = 0; j4 < (i + 3) / 4; ++j4) {
            const f32x4 l = *(const f32x4*)(Lb + i * 32 + 4 * j4);
            if (4 * j4 + 0 < i) s0 += l.x * t[4 * j4 + 0];
            if (4 * j4 + 1 < i) s1 += l.y * t[4 * j4 + 1];
            if (4 * j4 + 2 < i) s2 += l.z * t[4 * j4 + 2];
            if (4 * j4 + 3 < i) s3 += l.w * t[4 * j4 + 3];
        }
        float sm = -((s0 + s1) + (s2 + s3));
#ifndef EMU
        asm volatile("" : "+v"(sm));
#endif
        t[i] = (i > c) ? sm : (i == c ? 1.f : 0.f);
    }
    if (r < 16) {
        if (blk == 0) {
#pragma unroll
            for (int q = 0; q < 4; ++q) { u32x2 o; o.x = pk2(t[4 * q], t[4 * q + 1]); o.y = pk2(t[4 * q + 2], t[4 * q + 3]); *(u32x2*)(T00T + c * LD32 + 4 * q) = o; }
        } else {
#pragma unroll
            for (int i = 0; i < 16; ++i) T11R[i * LD32 + c] = f2bf(t[i]);
        }
    }
    { const int i = lane >> 2, j4 = (lane & 3) * 4; const f32x4 l = *(const f32x4*)(Lf + (16 + i) * 32 + j4);
      u32x2 o; o.x = pk2(l.x, l.y); o.y = pk2(l.z, l.w); *(u32x2*)(L10R + i * LD32 + j4) = o; }
    WAVE_SYNC();
    const bf16x8 zf = {0, 0, 0, 0, 0, 0, 0, 0};
    f32x4 p1 = {0.f, 0.f, 0.f, 0.f};
    {
        const bf16x8 af = fq < 2 ? *(const bf16x8*)(L10R + fr * LD32 + 8 * fq) : zf, bfm = fq < 2 ? *(const bf16x8*)(T00T + fr * LD32 + 8 * fq) : zf;
        p1 = MFMA16(af, bfm, p1);
    }
    { u32x2 o; o.x = pk2(p1[0], p1[1]); o.y = pk2(p1[2], p1[3]); *(u32x2*)(P1T + fr * LD32 + 4 * fq) = o; }
    WAVE_SYNC();
    f32x4 p2 = {0.f, 0.f, 0.f, 0.f};
    {
        const bf16x8 af = fq < 2 ? *(const bf16x8*)(T11R + fr * LD32 + 8 * fq) : zf, bfm = fq < 2 ? *(const bf16x8*)(P1T + fr * LD32 + 8 * fq) : zf;
        p2 = MFMA16(af, bfm, p2);
    }
#pragma unroll
    for (int j = 0; j < 4; ++j) emit(16 + 4 * fq + j, fr, -p2[j]);
    if (r < 16) {
#pragma unroll
        for (int i = 0; i < 16; ++i) { emit(16 * blk + i, 16 * blk + c, t[i]); if (blk == 0) emit(i, 16 + c, 0.f); }
    }
}
constexpr int GL_Q = 0;
constexpr int GL_KT = GL_Q + 2 * 32 * LD128 * 2;
constexpr int GL_VT = GL_KT + 2 * 128 * LD32 * 2;
constexpr int GL_K = GL_VT + 2 * 128 * LD32 * 2;
constexpr int GL_QKM = GL_K + 32 * LD128 * 2;
constexpr int GL_LF = GL_QKM + 2 * 32 * LD32 * 2;
constexpr int GL_TP = GL_LF + 32 * 32 * 4;
constexpr int GL_TPP = GL_TP + 32 * LD32 * 2;
constexpr int GL_WN = GL_TPP + 2 * 32 * LD32 * 2;
constexpr int GL_SC = GL_WN + 32 * LD128 * 2;
constexpr int GL_GC = GL_SC + 2 * 8 * 32 * 4;
constexpr int GL_CW = GL_GC + 8 * 32 * 4;
constexpr int GL_INV = GL_CW + 5 * 3 * 128 * 4;
constexpr int GL_RAW = GL_INV + 4 * 32 * LD32 * 2;
constexpr int GL_END = GL_RAW + 32 * 384 * 2;
static_assert(GL_END <= LDS_BYTES, "gdn lds");

DI void gdn_chain2(const Params& p, char* smem, int item) {
    const int d = item / (NB * H_A), b = (item / H_A) % NB, h = item % H_A;
    const int tid = tid_x(), lane = tid & 63, wave0_ = tid >> 6;
    bf16_t* Qs = (bf16_t*)(smem + GL_Q); bf16_t* KTs = (bf16_t*)(smem + GL_KT); bf16_t* VTs = (bf16_t*)(smem + GL_VT); bf16_t* Ks = (bf16_t*)(smem + GL_K);
    bf16_t* QKMs = (bf16_t*)(smem + GL_QKM); float* Lf = (float*)(smem + GL_LF); bf16_t* Tp = (bf16_t*)(smem + GL_TP); bf16_t* Tpp = (bf16_t*)(smem + GL_TPP);
    bf16_t* Wn = (bf16_t*)(smem + GL_WN); float* SC = (float*)(smem + GL_SC); float* GCs = (float*)(smem + GL_GC); float* CW = (float*)(smem + GL_CW);
    const float alog = p.in[I_ALOG][d * 4 + h], dtb = p.in[I_DTB][d * 4 + h], negea = -expf(alog);
    bf16_t* ODIR = (bf16_t*)(p.ws + WS_OA);
    __syncthreads();
    f32x16 St[4];
#pragma unroll
    for (int ct = 0; ct < 4; ++ct) St[ct] = zero16();
    bf16_t* RAW = (bf16_t*)(smem + GL_RAW);
    float pa = 0.f, pbt = 0.f;
    auto prefetch = [&](int x, int wsel, int nw) {
        int seg, j0; chunk_pos(x, d, seg, j0);
        const int ldp = seg ? IN_COLS : CTX_COLS;
        const bf16_t* pbase = seg ? (const bf16_t*)(p.ws + WS_PLAT) + (size_t)b * S * IN_COLS : (const bf16_t*)(p.ws + WS_PCTX) + (size_t)b * CTXL * CTX_COLS;
        for (int inst = wsel; inst < 24; inst += nw) {
            const int q = inst * 64 + lane, row = q / 48, c16 = q % 48;
            const bf16_t* src = pbase + (size_t)(j0 + row) * ldp + (c16 >> 4) * 512 + h * 128 + (c16 & 15) * 8;
#ifdef EMU
            emu_global_load_lds16(src, (char*)RAW + q * 16);
#else
            __builtin_amdgcn_global_load_lds((const unsigned*)src, (__attribute__((address_space(3))) unsigned*)((char*)RAW + q * 16), 16, 0, 0);
#endif
        }
    };
    auto prefetch_ab = [&](int x) {
        int seg, j0; chunk_pos(x, d, seg, j0);
        const float* abbase = (const float*)(p.ws + WS_AB) + (size_t)(seg ? T_CTX + b * S : b * CTXL) * 16;
        const int jw = j0 + 4 * wave0_;
        if (lane < 4) { pa = abbase[(size_t)(jw + lane) * 16 + d * 4 + h]; pbt = abbase[(size_t)(jw + lane) * 16 + 8 + d * 4 + h]; }
    };
    prefetch(0, wave0_, 8); prefetch_ab(0);
#ifndef EMU
    asm volatile("s_waitcnt vmcnt(0)" ::: "memory");
#endif
    const int r0_ = lane & 31, hh0_ = lane >> 5;
    __syncthreads();
    for (int it = -1; it < G_NT; ++it) {
        int r = r0_, hh = hh0_, wave = wave0_;
#ifndef EMU
        asm volatile("" : "+v"(r), "+v"(hh), "+v"(wave));
#endif
        const int xn = it + 1, par = xn & 1;
        int segn = 0, j0n = 0; if (xn < G_NT) chunk_pos(xn, d, segn, j0n);
        if (xn < G_NT) {
            const int i0 = d ? (GC - 4 - 4 * wave) : 4 * wave;
            bf16_t kt[2][4], vt[2][4];
#pragma unroll
            for (int t = 0; t < 4; ++t) {
                const int e = d ? 3 - t : t, i = i0 + e;
                const unsigned wq = *(const unsigned*)(RAW + (4 * wave + t) * 384 + 2 * lane), wk = *(const unsigned*)(RAW + (4 * wave + t) * 384 + 128 + 2 * lane), wv = *(const unsigned*)(RAW + (4 * wave + t) * 384 + 256 + 2 * lane);
                *(unsigned*)(Qs + (par * 32 + i) * LD128 + 2 * lane) = wq;
                *(unsigned*)(Ks + i * LD128 + 2 * lane) = wk;
                kt[0][e] = (bf16_t)(wk & 0xffffu); kt[1][e] = (bf16_t)(wk >> 16); vt[0][e] = (bf16_t)(wv & 0xffffu); vt[1][e] = (bf16_t)(wv >> 16);
            }
#pragma unroll
            for (int q = 0; q < 2; ++q) {
                u32x2 o; o.x = (unsigned)kt[q][0] | ((unsigned)kt[q][1] << 16); o.y = (unsigned)kt[q][2] | ((unsigned)kt[q][3] << 16);
                *(u32x2*)(KTs + (par * 128 + 2 * lane + q) * LD32 + i0) = o;
                u32x2 o2; o2.x = (unsigned)vt[q][0] | ((unsigned)vt[q][1] << 16); o2.y = (unsigned)vt[q][2] | ((unsigned)vt[q][3] << 16);
                *(u32x2*)(VTs + (par * 128 + 2 * lane + q) * LD32 + i0) = o2;
            }
            if (lane < 4) { const int i = d ? (GC - 1 - 4 * wave - lane) : (4 * wave + lane);
                SC[(par * 8 + 0) * 32 + i] = negea * fsoftplus(pa + dtb); SC[(par * 8 + 1) * 32 + i] = fsigmoid(pbt); }
            if (xn + 1 < G_NT) prefetch_ab(xn + 1);
        }
        LDS_BARRIER();
        if (wave >= 4 && wave < 7 && xn + 1 < G_NT) {
            prefetch(xn + 1, wave - 4, 3);
#ifndef EMU
            asm volatile("s_waitcnt vmcnt(0)" ::: "memory");
#endif
        }
        if (xn < G_NT) {
            const float* graw = SC + (par * 8 + 0) * 32;
            float gcv = 0.f;
#pragma unroll
            for (int s4 = 0; s4 < 8; ++s4) { const f32x4 g4 = *(const f32x4*)(graw + 4 * s4);
                gcv += (4 * s4 + 0 <= r ? g4.x : 0.f) + (4 * s4 + 1 <= r ? g4.y : 0.f) + (4 * s4 + 2 <= r ? g4.z : 0.f) + (4 * s4 + 3 <= r ? g4.w : 0.f); }
            if (lane < 32) GCs[wave * 32 + r] = gcv;
            if (wave == 7 && lane < 32) {
                float gl = 0.f;
#pragma unroll
                for (int s4 = 0; s4 < 8; ++s4) { const f32x4 g4 = *(const f32x4*)(graw + 4 * s4); gl += (g4.x + g4.y) + (g4.z + g4.w); }
                const float be = SC[(par * 8 + 1) * 32 + r];
                SC[(par * 8 + 3) * 32 + r] = fexp(gcv); SC[(par * 8 + 4) * 32 + r] = fexp(gl - gcv); SC[(par * 8 + 5) * 32 + r] = be * fexp(gcv); SC[(par * 8 + 6) * 32 + r] = fexp(gl);
            }
            const int pr = wave >> 2, th = (wave >> 1) & 1, ch = wave & 1, fr = lane & 15, fq = lane >> 4;
            const bf16_t* arow = (pr == 0 ? Ks : Qs + par * 32 * LD128) + (16 * th + fr) * LD128 + 8 * fq; const bf16_t* brow = Ks + (16 * ch + fr) * LD128 + 8 * fq;
            f32x4 cc = {0.f, 0.f, 0.f, 0.f};
#pragma unroll
            for (int ks = 0; ks < 4; ++ks) cc = MFMA16(*(const bf16x8*)(arow + 32 * ks), *(const bf16x8*)(brow + 32 * ks), cc);
            WAVE_SYNC();
            const int jj = 16 * ch + fr; const float gj = GCs[wave * 32 + jj];
#pragma unroll
            for (int j = 0; j < 4; ++j) {
                const int i = 16 * th + 4 * fq + j; const float dec = fexp(GCs[wave * 32 + i] - gj);
                if (pr == 0) Lf[i * 32 + jj] = (jj < i) ? SC[(par * 8 + 1) * 32 + i] * cc[j] * dec : 0.f;
                else QKMs[(par * 32 + i) * LD32 + jj] = f2bf((jj <= i) ? cc[j] * dec : 0.f);
            }
        }
        LDS_BARRIER();
        if (wave == 7 && xn < G_NT) {
            const float* sb1 = SC + (par * 8 + 5) * 32; const float* sb0 = SC + (par * 8 + 1) * 32; bf16_t* Tppw = Tpp + par * 32 * LD32;
            invert32_blocked(Lf, (bf16_t*)(smem + GL_INV), lane, [&](int i, int c, float v) { Tp[i * LD32 + c] = f2bf(v * sb1[c]); Tppw[i * LD32 + c] = f2bf(v * sb0[c]); });
        }
        if (wave < 4 && it >= 0) {
            const int pc = it & 1; int seg = 0, j0 = 0; chunk_pos(it, d, seg, j0);
            const bf16_t* Qc = Qs + pc * 32 * LD128; const bf16_t* KTc = KTs + pc * 128 * LD32; const bf16_t* VTc = VTs + pc * 128 * LD32;
            const bf16_t* QKc = QKMs + pc * 32 * LD32; const bf16_t* Tc = Tpp + pc * 32 * LD32; const float* sc = SC + pc * 8 * 32;
            f32x16 vn = zero16();
#pragma unroll
            for (int s = 0; s < 2; ++s) vn = MFMA32(ld_nat(Tc + r * LD32, s, hh), ld_nat(VTc + (32 * wave + r) * LD32, s, hh), vn);
            f32x16 oacc = zero16();
#define GDN_KSTEP(s) { const bf16x8 sb = pack_acc<(s) & 1>(St[(s) >> 1]); vn = MFMA32(ld_perm(Wn + r * LD128, (s), hh), sb, vn); oacc = MFMA32(ld_perm(Qc + r * LD128, (s), hh), sb, oacc); }
            GDN_KSTEP(0) GDN_KSTEP(1) GDN_KSTEP(2) GDN_KSTEP(3) GDN_KSTEP(4) GDN_KSTEP(5) GDN_KSTEP(6) GDN_KSTEP(7)
#undef GDN_KSTEP
#pragma unroll
            for (int g = 0; g < 16; ++g) oacc[g] *= sc[3 * 32 + crow(g, hh)];
            { const bf16x8 v0 = pack_acc<0>(vn), v1 = pack_acc<1>(vn);
              oacc = MFMA32(ld_perm(QKc + r * LD32, 0, hh), v0, oacc); oacc = MFMA32(ld_perm(QKc + r * LD32, 1, hh), v1, oacc); }
#pragma unroll
            for (int g = 0; g < 16; ++g) vn[g] *= sc[4 * 32 + crow(g, hh)];
            const float ge = sc[6 * 32];
            { const bf16x8 v0 = pack_acc<0>(vn), v1 = pack_acc<1>(vn);
#pragma unroll
              for (int ct = 0; ct < 4; ++ct) {
#pragma unroll
                  for (int g = 0; g < 16; ++g) St[ct][g] *= ge;
                  St[ct] = MFMA32(ld_perm(KTc + (32 * ct + r) * LD32, 0, hh), v0, St[ct]);
                  St[ct] = MFMA32(ld_perm(KTc + (32 * ct + r) * LD32, 1, hh), v1, St[ct]);
              } }
            if (seg) {
#pragma unroll
                for (int g = 0; g < 16; ++g) {
                    const int i = crow(g, hh), j = d ? j0 + GC - 1 - i : j0 + i;
                    ODIR[((size_t)d * T_LAT + (size_t)b * S + j) * 512 + h * 128 + 32 * wave + r] = f2bf(oacc[g]);
                }
            }
        }
        LDS_BARRIER();
        if (xn < G_NT && wave < 4) {
            f32x16 acc = zero16();
#pragma unroll
            for (int s = 0; s < 2; ++s) acc = MFMA32(ld_nat(KTs + (par * 128 + 32 * wave + r) * LD32, s, hh), ld_nat(Tp + r * LD32, s, hh), acc);
#pragma unroll
            for (int q = 0; q < 4; ++q) {
                u32x2 o; o.x = pk2(-acc[4 * q], -acc[4 * q + 1]); o.y = pk2(-acc[4 * q + 2], -acc[4 * q + 3]);
                *(u32x2*)(Wn + r * LD128 + 32 * wave + 8 * q + 4 * hh) = o;
            }
        }
        LDS_BARRIER();
    }
}

constexpr int RL_RX = 0;
constexpr int RL_KX = RL_RX + 32 * 64 * 4;
constexpr int RL_VX = RL_KX + 32 * 64 * 4;
constexpr int RL_KK = RL_VX + 32 * 64 * 4;
constexpr int RL_LW = RL_KK + 32 * 64 * 4;
constexpr int RL_IC = RL_LW + 32 * 64 * 4;
constexpr int RL_PC = RL_IC + 32 * 64 * 4;
constexpr int RL_CST = RL_PC + 2 * 64 * 4;
constexpr int RL_TW = RL_CST + 4 * 64 * 4;
constexpr int RL_AL = RL_TW + 32 * LD64 * 2;
constexpr int RL_LF = RL_TW;
constexpr int RL_LAKT = RL_LF + 32 * 32 * 4;
constexpr int RL_TB = RL_LAKT + 32 * LD32 * 2;
static_assert(RL_TB + 32 * LD32 * 2 <= RL_AL + 32 * LD64 * 2, "overlay");
constexpr int RL_W2T = RL_AL + 32 * LD64 * 2;
constexpr int RL_A2T = RL_W2T + 64 * LD64 * 2;
constexpr int RL_AR = RL_A2T + 64 * LD64 * 2;
constexpr int RL_BR = RL_AR + 32 * LD64 * 2;
constexpr int RL_KR = RL_BR + 32 * LD64 * 2;
constexpr int RL_RR = RL_KR + 32 * LD64 * 2;
constexpr int RL_AT = RL_RR + 2 * 32 * LD64 * 2;
constexpr int RL_BHT = RL_AT + 64 * LD32 * 2;
constexpr int RL_KHT = RL_BHT + 2 * 64 * LD32 * 2;
constexpr int RL_VT = RL_KHT + 2 * 64 * LD32 * 2;
constexpr int RL_MRB = RL_VT + 2 * 64 * LD32 * 2;
constexpr int RL_MRK = RL_MRB + 2 * 32 * LD32 * 2;
constexpr int RL_WM = RL_MRK + 2 * 32 * LD32 * 2;
constexpr int RL_TL = RL_WM + 32 * LD64 * 2;
constexpr int RL_END = RL_TL + 32 * LD32 * 2;
static_assert(RL_END <= LDS_BYTES, "rwkv lds");

DI void rwkv_chain2(const Params& p, char* smem, int item) {
    const int d = item / (NB * H_B), b = (item / H_B) % NB, h = item % H_B;
    const int tid = tid_x(), lane = tid & 63, wave = tid >> 6;
    float* RX = (float*)(smem + RL_RX); float* KX = (float*)(smem + RL_KX); float* VX = (float*)(smem + RL_VX); float* KKs = (float*)(smem + RL_KK);
    float* LW = (float*)(smem + RL_LW); float* IC = (float*)(smem + RL_IC); float* Lf = (float*)(smem + RL_LF); float* PC = (float*)(smem + RL_PC); float* CST = (float*)(smem + RL_CST);
    bf16_t* TW = (bf16_t*)(smem + RL_TW); bf16_t* AL = (bf16_t*)(smem + RL_AL); bf16_t* W2T = (bf16_t*)(smem + RL_W2T); bf16_t* A2T = (bf16_t*)(smem + RL_A2T);
    bf16_t* Ar = (bf16_t*)(smem + RL_AR); bf16_t* Br = (bf16_t*)(smem + RL_BR); bf16_t* Kr = (bf16_t*)(smem + RL_KR); bf16_t* Rr = (bf16_t*)(smem + RL_RR);
    bf16_t* AT = (bf16_t*)(smem + RL_AT); bf16_t* BhT = (bf16_t*)(smem + RL_BHT); bf16_t* KhT = (bf16_t*)(smem + RL_KHT); bf16_t* VT = (bf16_t*)(smem + RL_VT);
    bf16_t* LakT = (bf16_t*)(smem + RL_LAKT); bf16_t* Mrb = (bf16_t*)(smem + RL_MRB); bf16_t* Mrk = (bf16_t*)(smem + RL_MRK); bf16_t* Tb = (bf16_t*)(smem + RL_TB);
    bf16_t* Wm = (bf16_t*)(smem + RL_WM); bf16_t* TLm = (bf16_t*)(smem + RL_TL);
    bf16_t* YDIR = (bf16_t*)(p.aux + AUX_YDIR); float* BON = (float*)(p.ws + WS_BONUS);
    __syncthreads();
    for (int i = tid; i < 64 * 64; i += NTHREADS) {
        const int c = i >> 6, rr = i & 63;
        W2T[c * LD64 + rr] = f2bf(p.in[I_W2][((size_t)d * 64 + rr) * 512 + h * 64 + c]); A2T[c * LD64 + rr] = f2bf(p.in[I_A2][((size_t)d * 64 + rr) * 512 + h * 64 + c]);
    }
    if (tid < 256) { const int w = tid >> 6, c = tid & 63, gc = h * 64 + c;
        CST[tid] = w == 0 ? p.in[I_W0][d * 512 + gc] : (w == 1 ? p.in[I_A0][d * 512 + gc] : (w == 2 ? p.in[I_KA][gc] : p.in[I_RK][gc])); }
    const float kkw = p.in[I_KK][h * 64 + lane];
    f32x16 Xt[2]; Xt[0] = zero16(); Xt[1] = zero16();
    bf16_t rawv[4][5];
    auto prefetch = [&](int x) {
        int seg, j0; chunk_pos(x, d, seg, j0);
        const int ldp = seg ? IN_COLS : CTX_COLS;
        const bf16_t* pb = seg ? (const bf16_t*)(p.ws + WS_PLAT) + (size_t)b * S * IN_COLS : (const bf16_t*)(p.ws + WS_PCTX) + (size_t)b * CTXL * CTX_COLS;
        const int jw = j0 + 4 * wave;
#pragma unroll
        for (int rr = 0; rr < 4; ++rr) {
            const int j = jw + rr; const int row = seg ? (j % ROWS) * GW + j / ROWS : j;
#pragma unroll
            for (int s = 0; s < 5; ++s) {
                const int bcol = (s < 3 ? s * 512 + h * 64 : (s == 3 ? 1536 + d * 64 : 1664 + d * 64)) + lane;
                rawv[rr][s] = pb[(size_t)row * ldp + COL_B0 + bcol];
            }
        }
    };
    prefetch(0);
    const int r0_ = lane & 31, hh0_ = lane >> 5;
    __syncthreads();
    for (int it = -1; it < G_NT; ++it) {
        int r = r0_, hh = hh0_;
#ifndef EMU
        asm volatile("" : "+v"(r), "+v"(hh));
#endif
        const int xn = it + 1, par = xn & 1;
        int segn = 0, j0n = 0; if (xn < G_NT) chunk_pos(xn, d, segn, j0n);
        if (xn < G_NT) {
#pragma unroll
            for (int t = 0; t < 4; ++t) {
                const int i = d ? (GC - 1 - 4 * wave - t) : (4 * wave + t);
                const float xr = bf2f(rawv[t][0]), xk = bf2f(rawv[t][1]), xv = bf2f(rawv[t][2]);
                const float kxk = xk * kkw; const float ss = wave_sum_fast(kxk * kxk);
                RX[i * 64 + lane] = xr; KX[i * 64 + lane] = xk; VX[i * 64 + lane] = xv; KKs[i * 64 + lane] = kxk * frsq(ss + 1e-6f);
                TW[i * LD64 + lane] = rawv[t][3]; AL[i * LD64 + lane] = rawv[t][4];
            }
            if (xn + 1 < G_NT) prefetch(xn + 1);
        }
        LDS_BARRIER();
        if (xn < G_NT) {
            const int which = wave >> 2, cg = wave & 3, fr = lane & 15, fq = lane >> 4;
            const bf16_t* arow0 = (which ? AL : TW) + fr * LD64 + 8 * fq; const bf16_t* brow = (which ? A2T : W2T) + (16 * cg + fr) * LD64 + 8 * fq;
            f32x4 c0 = {0.f, 0.f, 0.f, 0.f}, c1 = {0.f, 0.f, 0.f, 0.f};
#pragma unroll
            for (int ks = 0; ks < 2; ++ks) {
                const bf16x8 bfrag = *(const bf16x8*)(brow + 32 * ks);
                c0 = MFMA16(*(const bf16x8*)(arow0 + 32 * ks), bfrag, c0); c1 = MFMA16(*(const bf16x8*)(arow0 + 16 * LD64 + 32 * ks), bfrag, c1);
            }
            const int c = 16 * cg + fr; const float bias = CST[which * 64 + c];
#pragma unroll
            for (int th = 0; th < 2; ++th)
#pragma unroll
                for (int j = 0; j < 4; ++j) {
                    const int i = 16 * th + 4 * fq + j; const float z = bias + (th ? c1[j] : c0[j]);
                    if (which) IC[i * 64 + c] = fsigmoid(z);
                    else { const float wl = -fsoftplus(-z) - 0.5f; LW[i * 64 + c] = -fexp(wl); }
                }
        }
        LDS_BARRIER();
        if (xn < G_NT) {
            const int c = lane, i0 = 4 * wave;
            const float ka = CST[2 * 64 + c], rk = CST[3 * 64 + c];
            float lpb = 0.f, lpc = 0.f; float lw4[4];
#pragma unroll
            for (int s2 = 0; s2 < 32; ++s2) { const float w = LW[s2 * 64 + c]; lpc += w; if (s2 < i0) lpb += w; }
#pragma unroll
            for (int e = 0; e < 4; ++e) lw4[e] = LW[(i0 + e) * 64 + c];
            bf16_t ta[4], tb[4], tk[4], tv[4]; float bon[4];
            float lprun = lpb;
#pragma unroll
            for (int e = 0; e < 4; ++e) {
                const int i = i0 + e;
                const float lpm = lprun; lprun += lw4[e]; const float lp = lprun;
                const float Pi = fexp(lp), Pm = fexp(lpm), invP = fexp(-lp), PCi = fexp(lpc - lp);
                const float ic = IC[i * 64 + c], kxv = KX[i * 64 + c], kkv = KKs[i * 64 + c], rxv = RX[i * 64 + c], vxv = VX[i * 64 + c];
                const float kd = kxv * (1.f + (ic - 1.f) * ka), bb = kkv * ic, aa = -kkv;
                ta[e] = f2bf(aa * Pm); tb[e] = f2bf(bb * PCi); tk[e] = f2bf(kd * PCi); tv[e] = f2bf(vxv);
                Ar[i * LD64 + c] = ta[e]; Br[i * LD64 + c] = f2bf(bb * invP); Kr[i * LD64 + c] = f2bf(kd * invP); Rr[(par * 32 + i) * LD64 + c] = f2bf(rxv * Pi);
                bon[e] = wave_sum_fast(rxv * kd * rk);
            }
            { u32x2 o; o.x = (unsigned)ta[0] | ((unsigned)ta[1] << 16); o.y = (unsigned)ta[2] | ((unsigned)ta[3] << 16); *(u32x2*)(AT + c * LD32 + i0) = o; }
            { u32x2 o; o.x = (unsigned)tb[0] | ((unsigned)tb[1] << 16); o.y = (unsigned)tb[2] | ((unsigned)tb[3] << 16); *(u32x2*)(BhT + (par * 64 + c) * LD32 + i0) = o; }
            { u32x2 o; o.x = (unsigned)tk[0] | ((unsigned)tk[1] << 16); o.y = (unsigned)tk[2] | ((unsigned)tk[3] << 16); *(u32x2*)(KhT + (par * 64 + c) * LD32 + i0) = o; }
            { u32x2 o; o.x = (unsigned)tv[0] | ((unsigned)tv[1] << 16); o.y = (unsigned)tv[2] | ((unsigned)tv[3] << 16); *(u32x2*)(VT + (par * 64 + c) * LD32 + i0) = o; }
            if (wave == 7) PC[par * 64 + c] = fexp(lpc);
            if (segn && lane < 4) { const int i = i0 + lane, jj = d ? j0n + GC - 1 - i : j0n + i;
                const float bv = lane == 0 ? bon[0] : (lane == 1 ? bon[1] : (lane == 2 ? bon[2] : bon[3]));
                BON[((size_t)d * T_LAT + (size_t)b * S + (jj % ROWS) * GW + jj / ROWS) * 8 + h] = bv; }
        }
        LDS_BARRIER();
        if (xn < G_NT) {
            const int m = wave >> 1, th = wave & 1, fr = lane & 15, fq = lane >> 4;
            const bf16_t* arow = ((m < 2) ? Ar : Rr + par * 32 * LD64) + (16 * th + fr) * LD64 + 8 * fq; const bf16_t* brow = ((m & 1) ? Kr : Br) + fr * LD64 + 8 * fq;
            f32x4 c0 = {0.f, 0.f, 0.f, 0.f}, c1 = {0.f, 0.f, 0.f, 0.f};
#pragma unroll
            for (int ks = 0; ks < 2; ++ks) {
                const bf16x8 afrag = *(const bf16x8*)(arow + 32 * ks);
                c0 = MFMA16(afrag, *(const bf16x8*)(brow + 32 * ks), c0); c1 = MFMA16(afrag, *(const bf16x8*)(brow + 16 * LD64 + 32 * ks), c1);
            }
#pragma unroll
            for (int ch = 0; ch < 2; ++ch) {
                const f32x4 cc = ch ? c1 : c0; const int ic = 16 * ch + fr; const int t0 = 16 * th + 4 * fq;
                if (m == 0) {
#pragma unroll
                    for (int j = 0; j < 4; ++j) Lf[(t0 + j) * 32 + ic] = (ic < t0 + j) ? -cc[j] : 0.f;
                } else if (m == 1) {
                    u32x2 o; o.x = pk2((ic < t0) ? cc[0] : 0.f, (ic < t0 + 1) ? cc[1] : 0.f); o.y = pk2((ic < t0 + 2) ? cc[2] : 0.f, (ic < t0 + 3) ? cc[3] : 0.f);
                    *(u32x2*)(LakT + ic * LD32 + t0) = o;
                } else {
                    bf16_t* M = (m == 2 ? Mrb : Mrk) + par * 32 * LD32;
#pragma unroll
                    for (int j = 0; j < 4; ++j) M[(t0 + j) * LD32 + ic] = f2bf((ic <= t0 + j) ? cc[j] : 0.f);
                }
            }
        }
        LDS_BARRIER();
        if (wave == 7 && xn < G_NT) {
            invert32_blocked(Lf, (bf16_t*)(smem + RL_RX), lane, [&](int i, int c, float v) { Tb[i * LD32 + c] = f2bf(v); });
        }
        if (wave < 2 && it >= 0) {
            const int pc = it & 1; int seg = 0, j0 = 0; chunk_pos(it, d, seg, j0);
            const bf16_t* Rc = Rr + pc * 32 * LD64; const bf16_t* BhTc = BhT + pc * 64 * LD32; const bf16_t* KhTc = KhT + pc * 64 * LD32; const bf16_t* VTc = VT + (pc * 64 + 32 * wave + r) * LD32;
            const bf16_t* Mrbc = Mrb + pc * 32 * LD32; const bf16_t* Mrkc = Mrk + pc * 32 * LD32; const float* PCc = PC + pc * 64;
            const bf16x8 vf0 = ld_nat(VTc, 0, hh), vf1 = ld_nat(VTc, 1, hh);
            f32x16 u = zero16(), y = zero16();
            u = MFMA32(ld_nat(TLm + r * LD32, 0, hh), vf0, u); u = MFMA32(ld_nat(TLm + r * LD32, 1, hh), vf1, u);
            y = MFMA32(ld_nat(Mrkc + r * LD32, 0, hh), vf0, y); y = MFMA32(ld_nat(Mrkc + r * LD32, 1, hh), vf1, y);
#define RW_KSTEP(s) { const bf16x8 xb = pack_acc<(s) & 1>(Xt[(s) >> 1]); u = MFMA32(ld_perm(Wm + r * LD64, (s), hh), xb, u); y = MFMA32(ld_perm(Rc + r * LD64, (s), hh), xb, y); }
            RW_KSTEP(0) RW_KSTEP(1) RW_KSTEP(2) RW_KSTEP(3)
#undef RW_KSTEP
            const bf16x8 ub0 = pack_acc<0>(u), ub1 = pack_acc<1>(u);
            y = MFMA32(ld_perm(Mrbc + r * LD32, 0, hh), ub0, y); y = MFMA32(ld_perm(Mrbc + r * LD32, 1, hh), ub1, y);
#pragma unroll
            for (int kt = 0; kt < 2; ++kt) {
#pragma unroll
                for (int g = 0; g < 16; ++g) Xt[kt][g] *= PCc[32 * kt + crow(g, hh)];
                Xt[kt] = MFMA32(ld_perm(BhTc + (32 * kt + r) * LD32, 0, hh), ub0, Xt[kt]); Xt[kt] = MFMA32(ld_perm(BhTc + (32 * kt + r) * LD32, 1, hh), ub1, Xt[kt]);
                Xt[kt] = MFMA32(ld_nat(KhTc + (32 * kt + r) * LD32, 0, hh), vf0, Xt[kt]); Xt[kt] = MFMA32(ld_nat(KhTc + (32 * kt + r) * LD32, 1, hh), vf1, Xt[kt]);
            }
            if (seg) {
#pragma unroll
                for (int g = 0; g < 16; ++g) {
                    const int i = crow(g, hh), jj = d ? j0 + GC - 1 - i : j0 + i;
                    YDIR[((size_t)d * T_LAT + (size_t)b * S + (jj % ROWS) * GW + jj / ROWS) * 512 + h * 64 + 32 * wave + r] = f2bf(y[g]);
                }
            }
        }
        LDS_BARRIER();
        if (xn < G_NT && wave < 3) {
            const bf16_t* arow = (wave < 2) ? AT + (32 * wave + r) * LD32 : LakT + r * LD32;
            f32x16 acc = zero16();
#pragma unroll
            for (int s = 0; s < 2; ++s) acc = MFMA32(ld_nat(arow, s, hh), ld_nat(Tb + r * LD32, s, hh), acc);
#pragma unroll
            for (int q = 0; q < 4; ++q) {
                u32x2 o; o.x = pk2(acc[4 * q], acc[4 * q + 1]); o.y = pk2(acc[4 * q + 2], acc[4 * q + 3]);
                if (wave < 2) *(u32x2*)(Wm + r * LD64 + 32 * wave + 8 * q + 4 * hh) = o; else *(u32x2*)(TLm + r * LD32 + 8 * q + 4 * hh) = o;
            }
        }
        LDS_BARRIER();
    }
}

DI void phase3(const Params& p, char* smem) {
    constexpr int NG = 2 * NB * H_A, NR = 2 * NB * H_B;
    for (int it = blockIdx.x; it < NG; it += gridDim.x) gdn_chain2(p, smem, it);
    for (int it = blockIdx.x; it < NG + NR; it += gridDim.x) if (it >= NG) rwkv_chain2(p, smem, it - NG);
    const int nchain = NG + NR, G = (int)gridDim.x;
    const int tb = G > nchain ? (int)blockIdx.x - nchain : (int)blockIdx.x, ntb = G > nchain ? G - nchain : G;
    if (tb >= 0) {
        __syncthreads();
        const int tid3 = tid_x(), lane = tid3 & 63, wave = tid3 >> 6;
        float* scr = (float*)smem + wave * (64 * 33);
        bf16_t* GUT = (bf16_t*)(p.aux + AUX_GUT);
        constexpr int nkb = D / 64, nnb = DE / 32, per = nkb * nnb;
        for (int it = tb * 8 + wave; it < NEXP * 2 * per; it += ntb * 8) {
            const int e = it / (2 * per), r = it % (2 * per), up = r / per, r2 = r % per, kb = r2 / nnb, nb = r2 % nnb;
            transpose_item((up ? p.in[I_MU_UP] : p.in[I_MG]) + (size_t)e * D * DE, DE, DE, kb * 64, nb * 32, GUT + (size_t)e * 512 * D, D, up ? 2 : 1, scr, lane);
        }
        constexpr int nkb2 = DE / 64, nnb2 = D / 32, per2 = nkb2 * nnb2;
        for (int it = tb * 8 + wave; it < NE_EARLY * per2; it += ntb * 8) {
            const int e = it / per2, r2 = it % per2, kb = r2 / nnb2, nb = r2 % nnb2;
            transpose_item(p.in[I_MD] + (size_t)e * DE * D, D, D, kb * 64, nb * 32, DNT_PTR(p.ws, e), DE, 0, scr, lane);
        }
    }
}

constexpr int P4_SG = 0;
constexpr int P4_XV = P4_SG + 32 * LD128 * 2;
constexpr int P4_YF = P4_XV + 32 * 520 * 2;
static_assert(P4_YF + 32 * 516 * 4 <= LDS_BYTES, "phase4 lds");
DI float half_sum(float v, int hh) {
#ifdef EMU
    v += __shfl_xor(v, 1); v += __shfl_xor(v, 2); v += __shfl_xor(v, 4); v += __shfl_xor(v, 8); v += __shfl_xor(v, 16); return v;
#else
    v = DPP_ADD(v, 0xB1); v = DPP_ADD(v, 0x4E); v = DPP_ADD(v, 0x141); v = DPP_ADD(v, 0x140);
    const int iv = __builtin_bit_cast(int, v);
    const float s0 = __builtin_bit_cast(float, __builtin_amdgcn_readlane(iv, 0)) + __builtin_bit_cast(float, __builtin_amdgcn_readlane(iv, 16));
    const float s1 = __builtin_bit_cast(float, __builtin_amdgcn_readlane(iv, 32)) + __builtin_bit_cast(float, __builtin_amdgcn_readlane(iv, 48));
    return hh ? s1 : s0;
#endif
}
DI void phase4(const Params& p, char* smem) {
    const int tid = tid_x(), lane = tid & 63, wave = tid >> 6, r = lane & 31, hh = lane >> 5;
    const bf16_t* PL = (const bf16_t*)(p.ws + WS_PLAT);
    const bf16_t* ODIR = (const bf16_t*)(p.ws + WS_OA); const bf16_t* YDIR = (const bf16_t*)(p.aux + AUX_YDIR);
    const float* BON = (const float*)(p.ws + WS_BONUS); const float* mu = p.in[I_MU]; const bf16_t* G2T = (const bf16_t*)(p.ws + WS_G2T);
    bf16_t* OA = (bf16_t*)(p.ws + WS_OA); bf16_t* OB = (bf16_t*)(p.ws + WS_OB);
    bf16_t* SG = (bf16_t*)(smem + P4_SG); bf16_t* XV = (bf16_t*)(smem + P4_XV); float* YF = (float*)(smem + P4_YF);
    for (int it = blockIdx.x; it < T_LAT / 32; it += gridDim.x) {
        const int tok0 = it * 32, b = tok0 / S, l0 = tok0 % S;
        __syncthreads();
        for (int q = tid; q < 32 * 80; q += NTHREADS) {
            const int t = q / 80, c8 = q % 80;
            const int l = l0 + t;
            const int bcol = c8 < 16 ? 1792 + c8 * 8 : 1024 + (c8 - 16) * 8;
            float cu[8], o[8];
            unpack8(*(const u32x4*)(PL + (size_t)(b * S + l) * IN_COLS + COL_B0 + bcol), cu);
#pragma unroll
            for (int e = 0; e < 8; ++e) o[e] = c8 < 16 ? fsigmoid(cu[e]) : cu[e];
            u32x4 w; w.x = pk2(o[0], o[1]); w.y = pk2(o[2], o[3]); w.z = pk2(o[4], o[5]); w.w = pk2(o[6], o[7]);
            if (c8 < 16) *(u32x4*)(SG + t * LD128 + c8 * 8) = w; else *(u32x4*)(XV + t * 520 + (c8 - 16) * 8) = w;
        }
        for (int q = tid; q < 32 * 64; q += NTHREADS) {
            const int t = q >> 6, c8 = q & 63, tok = tok0 + t;
            float a0[8], a1[8];
            unpack8(*(const u32x4*)(YDIR + (size_t)tok * 512 + c8 * 8), a0); unpack8(*(const u32x4*)(YDIR + ((size_t)T_LAT + tok) * 512 + c8 * 8), a1);
            f32x4 s0 = {a0[0] + a1[0], a0[1] + a1[1], a0[2] + a1[2], a0[3] + a1[3]}, s1 = {a0[4] + a1[4], a0[5] + a1[5], a0[6] + a1[6], a0[7] + a1[7]};
            *(f32x4*)(YF + t * 516 + c8 * 8) = s0; *(f32x4*)(YF + t * 516 + c8 * 8 + 4) = s1;
        }
        __syncthreads();
        {
            unsigned q0[16], q1[16], zq[16];
#pragma unroll
            for (int k = 0; k < 16; ++k) {
                const int pi = wave * 16 + k, t = pi >> 2, h = pi & 3, tok = tok0 + t;
                const size_t o0 = (size_t)tok * 512 + h * 128 + 2 * lane;
                q0[k] = *(const unsigned*)(ODIR + o0); q1[k] = *(const unsigned*)(ODIR + (size_t)T_LAT * 512 + o0); zq[k] = *(const unsigned*)(PL + (size_t)tok * IN_COLS + 1536 + h * 128 + 2 * lane);
            }
            const float on0 = p.in[I_ONORM][2 * lane], on1 = p.in[I_ONORM][2 * lane + 1];
#pragma unroll
            for (int k = 0; k < 16; ++k) {
                const int pi = wave * 16 + k, t = pi >> 2, h = pi & 3, tok = tok0 + t;
                const size_t o0 = (size_t)tok * 512 + h * 128 + 2 * lane;
                const float a0 = bf2f((bf16_t)(q0[k] & 0xffffu)) + bf2f((bf16_t)(q1[k] & 0xffffu)), a1 = bf2f((bf16_t)(q0[k] >> 16)) + bf2f((bf16_t)(q1[k] >> 16));
                const float ss = wave_sum_fast(a0 * a0 + a1 * a1);
                const float rstd = frsq(ss * (1.f / 128.f) + 1e-6f);
                const float z0 = bf2f((bf16_t)(zq[k] & 0xffffu)), z1 = bf2f((bf16_t)(zq[k] >> 16));
                *(unsigned*)(OA + o0) = pk2(a0 * rstd * on0 * fsilu(z0), a1 * rstd * on1 * fsilu(z1));
            }
        }
        __syncthreads();
        {
            const int h = wave;
            f32x16 acc0 = zero16(), acc1 = zero16();
#pragma unroll
            for (int s2 = 0; s2 < 8; ++s2) {
                const bf16x8 a = ld_nat(SG + r * LD128, s2, hh);
                const bf16x8 b0 = *(const bf16x8*)(G2T + (size_t)(64 * h + r) * 128 + 16 * s2 + 8 * hh), b1 = *(const bf16x8*)(G2T + (size_t)(64 * h + 32 + r) * 128 + 16 * s2 + 8 * hh);
                acc0 = MFMA32(a, b0, acc0); acc1 = MFMA32(a, b1, acc1);
            }
            const int c0 = 64 * h + r, c1 = c0 + 32;
            const float lg0 = p.in[I_LNG][c0], lb0 = p.in[I_LNB][c0], lg1 = p.in[I_LNG][c1], lb1 = p.in[I_LNB][c1];
            float bonv[16];
#pragma unroll
            for (int g = 0; g < 16; ++g) { const int tok = tok0 + crow(g, hh); bonv[g] = BON[(size_t)tok * 8 + h] + BON[((size_t)T_LAT + tok) * 8 + h]; }
#pragma unroll
            for (int g = 0; g < 16; ++g) {
                const int i = crow(g, hh), tok = tok0 + i;
                const float y0 = YF[i * 516 + c0], y1 = YF[i * 516 + c1];
                const float mean = half_sum(y0 + y1, hh) * (1.f / 64.f); const float d0 = y0 - mean, d1 = y1 - mean;
                const float var = half_sum(d0 * d0 + d1 * d1, hh) * (1.f / 64.f); const float rs = frsq(var + 64e-5f);
                const float bon = bonv[g];
                const float o0 = (d0 * rs * lg0 + lb0 + bon * bf2f(XV[i * 520 + c0])) * acc0[g], o1 = (d1 * rs * lg1 + lb1 + bon * bf2f(XV[i * 520 + c1])) * acc1[g];
                OB[(size_t)tok * 512 + c0] = f2bf(o0); OB[(size_t)tok * 512 + c1] = f2bf(o1);
            }
        }
    }
}

DI void phase5(const Params& p, char* smem) {
    const bf16_t* OA = (const bf16_t*)(p.ws + WS_OA); const bf16_t* OB = (const bf16_t*)(p.ws + WS_OB);
    const bf16_t* WA = (const bf16_t*)(p.ws + WS_WOA); const bf16_t* WB = (const bf16_t*)(p.ws + WS_WOB);
    const bf16_t* PL = (const bf16_t*)(p.ws + WS_PLAT); bf16_t* Y = (bf16_t*)(p.aux + AUX_Y);
    if (USE_G8) {
        constexpr int NT8 = D / 256, MT8 = T_LAT / 256;
        constexpr int GLD = 264;
        static_assert(256 * GLD * 2 <= LDS_BYTES, "gate tile lds");
        bf16_t* GT = (bf16_t*)smem;
        auto stage_gates = [&](int brow, int gcol0) {
            const int tid = tid_x();
            u32x4 gv[16];
#pragma unroll
            for (int i = 0; i < 16; ++i) { const int ch = tid + i * NTHREADS, row = ch >> 5, c16 = ch & 31; gv[i] = *(const u32x4*)(PL + (size_t)(brow + row) * IN_COLS + gcol0 + c16 * 8); }
#pragma unroll
            for (int i = 0; i < 16; ++i) { const int ch = tid + i * NTHREADS, row = ch >> 5, c16 = ch & 31; *(u32x4*)(GT + row * GLD + c16 * 8) = gv[i]; }
            __syncthreads();
        };
        for (int t = blockIdx.x; t < MT8 * NT8; t += gridDim.x) {
            int mt, nt; if (!g8::tile_order(t, MT8, NT8, mt, nt)) break;
            const int brow = mt * 256, bcol = nt * 256;
            g8::Acc acc; g8::acc_zero(acc);
            g8::kloop(acc, smem, OA, 512, WA, 512, 512, brow, bcol);
            stage_gates(brow, COL_G0 + bcol);
            g8::for_each_quad(acc, brow, bcol, [&](int row, int col, const f32x4& v) {
                const u32x2 gq = *(const u32x2*)(GT + (row - brow) * GLD + (col - bcol));
                const float g0 = bf2f((bf16_t)(gq.x & 0xffffu)), g1 = bf2f((bf16_t)(gq.x >> 16)), g2 = bf2f((bf16_t)(gq.y & 0xffffu)), g3 = bf2f((bf16_t)(gq.y >> 16));
                u32x2 o; o.x = pk2(fsigmoid(g0) * v.x, fsigmoid(g1) * v.y); o.y = pk2(fsigmoid(g2) * v.z, fsigmoid(g3) * v.w);
                *(u32x2*)(Y + (size_t)row * D + col) = o;
            });
            __syncthreads();
            g8::acc_zero(acc);
            g8::kloop(acc, smem, OB, 512, WB, 512, 512, brow, bcol);
            stage_gates(brow, COL_G0 + D + bcol);
            g8::for_each_quad(acc, brow, bcol, [&](int row, int col, const f32x4& v) {
                const u32x2 gq = *(const u32x2*)(GT + (row - brow) * GLD + (col - bcol));
                const float g0 = bf2f((bf16_t)(gq.x & 0xffffu)), g1 = bf2f((bf16_t)(gq.x >> 16)), g2 = bf2f((bf16_t)(gq.y & 0xffffu)), g3 = bf2f((bf16_t)(gq.y >> 16));
#ifdef EMU
                const unsigned long long tq = *(const unsigned long long*)(Y + (size_t)row * D + col);
#else
                const unsigned long long tq = __hip_atomic_load((const unsigned long long*)(Y + (size_t)row * D + col), __ATOMIC_RELAXED, __HIP_MEMORY_SCOPE_AGENT);
#endif
                const unsigned tlo = (unsigned)tq, thi = (unsigned)(tq >> 32);
                const float t0 = bf2f((bf16_t)(tlo & 0xffffu)), t1 = bf2f((bf16_t)(tlo >> 16)), t2 = bf2f((bf16_t)(thi & 0xffffu)), t3 = bf2f((bf16_t)(thi >> 16));
                u32x2 o; o.x = pk2(t0 + fsigmoid(g0) * v.x, t1 + fsigmoid(g1) * v.y); o.y = pk2(t2 + fsigmoid(g2) * v.z, t3 + fsigmoid(g3) * v.w);
                *(u32x2*)(Y + (size_t)row * D + col) = o;
            });
            __syncthreads();
        }
        return;
    }
    constexpr int MR5 = 2, BM5 = 64 * MR5; constexpr int NT = D / 128, MT = T_LAT / BM5;
    for (int t = blockIdx.x; t < MT * NT; t += gridDim.x) {
        const int mt = t / NT, nt = t % NT, row0 = mt * BM5;
        f32x4 acca[MR5][4], accb[MR5][4]; acc_zero(acca); acc_zero(accb);
        gemm_kloop(acca, smem, [&](int i) { return OA + (size_t)(row0 + i) * 512; }, WA + (size_t)nt * 128 * 512, 512, 512);
        gemm_kloop(accb, smem, [&](int i) { return OB + (size_t)(row0 + i) * 512; }, WB + (size_t)nt * 128 * 512, 512, 512);
        const int t2 = tid_x(), l2 = t2 & 63, w2 = t2 >> 6; const int wr = w2 >> 1, wc = w2 & 1, fr = l2 & 15, fq = l2 >> 4;
#pragma unroll
        for (int m = 0; m < MR5; ++m)
#pragma unroll
            for (int n = 0; n < 4; ++n)
#pragma unroll
                for (int j = 0; j < 4; ++j) {
                    const int row = row0 + wr * 16 * MR5 + m * 16 + fq * 4 + j, col = nt * 128 + wc * 64 + n * 16 + fr;
                    const float ga = bf2f(PL[(size_t)row * IN_COLS + COL_G0 + col]), gb = bf2f(PL[(size_t)row * IN_COLS + COL_G0 + D + col]);
                    Y[(size_t)row * D + col] = f2bf(sigmoidf_(ga) * acca[m][n][j] + sigmoidf_(gb) * accb[m][n][j]);
                }
    }
}

DI void phase6(const Params& p, char* smem) {
    const bf16_t* Y = (const bf16_t*)(p.aux + AUX_Y); const bf16_t* WO = (const bf16_t*)(p.ws + WS_WOUT);
    const float* mod = (const float*)(p.ws + WS_MOD); float* Hh = (float*)(p.ws + WS_H);
    if (USE_G8) {
        constexpr int NT = D / 256, MT = T_LAT / 256;
        const float* X = p.in[I_X];
        for (int t = blockIdx.x; t < MT * NT; t += gridDim.x) {
            int mt, nt; if (!g8::tile_order(t, MT, NT, mt, nt)) break;
            const int brow = mt * 256, bcol = nt * 256;
            g8::Acc acc; g8::acc_zero(acc);
            g8::kloop(acc, smem, Y, D, WO, D, D, brow, bcol);
            g8::for_each_quad(acc, brow, bcol, [&](int row, int col, const f32x4& v) {
                const int b = row / S; const f32x4 xv = *(const f32x4*)(X + (size_t)row * D + col), gv = *(const f32x4*)(mod + (size_t)b * 6 * D + 2 * D + col);
                f32x4 o; o.x = xv.x + gv.x * v.x; o.y = xv.y + gv.y * v.y; o.z = xv.z + gv.z * v.z; o.w = xv.w + gv.w * v.w;
                *(f32x4*)(Hh + (size_t)row * D + col) = o;
            });
        }
    } else {
        const int tid = tid_x(), lane = tid & 63, wave = tid >> 6, wr = wave >> 1, wc = wave & 1, fr = lane & 15, fq = lane >> 4;
        constexpr int NT = D / 128, MT = T_LAT / BM;
        for (int t = blockIdx.x; t < MT * NT; t += gridDim.x) {
            const int mt = t / NT, nt = t % NT, row0 = mt * BM;
            f32x4 acc[MREP][4]; acc_zero(acc);
            gemm_kloop(acc, smem, [&](int i) { return Y + (size_t)(row0 + i) * D; }, WO + (size_t)nt * 128 * D, D, D);
#pragma unroll
            for (int m = 0; m < MREP; ++m)
#pragma unroll
                for (int n = 0; n < 4; ++n)
#pragma unroll
                    for (int j = 0; j < 4; ++j) {
                        const int row = row0 + wr * 16 * MREP + m * 16 + fq * 4 + j, col = nt * 128 + wc * 64 + n * 16 + fr, b = row / S;
                        Hh[(size_t)row * D + col] = p.in[I_X][(size_t)row * D + col] + mod[(size_t)b * 6 * D + 2 * D + col] * acc[m][n][j];
                    }
        }
    }
    __syncthreads();
    const int tid6 = tid_x(), lane = tid6 & 63, wave = tid6 >> 6;
    const int gw = blockIdx.x * 8 + wave, ngw = gridDim.x * 8;
    float* scr = (float*)smem + wave * (64 * 33);
    {
        constexpr int nkb = DE / 64, nnb = D / 32, per = nkb * nnb;
        for (int it = gw; it < (NEXP - NE_EARLY) * per; it += ngw) {
            const int e = NE_EARLY + it / per, r2 = it % per, kb = r2 / nnb, nb = r2 % nnb;
            transpose_item(p.in[I_MD] + (size_t)e * DE * D, D, D, kb * 64, nb * 32, DNT_PTR(p.ws, e), DE, 0, scr, lane);
        }
    }
}

#ifdef EMU
#define MFMA32F(a, b, c) emu_mfma32_f32((a), (b), (c))
#else
#define MFMA32F(a, b, c) __builtin_amdgcn_mfma_f32_32x32x2f32((a), (b), (c), 0, 0, 0)
#endif
constexpr int TB_LD = D + 4;
static_assert(32 * TB_LD * 4 <= LDS_BYTES && 8 * 32 * 64 * 4 <= LDS_BYTES, "phase7 lds");
DI void phase7(const Params& p, char* smem) {
    const int tid = tid_x(), lane = tid & 63, wave = tid >> 6, r = lane & 31, hh = lane >> 5;
    const float* Hh = (const float*)(p.ws + WS_H); const float* mod = (const float*)(p.ws + WS_MOD); const float* WRT = (const float*)(p.ws + WS_WRT);
    bf16_t* Tt = (bf16_t*)(p.ws + WS_T); int* cnt = (int*)(p.ws + WS_CNT); int* rowlist = (int*)(p.ws + WS_ROWLIST); float* pairw = (float*)(p.ws + WS_PAIRW);
    float* tb = (float*)smem;
    float* bias = (float*)(smem + LDS_BYTES - 1024);
    int* lcnt = (int*)(smem + LDS_BYTES - 768);
    int* lbase = lcnt + 32;
    if (tid < 36) bias[tid] = tid < 4 ? p.in[I_RGB][tid] : p.in[I_REB][tid - 4];
    f32x4 x[4][D / 256];
    int itn = blockIdx.x;
    if (itn < T_LAT / 32) {
#pragma unroll
        for (int tt = 0; tt < 4; ++tt)
#pragma unroll
            for (int j = 0; j < D / 256; ++j) x[tt][j] = *(const f32x4*)(Hh + (size_t)(itn * 32 + wave * 4 + tt) * D + j * 256 + lane * 4);
    }
    for (int it = blockIdx.x; it < T_LAT / 32; it += gridDim.x) {
        const int tok0 = it * 32;
        __syncthreads();
        if (tid < 32) lcnt[tid] = 0;
#pragma unroll
        for (int tt = 0; tt < 4; ++tt) {
            const int ti = wave * 4 + tt, tok = tok0 + ti, b = tok / S;
            float ss = 0.f;
#pragma unroll
            for (int j = 0; j < D / 256; ++j) ss += x[tt][j].x * x[tt][j].x + x[tt][j].y * x[tt][j].y + x[tt][j].z * x[tt][j].z + x[tt][j].w * x[tt][j].w;
            ss = wave_sum_fast(ss);
            const float rstd = frsq(ss * (1.0f / D) + 1e-6f);
#pragma unroll
            for (int j = 0; j < D / 256; ++j) {
                const int k = j * 256 + lane * 4;
                const f32x4 g = *(const f32x4*)(p.in[I_NFFN] + k), sh = *(const f32x4*)(mod + (size_t)b * 6 * D + 3 * D + k), sc = *(const f32x4*)(mod + (size_t)b * 6 * D + 4 * D + k);
                f32x4 o; o.x = x[tt][j].x * rstd * g.x * (1.f + sc.x) + sh.x; o.y = x[tt][j].y * rstd * g.y * (1.f + sc.y) + sh.y;
                o.z = x[tt][j].z * rstd * g.z * (1.f + sc.z) + sh.z; o.w = x[tt][j].w * rstd * g.w * (1.f + sc.w) + sh.w;
                *(f32x4*)(tb + ti * TB_LD + k) = o;
                u32x2 ob; ob.x = pk2(o.x, o.y); ob.y = pk2(o.z, o.w);
                *(u32x2*)(Tt + (size_t)tok * D + k) = ob;
            }
        }
        itn = it + gridDim.x;
        if (itn < T_LAT / 32) {
#pragma unroll
            for (int tt = 0; tt < 4; ++tt)
#pragma unroll
                for (int j = 0; j < D / 256; ++j) x[tt][j] = *(const f32x4*)(Hh + (size_t)(itn * 32 + wave * 4 + tt) * D + j * 256 + lane * 4);
        }
        LDS_BARRIER();
        f32x16 a0 = zero16(), a1 = zero16();
        {
            const int kbeg = wave * (D / 8);
            const float* arow = tb + r * TB_LD + kbeg + 4 * hh;
            const float* b0row = WRT + (size_t)(4 + r) * D + kbeg + 4 * hh;
            const float* b1row = WRT + (size_t)(r < 4 ? r : 0) * D + kbeg + 4 * hh;
            const float m1 = r < 4 ? 1.f : 0.f;
#pragma unroll 4
            for (int g = 0; g < D / 64; ++g) {
                const f32x4 av = *(const f32x4*)(arow + 8 * g), b0 = *(const f32x4*)(b0row + 8 * g); const f32x4 b1 = *(const f32x4*)(b1row + 8 * g) * m1;
                a0 = MFMA32F(av.x, b0.x, a0); a1 = MFMA32F(av.x, b1.x, a1); a0 = MFMA32F(av.y, b0.y, a0); a1 = MFMA32F(av.y, b1.y, a1);
                a0 = MFMA32F(av.z, b0.z, a0); a1 = MFMA32F(av.z, b1.z, a1); a0 = MFMA32F(av.w, b0.w, a0); a1 = MFMA32F(av.w, b1.w, a1);
            }
        }
        LDS_BARRIER();
        {
            float* part = tb + wave * (32 * 64);
#pragma unroll
            for (int g = 0; g < 16; ++g) { const int i = crow(g, hh); part[i * 64 + r] = a0[g]; part[i * 64 + 32 + r] = a1[g]; }
        }
        LDS_BARRIER();
        float lsum[4];
        {
            const int i = tid >> 4, c4 = (tid & 15) * 4;
#pragma unroll
            for (int e = 0; e < 4; ++e) { float sacc = 0.f;
#pragma unroll
                for (int w = 0; w < 8; ++w) sacc += tb[w * (32 * 64) + i * 64 + c4 + e];
                lsum[e] = sacc; }
        }
        LDS_BARRIER();
        { const int i = tid >> 4, c4 = (tid & 15) * 4;
#pragma unroll
          for (int e = 0; e < 4; ++e) tb[i * 64 + c4 + e] = lsum[e]; }
        LDS_BARRIER();
        int ex1 = 0, ex2 = 0, rk1 = 0, rk2 = 0; float w1 = 0.f, w2 = 0.f;
        if (tid < 32) {
            const float* L = tb + tid * 64;
            float gl[4];
#pragma unroll
            for (int i = 0; i < 4; ++i) gl[i] = L[32 + i] + bias[i];
            int g = 0; float mx = gl[0];
#pragma unroll
            for (int i = 1; i < 4; ++i) if (gl[i] > mx) { mx = gl[i]; g = i; }
            float se = 0.f;
#pragma unroll
            for (int i = 0; i < 4; ++i) se += fexp(gl[i] - mx);
            const float pg = 1.0f / se;
            int i1 = 0; float l1 = L[g * 8] + bias[4 + g * 8];
            for (int i = 1; i < 8; ++i) { const float v = L[g * 8 + i] + bias[4 + g * 8 + i]; if (v > l1) { l1 = v; i1 = i; } }
            int i2 = -1; float l2 = -3.0e38f;
            for (int i = 0; i < 8; ++i) { const float v = L[g * 8 + i] + bias[4 + g * 8 + i]; if (i != i1 && v > l2) { l2 = v; i2 = i; } }
            const float e2 = fexp(l2 - l1); w1 = pg / (1.f + e2); w2 = pg * e2 / (1.f + e2);
            ex1 = g * 8 + i1; ex2 = g * 8 + i2;
            rk1 = atomicAdd(&lcnt[ex1], 1); rk2 = atomicAdd(&lcnt[ex2], 1);
        }
        LDS_BARRIER();
        if (tid < 32) { const int c = lcnt[tid]; lbase[tid] = c ? atomicAdd(&cnt[tid * CNT_STRIDE], c) : 0; }
        __syncthreads();
        if (tid < 32) {
            const int tok = tok0 + tid;
            rowlist[(size_t)ex1 * CAP + lbase[ex1] + rk1] = tok * 2; pairw[tok * 2] = w1;
            rowlist[(size_t)ex2 * CAP + lbase[ex2] + rk2] = tok * 2 + 1; pairw[tok * 2 + 1] = w2;
        }
    }
}

constexpr int MOE_TM = USE_G8 ? 256 : BM;
DI void moe_tiles(const Params& p, char* smem, int* pre) {
    const int* cnt = (const int*)(p.ws + WS_CNT);
    __syncthreads();
    if (tid_x() == 0) { int s = 0; for (int e = 0; e < NEXP; ++e) { pre[e] = s; s += (cnt[e * CNT_STRIDE] + MOE_TM - 1) / MOE_TM; } pre[NEXP] = s; }
    __syncthreads();
}
DI void moe_up_tile(const Params& p, char* smem, const int* pre, int t) {
    const int* cnt = (const int*)(p.ws + WS_CNT); const int* rowlist = (const int*)(p.ws + WS_ROWLIST);
    const bf16_t* Tt = (const bf16_t*)(p.ws + WS_T); const bf16_t* GUT = (const bf16_t*)(p.aux + AUX_GUT); bf16_t* HID = (bf16_t*)(p.ws + WS_HID);
    const int mg = t >> 1, nt = t & 1; int e = 0;
    while (pre[e + 1] <= mg) ++e;
    const int mt = mg - pre[e], ce = cnt[e * CNT_STRIDE]; const int* rl = rowlist + (size_t)e * CAP;
    g8::Acc acc; g8::acc_zero(acc);
    g8::kloop_g(acc, smem, Tt, [&](int r) { int idx = mt * 256 + r; idx = idx < ce ? idx : ce - 1; return (rl[idx] >> 1) * D; }, GUT + ((size_t)e * 512 + nt * 256) * D, D, D, 0);
    const int t2 = tid_x(), wid = t2 >> 6, l2 = t2 & 63, wr2 = wid >> 2, wc2 = wid & 3, fr2 = l2 & 15, fq2 = l2 >> 4;
    int prs[2][4];
#pragma unroll
    for (int ai = 0; ai < 2; ++ai)
#pragma unroll
        for (int m = 0; m < 4; ++m) { const int idx = mt * 256 + ai * 128 + wr2 * 64 + m * 16 + fr2; prs[ai][m] = idx < ce ? rl[idx] : -1; }
#pragma unroll
    for (int ai = 0; ai < 2; ++ai)
#pragma unroll
        for (int m = 0; m < 4; ++m) {
            if (prs[ai][m] >= 0) {
                const int pair = prs[ai][m];
#pragma unroll
                for (int bj = 0; bj < 2; ++bj) {
                    const f32x4 g = acc[ai][bj][m][0], u = acc[ai][bj][m][1];
                    u32x2 o; o.x = pk2(fsilu(g.x) * u.x, fsilu(g.y) * u.y); o.y = pk2(fsilu(g.z) * u.z, fsilu(g.w) * u.w);
                    *(u32x2*)(HID + (size_t)pair * DE + nt * 128 + bj * 64 + wc2 * 16 + fq2 * 4) = o;
                }
            }
        }
}
DI void moe_down_tile(const Params& p, char* smem, const int* pre, int t) {
    constexpr int NT8 = D / 256;
    const int* cnt = (const int*)(p.ws + WS_CNT); const int* rowlist = (const int*)(p.ws + WS_ROWLIST); const float* pairw = (const float*)(p.ws + WS_PAIRW);
    const bf16_t* HID = (const bf16_t*)(p.ws + WS_HID); bf16_t* OP = (bf16_t*)(p.ws + WS_OPAIR);
    const int mg = t / NT8, nt = t % NT8; int e = 0;
    while (pre[e + 1] <= mg) ++e;
    const int mt = mg - pre[e], ce = cnt[e * CNT_STRIDE]; const int* rl = rowlist + (size_t)e * CAP;
    g8::Acc acc; g8::acc_zero(acc);
    g8::kloop_g(acc, smem, HID, [&](int r) { int idx = mt * 256 + r; idx = idx < ce ? idx : ce - 1; return rl[idx] * DE; }, DNT_PTR(p.ws, e) + (size_t)nt * 256 * DE, DE, DE, 0);
    {
        const int t2 = tid_x(), wid = t2 >> 6, l2 = t2 & 63, wr2 = wid >> 2, wc2 = wid & 3, fr2 = l2 & 15, fq2 = l2 >> 4;
        int prs[2][4]; float pws[2][4];
#pragma unroll
        for (int ai = 0; ai < 2; ++ai)
#pragma unroll
            for (int m = 0; m < 4; ++m) { const int idx = mt * 256 + ai * 128 + wr2 * 64 + m * 16 + fr2; prs[ai][m] = idx < ce ? rl[idx] : -1; }
#pragma unroll
        for (int ai = 0; ai < 2; ++ai)
#pragma unroll
            for (int m = 0; m < 4; ++m) pws[ai][m] = prs[ai][m] >= 0 ? pairw[prs[ai][m]] : 0.f;
#pragma unroll
        for (int ai = 0; ai < 2; ++ai)
#pragma unroll
            for (int m = 0; m < 4; ++m) {
                if (prs[ai][m] >= 0) {
                    const float w = pws[ai][m]; bf16_t* orow = OP + (size_t)prs[ai][m] * D + nt * 256 + wc2 * 32 + fq2 * 4;
#pragma unroll
                    for (int bj = 0; bj < 2; ++bj)
#pragma unroll
                        for (int n = 0; n < 2; ++n) { const f32x4 v = acc[ai][bj][m][n];
                            u32x2 o; o.x = pk2(v.x * w, v.y * w); o.y = pk2(v.z * w, v.w * w); *(u32x2*)(orow + bj * 128 + n * 16) = o; }
                }
            }
    }
}
DI void phase8(const Params& p, char* smem) {
    const int tid = tid_x(), lane = tid & 63, wave = tid >> 6, wr = wave >> 1, wc = wave & 1, fr = lane & 15, fq = lane >> 4;
    int* pre = (int*)(smem + LDS_BYTES - 256);
    moe_tiles(p, smem, pre);
    const int* cnt = (const int*)(p.ws + WS_CNT); const int* rowlist = (const int*)(p.ws + WS_ROWLIST);
    const bf16_t* Tt = (const bf16_t*)(p.ws + WS_T); const bf16_t* GUT = (const bf16_t*)(p.aux + AUX_GUT); bf16_t* HID = (bf16_t*)(p.ws + WS_HID);
    if (USE_G8) {
        if ((int)blockIdx.x < pre[NEXP] * 2) moe_up_tile(p, smem, pre, (int)blockIdx.x);
        return;
    }
    const int ntile = pre[NEXP] * 4;
    for (int t = blockIdx.x; t < ntile; t += gridDim.x) {
        const int mg = t >> 2, nt = t & 3; int e = 0;
        while (pre[e + 1] <= mg) ++e;
        const int mt = mg - pre[e], ce = cnt[e * CNT_STRIDE]; const int* rl = rowlist + (size_t)e * CAP;
        f32x4 acc[MREP][4]; acc_zero(acc);
        gemm_kloop(acc, smem, [&](int i) { int idx = mt * BM + i; idx = idx < ce ? idx : ce - 1; return Tt + (size_t)(rl[idx] >> 1) * D; }, GUT + ((size_t)e * 512 + nt * 128) * D, D, D);
#pragma unroll
        for (int m = 0; m < MREP; ++m)
#pragma unroll
            for (int j = 0; j < 4; ++j) {
                const int idx = mt * BM + wr * 16 * MREP + m * 16 + fq * 4 + j;
                if (idx < ce) {
                    const int pair = rl[idx];
#pragma unroll
                    for (int n = 0; n < 2; ++n) {
                        const float g = acc[m][n][j], u = acc[m][n + 2][j];
                        HID[(size_t)pair * DE + nt * 64 + wc * 32 + n * 16 + fr] = f2bf(siluf_(g) * u);
                    }
                }
            }
    }
}
DI void phase9(const Params& p, char* smem) {
    const int tid = tid_x(), lane = tid & 63, wave = tid >> 6, wr = wave >> 1, wc = wave & 1, fr = lane & 15, fq = lane >> 4;
    int* pre = (int*)(smem + LDS_BYTES - 256);
    moe_tiles(p, smem, pre);
    const int* cnt = (const int*)(p.ws + WS_CNT); const int* rowlist = (const int*)(p.ws + WS_ROWLIST); const float* pairw = (const float*)(p.ws + WS_PAIRW);
    const bf16_t* HID = (const bf16_t*)(p.ws + WS_HID); const bf16_t* DNT = (const bf16_t*)(p.ws + WS_DNT); bf16_t* OP = (bf16_t*)(p.ws + WS_OPAIR);
    if (USE_G8) {
        constexpr int NT8 = D / 256;
        const int G = (int)gridDim.x, NU = pre[NEXP] * 2, NU2 = NU > G ? NU - G : 0, ND = pre[NEXP] * NT8;
        int* cntw = (int*)(p.ws + WS_CNT);
        int* tk = (int*)(smem + LDS_BYTES - 512);
        for (;;) {
            __syncthreads();
            if (tid_x() == 0) *tk = atomicAdd(&cntw[CNT_TICKET], 1);
            __syncthreads();
            const int j = *tk;
            if (j >= NU2 + ND) break;
            if (j < NU2) {
                moe_up_tile(p, smem, pre, G + j);
#ifndef EMU
                asm volatile("s_waitcnt vmcnt(0)" ::: "memory");
#endif
                __syncthreads();
                if (tid_x() == 0) {
#ifndef EMU
                    __builtin_amdgcn_fence(__ATOMIC_RELEASE, "agent");
                    asm volatile("s_waitcnt vmcnt(0)" ::: "memory");
#endif
                    (void)atomicAdd(&cntw[CNT_U2DONE], 1);
                }
            } else {
                const int dt = j - NU2;
                if (2 * (dt / NT8) + 1 >= G) {
                    if (tid_x() == 0) {
#ifndef EMU
                        while (__hip_atomic_load(&cntw[CNT_U2DONE], __ATOMIC_RELAXED, __HIP_MEMORY_SCOPE_AGENT) < NU2) __builtin_amdgcn_s_sleep(2);
                        __builtin_amdgcn_fence(__ATOMIC_ACQUIRE, "agent");
                        asm volatile("s_waitcnt vmcnt(0)" ::: "memory");
#endif
                    }
                    __syncthreads();
                }
                moe_down_tile(p, smem, pre, dt);
            }
        }
        return;
    }
    constexpr int NT = D / 128;
    const int ntile = pre[NEXP] * NT;
    for (int t = blockIdx.x; t < ntile; t += gridDim.x) {
        const int mg = t / NT, nt = t % NT; int e = 0;
        while (pre[e + 1] <= mg) ++e;
        const int mt = mg - pre[e], ce = cnt[e * CNT_STRIDE]; const int* rl = rowlist + (size_t)e * CAP;
        f32x4 acc[MREP][4]; acc_zero(acc);
        gemm_kloop(acc, smem, [&](int i) { int idx = mt * BM + i; idx = idx < ce ? idx : ce - 1; return HID + (size_t)rl[idx] * DE; }, DNT_PTR(p.ws, e) + (size_t)nt * 128 * DE, DE, DE);
#pragma unroll
        for (int m = 0; m < MREP; ++m)
#pragma unroll
            for (int j = 0; j < 4; ++j) {
                const int idx = mt * BM + wr * 16 * MREP + m * 16 + fq * 4 + j;
                if (idx < ce) {
                    const int pair = rl[idx]; const float w = pairw[pair];
#pragma unroll
                    for (int n = 0; n < 4; ++n) OP[(size_t)pair * D + nt * 128 + wc * 64 + n * 16 + fr] = f2bf(acc[m][n][j] * w);
                }
            }
    }
}

DI void phase10(const Params& p, char* smem) {
    const int lane = tid_x() & 63, wave = tid_x() >> 6;
    const int gw = blockIdx.x * 8 + wave, ngw = gridDim.x * 8;
    const float* Hh = (const float*)(p.ws + WS_H); const float* mod = (const float*)(p.ws + WS_MOD); const bf16_t* OP = (const bf16_t*)(p.ws + WS_OPAIR);
    for (int tok = gw; tok < T_LAT; tok += ngw) {
        const int b = tok / S;
        f32x4 x[D / 256]; float ss = 0.f;
#pragma unroll
        for (int j = 0; j < D / 256; ++j) {
            const int k = j * 256 + lane * 4;
            const f32x4 hv = *(const f32x4*)(Hh + (size_t)tok * D + k), g2 = *(const f32x4*)(mod + (size_t)b * 6 * D + 5 * D + k);
            const u32x2 p0 = *(const u32x2*)(OP + (size_t)(tok * 2) * D + k), p1 = *(const u32x2*)(OP + (size_t)(tok * 2 + 1) * D + k);
            f32x4 m;
            m.x = bf2f((bf16_t)(p0.x & 0xffffu)) + bf2f((bf16_t)(p1.x & 0xffffu)); m.y = bf2f((bf16_t)(p0.x >> 16)) + bf2f((bf16_t)(p1.x >> 16));
            m.z = bf2f((bf16_t)(p0.y & 0xffffu)) + bf2f((bf16_t)(p1.y & 0xffffu)); m.w = bf2f((bf16_t)(p0.y >> 16)) + bf2f((bf16_t)(p1.y >> 16));
            x[j].x = hv.x + g2.x * m.x; x[j].y = hv.y + g2.y * m.y; x[j].z = hv.z + g2.z * m.z; x[j].w = hv.w + g2.w * m.w;
            ss += x[j].x * x[j].x + x[j].y * x[j].y + x[j].z * x[j].z + x[j].w * x[j].w;
        }
        ss = wave_sum(ss);
        const float rstd = 1.0f / sqrtf(ss * (1.0f / D) + 1e-6f);
#pragma unroll
        for (int j = 0; j < D / 256; ++j) {
            const int k = j * 256 + lane * 4; const f32x4 g = *(const f32x4*)(p.in[I_FIN] + k);
            f32x4 o; o.x = x[j].x * rstd * g.x; o.y = x[j].y * rstd * g.y; o.z = x[j].z * rstd * g.z; o.w = x[j].w * rstd * g.w;
            *(f32x4*)(p.out + (size_t)tok * D + k) = o;
        }
    }
}

DI void run_phase(const Params& p, int ph, char* smem) {
    switch (ph) {
        case PH_MOD: phase0(p, smem); break;
        case PH_U: phase1(p, smem); break;
        case PH_P: phase2(p, smem); break;
        case PH_HALO: phase_halo(p, smem); break;
        case PH_FIR: phase_fir(p, smem); break;
        case PH_CHAINS: phase3(p, smem); break;
        case PH_POST: phase4(p, smem); break;
        case PH_MERGE: phase5(p, smem); break;
        case PH_WOUT: phase6(p, smem); break;
        case PH_ROUTER: phase7(p, smem); break;
        case PH_UP: phase8(p, smem); break;
        case PH_DOWN: phase9(p, smem); break;
        default: phase10(p, smem); break;
    }
}

#ifndef EMU
namespace cg = cooperative_groups;
#define XB_TMO      128
#define XB_XCNT(j)  (256  + 64 * (j))
#define XB_XSUB(j)  (1280 + 64 * (j))
#define XB_XGEN(j)  (2304 + 64 * (j))
#define XB_TOP      3328
#define XB_TOPGEN   3392
#define XB_SPIN_CAP (1u << 20)
DI unsigned xb_ld(unsigned* p) { return __hip_atomic_load(p, __ATOMIC_RELAXED, __HIP_MEMORY_SCOPE_AGENT); }
DI unsigned xb_add(unsigned* p, unsigned v) { return __hip_atomic_fetch_add(p, v, __ATOMIC_RELAXED, __HIP_MEMORY_SCOPE_AGENT); }
DI unsigned xb_xcc_id() { return (unsigned)__builtin_amdgcn_s_getreg((3 << 11) | 20) & 0xFu; }
#define XB_SPIN(cond, bar) do { unsigned _sp = 0; while (cond) { __builtin_amdgcn_s_sleep(1); \
    if ((++_sp & 255u) == 0u) { if (xb_ld(&(bar)[XB_TMO])) break; if (_sp > XB_SPIN_CAP) { atomicAdd(&(bar)[XB_TMO], 1u); break; } } } } while (0)
DI void xcd_barrier_post(unsigned* bar) { if (threadIdx.x == 0) (void)xb_add(&bar[XB_XCNT(xb_xcc_id())], 1u); }
DI void xcd_barrier_complete(unsigned* bar, unsigned x, unsigned& nloc, unsigned& nx) {
    const unsigned G = gridDim.x;
    unsigned sum, cnt, mine, sp = 0u;
    for (;;) {
        sum = 0u; cnt = 0u; mine = 0u;
#pragma unroll
        for (unsigned j = 0; j < 16; ++j) { const unsigned c = xb_ld(&bar[XB_XCNT(j)]); sum += c; cnt += (c > 0u) ? 1u : 0u; mine = (j == x) ? c : mine; }
        if (sum == G) break;
        __builtin_amdgcn_s_sleep(1);
        if ((++sp & 255u) == 0u) { if (xb_ld(&bar[XB_TMO])) break; if (sp > XB_SPIN_CAP) { atomicAdd(&bar[XB_TMO], 1u); break; } }
    }
    nloc = mine > 0u ? mine : 1u; nx = cnt > 0u ? cnt : 1u;
}
DI void xcd_barrier(unsigned* bar, volatile unsigned* st) {
    asm volatile("s_waitcnt vmcnt(0)" ::: "memory");
    __syncthreads();
    if (threadIdx.x == 0) {
        __builtin_amdgcn_s_waitcnt(0);
        const unsigned x = xb_xcc_id();
        unsigned nloc = st[0], nx = st[1];
        if (nloc == 0u) { xcd_barrier_complete(bar, x, nloc, nx); st[0] = nloc; st[1] = nx; }
        const unsigned old = xb_add(&bar[XB_XSUB(x)], 1u);
        const unsigned gen = old / nloc;
        if (old + 1u == (gen + 1u) * nloc) {
            __builtin_amdgcn_fence(__ATOMIC_RELEASE, "agent");
            asm volatile("s_waitcnt vmcnt(0)" ::: "memory");
            const unsigned og = xb_add(&bar[XB_TOP], 1u);
            const unsigned tg = og / nx;
            if (og + 1u == (tg + 1u) * nx) xb_add(&bar[XB_TOPGEN], 1u);
            else XB_SPIN(xb_ld(&bar[XB_TOPGEN]) == tg, bar);
            __builtin_amdgcn_fence(__ATOMIC_ACQUIRE, "agent");
            xb_add(&bar[XB_XGEN(x)], 1u);
            asm volatile("s_waitcnt vmcnt(0)" ::: "memory");
        } else {
            XB_SPIN(xb_ld(&bar[XB_XGEN(x)]) == gen, bar);
            __builtin_amdgcn_fence(__ATOMIC_ACQUIRE, "agent");
            asm volatile("s_waitcnt vmcnt(0)" ::: "memory");
        }
    }
    __syncthreads();
}
__global__ void __launch_bounds__(NTHREADS) mk_forward(Params p) {
    extern __shared__ __attribute__((aligned(16))) char smem[];
    typedef const Params __attribute__((address_space(4)))* KPtr;
    volatile unsigned* xst = (volatile unsigned*)(smem + LDS_BYTES);
    if (threadIdx.x < 2) xst[threadIdx.x] = 0u;
    xcd_barrier_post((unsigned*)(p.ws + WS_XBAR));
#define PHASE(k, fn) { KPtr kp = (KPtr)__builtin_amdgcn_kernarg_segment_ptr(); asm volatile("" : "+s"(kp)); fn(*(const Params*)kp, smem); \
        unsigned* xbar = (unsigned*)(((const Params*)kp)->ws + WS_XBAR); \
        if ((k) + 1 < NPHASES) xcd_barrier(xbar, xst); }
    PHASE(0, phase0) PHASE(1, phase1) PHASE(2, phase2)
    if (!USE_G8) PHASE(3, phase_halo)
    PHASE(4, phase_fir) PHASE(5, phase3) PHASE(6, phase4)
    PHASE(7, phase5) PHASE(8, phase6) PHASE(9, phase7) PHASE(10, phase8) PHASE(11, phase9) PHASE(12, phase10)
#undef PHASE
}

extern "C" void kernel_launch(void* const* d_in, const int* in_sizes, int n_in, void* d_out, int out_size, void* d_ws, size_t ws_size, hipStream_t stream) {
    static int grid_blocks = 0;
    if (grid_blocks == 0) {
        if (n_in != 35 || out_size != T_LAT * D || ws_size < WS_END || (size_t)out_size * 4 < AUX_END) {
            fprintf(stderr, "kernel_launch: unexpected shapes (n_in %d out %d ws %zu need %zu aux need %zu)\n", n_in, out_size, ws_size, (size_t)WS_END, (size_t)AUX_END);
            grid_blocks = -1; return;
        }
        int dev = 0, cus = 0, per_cu = 0;
        hipGetDevice(&dev);
        hipDeviceGetAttribute(&cus, hipDeviceAttributeMultiprocessorCount, dev);
        hipFuncSetAttribute((const void*)mk_forward, hipFuncAttributeMaxDynamicSharedMemorySize, LDS_BYTES + 256);
        hipOccupancyMaxActiveBlocksPerMultiprocessor(&per_cu, (const void*)mk_forward, NTHREADS, LDS_BYTES + 256);
        if (per_cu < 1) { fprintf(stderr, "kernel_launch: occupancy query says %d blocks/CU\n", per_cu); per_cu = 1; }
        if (per_cu > 1) per_cu = 1;
        grid_blocks = cus * per_cu;
    }
    if (grid_blocks < 0) return;
    Params p{};
    for (int i = 0; i < 35; ++i) p.in[i] = (const float*)d_in[i];
    p.out = (float*)d_out; p.ws = (char*)d_ws; p.aux = (char*)d_out;
    p.ph_lo = 0; p.ph_hi = NPHASES;
    (void)hipMemsetAsync((char*)d_ws + WS_XBAR, 0, 3456 * 4, stream);
    void* args[] = {&p};
    hipError_t e = hipLaunchCooperativeKernel((const void*)mk_forward, dim3(grid_blocks), dim3(NTHREADS), args, LDS_BYTES + 256, stream);
    if (e != hipSuccess) fprintf(stderr, "cooperative launch failed: %s (grid %d)\n", hipGetErrorString(e), grid_blocks);
}
#endif
```

```cpp
#ifndef EMU
#include <hip/hip_runtime.h>
#include <hip/hip_cooperative_groups.h>
#include <cstdio>
#endif
#include <stdint.h>
#include <stddef.h>

#ifndef CFG_D
#define CFG_D 1024
#define CFG_B 8
#define CFG_S 2048
#define CFG_CTX 256
#endif
#ifndef MK_LAUNCHES
#define MK_LAUNCHES 1
#endif

typedef unsigned short bf16_t;
typedef short bf16x8 __attribute__((ext_vector_type(8)));
typedef float f32x4 __attribute__((ext_vector_type(4)));
typedef unsigned u32x4 __attribute__((ext_vector_type(4)));
typedef unsigned u32x2 __attribute__((ext_vector_type(2)));

#define DI __device__ __forceinline__
DI int tid_x() { int t = (int)threadIdx.x;
#ifndef EMU
    asm volatile("" : "+v"(t));
#endif
    return t; }

constexpr int D = CFG_D, NB = CFG_B, S = CFG_S, CTXL = CFG_CTX;
constexpr int GW = 64, ROWS = S / GW;
constexpr int T_CTX = NB * CTXL, T_LAT = NB * S, T_ALL = T_CTX + T_LAT;
constexpr int H_A = 4, H_B = 8;
constexpr int A_COLS = 2064, B_COLS = 1920;
constexpr int IN_COLS = A_COLS + B_COLS + 2 * D;
constexpr int COL_B0 = A_COLS, COL_G0 = A_COLS + B_COLS;
constexpr int CTX_COLS = COL_G0;
constexpr int NP = ((IN_COLS + 127) / 128) * 128;
constexpr int NEXP = 32, DE = 256;
constexpr int NV = NB + 1;
constexpr int NTHREADS = 512;
constexpr int MREP = (T_CTX % 256 == 0 && T_LAT % 256 == 0) ? 4 : 2;
constexpr int BM = 64 * MREP;
constexpr int NPHASES = 13;
enum { PH_MOD = 0, PH_U, PH_P, PH_HALO, PH_FIR, PH_CHAINS, PH_POST, PH_MERGE, PH_WOUT, PH_ROUTER, PH_UP, PH_DOWN, PH_FINAL };
constexpr int LDS_BYTES = 155648;
constexpr int CAP = T_LAT;

static_assert(D % 256 == 0 && S % 64 == 0 && CTXL % 64 == 0 && T_CTX % BM == 0 && T_LAT % BM == 0, "shape");

constexpr size_t al256(size_t x) { return (x + 255) & ~(size_t)255; }
constexpr int CNT_STRIDE = 64;
constexpr size_t WS_CNT = 512 + 3456 * 4 + 256;
constexpr int CNT_TICKET = 2 * CNT_STRIDE + 16, CNT_U2DONE = 3 * CNT_STRIDE + 16;
constexpr size_t WS_BAR = 256;
constexpr size_t WS_XBAR = 512;
constexpr size_t WS_MOD = 512 + 3456 * 4 + 256 + 32 * 64 * 4;
constexpr size_t WS_AB = al256(WS_MOD + (size_t)NV * 6 * D * 4);
constexpr size_t WS_BONUS = al256(WS_AB + (size_t)T_ALL * 16 * 4);
constexpr size_t WS_PAIRW = al256(WS_BONUS + (size_t)2 * T_LAT * 8 * 4);
constexpr size_t WS_ROWLIST = al256(WS_PAIRW + (size_t)T_LAT * 2 * 4);
constexpr size_t WS_WRT = al256(WS_ROWLIST + (size_t)NEXP * CAP * 4);
constexpr size_t WS_G2T = al256(WS_WRT + (size_t)36 * D * 4);
constexpr size_t WS_WOA = al256(WS_G2T + (size_t)512 * 128 * 2);
constexpr size_t WS_WOB = al256(WS_WOA + (size_t)D * 512 * 2);
constexpr size_t WS_WOUT = al256(WS_WOB + (size_t)D * 512 * 2);
constexpr size_t WS_OA = al256(WS_WOUT + (size_t)D * D * 2);
constexpr size_t WS_OB = al256(WS_OA + (size_t)T_LAT * 512 * 2);
constexpr size_t WS_HALO_A = WS_OA;
constexpr size_t WS_HALO_B = WS_OA + al256((size_t)(T_ALL / 64) * 4 * 1536 * 2);
static_assert(WS_HALO_B + (size_t)(T_ALL / 64) * 2 * 1920 * 2 <= WS_OB + (size_t)T_LAT * 512 * 2, "halo buffers");
constexpr size_t WS_DNT = WS_OA;
constexpr size_t WS_SPARE_END = al256(WS_OB + (size_t)T_LAT * 512 * 2) > al256(WS_DNT + (size_t)NEXP * D * DE * 2) ? al256(WS_OB + (size_t)T_LAT * 512 * 2) : al256(WS_DNT + (size_t)NEXP * D * DE * 2);
constexpr size_t WS_P = WS_SPARE_END;
constexpr size_t WS_PLAT = WS_P;
constexpr size_t WS_PCTX = al256(WS_PLAT + (size_t)T_LAT * IN_COLS * 2);
constexpr size_t WS_P_END = al256(WS_PCTX + (size_t)T_CTX * CTX_COLS * 2);
constexpr size_t WS_H = WS_P;
constexpr size_t WS_T = al256(WS_H + (size_t)T_LAT * D * 4);
constexpr size_t WS_HID = al256(WS_T + (size_t)T_LAT * D * 2);
constexpr size_t WS_OPAIR = al256(WS_HID + (size_t)T_LAT * 2 * DE * 2);
constexpr size_t WS_P2_END = al256(WS_OPAIR + (size_t)T_LAT * 2 * D * 2);
constexpr size_t WS_END0 = WS_P_END > WS_P2_END ? WS_P_END : WS_P2_END;
constexpr size_t WS_GUARANTEED = (size_t)256 << 20;
constexpr int NE_EARLY = WS_END0 >= WS_GUARANTEED ? 0 : ((WS_GUARANTEED - WS_END0) / ((size_t)D * DE * 2) >= (size_t)NEXP ? NEXP : (int)((WS_GUARANTEED - WS_END0) / ((size_t)D * DE * 2)));
constexpr size_t WS_DNT2 = WS_END0;
constexpr size_t WS_END = WS_DNT2 + (size_t)NE_EARLY * D * DE * 2;
constexpr size_t AUX_WINT = 0;
constexpr size_t AUX_U = al256((size_t)NP * D * 2);
constexpr size_t AUX_YDIR = 0;
constexpr size_t AUX_Y = 0;
constexpr size_t AUX_GUT = (size_t)T_LAT * D * 2 > (size_t)2 * T_LAT * 512 * 2 ? (size_t)T_LAT * D * 2 : (size_t)2 * T_LAT * 512 * 2;
constexpr size_t AUX_END1 = AUX_U + (size_t)T_ALL * D * 2;
constexpr size_t AUX_END2 = AUX_YDIR + (size_t)2 * T_LAT * 512 * 2;
static_assert(AUX_YDIR + (size_t)2 * T_LAT * 512 * 2 <= AUX_GUT && AUX_Y + (size_t)T_LAT * D * 2 <= AUX_GUT, "aux overlap");
constexpr size_t AUX_END3 = AUX_GUT + (size_t)NEXP * 512 * D * 2;
constexpr size_t AUX_END = (AUX_END1 > AUX_END2 ? (AUX_END1 > AUX_END3 ? AUX_END1 : AUX_END3) : (AUX_END2 > AUX_END3 ? AUX_END2 : AUX_END3));

#define DNT_PTR(ws, e) ((bf16_t*)((ws) + ((e) < NE_EARLY ? WS_DNT2 : WS_DNT)) + (size_t)(e) * D * DE)
struct Params {
    const float* in[35];
    float* out;
    char* ws;
    char* aux;
    int ph_lo, ph_hi;
};
enum { I_X = 0, I_C, I_CTX, I_CCTX, I_ADAW, I_ADAB, I_NMIX, I_NFFN, I_WIN, I_CONV, I_ALOG, I_DTB, I_ONORM, I_MU, I_W0, I_W2, I_A0, I_A2, I_G2, I_KK, I_KA, I_RK, I_LNG, I_LNB, I_WOA, I_WOB, I_WOUT, I_RG, I_RGB, I_RE, I_REB, I_MG, I_MU_UP, I_MD, I_FIN };

DI float bf2f(bf16_t v) { union { unsigned u; float f; } x; x.u = ((unsigned)v) << 16; return x.f; }
#ifdef EMU
DI bf16_t f2bf(float f) { union { float f; unsigned u; } x; x.f = f; unsigned u = x.u; u += 0x7fffu + ((u >> 16) & 1u); return (bf16_t)(u >> 16); }
DI unsigned pk2(float lo, float hi) { return (unsigned)f2bf(lo) | ((unsigned)f2bf(hi) << 16); }
#else
typedef __bf16 hbf16x2 __attribute__((ext_vector_type(2)));
typedef float f32x2_ __attribute__((ext_vector_type(2)));
DI bf16_t f2bf(float f) { return __builtin_bit_cast(unsigned short, (__bf16)f); }
DI unsigned pk2(float lo, float hi) { const f32x2_ v = {lo, hi}; return __builtin_bit_cast(unsigned, __builtin_convertvector(v, hbf16x2)); }
#endif
DI float sigmoidf_(float x) { return 1.0f / (1.0f + expf(-x)); }
DI float siluf_(float x) { return x / (1.0f + expf(-x)); }
DI float softplusf_(float x) { return x > 20.f ? x : log1pf(expf(x)); }
DI float wave_sum(float v) {
#pragma unroll
    for (int o = 1; o < 64; o <<= 1) v += __shfl_xor(v, o);
    return v;
}
#ifdef EMU
#define MFMA16(a, b, c) emu_mfma16((a), (b), (c))
#define WAVE_SYNC() emu::wave_bar()
#else
#define MFMA16(a, b, c) __builtin_amdgcn_mfma_f32_16x16x32_bf16((a), (b), (c), 0, 0, 0)
#define WAVE_SYNC() asm volatile("s_waitcnt lgkmcnt(0)" ::: "memory")
#endif
#ifdef EMU
#define LDS_BARRIER() __syncthreads()
#else
#define LDS_BARRIER() do { asm volatile("s_waitcnt lgkmcnt(0)" ::: "memory"); __builtin_amdgcn_s_barrier(); asm volatile("" ::: "memory"); } while (0)
#endif

typedef float f32x16 __attribute__((ext_vector_type(16)));
typedef float f32x2_ac __attribute__((ext_vector_type(2)));
typedef short bf16x4 __attribute__((ext_vector_type(4)));
#ifdef EMU
#define MFMA32(a, b, c) emu_mfma32((a), (b), (c))
DI float fexp(float x) { return expf(x); }
DI float flog(float x) { return logf(x); }
DI float frcp(float x) { return 1.0f / x; }
DI float frsq(float x) { return 1.0f / sqrtf(x); }
DI float wave_sum_fast(float v) { return wave_sum(v); }
#else
#define MFMA32(a, b, c) __builtin_amdgcn_mfma_f32_32x32x16_bf16((a), (b), (c), 0, 0, 0)
DI float fexp(float x) { return __expf(x); }
DI float flog(float x) { return __logf(x); }
DI float frcp(float x) { return __builtin_amdgcn_rcpf(x); }
DI float frsq(float x) { return __builtin_amdgcn_rsqf(x); }
#define DPP_ADD(v, ctrl) ((v) + __builtin_bit_cast(float, __builtin_amdgcn_update_dpp(0, __builtin_bit_cast(int, (v)), (ctrl), 0xf, 0xf, false)))
DI float wave_sum_fast(float v) {
    v = DPP_ADD(v, 0xB1); v = DPP_ADD(v, 0x4E); v = DPP_ADD(v, 0x141); v = DPP_ADD(v, 0x140);
    const int iv = __builtin_bit_cast(int, v);
    return (__builtin_bit_cast(float, __builtin_amdgcn_readlane(iv, 0)) + __builtin_bit_cast(float, __builtin_amdgcn_readlane(iv, 16))) +
           (__builtin_bit_cast(float, __builtin_amdgcn_readlane(iv, 32)) + __builtin_bit_cast(float, __builtin_amdgcn_readlane(iv, 48)));
}
#endif
DI float fsigmoid(float x) { return frcp(1.0f + fexp(-x)); }
DI float fsilu(float x) { return x * fsigmoid(x); }
DI float fsoftplus(float x) { return fmaxf(x, 0.f) + flog(1.f + fexp(-fabsf(x))); }
DI float ftanh(float x) { return 1.0f - 2.0f * frcp(1.0f + fexp(2.0f * x)); }

constexpr int LDS_ROW = 40;
constexpr int GEMM_A_BYTES = BM * LDS_ROW * 2, GEMM_B_BYTES = 128 * LDS_ROW * 2;
template <int MR, class ARow>
DI void gemm_kloop(f32x4 (&acc)[MR][4], char* smem, ARow arow, const bf16_t* Bt, int ldb, int K) {
    constexpr int BM = 64 * MR;
    const int tid = tid_x(), lane = tid & 63, wave = tid >> 6, wr = wave >> 1, wc = wave & 1, fr = lane & 15, fq = lane >> 4;
    bf16_t* As = (bf16_t*)smem;
    bf16_t* Bs = (bf16_t*)(smem + 2 * GEMM_A_BYTES);
    constexpr int ACH = BM * 4 / NTHREADS;
    static_assert(ACH >= 1, "tile");
    const bf16_t* ap[ACH];
#pragma unroll
    for (int i = 0; i < ACH; ++i) { const int q = tid + i * NTHREADS; ap[i] = arow(q >> 2) + (q & 3) * 8; }
    const bf16_t* bp = Bt + (size_t)(tid >> 2) * ldb + (tid & 3) * 8;
    u32x4 ra[ACH], rb;
#pragma unroll
    for (int i = 0; i < ACH; ++i) ra[i] = *(const u32x4*)(ap[i]);
    rb = *(const u32x4*)(bp);
    const int nk = K / 32;
    for (int kt = 0; kt < nk; ++kt) {
        const int buf = kt & 1;
#pragma unroll
        for (int i = 0; i < ACH; ++i) { const int q = tid + i * NTHREADS; *(u32x4*)(As + (buf * BM + (q >> 2)) * LDS_ROW + (q & 3) * 8) = ra[i]; }
        *(u32x4*)(Bs + (buf * 128 + (tid >> 2)) * LDS_ROW + (tid & 3) * 8) = rb;
        __syncthreads();
        if (kt + 1 < nk) {
#pragma unroll
            for (int i = 0; i < ACH; ++i) ra[i] = *(const u32x4*)(ap[i] + (kt + 1) * 32);
            rb = *(const u32x4*)(bp + (kt + 1) * 32);
        }
        bf16x8 af[MR], bfr[4];
#pragma unroll
        for (int m = 0; m < MR; ++m) af[m] = *(const bf16x8*)(As + (buf * BM + wr * 16 * MR + m * 16 + fr) * LDS_ROW + fq * 8);
#pragma unroll
        for (int n = 0; n < 4; ++n) bfr[n] = *(const bf16x8*)(Bs + (buf * 128 + wc * 64 + n * 16 + fr) * LDS_ROW + fq * 8);
#pragma unroll
        for (int m = 0; m < MR; ++m)
#pragma unroll
            for (int n = 0; n < 4; ++n) acc[m][n] = MFMA16(af[m], bfr[n], acc[m][n]);
    }
    __syncthreads();
}
template <int MR>
DI void acc_zero(f32x4 (&acc)[MR][4]) {
#pragma unroll
    for (int m = 0; m < MR; ++m)
#pragma unroll
        for (int n = 0; n < 4; ++n) acc[m][n] = (f32x4){0.f, 0.f, 0.f, 0.f};
}

namespace g8 {
constexpr int BM = 256, BK = 64, HALF = 128, HT = HALF * BK;
constexpr int LDS_NEED = 8 * HT * 2;
DI int lds_byte(int r, int c) { const int st = (r >> 4) * 2 + (c >> 5), rr = r & 15, cc = c & 31, ob = rr * 64 + cc * 2; return st * 1024 + (ob ^ (((ob >> 9) & 1) << 5)); }
DI void stage_rc(int b, int& R, int& C) { const int st = b / 1024, sb = b % 1024, swz = sb ^ (((sb >> 9) & 1) << 5); R = (st >> 1) * 16 + swz / 64; C = (st & 1) * 32 + (swz % 64) / 2; }
#ifdef EMU
#define G8_GLDS(src, dst) emu_global_load_lds16((src), (dst))
#define G8_WAIT_V(n)
#define G8_WAIT_L(n)
#define G8_BAR __syncthreads()
#define G8_SCHED
#define G8_PRIO(x)
#else
#define G8_GLDS(src, dst) __builtin_amdgcn_global_load_lds((const unsigned*)(src), (__attribute__((address_space(3))) unsigned*)(dst), 16, 0, 0)
#define G8_WAIT_V(n) asm volatile("s_waitcnt vmcnt(" #n ")" ::: "memory")
#define G8_WAIT_L(n) asm volatile("s_waitcnt lgkmcnt(" #n ")" ::: "memory")
#define G8_BAR __builtin_amdgcn_s_barrier()
#define G8_SCHED __builtin_amdgcn_sched_barrier(0)
#define G8_PRIO(x) __builtin_amdgcn_s_setprio(x)
#endif
typedef f32x4 Acc[2][2][4][2];
template <class AOff>
DI void kloop_g(Acc& acc, char* smem, const bf16_t* A, AOff aoff, const bf16_t* Bt, int ldb, int K, int bcol) {
    bf16_t* shm = (bf16_t*)smem;
    const int tid = tid_x(), wid = tid >> 6, lane = tid & 63, wr = wid >> 2, wc = wid & 3, fr = lane & 15, fq = lane >> 4;
    int ao[2][2];
#pragma unroll
    for (int h = 0; h < 2; ++h)
#pragma unroll
        for (int i = 0; i < 2; ++i) { int R, C; stage_rc(tid * 16 + i * 8192, R, C); ao[h][i] = aoff(h * HALF + R) + C; }
#define G8_STAGE_A(P, h, kt) do { for (int _i = 0; _i < 2; ++_i) { const int _b = tid * 16 + _i * 8192; G8_GLDS(A + (size_t)ao[h][_i] + (size_t)(kt) * BK, (char*)(P) + _b); } } while (0)
#define G8_SA(b, h) (shm + ((b) * 2 + (h)) * HT)
#define G8_SB(b, h) (shm + (4 + (b) * 2 + (h)) * HT)
#define G8_STAGE(P, BASE, LD, br, kt) do { const bf16_t* _g = (BASE) + (size_t)(br) * (LD) + (size_t)(kt) * BK; \
    for (int _i = 0; _i < 2; ++_i) { const int _b = tid * 16 + _i * 8192; int _r, _c; stage_rc(_b, _r, _c); G8_GLDS(_g + (size_t)_r * (LD) + _c, (char*)(P) + _b); } } while (0)
#define G8_LDA(dst, b, h) for (int m = 0; m < 4; ++m) for (int k = 0; k < 2; ++k) dst[m][k] = *(const bf16x8*)((const char*)G8_SA(b, h) + lds_byte(wr * 64 + m * 16 + fr, k * 32 + fq * 8))
#define G8_LDB(dst, b, h) for (int n = 0; n < 2; ++n) for (int k = 0; k < 2; ++k) dst[n][k] = *(const bf16x8*)((const char*)G8_SB(b, h) + lds_byte(wc * 32 + n * 16 + fr, k * 32 + fq * 8))
#define G8_MMA(ai, bj, At_, Bt_) do { G8_PRIO(1); for (int m = 0; m < 4; ++m) for (int n = 0; n < 2; ++n) for (int k = 0; k < 2; ++k) \
    acc[ai][bj][m][n] = MFMA16(Bt_[n][k], At_[m][k], acc[ai][bj][m][n]); G8_PRIO(0); } while (0)
    bf16x8 At[4][2], B0[2][2], B1[2][2];
    const int nt = K / BK;
    G8_STAGE(G8_SB(0, 0), Bt, ldb, bcol, 0); G8_STAGE_A(G8_SA(0, 0), 0, 0);
    G8_STAGE(G8_SB(0, 1), Bt, ldb, bcol + HALF, 0); G8_STAGE_A(G8_SA(0, 1), 1, 0);
    if (wr == 1) G8_BAR;
    G8_WAIT_V(4); G8_BAR;
    G8_STAGE(G8_SB(1, 0), Bt, ldb, bcol, 1); G8_STAGE_A(G8_SA(1, 0), 0, 1); G8_STAGE(G8_SB(1, 1), Bt, ldb, bcol + HALF, 1);
    G8_WAIT_V(6); G8_BAR;
    for (int t = 0; t < nt - 2; t += 2) {
        G8_LDB(B0, 0, 0); G8_SCHED; G8_LDA(At, 0, 0); G8_STAGE_A(G8_SA(1, 1), 1, t + 1);
        G8_WAIT_L(8); G8_BAR; G8_WAIT_L(0); G8_MMA(0, 0, At, B0); G8_BAR; G8_SCHED;
        G8_LDB(B1, 0, 1); G8_STAGE(G8_SB(0, 0), Bt, ldb, bcol, t + 2);
        G8_BAR; G8_WAIT_L(0); G8_MMA(0, 1, At, B1); G8_BAR;
        G8_LDA(At, 0, 1); G8_STAGE_A(G8_SA(0, 0), 0, t + 2);
        G8_BAR; G8_WAIT_L(0); G8_MMA(1, 0, At, B0); G8_BAR; G8_SCHED;
        G8_STAGE(G8_SB(0, 1), Bt, ldb, bcol + HALF, t + 2);
        G8_WAIT_V(6); G8_BAR; G8_MMA(1, 1, At, B1); G8_BAR;
        G8_LDB(B0, 1, 0); G8_SCHED; G8_LDA(At, 1, 0); G8_STAGE_A(G8_SA(0, 1), 1, t + 2);
        G8_WAIT_L(8); G8_BAR; G8_WAIT_L(0); G8_MMA(0, 0, At, B0); G8_BAR; G8_SCHED;
        G8_LDB(B1, 1, 1); G8_STAGE(G8_SB(1, 0), Bt, ldb, bcol, t + 3);
        G8_BAR; G8_WAIT_L(0); G8_MMA(0, 1, At, B1); G8_BAR;
        G8_LDA(At, 1, 1); G8_STAGE_A(G8_SA(1, 0), 0, t + 3);
        G8_BAR; G8_WAIT_L(0); G8_MMA(1, 0, At, B0); G8_BAR; G8_SCHED;
        G8_STAGE(G8_SB(1, 1), Bt, ldb, bcol + HALF, t + 3);
        G8_WAIT_V(6); G8_BAR; G8_MMA(1, 1, At, B1); G8_BAR;
    }
    { G8_LDB(B0, 0, 0); G8_LDA(At, 0, 0); G8_STAGE_A(G8_SA(1, 1), 1, nt - 1);
      G8_BAR; G8_WAIT_L(0); G8_MMA(0, 0, At, B0); G8_BAR;
      G8_LDB(B1, 0, 1); G8_BAR; G8_WAIT_L(0); G8_MMA(0, 1, At, B1); G8_BAR;
      G8_LDA(At, 0, 1); G8_WAIT_V(4); G8_BAR; G8_WAIT_L(0); G8_MMA(1, 0, At, B0); G8_MMA(1, 1, At, B1); G8_BAR; }
    { G8_LDB(B0, 1, 0); G8_LDA(At, 1, 0); G8_WAIT_V(2); G8_BAR; G8_WAIT_L(0); G8_MMA(0, 0, At, B0); G8_BAR;
      G8_LDB(B1, 1, 1); G8_WAIT_V(0); G8_BAR; G8_WAIT_L(0); G8_MMA(0, 1, At, B1); G8_BAR;
      G8_LDA(At, 1, 1); G8_BAR; G8_WAIT_L(0); G8_MMA(1, 0, At, B0); G8_MMA(1, 1, At, B1); G8_BAR; }
    if (wr == 0) G8_BAR;
#undef G8_SA
#undef G8_SB
#undef G8_STAGE
#undef G8_STAGE_A
#undef G8_LDA
#undef G8_LDB
#undef G8_MMA
}
DI void kloop(Acc& acc, char* smem, const bf16_t* A, int lda, const bf16_t* Bt, int ldb, int K, int brow, int bcol) {
    kloop_g(acc, smem, A, [&](int r) { return (brow + r) * lda; }, Bt, ldb, K, bcol);
}
DI bool tile_order(int L, int nM, int nN, int& pm, int& pn) {
    constexpr int NXCD = 8, WGM = 8;
    const int nwg = nM * nN; if (L >= nwg) return false;
    int wgid = L; { const int q = nwg / NXCD, r = nwg % NXCD, xcd = wgid % NXCD, off = wgid / NXCD; wgid = (xcd < r ? xcd * (q + 1) : r * (q + 1) + (xcd - r) * q) + off; }
    const int nig = WGM * nN, gid = wgid / nig, fm = gid * WGM, gsz = (nM - fm) < WGM ? (nM - fm) : WGM;
    pm = fm + ((wgid % nig) % gsz); pn = (wgid % nig) / gsz; return true;
}
DI void acc_zero(Acc& acc) {
#pragma unroll
    for (int a = 0; a < 2; ++a)
#pragma unroll
        for (int b = 0; b < 2; ++b)
#pragma unroll
            for (int m = 0; m < 4; ++m)
#pragma unroll
                for (int n = 0; n < 2; ++n) acc[a][b][m][n] = (f32x4){0.f, 0.f, 0.f, 0.f};
}
template <class F> DI void for_each_quad(const Acc& acc, int brow, int bcol, F f) {
    const int tid = tid_x(), wid = tid >> 6, lane = tid & 63, wr = wid >> 2, wc = wid & 3, fr = lane & 15, fq = lane >> 4;
#pragma unroll
    for (int ai = 0; ai < 2; ++ai)
#pragma unroll
        for (int m = 0; m < 4; ++m)
#pragma unroll
            for (int bj = 0; bj < 2; ++bj)
#pragma unroll
                for (int n = 0; n < 2; ++n) f(brow + ai * HALF + wr * 64 + m * 16 + fr, bcol + bj * HALF + wc * 32 + n * 16 + fq * 4, acc[ai][bj][m][n]);
}
}

constexpr bool USE_G8 = ((NB * CTXL) % 256 == 0) && ((NB * S) % 256 == 0) && (NP % 256 == 0) && (D % 256 == 0) && (D >= 256);
DI int gu_row(int c, int up) {
    if (USE_G8) return (c >> 7) * 256 + ((c >> 6) & 1) * 128 + ((c >> 4) & 3) * 32 + (up ? 16 : 0) + (c & 15);
    return (c >> 6) * 128 + ((c >> 5) & 1) * 64 + ((c >> 4) & 1) * 16 + (c & 15) + (up ? 32 : 0);
}
DI void transpose_item(const float* W, int N, int Nvalid, int k0, int n0, bf16_t* WT, int ldt, int mode, float* scr, int lane) {
    float tv[32];
#pragma unroll
    for (int i = 0; i < 32; ++i) {
        const int kk = 2 * i + (lane >> 5), n = n0 + (lane & 31);
        tv[i] = (n < Nvalid) ? W[(size_t)(k0 + kk) * N + n] : 0.f;
    }
#pragma unroll
    for (int i = 0; i < 32; ++i) scr[(2 * i + (lane >> 5)) * 33 + (lane & 31)] = tv[i];
    WAVE_SYNC();
    const int c = lane & 7;
#pragma unroll
    for (int j = 0; j < 4; ++j) {
        const int nl = (lane >> 3) + 8 * j; const float* s = scr + (8 * c) * 33 + nl;
        u32x4 o; o.x = pk2(s[0], s[33]); o.y = pk2(s[2 * 33], s[3 * 33]); o.z = pk2(s[4 * 33], s[5 * 33]); o.w = pk2(s[6 * 33], s[7 * 33]);
        const int n = n0 + nl; const int row = mode == 0 ? n : gu_row(n, mode == 2);
        *(u32x4*)(WT + (size_t)row * ldt + k0 + 8 * c) = o;
    }
    WAVE_SYNC();
}
DI void transpose_matrix(const float* W, int K, int N, int Npad, bf16_t* WT, int mode, char* smem, int gw, int ngw, int& base) {
    const int lane = tid_x() & 63, wave = tid_x() >> 6;
    float* scr = (float*)smem + wave * (64 * 33);
    const int nkb = K / 64, nnb = Npad / 32, nitems = nkb * nnb;
    int first = ((gw - base) % ngw + ngw) % ngw;
    for (int it = first; it < nitems; it += ngw) {
        const int kb = it / nnb, nb = it % nnb;
        transpose_item(W, N, N, kb * 64, nb * 32, WT, K, mode, scr, lane);
    }
    base = (base + nitems) % ngw;
}

DI void phase0(const Params& p, char* smem) {
    const int tid = tid_x(), lane = tid & 63, wave = tid >> 6;
    if (blockIdx.x == 0 && tid < NEXP) ((int*)(p.ws + WS_CNT))[tid * CNT_STRIDE] = 0;
    if (blockIdx.x == 0 && tid < 2) ((int*)(p.ws + WS_CNT))[tid ? CNT_U2DONE : CNT_TICKET] = 0;
    if (blockIdx.x == 0 && tid == 0) *(unsigned*)(p.ws + WS_BAR) = 0u;
    float* sil = (float*)smem;
    float* red = sil + NV * D;
    const int nitems = 6 * D / 32;
    bool did = false;
    for (int it = blockIdx.x; it < nitems; it += gridDim.x) {
        if (!did) {
            for (int i = tid; i < NV * D; i += NTHREADS) { const int v = i / D, k = i % D; const float cv = v < NB ? p.in[I_C][v * D + k] : p.in[I_CCTX][k]; sil[i] = siluf_(cv); }
            did = true;
        }
        __syncthreads();
        const int col = it * 32 + (lane & 31), rp = lane >> 5;
        float acc[NV];
#pragma unroll
        for (int v = 0; v < NV; ++v) acc[v] = 0.f;
        const int r0 = wave * (D / 8);
        float wv[D / 16];
#pragma unroll
        for (int i = 0; i < D / 16; ++i) wv[i] = p.in[I_ADAW][(size_t)(r0 + 2 * i + rp) * (6 * D) + col];
#pragma unroll
        for (int i = 0; i < D / 16; ++i) {
            const int row = r0 + 2 * i + rp;
#pragma unroll
            for (int v = 0; v < NV; ++v) acc[v] += sil[v * D + row] * wv[i];
        }
#pragma unroll
        for (int v = 0; v < NV; ++v) red[((wave * 2 + rp) * NV + v) * 32 + (lane & 31)] = acc[v];
        __syncthreads();
        if (tid < NV * 32) {
            const int v = tid / 32, cl = tid % 32; float s = p.in[I_ADAB][it * 32 + cl];
            for (int g = 0; g < 16; ++g) s += red[(g * NV + v) * 32 + cl];
            ((float*)(p.ws + WS_MOD))[(size_t)v * 6 * D + it * 32 + cl] = s;
        }
    }
    __syncthreads();
    const int gw = blockIdx.x * 8 + wave, ngw = gridDim.x * 8; int base = 0;
    {
        float* scr = (float*)smem + wave * (64 * 33);
        const int nkb = D / 64, nnb = NP / 32, nitems2 = nkb * nnb;
        for (int it = gw; it < nitems2; it += ngw) { const int kb = it / nnb, nb = it % nnb; transpose_item(p.in[I_WIN], IN_COLS, IN_COLS, kb * 64, nb * 32, (bf16_t*)(p.aux + AUX_WINT), D, 0, scr, lane); }
        base = nitems2 % ngw;
    }
    { float* WRT = (float*)(p.ws + WS_WRT);
      for (int i = blockIdx.x * NTHREADS + tid; i < 36 * D; i += gridDim.x * NTHREADS) { const int j = i / D, k = i % D; WRT[i] = j < 4 ? p.in[I_RG][(size_t)k * 4 + j] : p.in[I_RE][(size_t)k * 32 + (j - 4)]; } }
    transpose_matrix(p.in[I_WOA], 512, D, D, (bf16_t*)(p.ws + WS_WOA), 0, smem, gw, ngw, base);
    transpose_matrix(p.in[I_WOB], 512, D, D, (bf16_t*)(p.ws + WS_WOB), 0, smem, gw, ngw, base);
    transpose_matrix(p.in[I_WOUT], D, D, D, (bf16_t*)(p.ws + WS_WOUT), 0, smem, gw, ngw, base);
    transpose_matrix(p.in[I_G2], 128, 512, 512, (bf16_t*)(p.ws + WS_G2T), 0, smem, gw, ngw, base);
}

constexpr int NSEG = T_ALL / 64, NSEG_CTX = T_CTX / 64;
DI void halo_store(const Params& p, int row, int col, const u32x2& o) {
    int seq, b, j;
    if (row < T_CTX) { seq = 0; b = row / CTXL; j = row % CTXL; } else { seq = 1; const int rr = row - T_CTX; b = rr / S; j = rr % S; }
    const int L = seq ? S : CTXL; const int segbase = seq ? NSEG_CTX + b * (S / 64) : b * (CTXL / 64);
    if (col < 1536) {
        const int jm = j & 63;
        if (jm >= 62 && j + 2 < L) { const int g = segbase + (j >> 6) + 1; *(u32x2*)((bf16_t*)(p.ws + WS_HALO_A) + ((size_t)g * 4 + (jm - 62)) * 1536 + col) = o; }
        if (jm < 2 && j >= 64) { const int g = segbase + (j >> 6) - 1; *(u32x2*)((bf16_t*)(p.ws + WS_HALO_A) + ((size_t)g * 4 + 2 + jm) * 1536 + col) = o; }
    } else if (col >= COL_B0 && col < COL_B0 + 1920) {
        const int js = seq ? (j % GW) * ROWS + j / GW : j; const int jm = js & 63;
        if (jm == 63 && js + 1 < L) { const int g = segbase + (js >> 6) + 1; *(u32x2*)((bf16_t*)(p.ws + WS_HALO_B) + ((size_t)g * 2 + 0) * 1920 + (col - COL_B0)) = o; }
        if (jm == 0 && js >= 64) { const int g = segbase + (js >> 6) - 1; *(u32x2*)((bf16_t*)(p.ws + WS_HALO_B) + ((size_t)g * 2 + 1) * 1920 + (col - COL_B0)) = o; }
    }
}
DI void halo_zero_fill(const Params& p) {
    const int tid = tid_x(), lane = tid & 63, wave = tid >> 6; const int gw = blockIdx.x * 8 + wave, ngw = gridDim.x * 8;
    bf16_t* HA = (bf16_t*)(p.ws + WS_HALO_A); bf16_t* HB = (bf16_t*)(p.ws + WS_HALO_B);
    for (int it = gw; it < NSEG * 2; it += ngw) {
        const int g = it >> 1, side = it & 1;
        const bool ctx = g < NSEG_CTX; const int sg = ctx ? g % (CTXL / 64) : (g - NSEG_CTX) % (S / 64); const int nsg = ctx ? CTXL / 64 : S / 64;
        const bool edge = side ? (sg == nsg - 1) : (sg == 0);
        if (!edge) continue;
        for (int c = lane; c < 384; c += 64) *(u32x4*)(HA + ((size_t)g * 4 + 2 * side) * 1536 + c * 8) = (u32x4){0u, 0u, 0u, 0u};
        for (int c = lane; c < 240; c += 64) *(u32x4*)(HB + ((size_t)g * 2 + side) * 1920 + c * 8) = (u32x4){0u, 0u, 0u, 0u};
    }
}
DI void phase1(const Params& p, char* smem) {
    if (USE_G8) halo_zero_fill(p);
    const int lane = tid_x() & 63, wave = tid_x() >> 6;
    const int gw = blockIdx.x * 8 + wave, ngw = gridDim.x * 8;
    const float* mod = (const float*)(p.ws + WS_MOD);
    bf16_t* U = (bf16_t*)(p.aux + AUX_U);
    auto rowsrc = [&](int r) -> const float* { return r < T_CTX ? p.in[I_CTX] + (size_t)r * D : p.in[I_X] + (size_t)(r - T_CTX) * D; };
    f32x4 xn[D / 256];
    if (gw < T_ALL) {
#pragma unroll
        for (int j = 0; j < D / 256; ++j) xn[j] = *(const f32x4*)(rowsrc(gw) + j * 256 + lane * 4);
    }
    for (int r = gw; r < T_ALL; r += ngw) {
        const int v = r < T_CTX ? NB : (r - T_CTX) / S;
        f32x4 x[D / 256]; float ss = 0.f;
#pragma unroll
        for (int j = 0; j < D / 256; ++j) { x[j] = xn[j]; ss += x[j].x * x[j].x + x[j].y * x[j].y + x[j].z * x[j].z + x[j].w * x[j].w; }
        if (r + ngw < T_ALL) {
#pragma unroll
            for (int j = 0; j < D / 256; ++j) xn[j] = *(const f32x4*)(rowsrc(r + ngw) + j * 256 + lane * 4);
        }
        ss = wave_sum_fast(ss);
        const float rstd = frsq(ss * (1.0f / D) + 1e-6f);
#pragma unroll
        for (int j = 0; j < D / 256; ++j) {
            const int k = j * 256 + lane * 4;
            const f32x4 g = *(const f32x4*)(p.in[I_NMIX] + k), sh = *(const f32x4*)(mod + (size_t)v * 6 * D + k), sc = *(const f32x4*)(mod + (size_t)v * 6 * D + D + k);
            float o0 = x[j].x * rstd * g.x * (1.f + sc.x) + sh.x, o1 = x[j].y * rstd * g.y * (1.f + sc.y) + sh.y;
            float o2 = x[j].z * rstd * g.z * (1.f + sc.z) + sh.z, o3 = x[j].w * rstd * g.w * (1.f + sc.w) + sh.w;
            u32x2 o; o.x = pk2(o0, o1); o.y = pk2(o2, o3);
            *(u32x2*)(U + (size_t)r * D + k) = o;
        }
    }
}

DI void phase2(const Params& p, char* smem) {
    const bf16_t* U = (const bf16_t*)(p.aux + AUX_U); const bf16_t* WT = (const bf16_t*)(p.aux + AUX_WINT);
    bf16_t* PL = (bf16_t*)(p.ws + WS_PLAT); bf16_t* PC = (bf16_t*)(p.ws + WS_PCTX); float* AB = (float*)(p.ws + WS_AB);
    if (USE_G8) {
        constexpr int NT = NP / 256, MT = T_ALL / 256, NT_CTX = (CTX_COLS + 255) / 256;
        for (int t = blockIdx.x; t < MT * NT; t += gridDim.x) {
            int mt, nt; if (!g8::tile_order(t, MT, NT, mt, nt)) break;
            const int brow = mt * 256, bcol = nt * 256; const bool isctx = brow < T_CTX;
            if (isctx && nt >= NT_CTX) continue;
            g8::Acc acc; g8::acc_zero(acc);
            g8::kloop(acc, smem, U, D, WT, D, D, brow, bcol);
            constexpr int OLD_ = 264; bf16_t* OT = (bf16_t*)smem;
            g8::for_each_quad(acc, brow, bcol, [&](int row, int col, const f32x4& v) {
                u32x2 o; o.x = pk2(v.x, v.y); o.y = pk2(v.z, v.w);
                *(u32x2*)(OT + (row - brow) * OLD_ + (col - bcol)) = o;
                if (col >= 2048 && col < 2064) *(f32x4*)(AB + (size_t)row * 16 + (col - 2048)) = v;
                halo_store(p, row, col, o);
            });
            __syncthreads();
            {
                const int tid = tid_x(); const int ncols = isctx ? CTX_COLS : IN_COLS;
                bf16_t* dst = isctx ? PC + (size_t)brow * CTX_COLS : PL + (size_t)(brow - T_CTX) * IN_COLS;
#pragma unroll
                for (int i = 0; i < 16; ++i) {
                    const int ch = tid + i * NTHREADS, row = ch >> 5, c8 = (ch & 31) * 8, col = bcol + c8;
                    if (col < ncols) *(u32x4*)(dst + (size_t)row * ncols + col) = *(const u32x4*)(OT + row * OLD_ + c8);
                }
            }
            __syncthreads();
        }
        return;
    }
    const int tid = tid_x(), lane = tid & 63, wave = tid >> 6, wr = wave >> 1, wc = wave & 1, fr = lane & 15, fq = lane >> 4;
    constexpr int NT = NP / 128, MT = T_ALL / BM, NT_CTX = (CTX_COLS + 127) / 128;
    for (int t = blockIdx.x; t < MT * NT; t += gridDim.x) {
        const int mt = t / NT, nt = t % NT; const int row0 = mt * BM; const bool isctx = row0 < T_CTX;
        if (isctx && nt >= NT_CTX) continue;
        f32x4 acc[MREP][4]; acc_zero(acc);
        gemm_kloop(acc, smem, [&](int i) { return U + (size_t)(row0 + i) * D; }, WT + (size_t)nt * 128 * D, D, D);
#pragma unroll
        for (int m = 0; m < MREP; ++m)
#pragma unroll
            for (int n = 0; n < 4; ++n)
#pragma unroll
                for (int j = 0; j < 4; ++j) {
                    const int row = row0 + wr * 16 * MREP + m * 16 + fq * 4 + j, col = nt * 128 + wc * 64 + n * 16 + fr; const float v = acc[m][n][j];
                    if (isctx) { if (col < CTX_COLS) PC[(size_t)row * CTX_COLS + col] = f2bf(v); }
                    else { if (col < IN_COLS) PL[(size_t)(row - T_CTX) * IN_COLS + col] = f2bf(v); }
                    if (col >= 2048 && col < 2064) AB[(size_t)row * 16 + (col - 2048)] = v;
                }
    }
}


DI int crow(int g, int h) { return (g & 3) + 8 * (g >> 2) + 4 * h; }
template <int S_> DI bf16x8 pack_acc(const f32x16& x) {
    u32x4 r;
    r.x = pk2(x[8 * S_ + 0], x[8 * S_ + 1]); r.y = pk2(x[8 * S_ + 2], x[8 * S_ + 3]); r.z = pk2(x[8 * S_ + 4], x[8 * S_ + 5]); r.w = pk2(x[8 * S_ + 6], x[8 * S_ + 7]);
    return __builtin_bit_cast(bf16x8, r);
}
DI bf16x8 ld_nat(const bf16_t* row, int s, int h) { return *(const bf16x8*)(row + 16 * s + 8 * h); }
DI bf16x8 ld_perm(const bf16_t* row, int s, int h) {
    const bf16x4 lo = *(const bf16x4*)(row + 16 * s + 4 * h), hi = *(const bf16x4*)(row + 16 * s + 8 + 4 * h);
    return __builtin_shufflevector(lo, hi, 0, 1, 2, 3, 4, 5, 6, 7);
}
DI f32x16 zero16() { f32x16 z;
#pragma unroll
    for (int i = 0; i < 16; ++i) z[i] = 0.f;
    return z; }
#define TGET(i) ((i) < 16 ? t0[(i) & 15] : t1[(i) & 15])
DI void invert32_col(const float* Lf, f32x16& t0, f32x16& t1, int c) {
#pragma unroll
    for (int i = 0; i < 32; ++i) {
        float s0 = 0.f, s1 = 0.f, s2 = 0.f, s3 = 0.f;
#pragma unroll
        for (int j4 = 0; j4 < (i + 3) / 4; ++j4) {
            const f32x4 l = *(const f32x4*)(Lf + i * 32 + 4 * j4);
            if (4 * j4 + 0 < i) s0 += l.x * TGET(4 * j4 + 0);
            if (4 * j4 + 1 < i) s1 += l.y * TGET(4 * j4 + 1);
            if (4 * j4 + 2 < i) s2 += l.z * TGET(4 * j4 + 2);
            if (4 * j4 + 3 < i) s3 += l.w * TGET(4 * j4 + 3);
        }
        float sm = -((s0 + s1) + (s2 + s3));
#ifndef EMU
        asm volatile("" : "+v"(sm));
#endif
        const float v = (i > c) ? sm : (i == c ? 1.f : 0.f);
        if (i < 16) t0[i & 15] = v; else t1[i & 15] = v;
    }
}

DI void seg_info(int g, int& seq, int& b, int& j0) {
    if (g < NSEG_CTX) { seq = 0; b = g / (CTXL / 64); j0 = (g % (CTXL / 64)) * 64; } else { const int g2 = g - NSEG_CTX; seq = 1; b = g2 / (S / 64); j0 = (g2 % (S / 64)) * 64; }
}
DI const bf16_t* seq_row(const Params& p, int seq, int b, int j, bool scan_order) {
    if (seq) { const int l = scan_order ? (j % ROWS) * GW + j / ROWS : j; return (const bf16_t*)(p.ws + WS_PLAT) + (size_t)(b * S + l) * IN_COLS; }
    return (const bf16_t*)(p.ws + WS_PCTX) + (size_t)(b * CTXL + j) * CTX_COLS;
}
DI void phase_halo(const Params& p, char* smem) {
    if (USE_G8) return;
    const int tid = tid_x(), lane = tid & 63, wave = tid >> 6;
    const int gw = blockIdx.x * 8 + wave, ngw = gridDim.x * 8;
    bf16_t* HA = (bf16_t*)(p.ws + WS_HALO_A); bf16_t* HB = (bf16_t*)(p.ws + WS_HALO_B);
    for (int it = gw; it < NSEG * 6; it += ngw) {
        const int g = it / 6, hr = it % 6; int seq, b, j0; seg_info(g, seq, b, j0);
        const int L = seq ? S : CTXL;
        if (hr < 4) {
            const int j = hr < 2 ? j0 - 2 + hr : j0 + 62 + hr; const bool ok = j >= 0 && j < L;
            const bf16_t* src = seq_row(p, seq, b, ok ? j : 0, false);
            for (int c = lane; c < 192; c += 64) { u32x4 v = {0u, 0u, 0u, 0u}; if (ok) v = *(const u32x4*)(src + c * 8); *(u32x4*)(HA + ((size_t)g * 4 + hr) * 1536 + c * 8) = v; }
        } else {
            const int j = hr == 4 ? j0 - 1 : j0 + 64; const bool ok = j >= 0 && j < L;
            const bf16_t* src = seq_row(p, seq, b, ok ? j : 0, true) + COL_B0;
            for (int c = lane; c < 240; c += 64) { u32x4 v = {0u, 0u, 0u, 0u}; if (ok) v = *(const u32x4*)(src + c * 8); *(u32x4*)(HB + ((size_t)g * 2 + (hr - 4)) * 1920 + c * 8) = v; }
        }
    }
}
DI f32x2_ac unpk2(unsigned w) { return (f32x2_ac){bf2f((bf16_t)(w & 0xffffu)), bf2f((bf16_t)(w >> 16))}; }
DI void unpack8(const u32x4& q, float (&f)[8]) {
    f[0] = bf2f((bf16_t)(q.x & 0xffffu)); f[1] = bf2f((bf16_t)(q.x >> 16)); f[2] = bf2f((bf16_t)(q.y & 0xffffu)); f[3] = bf2f((bf16_t)(q.y >> 16));
    f[4] = bf2f((bf16_t)(q.z & 0xffffu)); f[5] = bf2f((bf16_t)(q.z >> 16)); f[6] = bf2f((bf16_t)(q.w & 0xffffu)); f[7] = bf2f((bf16_t)(q.w >> 16));
}
DI float row16_sum(float v) {
#ifdef EMU
    v += __shfl_xor(v, 1); v += __shfl_xor(v, 2); v += __shfl_xor(v, 4); v += __shfl_xor(v, 8); return v;
#else
    v = DPP_ADD(v, 0xB1); v = DPP_ADD(v, 0x4E); v = DPP_ADD(v, 0x141); v = DPP_ADD(v, 0x140); return v;
#endif
}
DI void phase_fir(const Params& p, char* smem) {
    const int tid = tid_x(), lane = tid & 63, wave = tid >> 6;
    const int gw = blockIdx.x * 8 + wave, ngw = gridDim.x * 8;
    const bf16_t* HA = (const bf16_t*)(p.ws + WS_HALO_A); const bf16_t* HB = (const bf16_t*)(p.ws + WS_HALO_B);
    constexpr int NA = NSEG * 3, NBI = NSEG * 4;
    const u32x4 z4 = {0u, 0u, 0u, 0u};
    for (int it = gw; it < NA + NBI; it += ngw) {
        if (it < NA) {
            const int g = it / 3, s = it % 3; int seq, b, j0; seg_info(g, seq, b, j0);
            const int col = s * 512 + 8 * lane, ldp = seq ? IN_COLS : CTX_COLS;
            bf16_t* base = (bf16_t*)seq_row(p, seq, b, j0, false) + col;
            const bf16_t* hal = HA + (size_t)g * 4 * 1536 + col;
            float cw[5][8];
#pragma unroll
            for (int t = 0; t < 5; ++t) { const f32x4 w0 = *(const f32x4*)(p.in[I_CONV] + t * 1536 + col), w1 = *(const f32x4*)(p.in[I_CONV] + t * 1536 + col + 4);
                cw[t][0] = w0.x; cw[t][1] = w0.y; cw[t][2] = w0.z; cw[t][3] = w0.w; cw[t][4] = w1.x; cw[t][5] = w1.y; cw[t][6] = w1.z; cw[t][7] = w1.w; }
            u32x4 win[12], nxt[8];
            win[0] = *(const u32x4*)(hal); win[1] = *(const u32x4*)(hal + 1536);
            win[2] = *(const u32x4*)(base); win[3] = *(const u32x4*)(base + ldp);
#pragma unroll
            for (int i = 0; i < 8; ++i) win[4 + i] = *(const u32x4*)(base + (size_t)(2 + i) * ldp);
#pragma unroll 1
            for (int blk = 0; blk < 8; ++blk) {
                if (blk < 7) {
#pragma unroll
                    for (int i = 0; i < 8; ++i) { const int t = 8 * blk + 10 + i; nxt[i] = t < 64 ? *(const u32x4*)(base + (size_t)t * ldp) : *(const u32x4*)(hal + (size_t)(2 + (t - 64)) * 1536); }
                }
#pragma unroll
                for (int i = 0; i < 8; ++i) {
                    float a[8];
#pragma unroll
                    for (int e = 0; e < 8; ++e) a[e] = 0.f;
#pragma unroll
                    for (int t = 0; t < 5; ++t) { float x[8]; unpack8(win[i + t], x);
#pragma unroll
                        for (int e = 0; e < 8; ++e) a[e] += x[e] * cw[t][e]; }
                    float ss = 0.f;
#pragma unroll
                    for (int e = 0; e < 8; ++e) { a[e] = fsilu(a[e]); ss += a[e] * a[e]; }
                    if (s < 2) { const float sc = frsq(row16_sum(ss) + 1e-6f) * (s == 0 ? 0.08838834764831845f : 1.0f);
#pragma unroll
                        for (int e = 0; e < 8; ++e) a[e] *= sc; }
                    u32x4 o; o.x = pk2(a[0], a[1]); o.y = pk2(a[2], a[3]); o.z = pk2(a[4], a[5]); o.w = pk2(a[6], a[7]);
                    *(u32x4*)(base + (size_t)(8 * blk + i) * ldp) = o;
                }
#pragma unroll
                for (int i = 0; i < 4; ++i) win[i] = win[8 + i];
#pragma unroll
                for (int i = 0; i < 8; ++i) win[4 + i] = nxt[i];
            }
        } else {
            const int it2 = it - NA, g = it2 / 4, sl = it2 % 4; int seq, b, j0; seg_info(g, seq, b, j0);
            const int bcol = sl * 512 + 8 * lane; const bool act = bcol < 1920;
            const int bc = act ? bcol : 0, col = COL_B0 + bc;
            float mu8[8];
            { const f32x4 m0 = *(const f32x4*)(p.in[I_MU] + bc), m1 = *(const f32x4*)(p.in[I_MU] + bc + 4); mu8[0] = m0.x; mu8[1] = m0.y; mu8[2] = m0.z; mu8[3] = m0.w; mu8[4] = m1.x; mu8[5] = m1.y; mu8[6] = m1.z; mu8[7] = m1.w; }
            const bool th = (bc >= 1536 && bc < 1664);
            const bf16_t* hal = HB + (size_t)g * 2 * 1920 + bc;
            u32x4 win[10], nxt[8];
            win[0] = *(const u32x4*)(hal); win[1] = *(const u32x4*)(seq_row(p, seq, b, j0, true) + col);
#pragma unroll
            for (int i = 0; i < 8; ++i) win[2 + i] = *(const u32x4*)(seq_row(p, seq, b, j0 + 1 + i, true) + col);
#pragma unroll 1
            for (int blk = 0; blk < 8; ++blk) {
                if (blk < 7) {
#pragma unroll
                    for (int i = 0; i < 8; ++i) { const int t = 8 * blk + 9 + i; nxt[i] = t < 64 ? *(const u32x4*)(seq_row(p, seq, b, j0 + t, true) + col) : *(const u32x4*)(hal + 1920); }
                }
#pragma unroll
                for (int i = 0; i < 8; ++i) {
                    float pv[8], cu[8], nx[8], x[8]; unpack8(win[i], pv); unpack8(win[i + 1], cu); unpack8(win[i + 2], nx);
#pragma unroll
                    for (int e = 0; e < 8; ++e) { x[e] = cu[e] + (0.5f * (pv[e] + nx[e]) - cu[e]) * mu8[e]; if (th) x[e] = ftanh(x[e]); }
                    u32x4 o; o.x = pk2(x[0], x[1]); o.y = pk2(x[2], x[3]); o.z = pk2(x[4], x[5]); o.w = pk2(x[6], x[7]);
                    if (act) *(u32x4*)((bf16_t*)seq_row(p, seq, b, j0 + 8 * blk + i, true) + col) = o;
                }
                win[0] = win[8]; win[1] = win[9];
#pragma unroll
                for (int i = 0; i < 8; ++i) win[2 + i] = nxt[i];
            }
        }
    }
}

constexpr int GC = 32;
constexpr int G_NT = (CTXL + S) / GC;
constexpr int LD128 = 136, LD64 = 72, LD32 = 40;
DI void chunk_pos(int x, int d, int& seg, int& j0) {
    constexpr int n0 = CTXL / GC, n1 = S / GC;
    if (x < n0) { seg = 0; j0 = (d ? n0 - 1 - x : x) * GC; } else { seg = 1; const int xx = x - n0; j0 = (d ? n1 - 1 - xx : xx) * GC; }
}

template <class Emit>
DI void invert32_blocked(const float* Lf, bf16_t* scr, int lane, Emit emit) {
    bf16_t* T00T = scr; bf16_t* T11R = scr + 16 * LD32; bf16_t* L10R = scr + 2 * 16 * LD32; bf16_t* P1T = scr + 3 * 16 * LD32;
    const int blk = lane >> 5, c = lane & 15, r = lane & 31, fr = lane & 15, fq = lane >> 4;
    f32x16 t;
    const float* Lb = Lf + (16 * blk) * 32 + 16 * blk;
#pragma unroll
    for (int i = 0; i < 16; ++i) {
        float s0 = 0.f, s1 = 0.f, s2 = 0.f, s3 = 0.f;
#pragma unroll
        for (int j4 = 0; j4 < (i + 3) / 4; ++j4) {
            const f32x4 l = *(const f32x4*)(Lb + i * 32 + 4 * j4);
            if (4 * j4 + 0 < i) s0 += l.x * t[4 * j4 + 0];
            if (4 * j4 + 1 < i) s1 += l.y * t[4 * j4 + 1];
            if (4 * j4 + 2 < i) s2 += l.z * t[4 * j4 + 2];
            if (4 * j4 + 3 < i) s3 += l.w * t[4 * j4 + 3];
        }
        float sm = -((s0 + s1) + (s2 + s3));
#ifndef EMU
        asm volatile("" : "+v"(sm));
#endif
        t[i] = (i > c) ? sm : (i == c ? 1.f : 0.f);
    }
    if (r < 16) {
        if (blk == 0) {
#pragma unroll
            for (int q = 0; q < 4; ++q) { u32x2 o; o.x = pk2(t[4 * q], t[4 * q + 1]); o.y = pk2(t[4 * q + 2], t[4 * q + 3]); *(u32x2*)(T00T + c * LD32 + 4 * q) = o; }
        } else {
#pragma unroll
            for (int i = 0; i < 16; ++i) T11R[i * LD32 + c] = f2bf(t[i]);
        }
    }
    { const int i = lane >> 2, j4 = (lane & 3) * 4; const f32x4 l = *(const f32x4*)(Lf + (16 + i) * 32 + j4);
      u32x2 o; o.x = pk2(l.x, l.y); o.y = pk2(l.z, l.w); *(u32x2*)(L10R + i * LD32 + j4) = o; }
    WAVE_SYNC();
    const bf16x8 zf = {0, 0, 0, 0, 0, 0, 0, 0};
    f32x4 p1 = {0.f, 0.f, 0.f, 0.f};
    {
        const bf16x8 af = fq < 2 ? *(const bf16x8*)(L10R + fr * LD32 + 8 * fq) : zf, bfm = fq < 2 ? *(const bf16x8*)(T00T + fr * LD32 + 8 * fq) : zf;
        p1 = MFMA16(af, bfm, p1);
    }
    { u32x2 o; o.x = pk2(p1[0], p1[1]); o.y = pk2(p1[2], p1[3]); *(u32x2*)(P1T + fr * LD32 + 4 * fq) = o; }
    WAVE_SYNC();
    f32x4 p2 = {0.f, 0.f, 0.f, 0.f};
    {
        const bf16x8 af = fq < 2 ? *(const bf16x8*)(T11R + fr * LD32 + 8 * fq) : zf, bfm = fq < 2 ? *(const bf16x8*)(P1T + fr * LD32 + 8 * fq) : zf;
        p2 = MFMA16(af, bfm, p2);
    }
#pragma unroll
    for (int j = 0; j < 4; ++j) emit(16 + 4 * fq + j, fr, -p2[j]);
    if (r < 16) {
#pragma unroll
        for (int i = 0; i < 16; ++i) { emit(16 * blk + i, 16 * blk + c, t[i]); if (blk == 0) emit(i, 16 + c, 0.f); }
    }
}
DI float half_sum(float v, int hh) {
#ifdef EMU
    v += __shfl_xor(v, 1); v += __shfl_xor(v, 2); v += __shfl_xor(v, 4); v += __shfl_xor(v, 8); v += __shfl_xor(v, 16); return v;
#else
    v = DPP_ADD(v, 0xB1); v = DPP_ADD(v, 0x4E); v = DPP_ADD(v, 0x141); v = DPP_ADD(v, 0x140);
    const int iv = __builtin_bit_cast(int, v);
    const float s0 = __builtin_bit_cast(float, __builtin_amdgcn_readlane(iv, 0)) + __builtin_bit_cast(float, __builtin_amdgcn_readlane(iv, 16));
    const float s1 = __builtin_bit_cast(float, __builtin_amdgcn_readlane(iv, 32)) + __builtin_bit_cast(float, __builtin_amdgcn_readlane(iv, 48));
    return hh ? s1 : s0;
#endif
}
constexpr int GL_Q = 0;
constexpr int GL_KT = GL_Q + 3 * 32 * LD128 * 2;
constexpr int GL_VT = GL_KT + 3 * 128 * LD32 * 2;
constexpr int GL_K = GL_VT + 3 * 128 * LD32 * 2;
constexpr int GL_QKM = GL_K + 32 * LD128 * 2;
constexpr int GL_LF = GL_QKM + 2 * 32 * LD32 * 2;
constexpr int GL_TP = GL_LF + 32 * 32 * 4;
constexpr int GL_TPP = GL_TP + 32 * LD32 * 2;
constexpr int GL_WN = GL_TPP + 2 * 32 * LD32 * 2;
constexpr int GL_SC = GL_WN + 32 * LD128 * 2;
constexpr int GL_GC = GL_SC + 2 * 8 * 32 * 4;
constexpr int GL_INV = GL_GC + 8 * 32 * 4;
constexpr int GL_RAW = GL_INV + 4 * 16 * LD32 * 2;
constexpr int GL_END = GL_RAW + 32 * 384 * 2;
static_assert(GL_END <= LDS_BYTES, "gdn lds");

DI void gdn_chain2(const Params& p, char* smem, int item) {
    const int d = item / (NB * H_A), b = (item / H_A) % NB, h = item % H_A;
    const int tid = tid_x(), lane = tid & 63, wave0_ = tid >> 6;
    bf16_t* Qs = (bf16_t*)(smem + GL_Q); bf16_t* KTs = (bf16_t*)(smem + GL_KT); bf16_t* VTs = (bf16_t*)(smem + GL_VT); bf16_t* Ks = (bf16_t*)(smem + GL_K);
    bf16_t* QKMs = (bf16_t*)(smem + GL_QKM); float* Lf = (float*)(smem + GL_LF); bf16_t* Tp = (bf16_t*)(smem + GL_TP); bf16_t* Tpp = (bf16_t*)(smem + GL_TPP);
    bf16_t* Wn = (bf16_t*)(smem + GL_WN); float* SC = (float*)(smem + GL_SC); float* GCs = (float*)(smem + GL_GC);
    const float alog = p.in[I_ALOG][d * 4 + h], dtb = p.in[I_DTB][d * 4 + h], negea = -expf(alog);
    bf16_t* ODIR = (bf16_t*)(p.ws + WS_OA);
    __syncthreads();
    f32x16 St[4];
#pragma unroll
    for (int ct = 0; ct < 4; ++ct) St[ct] = zero16();
    bf16_t* RAW = (bf16_t*)(smem + GL_RAW);
    float pa = 0.f, pbt = 0.f;
    auto prefetch = [&](int x, int wsel, int nw) {
        int seg, j0; chunk_pos(x, d, seg, j0);
        const int ldp = seg ? IN_COLS : CTX_COLS;
        const bf16_t* pbase = seg ? (const bf16_t*)(p.ws + WS_PLAT) + (size_t)b * S * IN_COLS : (const bf16_t*)(p.ws + WS_PCTX) + (size_t)b * CTXL * CTX_COLS;
        for (int inst = wsel; inst < 24; inst += nw) {
            const int q = inst * 64 + lane, row = q / 48, c16 = q % 48;
            const bf16_t* src = pbase + (size_t)(j0 + row) * ldp + (c16 >> 4) * 512 + h * 128 + (c16 & 15) * 8;
#ifdef EMU
            emu_global_load_lds16(src, (char*)RAW + q * 16);
#else
            __builtin_amdgcn_global_load_lds((const unsigned*)src, (__attribute__((address_space(3))) unsigned*)((char*)RAW + q * 16), 16, 0, 0);
#endif
        }
    };
    auto prefetch_ab = [&](int x, int g0, int ng) {
        int seg, j0; chunk_pos(x, d, seg, j0);
        const float* abbase = (const float*)(p.ws + WS_AB) + (size_t)(seg ? T_CTX + b * S : b * CTXL) * 16;
        if (lane < 4 * ng) { const int j = j0 + 4 * g0 + lane; pa = abbase[(size_t)j * 16 + d * 4 + h]; pbt = abbase[(size_t)j * 16 + 8 + d * 4 + h]; }
    };
    auto x1 = [&](int c, int g0, int ng) {
        const int q3 = c % 3, parc = c & 1;
        for (int gi = 0; gi < ng; ++gi) {
            const int g = g0 + gi;
            const int i0 = d ? (GC - 4 - 4 * g) : 4 * g;
            bf16_t kt[2][4], vt[2][4];
#pragma unroll
            for (int t = 0; t < 4; ++t) {
                const int e = d ? 3 - t : t, i = i0 + e;
                const unsigned wq = *(const unsigned*)(RAW + (4 * g + t) * 384 + 2 * lane), wk = *(const unsigned*)(RAW + (4 * g + t) * 384 + 128 + 2 * lane), wv = *(const unsigned*)(RAW + (4 * g + t) * 384 + 256 + 2 * lane);
                *(unsigned*)(Qs + (q3 * 32 + i) * LD128 + 2 * lane) = wq;
                *(unsigned*)(Ks + i * LD128 + 2 * lane) = wk;
                kt[0][e] = (bf16_t)(wk & 0xffffu); kt[1][e] = (bf16_t)(wk >> 16); vt[0][e] = (bf16_t)(wv & 0xffffu); vt[1][e] = (bf16_t)(wv >> 16);
            }
#pragma unroll
            for (int q = 0; q < 2; ++q) {
                u32x2 o; o.x = (unsigned)kt[q][0] | ((unsigned)kt[q][1] << 16); o.y = (unsigned)kt[q][2] | ((unsigned)kt[q][3] << 16);
                *(u32x2*)(KTs + (q3 * 128 + 2 * lane + q) * LD32 + i0) = o;
                u32x2 o2; o2.x = (unsigned)vt[q][0] | ((unsigned)vt[q][1] << 16); o2.y = (unsigned)vt[q][2] | ((unsigned)vt[q][3] << 16);
                *(u32x2*)(VTs + (q3 * 128 + 2 * lane + q) * LD32 + i0) = o2;
            }
        }
        if (lane < 4 * ng) { const int jo = 4 * g0 + lane; const int i = d ? (GC - 1 - jo) : jo;
            SC[(parc * 8 + 0) * 32 + i] = negea * fsoftplus(pa + dtb); SC[(parc * 8 + 1) * 32 + i] = fsigmoid(pbt); }
    };
    prefetch(0, wave0_, 8); prefetch_ab(0, wave0_, 1);
#ifndef EMU
    asm volatile("s_waitcnt vmcnt(0)" ::: "memory");
#endif
    const int r0_ = lane & 31, hh0_ = lane >> 5;
    __syncthreads();
    x1(0, wave0_, 1);
    LDS_BARRIER();
    for (int it = -1; it < G_NT; ++it) {
        int r = r0_, hh = hh0_, wave = wave0_;
#ifndef EMU
        asm volatile("" : "+v"(r), "+v"(hh), "+v"(wave));
#endif
        const int xn = it + 1, par = xn & 1, q3 = xn % 3;
        const int g0w = 3 * (wave - 4), ngw = wave == 6 ? 2 : 3;
        if (wave >= 4 && wave < 7 && xn + 1 < G_NT) {
            prefetch(xn + 1, wave - 4, 3); prefetch_ab(xn + 1, g0w, ngw);
#ifndef EMU
            asm volatile("s_waitcnt vmcnt(0)" ::: "memory");
#endif
        }
        if (xn < G_NT) {
            const float* graw = SC + (par * 8 + 0) * 32;
            float gcv = 0.f;
#pragma unroll
            for (int s4 = 0; s4 < 8; ++s4) { const f32x4 g4 = *(const f32x4*)(graw + 4 * s4);
                gcv += (4 * s4 + 0 <= r ? g4.x : 0.f) + (4 * s4 + 1 <= r ? g4.y : 0.f) + (4 * s4 + 2 <= r ? g4.z : 0.f) + (4 * s4 + 3 <= r ? g4.w : 0.f); }
            if (lane < 32) GCs[wave * 32 + r] = gcv;
            if (wave == 7 && lane < 32) {
                float gl = 0.f;
#pragma unroll
                for (int s4 = 0; s4 < 8; ++s4) { const f32x4 g4 = *(const f32x4*)(graw + 4 * s4); gl += (g4.x + g4.y) + (g4.z + g4.w); }
                const float be = SC[(par * 8 + 1) * 32 + r];
                SC[(par * 8 + 3) * 32 + r] = fexp(gcv); SC[(par * 8 + 4) * 32 + r] = fexp(gl - gcv); SC[(par * 8 + 5) * 32 + r] = be * fexp(gcv); SC[(par * 8 + 6) * 32 + r] = fexp(gl);
            }
            const int pr = wave >> 2, th = (wave >> 1) & 1, ch = wave & 1, fr = lane & 15, fq = lane >> 4;
            const bf16_t* arow = (pr == 0 ? Ks : Qs + q3 * 32 * LD128) + (16 * th + fr) * LD128 + 8 * fq; const bf16_t* brow = Ks + (16 * ch + fr) * LD128 + 8 * fq;
            f32x4 cc = {0.f, 0.f, 0.f, 0.f};
#pragma unroll
            for (int ks = 0; ks < 4; ++ks) cc = MFMA16(*(const bf16x8*)(arow + 32 * ks), *(const bf16x8*)(brow + 32 * ks), cc);
            WAVE_SYNC();
            const int jj = 16 * ch + fr; const float gj = GCs[wave * 32 + jj];
#pragma unroll
            for (int j = 0; j < 4; ++j) {
                const int i = 16 * th + 4 * fq + j; const float dec = fexp(GCs[wave * 32 + i] - gj);
                if (pr == 0) Lf[i * 32 + jj] = (jj < i) ? SC[(par * 8 + 1) * 32 + i] * cc[j] * dec : 0.f;
                else QKMs[(par * 32 + i) * LD32 + jj] = f2bf((jj <= i) ? cc[j] * dec : 0.f);
            }
        }
        LDS_BARRIER();
        if (wave == 7 && xn < G_NT) {
            const float* sb1 = SC + (par * 8 + 5) * 32; const float* sb0 = SC + (par * 8 + 1) * 32; bf16_t* Tppw = Tpp + par * 32 * LD32;
            invert32_blocked(Lf, (bf16_t*)(smem + GL_INV), lane, [&](int i, int c, float v) { Tp[i * LD32 + c] = f2bf(v * sb1[c]); Tppw[i * LD32 + c] = f2bf(v * sb0[c]); });
        }
        if (wave >= 4 && wave < 7 && xn + 1 < G_NT) x1(xn + 1, g0w, ngw);
        if (wave < 4 && it >= 0) {
            const int pc = it & 1, qc = it % 3; int seg = 0, j0 = 0; chunk_pos(it, d, seg, j0);
            const bf16_t* Qc = Qs + qc * 32 * LD128; const bf16_t* KTc = KTs + qc * 128 * LD32; const bf16_t* VTc = VTs + qc * 128 * LD32;
            const bf16_t* QKc = QKMs + pc * 32 * LD32; const bf16_t* Tc = Tpp + pc * 32 * LD32; const float* sc = SC + pc * 8 * 32;
            f32x16 vn = zero16();
#pragma unroll
            for (int s = 0; s < 2; ++s) vn = MFMA32(ld_nat(Tc + r * LD32, s, hh), ld_nat(VTc + (32 * wave + r) * LD32, s, hh), vn);
            f32x16 oacc = zero16();
#define GDN_KSTEP(s) { const bf16x8 sb = pack_acc<(s) & 1>(St[(s) >> 1]); vn = MFMA32(ld_perm(Wn + r * LD128, (s), hh), sb, vn); oacc = MFMA32(ld_perm(Qc + r * LD128, (s), hh), sb, oacc); }
            GDN_KSTEP(0) GDN_KSTEP(1) GDN_KSTEP(2) GDN_KSTEP(3) GDN_KSTEP(4) GDN_KSTEP(5) GDN_KSTEP(6) GDN_KSTEP(7)
#undef GDN_KSTEP
#pragma unroll
            for (int g = 0; g < 16; ++g) oacc[g] *= sc[3 * 32 + crow(g, hh)];
            { const bf16x8 v0 = pack_acc<0>(vn), v1 = pack_acc<1>(vn);
              oacc = MFMA32(ld_perm(QKc + r * LD32, 0, hh), v0, oacc); oacc = MFMA32(ld_perm(QKc + r * LD32, 1, hh), v1, oacc); }
#pragma unroll
            for (int g = 0; g < 16; ++g) vn[g] *= sc[4 * 32 + crow(g, hh)];
            const float ge = sc[6 * 32];
            { const bf16x8 v0 = pack_acc<0>(vn), v1 = pack_acc<1>(vn);
#pragma unroll
              for (int ct = 0; ct < 4; ++ct) {
#pragma unroll
                  for (int g = 0; g < 16; ++g) St[ct][g] *= ge;
                  St[ct] = MFMA32(ld_perm(KTc + (32 * ct + r) * LD32, 0, hh), v0, St[ct]);
                  St[ct] = MFMA32(ld_perm(KTc + (32 * ct + r) * LD32, 1, hh), v1, St[ct]);
              } }
            if (seg) {
#pragma unroll
                for (int g = 0; g < 16; ++g) {
                    const int i = crow(g, hh), j = d ? j0 + GC - 1 - i : j0 + i;
                    ODIR[((size_t)d * T_LAT + (size_t)b * S + j) * 512 + h * 128 + 32 * wave + r] = f2bf(oacc[g]);
                }
            }
        }
        LDS_BARRIER();
        if (xn < G_NT && wave < 4) {
            f32x16 acc = zero16();
#pragma unroll
            for (int s = 0; s < 2; ++s) acc = MFMA32(ld_nat(KTs + (q3 * 128 + 32 * wave + r) * LD32, s, hh), ld_nat(Tp + r * LD32, s, hh), acc);
#pragma unroll
            for (int q = 0; q < 4; ++q) {
                u32x2 o; o.x = pk2(-acc[4 * q], -acc[4 * q + 1]); o.y = pk2(-acc[4 * q + 2], -acc[4 * q + 3]);
                *(u32x2*)(Wn + r * LD128 + 32 * wave + 8 * q + 4 * hh) = o;
            }
        }
        LDS_BARRIER();
    }
}

constexpr int RL_RX = 0;
constexpr int RL_KX = RL_RX + 32 * 64 * 2;
constexpr int RL_VX = RL_KX + 32 * 64 * 2;
constexpr int RL_KK = RL_VX + 32 * 64 * 2;
constexpr int RL_LW = RL_KK + 32 * 64 * 4;
constexpr int RL_IC = RL_LW + 32 * 64 * 4;
constexpr int RL_PC = RL_IC + 32 * 64 * 4;
constexpr int RL_CST = RL_PC + 2 * 64 * 4;
constexpr int RL_TW = RL_CST + 4 * 64 * 4;
constexpr int RL_AL = RL_TW + 32 * LD64 * 2;
constexpr int RL_LF = RL_AL + 32 * LD64 * 2;
constexpr int RL_LAKT = RL_LF + 32 * 32 * 4;
constexpr int RL_TB = RL_LAKT + 32 * LD32 * 2;
constexpr int RL_W2T = RL_TB + 32 * LD32 * 2;
constexpr int RL_A2T = RL_W2T + 64 * LD64 * 2;
constexpr int RL_AR = RL_A2T + 64 * LD64 * 2;
constexpr int RL_BR = RL_AR + 32 * LD64 * 2;
constexpr int RL_KR = RL_BR + 32 * LD64 * 2;
constexpr int RL_RR = RL_KR + 32 * LD64 * 2;
constexpr int RL_AT = RL_RR + 2 * 32 * LD64 * 2;
constexpr int RL_BHT = RL_AT + 64 * LD32 * 2;
constexpr int RL_KHT = RL_BHT + 2 * 64 * LD32 * 2;
constexpr int RL_VT = RL_KHT + 2 * 64 * LD32 * 2;
constexpr int RL_MRB = RL_VT + 2 * 64 * LD32 * 2;
constexpr int RL_MRK = RL_MRB + 2 * 32 * LD32 * 2;
constexpr int RL_WM = RL_MRK + 2 * 32 * LD32 * 2;
constexpr int RL_TL = RL_WM + 32 * LD64 * 2;
constexpr int RL_END = RL_TL + 32 * LD32 * 2;
static_assert(RL_END <= LDS_BYTES, "rwkv lds");
static_assert(4 * 16 * LD32 * 2 <= 2 * 32 * LD64 * 2, "inversion scratch over AR/BR");

DI void rwkv_chain2(const Params& p, char* smem, int item) {
    const int d = item / (NB * H_B), b = (item / H_B) % NB, h = item % H_B;
    const int tid = tid_x(), lane = tid & 63, wave = tid >> 6;
    bf16_t* RX = (bf16_t*)(smem + RL_RX); bf16_t* KX = (bf16_t*)(smem + RL_KX); bf16_t* VX = (bf16_t*)(smem + RL_VX); float* KKs = (float*)(smem + RL_KK);
    float* LW = (float*)(smem + RL_LW); float* IC = (float*)(smem + RL_IC); float* Lf = (float*)(smem + RL_LF); float* PC = (float*)(smem + RL_PC); float* CST = (float*)(smem + RL_CST);
    bf16_t* TW = (bf16_t*)(smem + RL_TW); bf16_t* AL = (bf16_t*)(smem + RL_AL); bf16_t* W2T = (bf16_t*)(smem + RL_W2T); bf16_t* A2T = (bf16_t*)(smem + RL_A2T);
    bf16_t* Ar = (bf16_t*)(smem + RL_AR); bf16_t* Br = (bf16_t*)(smem + RL_BR); bf16_t* Kr = (bf16_t*)(smem + RL_KR); bf16_t* Rr = (bf16_t*)(smem + RL_RR);
    bf16_t* AT = (bf16_t*)(smem + RL_AT); bf16_t* BhT = (bf16_t*)(smem + RL_BHT); bf16_t* KhT = (bf16_t*)(smem + RL_KHT); bf16_t* VT = (bf16_t*)(smem + RL_VT);
    bf16_t* LakT = (bf16_t*)(smem + RL_LAKT); bf16_t* Mrb = (bf16_t*)(smem + RL_MRB); bf16_t* Mrk = (bf16_t*)(smem + RL_MRK); bf16_t* Tb = (bf16_t*)(smem + RL_TB);
    bf16_t* Wm = (bf16_t*)(smem + RL_WM); bf16_t* TLm = (bf16_t*)(smem + RL_TL);
    bf16_t* YDIR = (bf16_t*)(p.aux + AUX_YDIR); float* BON = (float*)(p.ws + WS_BONUS);
    __syncthreads();
    for (int i = tid; i < 64 * 64; i += NTHREADS) {
        const int c = i >> 6, rr = i & 63;
        W2T[c * LD64 + rr] = f2bf(p.in[I_W2][((size_t)d * 64 + rr) * 512 + h * 64 + c]); A2T[c * LD64 + rr] = f2bf(p.in[I_A2][((size_t)d * 64 + rr) * 512 + h * 64 + c]);
    }
    if (tid < 256) { const int w = tid >> 6, c = tid & 63, gc = h * 64 + c;
        CST[tid] = w == 0 ? p.in[I_W0][d * 512 + gc] : (w == 1 ? p.in[I_A0][d * 512 + gc] : (w == 2 ? p.in[I_KA][gc] : p.in[I_RK][gc])); }
    const float kkw0 = p.in[I_KK][h * 64 + 2 * (lane & 31)], kkw1 = p.in[I_KK][h * 64 + 2 * (lane & 31) + 1];
    f32x16 Xt[2]; Xt[0] = zero16(); Xt[1] = zero16();
    unsigned rawv[4][5];
    auto prefetch = [&](int x, int w) {
        int seg, j0; chunk_pos(x, d, seg, j0);
        const int ldp = seg ? IN_COLS : CTX_COLS;
        const bf16_t* pb = seg ? (const bf16_t*)(p.ws + WS_PLAT) + (size_t)b * S * IN_COLS : (const bf16_t*)(p.ws + WS_PCTX) + (size_t)b * CTXL * CTX_COLS;
#pragma unroll
        for (int k = 0; k < 4; ++k) {
            const int pi = (w - 2) + 5 * k;
            if (pi < GC / 2) {
                const int j = j0 + 2 * pi + (lane >> 5); const int row = seg ? (j % ROWS) * GW + j / ROWS : j;
#pragma unroll
                for (int s = 0; s < 5; ++s) {
                    const int bcol = (s < 3 ? s * 512 + h * 64 : (s == 3 ? 1536 + d * 64 : 1664 + d * 64)) + 2 * (lane & 31);
                    rawv[k][s] = *(const unsigned*)(pb + (size_t)row * ldp + COL_B0 + bcol);
                }
            }
        }
    };
    auto y1 = [&](int w) {
#pragma unroll
        for (int k = 0; k < 4; ++k) {
            const int pi = (w - 2) + 5 * k;
            if (pi < GC / 2) {
                const int jo = 2 * pi + (lane >> 5), i = d ? (GC - 1 - jo) : jo, c2 = 2 * (lane & 31);
                const float kx0 = bf2f((bf16_t)(rawv[k][1] & 0xffffu)) * kkw0, kx1 = bf2f((bf16_t)(rawv[k][1] >> 16)) * kkw1;
                const float rs = frsq(half_sum(kx0 * kx0 + kx1 * kx1, lane >> 5) + 1e-6f);
                *(unsigned*)(RX + i * 64 + c2) = rawv[k][0]; *(unsigned*)(KX + i * 64 + c2) = rawv[k][1]; *(unsigned*)(VX + i * 64 + c2) = rawv[k][2];
                KKs[i * 64 + c2] = kx0 * rs; KKs[i * 64 + c2 + 1] = kx1 * rs;
                *(unsigned*)(TW + i * LD64 + c2) = rawv[k][3]; *(unsigned*)(AL + i * LD64 + c2) = rawv[k][4];
            }
        }
    };
    if (wave >= 2 && wave < 7) prefetch(0, wave);
    const int r0_ = lane & 31, hh0_ = lane >> 5;
    __syncthreads();
    if (wave >= 2 && wave < 7) y1(wave);
    LDS_BARRIER();
    for (int it = -1; it < G_NT; ++it) {
        int r = r0_, hh = hh0_;
#ifndef EMU
        asm volatile("" : "+v"(r), "+v"(hh));
#endif
        const int xn = it + 1, par = xn & 1;
        int segn = 0, j0n = 0; if (xn < G_NT) chunk_pos(xn, d, segn, j0n);
        if (wave >= 2 && wave < 7 && xn + 1 < G_NT) prefetch(xn + 1, wave);
        if (xn < G_NT) {
            const int which = wave >> 2, cg = wave & 3, fr = lane & 15, fq = lane >> 4;
            const bf16_t* arow0 = (which ? AL : TW) + fr * LD64 + 8 * fq; const bf16_t* brow = (which ? A2T : W2T) + (16 * cg + fr) * LD64 + 8 * fq;
            f32x4 c0 = {0.f, 0.f, 0.f, 0.f}, c1 = {0.f, 0.f, 0.f, 0.f};
#pragma unroll
            for (int ks = 0; ks < 2; ++ks) {
                const bf16x8 bfrag = *(const bf16x8*)(brow + 32 * ks);
                c0 = MFMA16(*(const bf16x8*)(arow0 + 32 * ks), bfrag, c0); c1 = MFMA16(*(const bf16x8*)(arow0 + 16 * LD64 + 32 * ks), bfrag, c1);
            }
            const int c = 16 * cg + fr; const float bias = CST[which * 64 + c];
#pragma unroll
            for (int th = 0; th < 2; ++th)
#pragma unroll
                for (int j = 0; j < 4; ++j) {
                    const int i = 16 * th + 4 * fq + j; const float z = bias + (th ? c1[j] : c0[j]);
                    if (which) IC[i * 64 + c] = fsigmoid(z);
                    else { const float wl = -fsoftplus(-z) - 0.5f; LW[i * 64 + c] = -fexp(wl); }
                }
        }
        LDS_BARRIER();
        if (xn < G_NT) {
            const int c = lane, i0 = 4 * wave;
            const float ka = CST[2 * 64 + c], rk = CST[3 * 64 + c];
            float lpb = 0.f, lpc = 0.f; float lw4[4];
#pragma unroll
            for (int s2 = 0; s2 < 32; ++s2) { const float w = LW[s2 * 64 + c]; lpc += w; if (s2 < i0) lpb += w; }
#pragma unroll
            for (int e = 0; e < 4; ++e) lw4[e] = LW[(i0 + e) * 64 + c];
            bf16_t ta[4], tb[4], tk[4], tv[4]; float bon[4];
            float lprun = lpb;
#pragma unroll
            for (int e = 0; e < 4; ++e) {
                const int i = i0 + e;
                const float lpm = lprun; lprun += lw4[e]; const float lp = lprun;
                const float Pi = fexp(lp), Pm = fexp(lpm), invP = fexp(-lp), PCi = fexp(lpc - lp);
                const float ic = IC[i * 64 + c], kxv = bf2f(KX[i * 64 + c]), kkv = KKs[i * 64 + c], rxv = bf2f(RX[i * 64 + c]); const bf16_t vxb = VX[i * 64 + c];
                const float kd = kxv * (1.f + (ic - 1.f) * ka), bb = kkv * ic, aa = -kkv;
                ta[e] = f2bf(aa * Pm); tb[e] = f2bf(bb * PCi); tk[e] = f2bf(kd * PCi); tv[e] = vxb;
                Ar[i * LD64 + c] = ta[e]; Br[i * LD64 + c] = f2bf(bb * invP); Kr[i * LD64 + c] = f2bf(kd * invP); Rr[(par * 32 + i) * LD64 + c] = f2bf(rxv * Pi);
                bon[e] = wave_sum_fast(rxv * kd * rk);
            }
            { u32x2 o; o.x = (unsigned)ta[0] | ((unsigned)ta[1] << 16); o.y = (unsigned)ta[2] | ((unsigned)ta[3] << 16); *(u32x2*)(AT + c * LD32 + i0) = o; }
            { u32x2 o; o.x = (unsigned)tb[0] | ((unsigned)tb[1] << 16); o.y = (unsigned)tb[2] | ((unsigned)tb[3] << 16); *(u32x2*)(BhT + (par * 64 + c) * LD32 + i0) = o; }
            { u32x2 o; o.x = (unsigned)tk[0] | ((unsigned)tk[1] << 16); o.y = (unsigned)tk[2] | ((unsigned)tk[3] << 16); *(u32x2*)(KhT + (par * 64 + c) * LD32 + i0) = o; }
            { u32x2 o; o.x = (unsigned)tv[0] | ((unsigned)tv[1] << 16); o.y = (unsigned)tv[2] | ((unsigned)tv[3] << 16); *(u32x2*)(VT + (par * 64 + c) * LD32 + i0) = o; }
            if (wave == 7) PC[par * 64 + c] = fexp(lpc);
            if (segn && lane < 4) { const int i = i0 + lane, jj = d ? j0n + GC - 1 - i : j0n + i;
                const float bv = lane == 0 ? bon[0] : (lane == 1 ? bon[1] : (lane == 2 ? bon[2] : bon[3]));
                BON[((size_t)d * T_LAT + (size_t)b * S + (jj % ROWS) * GW + jj / ROWS) * 8 + h] = bv; }
        }
        LDS_BARRIER();
        if (xn < G_NT) {
            const int m = wave >> 1, th = wave & 1, fr = lane & 15, fq = lane >> 4;
            const bf16_t* arow = ((m < 2) ? Ar : Rr + par * 32 * LD64) + (16 * th + fr) * LD64 + 8 * fq; const bf16_t* brow = ((m & 1) ? Kr : Br) + fr * LD64 + 8 * fq;
            f32x4 c0 = {0.f, 0.f, 0.f, 0.f}, c1 = {0.f, 0.f, 0.f, 0.f};
#pragma unroll
            for (int ks = 0; ks < 2; ++ks) {
                const bf16x8 afrag = *(const bf16x8*)(arow + 32 * ks);
                c0 = MFMA16(afrag, *(const bf16x8*)(brow + 32 * ks), c0); c1 = MFMA16(afrag, *(const bf16x8*)(brow + 16 * LD64 + 32 * ks), c1);
            }
#pragma unroll
            for (int ch = 0; ch < 2; ++ch) {
                const f32x4 cc = ch ? c1 : c0; const int ic = 16 * ch + fr; const int t0 = 16 * th + 4 * fq;
                if (m == 0) {
#pragma unroll
                    for (int j = 0; j < 4; ++j) Lf[(t0 + j) * 32 + ic] = (ic < t0 + j) ? -cc[j] : 0.f;
                } else if (m == 1) {
                    u32x2 o; o.x = pk2((ic < t0) ? cc[0] : 0.f, (ic < t0 + 1) ? cc[1] : 0.f); o.y = pk2((ic < t0 + 2) ? cc[2] : 0.f, (ic < t0 + 3) ? cc[3] : 0.f);
                    *(u32x2*)(LakT + ic * LD32 + t0) = o;
                } else {
                    bf16_t* M = (m == 2 ? Mrb : Mrk) + par * 32 * LD32;
#pragma unroll
                    for (int j = 0; j < 4; ++j) M[(t0 + j) * LD32 + ic] = f2bf((ic <= t0 + j) ? cc[j] : 0.f);
                }
            }
        }
        LDS_BARRIER();
        if (wave == 7 && xn < G_NT) {
            invert32_blocked(Lf, (bf16_t*)(smem + RL_AR), lane, [&](int i, int c, float v) { Tb[i * LD32 + c] = f2bf(v); });
        }
        if (wave >= 2 && wave < 7 && xn + 1 < G_NT) y1(wave);
        if (wave < 2 && it >= 0) {
            const int pc = it & 1; int seg = 0, j0 = 0; chunk_pos(it, d, seg, j0);
            const bf16_t* Rc = Rr + pc * 32 * LD64; const bf16_t* BhTc = BhT + pc * 64 * LD32; const bf16_t* KhTc = KhT + pc * 64 * LD32; const bf16_t* VTc = VT + (pc * 64 + 32 * wave + r) * LD32;
            const bf16_t* Mrbc = Mrb + pc * 32 * LD32; const bf16_t* Mrkc = Mrk + pc * 32 * LD32; const float* PCc = PC + pc * 64;
            const bf16x8 vf0 = ld_nat(VTc, 0, hh), vf1 = ld_nat(VTc, 1, hh);
            f32x16 u = zero16(), y = zero16();
            u = MFMA32(ld_nat(TLm + r * LD32, 0, hh), vf0, u); u = MFMA32(ld_nat(TLm + r * LD32, 1, hh), vf1, u);
            y = MFMA32(ld_nat(Mrkc + r * LD32, 0, hh), vf0, y); y = MFMA32(ld_nat(Mrkc + r * LD32, 1, hh), vf1, y);
#define RW_KSTEP(s) { const bf16x8 xb = pack_acc<(s) & 1>(Xt[(s) >> 1]); u = MFMA32(ld_perm(Wm + r * LD64, (s), hh), xb, u); y = MFMA32(ld_perm(Rc + r * LD64, (s), hh), xb, y); }
            RW_KSTEP(0) RW_KSTEP(1) RW_KSTEP(2) RW_KSTEP(3)
#undef RW_KSTEP
            const bf16x8 ub0 = pack_acc<0>(u), ub1 = pack_acc<1>(u);
            y = MFMA32(ld_perm(Mrbc + r * LD32, 0, hh), ub0, y); y = MFMA32(ld_perm(Mrbc + r * LD32, 1, hh), ub1, y);
#pragma unroll
            for (int kt = 0; kt < 2; ++kt) {
#pragma unroll
                for (int g = 0; g < 16; ++g) Xt[kt][g] *= PCc[32 * kt + crow(g, hh)];
                Xt[kt] = MFMA32(ld_perm(BhTc + (32 * kt + r) * LD32, 0, hh), ub0, Xt[kt]); Xt[kt] = MFMA32(ld_perm(BhTc + (32 * kt + r) * LD32, 1, hh), ub1, Xt[kt]);
                Xt[kt] = MFMA32(ld_nat(KhTc + (32 * kt + r) * LD32, 0, hh), vf0, Xt[kt]); Xt[kt] = MFMA32(ld_nat(KhTc + (32 * kt + r) * LD32, 1, hh), vf1, Xt[kt]);
            }
            if (seg) {
#pragma unroll
                for (int g = 0; g < 16; ++g) {
                    const int i = crow(g, hh), jj = d ? j0 + GC - 1 - i : j0 + i;
                    YDIR[((size_t)d * T_LAT + (size_t)b * S + (jj % ROWS) * GW + jj / ROWS) * 512 + h * 64 + 32 * wave + r] = f2bf(y[g]);
                }
            }
        }
        LDS_BARRIER();
        if (xn < G_NT && wave < 3) {
            const bf16_t* arow = (wave < 2) ? AT + (32 * wave + r) * LD32 : LakT + r * LD32;
            f32x16 acc = zero16();
#pragma unroll
            for (int s = 0; s < 2; ++s) acc = MFMA32(ld_nat(arow, s, hh), ld_nat(Tb + r * LD32, s, hh), acc);
#pragma unroll
            for (int q = 0; q < 4; ++q) {
                u32x2 o; o.x = pk2(acc[4 * q], acc[4 * q + 1]); o.y = pk2(acc[4 * q + 2], acc[4 * q + 3]);
                if (wave < 2) *(u32x2*)(Wm + r * LD64 + 32 * wave + 8 * q + 4 * hh) = o; else *(u32x2*)(TLm + r * LD32 + 8 * q + 4 * hh) = o;
            }
        }
        LDS_BARRIER();
    }
}

DI void phase3(const Params& p, char* smem) {
    constexpr int NG = 2 * NB * H_A, NR = 2 * NB * H_B;
    for (int it = blockIdx.x; it < NG; it += gridDim.x) gdn_chain2(p, smem, it);
    for (int it = blockIdx.x; it < NG + NR; it += gridDim.x) if (it >= NG) rwkv_chain2(p, smem, it - NG);
    const int nchain = NG + NR, G = (int)gridDim.x;
    const int tb = G > nchain ? (int)blockIdx.x - nchain : (int)blockIdx.x, ntb = G > nchain ? G - nchain : G;
    if (tb >= 0) {
        __syncthreads();
        const int tid3 = tid_x(), lane = tid3 & 63, wave = tid3 >> 6;
        float* scr = (float*)smem + wave * (64 * 33);
        bf16_t* GUT = (bf16_t*)(p.aux + AUX_GUT);
        constexpr int nkb = D / 64, nnb = DE / 32, per = nkb * nnb;
        for (int it = tb * 8 + wave; it < NEXP * 2 * per; it += ntb * 8) {
            const int e = it / (2 * per), r = it % (2 * per), up = r / per, r2 = r % per, kb = r2 / nnb, nb = r2 % nnb;
            transpose_item((up ? p.in[I_MU_UP] : p.in[I_MG]) + (size_t)e * D * DE, DE, DE, kb * 64, nb * 32, GUT + (size_t)e * 512 * D, D, up ? 2 : 1, scr, lane);
        }
        constexpr int nkb2 = DE / 64, nnb2 = D / 32, per2 = nkb2 * nnb2;
        for (int it = tb * 8 + wave; it < NE_EARLY * per2; it += ntb * 8) {
            const int e = it / per2, r2 = it % per2, kb = r2 / nnb2, nb = r2 % nnb2;
            transpose_item(p.in[I_MD] + (size_t)e * DE * D, D, D, kb * 64, nb * 32, DNT_PTR(p.ws, e), DE, 0, scr, lane);
        }
    }
}

constexpr int P4_SG = 0;
constexpr int P4_XV = P4_SG + 32 * LD128 * 2;
constexpr int P4_YF = P4_XV + 32 * 520 * 2;
static_assert(P4_YF + 32 * 516 * 4 <= LDS_BYTES, "phase4 lds");
DI void phase4(const Params& p, char* smem) {
    const int tid = tid_x(), lane = tid & 63, wave = tid >> 6, r = lane & 31, hh = lane >> 5;
    const bf16_t* PL = (const bf16_t*)(p.ws + WS_PLAT);
    const bf16_t* ODIR = (const bf16_t*)(p.ws + WS_OA); const bf16_t* YDIR = (const bf16_t*)(p.aux + AUX_YDIR);
    const float* BON = (const float*)(p.ws + WS_BONUS); const float* mu = p.in[I_MU]; const bf16_t* G2T = (const bf16_t*)(p.ws + WS_G2T);
    bf16_t* OA = (bf16_t*)(p.ws + WS_OA); bf16_t* OB = (bf16_t*)(p.ws + WS_OB);
    bf16_t* SG = (bf16_t*)(smem + P4_SG); bf16_t* XV = (bf16_t*)(smem + P4_XV); float* YF = (float*)(smem + P4_YF);
    for (int it = blockIdx.x; it < T_LAT / 32; it += gridDim.x) {
        const int tok0 = it * 32, b = tok0 / S, l0 = tok0 % S;
        __syncthreads();
        for (int q = tid; q < 32 * 80; q += NTHREADS) {
            const int t = q / 80, c8 = q % 80;
            const int l = l0 + t;
            const int bcol = c8 < 16 ? 1792 + c8 * 8 : 1024 + (c8 - 16) * 8;
            float cu[8], o[8];
            unpack8(*(const u32x4*)(PL + (size_t)(b * S + l) * IN_COLS + COL_B0 + bcol), cu);
#pragma unroll
            for (int e = 0; e < 8; ++e) o[e] = c8 < 16 ? fsigmoid(cu[e]) : cu[e];
            u32x4 w; w.x = pk2(o[0], o[1]); w.y = pk2(o[2], o[3]); w.z = pk2(o[4], o[5]); w.w = pk2(o[6], o[7]);
            if (c8 < 16) *(u32x4*)(SG + t * LD128 + c8 * 8) = w; else *(u32x4*)(XV + t * 520 + (c8 - 16) * 8) = w;
        }
        for (int q = tid; q < 32 * 64; q += NTHREADS) {
            const int t = q >> 6, c8 = q & 63, tok = tok0 + t;
            float a0[8], a1[8];
            unpack8(*(const u32x4*)(YDIR + (size_t)tok * 512 + c8 * 8), a0); unpack8(*(const u32x4*)(YDIR + ((size_t)T_LAT + tok) * 512 + c8 * 8), a1);
            f32x4 s0 = {a0[0] + a1[0], a0[1] + a1[1], a0[2] + a1[2], a0[3] + a1[3]}, s1 = {a0[4] + a1[4], a0[5] + a1[5], a0[6] + a1[6], a0[7] + a1[7]};
            *(f32x4*)(YF + t * 516 + c8 * 8) = s0; *(f32x4*)(YF + t * 516 + c8 * 8 + 4) = s1;
        }
        __syncthreads();
        {
            unsigned q0[16], q1[16], zq[16];
#pragma unroll
            for (int k = 0; k < 16; ++k) {
                const int pi = wave * 16 + k, t = pi >> 2, h = pi & 3, tok = tok0 + t;
                const size_t o0 = (size_t)tok * 512 + h * 128 + 2 * lane;
                q0[k] = *(const unsigned*)(ODIR + o0); q1[k] = *(const unsigned*)(ODIR + (size_t)T_LAT * 512 + o0); zq[k] = *(const unsigned*)(PL + (size_t)tok * IN_COLS + 1536 + h * 128 + 2 * lane);
            }
            const float on0 = p.in[I_ONORM][2 * lane], on1 = p.in[I_ONORM][2 * lane + 1];
#pragma unroll
            for (int k = 0; k < 16; ++k) {
                const int pi = wave * 16 + k, t = pi >> 2, h = pi & 3, tok = tok0 + t;
                const size_t o0 = (size_t)tok * 512 + h * 128 + 2 * lane;
                const float a0 = bf2f((bf16_t)(q0[k] & 0xffffu)) + bf2f((bf16_t)(q1[k] & 0xffffu)), a1 = bf2f((bf16_t)(q0[k] >> 16)) + bf2f((bf16_t)(q1[k] >> 16));
                const float ss = wave_sum_fast(a0 * a0 + a1 * a1);
                const float rstd = frsq(ss * (1.f / 128.f) + 1e-6f);
                const float z0 = bf2f((bf16_t)(zq[k] & 0xffffu)), z1 = bf2f((bf16_t)(zq[k] >> 16));
                *(unsigned*)(OA + o0) = pk2(a0 * rstd * on0 * fsilu(z0), a1 * rstd * on1 * fsilu(z1));
            }
        }
        __syncthreads();
        {
            const int h = wave;
            f32x16 acc0 = zero16(), acc1 = zero16();
#pragma unroll
            for (int s2 = 0; s2 < 8; ++s2) {
                const bf16x8 a = ld_nat(SG + r * LD128, s2, hh);
                const bf16x8 b0 = *(const bf16x8*)(G2T + (size_t)(64 * h + r) * 128 + 16 * s2 + 8 * hh), b1 = *(const bf16x8*)(G2T + (size_t)(64 * h + 32 + r) * 128 + 16 * s2 + 8 * hh);
                acc0 = MFMA32(a, b0, acc0); acc1 = MFMA32(a, b1, acc1);
            }
            const int c0 = 64 * h + r, c1 = c0 + 32;
            const float lg0 = p.in[I_LNG][c0], lb0 = p.in[I_LNB][c0], lg1 = p.in[I_LNG][c1], lb1 = p.in[I_LNB][c1];
            float bonv[16];
#pragma unroll
            for (int g = 0; g < 16; ++g) { const int tok = tok0 + crow(g, hh); bonv[g] = BON[(size_t)tok * 8 + h] + BON[((size_t)T_LAT + tok) * 8 + h]; }
#pragma unroll
            for (int g = 0; g < 16; ++g) {
                const int i = crow(g, hh), tok = tok0 + i;
                const float y0 = YF[i * 516 + c0], y1 = YF[i * 516 + c1];
                const float mean = half_sum(y0 + y1, hh) * (1.f / 64.f); const float d0 = y0 - mean, d1 = y1 - mean;
                const float var = half_sum(d0 * d0 + d1 * d1, hh) * (1.f / 64.f); const float rs = frsq(var + 64e-5f);
                const float bon = bonv[g];
                const float o0 = (d0 * rs * lg0 + lb0 + bon * bf2f(XV[i * 520 + c0])) * acc0[g], o1 = (d1 * rs * lg1 + lb1 + bon * bf2f(XV[i * 520 + c1])) * acc1[g];
                OB[(size_t)tok * 512 + c0] = f2bf(o0); OB[(size_t)tok * 512 + c1] = f2bf(o1);
            }
        }
    }
}

DI void phase5(const Params& p, char* smem) {
    const bf16_t* OA = (const bf16_t*)(p.ws + WS_OA); const bf16_t* OB = (const bf16_t*)(p.ws + WS_OB);
    const bf16_t* WA = (const bf16_t*)(p.ws + WS_WOA); const bf16_t* WB = (const bf16_t*)(p.ws + WS_WOB);
    const bf16_t* PL = (const bf16_t*)(p.ws + WS_PLAT); bf16_t* Y = (bf16_t*)(p.aux + AUX_Y);
    if (USE_G8) {
        constexpr int NT8 = D / 256, MT8 = T_LAT / 256;
        constexpr int GLD = 264;
        static_assert(256 * GLD * 2 <= LDS_BYTES, "gate tile lds");
        bf16_t* GT = (bf16_t*)smem;
        auto stage_gates = [&](int brow, int gcol0) {
            const int tid = tid_x();
            u32x4 gv[16];
#pragma unroll
            for (int i = 0; i < 16; ++i) { const int ch = tid + i * NTHREADS, row = ch >> 5, c16 = ch & 31; gv[i] = *(const u32x4*)(PL + (size_t)(brow + row) * IN_COLS + gcol0 + c16 * 8); }
#pragma unroll
            for (int i = 0; i < 16; ++i) { const int ch = tid + i * NTHREADS, row = ch >> 5, c16 = ch & 31; *(u32x4*)(GT + row * GLD + c16 * 8) = gv[i]; }
            __syncthreads();
        };
        for (int t = blockIdx.x; t < MT8 * NT8; t += gridDim.x) {
            int mt, nt; if (!g8::tile_order(t, MT8, NT8, mt, nt)) break;
            const int brow = mt * 256, bcol = nt * 256;
            g8::Acc acc; g8::acc_zero(acc);
            g8::kloop(acc, smem, OA, 512, WA, 512, 512, brow, bcol);
            stage_gates(brow, COL_G0 + bcol);
            g8::for_each_quad(acc, brow, bcol, [&](int row, int col, const f32x4& v) {
                const u32x2 gq = *(const u32x2*)(GT + (row - brow) * GLD + (col - bcol));
                const float g0 = bf2f((bf16_t)(gq.x & 0xffffu)), g1 = bf2f((bf16_t)(gq.x >> 16)), g2 = bf2f((bf16_t)(gq.y & 0xffffu)), g3 = bf2f((bf16_t)(gq.y >> 16));
                u32x2 o; o.x = pk2(fsigmoid(g0) * v.x, fsigmoid(g1) * v.y); o.y = pk2(fsigmoid(g2) * v.z, fsigmoid(g3) * v.w);
                *(u32x2*)(Y + (size_t)row * D + col) = o;
            });
            __syncthreads();
            g8::acc_zero(acc);
            g8::kloop(acc, smem, OB, 512, WB, 512, 512, brow, bcol);
            stage_gates(brow, COL_G0 + D + bcol);
            g8::for_each_quad(acc, brow, bcol, [&](int row, int col, const f32x4& v) {
                const u32x2 gq = *(const u32x2*)(GT + (row - brow) * GLD + (col - bcol));
                const float g0 = bf2f((bf16_t)(gq.x & 0xffffu)), g1 = bf2f((bf16_t)(gq.x >> 16)), g2 = bf2f((bf16_t)(gq.y & 0xffffu)), g3 = bf2f((bf16_t)(gq.y >> 16));
#ifdef EMU
                const unsigned long long tq = *(const unsigned long long*)(Y + (size_t)row * D + col);
#else
                const unsigned long long tq = __hip_atomic_load((const unsigned long long*)(Y + (size_t)row * D + col), __ATOMIC_RELAXED, __HIP_MEMORY_SCOPE_AGENT);
#endif
                const unsigned tlo = (unsigned)tq, thi = (unsigned)(tq >> 32);
                const float t0 = bf2f((bf16_t)(tlo & 0xffffu)), t1 = bf2f((bf16_t)(tlo >> 16)), t2 = bf2f((bf16_t)(thi & 0xffffu)), t3 = bf2f((bf16_t)(thi >> 16));
                u32x2 o; o.x = pk2(t0 + fsigmoid(g0) * v.x, t1 + fsigmoid(g1) * v.y); o.y = pk2(t2 + fsigmoid(g2) * v.z, t3 + fsigmoid(g3) * v.w);
                *(u32x2*)(Y + (size_t)row * D + col) = o;
            });
            __syncthreads();
        }
        return;
    }
    constexpr int MR5 = 2, BM5 = 64 * MR5; constexpr int NT = D / 128, MT = T_LAT / BM5;
    for (int t = blockIdx.x; t < MT * NT; t += gridDim.x) {
        const int mt = t / NT, nt = t % NT, row0 = mt * BM5;
        f32x4 acca[MR5][4], accb[MR5][4]; acc_zero(acca); acc_zero(accb);
        gemm_kloop(acca, smem, [&](int i) { return OA + (size_t)(row0 + i) * 512; }, WA + (size_t)nt * 128 * 512, 512, 512);
        gemm_kloop(accb, smem, [&](int i) { return OB + (size_t)(row0 + i) * 512; }, WB + (size_t)nt * 128 * 512, 512, 512);
        const int t2 = tid_x(), l2 = t2 & 63, w2 = t2 >> 6; const int wr = w2 >> 1, wc = w2 & 1, fr = l2 & 15, fq = l2 >> 4;
#pragma unroll
        for (int m = 0; m < MR5; ++m)
#pragma unroll
            for (int n = 0; n < 4; ++n)
#pragma unroll
                for (int j = 0; j < 4; ++j) {
                    const int row = row0 + wr * 16 * MR5 + m * 16 + fq * 4 + j, col = nt * 128 + wc * 64 + n * 16 + fr;
                    const float ga = bf2f(PL[(size_t)row * IN_COLS + COL_G0 + col]), gb = bf2f(PL[(size_t)row * IN_COLS + COL_G0 + D + col]);
                    Y[(size_t)row * D + col] = f2bf(sigmoidf_(ga) * acca[m][n][j] + sigmoidf_(gb) * accb[m][n][j]);
                }
    }
}

DI void phase6(const Params& p, char* smem) {
    const bf16_t* Y = (const bf16_t*)(p.aux + AUX_Y); const bf16_t* WO = (const bf16_t*)(p.ws + WS_WOUT);
    const float* mod = (const float*)(p.ws + WS_MOD); float* Hh = (float*)(p.ws + WS_H);
    if (USE_G8) {
        constexpr int NT = D / 256, MT = T_LAT / 256;
        const float* X = p.in[I_X];
        for (int t = blockIdx.x; t < MT * NT; t += gridDim.x) {
            int mt, nt; if (!g8::tile_order(t, MT, NT, mt, nt)) break;
            const int brow = mt * 256, bcol = nt * 256;
            g8::Acc acc; g8::acc_zero(acc);
            g8::kloop(acc, smem, Y, D, WO, D, D, brow, bcol);
            g8::for_each_quad(acc, brow, bcol, [&](int row, int col, const f32x4& v) {
                const int b = row / S; const f32x4 xv = *(const f32x4*)(X + (size_t)row * D + col), gv = *(const f32x4*)(mod + (size_t)b * 6 * D + 2 * D + col);
                f32x4 o; o.x = xv.x + gv.x * v.x; o.y = xv.y + gv.y * v.y; o.z = xv.z + gv.z * v.z; o.w = xv.w + gv.w * v.w;
                *(f32x4*)(Hh + (size_t)row * D + col) = o;
            });
        }
    } else {
        const int tid = tid_x(), lane = tid & 63, wave = tid >> 6, wr = wave >> 1, wc = wave & 1, fr = lane & 15, fq = lane >> 4;
        constexpr int NT = D / 128, MT = T_LAT / BM;
        for (int t = blockIdx.x; t < MT * NT; t += gridDim.x) {
            const int mt = t / NT, nt = t % NT, row0 = mt * BM;
            f32x4 acc[MREP][4]; acc_zero(acc);
            gemm_kloop(acc, smem, [&](int i) { return Y + (size_t)(row0 + i) * D; }, WO + (size_t)nt * 128 * D, D, D);
#pragma unroll
            for (int m = 0; m < MREP; ++m)
#pragma unroll
                for (int n = 0; n < 4; ++n)
#pragma unroll
                    for (int j = 0; j < 4; ++j) {
                        const int row = row0 + wr * 16 * MREP + m * 16 + fq * 4 + j, col = nt * 128 + wc * 64 + n * 16 + fr, b = row / S;
                        Hh[(size_t)row * D + col] = p.in[I_X][(size_t)row * D + col] + mod[(size_t)b * 6 * D + 2 * D + col] * acc[m][n][j];
                    }
        }
    }
    __syncthreads();
    const int tid6 = tid_x(), lane = tid6 & 63, wave = tid6 >> 6;
    const int gw = blockIdx.x * 8 + wave, ngw = gridDim.x * 8;
    float* scr = (float*)smem + wave * (64 * 33);
    {
        constexpr int nkb = DE / 64, nnb = D / 32, per = nkb * nnb;
        for (int it = gw; it < (NEXP - NE_EARLY) * per; it += ngw) {
            const int e = NE_EARLY + it / per, r2 = it % per, kb = r2 / nnb, nb = r2 % nnb;
            transpose_item(p.in[I_MD] + (size_t)e * DE * D, D, D, kb * 64, nb * 32, DNT_PTR(p.ws, e), DE, 0, scr, lane);
        }
    }
}

#ifdef EMU
#define MFMA32F(a, b, c) emu_mfma32_f32((a), (b), (c))
#else
#define MFMA32F(a, b, c) __builtin_amdgcn_mfma_f32_32x32x2f32((a), (b), (c), 0, 0, 0)
#endif
constexpr int TB_LD = D + 4;
static_assert(32 * TB_LD * 4 <= LDS_BYTES && 8 * 32 * 64 * 4 <= LDS_BYTES, "phase7 lds");
DI void phase7(const Params& p, char* smem) {
    const int tid = tid_x(), lane = tid & 63, wave = tid >> 6, r = lane & 31, hh = lane >> 5;
    const float* Hh = (const float*)(p.ws + WS_H); const float* mod = (const float*)(p.ws + WS_MOD); const float* WRT = (const float*)(p.ws + WS_WRT);
    bf16_t* Tt = (bf16_t*)(p.ws + WS_T); int* cnt = (int*)(p.ws + WS_CNT); int* rowlist = (int*)(p.ws + WS_ROWLIST); float* pairw = (float*)(p.ws + WS_PAIRW);
    float* tb = (float*)smem;
    float* bias = (float*)(smem + LDS_BYTES - 1024);
    int* lcnt = (int*)(smem + LDS_BYTES - 768);
    int* lbase = lcnt + 32;
    if (tid < 36) bias[tid] = tid < 4 ? p.in[I_RGB][tid] : p.in[I_REB][tid - 4];
    f32x4 x[4][D / 256];
    int itn = blockIdx.x;
    if (itn < T_LAT / 32) {
#pragma unroll
        for (int tt = 0; tt < 4; ++tt)
#pragma unroll
            for (int j = 0; j < D / 256; ++j) x[tt][j] = *(const f32x4*)(Hh + (size_t)(itn * 32 + wave * 4 + tt) * D + j * 256 + lane * 4);
    }
    for (int it = blockIdx.x; it < T_LAT / 32; it += gridDim.x) {
        const int tok0 = it * 32;
        __syncthreads();
        if (tid < 32) lcnt[tid] = 0;
#pragma unroll
        for (int tt = 0; tt < 4; ++tt) {
            const int ti = wave * 4 + tt, tok = tok0 + ti, b = tok / S;
            float ss = 0.f;
#pragma unroll
            for (int j = 0; j < D / 256; ++j) ss += x[tt][j].x * x[tt][j].x + x[tt][j].y * x[tt][j].y + x[tt][j].z * x[tt][j].z + x[tt][j].w * x[tt][j].w;
            ss = wave_sum_fast(ss);
            const float rstd = frsq(ss * (1.0f / D) + 1e-6f);
#pragma unroll
            for (int j = 0; j < D / 256; ++j) {
                const int k = j * 256 + lane * 4;
                const f32x4 g = *(const f32x4*)(p.in[I_NFFN] + k), sh = *(const f32x4*)(mod + (size_t)b * 6 * D + 3 * D + k), sc = *(const f32x4*)(mod + (size_t)b * 6 * D + 4 * D + k);
                f32x4 o; o.x = x[tt][j].x * rstd * g.x * (1.f + sc.x) + sh.x; o.y = x[tt][j].y * rstd * g.y * (1.f + sc.y) + sh.y;
                o.z = x[tt][j].z * rstd * g.z * (1.f + sc.z) + sh.z; o.w = x[tt][j].w * rstd * g.w * (1.f + sc.w) + sh.w;
                *(f32x4*)(tb + ti * TB_LD + k) = o;
                u32x2 ob; ob.x = pk2(o.x, o.y); ob.y = pk2(o.z, o.w);
                *(u32x2*)(Tt + (size_t)tok * D + k) = ob;
            }
        }
        itn = it + gridDim.x;
        if (itn < T_LAT / 32) {
#pragma unroll
            for (int tt = 0; tt < 4; ++tt)
#pragma unroll
                for (int j = 0; j < D / 256; ++j) x[tt][j] = *(const f32x4*)(Hh + (size_t)(itn * 32 + wave * 4 + tt) * D + j * 256 + lane * 4);
        }
        LDS_BARRIER();
        f32x16 a0 = zero16(), a1 = zero16();
        {
            const int kbeg = wave * (D / 8);
            const float* arow = tb + r * TB_LD + kbeg + 4 * hh;
            const float* b0row = WRT + (size_t)(4 + r) * D + kbeg + 4 * hh;
            const float* b1row = WRT + (size_t)(r < 4 ? r : 0) * D + kbeg + 4 * hh;
            const float m1 = r < 4 ? 1.f : 0.f;
#pragma unroll 4
            for (int g = 0; g < D / 64; ++g) {
                const f32x4 av = *(const f32x4*)(arow + 8 * g), b0 = *(const f32x4*)(b0row + 8 * g); const f32x4 b1 = *(const f32x4*)(b1row + 8 * g) * m1;
                a0 = MFMA32F(av.x, b0.x, a0); a1 = MFMA32F(av.x, b1.x, a1); a0 = MFMA32F(av.y, b0.y, a0); a1 = MFMA32F(av.y, b1.y, a1);
                a0 = MFMA32F(av.z, b0.z, a0); a1 = MFMA32F(av.z, b1.z, a1); a0 = MFMA32F(av.w, b0.w, a0); a1 = MFMA32F(av.w, b1.w, a1);
            }
        }
        LDS_BARRIER();
        {
            float* part = tb + wave * (32 * 64);
#pragma unroll
            for (int g = 0; g < 16; ++g) { const int i = crow(g, hh); part[i * 64 + r] = a0[g]; part[i * 64 + 32 + r] = a1[g]; }
        }
        LDS_BARRIER();
        float lsum[4];
        {
            const int i = tid >> 4, c4 = (tid & 15) * 4;
#pragma unroll
            for (int e = 0; e < 4; ++e) { float sacc = 0.f;
#pragma unroll
                for (int w = 0; w < 8; ++w) sacc += tb[w * (32 * 64) + i * 64 + c4 + e];
                lsum[e] = sacc; }
        }
        LDS_BARRIER();
        { const int i = tid >> 4, c4 = (tid & 15) * 4;
#pragma unroll
          for (int e = 0; e < 4; ++e) tb[i * 64 + c4 + e] = lsum[e]; }
        LDS_BARRIER();
        int ex1 = 0, ex2 = 0, rk1 = 0, rk2 = 0; float w1 = 0.f, w2 = 0.f;
        if (tid < 32) {
            const float* L = tb + tid * 64;
            float gl[4];
#pragma unroll
            for (int i = 0; i < 4; ++i) gl[i] = L[32 + i] + bias[i];
            int g = 0; float mx = gl[0];
#pragma unroll
            for (int i = 1; i < 4; ++i) if (gl[i] > mx) { mx = gl[i]; g = i; }
            float se = 0.f;
#pragma unroll
            for (int i = 0; i < 4; ++i) se += fexp(gl[i] - mx);
            const float pg = 1.0f / se;
            int i1 = 0; float l1 = L[g * 8] + bias[4 + g * 8];
            for (int i = 1; i < 8; ++i) { const float v = L[g * 8 + i] + bias[4 + g * 8 + i]; if (v > l1) { l1 = v; i1 = i; } }
            int i2 = -1; float l2 = -3.0e38f;
            for (int i = 0; i < 8; ++i) { const float v = L[g * 8 + i] + bias[4 + g * 8 + i]; if (i != i1 && v > l2) { l2 = v; i2 = i; } }
            const float e2 = fexp(l2 - l1); w1 = pg / (1.f + e2); w2 = pg * e2 / (1.f + e2);
            ex1 = g * 8 + i1; ex2 = g * 8 + i2;
            rk1 = atomicAdd(&lcnt[ex1], 1); rk2 = atomicAdd(&lcnt[ex2], 1);
        }
        LDS_BARRIER();
        if (tid < 32) { const int c = lcnt[tid]; lbase[tid] = c ? atomicAdd(&cnt[tid * CNT_STRIDE], c) : 0; }
        __syncthreads();
        if (tid < 32) {
            const int tok = tok0 + tid;
            rowlist[(size_t)ex1 * CAP + lbase[ex1] + rk1] = tok * 2; pairw[tok * 2] = w1;
            rowlist[(size_t)ex2 * CAP + lbase[ex2] + rk2] = tok * 2 + 1; pairw[tok * 2 + 1] = w2;
        }
    }
}

constexpr int MOE_TM = USE_G8 ? 256 : BM;
DI void moe_tiles(const Params& p, char* smem, int* pre) {
    const int* cnt = (const int*)(p.ws + WS_CNT);
    __syncthreads();
    if (tid_x() == 0) { int s = 0; for (int e = 0; e < NEXP; ++e) { pre[e] = s; s += (cnt[e * CNT_STRIDE] + MOE_TM - 1) / MOE_TM; } pre[NEXP] = s; }
    __syncthreads();
}
DI void moe_up_tile(const Params& p, char* smem, const int* pre, int t) {
    const int* cnt = (const int*)(p.ws + WS_CNT); const int* rowlist = (const int*)(p.ws + WS_ROWLIST);
    const bf16_t* Tt = (const bf16_t*)(p.ws + WS_T); const bf16_t* GUT = (const bf16_t*)(p.aux + AUX_GUT); bf16_t* HID = (bf16_t*)(p.ws + WS_HID);
    const int mg = t >> 1, nt = t & 1; int e = 0;
    while (pre[e + 1] <= mg) ++e;
    const int mt = mg - pre[e], ce = cnt[e * CNT_STRIDE]; const int* rl = rowlist + (size_t)e * CAP;
    g8::Acc acc; g8::acc_zero(acc);
    g8::kloop_g(acc, smem, Tt, [&](int r) { int idx = mt * 256 + r; idx = idx < ce ? idx : ce - 1; return (rl[idx] >> 1) * D; }, GUT + ((size_t)e * 512 + nt * 256) * D, D, D, 0);
    const int t2 = tid_x(), wid = t2 >> 6, l2 = t2 & 63, wr2 = wid >> 2, wc2 = wid & 3, fr2 = l2 & 15, fq2 = l2 >> 4;
    int prs[2][4];
#pragma unroll
    for (int ai = 0; ai < 2; ++ai)
#pragma unroll
        for (int m = 0; m < 4; ++m) { const int idx = mt * 256 + ai * 128 + wr2 * 64 + m * 16 + fr2; prs[ai][m] = idx < ce ? rl[idx] : -1; }
#pragma unroll
    for (int ai = 0; ai < 2; ++ai)
#pragma unroll
        for (int m = 0; m < 4; ++m) {
            if (prs[ai][m] >= 0) {
                const int pair = prs[ai][m];
#pragma unroll
                for (int bj = 0; bj < 2; ++bj) {
                    const f32x4 g = acc[ai][bj][m][0], u = acc[ai][bj][m][1];
                    u32x2 o; o.x = pk2(fsilu(g.x) * u.x, fsilu(g.y) * u.y); o.y = pk2(fsilu(g.z) * u.z, fsilu(g.w) * u.w);
                    *(u32x2*)(HID + (size_t)pair * DE + nt * 128 + bj * 64 + wc2 * 16 + fq2 * 4) = o;
                }
            }
        }
}
DI void moe_down_tile(const Params& p, char* smem, const int* pre, int t) {
    constexpr int NT8 = D / 256;
    const int* cnt = (const int*)(p.ws + WS_CNT); const int* rowlist = (const int*)(p.ws + WS_ROWLIST); const float* pairw = (const float*)(p.ws + WS_PAIRW);
    const bf16_t* HID = (const bf16_t*)(p.ws + WS_HID); bf16_t* OP = (bf16_t*)(p.ws + WS_OPAIR);
    const int mg = t / NT8, nt = t % NT8; int e = 0;
    while (pre[e + 1] <= mg) ++e;
    const int mt = mg - pre[e], ce = cnt[e * CNT_STRIDE]; const int* rl = rowlist + (size_t)e * CAP;
    g8::Acc acc; g8::acc_zero(acc);
    g8::kloop_g(acc, smem, HID, [&](int r) { int idx = mt * 256 + r; idx = idx < ce ? idx : ce - 1; return rl[idx] * DE; }, DNT_PTR(p.ws, e) + (size_t)nt * 256 * DE, DE, DE, 0);
    {
        const int t2 = tid_x(), wid = t2 >> 6, l2 = t2 & 63, wr2 = wid >> 2, wc2 = wid & 3, fr2 = l2 & 15, fq2 = l2 >> 4;
        int prs[2][4]; float pws[2][4];
#pragma unroll
        for (int ai = 0; ai < 2; ++ai)
#pragma unroll
            for (int m = 0; m < 4; ++m) { const int idx = mt * 256 + ai * 128 + wr2 * 64 + m * 16 + fr2; prs[ai][m] = idx < ce ? rl[idx] : -1; }
#pragma unroll
        for (int ai = 0; ai < 2; ++ai)
#pragma unroll
            for (int m = 0; m < 4; ++m) pws[ai][m] = prs[ai][m] >= 0 ? pairw[prs[ai][m]] : 0.f;
#pragma unroll
        for (int ai = 0; ai < 2; ++ai)
#pragma unroll
            for (int m = 0; m < 4; ++m) {
                if (prs[ai][m] >= 0) {
                    const float w = pws[ai][m]; bf16_t* orow = OP + (size_t)prs[ai][m] * D + nt * 256 + wc2 * 32 + fq2 * 4;
#pragma unroll
                    for (int bj = 0; bj < 2; ++bj)
#pragma unroll
                        for (int n = 0; n < 2; ++n) { const f32x4 v = acc[ai][bj][m][n];
                            u32x2 o; o.x = pk2(v.x * w, v.y * w); o.y = pk2(v.z * w, v.w * w); *(u32x2*)(orow + bj * 128 + n * 16) = o; }
                }
            }
    }
}
DI void phase8(const Params& p, char* smem) {
    const int tid = tid_x(), lane = tid & 63, wave = tid >> 6, wr = wave >> 1, wc = wave & 1, fr = lane & 15, fq = lane >> 4;
    int* pre = (int*)(smem + LDS_BYTES - 256);
    moe_tiles(p, smem, pre);
    const int* cnt = (const int*)(p.ws + WS_CNT); const int* rowlist = (const int*)(p.ws + WS_ROWLIST);
    const bf16_t* Tt = (const bf16_t*)(p.ws + WS_T); const bf16_t* GUT = (const bf16_t*)(p.aux + AUX_GUT); bf16_t* HID = (bf16_t*)(p.ws + WS_HID);
    if (USE_G8) {
        if ((int)blockIdx.x < pre[NEXP] * 2) moe_up_tile(p, smem, pre, (int)blockIdx.x);
        return;
    }
    const int ntile = pre[NEXP] * 4;
    for (int t = blockIdx.x; t < ntile; t += gridDim.x) {
        const int mg = t >> 2, nt = t & 3; int e = 0;
        while (pre[e + 1] <= mg) ++e;
        const int mt = mg - pre[e], ce = cnt[e * CNT_STRIDE]; const int* rl = rowlist + (size_t)e * CAP;
        f32x4 acc[MREP][4]; acc_zero(acc);
        gemm_kloop(acc, smem, [&](int i) { int idx = mt * BM + i; idx = idx < ce ? idx : ce - 1; return Tt + (size_t)(rl[idx] >> 1) * D; }, GUT + ((size_t)e * 512 + nt * 128) * D, D, D);
#pragma unroll
        for (int m = 0; m < MREP; ++m)
#pragma unroll
            for (int j = 0; j < 4; ++j) {
                const int idx = mt * BM + wr * 16 * MREP + m * 16 + fq * 4 + j;
                if (idx < ce) {
                    const int pair = rl[idx];
#pragma unroll
                    for (int n = 0; n < 2; ++n) {
                        const float g = acc[m][n][j], u = acc[m][n + 2][j];
                        HID[(size_t)pair * DE + nt * 64 + wc * 32 + n * 16 + fr] = f2bf(siluf_(g) * u);
                    }
                }
            }
    }
}
DI void phase9(const Params& p, char* smem) {
    const int tid = tid_x(), lane = tid & 63, wave = tid >> 6, wr = wave >> 1, wc = wave & 1, fr = lane & 15, fq = lane >> 4;
    int* pre = (int*)(smem + LDS_BYTES - 256);
    moe_tiles(p, smem, pre);
    const int* cnt = (const int*)(p.ws + WS_CNT); const int* rowlist = (const int*)(p.ws + WS_ROWLIST); const float* pairw = (const float*)(p.ws + WS_PAIRW);
    const bf16_t* HID = (const bf16_t*)(p.ws + WS_HID); const bf16_t* DNT = (const bf16_t*)(p.ws + WS_DNT); bf16_t* OP = (bf16_t*)(p.ws + WS_OPAIR);
    if (USE_G8) {
        constexpr int NT8 = D / 256;
        const int G = (int)gridDim.x, NU = pre[NEXP] * 2, NU2 = NU > G ? NU - G : 0, ND = pre[NEXP] * NT8;
        int* cntw = (int*)(p.ws + WS_CNT);
        int* tk = (int*)(smem + LDS_BYTES - 512);
        for (;;) {
            __syncthreads();
            if (tid_x() == 0) *tk = atomicAdd(&cntw[CNT_TICKET], 1);
            __syncthreads();
            const int j = *tk;
            if (j >= NU2 + ND) break;
            if (j < NU2) {
                moe_up_tile(p, smem, pre, G + j);
#ifndef EMU
                asm volatile("s_waitcnt vmcnt(0)" ::: "memory");
#endif
                __syncthreads();
                if (tid_x() == 0) {
#ifndef EMU
                    __builtin_amdgcn_fence(__ATOMIC_RELEASE, "agent");
                    asm volatile("s_waitcnt vmcnt(0)" ::: "memory");
#endif
                    (void)atomicAdd(&cntw[CNT_U2DONE], 1);
                }
            } else {
                const int dt = j - NU2;
                if (2 * (dt / NT8) + 1 >= G) {
                    if (tid_x() == 0) {
#ifndef EMU
                        while (__hip_atomic_load(&cntw[CNT_U2DONE], __ATOMIC_RELAXED, __HIP_MEMORY_SCOPE_AGENT) < NU2) __builtin_amdgcn_s_sleep(2);
                        __builtin_amdgcn_fence(__ATOMIC_ACQUIRE, "agent");
                        asm volatile("s_waitcnt vmcnt(0)" ::: "memory");
#endif
                    }
                    __syncthreads();
                }
                moe_down_tile(p, smem, pre, dt);
            }
        }
        return;
    }
    constexpr int NT = D / 128;
    const int ntile = pre[NEXP] * NT;
    for (int t = blockIdx.x; t < ntile; t += gridDim.x) {
        const int mg = t / NT, nt = t % NT; int e = 0;
        while (pre[e + 1] <= mg) ++e;
        const int mt = mg - pre[e], ce = cnt[e * CNT_STRIDE]; const int* rl = rowlist + (size_t)e * CAP;
        f32x4 acc[MREP][4]; acc_zero(acc);
        gemm_kloop(acc, smem, [&](int i) { int idx = mt * BM + i; idx = idx < ce ? idx : ce - 1; return HID + (size_t)rl[idx] * DE; }, DNT_PTR(p.ws, e) + (size_t)nt * 128 * DE, DE, DE);
#pragma unroll
        for (int m = 0; m < MREP; ++m)
#pragma unroll
            for (int j = 0; j < 4; ++j) {
                const int idx = mt * BM + wr * 16 * MREP + m * 16 + fq * 4 + j;
                if (idx < ce) {
                    const int pair = rl[idx]; const float w = pairw[pair];
#pragma unroll
                    for (int n = 0; n < 4; ++n) OP[(size_t)pair * D + nt * 128 + wc * 64 + n * 16 + fr] = f2bf(acc[m][n][j] * w);
                }
            }
    }
}

DI void phase10(const Params& p, char* smem) {
    const int lane = tid_x() & 63, wave = tid_x() >> 6;
    const int gw = blockIdx.x * 8 + wave, ngw = gridDim.x * 8;
    const float* Hh = (const float*)(p.ws + WS_H); const float* mod = (const float*)(p.ws + WS_MOD); const bf16_t* OP = (const bf16_t*)(p.ws + WS_OPAIR);
    for (int tok = gw; tok < T_LAT; tok += ngw) {
        const int b = tok / S;
        f32x4 x[D / 256]; float ss = 0.f;
#pragma unroll
        for (int j = 0; j < D / 256; ++j) {
            const int k = j * 256 + lane * 4;
            const f32x4 hv = *(const f32x4*)(Hh + (size_t)tok * D + k), g2 = *(const f32x4*)(mod + (size_t)b * 6 * D + 5 * D + k);
            const u32x2 p0 = *(const u32x2*)(OP + (size_t)(tok * 2) * D + k), p1 = *(const u32x2*)(OP + (size_t)(tok * 2 + 1) * D + k);
            f32x4 m;
            m.x = bf2f((bf16_t)(p0.x & 0xffffu)) + bf2f((bf16_t)(p1.x & 0xffffu)); m.y = bf2f((bf16_t)(p0.x >> 16)) + bf2f((bf16_t)(p1.x >> 16));
            m.z = bf2f((bf16_t)(p0.y & 0xffffu)) + bf2f((bf16_t)(p1.y & 0xffffu)); m.w = bf2f((bf16_t)(p0.y >> 16)) + bf2f((bf16_t)(p1.y >> 16));
            x[j].x = hv.x + g2.x * m.x; x[j].y = hv.y + g2.y * m.y; x[j].z = hv.z + g2.z * m.z; x[j].w = hv.w + g2.w * m.w;
            ss += x[j].x * x[j].x + x[j].y * x[j].y + x[j].z * x[j].z + x[j].w * x[j].w;
        }
        ss = wave_sum(ss);
        const float rstd = 1.0f / sqrtf(ss * (1.0f / D) + 1e-6f);
#pragma unroll
        for (int j = 0; j < D / 256; ++j) {
            const int k = j * 256 + lane * 4; const f32x4 g = *(const f32x4*)(p.in[I_FIN] + k);
            f32x4 o; o.x = x[j].x * rstd * g.x; o.y = x[j].y * rstd * g.y; o.z = x[j].z * rstd * g.z; o.w = x[j].w * rstd * g.w;
            *(f32x4*)(p.out + (size_t)tok * D + k) = o;
        }
    }
}

DI void run_phase(const Params& p, int ph, char* smem) {
    switch (ph) {
        case PH_MOD: phase0(p, smem); break;
        case PH_U: phase1(p, smem); break;
        case PH_P: phase2(p, smem); break;
        case PH_HALO: phase_halo(p, smem); break;
        case PH_FIR: phase_fir(p, smem); break;
        case PH_CHAINS: phase3(p, smem); break;
        case PH_POST: phase4(p, smem); break;
        case PH_MERGE: phase5(p, smem); break;
        case PH_WOUT: phase6(p, smem); break;
        case PH_ROUTER: phase7(p, smem); break;
        case PH_UP: phase8(p, smem); break;
        case PH_DOWN: phase9(p, smem); break;
        default: phase10(p, smem); break;
    }
}

#ifndef EMU
namespace cg = cooperative_groups;
#define XB_TMO      128
#define XB_XCNT(j)  (256  + 64 * (j))
#define XB_XSUB(j)  (1280 + 64 * (j))
#define XB_XGEN(j)  (2304 + 64 * (j))
#define XB_TOP      3328
#define XB_TOPGEN   3392
#define XB_SPIN_CAP (1u << 20)
DI unsigned xb_ld(unsigned* p) { return __hip_atomic_load(p, __ATOMIC_RELAXED, __HIP_MEMORY_SCOPE_AGENT); }
DI unsigned xb_add(unsigned* p, unsigned v) { return __hip_atomic_fetch_add(p, v, __ATOMIC_RELAXED, __HIP_MEMORY_SCOPE_AGENT); }
DI unsigned xb_xcc_id() { return (unsigned)__builtin_amdgcn_s_getreg((3 << 11) | 20) & 0xFu; }
#define XB_SPIN(cond, bar) do { unsigned _sp = 0; while (cond) { __builtin_amdgcn_s_sleep(1); \
    if ((++_sp & 255u) == 0u) { if (xb_ld(&(bar)[XB_TMO])) break; if (_sp > XB_SPIN_CAP) { atomicAdd(&(bar)[XB_TMO], 1u); break; } } } } while (0)
DI void xcd_barrier_post(unsigned* bar) { if (threadIdx.x == 0) (void)xb_add(&bar[XB_XCNT(xb_xcc_id())], 1u); }
DI void xcd_barrier_complete(unsigned* bar, unsigned x, unsigned& nloc, unsigned& nx) {
    const unsigned G = gridDim.x;
    unsigned sum, cnt, mine, sp = 0u;
    for (;;) {
        sum = 0u; cnt = 0u; mine = 0u;
#pragma unroll
        for (unsigned j = 0; j < 16; ++j) { const unsigned c = xb_ld(&bar[XB_XCNT(j)]); sum += c; cnt += (c > 0u) ? 1u : 0u; mine = (j == x) ? c : mine; }
        if (sum == G) break;
        __builtin_amdgcn_s_sleep(1);
        if ((++sp & 255u) == 0u) { if (xb_ld(&bar[XB_TMO])) break; if (sp > XB_SPIN_CAP) { atomicAdd(&bar[XB_TMO], 1u); break; } }
    }
    nloc = mine > 0u ? mine : 1u; nx = cnt > 0u ? cnt : 1u;
}
DI void xcd_barrier(unsigned* bar, volatile unsigned* st) {
    asm volatile("s_waitcnt vmcnt(0)" ::: "memory");
    __syncthreads();
    if (threadIdx.x == 0) {
        __builtin_amdgcn_s_waitcnt(0);
        const unsigned x = xb_xcc_id();
        unsigned nloc = st[0], nx = st[1];
        if (nloc == 0u) { xcd_barrier_complete(bar, x, nloc, nx); st[0] = nloc; st[1] = nx; }
        const unsigned old = xb_add(&bar[XB_XSUB(x)], 1u);
        const unsigned gen = old / nloc;
        if (old + 1u == (gen + 1u) * nloc) {
            __builtin_amdgcn_fence(__ATOMIC_RELEASE, "agent");
            asm volatile("s_waitcnt vmcnt(0)" ::: "memory");
            const unsigned og = xb_add(&bar[XB_TOP], 1u);
            const unsigned tg = og / nx;
            if (og + 1u == (tg + 1u) * nx) xb_add(&bar[XB_TOPGEN], 1u);
            else XB_SPIN(xb_ld(&bar[XB_TOPGEN]) == tg, bar);
            __builtin_amdgcn_fence(__ATOMIC_ACQUIRE, "agent");
            xb_add(&bar[XB_XGEN(x)], 1u);
            asm volatile("s_waitcnt vmcnt(0)" ::: "memory");
        } else {
            XB_SPIN(xb_ld(&bar[XB_XGEN(x)]) == gen, bar);
            __builtin_amdgcn_fence(__ATOMIC_ACQUIRE, "agent");
            asm volatile("s_waitcnt vmcnt(0)" ::: "memory");
        }
    }
    __syncthreads();
}
__global__ void __launch_bounds__(NTHREADS) mk_forward(Params p) {
    extern __shared__ __attribute__((aligned(16))) char smem[];
    typedef const Params __attribute__((address_space(4)))* KPtr;
    volatile unsigned* xst = (volatile unsigned*)(smem + LDS_BYTES);
    if (threadIdx.x < 2) xst[threadIdx.x] = 0u;
    xcd_barrier_post((unsigned*)(p.ws + WS_XBAR));
#define PHASE(k, fn) { KPtr kp = (KPtr)__builtin_amdgcn_kernarg_segment_ptr(); asm volatile("" : "+s"(kp)); fn(*(const Params*)kp, smem); \
        unsigned* xbar = (unsigned*)(((const Params*)kp)->ws + WS_XBAR); \
        if ((k) + 1 < NPHASES) xcd_barrier(xbar, xst); }
    PHASE(0, phase0) PHASE(1, phase1) PHASE(2, phase2)
    if (!USE_G8) PHASE(3, phase_halo)
    PHASE(4, phase_fir) PHASE(5, phase3) PHASE(6, phase4)
    PHASE(7, phase5) PHASE(8, phase6) PHASE(9, phase7) PHASE(10, phase8) PHASE(11, phase9) PHASE(12, phase10)
#undef PHASE
}

extern "C" void kernel_launch(void* const* d_in, const int* in_sizes, int n_in, void* d_out, int out_size, void* d_ws, size_t ws_size, hipStream_t stream) {
    static int grid_blocks = 0;
    if (grid_blocks == 0) {
        if (n_in != 35 || out_size != T_LAT * D || ws_size < WS_END || (size_t)out_size * 4 < AUX_END) {
            fprintf(stderr, "kernel_launch: unexpected shapes (n_in %d out %d ws %zu need %zu aux need %zu)\n", n_in, out_size, ws_size, (size_t)WS_END, (size_t)AUX_END);
            grid_blocks = -1; return;
        }
        int dev = 0, cus = 0, per_cu = 0;
        hipGetDevice(&dev);
        hipDeviceGetAttribute(&cus, hipDeviceAttributeMultiprocessorCount, dev);
        hipFuncSetAttribute((const void*)mk_forward, hipFuncAttributeMaxDynamicSharedMemorySize, LDS_BYTES + 256);
        hipOccupancyMaxActiveBlocksPerMultiprocessor(&per_cu, (const void*)mk_forward, NTHREADS, LDS_BYTES + 256);
        if (per_cu < 1) { fprintf(stderr, "kernel_launch: occupancy query says %d blocks/CU\n", per_cu); per_cu = 1; }
        if (per_cu > 1) per_cu = 1;
        grid_blocks = cus * per_cu;
    }
    if (grid_blocks < 0) return;
    Params p{};
    for (int i = 0; i < 35; ++i) p.in[i] = (const float*)d_in[i];
    p.out = (float*)d_out; p.ws = (char*)d_ws; p.aux = (char*)d_out;
    p.ph_lo = 0; p.ph_hi = NPHASES;
    (void)hipMemsetAsync((char*)d_ws + WS_XBAR, 0, 3456 * 4, stream);
    void* args[] = {&p};
    hipError_t e = hipLaunchCooperativeKernel((const void*)mk_forward, dim3(grid_blocks), dim3(NTHREADS), args, LDS_BYTES + 256, stream);
    if (e != hipSuccess) fprintf(stderr, "cooperative launch failed: %s (grid %d)\n", hipGetErrorString(e), grid_blocks);
}
#endif
```

```cpp
#ifndef EMU
#include <hip/hip_runtime.h>
#include <hip/hip_cooperative_groups.h>
#include <cstdio>
#endif
#include <stdint.h>
#include <stddef.h>

#ifndef CFG_D
#define CFG_D 1024
#define CFG_B 8
#define CFG_S 2048
#define CFG_CTX 256
#endif
#ifndef MK_LAUNCHES
#define MK_LAUNCHES 1
#endif

typedef unsigned short bf16_t;
typedef short bf16x8 __attribute__((ext_vector_type(8)));
typedef float f32x4 __attribute__((ext_vector_type(4)));
typedef unsigned u32x4 __attribute__((ext_vector_type(4)));
typedef unsigned u32x2 __attribute__((ext_vector_type(2)));

#define DI __device__ __forceinline__
DI int tid_x() { int t = (int)threadIdx.x;
#ifndef EMU
    asm volatile("" : "+v"(t));
#endif
    return t; }

constexpr int D = CFG_D, NB = CFG_B, S = CFG_S, CTXL = CFG_CTX;
constexpr int GW = 64, ROWS = S / GW;
constexpr int T_CTX = NB * CTXL, T_LAT = NB * S, T_ALL = T_CTX + T_LAT;
constexpr int H_A = 4, H_B = 8;
constexpr int A_COLS = 2064, B_COLS = 1920;
constexpr int IN_COLS = A_COLS + B_COLS + 2 * D;
constexpr int COL_B0 = A_COLS, COL_G0 = A_COLS + B_COLS;
constexpr int CTX_COLS = COL_G0;
constexpr int NP = ((IN_COLS + 127) / 128) * 128;
constexpr int NEXP = 32, DE = 256;
constexpr int NV = NB + 1;
constexpr int NTHREADS = 512;
constexpr int MREP = (T_CTX % 256 == 0 && T_LAT % 256 == 0) ? 4 : 2;
constexpr int BM = 64 * MREP;
constexpr int NPHASES = 13;
enum { PH_MOD = 0, PH_U, PH_P, PH_HALO, PH_FIR, PH_CHAINS, PH_POST, PH_MERGE, PH_WOUT, PH_ROUTER, PH_UP, PH_DOWN, PH_FINAL };
constexpr int LDS_BYTES = 155648;
constexpr int CAP = T_LAT;

static_assert(D % 256 == 0 && S % 64 == 0 && CTXL % 64 == 0 && T_CTX % BM == 0 && T_LAT % BM == 0, "shape");

constexpr size_t al256(size_t x) { return (x + 255) & ~(size_t)255; }
constexpr int CNT_STRIDE = 64;
constexpr size_t WS_CNT = 512 + 3456 * 4 + 256;
constexpr int CNT_TICKET = 2 * CNT_STRIDE + 16, CNT_U2DONE = 3 * CNT_STRIDE + 16;
constexpr size_t WS_BAR = 256;
constexpr size_t WS_XBAR = 512;
constexpr size_t WS_MOD = 512 + 3456 * 4 + 256 + 32 * 64 * 4;
constexpr size_t WS_AB = al256(WS_MOD + (size_t)NV * 6 * D * 4);
constexpr size_t WS_BONUS = al256(WS_AB + (size_t)T_ALL * 16 * 4);
constexpr size_t WS_PAIRW = al256(WS_BONUS + (size_t)2 * T_LAT * 8 * 4);
constexpr size_t WS_ROWLIST = al256(WS_PAIRW + (size_t)T_LAT * 2 * 4);
constexpr size_t WS_WRT = al256(WS_ROWLIST + (size_t)NEXP * CAP * 4);
constexpr size_t WS_G2T = al256(WS_WRT + (size_t)36 * D * 4);
constexpr size_t WS_WOA = al256(WS_G2T + (size_t)512 * 128 * 2);
constexpr size_t WS_WOB = al256(WS_WOA + (size_t)D * 512 * 2);
constexpr size_t WS_WOUT = al256(WS_WOB + (size_t)D * 512 * 2);
constexpr size_t WS_OA = al256(WS_WOUT + (size_t)D * D * 2);
constexpr size_t WS_OB = al256(WS_OA + (size_t)T_LAT * 512 * 2);
constexpr size_t WS_HALO_A = WS_OA;
constexpr size_t WS_HALO_B = WS_OA + al256((size_t)(T_ALL / 64) * 4 * 1536 * 2);
static_assert(WS_HALO_B + (size_t)(T_ALL / 64) * 2 * 1920 * 2 <= WS_OB + (size_t)T_LAT * 512 * 2, "halo buffers");
constexpr size_t WS_DNT = WS_OA;
constexpr size_t WS_SPARE_END = al256(WS_OB + (size_t)T_LAT * 512 * 2) > al256(WS_DNT + (size_t)NEXP * D * DE * 2) ? al256(WS_OB + (size_t)T_LAT * 512 * 2) : al256(WS_DNT + (size_t)NEXP * D * DE * 2);
constexpr size_t WS_P = WS_SPARE_END;
constexpr size_t WS_PLAT = WS_P;
constexpr size_t WS_PCTX = al256(WS_PLAT + (size_t)T_LAT * IN_COLS * 2);
constexpr size_t WS_P_END = al256(WS_PCTX + (size_t)T_CTX * CTX_COLS * 2);
constexpr size_t WS_H = WS_P;
constexpr size_t WS_T = al256(WS_H + (size_t)T_LAT * D * 4);
constexpr size_t WS_HID = al256(WS_T + (size_t)T_LAT * D * 2);
constexpr size_t WS_OPAIR = al256(WS_HID + (size_t)T_LAT * 2 * DE * 2);
constexpr size_t WS_P2_END = al256(WS_OPAIR + (size_t)T_LAT * 2 * D * 2);
constexpr size_t WS_END0 = WS_P_END > WS_P2_END ? WS_P_END : WS_P2_END;
constexpr size_t WS_GUARANTEED = (size_t)256 << 20;
constexpr int NE_EARLY = WS_END0 >= WS_GUARANTEED ? 0 : ((WS_GUARANTEED - WS_END0) / ((size_t)D * DE * 2) >= (size_t)NEXP ? NEXP : (int)((WS_GUARANTEED - WS_END0) / ((size_t)D * DE * 2)));
constexpr size_t WS_DNT2 = WS_END0;
constexpr size_t WS_END = WS_DNT2 + (size_t)NE_EARLY * D * DE * 2;
constexpr size_t AUX_WINT = 0;
constexpr size_t AUX_U = al256((size_t)NP * D * 2);
constexpr size_t AUX_YDIR = 0;
constexpr size_t AUX_Y = 0;
constexpr size_t AUX_GUT = (size_t)T_LAT * D * 2 > (size_t)2 * T_LAT * 512 * 2 ? (size_t)T_LAT * D * 2 : (size_t)2 * T_LAT * 512 * 2;
constexpr size_t AUX_END1 = AUX_U + (size_t)T_ALL * D * 2;
constexpr size_t AUX_END2 = AUX_YDIR + (size_t)2 * T_LAT * 512 * 2;
static_assert(AUX_YDIR + (size_t)2 * T_LAT * 512 * 2 <= AUX_GUT && AUX_Y + (size_t)T_LAT * D * 2 <= AUX_GUT, "aux overlap");
constexpr size_t AUX_END3 = AUX_GUT + (size_t)NEXP * 512 * D * 2;
constexpr size_t AUX_END = (AUX_END1 > AUX_END2 ? (AUX_END1 > AUX_END3 ? AUX_END1 : AUX_END3) : (AUX_END2 > AUX_END3 ? AUX_END2 : AUX_END3));

#define DNT_PTR(ws, e) ((bf16_t*)((ws) + ((e) < NE_EARLY ? WS_DNT2 : WS_DNT)) + (size_t)(e) * D * DE)
struct Params {
    const float* in[35];
    float* out;
    char* ws;
    char* aux;
    int ph_lo, ph_hi;
};
enum { I_X = 0, I_C, I_CTX, I_CCTX, I_ADAW, I_ADAB, I_NMIX, I_NFFN, I_WIN, I_CONV, I_ALOG, I_DTB, I_ONORM, I_MU, I_W0, I_W2, I_A0, I_A2, I_G2, I_KK, I_KA, I_RK, I_LNG, I_LNB, I_WOA, I_WOB, I_WOUT, I_RG, I_RGB, I_RE, I_REB, I_MG, I_MU_UP, I_MD, I_FIN };

DI float bf2f(bf16_t v) { union { unsigned u; float f; } x; x.u = ((unsigned)v) << 16; return x.f; }
#ifdef EMU
DI bf16_t f2bf(float f) { union { float f; unsigned u; } x; x.f = f; unsigned u = x.u; u += 0x7fffu + ((u >> 16) & 1u); return (bf16_t)(u >> 16); }
DI unsigned pk2(float lo, float hi) { return (unsigned)f2bf(lo) | ((unsigned)f2bf(hi) << 16); }
#else
typedef __bf16 hbf16x2 __attribute__((ext_vector_type(2)));
typedef float f32x2_ __attribute__((ext_vector_type(2)));
DI bf16_t f2bf(float f) { return __builtin_bit_cast(unsigned short, (__bf16)f); }
DI unsigned pk2(float lo, float hi) { const f32x2_ v = {lo, hi}; return __builtin_bit_cast(unsigned, __builtin_convertvector(v, hbf16x2)); }
#endif
DI float sigmoidf_(float x) { return 1.0f / (1.0f + expf(-x)); }
DI float siluf_(float x) { return x / (1.0f + expf(-x)); }
DI float softplusf_(float x) { return x > 20.f ? x : log1pf(expf(x)); }
DI float wave_sum(float v) {
#pragma unroll
    for (int o = 1; o < 64; o <<= 1) v += __shfl_xor(v, o);
    return v;
}
#ifdef EMU
#define MFMA16(a, b, c) emu_mfma16((a), (b), (c))
#define WAVE_SYNC() emu::wave_bar()
#else
#define MFMA16(a, b, c) __builtin_amdgcn_mfma_f32_16x16x32_bf16((a), (b), (c), 0, 0, 0)
#define WAVE_SYNC() asm volatile("s_waitcnt lgkmcnt(0)" ::: "memory")
#endif
#ifdef EMU
#define LDS_BARRIER() __syncthreads()
#else
#define LDS_BARRIER() do { asm volatile("s_waitcnt lgkmcnt(0)" ::: "memory"); __builtin_amdgcn_s_barrier(); asm volatile("" ::: "memory"); } while (0)
#endif

typedef float f32x16 __attribute__((ext_vector_type(16)));
typedef float f32x2_ac __attribute__((ext_vector_type(2)));
typedef short bf16x4 __attribute__((ext_vector_type(4)));
#ifdef EMU
#define MFMA32(a, b, c) emu_mfma32((a), (b), (c))
DI float fexp(float x) { return expf(x); }
DI float flog(float x) { return logf(x); }
DI float frcp(float x) { return 1.0f / x; }
DI float frsq(float x) { return 1.0f / sqrtf(x); }
DI float wave_sum_fast(float v) { return wave_sum(v); }
#else
#define MFMA32(a, b, c) __builtin_amdgcn_mfma_f32_32x32x16_bf16((a), (b), (c), 0, 0, 0)
DI float fexp(float x) { return __expf(x); }
DI float flog(float x) { return __logf(x); }
DI float frcp(float x) { return __builtin_amdgcn_rcpf(x); }
DI float frsq(float x) { return __builtin_amdgcn_rsqf(x); }
#define DPP_ADD(v, ctrl) ((v) + __builtin_bit_cast(float, __builtin_amdgcn_update_dpp(0, __builtin_bit_cast(int, (v)), (ctrl), 0xf, 0xf, false)))
DI float wave_sum_fast(float v) {
    v = DPP_ADD(v, 0xB1); v = DPP_ADD(v, 0x4E); v = DPP_ADD(v, 0x141); v = DPP_ADD(v, 0x140);
    const int iv = __builtin_bit_cast(int, v);
    return (__builtin_bit_cast(float, __builtin_amdgcn_readlane(iv, 0)) + __builtin_bit_cast(float, __builtin_amdgcn_readlane(iv, 16))) +
           (__builtin_bit_cast(float, __builtin_amdgcn_readlane(iv, 32)) + __builtin_bit_cast(float, __builtin_amdgcn_readlane(iv, 48)));
}
#endif
DI float fsigmoid(float x) { return frcp(1.0f + fexp(-x)); }
DI float fsilu(float x) { return x * fsigmoid(x); }
DI float fsoftplus(float x) { return fmaxf(x, 0.f) + flog(1.f + fexp(-fabsf(x))); }
DI float ftanh(float x) { return 1.0f - 2.0f * frcp(1.0f + fexp(2.0f * x)); }

constexpr int LDS_ROW = 40;
constexpr int GEMM_A_BYTES = BM * LDS_ROW * 2, GEMM_B_BYTES = 128 * LDS_ROW * 2;
template <int MR, class ARow>
DI void gemm_kloop(f32x4 (&acc)[MR][4], char* smem, ARow arow, const bf16_t* Bt, int ldb, int K) {
    constexpr int BM = 64 * MR;
    const int tid = tid_x(), lane = tid & 63, wave = tid >> 6, wr = wave >> 1, wc = wave & 1, fr = lane & 15, fq = lane >> 4;
    bf16_t* As = (bf16_t*)smem;
    bf16_t* Bs = (bf16_t*)(smem + 2 * GEMM_A_BYTES);
    constexpr int ACH = BM * 4 / NTHREADS;
    static_assert(ACH >= 1, "tile");
    const bf16_t* ap[ACH];
#pragma unroll
    for (int i = 0; i < ACH; ++i) { const int q = tid + i * NTHREADS; ap[i] = arow(q >> 2) + (q & 3) * 8; }
    const bf16_t* bp = Bt + (size_t)(tid >> 2) * ldb + (tid & 3) * 8;
    u32x4 ra[ACH], rb;
#pragma unroll
    for (int i = 0; i < ACH; ++i) ra[i] = *(const u32x4*)(ap[i]);
    rb = *(const u32x4*)(bp);
    const int nk = K / 32;
    for (int kt = 0; kt < nk; ++kt) {
        const int buf = kt & 1;
#pragma unroll
        for (int i = 0; i < ACH; ++i) { const int q = tid + i * NTHREADS; *(u32x4*)(As + (buf * BM + (q >> 2)) * LDS_ROW + (q & 3) * 8) = ra[i]; }
        *(u32x4*)(Bs + (buf * 128 + (tid >> 2)) * LDS_ROW + (tid & 3) * 8) = rb;
        __syncthreads();
        if (kt + 1 < nk) {
#pragma unroll
            for (int i = 0; i < ACH; ++i) ra[i] = *(const u32x4*)(ap[i] + (kt + 1) * 32);
            rb = *(const u32x4*)(bp + (kt + 1) * 32);
        }
        bf16x8 af[MR], bfr[4];
#pragma unroll
        for (int m = 0; m < MR; ++m) af[m] = *(const bf16x8*)(As + (buf * BM + wr * 16 * MR + m * 16 + fr) * LDS_ROW + fq * 8);
#pragma unroll
        for (int n = 0; n < 4; ++n) bfr[n] = *(const bf16x8*)(Bs + (buf * 128 + wc * 64 + n * 16 + fr) * LDS_ROW + fq * 8);
#pragma unroll
        for (int m = 0; m < MR; ++m)
#pragma unroll
            for (int n = 0; n < 4; ++n) acc[m][n] = MFMA16(af[m], bfr[n], acc[m][n]);
    }
    __syncthreads();
}
template <int MR>
DI void acc_zero(f32x4 (&acc)[MR][4]) {
#pragma unroll
    for (int m = 0; m < MR; ++m)
#pragma unroll
        for (int n = 0; n < 4; ++n) acc[m][n] = (f32x4){0.f, 0.f, 0.f, 0.f};
}

namespace g8 {
constexpr int BM = 256, BK = 64, HALF = 128, HT = HALF * BK;
constexpr int LDS_NEED = 8 * HT * 2;
DI int lds_byte(int r, int c) { const int st = (r >> 4) * 2 + (c >> 5), rr = r & 15, cc = c & 31, ob = rr * 64 + cc * 2; return st * 1024 + (ob ^ (((ob >> 9) & 1) << 5)); }
DI void stage_rc(int b, int& R, int& C) { const int st = b / 1024, sb = b % 1024, swz = sb ^ (((sb >> 9) & 1) << 5); R = (st >> 1) * 16 + swz / 64; C = (st & 1) * 32 + (swz % 64) / 2; }
#ifdef EMU
#define G8_GLDS(src, dst) emu_global_load_lds16((src), (dst))
#define G8_WAIT_V(n)
#define G8_WAIT_L(n)
#define G8_BAR __syncthreads()
#define G8_SCHED
#define G8_PRIO(x)
#else
#define G8_GLDS(src, dst) __builtin_amdgcn_global_load_lds((const unsigned*)(src), (__attribute__((address_space(3))) unsigned*)(dst), 16, 0, 0)
#define G8_WAIT_V(n) asm volatile("s_waitcnt vmcnt(" #n ")" ::: "memory")
#define G8_WAIT_L(n) asm volatile("s_waitcnt lgkmcnt(" #n ")" ::: "memory")
#define G8_BAR __builtin_amdgcn_s_barrier()
#define G8_SCHED __builtin_amdgcn_sched_barrier(0)
#define G8_PRIO(x) __builtin_amdgcn_s_setprio(x)
#endif
typedef f32x4 Acc[2][2][4][2];
template <class AOff>
DI void kloop_g(Acc& acc, char* smem, const bf16_t* A, AOff aoff, const bf16_t* Bt, int ldb, int K, int bcol) {
    bf16_t* shm = (bf16_t*)smem;
    const int tid = tid_x(), wid = tid >> 6, lane = tid & 63, wr = wid >> 2, wc = wid & 3, fr = lane & 15, fq = lane >> 4;
    int ao[2][2];
#pragma unroll
    for (int h = 0; h < 2; ++h)
#pragma unroll
        for (int i = 0; i < 2; ++i) { int R, C; stage_rc(tid * 16 + i * 8192, R, C); ao[h][i] = aoff(h * HALF + R) + C; }
#define G8_STAGE_A(P, h, kt) do { for (int _i = 0; _i < 2; ++_i) { const int _b = tid * 16 + _i * 8192; G8_GLDS(A + (size_t)ao[h][_i] + (size_t)(kt) * BK, (char*)(P) + _b); } } while (0)
#define G8_SA(b, h) (shm + ((b) * 2 + (h)) * HT)
#define G8_SB(b, h) (shm + (4 + (b) * 2 + (h)) * HT)
#define G8_STAGE(P, BASE, LD, br, kt) do { const bf16_t* _g = (BASE) + (size_t)(br) * (LD) + (size_t)(kt) * BK; \
    for (int _i = 0; _i < 2; ++_i) { const int _b = tid * 16 + _i * 8192; int _r, _c; stage_rc(_b, _r, _c); G8_GLDS(_g + (size_t)_r * (LD) + _c, (char*)(P) + _b); } } while (0)
#define G8_LDA(dst, b, h) for (int m = 0; m < 4; ++m) for (int k = 0; k < 2; ++k) dst[m][k] = *(const bf16x8*)((const char*)G8_SA(b, h) + lds_byte(wr * 64 + m * 16 + fr, k * 32 + fq * 8))
#define G8_LDB(dst, b, h) for (int n = 0; n < 2; ++n) for (int k = 0; k < 2; ++k) dst[n][k] = *(const bf16x8*)((const char*)G8_SB(b, h) + lds_byte(wc * 32 + n * 16 + fr, k * 32 + fq * 8))
#define G8_MMA(ai, bj, At_, Bt_) do { G8_PRIO(1); for (int m = 0; m < 4; ++m) for (int n = 0; n < 2; ++n) for (int k = 0; k < 2; ++k) \
    acc[ai][bj][m][n] = MFMA16(Bt_[n][k], At_[m][k], acc[ai][bj][m][n]); G8_PRIO(0); } while (0)
    bf16x8 At[4][2], B0[2][2], B1[2][2];
    const int nt = K / BK;
    G8_STAGE(G8_SB(0, 0), Bt, ldb, bcol, 0); G8_STAGE_A(G8_SA(0, 0), 0, 0);
    G8_STAGE(G8_SB(0, 1), Bt, ldb, bcol + HALF, 0); G8_STAGE_A(G8_SA(0, 1), 1, 0);
    if (wr == 1) G8_BAR;
    G8_WAIT_V(4); G8_BAR;
    G8_STAGE(G8_SB(1, 0), Bt, ldb, bcol, 1); G8_STAGE_A(G8_SA(1, 0), 0, 1); G8_STAGE(G8_SB(1, 1), Bt, ldb, bcol + HALF, 1);
    G8_WAIT_V(6); G8_BAR;
    for (int t = 0; t < nt - 2; t += 2) {
        G8_LDB(B0, 0, 0); G8_SCHED; G8_LDA(At, 0, 0); G8_STAGE_A(G8_SA(1, 1), 1, t + 1);
        G8_WAIT_L(8); G8_BAR; G8_WAIT_L(0); G8_MMA(0, 0, At, B0); G8_BAR; G8_SCHED;
        G8_LDB(B1, 0, 1); G8_STAGE(G8_SB(0, 0), Bt, ldb, bcol, t + 2);
        G8_BAR; G8_WAIT_L(0); G8_MMA(0, 1, At, B1); G8_BAR;
        G8_LDA(At, 0, 1); G8_STAGE_A(G8_SA(0, 0), 0, t + 2);
        G8_BAR; G8_WAIT_L(0); G8_MMA(1, 0, At, B0); G8_BAR; G8_SCHED;
        G8_STAGE(G8_SB(0, 1), Bt, ldb, bcol + HALF, t + 2);
        G8_WAIT_V(6); G8_BAR; G8_MMA(1, 1, At, B1); G8_BAR;
        G8_LDB(B0, 1, 0); G8_SCHED; G8_LDA(At, 1, 0); G8_STAGE_A(G8_SA(0, 1), 1, t + 2);
        G8_WAIT_L(8); G8_BAR; G8_WAIT_L(0); G8_MMA(0, 0, At, B0); G8_BAR; G8_SCHED;
        G8_LDB(B1, 1, 1); G8_STAGE(G8_SB(1, 0), Bt, ldb, bcol, t + 3);
        G8_BAR; G8_WAIT_L(0); G8_MMA(0, 1, At, B1); G8_BAR;
        G8_LDA(At, 1, 1); G8_STAGE_A(G8_SA(1, 0), 0, t + 3);
        G8_BAR; G8_WAIT_L(0); G8_MMA(1, 0, At, B0); G8_BAR; G8_SCHED;
        G8_STAGE(G8_SB(1, 1), Bt, ldb, bcol + HALF, t + 3);
        G8_WAIT_V(6); G8_BAR; G8_MMA(1, 1, At, B1); G8_BAR;
    }
    { G8_LDB(B0, 0, 0); G8_LDA(At, 0, 0); G8_STAGE_A(G8_SA(1, 1), 1, nt - 1);
      G8_BAR; G8_WAIT_L(0); G8_MMA(0, 0, At, B0); G8_BAR;
      G8_LDB(B1, 0, 1); G8_BAR; G8_WAIT_L(0); G8_MMA(0, 1, At, B1); G8_BAR;
      G8_LDA(At, 0, 1); G8_WAIT_V(4); G8_BAR; G8_WAIT_L(0); G8_MMA(1, 0, At, B0); G8_MMA(1, 1, At, B1); G8_BAR; }
    { G8_LDB(B0, 1, 0); G8_LDA(At, 1, 0); G8_WAIT_V(2); G8_BAR; G8_WAIT_L(0); G8_MMA(0, 0, At, B0); G8_BAR;
      G8_LDB(B1, 1, 1); G8_WAIT_V(0); G8_BAR; G8_WAIT_L(0); G8_MMA(0, 1, At, B1); G8_BAR;
      G8_LDA(At, 1, 1); G8_BAR; G8_WAIT_L(0); G8_MMA(1, 0, At, B0); G8_MMA(1, 1, At, B1); G8_BAR; }
    if (wr == 0) G8_BAR;
#undef G8_SA
#undef G8_SB
#undef G8_STAGE
#undef G8_STAGE_A
#undef G8_LDA
#undef G8_LDB
#undef G8_MMA
}
DI void kloop(Acc& acc, char* smem, const bf16_t* A, int lda, const bf16_t* Bt, int ldb, int K, int brow, int bcol) {
    kloop_g(acc, smem, A, [&](int r) { return (brow + r) * lda; }, Bt, ldb, K, bcol);
}
DI bool tile_order(int L, int nM, int nN, int& pm, int& pn) {
    constexpr int NXCD = 8, WGM = 8;
    const int nwg = nM * nN; if (L >= nwg) return false;
    int wgid = L; { const int q = nwg / NXCD, r = nwg % NXCD, xcd = wgid % NXCD, off = wgid / NXCD; wgid = (xcd < r ? xcd * (q + 1) : r * (q + 1) + (xcd - r) * q) + off; }
    const int nig = WGM * nN, gid = wgid / nig, fm = gid * WGM, gsz = (nM - fm) < WGM ? (nM - fm) : WGM;
    pm = fm + ((wgid % nig) % gsz); pn = (wgid % nig) / gsz; return true;
}
DI void acc_zero(Acc& acc) {
#pragma unroll
    for (int a = 0; a < 2; ++a)
#pragma unroll
        for (int b = 0; b < 2; ++b)
#pragma unroll
            for (int m = 0; m < 4; ++m)
#pragma unroll
                for (int n = 0; n < 2; ++n) acc[a][b][m][n] = (f32x4){0.f, 0.f, 0.f, 0.f};
}
template <class F> DI void for_each_quad(const Acc& acc, int brow, int bcol, F f) {
    const int tid = tid_x(), wid = tid >> 6, lane = tid & 63, wr = wid >> 2, wc = wid & 3, fr = lane & 15, fq = lane >> 4;
#pragma unroll
    for (int ai = 0; ai < 2; ++ai)
#pragma unroll
        for (int m = 0; m < 4; ++m)
#pragma unroll
            for (int bj = 0; bj < 2; ++bj)
#pragma unroll
                for (int n = 0; n < 2; ++n) f(brow + ai * HALF + wr * 64 + m * 16 + fr, bcol + bj * HALF + wc * 32 + n * 16 + fq * 4, acc[ai][bj][m][n]);
}
}

constexpr bool USE_G8 = ((NB * CTXL) % 256 == 0) && ((NB * S) % 256 == 0) && (NP % 256 == 0) && (D % 256 == 0) && (D >= 256);
DI int gu_row(int c, int up) {
    if (USE_G8) return (c >> 7) * 256 + ((c >> 6) & 1) * 128 + ((c >> 4) & 3) * 32 + (up ? 16 : 0) + (c & 15);
    return (c >> 6) * 128 + ((c >> 5) & 1) * 64 + ((c >> 4) & 1) * 16 + (c & 15) + (up ? 32 : 0);
}
DI void transpose_item(const float* W, int N, int Nvalid, int k0, int n0, bf16_t* WT, int ldt, int mode, float* scr, int lane) {
    float tv[32];
#pragma unroll
    for (int i = 0; i < 32; ++i) {
        const int kk = 2 * i + (lane >> 5), n = n0 + (lane & 31);
        tv[i] = (n < Nvalid) ? W[(size_t)(k0 + kk) * N + n] : 0.f;
    }
#pragma unroll
    for (int i = 0; i < 32; ++i) scr[(2 * i + (lane >> 5)) * 33 + (lane & 31)] = tv[i];
    WAVE_SYNC();
    const int c = lane & 7;
#pragma unroll
    for (int j = 0; j < 4; ++j) {
        const int nl = (lane >> 3) + 8 * j; const float* s = scr + (8 * c) * 33 + nl;
        u32x4 o; o.x = pk2(s[0], s[33]); o.y = pk2(s[2 * 33], s[3 * 33]); o.z = pk2(s[4 * 33], s[5 * 33]); o.w = pk2(s[6 * 33], s[7 * 33]);
        const int n = n0 + nl; const int row = mode == 0 ? n : gu_row(n, mode == 2);
        *(u32x4*)(WT + (size_t)row * ldt + k0 + 8 * c) = o;
    }
    WAVE_SYNC();
}
DI void transpose_matrix(const float* W, int K, int N, int Npad, bf16_t* WT, int mode, char* smem, int gw, int ngw, int& base) {
    const int lane = tid_x() & 63, wave = tid_x() >> 6;
    float* scr = (float*)smem + wave * (64 * 33);
    const int nkb = K / 64, nnb = Npad / 32, nitems = nkb * nnb;
    int first = ((gw - base) % ngw + ngw) % ngw;
    for (int it = first; it < nitems; it += ngw) {
        const int kb = it / nnb, nb = it % nnb;
        transpose_item(W, N, N, kb * 64, nb * 32, WT, K, mode, scr, lane);
    }
    base = (base + nitems) % ngw;
}

DI void phase0(const Params& p, char* smem) {
    const int tid = tid_x(), lane = tid & 63, wave = tid >> 6;
    if (blockIdx.x == 0 && tid < NEXP) ((int*)(p.ws + WS_CNT))[tid * CNT_STRIDE] = 0;
    if (blockIdx.x == 0 && tid < 2) ((int*)(p.ws + WS_CNT))[tid ? CNT_U2DONE : CNT_TICKET] = 0;
    if (blockIdx.x == 0 && tid == 0) *(unsigned*)(p.ws + WS_BAR) = 0u;
    float* sil = (float*)smem;
    float* red = sil + NV * D;
    const int nitems = 6 * D / 32;
    bool did = false;
    for (int it = blockIdx.x; it < nitems; it += gridDim.x) {
        if (!did) {
            for (int i = tid; i < NV * D; i += NTHREADS) { const int v = i / D, k = i % D; const float cv = v < NB ? p.in[I_C][v * D + k] : p.in[I_CCTX][k]; sil[i] = siluf_(cv); }
            did = true;
        }
        __syncthreads();
        const int col = it * 32 + (lane & 31), rp = lane >> 5;
        float acc[NV];
#pragma unroll
        for (int v = 0; v < NV; ++v) acc[v] = 0.f;
        const int r0 = wave * (D / 8);
        float wv[D / 16];
#pragma unroll
        for (int i = 0; i < D / 16; ++i) wv[i] = p.in[I_ADAW][(size_t)(r0 + 2 * i + rp) * (6 * D) + col];
#pragma unroll
        for (int i = 0; i < D / 16; ++i) {
            const int row = r0 + 2 * i + rp;
#pragma unroll
            for (int v = 0; v < NV; ++v) acc[v] += sil[v * D + row] * wv[i];
        }
#pragma unroll
        for (int v = 0; v < NV; ++v) red[((wave * 2 + rp) * NV + v) * 32 + (lane & 31)] = acc[v];
        __syncthreads();
        if (tid < NV * 32) {
            const int v = tid / 32, cl = tid % 32; float s = p.in[I_ADAB][it * 32 + cl];
            for (int g = 0; g < 16; ++g) s += red[(g * NV + v) * 32 + cl];
            ((float*)(p.ws + WS_MOD))[(size_t)v * 6 * D + it * 32 + cl] = s;
        }
    }
    __syncthreads();
    const int gw = blockIdx.x * 8 + wave, ngw = gridDim.x * 8; int base = 0;
    {
        float* scr = (float*)smem + wave * (64 * 33);
        const int nkb = D / 64, nnb = NP / 32, nitems2 = nkb * nnb;
        for (int it = gw; it < nitems2; it += ngw) { const int kb = it / nnb, nb = it % nnb; transpose_item(p.in[I_WIN], IN_COLS, IN_COLS, kb * 64, nb * 32, (bf16_t*)(p.aux + AUX_WINT), D, 0, scr, lane); }
        base = nitems2 % ngw;
    }
    { float* WRT = (float*)(p.ws + WS_WRT);
      for (int i = blockIdx.x * NTHREADS + tid; i < 36 * D; i += gridDim.x * NTHREADS) { const int j = i / D, k = i % D; WRT[i] = j < 4 ? p.in[I_RG][(size_t)k * 4 + j] : p.in[I_RE][(size_t)k * 32 + (j - 4)]; } }
    transpose_matrix(p.in[I_WOA], 512, D, D, (bf16_t*)(p.ws + WS_WOA), 0, smem, gw, ngw, base);
    transpose_matrix(p.in[I_WOB], 512, D, D, (bf16_t*)(p.ws + WS_WOB), 0, smem, gw, ngw, base);
    transpose_matrix(p.in[I_WOUT], D, D, D, (bf16_t*)(p.ws + WS_WOUT), 0, smem, gw, ngw, base);
    transpose_matrix(p.in[I_G2], 128, 512, 512, (bf16_t*)(p.ws + WS_G2T), 0, smem, gw, ngw, base);
}

constexpr int NSEG = T_ALL / 64, NSEG_CTX = T_CTX / 64;
DI void halo_store(const Params& p, int row, int col, const u32x2& o) {
    int seq, b, j;
    if (row < T_CTX) { seq = 0; b = row / CTXL; j = row % CTXL; } else { seq = 1; const int rr = row - T_CTX; b = rr / S; j = rr % S; }
    const int L = seq ? S : CTXL; const int segbase = seq ? NSEG_CTX + b * (S / 64) : b * (CTXL / 64);
    if (col < 1536) {
        const int jm = j & 63;
        if (jm >= 62 && j + 2 < L) { const int g = segbase + (j >> 6) + 1; *(u32x2*)((bf16_t*)(p.ws + WS_HALO_A) + ((size_t)g * 4 + (jm - 62)) * 1536 + col) = o; }
        if (jm < 2 && j >= 64) { const int g = segbase + (j >> 6) - 1; *(u32x2*)((bf16_t*)(p.ws + WS_HALO_A) + ((size_t)g * 4 + 2 + jm) * 1536 + col) = o; }
    } else if (col >= COL_B0 && col < COL_B0 + 1920) {
        const int js = seq ? (j % GW) * ROWS + j / GW : j; const int jm = js & 63;
        if (jm == 63 && js + 1 < L) { const int g = segbase + (js >> 6) + 1; *(u32x2*)((bf16_t*)(p.ws + WS_HALO_B) + ((size_t)g * 2 + 0) * 1920 + (col - COL_B0)) = o; }
        if (jm == 0 && js >= 64) { const int g = segbase + (js >> 6) - 1; *(u32x2*)((bf16_t*)(p.ws + WS_HALO_B) + ((size_t)g * 2 + 1) * 1920 + (col - COL_B0)) = o; }
    }
}
DI void halo_zero_fill(const Params& p) {
    const int tid = tid_x(), lane = tid & 63, wave = tid >> 6; const int gw = blockIdx.x * 8 + wave, ngw = gridDim.x * 8;
    bf16_t* HA = (bf16_t*)(p.ws + WS_HALO_A); bf16_t* HB = (bf16_t*)(p.ws + WS_HALO_B);
    for (int it = gw; it < NSEG * 2; it += ngw) {
        const int g = it >> 1, side = it & 1;
        const bool ctx = g < NSEG_CTX; const int sg = ctx ? g % (CTXL / 64) : (g - NSEG_CTX) % (S / 64); const int nsg = ctx ? CTXL / 64 : S / 64;
        const bool edge = side ? (sg == nsg - 1) : (sg == 0);
        if (!edge) continue;
        for (int c = lane; c < 384; c += 64) *(u32x4*)(HA + ((size_t)g * 4 + 2 * side) * 1536 + c * 8) = (u32x4){0u, 0u, 0u, 0u};
        for (int c = lane; c < 240; c += 64) *(u32x4*)(HB + ((size_t)g * 2 + side) * 1920 + c * 8) = (u32x4){0u, 0u, 0u, 0u};
    }
}
DI void phase1(const Params& p, char* smem) {
    if (USE_G8) halo_zero_fill(p);
    const int lane = tid_x() & 63, wave = tid_x() >> 6;
    const int gw = blockIdx.x * 8 + wave, ngw = gridDim.x * 8;
    const float* mod = (const float*)(p.ws + WS_MOD);
    bf16_t* U = (bf16_t*)(p.aux + AUX_U);
    auto rowsrc = [&](int r) -> const float* { return r < T_CTX ? p.in[I_CTX] + (size_t)r * D : p.in[I_X] + (size_t)(r - T_CTX) * D; };
    f32x4 xn[D / 256];
    if (gw < T_ALL) {
#pragma unroll
        for (int j = 0; j < D / 256; ++j) xn[j] = *(const f32x4*)(rowsrc(gw) + j * 256 + lane * 4);
    }
    for (int r = gw; r < T_ALL; r += ngw) {
        const int v = r < T_CTX ? NB : (r - T_CTX) / S;
        f32x4 x[D / 256]; float ss = 0.f;
#pragma unroll
        for (int j = 0; j < D / 256; ++j) { x[j] = xn[j]; ss += x[j].x * x[j].x + x[j].y * x[j].y + x[j].z * x[j].z + x[j].w * x[j].w; }
        if (r + ngw < T_ALL) {
#pragma unroll
            for (int j = 0; j < D / 256; ++j) xn[j] = *(const f32x4*)(rowsrc(r + ngw) + j * 256 + lane * 4);
        }
        ss = wave_sum_fast(ss);
        const float rstd = frsq(ss * (1.0f / D) + 1e-6f);
#pragma unroll
        for (int j = 0; j < D / 256; ++j) {
            const int k = j * 256 + lane * 4;
            const f32x4 g = *(const f32x4*)(p.in[I_NMIX] + k), sh = *(const f32x4*)(mod + (size_t)v * 6 * D + k), sc = *(const f32x4*)(mod + (size_t)v * 6 * D + D + k);
            float o0 = x[j].x * rstd * g.x * (1.f + sc.x) + sh.x, o1 = x[j].y * rstd * g.y * (1.f + sc.y) + sh.y;
            float o2 = x[j].z * rstd * g.z * (1.f + sc.z) + sh.z, o3 = x[j].w * rstd * g.w * (1.f + sc.w) + sh.w;
            u32x2 o; o.x = pk2(o0, o1); o.y = pk2(o2, o3);
            *(u32x2*)(U + (size_t)r * D + k) = o;
        }
    }
}

DI void phase2(const Params& p, char* smem) {
    const bf16_t* U = (const bf16_t*)(p.aux + AUX_U); const bf16_t* WT = (const bf16_t*)(p.aux + AUX_WINT);
    bf16_t* PL = (bf16_t*)(p.ws + WS_PLAT); bf16_t* PC = (bf16_t*)(p.ws + WS_PCTX); float* AB = (float*)(p.ws + WS_AB);
    if (USE_G8) {
        constexpr int NT = NP / 256, MT = T_ALL / 256, NT_CTX = (CTX_COLS + 255) / 256;
        for (int t = blockIdx.x; t < MT * NT; t += gridDim.x) {
            int mt, nt; if (!g8::tile_order(t, MT, NT, mt, nt)) break;
            const int brow = mt * 256, bcol = nt * 256; const bool isctx = brow < T_CTX;
            if (isctx && nt >= NT_CTX) continue;
            g8::Acc acc; g8::acc_zero(acc);
            g8::kloop(acc, smem, U, D, WT, D, D, brow, bcol);
            constexpr int OLD_ = 264; bf16_t* OT = (bf16_t*)smem;
            g8::for_each_quad(acc, brow, bcol, [&](int row, int col, const f32x4& v) {
                u32x2 o; o.x = pk2(v.x, v.y); o.y = pk2(v.z, v.w);
                *(u32x2*)(OT + (row - brow) * OLD_ + (col - bcol)) = o;
                if (col >= 2048 && col < 2064) *(f32x4*)(AB + (size_t)row * 16 + (col - 2048)) = v;
                halo_store(p, row, col, o);
            });
            __syncthreads();
            {
                const int tid = tid_x(); const int ncols = isctx ? CTX_COLS : IN_COLS;
                bf16_t* dst = isctx ? PC + (size_t)brow * CTX_COLS : PL + (size_t)(brow - T_CTX) * IN_COLS;
#pragma unroll
                for (int i = 0; i < 16; ++i) {
                    const int ch = tid + i * NTHREADS, row = ch >> 5, c8 = (ch & 31) * 8, col = bcol + c8;
                    if (col < ncols) *(u32x4*)(dst + (size_t)row * ncols + col) = *(const u32x4*)(OT + row * OLD_ + c8);
                }
            }
            __syncthreads();
        }
        return;
    }
    const int tid = tid_x(), lane = tid & 63, wave = tid >> 6, wr = wave >> 1, wc = wave & 1, fr = lane & 15, fq = lane >> 4;
    constexpr int NT = NP / 128, MT = T_ALL / BM, NT_CTX = (CTX_COLS + 127) / 128;
    for (int t = blockIdx.x; t < MT * NT; t += gridDim.x) {
        const int mt = t / NT, nt = t % NT; const int row0 = mt * BM; const bool isctx = row0 < T_CTX;
        if (isctx && nt >= NT_CTX) continue;
        f32x4 acc[MREP][4]; acc_zero(acc);
        gemm_kloop(acc, smem, [&](int i) { return U + (size_t)(row0 + i) * D; }, WT + (size_t)nt * 128 * D, D, D);
#pragma unroll
        for (int m = 0; m < MREP; ++m)
#pragma unroll
            for (int n = 0; n < 4; ++n)
#pragma unroll
                for (int j = 0; j < 4; ++j) {
                    const int row = row0 + wr * 16 * MREP + m * 16 + fq * 4 + j, col = nt * 128 + wc * 64 + n * 16 + fr; const float v = acc[m][n][j];
                    if (isctx) { if (col < CTX_COLS) PC[(size_t)row * CTX_COLS + col] = f2bf(v); }
                    else { if (col < IN_COLS) PL[(size_t)(row - T_CTX) * IN_COLS + col] = f2bf(v); }
                    if (col >= 2048 && col < 2064) AB[(size_t)row * 16 + (col - 2048)] = v;
                }
    }
}


DI int crow(int g, int h) { return (g & 3) + 8 * (g >> 2) + 4 * h; }
template <int S_> DI bf16x8 pack_acc(const f32x16& x) {
    u32x4 r;
    r.x = pk2(x[8 * S_ + 0], x[8 * S_ + 1]); r.y = pk2(x[8 * S_ + 2], x[8 * S_ + 3]); r.z = pk2(x[8 * S_ + 4], x[8 * S_ + 5]); r.w = pk2(x[8 * S_ + 6], x[8 * S_ + 7]);
    return __builtin_bit_cast(bf16x8, r);
}
DI bf16x8 ld_nat(const bf16_t* row, int s, int h) { return *(const bf16x8*)(row + 16 * s + 8 * h); }
DI bf16x8 ld_perm(const bf16_t* row, int s, int h) {
    const bf16x4 lo = *(const bf16x4*)(row + 16 * s + 4 * h), hi = *(const bf16x4*)(row + 16 * s + 8 + 4 * h);
    return __builtin_shufflevector(lo, hi, 0, 1, 2, 3, 4, 5, 6, 7);
}
DI f32x16 zero16() { f32x16 z;
#pragma unroll
    for (int i = 0; i < 16; ++i) z[i] = 0.f;
    return z; }
#define TGET(i) ((i) < 16 ? t0[(i) & 15] : t1[(i) & 15])
DI void invert32_col(const float* Lf, f32x16& t0, f32x16& t1, int c) {
#pragma unroll
    for (int i = 0; i < 32; ++i) {
        float s0 = 0.f, s1 = 0.f, s2 = 0.f, s3 = 0.f;
#pragma unroll
        for (int j4 = 0; j4 < (i + 3) / 4; ++j4) {
            const f32x4 l = *(const f32x4*)(Lf + i * 32 + 4 * j4);
            if (4 * j4 + 0 < i) s0 += l.x * TGET(4 * j4 + 0);
            if (4 * j4 + 1 < i) s1 += l.y * TGET(4 * j4 + 1);
            if (4 * j4 + 2 < i) s2 += l.z * TGET(4 * j4 + 2);
            if (4 * j4 + 3 < i) s3 += l.w * TGET(4 * j4 + 3);
        }
        float sm = -((s0 + s1) + (s2 + s3));
#ifndef EMU
        asm volatile("" : "+v"(sm));
#endif
        const float v = (i > c) ? sm : (i == c ? 1.f : 0.f);
        if (i < 16) t0[i & 15] = v; else t1[i & 15] = v;
    }
}

DI void seg_info(int g, int& seq, int& b, int& j0) {
    if (g < NSEG_CTX) { seq = 0; b = g / (CTXL / 64); j0 = (g % (CTXL / 64)) * 64; } else { const int g2 = g - NSEG_CTX; seq = 1; b = g2 / (S / 64); j0 = (g2 % (S / 64)) * 64; }
}
DI const bf16_t* seq_row(const Params& p, int seq, int b, int j, bool scan_order) {
    if (seq) { const int l = scan_order ? (j % ROWS) * GW + j / ROWS : j; return (const bf16_t*)(p.ws + WS_PLAT) + (size_t)(b * S + l) * IN_COLS; }
    return (const bf16_t*)(p.ws + WS_PCTX) + (size_t)(b * CTXL + j) * CTX_COLS;
}
DI void phase_halo(const Params& p, char* smem) {
    if (USE_G8) return;
    const int tid = tid_x(), lane = tid & 63, wave = tid >> 6;
    const int gw = blockIdx.x * 8 + wave, ngw = gridDim.x * 8;
    bf16_t* HA = (bf16_t*)(p.ws + WS_HALO_A); bf16_t* HB = (bf16_t*)(p.ws + WS_HALO_B);
    for (int it = gw; it < NSEG * 6; it += ngw) {
        const int g = it / 6, hr = it % 6; int seq, b, j0; seg_info(g, seq, b, j0);
        const int L = seq ? S : CTXL;
        if (hr < 4) {
            const int j = hr < 2 ? j0 - 2 + hr : j0 + 62 + hr; const bool ok = j >= 0 && j < L;
            const bf16_t* src = seq_row(p, seq, b, ok ? j : 0, false);
            for (int c = lane; c < 192; c += 64) { u32x4 v = {0u, 0u, 0u, 0u}; if (ok) v = *(const u32x4*)(src + c * 8); *(u32x4*)(HA + ((size_t)g * 4 + hr) * 1536 + c * 8) = v; }
        } else {
            const int j = hr == 4 ? j0 - 1 : j0 + 64; const bool ok = j >= 0 && j < L;
            const bf16_t* src = seq_row(p, seq, b, ok ? j : 0, true) + COL_B0;
            for (int c = lane; c < 240; c += 64) { u32x4 v = {0u, 0u, 0u, 0u}; if (ok) v = *(const u32x4*)(src + c * 8); *(u32x4*)(HB + ((size_t)g * 2 + (hr - 4)) * 1920 + c * 8) = v; }
        }
    }
}
DI f32x2_ac unpk2(unsigned w) { return (f32x2_ac){bf2f((bf16_t)(w & 0xffffu)), bf2f((bf16_t)(w >> 16))}; }
DI void unpack8(const u32x4& q, float (&f)[8]) {
    f[0] = bf2f((bf16_t)(q.x & 0xffffu)); f[1] = bf2f((bf16_t)(q.x >> 16)); f[2] = bf2f((bf16_t)(q.y & 0xffffu)); f[3] = bf2f((bf16_t)(q.y >> 16));
    f[4] = bf2f((bf16_t)(q.z & 0xffffu)); f[5] = bf2f((bf16_t)(q.z >> 16)); f[6] = bf2f((bf16_t)(q.w & 0xffffu)); f[7] = bf2f((bf16_t)(q.w >> 16));
}
DI float row16_sum(float v) {
#ifdef EMU
    v += __shfl_xor(v, 1); v += __shfl_xor(v, 2); v += __shfl_xor(v, 4); v += __shfl_xor(v, 8); return v;
#else
    v = DPP_ADD(v, 0xB1); v = DPP_ADD(v, 0x4E); v = DPP_ADD(v, 0x141); v = DPP_ADD(v, 0x140); return v;
#endif
}
DI void phase_fir(const Params& p, char* smem) {
    const int tid = tid_x(), lane = tid & 63, wave = tid >> 6;
    const int gw = blockIdx.x * 8 + wave, ngw = gridDim.x * 8;
    const bf16_t* HA = (const bf16_t*)(p.ws + WS_HALO_A); const bf16_t* HB = (const bf16_t*)(p.ws + WS_HALO_B);
    constexpr int NA = NSEG * 3, NBI = NSEG * 4;
    const u32x4 z4 = {0u, 0u, 0u, 0u};
    for (int it = gw; it < NA + NBI; it += ngw) {
        if (it < NA) {
            const int g = it / 3, s = it % 3; int seq, b, j0; seg_info(g, seq, b, j0);
            const int col = s * 512 + 8 * lane, ldp = seq ? IN_COLS : CTX_COLS;
            bf16_t* base = (bf16_t*)seq_row(p, seq, b, j0, false) + col;
            const bf16_t* hal = HA + (size_t)g * 4 * 1536 + col;
            float cw[5][8];
#pragma unroll
            for (int t = 0; t < 5; ++t) { const f32x4 w0 = *(const f32x4*)(p.in[I_CONV] + t * 1536 + col), w1 = *(const f32x4*)(p.in[I_CONV] + t * 1536 + col + 4);
                cw[t][0] = w0.x; cw[t][1] = w0.y; cw[t][2] = w0.z; cw[t][3] = w0.w; cw[t][4] = w1.x; cw[t][5] = w1.y; cw[t][6] = w1.z; cw[t][7] = w1.w; }
            u32x4 win[12], nxt[8];
            win[0] = *(const u32x4*)(hal); win[1] = *(const u32x4*)(hal + 1536);
            win[2] = *(const u32x4*)(base); win[3] = *(const u32x4*)(base + ldp);
#pragma unroll
            for (int i = 0; i < 8; ++i) win[4 + i] = *(const u32x4*)(base + (size_t)(2 + i) * ldp);
#pragma unroll 1
            for (int blk = 0; blk < 8; ++blk) {
                if (blk < 7) {
#pragma unroll
                    for (int i = 0; i < 8; ++i) { const int t = 8 * blk + 10 + i; nxt[i] = t < 64 ? *(const u32x4*)(base + (size_t)t * ldp) : *(const u32x4*)(hal + (size_t)(2 + (t - 64)) * 1536); }
                }
#pragma unroll
                for (int i = 0; i < 8; ++i) {
                    float a[8];
#pragma unroll
                    for (int e = 0; e < 8; ++e) a[e] = 0.f;
#pragma unroll
                    for (int t = 0; t < 5; ++t) { float x[8]; unpack8(win[i + t], x);
#pragma unroll
                        for (int e = 0; e < 8; ++e) a[e] += x[e] * cw[t][e]; }
                    float ss = 0.f;
#pragma unroll
                    for (int e = 0; e < 8; ++e) { a[e] = fsilu(a[e]); ss += a[e] * a[e]; }
                    if (s < 2) { const float sc = frsq(row16_sum(ss) + 1e-6f) * (s == 0 ? 0.08838834764831845f : 1.0f);
#pragma unroll
                        for (int e = 0; e < 8; ++e) a[e] *= sc; }
                    u32x4 o; o.x = pk2(a[0], a[1]); o.y = pk2(a[2], a[3]); o.z = pk2(a[4], a[5]); o.w = pk2(a[6], a[7]);
                    *(u32x4*)(base + (size_t)(8 * blk + i) * ldp) = o;
                }
#pragma unroll
                for (int i = 0; i < 4; ++i) win[i] = win[8 + i];
#pragma unroll
                for (int i = 0; i < 8; ++i) win[4 + i] = nxt[i];
            }
        } else {
            const int it2 = it - NA, g = it2 / 4, sl = it2 % 4; int seq, b, j0; seg_info(g, seq, b, j0);
            const int bcol = sl * 512 + 8 * lane; const bool act = bcol < 1920;
            const int bc = act ? bcol : 0, col = COL_B0 + bc;
            float mu8[8];
            { const f32x4 m0 = *(const f32x4*)(p.in[I_MU] + bc), m1 = *(const f32x4*)(p.in[I_MU] + bc + 4); mu8[0] = m0.x; mu8[1] = m0.y; mu8[2] = m0.z; mu8[3] = m0.w; mu8[4] = m1.x; mu8[5] = m1.y; mu8[6] = m1.z; mu8[7] = m1.w; }
            const bool th = (bc >= 1536 && bc < 1664);
            const bf16_t* hal = HB + (size_t)g * 2 * 1920 + bc;
            u32x4 win[10], nxt[8];
            win[0] = *(const u32x4*)(hal); win[1] = *(const u32x4*)(seq_row(p, seq, b, j0, true) + col);
#pragma unroll
            for (int i = 0; i < 8; ++i) win[2 + i] = *(const u32x4*)(seq_row(p, seq, b, j0 + 1 + i, true) + col);
#pragma unroll 1
            for (int blk = 0; blk < 8; ++blk) {
                if (blk < 7) {
#pragma unroll
                    for (int i = 0; i < 8; ++i) { const int t = 8 * blk + 9 + i; nxt[i] = t < 64 ? *(const u32x4*)(seq_row(p, seq, b, j0 + t, true) + col) : *(const u32x4*)(hal + 1920); }
                }
#pragma unroll
                for (int i = 0; i < 8; ++i) {
                    float pv[8], cu[8], nx[8], x[8]; unpack8(win[i], pv); unpack8(win[i + 1], cu); unpack8(win[i + 2], nx);
#pragma unroll
                    for (int e = 0; e < 8; ++e) { x[e] = cu[e] + (0.5f * (pv[e] + nx[e]) - cu[e]) * mu8[e]; if (th) x[e] = ftanh(x[e]); }
                    u32x4 o; o.x = pk2(x[0], x[1]); o.y = pk2(x[2], x[3]); o.z = pk2(x[4], x[5]); o.w = pk2(x[6], x[7]);
                    if (act) *(u32x4*)((bf16_t*)seq_row(p, seq, b, j0 + 8 * blk + i, true) + col) = o;
                }
                win[0] = win[8]; win[1] = win[9];
#pragma unroll
                for (int i = 0; i < 8; ++i) win[2 + i] = nxt[i];
            }
        }
    }
}

constexpr int GC = 32;
constexpr int G_NT = (CTXL + S) / GC;
constexpr int LD128 = 136, LD64 = 72, LD32 = 40;
DI void chunk_pos(int x, int d, int& seg, int& j0) {
    constexpr int n0 = CTXL / GC, n1 = S / GC;
    if (x < n0) { seg = 0; j0 = (d ? n0 - 1 - x : x) * GC; } else { seg = 1; const int xx = x - n0; j0 = (d ? n1 - 1 - xx : xx) * GC; }
}

template <class Emit>
DI void invert32_blocked(const float* Lf, bf16_t* scr, int lane, Emit emit) {
    bf16_t* T00T = scr; bf16_t* T11R = scr + 16 * LD32; bf16_t* L10R = scr + 2 * 16 * LD32; bf16_t* P1T = scr + 3 * 16 * LD32;
    const int blk = lane >> 5, c = lane & 15, r = lane & 31, fr = lane & 15, fq = lane >> 4;
    f32x16 t;
    const float* Lb = Lf + (16 * blk) * 32 + 16 * blk;
#pragma unroll
    for (int i = 0; i < 16; ++i) {
        float s0 = 0.f, s1 = 0.f, s2 = 0.f, s3 = 0.f;
#pragma unroll
        for (int j4 = 0; j4 < (i + 3) / 4; ++j4) {
            const f32x4 l = *(const f32x4*)(Lb + i * 32 + 4 * j4);
            if (4 * j4 + 0 < i) s0 += l.x * t[4 * j4 + 0];
            if (4 * j4 + 1 < i) s1 += l.y * t[4 * j4 + 1];
            if (4 * j4 + 2 < i) s2 += l.z * t[4 * j4 + 2];
            if (4 * j4 + 3 < i) s3 += l.w * t[4 * j4 + 3];
        }
        float sm = -((s0 + s1) + (s2 + s3));
#ifndef EMU
        asm volatile("" : "+v"(sm));
#endif
        t[i] = (i > c) ? sm : (i == c ? 1.f : 0.f);
    }
    if (r < 16) {
        if (blk == 0) {
#pragma unroll
            for (int q = 0; q < 4; ++q) { u32x2 o; o.x = pk2(t[4 * q], t[4 * q + 1]); o.y = pk2(t[4 * q + 2], t[4 * q + 3]); *(u32x2*)(T00T + c * LD32 + 4 * q) = o; }
        } else {
#pragma unroll
            for (int i = 0; i < 16; ++i) T11R[i * LD32 + c] = f2bf(t[i]);
        }
    }
    { const int i = lane >> 2, j4 = (lane & 3) * 4; const f32x4 l = *(const f32x4*)(Lf + (16 + i) * 32 + j4);
      u32x2 o; o.x = pk2(l.x, l.y); o.y = pk2(l.z, l.w); *(u32x2*)(L10R + i * LD32 + j4) = o; }
    WAVE_SYNC();
    const bf16x8 zf = {0, 0, 0, 0, 0, 0, 0, 0};
    f32x4 p1 = {0.f, 0.f, 0.f, 0.f};
    {
        const bf16x8 af = fq < 2 ? *(const bf16x8*)(L10R + fr * LD32 + 8 * fq) : zf, bfm = fq < 2 ? *(const bf16x8*)(T00T + fr * LD32 + 8 * fq) : zf;
        p1 = MFMA16(af, bfm, p1);
    }
    { u32x2 o; o.x = pk2(p1[0], p1[1]); o.y = pk2(p1[2], p1[3]); *(u32x2*)(P1T + fr * LD32 + 4 * fq) = o; }
    WAVE_SYNC();
    f32x4 p2 = {0.f, 0.f, 0.f, 0.f};
    {
        const bf16x8 af = fq < 2 ? *(const bf16x8*)(T11R + fr * LD32 + 8 * fq) : zf, bfm = fq < 2 ? *(const bf16x8*)(P1T + fr * LD32 + 8 * fq) : zf;
        p2 = MFMA16(af, bfm, p2);
    }
#pragma unroll
    for (int j = 0; j < 4; ++j) emit(16 + 4 * fq + j, fr, -p2[j]);
    if (r < 16) {
#pragma unroll
        for (int i = 0; i < 16; ++i) { emit(16 * blk + i, 16 * blk + c, t[i]); if (blk == 0) emit(i, 16 + c, 0.f); }
    }
}
DI float half_sum(float v, int hh) {
#ifdef EMU
    v += __shfl_xor(v, 1); v += __shfl_xor(v, 2); v += __shfl_xor(v, 4); v += __shfl_xor(v, 8); v += __shfl_xor(v, 16); return v;
#else
    v = DPP_ADD(v, 0xB1); v = DPP_ADD(v, 0x4E); v = DPP_ADD(v, 0x141); v = DPP_ADD(v, 0x140);
    const int iv = __builtin_bit_cast(int, v);
    const float s0 = __builtin_bit_cast(float, __builtin_amdgcn_readlane(iv, 0)) + __builtin_bit_cast(float, __builtin_amdgcn_readlane(iv, 16));
    const float s1 = __builtin_bit_cast(float, __builtin_amdgcn_readlane(iv, 32)) + __builtin_bit_cast(float, __builtin_amdgcn_readlane(iv, 48));
    return hh ? s1 : s0;
#endif
}
constexpr int GL_Q = 0;
constexpr int GL_KT = GL_Q + 3 * 32 * LD128 * 2;
constexpr int GL_VT = GL_KT + 3 * 128 * LD32 * 2;
constexpr int GL_K = GL_VT + 3 * 128 * LD32 * 2;
constexpr int GL_QKM = GL_K + 32 * LD128 * 2;
constexpr int GL_LF = GL_QKM + 2 * 32 * LD32 * 2;
constexpr int GL_TP = GL_LF + 32 * 32 * 4;
constexpr int GL_TPP = GL_TP + 32 * LD32 * 2;
constexpr int GL_WN = GL_TPP + 2 * 32 * LD32 * 2;
constexpr int GL_SC = GL_WN + 32 * LD128 * 2;
constexpr int GL_GC = GL_SC + 2 * 8 * 32 * 4;
constexpr int GL_INV = GL_GC + 8 * 32 * 4;
constexpr int GL_RAW = GL_INV + 4 * 16 * LD32 * 2;
constexpr int GL_END = GL_RAW + 32 * 384 * 2;
static_assert(GL_END <= LDS_BYTES, "gdn lds");

DI void gdn_chain2(const Params& p, char* smem, int item) {
    const int d = item / (NB * H_A), b = (item / H_A) % NB, h = item % H_A;
    const int tid = tid_x(), lane = tid & 63, wave0_ = tid >> 6;
    bf16_t* Qs = (bf16_t*)(smem + GL_Q); bf16_t* KTs = (bf16_t*)(smem + GL_KT); bf16_t* VTs = (bf16_t*)(smem + GL_VT); bf16_t* Ks = (bf16_t*)(smem + GL_K);
    bf16_t* QKMs = (bf16_t*)(smem + GL_QKM); float* Lf = (float*)(smem + GL_LF); bf16_t* Tp = (bf16_t*)(smem + GL_TP); bf16_t* Tpp = (bf16_t*)(smem + GL_TPP);
    bf16_t* Wn = (bf16_t*)(smem + GL_WN); float* SC = (float*)(smem + GL_SC); float* GCs = (float*)(smem + GL_GC);
    const float alog = p.in[I_ALOG][d * 4 + h], dtb = p.in[I_DTB][d * 4 + h], negea = -expf(alog);
    bf16_t* ODIR = (bf16_t*)(p.ws + WS_OA);
    __syncthreads();
    f32x16 St[4];
#pragma unroll
    for (int ct = 0; ct < 4; ++ct) St[ct] = zero16();
    bf16_t* RAW = (bf16_t*)(smem + GL_RAW);
    float pa = 0.f, pbt = 0.f;
    auto prefetch = [&](int x, int inst0, int ninst) {
        int seg, j0; chunk_pos(x, d, seg, j0);
        const int ldp = seg ? IN_COLS : CTX_COLS;
        const bf16_t* pbase = seg ? (const bf16_t*)(p.ws + WS_PLAT) + (size_t)b * S * IN_COLS : (const bf16_t*)(p.ws + WS_PCTX) + (size_t)b * CTXL * CTX_COLS;
        for (int inst = inst0; inst < inst0 + ninst; ++inst) {
            const int q = inst * 64 + lane, row = q / 48, c16 = q % 48;
            const bf16_t* src = pbase + (size_t)(j0 + row) * ldp + (c16 >> 4) * 512 + h * 128 + (c16 & 15) * 8;
#ifdef EMU
            emu_global_load_lds16(src, (char*)RAW + q * 16);
#else
            __builtin_amdgcn_global_load_lds((const unsigned*)src, (__attribute__((address_space(3))) unsigned*)((char*)RAW + q * 16), 16, 0, 0);
#endif
        }
    };
    auto prefetch_ab = [&](int x, int g0, int ng) {
        int seg, j0; chunk_pos(x, d, seg, j0);
        const float* abbase = (const float*)(p.ws + WS_AB) + (size_t)(seg ? T_CTX + b * S : b * CTXL) * 16;
        if (lane < 4 * ng) { const int j = j0 + 4 * g0 + lane; pa = abbase[(size_t)j * 16 + d * 4 + h]; pbt = abbase[(size_t)j * 16 + 8 + d * 4 + h]; }
    };
    auto x1 = [&](int c, int g0, int ng) {
        const int q3 = c % 3, parc = c & 1;
        for (int gi = 0; gi < ng; ++gi) {
            const int g = g0 + gi;
            const int i0 = d ? (GC - 4 - 4 * g) : 4 * g;
            bf16_t kt[2][4], vt[2][4];
#pragma unroll
            for (int t = 0; t < 4; ++t) {
                const int e = d ? 3 - t : t, i = i0 + e;
                const unsigned wq = *(const unsigned*)(RAW + (4 * g + t) * 384 + 2 * lane), wk = *(const unsigned*)(RAW + (4 * g + t) * 384 + 128 + 2 * lane), wv = *(const unsigned*)(RAW + (4 * g + t) * 384 + 256 + 2 * lane);
                *(unsigned*)(Qs + (q3 * 32 + i) * LD128 + 2 * lane) = wq;
                *(unsigned*)(Ks + i * LD128 + 2 * lane) = wk;
                kt[0][e] = (bf16_t)(wk & 0xffffu); kt[1][e] = (bf16_t)(wk >> 16); vt[0][e] = (bf16_t)(wv & 0xffffu); vt[1][e] = (bf16_t)(wv >> 16);
            }
#pragma unroll
            for (int q = 0; q < 2; ++q) {
                u32x2 o; o.x = (unsigned)kt[q][0] | ((unsigned)kt[q][1] << 16); o.y = (unsigned)kt[q][2] | ((unsigned)kt[q][3] << 16);
                *(u32x2*)(KTs + (q3 * 128 + 2 * lane + q) * LD32 + i0) = o;
                u32x2 o2; o2.x = (unsigned)vt[q][0] | ((unsigned)vt[q][1] << 16); o2.y = (unsigned)vt[q][2] | ((unsigned)vt[q][3] << 16);
                *(u32x2*)(VTs + (q3 * 128 + 2 * lane + q) * LD32 + i0) = o2;
            }
        }
        if (lane < 4 * ng) { const int jo = 4 * g0 + lane; const int i = d ? (GC - 1 - jo) : jo;
            SC[(parc * 8 + 0) * 32 + i] = negea * fsoftplus(pa + dtb); SC[(parc * 8 + 1) * 32 + i] = fsigmoid(pbt); }
    };
    prefetch(0, 3 * wave0_, 3); prefetch_ab(0, wave0_, 1);
#ifndef EMU
    asm volatile("s_waitcnt vmcnt(0)" ::: "memory");
#endif
    const int r0_ = lane & 31, hh0_ = lane >> 5;
    __syncthreads();
    x1(0, wave0_, 1);
    LDS_BARRIER();
    if (wave0_ >= 4 && wave0_ < 7 && 1 < G_NT) { prefetch(1, 9 * (wave0_ - 4), wave0_ == 6 ? 6 : 9); prefetch_ab(1, 3 * (wave0_ - 4), wave0_ == 6 ? 2 : 3); }
    for (int it = -1; it < G_NT; ++it) {
        int r = r0_, hh = hh0_, wave = wave0_;
#ifndef EMU
        asm volatile("" : "+v"(r), "+v"(hh), "+v"(wave));
#endif
        const int xn = it + 1, par = xn & 1, q3 = xn % 3;
        const int g0w = 3 * (wave - 4), ngw = wave == 6 ? 2 : 3;
        if (xn < G_NT) {
            const float* graw = SC + (par * 8 + 0) * 32;
            float gcv = 0.f;
#pragma unroll
            for (int s4 = 0; s4 < 8; ++s4) { const f32x4 g4 = *(const f32x4*)(graw + 4 * s4);
                gcv += (4 * s4 + 0 <= r ? g4.x : 0.f) + (4 * s4 + 1 <= r ? g4.y : 0.f) + (4 * s4 + 2 <= r ? g4.z : 0.f) + (4 * s4 + 3 <= r ? g4.w : 0.f); }
            if (lane < 32) GCs[wave * 32 + r] = gcv;
            if (wave == 7 && lane < 32) {
                float gl = 0.f;
#pragma unroll
                for (int s4 = 0; s4 < 8; ++s4) { const f32x4 g4 = *(const f32x4*)(graw + 4 * s4); gl += (g4.x + g4.y) + (g4.z + g4.w); }
                const float be = SC[(par * 8 + 1) * 32 + r];
                SC[(par * 8 + 3) * 32 + r] = fexp(gcv); SC[(par * 8 + 4) * 32 + r] = fexp(gl - gcv); SC[(par * 8 + 5) * 32 + r] = be * fexp(gcv); SC[(par * 8 + 6) * 32 + r] = fexp(gl);
            }
            const int pr = wave >> 2, th = (wave >> 1) & 1, ch = wave & 1, fr = lane & 15, fq = lane >> 4;
            const bf16_t* arow = (pr == 0 ? Ks : Qs + q3 * 32 * LD128) + (16 * th + fr) * LD128 + 8 * fq; const bf16_t* brow = Ks + (16 * ch + fr) * LD128 + 8 * fq;
            f32x4 cc = {0.f, 0.f, 0.f, 0.f};
#pragma unroll
            for (int ks = 0; ks < 4; ++ks) cc = MFMA16(*(const bf16x8*)(arow + 32 * ks), *(const bf16x8*)(brow + 32 * ks), cc);
            WAVE_SYNC();
            const int jj = 16 * ch + fr; const float gj = GCs[wave * 32 + jj];
#pragma unroll
            for (int j = 0; j < 4; ++j) {
                const int i = 16 * th + 4 * fq + j; const float dec = fexp(GCs[wave * 32 + i] - gj);
                if (pr == 0) Lf[i * 32 + jj] = (jj < i) ? SC[(par * 8 + 1) * 32 + i] * cc[j] * dec : 0.f;
                else QKMs[(par * 32 + i) * LD32 + jj] = f2bf((jj <= i) ? cc[j] * dec : 0.f);
            }
        }
#ifndef EMU
        asm volatile("s_waitcnt vmcnt(0)" ::: "memory");
#endif
        LDS_BARRIER();
        if (wave == 7 && xn < G_NT) {
            const float* sb1 = SC + (par * 8 + 5) * 32; const float* sb0 = SC + (par * 8 + 1) * 32; bf16_t* Tppw = Tpp + par * 32 * LD32;
            invert32_blocked(Lf, (bf16_t*)(smem + GL_INV), lane, [&](int i, int c, float v) { Tp[i * LD32 + c] = f2bf(v * sb1[c]); Tppw[i * LD32 + c] = f2bf(v * sb0[c]); });
        }
        if (wave >= 4 && wave < 7 && xn + 1 < G_NT) {
            x1(xn + 1, g0w, ngw);
            if (xn + 2 < G_NT) {
                WAVE_SYNC();
                prefetch(xn + 2, 9 * (wave - 4), wave == 6 ? 6 : 9); prefetch_ab(xn + 2, g0w, ngw);
            }
        }
        if (wave < 4 && it >= 0) {
            const int pc = it & 1, qc = it % 3; int seg = 0, j0 = 0; chunk_pos(it, d, seg, j0);
            const bf16_t* Qc = Qs + qc * 32 * LD128; const bf16_t* KTc = KTs + qc * 128 * LD32; const bf16_t* VTc = VTs + qc * 128 * LD32;
            const bf16_t* QKc = QKMs + pc * 32 * LD32; const bf16_t* Tc = Tpp + pc * 32 * LD32; const float* sc = SC + pc * 8 * 32;
            f32x16 vn = zero16();
#pragma unroll
            for (int s = 0; s < 2; ++s) vn = MFMA32(ld_nat(Tc + r * LD32, s, hh), ld_nat(VTc + (32 * wave + r) * LD32, s, hh), vn);
            f32x16 oacc = zero16();
#define GDN_KSTEP(s) { const bf16x8 sb = pack_acc<(s) & 1>(St[(s) >> 1]); vn = MFMA32(ld_perm(Wn + r * LD128, (s), hh), sb, vn); oacc = MFMA32(ld_perm(Qc + r * LD128, (s), hh), sb, oacc); }
            GDN_KSTEP(0) GDN_KSTEP(1) GDN_KSTEP(2) GDN_KSTEP(3) GDN_KSTEP(4) GDN_KSTEP(5) GDN_KSTEP(6) GDN_KSTEP(7)
#undef GDN_KSTEP
#pragma unroll
            for (int g = 0; g < 16; ++g) oacc[g] *= sc[3 * 32 + crow(g, hh)];
            { const bf16x8 v0 = pack_acc<0>(vn), v1 = pack_acc<1>(vn);
              oacc = MFMA32(ld_perm(QKc + r * LD32, 0, hh), v0, oacc); oacc = MFMA32(ld_perm(QKc + r * LD32, 1, hh), v1, oacc); }
#pragma unroll
            for (int g = 0; g < 16; ++g) vn[g] *= sc[4 * 32 + crow(g, hh)];
            const float ge = sc[6 * 32];
            { const bf16x8 v0 = pack_acc<0>(vn), v1 = pack_acc<1>(vn);
#pragma unroll
              for (int ct = 0; ct < 4; ++ct) {
#pragma unroll
                  for (int g = 0; g < 16; ++g) St[ct][g] *= ge;
                  St[ct] = MFMA32(ld_perm(KTc + (32 * ct + r) * LD32, 0, hh), v0, St[ct]);
                  St[ct] = MFMA32(ld_perm(KTc + (32 * ct + r) * LD32, 1, hh), v1, St[ct]);
              } }
            if (seg) {
#pragma unroll
                for (int g = 0; g < 16; ++g) {
                    const int i = crow(g, hh), j = d ? j0 + GC - 1 - i : j0 + i;
                    ODIR[((size_t)d * T_LAT + (size_t)b * S + j) * 512 + h * 128 + 32 * wave + r] = f2bf(oacc[g]);
                }
            }
        }
        LDS_BARRIER();
        if (xn < G_NT && wave < 4) {
            f32x16 acc = zero16();
#pragma unroll
            for (int s = 0; s < 2; ++s) acc = MFMA32(ld_nat(KTs + (q3 * 128 + 32 * wave + r) * LD32, s, hh), ld_nat(Tp + r * LD32, s, hh), acc);
#pragma unroll
            for (int q = 0; q < 4; ++q) {
                u32x2 o; o.x = pk2(-acc[4 * q], -acc[4 * q + 1]); o.y = pk2(-acc[4 * q + 2], -acc[4 * q + 3]);
                *(u32x2*)(Wn + r * LD128 + 32 * wave + 8 * q + 4 * hh) = o;
            }
        }
        LDS_BARRIER();
    }
}

constexpr int RL_RX = 0;
constexpr int RL_KX = RL_RX + 32 * 64 * 2;
constexpr int RL_VX = RL_KX + 32 * 64 * 2;
constexpr int RL_KK = RL_VX + 32 * 64 * 2;
constexpr int RL_LW = RL_KK + 32 * 64 * 4;
constexpr int RL_IC = RL_LW + 32 * 64 * 4;
constexpr int RL_PC = RL_IC + 32 * 64 * 4;
constexpr int RL_CST = RL_PC + 2 * 64 * 4;
constexpr int RL_TW = RL_CST + 4 * 64 * 4;
constexpr int RL_AL = RL_TW + 32 * LD64 * 2;
constexpr int RL_LF = RL_AL + 32 * LD64 * 2;
constexpr int RL_LAKT = RL_LF + 32 * 32 * 4;
constexpr int RL_TB = RL_LAKT + 32 * LD32 * 2;
constexpr int RL_W2T = RL_TB + 32 * LD32 * 2;
constexpr int RL_A2T = RL_W2T + 64 * LD64 * 2;
constexpr int RL_AR = RL_A2T + 64 * LD64 * 2;
constexpr int RL_BR = RL_AR + 32 * LD64 * 2;
constexpr int RL_KR = RL_BR + 32 * LD64 * 2;
constexpr int RL_RR = RL_KR + 32 * LD64 * 2;
constexpr int RL_AT = RL_RR + 2 * 32 * LD64 * 2;
constexpr int RL_BHT = RL_AT + 64 * LD32 * 2;
constexpr int RL_KHT = RL_BHT + 2 * 64 * LD32 * 2;
constexpr int RL_VT = RL_KHT + 2 * 64 * LD32 * 2;
constexpr int RL_MRB = RL_VT + 2 * 64 * LD32 * 2;
constexpr int RL_MRK = RL_MRB + 2 * 32 * LD32 * 2;
constexpr int RL_WM = RL_MRK + 2 * 32 * LD32 * 2;
constexpr int RL_TL = RL_WM + 32 * LD64 * 2;
constexpr int RL_END = RL_TL + 32 * LD32 * 2;
static_assert(RL_END <= LDS_BYTES, "rwkv lds");
static_assert(4 * 16 * LD32 * 2 <= 2 * 32 * LD64 * 2, "inversion scratch over AR/BR");

DI void rwkv_chain2(const Params& p, char* smem, int item) {
    const int d = item / (NB * H_B), b = (item / H_B) % NB, h = item % H_B;
    const int tid = tid_x(), lane = tid & 63, wave = tid >> 6;
    bf16_t* RX = (bf16_t*)(smem + RL_RX); bf16_t* KX = (bf16_t*)(smem + RL_KX); bf16_t* VX = (bf16_t*)(smem + RL_VX); float* KKs = (float*)(smem + RL_KK);
    float* LW = (float*)(smem + RL_LW); float* IC = (float*)(smem + RL_IC); float* Lf = (float*)(smem + RL_LF); float* PC = (float*)(smem + RL_PC); float* CST = (float*)(smem + RL_CST);
    bf16_t* TW = (bf16_t*)(smem + RL_TW); bf16_t* AL = (bf16_t*)(smem + RL_AL); bf16_t* W2T = (bf16_t*)(smem + RL_W2T); bf16_t* A2T = (bf16_t*)(smem + RL_A2T);
    bf16_t* Ar = (bf16_t*)(smem + RL_AR); bf16_t* Br = (bf16_t*)(smem + RL_BR); bf16_t* Kr = (bf16_t*)(smem + RL_KR); bf16_t* Rr = (bf16_t*)(smem + RL_RR);
    bf16_t* AT = (bf16_t*)(smem + RL_AT); bf16_t* BhT = (bf16_t*)(smem + RL_BHT); bf16_t* KhT = (bf16_t*)(smem + RL_KHT); bf16_t* VT = (bf16_t*)(smem + RL_VT);
    bf16_t* LakT = (bf16_t*)(smem + RL_LAKT); bf16_t* Mrb = (bf16_t*)(smem + RL_MRB); bf16_t* Mrk = (bf16_t*)(smem + RL_MRK); bf16_t* Tb = (bf16_t*)(smem + RL_TB);
    bf16_t* Wm = (bf16_t*)(smem + RL_WM); bf16_t* TLm = (bf16_t*)(smem + RL_TL);
    bf16_t* YDIR = (bf16_t*)(p.aux + AUX_YDIR); float* BON = (float*)(p.ws + WS_BONUS);
    __syncthreads();
    for (int i = tid; i < 64 * 64; i += NTHREADS) {
        const int c = i >> 6, rr = i & 63;
        W2T[c * LD64 + rr] = f2bf(p.in[I_W2][((size_t)d * 64 + rr) * 512 + h * 64 + c]); A2T[c * LD64 + rr] = f2bf(p.in[I_A2][((size_t)d * 64 + rr) * 512 + h * 64 + c]);
    }
    if (tid < 256) { const int w = tid >> 6, c = tid & 63, gc = h * 64 + c;
        CST[tid] = w == 0 ? p.in[I_W0][d * 512 + gc] : (w == 1 ? p.in[I_A0][d * 512 + gc] : (w == 2 ? p.in[I_KA][gc] : p.in[I_RK][gc])); }
    const float kkw0 = p.in[I_KK][h * 64 + 2 * (lane & 31)], kkw1 = p.in[I_KK][h * 64 + 2 * (lane & 31) + 1];
    f32x16 Xt[2]; Xt[0] = zero16(); Xt[1] = zero16();
    unsigned rawv[4][5];
    auto prefetch = [&](int x, int w) {
        int seg, j0; chunk_pos(x, d, seg, j0);
        const int ldp = seg ? IN_COLS : CTX_COLS;
        const bf16_t* pb = seg ? (const bf16_t*)(p.ws + WS_PLAT) + (size_t)b * S * IN_COLS : (const bf16_t*)(p.ws + WS_PCTX) + (size_t)b * CTXL * CTX_COLS;
#pragma unroll
        for (int k = 0; k < 4; ++k) {
            const int pi = (w - 2) + 5 * k;
            if (pi < GC / 2) {
                const int j = j0 + 2 * pi + (lane >> 5); const int row = seg ? (j % ROWS) * GW + j / ROWS : j;
#pragma unroll
                for (int s = 0; s < 5; ++s) {
                    const int bcol = (s < 3 ? s * 512 + h * 64 : (s == 3 ? 1536 + d * 64 : 1664 + d * 64)) + 2 * (lane & 31);
                    rawv[k][s] = *(const unsigned*)(pb + (size_t)row * ldp + COL_B0 + bcol);
                }
            }
        }
    };
    auto y1 = [&](int w) {
#pragma unroll
        for (int k = 0; k < 4; ++k) {
            const int pi = (w - 2) + 5 * k;
            if (pi < GC / 2) {
                const int jo = 2 * pi + (lane >> 5), i = d ? (GC - 1 - jo) : jo, c2 = 2 * (lane & 31);
                const float kx0 = bf2f((bf16_t)(rawv[k][1] & 0xffffu)) * kkw0, kx1 = bf2f((bf16_t)(rawv[k][1] >> 16)) * kkw1;
                const float rs = frsq(half_sum(kx0 * kx0 + kx1 * kx1, lane >> 5) + 1e-6f);
                *(unsigned*)(RX + i * 64 + c2) = rawv[k][0]; *(unsigned*)(KX + i * 64 + c2) = rawv[k][1]; *(unsigned*)(VX + i * 64 + c2) = rawv[k][2];
                KKs[i * 64 + c2] = kx0 * rs; KKs[i * 64 + c2 + 1] = kx1 * rs;
                *(unsigned*)(TW + i * LD64 + c2) = rawv[k][3]; *(unsigned*)(AL + i * LD64 + c2) = rawv[k][4];
            }
        }
    };
    if (wave >= 2 && wave < 7) prefetch(0, wave);
    const int r0_ = lane & 31, hh0_ = lane >> 5;
    __syncthreads();
    if (wave >= 2 && wave < 7) { y1(wave); if (1 < G_NT) prefetch(1, wave); }
    LDS_BARRIER();
    for (int it = -1; it < G_NT; ++it) {
        int r = r0_, hh = hh0_;
#ifndef EMU
        asm volatile("" : "+v"(r), "+v"(hh));
#endif
        const int xn = it + 1, par = xn & 1;
        int segn = 0, j0n = 0; if (xn < G_NT) chunk_pos(xn, d, segn, j0n);
        if (xn < G_NT) {
            const int which = wave >> 2, cg = wave & 3, fr = lane & 15, fq = lane >> 4;
            const bf16_t* arow0 = (which ? AL : TW) + fr * LD64 + 8 * fq; const bf16_t* brow = (which ? A2T : W2T) + (16 * cg + fr) * LD64 + 8 * fq;
            f32x4 c0 = {0.f, 0.f, 0.f, 0.f}, c1 = {0.f, 0.f, 0.f, 0.f};
#pragma unroll
            for (int ks = 0; ks < 2; ++ks) {
                const bf16x8 bfrag = *(const bf16x8*)(brow + 32 * ks);
                c0 = MFMA16(*(const bf16x8*)(arow0 + 32 * ks), bfrag, c0); c1 = MFMA16(*(const bf16x8*)(arow0 + 16 * LD64 + 32 * ks), bfrag, c1);
            }
            const int c = 16 * cg + fr; const float bias = CST[which * 64 + c];
#pragma unroll
            for (int th = 0; th < 2; ++th)
#pragma unroll
                for (int j = 0; j < 4; ++j) {
                    const int i = 16 * th + 4 * fq + j; const float z = bias + (th ? c1[j] : c0[j]);
                    if (which) IC[i * 64 + c] = fsigmoid(z);
                    else { const float wl = -fsoftplus(-z) - 0.5f; LW[i * 64 + c] = -fexp(wl); }
                }
        }
        LDS_BARRIER();
        if (xn < G_NT) {
            const int c = lane, i0 = 4 * wave;
            const float ka = CST[2 * 64 + c], rk = CST[3 * 64 + c];
            float lpb = 0.f, lpc = 0.f; float lw4[4];
#pragma unroll
            for (int s2 = 0; s2 < 32; ++s2) { const float w = LW[s2 * 64 + c]; lpc += w; if (s2 < i0) lpb += w; }
#pragma unroll
            for (int e = 0; e < 4; ++e) lw4[e] = LW[(i0 + e) * 64 + c];
            bf16_t ta[4], tb[4], tk[4], tv[4]; float bon[4];
            float lprun = lpb;
#pragma unroll
            for (int e = 0; e < 4; ++e) {
                const int i = i0 + e;
                const float lpm = lprun; lprun += lw4[e]; const float lp = lprun;
                const float Pi = fexp(lp), Pm = fexp(lpm), invP = fexp(-lp), PCi = fexp(lpc - lp);
                const float ic = IC[i * 64 + c], kxv = bf2f(KX[i * 64 + c]), kkv = KKs[i * 64 + c], rxv = bf2f(RX[i * 64 + c]); const bf16_t vxb = VX[i * 64 + c];
                const float kd = kxv * (1.f + (ic - 1.f) * ka), bb = kkv * ic, aa = -kkv;
                ta[e] = f2bf(aa * Pm); tb[e] = f2bf(bb * PCi); tk[e] = f2bf(kd * PCi); tv[e] = vxb;
                Ar[i * LD64 + c] = ta[e]; Br[i * LD64 + c] = f2bf(bb * invP); Kr[i * LD64 + c] = f2bf(kd * invP); Rr[(par * 32 + i) * LD64 + c] = f2bf(rxv * Pi);
                bon[e] = wave_sum_fast(rxv * kd * rk);
            }
            { u32x2 o; o.x = (unsigned)ta[0] | ((unsigned)ta[1] << 16); o.y = (unsigned)ta[2] | ((unsigned)ta[3] << 16); *(u32x2*)(AT + c * LD32 + i0) = o; }
            { u32x2 o; o.x = (unsigned)tb[0] | ((unsigned)tb[1] << 16); o.y = (unsigned)tb[2] | ((unsigned)tb[3] << 16); *(u32x2*)(BhT + (par * 64 + c) * LD32 + i0) = o; }
            { u32x2 o; o.x = (unsigned)tk[0] | ((unsigned)tk[1] << 16); o.y = (unsigned)tk[2] | ((unsigned)tk[3] << 16); *(u32x2*)(KhT + (par * 64 + c) * LD32 + i0) = o; }
            { u32x2 o; o.x = (unsigned)tv[0] | ((unsigned)tv[1] << 16); o.y = (unsigned)tv[2] | ((unsigned)tv[3] << 16); *(u32x2*)(VT + (par * 64 + c) * LD32 + i0) = o; }
            if (wave == 7) PC[par * 64 + c] = fexp(lpc);
            if (segn && lane < 4) { const int i = i0 + lane, jj = d ? j0n + GC - 1 - i : j0n + i;
                const float bv = lane == 0 ? bon[0] : (lane == 1 ? bon[1] : (lane == 2 ? bon[2] : bon[3]));
                BON[((size_t)d * T_LAT + (size_t)b * S + (jj % ROWS) * GW + jj / ROWS) * 8 + h] = bv; }
        }
        LDS_BARRIER();
        if (xn < G_NT) {
            const int m = wave >> 1, th = wave & 1, fr = lane & 15, fq = lane >> 4;
            const bf16_t* arow = ((m < 2) ? Ar : Rr + par * 32 * LD64) + (16 * th + fr) * LD64 + 8 * fq; const bf16_t* brow = ((m & 1) ? Kr : Br) + fr * LD64 + 8 * fq;
            f32x4 c0 = {0.f, 0.f, 0.f, 0.f}, c1 = {0.f, 0.f, 0.f, 0.f};
#pragma unroll
            for (int ks = 0; ks < 2; ++ks) {
                const bf16x8 afrag = *(const bf16x8*)(arow + 32 * ks);
                c0 = MFMA16(afrag, *(const bf16x8*)(brow + 32 * ks), c0); c1 = MFMA16(afrag, *(const bf16x8*)(brow + 16 * LD64 + 32 * ks), c1);
            }
#pragma unroll
            for (int ch = 0; ch < 2; ++ch) {
                const f32x4 cc = ch ? c1 : c0; const int ic = 16 * ch + fr; const int t0 = 16 * th + 4 * fq;
                if (m == 0) {
#pragma unroll
                    for (int j = 0; j < 4; ++j) Lf[(t0 + j) * 32 + ic] = (ic < t0 + j) ? -cc[j] : 0.f;
                } else if (m == 1) {
                    u32x2 o; o.x = pk2((ic < t0) ? cc[0] : 0.f, (ic < t0 + 1) ? cc[1] : 0.f); o.y = pk2((ic < t0 + 2) ? cc[2] : 0.f, (ic < t0 + 3) ? cc[3] : 0.f);
                    *(u32x2*)(LakT + ic * LD32 + t0) = o;
                } else {
                    bf16_t* M = (m == 2 ? Mrb : Mrk) + par * 32 * LD32;
#pragma unroll
                    for (int j = 0; j < 4; ++j) M[(t0 + j) * LD32 + ic] = f2bf((ic <= t0 + j) ? cc[j] : 0.f);
                }
            }
        }
        LDS_BARRIER();
        if (wave == 7 && xn < G_NT) {
            invert32_blocked(Lf, (bf16_t*)(smem + RL_AR), lane, [&](int i, int c, float v) { Tb[i * LD32 + c] = f2bf(v); });
        }
        if (wave >= 2 && wave < 7 && xn + 1 < G_NT) { y1(wave); if (xn + 2 < G_NT) prefetch(xn + 2, wave); }
        if (wave < 2 && it >= 0) {
            const int pc = it & 1; int seg = 0, j0 = 0; chunk_pos(it, d, seg, j0);
            const bf16_t* Rc = Rr + pc * 32 * LD64; const bf16_t* BhTc = BhT + pc * 64 * LD32; const bf16_t* KhTc = KhT + pc * 64 * LD32; const bf16_t* VTc = VT + (pc * 64 + 32 * wave + r) * LD32;
            const bf16_t* Mrbc = Mrb + pc * 32 * LD32; const bf16_t* Mrkc = Mrk + pc * 32 * LD32; const float* PCc = PC + pc * 64;
            const bf16x8 vf0 = ld_nat(VTc, 0, hh), vf1 = ld_nat(VTc, 1, hh);
            f32x16 u = zero16(), y = zero16();
            u = MFMA32(ld_nat(TLm + r * LD32, 0, hh), vf0, u); u = MFMA32(ld_nat(TLm + r * LD32, 1, hh), vf1, u);
            y = MFMA32(ld_nat(Mrkc + r * LD32, 0, hh), vf0, y); y = MFMA32(ld_nat(Mrkc + r * LD32, 1, hh), vf1, y);
#define RW_KSTEP(s) { const bf16x8 xb = pack_acc<(s) & 1>(Xt[(s) >> 1]); u = MFMA32(ld_perm(Wm + r * LD64, (s), hh), xb, u); y = MFMA32(ld_perm(Rc + r * LD64, (s), hh), xb, y); }
            RW_KSTEP(0) RW_KSTEP(1) RW_KSTEP(2) RW_KSTEP(3)
#undef RW_KSTEP
            const bf16x8 ub0 = pack_acc<0>(u), ub1 = pack_acc<1>(u);
            y = MFMA32(ld_perm(Mrbc + r * LD32, 0, hh), ub0, y); y = MFMA32(ld_perm(Mrbc + r * LD32, 1, hh), ub1, y);
#pragma unroll
            for (int kt = 0; kt < 2; ++kt) {
#pragma unroll
                for (int g = 0; g < 16; ++g) Xt[kt][g] *= PCc[32 * kt + crow(g, hh)];
                Xt[kt] = MFMA32(ld_perm(BhTc + (32 * kt + r) * LD32, 0, hh), ub0, Xt[kt]); Xt[kt] = MFMA32(ld_perm(BhTc + (32 * kt + r) * LD32, 1, hh), ub1, Xt[kt]);
                Xt[kt] = MFMA32(ld_nat(KhTc + (32 * kt + r) * LD32, 0, hh), vf0, Xt[kt]); Xt[kt] = MFMA32(ld_nat(KhTc + (32 * kt + r) * LD32, 1, hh), vf1, Xt[kt]);
            }
            if (seg) {
#pragma unroll
                for (int g = 0; g < 16; ++g) {
                    const int i = crow(g, hh), jj = d ? j0 + GC - 1 - i : j0 + i;
                    YDIR[((size_t)d * T_LAT + (size_t)b * S + (jj % ROWS) * GW + jj / ROWS) * 512 + h * 64 + 32 * wave + r] = f2bf(y[g]);
                }
            }
        }
        LDS_BARRIER();
        if (xn < G_NT && wave < 3) {
            const bf16_t* arow = (wave < 2) ? AT + (32 * wave + r) * LD32 : LakT + r * LD32;
            f32x16 acc = zero16();
#pragma unroll
            for (int s = 0; s < 2; ++s) acc = MFMA32(ld_nat(arow, s, hh), ld_nat(Tb + r * LD32, s, hh), acc);
#pragma unroll
            for (int q = 0; q < 4; ++q) {
                u32x2 o; o.x = pk2(acc[4 * q], acc[4 * q + 1]); o.y = pk2(acc[4 * q + 2], acc[4 * q + 3]);
                if (wave < 2) *(u32x2*)(Wm + r * LD64 + 32 * wave + 8 * q + 4 * hh) = o; else *(u32x2*)(TLm + r * LD32 + 8 * q + 4 * hh) = o;
            }
        }
        LDS_BARRIER();
    }
}

DI void phase3(const Params& p, char* smem) {
    constexpr int NG = 2 * NB * H_A, NR = 2 * NB * H_B;
    for (int it = blockIdx.x; it < NG; it += gridDim.x) gdn_chain2(p, smem, it);
    for (int it = blockIdx.x; it < NG + NR; it += gridDim.x) if (it >= NG) rwkv_chain2(p, smem, it - NG);
    const int nchain = NG + NR, G = (int)gridDim.x;
    const int tb = G > nchain ? (int)blockIdx.x - nchain : (int)blockIdx.x, ntb = G > nchain ? G - nchain : G;
    if (tb >= 0) {
        __syncthreads();
        const int tid3 = tid_x(), lane = tid3 & 63, wave = tid3 >> 6;
        float* scr = (float*)smem + wave * (64 * 33);
        bf16_t* GUT = (bf16_t*)(p.aux + AUX_GUT);
        constexpr int nkb = D / 64, nnb = DE / 32, per = nkb * nnb;
        for (int it = tb * 8 + wave; it < NEXP * 2 * per; it += ntb * 8) {
            const int e = it / (2 * per), r = it % (2 * per), up = r / per, r2 = r % per, kb = r2 / nnb, nb = r2 % nnb;
            transpose_item((up ? p.in[I_MU_UP] : p.in[I_MG]) + (size_t)e * D * DE, DE, DE, kb * 64, nb * 32, GUT + (size_t)e * 512 * D, D, up ? 2 : 1, scr, lane);
        }
        constexpr int nkb2 = DE / 64, nnb2 = D / 32, per2 = nkb2 * nnb2;
        for (int it = tb * 8 + wave; it < NE_EARLY * per2; it += ntb * 8) {
            const int e = it / per2, r2 = it % per2, kb = r2 / nnb2, nb = r2 % nnb2;
            transpose_item(p.in[I_MD] + (size_t)e * DE * D, D, D, kb * 64, nb * 32, DNT_PTR(p.ws, e), DE, 0, scr, lane);
        }
    }
}

constexpr int P4_SG = 0;
constexpr int P4_XV = P4_SG + 32 * LD128 * 2;
constexpr int P4_YF = P4_XV + 32 * 520 * 2;
static_assert(P4_YF + 32 * 516 * 4 <= LDS_BYTES, "phase4 lds");
DI void phase4(const Params& p, char* smem) {
    const int tid = tid_x(), lane = tid & 63, wave = tid >> 6, r = lane & 31, hh = lane >> 5;
    const bf16_t* PL = (const bf16_t*)(p.ws + WS_PLAT);
    const bf16_t* ODIR = (const bf16_t*)(p.ws + WS_OA); const bf16_t* YDIR = (const bf16_t*)(p.aux + AUX_YDIR);
    const float* BON = (const float*)(p.ws + WS_BONUS); const float* mu = p.in[I_MU]; const bf16_t* G2T = (const bf16_t*)(p.ws + WS_G2T);
    bf16_t* OA = (bf16_t*)(p.ws + WS_OA); bf16_t* OB = (bf16_t*)(p.ws + WS_OB);
    bf16_t* SG = (bf16_t*)(smem + P4_SG); bf16_t* XV = (bf16_t*)(smem + P4_XV); float* YF = (float*)(smem + P4_YF);
    for (int it = blockIdx.x; it < T_LAT / 32; it += gridDim.x) {
        const int tok0 = it * 32, b = tok0 / S, l0 = tok0 % S;
        __syncthreads();
        for (int q = tid; q < 32 * 80; q += NTHREADS) {
            const int t = q / 80, c8 = q % 80;
            const int l = l0 + t;
            const int bcol = c8 < 16 ? 1792 + c8 * 8 : 1024 + (c8 - 16) * 8;
            float cu[8], o[8];
            unpack8(*(const u32x4*)(PL + (size_t)(b * S + l) * IN_COLS + COL_B0 + bcol), cu);
#pragma unroll
            for (int e = 0; e < 8; ++e) o[e] = c8 < 16 ? fsigmoid(cu[e]) : cu[e];
            u32x4 w; w.x = pk2(o[0], o[1]); w.y = pk2(o[2], o[3]); w.z = pk2(o[4], o[5]); w.w = pk2(o[6], o[7]);
            if (c8 < 16) *(u32x4*)(SG + t * LD128 + c8 * 8) = w; else *(u32x4*)(XV + t * 520 + (c8 - 16) * 8) = w;
        }
        for (int q = tid; q < 32 * 64; q += NTHREADS) {
            const int t = q >> 6, c8 = q & 63, tok = tok0 + t;
            float a0[8], a1[8];
            unpack8(*(const u32x4*)(YDIR + (size_t)tok * 512 + c8 * 8), a0); unpack8(*(const u32x4*)(YDIR + ((size_t)T_LAT + tok) * 512 + c8 * 8), a1);
            f32x4 s0 = {a0[0] + a1[0], a0[1] + a1[1], a0[2] + a1[2], a0[3] + a1[3]}, s1 = {a0[4] + a1[4], a0[5] + a1[5], a0[6] + a1[6], a0[7] + a1[7]};
            *(f32x4*)(YF + t * 516 + c8 * 8) = s0; *(f32x4*)(YF + t * 516 + c8 * 8 + 4) = s1;
        }
        __syncthreads();
        {
            unsigned q0[16], q1[16], zq[16];
#pragma unroll
            for (int k = 0; k < 16; ++k) {
                const int pi = wave * 16 + k, t = pi >> 2, h = pi & 3, tok = tok0 + t;
                const size_t o0 = (size_t)tok * 512 + h * 128 + 2 * lane;
                q0[k] = *(const unsigned*)(ODIR + o0); q1[k] = *(const unsigned*)(ODIR + (size_t)T_LAT * 512 + o0); zq[k] = *(const unsigned*)(PL + (size_t)tok * IN_COLS + 1536 + h * 128 + 2 * lane);
            }
            const float on0 = p.in[I_ONORM][2 * lane], on1 = p.in[I_ONORM][2 * lane + 1];
#pragma unroll
            for (int k = 0; k < 16; ++k) {
                const int pi = wave * 16 + k, t = pi >> 2, h = pi & 3, tok = tok0 + t;
                const size_t o0 = (size_t)tok * 512 + h * 128 + 2 * lane;
                const float a0 = bf2f((bf16_t)(q0[k] & 0xffffu)) + bf2f((bf16_t)(q1[k] & 0xffffu)), a1 = bf2f((bf16_t)(q0[k] >> 16)) + bf2f((bf16_t)(q1[k] >> 16));
                const float ss = wave_sum_fast(a0 * a0 + a1 * a1);
                const float rstd = frsq(ss * (1.f / 128.f) + 1e-6f);
                const float z0 = bf2f((bf16_t)(zq[k] & 0xffffu)), z1 = bf2f((bf16_t)(zq[k] >> 16));
                *(unsigned*)(OA + o0) = pk2(a0 * rstd * on0 * fsilu(z0), a1 * rstd * on1 * fsilu(z1));
            }
        }
        __syncthreads();
        {
            const int h = wave;
            f32x16 acc0 = zero16(), acc1 = zero16();
#pragma unroll
            for (int s2 = 0; s2 < 8; ++s2) {
                const bf16x8 a = ld_nat(SG + r * LD128, s2, hh);
                const bf16x8 b0 = *(const bf16x8*)(G2T + (size_t)(64 * h + r) * 128 + 16 * s2 + 8 * hh), b1 = *(const bf16x8*)(G2T + (size_t)(64 * h + 32 + r) * 128 + 16 * s2 + 8 * hh);
                acc0 = MFMA32(a, b0, acc0); acc1 = MFMA32(a, b1, acc1);
            }
            const int c0 = 64 * h + r, c1 = c0 + 32;
            const float lg0 = p.in[I_LNG][c0], lb0 = p.in[I_LNB][c0], lg1 = p.in[I_LNG][c1], lb1 = p.in[I_LNB][c1];
            float bonv[16];
#pragma unroll
            for (int g = 0; g < 16; ++g) { const int tok = tok0 + crow(g, hh); bonv[g] = BON[(size_t)tok * 8 + h] + BON[((size_t)T_LAT + tok) * 8 + h]; }
#pragma unroll
            for (int g = 0; g < 16; ++g) {
                const int i = crow(g, hh), tok = tok0 + i;
                const float y0 = YF[i * 516 + c0], y1 = YF[i * 516 + c1];
                const float mean = half_sum(y0 + y1, hh) * (1.f / 64.f); const float d0 = y0 - mean, d1 = y1 - mean;
                const float var = half_sum(d0 * d0 + d1 * d1, hh) * (1.f / 64.f); const float rs = frsq(var + 64e-5f);
                const float bon = bonv[g];
                const float o0 = (d0 * rs * lg0 + lb0 + bon * bf2f(XV[i * 520 + c0])) * acc0[g], o1 = (d1 * rs * lg1 + lb1 + bon * bf2f(XV[i * 520 + c1])) * acc1[g];
                OB[(size_t)tok * 512 + c0] = f2bf(o0); OB[(size_t)tok * 512 + c1] = f2bf(o1);
            }
        }
    }
}

DI void phase5(const Params& p, char* smem) {
    const bf16_t* OA = (const bf16_t*)(p.ws + WS_OA); const bf16_t* OB = (const bf16_t*)(p.ws + WS_OB);
    const bf16_t* WA = (const bf16_t*)(p.ws + WS_WOA); const bf16_t* WB = (const bf16_t*)(p.ws + WS_WOB);
    const bf16_t* PL = (const bf16_t*)(p.ws + WS_PLAT); bf16_t* Y = (bf16_t*)(p.aux + AUX_Y);
    if (USE_G8) {
        constexpr int NT8 = D / 256, MT8 = T_LAT / 256;
        constexpr int GLD = 264;
        static_assert(256 * GLD * 2 <= LDS_BYTES, "gate tile lds");
        bf16_t* GT = (bf16_t*)smem;
        auto stage_gates = [&](int brow, int gcol0) {
            const int tid = tid_x();
            u32x4 gv[16];
#pragma unroll
            for (int i = 0; i < 16; ++i) { const int ch = tid + i * NTHREADS, row = ch >> 5, c16 = ch & 31; gv[i] = *(const u32x4*)(PL + (size_t)(brow + row) * IN_COLS + gcol0 + c16 * 8); }
#pragma unroll
            for (int i = 0; i < 16; ++i) { const int ch = tid + i * NTHREADS, row = ch >> 5, c16 = ch & 31; *(u32x4*)(GT + row * GLD + c16 * 8) = gv[i]; }
            __syncthreads();
        };
        for (int t = blockIdx.x; t < MT8 * NT8; t += gridDim.x) {
            int mt, nt; if (!g8::tile_order(t, MT8, NT8, mt, nt)) break;
            const int brow = mt * 256, bcol = nt * 256;
            g8::Acc acc; g8::acc_zero(acc);
            g8::kloop(acc, smem, OA, 512, WA, 512, 512, brow, bcol);
            stage_gates(brow, COL_G0 + bcol);
            g8::for_each_quad(acc, brow, bcol, [&](int row, int col, const f32x4& v) {
                const u32x2 gq = *(const u32x2*)(GT + (row - brow) * GLD + (col - bcol));
                const float g0 = bf2f((bf16_t)(gq.x & 0xffffu)), g1 = bf2f((bf16_t)(gq.x >> 16)), g2 = bf2f((bf16_t)(gq.y & 0xffffu)), g3 = bf2f((bf16_t)(gq.y >> 16));
                u32x2 o; o.x = pk2(fsigmoid(g0) * v.x, fsigmoid(g1) * v.y); o.y = pk2(fsigmoid(g2) * v.z, fsigmoid(g3) * v.w);
                *(u32x2*)(Y + (size_t)row * D + col) = o;
            });
            __syncthreads();
            g8::acc_zero(acc);
            g8::kloop(acc, smem, OB, 512, WB, 512, 512, brow, bcol);
            stage_gates(brow, COL_G0 + D + bcol);
            g8::for_each_quad(acc, brow, bcol, [&](int row, int col, const f32x4& v) {
                const u32x2 gq = *(const u32x2*)(GT + (row - brow) * GLD + (col - bcol));
                const float g0 = bf2f((bf16_t)(gq.x & 0xffffu)), g1 = bf2f((bf16_t)(gq.x >> 16)), g2 = bf2f((bf16_t)(gq.y & 0xffffu)), g3 = bf2f((bf16_t)(gq.y >> 16));
#ifdef EMU
                const unsigned long long tq = *(const unsigned long long*)(Y + (size_t)row * D + col);
#else
                const unsigned long long tq = __hip_atomic_load((const unsigned long long*)(Y + (size_t)row * D + col), __ATOMIC_RELAXED, __HIP_MEMORY_SCOPE_AGENT);
#endif
                const unsigned tlo = (unsigned)tq, thi = (unsigned)(tq >> 32);
                const float t0 = bf2f((bf16_t)(tlo & 0xffffu)), t1 = bf2f((bf16_t)(tlo >> 16)), t2 = bf2f((bf16_t)(thi & 0xffffu)), t3 = bf2f((bf16_t)(thi >> 16));
                u32x2 o; o.x = pk2(t0 + fsigmoid(g0) * v.x, t1 + fsigmoid(g1) * v.y); o.y = pk2(t2 + fsigmoid(g2) * v.z, t3 + fsigmoid(g3) * v.w);
                *(u32x2*)(Y + (size_t)row * D + col) = o;
            });
            __syncthreads();
        }
        return;
    }
    constexpr int MR5 = 2, BM5 = 64 * MR5; constexpr int NT = D / 128, MT = T_LAT / BM5;
    for (int t = blockIdx.x; t < MT * NT; t += gridDim.x) {
        const int mt = t / NT, nt = t % NT, row0 = mt * BM5;
        f32x4 acca[MR5][4], accb[MR5][4]; acc_zero(acca); acc_zero(accb);
        gemm_kloop(acca, smem, [&](int i) { return OA + (size_t)(row0 + i) * 512; }, WA + (size_t)nt * 128 * 512, 512, 512);
        gemm_kloop(accb, smem, [&](int i) { return OB + (size_t)(row0 + i) * 512; }, WB + (size_t)nt * 128 * 512, 512, 512);
        const int t2 = tid_x(), l2 = t2 & 63, w2 = t2 >> 6; const int wr = w2 >> 1, wc = w2 & 1, fr = l2 & 15, fq = l2 >> 4;
#pragma unroll
        for (int m = 0; m < MR5; ++m)
#pragma unroll
            for (int n = 0; n < 4; ++n)
#pragma unroll
                for (int j = 0; j < 4; ++j) {
                    const int row = row0 + wr * 16 * MR5 + m * 16 + fq * 4 + j, col = nt * 128 + wc * 64 + n * 16 + fr;
                    const float ga = bf2f(PL[(size_t)row * IN_COLS + COL_G0 + col]), gb = bf2f(PL[(size_t)row * IN_COLS + COL_G0 + D + col]);
                    Y[(size_t)row * D + col] = f2bf(sigmoidf_(ga) * acca[m][n][j] + sigmoidf_(gb) * accb[m][n][j]);
                }
    }
}

DI void phase6(const Params& p, char* smem) {
    const bf16_t* Y = (const bf16_t*)(p.aux + AUX_Y); const bf16_t* WO = (const bf16_t*)(p.ws + WS_WOUT);
    const float* mod = (const float*)(p.ws + WS_MOD); float* Hh = (float*)(p.ws + WS_H);
    if (USE_G8) {
        constexpr int NT = D / 256, MT = T_LAT / 256;
        const float* X = p.in[I_X];
        for (int t = blockIdx.x; t < MT * NT; t += gridDim.x) {
            int mt, nt; if (!g8::tile_order(t, MT, NT, mt, nt)) break;
            const int brow = mt * 256, bcol = nt * 256;
            g8::Acc acc; g8::acc_zero(acc);
            g8::kloop(acc, smem, Y, D, WO, D, D, brow, bcol);
            g8::for_each_quad(acc, brow, bcol, [&](int row, int col, const f32x4& v) {
                const int b = row / S; const f32x4 xv = *(const f32x4*)(X + (size_t)row * D + col), gv = *(const f32x4*)(mod + (size_t)b * 6 * D + 2 * D + col);
                f32x4 o; o.x = xv.x + gv.x * v.x; o.y = xv.y + gv.y * v.y; o.z = xv.z + gv.z * v.z; o.w = xv.w + gv.w * v.w;
                *(f32x4*)(Hh + (size_t)row * D + col) = o;
            });
        }
    } else {
        const int tid = tid_x(), lane = tid & 63, wave = tid >> 6, wr = wave >> 1, wc = wave & 1, fr = lane & 15, fq = lane >> 4;
        constexpr int NT = D / 128, MT = T_LAT / BM;
        for (int t = blockIdx.x; t < MT * NT; t += gridDim.x) {
            const int mt = t / NT, nt = t % NT, row0 = mt * BM;
            f32x4 acc[MREP][4]; acc_zero(acc);
            gemm_kloop(acc, smem, [&](int i) { return Y + (size_t)(row0 + i) * D; }, WO + (size_t)nt * 128 * D, D, D);
#pragma unroll
            for (int m = 0; m < MREP; ++m)
#pragma unroll
                for (int n = 0; n < 4; ++n)
#pragma unroll
                    for (int j = 0; j < 4; ++j) {
                        const int row = row0 + wr * 16 * MREP + m * 16 + fq * 4 + j, col = nt * 128 + wc * 64 + n * 16 + fr, b = row / S;
                        Hh[(size_t)row * D + col] = p.in[I_X][(size_t)row * D + col] + mod[(size_t)b * 6 * D + 2 * D + col] * acc[m][n][j];
                    }
        }
    }
    __syncthreads();
    const int tid6 = tid_x(), lane = tid6 & 63, wave = tid6 >> 6;
    const int gw = blockIdx.x * 8 + wave, ngw = gridDim.x * 8;
    float* scr = (float*)smem + wave * (64 * 33);
    {
        constexpr int nkb = DE / 64, nnb = D / 32, per = nkb * nnb;
        for (int it = gw; it < (NEXP - NE_EARLY) * per; it += ngw) {
            const int e = NE_EARLY + it / per, r2 = it % per, kb = r2 / nnb, nb = r2 % nnb;
            transpose_item(p.in[I_MD] + (size_t)e * DE * D, D, D, kb * 64, nb * 32, DNT_PTR(p.ws, e), DE, 0, scr, lane);
        }
    }
}

#ifdef EMU
#define MFMA32F(a, b, c) emu_mfma32_f32((a), (b), (c))
#else
#define MFMA32F(a, b, c) __builtin_amdgcn_mfma_f32_32x32x2f32((a), (b), (c), 0, 0, 0)
#endif
constexpr int TB_LD = D + 4;
static_assert(32 * TB_LD * 4 <= LDS_BYTES && 8 * 32 * 64 * 4 <= LDS_BYTES, "phase7 lds");
DI void phase7(const Params& p, char* smem) {
    const int tid = tid_x(), lane = tid & 63, wave = tid >> 6, r = lane & 31, hh = lane >> 5;
    const float* Hh = (const float*)(p.ws + WS_H); const float* mod = (const float*)(p.ws + WS_MOD); const float* WRT = (const float*)(p.ws + WS_WRT);
    bf16_t* Tt = (bf16_t*)(p.ws + WS_T); int* cnt = (int*)(p.ws + WS_CNT); int* rowlist = (int*)(p.ws + WS_ROWLIST); float* pairw = (float*)(p.ws + WS_PAIRW);
    float* tb = (float*)smem;
    float* bias = (float*)(smem + LDS_BYTES - 1024);
    int* lcnt = (int*)(smem + LDS_BYTES - 768);
    int* lbase = lcnt + 32;
    if (tid < 36) bias[tid] = tid < 4 ? p.in[I_RGB][tid] : p.in[I_REB][tid - 4];
    f32x4 x[4][D / 256];
    int itn = blockIdx.x;
    if (itn < T_LAT / 32) {
#pragma unroll
        for (int tt = 0; tt < 4; ++tt)
#pragma unroll
            for (int j = 0; j < D / 256; ++j) x[tt][j] = *(const f32x4*)(Hh + (size_t)(itn * 32 + wave * 4 + tt) * D + j * 256 + lane * 4);
    }
    for (int it = blockIdx.x; it < T_LAT / 32; it += gridDim.x) {
        const int tok0 = it * 32;
        __syncthreads();
        if (tid < 32) lcnt[tid] = 0;
#pragma unroll
        for (int tt = 0; tt < 4; ++tt) {
            const int ti = wave * 4 + tt, tok = tok0 + ti, b = tok / S;
            float ss = 0.f;
#pragma unroll
            for (int j = 0; j < D / 256; ++j) ss += x[tt][j].x * x[tt][j].x + x[tt][j].y * x[tt][j].y + x[tt][j].z * x[tt][j].z + x[tt][j].w * x[tt][j].w;
            ss = wave_sum_fast(ss);
            const float rstd = frsq(ss * (1.0f / D) + 1e-6f);
#pragma unroll
            for (int j = 0; j < D / 256; ++j) {
                const int k = j * 256 + lane * 4;
                const f32x4 g = *(const f32x4*)(p.in[I_NFFN] + k), sh = *(const f32x4*)(mod + (size_t)b * 6 * D + 3 * D + k), sc = *(const f32x4*)(mod + (size_t)b * 6 * D + 4 * D + k);
                f32x4 o; o.x = x[tt][j].x * rstd * g.x * (1.f + sc.x) + sh.x; o.y = x[tt][j].y * rstd * g.y * (1.f + sc.y) + sh.y;
                o.z = x[tt][j].z * rstd * g.z * (1.f + sc.z) + sh.z; o.w = x[tt][j].w * rstd * g.w * (1.f + sc.w) + sh.w;
                *(f32x4*)(tb + ti * TB_LD + k) = o;
                u32x2 ob; ob.x = pk2(o.x, o.y); ob.y = pk2(o.z, o.w);
                *(u32x2*)(Tt + (size_t)tok * D + k) = ob;
            }
        }
        itn = it + gridDim.x;
        if (itn < T_LAT / 32) {
#pragma unroll
            for (int tt = 0; tt < 4; ++tt)
#pragma unroll
                for (int j = 0; j < D / 256; ++j) x[tt][j] = *(const f32x4*)(Hh + (size_t)(itn * 32 + wave * 4 + tt) * D + j * 256 + lane * 4);
        }
        LDS_BARRIER();
        f32x16 a0 = zero16(), a1 = zero16();
        {
            const int kbeg = wave * (D / 8);
            const float* arow = tb + r * TB_LD + kbeg + 4 * hh;
            const float* b0row = WRT + (size_t)(4 + r) * D + kbeg + 4 * hh;
            const float* b1row = WRT + (size_t)(r < 4 ? r : 0) * D + kbeg + 4 * hh;
            const float m1 = r < 4 ? 1.f : 0.f;
#pragma unroll 4
            for (int g = 0; g < D / 64; ++g) {
                const f32x4 av = *(const f32x4*)(arow + 8 * g), b0 = *(const f32x4*)(b0row + 8 * g); const f32x4 b1 = *(const f32x4*)(b1row + 8 * g) * m1;
                a0 = MFMA32F(av.x, b0.x, a0); a1 = MFMA32F(av.x, b1.x, a1); a0 = MFMA32F(av.y, b0.y, a0); a1 = MFMA32F(av.y, b1.y, a1);
                a0 = MFMA32F(av.z, b0.z, a0); a1 = MFMA32F(av.z, b1.z, a1); a0 = MFMA32F(av.w, b0.w, a0); a1 = MFMA32F(av.w, b1.w, a1);
            }
        }
        LDS_BARRIER();
        {
            float* part = tb + wave * (32 * 64);
#pragma unroll
            for (int g = 0; g < 16; ++g) { const int i = crow(g, hh); part[i * 64 + r] = a0[g]; part[i * 64 + 32 + r] = a1[g]; }
        }
        LDS_BARRIER();
        float lsum[4];
        {
            const int i = tid >> 4, c4 = (tid & 15) * 4;
#pragma unroll
            for (int e = 0; e < 4; ++e) { float sacc = 0.f;
#pragma unroll
                for (int w = 0; w < 8; ++w) sacc += tb[w * (32 * 64) + i * 64 + c4 + e];
                lsum[e] = sacc; }
        }
        LDS_BARRIER();
        { const int i = tid >> 4, c4 = (tid & 15) * 4;
#pragma unroll
          for (int e = 0; e < 4; ++e) tb[i * 64 + c4 + e] = lsum[e]; }
        LDS_BARRIER();
        int ex1 = 0, ex2 = 0, rk1 = 0, rk2 = 0; float w1 = 0.f, w2 = 0.f;
        if (tid < 32) {
            const float* L = tb + tid * 64;
            float gl[4];
#pragma unroll
            for (int i = 0; i < 4; ++i) gl[i] = L[32 + i] + bias[i];
            int g = 0; float mx = gl[0];
#pragma unroll
            for (int i = 1; i < 4; ++i) if (gl[i] > mx) { mx = gl[i]; g = i; }
            float se = 0.f;
#pragma unroll
            for (int i = 0; i < 4; ++i) se += fexp(gl[i] - mx);
            const float pg = 1.0f / se;
            int i1 = 0; float l1 = L[g * 8] + bias[4 + g * 8];
            for (int i = 1; i < 8; ++i) { const float v = L[g * 8 + i] + bias[4 + g * 8 + i]; if (v > l1) { l1 = v; i1 = i; } }
            int i2 = -1; float l2 = -3.0e38f;
            for (int i = 0; i < 8; ++i) { const float v = L[g * 8 + i] + bias[4 + g * 8 + i]; if (i != i1 && v > l2) { l2 = v; i2 = i; } }
            const float e2 = fexp(l2 - l1); w1 = pg / (1.f + e2); w2 = pg * e2 / (1.f + e2);
            ex1 = g * 8 + i1; ex2 = g * 8 + i2;
            rk1 = atomicAdd(&lcnt[ex1], 1); rk2 = atomicAdd(&lcnt[ex2], 1);
        }
        LDS_BARRIER();
        if (tid < 32) { const int c = lcnt[tid]; lbase[tid] = c ? atomicAdd(&cnt[tid * CNT_STRIDE], c) : 0; }
        __syncthreads();
        if (tid < 32) {
            const int tok = tok0 + tid;
            rowlist[(size_t)ex1 * CAP + lbase[ex1] + rk1] = tok * 2; pairw[tok * 2] = w1;
            rowlist[(size_t)ex2 * CAP + lbase[ex2] + rk2] = tok * 2 + 1; pairw[tok * 2 + 1] = w2;
        }
    }
}

constexpr int MOE_TM = USE_G8 ? 256 : BM;
DI void moe_tiles(const Params& p, char* smem, int* pre) {
    const int* cnt = (const int*)(p.ws + WS_CNT);
    __syncthreads();
    if (tid_x() == 0) { int s = 0; for (int e = 0; e < NEXP; ++e) { pre[e] = s; s += (cnt[e * CNT_STRIDE] + MOE_TM - 1) / MOE_TM; } pre[NEXP] = s; }
    __syncthreads();
}
DI void moe_up_tile(const Params& p, char* smem, const int* pre, int t) {
    const int* cnt = (const int*)(p.ws + WS_CNT); const int* rowlist = (const int*)(p.ws + WS_ROWLIST);
    const bf16_t* Tt = (const bf16_t*)(p.ws + WS_T); const bf16_t* GUT = (const bf16_t*)(p.aux + AUX_GUT); bf16_t* HID = (bf16_t*)(p.ws + WS_HID);
    const int mg = t >> 1, nt = t & 1; int e = 0;
    while (pre[e + 1] <= mg) ++e;
    const int mt = mg - pre[e], ce = cnt[e * CNT_STRIDE]; const int* rl = rowlist + (size_t)e * CAP;
    g8::Acc acc; g8::acc_zero(acc);
    g8::kloop_g(acc, smem, Tt, [&](int r) { int idx = mt * 256 + r; idx = idx < ce ? idx : ce - 1; return (rl[idx] >> 1) * D; }, GUT + ((size_t)e * 512 + nt * 256) * D, D, D, 0);
    const int t2 = tid_x(), wid = t2 >> 6, l2 = t2 & 63, wr2 = wid >> 2, wc2 = wid & 3, fr2 = l2 & 15, fq2 = l2 >> 4;
    int prs[2][4];
#pragma unroll
    for (int ai = 0; ai < 2; ++ai)
#pragma unroll
        for (int m = 0; m < 4; ++m) { const int idx = mt * 256 + ai * 128 + wr2 * 64 + m * 16 + fr2; prs[ai][m] = idx < ce ? rl[idx] : -1; }
#pragma unroll
    for (int ai = 0; ai < 2; ++ai)
#pragma unroll
        for (int m = 0; m < 4; ++m) {
            if (prs[ai][m] >= 0) {
                const int pair = prs[ai][m];
#pragma unroll
                for (int bj = 0; bj < 2; ++bj) {
                    const f32x4 g = acc[ai][bj][m][0], u = acc[ai][bj][m][1];
                    u32x2 o; o.x = pk2(fsilu(g.x) * u.x, fsilu(g.y) * u.y); o.y = pk2(fsilu(g.z) * u.z, fsilu(g.w) * u.w);
                    *(u32x2*)(HID + (size_t)pair * DE + nt * 128 + bj * 64 + wc2 * 16 + fq2 * 4) = o;
                }
            }
        }
}
DI void moe_down_tile(const Params& p, char* smem, const int* pre, int t) {
    constexpr int NT8 = D / 256;
    const int* cnt = (const int*)(p.ws + WS_CNT); const int* rowlist = (const int*)(p.ws + WS_ROWLIST); const float* pairw = (const float*)(p.ws + WS_PAIRW);
    const bf16_t* HID = (const bf16_t*)(p.ws + WS_HID); bf16_t* OP = (bf16_t*)(p.ws + WS_OPAIR);
    const int mg = t / NT8, nt = t % NT8; int e = 0;
    while (pre[e + 1] <= mg) ++e;
    const int mt = mg - pre[e], ce = cnt[e * CNT_STRIDE]; const int* rl = rowlist + (size_t)e * CAP;
    g8::Acc acc; g8::acc_zero(acc);
    g8::kloop_g(acc, smem, HID, [&](int r) { int idx = mt * 256 + r; idx = idx < ce ? idx : ce - 1; return rl[idx] * DE; }, DNT_PTR(p.ws, e) + (size_t)nt * 256 * DE, DE, DE, 0);
    {
        const int t2 = tid_x(), wid = t2 >> 6, l2 = t2 & 63, wr2 = wid >> 2, wc2 = wid & 3, fr2 = l2 & 15, fq2 = l2 >> 4;
        int prs[2][4]; float pws[2][4];
#pragma unroll
        for (int ai = 0; ai < 2; ++ai)
#pragma unroll
            for (int m = 0; m < 4; ++m) { const int idx = mt * 256 + ai * 128 + wr2 * 64 + m * 16 + fr2; prs[ai][m] = idx < ce ? rl[idx] : -1; }
#pragma unroll
        for (int ai = 0; ai < 2; ++ai)
#pragma unroll
            for (int m = 0; m < 4; ++m) pws[ai][m] = prs[ai][m] >= 0 ? pairw[prs[ai][m]] : 0.f;
#pragma unroll
        for (int ai = 0; ai < 2; ++ai)
#pragma unroll
            for (int m = 0; m < 4; ++m) {
                if (prs[ai][m] >= 0) {
                    const float w = pws[ai][m]; bf16_t* orow = OP + (size_t)prs[ai][m] * D + nt * 256 + wc2 * 32 + fq2 * 4;
#pragma unroll
                    for (int bj = 0; bj < 2; ++bj)
#pragma unroll
                        for (int n = 0; n < 2; ++n) { const f32x4 v = acc[ai][bj][m][n];
                            u32x2 o; o.x = pk2(v.x * w, v.y * w); o.y = pk2(v.z * w, v.w * w); *(u32x2*)(orow + bj * 128 + n * 16) = o; }
                }
            }
    }
}
DI void phase8(const Params& p, char* smem) {
    const int tid = tid_x(), lane = tid & 63, wave = tid >> 6, wr = wave >> 1, wc = wave & 1, fr = lane & 15, fq = lane >> 4;
    int* pre = (int*)(smem + LDS_BYTES - 256);
    moe_tiles(p, smem, pre);
    const int* cnt = (const int*)(p.ws + WS_CNT); const int* rowlist = (const int*)(p.ws + WS_ROWLIST);
    const bf16_t* Tt = (const bf16_t*)(p.ws + WS_T); const bf16_t* GUT = (const bf16_t*)(p.aux + AUX_GUT); bf16_t* HID = (bf16_t*)(p.ws + WS_HID);
    if (USE_G8) {
        if ((int)blockIdx.x < pre[NEXP] * 2) moe_up_tile(p, smem, pre, (int)blockIdx.x);
        return;
    }
    const int ntile = pre[NEXP] * 4;
    for (int t = blockIdx.x; t < ntile; t += gridDim.x) {
        const int mg = t >> 2, nt = t & 3; int e = 0;
        while (pre[e + 1] <= mg) ++e;
        const int mt = mg - pre[e], ce = cnt[e * CNT_STRIDE]; const int* rl = rowlist + (size_t)e * CAP;
        f32x4 acc[MREP][4]; acc_zero(acc);
        gemm_kloop(acc, smem, [&](int i) { int idx = mt * BM + i; idx = idx < ce ? idx : ce - 1; return Tt + (size_t)(rl[idx] >> 1) * D; }, GUT + ((size_t)e * 512 + nt * 128) * D, D, D);
#pragma unroll
        for (int m = 0; m < MREP; ++m)
#pragma unroll
            for (int j = 0; j < 4; ++j) {
                const int idx = mt * BM + wr * 16 * MREP + m * 16 + fq * 4 + j;
                if (idx < ce) {
                    const int pair = rl[idx];
#pragma unroll
                    for (int n = 0; n < 2; ++n) {
                        const float g = acc[m][n][j], u = acc[m][n + 2][j];
                        HID[(size_t)pair * DE + nt * 64 + wc * 32 + n * 16 + fr] = f2bf(siluf_(g) * u);
                    }
                }
            }
    }
}
DI void phase9(const Params& p, char* smem) {
    const int tid = tid_x(), lane = tid & 63, wave = tid >> 6, wr = wave >> 1, wc = wave & 1, fr = lane & 15, fq = lane >> 4;
    int* pre = (int*)(smem + LDS_BYTES - 256);
    moe_tiles(p, smem, pre);
    const int* cnt = (const int*)(p.ws + WS_CNT); const int* rowlist = (const int*)(p.ws + WS_ROWLIST); const float* pairw = (const float*)(p.ws + WS_PAIRW);
    const bf16_t* HID = (const bf16_t*)(p.ws + WS_HID); const bf16_t* DNT = (const bf16_t*)(p.ws + WS_DNT); bf16_t* OP = (bf16_t*)(p.ws + WS_OPAIR);
    if (USE_G8) {
        constexpr int NT8 = D / 256;
        const int G = (int)gridDim.x, NU = pre[NEXP] * 2, NU2 = NU > G ? NU - G : 0, ND = pre[NEXP] * NT8;
        int* cntw = (int*)(p.ws + WS_CNT);
        int* tk = (int*)(smem + LDS_BYTES - 512);
        for (;;) {
            __syncthreads();
            if (tid_x() == 0) *tk = atomicAdd(&cntw[CNT_TICKET], 1);
            __syncthreads();
            const int j = *tk;
            if (j >= NU2 + ND) break;
            if (j < NU2) {
                moe_up_tile(p, smem, pre, G + j);
#ifndef EMU
                asm volatile("s_waitcnt vmcnt(0)" ::: "memory");
#endif
                __syncthreads();
                if (tid_x() == 0) {
#ifndef EMU
                    __builtin_amdgcn_fence(__ATOMIC_RELEASE, "agent");
                    asm volatile("s_waitcnt vmcnt(0)" ::: "memory");
#endif
                    (void)atomicAdd(&cntw[CNT_U2DONE], 1);
                }
            } else {
                const int dt = j - NU2;
                if (2 * (dt / NT8) + 1 >= G) {
                    if (tid_x() == 0) {
#ifndef EMU
                        while (__hip_atomic_load(&cntw[CNT_U2DONE], __ATOMIC_RELAXED, __HIP_MEMORY_SCOPE_AGENT) < NU2) __builtin_amdgcn_s_sleep(2);
                        __builtin_amdgcn_fence(__ATOMIC_ACQUIRE, "agent");
                        asm volatile("s_waitcnt vmcnt(0)" ::: "memory");
#endif
                    }
                    __syncthreads();
                }
                moe_down_tile(p, smem, pre, dt);
            }
        }
        return;
    }
    constexpr int NT = D / 128;
    const int ntile = pre[NEXP] * NT;
    for (int t = blockIdx.x; t < ntile; t += gridDim.x) {
        const int mg = t / NT, nt = t % NT; int e = 0;
        while (pre[e + 1] <= mg) ++e;
        const int mt = mg - pre[e], ce = cnt[e * CNT_STRIDE]; const int* rl = rowlist + (size_t)e * CAP;
        f32x4 acc[MREP][4]; acc_zero(acc);
        gemm_kloop(acc, smem, [&](int i) { int idx = mt * BM + i; idx = idx < ce ? idx : ce - 1; return HID + (size_t)rl[idx] * DE; }, DNT_PTR(p.ws, e) + (size_t)nt * 128 * DE, DE, DE);
#pragma unroll
        for (int m = 0; m < MREP; ++m)
#pragma unroll
            for (int j = 0; j < 4; ++j) {
                const int idx = mt * BM + wr * 16 * MREP + m * 16 + fq * 4 + j;
                if (idx < ce) {
                    const int pair = rl[idx]; const float w = pairw[pair];
#pragma unroll
                    for (int n = 0; n < 4; ++n) OP[(size_t)pair * D + nt * 128 + wc * 64 + n * 16 + fr] = f2bf(acc[m][n][j] * w);
                }
            }
    }
}

DI void phase10(const Params& p, char* smem) {
    const int lane = tid_x() & 63, wave = tid_x() >> 6;
    const int gw = blockIdx.x * 8 + wave, ngw = gridDim.x * 8;
    const float* Hh = (const float*)(p.ws + WS_H); const float* mod = (const float*)(p.ws + WS_MOD); const bf16_t* OP = (const bf16_t*)(p.ws + WS_OPAIR);
    for (int tok = gw; tok < T_LAT; tok += ngw) {
        const int b = tok / S;
        f32x4 x[D / 256]; float ss = 0.f;
#pragma unroll
        for (int j = 0; j < D / 256; ++j) {
            const int k = j * 256 + lane * 4;
            const f32x4 hv = *(const f32x4*)(Hh + (size_t)tok * D + k), g2 = *(const f32x4*)(mod + (size_t)b * 6 * D + 5 * D + k);
            const u32x2 p0 = *(const u32x2*)(OP + (size_t)(tok * 2) * D + k), p1 = *(const u32x2*)(OP + (size_t)(tok * 2 + 1) * D + k);
            f32x4 m;
            m.x = bf2f((bf16_t)(p0.x & 0xffffu)) + bf2f((bf16_t)(p1.x & 0xffffu)); m.y = bf2f((bf16_t)(p0.x >> 16)) + bf2f((bf16_t)(p1.x >> 16));
            m.z = bf2f((bf16_t)(p0.y & 0xffffu)) + bf2f((bf16_t)(p1.y & 0xffffu)); m.w = bf2f((bf16_t)(p0.y >> 16)) + bf2f((bf16_t)(p1.y >> 16));
            x[j].x = hv.x + g2.x * m.x; x[j].y = hv.y + g2.y * m.y; x[j].z = hv.z + g2.z * m.z; x[j].w = hv.w + g2.w * m.w;
            ss += x[j].x * x[j].x + x[j].y * x[j].y + x[j].z * x[j].z + x[j].w * x[j].w;
        }
        ss = wave_sum(ss);
        const float rstd = 1.0f / sqrtf(ss * (1.0f / D) + 1e-6f);
#pragma unroll
        for (int j = 0; j < D / 256; ++j) {
            const int k = j * 256 + lane * 4; const f32x4 g = *(const f32x4*)(p.in[I_FIN] + k);
            f32x4 o; o.x = x[j].x * rstd * g.x; o.y = x[j].y * rstd * g.y; o.z = x[j].z * rstd * g.z; o.w = x[j].w * rstd * g.w;
            *(f32x4*)(p.out + (size_t)tok * D + k) = o;
        }
    }
}

DI void run_phase(const Params& p, int ph, char* smem) {
    switch (ph) {
        case PH_MOD: phase0(p, smem); break;
        case PH_U: phase1(p, smem); break;
        case PH_P: phase2(p, smem); break;
        case PH_HALO: phase_halo(p, smem); break;
        case PH_FIR: phase_fir(p, smem); break;
        case PH_CHAINS: phase3(p, smem); break;
        case PH_POST: phase4(p, smem); break;
        case PH_MERGE: phase5(p, smem); break;
        case PH_WOUT: phase6(p, smem); break;
        case PH_ROUTER: phase7(p, smem); break;
        case PH_UP: phase8(p, smem); break;
        case PH_DOWN: phase9(p, smem); break;
        default: phase10(p, smem); break;
    }
}

#ifndef EMU
namespace cg = cooperative_groups;
#define XB_TMO      128
#define XB_XCNT(j)  (256  + 64 * (j))
#define XB_XSUB(j)  (1280 + 64 * (j))
#define XB_XGEN(j)  (2304 + 64 * (j))
#define XB_TOP      3328
#define XB_TOPGEN   3392
#define XB_SPIN_CAP (1u << 20)
DI unsigned xb_ld(unsigned* p) { return __hip_atomic_load(p, __ATOMIC_RELAXED, __HIP_MEMORY_SCOPE_AGENT); }
DI unsigned xb_add(unsigned* p, unsigned v) { return __hip_atomic_fetch_add(p, v, __ATOMIC_RELAXED, __HIP_MEMORY_SCOPE_AGENT); }
DI unsigned xb_xcc_id() { return (unsigned)__builtin_amdgcn_s_getreg((3 << 11) | 20) & 0xFu; }
#define XB_SPIN(cond, bar) do { unsigned _sp = 0; while (cond) { __builtin_amdgcn_s_sleep(1); \
    if ((++_sp & 255u) == 0u) { if (xb_ld(&(bar)[XB_TMO])) break; if (_sp > XB_SPIN_CAP) { atomicAdd(&(bar)[XB_TMO], 1u); break; } } } } while (0)
DI void xcd_barrier_post(unsigned* bar) { if (threadIdx.x == 0) (void)xb_add(&bar[XB_XCNT(xb_xcc_id())], 1u); }
DI void xcd_barrier_complete(unsigned* bar, unsigned x, unsigned& nloc, unsigned& nx) {
    const unsigned G = gridDim.x;
    unsigned sum, cnt, mine, sp = 0u;
    for (;;) {
        sum = 0u; cnt = 0u; mine = 0u;
#pragma unroll
        for (unsigned j = 0; j < 16; ++j) { const unsigned c = xb_ld(&bar[XB_XCNT(j)]); sum += c; cnt += (c > 0u) ? 1u : 0u; mine = (j == x) ? c : mine; }
        if (sum == G) break;
        __builtin_amdgcn_s_sleep(1);
        if ((++sp & 255u) == 0u) { if (xb_ld(&bar[XB_TMO])) break; if (sp > XB_SPIN_CAP) { atomicAdd(&bar[XB_TMO], 1u); break; } }
    }
    nloc = mine > 0u ? mine : 1u; nx = cnt > 0u ? cnt : 1u;
}
DI void xcd_barrier(unsigned* bar, volatile unsigned* st) {
    asm volatile("s_waitcnt vmcnt(0)" ::: "memory");
    __syncthreads();
    if (threadIdx.x == 0) {
        __builtin_amdgcn_s_waitcnt(0);
        const unsigned x = xb_xcc_id();
        unsigned nloc = st[0], nx = st[1];
        if (nloc == 0u) { xcd_barrier_complete(bar, x, nloc, nx); st[0] = nloc; st[1] = nx; }
        const unsigned old = xb_add(&bar[XB_XSUB(x)], 1u);
        const unsigned gen = old / nloc;
        if (old + 1u == (gen + 1u) * nloc) {
            __builtin_amdgcn_fence(__ATOMIC_RELEASE, "agent");
            asm volatile("s_waitcnt vmcnt(0)" ::: "memory");
            const unsigned og = xb_add(&bar[XB_TOP], 1u);
            const unsigned tg = og / nx;
            if (og + 1u == (tg + 1u) * nx) xb_add(&bar[XB_TOPGEN], 1u);
            else XB_SPIN(xb_ld(&bar[XB_TOPGEN]) == tg, bar);
            __builtin_amdgcn_fence(__ATOMIC_ACQUIRE, "agent");
            xb_add(&bar[XB_XGEN(x)], 1u);
            asm volatile("s_waitcnt vmcnt(0)" ::: "memory");
        } else {
            XB_SPIN(xb_ld(&bar[XB_XGEN(x)]) == gen, bar);
            __builtin_amdgcn_fence(__ATOMIC_ACQUIRE, "agent");
            asm volatile("s_waitcnt vmcnt(0)" ::: "memory");
        }
    }
    __syncthreads();
}
__global__ void __launch_bounds__(NTHREADS) mk_forward(Params p) {
    extern __shared__ __attribute__((aligned(16))) char smem[];
    typedef const Params __attribute__((address_space(4)))* KPtr;
    volatile unsigned* xst = (volatile unsigned*)(smem + LDS_BYTES);
    if (threadIdx.x < 2) xst[threadIdx.x] = 0u;
    xcd_barrier_post((unsigned*)(p.ws + WS_XBAR));
#define PHASE(k, fn) { KPtr kp = (KPtr)__builtin_amdgcn_kernarg_segment_ptr(); asm volatile("" : "+s"(kp)); fn(*(const Params*)kp, smem); \
        unsigned* xbar = (unsigned*)(((const Params*)kp)->ws + WS_XBAR); \
        if ((k) + 1 < NPHASES) xcd_barrier(xbar, xst); }
    PHASE(0, phase0) PHASE(1, phase1) PHASE(2, phase2)
    if (!USE_G8) PHASE(3, phase_halo)
    PHASE(4, phase_fir) PHASE(5, phase3) PHASE(6, phase4)
    PHASE(7, phase5) PHASE(8, phase6) PHASE(9, phase7) PHASE(10, phase8) PHASE(11, phase9) PHASE(12, phase10)
#undef PHASE
}

extern "C" void kernel_launch(void* const* d_in, const int* in_sizes, int n_in, void* d_out, int out_size, void* d_ws, size_t ws_size, hipStream_t stream) {
    static int grid_blocks = 0;
    if (grid_blocks == 0) {
        if (n_in != 35 || out_size != T_LAT * D || ws_size < WS_END || (size_t)out_size * 4 < AUX_END) {
            fprintf(stderr, "kernel_launch: unexpected shapes (n_in %d out %d ws %zu need %zu aux need %zu)\n", n_in, out_size, ws_size, (size_t)WS_END, (size_t)AUX_END);
            grid_blocks = -1; return;
        }
        int dev = 0, cus = 0, per_cu = 0;
        hipGetDevice(&dev);
        hipDeviceGetAttribute(&cus, hipDeviceAttributeMultiprocessorCount, dev);
        hipFuncSetAttribute((const void*)mk_forward, hipFuncAttributeMaxDynamicSharedMemorySize, LDS_BYTES + 256);
        hipOccupancyMaxActiveBlocksPerMultiprocessor(&per_cu, (const void*)mk_forward, NTHREADS, LDS_BYTES + 256);
        if (per_cu < 1) { fprintf(stderr, "kernel_launch: occupancy query says %d blocks/CU\n", per_cu); per_cu = 1; }
        if (per_cu > 1) per_cu = 1;
        grid_blocks = cus * per_cu;
    }
    if (grid_blocks < 0) return;
    Params p{};
    for (int i = 0; i < 35; ++i) p.in[i] = (const float*)d_in[i];
    p.out = (float*)d_out; p.ws = (char*)d_ws; p.aux = (char*)d_out;
    p.ph_lo = 0; p.ph_hi = NPHASES;
    (void)hipMemsetAsync((char*)d_ws + WS_XBAR, 0, 3456 * 4, stream);
    void* args[] = {&p};
    hipError_t e = hipLaunchCooperativeKernel((const void*)mk_forward, dim3(grid_blocks), dim3(NTHREADS), args, LDS_BYTES + 256, stream);
    if (e != hipSuccess) fprintf(stderr, "cooperative launch failed: %s (grid %d)\n", hipGetErrorString(e), grid_blocks);
}
#endif
```

```cpp
#ifndef EMU
#include <hip/hip_runtime.h>
#include <hip/hip_cooperative_groups.h>
#include <cstdio>
#endif
#include <stdint.h>
#include <stddef.h>

#ifndef CFG_D
#define CFG_D 1024
#define CFG_B 8
#define CFG_S 2048
#define CFG_CTX 256
#endif
#ifndef MK_LAUNCHES
#define MK_LAUNCHES 1
#endif

typedef unsigned short bf16_t;
typedef short bf16x8 __attribute__((ext_vector_type(8)));
typedef float f32x4 __attribute__((ext_vector_type(4)));
typedef unsigned u32x4 __attribute__((ext_vector_type(4)));
typedef unsigned u32x2 __attribute__((ext_vector_type(2)));

#define DI __device__ __forceinline__
DI int tid_x() { int t = (int)threadIdx.x;
#ifndef EMU
    asm volatile("" : "+v"(t));
#endif
    return t; }

constexpr int D = CFG_D, NB = CFG_B, S = CFG_S, CTXL = CFG_CTX;
constexpr int GW = 64, ROWS = S / GW;
constexpr int T_CTX = NB * CTXL, T_LAT = NB * S, T_ALL = T_CTX + T_LAT;
constexpr int H_A = 4, H_B = 8;
constexpr int A_COLS = 2064, B_COLS = 1920;
constexpr int IN_COLS = A_COLS + B_COLS + 2 * D;
constexpr int COL_B0 = A_COLS, COL_G0 = A_COLS + B_COLS;
constexpr int CTX_COLS = COL_G0;
constexpr int NP = ((IN_COLS + 127) / 128) * 128;
constexpr int NEXP = 32, DE = 256;
constexpr int NV = NB + 1;
constexpr int NTHREADS = 512;
constexpr int MREP = (T_CTX % 256 == 0 && T_LAT % 256 == 0) ? 4 : 2;
constexpr int BM = 64 * MREP;
constexpr int NPHASES = 13;
enum { PH_MOD = 0, PH_U, PH_P, PH_HALO, PH_FIR, PH_CHAINS, PH_POST, PH_MERGE, PH_WOUT, PH_ROUTER, PH_UP, PH_DOWN, PH_FINAL };
constexpr int LDS_BYTES = 155648;
constexpr int CAP = T_LAT;

static_assert(D % 256 == 0 && S % 64 == 0 && CTXL % 64 == 0 && T_CTX % BM == 0 && T_LAT % BM == 0, "shape");

constexpr size_t al256(size_t x) { return (x + 255) & ~(size_t)255; }
constexpr int CNT_STRIDE = 64;
constexpr size_t WS_CNT = 512 + 3456 * 4 + 256;
constexpr int CNT_TICKET = 2 * CNT_STRIDE + 16, CNT_U2DONE = 3 * CNT_STRIDE + 16;
constexpr size_t WS_BAR = 256;
constexpr size_t WS_XBAR = 512;
constexpr size_t WS_MOD = 512 + 3456 * 4 + 256 + 32 * 64 * 4;
constexpr size_t WS_AB = al256(WS_MOD + (size_t)NV * 6 * D * 4);
constexpr size_t WS_BONUS = al256(WS_AB + (size_t)T_ALL * 16 * 4);
constexpr size_t WS_PAIRW = al256(WS_BONUS + (size_t)2 * T_LAT * 8 * 4);
constexpr size_t WS_ROWLIST = al256(WS_PAIRW + (size_t)T_LAT * 2 * 4);
constexpr size_t WS_WRT = al256(WS_ROWLIST + (size_t)NEXP * CAP * 4);
constexpr size_t WS_G2T = al256(WS_WRT + (size_t)36 * D * 4);
constexpr size_t WS_WOA = al256(WS_G2T + (size_t)512 * 128 * 2);
constexpr size_t WS_WOB = al256(WS_WOA + (size_t)D * 512 * 2);
constexpr size_t WS_WOUT = al256(WS_WOB + (size_t)D * 512 * 2);
constexpr size_t WS_OA = al256(WS_WOUT + (size_t)D * D * 2);
constexpr size_t WS_OB = al256(WS_OA + (size_t)T_LAT * 512 * 2);
constexpr size_t WS_HALO_A = WS_OA;
constexpr size_t WS_HALO_B = WS_OA + al256((size_t)(T_ALL / 64) * 4 * 1536 * 2);
static_assert(WS_HALO_B + (size_t)(T_ALL / 64) * 2 * 1920 * 2 <= WS_OB + (size_t)T_LAT * 512 * 2, "halo buffers");
constexpr size_t WS_DNT = WS_OA;
constexpr size_t WS_SPARE_END = al256(WS_OB + (size_t)T_LAT * 512 * 2) > al256(WS_DNT + (size_t)NEXP * D * DE * 2) ? al256(WS_OB + (size_t)T_LAT * 512 * 2) : al256(WS_DNT + (size_t)NEXP * D * DE * 2);
constexpr size_t WS_P = WS_SPARE_END;
constexpr size_t WS_PLAT = WS_P;
constexpr size_t WS_PCTX = al256(WS_PLAT + (size_t)T_LAT * IN_COLS * 2);
constexpr size_t WS_P_END = al256(WS_PCTX + (size_t)T_CTX * CTX_COLS * 2);
constexpr size_t WS_H = WS_P;
constexpr size_t WS_T = al256(WS_H + (size_t)T_LAT * D * 4);
constexpr size_t WS_HID = al256(WS_T + (size_t)T_LAT * D * 2);
constexpr size_t WS_OPAIR = al256(WS_HID + (size_t)T_LAT * 2 * DE * 2);
constexpr size_t WS_P2_END = al256(WS_OPAIR + (size_t)T_LAT * 2 * D * 2);
constexpr size_t WS_END0 = WS_P_END > WS_P2_END ? WS_P_END : WS_P2_END;
constexpr size_t WS_GUARANTEED = (size_t)256 << 20;
constexpr int NE_EARLY = WS_END0 >= WS_GUARANTEED ? 0 : ((WS_GUARANTEED - WS_END0) / ((size_t)D * DE * 2) >= (size_t)NEXP ? NEXP : (int)((WS_GUARANTEED - WS_END0) / ((size_t)D * DE * 2)));
constexpr size_t WS_DNT2 = WS_END0;
constexpr size_t WS_END = WS_DNT2 + (size_t)NE_EARLY * D * DE * 2;
constexpr size_t AUX_WINT = 0;
constexpr size_t AUX_U = al256((size_t)NP * D * 2);
constexpr size_t AUX_YDIR = 0;
constexpr size_t AUX_Y = 0;
constexpr size_t AUX_GUT = (size_t)T_LAT * D * 2 > (size_t)2 * T_LAT * 512 * 2 ? (size_t)T_LAT * D * 2 : (size_t)2 * T_LAT * 512 * 2;
constexpr size_t AUX_END1 = AUX_U + (size_t)T_ALL * D * 2;
constexpr size_t AUX_END2 = AUX_YDIR + (size_t)2 * T_LAT * 512 * 2;
static_assert(AUX_YDIR + (size_t)2 * T_LAT * 512 * 2 <= AUX_GUT && AUX_Y + (size_t)T_LAT * D * 2 <= AUX_GUT, "aux overlap");
constexpr size_t AUX_END3 = AUX_GUT + (size_t)NEXP * 512 * D * 2;
constexpr size_t AUX_END = (AUX_END1 > AUX_END2 ? (AUX_END1 > AUX_END3 ? AUX_END1 : AUX_END3) : (AUX_END2 > AUX_END3 ? AUX_END2 : AUX_END3));

#define DNT_PTR(ws, e) ((bf16_t*)((ws) + ((e) < NE_EARLY ? WS_DNT2 : WS_DNT)) + (size_t)(e) * D * DE)
struct Params {
    const float* in[35];
    float* out;
    char* ws;
    char* aux;
    int ph_lo, ph_hi;
};
enum { I_X = 0, I_C, I_CTX, I_CCTX, I_ADAW, I_ADAB, I_NMIX, I_NFFN, I_WIN, I_CONV, I_ALOG, I_DTB, I_ONORM, I_MU, I_W0, I_W2, I_A0, I_A2, I_G2, I_KK, I_KA, I_RK, I_LNG, I_LNB, I_WOA, I_WOB, I_WOUT, I_RG, I_RGB, I_RE, I_REB, I_MG, I_MU_UP, I_MD, I_FIN };

DI float bf2f(bf16_t v) { union { unsigned u; float f; } x; x.u = ((unsigned)v) << 16; return x.f; }
#ifdef EMU
DI bf16_t f2bf(float f) { union { float f; unsigned u; } x; x.f = f; unsigned u = x.u; u += 0x7fffu + ((u >> 16) & 1u); return (bf16_t)(u >> 16); }
DI unsigned pk2(float lo, float hi) { return (unsigned)f2bf(lo) | ((unsigned)f2bf(hi) << 16); }
#else
typedef __bf16 hbf16x2 __attribute__((ext_vector_type(2)));
typedef float f32x2_ __attribute__((ext_vector_type(2)));
DI bf16_t f2bf(float f) { return __builtin_bit_cast(unsigned short, (__bf16)f); }
DI unsigned pk2(float lo, float hi) { const f32x2_ v = {lo, hi}; return __builtin_bit_cast(unsigned, __builtin_convertvector(v, hbf16x2)); }
#endif
DI float sigmoidf_(float x) { return 1.0f / (1.0f + expf(-x)); }
DI float siluf_(float x) { return x / (1.0f + expf(-x)); }
DI float softplusf_(float x) { return x > 20.f ? x : log1pf(expf(x)); }
DI float wave_sum(float v) {
#pragma unroll
    for (int o = 1; o < 64; o <<= 1) v += __shfl_xor(v, o);
    return v;
}
#ifdef EMU
#define MFMA16(a, b, c) emu_mfma16((a), (b), (c))
#define WAVE_SYNC() emu::wave_bar()
#else
#define MFMA16(a, b, c) __builtin_amdgcn_mfma_f32_16x16x32_bf16((a), (b), (c), 0, 0, 0)
#define WAVE_SYNC() asm volatile("s_waitcnt lgkmcnt(0)" ::: "memory")
#endif
#ifdef EMU
#define LDS_BARRIER() __syncthreads()
#else
#define LDS_BARRIER() do { asm volatile("s_waitcnt lgkmcnt(0)" ::: "memory"); __builtin_amdgcn_s_barrier(); asm volatile("" ::: "memory"); } while (0)
#endif

typedef float f32x16 __attribute__((ext_vector_type(16)));
typedef float f32x2_ac __attribute__((ext_vector_type(2)));
typedef short bf16x4 __attribute__((ext_vector_type(4)));
#ifdef EMU
#define MFMA32(a, b, c) emu_mfma32((a), (b), (c))
DI float fexp(float x) { return expf(x); }
DI float flog(float x) { return logf(x); }
DI float frcp(float x) { return 1.0f / x; }
DI float frsq(float x) { return 1.0f / sqrtf(x); }
DI float wave_sum_fast(float v) { return wave_sum(v); }
#else
#define MFMA32(a, b, c) __builtin_amdgcn_mfma_f32_32x32x16_bf16((a), (b), (c), 0, 0, 0)
DI float fexp(float x) { return __expf(x); }
DI float flog(float x) { return __logf(x); }
DI float frcp(float x) { return __builtin_amdgcn_rcpf(x); }
DI float frsq(float x) { return __builtin_amdgcn_rsqf(x); }
#define DPP_ADD(v, ctrl) ((v) + __builtin_bit_cast(float, __builtin_amdgcn_update_dpp(0, __builtin_bit_cast(int, (v)), (ctrl), 0xf, 0xf, false)))
DI float wave_sum_fast(float v) {
    v = DPP_ADD(v, 0xB1); v = DPP_ADD(v, 0x4E); v = DPP_ADD(v, 0x141); v = DPP_ADD(v, 0x140);
    const int iv = __builtin_bit_cast(int, v);
    return (__builtin_bit_cast(float, __builtin_amdgcn_readlane(iv, 0)) + __builtin_bit_cast(float, __builtin_amdgcn_readlane(iv, 16))) +
           (__builtin_bit_cast(float, __builtin_amdgcn_readlane(iv, 32)) + __builtin_bit_cast(float, __builtin_amdgcn_readlane(iv, 48)));
}
#endif
DI float fsigmoid(float x) { return frcp(1.0f + fexp(-x)); }
DI float fsilu(float x) { return x * fsigmoid(x); }
DI float fsoftplus(float x) { return fmaxf(x, 0.f) + flog(1.f + fexp(-fabsf(x))); }
DI float ftanh(float x) { return 1.0f - 2.0f * frcp(1.0f + fexp(2.0f * x)); }

constexpr int LDS_ROW = 40;
constexpr int GEMM_A_BYTES = BM * LDS_ROW * 2, GEMM_B_BYTES = 128 * LDS_ROW * 2;
template <int MR, class ARow>
DI void gemm_kloop(f32x4 (&acc)[MR][4], char* smem, ARow arow, const bf16_t* Bt, int ldb, int K) {
    constexpr int BM = 64 * MR;
    const int tid = tid_x(), lane = tid & 63, wave = tid >> 6, wr = wave >> 1, wc = wave & 1, fr = lane & 15, fq = lane >> 4;
    bf16_t* As = (bf16_t*)smem;
    bf16_t* Bs = (bf16_t*)(smem + 2 * GEMM_A_BYTES);
    constexpr int ACH = BM * 4 / NTHREADS;
    static_assert(ACH >= 1, "tile");
    const bf16_t* ap[ACH];
#pragma unroll
    for (int i = 0; i < ACH; ++i) { const int q = tid + i * NTHREADS; ap[i] = arow(q >> 2) + (q & 3) * 8; }
    const bf16_t* bp = Bt + (size_t)(tid >> 2) * ldb + (tid & 3) * 8;
    u32x4 ra[ACH], rb;
#pragma unroll
    for (int i = 0; i < ACH; ++i) ra[i] = *(const u32x4*)(ap[i]);
    rb = *(const u32x4*)(bp);
    const int nk = K / 32;
    for (int kt = 0; kt < nk; ++kt) {
        const int buf = kt & 1;
#pragma unroll
        for (int i = 0; i < ACH; ++i) { const int q = tid + i * NTHREADS; *(u32x4*)(As + (buf * BM + (q >> 2)) * LDS_ROW + (q & 3) * 8) = ra[i]; }
        *(u32x4*)(Bs + (buf * 128 + (tid >> 2)) * LDS_ROW + (tid & 3) * 8) = rb;
        __syncthreads();
        if (kt + 1 < nk) {
#pragma unroll
            for (int i = 0; i < ACH; ++i) ra[i] = *(const u32x4*)(ap[i] + (kt + 1) * 32);
            rb = *(const u32x4*)(bp + (kt + 1) * 32);
        }
        bf16x8 af[MR], bfr[4];
#pragma unroll
        for (int m = 0; m < MR; ++m) af[m] = *(const bf16x8*)(As + (buf * BM + wr * 16 * MR + m * 16 + fr) * LDS_ROW + fq * 8);
#pragma unroll
        for (int n = 0; n < 4; ++n) bfr[n] = *(const bf16x8*)(Bs + (buf * 128 + wc * 64 + n * 16 + fr) * LDS_ROW + fq * 8);
#pragma unroll
        for (int m = 0; m < MR; ++m)
#pragma unroll
            for (int n = 0; n < 4; ++n) acc[m][n] = MFMA16(af[m], bfr[n], acc[m][n]);
    }
    __syncthreads();
}
template <int MR>
DI void acc_zero(f32x4 (&acc)[MR][4]) {
#pragma unroll
    for (int m = 0; m < MR; ++m)
#pragma unroll
        for (int n = 0; n < 4; ++n) acc[m][n] = (f32x4){0.f, 0.f, 0.f, 0.f};
}

namespace g8 {
constexpr int BM = 256, BK = 64, HALF = 128, HT = HALF * BK;
constexpr int LDS_NEED = 8 * HT * 2;
DI int lds_byte(int r, int c) { const int st = (r >> 4) * 2 + (c >> 5), rr = r & 15, cc = c & 31, ob = rr * 64 + cc * 2; return st * 1024 + (ob ^ (((ob >> 9) & 1) << 5)); }
DI void stage_rc(int b, int& R, int& C) { const int st = b / 1024, sb = b % 1024, swz = sb ^ (((sb >> 9) & 1) << 5); R = (st >> 1) * 16 + swz / 64; C = (st & 1) * 32 + (swz % 64) / 2; }
#ifdef EMU
#define G8_GLDS(src, dst) emu_global_load_lds16((src), (dst))
#define G8_WAIT_V(n)
#define G8_WAIT_L(n)
#define G8_BAR __syncthreads()
#define G8_SCHED
#define G8_PRIO(x)
#else
#define G8_GLDS(src, dst) __builtin_amdgcn_global_load_lds((const unsigned*)(src), (__attribute__((address_space(3))) unsigned*)(dst), 16, 0, 0)
#define G8_WAIT_V(n) asm volatile("s_waitcnt vmcnt(" #n ")" ::: "memory")
#define G8_WAIT_L(n) asm volatile("s_waitcnt lgkmcnt(" #n ")" ::: "memory")
#define G8_BAR __builtin_amdgcn_s_barrier()
#define G8_SCHED __builtin_amdgcn_sched_barrier(0)
#define G8_PRIO(x) __builtin_amdgcn_s_setprio(x)
#endif
typedef f32x4 Acc[2][2][4][2];
template <class AOff>
DI void kloop_g(Acc& acc, char* smem, const bf16_t* A, AOff aoff, const bf16_t* Bt, int ldb, int K, int bcol) {
    bf16_t* shm = (bf16_t*)smem;
    const int tid = tid_x(), wid = tid >> 6, lane = tid & 63, wr = wid >> 2, wc = wid & 3, fr = lane & 15, fq = lane >> 4;
    int ao[2][2];
#pragma unroll
    for (int h = 0; h < 2; ++h)
#pragma unroll
        for (int i = 0; i < 2; ++i) { int R, C; stage_rc(tid * 16 + i * 8192, R, C); ao[h][i] = aoff(h * HALF + R) + C; }
#define G8_STAGE_A(P, h, kt) do { for (int _i = 0; _i < 2; ++_i) { const int _b = tid * 16 + _i * 8192; G8_GLDS(A + (size_t)ao[h][_i] + (size_t)(kt) * BK, (char*)(P) + _b); } } while (0)
#define G8_SA(b, h) (shm + ((b) * 2 + (h)) * HT)
#define G8_SB(b, h) (shm + (4 + (b) * 2 + (h)) * HT)
#define G8_STAGE(P, BASE, LD, br, kt) do { const bf16_t* _g = (BASE) + (size_t)(br) * (LD) + (size_t)(kt) * BK; \
    for (int _i = 0; _i < 2; ++_i) { const int _b = tid * 16 + _i * 8192; int _r, _c; stage_rc(_b, _r, _c); G8_GLDS(_g + (size_t)_r * (LD) + _c, (char*)(P) + _b); } } while (0)
#define G8_LDA(dst, b, h) for (int m = 0; m < 4; ++m) for (int k = 0; k < 2; ++k) dst[m][k] = *(const bf16x8*)((const char*)G8_SA(b, h) + lds_byte(wr * 64 + m * 16 + fr, k * 32 + fq * 8))
#define G8_LDB(dst, b, h) for (int n = 0; n < 2; ++n) for (int k = 0; k < 2; ++k) dst[n][k] = *(const bf16x8*)((const char*)G8_SB(b, h) + lds_byte(wc * 32 + n * 16 + fr, k * 32 + fq * 8))
#define G8_MMA(ai, bj, At_, Bt_) do { G8_PRIO(1); for (int m = 0; m < 4; ++m) for (int n = 0; n < 2; ++n) for (int k = 0; k < 2; ++k) \
    acc[ai][bj][m][n] = MFMA16(Bt_[n][k], At_[m][k], acc[ai][bj][m][n]); G8_PRIO(0); } while (0)
    bf16x8 At[4][2], B0[2][2], B1[2][2];
    const int nt = K / BK;
    G8_STAGE(G8_SB(0, 0), Bt, ldb, bcol, 0); G8_STAGE_A(G8_SA(0, 0), 0, 0);
    G8_STAGE(G8_SB(0, 1), Bt, ldb, bcol + HALF, 0); G8_STAGE_A(G8_SA(0, 1), 1, 0);
    if (wr == 1) G8_BAR;
    G8_WAIT_V(4); G8_BAR;
    G8_STAGE(G8_SB(1, 0), Bt, ldb, bcol, 1); G8_STAGE_A(G8_SA(1, 0), 0, 1); G8_STAGE(G8_SB(1, 1), Bt, ldb, bcol + HALF, 1);
    G8_WAIT_V(6); G8_BAR;
    for (int t = 0; t < nt - 2; t += 2) {
        G8_LDB(B0, 0, 0); G8_SCHED; G8_LDA(At, 0, 0); G8_STAGE_A(G8_SA(1, 1), 1, t + 1);
        G8_WAIT_L(8); G8_BAR; G8_WAIT_L(0); G8_MMA(0, 0, At, B0); G8_BAR; G8_SCHED;
        G8_LDB(B1, 0, 1); G8_STAGE(G8_SB(0, 0), Bt, ldb, bcol, t + 2);
        G8_BAR; G8_WAIT_L(0); G8_MMA(0, 1, At, B1); G8_BAR;
        G8_LDA(At, 0, 1); G8_STAGE_A(G8_SA(0, 0), 0, t + 2);
        G8_BAR; G8_WAIT_L(0); G8_MMA(1, 0, At, B0); G8_BAR; G8_SCHED;
        G8_STAGE(G8_SB(0, 1), Bt, ldb, bcol + HALF, t + 2);
        G8_WAIT_V(6); G8_BAR; G8_MMA(1, 1, At, B1); G8_BAR;
        G8_LDB(B0, 1, 0); G8_SCHED; G8_LDA(At, 1, 0); G8_STAGE_A(G8_SA(0, 1), 1, t + 2);
        G8_WAIT_L(8); G8_BAR; G8_WAIT_L(0); G8_MMA(0, 0, At, B0); G8_BAR; G8_SCHED;
        G8_LDB(B1, 1, 1); G8_STAGE(G8_SB(1, 0), Bt, ldb, bcol, t + 3);
        G8_BAR; G8_WAIT_L(0); G8_MMA(0, 1, At, B1); G8_BAR;
        G8_LDA(At, 1, 1); G8_STAGE_A(G8_SA(1, 0), 0, t + 3);
        G8_BAR; G8_WAIT_L(0); G8_MMA(1, 0, At, B0); G8_BAR; G8_SCHED;
        G8_STAGE(G8_SB(1, 1), Bt, ldb, bcol + HALF, t + 3);
        G8_WAIT_V(6); G8_BAR; G8_MMA(1, 1, At, B1); G8_BAR;
    }
    { G8_LDB(B0, 0, 0); G8_LDA(At, 0, 0); G8_STAGE_A(G8_SA(1, 1), 1, nt - 1);
      G8_BAR; G8_WAIT_L(0); G8_MMA(0, 0, At, B0); G8_BAR;
      G8_LDB(B1, 0, 1); G8_BAR; G8_WAIT_L(0); G8_MMA(0, 1, At, B1); G8_BAR;
      G8_LDA(At, 0, 1); G8_WAIT_V(4); G8_BAR; G8_WAIT_L(0); G8_MMA(1, 0, At, B0); G8_MMA(1, 1, At, B1); G8_BAR; }
    { G8_LDB(B0, 1, 0); G8_LDA(At, 1, 0); G8_WAIT_V(2); G8_BAR; G8_WAIT_L(0); G8_MMA(0, 0, At, B0); G8_BAR;
      G8_LDB(B1, 1, 1); G8_WAIT_V(0); G8_BAR; G8_WAIT_L(0); G8_MMA(0, 1, At, B1); G8_BAR;
      G8_LDA(At, 1, 1); G8_BAR; G8_WAIT_L(0); G8_MMA(1, 0, At, B0); G8_MMA(1, 1, At, B1); G8_BAR; }
    if (wr == 0) G8_BAR;
#undef G8_SA
#undef G8_SB
#undef G8_STAGE
#undef G8_STAGE_A
#undef G8_LDA
#undef G8_LDB
#undef G8_MMA
}
DI void kloop(Acc& acc, char* smem, const bf16_t* A, int lda, const bf16_t* Bt, int ldb, int K, int brow, int bcol) {
    kloop_g(acc, smem, A, [&](int r) { return (brow + r) * lda; }, Bt, ldb, K, bcol);
}
DI bool tile_order(int L, int nM, int nN, int& pm, int& pn) {
    constexpr int NXCD = 8, WGM = 8;
    const int nwg = nM * nN; if (L >= nwg) return false;
    int wgid = L; { const int q = nwg / NXCD, r = nwg % NXCD, xcd = wgid % NXCD, off = wgid / NXCD; wgid = (xcd < r ? xcd * (q + 1) : r * (q + 1) + (xcd - r) * q) + off; }
    const int nig = WGM * nN, gid = wgid / nig, fm = gid * WGM, gsz = (nM - fm) < WGM ? (nM - fm) : WGM;
    pm = fm + ((wgid % nig) % gsz); pn = (wgid % nig) / gsz; return true;
}
DI void acc_zero(Acc& acc) {
#pragma unroll
    for (int a = 0; a < 2; ++a)
#pragma unroll
        for (int b = 0; b < 2; ++b)
#pragma unroll
            for (int m = 0; m < 4; ++m)
#pragma unroll
                for (int n = 0; n < 2; ++n) acc[a][b][m][n] = (f32x4){0.f, 0.f, 0.f, 0.f};
}
template <class F> DI void for_each_quad(const Acc& acc, int brow, int bcol, F f) {
    const int tid = tid_x(), wid = tid >> 6, lane = tid & 63, wr = wid >> 2, wc = wid & 3, fr = lane & 15, fq = lane >> 4;
#pragma unroll
    for (int ai = 0; ai < 2; ++ai)
#pragma unroll
        for (int m = 0; m < 4; ++m)
#pragma unroll
            for (int bj = 0; bj < 2; ++bj)
#pragma unroll
                for (int n = 0; n < 2; ++n) f(brow + ai * HALF + wr * 64 + m * 16 + fr, bcol + bj * HALF + wc * 32 + n * 16 + fq * 4, acc[ai][bj][m][n]);
}
}

constexpr bool USE_G8 = ((NB * CTXL) % 256 == 0) && ((NB * S) % 256 == 0) && (NP % 256 == 0) && (D % 256 == 0) && (D >= 256);
DI int gu_row(int c, int up) {
    if (USE_G8) return (c >> 7) * 256 + ((c >> 6) & 1) * 128 + ((c >> 4) & 3) * 32 + (up ? 16 : 0) + (c & 15);
    return (c >> 6) * 128 + ((c >> 5) & 1) * 64 + ((c >> 4) & 1) * 16 + (c & 15) + (up ? 32 : 0);
}
DI void transpose_item(const float* W, int N, int Nvalid, int k0, int n0, bf16_t* WT, int ldt, int mode, float* scr, int lane) {
    float tv[32];
#pragma unroll
    for (int i = 0; i < 32; ++i) {
        const int kk = 2 * i + (lane >> 5), n = n0 + (lane & 31);
        tv[i] = (n < Nvalid) ? W[(size_t)(k0 + kk) * N + n] : 0.f;
    }
#pragma unroll
    for (int i = 0; i < 32; ++i) scr[(2 * i + (lane >> 5)) * 33 + (lane & 31)] = tv[i];
    WAVE_SYNC();
    const int c = lane & 7;
#pragma unroll
    for (int j = 0; j < 4; ++j) {
        const int nl = (lane >> 3) + 8 * j; const float* s = scr + (8 * c) * 33 + nl;
        u32x4 o; o.x = pk2(s[0], s[33]); o.y = pk2(s[2 * 33], s[3 * 33]); o.z = pk2(s[4 * 33], s[5 * 33]); o.w = pk2(s[6 * 33], s[7 * 33]);
        const int n = n0 + nl; const int row = mode == 0 ? n : gu_row(n, mode == 2);
        *(u32x4*)(WT + (size_t)row * ldt + k0 + 8 * c) = o;
    }
    WAVE_SYNC();
}
DI void transpose_matrix(const float* W, int K, int N, int Npad, bf16_t* WT, int mode, char* smem, int gw, int ngw, int& base) {
    const int lane = tid_x() & 63, wave = tid_x() >> 6;
    float* scr = (float*)smem + wave * (64 * 33);
    const int nkb = K / 64, nnb = Npad / 32, nitems = nkb * nnb;
    int first = ((gw - base) % ngw + ngw) % ngw;
    for (int it = first; it < nitems; it += ngw) {
        const int kb = it / nnb, nb = it % nnb;
        transpose_item(W, N, N, kb * 64, nb * 32, WT, K, mode, scr, lane);
    }
    base = (base + nitems) % ngw;
}

DI void phase0(const Params& p, char* smem) {
    const int tid = tid_x(), lane = tid & 63, wave = tid >> 6;
    if (blockIdx.x == 0 && tid < NEXP) ((int*)(p.ws + WS_CNT))[tid * CNT_STRIDE] = 0;
    if (blockIdx.x == 0 && tid < 2) ((int*)(p.ws + WS_CNT))[tid ? CNT_U2DONE : CNT_TICKET] = 0;
    if (blockIdx.x == 0 && tid == 0) *(unsigned*)(p.ws + WS_BAR) = 0u;
    float* sil = (float*)smem;
    float* red = sil + NV * D;
    const int nitems = 6 * D / 32;
    bool did = false;
    for (int it = blockIdx.x; it < nitems; it += gridDim.x) {
        if (!did) {
            for (int i = tid; i < NV * D; i += NTHREADS) { const int v = i / D, k = i % D; const float cv = v < NB ? p.in[I_C][v * D + k] : p.in[I_CCTX][k]; sil[i] = siluf_(cv); }
            did = true;
        }
        __syncthreads();
        const int col = it * 32 + (lane & 31), rp = lane >> 5;
        float acc[NV];
#pragma unroll
        for (int v = 0; v < NV; ++v) acc[v] = 0.f;
        const int r0 = wave * (D / 8);
        float wv[D / 16];
#pragma unroll
        for (int i = 0; i < D / 16; ++i) wv[i] = p.in[I_ADAW][(size_t)(r0 + 2 * i + rp) * (6 * D) + col];
#pragma unroll
        for (int i = 0; i < D / 16; ++i) {
            const int row = r0 + 2 * i + rp;
#pragma unroll
            for (int v = 0; v < NV; ++v) acc[v] += sil[v * D + row] * wv[i];
        }
#pragma unroll
        for (int v = 0; v < NV; ++v) red[((wave * 2 + rp) * NV + v) * 32 + (lane & 31)] = acc[v];
        __syncthreads();
        if (tid < NV * 32) {
            const int v = tid / 32, cl = tid % 32; float s = p.in[I_ADAB][it * 32 + cl];
            for (int g = 0; g < 16; ++g) s += red[(g * NV + v) * 32 + cl];
            ((float*)(p.ws + WS_MOD))[(size_t)v * 6 * D + it * 32 + cl] = s;
        }
    }
    __syncthreads();
    const int gw = blockIdx.x * 8 + wave, ngw = gridDim.x * 8; int base = 0;
    {
        float* scr = (float*)smem + wave * (64 * 33);
        const int nkb = D / 64, nnb = NP / 32, nitems2 = nkb * nnb;
        for (int it = gw; it < nitems2; it += ngw) { const int kb = it / nnb, nb = it % nnb; transpose_item(p.in[I_WIN], IN_COLS, IN_COLS, kb * 64, nb * 32, (bf16_t*)(p.aux + AUX_WINT), D, 0, scr, lane); }
        base = nitems2 % ngw;
    }
    { float* WRT = (float*)(p.ws + WS_WRT);
      for (int i = blockIdx.x * NTHREADS + tid; i < 36 * D; i += gridDim.x * NTHREADS) { const int j = i / D, k = i % D; WRT[i] = j < 4 ? p.in[I_RG][(size_t)k * 4 + j] : p.in[I_RE][(size_t)k * 32 + (j - 4)]; } }
    transpose_matrix(p.in[I_WOA], 512, D, D, (bf16_t*)(p.ws + WS_WOA), 0, smem, gw, ngw, base);
    transpose_matrix(p.in[I_WOB], 512, D, D, (bf16_t*)(p.ws + WS_WOB), 0, smem, gw, ngw, base);
    transpose_matrix(p.in[I_WOUT], D, D, D, (bf16_t*)(p.ws + WS_WOUT), 0, smem, gw, ngw, base);
    transpose_matrix(p.in[I_G2], 128, 512, 512, (bf16_t*)(p.ws + WS_G2T), 0, smem, gw, ngw, base);
}

constexpr int NSEG = T_ALL / 64, NSEG_CTX = T_CTX / 64;
DI void halo_store(const Params& p, int row, int col, const u32x2& o) {
    int seq, b, j;
    if (row < T_CTX) { seq = 0; b = row / CTXL; j = row % CTXL; } else { seq = 1; const int rr = row - T_CTX; b = rr / S; j = rr % S; }
    const int L = seq ? S : CTXL; const int segbase = seq ? NSEG_CTX + b * (S / 64) : b * (CTXL / 64);
    if (col < 1536) {
        const int jm = j & 63;
        if (jm >= 62 && j + 2 < L) { const int g = segbase + (j >> 6) + 1; *(u32x2*)((bf16_t*)(p.ws + WS_HALO_A) + ((size_t)g * 4 + (jm - 62)) * 1536 + col) = o; }
        if (jm < 2 && j >= 64) { const int g = segbase + (j >> 6) - 1; *(u32x2*)((bf16_t*)(p.ws + WS_HALO_A) + ((size_t)g * 4 + 2 + jm) * 1536 + col) = o; }
    } else if (col >= COL_B0 && col < COL_B0 + 1920) {
        const int js = seq ? (j % GW) * ROWS + j / GW : j; const int jm = js & 63;
        if (jm == 63 && js + 1 < L) { const int g = segbase + (js >> 6) + 1; *(u32x2*)((bf16_t*)(p.ws + WS_HALO_B) + ((size_t)g * 2 + 0) * 1920 + (col - COL_B0)) = o; }
        if (jm == 0 && js >= 64) { const int g = segbase + (js >> 6) - 1; *(u32x2*)((bf16_t*)(p.ws + WS_HALO_B) + ((size_t)g * 2 + 1) * 1920 + (col - COL_B0)) = o; }
    }
}
DI void halo_zero_fill(const Params& p) {
    const int tid = tid_x(), lane = tid & 63, wave = tid >> 6; const int gw = blockIdx.x * 8 + wave, ngw = gridDim.x * 8;
    bf16_t* HA = (bf16_t*)(p.ws + WS_HALO_A); bf16_t* HB = (bf16_t*)(p.ws + WS_HALO_B);
    for (int it = gw; it < NSEG * 2; it += ngw) {
        const int g = it >> 1, side = it & 1;
        const bool ctx = g < NSEG_CTX; const int sg = ctx ? g % (CTXL / 64) : (g - NSEG_CTX) % (S / 64); const int nsg = ctx ? CTXL / 64 : S / 64;
        const bool edge = side ? (sg == nsg - 1) : (sg == 0);
        if (!edge) continue;
        for (int c = lane; c < 384; c += 64) *(u32x4*)(HA + ((size_t)g * 4 + 2 * side) * 1536 + c * 8) = (u32x4){0u, 0u, 0u, 0u};
        for (int c = lane; c < 240; c += 64) *(u32x4*)(HB + ((size_t)g * 2 + side) * 1920 + c * 8) = (u32x4){0u, 0u, 0u, 0u};
    }
}
DI void phase1(const Params& p, char* smem) {
    if (USE_G8) halo_zero_fill(p);
    const int lane = tid_x() & 63, wave = tid_x() >> 6;
    const int gw = blockIdx.x * 8 + wave, ngw = gridDim.x * 8;
    const float* mod = (const float*)(p.ws + WS_MOD);
    bf16_t* U = (bf16_t*)(p.aux + AUX_U);
    auto rowsrc = [&](int r) -> const float* { return r < T_CTX ? p.in[I_CTX] + (size_t)r * D : p.in[I_X] + (size_t)(r - T_CTX) * D; };
    f32x4 xn[D / 256];
    if (gw < T_ALL) {
#pragma unroll
        for (int j = 0; j < D / 256; ++j) xn[j] = *(const f32x4*)(rowsrc(gw) + j * 256 + lane * 4);
    }
    for (int r = gw; r < T_ALL; r += ngw) {
        const int v = r < T_CTX ? NB : (r - T_CTX) / S;
        f32x4 x[D / 256]; float ss = 0.f;
#pragma unroll
        for (int j = 0; j < D / 256; ++j) { x[j] = xn[j]; ss += x[j].x * x[j].x + x[j].y * x[j].y + x[j].z * x[j].z + x[j].w * x[j].w; }
        if (r + ngw < T_ALL) {
#pragma unroll
            for (int j = 0; j < D / 256; ++j) xn[j] = *(const f32x4*)(rowsrc(r + ngw) + j * 256 + lane * 4);
        }
        ss = wave_sum_fast(ss);
        const float rstd = frsq(ss * (1.0f / D) + 1e-6f);
#pragma unroll
        for (int j = 0; j < D / 256; ++j) {
            const int k = j * 256 + lane * 4;
            const f32x4 g = *(const f32x4*)(p.in[I_NMIX] + k), sh = *(const f32x4*)(mod + (size_t)v * 6 * D + k), sc = *(const f32x4*)(mod + (size_t)v * 6 * D + D + k);
            float o0 = x[j].x * rstd * g.x * (1.f + sc.x) + sh.x, o1 = x[j].y * rstd * g.y * (1.f + sc.y) + sh.y;
            float o2 = x[j].z * rstd * g.z * (1.f + sc.z) + sh.z, o3 = x[j].w * rstd * g.w * (1.f + sc.w) + sh.w;
            u32x2 o; o.x = pk2(o0, o1); o.y = pk2(o2, o3);
            *(u32x2*)(U + (size_t)r * D + k) = o;
        }
    }
}

DI void phase2(const Params& p, char* smem) {
    const bf16_t* U = (const bf16_t*)(p.aux + AUX_U); const bf16_t* WT = (const bf16_t*)(p.aux + AUX_WINT);
    bf16_t* PL = (bf16_t*)(p.ws + WS_PLAT); bf16_t* PC = (bf16_t*)(p.ws + WS_PCTX); float* AB = (float*)(p.ws + WS_AB);
    if (USE_G8) {
        constexpr int NT = NP / 256, MT = T_ALL / 256, NT_CTX = (CTX_COLS + 255) / 256;
        for (int t = blockIdx.x; t < MT * NT; t += gridDim.x) {
            int mt, nt; if (!g8::tile_order(t, MT, NT, mt, nt)) break;
            const int brow = mt * 256, bcol = nt * 256; const bool isctx = brow < T_CTX;
            if (isctx && nt >= NT_CTX) continue;
            g8::Acc acc; g8::acc_zero(acc);
            g8::kloop(acc, smem, U, D, WT, D, D, brow, bcol);
            constexpr int OLD_ = 264; bf16_t* OT = (bf16_t*)smem;
            g8::for_each_quad(acc, brow, bcol, [&](int row, int col, const f32x4& v) {
                u32x2 o; o.x = pk2(v.x, v.y); o.y = pk2(v.z, v.w);
                *(u32x2*)(OT + (row - brow) * OLD_ + (col - bcol)) = o;
                if (col >= 2048 && col < 2064) *(f32x4*)(AB + (size_t)row * 16 + (col - 2048)) = v;
                halo_store(p, row, col, o);
            });
            __syncthreads();
            {
                const int tid = tid_x(); const int ncols = isctx ? CTX_COLS : IN_COLS;
                bf16_t* dst = isctx ? PC + (size_t)brow * CTX_COLS : PL + (size_t)(brow - T_CTX) * IN_COLS;
#pragma unroll
                for (int i = 0; i < 16; ++i) {
                    const int ch = tid + i * NTHREADS, row = ch >> 5, c8 = (ch & 31) * 8, col = bcol + c8;
                    if (col < ncols) *(u32x4*)(dst + (size_t)row * ncols + col) = *(const u32x4*)(OT + row * OLD_ + c8);
                }
            }
            __syncthreads();
        }
        return;
    }
    const int tid = tid_x(), lane = tid & 63, wave = tid >> 6, wr = wave >> 1, wc = wave & 1, fr = lane & 15, fq = lane >> 4;
    constexpr int NT = NP / 128, MT = T_ALL / BM, NT_CTX = (CTX_COLS + 127) / 128;
    for (int t = blockIdx.x; t < MT * NT; t += gridDim.x) {
        const int mt = t / NT, nt = t % NT; const int row0 = mt * BM; const bool isctx = row0 < T_CTX;
        if (isctx && nt >= NT_CTX) continue;
        f32x4 acc[MREP][4]; acc_zero(acc);
        gemm_kloop(acc, smem, [&](int i) { return U + (size_t)(row0 + i) * D; }, WT + (size_t)nt * 128 * D, D, D);
#pragma unroll
        for (int m = 0; m < MREP; ++m)
#pragma unroll
            for (int n = 0; n < 4; ++n)
#pragma unroll
                for (int j = 0; j < 4; ++j) {
                    const int row = row0 + wr * 16 * MREP + m * 16 + fq * 4 + j, col = nt * 128 + wc * 64 + n * 16 + fr; const float v = acc[m][n][j];
                    if (isctx) { if (col < CTX_COLS) PC[(size_t)row * CTX_COLS + col] = f2bf(v); }
                    else { if (col < IN_COLS) PL[(size_t)(row - T_CTX) * IN_COLS + col] = f2bf(v); }
                    if (col >= 2048 && col < 2064) AB[(size_t)row * 16 + (col - 2048)] = v;
                }
    }
}


DI int crow(int g, int h) { return (g & 3) + 8 * (g >> 2) + 4 * h; }
template <int S_> DI bf16x8 pack_acc(const f32x16& x) {
    u32x4 r;
    r.x = pk2(x[8 * S_ + 0], x[8 * S_ + 1]); r.y = pk2(x[8 * S_ + 2], x[8 * S_ + 3]); r.z = pk2(x[8 * S_ + 4], x[8 * S_ + 5]); r.w = pk2(x[8 * S_ + 6], x[8 * S_ + 7]);
    return __builtin_bit_cast(bf16x8, r);
}
DI bf16x8 ld_nat(const bf16_t* row, int s, int h) { return *(const bf16x8*)(row + 16 * s + 8 * h); }
DI bf16x8 ld_perm(const bf16_t* row, int s, int h) {
    const bf16x4 lo = *(const bf16x4*)(row + 16 * s + 4 * h), hi = *(const bf16x4*)(row + 16 * s + 8 + 4 * h);
    return __builtin_shufflevector(lo, hi, 0, 1, 2, 3, 4, 5, 6, 7);
}
DI f32x16 zero16() { f32x16 z;
#pragma unroll
    for (int i = 0; i < 16; ++i) z[i] = 0.f;
    return z; }
#define TGET(i) ((i) < 16 ? t0[(i) & 15] : t1[(i) & 15])
DI void invert32_col(const float* Lf, f32x16& t0, f32x16& t1, int c) {
#pragma unroll
    for (int i = 0; i < 32; ++i) {
        float s0 = 0.f, s1 = 0.f, s2 = 0.f, s3 = 0.f;
#pragma unroll
        for (int j4 = 0; j4 < (i + 3) / 4; ++j4) {
            const f32x4 l = *(const f32x4*)(Lf + i * 32 + 4 * j4);
            if (4 * j4 + 0 < i) s0 += l.x * TGET(4 * j4 + 0);
            if (4 * j4 + 1 < i) s1 += l.y * TGET(4 * j4 + 1);
            if (4 * j4 + 2 < i) s2 += l.z * TGET(4 * j4 + 2);
            if (4 * j4 + 3 < i) s3 += l.w * TGET(4 * j4 + 3);
        }
        float sm = -((s0 + s1) + (s2 + s3));
#ifndef EMU
        asm volatile("" : "+v"(sm));
#endif
        const float v = (i > c) ? sm : (i == c ? 1.f : 0.f);
        if (i < 16) t0[i & 15] = v; else t1[i & 15] = v;
    }
}

DI void seg_info(int g, int& seq, int& b, int& j0) {
    if (g < NSEG_CTX) { seq = 0; b = g / (CTXL / 64); j0 = (g % (CTXL / 64)) * 64; } else { const int g2 = g - NSEG_CTX; seq = 1; b = g2 / (S / 64); j0 = (g2 % (S / 64)) * 64; }
}
DI const bf16_t* seq_row(const Params& p, int seq, int b, int j, bool scan_order) {
    if (seq) { const int l = scan_order ? (j % ROWS) * GW + j / ROWS : j; return (const bf16_t*)(p.ws + WS_PLAT) + (size_t)(b * S + l) * IN_COLS; }
    return (const bf16_t*)(p.ws + WS_PCTX) + (size_t)(b * CTXL + j) * CTX_COLS;
}
DI void phase_halo(const Params& p, char* smem) {
    if (USE_G8) return;
    const int tid = tid_x(), lane = tid & 63, wave = tid >> 6;
    const int gw = blockIdx.x * 8 + wave, ngw = gridDim.x * 8;
    bf16_t* HA = (bf16_t*)(p.ws + WS_HALO_A); bf16_t* HB = (bf16_t*)(p.ws + WS_HALO_B);
    for (int it = gw; it < NSEG * 6; it += ngw) {
        const int g = it / 6, hr = it % 6; int seq, b, j0; seg_info(g, seq, b, j0);
        const int L = seq ? S : CTXL;
        if (hr < 4) {
            const int j = hr < 2 ? j0 - 2 + hr : j0 + 62 + hr; const bool ok = j >= 0 && j < L;
            const bf16_t* src = seq_row(p, seq, b, ok ? j : 0, false);
            for (int c = lane; c < 192; c += 64) { u32x4 v = {0u, 0u, 0u, 0u}; if (ok) v = *(const u32x4*)(src + c * 8); *(u32x4*)(HA + ((size_t)g * 4 + hr) * 1536 + c * 8) = v; }
        } else {
            const int j = hr == 4 ? j0 - 1 : j0 + 64; const bool ok = j >= 0 && j < L;
            const bf16_t* src = seq_row(p, seq, b, ok ? j : 0, true) + COL_B0;
            for (int c = lane; c < 240; c += 64) { u32x4 v = {0u, 0u, 0u, 0u}; if (ok) v = *(const u32x4*)(src + c * 8); *(u32x4*)(HB + ((size_t)g * 2 + (hr - 4)) * 1920 + c * 8) = v; }
        }
    }
}
DI f32x2_ac unpk2(unsigned w) { return (f32x2_ac){bf2f((bf16_t)(w & 0xffffu)), bf2f((bf16_t)(w >> 16))}; }
DI void unpack8(const u32x4& q, float (&f)[8]) {
    f[0] = bf2f((bf16_t)(q.x & 0xffffu)); f[1] = bf2f((bf16_t)(q.x >> 16)); f[2] = bf2f((bf16_t)(q.y & 0xffffu)); f[3] = bf2f((bf16_t)(q.y >> 16));
    f[4] = bf2f((bf16_t)(q.z & 0xffffu)); f[5] = bf2f((bf16_t)(q.z >> 16)); f[6] = bf2f((bf16_t)(q.w & 0xffffu)); f[7] = bf2f((bf16_t)(q.w >> 16));
}
DI float row16_sum(float v) {
#ifdef EMU
    v += __shfl_xor(v, 1); v += __shfl_xor(v, 2); v += __shfl_xor(v, 4); v += __shfl_xor(v, 8); return v;
#else
    v = DPP_ADD(v, 0xB1); v = DPP_ADD(v, 0x4E); v = DPP_ADD(v, 0x141); v = DPP_ADD(v, 0x140); return v;
#endif
}
DI void phase_fir(const Params& p, char* smem) {
    const int tid = tid_x(), lane = tid & 63, wave = tid >> 6;
    const int gw = blockIdx.x * 8 + wave, ngw = gridDim.x * 8;
    const bf16_t* HA = (const bf16_t*)(p.ws + WS_HALO_A); const bf16_t* HB = (const bf16_t*)(p.ws + WS_HALO_B);
    constexpr int NA = NSEG * 3, NBI = NSEG * 4;
    const u32x4 z4 = {0u, 0u, 0u, 0u};
    for (int it = gw; it < NA + NBI; it += ngw) {
        if (it < NA) {
            const int g = it / 3, s = it % 3; int seq, b, j0; seg_info(g, seq, b, j0);
            const int col = s * 512 + 8 * lane, ldp = seq ? IN_COLS : CTX_COLS;
            bf16_t* base = (bf16_t*)seq_row(p, seq, b, j0, false) + col;
            const bf16_t* hal = HA + (size_t)g * 4 * 1536 + col;
            float cw[5][8];
#pragma unroll
            for (int t = 0; t < 5; ++t) { const f32x4 w0 = *(const f32x4*)(p.in[I_CONV] + t * 1536 + col), w1 = *(const f32x4*)(p.in[I_CONV] + t * 1536 + col + 4);
                cw[t][0] = w0.x; cw[t][1] = w0.y; cw[t][2] = w0.z; cw[t][3] = w0.w; cw[t][4] = w1.x; cw[t][5] = w1.y; cw[t][6] = w1.z; cw[t][7] = w1.w; }
            u32x4 win[12], nxt[8];
            win[0] = *(const u32x4*)(hal); win[1] = *(const u32x4*)(hal + 1536);
            win[2] = *(const u32x4*)(base); win[3] = *(const u32x4*)(base + ldp);
#pragma unroll
            for (int i = 0; i < 8; ++i) win[4 + i] = *(const u32x4*)(base + (size_t)(2 + i) * ldp);
#pragma unroll 1
            for (int blk = 0; blk < 8; ++blk) {
                if (blk < 7) {
#pragma unroll
                    for (int i = 0; i < 8; ++i) { const int t = 8 * blk + 10 + i; nxt[i] = t < 64 ? *(const u32x4*)(base + (size_t)t * ldp) : *(const u32x4*)(hal + (size_t)(2 + (t - 64)) * 1536); }
                }
#pragma unroll
                for (int i = 0; i < 8; ++i) {
                    float a[8];
#pragma unroll
                    for (int e = 0; e < 8; ++e) a[e] = 0.f;
#pragma unroll
                    for (int t = 0; t < 5; ++t) { float x[8]; unpack8(win[i + t], x);
#pragma unroll
                        for (int e = 0; e < 8; ++e) a[e] += x[e] * cw[t][e]; }
                    float ss = 0.f;
#pragma unroll
                    for (int e = 0; e < 8; ++e) { a[e] = fsilu(a[e]); ss += a[e] * a[e]; }
                    if (s < 2) { const float sc = frsq(row16_sum(ss) + 1e-6f) * (s == 0 ? 0.08838834764831845f : 1.0f);
#pragma unroll
                        for (int e = 0; e < 8; ++e) a[e] *= sc; }
                    u32x4 o; o.x = pk2(a[0], a[1]); o.y = pk2(a[2], a[3]); o.z = pk2(a[4], a[5]); o.w = pk2(a[6], a[7]);
                    *(u32x4*)(base + (size_t)(8 * blk + i) * ldp) = o;
                }
#pragma unroll
                for (int i = 0; i < 4; ++i) win[i] = win[8 + i];
#pragma unroll
                for (int i = 0; i < 8; ++i) win[4 + i] = nxt[i];
            }
        } else {
            const int it2 = it - NA, g = it2 / 4, sl = it2 % 4; int seq, b, j0; seg_info(g, seq, b, j0);
            const int bcol = sl * 512 + 8 * lane; const bool act = bcol < 1920;
            const int bc = act ? bcol : 0, col = COL_B0 + bc;
            float mu8[8];
            { const f32x4 m0 = *(const f32x4*)(p.in[I_MU] + bc), m1 = *(const f32x4*)(p.in[I_MU] + bc + 4); mu8[0] = m0.x; mu8[1] = m0.y; mu8[2] = m0.z; mu8[3] = m0.w; mu8[4] = m1.x; mu8[5] = m1.y; mu8[6] = m1.z; mu8[7] = m1.w; }
            const bool th = (bc >= 1536 && bc < 1664);
            const bf16_t* hal = HB + (size_t)g * 2 * 1920 + bc;
            u32x4 win[10], nxt[8];
            win[0] = *(const u32x4*)(hal); win[1] = *(const u32x4*)(seq_row(p, seq, b, j0, true) + col);
#pragma unroll
            for (int i = 0; i < 8; ++i) win[2 + i] = *(const u32x4*)(seq_row(p, seq, b, j0 + 1 + i, true) + col);
#pragma unroll 1
            for (int blk = 0; blk < 8; ++blk) {
                if (blk < 7) {
#pragma unroll
                    for (int i = 0; i < 8; ++i) { const int t = 8 * blk + 9 + i; nxt[i] = t < 64 ? *(const u32x4*)(seq_row(p, seq, b, j0 + t, true) + col) : *(const u32x4*)(hal + 1920); }
                }
#pragma unroll
                for (int i = 0; i < 8; ++i) {
                    float pv[8], cu[8], nx[8], x[8]; unpack8(win[i], pv); unpack8(win[i + 1], cu); unpack8(win[i + 2], nx);
#pragma unroll
                    for (int e = 0; e < 8; ++e) { x[e] = cu[e] + (0.5f * (pv[e] + nx[e]) - cu[e]) * mu8[e]; if (th) x[e] = ftanh(x[e]); }
                    u32x4 o; o.x = pk2(x[0], x[1]); o.y = pk2(x[2], x[3]); o.z = pk2(x[4], x[5]); o.w = pk2(x[6], x[7]);
                    if (act) *(u32x4*)((bf16_t*)seq_row(p, seq, b, j0 + 8 * blk + i, true) + col) = o;
                }
                win[0] = win[8]; win[1] = win[9];
#pragma unroll
                for (int i = 0; i < 8; ++i) win[2 + i] = nxt[i];
            }
        }
    }
}

constexpr int GC = 32;
constexpr int G_NT = (CTXL + S) / GC;
constexpr int LD128 = 136, LD64 = 72, LD32 = 40;
DI void chunk_pos(int x, int d, int& seg, int& j0) {
    constexpr int n0 = CTXL / GC, n1 = S / GC;
    if (x < n0) { seg = 0; j0 = (d ? n0 - 1 - x : x) * GC; } else { seg = 1; const int xx = x - n0; j0 = (d ? n1 - 1 - xx : xx) * GC; }
}

template <class Emit>
DI void invert32_blocked(const float* Lf, bf16_t* scr, int lane, Emit emit) {
    bf16_t* T00T = scr; bf16_t* T11R = scr + 16 * LD32; bf16_t* L10R = scr + 2 * 16 * LD32; bf16_t* P1T = scr + 3 * 16 * LD32;
    const int blk = lane >> 5, c = lane & 15, r = lane & 31, fr = lane & 15, fq = lane >> 4;
    f32x16 t;
    const float* Lb = Lf + (16 * blk) * 32 + 16 * blk;
#pragma unroll
    for (int i = 0; i < 16; ++i) {
        float s0 = 0.f, s1 = 0.f, s2 = 0.f, s3 = 0.f;
#pragma unroll
        for (int j4 = 0; j4 < (i + 3) / 4; ++j4) {
            const f32x4 l = *(const f32x4*)(Lb + i * 32 + 4 * j4);
            if (4 * j4 + 0 < i) s0 += l.x * t[4 * j4 + 0];
            if (4 * j4 + 1 < i) s1 += l.y * t[4 * j4 + 1];
            if (4 * j4 + 2 < i) s2 += l.z * t[4 * j4 + 2];
            if (4 * j4 + 3 < i) s3 += l.w * t[4 * j4 + 3];
        }
        float sm = -((s0 + s1) + (s2 + s3));
#ifndef EMU
        asm volatile("" : "+v"(sm));
#endif
        t[i] = (i > c) ? sm : (i == c ? 1.f : 0.f);
    }
    if (r < 16) {
        if (blk == 0) {
#pragma unroll
            for (int q = 0; q < 4; ++q) { u32x2 o; o.x = pk2(t[4 * q], t[4 * q + 1]); o.y = pk2(t[4 * q + 2], t[4 * q + 3]); *(u32x2*)(T00T + c * LD32 + 4 * q) = o; }
        } else {
#pragma unroll
            for (int i = 0; i < 16; ++i) T11R[i * LD32 + c] = f2bf(t[i]);
        }
    }
    { const int i = lane >> 2, j4 = (lane & 3) * 4; const f32x4 l = *(const f32x4*)(Lf + (16 + i) * 32 + j4);
      u32x2 o; o.x = pk2(l.x, l.y); o.y = pk2(l.z, l.w); *(u32x2*)(L10R + i * LD32 + j4) = o; }
    WAVE_SYNC();
    const bf16x8 zf = {0, 0, 0, 0, 0, 0, 0, 0};
    f32x4 p1 = {0.f, 0.f, 0.f, 0.f};
    {
        const bf16x8 af = fq < 2 ? *(const bf16x8*)(L10R + fr * LD32 + 8 * fq) : zf, bfm = fq < 2 ? *(const bf16x8*)(T00T + fr * LD32 + 8 * fq) : zf;
        p1 = MFMA16(af, bfm, p1);
    }
    { u32x2 o; o.x = pk2(p1[0], p1[1]); o.y = pk2(p1[2], p1[3]); *(u32x2*)(P1T + fr * LD32 + 4 * fq) = o; }
    WAVE_SYNC();
    f32x4 p2 = {0.f, 0.f, 0.f, 0.f};
    {
        const bf16x8 af = fq < 2 ? *(const bf16x8*)(T11R + fr * LD32 + 8 * fq) : zf, bfm = fq < 2 ? *(const bf16x8*)(P1T + fr * LD32 + 8 * fq) : zf;
        p2 = MFMA16(af, bfm, p2);
    }
#pragma unroll
    for (int j = 0; j < 4; ++j) emit(16 + 4 * fq + j, fr, -p2[j]);
    if (r < 16) {
#pragma unroll
        for (int i = 0; i < 16; ++i) { emit(16 * blk + i, 16 * blk + c, t[i]); if (blk == 0) emit(i, 16 + c, 0.f); }
    }
}
DI float half_sum(float v, int hh) {
#ifdef EMU
    v += __shfl_xor(v, 1); v += __shfl_xor(v, 2); v += __shfl_xor(v, 4); v += __shfl_xor(v, 8); v += __shfl_xor(v, 16); return v;
#else
    v = DPP_ADD(v, 0xB1); v = DPP_ADD(v, 0x4E); v = DPP_ADD(v, 0x141); v = DPP_ADD(v, 0x140);
    const int iv = __builtin_bit_cast(int, v);
    const float s0 = __builtin_bit_cast(float, __builtin_amdgcn_readlane(iv, 0)) + __builtin_bit_cast(float, __builtin_amdgcn_readlane(iv, 16));
    const float s1 = __builtin_bit_cast(float, __builtin_amdgcn_readlane(iv, 32)) + __builtin_bit_cast(float, __builtin_amdgcn_readlane(iv, 48));
    return hh ? s1 : s0;
#endif
}
constexpr int GL_Q = 0;
constexpr int GL_KT = GL_Q + 3 * 32 * LD128 * 2;
constexpr int GL_VT = GL_KT + 3 * 128 * LD32 * 2;
constexpr int GL_K = GL_VT + 3 * 128 * LD32 * 2;
constexpr int GL_QKM = GL_K + 32 * LD128 * 2;
constexpr int GL_LF = GL_QKM + 2 * 32 * LD32 * 2;
constexpr int GL_TP = GL_LF + 32 * 32 * 4;
constexpr int GL_TPP = GL_TP + 32 * LD32 * 2;
constexpr int GL_WN = GL_TPP + 2 * 32 * LD32 * 2;
constexpr int GL_SC = GL_WN + 32 * LD128 * 2;
constexpr int GL_GC = GL_SC + 2 * 8 * 32 * 4;
constexpr int GL_INV = GL_GC + 8 * 32 * 4;
constexpr int GL_RAW = GL_INV + 4 * 16 * LD32 * 2;
constexpr int GL_END = GL_RAW + 32 * 384 * 2;
static_assert(GL_END <= LDS_BYTES, "gdn lds");

DI void gdn_chain2(const Params& p, char* smem, int item) {
    const int d = item / (NB * H_A), b = (item / H_A) % NB, h = item % H_A;
    const int tid = tid_x(), lane = tid & 63, wave0_ = tid >> 6;
    bf16_t* Qs = (bf16_t*)(smem + GL_Q); bf16_t* KTs = (bf16_t*)(smem + GL_KT); bf16_t* VTs = (bf16_t*)(smem + GL_VT); bf16_t* Ks = (bf16_t*)(smem + GL_K);
    bf16_t* QKMs = (bf16_t*)(smem + GL_QKM); float* Lf = (float*)(smem + GL_LF); bf16_t* Tp = (bf16_t*)(smem + GL_TP); bf16_t* Tpp = (bf16_t*)(smem + GL_TPP);
    bf16_t* Wn = (bf16_t*)(smem + GL_WN); float* SC = (float*)(smem + GL_SC); float* GCs = (float*)(smem + GL_GC);
    const float alog = p.in[I_ALOG][d * 4 + h], dtb = p.in[I_DTB][d * 4 + h], negea = -expf(alog);
    bf16_t* ODIR = (bf16_t*)(p.ws + WS_OA);
    __syncthreads();
    f32x16 St[4];
#pragma unroll
    for (int ct = 0; ct < 4; ++ct) St[ct] = zero16();
    bf16_t* RAW = (bf16_t*)(smem + GL_RAW);
    float pa = 0.f, pbt = 0.f;
    auto prefetch = [&](int x, int inst0, int ninst) {
        int seg, j0; chunk_pos(x, d, seg, j0);
        const int ldp = seg ? IN_COLS : CTX_COLS;
        const bf16_t* pbase = seg ? (const bf16_t*)(p.ws + WS_PLAT) + (size_t)b * S * IN_COLS : (const bf16_t*)(p.ws + WS_PCTX) + (size_t)b * CTXL * CTX_COLS;
        for (int inst = inst0; inst < inst0 + ninst; ++inst) {
            const int q = inst * 64 + lane, row = q / 48, c16 = q % 48;
            const bf16_t* src = pbase + (size_t)(j0 + row) * ldp + (c16 >> 4) * 512 + h * 128 + (c16 & 15) * 8;
#ifdef EMU
            emu_global_load_lds16(src, (char*)RAW + q * 16);
#else
            __builtin_amdgcn_global_load_lds((const unsigned*)src, (__attribute__((address_space(3))) unsigned*)((char*)RAW + q * 16), 16, 0, 0);
#endif
        }
    };
    auto prefetch_ab = [&](int x, int g0, int ng) {
        int seg, j0; chunk_pos(x, d, seg, j0);
        const float* abbase = (const float*)(p.ws + WS_AB) + (size_t)(seg ? T_CTX + b * S : b * CTXL) * 16;
        if (lane < 4 * ng) { const int j = j0 + 4 * g0 + lane; pa = abbase[(size_t)j * 16 + d * 4 + h]; pbt = abbase[(size_t)j * 16 + 8 + d * 4 + h]; }
    };
    auto x1 = [&](int c, int g0, int ng) {
        const int q3 = c % 3, parc = c & 1;
        for (int gi = 0; gi < ng; ++gi) {
            const int g = g0 + gi;
            const int i0 = d ? (GC - 4 - 4 * g) : 4 * g;
            const char* rawg = (const char*)RAW + (4 * g + (d ? 3 : 0)) * 768 + 4 * lane; const int rstep = d ? -768 : 768;
            unsigned wq[4], wk[4], wv[4];
#pragma unroll
            for (int e = 0; e < 4; ++e) { const char* rr = rawg + e * rstep; wq[e] = *(const unsigned*)rr; wk[e] = *(const unsigned*)(rr + 256); wv[e] = *(const unsigned*)(rr + 512); }
            char* qrow = (char*)Qs + ((q3 * 32 + i0) * LD128 + 2 * lane) * 2; char* krow = (char*)Ks + (i0 * LD128 + 2 * lane) * 2;
#pragma unroll
            for (int e = 0; e < 4; ++e) { *(unsigned*)(qrow + e * LD128 * 2) = wq[e]; *(unsigned*)(krow + e * LD128 * 2) = wk[e]; }
            char* ktrow = (char*)KTs + ((q3 * 128 + 2 * lane) * LD32 + i0) * 2; char* vtrow = (char*)VTs + ((q3 * 128 + 2 * lane) * LD32 + i0) * 2;
            { u32x2 o; o.x = (wk[0] & 0xffffu) | (wk[1] << 16); o.y = (wk[2] & 0xffffu) | (wk[3] << 16); *(u32x2*)ktrow = o;
              u32x2 o1; o1.x = (wk[0] >> 16) | (wk[1] & 0xffff0000u); o1.y = (wk[2] >> 16) | (wk[3] & 0xffff0000u); *(u32x2*)(ktrow + LD32 * 2) = o1; }
            { u32x2 o; o.x = (wv[0] & 0xffffu) | (wv[1] << 16); o.y = (wv[2] & 0xffffu) | (wv[3] << 16); *(u32x2*)vtrow = o;
              u32x2 o1; o1.x = (wv[0] >> 16) | (wv[1] & 0xffff0000u); o1.y = (wv[2] >> 16) | (wv[3] & 0xffff0000u); *(u32x2*)(vtrow + LD32 * 2) = o1; }
        }
        if (lane < 4 * ng) { const int jo = 4 * g0 + lane; const int i = d ? (GC - 1 - jo) : jo;
            SC[(parc * 8 + 0) * 32 + i] = negea * fsoftplus(pa + dtb); SC[(parc * 8 + 1) * 32 + i] = fsigmoid(pbt); }
    };
    prefetch(0, 3 * wave0_, 3); prefetch_ab(0, wave0_, 1);
#ifndef EMU
    asm volatile("s_waitcnt vmcnt(0)" ::: "memory");
#endif
    const int r0_ = lane & 31, hh0_ = lane >> 5;
    __syncthreads();
    x1(0, wave0_, 1);
    LDS_BARRIER();
    if (wave0_ >= 4 && wave0_ < 7 && 1 < G_NT) { prefetch(1, 9 * (wave0_ - 4), wave0_ == 6 ? 6 : 9); prefetch_ab(1, 3 * (wave0_ - 4), wave0_ == 6 ? 2 : 3); }
    for (int it = -1; it < G_NT; ++it) {
        int r = r0_, hh = hh0_, wave = wave0_;
#ifndef EMU
        asm volatile("" : "+v"(r), "+v"(hh), "+v"(wave));
#endif
        const int xn = it + 1, par = xn & 1, q3 = xn % 3;
        const int g0w = 3 * (wave - 4), ngw = wave == 6 ? 2 : 3;
        if (xn < G_NT) {
            const float* graw = SC + (par * 8 + 0) * 32;
            float gcv = 0.f;
#pragma unroll
            for (int s4 = 0; s4 < 8; ++s4) { const f32x4 g4 = *(const f32x4*)(graw + 4 * s4);
                gcv += (4 * s4 + 0 <= r ? g4.x : 0.f) + (4 * s4 + 1 <= r ? g4.y : 0.f) + (4 * s4 + 2 <= r ? g4.z : 0.f) + (4 * s4 + 3 <= r ? g4.w : 0.f); }
            if (lane < 32) GCs[wave * 32 + r] = gcv;
            if (wave == 7 && lane < 32) {
                float gl = 0.f;
#pragma unroll
                for (int s4 = 0; s4 < 8; ++s4) { const f32x4 g4 = *(const f32x4*)(graw + 4 * s4); gl += (g4.x + g4.y) + (g4.z + g4.w); }
                const float be = SC[(par * 8 + 1) * 32 + r];
                SC[(par * 8 + 3) * 32 + r] = fexp(gcv); SC[(par * 8 + 4) * 32 + r] = fexp(gl - gcv); SC[(par * 8 + 5) * 32 + r] = be * fexp(gcv); SC[(par * 8 + 6) * 32 + r] = fexp(gl);
            }
            const int pr = wave >> 2, th = (wave >> 1) & 1, ch = wave & 1, fr = lane & 15, fq = lane >> 4;
            const bf16_t* arow = (pr == 0 ? Ks : Qs + q3 * 32 * LD128) + (16 * th + fr) * LD128 + 8 * fq; const bf16_t* brow = Ks + (16 * ch + fr) * LD128 + 8 * fq;
            f32x4 cc = {0.f, 0.f, 0.f, 0.f};
#pragma unroll
            for (int ks = 0; ks < 4; ++ks) cc = MFMA16(*(const bf16x8*)(arow + 32 * ks), *(const bf16x8*)(brow + 32 * ks), cc);
            WAVE_SYNC();
            const int jj = 16 * ch + fr; const float gj = GCs[wave * 32 + jj];
#pragma unroll
            for (int j = 0; j < 4; ++j) {
                const int i = 16 * th + 4 * fq + j; const float dec = fexp(GCs[wave * 32 + i] - gj);
                if (pr == 0) Lf[i * 32 + jj] = (jj < i) ? SC[(par * 8 + 1) * 32 + i] * cc[j] * dec : 0.f;
                else QKMs[(par * 32 + i) * LD32 + jj] = f2bf((jj <= i) ? cc[j] * dec : 0.f);
            }
        }
#ifndef EMU
        asm volatile("s_waitcnt vmcnt(0)" ::: "memory");
#endif
        LDS_BARRIER();
        if (wave == 7 && xn < G_NT) {
            const float* sb1 = SC + (par * 8 + 5) * 32; const float* sb0 = SC + (par * 8 + 1) * 32; bf16_t* Tppw = Tpp + par * 32 * LD32;
            invert32_blocked(Lf, (bf16_t*)(smem + GL_INV), lane, [&](int i, int c, float v) { Tp[i * LD32 + c] = f2bf(v * sb1[c]); Tppw[i * LD32 + c] = f2bf(v * sb0[c]); });
        }
        if (wave >= 4 && wave < 7 && xn + 1 < G_NT) {
            x1(xn + 1, g0w, ngw);
            if (xn + 2 < G_NT) {
                WAVE_SYNC();
                prefetch(xn + 2, 9 * (wave - 4), wave == 6 ? 6 : 9); prefetch_ab(xn + 2, g0w, ngw);
            }
        }
        if (wave < 4 && it >= 0) {
            const int pc = it & 1, qc = it % 3; int seg = 0, j0 = 0; chunk_pos(it, d, seg, j0);
            const bf16_t* Qc = Qs + qc * 32 * LD128; const bf16_t* KTc = KTs + qc * 128 * LD32; const bf16_t* VTc = VTs + qc * 128 * LD32;
            const bf16_t* QKc = QKMs + pc * 32 * LD32; const bf16_t* Tc = Tpp + pc * 32 * LD32; const float* sc = SC + pc * 8 * 32;
            f32x16 vn = zero16();
#pragma unroll
            for (int s = 0; s < 2; ++s) vn = MFMA32(ld_nat(Tc + r * LD32, s, hh), ld_nat(VTc + (32 * wave + r) * LD32, s, hh), vn);
            f32x16 oacc = zero16();
#define GDN_KSTEP(s) { const bf16x8 sb = pack_acc<(s) & 1>(St[(s) >> 1]); vn = MFMA32(ld_perm(Wn + r * LD128, (s), hh), sb, vn); oacc = MFMA32(ld_perm(Qc + r * LD128, (s), hh), sb, oacc); }
            GDN_KSTEP(0) GDN_KSTEP(1) GDN_KSTEP(2) GDN_KSTEP(3) GDN_KSTEP(4) GDN_KSTEP(5) GDN_KSTEP(6) GDN_KSTEP(7)
#undef GDN_KSTEP
#pragma unroll
            for (int g = 0; g < 16; ++g) oacc[g] *= sc[3 * 32 + crow(g, hh)];
            { const bf16x8 v0 = pack_acc<0>(vn), v1 = pack_acc<1>(vn);
              oacc = MFMA32(ld_perm(QKc + r * LD32, 0, hh), v0, oacc); oacc = MFMA32(ld_perm(QKc + r * LD32, 1, hh), v1, oacc); }
#pragma unroll
            for (int g = 0; g < 16; ++g) vn[g] *= sc[4 * 32 + crow(g, hh)];
            const float ge = sc[6 * 32];
            { const bf16x8 v0 = pack_acc<0>(vn), v1 = pack_acc<1>(vn);
#pragma unroll
              for (int ct = 0; ct < 4; ++ct) {
#pragma unroll
                  for (int g = 0; g < 16; ++g) St[ct][g] *= ge;
                  St[ct] = MFMA32(ld_perm(KTc + (32 * ct + r) * LD32, 0, hh), v0, St[ct]);
                  St[ct] = MFMA32(ld_perm(KTc + (32 * ct + r) * LD32, 1, hh), v1, St[ct]);
              } }
            if (seg) {
#pragma unroll
                for (int g = 0; g < 16; ++g) {
                    const int i = crow(g, hh), j = d ? j0 + GC - 1 - i : j0 + i;
                    ODIR[((size_t)d * T_LAT + (size_t)b * S + j) * 512 + h * 128 + 32 * wave + r] = f2bf(oacc[g]);
                }
            }
        }
        LDS_BARRIER();
        if (xn < G_NT && wave < 4) {
            f32x16 acc = zero16();
#pragma unroll
            for (int s = 0; s < 2; ++s) acc = MFMA32(ld_nat(KTs + (q3 * 128 + 32 * wave + r) * LD32, s, hh), ld_nat(Tp + r * LD32, s, hh), acc);
#pragma unroll
            for (int q = 0; q < 4; ++q) {
                u32x2 o; o.x = pk2(-acc[4 * q], -acc[4 * q + 1]); o.y = pk2(-acc[4 * q + 2], -acc[4 * q + 3]);
                *(u32x2*)(Wn + r * LD128 + 32 * wave + 8 * q + 4 * hh) = o;
            }
        }
        LDS_BARRIER();
    }
}

constexpr int RL_RX = 0;
constexpr int RL_KX = RL_RX + 32 * 64 * 2;
constexpr int RL_VX = RL_KX + 32 * 64 * 2;
constexpr int RL_KK = RL_VX + 32 * 64 * 2;
constexpr int RL_LW = RL_KK + 32 * 64 * 4;
constexpr int RL_IC = RL_LW + 32 * 64 * 4;
constexpr int RL_PC = RL_IC + 32 * 64 * 4;
constexpr int RL_CST = RL_PC + 2 * 64 * 4;
constexpr int RL_TW = RL_CST + 4 * 64 * 4;
constexpr int RL_AL = RL_TW + 32 * LD64 * 2;
constexpr int RL_LF = RL_AL + 32 * LD64 * 2;
constexpr int RL_LAKT = RL_LF + 32 * 32 * 4;
constexpr int RL_TB = RL_LAKT + 32 * LD32 * 2;
constexpr int RL_W2T = RL_TB + 32 * LD32 * 2;
constexpr int RL_A2T = RL_W2T + 64 * LD64 * 2;
constexpr int RL_AR = RL_A2T + 64 * LD64 * 2;
constexpr int RL_BR = RL_AR + 32 * LD64 * 2;
constexpr int RL_KR = RL_BR + 32 * LD64 * 2;
constexpr int RL_RR = RL_KR + 32 * LD64 * 2;
constexpr int RL_AT = RL_RR + 2 * 32 * LD64 * 2;
constexpr int RL_BHT = RL_AT + 64 * LD32 * 2;
constexpr int RL_KHT = RL_BHT + 2 * 64 * LD32 * 2;
constexpr int RL_VT = RL_KHT + 2 * 64 * LD32 * 2;
constexpr int RL_MRB = RL_VT + 2 * 64 * LD32 * 2;
constexpr int RL_MRK = RL_MRB + 2 * 32 * LD32 * 2;
constexpr int RL_WM = RL_MRK + 2 * 32 * LD32 * 2;
constexpr int RL_TL = RL_WM + 32 * LD64 * 2;
constexpr int RL_END = RL_TL + 32 * LD32 * 2;
static_assert(RL_END <= LDS_BYTES, "rwkv lds");
static_assert(4 * 16 * LD32 * 2 <= 2 * 32 * LD64 * 2, "inversion scratch over AR/BR");

DI void rwkv_chain2(const Params& p, char* smem, int item) {
    const int d = item / (NB * H_B), b = (item / H_B) % NB, h = item % H_B;
    const int tid = tid_x(), lane = tid & 63, wave = tid >> 6;
    bf16_t* RX = (bf16_t*)(smem + RL_RX); bf16_t* KX = (bf16_t*)(smem + RL_KX); bf16_t* VX = (bf16_t*)(smem + RL_VX); float* KKs = (float*)(smem + RL_KK);
    float* LW = (float*)(smem + RL_LW); float* IC = (float*)(smem + RL_IC); float* Lf = (float*)(smem + RL_LF); float* PC = (float*)(smem + RL_PC); float* CST = (float*)(smem + RL_CST);
    bf16_t* TW = (bf16_t*)(smem + RL_TW); bf16_t* AL = (bf16_t*)(smem + RL_AL); bf16_t* W2T = (bf16_t*)(smem + RL_W2T); bf16_t* A2T = (bf16_t*)(smem + RL_A2T);
    bf16_t* Ar = (bf16_t*)(smem + RL_AR); bf16_t* Br = (bf16_t*)(smem + RL_BR); bf16_t* Kr = (bf16_t*)(smem + RL_KR); bf16_t* Rr = (bf16_t*)(smem + RL_RR);
    bf16_t* AT = (bf16_t*)(smem + RL_AT); bf16_t* BhT = (bf16_t*)(smem + RL_BHT); bf16_t* KhT = (bf16_t*)(smem + RL_KHT); bf16_t* VT = (bf16_t*)(smem + RL_VT);
    bf16_t* LakT = (bf16_t*)(smem + RL_LAKT); bf16_t* Mrb = (bf16_t*)(smem + RL_MRB); bf16_t* Mrk = (bf16_t*)(smem + RL_MRK); bf16_t* Tb = (bf16_t*)(smem + RL_TB);
    bf16_t* Wm = (bf16_t*)(smem + RL_WM); bf16_t* TLm = (bf16_t*)(smem + RL_TL);
    bf16_t* YDIR = (bf16_t*)(p.aux + AUX_YDIR); float* BON = (float*)(p.ws + WS_BONUS);
    __syncthreads();
    for (int i = tid; i < 64 * 64; i += NTHREADS) {
        const int c = i >> 6, rr = i & 63;
        W2T[c * LD64 + rr] = f2bf(p.in[I_W2][((size_t)d * 64 + rr) * 512 + h * 64 + c]); A2T[c * LD64 + rr] = f2bf(p.in[I_A2][((size_t)d * 64 + rr) * 512 + h * 64 + c]);
    }
    if (tid < 256) { const int w = tid >> 6, c = tid & 63, gc = h * 64 + c;
        CST[tid] = w == 0 ? p.in[I_W0][d * 512 + gc] : (w == 1 ? p.in[I_A0][d * 512 + gc] : (w == 2 ? p.in[I_KA][gc] : p.in[I_RK][gc])); }
    const float kkw0 = p.in[I_KK][h * 64 + 2 * (lane & 31)], kkw1 = p.in[I_KK][h * 64 + 2 * (lane & 31) + 1];
    f32x16 Xt[2]; Xt[0] = zero16(); Xt[1] = zero16();
    unsigned rawv[4][5];
    auto prefetch = [&](int x, int w) {
        int seg, j0; chunk_pos(x, d, seg, j0);
        const int ldp = seg ? IN_COLS : CTX_COLS;
        const bf16_t* pb = seg ? (const bf16_t*)(p.ws + WS_PLAT) + (size_t)b * S * IN_COLS : (const bf16_t*)(p.ws + WS_PCTX) + (size_t)b * CTXL * CTX_COLS;
#pragma unroll
        for (int k = 0; k < 4; ++k) {
            const int pi = (w - 2) + 5 * k;
            if (pi < GC / 2) {
                const int j = j0 + 2 * pi + (lane >> 5); const int row = seg ? (j % ROWS) * GW + j / ROWS : j;
#pragma unroll
                for (int s = 0; s < 5; ++s) {
                    const int bcol = (s < 3 ? s * 512 + h * 64 : (s == 3 ? 1536 + d * 64 : 1664 + d * 64)) + 2 * (lane & 31);
                    rawv[k][s] = *(const unsigned*)(pb + (size_t)row * ldp + COL_B0 + bcol);
                }
            }
        }
    };
    auto y1 = [&](int w) {
#pragma unroll
        for (int k = 0; k < 4; ++k) {
            const int pi = (w - 2) + 5 * k;
            if (pi < GC / 2) {
                const int jo = 2 * pi + (lane >> 5), i = d ? (GC - 1 - jo) : jo, c2 = 2 * (lane & 31);
                const float kx0 = bf2f((bf16_t)(rawv[k][1] & 0xffffu)) * kkw0, kx1 = bf2f((bf16_t)(rawv[k][1] >> 16)) * kkw1;
                const float rs = frsq(half_sum(kx0 * kx0 + kx1 * kx1, lane >> 5) + 1e-6f);
                *(unsigned*)(RX + i * 64 + c2) = rawv[k][0]; *(unsigned*)(KX + i * 64 + c2) = rawv[k][1]; *(unsigned*)(VX + i * 64 + c2) = rawv[k][2];
                KKs[i * 64 + c2] = kx0 * rs; KKs[i * 64 + c2 + 1] = kx1 * rs;
                *(unsigned*)(TW + i * LD64 + c2) = rawv[k][3]; *(unsigned*)(AL + i * LD64 + c2) = rawv[k][4];
            }
        }
    };
    if (wave >= 2 && wave < 7) prefetch(0, wave);
    const int r0_ = lane & 31, hh0_ = lane >> 5;
    __syncthreads();
    if (wave >= 2 && wave < 7) { y1(wave); if (1 < G_NT) prefetch(1, wave); }
    LDS_BARRIER();
    for (int it = -1; it < G_NT; ++it) {
        int r = r0_, hh = hh0_;
#ifndef EMU
        asm volatile("" : "+v"(r), "+v"(hh));
#endif
        const int xn = it + 1, par = xn & 1;
        int segn = 0, j0n = 0; if (xn < G_NT) chunk_pos(xn, d, segn, j0n);
        if (xn < G_NT) {
            const int which = wave >> 2, cg = wave & 3, fr = lane & 15, fq = lane >> 4;
            const bf16_t* arow0 = (which ? AL : TW) + fr * LD64 + 8 * fq; const bf16_t* brow = (which ? A2T : W2T) + (16 * cg + fr) * LD64 + 8 * fq;
            f32x4 c0 = {0.f, 0.f, 0.f, 0.f}, c1 = {0.f, 0.f, 0.f, 0.f};
#pragma unroll
            for (int ks = 0; ks < 2; ++ks) {
                const bf16x8 bfrag = *(const bf16x8*)(brow + 32 * ks);
                c0 = MFMA16(*(const bf16x8*)(arow0 + 32 * ks), bfrag, c0); c1 = MFMA16(*(const bf16x8*)(arow0 + 16 * LD64 + 32 * ks), bfrag, c1);
            }
            const int c = 16 * cg + fr; const float bias = CST[which * 64 + c];
#pragma unroll
            for (int th = 0; th < 2; ++th)
#pragma unroll
                for (int j = 0; j < 4; ++j) {
                    const int i = 16 * th + 4 * fq + j; const float z = bias + (th ? c1[j] : c0[j]);
                    if (which) IC[i * 64 + c] = fsigmoid(z);
                    else { const float wl = -fsoftplus(-z) - 0.5f; LW[i * 64 + c] = -fexp(wl); }
                }
        }
        LDS_BARRIER();
        if (xn < G_NT) {
            const int c = lane, i0 = 4 * wave;
            const float ka = CST[2 * 64 + c], rk = CST[3 * 64 + c];
            float lpb = 0.f, lpc = 0.f; float lw4[4];
#pragma unroll
            for (int s2 = 0; s2 < 32; ++s2) { const float w = LW[s2 * 64 + c]; lpc += w; if (s2 < i0) lpb += w; }
#pragma unroll
            for (int e = 0; e < 4; ++e) lw4[e] = LW[(i0 + e) * 64 + c];
            bf16_t ta[4], tb[4], tk[4], tv[4]; float bon[4];
            float lprun = lpb;
#pragma unroll
            for (int e = 0; e < 4; ++e) {
                const int i = i0 + e;
                const float lpm = lprun; lprun += lw4[e]; const float lp = lprun;
                const float Pi = fexp(lp), Pm = fexp(lpm), invP = fexp(-lp), PCi = fexp(lpc - lp);
                const float ic = IC[i * 64 + c], kxv = bf2f(KX[i * 64 + c]), kkv = KKs[i * 64 + c], rxv = bf2f(RX[i * 64 + c]); const bf16_t vxb = VX[i * 64 + c];
                const float kd = kxv * (1.f + (ic - 1.f) * ka), bb = kkv * ic, aa = -kkv;
                ta[e] = f2bf(aa * Pm); tb[e] = f2bf(bb * PCi); tk[e] = f2bf(kd * PCi); tv[e] = vxb;
                Ar[i * LD64 + c] = ta[e]; Br[i * LD64 + c] = f2bf(bb * invP); Kr[i * LD64 + c] = f2bf(kd * invP); Rr[(par * 32 + i) * LD64 + c] = f2bf(rxv * Pi);
                bon[e] = wave_sum_fast(rxv * kd * rk);
            }
            { u32x2 o; o.x = (unsigned)ta[0] | ((unsigned)ta[1] << 16); o.y = (unsigned)ta[2] | ((unsigned)ta[3] << 16); *(u32x2*)(AT + c * LD32 + i0) = o; }
            { u32x2 o; o.x = (unsigned)tb[0] | ((unsigned)tb[1] << 16); o.y = (unsigned)tb[2] | ((unsigned)tb[3] << 16); *(u32x2*)(BhT + (par * 64 + c) * LD32 + i0) = o; }
            { u32x2 o; o.x = (unsigned)tk[0] | ((unsigned)tk[1] << 16); o.y = (unsigned)tk[2] | ((unsigned)tk[3] << 16); *(u32x2*)(KhT + (par * 64 + c) * LD32 + i0) = o; }
            { u32x2 o; o.x = (unsigned)tv[0] | ((unsigned)tv[1] << 16); o.y = (unsigned)tv[2] | ((unsigned)tv[3] << 16); *(u32x2*)(VT + (par * 64 + c) * LD32 + i0) = o; }
            if (wave == 7) PC[par * 64 + c] = fexp(lpc);
            if (segn && lane < 4) { const int i = i0 + lane, jj = d ? j0n + GC - 1 - i : j0n + i;
                const float bv = lane == 0 ? bon[0] : (lane == 1 ? bon[1] : (lane == 2 ? bon[2] : bon[3]));
                BON[((size_t)d * T_LAT + (size_t)b * S + (jj % ROWS) * GW + jj / ROWS) * 8 + h] = bv; }
        }
        LDS_BARRIER();
        if (xn < G_NT) {
            const int m = wave >> 1, th = wave & 1, fr = lane & 15, fq = lane >> 4;
            const bf16_t* arow = ((m < 2) ? Ar : Rr + par * 32 * LD64) + (16 * th + fr) * LD64 + 8 * fq; const bf16_t* brow = ((m & 1) ? Kr : Br) + fr * LD64 + 8 * fq;
            f32x4 c0 = {0.f, 0.f, 0.f, 0.f}, c1 = {0.f, 0.f, 0.f, 0.f};
#pragma unroll
            for (int ks = 0; ks < 2; ++ks) {
                const bf16x8 afrag = *(const bf16x8*)(arow + 32 * ks);
                c0 = MFMA16(afrag, *(const bf16x8*)(brow + 32 * ks), c0); c1 = MFMA16(afrag, *(const bf16x8*)(brow + 16 * LD64 + 32 * ks), c1);
            }
#pragma unroll
            for (int ch = 0; ch < 2; ++ch) {
                const f32x4 cc = ch ? c1 : c0; const int ic = 16 * ch + fr; const int t0 = 16 * th + 4 * fq;
                if (m == 0) {
#pragma unroll
                    for (int j = 0; j < 4; ++j) Lf[(t0 + j) * 32 + ic] = (ic < t0 + j) ? -cc[j] : 0.f;
                } else if (m == 1) {
                    u32x2 o; o.x = pk2((ic < t0) ? cc[0] : 0.f, (ic < t0 + 1) ? cc[1] : 0.f); o.y = pk2((ic < t0 + 2) ? cc[2] : 0.f, (ic < t0 + 3) ? cc[3] : 0.f);
                    *(u32x2*)(LakT + ic * LD32 + t0) = o;
                } else {
                    bf16_t* M = (m == 2 ? Mrb : Mrk) + par * 32 * LD32;
#pragma unroll
                    for (int j = 0; j < 4; ++j) M[(t0 + j) * LD32 + ic] = f2bf((ic <= t0 + j) ? cc[j] : 0.f);
                }
            }
        }
        LDS_BARRIER();
        if (wave == 7 && xn < G_NT) {
            invert32_blocked(Lf, (bf16_t*)(smem + RL_AR), lane, [&](int i, int c, float v) { Tb[i * LD32 + c] = f2bf(v); });
        }
        if (wave >= 2 && wave < 7 && xn + 1 < G_NT) { y1(wave); if (xn + 2 < G_NT) prefetch(xn + 2, wave); }
        if (wave < 2 && it >= 0) {
            const int pc = it & 1; int seg = 0, j0 = 0; chunk_pos(it, d, seg, j0);
            const bf16_t* Rc = Rr + pc * 32 * LD64; const bf16_t* BhTc = BhT + pc * 64 * LD32; const bf16_t* KhTc = KhT + pc * 64 * LD32; const bf16_t* VTc = VT + (pc * 64 + 32 * wave + r) * LD32;
            const bf16_t* Mrbc = Mrb + pc * 32 * LD32; const bf16_t* Mrkc = Mrk + pc * 32 * LD32; const float* PCc = PC + pc * 64;
            const bf16x8 vf0 = ld_nat(VTc, 0, hh), vf1 = ld_nat(VTc, 1, hh);
            f32x16 u = zero16(), y = zero16();
            u = MFMA32(ld_nat(TLm + r * LD32, 0, hh), vf0, u); u = MFMA32(ld_nat(TLm + r * LD32, 1, hh), vf1, u);
            y = MFMA32(ld_nat(Mrkc + r * LD32, 0, hh), vf0, y); y = MFMA32(ld_nat(Mrkc + r * LD32, 1, hh), vf1, y);
#define RW_KSTEP(s) { const bf16x8 xb = pack_acc<(s) & 1>(Xt[(s) >> 1]); u = MFMA32(ld_perm(Wm + r * LD64, (s), hh), xb, u); y = MFMA32(ld_perm(Rc + r * LD64, (s), hh), xb, y); }
            RW_KSTEP(0) RW_KSTEP(1) RW_KSTEP(2) RW_KSTEP(3)
#undef RW_KSTEP
            const bf16x8 ub0 = pack_acc<0>(u), ub1 = pack_acc<1>(u);
            y = MFMA32(ld_perm(Mrbc + r * LD32, 0, hh), ub0, y); y = MFMA32(ld_perm(Mrbc + r * LD32, 1, hh), ub1, y);
#pragma unroll
            for (int kt = 0; kt < 2; ++kt) {
#pragma unroll
                for (int g = 0; g < 16; ++g) Xt[kt][g] *= PCc[32 * kt + crow(g, hh)];
                Xt[kt] = MFMA32(ld_perm(BhTc + (32 * kt + r) * LD32, 0, hh), ub0, Xt[kt]); Xt[kt] = MFMA32(ld_perm(BhTc + (32 * kt + r) * LD32, 1, hh), ub1, Xt[kt]);
                Xt[kt] = MFMA32(ld_nat(KhTc + (32 * kt + r) * LD32, 0, hh), vf0, Xt[kt]); Xt[kt] = MFMA32(ld_nat(KhTc + (32 * kt + r) * LD32, 1, hh), vf1, Xt[kt]);
            }
            if (seg) {
#pragma unroll
                for (int g = 0; g < 16; ++g) {
                    const int i = crow(g, hh), jj = d ? j0 + GC - 1 - i : j0 + i;
                    YDIR[((size_t)d * T_LAT + (size_t)b * S + (jj % ROWS) * GW + jj / ROWS) * 512 + h * 64 + 32 * wave + r] = f2bf(y[g]);
                }
            }
        }
        LDS_BARRIER();
        if (xn < G_NT && wave < 3) {
            const bf16_t* arow = (wave < 2) ? AT + (32 * wave + r) * LD32 : LakT + r * LD32;
            f32x16 acc = zero16();
#pragma unroll
            for (int s = 0; s < 2; ++s) acc = MFMA32(ld_nat(arow, s, hh), ld_nat(Tb + r * LD32, s, hh), acc);
#pragma unroll
            for (int q = 0; q < 4; ++q) {
                u32x2 o; o.x = pk2(acc[4 * q], acc[4 * q + 1]); o.y = pk2(acc[4 * q + 2], acc[4 * q + 3]);
                if (wave < 2) *(u32x2*)(Wm + r * LD64 + 32 * wave + 8 * q + 4 * hh) = o; else *(u32x2*)(TLm + r * LD32 + 8 * q + 4 * hh) = o;
            }
        }
        LDS_BARRIER();
    }
}

DI void phase3(const Params& p, char* smem) {
    constexpr int NG = 2 * NB * H_A, NR = 2 * NB * H_B;
    for (int it = blockIdx.x; it < NG; it += gridDim.x) gdn_chain2(p, smem, it);
    for (int it = blockIdx.x; it < NG + NR; it += gridDim.x) if (it >= NG) rwkv_chain2(p, smem, it - NG);
    const int nchain = NG + NR, G = (int)gridDim.x;
    const int tb = G > nchain ? (int)blockIdx.x - nchain : (int)blockIdx.x, ntb = G > nchain ? G - nchain : G;
    if (tb >= 0) {
        __syncthreads();
        const int tid3 = tid_x(), lane = tid3 & 63, wave = tid3 >> 6;
        float* scr = (float*)smem + wave * (64 * 33);
        bf16_t* GUT = (bf16_t*)(p.aux + AUX_GUT);
        constexpr int nkb = D / 64, nnb = DE / 32, per = nkb * nnb;
        for (int it = tb * 8 + wave; it < NEXP * 2 * per; it += ntb * 8) {
            const int e = it / (2 * per), r = it % (2 * per), up = r / per, r2 = r % per, kb = r2 / nnb, nb = r2 % nnb;
            transpose_item((up ? p.in[I_MU_UP] : p.in[I_MG]) + (size_t)e * D * DE, DE, DE, kb * 64, nb * 32, GUT + (size_t)e * 512 * D, D, up ? 2 : 1, scr, lane);
        }
        constexpr int nkb2 = DE / 64, nnb2 = D / 32, per2 = nkb2 * nnb2;
        for (int it = tb * 8 + wave; it < NE_EARLY * per2; it += ntb * 8) {
            const int e = it / per2, r2 = it % per2, kb = r2 / nnb2, nb = r2 % nnb2;
            transpose_item(p.in[I_MD] + (size_t)e * DE * D, D, D, kb * 64, nb * 32, DNT_PTR(p.ws, e), DE, 0, scr, lane);
        }
    }
}

constexpr int P4_SG = 0;
constexpr int P4_XV = P4_SG + 32 * LD128 * 2;
constexpr int P4_YF = P4_XV + 32 * 520 * 2;
static_assert(P4_YF + 32 * 516 * 4 <= LDS_BYTES, "phase4 lds");
DI void phase4(const Params& p, char* smem) {
    const int tid = tid_x(), lane = tid & 63, wave = tid >> 6, r = lane & 31, hh = lane >> 5;
    const bf16_t* PL = (const bf16_t*)(p.ws + WS_PLAT);
    const bf16_t* ODIR = (const bf16_t*)(p.ws + WS_OA); const bf16_t* YDIR = (const bf16_t*)(p.aux + AUX_YDIR);
    const float* BON = (const float*)(p.ws + WS_BONUS); const float* mu = p.in[I_MU]; const bf16_t* G2T = (const bf16_t*)(p.ws + WS_G2T);
    bf16_t* OA = (bf16_t*)(p.ws + WS_OA); bf16_t* OB = (bf16_t*)(p.ws + WS_OB);
    bf16_t* SG = (bf16_t*)(smem + P4_SG); bf16_t* XV = (bf16_t*)(smem + P4_XV); float* YF = (float*)(smem + P4_YF);
    for (int it = blockIdx.x; it < T_LAT / 32; it += gridDim.x) {
        const int tok0 = it * 32, b = tok0 / S, l0 = tok0 % S;
        __syncthreads();
        for (int q = tid; q < 32 * 80; q += NTHREADS) {
            const int t = q / 80, c8 = q % 80;
            const int l = l0 + t;
            const int bcol = c8 < 16 ? 1792 + c8 * 8 : 1024 + (c8 - 16) * 8;
            float cu[8], o[8];
            unpack8(*(const u32x4*)(PL + (size_t)(b * S + l) * IN_COLS + COL_B0 + bcol), cu);
#pragma unroll
            for (int e = 0; e < 8; ++e) o[e] = c8 < 16 ? fsigmoid(cu[e]) : cu[e];
            u32x4 w; w.x = pk2(o[0], o[1]); w.y = pk2(o[2], o[3]); w.z = pk2(o[4], o[5]); w.w = pk2(o[6], o[7]);
            if (c8 < 16) *(u32x4*)(SG + t * LD128 + c8 * 8) = w; else *(u32x4*)(XV + t * 520 + (c8 - 16) * 8) = w;
        }
        for (int q = tid; q < 32 * 64; q += NTHREADS) {
            const int t = q >> 6, c8 = q & 63, tok = tok0 + t;
            float a0[8], a1[8];
            unpack8(*(const u32x4*)(YDIR + (size_t)tok * 512 + c8 * 8), a0); unpack8(*(const u32x4*)(YDIR + ((size_t)T_LAT + tok) * 512 + c8 * 8), a1);
            f32x4 s0 = {a0[0] + a1[0], a0[1] + a1[1], a0[2] + a1[2], a0[3] + a1[3]}, s1 = {a0[4] + a1[4], a0[5] + a1[5], a0[6] + a1[6], a0[7] + a1[7]};
            *(f32x4*)(YF + t * 516 + c8 * 8) = s0; *(f32x4*)(YF + t * 516 + c8 * 8 + 4) = s1;
        }
        __syncthreads();
        {
            unsigned q0[16], q1[16], zq[16];
#pragma unroll
            for (int k = 0; k < 16; ++k) {
                const int pi = wave * 16 + k, t = pi >> 2, h = pi & 3, tok = tok0 + t;
                const size_t o0 = (size_t)tok * 512 + h * 128 + 2 * lane;
                q0[k] = *(const unsigned*)(ODIR + o0); q1[k] = *(const unsigned*)(ODIR + (size_t)T_LAT * 512 + o0); zq[k] = *(const unsigned*)(PL + (size_t)tok * IN_COLS + 1536 + h * 128 + 2 * lane);
            }
            const float on0 = p.in[I_ONORM][2 * lane], on1 = p.in[I_ONORM][2 * lane + 1];
#pragma unroll
            for (int k = 0; k < 16; ++k) {
                const int pi = wave * 16 + k, t = pi >> 2, h = pi & 3, tok = tok0 + t;
                const size_t o0 = (size_t)tok * 512 + h * 128 + 2 * lane;
                const float a0 = bf2f((bf16_t)(q0[k] & 0xffffu)) + bf2f((bf16_t)(q1[k] & 0xffffu)), a1 = bf2f((bf16_t)(q0[k] >> 16)) + bf2f((bf16_t)(q1[k] >> 16));
                const float ss = wave_sum_fast(a0 * a0 + a1 * a1);
                const float rstd = frsq(ss * (1.f / 128.f) + 1e-6f);
                const float z0 = bf2f((bf16_t)(zq[k] & 0xffffu)), z1 = bf2f((bf16_t)(zq[k] >> 16));
                *(unsigned*)(OA + o0) = pk2(a0 * rstd * on0 * fsilu(z0), a1 * rstd * on1 * fsilu(z1));
            }
        }
        __syncthreads();
        {
            const int h = wave;
            f32x16 acc0 = zero16(), acc1 = zero16();
#pragma unroll
            for (int s2 = 0; s2 < 8; ++s2) {
                const bf16x8 a = ld_nat(SG + r * LD128, s2, hh);
                const bf16x8 b0 = *(const bf16x8*)(G2T + (size_t)(64 * h + r) * 128 + 16 * s2 + 8 * hh), b1 = *(const bf16x8*)(G2T + (size_t)(64 * h + 32 + r) * 128 + 16 * s2 + 8 * hh);
                acc0 = MFMA32(a, b0, acc0); acc1 = MFMA32(a, b1, acc1);
            }
            const int c0 = 64 * h + r, c1 = c0 + 32;
            const float lg0 = p.in[I_LNG][c0], lb0 = p.in[I_LNB][c0], lg1 = p.in[I_LNG][c1], lb1 = p.in[I_LNB][c1];
            float bonv[16];
#pragma unroll
            for (int g = 0; g < 16; ++g) { const int tok = tok0 + crow(g, hh); bonv[g] = BON[(size_t)tok * 8 + h] + BON[((size_t)T_LAT + tok) * 8 + h]; }
#pragma unroll
            for (int g = 0; g < 16; ++g) {
                const int i = crow(g, hh), tok = tok0 + i;
                const float y0 = YF[i * 516 + c0], y1 = YF[i * 516 + c1];
                const float mean = half_sum(y0 + y1, hh) * (1.f / 64.f); const float d0 = y0 - mean, d1 = y1 - mean;
                const float var = half_sum(d0 * d0 + d1 * d1, hh) * (1.f / 64.f); const float rs = frsq(var + 64e-5f);
                const float bon = bonv[g];
                const float o0 = (d0 * rs * lg0 + lb0 + bon * bf2f(XV[i * 520 + c0])) * acc0[g], o1 = (d1 * rs * lg1 + lb1 + bon * bf2f(XV[i * 520 + c1])) * acc1[g];
                OB[(size_t)tok * 512 + c0] = f2bf(o0); OB[(size_t)tok * 512 + c1] = f2bf(o1);
            }
        }
    }
}

DI void phase5(const Params& p, char* smem) {
    const bf16_t* OA = (const bf16_t*)(p.ws + WS_OA); const bf16_t* OB = (const bf16_t*)(p.ws + WS_OB);
    const bf16_t* WA = (const bf16_t*)(p.ws + WS_WOA); const bf16_t* WB = (const bf16_t*)(p.ws + WS_WOB);
    const bf16_t* PL = (const bf16_t*)(p.ws + WS_PLAT); bf16_t* Y = (bf16_t*)(p.aux + AUX_Y);
    if (USE_G8) {
        constexpr int NT8 = D / 256, MT8 = T_LAT / 256;
        constexpr int GLD = 264;
        static_assert(256 * GLD * 2 <= LDS_BYTES, "gate tile lds");
        bf16_t* GT = (bf16_t*)smem;
        auto stage_gates = [&](int brow, int gcol0) {
            const int tid = tid_x();
            u32x4 gv[16];
#pragma unroll
            for (int i = 0; i < 16; ++i) { const int ch = tid + i * NTHREADS, row = ch >> 5, c16 = ch & 31; gv[i] = *(const u32x4*)(PL + (size_t)(brow + row) * IN_COLS + gcol0 + c16 * 8); }
#pragma unroll
            for (int i = 0; i < 16; ++i) { const int ch = tid + i * NTHREADS, row = ch >> 5, c16 = ch & 31; *(u32x4*)(GT + row * GLD + c16 * 8) = gv[i]; }
            __syncthreads();
        };
        for (int t = blockIdx.x; t < MT8 * NT8; t += gridDim.x) {
            int mt, nt; if (!g8::tile_order(t, MT8, NT8, mt, nt)) break;
            const int brow = mt * 256, bcol = nt * 256;
            g8::Acc acc; g8::acc_zero(acc);
            g8::kloop(acc, smem, OA, 512, WA, 512, 512, brow, bcol);
            stage_gates(brow, COL_G0 + bcol);
            g8::for_each_quad(acc, brow, bcol, [&](int row, int col, const f32x4& v) {
                const u32x2 gq = *(const u32x2*)(GT + (row - brow) * GLD + (col - bcol));
                const float g0 = bf2f((bf16_t)(gq.x & 0xffffu)), g1 = bf2f((bf16_t)(gq.x >> 16)), g2 = bf2f((bf16_t)(gq.y & 0xffffu)), g3 = bf2f((bf16_t)(gq.y >> 16));
                u32x2 o; o.x = pk2(fsigmoid(g0) * v.x, fsigmoid(g1) * v.y); o.y = pk2(fsigmoid(g2) * v.z, fsigmoid(g3) * v.w);
                *(u32x2*)(Y + (size_t)row * D + col) = o;
            });
            __syncthreads();
            g8::acc_zero(acc);
            g8::kloop(acc, smem, OB, 512, WB, 512, 512, brow, bcol);
            stage_gates(brow, COL_G0 + D + bcol);
            g8::for_each_quad(acc, brow, bcol, [&](int row, int col, const f32x4& v) {
                const u32x2 gq = *(const u32x2*)(GT + (row - brow) * GLD + (col - bcol));
                const float g0 = bf2f((bf16_t)(gq.x & 0xffffu)), g1 = bf2f((bf16_t)(gq.x >> 16)), g2 = bf2f((bf16_t)(gq.y & 0xffffu)), g3 = bf2f((bf16_t)(gq.y >> 16));
#ifdef EMU
                const unsigned long long tq = *(const unsigned long long*)(Y + (size_t)row * D + col);
#else
                const unsigned long long tq = __hip_atomic_load((const unsigned long long*)(Y + (size_t)row * D + col), __ATOMIC_RELAXED, __HIP_MEMORY_SCOPE_AGENT);
#endif
                const unsigned tlo = (unsigned)tq, thi = (unsigned)(tq >> 32);
                const float t0 = bf2f((bf16_t)(tlo & 0xffffu)), t1 = bf2f((bf16_t)(tlo >> 16)), t2 = bf2f((bf16_t)(thi & 0xffffu)), t3 = bf2f((bf16_t)(thi >> 16));
                u32x2 o; o.x = pk2(t0 + fsigmoid(g0) * v.x, t1 + fsigmoid(g1) * v.y); o.y = pk2(t2 + fsigmoid(g2) * v.z, t3 + fsigmoid(g3) * v.w);
                *(u32x2*)(Y + (size_t)row * D + col) = o;
            });
            __syncthreads();
        }
        return;
    }
    constexpr int MR5 = 2, BM5 = 64 * MR5; constexpr int NT = D / 128, MT = T_LAT / BM5;
    for (int t = blockIdx.x; t < MT * NT; t += gridDim.x) {
        const int mt = t / NT, nt = t % NT, row0 = mt * BM5;
        f32x4 acca[MR5][4], accb[MR5][4]; acc_zero(acca); acc_zero(accb);
        gemm_kloop(acca, smem, [&](int i) { return OA + (size_t)(row0 + i) * 512; }, WA + (size_t)nt * 128 * 512, 512, 512);
        gemm_kloop(accb, smem, [&](int i) { return OB + (size_t)(row0 + i) * 512; }, WB + (size_t)nt * 128 * 512, 512, 512);
        const int t2 = tid_x(), l2 = t2 & 63, w2 = t2 >> 6; const int wr = w2 >> 1, wc = w2 & 1, fr = l2 & 15, fq = l2 >> 4;
#pragma unroll
        for (int m = 0; m < MR5; ++m)
#pragma unroll
            for (int n = 0; n < 4; ++n)
#pragma unroll
                for (int j = 0; j < 4; ++j) {
                    const int row = row0 + wr * 16 * MR5 + m * 16 + fq * 4 + j, col = nt * 128 + wc * 64 + n * 16 + fr;
                    const float ga = bf2f(PL[(size_t)row * IN_COLS + COL_G0 + col]), gb = bf2f(PL[(size_t)row * IN_COLS + COL_G0 + D + col]);
                    Y[(size_t)row * D + col] = f2bf(sigmoidf_(ga) * acca[m][n][j] + sigmoidf_(gb) * accb[m][n][j]);
                }
    }
}

DI void phase6(const Params& p, char* smem) {
    const bf16_t* Y = (const bf16_t*)(p.aux + AUX_Y); const bf16_t* WO = (const bf16_t*)(p.ws + WS_WOUT);
    const float* mod = (const float*)(p.ws + WS_MOD); float* Hh = (float*)(p.ws + WS_H);
    if (USE_G8) {
        constexpr int NT = D / 256, MT = T_LAT / 256;
        const float* X = p.in[I_X];
        for (int t = blockIdx.x; t < MT * NT; t += gridDim.x) {
            int mt, nt; if (!g8::tile_order(t, MT, NT, mt, nt)) break;
            const int brow = mt * 256, bcol = nt * 256;
            g8::Acc acc; g8::acc_zero(acc);
            g8::kloop(acc, smem, Y, D, WO, D, D, brow, bcol);
            g8::for_each_quad(acc, brow, bcol, [&](int row, int col, const f32x4& v) {
                const int b = row / S; const f32x4 xv = *(const f32x4*)(X + (size_t)row * D + col), gv = *(const f32x4*)(mod + (size_t)b * 6 * D + 2 * D + col);
                f32x4 o; o.x = xv.x + gv.x * v.x; o.y = xv.y + gv.y * v.y; o.z = xv.z + gv.z * v.z; o.w = xv.w + gv.w * v.w;
                *(f32x4*)(Hh + (size_t)row * D + col) = o;
            });
        }
    } else {
        const int tid = tid_x(), lane = tid & 63, wave = tid >> 6, wr = wave >> 1, wc = wave & 1, fr = lane & 15, fq = lane >> 4;
        constexpr int NT = D / 128, MT = T_LAT / BM;
        for (int t = blockIdx.x; t < MT * NT; t += gridDim.x) {
            const int mt = t / NT, nt = t % NT, row0 = mt * BM;
            f32x4 acc[MREP][4]; acc_zero(acc);
            gemm_kloop(acc, smem, [&](int i) { return Y + (size_t)(row0 + i) * D; }, WO + (size_t)nt * 128 * D, D, D);
#pragma unroll
            for (int m = 0; m < MREP; ++m)
#pragma unroll
                for (int n = 0; n < 4; ++n)
#pragma unroll
                    for (int j = 0; j < 4; ++j) {
                        const int row = row0 + wr * 16 * MREP + m * 16 + fq * 4 + j, col = nt * 128 + wc * 64 + n * 16 + fr, b = row / S;
                        Hh[(size_t)row * D + col] = p.in[I_X][(size_t)row * D + col] + mod[(size_t)b * 6 * D + 2 * D + col] * acc[m][n][j];
                    }
        }
    }
    __syncthreads();
    const int tid6 = tid_x(), lane = tid6 & 63, wave = tid6 >> 6;
    const int gw = blockIdx.x * 8 + wave, ngw = gridDim.x * 8;
    float* scr = (float*)smem + wave * (64 * 33);
    {
        constexpr int nkb = DE / 64, nnb = D / 32, per = nkb * nnb;
        for (int it = gw; it < (NEXP - NE_EARLY) * per; it += ngw) {
            const int e = NE_EARLY + it / per, r2 = it % per, kb = r2 / nnb, nb = r2 % nnb;
            transpose_item(p.in[I_MD] + (size_t)e * DE * D, D, D, kb * 64, nb * 32, DNT_PTR(p.ws, e), DE, 0, scr, lane);
        }
    }
}

#ifdef EMU
#define MFMA32F(a, b, c) emu_mfma32_f32((a), (b), (c))
#else
#define MFMA32F(a, b, c) __builtin_amdgcn_mfma_f32_32x32x2f32((a), (b), (c), 0, 0, 0)
#endif
constexpr int TB_LD = D + 4;
static_assert(32 * TB_LD * 4 <= LDS_BYTES && 8 * 32 * 64 * 4 <= LDS_BYTES, "phase7 lds");
DI void phase7(const Params& p, char* smem) {
    const int tid = tid_x(), lane = tid & 63, wave = tid >> 6, r = lane & 31, hh = lane >> 5;
    const float* Hh = (const float*)(p.ws + WS_H); const float* mod = (const float*)(p.ws + WS_MOD); const float* WRT = (const float*)(p.ws + WS_WRT);
    bf16_t* Tt = (bf16_t*)(p.ws + WS_T); int* cnt = (int*)(p.ws + WS_CNT); int* rowlist = (int*)(p.ws + WS_ROWLIST); float* pairw = (float*)(p.ws + WS_PAIRW);
    float* tb = (float*)smem;
    float* bias = (float*)(smem + LDS_BYTES - 1024);
    int* lcnt = (int*)(smem + LDS_BYTES - 768);
    int* lbase = lcnt + 32;
    if (tid < 36) bias[tid] = tid < 4 ? p.in[I_RGB][tid] : p.in[I_REB][tid - 4];
    f32x4 x[4][D / 256];
    int itn = blockIdx.x;
    if (itn < T_LAT / 32) {
#pragma unroll
        for (int tt = 0; tt < 4; ++tt)
#pragma unroll
            for (int j = 0; j < D / 256; ++j) x[tt][j] = *(const f32x4*)(Hh + (size_t)(itn * 32 + wave * 4 + tt) * D + j * 256 + lane * 4);
    }
    for (int it = blockIdx.x; it < T_LAT / 32; it += gridDim.x) {
        const int tok0 = it * 32;
        __syncthreads();
        if (tid < 32) lcnt[tid] = 0;
#pragma unroll
        for (int tt = 0; tt < 4; ++tt) {
            const int ti = wave * 4 + tt, tok = tok0 + ti, b = tok / S;
            float ss = 0.f;
#pragma unroll
            for (int j = 0; j < D / 256; ++j) ss += x[tt][j].x * x[tt][j].x + x[tt][j].y * x[tt][j].y + x[tt][j].z * x[tt][j].z + x[tt][j].w * x[tt][j].w;
            ss = wave_sum_fast(ss);
            const float rstd = frsq(ss * (1.0f / D) + 1e-6f);
#pragma unroll
            for (int j = 0; j < D / 256; ++j) {
                const int k = j * 256 + lane * 4;
                const f32x4 g = *(const f32x4*)(p.in[I_NFFN] + k), sh = *(const f32x4*)(mod + (size_t)b * 6 * D + 3 * D + k), sc = *(const f32x4*)(mod + (size_t)b * 6 * D + 4 * D + k);
                f32x4 o; o.x = x[tt][j].x * rstd * g.x * (1.f + sc.x) + sh.x; o.y = x[tt][j].y * rstd * g.y * (1.f + sc.y) + sh.y;
                o.z = x[tt][j].z * rstd * g.z * (1.f + sc.z) + sh.z; o.w = x[tt][j].w * rstd * g.w * (1.f + sc.w) + sh.w;
                *(f32x4*)(tb + ti * TB_LD + k) = o;
                u32x2 ob; ob.x = pk2(o.x, o.y); ob.y = pk2(o.z, o.w);
                *(u32x2*)(Tt + (size_t)tok * D + k) = ob;
            }
        }
        itn = it + gridDim.x;
        if (itn < T_LAT / 32) {
#pragma unroll
            for (int tt = 0; tt < 4; ++tt)
#pragma unroll
                for (int j = 0; j < D / 256; ++j) x[tt][j] = *(const f32x4*)(Hh + (size_t)(itn * 32 + wave * 4 + tt) * D + j * 256 + lane * 4);
        }
        LDS_BARRIER();
        f32x16 a0 = zero16(), a1 = zero16();
        {
            const int kbeg = wave * (D / 8);
            const float* arow = tb + r * TB_LD + kbeg + 4 * hh;
            const float* b0row = WRT + (size_t)(4 + r) * D + kbeg + 4 * hh;
            const float* b1row = WRT + (size_t)(r < 4 ? r : 0) * D + kbeg + 4 * hh;
            const float m1 = r < 4 ? 1.f : 0.f;
#pragma unroll 4
            for (int g = 0; g < D / 64; ++g) {
                const f32x4 av = *(const f32x4*)(arow + 8 * g), b0 = *(const f32x4*)(b0row + 8 * g); const f32x4 b1 = *(const f32x4*)(b1row + 8 * g) * m1;
                a0 = MFMA32F(av.x, b0.x, a0); a1 = MFMA32F(av.x, b1.x, a1); a0 = MFMA32F(av.y, b0.y, a0); a1 = MFMA32F(av.y, b1.y, a1);
                a0 = MFMA32F(av.z, b0.z, a0); a1 = MFMA32F(av.z, b1.z, a1); a0 = MFMA32F(av.w, b0.w, a0); a1 = MFMA32F(av.w, b1.w, a1);
            }
        }
        LDS_BARRIER();
        {
            float* part = tb + wave * (32 * 64);
#pragma unroll
            for (int g = 0; g < 16; ++g) { const int i = crow(g, hh); part[i * 64 + r] = a0[g]; part[i * 64 + 32 + r] = a1[g]; }
        }
        LDS_BARRIER();
        float lsum[4];
        {
            const int i = tid >> 4, c4 = (tid & 15) * 4;
#pragma unroll
            for (int e = 0; e < 4; ++e) { float sacc = 0.f;
#pragma unroll
                for (int w = 0; w < 8; ++w) sacc += tb[w * (32 * 64) + i * 64 + c4 + e];
                lsum[e] = sacc; }
        }
        LDS_BARRIER();
        { const int i = tid >> 4, c4 = (tid & 15) * 4;
#pragma unroll
          for (int e = 0; e < 4; ++e) tb[i * 64 + c4 + e] = lsum[e]; }
        LDS_BARRIER();
        int ex1 = 0, ex2 = 0, rk1 = 0, rk2 = 0; float w1 = 0.f, w2 = 0.f;
        if (tid < 32) {
            const float* L = tb + tid * 64;
            float gl[4];
#pragma unroll
            for (int i = 0; i < 4; ++i) gl[i] = L[32 + i] + bias[i];
            int g = 0; float mx = gl[0];
#pragma unroll
            for (int i = 1; i < 4; ++i) if (gl[i] > mx) { mx = gl[i]; g = i; }
            float se = 0.f;
#pragma unroll
            for (int i = 0; i < 4; ++i) se += fexp(gl[i] - mx);
            const float pg = 1.0f / se;
            int i1 = 0; float l1 = L[g * 8] + bias[4 + g * 8];
            for (int i = 1; i < 8; ++i) { const float v = L[g * 8 + i] + bias[4 + g * 8 + i]; if (v > l1) { l1 = v; i1 = i; } }
            int i2 = -1; float l2 = -3.0e38f;
            for (int i = 0; i < 8; ++i) { const float v = L[g * 8 + i] + bias[4 + g * 8 + i]; if (i != i1 && v > l2) { l2 = v; i2 = i; } }
            const float e2 = fexp(l2 - l1); w1 = pg / (1.f + e2); w2 = pg * e2 / (1.f + e2);
            ex1 = g * 8 + i1; ex2 = g * 8 + i2;
            rk1 = atomicAdd(&lcnt[ex1], 1); rk2 = atomicAdd(&lcnt[ex2], 1);
        }
        LDS_BARRIER();
        if (tid < 32) { const int c = lcnt[tid]; lbase[tid] = c ? atomicAdd(&cnt[tid * CNT_STRIDE], c) : 0; }
        __syncthreads();
        if (tid < 32) {
            const int tok = tok0 + tid;
            rowlist[(size_t)ex1 * CAP + lbase[ex1] + rk1] = tok * 2; pairw[tok * 2] = w1;
            rowlist[(size_t)ex2 * CAP + lbase[ex2] + rk2] = tok * 2 + 1; pairw[tok * 2 + 1] = w2;
        }
    }
}

constexpr int MOE_TM = USE_G8 ? 256 : BM;
DI void moe_tiles(const Params& p, char* smem, int* pre) {
    const int* cnt = (const int*)(p.ws + WS_CNT);
    __syncthreads();
    if (tid_x() == 0) { int s = 0; for (int e = 0; e < NEXP; ++e) { pre[e] = s; s += (cnt[e * CNT_STRIDE] + MOE_TM - 1) / MOE_TM; } pre[NEXP] = s; }
    __syncthreads();
}
DI void moe_up_tile(const Params& p, char* smem, const int* pre, int t) {
    const int* cnt = (const int*)(p.ws + WS_CNT); const int* rowlist = (const int*)(p.ws + WS_ROWLIST);
    const bf16_t* Tt = (const bf16_t*)(p.ws + WS_T); const bf16_t* GUT = (const bf16_t*)(p.aux + AUX_GUT); bf16_t* HID = (bf16_t*)(p.ws + WS_HID);
    const int mg = t >> 1, nt = t & 1; int e = 0;
    while (pre[e + 1] <= mg) ++e;
    const int mt = mg - pre[e], ce = cnt[e * CNT_STRIDE]; const int* rl = rowlist + (size_t)e * CAP;
    g8::Acc acc; g8::acc_zero(acc);
    g8::kloop_g(acc, smem, Tt, [&](int r) { int idx = mt * 256 + r; idx = idx < ce ? idx : ce - 1; return (rl[idx] >> 1) * D; }, GUT + ((size_t)e * 512 + nt * 256) * D, D, D, 0);
    const int t2 = tid_x(), wid = t2 >> 6, l2 = t2 & 63, wr2 = wid >> 2, wc2 = wid & 3, fr2 = l2 & 15, fq2 = l2 >> 4;
    int prs[2][4];
#pragma unroll
    for (int ai = 0; ai < 2; ++ai)
#pragma unroll
        for (int m = 0; m < 4; ++m) { const int idx = mt * 256 + ai * 128 + wr2 * 64 + m * 16 + fr2; prs[ai][m] = idx < ce ? rl[idx] : -1; }
#pragma unroll
    for (int ai = 0; ai < 2; ++ai)
#pragma unroll
        for (int m = 0; m < 4; ++m) {
            if (prs[ai][m] >= 0) {
                const int pair = prs[ai][m];
#pragma unroll
                for (int bj = 0; bj < 2; ++bj) {
                    const f32x4 g = acc[ai][bj][m][0], u = acc[ai][bj][m][1];
                    u32x2 o; o.x = pk2(fsilu(g.x) * u.x, fsilu(g.y) * u.y); o.y = pk2(fsilu(g.z) * u.z, fsilu(g.w) * u.w);
                    *(u32x2*)(HID + (size_t)pair * DE + nt * 128 + bj * 64 + wc2 * 16 + fq2 * 4) = o;
                }
            }
        }
}
DI void moe_down_tile(const Params& p, char* smem, const int* pre, int t) {
    constexpr int NT8 = D / 256;
    const int* cnt = (const int*)(p.ws + WS_CNT); const int* rowlist = (const int*)(p.ws + WS_ROWLIST); const float* pairw = (const float*)(p.ws + WS_PAIRW);
    const bf16_t* HID = (const bf16_t*)(p.ws + WS_HID); bf16_t* OP = (bf16_t*)(p.ws + WS_OPAIR);
    const int mg = t / NT8, nt = t % NT8; int e = 0;
    while (pre[e + 1] <= mg) ++e;
    const int mt = mg - pre[e], ce = cnt[e * CNT_STRIDE]; const int* rl = rowlist + (size_t)e * CAP;
    g8::Acc acc; g8::acc_zero(acc);
    g8::kloop_g(acc, smem, HID, [&](int r) { int idx = mt * 256 + r; idx = idx < ce ? idx : ce - 1; return rl[idx] * DE; }, DNT_PTR(p.ws, e) + (size_t)nt * 256 * DE, DE, DE, 0);
    {
        const int t2 = tid_x(), wid = t2 >> 6, l2 = t2 & 63, wr2 = wid >> 2, wc2 = wid & 3, fr2 = l2 & 15, fq2 = l2 >> 4;
        int prs[2][4]; float pws[2][4];
#pragma unroll
        for (int ai = 0; ai < 2; ++ai)
#pragma unroll
            for (int m = 0; m < 4; ++m) { const int idx = mt * 256 + ai * 128 + wr2 * 64 + m * 16 + fr2; prs[ai][m] = idx < ce ? rl[idx] : -1; }
#pragma unroll
        for (int ai = 0; ai < 2; ++ai)
#pragma unroll
            for (int m = 0; m < 4; ++m) pws[ai][m] = prs[ai][m] >= 0 ? pairw[prs[ai][m]] : 0.f;
#pragma unroll
        for (int ai = 0; ai < 2; ++ai)
#pragma unroll
            for (int m = 0; m < 4; ++m) {
                if (prs[ai][m] >= 0) {
                    const float w = pws[ai][m]; bf16_t* orow = OP + (size_t)prs[ai][m] * D + nt * 256 + wc2 * 32 + fq2 * 4;
#pragma unroll
                    for (int bj = 0; bj < 2; ++bj)
#pragma unroll
                        for (int n = 0; n < 2; ++n) { const f32x4 v = acc[ai][bj][m][n];
                            u32x2 o; o.x = pk2(v.x * w, v.y * w); o.y = pk2(v.z * w, v.w * w); *(u32x2*)(orow + bj * 128 + n * 16) = o; }
                }
            }
    }
}
DI void phase8(const Params& p, char* smem) {
    const int tid = tid_x(), lane = tid & 63, wave = tid >> 6, wr = wave >> 1, wc = wave & 1, fr = lane & 15, fq = lane >> 4;
    int* pre = (int*)(smem + LDS_BYTES - 256);
    moe_tiles(p, smem, pre);
    const int* cnt = (const int*)(p.ws + WS_CNT); const int* rowlist = (const int*)(p.ws + WS_ROWLIST);
    const bf16_t* Tt = (const bf16_t*)(p.ws + WS_T); const bf16_t* GUT = (const bf16_t*)(p.aux + AUX_GUT); bf16_t* HID = (bf16_t*)(p.ws + WS_HID);
    if (USE_G8) {
        if ((int)blockIdx.x < pre[NEXP] * 2) moe_up_tile(p, smem, pre, (int)blockIdx.x);
        return;
    }
    const int ntile = pre[NEXP] * 4;
    for (int t = blockIdx.x; t < ntile; t += gridDim.x) {
        const int mg = t >> 2, nt = t & 3; int e = 0;
        while (pre[e + 1] <= mg) ++e;
        const int mt = mg - pre[e], ce = cnt[e * CNT_STRIDE]; const int* rl = rowlist + (size_t)e * CAP;
        f32x4 acc[MREP][4]; acc_zero(acc);
        gemm_kloop(acc, smem, [&](int i) { int idx = mt * BM + i; idx = idx < ce ? idx : ce - 1; return Tt + (size_t)(rl[idx] >> 1) * D; }, GUT + ((size_t)e * 512 + nt * 128) * D, D, D);
#pragma unroll
        for (int m = 0; m < MREP; ++m)
#pragma unroll
            for (int j = 0; j < 4; ++j) {
                const int idx = mt * BM + wr * 16 * MREP + m * 16 + fq * 4 + j;
                if (idx < ce) {
                    const int pair = rl[idx];
#pragma unroll
                    for (int n = 0; n < 2; ++n) {
                        const float g = acc[m][n][j], u = acc[m][n + 2][j];
                        HID[(size_t)pair * DE + nt * 64 + wc * 32 + n * 16 + fr] = f2bf(siluf_(g) * u);
                    }
                }
            }
    }
}
DI void phase9(const Params& p, char* smem) {
    const int tid = tid_x(), lane = tid & 63, wave = tid >> 6, wr = wave >> 1, wc = wave & 1, fr = lane & 15, fq = lane >> 4;
    int* pre = (int*)(smem + LDS_BYTES - 256);
    moe_tiles(p, smem, pre);
    const int* cnt = (const int*)(p.ws + WS_CNT); const int* rowlist = (const int*)(p.ws + WS_ROWLIST); const float* pairw = (const float*)(p.ws + WS_PAIRW);
    const bf16_t* HID = (const bf16_t*)(p.ws + WS_HID); const bf16_t* DNT = (const bf16_t*)(p.ws + WS_DNT); bf16_t* OP = (bf16_t*)(p.ws + WS_OPAIR);
    if (USE_G8) {
        constexpr int NT8 = D / 256;
        const int G = (int)gridDim.x, NU = pre[NEXP] * 2, NU2 = NU > G ? NU - G : 0, ND = pre[NEXP] * NT8;
        int* cntw = (int*)(p.ws + WS_CNT);
        int* tk = (int*)(smem + LDS_BYTES - 512);
        for (;;) {
            __syncthreads();
            if (tid_x() == 0) *tk = atomicAdd(&cntw[CNT_TICKET], 1);
            __syncthreads();
            const int j = *tk;
            if (j >= NU2 + ND) break;
            if (j < NU2) {
                moe_up_tile(p, smem, pre, G + j);
#ifndef EMU
                asm volatile("s_waitcnt vmcnt(0)" ::: "memory");
#endif
                __syncthreads();
                if (tid_x() == 0) {
#ifndef EMU
                    __builtin_amdgcn_fence(__ATOMIC_RELEASE, "agent");
                    asm volatile("s_waitcnt vmcnt(0)" ::: "memory");
#endif
                    (void)atomicAdd(&cntw[CNT_U2DONE], 1);
                }
            } else {
                const int dt = j - NU2;
                if (2 * (dt / NT8) + 1 >= G) {
                    if (tid_x() == 0) {
#ifndef EMU
                        while (__hip_atomic_load(&cntw[CNT_U2DONE], __ATOMIC_RELAXED, __HIP_MEMORY_SCOPE_AGENT) < NU2) __builtin_amdgcn_s_sleep(2);
                        __builtin_amdgcn_fence(__ATOMIC_ACQUIRE, "agent");
                        asm volatile("s_waitcnt vmcnt(0)" ::: "memory");
#endif
                    }
                    __syncthreads();
                }
                moe_down_tile(p, smem, pre, dt);
            }
        }
        return;
    }
    constexpr int NT = D / 128;
    const int ntile = pre[NEXP] * NT;
    for (int t = blockIdx.x; t < ntile; t += gridDim.x) {
        const int mg = t / NT, nt = t % NT; int e = 0;
        while (pre[e + 1] <= mg) ++e;
        const int mt = mg - pre[e], ce = cnt[e * CNT_STRIDE]; const int* rl = rowlist + (size_t)e * CAP;
        f32x4 acc[MREP][4]; acc_zero(acc);
        gemm_kloop(acc, smem, [&](int i) { int idx = mt * BM + i; idx = idx < ce ? idx : ce - 1; return HID + (size_t)rl[idx] * DE; }, DNT_PTR(p.ws, e) + (size_t)nt * 128 * DE, DE, DE);
#pragma unroll
        for (int m = 0; m < MREP; ++m)
#pragma unroll
            for (int j = 0; j < 4; ++j) {
                const int idx = mt * BM + wr * 16 * MREP + m * 16 + fq * 4 + j;
                if (idx < ce) {
                    const int pair = rl[idx]; const float w = pairw[pair];
#pragma unroll
                    for (int n = 0; n < 4; ++n) OP[(size_t)pair * D + nt * 128 + wc * 64 + n * 16 + fr] = f2bf(acc[m][n][j] * w);
                }
            }
    }
}

DI void phase10(const Params& p, char* smem) {
    const int lane = tid_x() & 63, wave = tid_x() >> 6;
    const int gw = blockIdx.x * 8 + wave, ngw = gridDim.x * 8;
    const float* Hh = (const float*)(p.ws + WS_H); const float* mod = (const float*)(p.ws + WS_MOD); const bf16_t* OP = (const bf16_t*)(p.ws + WS_OPAIR);
    for (int tok = gw; tok < T_LAT; tok += ngw) {
        const int b = tok / S;
        f32x4 x[D / 256]; float ss = 0.f;
#pragma unroll
        for (int j = 0; j < D / 256; ++j) {
            const int k = j * 256 + lane * 4;
            const f32x4 hv = *(const f32x4*)(Hh + (size_t)tok * D + k), g2 = *(const f32x4*)(mod + (size_t)b * 6 * D + 5 * D + k);
            const u32x2 p0 = *(const u32x2*)(OP + (size_t)(tok * 2) * D + k), p1 = *(const u32x2*)(OP + (size_t)(tok * 2 + 1) * D + k);
            f32x4 m;
            m.x = bf2f((bf16_t)(p0.x & 0xffffu)) + bf2f((bf16_t)(p1.x & 0xffffu)); m.y = bf2f((bf16_t)(p0.x >> 16)) + bf2f((bf16_t)(p1.x >> 16));
            m.z = bf2f((bf16_t)(p0.y & 0xffffu)) + bf2f((bf16_t)(p1.y & 0xffffu)); m.w = bf2f((bf16_t)(p0.y >> 16)) + bf2f((bf16_t)(p1.y >> 16));
            x[j].x = hv.x + g2.x * m.x; x[j].y = hv.y + g2.y * m.y; x[j].z = hv.z + g2.z * m.z; x[j].w = hv.w + g2.w * m.w;
            ss += x[j].x * x[j].x + x[j].y * x[j].y + x[j].z * x[j].z + x[j].w * x[j].w;
        }
        ss = wave_sum(ss);
        const float rstd = 1.0f / sqrtf(ss * (1.0f / D) + 1e-6f);
#pragma unroll
        for (int j = 0; j < D / 256; ++j) {
            const int k = j * 256 + lane * 4; const f32x4 g = *(const f32x4*)(p.in[I_FIN] + k);
            f32x4 o; o.x = x[j].x * rstd * g.x; o.y = x[j].y * rstd * g.y; o.z = x[j].z * rstd * g.z; o.w = x[j].w * rstd * g.w;
            *(f32x4*)(p.out + (size_t)tok * D + k) = o;
        }
    }
}

DI void run_phase(const Params& p, int ph, char* smem) {
    switch (ph) {
        case PH_MOD: phase0(p, smem); break;
        case PH_U: phase1(p, smem); break;
        case PH_P: phase2(p, smem); break;
        case PH_HALO: phase_halo(p, smem); break;
        case PH_FIR: phase_fir(p, smem); break;
        case PH_CHAINS: phase3(p, smem); break;
        case PH_POST: phase4(p, smem); break;
        case PH_MERGE: phase5(p, smem); break;
        case PH_WOUT: phase6(p, smem); break;
        case PH_ROUTER: phase7(p, smem); break;
        case PH_UP: phase8(p, smem); break;
        case PH_DOWN: phase9(p, smem); break;
        default: phase10(p, smem); break;
    }
}

#ifndef EMU
namespace cg = cooperative_groups;
#define XB_TMO      128
#define XB_XCNT(j)  (256  + 64 * (j))
#define XB_XSUB(j)  (1280 + 64 * (j))
#define XB_XGEN(j)  (2304 + 64 * (j))
#define XB_TOP      3328
#define XB_TOPGEN   3392
#define XB_SPIN_CAP (1u << 20)
DI unsigned xb_ld(unsigned* p) { return __hip_atomic_load(p, __ATOMIC_RELAXED, __HIP_MEMORY_SCOPE_AGENT); }
DI unsigned xb_add(unsigned* p, unsigned v) { return __hip_atomic_fetch_add(p, v, __ATOMIC_RELAXED, __HIP_MEMORY_SCOPE_AGENT); }
DI unsigned xb_xcc_id() { return (unsigned)__builtin_amdgcn_s_getreg((3 << 11) | 20) & 0xFu; }
#define XB_SPIN(cond, bar) do { unsigned _sp = 0; while (cond) { __builtin_amdgcn_s_sleep(1); \
    if ((++_sp & 255u) == 0u) { if (xb_ld(&(bar)[XB_TMO])) break; if (_sp > XB_SPIN_CAP) { atomicAdd(&(bar)[XB_TMO], 1u); break; } } } } while (0)
DI void xcd_barrier_post(unsigned* bar) { if (threadIdx.x == 0) (void)xb_add(&bar[XB_XCNT(xb_xcc_id())], 1u); }
DI void xcd_barrier_complete(unsigned* bar, unsigned x, unsigned& nloc, unsigned& nx) {
    const unsigned G = gridDim.x;
    unsigned sum, cnt, mine, sp = 0u;
    for (;;) {
        sum = 0u; cnt = 0u; mine = 0u;
#pragma unroll
        for (unsigned j = 0; j < 16; ++j) { const unsigned c = xb_ld(&bar[XB_XCNT(j)]); sum += c; cnt += (c > 0u) ? 1u : 0u; mine = (j == x) ? c : mine; }
        if (sum == G) break;
        __builtin_amdgcn_s_sleep(1);
        if ((++sp & 255u) == 0u) { if (xb_ld(&bar[XB_TMO])) break; if (sp > XB_SPIN_CAP) { atomicAdd(&bar[XB_TMO], 1u); break; } }
    }
    nloc = mine > 0u ? mine : 1u; nx = cnt > 0u ? cnt : 1u;
}
DI void xcd_barrier(unsigned* bar, volatile unsigned* st) {
    asm volatile("s_waitcnt vmcnt(0)" ::: "memory");
    __syncthreads();
    if (threadIdx.x == 0) {
        __builtin_amdgcn_s_waitcnt(0);
        const unsigned x = xb_xcc_id();
        unsigned nloc = st[0], nx = st[1];
        if (nloc == 0u) { xcd_barrier_complete(bar, x, nloc, nx); st[0] = nloc; st[1] = nx; }
        const unsigned old = xb_add(&bar[XB_XSUB(x)], 1u);
        const unsigned gen = old / nloc;
        if (old + 1u == (gen + 1u) * nloc) {
            __builtin_amdgcn_fence(__ATOMIC_RELEASE, "agent");
            asm volatile("s_waitcnt vmcnt(0)" ::: "memory");
            const unsigned og = xb_add(&bar[XB_TOP], 1u);
            const unsigned tg = og / nx;
            if (og + 1u == (tg + 1u) * nx) xb_add(&bar[XB_TOPGEN], 1u);
            else XB_SPIN(xb_ld(&bar[XB_TOPGEN]) == tg, bar);
            __builtin_amdgcn_fence(__ATOMIC_ACQUIRE, "agent");
            xb_add(&bar[XB_XGEN(x)], 1u);
            asm volatile("s_waitcnt vmcnt(0)" ::: "memory");
        } else {
            XB_SPIN(xb_ld(&bar[XB_XGEN(x)]) == gen, bar);
            __builtin_amdgcn_fence(__ATOMIC_ACQUIRE, "agent");
            asm volatile("s_waitcnt vmcnt(0)" ::: "memory");
        }
    }
    __syncthreads();
}
__global__ void __launch_bounds__(NTHREADS) mk_forward(Params p) {
    extern __shared__ __attribute__((aligned(16))) char smem[];
    typedef const Params __attribute__((address_space(4)))* KPtr;
    volatile unsigned* xst = (volatile unsigned*)(smem + LDS_BYTES);
    if (threadIdx.x < 2) xst[threadIdx.x] = 0u;
    xcd_barrier_post((unsigned*)(p.ws + WS_XBAR));
#define PHASE(k, fn) { KPtr kp = (KPtr)__builtin_amdgcn_kernarg_segment_ptr(); asm volatile("" : "+s"(kp)); fn(*(const Params*)kp, smem); \
        unsigned* xbar = (unsigned*)(((const Params*)kp)->ws + WS_XBAR); \
        if ((k) + 1 < NPHASES) xcd_barrier(xbar, xst); }
    PHASE(0, phase0) PHASE(1, phase1) PHASE(2, phase2)
    if (!USE_G8) PHASE(3, phase_halo)
    PHASE(4, phase_fir) PHASE(5, phase3) PHASE(6, phase4)
    PHASE(7, phase5) PHASE(8, phase6) PHASE(9, phase7) PHASE(10, phase8) PHASE(11, phase9) PHASE(12, phase10)
#undef PHASE
}

extern "C" void kernel_launch(void* const* d_in, const int* in_sizes, int n_in, void* d_out, int out_size, void* d_ws, size_t ws_size, hipStream_t stream) {
    static int grid_blocks = 0;
    if (grid_blocks == 0) {
        if (n_in != 35 || out_size != T_LAT * D || ws_size < WS_END || (size_t)out_size * 4 < AUX_END) {
            fprintf(stderr, "kernel_launch: unexpected shapes (n_in %d out %d ws %zu need %zu aux need %zu)\n", n_in, out_size, ws_size, (size_t)WS_END, (size_t)AUX_END);
            grid_blocks = -1; return;
        }
        int dev = 0, cus = 0, per_cu = 0;
        hipGetDevice(&dev);
        hipDeviceGetAttribute(&cus, hipDeviceAttributeMultiprocessorCount, dev);
        hipFuncSetAttribute((const void*)mk_forward, hipFuncAttributeMaxDynamicSharedMemorySize, LDS_BYTES + 256);
        hipOccupancyMaxActiveBlocksPerMultiprocessor(&per_cu, (const void*)mk_forward, NTHREADS, LDS_BYTES + 256);
        if (per_cu < 1) { fprintf(stderr, "kernel_launch: occupancy query says %d blocks/CU\n", per_cu); per_cu = 1; }
        if (per_cu > 1) per_cu = 1;
        grid_blocks = cus * per_cu;
    }
    if (grid_blocks < 0) return;
    Params p{};
    for (int i = 0; i < 35; ++i) p.in[i] = (const float*)d_in[i];
    p.out = (float*)d_out; p.ws = (char*)d_ws; p.aux = (char*)d_out;
    p.ph_lo = 0; p.ph_hi = NPHASES;
    (void)hipMemsetAsync((char*)d_ws + WS_XBAR, 0, 3456 * 4, stream);
    void* args[] = {&p};
    hipError_t e = hipLaunchCooperativeKernel((const void*)mk_forward, dim3(grid_blocks), dim3(NTHREADS), args, LDS_BYTES + 256, stream);
    if (e != hipSuccess) fprintf(stderr, "cooperative launch failed: %s (grid %d)\n", hipGetErrorString(e), grid_blocks);
}
#endif
```

```cpp
#ifndef EMU
#include <hip/hip_runtime.h>
#include <hip/hip_cooperative_groups.h>
#include <cstdio>
#endif
#include <stdint.h>
#include <stddef.h>

#ifndef CFG_D
#define CFG_D 1024
#define CFG_B 8
#define CFG_S 2048
#define CFG_CTX 256
#endif
#ifndef MK_LAUNCHES
#define MK_LAUNCHES 1
#endif

typedef unsigned short bf16_t;
typedef short bf16x8 __attribute__((ext_vector_type(8)));
typedef float f32x4 __attribute__((ext_vector_type(4)));
typedef unsigned u32x4 __attribute__((ext_vector_type(4)));
typedef unsigned u32x2 __attribute__((ext_vector_type(2)));

#define DI __device__ __forceinline__
DI int tid_x() { int t = (int)threadIdx.x;
#ifndef EMU
    asm volatile("" : "+v"(t));
#endif
    return t; }

constexpr int D = CFG_D, NB = CFG_B, S = CFG_S, CTXL = CFG_CTX;
constexpr int GW = 64, ROWS = S / GW;
constexpr int T_CTX = NB * CTXL, T_LAT = NB * S, T_ALL = T_CTX + T_LAT;
constexpr int H_A = 4, H_B = 8;
constexpr int A_COLS = 2064, B_COLS = 1920;
constexpr int IN_COLS = A_COLS + B_COLS + 2 * D;
constexpr int COL_B0 = A_COLS, COL_G0 = A_COLS + B_COLS;
constexpr int CTX_COLS = COL_G0;
constexpr int NP = ((IN_COLS + 127) / 128) * 128;
constexpr int NEXP = 32, DE = 256;
constexpr int NV = NB + 1;
constexpr int NTHREADS = 512;
constexpr int MREP = (T_CTX % 256 == 0 && T_LAT % 256 == 0) ? 4 : 2;
constexpr int BM = 64 * MREP;
constexpr int NPHASES = 13;
enum { PH_MOD = 0, PH_U, PH_P, PH_HALO, PH_FIR, PH_CHAINS, PH_POST, PH_MERGE, PH_WOUT, PH_ROUTER, PH_UP, PH_DOWN, PH_FINAL };
constexpr int LDS_BYTES = 155648;
constexpr int CAP = T_LAT;

static_assert(D % 256 == 0 && S % 64 == 0 && CTXL % 64 == 0 && T_CTX % BM == 0 && T_LAT % BM == 0, "shape");

constexpr size_t al256(size_t x) { return (x + 255) & ~(size_t)255; }
constexpr int CNT_STRIDE = 64;
constexpr size_t WS_CNT = 512 + 3456 * 4 + 256;
constexpr int CNT_TICKET = 2 * CNT_STRIDE + 16, CNT_U2DONE = 3 * CNT_STRIDE + 16;
constexpr size_t WS_BAR = 256;
constexpr size_t WS_XBAR = 512;
constexpr size_t WS_MOD = 512 + 3456 * 4 + 256 + 32 * 64 * 4;
constexpr size_t WS_AB = al256(WS_MOD + (size_t)NV * 6 * D * 4);
constexpr size_t WS_BONUS = al256(WS_AB + (size_t)T_ALL * 16 * 4);
constexpr size_t WS_PAIRW = al256(WS_BONUS + (size_t)2 * T_LAT * 8 * 4);
constexpr size_t WS_ROWLIST = al256(WS_PAIRW + (size_t)T_LAT * 2 * 4);
constexpr size_t WS_WRT = al256(WS_ROWLIST + (size_t)NEXP * CAP * 4);
constexpr size_t WS_G2T = al256(WS_WRT + (size_t)36 * D * 4);
constexpr size_t WS_WOA = al256(WS_G2T + (size_t)512 * 128 * 2);
constexpr size_t WS_WOB = al256(WS_WOA + (size_t)D * 512 * 2);
constexpr size_t WS_WOUT = al256(WS_WOB + (size_t)D * 512 * 2);
constexpr size_t WS_OA = al256(WS_WOUT + (size_t)D * D * 2);
constexpr size_t WS_OB = al256(WS_OA + (size_t)T_LAT * 512 * 2);
constexpr size_t WS_HALO_A = WS_OA;
constexpr size_t WS_HALO_B = WS_OA + al256((size_t)(T_ALL / 64) * 4 * 1536 * 2);
static_assert(WS_HALO_B + (size_t)(T_ALL / 64) * 2 * 1920 * 2 <= WS_OB + (size_t)T_LAT * 512 * 2, "halo buffers");
constexpr size_t WS_DNT = WS_OA;
constexpr size_t WS_SPARE_END = al256(WS_OB + (size_t)T_LAT * 512 * 2) > al256(WS_DNT + (size_t)NEXP * D * DE * 2) ? al256(WS_OB + (size_t)T_LAT * 512 * 2) : al256(WS_DNT + (size_t)NEXP * D * DE * 2);
constexpr size_t WS_P = WS_SPARE_END;
constexpr size_t WS_PLAT = WS_P;
constexpr size_t WS_PCTX = al256(WS_PLAT + (size_t)T_LAT * IN_COLS * 2);
constexpr size_t WS_P_END = al256(WS_PCTX + (size_t)T_CTX * CTX_COLS * 2);
constexpr size_t WS_H = WS_P;
constexpr size_t WS_T = al256(WS_H + (size_t)T_LAT * D * 4);
constexpr size_t WS_HID = al256(WS_T + (size_t)T_LAT * D * 2);
constexpr size_t WS_OPAIR = al256(WS_HID + (size_t)T_LAT * 2 * DE * 2);
constexpr size_t WS_P2_END = al256(WS_OPAIR + (size_t)T_LAT * 2 * D * 2);
constexpr size_t WS_END0 = WS_P_END > WS_P2_END ? WS_P_END : WS_P2_END;
constexpr size_t WS_GUARANTEED = (size_t)256 << 20;
constexpr int NE_EARLY = WS_END0 >= WS_GUARANTEED ? 0 : ((WS_GUARANTEED - WS_END0) / ((size_t)D * DE * 2) >= (size_t)NEXP ? NEXP : (int)((WS_GUARANTEED - WS_END0) / ((size_t)D * DE * 2)));
constexpr size_t WS_DNT2 = WS_END0;
constexpr size_t WS_END = WS_DNT2 + (size_t)NE_EARLY * D * DE * 2;
constexpr size_t AUX_WINT = 0;
constexpr size_t AUX_U = al256((size_t)NP * D * 2);
constexpr size_t AUX_YDIR = 0;
constexpr size_t AUX_Y = 0;
constexpr size_t AUX_GUT = (size_t)T_LAT * D * 2 > (size_t)2 * T_LAT * 512 * 2 ? (size_t)T_LAT * D * 2 : (size_t)2 * T_LAT * 512 * 2;
constexpr size_t AUX_END1 = AUX_U + (size_t)T_ALL * D * 2;
constexpr size_t AUX_END2 = AUX_YDIR + (size_t)2 * T_LAT * 512 * 2;
static_assert(AUX_YDIR + (size_t)2 * T_LAT * 512 * 2 <= AUX_GUT && AUX_Y + (size_t)T_LAT * D * 2 <= AUX_GUT, "aux overlap");
constexpr size_t AUX_END3 = AUX_GUT + (size_t)NEXP * 512 * D * 2;
constexpr size_t AUX_END = (AUX_END1 > AUX_END2 ? (AUX_END1 > AUX_END3 ? AUX_END1 : AUX_END3) : (AUX_END2 > AUX_END3 ? AUX_END2 : AUX_END3));

#define DNT_PTR(ws, e) ((bf16_t*)((ws) + ((e) < NE_EARLY ? WS_DNT2 : WS_DNT)) + (size_t)(e) * D * DE)
struct Params {
    const float* in[35];
    float* out;
    char* ws;
    char* aux;
    int ph_lo, ph_hi;
};
enum { I_X = 0, I_C, I_CTX, I_CCTX, I_ADAW, I_ADAB, I_NMIX, I_NFFN, I_WIN, I_CONV, I_ALOG, I_DTB, I_ONORM, I_MU, I_W0, I_W2, I_A0, I_A2, I_G2, I_KK, I_KA, I_RK, I_LNG, I_LNB, I_WOA, I_WOB, I_WOUT, I_RG, I_RGB, I_RE, I_REB, I_MG, I_MU_UP, I_MD, I_FIN };

DI float bf2f(bf16_t v) { union { unsigned u; float f; } x; x.u = ((unsigned)v) << 16; return x.f; }
#ifdef EMU
DI bf16_t f2bf(float f) { union { float f; unsigned u; } x; x.f = f; unsigned u = x.u; u += 0x7fffu + ((u >> 16) & 1u); return (bf16_t)(u >> 16); }
DI unsigned pk2(float lo, float hi) { return (unsigned)f2bf(lo) | ((unsigned)f2bf(hi) << 16); }
#else
typedef __bf16 hbf16x2 __attribute__((ext_vector_type(2)));
typedef float f32x2_ __attribute__((ext_vector_type(2)));
DI bf16_t f2bf(float f) { return __builtin_bit_cast(unsigned short, (__bf16)f); }
DI unsigned pk2(float lo, float hi) { const f32x2_ v = {lo, hi}; return __builtin_bit_cast(unsigned, __builtin_convertvector(v, hbf16x2)); }
#endif
DI float sigmoidf_(float x) { return 1.0f / (1.0f + expf(-x)); }
DI float siluf_(float x) { return x / (1.0f + expf(-x)); }
DI float softplusf_(float x) { return x > 20.f ? x : log1pf(expf(x)); }
DI float wave_sum(float v) {
#pragma unroll
    for (int o = 1; o < 64; o <<= 1) v += __shfl_xor(v, o);
    return v;
}
#ifdef EMU
#define MFMA16(a, b, c) emu_mfma16((a), (b), (c))
#define WAVE_SYNC() emu::wave_bar()
#else
#define MFMA16(a, b, c) __builtin_amdgcn_mfma_f32_16x16x32_bf16((a), (b), (c), 0, 0, 0)
#define WAVE_SYNC() asm volatile("s_waitcnt lgkmcnt(0)" ::: "memory")
#endif
#ifdef EMU
#define LDS_BARRIER() __syncthreads()
#else
#define LDS_BARRIER() do { asm volatile("s_waitcnt lgkmcnt(0)" ::: "memory"); __builtin_amdgcn_s_barrier(); asm volatile("" ::: "memory"); } while (0)
#endif

typedef float f32x16 __attribute__((ext_vector_type(16)));
typedef float f32x2_ac __attribute__((ext_vector_type(2)));
typedef short bf16x4 __attribute__((ext_vector_type(4)));
#ifdef EMU
#define MFMA32(a, b, c) emu_mfma32((a), (b), (c))
DI float fexp(float x) { return expf(x); }
DI float flog(float x) { return logf(x); }
DI float frcp(float x) { return 1.0f / x; }
DI float frsq(float x) { return 1.0f / sqrtf(x); }
DI float wave_sum_fast(float v) { return wave_sum(v); }
#else
#define MFMA32(a, b, c) __builtin_amdgcn_mfma_f32_32x32x16_bf16((a), (b), (c), 0, 0, 0)
DI float fexp(float x) { return __expf(x); }
DI float flog(float x) { return __logf(x); }
DI float frcp(float x) { return __builtin_amdgcn_rcpf(x); }
DI float frsq(float x) { return __builtin_amdgcn_rsqf(x); }
#define DPP_ADD(v, ctrl) ((v) + __builtin_bit_cast(float, __builtin_amdgcn_update_dpp(0, __builtin_bit_cast(int, (v)), (ctrl), 0xf, 0xf, false)))
DI float wave_sum_fast(float v) {
    v = DPP_ADD(v, 0xB1); v = DPP_ADD(v, 0x4E); v = DPP_ADD(v, 0x141); v = DPP_ADD(v, 0x140);
    const int iv = __builtin_bit_cast(int, v);
    return (__builtin_bit_cast(float, __builtin_amdgcn_readlane(iv, 0)) + __builtin_bit_cast(float, __builtin_amdgcn_readlane(iv, 16))) +
           (__builtin_bit_cast(float, __builtin_amdgcn_readlane(iv, 32)) + __builtin_bit_cast(float, __builtin_amdgcn_readlane(iv, 48)));
}
#endif
DI float fsigmoid(float x) { return frcp(1.0f + fexp(-x)); }
DI float fsilu(float x) { return x * fsigmoid(x); }
DI float fsoftplus(float x) { return fmaxf(x, 0.f) + flog(1.f + fexp(-fabsf(x))); }
DI float ftanh(float x) { return 1.0f - 2.0f * frcp(1.0f + fexp(2.0f * x)); }

constexpr int LDS_ROW = 40;
constexpr int GEMM_A_BYTES = BM * LDS_ROW * 2, GEMM_B_BYTES = 128 * LDS_ROW * 2;
template <int MR, class ARow>
DI void gemm_kloop(f32x4 (&acc)[MR][4], char* smem, ARow arow, const bf16_t* Bt, int ldb, int K) {
    constexpr int BM = 64 * MR;
    const int tid = tid_x(), lane = tid & 63, wave = tid >> 6, wr = wave >> 1, wc = wave & 1, fr = lane & 15, fq = lane >> 4;
    bf16_t* As = (bf16_t*)smem;
    bf16_t* Bs = (bf16_t*)(smem + 2 * GEMM_A_BYTES);
    constexpr int ACH = BM * 4 / NTHREADS;
    static_assert(ACH >= 1, "tile");
    const bf16_t* ap[ACH];
#pragma unroll
    for (int i = 0; i < ACH; ++i) { const int q = tid + i * NTHREADS; ap[i] = arow(q >> 2) + (q & 3) * 8; }
    const bf16_t* bp = Bt + (size_t)(tid >> 2) * ldb + (tid & 3) * 8;
    u32x4 ra[ACH], rb;
#pragma unroll
    for (int i = 0; i < ACH; ++i) ra[i] = *(const u32x4*)(ap[i]);
    rb = *(const u32x4*)(bp);
    const int nk = K / 32;
    for (int kt = 0; kt < nk; ++kt) {
        const int buf = kt & 1;
#pragma unroll
        for (int i = 0; i < ACH; ++i) { const int q = tid + i * NTHREADS; *(u32x4*)(As + (buf * BM + (q >> 2)) * LDS_ROW + (q & 3) * 8) = ra[i]; }
        *(u32x4*)(Bs + (buf * 128 + (tid >> 2)) * LDS_ROW + (tid & 3) * 8) = rb;
        __syncthreads();
        if (kt + 1 < nk) {
#pragma unroll
            for (int i = 0; i < ACH; ++i) ra[i] = *(const u32x4*)(ap[i] + (kt + 1) * 32);
            rb = *(const u32x4*)(bp + (kt + 1) * 32);
        }
        bf16x8 af[MR], bfr[4];
#pragma unroll
        for (int m = 0; m < MR; ++m) af[m] = *(const bf16x8*)(As + (buf * BM + wr * 16 * MR + m * 16 + fr) * LDS_ROW + fq * 8);
#pragma unroll
        for (int n = 0; n < 4; ++n) bfr[n] = *(const bf16x8*)(Bs + (buf * 128 + wc * 64 + n * 16 + fr) * LDS_ROW + fq * 8);
#pragma unroll
        for (int m = 0; m < MR; ++m)
#pragma unroll
            for (int n = 0; n < 4; ++n) acc[m][n] = MFMA16(af[m], bfr[n], acc[m][n]);
    }
    __syncthreads();
}
template <int MR>
DI void acc_zero(f32x4 (&acc)[MR][4]) {
#pragma unroll
    for (int m = 0; m < MR; ++m)
#pragma unroll
        for (int n = 0; n < 4; ++n) acc[m][n] = (f32x4){0.f, 0.f, 0.f, 0.f};
}

namespace g8 {
constexpr int BM = 256, BK = 64, HALF = 128, HT = HALF * BK;
constexpr int LDS_NEED = 8 * HT * 2;
DI int lds_byte(int r, int c) { const int st = (r >> 4) * 2 + (c >> 5), rr = r & 15, cc = c & 31, ob = rr * 64 + cc * 2; return st * 1024 + (ob ^ (((ob >> 9) & 1) << 5)); }
DI void stage_rc(int b, int& R, int& C) { const int st = b / 1024, sb = b % 1024, swz = sb ^ (((sb >> 9) & 1) << 5); R = (st >> 1) * 16 + swz / 64; C = (st & 1) * 32 + (swz % 64) / 2; }
#ifdef EMU
#define G8_GLDS(src, dst) emu_global_load_lds16((src), (dst))
#define G8_WAIT_V(n)
#define G8_WAIT_L(n)
#define G8_BAR __syncthreads()
#define G8_SCHED
#define G8_PRIO(x)
#else
#define G8_GLDS(src, dst) __builtin_amdgcn_global_load_lds((const unsigned*)(src), (__attribute__((address_space(3))) unsigned*)(dst), 16, 0, 0)
#define G8_WAIT_V(n) asm volatile("s_waitcnt vmcnt(" #n ")" ::: "memory")
#define G8_WAIT_L(n) asm volatile("s_waitcnt lgkmcnt(" #n ")" ::: "memory")
#define G8_BAR __builtin_amdgcn_s_barrier()
#define G8_SCHED __builtin_amdgcn_sched_barrier(0)
#define G8_PRIO(x) __builtin_amdgcn_s_setprio(x)
#endif
typedef f32x4 Acc[2][2][4][2];
template <class AOff>
DI void kloop_g(Acc& acc, char* smem, const bf16_t* A, AOff aoff, const bf16_t* Bt, int ldb, int K, int bcol) {
    bf16_t* shm = (bf16_t*)smem;
    const int tid = tid_x(), wid = tid >> 6, lane = tid & 63, wr = wid >> 2, wc = wid & 3, fr = lane & 15, fq = lane >> 4;
    int ao[2][2];
#pragma unroll
    for (int h = 0; h < 2; ++h)
#pragma unroll
        for (int i = 0; i < 2; ++i) { int R, C; stage_rc(tid * 16 + i * 8192, R, C); ao[h][i] = aoff(h * HALF + R) + C; }
#define G8_STAGE_A(P, h, kt) do { for (int _i = 0; _i < 2; ++_i) { const int _b = tid * 16 + _i * 8192; G8_GLDS(A + (size_t)ao[h][_i] + (size_t)(kt) * BK, (char*)(P) + _b); } } while (0)
#define G8_SA(b, h) (shm + ((b) * 2 + (h)) * HT)
#define G8_SB(b, h) (shm + (4 + (b) * 2 + (h)) * HT)
#define G8_STAGE(P, BASE, LD, br, kt) do { const bf16_t* _g = (BASE) + (size_t)(br) * (LD) + (size_t)(kt) * BK; \
    for (int _i = 0; _i < 2; ++_i) { const int _b = tid * 16 + _i * 8192; int _r, _c; stage_rc(_b, _r, _c); G8_GLDS(_g + (size_t)_r * (LD) + _c, (char*)(P) + _b); } } while (0)
#define G8_LDA(dst, b, h) for (int m = 0; m < 4; ++m) for (int k = 0; k < 2; ++k) dst[m][k] = *(const bf16x8*)((const char*)G8_SA(b, h) + lds_byte(wr * 64 + m * 16 + fr, k * 32 + fq * 8))
#define G8_LDB(dst, b, h) for (int n = 0; n < 2; ++n) for (int k = 0; k < 2; ++k) dst[n][k] = *(const bf16x8*)((const char*)G8_SB(b, h) + lds_byte(wc * 32 + n * 16 + fr, k * 32 + fq * 8))
#define G8_MMA(ai, bj, At_, Bt_) do { G8_PRIO(1); for (int m = 0; m < 4; ++m) for (int n = 0; n < 2; ++n) for (int k = 0; k < 2; ++k) \
    acc[ai][bj][m][n] = MFMA16(Bt_[n][k], At_[m][k], acc[ai][bj][m][n]); G8_PRIO(0); } while (0)
    bf16x8 At[4][2], B0[2][2], B1[2][2];
    const int nt = K / BK;
    G8_STAGE(G8_SB(0, 0), Bt, ldb, bcol, 0); G8_STAGE_A(G8_SA(0, 0), 0, 0);
    G8_STAGE(G8_SB(0, 1), Bt, ldb, bcol + HALF, 0); G8_STAGE_A(G8_SA(0, 1), 1, 0);
    if (wr == 1) G8_BAR;
    G8_WAIT_V(4); G8_BAR;
    G8_STAGE(G8_SB(1, 0), Bt, ldb, bcol, 1); G8_STAGE_A(G8_SA(1, 0), 0, 1); G8_STAGE(G8_SB(1, 1), Bt, ldb, bcol + HALF, 1);
    G8_WAIT_V(6); G8_BAR;
    for (int t = 0; t < nt - 2; t += 2) {
        G8_LDB(B0, 0, 0); G8_SCHED; G8_LDA(At, 0, 0); G8_STAGE_A(G8_SA(1, 1), 1, t + 1);
        G8_WAIT_L(8); G8_BAR; G8_WAIT_L(0); G8_MMA(0, 0, At, B0); G8_BAR; G8_SCHED;
        G8_LDB(B1, 0, 1); G8_STAGE(G8_SB(0, 0), Bt, ldb, bcol, t + 2);
        G8_BAR; G8_WAIT_L(0); G8_MMA(0, 1, At, B1); G8_BAR;
        G8_LDA(At, 0, 1); G8_STAGE_A(G8_SA(0, 0), 0, t + 2);
        G8_BAR; G8_WAIT_L(0); G8_MMA(1, 0, At, B0); G8_BAR; G8_SCHED;
        G8_STAGE(G8_SB(0, 1), Bt, ldb, bcol + HALF, t + 2);
        G8_WAIT_V(6); G8_BAR; G8_MMA(1, 1, At, B1); G8_BAR;
        G8_LDB(B0, 1, 0); G8_SCHED; G8_LDA(At, 1, 0); G8_STAGE_A(G8_SA(0, 1), 1, t + 2);
        G8_WAIT_L(8); G8_BAR; G8_WAIT_L(0); G8_MMA(0, 0, At, B0); G8_BAR; G8_SCHED;
        G8_LDB(B1, 1, 1); G8_STAGE(G8_SB(1, 0), Bt, ldb, bcol, t + 3);
        G8_BAR; G8_WAIT_L(0); G8_MMA(0, 1, At, B1); G8_BAR;
        G8_LDA(At, 1, 1); G8_STAGE_A(G8_SA(1, 0), 0, t + 3);
        G8_BAR; G8_WAIT_L(0); G8_MMA(1, 0, At, B0); G8_BAR; G8_SCHED;
        G8_STAGE(G8_SB(1, 1), Bt, ldb, bcol + HALF, t + 3);
        G8_WAIT_V(6); G8_BAR; G8_MMA(1, 1, At, B1); G8_BAR;
    }
    { G8_LDB(B0, 0, 0); G8_LDA(At, 0, 0); G8_STAGE_A(G8_SA(1, 1), 1, nt - 1);
      G8_BAR; G8_WAIT_L(0); G8_MMA(0, 0, At, B0); G8_BAR;
      G8_LDB(B1, 0, 1); G8_BAR; G8_WAIT_L(0); G8_MMA(0, 1, At, B1); G8_BAR;
      G8_LDA(At, 0, 1); G8_WAIT_V(4); G8_BAR; G8_WAIT_L(0); G8_MMA(1, 0, At, B0); G8_MMA(1, 1, At, B1); G8_BAR; }
    { G8_LDB(B0, 1, 0); G8_LDA(At, 1, 0); G8_WAIT_V(2); G8_BAR; G8_WAIT_L(0); G8_MMA(0, 0, At, B0); G8_BAR;
      G8_LDB(B1, 1, 1); G8_WAIT_V(0); G8_BAR; G8_WAIT_L(0); G8_MMA(0, 1, At, B1); G8_BAR;
      G8_LDA(At, 1, 1); G8_BAR; G8_WAIT_L(0); G8_MMA(1, 0, At, B0); G8_MMA(1, 1, At, B1); G8_BAR; }
    if (wr == 0) G8_BAR;
#undef G8_SA
#undef G8_SB
#undef G8_STAGE
#undef G8_STAGE_A
#undef G8_LDA
#undef G8_LDB
#undef G8_MMA
}
DI void kloop(Acc& acc, char* smem, const bf16_t* A, int lda, const bf16_t* Bt, int ldb, int K, int brow, int bcol) {
    kloop_g(acc, smem, A, [&](int r) { return (brow + r) * lda; }, Bt, ldb, K, bcol);
}
DI bool tile_order(int L, int nM, int nN, int& pm, int& pn) {
    constexpr int NXCD = 8, WGM = 8;
    const int nwg = nM * nN; if (L >= nwg) return false;
    int wgid = L; { const int q = nwg / NXCD, r = nwg % NXCD, xcd = wgid % NXCD, off = wgid / NXCD; wgid = (xcd < r ? xcd * (q + 1) : r * (q + 1) + (xcd - r) * q) + off; }
    const int nig = WGM * nN, gid = wgid / nig, fm = gid * WGM, gsz = (nM - fm) < WGM ? (nM - fm) : WGM;
    pm = fm + ((wgid % nig) % gsz); pn = (wgid % nig) / gsz; return true;
}
DI void acc_zero(Acc& acc) {
#pragma unroll
    for (int a = 0; a < 2; ++a)
#pragma unroll
        for (int b = 0; b < 2; ++b)
#pragma unroll
            for (int m = 0; m < 4; ++m)
#pragma unroll
                for (int n = 0; n < 2; ++n) acc[a][b][m][n] = (f32x4){0.f, 0.f, 0.f, 0.f};
}
template <class F> DI void for_each_quad(const Acc& acc, int brow, int bcol, F f) {
    const int tid = tid_x(), wid = tid >> 6, lane = tid & 63, wr = wid >> 2, wc = wid & 3, fr = lane & 15, fq = lane >> 4;
#pragma unroll
    for (int ai = 0; ai < 2; ++ai)
#pragma unroll
        for (int m = 0; m < 4; ++m)
#pragma unroll
            for (int bj = 0; bj < 2; ++bj)
#pragma unroll
                for (int n = 0; n < 2; ++n) f(brow + ai * HALF + wr * 64 + m * 16 + fr, bcol + bj * HALF + wc * 32 + n * 16 + fq * 4, acc[ai][bj][m][n]);
}
}

constexpr bool USE_G8 = ((NB * CTXL) % 256 == 0) && ((NB * S) % 256 == 0) && (NP % 256 == 0) && (D % 256 == 0) && (D >= 256);
DI int gu_row(int c, int up) {
    if (USE_G8) return (c >> 7) * 256 + ((c >> 6) & 1) * 128 + ((c >> 4) & 3) * 32 + (up ? 16 : 0) + (c & 15);
    return (c >> 6) * 128 + ((c >> 5) & 1) * 64 + ((c >> 4) & 1) * 16 + (c & 15) + (up ? 32 : 0);
}
DI void transpose_item(const float* W, int N, int Nvalid, int k0, int n0, bf16_t* WT, int ldt, int mode, float* scr, int lane) {
    float tv[32];
#pragma unroll
    for (int i = 0; i < 32; ++i) {
        const int kk = 2 * i + (lane >> 5), n = n0 + (lane & 31);
        tv[i] = (n < Nvalid) ? W[(size_t)(k0 + kk) * N + n] : 0.f;
    }
#pragma unroll
    for (int i = 0; i < 32; ++i) scr[(2 * i + (lane >> 5)) * 33 + (lane & 31)] = tv[i];
    WAVE_SYNC();
    const int c = lane & 7;
#pragma unroll
    for (int j = 0; j < 4; ++j) {
        const int nl = (lane >> 3) + 8 * j; const float* s = scr + (8 * c) * 33 + nl;
        u32x4 o; o.x = pk2(s[0], s[33]); o.y = pk2(s[2 * 33], s[3 * 33]); o.z = pk2(s[4 * 33], s[5 * 33]); o.w = pk2(s[6 * 33], s[7 * 33]);
        const int n = n0 + nl; const int row = mode == 0 ? n : gu_row(n, mode == 2);
        *(u32x4*)(WT + (size_t)row * ldt + k0 + 8 * c) = o;
    }
    WAVE_SYNC();
}
DI void transpose_matrix(const float* W, int K, int N, int Npad, bf16_t* WT, int mode, char* smem, int gw, int ngw, int& base) {
    const int lane = tid_x() & 63, wave = tid_x() >> 6;
    float* scr = (float*)smem + wave * (64 * 33);
    const int nkb = K / 64, nnb = Npad / 32, nitems = nkb * nnb;
    int first = ((gw - base) % ngw + ngw) % ngw;
    for (int it = first; it < nitems; it += ngw) {
        const int kb = it / nnb, nb = it % nnb;
        transpose_item(W, N, N, kb * 64, nb * 32, WT, K, mode, scr, lane);
    }
    base = (base + nitems) % ngw;
}

DI void phase0(const Params& p, char* smem) {
    const int tid = tid_x(), lane = tid & 63, wave = tid >> 6;
    if (blockIdx.x == 0 && tid < NEXP) ((int*)(p.ws + WS_CNT))[tid * CNT_STRIDE] = 0;
    if (blockIdx.x == 0 && tid < 2) ((int*)(p.ws + WS_CNT))[tid ? CNT_U2DONE : CNT_TICKET] = 0;
    if (blockIdx.x == 0 && tid == 0) *(unsigned*)(p.ws + WS_BAR) = 0u;
    float* sil = (float*)smem;
    float* red = sil + NV * D;
    const int nitems = 6 * D / 32;
    bool did = false;
    for (int it = blockIdx.x; it < nitems; it += gridDim.x) {
        if (!did) {
            for (int i = tid; i < NV * D; i += NTHREADS) { const int v = i / D, k = i % D; const float cv = v < NB ? p.in[I_C][v * D + k] : p.in[I_CCTX][k]; sil[i] = siluf_(cv); }
            did = true;
        }
        __syncthreads();
        const int col = it * 32 + (lane & 31), rp = lane >> 5;
        float acc[NV];
#pragma unroll
        for (int v = 0; v < NV; ++v) acc[v] = 0.f;
        const int r0 = wave * (D / 8);
        float wv[D / 16];
#pragma unroll
        for (int i = 0; i < D / 16; ++i) wv[i] = p.in[I_ADAW][(size_t)(r0 + 2 * i + rp) * (6 * D) + col];
#pragma unroll
        for (int i = 0; i < D / 16; ++i) {
            const int row = r0 + 2 * i + rp;
#pragma unroll
            for (int v = 0; v < NV; ++v) acc[v] += sil[v * D + row] * wv[i];
        }
#pragma unroll
        for (int v = 0; v < NV; ++v) red[((wave * 2 + rp) * NV + v) * 32 + (lane & 31)] = acc[v];
        __syncthreads();
        if (tid < NV * 32) {
            const int v = tid / 32, cl = tid % 32; float s = p.in[I_ADAB][it * 32 + cl];
            for (int g = 0; g < 16; ++g) s += red[(g * NV + v) * 32 + cl];
            ((float*)(p.ws + WS_MOD))[(size_t)v * 6 * D + it * 32 + cl] = s;
        }
    }
    __syncthreads();
    const int gw = blockIdx.x * 8 + wave, ngw = gridDim.x * 8; int base = 0;
    {
        float* scr = (float*)smem + wave * (64 * 33);
        const int nkb = D / 64, nnb = NP / 32, nitems2 = nkb * nnb;
        for (int it = gw; it < nitems2; it += ngw) { const int kb = it / nnb, nb = it % nnb; transpose_item(p.in[I_WIN], IN_COLS, IN_COLS, kb * 64, nb * 32, (bf16_t*)(p.aux + AUX_WINT), D, 0, scr, lane); }
        base = nitems2 % ngw;
    }
    { float* WRT = (float*)(p.ws + WS_WRT);
      for (int i = blockIdx.x * NTHREADS + tid; i < 36 * D; i += gridDim.x * NTHREADS) { const int j = i / D, k = i % D; WRT[i] = j < 4 ? p.in[I_RG][(size_t)k * 4 + j] : p.in[I_RE][(size_t)k * 32 + (j - 4)]; } }
    transpose_matrix(p.in[I_WOA], 512, D, D, (bf16_t*)(p.ws + WS_WOA), 0, smem, gw, ngw, base);
    transpose_matrix(p.in[I_WOB], 512, D, D, (bf16_t*)(p.ws + WS_WOB), 0, smem, gw, ngw, base);
    transpose_matrix(p.in[I_WOUT], D, D, D, (bf16_t*)(p.ws + WS_WOUT), 0, smem, gw, ngw, base);
    transpose_matrix(p.in[I_G2], 128, 512, 512, (bf16_t*)(p.ws + WS_G2T), 0, smem, gw, ngw, base);
}

constexpr int NSEG = T_ALL / 64, NSEG_CTX = T_CTX / 64;
DI void halo_store(const Params& p, int row, int col, const u32x2& o) {
    int seq, b, j;
    if (row < T_CTX) { seq = 0; b = row / CTXL; j = row % CTXL; } else { seq = 1; const int rr = row - T_CTX; b = rr / S; j = rr % S; }
    const int L = seq ? S : CTXL; const int segbase = seq ? NSEG_CTX + b * (S / 64) : b * (CTXL / 64);
    if (col < 1536) {
        const int jm = j & 63;
        if (jm >= 62 && j + 2 < L) { const int g = segbase + (j >> 6) + 1; *(u32x2*)((bf16_t*)(p.ws + WS_HALO_A) + ((size_t)g * 4 + (jm - 62)) * 1536 + col) = o; }
        if (jm < 2 && j >= 64) { const int g = segbase + (j >> 6) - 1; *(u32x2*)((bf16_t*)(p.ws + WS_HALO_A) + ((size_t)g * 4 + 2 + jm) * 1536 + col) = o; }
    } else if (col >= COL_B0 && col < COL_B0 + 1920) {
        const int js = seq ? (j % GW) * ROWS + j / GW : j; const int jm = js & 63;
        if (jm == 63 && js + 1 < L) { const int g = segbase + (js >> 6) + 1; *(u32x2*)((bf16_t*)(p.ws + WS_HALO_B) + ((size_t)g * 2 + 0) * 1920 + (col - COL_B0)) = o; }
        if (jm == 0 && js >= 64) { const int g = segbase + (js >> 6) - 1; *(u32x2*)((bf16_t*)(p.ws + WS_HALO_B) + ((size_t)g * 2 + 1) * 1920 + (col - COL_B0)) = o; }
    }
}
DI void halo_zero_fill(const Params& p) {
    const int tid = tid_x(), lane = tid & 63, wave = tid >> 6; const int gw = blockIdx.x * 8 + wave, ngw = gridDim.x * 8;
    bf16_t* HA = (bf16_t*)(p.ws + WS_HALO_A); bf16_t* HB = (bf16_t*)(p.ws + WS_HALO_B);
    for (int it = gw; it < NSEG * 2; it += ngw) {
        const int g = it >> 1, side = it & 1;
        const bool ctx = g < NSEG_CTX; const int sg = ctx ? g % (CTXL / 64) : (g - NSEG_CTX) % (S / 64); const int nsg = ctx ? CTXL / 64 : S / 64;
        const bool edge = side ? (sg == nsg - 1) : (sg == 0);
        if (!edge) continue;
        for (int c = lane; c < 384; c += 64) *(u32x4*)(HA + ((size_t)g * 4 + 2 * side) * 1536 + c * 8) = (u32x4){0u, 0u, 0u, 0u};
        for (int c = lane; c < 240; c += 64) *(u32x4*)(HB + ((size_t)g * 2 + side) * 1920 + c * 8) = (u32x4){0u, 0u, 0u, 0u};
    }
}
DI void phase1(const Params& p, char* smem) {
    if (USE_G8) halo_zero_fill(p);
    const int lane = tid_x() & 63, wave = tid_x() >> 6;
    const int gw = blockIdx.x * 8 + wave, ngw = gridDim.x * 8;
    const float* mod = (const float*)(p.ws + WS_MOD);
    bf16_t* U = (bf16_t*)(p.aux + AUX_U);
    auto rowsrc = [&](int r) -> const float* { return r < T_CTX ? p.in[I_CTX] + (size_t)r * D : p.in[I_X] + (size_t)(r - T_CTX) * D; };
    f32x4 xn[D / 256];
    if (gw < T_ALL) {
#pragma unroll
        for (int j = 0; j < D / 256; ++j) xn[j] = *(const f32x4*)(rowsrc(gw) + j * 256 + lane * 4);
    }
    for (int r = gw; r < T_ALL; r += ngw) {
        const int v = r < T_CTX ? NB : (r - T_CTX) / S;
        f32x4 x[D / 256]; float ss = 0.f;
#pragma unroll
        for (int j = 0; j < D / 256; ++j) { x[j] = xn[j]; ss += x[j].x * x[j].x + x[j].y * x[j].y + x[j].z * x[j].z + x[j].w * x[j].w; }
        if (r + ngw < T_ALL) {
#pragma unroll
            for (int j = 0; j < D / 256; ++j) xn[j] = *(const f32x4*)(rowsrc(r + ngw) + j * 256 + lane * 4);
        }
        ss = wave_sum_fast(ss);
        const float rstd = frsq(ss * (1.0f / D) + 1e-6f);
#pragma unroll
        for (int j = 0; j < D / 256; ++j) {
            const int k = j * 256 + lane * 4;
            const f32x4 g = *(const f32x4*)(p.in[I_NMIX] + k), sh = *(const f32x4*)(mod + (size_t)v * 6 * D + k), sc = *(const f32x4*)(mod + (size_t)v * 6 * D + D + k);
            float o0 = x[j].x * rstd * g.x * (1.f + sc.x) + sh.x, o1 = x[j].y * rstd * g.y * (1.f + sc.y) + sh.y;
            float o2 = x[j].z * rstd * g.z * (1.f + sc.z) + sh.z, o3 = x[j].w * rstd * g.w * (1.f + sc.w) + sh.w;
            u32x2 o; o.x = pk2(o0, o1); o.y = pk2(o2, o3);
            *(u32x2*)(U + (size_t)r * D + k) = o;
        }
    }
}

DI void phase2(const Params& p, char* smem) {
    const bf16_t* U = (const bf16_t*)(p.aux + AUX_U); const bf16_t* WT = (const bf16_t*)(p.aux + AUX_WINT);
    bf16_t* PL = (bf16_t*)(p.ws + WS_PLAT); bf16_t* PC = (bf16_t*)(p.ws + WS_PCTX); float* AB = (float*)(p.ws + WS_AB);
    if (USE_G8) {
        constexpr int NT = NP / 256, MT = T_ALL / 256, NT_CTX = (CTX_COLS + 255) / 256;
        for (int t = blockIdx.x; t < MT * NT; t += gridDim.x) {
            int mt, nt; if (!g8::tile_order(t, MT, NT, mt, nt)) break;
            const int brow = mt * 256, bcol = nt * 256; const bool isctx = brow < T_CTX;
            if (isctx && nt >= NT_CTX) continue;
            g8::Acc acc; g8::acc_zero(acc);
            g8::kloop(acc, smem, U, D, WT, D, D, brow, bcol);
            constexpr int OLD_ = 264; bf16_t* OT = (bf16_t*)smem;
            g8::for_each_quad(acc, brow, bcol, [&](int row, int col, const f32x4& v) {
                u32x2 o; o.x = pk2(v.x, v.y); o.y = pk2(v.z, v.w);
                *(u32x2*)(OT + (row - brow) * OLD_ + (col - bcol)) = o;
                if (col >= 2048 && col < 2064) *(f32x4*)(AB + (size_t)row * 16 + (col - 2048)) = v;
                halo_store(p, row, col, o);
            });
            __syncthreads();
            {
                const int tid = tid_x(); const int ncols = isctx ? CTX_COLS : IN_COLS;
                bf16_t* dst = isctx ? PC + (size_t)brow * CTX_COLS : PL + (size_t)(brow - T_CTX) * IN_COLS;
#pragma unroll
                for (int i = 0; i < 16; ++i) {
                    const int ch = tid + i * NTHREADS, row = ch >> 5, c8 = (ch & 31) * 8, col = bcol + c8;
                    if (col < ncols) *(u32x4*)(dst + (size_t)row * ncols + col) = *(const u32x4*)(OT + row * OLD_ + c8);
                }
            }
            __syncthreads();
        }
        return;
    }
    const int tid = tid_x(), lane = tid & 63, wave = tid >> 6, wr = wave >> 1, wc = wave & 1, fr = lane & 15, fq = lane >> 4;
    constexpr int NT = NP / 128, MT = T_ALL / BM, NT_CTX = (CTX_COLS + 127) / 128;
    for (int t = blockIdx.x; t < MT * NT; t += gridDim.x) {
        const int mt = t / NT, nt = t % NT; const int row0 = mt * BM; const bool isctx = row0 < T_CTX;
        if (isctx && nt >= NT_CTX) continue;
        f32x4 acc[MREP][4]; acc_zero(acc);
        gemm_kloop(acc, smem, [&](int i) { return U + (size_t)(row0 + i) * D; }, WT + (size_t)nt * 128 * D, D, D);
#pragma unroll
        for (int m = 0; m < MREP; ++m)
#pragma unroll
            for (int n = 0; n < 4; ++n)
#pragma unroll
                for (int j = 0; j < 4; ++j) {
                    const int row = row0 + wr * 16 * MREP + m * 16 + fq * 4 + j, col = nt * 128 + wc * 64 + n * 16 + fr; const float v = acc[m][n][j];
                    if (isctx) { if (col < CTX_COLS) PC[(size_t)row * CTX_COLS + col] = f2bf(v); }
                    else { if (col < IN_COLS) PL[(size_t)(row - T_CTX) * IN_COLS + col] = f2bf(v); }
                    if (col >= 2048 && col < 2064) AB[(size_t)row * 16 + (col - 2048)] = v;
                }
    }
}


DI int crow(int g, int h) { return (g & 3) + 8 * (g >> 2) + 4 * h; }
template <int S_> DI bf16x8 pack_acc(const f32x16& x) {
    u32x4 r;
    r.x = pk2(x[8 * S_ + 0], x[8 * S_ + 1]); r.y = pk2(x[8 * S_ + 2], x[8 * S_ + 3]); r.z = pk2(x[8 * S_ + 4], x[8 * S_ + 5]); r.w = pk2(x[8 * S_ + 6], x[8 * S_ + 7]);
    return __builtin_bit_cast(bf16x8, r);
}
DI bf16x8 ld_nat(const bf16_t* row, int s, int h) { return *(const bf16x8*)(row + 16 * s + 8 * h); }
DI bf16x8 ld_perm(const bf16_t* row, int s, int h) {
    const bf16x4 lo = *(const bf16x4*)(row + 16 * s + 4 * h), hi = *(const bf16x4*)(row + 16 * s + 8 + 4 * h);
    return __builtin_shufflevector(lo, hi, 0, 1, 2, 3, 4, 5, 6, 7);
}
DI f32x16 zero16() { f32x16 z;
#pragma unroll
    for (int i = 0; i < 16; ++i) z[i] = 0.f;
    return z; }
#define TGET(i) ((i) < 16 ? t0[(i) & 15] : t1[(i) & 15])
DI void invert32_col(const float* Lf, f32x16& t0, f32x16& t1, int c) {
#pragma unroll
    for (int i = 0; i < 32; ++i) {
        float s0 = 0.f, s1 = 0.f, s2 = 0.f, s3 = 0.f;
#pragma unroll
        for (int j4 = 0; j4 < (i + 3) / 4; ++j4) {
            const f32x4 l = *(const f32x4*)(Lf + i * 32 + 4 * j4);
            if (4 * j4 + 0 < i) s0 += l.x * TGET(4 * j4 + 0);
            if (4 * j4 + 1 < i) s1 += l.y * TGET(4 * j4 + 1);
            if (4 * j4 + 2 < i) s2 += l.z * TGET(4 * j4 + 2);
            if (4 * j4 + 3 < i) s3 += l.w * TGET(4 * j4 + 3);
        }
        float sm = -((s0 + s1) + (s2 + s3));
#ifndef EMU
        asm volatile("" : "+v"(sm));
#endif
        const float v = (i > c) ? sm : (i == c ? 1.f : 0.f);
        if (i < 16) t0[i & 15] = v; else t1[i & 15] = v;
    }
}

DI void seg_info(int g, int& seq, int& b, int& j0) {
    if (g < NSEG_CTX) { seq = 0; b = g / (CTXL / 64); j0 = (g % (CTXL / 64)) * 64; } else { const int g2 = g - NSEG_CTX; seq = 1; b = g2 / (S / 64); j0 = (g2 % (S / 64)) * 64; }
}
DI const bf16_t* seq_row(const Params& p, int seq, int b, int j, bool scan_order) {
    if (seq) { const int l = scan_order ? (j % ROWS) * GW + j / ROWS : j; return (const bf16_t*)(p.ws + WS_PLAT) + (size_t)(b * S + l) * IN_COLS; }
    return (const bf16_t*)(p.ws + WS_PCTX) + (size_t)(b * CTXL + j) * CTX_COLS;
}
DI void phase_halo(const Params& p, char* smem) {
    if (USE_G8) return;
    const int tid = tid_x(), lane = tid & 63, wave = tid >> 6;
    const int gw = blockIdx.x * 8 + wave, ngw = gridDim.x * 8;
    bf16_t* HA = (bf16_t*)(p.ws + WS_HALO_A); bf16_t* HB = (bf16_t*)(p.ws + WS_HALO_B);
    for (int it = gw; it < NSEG * 6; it += ngw) {
        const int g = it / 6, hr = it % 6; int seq, b, j0; seg_info(g, seq, b, j0);
        const int L = seq ? S : CTXL;
        if (hr < 4) {
            const int j = hr < 2 ? j0 - 2 + hr : j0 + 62 + hr; const bool ok = j >= 0 && j < L;
            const bf16_t* src = seq_row(p, seq, b, ok ? j : 0, false);
            for (int c = lane; c < 192; c += 64) { u32x4 v = {0u, 0u, 0u, 0u}; if (ok) v = *(const u32x4*)(src + c * 8); *(u32x4*)(HA + ((size_t)g * 4 + hr) * 1536 + c * 8) = v; }
        } else {
            const int j = hr == 4 ? j0 - 1 : j0 + 64; const bool ok = j >= 0 && j < L;
            const bf16_t* src = seq_row(p, seq, b, ok ? j : 0, true) + COL_B0;
            for (int c = lane; c < 240; c += 64) { u32x4 v = {0u, 0u, 0u, 0u}; if (ok) v = *(const u32x4*)(src + c * 8); *(u32x4*)(HB + ((size_t)g * 2 + (hr - 4)) * 1920 + c * 8) = v; }
        }
    }
}
DI f32x2_ac unpk2(unsigned w) { return (f32x2_ac){bf2f((bf16_t)(w & 0xffffu)), bf2f((bf16_t)(w >> 16))}; }
DI void unpack8(const u32x4& q, float (&f)[8]) {
    f[0] = bf2f((bf16_t)(q.x & 0xffffu)); f[1] = bf2f((bf16_t)(q.x >> 16)); f[2] = bf2f((bf16_t)(q.y & 0xffffu)); f[3] = bf2f((bf16_t)(q.y >> 16));
    f[4] = bf2f((bf16_t)(q.z & 0xffffu)); f[5] = bf2f((bf16_t)(q.z >> 16)); f[6] = bf2f((bf16_t)(q.w & 0xffffu)); f[7] = bf2f((bf16_t)(q.w >> 16));
}
DI float row16_sum(float v) {
#ifdef EMU
    v += __shfl_xor(v, 1); v += __shfl_xor(v, 2); v += __shfl_xor(v, 4); v += __shfl_xor(v, 8); return v;
#else
    v = DPP_ADD(v, 0xB1); v = DPP_ADD(v, 0x4E); v = DPP_ADD(v, 0x141); v = DPP_ADD(v, 0x140); return v;
#endif
}
DI void phase_fir(const Params& p, char* smem) {
    const int tid = tid_x(), lane = tid & 63, wave = tid >> 6;
    const int gw = blockIdx.x * 8 + wave, ngw = gridDim.x * 8;
    const bf16_t* HA = (const bf16_t*)(p.ws + WS_HALO_A); const bf16_t* HB = (const bf16_t*)(p.ws + WS_HALO_B);
    constexpr int NA = NSEG * 3, NBI = NSEG * 4;
    const u32x4 z4 = {0u, 0u, 0u, 0u};
    for (int it = gw; it < NA + NBI; it += ngw) {
        if (it < NA) {
            const int g = it / 3, s = it % 3; int seq, b, j0; seg_info(g, seq, b, j0);
            const int col = s * 512 + 8 * lane, ldp = seq ? IN_COLS : CTX_COLS;
            bf16_t* base = (bf16_t*)seq_row(p, seq, b, j0, false) + col;
            const bf16_t* hal = HA + (size_t)g * 4 * 1536 + col;
            float cw[5][8];
#pragma unroll
            for (int t = 0; t < 5; ++t) { const f32x4 w0 = *(const f32x4*)(p.in[I_CONV] + t * 1536 + col), w1 = *(const f32x4*)(p.in[I_CONV] + t * 1536 + col + 4);
                cw[t][0] = w0.x; cw[t][1] = w0.y; cw[t][2] = w0.z; cw[t][3] = w0.w; cw[t][4] = w1.x; cw[t][5] = w1.y; cw[t][6] = w1.z; cw[t][7] = w1.w; }
            u32x4 win[12], nxt[8];
            win[0] = *(const u32x4*)(hal); win[1] = *(const u32x4*)(hal + 1536);
            win[2] = *(const u32x4*)(base); win[3] = *(const u32x4*)(base + ldp);
#pragma unroll
            for (int i = 0; i < 8; ++i) win[4 + i] = *(const u32x4*)(base + (size_t)(2 + i) * ldp);
#pragma unroll 1
            for (int blk = 0; blk < 8; ++blk) {
                if (blk < 7) {
#pragma unroll
                    for (int i = 0; i < 8; ++i) { const int t = 8 * blk + 10 + i; nxt[i] = t < 64 ? *(const u32x4*)(base + (size_t)t * ldp) : *(const u32x4*)(hal + (size_t)(2 + (t - 64)) * 1536); }
                }
#pragma unroll
                for (int i = 0; i < 8; ++i) {
                    float a[8];
#pragma unroll
                    for (int e = 0; e < 8; ++e) a[e] = 0.f;
#pragma unroll
                    for (int t = 0; t < 5; ++t) { float x[8]; unpack8(win[i + t], x);
#pragma unroll
                        for (int e = 0; e < 8; ++e) a[e] += x[e] * cw[t][e]; }
                    float ss = 0.f;
#pragma unroll
                    for (int e = 0; e < 8; ++e) { a[e] = fsilu(a[e]); ss += a[e] * a[e]; }
                    if (s < 2) { const float sc = frsq(row16_sum(ss) + 1e-6f) * (s == 0 ? 0.08838834764831845f : 1.0f);
#pragma unroll
                        for (int e = 0; e < 8; ++e) a[e] *= sc; }
                    u32x4 o; o.x = pk2(a[0], a[1]); o.y = pk2(a[2], a[3]); o.z = pk2(a[4], a[5]); o.w = pk2(a[6], a[7]);
                    *(u32x4*)(base + (size_t)(8 * blk + i) * ldp) = o;
                }
#pragma unroll
                for (int i = 0; i < 4; ++i) win[i] = win[8 + i];
#pragma unroll
                for (int i = 0; i < 8; ++i) win[4 + i] = nxt[i];
            }
        } else {
            const int it2 = it - NA, g = it2 / 4, sl = it2 % 4; int seq, b, j0; seg_info(g, seq, b, j0);
            const int bcol = sl * 512 + 8 * lane; const bool act = bcol < 1920;
            const int bc = act ? bcol : 0, col = COL_B0 + bc;
            float mu8[8];
            { const f32x4 m0 = *(const f32x4*)(p.in[I_MU] + bc), m1 = *(const f32x4*)(p.in[I_MU] + bc + 4); mu8[0] = m0.x; mu8[1] = m0.y; mu8[2] = m0.z; mu8[3] = m0.w; mu8[4] = m1.x; mu8[5] = m1.y; mu8[6] = m1.z; mu8[7] = m1.w; }
            const bool th = (bc >= 1536 && bc < 1664);
            const bf16_t* hal = HB + (size_t)g * 2 * 1920 + bc;
            u32x4 win[10], nxt[8];
            win[0] = *(const u32x4*)(hal); win[1] = *(const u32x4*)(seq_row(p, seq, b, j0, true) + col);
#pragma unroll
            for (int i = 0; i < 8; ++i) win[2 + i] = *(const u32x4*)(seq_row(p, seq, b, j0 + 1 + i, true) + col);
#pragma unroll 1
            for (int blk = 0; blk < 8; ++blk) {
                if (blk < 7) {
#pragma unroll
                    for (int i = 0; i < 8; ++i) { const int t = 8 * blk + 9 + i; nxt[i] = t < 64 ? *(const u32x4*)(seq_row(p, seq, b, j0 + t, true) + col) : *(const u32x4*)(hal + 1920); }
                }
#pragma unroll
                for (int i = 0; i < 8; ++i) {
                    float pv[8], cu[8], nx[8], x[8]; unpack8(win[i], pv); unpack8(win[i + 1], cu); unpack8(win[i + 2], nx);
#pragma unroll
                    for (int e = 0; e < 8; ++e) { x[e] = cu[e] + (0.5f * (pv[e] + nx[e]) - cu[e]) * mu8[e]; if (th) x[e] = ftanh(x[e]); }
                    u32x4 o; o.x = pk2(x[0], x[1]); o.y = pk2(x[2], x[3]); o.z = pk2(x[4], x[5]); o.w = pk2(x[6], x[7]);
                    if (act) *(u32x4*)((bf16_t*)seq_row(p, seq, b, j0 + 8 * blk + i, true) + col) = o;
                }
                win[0] = win[8]; win[1] = win[9];
#pragma unroll
                for (int i = 0; i < 8; ++i) win[2 + i] = nxt[i];
            }
        }
    }
}

constexpr int GC = 32;
constexpr int G_NT = (CTXL + S) / GC;
constexpr int LD128 = 136, LD64 = 72, LD32 = 40;
DI void chunk_pos(int x, int d, int& seg, int& j0) {
    constexpr int n0 = CTXL / GC, n1 = S / GC;
    if (x < n0) { seg = 0; j0 = (d ? n0 - 1 - x : x) * GC; } else { seg = 1; const int xx = x - n0; j0 = (d ? n1 - 1 - xx : xx) * GC; }
}

template <class Emit, class Emit0>
DI void invert32_blocked(const float* Lf, bf16_t* scr, int lane, Emit emit, Emit0 emit0) {
    bf16_t* T00T = scr; bf16_t* T11R = scr + 16 * LD32; bf16_t* L10R = scr + 2 * 16 * LD32; bf16_t* P1T = scr + 3 * 16 * LD32;
    const int blk = lane >> 5, c = lane & 15, r = lane & 31, fr = lane & 15, fq = lane >> 4;
    f32x16 t;
    const float* Lb = Lf + (16 * blk) * 32 + 16 * blk;
    f32x4 rb[3][4];
#pragma unroll
    for (int j4 = 0; j4 < 1; ++j4) { rb[1][j4] = *(const f32x4*)(Lb + 1 * 32 + 4 * j4); rb[2][j4] = *(const f32x4*)(Lb + 2 * 32 + 4 * j4); }
#pragma unroll
    for (int i = 0; i < 16; ++i) {
        if (i >= 1 && i + 2 < 16) {
#pragma unroll
            for (int j4 = 0; j4 < (i + 2 + 3) / 4; ++j4) rb[(i + 2) % 3][j4] = *(const f32x4*)(Lb + (i + 2) * 32 + 4 * j4);
        }
        float s0 = 0.f, s1 = 0.f, s2 = 0.f, s3 = 0.f;
#pragma unroll
        for (int j4 = 0; j4 < (i + 3) / 4; ++j4) {
            const f32x4 l = rb[i % 3][j4];
            if (4 * j4 + 0 < i) s0 += l.x * t[4 * j4 + 0];
            if (4 * j4 + 1 < i) s1 += l.y * t[4 * j4 + 1];
            if (4 * j4 + 2 < i) s2 += l.z * t[4 * j4 + 2];
            if (4 * j4 + 3 < i) s3 += l.w * t[4 * j4 + 3];
        }
        float sm = -((s0 + s1) + (s2 + s3));
#ifndef EMU
        asm volatile("" : "+v"(sm));
#endif
        t[i] = (i > c) ? sm : (i == c ? 1.f : 0.f);
    }
    if (r < 16) {
        if (blk == 0) {
#pragma unroll
            for (int q = 0; q < 4; ++q) { u32x2 o; o.x = pk2(t[4 * q], t[4 * q + 1]); o.y = pk2(t[4 * q + 2], t[4 * q + 3]); *(u32x2*)(T00T + c * LD32 + 4 * q) = o; }
        } else {
#pragma unroll
            for (int i = 0; i < 16; ++i) T11R[i * LD32 + c] = f2bf(t[i]);
        }
    }
    { const int i = lane >> 2, j4 = (lane & 3) * 4; const f32x4 l = *(const f32x4*)(Lf + (16 + i) * 32 + j4);
      u32x2 o; o.x = pk2(l.x, l.y); o.y = pk2(l.z, l.w); *(u32x2*)(L10R + i * LD32 + j4) = o; }
    WAVE_SYNC();
    const bf16x8 zf = {0, 0, 0, 0, 0, 0, 0, 0};
    f32x4 p1 = {0.f, 0.f, 0.f, 0.f};
    {
        const bf16x8 af = fq < 2 ? *(const bf16x8*)(L10R + fr * LD32 + 8 * fq) : zf, bfm = fq < 2 ? *(const bf16x8*)(T00T + fr * LD32 + 8 * fq) : zf;
        p1 = MFMA16(af, bfm, p1);
    }
    { u32x2 o; o.x = pk2(p1[0], p1[1]); o.y = pk2(p1[2], p1[3]); *(u32x2*)(P1T + fr * LD32 + 4 * fq) = o; }
    WAVE_SYNC();
    f32x4 p2 = {0.f, 0.f, 0.f, 0.f};
    {
        const bf16x8 af = fq < 2 ? *(const bf16x8*)(T11R + fr * LD32 + 8 * fq) : zf, bfm = fq < 2 ? *(const bf16x8*)(P1T + fr * LD32 + 8 * fq) : zf;
        p2 = MFMA16(af, bfm, p2);
    }
#pragma unroll
    for (int j = 0; j < 4; ++j) emit(16 + 4 * fq + j, fr, -p2[j]);
    if (r < 16) {
#pragma unroll
        for (int i = 0; i < 16; ++i) emit(16 * blk + i, 16 * blk + c, t[i]);
        if (blk == 0) {
#pragma unroll
            for (int i = 0; i < 16; ++i) emit0(i, 16 + c);
        }
    }
}
DI float half_sum(float v, int hh) {
#ifdef EMU
    v += __shfl_xor(v, 1); v += __shfl_xor(v, 2); v += __shfl_xor(v, 4); v += __shfl_xor(v, 8); v += __shfl_xor(v, 16); return v;
#else
    v = DPP_ADD(v, 0xB1); v = DPP_ADD(v, 0x4E); v = DPP_ADD(v, 0x141); v = DPP_ADD(v, 0x140);
    const int iv = __builtin_bit_cast(int, v);
    const float s0 = __builtin_bit_cast(float, __builtin_amdgcn_readlane(iv, 0)) + __builtin_bit_cast(float, __builtin_amdgcn_readlane(iv, 16));
    const float s1 = __builtin_bit_cast(float, __builtin_amdgcn_readlane(iv, 32)) + __builtin_bit_cast(float, __builtin_amdgcn_readlane(iv, 48));
    return hh ? s1 : s0;
#endif
}
constexpr int GL_Q = 0;
constexpr int GL_KT = GL_Q + 3 * 32 * LD128 * 2;
constexpr int GL_VT = GL_KT + 3 * 128 * LD32 * 2;
constexpr int GL_K = GL_VT + 3 * 128 * LD32 * 2;
constexpr int GL_QKM = GL_K + 32 * LD128 * 2;
constexpr int GL_LF = GL_QKM + 2 * 32 * LD32 * 2;
constexpr int GL_TP = GL_LF + 32 * 32 * 4;
constexpr int GL_TPP = GL_TP + 32 * LD32 * 2;
constexpr int GL_WN = GL_TPP + 2 * 32 * LD32 * 2;
constexpr int GL_SC = GL_WN + 32 * LD128 * 2;
constexpr int GL_GC = GL_SC + 2 * 8 * 32 * 4;
constexpr int GL_INV = GL_GC + 8 * 32 * 4;
constexpr int GL_RAW = GL_INV + 4 * 16 * LD32 * 2;
constexpr int GL_END = GL_RAW + 32 * 384 * 2;
static_assert(GL_END <= LDS_BYTES, "gdn lds");

DI void gdn_chain2(const Params& p, char* smem, int item) {
    const int d = item / (NB * H_A), b = (item / H_A) % NB, h = item % H_A;
    const int tid = tid_x(), lane = tid & 63, wave0_ = tid >> 6;
    bf16_t* Qs = (bf16_t*)(smem + GL_Q); bf16_t* KTs = (bf16_t*)(smem + GL_KT); bf16_t* VTs = (bf16_t*)(smem + GL_VT); bf16_t* Ks = (bf16_t*)(smem + GL_K);
    bf16_t* QKMs = (bf16_t*)(smem + GL_QKM); float* Lf = (float*)(smem + GL_LF); bf16_t* Tp = (bf16_t*)(smem + GL_TP); bf16_t* Tpp = (bf16_t*)(smem + GL_TPP);
    bf16_t* Wn = (bf16_t*)(smem + GL_WN); float* SC = (float*)(smem + GL_SC); float* GCs = (float*)(smem + GL_GC);
    const float alog = p.in[I_ALOG][d * 4 + h], dtb = p.in[I_DTB][d * 4 + h], negea = -expf(alog);
    bf16_t* ODIR = (bf16_t*)(p.ws + WS_OA);
    __syncthreads();
    f32x16 St[4];
#pragma unroll
    for (int ct = 0; ct < 4; ++ct) St[ct] = zero16();
    bf16_t* RAW = (bf16_t*)(smem + GL_RAW);
    float pa = 0.f, pbt = 0.f;
    auto prefetch = [&](int x, int inst0, int ninst) {
        int seg, j0; chunk_pos(x, d, seg, j0);
        const int ldp = seg ? IN_COLS : CTX_COLS;
        const bf16_t* pbase = seg ? (const bf16_t*)(p.ws + WS_PLAT) + (size_t)b * S * IN_COLS : (const bf16_t*)(p.ws + WS_PCTX) + (size_t)b * CTXL * CTX_COLS;
        for (int inst = inst0; inst < inst0 + ninst; ++inst) {
            const int q = inst * 64 + lane, row = q / 48, c16 = q % 48;
            const bf16_t* src = pbase + (size_t)(j0 + row) * ldp + (c16 >> 4) * 512 + h * 128 + (c16 & 15) * 8;
#ifdef EMU
            emu_global_load_lds16(src, (char*)RAW + q * 16);
#else
            __builtin_amdgcn_global_load_lds((const unsigned*)src, (__attribute__((address_space(3))) unsigned*)((char*)RAW + q * 16), 16, 0, 0);
#endif
        }
    };
    auto prefetch_ab = [&](int x, int g0, int ng) {
        int seg, j0; chunk_pos(x, d, seg, j0);
        const float* abbase = (const float*)(p.ws + WS_AB) + (size_t)(seg ? T_CTX + b * S : b * CTXL) * 16;
        if (lane < 4 * ng) { const int j = j0 + 4 * g0 + lane; pa = abbase[(size_t)j * 16 + d * 4 + h]; pbt = abbase[(size_t)j * 16 + 8 + d * 4 + h]; }
    };
    auto x1 = [&](int c, int g0, int ng) {
        const int q3 = c % 3, parc = c & 1;
        for (int gi = 0; gi < ng; ++gi) {
            const int g = g0 + gi;
            const int i0 = d ? (GC - 4 - 4 * g) : 4 * g;
            const char* rawg = (const char*)RAW + (4 * g + (d ? 3 : 0)) * 768 + 4 * lane; const int rstep = d ? -768 : 768;
            unsigned wq[4], wk[4], wv[4];
#pragma unroll
            for (int e = 0; e < 4; ++e) { const char* rr = rawg + e * rstep; wq[e] = *(const unsigned*)rr; wk[e] = *(const unsigned*)(rr + 256); wv[e] = *(const unsigned*)(rr + 512); }
            char* qrow = (char*)Qs + ((q3 * 32 + i0) * LD128 + 2 * lane) * 2; char* krow = (char*)Ks + (i0 * LD128 + 2 * lane) * 2;
#pragma unroll
            for (int e = 0; e < 4; ++e) { *(unsigned*)(qrow + e * LD128 * 2) = wq[e]; *(unsigned*)(krow + e * LD128 * 2) = wk[e]; }
            char* ktrow = (char*)KTs + ((q3 * 128 + 2 * lane) * LD32 + i0) * 2; char* vtrow = (char*)VTs + ((q3 * 128 + 2 * lane) * LD32 + i0) * 2;
            { u32x2 o; o.x = (wk[0] & 0xffffu) | (wk[1] << 16); o.y = (wk[2] & 0xffffu) | (wk[3] << 16); *(u32x2*)ktrow = o;
              u32x2 o1; o1.x = (wk[0] >> 16) | (wk[1] & 0xffff0000u); o1.y = (wk[2] >> 16) | (wk[3] & 0xffff0000u); *(u32x2*)(ktrow + LD32 * 2) = o1; }
            { u32x2 o; o.x = (wv[0] & 0xffffu) | (wv[1] << 16); o.y = (wv[2] & 0xffffu) | (wv[3] << 16); *(u32x2*)vtrow = o;
              u32x2 o1; o1.x = (wv[0] >> 16) | (wv[1] & 0xffff0000u); o1.y = (wv[2] >> 16) | (wv[3] & 0xffff0000u); *(u32x2*)(vtrow + LD32 * 2) = o1; }
        }
        if (lane < 4 * ng) { const int jo = 4 * g0 + lane; const int i = d ? (GC - 1 - jo) : jo;
            SC[(parc * 8 + 0) * 32 + i] = negea * fsoftplus(pa + dtb); SC[(parc * 8 + 1) * 32 + i] = fsigmoid(pbt); }
    };
    prefetch(0, 3 * wave0_, 3); prefetch_ab(0, wave0_, 1);
#ifndef EMU
    asm volatile("s_waitcnt vmcnt(0)" ::: "memory");
#endif
    const int r0_ = lane & 31, hh0_ = lane >> 5;
    __syncthreads();
    x1(0, wave0_, 1);
    LDS_BARRIER();
    if (wave0_ >= 4 && wave0_ < 7 && 1 < G_NT) { prefetch(1, 9 * (wave0_ - 4), wave0_ == 6 ? 6 : 9); prefetch_ab(1, 3 * (wave0_ - 4), wave0_ == 6 ? 2 : 3); }
    for (int it = -1; it < G_NT; ++it) {
        int r = r0_, hh = hh0_, wave = wave0_;
#ifndef EMU
        asm volatile("" : "+v"(r), "+v"(hh), "+v"(wave));
#endif
        const int xn = it + 1, par = xn & 1, q3 = xn % 3;
        const int g0w = 3 * (wave - 4), ngw = wave == 6 ? 2 : 3;
        if (xn < G_NT) {
            const float* graw = SC + (par * 8 + 0) * 32;
            float gcv = 0.f;
#pragma unroll
            for (int s4 = 0; s4 < 8; ++s4) { const f32x4 g4 = *(const f32x4*)(graw + 4 * s4);
                gcv += (4 * s4 + 0 <= r ? g4.x : 0.f) + (4 * s4 + 1 <= r ? g4.y : 0.f) + (4 * s4 + 2 <= r ? g4.z : 0.f) + (4 * s4 + 3 <= r ? g4.w : 0.f); }
            if (lane < 32) GCs[wave * 32 + r] = gcv;
            if (wave == 7 && lane < 32) {
                float gl = 0.f;
#pragma unroll
                for (int s4 = 0; s4 < 8; ++s4) { const f32x4 g4 = *(const f32x4*)(graw + 4 * s4); gl += (g4.x + g4.y) + (g4.z + g4.w); }
                const float be = SC[(par * 8 + 1) * 32 + r];
                SC[(par * 8 + 3) * 32 + r] = fexp(gcv); SC[(par * 8 + 4) * 32 + r] = fexp(gl - gcv); SC[(par * 8 + 5) * 32 + r] = be * fexp(gcv); SC[(par * 8 + 6) * 32 + r] = fexp(gl);
            }
            const int pr = wave >> 2, th = (wave >> 1) & 1, ch = wave & 1, fr = lane & 15, fq = lane >> 4;
            const bf16_t* arow = (pr == 0 ? Ks : Qs + q3 * 32 * LD128) + (16 * th + fr) * LD128 + 8 * fq; const bf16_t* brow = Ks + (16 * ch + fr) * LD128 + 8 * fq;
            f32x4 cc = {0.f, 0.f, 0.f, 0.f};
#pragma unroll
            for (int ks = 0; ks < 4; ++ks) cc = MFMA16(*(const bf16x8*)(arow + 32 * ks), *(const bf16x8*)(brow + 32 * ks), cc);
            WAVE_SYNC();
            const int jj = 16 * ch + fr; const float gj = GCs[wave * 32 + jj];
#pragma unroll
            for (int j = 0; j < 4; ++j) {
                const int i = 16 * th + 4 * fq + j; const float dec = fexp(GCs[wave * 32 + i] - gj);
                if (pr == 0) Lf[i * 32 + jj] = (jj < i) ? SC[(par * 8 + 1) * 32 + i] * cc[j] * dec : 0.f;
                else QKMs[(par * 32 + i) * LD32 + jj] = f2bf((jj <= i) ? cc[j] * dec : 0.f);
            }
        }
#ifndef EMU
        asm volatile("s_waitcnt vmcnt(0)" ::: "memory");
#endif
        LDS_BARRIER();
        if (wave == 7 && xn < G_NT) {
            const float* sb1 = SC + (par * 8 + 5) * 32; const float* sb0 = SC + (par * 8 + 1) * 32; bf16_t* Tppw = Tpp + par * 32 * LD32;
            const float s1lo = sb1[lane & 15], s1hi = sb1[16 + (lane & 15)], s0lo = sb0[lane & 15], s0hi = sb0[16 + (lane & 15)];
            invert32_blocked(Lf, (bf16_t*)(smem + GL_INV), lane,
                [&](int i, int c, float v) { Tp[i * LD32 + c] = f2bf(v * (c < 16 ? s1lo : s1hi)); Tppw[i * LD32 + c] = f2bf(v * (c < 16 ? s0lo : s0hi)); },
                [&](int i, int c) { Tp[i * LD32 + c] = (bf16_t)0; Tppw[i * LD32 + c] = (bf16_t)0; });
        }
        if (wave >= 4 && wave < 7 && xn + 1 < G_NT) {
            x1(xn + 1, g0w, ngw);
            if (xn + 2 < G_NT) {
                WAVE_SYNC();
                prefetch(xn + 2, 9 * (wave - 4), wave == 6 ? 6 : 9); prefetch_ab(xn + 2, g0w, ngw);
            }
        }
        if (wave < 4 && it >= 0) {
            const int pc = it & 1, qc = it % 3; int seg = 0, j0 = 0; chunk_pos(it, d, seg, j0);
            const bf16_t* Qc = Qs + qc * 32 * LD128; const bf16_t* KTc = KTs + qc * 128 * LD32; const bf16_t* VTc = VTs + qc * 128 * LD32;
            const bf16_t* QKc = QKMs + pc * 32 * LD32; const bf16_t* Tc = Tpp + pc * 32 * LD32; const float* sc = SC + pc * 8 * 32;
            f32x16 vn = zero16();
#pragma unroll
            for (int s = 0; s < 2; ++s) vn = MFMA32(ld_nat(Tc + r * LD32, s, hh), ld_nat(VTc + (32 * wave + r) * LD32, s, hh), vn);
            f32x16 oacc = zero16();
#define GDN_KSTEP(s) { const bf16x8 sb = pack_acc<(s) & 1>(St[(s) >> 1]); vn = MFMA32(ld_perm(Wn + r * LD128, (s), hh), sb, vn); oacc = MFMA32(ld_perm(Qc + r * LD128, (s), hh), sb, oacc); }
            GDN_KSTEP(0) GDN_KSTEP(1) GDN_KSTEP(2) GDN_KSTEP(3) GDN_KSTEP(4) GDN_KSTEP(5) GDN_KSTEP(6) GDN_KSTEP(7)
#undef GDN_KSTEP
#pragma unroll
            for (int g = 0; g < 16; ++g) oacc[g] *= sc[3 * 32 + crow(g, hh)];
            { const bf16x8 v0 = pack_acc<0>(vn), v1 = pack_acc<1>(vn);
              oacc = MFMA32(ld_perm(QKc + r * LD32, 0, hh), v0, oacc); oacc = MFMA32(ld_perm(QKc + r * LD32, 1, hh), v1, oacc); }
#pragma unroll
            for (int g = 0; g < 16; ++g) vn[g] *= sc[4 * 32 + crow(g, hh)];
            const float ge = sc[6 * 32];
            { const bf16x8 v0 = pack_acc<0>(vn), v1 = pack_acc<1>(vn);
#pragma unroll
              for (int ct = 0; ct < 4; ++ct) {
#pragma unroll
                  for (int g = 0; g < 16; ++g) St[ct][g] *= ge;
                  St[ct] = MFMA32(ld_perm(KTc + (32 * ct + r) * LD32, 0, hh), v0, St[ct]);
                  St[ct] = MFMA32(ld_perm(KTc + (32 * ct + r) * LD32, 1, hh), v1, St[ct]);
              } }
            if (seg) {
#pragma unroll
                for (int g = 0; g < 16; ++g) {
                    const int i = crow(g, hh), j = d ? j0 + GC - 1 - i : j0 + i;
                    ODIR[((size_t)d * T_LAT + (size_t)b * S + j) * 512 + h * 128 + 32 * wave + r] = f2bf(oacc[g]);
                }
            }
        }
        LDS_BARRIER();
        if (xn < G_NT && wave < 4) {
            f32x16 acc = zero16();
#pragma unroll
            for (int s = 0; s < 2; ++s) acc = MFMA32(ld_nat(KTs + (q3 * 128 + 32 * wave + r) * LD32, s, hh), ld_nat(Tp + r * LD32, s, hh), acc);
#pragma unroll
            for (int q = 0; q < 4; ++q) {
                u32x2 o; o.x = pk2(-acc[4 * q], -acc[4 * q + 1]); o.y = pk2(-acc[4 * q + 2], -acc[4 * q + 3]);
                *(u32x2*)(Wn + r * LD128 + 32 * wave + 8 * q + 4 * hh) = o;
            }
        }
        LDS_BARRIER();
    }
}

constexpr int RL_RX = 0;
constexpr int RL_KX = RL_RX + 32 * 64 * 2;
constexpr int RL_VX = RL_KX + 32 * 64 * 2;
constexpr int RL_KK = RL_VX + 32 * 64 * 2;
constexpr int RL_LW = RL_KK + 32 * 64 * 4;
constexpr int RL_IC = RL_LW + 32 * 64 * 4;
constexpr int RL_PC = RL_IC + 32 * 64 * 4;
constexpr int RL_CST = RL_PC + 2 * 64 * 4;
constexpr int RL_TW = RL_CST + 4 * 64 * 4;
constexpr int RL_AL = RL_TW + 32 * LD64 * 2;
constexpr int RL_LF = RL_AL + 32 * LD64 * 2;
constexpr int RL_LAKT = RL_LF + 32 * 32 * 4;
constexpr int RL_TB = RL_LAKT + 32 * LD32 * 2;
constexpr int RL_W2T = RL_TB + 32 * LD32 * 2;
constexpr int RL_A2T = RL_W2T + 64 * LD64 * 2;
constexpr int RL_AR = RL_A2T + 64 * LD64 * 2;
constexpr int RL_BR = RL_AR + 32 * LD64 * 2;
constexpr int RL_KR = RL_BR + 32 * LD64 * 2;
constexpr int RL_RR = RL_KR + 32 * LD64 * 2;
constexpr int RL_AT = RL_RR + 2 * 32 * LD64 * 2;
constexpr int RL_BHT = RL_AT + 64 * LD32 * 2;
constexpr int RL_KHT = RL_BHT + 2 * 64 * LD32 * 2;
constexpr int RL_VT = RL_KHT + 2 * 64 * LD32 * 2;
constexpr int RL_MRB = RL_VT + 2 * 64 * LD32 * 2;
constexpr int RL_MRK = RL_MRB + 2 * 32 * LD32 * 2;
constexpr int RL_WM = RL_MRK + 2 * 32 * LD32 * 2;
constexpr int RL_TL = RL_WM + 32 * LD64 * 2;
constexpr int RL_END = RL_TL + 32 * LD32 * 2;
static_assert(RL_END <= LDS_BYTES, "rwkv lds");
static_assert(4 * 16 * LD32 * 2 <= 2 * 32 * LD64 * 2, "inversion scratch over AR/BR");

DI void rwkv_chain2(const Params& p, char* smem, int item) {
    const int d = item / (NB * H_B), b = (item / H_B) % NB, h = item % H_B;
    const int tid = tid_x(), lane = tid & 63, wave = tid >> 6;
    bf16_t* RX = (bf16_t*)(smem + RL_RX); bf16_t* KX = (bf16_t*)(smem + RL_KX); bf16_t* VX = (bf16_t*)(smem + RL_VX); float* KKs = (float*)(smem + RL_KK);
    float* LW = (float*)(smem + RL_LW); float* IC = (float*)(smem + RL_IC); float* Lf = (float*)(smem + RL_LF); float* PC = (float*)(smem + RL_PC); float* CST = (float*)(smem + RL_CST);
    bf16_t* TW = (bf16_t*)(smem + RL_TW); bf16_t* AL = (bf16_t*)(smem + RL_AL); bf16_t* W2T = (bf16_t*)(smem + RL_W2T); bf16_t* A2T = (bf16_t*)(smem + RL_A2T);
    bf16_t* Ar = (bf16_t*)(smem + RL_AR); bf16_t* Br = (bf16_t*)(smem + RL_BR); bf16_t* Kr = (bf16_t*)(smem + RL_KR); bf16_t* Rr = (bf16_t*)(smem + RL_RR);
    bf16_t* AT = (bf16_t*)(smem + RL_AT); bf16_t* BhT = (bf16_t*)(smem + RL_BHT); bf16_t* KhT = (bf16_t*)(smem + RL_KHT); bf16_t* VT = (bf16_t*)(smem + RL_VT);
    bf16_t* LakT = (bf16_t*)(smem + RL_LAKT); bf16_t* Mrb = (bf16_t*)(smem + RL_MRB); bf16_t* Mrk = (bf16_t*)(smem + RL_MRK); bf16_t* Tb = (bf16_t*)(smem + RL_TB);
    bf16_t* Wm = (bf16_t*)(smem + RL_WM); bf16_t* TLm = (bf16_t*)(smem + RL_TL);
    bf16_t* YDIR = (bf16_t*)(p.aux + AUX_YDIR); float* BON = (float*)(p.ws + WS_BONUS);
    __syncthreads();
    for (int i = tid; i < 64 * 64; i += NTHREADS) {
        const int c = i >> 6, rr = i & 63;
        W2T[c * LD64 + rr] = f2bf(p.in[I_W2][((size_t)d * 64 + rr) * 512 + h * 64 + c]); A2T[c * LD64 + rr] = f2bf(p.in[I_A2][((size_t)d * 64 + rr) * 512 + h * 64 + c]);
    }
    if (tid < 256) { const int w = tid >> 6, c = tid & 63, gc = h * 64 + c;
        CST[tid] = w == 0 ? p.in[I_W0][d * 512 + gc] : (w == 1 ? p.in[I_A0][d * 512 + gc] : (w == 2 ? p.in[I_KA][gc] : p.in[I_RK][gc])); }
    const float kkw0 = p.in[I_KK][h * 64 + 2 * (lane & 31)], kkw1 = p.in[I_KK][h * 64 + 2 * (lane & 31) + 1];
    f32x16 Xt[2]; Xt[0] = zero16(); Xt[1] = zero16();
    unsigned rawv[4][5];
    auto prefetch = [&](int x, int w) {
        int seg, j0; chunk_pos(x, d, seg, j0);
        const int ldp = seg ? IN_COLS : CTX_COLS;
        const bf16_t* pb = seg ? (const bf16_t*)(p.ws + WS_PLAT) + (size_t)b * S * IN_COLS : (const bf16_t*)(p.ws + WS_PCTX) + (size_t)b * CTXL * CTX_COLS;
#pragma unroll
        for (int k = 0; k < 4; ++k) {
            const int pi = (w - 2) + 5 * k;
            if (pi < GC / 2) {
                const int j = j0 + 2 * pi + (lane >> 5); const int row = seg ? (j % ROWS) * GW + j / ROWS : j;
#pragma unroll
                for (int s = 0; s < 5; ++s) {
                    const int bcol = (s < 3 ? s * 512 + h * 64 : (s == 3 ? 1536 + d * 64 : 1664 + d * 64)) + 2 * (lane & 31);
                    rawv[k][s] = *(const unsigned*)(pb + (size_t)row * ldp + COL_B0 + bcol);
                }
            }
        }
    };
    auto y1 = [&](int w) {
#pragma unroll
        for (int k = 0; k < 4; ++k) {
            const int pi = (w - 2) + 5 * k;
            if (pi < GC / 2) {
                const int jo = 2 * pi + (lane >> 5), i = d ? (GC - 1 - jo) : jo, c2 = 2 * (lane & 31);
                const float kx0 = bf2f((bf16_t)(rawv[k][1] & 0xffffu)) * kkw0, kx1 = bf2f((bf16_t)(rawv[k][1] >> 16)) * kkw1;
                const float rs = frsq(half_sum(kx0 * kx0 + kx1 * kx1, lane >> 5) + 1e-6f);
                *(unsigned*)(RX + i * 64 + c2) = rawv[k][0]; *(unsigned*)(KX + i * 64 + c2) = rawv[k][1]; *(unsigned*)(VX + i * 64 + c2) = rawv[k][2];
                KKs[i * 64 + c2] = kx0 * rs; KKs[i * 64 + c2 + 1] = kx1 * rs;
                *(unsigned*)(TW + i * LD64 + c2) = rawv[k][3]; *(unsigned*)(AL + i * LD64 + c2) = rawv[k][4];
            }
        }
    };
    if (wave >= 2 && wave < 7) prefetch(0, wave);
    const int r0_ = lane & 31, hh0_ = lane >> 5;
    __syncthreads();
    if (wave >= 2 && wave < 7) { y1(wave); if (1 < G_NT) prefetch(1, wave); }
    LDS_BARRIER();
    for (int it = -1; it < G_NT; ++it) {
        int r = r0_, hh = hh0_;
#ifndef EMU
        asm volatile("" : "+v"(r), "+v"(hh));
#endif
        const int xn = it + 1, par = xn & 1;
        int segn = 0, j0n = 0; if (xn < G_NT) chunk_pos(xn, d, segn, j0n);
        if (xn < G_NT) {
            const int which = wave >> 2, cg = wave & 3, fr = lane & 15, fq = lane >> 4;
            const bf16_t* arow0 = (which ? AL : TW) + fr * LD64 + 8 * fq; const bf16_t* brow = (which ? A2T : W2T) + (16 * cg + fr) * LD64 + 8 * fq;
            f32x4 c0 = {0.f, 0.f, 0.f, 0.f}, c1 = {0.f, 0.f, 0.f, 0.f};
#pragma unroll
            for (int ks = 0; ks < 2; ++ks) {
                const bf16x8 bfrag = *(const bf16x8*)(brow + 32 * ks);
                c0 = MFMA16(*(const bf16x8*)(arow0 + 32 * ks), bfrag, c0); c1 = MFMA16(*(const bf16x8*)(arow0 + 16 * LD64 + 32 * ks), bfrag, c1);
            }
            const int c = 16 * cg + fr; const float bias = CST[which * 64 + c];
#pragma unroll
            for (int th = 0; th < 2; ++th)
#pragma unroll
                for (int j = 0; j < 4; ++j) {
                    const int i = 16 * th + 4 * fq + j; const float z = bias + (th ? c1[j] : c0[j]);
                    if (which) IC[i * 64 + c] = fsigmoid(z);
                    else { const float wl = -fsoftplus(-z) - 0.5f; LW[i * 64 + c] = -fexp(wl); }
                }
        }
        LDS_BARRIER();
        if (xn < G_NT) {
            const int c = lane, i0 = 4 * wave;
            const float ka = CST[2 * 64 + c], rk = CST[3 * 64 + c];
            float lpb = 0.f, lpc = 0.f; float lw4[4];
#pragma unroll
            for (int s2 = 0; s2 < 32; ++s2) { const float w = LW[s2 * 64 + c]; lpc += w; if (s2 < i0) lpb += w; }
#pragma unroll
            for (int e = 0; e < 4; ++e) lw4[e] = LW[(i0 + e) * 64 + c];
            bf16_t ta[4], tb[4], tk[4], tv[4]; float bon[4];
            float lprun = lpb;
#pragma unroll
            for (int e = 0; e < 4; ++e) {
                const int i = i0 + e;
                const float lpm = lprun; lprun += lw4[e]; const float lp = lprun;
                const float Pi = fexp(lp), Pm = fexp(lpm), invP = fexp(-lp), PCi = fexp(lpc - lp);
                const float ic = IC[i * 64 + c], kxv = bf2f(KX[i * 64 + c]), kkv = KKs[i * 64 + c], rxv = bf2f(RX[i * 64 + c]); const bf16_t vxb = VX[i * 64 + c];
                const float kd = kxv * (1.f + (ic - 1.f) * ka), bb = kkv * ic, aa = -kkv;
                ta[e] = f2bf(aa * Pm); tb[e] = f2bf(bb * PCi); tk[e] = f2bf(kd * PCi); tv[e] = vxb;
                Ar[i * LD64 + c] = ta[e]; Br[i * LD64 + c] = f2bf(bb * invP); Kr[i * LD64 + c] = f2bf(kd * invP); Rr[(par * 32 + i) * LD64 + c] = f2bf(rxv * Pi);
                bon[e] = wave_sum_fast(rxv * kd * rk);
            }
            { u32x2 o; o.x = (unsigned)ta[0] | ((unsigned)ta[1] << 16); o.y = (unsigned)ta[2] | ((unsigned)ta[3] << 16); *(u32x2*)(AT + c * LD32 + i0) = o; }
            { u32x2 o; o.x = (unsigned)tb[0] | ((unsigned)tb[1] << 16); o.y = (unsigned)tb[2] | ((unsigned)tb[3] << 16); *(u32x2*)(BhT + (par * 64 + c) * LD32 + i0) = o; }
            { u32x2 o; o.x = (unsigned)tk[0] | ((unsigned)tk[1] << 16); o.y = (unsigned)tk[2] | ((unsigned)tk[3] << 16); *(u32x2*)(KhT + (par * 64 + c) * LD32 + i0) = o; }
            { u32x2 o; o.x = (unsigned)tv[0] | ((unsigned)tv[1] << 16); o.y = (unsigned)tv[2] | ((unsigned)tv[3] << 16); *(u32x2*)(VT + (par * 64 + c) * LD32 + i0) = o; }
            if (wave == 7) PC[par * 64 + c] = fexp(lpc);
            if (segn && lane < 4) { const int i = i0 + lane, jj = d ? j0n + GC - 1 - i : j0n + i;
                const float bv = lane == 0 ? bon[0] : (lane == 1 ? bon[1] : (lane == 2 ? bon[2] : bon[3]));
                BON[((size_t)d * T_LAT + (size_t)b * S + (jj % ROWS) * GW + jj / ROWS) * 8 + h] = bv; }
        }
        LDS_BARRIER();
        if (xn < G_NT) {
            const int m = wave >> 1, th = wave & 1, fr = lane & 15, fq = lane >> 4;
            const bf16_t* arow = ((m < 2) ? Ar : Rr + par * 32 * LD64) + (16 * th + fr) * LD64 + 8 * fq; const bf16_t* brow = ((m & 1) ? Kr : Br) + fr * LD64 + 8 * fq;
            f32x4 c0 = {0.f, 0.f, 0.f, 0.f}, c1 = {0.f, 0.f, 0.f, 0.f};
#pragma unroll
            for (int ks = 0; ks < 2; ++ks) {
                const bf16x8 afrag = *(const bf16x8*)(arow + 32 * ks);
                c0 = MFMA16(afrag, *(const bf16x8*)(brow + 32 * ks), c0); c1 = MFMA16(afrag, *(const bf16x8*)(brow + 16 * LD64 + 32 * ks), c1);
            }
#pragma unroll
            for (int ch = 0; ch < 2; ++ch) {
                const f32x4 cc = ch ? c1 : c0; const int ic = 16 * ch + fr; const int t0 = 16 * th + 4 * fq;
                if (m == 0) {
#pragma unroll
                    for (int j = 0; j < 4; ++j) Lf[(t0 + j) * 32 + ic] = (ic < t0 + j) ? -cc[j] : 0.f;
                } else if (m == 1) {
                    u32x2 o; o.x = pk2((ic < t0) ? cc[0] : 0.f, (ic < t0 + 1) ? cc[1] : 0.f); o.y = pk2((ic < t0 + 2) ? cc[2] : 0.f, (ic < t0 + 3) ? cc[3] : 0.f);
                    *(u32x2*)(LakT + ic * LD32 + t0) = o;
                } else {
                    bf16_t* M = (m == 2 ? Mrb : Mrk) + par * 32 * LD32;
#pragma unroll
                    for (int j = 0; j < 4; ++j) M[(t0 + j) * LD32 + ic] = f2bf((ic <= t0 + j) ? cc[j] : 0.f);
                }
            }
        }
        LDS_BARRIER();
        if (wave == 7 && xn < G_NT) {
            invert32_blocked(Lf, (bf16_t*)(smem + RL_AR), lane, [&](int i, int c, float v) { Tb[i * LD32 + c] = f2bf(v); },
                             [&](int i, int c) { Tb[i * LD32 + c] = (bf16_t)0; });
        }
        if (wave >= 2 && wave < 7 && xn + 1 < G_NT) { y1(wave); if (xn + 2 < G_NT) prefetch(xn + 2, wave); }
        if (wave < 2 && it >= 0) {
            const int pc = it & 1; int seg = 0, j0 = 0; chunk_pos(it, d, seg, j0);
            const bf16_t* Rc = Rr + pc * 32 * LD64; const bf16_t* BhTc = BhT + pc * 64 * LD32; const bf16_t* KhTc = KhT + pc * 64 * LD32; const bf16_t* VTc = VT + (pc * 64 + 32 * wave + r) * LD32;
            const bf16_t* Mrbc = Mrb + pc * 32 * LD32; const bf16_t* Mrkc = Mrk + pc * 32 * LD32; const float* PCc = PC + pc * 64;
            const bf16x8 vf0 = ld_nat(VTc, 0, hh), vf1 = ld_nat(VTc, 1, hh);
            f32x16 u = zero16(), y = zero16();
            u = MFMA32(ld_nat(TLm + r * LD32, 0, hh), vf0, u); u = MFMA32(ld_nat(TLm + r * LD32, 1, hh), vf1, u);
            y = MFMA32(ld_nat(Mrkc + r * LD32, 0, hh), vf0, y); y = MFMA32(ld_nat(Mrkc + r * LD32, 1, hh), vf1, y);
#define RW_KSTEP(s) { const bf16x8 xb = pack_acc<(s) & 1>(Xt[(s) >> 1]); u = MFMA32(ld_perm(Wm + r * LD64, (s), hh), xb, u); y = MFMA32(ld_perm(Rc + r * LD64, (s), hh), xb, y); }
            RW_KSTEP(0) RW_KSTEP(1) RW_KSTEP(2) RW_KSTEP(3)
#undef RW_KSTEP
            const bf16x8 ub0 = pack_acc<0>(u), ub1 = pack_acc<1>(u);
            y = MFMA32(ld_perm(Mrbc + r * LD32, 0, hh), ub0, y); y = MFMA32(ld_perm(Mrbc + r * LD32, 1, hh), ub1, y);
#pragma unroll
            for (int kt = 0; kt < 2; ++kt) {
#pragma unroll
                for (int g = 0; g < 16; ++g) Xt[kt][g] *= PCc[32 * kt + crow(g, hh)];
                Xt[kt] = MFMA32(ld_perm(BhTc + (32 * kt + r) * LD32, 0, hh), ub0, Xt[kt]); Xt[kt] = MFMA32(ld_perm(BhTc + (32 * kt + r) * LD32, 1, hh), ub1, Xt[kt]);
                Xt[kt] = MFMA32(ld_nat(KhTc + (32 * kt + r) * LD32, 0, hh), vf0, Xt[kt]); Xt[kt] = MFMA32(ld_nat(KhTc + (32 * kt + r) * LD32, 1, hh), vf1, Xt[kt]);
            }
            if (seg) {
#pragma unroll
                for (int g = 0; g < 16; ++g) {
                    const int i = crow(g, hh), jj = d ? j0 + GC - 1 - i : j0 + i;
                    YDIR[((size_t)d * T_LAT + (size_t)b * S + (jj % ROWS) * GW + jj / ROWS) * 512 + h * 64 + 32 * wave + r] = f2bf(y[g]);
                }
            }
        }
        LDS_BARRIER();
        if (xn < G_NT && wave < 3) {
            const bf16_t* arow = (wave < 2) ? AT + (32 * wave + r) * LD32 : LakT + r * LD32;
            f32x16 acc = zero16();
#pragma unroll
            for (int s = 0; s < 2; ++s) acc = MFMA32(ld_nat(arow, s, hh), ld_nat(Tb + r * LD32, s, hh), acc);
#pragma unroll
            for (int q = 0; q < 4; ++q) {
                u32x2 o; o.x = pk2(acc[4 * q], acc[4 * q + 1]); o.y = pk2(acc[4 * q + 2], acc[4 * q + 3]);
                if (wave < 2) *(u32x2*)(Wm + r * LD64 + 32 * wave + 8 * q + 4 * hh) = o; else *(u32x2*)(TLm + r * LD32 + 8 * q + 4 * hh) = o;
            }
        }
        LDS_BARRIER();
    }
}

DI void phase3(const Params& p, char* smem) {
    constexpr int NG = 2 * NB * H_A, NR = 2 * NB * H_B;
    for (int it = blockIdx.x; it < NG; it += gridDim.x) gdn_chain2(p, smem, it);
    for (int it = blockIdx.x; it < NG + NR; it += gridDim.x) if (it >= NG) rwkv_chain2(p, smem, it - NG);
    const int nchain = NG + NR, G = (int)gridDim.x;
    const int tb = G > nchain ? (int)blockIdx.x - nchain : (int)blockIdx.x, ntb = G > nchain ? G - nchain : G;
    if (tb >= 0) {
        __syncthreads();
        const int tid3 = tid_x(), lane = tid3 & 63, wave = tid3 >> 6;
        float* scr = (float*)smem + wave * (64 * 33);
        bf16_t* GUT = (bf16_t*)(p.aux + AUX_GUT);
        constexpr int nkb = D / 64, nnb = DE / 32, per = nkb * nnb;
        for (int it = tb * 8 + wave; it < NEXP * 2 * per; it += ntb * 8) {
            const int e = it / (2 * per), r = it % (2 * per), up = r / per, r2 = r % per, kb = r2 / nnb, nb = r2 % nnb;
            transpose_item((up ? p.in[I_MU_UP] : p.in[I_MG]) + (size_t)e * D * DE, DE, DE, kb * 64, nb * 32, GUT + (size_t)e * 512 * D, D, up ? 2 : 1, scr, lane);
        }
        constexpr int nkb2 = DE / 64, nnb2 = D / 32, per2 = nkb2 * nnb2;
        for (int it = tb * 8 + wave; it < NE_EARLY * per2; it += ntb * 8) {
            const int e = it / per2, r2 = it % per2, kb = r2 / nnb2, nb = r2 % nnb2;
            transpose_item(p.in[I_MD] + (size_t)e * DE * D, D, D, kb * 64, nb * 32, DNT_PTR(p.ws, e), DE, 0, scr, lane);
        }
    }
}

constexpr int P4_SG = 0;
constexpr int P4_XV = P4_SG + 32 * LD128 * 2;
constexpr int P4_YF = P4_XV + 32 * 520 * 2;
static_assert(P4_YF + 32 * 516 * 4 <= LDS_BYTES, "phase4 lds");
DI void phase4(const Params& p, char* smem) {
    const int tid = tid_x(), lane = tid & 63, wave = tid >> 6, r = lane & 31, hh = lane >> 5;
    const bf16_t* PL = (const bf16_t*)(p.ws + WS_PLAT);
    const bf16_t* ODIR = (const bf16_t*)(p.ws + WS_OA); const bf16_t* YDIR = (const bf16_t*)(p.aux + AUX_YDIR);
    const float* BON = (const float*)(p.ws + WS_BONUS); const float* mu = p.in[I_MU]; const bf16_t* G2T = (const bf16_t*)(p.ws + WS_G2T);
    bf16_t* OA = (bf16_t*)(p.ws + WS_OA); bf16_t* OB = (bf16_t*)(p.ws + WS_OB);
    bf16_t* SG = (bf16_t*)(smem + P4_SG); bf16_t* XV = (bf16_t*)(smem + P4_XV); float* YF = (float*)(smem + P4_YF);
    for (int it = blockIdx.x; it < T_LAT / 32; it += gridDim.x) {
        const int tok0 = it * 32, b = tok0 / S, l0 = tok0 % S;
        __syncthreads();
        for (int q = tid; q < 32 * 80; q += NTHREADS) {
            const int t = q / 80, c8 = q % 80;
            const int l = l0 + t;
            const int bcol = c8 < 16 ? 1792 + c8 * 8 : 1024 + (c8 - 16) * 8;
            float cu[8], o[8];
            unpack8(*(const u32x4*)(PL + (size_t)(b * S + l) * IN_COLS + COL_B0 + bcol), cu);
#pragma unroll
            for (int e = 0; e < 8; ++e) o[e] = c8 < 16 ? fsigmoid(cu[e]) : cu[e];
            u32x4 w; w.x = pk2(o[0], o[1]); w.y = pk2(o[2], o[3]); w.z = pk2(o[4], o[5]); w.w = pk2(o[6], o[7]);
            if (c8 < 16) *(u32x4*)(SG + t * LD128 + c8 * 8) = w; else *(u32x4*)(XV + t * 520 + (c8 - 16) * 8) = w;
        }
        for (int q = tid; q < 32 * 64; q += NTHREADS) {
            const int t = q >> 6, c8 = q & 63, tok = tok0 + t;
            float a0[8], a1[8];
            unpack8(*(const u32x4*)(YDIR + (size_t)tok * 512 + c8 * 8), a0); unpack8(*(const u32x4*)(YDIR + ((size_t)T_LAT + tok) * 512 + c8 * 8), a1);
            f32x4 s0 = {a0[0] + a1[0], a0[1] + a1[1], a0[2] + a1[2], a0[3] + a1[3]}, s1 = {a0[4] + a1[4], a0[5] + a1[5], a0[6] + a1[6], a0[7] + a1[7]};
            *(f32x4*)(YF + t * 516 + c8 * 8) = s0; *(f32x4*)(YF + t * 516 + c8 * 8 + 4) = s1;
        }
        __syncthreads();
        {
            unsigned q0[16], q1[16], zq[16];
#pragma unroll
            for (int k = 0; k < 16; ++k) {
                const int pi = wave * 16 + k, t = pi >> 2, h = pi & 3, tok = tok0 + t;
                const size_t o0 = (size_t)tok * 512 + h * 128 + 2 * lane;
                q0[k] = *(const unsigned*)(ODIR + o0); q1[k] = *(const unsigned*)(ODIR + (size_t)T_LAT * 512 + o0); zq[k] = *(const unsigned*)(PL + (size_t)tok * IN_COLS + 1536 + h * 128 + 2 * lane);
            }
            const float on0 = p.in[I_ONORM][2 * lane], on1 = p.in[I_ONORM][2 * lane + 1];
#pragma unroll
            for (int k = 0; k < 16; ++k) {
                const int pi = wave * 16 + k, t = pi >> 2, h = pi & 3, tok = tok0 + t;
                const size_t o0 = (size_t)tok * 512 + h * 128 + 2 * lane;
                const float a0 = bf2f((bf16_t)(q0[k] & 0xffffu)) + bf2f((bf16_t)(q1[k] & 0xffffu)), a1 = bf2f((bf16_t)(q0[k] >> 16)) + bf2f((bf16_t)(q1[k] >> 16));
                const float ss = wave_sum_fast(a0 * a0 + a1 * a1);
                const float rstd = frsq(ss * (1.f / 128.f) + 1e-6f);
                const float z0 = bf2f((bf16_t)(zq[k] & 0xffffu)), z1 = bf2f((bf16_t)(zq[k] >> 16));
                *(unsigned*)(OA + o0) = pk2(a0 * rstd * on0 * fsilu(z0), a1 * rstd * on1 * fsilu(z1));
            }
        }
        __syncthreads();
        {
            const int h = wave;
            f32x16 acc0 = zero16(), acc1 = zero16();
#pragma unroll
            for (int s2 = 0; s2 < 8; ++s2) {
                const bf16x8 a = ld_nat(SG + r * LD128, s2, hh);
                const bf16x8 b0 = *(const bf16x8*)(G2T + (size_t)(64 * h + r) * 128 + 16 * s2 + 8 * hh), b1 = *(const bf16x8*)(G2T + (size_t)(64 * h + 32 + r) * 128 + 16 * s2 + 8 * hh);
                acc0 = MFMA32(a, b0, acc0); acc1 = MFMA32(a, b1, acc1);
            }
            const int c0 = 64 * h + r, c1 = c0 + 32;
            const float lg0 = p.in[I_LNG][c0], lb0 = p.in[I_LNB][c0], lg1 = p.in[I_LNG][c1], lb1 = p.in[I_LNB][c1];
            float bonv[16];
#pragma unroll
            for (int g = 0; g < 16; ++g) { const int tok = tok0 + crow(g, hh); bonv[g] = BON[(size_t)tok * 8 + h] + BON[((size_t)T_LAT + tok) * 8 + h]; }
#pragma unroll
            for (int g = 0; g < 16; ++g) {
                const int i = crow(g, hh), tok = tok0 + i;
                const float y0 = YF[i * 516 + c0], y1 = YF[i * 516 + c1];
                const float mean = half_sum(y0 + y1, hh) * (1.f / 64.f); const float d0 = y0 - mean, d1 = y1 - mean;
                const float var = half_sum(d0 * d0 + d1 * d1, hh) * (1.f / 64.f); const float rs = frsq(var + 64e-5f);
                const float bon = bonv[g];
                const float o0 = (d0 * rs * lg0 + lb0 + bon * bf2f(XV[i * 520 + c0])) * acc0[g], o1 = (d1 * rs * lg1 + lb1 + bon * bf2f(XV[i * 520 + c1])) * acc1[g];
                OB[(size_t)tok * 512 + c0] = f2bf(o0); OB[(size_t)tok * 512 + c1] = f2bf(o1);
            }
        }
    }
}

DI void phase5(const Params& p, char* smem) {
    const bf16_t* OA = (const bf16_t*)(p.ws + WS_OA); const bf16_t* OB = (const bf16_t*)(p.ws + WS_OB);
    const bf16_t* WA = (const bf16_t*)(p.ws + WS_WOA); const bf16_t* WB = (const bf16_t*)(p.ws + WS_WOB);
    const bf16_t* PL = (const bf16_t*)(p.ws + WS_PLAT); bf16_t* Y = (bf16_t*)(p.aux + AUX_Y);
    if (USE_G8) {
        constexpr int NT8 = D / 256, MT8 = T_LAT / 256;
        constexpr int GLD = 264;
        static_assert(256 * GLD * 2 <= LDS_BYTES, "gate tile lds");
        bf16_t* GT = (bf16_t*)smem;
        auto stage_gates = [&](int brow, int gcol0) {
            const int tid = tid_x();
            u32x4 gv[16];
#pragma unroll
            for (int i = 0; i < 16; ++i) { const int ch = tid + i * NTHREADS, row = ch >> 5, c16 = ch & 31; gv[i] = *(const u32x4*)(PL + (size_t)(brow + row) * IN_COLS + gcol0 + c16 * 8); }
#pragma unroll
            for (int i = 0; i < 16; ++i) { const int ch = tid + i * NTHREADS, row = ch >> 5, c16 = ch & 31; *(u32x4*)(GT + row * GLD + c16 * 8) = gv[i]; }
            __syncthreads();
        };
        for (int t = blockIdx.x; t < MT8 * NT8; t += gridDim.x) {
            int mt, nt; if (!g8::tile_order(t, MT8, NT8, mt, nt)) break;
            const int brow = mt * 256, bcol = nt * 256;
            g8::Acc acc; g8::acc_zero(acc);
            g8::kloop(acc, smem, OA, 512, WA, 512, 512, brow, bcol);
            stage_gates(brow, COL_G0 + bcol);
            g8::for_each_quad(acc, brow, bcol, [&](int row, int col, const f32x4& v) {
                const u32x2 gq = *(const u32x2*)(GT + (row - brow) * GLD + (col - bcol));
                const float g0 = bf2f((bf16_t)(gq.x & 0xffffu)), g1 = bf2f((bf16_t)(gq.x >> 16)), g2 = bf2f((bf16_t)(gq.y & 0xffffu)), g3 = bf2f((bf16_t)(gq.y >> 16));
                u32x2 o; o.x = pk2(fsigmoid(g0) * v.x, fsigmoid(g1) * v.y); o.y = pk2(fsigmoid(g2) * v.z, fsigmoid(g3) * v.w);
                *(u32x2*)(Y + (size_t)row * D + col) = o;
            });
            __syncthreads();
            g8::acc_zero(acc);
            g8::kloop(acc, smem, OB, 512, WB, 512, 512, brow, bcol);
            stage_gates(brow, COL_G0 + D + bcol);
            g8::for_each_quad(acc, brow, bcol, [&](int row, int col, const f32x4& v) {
                const u32x2 gq = *(const u32x2*)(GT + (row - brow) * GLD + (col - bcol));
                const float g0 = bf2f((bf16_t)(gq.x & 0xffffu)), g1 = bf2f((bf16_t)(gq.x >> 16)), g2 = bf2f((bf16_t)(gq.y & 0xffffu)), g3 = bf2f((bf16_t)(gq.y >> 16));
#ifdef EMU
                const unsigned long long tq = *(const unsigned long long*)(Y + (size_t)row * D + col);
#else
                const unsigned long long tq = __hip_atomic_load((const unsigned long long*)(Y + (size_t)row * D + col), __ATOMIC_RELAXED, __HIP_MEMORY_SCOPE_AGENT);
#endif
                const unsigned tlo = (unsigned)tq, thi = (unsigned)(tq >> 32);
                const float t0 = bf2f((bf16_t)(tlo & 0xffffu)), t1 = bf2f((bf16_t)(tlo >> 16)), t2 = bf2f((bf16_t)(thi & 0xffffu)), t3 = bf2f((bf16_t)(thi >> 16));
                u32x2 o; o.x = pk2(t0 + fsigmoid(g0) * v.x, t1 + fsigmoid(g1) * v.y); o.y = pk2(t2 + fsigmoid(g2) * v.z, t3 + fsigmoid(g3) * v.w);
                *(u32x2*)(Y + (size_t)row * D + col) = o;
            });
            __syncthreads();
        }
        return;
    }
    constexpr int MR5 = 2, BM5 = 64 * MR5; constexpr int NT = D / 128, MT = T_LAT / BM5;
    for (int t = blockIdx.x; t < MT * NT; t += gridDim.x) {
        const int mt = t / NT, nt = t % NT, row0 = mt * BM5;
        f32x4 acca[MR5][4], accb[MR5][4]; acc_zero(acca); acc_zero(accb);
        gemm_kloop(acca, smem, [&](int i) { return OA + (size_t)(row0 + i) * 512; }, WA + (size_t)nt * 128 * 512, 512, 512);
        gemm_kloop(accb, smem, [&](int i) { return OB + (size_t)(row0 + i) * 512; }, WB + (size_t)nt * 128 * 512, 512, 512);
        const int t2 = tid_x(), l2 = t2 & 63, w2 = t2 >> 6; const int wr = w2 >> 1, wc = w2 & 1, fr = l2 & 15, fq = l2 >> 4;
#pragma unroll
        for (int m = 0; m < MR5; ++m)
#pragma unroll
            for (int n = 0; n < 4; ++n)
#pragma unroll
                for (int j = 0; j < 4; ++j) {
                    const int row = row0 + wr * 16 * MR5 + m * 16 + fq * 4 + j, col = nt * 128 + wc * 64 + n * 16 + fr;
                    const float ga = bf2f(PL[(size_t)row * IN_COLS + COL_G0 + col]), gb = bf2f(PL[(size_t)row * IN_COLS + COL_G0 + D + col]);
                    Y[(size_t)row * D + col] = f2bf(sigmoidf_(ga) * acca[m][n][j] + sigmoidf_(gb) * accb[m][n][j]);
                }
    }
}

DI void phase6(const Params& p, char* smem) {
    const bf16_t* Y = (const bf16_t*)(p.aux + AUX_Y); const bf16_t* WO = (const bf16_t*)(p.ws + WS_WOUT);
    const float* mod = (const float*)(p.ws + WS_MOD); float* Hh = (float*)(p.ws + WS_H);
    if (USE_G8) {
        constexpr int NT = D / 256, MT = T_LAT / 256;
        const float* X = p.in[I_X];
        for (int t = blockIdx.x; t < MT * NT; t += gridDim.x) {
            int mt, nt; if (!g8::tile_order(t, MT, NT, mt, nt)) break;
            const int brow = mt * 256, bcol = nt * 256;
            g8::Acc acc; g8::acc_zero(acc);
            g8::kloop(acc, smem, Y, D, WO, D, D, brow, bcol);
            g8::for_each_quad(acc, brow, bcol, [&](int row, int col, const f32x4& v) {
                const int b = row / S; const f32x4 xv = *(const f32x4*)(X + (size_t)row * D + col), gv = *(const f32x4*)(mod + (size_t)b * 6 * D + 2 * D + col);
                f32x4 o; o.x = xv.x + gv.x * v.x; o.y = xv.y + gv.y * v.y; o.z = xv.z + gv.z * v.z; o.w = xv.w + gv.w * v.w;
                *(f32x4*)(Hh + (size_t)row * D + col) = o;
            });
        }
    } else {
        const int tid = tid_x(), lane = tid & 63, wave = tid >> 6, wr = wave >> 1, wc = wave & 1, fr = lane & 15, fq = lane >> 4;
        constexpr int NT = D / 128, MT = T_LAT / BM;
        for (int t = blockIdx.x; t < MT * NT; t += gridDim.x) {
            const int mt = t / NT, nt = t % NT, row0 = mt * BM;
            f32x4 acc[MREP][4]; acc_zero(acc);
            gemm_kloop(acc, smem, [&](int i) { return Y + (size_t)(row0 + i) * D; }, WO + (size_t)nt * 128 * D, D, D);
#pragma unroll
            for (int m = 0; m < MREP; ++m)
#pragma unroll
                for (int n = 0; n < 4; ++n)
#pragma unroll
                    for (int j = 0; j < 4; ++j) {
                        const int row = row0 + wr * 16 * MREP + m * 16 + fq * 4 + j, col = nt * 128 + wc * 64 + n * 16 + fr, b = row / S;
                        Hh[(size_t)row * D + col] = p.in[I_X][(size_t)row * D + col] + mod[(size_t)b * 6 * D + 2 * D + col] * acc[m][n][j];
                    }
        }
    }
    __syncthreads();
    const int tid6 = tid_x(), lane = tid6 & 63, wave = tid6 >> 6;
    const int gw = blockIdx.x * 8 + wave, ngw = gridDim.x * 8;
    float* scr = (float*)smem + wave * (64 * 33);
    {
        constexpr int nkb = DE / 64, nnb = D / 32, per = nkb * nnb;
        for (int it = gw; it < (NEXP - NE_EARLY) * per; it += ngw) {
            const int e = NE_EARLY + it / per, r2 = it % per, kb = r2 / nnb, nb = r2 % nnb;
            transpose_item(p.in[I_MD] + (size_t)e * DE * D, D, D, kb * 64, nb * 32, DNT_PTR(p.ws, e), DE, 0, scr, lane);
        }
    }
}

#ifdef EMU
#define MFMA32F(a, b, c) emu_mfma32_f32((a), (b), (c))
#else
#define MFMA32F(a, b, c) __builtin_amdgcn_mfma_f32_32x32x2f32((a), (b), (c), 0, 0, 0)
#endif
constexpr int TB_LD = D + 4;
static_assert(32 * TB_LD * 4 <= LDS_BYTES && 8 * 32 * 64 * 4 <= LDS_BYTES, "phase7 lds");
DI void phase7(const Params& p, char* smem) {
    const int tid = tid_x(), lane = tid & 63, wave = tid >> 6, r = lane & 31, hh = lane >> 5;
    const float* Hh = (const float*)(p.ws + WS_H); const float* mod = (const float*)(p.ws + WS_MOD); const float* WRT = (const float*)(p.ws + WS_WRT);
    bf16_t* Tt = (bf16_t*)(p.ws + WS_T); int* cnt = (int*)(p.ws + WS_CNT); int* rowlist = (int*)(p.ws + WS_ROWLIST); float* pairw = (float*)(p.ws + WS_PAIRW);
    float* tb = (float*)smem;
    float* bias = (float*)(smem + LDS_BYTES - 1024);
    int* lcnt = (int*)(smem + LDS_BYTES - 768);
    int* lbase = lcnt + 32;
    if (tid < 36) bias[tid] = tid < 4 ? p.in[I_RGB][tid] : p.in[I_REB][tid - 4];
    f32x4 x[4][D / 256];
    int itn = blockIdx.x;
    if (itn < T_LAT / 32) {
#pragma unroll
        for (int tt = 0; tt < 4; ++tt)
#pragma unroll
            for (int j = 0; j < D / 256; ++j) x[tt][j] = *(const f32x4*)(Hh + (size_t)(itn * 32 + wave * 4 + tt) * D + j * 256 + lane * 4);
    }
    for (int it = blockIdx.x; it < T_LAT / 32; it += gridDim.x) {
        const int tok0 = it * 32;
        __syncthreads();
        if (tid < 32) lcnt[tid] = 0;
#pragma unroll
        for (int tt = 0; tt < 4; ++tt) {
            const int ti = wave * 4 + tt, tok = tok0 + ti, b = tok / S;
            float ss = 0.f;
#pragma unroll
            for (int j = 0; j < D / 256; ++j) ss += x[tt][j].x * x[tt][j].x + x[tt][j].y * x[tt][j].y + x[tt][j].z * x[tt][j].z + x[tt][j].w * x[tt][j].w;
            ss = wave_sum_fast(ss);
            const float rstd = frsq(ss * (1.0f / D) + 1e-6f);
#pragma unroll
            for (int j = 0; j < D / 256; ++j) {
                const int k = j * 256 + lane * 4;
                const f32x4 g = *(const f32x4*)(p.in[I_NFFN] + k), sh = *(const f32x4*)(mod + (size_t)b * 6 * D + 3 * D + k), sc = *(const f32x4*)(mod + (size_t)b * 6 * D + 4 * D + k);
                f32x4 o; o.x = x[tt][j].x * rstd * g.x * (1.f + sc.x) + sh.x; o.y = x[tt][j].y * rstd * g.y * (1.f + sc.y) + sh.y;
                o.z = x[tt][j].z * rstd * g.z * (1.f + sc.z) + sh.z; o.w = x[tt][j].w * rstd * g.w * (1.f + sc.w) + sh.w;
                *(f32x4*)(tb + ti * TB_LD + k) = o;
                u32x2 ob; ob.x = pk2(o.x, o.y); ob.y = pk2(o.z, o.w);
                *(u32x2*)(Tt + (size_t)tok * D + k) = ob;
            }
        }
        itn = it + gridDim.x;
        if (itn < T_LAT / 32) {
#pragma unroll
            for (int tt = 0; tt < 4; ++tt)
#pragma unroll
                for (int j = 0; j < D / 256; ++j) x[tt][j] = *(const f32x4*)(Hh + (size_t)(itn * 32 + wave * 4 + tt) * D + j * 256 + lane * 4);
        }
        LDS_BARRIER();
        f32x16 a0 = zero16(), a1 = zero16();
        {
            const int kbeg = wave * (D / 8);
            const float* arow = tb + r * TB_LD + kbeg + 4 * hh;
            const float* b0row = WRT + (size_t)(4 + r) * D + kbeg + 4 * hh;
            const float* b1row = WRT + (size_t)(r < 4 ? r : 0) * D + kbeg + 4 * hh;
            const float m1 = r < 4 ? 1.f : 0.f;
#pragma unroll 4
            for (int g = 0; g < D / 64; ++g) {
                const f32x4 av = *(const f32x4*)(arow + 8 * g), b0 = *(const f32x4*)(b0row + 8 * g); const f32x4 b1 = *(const f32x4*)(b1row + 8 * g) * m1;
                a0 = MFMA32F(av.x, b0.x, a0); a1 = MFMA32F(av.x, b1.x, a1); a0 = MFMA32F(av.y, b0.y, a0); a1 = MFMA32F(av.y, b1.y, a1);
                a0 = MFMA32F(av.z, b0.z, a0); a1 = MFMA32F(av.z, b1.z, a1); a0 = MFMA32F(av.w, b0.w, a0); a1 = MFMA32F(av.w, b1.w, a1);
            }
        }
        LDS_BARRIER();
        {
            float* part = tb + wave * (32 * 64);
#pragma unroll
            for (int g = 0; g < 16; ++g) { const int i = crow(g, hh); part[i * 64 + r] = a0[g]; part[i * 64 + 32 + r] = a1[g]; }
        }
        LDS_BARRIER();
        float lsum[4];
        {
            const int i = tid >> 4, c4 = (tid & 15) * 4;
#pragma unroll
            for (int e = 0; e < 4; ++e) { float sacc = 0.f;
#pragma unroll
                for (int w = 0; w < 8; ++w) sacc += tb[w * (32 * 64) + i * 64 + c4 + e];
                lsum[e] = sacc; }
        }
        LDS_BARRIER();
        { const int i = tid >> 4, c4 = (tid & 15) * 4;
#pragma unroll
          for (int e = 0; e < 4; ++e) tb[i * 64 + c4 + e] = lsum[e]; }
        LDS_BARRIER();
        int ex1 = 0, ex2 = 0, rk1 = 0, rk2 = 0; float w1 = 0.f, w2 = 0.f;
        if (tid < 32) {
            const float* L = tb + tid * 64;
            float gl[4];
#pragma unroll
            for (int i = 0; i < 4; ++i) gl[i] = L[32 + i] + bias[i];
            int g = 0; float mx = gl[0];
#pragma unroll
            for (int i = 1; i < 4; ++i) if (gl[i] > mx) { mx = gl[i]; g = i; }
            float se = 0.f;
#pragma unroll
            for (int i = 0; i < 4; ++i) se += fexp(gl[i] - mx);
            const float pg = 1.0f / se;
            int i1 = 0; float l1 = L[g * 8] + bias[4 + g * 8];
            for (int i = 1; i < 8; ++i) { const float v = L[g * 8 + i] + bias[4 + g * 8 + i]; if (v > l1) { l1 = v; i1 = i; } }
            int i2 = -1; float l2 = -3.0e38f;
            for (int i = 0; i < 8; ++i) { const float v = L[g * 8 + i] + bias[4 + g * 8 + i]; if (i != i1 && v > l2) { l2 = v; i2 = i; } }
            const float e2 = fexp(l2 - l1); w1 = pg / (1.f + e2); w2 = pg * e2 / (1.f + e2);
            ex1 = g * 8 + i1; ex2 = g * 8 + i2;
            rk1 = atomicAdd(&lcnt[ex1], 1); rk2 = atomicAdd(&lcnt[ex2], 1);
        }
        LDS_BARRIER();
        if (tid < 32) { const int c = lcnt[tid]; lbase[tid] = c ? atomicAdd(&cnt[tid * CNT_STRIDE], c) : 0; }
        __syncthreads();
        if (tid < 32) {
            const int tok = tok0 + tid;
            rowlist[(size_t)ex1 * CAP + lbase[ex1] + rk1] = tok * 2; pairw[tok * 2] = w1;
            rowlist[(size_t)ex2 * CAP + lbase[ex2] + rk2] = tok * 2 + 1; pairw[tok * 2 + 1] = w2;
        }
    }
}

constexpr int MOE_TM = USE_G8 ? 256 : BM;
DI void moe_tiles(const Params& p, char* smem, int* pre) {
    const int* cnt = (const int*)(p.ws + WS_CNT);
    __syncthreads();
    if (tid_x() == 0) { int s = 0; for (int e = 0; e < NEXP; ++e) { pre[e] = s; s += (cnt[e * CNT_STRIDE] + MOE_TM - 1) / MOE_TM; } pre[NEXP] = s; }
    __syncthreads();
}
DI void moe_up_tile(const Params& p, char* smem, const int* pre, int t) {
    const int* cnt = (const int*)(p.ws + WS_CNT); const int* rowlist = (const int*)(p.ws + WS_ROWLIST);
    const bf16_t* Tt = (const bf16_t*)(p.ws + WS_T); const bf16_t* GUT = (const bf16_t*)(p.aux + AUX_GUT); bf16_t* HID = (bf16_t*)(p.ws + WS_HID);
    const int mg = t >> 1, nt = t & 1; int e = 0;
    while (pre[e + 1] <= mg) ++e;
    const int mt = mg - pre[e], ce = cnt[e * CNT_STRIDE]; const int* rl = rowlist + (size_t)e * CAP;
    g8::Acc acc; g8::acc_zero(acc);
    g8::kloop_g(acc, smem, Tt, [&](int r) { int idx = mt * 256 + r; idx = idx < ce ? idx : ce - 1; return (rl[idx] >> 1) * D; }, GUT + ((size_t)e * 512 + nt * 256) * D, D, D, 0);
    const int t2 = tid_x(), wid = t2 >> 6, l2 = t2 & 63, wr2 = wid >> 2, wc2 = wid & 3, fr2 = l2 & 15, fq2 = l2 >> 4;
    int prs[2][4];
#pragma unroll
    for (int ai = 0; ai < 2; ++ai)
#pragma unroll
        for (int m = 0; m < 4; ++m) { const int idx = mt * 256 + ai * 128 + wr2 * 64 + m * 16 + fr2; prs[ai][m] = idx < ce ? rl[idx] : -1; }
#pragma unroll
    for (int ai = 0; ai < 2; ++ai)
#pragma unroll
        for (int m = 0; m < 4; ++m) {
            if (prs[ai][m] >= 0) {
                const int pair = prs[ai][m];
#pragma unroll
                for (int bj = 0; bj < 2; ++bj) {
                    const f32x4 g = acc[ai][bj][m][0], u = acc[ai][bj][m][1];
                    u32x2 o; o.x = pk2(fsilu(g.x) * u.x, fsilu(g.y) * u.y); o.y = pk2(fsilu(g.z) * u.z, fsilu(g.w) * u.w);
                    *(u32x2*)(HID + (size_t)pair * DE + nt * 128 + bj * 64 + wc2 * 16 + fq2 * 4) = o;
                }
            }
        }
}
DI void moe_down_tile(const Params& p, char* smem, const int* pre, int t) {
    constexpr int NT8 = D / 256;
    const int* cnt = (const int*)(p.ws + WS_CNT); const int* rowlist = (const int*)(p.ws + WS_ROWLIST); const float* pairw = (const float*)(p.ws + WS_PAIRW);
    const bf16_t* HID = (const bf16_t*)(p.ws + WS_HID); bf16_t* OP = (bf16_t*)(p.ws + WS_OPAIR);
    const int mg = t / NT8, nt = t % NT8; int e = 0;
    while (pre[e + 1] <= mg) ++e;
    const int mt = mg - pre[e], ce = cnt[e * CNT_STRIDE]; const int* rl = rowlist + (size_t)e * CAP;
    g8::Acc acc; g8::acc_zero(acc);
    g8::kloop_g(acc, smem, HID, [&](int r) { int idx = mt * 256 + r; idx = idx < ce ? idx : ce - 1; return rl[idx] * DE; }, DNT_PTR(p.ws, e) + (size_t)nt * 256 * DE, DE, DE, 0);
    {
        const int t2 = tid_x(), wid = t2 >> 6, l2 = t2 & 63, wr2 = wid >> 2, wc2 = wid & 3, fr2 = l2 & 15, fq2 = l2 >> 4;
        int prs[2][4]; float pws[2][4];
#pragma unroll
        for (int ai = 0; ai < 2; ++ai)
#pragma unroll
            for (int m = 0; m < 4; ++m) { const int idx = mt * 256 + ai * 128 + wr2 * 64 + m * 16 + fr2; prs[ai][m] = idx < ce ? rl[idx] : -1; }
#pragma unroll
        for (int ai = 0; ai < 2; ++ai)
#pragma unroll
            for (int m = 0; m < 4; ++m) pws[ai][m] = prs[ai][m] >= 0 ? pairw[prs[ai][m]] : 0.f;
#pragma unroll
        for (int ai = 0; ai < 2; ++ai)
#pragma unroll
            for (int m = 0; m < 4; ++m) {
                if (prs[ai][m] >= 0) {
                    const float w = pws[ai][m]; bf16_t* orow = OP + (size_t)prs[ai][m] * D + nt * 256 + wc2 * 32 + fq2 * 4;
#pragma unroll
                    for (int bj = 0; bj < 2; ++bj)
#pragma unroll
                        for (int n = 0; n < 2; ++n) { const f32x4 v = acc[ai][bj][m][n];
                            u32x2 o; o.x = pk2(v.x * w, v.y * w); o.y = pk2(v.z * w, v.w * w); *(u32x2*)(orow + bj * 128 + n * 16) = o; }
                }
            }
    }
}
DI void phase8(const Params& p, char* smem) {
    const int tid = tid_x(), lane = tid & 63, wave = tid >> 6, wr = wave >> 1, wc = wave & 1, fr = lane & 15, fq = lane >> 4;
    int* pre = (int*)(smem + LDS_BYTES - 256);
    moe_tiles(p, smem, pre);
    const int* cnt = (const int*)(p.ws + WS_CNT); const int* rowlist = (const int*)(p.ws + WS_ROWLIST);
    const bf16_t* Tt = (const bf16_t*)(p.ws + WS_T); const bf16_t* GUT = (const bf16_t*)(p.aux + AUX_GUT); bf16_t* HID = (bf16_t*)(p.ws + WS_HID);
    if (USE_G8) {
        if ((int)blockIdx.x < pre[NEXP] * 2) moe_up_tile(p, smem, pre, (int)blockIdx.x);
        return;
    }
    const int ntile = pre[NEXP] * 4;
    for (int t = blockIdx.x; t < ntile; t += gridDim.x) {
        const int mg = t >> 2, nt = t & 3; int e = 0;
        while (pre[e + 1] <= mg) ++e;
        const int mt = mg - pre[e], ce = cnt[e * CNT_STRIDE]; const int* rl = rowlist + (size_t)e * CAP;
        f32x4 acc[MREP][4]; acc_zero(acc);
        gemm_kloop(acc, smem, [&](int i) { int idx = mt * BM + i; idx = idx < ce ? idx : ce - 1; return Tt + (size_t)(rl[idx] >> 1) * D; }, GUT + ((size_t)e * 512 + nt * 128) * D, D, D);
#pragma unroll
        for (int m = 0; m < MREP; ++m)
#pragma unroll
            for (int j = 0; j < 4; ++j) {
                const int idx = mt * BM + wr * 16 * MREP + m * 16 + fq * 4 + j;
                if (idx < ce) {
                    const int pair = rl[idx];
#pragma unroll
                    for (int n = 0; n < 2; ++n) {
                        const float g = acc[m][n][j], u = acc[m][n + 2][j];
                        HID[(size_t)pair * DE + nt * 64 + wc * 32 + n * 16 + fr] = f2bf(siluf_(g) * u);
                    }
                }
            }
    }
}
DI void phase9(const Params& p, char* smem) {
    const int tid = tid_x(), lane = tid & 63, wave = tid >> 6, wr = wave >> 1, wc = wave & 1, fr = lane & 15, fq = lane >> 4;
    int* pre = (int*)(smem + LDS_BYTES - 256);
    moe_tiles(p, smem, pre);
    const int* cnt = (const int*)(p.ws + WS_CNT); const int* rowlist = (const int*)(p.ws + WS_ROWLIST); const float* pairw = (const float*)(p.ws + WS_PAIRW);
    const bf16_t* HID = (const bf16_t*)(p.ws + WS_HID); const bf16_t* DNT = (const bf16_t*)(p.ws + WS_DNT); bf16_t* OP = (bf16_t*)(p.ws + WS_OPAIR);
    if (USE_G8) {
        constexpr int NT8 = D / 256;
        const int G = (int)gridDim.x, NU = pre[NEXP] * 2, NU2 = NU > G ? NU - G : 0, ND = pre[NEXP] * NT8;
        int* cntw = (int*)(p.ws + WS_CNT);
        int* tk = (int*)(smem + LDS_BYTES - 512);
        for (;;) {
            __syncthreads();
            if (tid_x() == 0) *tk = atomicAdd(&cntw[CNT_TICKET], 1);
            __syncthreads();
            const int j = *tk;
            if (j >= NU2 + ND) break;
            if (j < NU2) {
                moe_up_tile(p, smem, pre, G + j);
#ifndef EMU
                asm volatile("s_waitcnt vmcnt(0)" ::: "memory");
#endif
                __syncthreads();
                if (tid_x() == 0) {
#ifndef EMU
                    __builtin_amdgcn_fence(__ATOMIC_RELEASE, "agent");
                    asm volatile("s_waitcnt vmcnt(0)" ::: "memory");
#endif
                    (void)atomicAdd(&cntw[CNT_U2DONE], 1);
                }
            } else {
                const int dt = j - NU2;
                if (2 * (dt / NT8) + 1 >= G) {
                    if (tid_x() == 0) {
#ifndef EMU
                        while (__hip_atomic_load(&cntw[CNT_U2DONE], __ATOMIC_RELAXED, __HIP_MEMORY_SCOPE_AGENT) < NU2) __builtin_amdgcn_s_sleep(2);
                        __builtin_amdgcn_fence(__ATOMIC_ACQUIRE, "agent");
                        asm volatile("s_waitcnt vmcnt(0)" ::: "memory");
#endif
                    }
                    __syncthreads();
                }
                moe_down_tile(p, smem, pre, dt);
            }
        }
        return;
    }
    constexpr int NT = D / 128;
    const int ntile = pre[NEXP] * NT;
    for (int t = blockIdx.x; t < ntile; t += gridDim.x) {
        const int mg = t / NT, nt = t % NT; int e = 0;
        while (pre[e + 1] <= mg) ++e;
        const int mt = mg - pre[e], ce = cnt[e * CNT_STRIDE]; const int* rl = rowlist + (size_t)e * CAP;
        f32x4 acc[MREP][4]; acc_zero(acc);
        gemm_kloop(acc, smem, [&](int i) { int idx = mt * BM + i; idx = idx < ce ? idx : ce - 1; return HID + (size_t)rl[idx] * DE; }, DNT_PTR(p.ws, e) + (size_t)nt * 128 * DE, DE, DE);
#pragma unroll
        for (int m = 0; m < MREP; ++m)
#pragma unroll
            for (int j = 0; j < 4; ++j) {
                const int idx = mt * BM + wr * 16 * MREP + m * 16 + fq * 4 + j;
                if (idx < ce) {
                    const int pair = rl[idx]; const float w = pairw[pair];
#pragma unroll
                    for (int n = 0; n < 4; ++n) OP[(size_t)pair * D + nt * 128 + wc * 64 + n * 16 + fr] = f2bf(acc[m][n][j] * w);
                }
            }
    }
}

DI void phase10(const Params& p, char* smem) {
    const int lane = tid_x() & 63, wave = tid_x() >> 6;
    const int gw = blockIdx.x * 8 + wave, ngw = gridDim.x * 8;
    const float* Hh = (const float*)(p.ws + WS_H); const float* mod = (const float*)(p.ws + WS_MOD); const bf16_t* OP = (const bf16_t*)(p.ws + WS_OPAIR);
    for (int tok = gw; tok < T_LAT; tok += ngw) {
        const int b = tok / S;
        f32x4 x[D / 256]; float ss = 0.f;
#pragma unroll
        for (int j = 0; j < D / 256; ++j) {
            const int k = j * 256 + lane * 4;
            const f32x4 hv = *(const f32x4*)(Hh + (size_t)tok * D + k), g2 = *(const f32x4*)(mod + (size_t)b * 6 * D + 5 * D + k);
            const u32x2 p0 = *(const u32x2*)(OP + (size_t)(tok * 2) * D + k), p1 = *(const u32x2*)(OP + (size_t)(tok * 2 + 1) * D + k);
            f32x4 m;
            m.x = bf2f((bf16_t)(p0.x & 0xffffu)) + bf2f((bf16_t)(p1.x & 0xffffu)); m.y = bf2f((bf16_t)(p0.x >> 16)) + bf2f((bf16_t)(p1.x >> 16));
            m.z = bf2f((bf16_t)(p0.y & 0xffffu)) + bf2f((bf16_t)(p1.y & 0xffffu)); m.w = bf2f((bf16_t)(p0.y >> 16)) + bf2f((bf16_t)(p1.y >> 16));
            x[j].x = hv.x + g2.x * m.x; x[j].y = hv.y + g2.y * m.y; x[j].z = hv.z + g2.z * m.z; x[j].w = hv.w + g2.w * m.w;
            ss += x[j].x * x[j].x + x[j].y * x[j].y + x[j].z * x[j].z + x[j].w * x[j].w;
        }
        ss = wave_sum(ss);
        const float rstd = 1.0f / sqrtf(ss * (1.0f / D) + 1e-6f);
#pragma unroll
        for (int j = 0; j < D / 256; ++j) {
            const int k = j * 256 + lane * 4; const f32x4 g = *(const f32x4*)(p.in[I_FIN] + k);
            f32x4 o; o.x = x[j].x * rstd * g.x; o.y = x[j].y * rstd * g.y; o.z = x[j].z * rstd * g.z; o.w = x[j].w * rstd * g.w;
            *(f32x4*)(p.out + (size_t)tok * D + k) = o;
        }
    }
}

DI void run_phase(const Params& p, int ph, char* smem) {
    switch (ph) {
        case PH_MOD: phase0(p, smem); break;
        case PH_U: phase1(p, smem); break;
        case PH_P: phase2(p, smem); break;
        case PH_HALO: phase_halo(p, smem); break;
        case PH_FIR: phase_fir(p, smem); break;
        case PH_CHAINS: phase3(p, smem); break;
        case PH_POST: phase4(p, smem); break;
        case PH_MERGE: phase5(p, smem); break;
        case PH_WOUT: phase6(p, smem); break;
        case PH_ROUTER: phase7(p, smem); break;
        case PH_UP: phase8(p, smem); break;
        case PH_DOWN: phase9(p, smem); break;
        default: phase10(p, smem); break;
    }
}

#ifndef EMU
namespace cg = cooperative_groups;
#define XB_TMO      128
#define XB_XCNT(j)  (256  + 64 * (j))
#define XB_XSUB(j)  (1280 + 64 * (j))
#define XB_XGEN(j)  (2304 + 64 * (j))
#define XB_TOP      3328
#define XB_TOPGEN   3392
#define XB_SPIN_CAP (1u << 20)
DI unsigned xb_ld(unsigned* p) { return __hip_atomic_load(p, __ATOMIC_RELAXED, __HIP_MEMORY_SCOPE_AGENT); }
DI unsigned xb_add(unsigned* p, unsigned v) { return __hip_atomic_fetch_add(p, v, __ATOMIC_RELAXED, __HIP_MEMORY_SCOPE_AGENT); }
DI unsigned xb_xcc_id() { return (unsigned)__builtin_amdgcn_s_getreg((3 << 11) | 20) & 0xFu; }
#define XB_SPIN(cond, bar) do { unsigned _sp = 0; while (cond) { __builtin_amdgcn_s_sleep(1); \
    if ((++_sp & 255u) == 0u) { if (xb_ld(&(bar)[XB_TMO])) break; if (_sp > XB_SPIN_CAP) { atomicAdd(&(bar)[XB_TMO], 1u); break; } } } } while (0)
DI void xcd_barrier_post(unsigned* bar) { if (threadIdx.x == 0) (void)xb_add(&bar[XB_XCNT(xb_xcc_id())], 1u); }
DI void xcd_barrier_complete(unsigned* bar, unsigned x, unsigned& nloc, unsigned& nx) {
    const unsigned G = gridDim.x;
    unsigned sum, cnt, mine, sp = 0u;
    for (;;) {
        sum = 0u; cnt = 0u; mine = 0u;
#pragma unroll
        for (unsigned j = 0; j < 16; ++j) { const unsigned c = xb_ld(&bar[XB_XCNT(j)]); sum += c; cnt += (c > 0u) ? 1u : 0u; mine = (j == x) ? c : mine; }
        if (sum == G) break;
        __builtin_amdgcn_s_sleep(1);
        if ((++sp & 255u) == 0u) { if (xb_ld(&bar[XB_TMO])) break; if (sp > XB_SPIN_CAP) { atomicAdd(&bar[XB_TMO], 1u); break; } }
    }
    nloc = mine > 0u ? mine : 1u; nx = cnt > 0u ? cnt : 1u;
}
DI void xcd_barrier(unsigned* bar, volatile unsigned* st) {
    asm volatile("s_waitcnt vmcnt(0)" ::: "memory");
    __syncthreads();
    if (threadIdx.x == 0) {
        __builtin_amdgcn_s_waitcnt(0);
        const unsigned x = xb_xcc_id();
        unsigned nloc = st[0], nx = st[1];
        if (nloc == 0u) { xcd_barrier_complete(bar, x, nloc, nx); st[0] = nloc; st[1] = nx; }
        const unsigned old = xb_add(&bar[XB_XSUB(x)], 1u);
        const unsigned gen = old / nloc;
        if (old + 1u == (gen + 1u) * nloc) {
            __builtin_amdgcn_fence(__ATOMIC_RELEASE, "agent");
            asm volatile("s_waitcnt vmcnt(0)" ::: "memory");
            const unsigned og = xb_add(&bar[XB_TOP], 1u);
            const unsigned tg = og / nx;
            if (og + 1u == (tg + 1u) * nx) xb_add(&bar[XB_TOPGEN], 1u);
            else XB_SPIN(xb_ld(&bar[XB_TOPGEN]) == tg, bar);
            __builtin_amdgcn_fence(__ATOMIC_ACQUIRE, "agent");
            xb_add(&bar[XB_XGEN(x)], 1u);
            asm volatile("s_waitcnt vmcnt(0)" ::: "memory");
        } else {
            XB_SPIN(xb_ld(&bar[XB_XGEN(x)]) == gen, bar);
            __builtin_amdgcn_fence(__ATOMIC_ACQUIRE, "agent");
            asm volatile("s_waitcnt vmcnt(0)" ::: "memory");
        }
    }
    __syncthreads();
}
__global__ void __launch_bounds__(NTHREADS) mk_forward(Params p) {
    extern __shared__ __attribute__((aligned(16))) char smem[];
    typedef const Params __attribute__((address_space(4)))* KPtr;
    volatile unsigned* xst = (volatile unsigned*)(smem + LDS_BYTES);
    if (threadIdx.x < 2) xst[threadIdx.x] = 0u;
    xcd_barrier_post((unsigned*)(p.ws + WS_XBAR));
#define PHASE(k, fn) { KPtr kp = (KPtr)__builtin_amdgcn_kernarg_segment_ptr(); asm volatile("" : "+s"(kp)); fn(*(const Params*)kp, smem); \
        unsigned* xbar = (unsigned*)(((const Params*)kp)->ws + WS_XBAR); \
        if ((k) + 1 < NPHASES) xcd_barrier(xbar, xst); }
    PHASE(0, phase0) PHASE(1, phase1) PHASE(2, phase2)
    if (!USE_G8) PHASE(3, phase_halo)
    PHASE(4, phase_fir) PHASE(5, phase3) PHASE(6, phase4)
    PHASE(7, phase5) PHASE(8, phase6) PHASE(9, phase7) PHASE(10, phase8) PHASE(11, phase9) PHASE(12, phase10)
#undef PHASE
}

extern "C" void kernel_launch(void* const* d_in, const int* in_sizes, int n_in, void* d_out, int out_size, void* d_ws, size_t ws_size, hipStream_t stream) {
    static int grid_blocks = 0;
    if (grid_blocks == 0) {
        if (n_in != 35 || out_size != T_LAT * D || ws_size < WS_END || (size_t)out_size * 4 < AUX_END) {
            fprintf(stderr, "kernel_launch: unexpected shapes (n_in %d out %d ws %zu need %zu aux need %zu)\n", n_in, out_size, ws_size, (size_t)WS_END, (size_t)AUX_END);
            grid_blocks = -1; return;
        }
        int dev = 0, cus = 0, per_cu = 0;
        hipGetDevice(&dev);
        hipDeviceGetAttribute(&cus, hipDeviceAttributeMultiprocessorCount, dev);
        hipFuncSetAttribute((const void*)mk_forward, hipFuncAttributeMaxDynamicSharedMemorySize, LDS_BYTES + 256);
        hipOccupancyMaxActiveBlocksPerMultiprocessor(&per_cu, (const void*)mk_forward, NTHREADS, LDS_BYTES + 256);
        if (per_cu < 1) { fprintf(stderr, "kernel_launch: occupancy query says %d blocks/CU\n", per_cu); per_cu = 1; }
        if (per_cu > 1) per_cu = 1;
        grid_blocks = cus * per_cu;
    }
    if (grid_blocks < 0) return;
    Params p{};
    for (int i = 0; i < 35; ++i) p.in[i] = (const float*)d_in[i];
    p.out = (float*)d_out; p.ws = (char*)d_ws; p.aux = (char*)d_out;
    p.ph_lo = 0; p.ph_hi = NPHASES;
    (void)hipMemsetAsync((char*)d_ws + WS_XBAR, 0, 3456 * 4, stream);
    void* args[] = {&p};
    hipError_t e = hipLaunchCooperativeKernel((const void*)mk_forward, dim3(grid_blocks), dim3(NTHREADS), args, LDS_BYTES + 256, stream);
    if (e != hipSuccess) fprintf(stderr, "cooperative launch failed: %s (grid %d)\n", hipGetErrorString(e), grid_blocks);
}
#endif
```

```cpp
#ifndef EMU
#include <hip/hip_runtime.h>
#include <hip/hip_cooperative_groups.h>
#include <cstdio>
#endif
#include <stdint.h>
#include <stddef.h>

#ifndef CFG_D
#define CFG_D 1024
#define CFG_B 8
#define CFG_S 2048
#define CFG_CTX 256
#endif
#ifndef MK_LAUNCHES
#define MK_LAUNCHES 1
#endif

typedef unsigned short bf16_t;
typedef short bf16x8 __attribute__((ext_vector_type(8)));
typedef float f32x4 __attribute__((ext_vector_type(4)));
typedef unsigned u32x4 __attribute__((ext_vector_type(4)));
typedef unsigned u32x2 __attribute__((ext_vector_type(2)));

#define DI __device__ __forceinline__
DI int tid_x() { int t = (int)threadIdx.x;
#ifndef EMU
    asm volatile("" : "+v"(t));
#endif
    return t; }

constexpr int D = CFG_D, NB = CFG_B, S = CFG_S, CTXL = CFG_CTX;
constexpr int GW = 64, ROWS = S / GW;
constexpr int T_CTX = NB * CTXL, T_LAT = NB * S, T_ALL = T_CTX + T_LAT;
constexpr int H_A = 4, H_B = 8;
constexpr int A_COLS = 2064, B_COLS = 1920;
constexpr int IN_COLS = A_COLS + B_COLS + 2 * D;
constexpr int COL_B0 = A_COLS, COL_G0 = A_COLS + B_COLS;
constexpr int CTX_COLS = COL_G0;
constexpr int NP = ((IN_COLS + 127) / 128) * 128;
constexpr int NEXP = 32, DE = 256;
constexpr int NV = NB + 1;
constexpr int NTHREADS = 512;
constexpr int MREP = (T_CTX % 256 == 0 && T_LAT % 256 == 0) ? 4 : 2;
constexpr int BM = 64 * MREP;
constexpr int NPHASES = 13;
enum { PH_MOD = 0, PH_U, PH_P, PH_HALO, PH_FIR, PH_CHAINS, PH_POST, PH_MERGE, PH_WOUT, PH_ROUTER, PH_UP, PH_DOWN, PH_FINAL };
constexpr int LDS_BYTES = 155648;
constexpr int CAP = T_LAT;

static_assert(D % 256 == 0 && S % 64 == 0 && CTXL % 64 == 0 && T_CTX % BM == 0 && T_LAT % BM == 0, "shape");

constexpr size_t al256(size_t x) { return (x + 255) & ~(size_t)255; }
constexpr int CNT_STRIDE = 64;
constexpr size_t WS_CNT = 512 + 3456 * 4 + 256;
constexpr int CNT_TICKET = 2 * CNT_STRIDE + 16, CNT_U2DONE = 3 * CNT_STRIDE + 16;
constexpr size_t WS_BAR = 256;
constexpr size_t WS_XBAR = 512;
constexpr size_t WS_MOD = 512 + 3456 * 4 + 256 + 32 * 64 * 4;
constexpr size_t WS_AB = al256(WS_MOD + (size_t)NV * 6 * D * 4);
constexpr size_t WS_BONUS = al256(WS_AB + (size_t)T_ALL * 16 * 4);
constexpr size_t WS_PAIRW = al256(WS_BONUS + (size_t)2 * T_LAT * 8 * 4);
constexpr size_t WS_ROWLIST = al256(WS_PAIRW + (size_t)T_LAT * 2 * 4);
constexpr size_t WS_WRT = al256(WS_ROWLIST + (size_t)NEXP * CAP * 4);
constexpr size_t WS_G2T = al256(WS_WRT + (size_t)36 * D * 4);
constexpr size_t WS_WOA = al256(WS_G2T + (size_t)512 * 128 * 2);
constexpr size_t WS_WOB = al256(WS_WOA + (size_t)D * 512 * 2);
constexpr size_t WS_WOUT = al256(WS_WOB + (size_t)D * 512 * 2);
constexpr size_t WS_OA = al256(WS_WOUT + (size_t)D * D * 2);
constexpr size_t WS_OB = al256(WS_OA + (size_t)T_LAT * 512 * 2);
constexpr size_t WS_HALO_A = WS_OA;
constexpr size_t WS_HALO_B = WS_OA + al256((size_t)(T_ALL / 64) * 4 * 1536 * 2);
static_assert(WS_HALO_B + (size_t)(T_ALL / 64) * 2 * 1920 * 2 <= WS_OB + (size_t)T_LAT * 512 * 2, "halo buffers");
constexpr size_t WS_DNT = WS_OA;
constexpr size_t WS_SPARE_END = al256(WS_OB + (size_t)T_LAT * 512 * 2) > al256(WS_DNT + (size_t)NEXP * D * DE * 2) ? al256(WS_OB + (size_t)T_LAT * 512 * 2) : al256(WS_DNT + (size_t)NEXP * D * DE * 2);
constexpr size_t WS_P = WS_SPARE_END;
constexpr size_t WS_PLAT = WS_P;
constexpr size_t WS_PCTX = al256(WS_PLAT + (size_t)T_LAT * IN_COLS * 2);
constexpr size_t WS_P_END = al256(WS_PCTX + (size_t)T_CTX * CTX_COLS * 2);
constexpr size_t WS_H = WS_P;
constexpr size_t WS_T = al256(WS_H + (size_t)T_LAT * D * 4);
constexpr size_t WS_HID = al256(WS_T + (size_t)T_LAT * D * 2);
constexpr size_t WS_OPAIR = al256(WS_HID + (size_t)T_LAT * 2 * DE * 2);
constexpr size_t WS_P2_END = al256(WS_OPAIR + (size_t)T_LAT * 2 * D * 2);
constexpr size_t WS_END0 = WS_P_END > WS_P2_END ? WS_P_END : WS_P2_END;
constexpr size_t WS_GUARANTEED = (size_t)256 << 20;
constexpr int NE_EARLY = WS_END0 >= WS_GUARANTEED ? 0 : ((WS_GUARANTEED - WS_END0) / ((size_t)D * DE * 2) >= (size_t)NEXP ? NEXP : (int)((WS_GUARANTEED - WS_END0) / ((size_t)D * DE * 2)));
constexpr size_t WS_DNT2 = WS_END0;
constexpr size_t WS_END = WS_DNT2 + (size_t)NE_EARLY * D * DE * 2;
constexpr size_t AUX_WINT = 0;
constexpr size_t AUX_U = al256((size_t)NP * D * 2);
constexpr size_t AUX_YDIR = 0;
constexpr size_t AUX_Y = 0;
constexpr size_t AUX_GUT = (size_t)T_LAT * D * 2 > (size_t)2 * T_LAT * 512 * 2 ? (size_t)T_LAT * D * 2 : (size_t)2 * T_LAT * 512 * 2;
constexpr size_t AUX_END1 = AUX_U + (size_t)T_ALL * D * 2;
constexpr size_t AUX_END2 = AUX_YDIR + (size_t)2 * T_LAT * 512 * 2;
static_assert(AUX_YDIR + (size_t)2 * T_LAT * 512 * 2 <= AUX_GUT && AUX_Y + (size_t)T_LAT * D * 2 <= AUX_GUT, "aux overlap");
constexpr size_t AUX_END3 = AUX_GUT + (size_t)NEXP * 512 * D * 2;
constexpr size_t AUX_END = (AUX_END1 > AUX_END2 ? (AUX_END1 > AUX_END3 ? AUX_END1 : AUX_END3) : (AUX_END2 > AUX_END3 ? AUX_END2 : AUX_END3));

#define DNT_PTR(ws, e) ((bf16_t*)((ws) + ((e) < NE_EARLY ? WS_DNT2 : WS_DNT)) + (size_t)(e) * D * DE)
struct Params {
    const float* in[35];
    float* out;
    char* ws;
    char* aux;
    int ph_lo, ph_hi;
};
enum { I_X = 0, I_C, I_CTX, I_CCTX, I_ADAW, I_ADAB, I_NMIX, I_NFFN, I_WIN, I_CONV, I_ALOG, I_DTB, I_ONORM, I_MU, I_W0, I_W2, I_A0, I_A2, I_G2, I_KK, I_KA, I_RK, I_LNG, I_LNB, I_WOA, I_WOB, I_WOUT, I_RG, I_RGB, I_RE, I_REB, I_MG, I_MU_UP, I_MD, I_FIN };

DI float bf2f(bf16_t v) { union { unsigned u; float f; } x; x.u = ((unsigned)v) << 16; return x.f; }
#ifdef EMU
DI bf16_t f2bf(float f) { union { float f; unsigned u; } x; x.f = f; unsigned u = x.u; u += 0x7fffu + ((u >> 16) & 1u); return (bf16_t)(u >> 16); }
DI unsigned pk2(float lo, float hi) { return (unsigned)f2bf(lo) | ((unsigned)f2bf(hi) << 16); }
#else
typedef __bf16 hbf16x2 __attribute__((ext_vector_type(2)));
typedef float f32x2_ __attribute__((ext_vector_type(2)));
DI bf16_t f2bf(float f) { return __builtin_bit_cast(unsigned short, (__bf16)f); }
DI unsigned pk2(float lo, float hi) { const f32x2_ v = {lo, hi}; return __builtin_bit_cast(unsigned, __builtin_convertvector(v, hbf16x2)); }
#endif
DI float sigmoidf_(float x) { return 1.0f / (1.0f + expf(-x)); }
DI float siluf_(float x) { return x / (1.0f + expf(-x)); }
DI float softplusf_(float x) { return x > 20.f ? x : log1pf(expf(x)); }
DI float wave_sum(float v) {
#pragma unroll
    for (int o = 1; o < 64; o <<= 1) v += __shfl_xor(v, o);
    return v;
}
#ifdef EMU
#define MFMA16(a, b, c) emu_mfma16((a), (b), (c))
#define WAVE_SYNC() emu::wave_bar()
#else
#define MFMA16(a, b, c) __builtin_amdgcn_mfma_f32_16x16x32_bf16((a), (b), (c), 0, 0, 0)
#define WAVE_SYNC() asm volatile("s_waitcnt lgkmcnt(0)" ::: "memory")
#endif
#ifdef EMU
#define LDS_BARRIER() __syncthreads()
#else
#define LDS_BARRIER() do { asm volatile("s_waitcnt lgkmcnt(0)" ::: "memory"); __builtin_amdgcn_s_barrier(); asm volatile("" ::: "memory"); } while (0)
#endif

typedef float f32x16 __attribute__((ext_vector_type(16)));
typedef float f32x2_ac __attribute__((ext_vector_type(2)));
typedef short bf16x4 __attribute__((ext_vector_type(4)));
#ifdef EMU
#define MFMA32(a, b, c) emu_mfma32((a), (b), (c))
DI float fexp(float x) { return expf(x); }
DI float flog(float x) { return logf(x); }
DI float frcp(float x) { return 1.0f / x; }
DI float frsq(float x) { return 1.0f / sqrtf(x); }
DI float wave_sum_fast(float v) { return wave_sum(v); }
#else
#define MFMA32(a, b, c) __builtin_amdgcn_mfma_f32_32x32x16_bf16((a), (b), (c), 0, 0, 0)
DI float fexp(float x) { return __expf(x); }
DI float flog(float x) { return __logf(x); }
DI float frcp(float x) { return __builtin_amdgcn_rcpf(x); }
DI float frsq(float x) { return __builtin_amdgcn_rsqf(x); }
#define DPP_ADD(v, ctrl) ((v) + __builtin_bit_cast(float, __builtin_amdgcn_update_dpp(0, __builtin_bit_cast(int, (v)), (ctrl), 0xf, 0xf, false)))
DI float wave_sum_fast(float v) {
    v = DPP_ADD(v, 0xB1); v = DPP_ADD(v, 0x4E); v = DPP_ADD(v, 0x141); v = DPP_ADD(v, 0x140);
    const int iv = __builtin_bit_cast(int, v);
    return (__builtin_bit_cast(float, __builtin_amdgcn_readlane(iv, 0)) + __builtin_bit_cast(float, __builtin_amdgcn_readlane(iv, 16))) +
           (__builtin_bit_cast(float, __builtin_amdgcn_readlane(iv, 32)) + __builtin_bit_cast(float, __builtin_amdgcn_readlane(iv, 48)));
}
#endif
DI float fsigmoid(float x) { return frcp(1.0f + fexp(-x)); }
DI float fsilu(float x) { return x * fsigmoid(x); }
DI float fsoftplus(float x) { return fmaxf(x, 0.f) + flog(1.f + fexp(-fabsf(x))); }
DI float ftanh(float x) { return 1.0f - 2.0f * frcp(1.0f + fexp(2.0f * x)); }

constexpr int LDS_ROW = 40;
constexpr int GEMM_A_BYTES = BM * LDS_ROW * 2, GEMM_B_BYTES = 128 * LDS_ROW * 2;
template <int MR, class ARow>
DI void gemm_kloop(f32x4 (&acc)[MR][4], char* smem, ARow arow, const bf16_t* Bt, int ldb, int K) {
    constexpr int BM = 64 * MR;
    const int tid = tid_x(), lane = tid & 63, wave = tid >> 6, wr = wave >> 1, wc = wave & 1, fr = lane & 15, fq = lane >> 4;
    bf16_t* As = (bf16_t*)smem;
    bf16_t* Bs = (bf16_t*)(smem + 2 * GEMM_A_BYTES);
    constexpr int ACH = BM * 4 / NTHREADS;
    static_assert(ACH >= 1, "tile");
    const bf16_t* ap[ACH];
#pragma unroll
    for (int i = 0; i < ACH; ++i) { const int q = tid + i * NTHREADS; ap[i] = arow(q >> 2) + (q & 3) * 8; }
    const bf16_t* bp = Bt + (size_t)(tid >> 2) * ldb + (tid & 3) * 8;
    u32x4 ra[ACH], rb;
#pragma unroll
    for (int i = 0; i < ACH; ++i) ra[i] = *(const u32x4*)(ap[i]);
    rb = *(const u32x4*)(bp);
    const int nk = K / 32;
    for (int kt = 0; kt < nk; ++kt) {
        const int buf = kt & 1;
#pragma unroll
        for (int i = 0; i < ACH; ++i) { const int q = tid + i * NTHREADS; *(u32x4*)(As + (buf * BM + (q >> 2)) * LDS_ROW + (q & 3) * 8) = ra[i]; }
        *(u32x4*)(Bs + (buf * 128 + (tid >> 2)) * LDS_ROW + (tid & 3) * 8) = rb;
        __syncthreads();
        if (kt + 1 < nk) {
#pragma unroll
            for (int i = 0; i < ACH; ++i) ra[i] = *(const u32x4*)(ap[i] + (kt + 1) * 32);
            rb = *(const u32x4*)(bp + (kt + 1) * 32);
        }
        bf16x8 af[MR], bfr[4];
#pragma unroll
        for (int m = 0; m < MR; ++m) af[m] = *(const bf16x8*)(As + (buf * BM + wr * 16 * MR + m * 16 + fr) * LDS_ROW + fq * 8);
#pragma unroll
        for (int n = 0; n < 4; ++n) bfr[n] = *(const bf16x8*)(Bs + (buf * 128 + wc * 64 + n * 16 + fr) * LDS_ROW + fq * 8);
#pragma unroll
        for (int m = 0; m < MR; ++m)
#pragma unroll
            for (int n = 0; n < 4; ++n) acc[m][n] = MFMA16(af[m], bfr[n], acc[m][n]);
    }
    __syncthreads();
}
template <int MR>
DI void acc_zero(f32x4 (&acc)[MR][4]) {
#pragma unroll
    for (int m = 0; m < MR; ++m)
#pragma unroll
        for (int n = 0; n < 4; ++n) acc[m][n] = (f32x4){0.f, 0.f, 0.f, 0.f};
}

namespace g8 {
constexpr int BM = 256, BK = 64, HALF = 128, HT = HALF * BK;
constexpr int LDS_NEED = 8 * HT * 2;
DI int lds_byte(int r, int c) { const int st = (r >> 4) * 2 + (c >> 5), rr = r & 15, cc = c & 31, ob = rr * 64 + cc * 2; return st * 1024 + (ob ^ (((ob >> 9) & 1) << 5)); }
DI void stage_rc(int b, int& R, int& C) { const int st = b / 1024, sb = b % 1024, swz = sb ^ (((sb >> 9) & 1) << 5); R = (st >> 1) * 16 + swz / 64; C = (st & 1) * 32 + (swz % 64) / 2; }
#ifdef EMU
#define G8_GLDS(src, dst) emu_global_load_lds16((src), (dst))
#define G8_WAIT_V(n)
#define G8_WAIT_L(n)
#define G8_BAR __syncthreads()
#define G8_SCHED
#define G8_PRIO(x)
#else
#define G8_GLDS(src, dst) __builtin_amdgcn_global_load_lds((const unsigned*)(src), (__attribute__((address_space(3))) unsigned*)(dst), 16, 0, 0)
#define G8_WAIT_V(n) asm volatile("s_waitcnt vmcnt(" #n ")" ::: "memory")
#define G8_WAIT_L(n) asm volatile("s_waitcnt lgkmcnt(" #n ")" ::: "memory")
#define G8_BAR __builtin_amdgcn_s_barrier()
#define G8_SCHED __builtin_amdgcn_sched_barrier(0)
#define G8_PRIO(x) __builtin_amdgcn_s_setprio(x)
#endif
typedef f32x4 Acc[2][2][4][2];
template <class AOff>
DI void kloop_g(Acc& acc, char* smem, const bf16_t* A, AOff aoff, const bf16_t* Bt, int ldb, int K, int bcol) {
    bf16_t* shm = (bf16_t*)smem;
    const int tid = tid_x(), wid = tid >> 6, lane = tid & 63, wr = wid >> 2, wc = wid & 3, fr = lane & 15, fq = lane >> 4;
    int ao[2][2];
#pragma unroll
    for (int h = 0; h < 2; ++h)
#pragma unroll
        for (int i = 0; i < 2; ++i) { int R, C; stage_rc(tid * 16 + i * 8192, R, C); ao[h][i] = aoff(h * HALF + R) + C; }
#define G8_STAGE_A(P, h, kt) do { for (int _i = 0; _i < 2; ++_i) { const int _b = tid * 16 + _i * 8192; G8_GLDS(A + (size_t)ao[h][_i] + (size_t)(kt) * BK, (char*)(P) + _b); } } while (0)
#define G8_SA(b, h) (shm + ((b) * 2 + (h)) * HT)
#define G8_SB(b, h) (shm + (4 + (b) * 2 + (h)) * HT)
#define G8_STAGE(P, BASE, LD, br, kt) do { const bf16_t* _g = (BASE) + (size_t)(br) * (LD) + (size_t)(kt) * BK; \
    for (int _i = 0; _i < 2; ++_i) { const int _b = tid * 16 + _i * 8192; int _r, _c; stage_rc(_b, _r, _c); G8_GLDS(_g + (size_t)_r * (LD) + _c, (char*)(P) + _b); } } while (0)
#define G8_LDA(dst, b, h) for (int m = 0; m < 4; ++m) for (int k = 0; k < 2; ++k) dst[m][k] = *(const bf16x8*)((const char*)G8_SA(b, h) + lds_byte(wr * 64 + m * 16 + fr, k * 32 + fq * 8))
#define G8_LDB(dst, b, h) for (int n = 0; n < 2; ++n) for (int k = 0; k < 2; ++k) dst[n][k] = *(const bf16x8*)((const char*)G8_SB(b, h) + lds_byte(wc * 32 + n * 16 + fr, k * 32 + fq * 8))
#define G8_MMA(ai, bj, At_, Bt_) do { G8_PRIO(1); for (int m = 0; m < 4; ++m) for (int n = 0; n < 2; ++n) for (int k = 0; k < 2; ++k) \
    acc[ai][bj][m][n] = MFMA16(Bt_[n][k], At_[m][k], acc[ai][bj][m][n]); G8_PRIO(0); } while (0)
    bf16x8 At[4][2], B0[2][2], B1[2][2];
    const int nt = K / BK;
    G8_STAGE(G8_SB(0, 0), Bt, ldb, bcol, 0); G8_STAGE_A(G8_SA(0, 0), 0, 0);
    G8_STAGE(G8_SB(0, 1), Bt, ldb, bcol + HALF, 0); G8_STAGE_A(G8_SA(0, 1), 1, 0);
    if (wr == 1) G8_BAR;
    G8_WAIT_V(4); G8_BAR;
    G8_STAGE(G8_SB(1, 0), Bt, ldb, bcol, 1); G8_STAGE_A(G8_SA(1, 0), 0, 1); G8_STAGE(G8_SB(1, 1), Bt, ldb, bcol + HALF, 1);
    G8_WAIT_V(6); G8_BAR;
    for (int t = 0; t < nt - 2; t += 2) {
        G8_LDB(B0, 0, 0); G8_SCHED; G8_LDA(At, 0, 0); G8_STAGE_A(G8_SA(1, 1), 1, t + 1);
        G8_WAIT_L(8); G8_BAR; G8_WAIT_L(0); G8_MMA(0, 0, At, B0); G8_BAR; G8_SCHED;
        G8_LDB(B1, 0, 1); G8_STAGE(G8_SB(0, 0), Bt, ldb, bcol, t + 2);
        G8_BAR; G8_WAIT_L(0); G8_MMA(0, 1, At, B1); G8_BAR;
        G8_LDA(At, 0, 1); G8_STAGE_A(G8_SA(0, 0), 0, t + 2);
        G8_BAR; G8_WAIT_L(0); G8_MMA(1, 0, At, B0); G8_BAR; G8_SCHED;
        G8_STAGE(G8_SB(0, 1), Bt, ldb, bcol + HALF, t + 2);
        G8_WAIT_V(6); G8_BAR; G8_MMA(1, 1, At, B1); G8_BAR;
        G8_LDB(B0, 1, 0); G8_SCHED; G8_LDA(At, 1, 0); G8_STAGE_A(G8_SA(0, 1), 1, t + 2);
        G8_WAIT_L(8); G8_BAR; G8_WAIT_L(0); G8_MMA(0, 0, At, B0); G8_BAR; G8_SCHED;
        G8_LDB(B1, 1, 1); G8_STAGE(G8_SB(1, 0), Bt, ldb, bcol, t + 3);
        G8_BAR; G8_WAIT_L(0); G8_MMA(0, 1, At, B1); G8_BAR;
        G8_LDA(At, 1, 1); G8_STAGE_A(G8_SA(1, 0), 0, t + 3);
        G8_BAR; G8_WAIT_L(0); G8_MMA(1, 0, At, B0); G8_BAR; G8_SCHED;
        G8_STAGE(G8_SB(1, 1), Bt, ldb, bcol + HALF, t + 3);
        G8_WAIT_V(6); G8_BAR; G8_MMA(1, 1, At, B1); G8_BAR;
    }
    { G8_LDB(B0, 0, 0); G8_LDA(At, 0, 0); G8_STAGE_A(G8_SA(1, 1), 1, nt - 1);
      G8_BAR; G8_WAIT_L(0); G8_MMA(0, 0, At, B0); G8_BAR;
      G8_LDB(B1, 0, 1); G8_BAR; G8_WAIT_L(0); G8_MMA(0, 1, At, B1); G8_BAR;
      G8_LDA(At, 0, 1); G8_WAIT_V(4); G8_BAR; G8_WAIT_L(0); G8_MMA(1, 0, At, B0); G8_MMA(1, 1, At, B1); G8_BAR; }
    { G8_LDB(B0, 1, 0); G8_LDA(At, 1, 0); G8_WAIT_V(2); G8_BAR; G8_WAIT_L(0); G8_MMA(0, 0, At, B0); G8_BAR;
      G8_LDB(B1, 1, 1); G8_WAIT_V(0); G8_BAR; G8_WAIT_L(0); G8_MMA(0, 1, At, B1); G8_BAR;
      G8_LDA(At, 1, 1); G8_BAR; G8_WAIT_L(0); G8_MMA(1, 0, At, B0); G8_MMA(1, 1, At, B1); G8_BAR; }
    if (wr == 0) G8_BAR;
#undef G8_SA
#undef G8_SB
#undef G8_STAGE
#undef G8_STAGE_A
#undef G8_LDA
#undef G8_LDB
#undef G8_MMA
}
DI void kloop(Acc& acc, char* smem, const bf16_t* A, int lda, const bf16_t* Bt, int ldb, int K, int brow, int bcol) {
    kloop_g(acc, smem, A, [&](int r) { return (brow + r) * lda; }, Bt, ldb, K, bcol);
}
DI bool tile_order(int L, int nM, int nN, int& pm, int& pn) {
    constexpr int NXCD = 8, WGM = 8;
    const int nwg = nM * nN; if (L >= nwg) return false;
    int wgid = L; { const int q = nwg / NXCD, r = nwg % NXCD, xcd = wgid % NXCD, off = wgid / NXCD; wgid = (xcd < r ? xcd * (q + 1) : r * (q + 1) + (xcd - r) * q) + off; }
    const int nig = WGM * nN, gid = wgid / nig, fm = gid * WGM, gsz = (nM - fm) < WGM ? (nM - fm) : WGM;
    pm = fm + ((wgid % nig) % gsz); pn = (wgid % nig) / gsz; return true;
}
DI void acc_zero(Acc& acc) {
#pragma unroll
    for (int a = 0; a < 2; ++a)
#pragma unroll
        for (int b = 0; b < 2; ++b)
#pragma unroll
            for (int m = 0; m < 4; ++m)
#pragma unroll
                for (int n = 0; n < 2; ++n) acc[a][b][m][n] = (f32x4){0.f, 0.f, 0.f, 0.f};
}
template <class F> DI void for_each_quad(const Acc& acc, int brow, int bcol, F f) {
    const int tid = tid_x(), wid = tid >> 6, lane = tid & 63, wr = wid >> 2, wc = wid & 3, fr = lane & 15, fq = lane >> 4;
#pragma unroll
    for (int ai = 0; ai < 2; ++ai)
#pragma unroll
        for (int m = 0; m < 4; ++m)
#pragma unroll
            for (int bj = 0; bj < 2; ++bj)
#pragma unroll
                for (int n = 0; n < 2; ++n) f(brow + ai * HALF + wr * 64 + m * 16 + fr, bcol + bj * HALF + wc * 32 + n * 16 + fq * 4, acc[ai][bj][m][n]);
}
}

constexpr bool USE_G8 = ((NB * CTXL) % 256 == 0) && ((NB * S) % 256 == 0) && (NP % 256 == 0) && (D % 256 == 0) && (D >= 256);
DI int gu_row(int c, int up) {
    if (USE_G8) return (c >> 7) * 256 + ((c >> 6) & 1) * 128 + ((c >> 4) & 3) * 32 + (up ? 16 : 0) + (c & 15);
    return (c >> 6) * 128 + ((c >> 5) & 1) * 64 + ((c >> 4) & 1) * 16 + (c & 15) + (up ? 32 : 0);
}
DI void transpose_item(const float* W, int N, int Nvalid, int k0, int n0, bf16_t* WT, int ldt, int mode, float* scr, int lane) {
    float tv[32];
#pragma unroll
    for (int i = 0; i < 32; ++i) {
        const int kk = 2 * i + (lane >> 5), n = n0 + (lane & 31);
        tv[i] = (n < Nvalid) ? W[(size_t)(k0 + kk) * N + n] : 0.f;
    }
#pragma unroll
    for (int i = 0; i < 32; ++i) scr[(2 * i + (lane >> 5)) * 33 + (lane & 31)] = tv[i];
    WAVE_SYNC();
    const int c = lane & 7;
#pragma unroll
    for (int j = 0; j < 4; ++j) {
        const int nl = (lane >> 3) + 8 * j; const float* s = scr + (8 * c) * 33 + nl;
        u32x4 o; o.x = pk2(s[0], s[33]); o.y = pk2(s[2 * 33], s[3 * 33]); o.z = pk2(s[4 * 33], s[5 * 33]); o.w = pk2(s[6 * 33], s[7 * 33]);
        const int n = n0 + nl; const int row = mode == 0 ? n : gu_row(n, mode == 2);
        *(u32x4*)(WT + (size_t)row * ldt + k0 + 8 * c) = o;
    }
    WAVE_SYNC();
}
DI void transpose_matrix(const float* W, int K, int N, int Npad, bf16_t* WT, int mode, char* smem, int gw, int ngw, int& base) {
    const int lane = tid_x() & 63, wave = tid_x() >> 6;
    float* scr = (float*)smem + wave * (64 * 33);
    const int nkb = K / 64, nnb = Npad / 32, nitems = nkb * nnb;
    int first = ((gw - base) % ngw + ngw) % ngw;
    for (int it = first; it < nitems; it += ngw) {
        const int kb = it / nnb, nb = it % nnb;
        transpose_item(W, N, N, kb * 64, nb * 32, WT, K, mode, scr, lane);
    }
    base = (base + nitems) % ngw;
}

DI void phase0(const Params& p, char* smem) {
    const int tid = tid_x(), lane = tid & 63, wave = tid >> 6;
    if (blockIdx.x == 0 && tid < NEXP) ((int*)(p.ws + WS_CNT))[tid * CNT_STRIDE] = 0;
    if (blockIdx.x == 0 && tid < 2) ((int*)(p.ws + WS_CNT))[tid ? CNT_U2DONE : CNT_TICKET] = 0;
    if (blockIdx.x == 0 && tid == 0) *(unsigned*)(p.ws + WS_BAR) = 0u;
    float* sil = (float*)smem;
    float* red = sil + NV * D;
    const int nitems = 6 * D / 32;
    bool did = false;
    for (int it = blockIdx.x; it < nitems; it += gridDim.x) {
        if (!did) {
            for (int i = tid; i < NV * D; i += NTHREADS) { const int v = i / D, k = i % D; const float cv = v < NB ? p.in[I_C][v * D + k] : p.in[I_CCTX][k]; sil[i] = siluf_(cv); }
            did = true;
        }
        __syncthreads();
        const int col = it * 32 + (lane & 31), rp = lane >> 5;
        float acc[NV];
#pragma unroll
        for (int v = 0; v < NV; ++v) acc[v] = 0.f;
        const int r0 = wave * (D / 8);
        float wv[D / 16];
#pragma unroll
        for (int i = 0; i < D / 16; ++i) wv[i] = p.in[I_ADAW][(size_t)(r0 + 2 * i + rp) * (6 * D) + col];
#pragma unroll
        for (int i = 0; i < D / 16; ++i) {
            const int row = r0 + 2 * i + rp;
#pragma unroll
            for (int v = 0; v < NV; ++v) acc[v] += sil[v * D + row] * wv[i];
        }
#pragma unroll
        for (int v = 0; v < NV; ++v) red[((wave * 2 + rp) * NV + v) * 32 + (lane & 31)] = acc[v];
        __syncthreads();
        if (tid < NV * 32) {
            const int v = tid / 32, cl = tid % 32; float s = p.in[I_ADAB][it * 32 + cl];
            for (int g = 0; g < 16; ++g) s += red[(g * NV + v) * 32 + cl];
            ((float*)(p.ws + WS_MOD))[(size_t)v * 6 * D + it * 32 + cl] = s;
        }
    }
    __syncthreads();
    const int gw = blockIdx.x * 8 + wave, ngw = gridDim.x * 8; int base = 0;
    {
        float* scr = (float*)smem + wave * (64 * 33);
        const int nkb = D / 64, nnb = NP / 32, nitems2 = nkb * nnb;
        for (int it = gw; it < nitems2; it += ngw) { const int kb = it / nnb, nb = it % nnb; transpose_item(p.in[I_WIN], IN_COLS, IN_COLS, kb * 64, nb * 32, (bf16_t*)(p.aux + AUX_WINT), D, 0, scr, lane); }
        base = nitems2 % ngw;
    }
    { float* WRT = (float*)(p.ws + WS_WRT);
      for (int i = blockIdx.x * NTHREADS + tid; i < 36 * D; i += gridDim.x * NTHREADS) { const int j = i / D, k = i % D; WRT[i] = j < 4 ? p.in[I_RG][(size_t)k * 4 + j] : p.in[I_RE][(size_t)k * 32 + (j - 4)]; } }
    transpose_matrix(p.in[I_WOA], 512, D, D, (bf16_t*)(p.ws + WS_WOA), 0, smem, gw, ngw, base);
    transpose_matrix(p.in[I_WOB], 512, D, D, (bf16_t*)(p.ws + WS_WOB), 0, smem, gw, ngw, base);
    transpose_matrix(p.in[I_WOUT], D, D, D, (bf16_t*)(p.ws + WS_WOUT), 0, smem, gw, ngw, base);
    transpose_matrix(p.in[I_G2], 128, 512, 512, (bf16_t*)(p.ws + WS_G2T), 0, smem, gw, ngw, base);
}

constexpr int NSEG = T_ALL / 64, NSEG_CTX = T_CTX / 64;
DI void halo_store(const Params& p, int row, int col, const u32x2& o) {
    int seq, b, j;
    if (row < T_CTX) { seq = 0; b = row / CTXL; j = row % CTXL; } else { seq = 1; const int rr = row - T_CTX; b = rr / S; j = rr % S; }
    const int L = seq ? S : CTXL; const int segbase = seq ? NSEG_CTX + b * (S / 64) : b * (CTXL / 64);
    if (col < 1536) {
        const int jm = j & 63;
        if (jm >= 62 && j + 2 < L) { const int g = segbase + (j >> 6) + 1; *(u32x2*)((bf16_t*)(p.ws + WS_HALO_A) + ((size_t)g * 4 + (jm - 62)) * 1536 + col) = o; }
        if (jm < 2 && j >= 64) { const int g = segbase + (j >> 6) - 1; *(u32x2*)((bf16_t*)(p.ws + WS_HALO_A) + ((size_t)g * 4 + 2 + jm) * 1536 + col) = o; }
    } else if (col >= COL_B0 && col < COL_B0 + 1920) {
        const int js = seq ? (j % GW) * ROWS + j / GW : j; const int jm = js & 63;
        if (jm == 63 && js + 1 < L) { const int g = segbase + (js >> 6) + 1; *(u32x2*)((bf16_t*)(p.ws + WS_HALO_B) + ((size_t)g * 2 + 0) * 1920 + (col - COL_B0)) = o; }
        if (jm == 0 && js >= 64) { const int g = segbase + (js >> 6) - 1; *(u32x2*)((bf16_t*)(p.ws + WS_HALO_B) + ((size_t)g * 2 + 1) * 1920 + (col - COL_B0)) = o; }
    }
}
DI void halo_zero_fill(const Params& p) {
    const int tid = tid_x(), lane = tid & 63, wave = tid >> 6; const int gw = blockIdx.x * 8 + wave, ngw = gridDim.x * 8;
    bf16_t* HA = (bf16_t*)(p.ws + WS_HALO_A); bf16_t* HB = (bf16_t*)(p.ws + WS_HALO_B);
    for (int it = gw; it < NSEG * 2; it += ngw) {
        const int g = it >> 1, side = it & 1;
        const bool ctx = g < NSEG_CTX; const int sg = ctx ? g % (CTXL / 64) : (g - NSEG_CTX) % (S / 64); const int nsg = ctx ? CTXL / 64 : S / 64;
        const bool edge = side ? (sg == nsg - 1) : (sg == 0);
        if (!edge) continue;
        for (int c = lane; c < 384; c += 64) *(u32x4*)(HA + ((size_t)g * 4 + 2 * side) * 1536 + c * 8) = (u32x4){0u, 0u, 0u, 0u};
        for (int c = lane; c < 240; c += 64) *(u32x4*)(HB + ((size_t)g * 2 + side) * 1920 + c * 8) = (u32x4){0u, 0u, 0u, 0u};
    }
}
DI void phase1(const Params& p, char* smem) {
    if (USE_G8) halo_zero_fill(p);
    const int lane = tid_x() & 63, wave = tid_x() >> 6;
    const int gw = blockIdx.x * 8 + wave, ngw = gridDim.x * 8;
    const float* mod = (const float*)(p.ws + WS_MOD);
    bf16_t* U = (bf16_t*)(p.aux + AUX_U);
    auto rowsrc = [&](int r) -> const float* { return r < T_CTX ? p.in[I_CTX] + (size_t)r * D : p.in[I_X] + (size_t)(r - T_CTX) * D; };
    f32x4 xn[D / 256];
    if (gw < T_ALL) {
#pragma unroll
        for (int j = 0; j < D / 256; ++j) xn[j] = *(const f32x4*)(rowsrc(gw) + j * 256 + lane * 4);
    }
    for (int r = gw; r < T_ALL; r += ngw) {
        const int v = r < T_CTX ? NB : (r - T_CTX) / S;
        f32x4 x[D / 256]; float ss = 0.f;
#pragma unroll
        for (int j = 0; j < D / 256; ++j) { x[j] = xn[j]; ss += x[j].x * x[j].x + x[j].y * x[j].y + x[j].z * x[j].z + x[j].w * x[j].w; }
        if (r + ngw < T_ALL) {
#pragma unroll
            for (int j = 0; j < D / 256; ++j) xn[j] = *(const f32x4*)(rowsrc(r + ngw) + j * 256 + lane * 4);
        }
        ss = wave_sum_fast(ss);
        const float rstd = frsq(ss * (1.0f / D) + 1e-6f);
#pragma unroll
        for (int j = 0; j < D / 256; ++j) {
            const int k = j * 256 + lane * 4;
            const f32x4 g = *(const f32x4*)(p.in[I_NMIX] + k), sh = *(const f32x4*)(mod + (size_t)v * 6 * D + k), sc = *(const f32x4*)(mod + (size_t)v * 6 * D + D + k);
            float o0 = x[j].x * rstd * g.x * (1.f + sc.x) + sh.x, o1 = x[j].y * rstd * g.y * (1.f + sc.y) + sh.y;
            float o2 = x[j].z * rstd * g.z * (1.f + sc.z) + sh.z, o3 = x[j].w * rstd * g.w * (1.f + sc.w) + sh.w;
            u32x2 o; o.x = pk2(o0, o1); o.y = pk2(o2, o3);
            *(u32x2*)(U + (size_t)r * D + k) = o;
        }
    }
}

DI void phase2(const Params& p, char* smem) {
    const bf16_t* U = (const bf16_t*)(p.aux + AUX_U); const bf16_t* WT = (const bf16_t*)(p.aux + AUX_WINT);
    bf16_t* PL = (bf16_t*)(p.ws + WS_PLAT); bf16_t* PC = (bf16_t*)(p.ws + WS_PCTX); float* AB = (float*)(p.ws + WS_AB);
    if (USE_G8) {
        constexpr int NT = NP / 256, MT = T_ALL / 256, NT_CTX = (CTX_COLS + 255) / 256;
        for (int t = blockIdx.x; t < MT * NT; t += gridDim.x) {
            int mt, nt; if (!g8::tile_order(t, MT, NT, mt, nt)) break;
            const int brow = mt * 256, bcol = nt * 256; const bool isctx = brow < T_CTX;
            if (isctx && nt >= NT_CTX) continue;
            g8::Acc acc; g8::acc_zero(acc);
            g8::kloop(acc, smem, U, D, WT, D, D, brow, bcol);
            constexpr int OLD_ = 264; bf16_t* OT = (bf16_t*)smem;
            g8::for_each_quad(acc, brow, bcol, [&](int row, int col, const f32x4& v) {
                u32x2 o; o.x = pk2(v.x, v.y); o.y = pk2(v.z, v.w);
                *(u32x2*)(OT + (row - brow) * OLD_ + (col - bcol)) = o;
                if (col >= 2048 && col < 2064) *(f32x4*)(AB + (size_t)row * 16 + (col - 2048)) = v;
                halo_store(p, row, col, o);
            });
            __syncthreads();
            {
                const int tid = tid_x(); const int ncols = isctx ? CTX_COLS : IN_COLS;
                bf16_t* dst = isctx ? PC + (size_t)brow * CTX_COLS : PL + (size_t)(brow - T_CTX) * IN_COLS;
#pragma unroll
                for (int i = 0; i < 16; ++i) {
                    const int ch = tid + i * NTHREADS, row = ch >> 5, c8 = (ch & 31) * 8, col = bcol + c8;
                    if (col < ncols) *(u32x4*)(dst + (size_t)row * ncols + col) = *(const u32x4*)(OT + row * OLD_ + c8);
                }
            }
            __syncthreads();
        }
        return;
    }
    const int tid = tid_x(), lane = tid & 63, wave = tid >> 6, wr = wave >> 1, wc = wave & 1, fr = lane & 15, fq = lane >> 4;
    constexpr int NT = NP / 128, MT = T_ALL / BM, NT_CTX = (CTX_COLS + 127) / 128;
    for (int t = blockIdx.x; t < MT * NT; t += gridDim.x) {
        const int mt = t / NT, nt = t % NT; const int row0 = mt * BM; const bool isctx = row0 < T_CTX;
        if (isctx && nt >= NT_CTX) continue;
        f32x4 acc[MREP][4]; acc_zero(acc);
        gemm_kloop(acc, smem, [&](int i) { return U + (size_t)(row0 + i) * D; }, WT + (size_t)nt * 128 * D, D, D);
#pragma unroll
        for (int m = 0; m < MREP; ++m)
#pragma unroll
            for (int n = 0; n < 4; ++n)
#pragma unroll
                for (int j = 0; j < 4; ++j) {
                    const int row = row0 + wr * 16 * MREP + m * 16 + fq * 4 + j, col = nt * 128 + wc * 64 + n * 16 + fr; const float v = acc[m][n][j];
                    if (isctx) { if (col < CTX_COLS) PC[(size_t)row * CTX_COLS + col] = f2bf(v); }
                    else { if (col < IN_COLS) PL[(size_t)(row - T_CTX) * IN_COLS + col] = f2bf(v); }
                    if (col >= 2048 && col < 2064) AB[(size_t)row * 16 + (col - 2048)] = v;
                }
    }
}


DI int crow(int g, int h) { return (g & 3) + 8 * (g >> 2) + 4 * h; }
template <int S_> DI bf16x8 pack_acc(const f32x16& x) {
    u32x4 r;
    r.x = pk2(x[8 * S_ + 0], x[8 * S_ + 1]); r.y = pk2(x[8 * S_ + 2], x[8 * S_ + 3]); r.z = pk2(x[8 * S_ + 4], x[8 * S_ + 5]); r.w = pk2(x[8 * S_ + 6], x[8 * S_ + 7]);
    return __builtin_bit_cast(bf16x8, r);
}
DI bf16x8 ld_nat(const bf16_t* row, int s, int h) { return *(const bf16x8*)(row + 16 * s + 8 * h); }
DI bf16x8 ld_perm(const bf16_t* row, int s, int h) {
    const bf16x4 lo = *(const bf16x4*)(row + 16 * s + 4 * h), hi = *(const bf16x4*)(row + 16 * s + 8 + 4 * h);
    return __builtin_shufflevector(lo, hi, 0, 1, 2, 3, 4, 5, 6, 7);
}
DI f32x16 zero16() { f32x16 z;
#pragma unroll
    for (int i = 0; i < 16; ++i) z[i] = 0.f;
    return z; }
#define TGET(i) ((i) < 16 ? t0[(i) & 15] : t1[(i) & 15])
DI void invert32_col(const float* Lf, f32x16& t0, f32x16& t1, int c) {
#pragma unroll
    for (int i = 0; i < 32; ++i) {
        float s0 = 0.f, s1 = 0.f, s2 = 0.f, s3 = 0.f;
#pragma unroll
        for (int j4 = 0; j4 < (i + 3) / 4; ++j4) {
            const f32x4 l = *(const f32x4*)(Lf + i * 32 + 4 * j4);
            if (4 * j4 + 0 < i) s0 += l.x * TGET(4 * j4 + 0);
            if (4 * j4 + 1 < i) s1 += l.y * TGET(4 * j4 + 1);
            if (4 * j4 + 2 < i) s2 += l.z * TGET(4 * j4 + 2);
            if (4 * j4 + 3 < i) s3 += l.w * TGET(4 * j4 + 3);
        }
        float sm = -((s0 + s1) + (s2 + s3));
#ifndef EMU
        asm volatile("" : "+v"(sm));
#endif
        const float v = (i > c) ? sm : (i == c ? 1.f : 0.f);
        if (i < 16) t0[i & 15] = v; else t1[i & 15] = v;
    }
}

DI void seg_info(int g, int& seq, int& b, int& j0) {
    if (g < NSEG_CTX) { seq = 0; b = g / (CTXL / 64); j0 = (g % (CTXL / 64)) * 64; } else { const int g2 = g - NSEG_CTX; seq = 1; b = g2 / (S / 64); j0 = (g2 % (S / 64)) * 64; }
}
DI const bf16_t* seq_row(const Params& p, int seq, int b, int j, bool scan_order) {
    if (seq) { const int l = scan_order ? (j % ROWS) * GW + j / ROWS : j; return (const bf16_t*)(p.ws + WS_PLAT) + (size_t)(b * S + l) * IN_COLS; }
    return (const bf16_t*)(p.ws + WS_PCTX) + (size_t)(b * CTXL + j) * CTX_COLS;
}
DI void phase_halo(const Params& p, char* smem) {
    if (USE_G8) return;
    const int tid = tid_x(), lane = tid & 63, wave = tid >> 6;
    const int gw = blockIdx.x * 8 + wave, ngw = gridDim.x * 8;
    bf16_t* HA = (bf16_t*)(p.ws + WS_HALO_A); bf16_t* HB = (bf16_t*)(p.ws + WS_HALO_B);
    for (int it = gw; it < NSEG * 6; it += ngw) {
        const int g = it / 6, hr = it % 6; int seq, b, j0; seg_info(g, seq, b, j0);
        const int L = seq ? S : CTXL;
        if (hr < 4) {
            const int j = hr < 2 ? j0 - 2 + hr : j0 + 62 + hr; const bool ok = j >= 0 && j < L;
            const bf16_t* src = seq_row(p, seq, b, ok ? j : 0, false);
            for (int c = lane; c < 192; c += 64) { u32x4 v = {0u, 0u, 0u, 0u}; if (ok) v = *(const u32x4*)(src + c * 8); *(u32x4*)(HA + ((size_t)g * 4 + hr) * 1536 + c * 8) = v; }
        } else {
            const int j = hr == 4 ? j0 - 1 : j0 + 64; const bool ok = j >= 0 && j < L;
            const bf16_t* src = seq_row(p, seq, b, ok ? j : 0, true) + COL_B0;
            for (int c = lane; c < 240; c += 64) { u32x4 v = {0u, 0u, 0u, 0u}; if (ok) v = *(const u32x4*)(src + c * 8); *(u32x4*)(HB + ((size_t)g * 2 + (hr - 4)) * 1920 + c * 8) = v; }
        }
    }
}
DI f32x2_ac unpk2(unsigned w) { return (f32x2_ac){bf2f((bf16_t)(w & 0xffffu)), bf2f((bf16_t)(w >> 16))}; }
DI void unpack8(const u32x4& q, float (&f)[8]) {
    f[0] = bf2f((bf16_t)(q.x & 0xffffu)); f[1] = bf2f((bf16_t)(q.x >> 16)); f[2] = bf2f((bf16_t)(q.y & 0xffffu)); f[3] = bf2f((bf16_t)(q.y >> 16));
    f[4] = bf2f((bf16_t)(q.z & 0xffffu)); f[5] = bf2f((bf16_t)(q.z >> 16)); f[6] = bf2f((bf16_t)(q.w & 0xffffu)); f[7] = bf2f((bf16_t)(q.w >> 16));
}
DI float row16_sum(float v) {
#ifdef EMU
    v += __shfl_xor(v, 1); v += __shfl_xor(v, 2); v += __shfl_xor(v, 4); v += __shfl_xor(v, 8); return v;
#else
    v = DPP_ADD(v, 0xB1); v = DPP_ADD(v, 0x4E); v = DPP_ADD(v, 0x141); v = DPP_ADD(v, 0x140); return v;
#endif
}
DI void phase_fir(const Params& p, char* smem) {
    const int tid = tid_x(), lane = tid & 63, wave = tid >> 6;
    const int gw = blockIdx.x * 8 + wave, ngw = gridDim.x * 8;
    const bf16_t* HA = (const bf16_t*)(p.ws + WS_HALO_A); const bf16_t* HB = (const bf16_t*)(p.ws + WS_HALO_B);
    constexpr int NA = NSEG * 3, NBI = NSEG * 4;
    const u32x4 z4 = {0u, 0u, 0u, 0u};
    for (int it = gw; it < NA + NBI; it += ngw) {
        if (it < NA) {
            const int g = it / 3, s = it % 3; int seq, b, j0; seg_info(g, seq, b, j0);
            const int col = s * 512 + 8 * lane, ldp = seq ? IN_COLS : CTX_COLS;
            bf16_t* base = (bf16_t*)seq_row(p, seq, b, j0, false) + col;
            const bf16_t* hal = HA + (size_t)g * 4 * 1536 + col;
            float cw[5][8];
#pragma unroll
            for (int t = 0; t < 5; ++t) { const f32x4 w0 = *(const f32x4*)(p.in[I_CONV] + t * 1536 + col), w1 = *(const f32x4*)(p.in[I_CONV] + t * 1536 + col + 4);
                cw[t][0] = w0.x; cw[t][1] = w0.y; cw[t][2] = w0.z; cw[t][3] = w0.w; cw[t][4] = w1.x; cw[t][5] = w1.y; cw[t][6] = w1.z; cw[t][7] = w1.w; }
            u32x4 win[12], nxt[8];
            win[0] = *(const u32x4*)(hal); win[1] = *(const u32x4*)(hal + 1536);
            win[2] = *(const u32x4*)(base); win[3] = *(const u32x4*)(base + ldp);
#pragma unroll
            for (int i = 0; i < 8; ++i) win[4 + i] = *(const u32x4*)(base + (size_t)(2 + i) * ldp);
#pragma unroll 1
            for (int blk = 0; blk < 8; ++blk) {
                if (blk < 7) {
#pragma unroll
                    for (int i = 0; i < 8; ++i) { const int t = 8 * blk + 10 + i; nxt[i] = t < 64 ? *(const u32x4*)(base + (size_t)t * ldp) : *(const u32x4*)(hal + (size_t)(2 + (t - 64)) * 1536); }
                }
#pragma unroll
                for (int i = 0; i < 8; ++i) {
                    float a[8];
#pragma unroll
                    for (int e = 0; e < 8; ++e) a[e] = 0.f;
#pragma unroll
                    for (int t = 0; t < 5; ++t) { float x[8]; unpack8(win[i + t], x);
#pragma unroll
                        for (int e = 0; e < 8; ++e) a[e] += x[e] * cw[t][e]; }
                    float ss = 0.f;
#pragma unroll
                    for (int e = 0; e < 8; ++e) { a[e] = fsilu(a[e]); ss += a[e] * a[e]; }
                    if (s < 2) { const float sc = frsq(row16_sum(ss) + 1e-6f) * (s == 0 ? 0.08838834764831845f : 1.0f);
#pragma unroll
                        for (int e = 0; e < 8; ++e) a[e] *= sc; }
                    u32x4 o; o.x = pk2(a[0], a[1]); o.y = pk2(a[2], a[3]); o.z = pk2(a[4], a[5]); o.w = pk2(a[6], a[7]);
                    *(u32x4*)(base + (size_t)(8 * blk + i) * ldp) = o;
                }
#pragma unroll
                for (int i = 0; i < 4; ++i) win[i] = win[8 + i];
#pragma unroll
                for (int i = 0; i < 8; ++i) win[4 + i] = nxt[i];
            }
        } else {
            const int it2 = it - NA, g = it2 / 4, sl = it2 % 4; int seq, b, j0; seg_info(g, seq, b, j0);
            const int bcol = sl * 512 + 8 * lane; const bool act = bcol < 1920;
            const int bc = act ? bcol : 0, col = COL_B0 + bc;
            float mu8[8];
            { const f32x4 m0 = *(const f32x4*)(p.in[I_MU] + bc), m1 = *(const f32x4*)(p.in[I_MU] + bc + 4); mu8[0] = m0.x; mu8[1] = m0.y; mu8[2] = m0.z; mu8[3] = m0.w; mu8[4] = m1.x; mu8[5] = m1.y; mu8[6] = m1.z; mu8[7] = m1.w; }
            const bool th = (bc >= 1536 && bc < 1664);
            const bf16_t* hal = HB + (size_t)g * 2 * 1920 + bc;
            u32x4 win[10], nxt[8];
            win[0] = *(const u32x4*)(hal); win[1] = *(const u32x4*)(seq_row(p, seq, b, j0, true) + col);
#pragma unroll
            for (int i = 0; i < 8; ++i) win[2 + i] = *(const u32x4*)(seq_row(p, seq, b, j0 + 1 + i, true) + col);
#pragma unroll 1
            for (int blk = 0; blk < 8; ++blk) {
                if (blk < 7) {
#pragma unroll
                    for (int i = 0; i < 8; ++i) { const int t = 8 * blk + 9 + i; nxt[i] = t < 64 ? *(const u32x4*)(seq_row(p, seq, b, j0 + t, true) + col) : *(const u32x4*)(hal + 1920); }
                }
#pragma unroll
                for (int i = 0; i < 8; ++i) {
                    float pv[8], cu[8], nx[8], x[8]; unpack8(win[i], pv); unpack8(win[i + 1], cu); unpack8(win[i + 2], nx);
#pragma unroll
                    for (int e = 0; e < 8; ++e) { x[e] = cu[e] + (0.5f * (pv[e] + nx[e]) - cu[e]) * mu8[e]; if (th) x[e] = ftanh(x[e]); }
                    u32x4 o; o.x = pk2(x[0], x[1]); o.y = pk2(x[2], x[3]); o.z = pk2(x[4], x[5]); o.w = pk2(x[6], x[7]);
                    if (act) *(u32x4*)((bf16_t*)seq_row(p, seq, b, j0 + 8 * blk + i, true) + col) = o;
                }
                win[0] = win[8]; win[1] = win[9];
#pragma unroll
                for (int i = 0; i < 8; ++i) win[2 + i] = nxt[i];
            }
        }
    }
}

constexpr int GC = 32;
constexpr int G_NT = (CTXL + S) / GC;
constexpr int LD128 = 136, LD64 = 72, LD32 = 40;
DI void chunk_pos(int x, int d, int& seg, int& j0) {
    constexpr int n0 = CTXL / GC, n1 = S / GC;
    if (x < n0) { seg = 0; j0 = (d ? n0 - 1 - x : x) * GC; } else { seg = 1; const int xx = x - n0; j0 = (d ? n1 - 1 - xx : xx) * GC; }
}

template <class Emit, class Emit0>
DI void invert32_blocked(const float* Lf, bf16_t* scr, int lane, Emit emit, Emit0 emit0) {
    bf16_t* T00T = scr; bf16_t* T11R = scr + 16 * LD32; bf16_t* L10R = scr + 2 * 16 * LD32; bf16_t* P1T = scr + 3 * 16 * LD32;
    const int blk = lane >> 5, c = lane & 15, r = lane & 31, fr = lane & 15, fq = lane >> 4;
    f32x16 t;
    const float* Lb = Lf + (16 * blk) * 32 + 16 * blk;
    f32x4 rb[3][4];
#pragma unroll
    for (int j4 = 0; j4 < 1; ++j4) { rb[1][j4] = *(const f32x4*)(Lb + 1 * 32 + 4 * j4); rb[2][j4] = *(const f32x4*)(Lb + 2 * 32 + 4 * j4); }
#pragma unroll
    for (int i = 0; i < 16; ++i) {
        if (i >= 1 && i + 2 < 16) {
#pragma unroll
            for (int j4 = 0; j4 < (i + 2 + 3) / 4; ++j4) rb[(i + 2) % 3][j4] = *(const f32x4*)(Lb + (i + 2) * 32 + 4 * j4);
        }
        float s0 = 0.f, s1 = 0.f, s2 = 0.f, s3 = 0.f;
#pragma unroll
        for (int j4 = 0; j4 < (i + 3) / 4; ++j4) {
            const f32x4 l = rb[i % 3][j4];
            if (4 * j4 + 0 < i) s0 += l.x * t[4 * j4 + 0];
            if (4 * j4 + 1 < i) s1 += l.y * t[4 * j4 + 1];
            if (4 * j4 + 2 < i) s2 += l.z * t[4 * j4 + 2];
            if (4 * j4 + 3 < i) s3 += l.w * t[4 * j4 + 3];
        }
        float sm = -((s0 + s1) + (s2 + s3));
#ifndef EMU
        asm volatile("" : "+v"(sm));
#endif
        t[i] = (i > c) ? sm : (i == c ? 1.f : 0.f);
    }
    if (r < 16) {
        if (blk == 0) {
#pragma unroll
            for (int q = 0; q < 4; ++q) { u32x2 o; o.x = pk2(t[4 * q], t[4 * q + 1]); o.y = pk2(t[4 * q + 2], t[4 * q + 3]); *(u32x2*)(T00T + c * LD32 + 4 * q) = o; }
        } else {
#pragma unroll
            for (int i = 0; i < 16; ++i) T11R[i * LD32 + c] = f2bf(t[i]);
        }
    }
    { const int i = lane >> 2, j4 = (lane & 3) * 4; const f32x4 l = *(const f32x4*)(Lf + (16 + i) * 32 + j4);
      u32x2 o; o.x = pk2(l.x, l.y); o.y = pk2(l.z, l.w); *(u32x2*)(L10R + i * LD32 + j4) = o; }
    WAVE_SYNC();
    const bf16x8 zf = {0, 0, 0, 0, 0, 0, 0, 0};
    f32x4 p1 = {0.f, 0.f, 0.f, 0.f};
    {
        const bf16x8 af = fq < 2 ? *(const bf16x8*)(L10R + fr * LD32 + 8 * fq) : zf, bfm = fq < 2 ? *(const bf16x8*)(T00T + fr * LD32 + 8 * fq) : zf;
        p1 = MFMA16(af, bfm, p1);
    }
    { u32x2 o; o.x = pk2(p1[0], p1[1]); o.y = pk2(p1[2], p1[3]); *(u32x2*)(P1T + fr * LD32 + 4 * fq) = o; }
    WAVE_SYNC();
    f32x4 p2 = {0.f, 0.f, 0.f, 0.f};
    {
        const bf16x8 af = fq < 2 ? *(const bf16x8*)(T11R + fr * LD32 + 8 * fq) : zf, bfm = fq < 2 ? *(const bf16x8*)(P1T + fr * LD32 + 8 * fq) : zf;
        p2 = MFMA16(af, bfm, p2);
    }
#pragma unroll
    for (int j = 0; j < 4; ++j) emit(16 + 4 * fq + j, fr, -p2[j]);
    if (r < 16) {
#pragma unroll
        for (int i = 0; i < 16; ++i) emit(16 * blk + i, 16 * blk + c, t[i]);
        if (blk == 0) {
#pragma unroll
            for (int i = 0; i < 16; ++i) emit0(i, 16 + c);
        }
    }
}
DI float half_sum(float v, int hh) {
#ifdef EMU
    v += __shfl_xor(v, 1); v += __shfl_xor(v, 2); v += __shfl_xor(v, 4); v += __shfl_xor(v, 8); v += __shfl_xor(v, 16); return v;
#else
    v = DPP_ADD(v, 0xB1); v = DPP_ADD(v, 0x4E); v = DPP_ADD(v, 0x141); v = DPP_ADD(v, 0x140);
    const int iv = __builtin_bit_cast(int, v);
    const float s0 = __builtin_bit_cast(float, __builtin_amdgcn_readlane(iv, 0)) + __builtin_bit_cast(float, __builtin_amdgcn_readlane(iv, 16));
    const float s1 = __builtin_bit_cast(float, __builtin_amdgcn_readlane(iv, 32)) + __builtin_bit_cast(float, __builtin_amdgcn_readlane(iv, 48));
    return hh ? s1 : s0;
#endif
}
constexpr int GL_Q = 0;
constexpr int GL_KT = GL_Q + 3 * 32 * LD128 * 2;
constexpr int GL_VT = GL_KT + 3 * 128 * LD32 * 2;
constexpr int GL_K = GL_VT + 3 * 128 * LD32 * 2;
constexpr int GL_QKM = GL_K + 32 * LD128 * 2;
constexpr int GL_LF = GL_QKM + 2 * 32 * LD32 * 2;
constexpr int GL_TP = GL_LF + 32 * 32 * 4;
constexpr int GL_TPP = GL_TP + 32 * LD32 * 2;
constexpr int GL_WN = GL_TPP + 2 * 32 * LD32 * 2;
constexpr int GL_SC = GL_WN + 32 * LD128 * 2;
constexpr int GL_GC = GL_SC + 2 * 8 * 32 * 4;
constexpr int GL_INV = GL_GC + 8 * 32 * 4;
constexpr int GL_RAW = GL_INV + 4 * 16 * LD32 * 2;
constexpr int GL_END = GL_RAW + 32 * 384 * 2;
static_assert(GL_END <= LDS_BYTES, "gdn lds");

DI void gdn_chain2(const Params& p, char* smem, int item) {
    const int d = item / (NB * H_A), b = (item / H_A) % NB, h = item % H_A;
    const int tid = tid_x(), lane = tid & 63, wave0_ = tid >> 6;
    bf16_t* Qs = (bf16_t*)(smem + GL_Q); bf16_t* KTs = (bf16_t*)(smem + GL_KT); bf16_t* VTs = (bf16_t*)(smem + GL_VT); bf16_t* Ks = (bf16_t*)(smem + GL_K);
    bf16_t* QKMs = (bf16_t*)(smem + GL_QKM); float* Lf = (float*)(smem + GL_LF); bf16_t* Tp = (bf16_t*)(smem + GL_TP); bf16_t* Tpp = (bf16_t*)(smem + GL_TPP);
    bf16_t* Wn = (bf16_t*)(smem + GL_WN); float* SC = (float*)(smem + GL_SC); float* GCs = (float*)(smem + GL_GC);
    const float alog = p.in[I_ALOG][d * 4 + h], dtb = p.in[I_DTB][d * 4 + h], negea = -expf(alog);
    bf16_t* ODIR = (bf16_t*)(p.ws + WS_OA);
    __syncthreads();
    f32x16 St[4];
#pragma unroll
    for (int ct = 0; ct < 4; ++ct) St[ct] = zero16();
    bf16_t* RAW = (bf16_t*)(smem + GL_RAW);
    float pa = 0.f, pbt = 0.f;
    auto prefetch = [&](int x, int inst0, int ninst) {
        int seg, j0; chunk_pos(x, d, seg, j0);
        const int ldp = seg ? IN_COLS : CTX_COLS;
        const bf16_t* pbase = seg ? (const bf16_t*)(p.ws + WS_PLAT) + (size_t)b * S * IN_COLS : (const bf16_t*)(p.ws + WS_PCTX) + (size_t)b * CTXL * CTX_COLS;
        for (int inst = inst0; inst < inst0 + ninst; ++inst) {
            const int q = inst * 64 + lane, row = q / 48, c16 = q % 48;
            const bf16_t* src = pbase + (size_t)(j0 + row) * ldp + (c16 >> 4) * 512 + h * 128 + (c16 & 15) * 8;
#ifdef EMU
            emu_global_load_lds16(src, (char*)RAW + q * 16);
#else
            __builtin_amdgcn_global_load_lds((const unsigned*)src, (__attribute__((address_space(3))) unsigned*)((char*)RAW + q * 16), 16, 0, 0);
#endif
        }
    };
    auto prefetch_ab = [&](int x, int g0, int ng) {
        int seg, j0; chunk_pos(x, d, seg, j0);
        const float* abbase = (const float*)(p.ws + WS_AB) + (size_t)(seg ? T_CTX + b * S : b * CTXL) * 16;
        if (lane < 4 * ng) { const int j = j0 + 4 * g0 + lane; pa = abbase[(size_t)j * 16 + d * 4 + h]; pbt = abbase[(size_t)j * 16 + 8 + d * 4 + h]; }
    };
    auto x1 = [&](int c, int g0, int ng) {
        const int q3 = c % 3, parc = c & 1;
        for (int gi = 0; gi < ng; ++gi) {
            const int g = g0 + gi;
            const int i0 = d ? (GC - 4 - 4 * g) : 4 * g;
            const char* rawg = (const char*)RAW + (4 * g + (d ? 3 : 0)) * 768 + 4 * lane; const int rstep = d ? -768 : 768;
            unsigned wq[4], wk[4], wv[4];
#pragma unroll
            for (int e = 0; e < 4; ++e) { const char* rr = rawg + e * rstep; wq[e] = *(const unsigned*)rr; wk[e] = *(const unsigned*)(rr + 256); wv[e] = *(const unsigned*)(rr + 512); }
            char* qrow = (char*)Qs + ((q3 * 32 + i0) * LD128 + 2 * lane) * 2; char* krow = (char*)Ks + (i0 * LD128 + 2 * lane) * 2;
#pragma unroll
            for (int e = 0; e < 4; ++e) { *(unsigned*)(qrow + e * LD128 * 2) = wq[e]; *(unsigned*)(krow + e * LD128 * 2) = wk[e]; }
            char* ktrow = (char*)KTs + ((q3 * 128 + 2 * lane) * LD32 + i0) * 2; char* vtrow = (char*)VTs + ((q3 * 128 + 2 * lane) * LD32 + i0) * 2;
            { u32x2 o; o.x = (wk[0] & 0xffffu) | (wk[1] << 16); o.y = (wk[2] & 0xffffu) | (wk[3] << 16); *(u32x2*)ktrow = o;
              u32x2 o1; o1.x = (wk[0] >> 16) | (wk[1] & 0xffff0000u); o1.y = (wk[2] >> 16) | (wk[3] & 0xffff0000u); *(u32x2*)(ktrow + LD32 * 2) = o1; }
            { u32x2 o; o.x = (wv[0] & 0xffffu) | (wv[1] << 16); o.y = (wv[2] & 0xffffu) | (wv[3] << 16); *(u32x2*)vtrow = o;
              u32x2 o1; o1.x = (wv[0] >> 16) | (wv[1] & 0xffff0000u); o1.y = (wv[2] >> 16) | (wv[3] & 0xffff0000u); *(u32x2*)(vtrow + LD32 * 2) = o1; }
        }
        if (lane < 4 * ng) { const int jo = 4 * g0 + lane; const int i = d ? (GC - 1 - jo) : jo;
            SC[(parc * 8 + 0) * 32 + i] = negea * fsoftplus(pa + dtb); SC[(parc * 8 + 1) * 32 + i] = fsigmoid(pbt); }
    };
    auto x2 = [&](int c, int r, int wave) {
        const int par = c & 1, q3 = c % 3;
        const float* graw = SC + (par * 8 + 0) * 32;
        float gcv = 0.f;
#pragma unroll
        for (int s4 = 0; s4 < 8; ++s4) { const f32x4 g4 = *(const f32x4*)(graw + 4 * s4);
            gcv += (4 * s4 + 0 <= r ? g4.x : 0.f) + (4 * s4 + 1 <= r ? g4.y : 0.f) + (4 * s4 + 2 <= r ? g4.z : 0.f) + (4 * s4 + 3 <= r ? g4.w : 0.f); }
        if (lane < 32) GCs[wave * 32 + r] = gcv;
        if (wave == 7 && lane < 32) {
            float gl = 0.f;
#pragma unroll
            for (int s4 = 0; s4 < 8; ++s4) { const f32x4 g4 = *(const f32x4*)(graw + 4 * s4); gl += (g4.x + g4.y) + (g4.z + g4.w); }
            const float be = SC[(par * 8 + 1) * 32 + r];
            SC[(par * 8 + 3) * 32 + r] = fexp(gcv); SC[(par * 8 + 4) * 32 + r] = fexp(gl - gcv); SC[(par * 8 + 5) * 32 + r] = be * fexp(gcv); SC[(par * 8 + 6) * 32 + r] = fexp(gl);
        }
        const int pr = wave >> 2, th = (wave >> 1) & 1, ch = wave & 1, fr = lane & 15, fq = lane >> 4;
        const bf16_t* arow = (pr == 0 ? Ks : Qs + q3 * 32 * LD128) + (16 * th + fr) * LD128 + 8 * fq; const bf16_t* brow = Ks + (16 * ch + fr) * LD128 + 8 * fq;
        f32x4 cc = {0.f, 0.f, 0.f, 0.f};
#pragma unroll
        for (int ks = 0; ks < 4; ++ks) cc = MFMA16(*(const bf16x8*)(arow + 32 * ks), *(const bf16x8*)(brow + 32 * ks), cc);
        WAVE_SYNC();
        const int jj = 16 * ch + fr; const float gj = GCs[wave * 32 + jj];
#pragma unroll
        for (int j = 0; j < 4; ++j) {
            const int i = 16 * th + 4 * fq + j; const float dec = fexp(GCs[wave * 32 + i] - gj);
            if (pr == 0) Lf[i * 32 + jj] = (jj < i) ? SC[(par * 8 + 1) * 32 + i] * cc[j] * dec : 0.f;
            else QKMs[(par * 32 + i) * LD32 + jj] = f2bf((jj <= i) ? cc[j] * dec : 0.f);
        }
    };
    prefetch(0, 3 * wave0_, 3); prefetch_ab(0, wave0_, 1);
#ifndef EMU
    asm volatile("s_waitcnt vmcnt(0)" ::: "memory");
#endif
    const int r0_ = lane & 31, hh0_ = lane >> 5;
    __syncthreads();
    x1(0, wave0_, 1);
    LDS_BARRIER();
    if (wave0_ >= 4 && wave0_ < 7 && 1 < G_NT) { prefetch(1, 9 * (wave0_ - 4), wave0_ == 6 ? 6 : 9); prefetch_ab(1, 3 * (wave0_ - 4), wave0_ == 6 ? 2 : 3); }
    x2(0, r0_, wave0_);
#ifndef EMU
    asm volatile("s_waitcnt vmcnt(0)" ::: "memory");
#endif
    LDS_BARRIER();
    for (int it = -1; it < G_NT; ++it) {
        int r = r0_, hh = hh0_, wave = wave0_;
#ifndef EMU
        asm volatile("" : "+v"(r), "+v"(hh), "+v"(wave));
#endif
        const int xn = it + 1, par = xn & 1, q3 = xn % 3;
        const int g0w = 3 * (wave - 4), ngw = wave == 6 ? 2 : 3;
        if (wave == 7 && xn < G_NT) {
            const float* sb1 = SC + (par * 8 + 5) * 32; const float* sb0 = SC + (par * 8 + 1) * 32; bf16_t* Tppw = Tpp + par * 32 * LD32;
            const float s1lo = sb1[lane & 15], s1hi = sb1[16 + (lane & 15)], s0lo = sb0[lane & 15], s0hi = sb0[16 + (lane & 15)];
            invert32_blocked(Lf, (bf16_t*)(smem + GL_INV), lane,
                [&](int i, int c, float v) { Tp[i * LD32 + c] = f2bf(v * (c < 16 ? s1lo : s1hi)); Tppw[i * LD32 + c] = f2bf(v * (c < 16 ? s0lo : s0hi)); },
                [&](int i, int c) { Tp[i * LD32 + c] = (bf16_t)0; Tppw[i * LD32 + c] = (bf16_t)0; });
        }
        if (wave >= 4 && wave < 7 && xn + 1 < G_NT) {
            x1(xn + 1, g0w, ngw);
            if (xn + 2 < G_NT) {
                WAVE_SYNC();
                prefetch(xn + 2, 9 * (wave - 4), wave == 6 ? 6 : 9); prefetch_ab(xn + 2, g0w, ngw);
            }
        }
        if (wave < 4 && it >= 0) {
            const int pc = it & 1, qc = it % 3; int seg = 0, j0 = 0; chunk_pos(it, d, seg, j0);
            const bf16_t* Qc = Qs + qc * 32 * LD128; const bf16_t* KTc = KTs + qc * 128 * LD32; const bf16_t* VTc = VTs + qc * 128 * LD32;
            const bf16_t* QKc = QKMs + pc * 32 * LD32; const bf16_t* Tc = Tpp + pc * 32 * LD32; const float* sc = SC + pc * 8 * 32;
            f32x16 vn = zero16();
#pragma unroll
            for (int s = 0; s < 2; ++s) vn = MFMA32(ld_nat(Tc + r * LD32, s, hh), ld_nat(VTc + (32 * wave + r) * LD32, s, hh), vn);
            f32x16 oacc = zero16();
#define GDN_KSTEP(s) { const bf16x8 sb = pack_acc<(s) & 1>(St[(s) >> 1]); vn = MFMA32(ld_perm(Wn + r * LD128, (s), hh), sb, vn); oacc = MFMA32(ld_perm(Qc + r * LD128, (s), hh), sb, oacc); }
            GDN_KSTEP(0) GDN_KSTEP(1) GDN_KSTEP(2) GDN_KSTEP(3) GDN_KSTEP(4) GDN_KSTEP(5) GDN_KSTEP(6) GDN_KSTEP(7)
#undef GDN_KSTEP
#pragma unroll
            for (int g = 0; g < 16; ++g) oacc[g] *= sc[3 * 32 + crow(g, hh)];
            { const bf16x8 v0 = pack_acc<0>(vn), v1 = pack_acc<1>(vn);
              oacc = MFMA32(ld_perm(QKc + r * LD32, 0, hh), v0, oacc); oacc = MFMA32(ld_perm(QKc + r * LD32, 1, hh), v1, oacc); }
#pragma unroll
            for (int g = 0; g < 16; ++g) vn[g] *= sc[4 * 32 + crow(g, hh)];
            const float ge = sc[6 * 32];
            { const bf16x8 v0 = pack_acc<0>(vn), v1 = pack_acc<1>(vn);
#pragma unroll
              for (int ct = 0; ct < 4; ++ct) {
#pragma unroll
                  for (int g = 0; g < 16; ++g) St[ct][g] *= ge;
                  St[ct] = MFMA32(ld_perm(KTc + (32 * ct + r) * LD32, 0, hh), v0, St[ct]);
                  St[ct] = MFMA32(ld_perm(KTc + (32 * ct + r) * LD32, 1, hh), v1, St[ct]);
              } }
            if (seg) {
#pragma unroll
                for (int g = 0; g < 16; ++g) {
                    const int i = crow(g, hh), j = d ? j0 + GC - 1 - i : j0 + i;
                    ODIR[((size_t)d * T_LAT + (size_t)b * S + j) * 512 + h * 128 + 32 * wave + r] = f2bf(oacc[g]);
                }
            }
        }
        LDS_BARRIER();
        if (xn < G_NT && wave < 4) {
            f32x16 acc = zero16();
#pragma unroll
            for (int s = 0; s < 2; ++s) acc = MFMA32(ld_nat(KTs + (q3 * 128 + 32 * wave + r) * LD32, s, hh), ld_nat(Tp + r * LD32, s, hh), acc);
#pragma unroll
            for (int q = 0; q < 4; ++q) {
                u32x2 o; o.x = pk2(-acc[4 * q], -acc[4 * q + 1]); o.y = pk2(-acc[4 * q + 2], -acc[4 * q + 3]);
                *(u32x2*)(Wn + r * LD128 + 32 * wave + 8 * q + 4 * hh) = o;
            }
        }
        if (xn + 1 < G_NT) x2(xn + 1, r, wave);
#ifndef EMU
        asm volatile("s_waitcnt vmcnt(0)" ::: "memory");
#endif
        LDS_BARRIER();
    }
}

constexpr int RL_RX = 0;
constexpr int RL_KX = RL_RX + 32 * 64 * 2;
constexpr int RL_VX = RL_KX + 32 * 64 * 2;
constexpr int RL_KK = RL_VX + 32 * 64 * 2;
constexpr int RL_LW = RL_KK + 32 * 64 * 4;
constexpr int RL_IC = RL_LW + 32 * 64 * 4;
constexpr int RL_PC = RL_IC + 32 * 64 * 4;
constexpr int RL_CST = RL_PC + 2 * 64 * 4;
constexpr int RL_TW = RL_CST + 4 * 64 * 4;
constexpr int RL_AL = RL_TW + 32 * LD64 * 2;
constexpr int RL_LF = RL_AL + 32 * LD64 * 2;
constexpr int RL_LAKT = RL_LF + 32 * 32 * 4;
constexpr int RL_TB = RL_LAKT + 32 * LD32 * 2;
constexpr int RL_W2T = RL_TB + 32 * LD32 * 2;
constexpr int RL_A2T = RL_W2T + 64 * LD64 * 2;
constexpr int RL_AR = RL_A2T + 64 * LD64 * 2;
constexpr int RL_BR = RL_AR + 32 * LD64 * 2;
constexpr int RL_KR = RL_BR + 32 * LD64 * 2;
constexpr int RL_RR = RL_KR + 32 * LD64 * 2;
constexpr int RL_AT = RL_RR + 2 * 32 * LD64 * 2;
constexpr int RL_BHT = RL_AT + 64 * LD32 * 2;
constexpr int RL_KHT = RL_BHT + 2 * 64 * LD32 * 2;
constexpr int RL_VT = RL_KHT + 2 * 64 * LD32 * 2;
constexpr int RL_MRB = RL_VT + 2 * 64 * LD32 * 2;
constexpr int RL_MRK = RL_MRB + 2 * 32 * LD32 * 2;
constexpr int RL_WM = RL_MRK + 2 * 32 * LD32 * 2;
constexpr int RL_TL = RL_WM + 32 * LD64 * 2;
constexpr int RL_END = RL_TL + 32 * LD32 * 2;
static_assert(RL_END <= LDS_BYTES, "rwkv lds");
static_assert(4 * 16 * LD32 * 2 <= 2 * 32 * LD64 * 2, "inversion scratch over AR/BR");

DI void rwkv_chain2(const Params& p, char* smem, int item) {
    const int d = item / (NB * H_B), b = (item / H_B) % NB, h = item % H_B;
    const int tid = tid_x(), lane = tid & 63, wave = tid >> 6;
    bf16_t* RX = (bf16_t*)(smem + RL_RX); bf16_t* KX = (bf16_t*)(smem + RL_KX); bf16_t* VX = (bf16_t*)(smem + RL_VX); float* KKs = (float*)(smem + RL_KK);
    float* LW = (float*)(smem + RL_LW); float* IC = (float*)(smem + RL_IC); float* Lf = (float*)(smem + RL_LF); float* PC = (float*)(smem + RL_PC); float* CST = (float*)(smem + RL_CST);
    bf16_t* TW = (bf16_t*)(smem + RL_TW); bf16_t* AL = (bf16_t*)(smem + RL_AL); bf16_t* W2T = (bf16_t*)(smem + RL_W2T); bf16_t* A2T = (bf16_t*)(smem + RL_A2T);
    bf16_t* Ar = (bf16_t*)(smem + RL_AR); bf16_t* Br = (bf16_t*)(smem + RL_BR); bf16_t* Kr = (bf16_t*)(smem + RL_KR); bf16_t* Rr = (bf16_t*)(smem + RL_RR);
    bf16_t* AT = (bf16_t*)(smem + RL_AT); bf16_t* BhT = (bf16_t*)(smem + RL_BHT); bf16_t* KhT = (bf16_t*)(smem + RL_KHT); bf16_t* VT = (bf16_t*)(smem + RL_VT);
    bf16_t* LakT = (bf16_t*)(smem + RL_LAKT); bf16_t* Mrb = (bf16_t*)(smem + RL_MRB); bf16_t* Mrk = (bf16_t*)(smem + RL_MRK); bf16_t* Tb = (bf16_t*)(smem + RL_TB);
    bf16_t* Wm = (bf16_t*)(smem + RL_WM); bf16_t* TLm = (bf16_t*)(smem + RL_TL);
    bf16_t* YDIR = (bf16_t*)(p.aux + AUX_YDIR); float* BON = (float*)(p.ws + WS_BONUS);
    __syncthreads();
    for (int i = tid; i < 64 * 64; i += NTHREADS) {
        const int c = i >> 6, rr = i & 63;
        W2T[c * LD64 + rr] = f2bf(p.in[I_W2][((size_t)d * 64 + rr) * 512 + h * 64 + c]); A2T[c * LD64 + rr] = f2bf(p.in[I_A2][((size_t)d * 64 + rr) * 512 + h * 64 + c]);
    }
    if (tid < 256) { const int w = tid >> 6, c = tid & 63, gc = h * 64 + c;
        CST[tid] = w == 0 ? p.in[I_W0][d * 512 + gc] : (w == 1 ? p.in[I_A0][d * 512 + gc] : (w == 2 ? p.in[I_KA][gc] : p.in[I_RK][gc])); }
    const float kkw0 = p.in[I_KK][h * 64 + 2 * (lane & 31)], kkw1 = p.in[I_KK][h * 64 + 2 * (lane & 31) + 1];
    f32x16 Xt[2]; Xt[0] = zero16(); Xt[1] = zero16();
    unsigned rawv[4][5];
    auto prefetch = [&](int x, int w) {
        int seg, j0; chunk_pos(x, d, seg, j0);
        const int ldp = seg ? IN_COLS : CTX_COLS;
        const bf16_t* pb = seg ? (const bf16_t*)(p.ws + WS_PLAT) + (size_t)b * S * IN_COLS : (const bf16_t*)(p.ws + WS_PCTX) + (size_t)b * CTXL * CTX_COLS;
#pragma unroll
        for (int k = 0; k < 4; ++k) {
            const int pi = (w - 2) + 5 * k;
            if (pi < GC / 2) {
                const int j = j0 + 2 * pi + (lane >> 5); const int row = seg ? (j % ROWS) * GW + j / ROWS : j;
#pragma unroll
                for (int s = 0; s < 5; ++s) {
                    const int bcol = (s < 3 ? s * 512 + h * 64 : (s == 3 ? 1536 + d * 64 : 1664 + d * 64)) + 2 * (lane & 31);
                    rawv[k][s] = *(const unsigned*)(pb + (size_t)row * ldp + COL_B0 + bcol);
                }
            }
        }
    };
    auto y1 = [&](int w) {
#pragma unroll
        for (int k = 0; k < 4; ++k) {
            const int pi = (w - 2) + 5 * k;
            if (pi < GC / 2) {
                const int jo = 2 * pi + (lane >> 5), i = d ? (GC - 1 - jo) : jo, c2 = 2 * (lane & 31);
                const float kx0 = bf2f((bf16_t)(rawv[k][1] & 0xffffu)) * kkw0, kx1 = bf2f((bf16_t)(rawv[k][1] >> 16)) * kkw1;
                const float rs = frsq(half_sum(kx0 * kx0 + kx1 * kx1, lane >> 5) + 1e-6f);
                *(unsigned*)(RX + i * 64 + c2) = rawv[k][0]; *(unsigned*)(KX + i * 64 + c2) = rawv[k][1]; *(unsigned*)(VX + i * 64 + c2) = rawv[k][2];
                KKs[i * 64 + c2] = kx0 * rs; KKs[i * 64 + c2 + 1] = kx1 * rs;
                *(unsigned*)(TW + i * LD64 + c2) = rawv[k][3]; *(unsigned*)(AL + i * LD64 + c2) = rawv[k][4];
            }
        }
    };
    auto y2 = [&]() {
        const int which = wave >> 2, cg = wave & 3, fr = lane & 15, fq = lane >> 4;
        const bf16_t* arow0 = (which ? AL : TW) + fr * LD64 + 8 * fq; const bf16_t* brow = (which ? A2T : W2T) + (16 * cg + fr) * LD64 + 8 * fq;
        f32x4 c0 = {0.f, 0.f, 0.f, 0.f}, c1 = {0.f, 0.f, 0.f, 0.f};
#pragma unroll
        for (int ks = 0; ks < 2; ++ks) {
            const bf16x8 bfrag = *(const bf16x8*)(brow + 32 * ks);
            c0 = MFMA16(*(const bf16x8*)(arow0 + 32 * ks), bfrag, c0); c1 = MFMA16(*(const bf16x8*)(arow0 + 16 * LD64 + 32 * ks), bfrag, c1);
        }
        const int c = 16 * cg + fr; const float bias = CST[which * 64 + c];
#pragma unroll
        for (int th = 0; th < 2; ++th)
#pragma unroll
            for (int j = 0; j < 4; ++j) {
                const int i = 16 * th + 4 * fq + j; const float z = bias + (th ? c1[j] : c0[j]);
                if (which) IC[i * 64 + c] = fsigmoid(z);
                else { const float wl = -fsoftplus(-z) - 0.5f; LW[i * 64 + c] = -fexp(wl); }
            }
    };
    if (wave >= 2 && wave < 7) prefetch(0, wave);
    const int r0_ = lane & 31, hh0_ = lane >> 5;
    __syncthreads();
    if (wave >= 2 && wave < 7) { y1(wave); if (1 < G_NT) prefetch(1, wave); }
    LDS_BARRIER();
    y2();
    LDS_BARRIER();
    for (int it = -1; it < G_NT; ++it) {
        int r = r0_, hh = hh0_;
#ifndef EMU
        asm volatile("" : "+v"(r), "+v"(hh));
#endif
        const int xn = it + 1, par = xn & 1;
        int segn = 0, j0n = 0; if (xn < G_NT) chunk_pos(xn, d, segn, j0n);
        if (xn < G_NT) {
            const int c = lane, i0 = 4 * wave;
            const float ka = CST[2 * 64 + c], rk = CST[3 * 64 + c];
            float lpb = 0.f, lpc = 0.f; float lw4[4];
#pragma unroll
            for (int s2 = 0; s2 < 32; ++s2) { const float w = LW[s2 * 64 + c]; lpc += w; if (s2 < i0) lpb += w; }
#pragma unroll
            for (int e = 0; e < 4; ++e) lw4[e] = LW[(i0 + e) * 64 + c];
            bf16_t ta[4], tb[4], tk[4], tv[4]; float bon[4];
            float lprun = lpb;
#pragma unroll
            for (int e = 0; e < 4; ++e) {
                const int i = i0 + e;
                const float lpm = lprun; lprun += lw4[e]; const float lp = lprun;
                const float Pi = fexp(lp), Pm = fexp(lpm), invP = fexp(-lp), PCi = fexp(lpc - lp);
                const float ic = IC[i * 64 + c], kxv = bf2f(KX[i * 64 + c]), kkv = KKs[i * 64 + c], rxv = bf2f(RX[i * 64 + c]); const bf16_t vxb = VX[i * 64 + c];
                const float kd = kxv * (1.f + (ic - 1.f) * ka), bb = kkv * ic, aa = -kkv;
                ta[e] = f2bf(aa * Pm); tb[e] = f2bf(bb * PCi); tk[e] = f2bf(kd * PCi); tv[e] = vxb;
                Ar[i * LD64 + c] = ta[e]; Br[i * LD64 + c] = f2bf(bb * invP); Kr[i * LD64 + c] = f2bf(kd * invP); Rr[(par * 32 + i) * LD64 + c] = f2bf(rxv * Pi);
                bon[e] = wave_sum_fast(rxv * kd * rk);
            }
            { u32x2 o; o.x = (unsigned)ta[0] | ((unsigned)ta[1] << 16); o.y = (unsigned)ta[2] | ((unsigned)ta[3] << 16); *(u32x2*)(AT + c * LD32 + i0) = o; }
            { u32x2 o; o.x = (unsigned)tb[0] | ((unsigned)tb[1] << 16); o.y = (unsigned)tb[2] | ((unsigned)tb[3] << 16); *(u32x2*)(BhT + (par * 64 + c) * LD32 + i0) = o; }
            { u32x2 o; o.x = (unsigned)tk[0] | ((unsigned)tk[1] << 16); o.y = (unsigned)tk[2] | ((unsigned)tk[3] << 16); *(u32x2*)(KhT + (par * 64 + c) * LD32 + i0) = o; }
            { u32x2 o; o.x = (unsigned)tv[0] | ((unsigned)tv[1] << 16); o.y = (unsigned)tv[2] | ((unsigned)tv[3] << 16); *(u32x2*)(VT + (par * 64 + c) * LD32 + i0) = o; }
            if (wave == 7) PC[par * 64 + c] = fexp(lpc);
            if (segn && lane < 4) { const int i = i0 + lane, jj = d ? j0n + GC - 1 - i : j0n + i;
                const float bv = lane == 0 ? bon[0] : (lane == 1 ? bon[1] : (lane == 2 ? bon[2] : bon[3]));
                BON[((size_t)d * T_LAT + (size_t)b * S + (jj % ROWS) * GW + jj / ROWS) * 8 + h] = bv; }
        }
        LDS_BARRIER();
        if (xn < G_NT) {
            const int m = wave >> 1, th = wave & 1, fr = lane & 15, fq = lane >> 4;
            const bf16_t* arow = ((m < 2) ? Ar : Rr + par * 32 * LD64) + (16 * th + fr) * LD64 + 8 * fq; const bf16_t* brow = ((m & 1) ? Kr : Br) + fr * LD64 + 8 * fq;
            f32x4 c0 = {0.f, 0.f, 0.f, 0.f}, c1 = {0.f, 0.f, 0.f, 0.f};
#pragma unroll
            for (int ks = 0; ks < 2; ++ks) {
                const bf16x8 afrag = *(const bf16x8*)(arow + 32 * ks);
                c0 = MFMA16(afrag, *(const bf16x8*)(brow + 32 * ks), c0); c1 = MFMA16(afrag, *(const bf16x8*)(brow + 16 * LD64 + 32 * ks), c1);
            }
#pragma unroll
            for (int ch = 0; ch < 2; ++ch) {
                const f32x4 cc = ch ? c1 : c0; const int ic = 16 * ch + fr; const int t0 = 16 * th + 4 * fq;
                if (m == 0) {
#pragma unroll
                    for (int j = 0; j < 4; ++j) Lf[(t0 + j) * 32 + ic] = (ic < t0 + j) ? -cc[j] : 0.f;
                } else if (m == 1) {
                    u32x2 o; o.x = pk2((ic < t0) ? cc[0] : 0.f, (ic < t0 + 1) ? cc[1] : 0.f); o.y = pk2((ic < t0 + 2) ? cc[2] : 0.f, (ic < t0 + 3) ? cc[3] : 0.f);
                    *(u32x2*)(LakT + ic * LD32 + t0) = o;
                } else {
                    bf16_t* M = (m == 2 ? Mrb : Mrk) + par * 32 * LD32;
#pragma unroll
                    for (int j = 0; j < 4; ++j) M[(t0 + j) * LD32 + ic] = f2bf((ic <= t0 + j) ? cc[j] : 0.f);
                }
            }
        }
        LDS_BARRIER();
        if (wave == 7 && xn < G_NT) {
            invert32_blocked(Lf, (bf16_t*)(smem + RL_AR), lane, [&](int i, int c, float v) { Tb[i * LD32 + c] = f2bf(v); },
                             [&](int i, int c) { Tb[i * LD32 + c] = (bf16_t)0; });
        }
        if (wave >= 2 && wave < 7 && xn + 1 < G_NT) { y1(wave); if (xn + 2 < G_NT) prefetch(xn + 2, wave); }
        if (wave < 2 && it >= 0) {
            const int pc = it & 1; int seg = 0, j0 = 0; chunk_pos(it, d, seg, j0);
            const bf16_t* Rc = Rr + pc * 32 * LD64; const bf16_t* BhTc = BhT + pc * 64 * LD32; const bf16_t* KhTc = KhT + pc * 64 * LD32; const bf16_t* VTc = VT + (pc * 64 + 32 * wave + r) * LD32;
            const bf16_t* Mrbc = Mrb + pc * 32 * LD32; const bf16_t* Mrkc = Mrk + pc * 32 * LD32; const float* PCc = PC + pc * 64;
            const bf16x8 vf0 = ld_nat(VTc, 0, hh), vf1 = ld_nat(VTc, 1, hh);
            f32x16 u = zero16(), y = zero16();
            u = MFMA32(ld_nat(TLm + r * LD32, 0, hh), vf0, u); u = MFMA32(ld_nat(TLm + r * LD32, 1, hh), vf1, u);
            y = MFMA32(ld_nat(Mrkc + r * LD32, 0, hh), vf0, y); y = MFMA32(ld_nat(Mrkc + r * LD32, 1, hh), vf1, y);
#define RW_KSTEP(s) { const bf16x8 xb = pack_acc<(s) & 1>(Xt[(s) >> 1]); u = MFMA32(ld_perm(Wm + r * LD64, (s), hh), xb, u); y = MFMA32(ld_perm(Rc + r * LD64, (s), hh), xb, y); }
            RW_KSTEP(0) RW_KSTEP(1) RW_KSTEP(2) RW_KSTEP(3)
#undef RW_KSTEP
            const bf16x8 ub0 = pack_acc<0>(u), ub1 = pack_acc<1>(u);
            y = MFMA32(ld_perm(Mrbc + r * LD32, 0, hh), ub0, y); y = MFMA32(ld_perm(Mrbc + r * LD32, 1, hh), ub1, y);
#pragma unroll
            for (int kt = 0; kt < 2; ++kt) {
#pragma unroll
                for (int g = 0; g < 16; ++g) Xt[kt][g] *= PCc[32 * kt + crow(g, hh)];
                Xt[kt] = MFMA32(ld_perm(BhTc + (32 * kt + r) * LD32, 0, hh), ub0, Xt[kt]); Xt[kt] = MFMA32(ld_perm(BhTc + (32 * kt + r) * LD32, 1, hh), ub1, Xt[kt]);
                Xt[kt] = MFMA32(ld_nat(KhTc + (32 * kt + r) * LD32, 0, hh), vf0, Xt[kt]); Xt[kt] = MFMA32(ld_nat(KhTc + (32 * kt + r) * LD32, 1, hh), vf1, Xt[kt]);
            }
            if (seg) {
#pragma unroll
                for (int g = 0; g < 16; ++g) {
                    const int i = crow(g, hh), jj = d ? j0 + GC - 1 - i : j0 + i;
                    YDIR[((size_t)d * T_LAT + (size_t)b * S + (jj % ROWS) * GW + jj / ROWS) * 512 + h * 64 + 32 * wave + r] = f2bf(y[g]);
                }
            }
        }
        LDS_BARRIER();
        if (xn < G_NT && wave < 3) {
            const bf16_t* arow = (wave < 2) ? AT + (32 * wave + r) * LD32 : LakT + r * LD32;
            f32x16 acc = zero16();
#pragma unroll
            for (int s = 0; s < 2; ++s) acc = MFMA32(ld_nat(arow, s, hh), ld_nat(Tb + r * LD32, s, hh), acc);
#pragma unroll
            for (int q = 0; q < 4; ++q) {
                u32x2 o; o.x = pk2(acc[4 * q], acc[4 * q + 1]); o.y = pk2(acc[4 * q + 2], acc[4 * q + 3]);
                if (wave < 2) *(u32x2*)(Wm + r * LD64 + 32 * wave + 8 * q + 4 * hh) = o; else *(u32x2*)(TLm + r * LD32 + 8 * q + 4 * hh) = o;
            }
        }
        if (xn + 1 < G_NT) y2();
        LDS_BARRIER();
    }
}

DI void phase3(const Params& p, char* smem) {
    constexpr int NG = 2 * NB * H_A, NR = 2 * NB * H_B;
    for (int it = blockIdx.x; it < NG; it += gridDim.x) gdn_chain2(p, smem, it);
    for (int it = blockIdx.x; it < NG + NR; it += gridDim.x) if (it >= NG) rwkv_chain2(p, smem, it - NG);
    const int nchain = NG + NR, G = (int)gridDim.x;
    const int tb = G > nchain ? (int)blockIdx.x - nchain : (int)blockIdx.x, ntb = G > nchain ? G - nchain : G;
    if (tb >= 0) {
        __syncthreads();
        const int tid3 = tid_x(), lane = tid3 & 63, wave = tid3 >> 6;
        float* scr = (float*)smem + wave * (64 * 33);
        bf16_t* GUT = (bf16_t*)(p.aux + AUX_GUT);
        constexpr int nkb = D / 64, nnb = DE / 32, per = nkb * nnb;
        for (int it = tb * 8 + wave; it < NEXP * 2 * per; it += ntb * 8) {
            const int e = it / (2 * per), r = it % (2 * per), up = r / per, r2 = r % per, kb = r2 / nnb, nb = r2 % nnb;
            transpose_item((up ? p.in[I_MU_UP] : p.in[I_MG]) + (size_t)e * D * DE, DE, DE, kb * 64, nb * 32, GUT + (size_t)e * 512 * D, D, up ? 2 : 1, scr, lane);
        }
        constexpr int nkb2 = DE / 64, nnb2 = D / 32, per2 = nkb2 * nnb2;
        for (int it = tb * 8 + wave; it < NE_EARLY * per2; it += ntb * 8) {
            const int e = it / per2, r2 = it % per2, kb = r2 / nnb2, nb = r2 % nnb2;
            transpose_item(p.in[I_MD] + (size_t)e * DE * D, D, D, kb * 64, nb * 32, DNT_PTR(p.ws, e), DE, 0, scr, lane);
        }
    }
}

constexpr int P4_SG = 0;
constexpr int P4_XV = P4_SG + 32 * LD128 * 2;
constexpr int P4_YF = P4_XV + 32 * 520 * 2;
static_assert(P4_YF + 32 * 516 * 4 <= LDS_BYTES, "phase4 lds");
DI void phase4(const Params& p, char* smem) {
    const int tid = tid_x(), lane = tid & 63, wave = tid >> 6, r = lane & 31, hh = lane >> 5;
    const bf16_t* PL = (const bf16_t*)(p.ws + WS_PLAT);
    const bf16_t* ODIR = (const bf16_t*)(p.ws + WS_OA); const bf16_t* YDIR = (const bf16_t*)(p.aux + AUX_YDIR);
    const float* BON = (const float*)(p.ws + WS_BONUS); const float* mu = p.in[I_MU]; const bf16_t* G2T = (const bf16_t*)(p.ws + WS_G2T);
    bf16_t* OA = (bf16_t*)(p.ws + WS_OA); bf16_t* OB = (bf16_t*)(p.ws + WS_OB);
    bf16_t* SG = (bf16_t*)(smem + P4_SG); bf16_t* XV = (bf16_t*)(smem + P4_XV); float* YF = (float*)(smem + P4_YF);
    for (int it = blockIdx.x; it < T_LAT / 32; it += gridDim.x) {
        const int tok0 = it * 32, b = tok0 / S, l0 = tok0 % S;
        __syncthreads();
        for (int q = tid; q < 32 * 80; q += NTHREADS) {
            const int t = q / 80, c8 = q % 80;
            const int l = l0 + t;
            const int bcol = c8 < 16 ? 1792 + c8 * 8 : 1024 + (c8 - 16) * 8;
            float cu[8], o[8];
            unpack8(*(const u32x4*)(PL + (size_t)(b * S + l) * IN_COLS + COL_B0 + bcol), cu);
#pragma unroll
            for (int e = 0; e < 8; ++e) o[e] = c8 < 16 ? fsigmoid(cu[e]) : cu[e];
            u32x4 w; w.x = pk2(o[0], o[1]); w.y = pk2(o[2], o[3]); w.z = pk2(o[4], o[5]); w.w = pk2(o[6], o[7]);
            if (c8 < 16) *(u32x4*)(SG + t * LD128 + c8 * 8) = w; else *(u32x4*)(XV + t * 520 + (c8 - 16) * 8) = w;
        }
        for (int q = tid; q < 32 * 64; q += NTHREADS) {
            const int t = q >> 6, c8 = q & 63, tok = tok0 + t;
            float a0[8], a1[8];
            unpack8(*(const u32x4*)(YDIR + (size_t)tok * 512 + c8 * 8), a0); unpack8(*(const u32x4*)(YDIR + ((size_t)T_LAT + tok) * 512 + c8 * 8), a1);
            f32x4 s0 = {a0[0] + a1[0], a0[1] + a1[1], a0[2] + a1[2], a0[3] + a1[3]}, s1 = {a0[4] + a1[4], a0[5] + a1[5], a0[6] + a1[6], a0[7] + a1[7]};
            *(f32x4*)(YF + t * 516 + c8 * 8) = s0; *(f32x4*)(YF + t * 516 + c8 * 8 + 4) = s1;
        }
        __syncthreads();
        {
            unsigned q0[16], q1[16], zq[16];
#pragma unroll
            for (int k = 0; k < 16; ++k) {
                const int pi = wave * 16 + k, t = pi >> 2, h = pi & 3, tok = tok0 + t;
                const size_t o0 = (size_t)tok * 512 + h * 128 + 2 * lane;
                q0[k] = *(const unsigned*)(ODIR + o0); q1[k] = *(const unsigned*)(ODIR + (size_t)T_LAT * 512 + o0); zq[k] = *(const unsigned*)(PL + (size_t)tok * IN_COLS + 1536 + h * 128 + 2 * lane);
            }
            const float on0 = p.in[I_ONORM][2 * lane], on1 = p.in[I_ONORM][2 * lane + 1];
#pragma unroll
            for (int k = 0; k < 16; ++k) {
                const int pi = wave * 16 + k, t = pi >> 2, h = pi & 3, tok = tok0 + t;
                const size_t o0 = (size_t)tok * 512 + h * 128 + 2 * lane;
                const float a0 = bf2f((bf16_t)(q0[k] & 0xffffu)) + bf2f((bf16_t)(q1[k] & 0xffffu)), a1 = bf2f((bf16_t)(q0[k] >> 16)) + bf2f((bf16_t)(q1[k] >> 16));
                const float ss = wave_sum_fast(a0 * a0 + a1 * a1);
                const float rstd = frsq(ss * (1.f / 128.f) + 1e-6f);
                const float z0 = bf2f((bf16_t)(zq[k] & 0xffffu)), z1 = bf2f((bf16_t)(zq[k] >> 16));
                *(unsigned*)(OA + o0) = pk2(a0 * rstd * on0 * fsilu(z0), a1 * rstd * on1 * fsilu(z1));
            }
        }
        __syncthreads();
        {
            const int h = wave;
            f32x16 acc0 = zero16(), acc1 = zero16();
#pragma unroll
            for (int s2 = 0; s2 < 8; ++s2) {
                const bf16x8 a = ld_nat(SG + r * LD128, s2, hh);
                const bf16x8 b0 = *(const bf16x8*)(G2T + (size_t)(64 * h + r) * 128 + 16 * s2 + 8 * hh), b1 = *(const bf16x8*)(G2T + (size_t)(64 * h + 32 + r) * 128 + 16 * s2 + 8 * hh);
                acc0 = MFMA32(a, b0, acc0); acc1 = MFMA32(a, b1, acc1);
            }
            const int c0 = 64 * h + r, c1 = c0 + 32;
            const float lg0 = p.in[I_LNG][c0], lb0 = p.in[I_LNB][c0], lg1 = p.in[I_LNG][c1], lb1 = p.in[I_LNB][c1];
            float bonv[16];
#pragma unroll
            for (int g = 0; g < 16; ++g) { const int tok = tok0 + crow(g, hh); bonv[g] = BON[(size_t)tok * 8 + h] + BON[((size_t)T_LAT + tok) * 8 + h]; }
#pragma unroll
            for (int g = 0; g < 16; ++g) {
                const int i = crow(g, hh), tok = tok0 + i;
                const float y0 = YF[i * 516 + c0], y1 = YF[i * 516 + c1];
                const float mean = half_sum(y0 + y1, hh) * (1.f / 64.f); const float d0 = y0 - mean, d1 = y1 - mean;
                const float var = half_sum(d0 * d0 + d1 * d1, hh) * (1.f / 64.f); const float rs = frsq(var + 64e-5f);
                const float bon = bonv[g];
                const float o0 = (d0 * rs * lg0 + lb0 + bon * bf2f(XV[i * 520 + c0])) * acc0[g], o1 = (d1 * rs * lg1 + lb1 + bon * bf2f(XV[i * 520 + c1])) * acc1[g];
                OB[(size_t)tok * 512 + c0] = f2bf(o0); OB[(size_t)tok * 512 + c1] = f2bf(o1);
            }
        }
    }
}

DI void phase5(const Params& p, char* smem) {
    const bf16_t* OA = (const bf16_t*)(p.ws + WS_OA); const bf16_t* OB = (const bf16_t*)(p.ws + WS_OB);
    const bf16_t* WA = (const bf16_t*)(p.ws + WS_WOA); const bf16_t* WB = (const bf16_t*)(p.ws + WS_WOB);
    const bf16_t* PL = (const bf16_t*)(p.ws + WS_PLAT); bf16_t* Y = (bf16_t*)(p.aux + AUX_Y);
    if (USE_G8) {
        constexpr int NT8 = D / 256, MT8 = T_LAT / 256;
        constexpr int GLD = 264;
        static_assert(256 * GLD * 2 <= LDS_BYTES, "gate tile lds");
        bf16_t* GT = (bf16_t*)smem;
        auto stage_gates = [&](int brow, int gcol0) {
            const int tid = tid_x();
            u32x4 gv[16];
#pragma unroll
            for (int i = 0; i < 16; ++i) { const int ch = tid + i * NTHREADS, row = ch >> 5, c16 = ch & 31; gv[i] = *(const u32x4*)(PL + (size_t)(brow + row) * IN_COLS + gcol0 + c16 * 8); }
#pragma unroll
            for (int i = 0; i < 16; ++i) { const int ch = tid + i * NTHREADS, row = ch >> 5, c16 = ch & 31; *(u32x4*)(GT + row * GLD + c16 * 8) = gv[i]; }
            __syncthreads();
        };
        for (int t = blockIdx.x; t < MT8 * NT8; t += gridDim.x) {
            int mt, nt; if (!g8::tile_order(t, MT8, NT8, mt, nt)) break;
            const int brow = mt * 256, bcol = nt * 256;
            g8::Acc acc; g8::acc_zero(acc);
            g8::kloop(acc, smem, OA, 512, WA, 512, 512, brow, bcol);
            stage_gates(brow, COL_G0 + bcol);
            g8::for_each_quad(acc, brow, bcol, [&](int row, int col, const f32x4& v) {
                const u32x2 gq = *(const u32x2*)(GT + (row - brow) * GLD + (col - bcol));
                const float g0 = bf2f((bf16_t)(gq.x & 0xffffu)), g1 = bf2f((bf16_t)(gq.x >> 16)), g2 = bf2f((bf16_t)(gq.y & 0xffffu)), g3 = bf2f((bf16_t)(gq.y >> 16));
                u32x2 o; o.x = pk2(fsigmoid(g0) * v.x, fsigmoid(g1) * v.y); o.y = pk2(fsigmoid(g2) * v.z, fsigmoid(g3) * v.w);
                *(u32x2*)(Y + (size_t)row * D + col) = o;
            });
            __syncthreads();
            g8::acc_zero(acc);
            g8::kloop(acc, smem, OB, 512, WB, 512, 512, brow, bcol);
            stage_gates(brow, COL_G0 + D + bcol);
            g8::for_each_quad(acc, brow, bcol, [&](int row, int col, const f32x4& v) {
                const u32x2 gq = *(const u32x2*)(GT + (row - brow) * GLD + (col - bcol));
                const float g0 = bf2f((bf16_t)(gq.x & 0xffffu)), g1 = bf2f((bf16_t)(gq.x >> 16)), g2 = bf2f((bf16_t)(gq.y & 0xffffu)), g3 = bf2f((bf16_t)(gq.y >> 16));
#ifdef EMU
                const unsigned long long tq = *(const unsigned long long*)(Y + (size_t)row * D + col);
#else
                const unsigned long long tq = __hip_atomic_load((const unsigned long long*)(Y + (size_t)row * D + col), __ATOMIC_RELAXED, __HIP_MEMORY_SCOPE_AGENT);
#endif
                const unsigned tlo = (unsigned)tq, thi = (unsigned)(tq >> 32);
                const float t0 = bf2f((bf16_t)(tlo & 0xffffu)), t1 = bf2f((bf16_t)(tlo >> 16)), t2 = bf2f((bf16_t)(thi & 0xffffu)), t3 = bf2f((bf16_t)(thi >> 16));
                u32x2 o; o.x = pk2(t0 + fsigmoid(g0) * v.x, t1 + fsigmoid(g1) * v.y); o.y = pk2(t2 + fsigmoid(g2) * v.z, t3 + fsigmoid(g3) * v.w);
                *(u32x2*)(Y + (size_t)row * D + col) = o;
            });
            __syncthreads();
        }
        return;
    }
    constexpr int MR5 = 2, BM5 = 64 * MR5; constexpr int NT = D / 128, MT = T_LAT / BM5;
    for (int t = blockIdx.x; t < MT * NT; t += gridDim.x) {
        const int mt = t / NT, nt = t % NT, row0 = mt * BM5;
        f32x4 acca[MR5][4], accb[MR5][4]; acc_zero(acca); acc_zero(accb);
        gemm_kloop(acca, smem, [&](int i) { return OA + (size_t)(row0 + i) * 512; }, WA + (size_t)nt * 128 * 512, 512, 512);
        gemm_kloop(accb, smem, [&](int i) { return OB + (size_t)(row0 + i) * 512; }, WB + (size_t)nt * 128 * 512, 512, 512);
        const int t2 = tid_x(), l2 = t2 & 63, w2 = t2 >> 6; const int wr = w2 >> 1, wc = w2 & 1, fr = l2 & 15, fq = l2 >> 4;
#pragma unroll
        for (int m = 0; m < MR5; ++m)
#pragma unroll
            for (int n = 0; n < 4; ++n)
#pragma unroll
                for (int j = 0; j < 4; ++j) {
                    const int row = row0 + wr * 16 * MR5 + m * 16 + fq * 4 + j, col = nt * 128 + wc * 64 + n * 16 + fr;
                    const float ga = bf2f(PL[(size_t)row * IN_COLS + COL_G0 + col]), gb = bf2f(PL[(size_t)row * IN_COLS + COL_G0 + D + col]);
                    Y[(size_t)row * D + col] = f2bf(sigmoidf_(ga) * acca[m][n][j] + sigmoidf_(gb) * accb[m][n][j]);
                }
    }
}

DI void phase6(const Params& p, char* smem) {
    const bf16_t* Y = (const bf16_t*)(p.aux + AUX_Y); const bf16_t* WO = (const bf16_t*)(p.ws + WS_WOUT);
    const float* mod = (const float*)(p.ws + WS_MOD); float* Hh = (float*)(p.ws + WS_H);
    if (USE_G8) {
        constexpr int NT = D / 256, MT = T_LAT / 256;
        const float* X = p.in[I_X];
        for (int t = blockIdx.x; t < MT * NT; t += gridDim.x) {
            int mt, nt; if (!g8::tile_order(t, MT, NT, mt, nt)) break;
            const int brow = mt * 256, bcol = nt * 256;
            g8::Acc acc; g8::acc_zero(acc);
            g8::kloop(acc, smem, Y, D, WO, D, D, brow, bcol);
            g8::for_each_quad(acc, brow, bcol, [&](int row, int col, const f32x4& v) {
                const int b = row / S; const f32x4 xv = *(const f32x4*)(X + (size_t)row * D + col), gv = *(const f32x4*)(mod + (size_t)b * 6 * D + 2 * D + col);
                f32x4 o; o.x = xv.x + gv.x * v.x; o.y = xv.y + gv.y * v.y; o.z = xv.z + gv.z * v.z; o.w = xv.w + gv.w * v.w;
                *(f32x4*)(Hh + (size_t)row * D + col) = o;
            });
        }
    } else {
        const int tid = tid_x(), lane = tid & 63, wave = tid >> 6, wr = wave >> 1, wc = wave & 1, fr = lane & 15, fq = lane >> 4;
        constexpr int NT = D / 128, MT = T_LAT / BM;
        for (int t = blockIdx.x; t < MT * NT; t += gridDim.x) {
            const int mt = t / NT, nt = t % NT, row0 = mt * BM;
            f32x4 acc[MREP][4]; acc_zero(acc);
            gemm_kloop(acc, smem, [&](int i) { return Y + (size_t)(row0 + i) * D; }, WO + (size_t)nt * 128 * D, D, D);
#pragma unroll
            for (int m = 0; m < MREP; ++m)
#pragma unroll
                for (int n = 0; n < 4; ++n)
#pragma unroll
                    for (int j = 0; j < 4; ++j) {
                        const int row = row0 + wr * 16 * MREP + m * 16 + fq * 4 + j, col = nt * 128 + wc * 64 + n * 16 + fr, b = row / S;
                        Hh[(size_t)row * D + col] = p.in[I_X][(size_t)row * D + col] + mod[(size_t)b * 6 * D + 2 * D + col] * acc[m][n][j];
                    }
        }
    }
    __syncthreads();
    const int tid6 = tid_x(), lane = tid6 & 63, wave = tid6 >> 6;
    const int gw = blockIdx.x * 8 + wave, ngw = gridDim.x * 8;
    float* scr = (float*)smem + wave * (64 * 33);
    {
        constexpr int nkb = DE / 64, nnb = D / 32, per = nkb * nnb;
        for (int it = gw; it < (NEXP - NE_EARLY) * per; it += ngw) {
            const int e = NE_EARLY + it / per, r2 = it % per, kb = r2 / nnb, nb = r2 % nnb;
            transpose_item(p.in[I_MD] + (size_t)e * DE * D, D, D, kb * 64, nb * 32, DNT_PTR(p.ws, e), DE, 0, scr, lane);
        }
    }
}

#ifdef EMU
#define MFMA32F(a, b, c) emu_mfma32_f32((a), (b), (c))
#else
#define MFMA32F(a, b, c) __builtin_amdgcn_mfma_f32_32x32x2f32((a), (b), (c), 0, 0, 0)
#endif
constexpr int TB_LD = D + 4;
static_assert(32 * TB_LD * 4 <= LDS_BYTES && 8 * 32 * 64 * 4 <= LDS_BYTES, "phase7 lds");
DI void phase7(const Params& p, char* smem) {
    const int tid = tid_x(), lane = tid & 63, wave = tid >> 6, r = lane & 31, hh = lane >> 5;
    const float* Hh = (const float*)(p.ws + WS_H); const float* mod = (const float*)(p.ws + WS_MOD); const float* WRT = (const float*)(p.ws + WS_WRT);
    bf16_t* Tt = (bf16_t*)(p.ws + WS_T); int* cnt = (int*)(p.ws + WS_CNT); int* rowlist = (int*)(p.ws + WS_ROWLIST); float* pairw = (float*)(p.ws + WS_PAIRW);
    float* tb = (float*)smem;
    float* bias = (float*)(smem + LDS_BYTES - 1024);
    int* lcnt = (int*)(smem + LDS_BYTES - 768);
    int* lbase = lcnt + 32;
    if (tid < 36) bias[tid] = tid < 4 ? p.in[I_RGB][tid] : p.in[I_REB][tid - 4];
    f32x4 x[4][D / 256];
    int itn = blockIdx.x;
    if (itn < T_LAT / 32) {
#pragma unroll
        for (int tt = 0; tt < 4; ++tt)
#pragma unroll
            for (int j = 0; j < D / 256; ++j) x[tt][j] = *(const f32x4*)(Hh + (size_t)(itn * 32 + wave * 4 + tt) * D + j * 256 + lane * 4);
    }
    for (int it = blockIdx.x; it < T_LAT / 32; it += gridDim.x) {
        const int tok0 = it * 32;
        __syncthreads();
        if (tid < 32) lcnt[tid] = 0;
#pragma unroll
        for (int tt = 0; tt < 4; ++tt) {
            const int ti = wave * 4 + tt, tok = tok0 + ti, b = tok / S;
            float ss = 0.f;
#pragma unroll
            for (int j = 0; j < D / 256; ++j) ss += x[tt][j].x * x[tt][j].x + x[tt][j].y * x[tt][j].y + x[tt][j].z * x[tt][j].z + x[tt][j].w * x[tt][j].w;
            ss = wave_sum_fast(ss);
            const float rstd = frsq(ss * (1.0f / D) + 1e-6f);
#pragma unroll
            for (int j = 0; j < D / 256; ++j) {
                const int k = j * 256 + lane * 4;
                const f32x4 g = *(const f32x4*)(p.in[I_NFFN] + k), sh = *(const f32x4*)(mod + (size_t)b * 6 * D + 3 * D + k), sc = *(const f32x4*)(mod + (size_t)b * 6 * D + 4 * D + k);
                f32x4 o; o.x = x[tt][j].x * rstd * g.x * (1.f + sc.x) + sh.x; o.y = x[tt][j].y * rstd * g.y * (1.f + sc.y) + sh.y;
                o.z = x[tt][j].z * rstd * g.z * (1.f + sc.z) + sh.z; o.w = x[tt][j].w * rstd * g.w * (1.f + sc.w) + sh.w;
                *(f32x4*)(tb + ti * TB_LD + k) = o;
                u32x2 ob; ob.x = pk2(o.x, o.y); ob.y = pk2(o.z, o.w);
                *(u32x2*)(Tt + (size_t)tok * D + k) = ob;
            }
        }
        itn = it + gridDim.x;
        if (itn < T_LAT / 32) {
#pragma unroll
            for (int tt = 0; tt < 4; ++tt)
#pragma unroll
                for (int j = 0; j < D / 256; ++j) x[tt][j] = *(const f32x4*)(Hh + (size_t)(itn * 32 + wave * 4 + tt) * D + j * 256 + lane * 4);
        }
        LDS_BARRIER();
        f32x16 a0 = zero16(), a1 = zero16();
        {
            const int kbeg = wave * (D / 8);
            const float* arow = tb + r * TB_LD + kbeg + 4 * hh;
            const float* b0row = WRT + (size_t)(4 + r) * D + kbeg + 4 * hh;
            const float* b1row = WRT + (size_t)(r < 4 ? r : 0) * D + kbeg + 4 * hh;
            const float m1 = r < 4 ? 1.f : 0.f;
#pragma unroll 4
            for (int g = 0; g < D / 64; ++g) {
                const f32x4 av = *(const f32x4*)(arow + 8 * g), b0 = *(const f32x4*)(b0row + 8 * g); const f32x4 b1 = *(const f32x4*)(b1row + 8 * g) * m1;
                a0 = MFMA32F(av.x, b0.x, a0); a1 = MFMA32F(av.x, b1.x, a1); a0 = MFMA32F(av.y, b0.y, a0); a1 = MFMA32F(av.y, b1.y, a1);
                a0 = MFMA32F(av.z, b0.z, a0); a1 = MFMA32F(av.z, b1.z, a1); a0 = MFMA32F(av.w, b0.w, a0); a1 = MFMA32F(av.w, b1.w, a1);
            }
        }
        LDS_BARRIER();
        {
            float* part = tb + wave * (32 * 64);
#pragma unroll
            for (int g = 0; g < 16; ++g) { const int i = crow(g, hh); part[i * 64 + r] = a0[g]; part[i * 64 + 32 + r] = a1[g]; }
        }
        LDS_BARRIER();
        float lsum[4];
        {
            const int i = tid >> 4, c4 = (tid & 15) * 4;
#pragma unroll
            for (int e = 0; e < 4; ++e) { float sacc = 0.f;
#pragma unroll
                for (int w = 0; w < 8; ++w) sacc += tb[w * (32 * 64) + i * 64 + c4 + e];
                lsum[e] = sacc; }
        }
        LDS_BARRIER();
        { const int i = tid >> 4, c4 = (tid & 15) * 4;
#pragma unroll
          for (int e = 0; e < 4; ++e) tb[i * 64 + c4 + e] = lsum[e]; }
        LDS_BARRIER();
        int ex1 = 0, ex2 = 0, rk1 = 0, rk2 = 0; float w1 = 0.f, w2 = 0.f;
        if (tid < 32) {
            const float* L = tb + tid * 64;
            float gl[4];
#pragma unroll
            for (int i = 0; i < 4; ++i) gl[i] = L[32 + i] + bias[i];
            int g = 0; float mx = gl[0];
#pragma unroll
            for (int i = 1; i < 4; ++i) if (gl[i] > mx) { mx = gl[i]; g = i; }
            float se = 0.f;
#pragma unroll
            for (int i = 0; i < 4; ++i) se += fexp(gl[i] - mx);
            const float pg = 1.0f / se;
            int i1 = 0; float l1 = L[g * 8] + bias[4 + g * 8];
            for (int i = 1; i < 8; ++i) { const float v = L[g * 8 + i] + bias[4 + g * 8 + i]; if (v > l1) { l1 = v; i1 = i; } }
            int i2 = -1; float l2 = -3.0e38f;
            for (int i = 0; i < 8; ++i) { const float v = L[g * 8 + i] + bias[4 + g * 8 + i]; if (i != i1 && v > l2) { l2 = v; i2 = i; } }
            const float e2 = fexp(l2 - l1); w1 = pg / (1.f + e2); w2 = pg * e2 / (1.f + e2);
            ex1 = g * 8 + i1; ex2 = g * 8 + i2;
            rk1 = atomicAdd(&lcnt[ex1], 1); rk2 = atomicAdd(&lcnt[ex2], 1);
        }
        LDS_BARRIER();
        if (tid < 32) { const int c = lcnt[tid]; lbase[tid] = c ? atomicAdd(&cnt[tid * CNT_STRIDE], c) : 0; }
        __syncthreads();
        if (tid < 32) {
            const int tok = tok0 + tid;
            rowlist[(size_t)ex1 * CAP + lbase[ex1] + rk1] = tok * 2; pairw[tok * 2] = w1;
            rowlist[(size_t)ex2 * CAP + lbase[ex2] + rk2] = tok * 2 + 1; pairw[tok * 2 + 1] = w2;
        }
    }
}

constexpr int MOE_TM = USE_G8 ? 256 : BM;
DI void moe_tiles(const Params& p, char* smem, int* pre) {
    const int* cnt = (const int*)(p.ws + WS_CNT);
    __syncthreads();
    if (tid_x() == 0) { int s = 0; for (int e = 0; e < NEXP; ++e) { pre[e] = s; s += (cnt[e * CNT_STRIDE] + MOE_TM - 1) / MOE_TM; } pre[NEXP] = s; }
    __syncthreads();
}
DI void moe_up_tile(const Params& p, char* smem, const int* pre, int t) {
    const int* cnt = (const int*)(p.ws + WS_CNT); const int* rowlist = (const int*)(p.ws + WS_ROWLIST);
    const bf16_t* Tt = (const bf16_t*)(p.ws + WS_T); const bf16_t* GUT = (const bf16_t*)(p.aux + AUX_GUT); bf16_t* HID = (bf16_t*)(p.ws + WS_HID);
    const int mg = t >> 1, nt = t & 1; int e = 0;
    while (pre[e + 1] <= mg) ++e;
    const int mt = mg - pre[e], ce = cnt[e * CNT_STRIDE]; const int* rl = rowlist + (size_t)e * CAP;
    g8::Acc acc; g8::acc_zero(acc);
    g8::kloop_g(acc, smem, Tt, [&](int r) { int idx = mt * 256 + r; idx = idx < ce ? idx : ce - 1; return (rl[idx] >> 1) * D; }, GUT + ((size_t)e * 512 + nt * 256) * D, D, D, 0);
    const int t2 = tid_x(), wid = t2 >> 6, l2 = t2 & 63, wr2 = wid >> 2, wc2 = wid & 3, fr2 = l2 & 15, fq2 = l2 >> 4;
    int prs[2][4];
#pragma unroll
    for (int ai = 0; ai < 2; ++ai)
#pragma unroll
        for (int m = 0; m < 4; ++m) { const int idx = mt * 256 + ai * 128 + wr2 * 64 + m * 16 + fr2; prs[ai][m] = idx < ce ? rl[idx] : -1; }
#pragma unroll
    for (int ai = 0; ai < 2; ++ai)
#pragma unroll
        for (int m = 0; m < 4; ++m) {
            if (prs[ai][m] >= 0) {
                const int pair = prs[ai][m];
#pragma unroll
                for (int bj = 0; bj < 2; ++bj) {
                    const f32x4 g = acc[ai][bj][m][0], u = acc[ai][bj][m][1];
                    u32x2 o; o.x = pk2(fsilu(g.x) * u.x, fsilu(g.y) * u.y); o.y = pk2(fsilu(g.z) * u.z, fsilu(g.w) * u.w);
                    *(u32x2*)(HID + (size_t)pair * DE + nt * 128 + bj * 64 + wc2 * 16 + fq2 * 4) = o;
                }
            }
        }
}
DI void moe_down_tile(const Params& p, char* smem, const int* pre, int t) {
    constexpr int NT8 = D / 256;
    const int* cnt = (const int*)(p.ws + WS_CNT); const int* rowlist = (const int*)(p.ws + WS_ROWLIST); const float* pairw = (const float*)(p.ws + WS_PAIRW);
    const bf16_t* HID = (const bf16_t*)(p.ws + WS_HID); bf16_t* OP = (bf16_t*)(p.ws + WS_OPAIR);
    const int mg = t / NT8, nt = t % NT8; int e = 0;
    while (pre[e + 1] <= mg) ++e;
    const int mt = mg - pre[e], ce = cnt[e * CNT_STRIDE]; const int* rl = rowlist + (size_t)e * CAP;
    g8::Acc acc; g8::acc_zero(acc);
    g8::kloop_g(acc, smem, HID, [&](int r) { int idx = mt * 256 + r; idx = idx < ce ? idx : ce - 1; return rl[idx] * DE; }, DNT_PTR(p.ws, e) + (size_t)nt * 256 * DE, DE, DE, 0);
    {
        const int t2 = tid_x(), wid = t2 >> 6, l2 = t2 & 63, wr2 = wid >> 2, wc2 = wid & 3, fr2 = l2 & 15, fq2 = l2 >> 4;
        int prs[2][4]; float pws[2][4];
#pragma unroll
        for (int ai = 0; ai < 2; ++ai)
#pragma unroll
            for (int m = 0; m < 4; ++m) { const int idx = mt * 256 + ai * 128 + wr2 * 64 + m * 16 + fr2; prs[ai][m] = idx < ce ? rl[idx] : -1; }
#pragma unroll
        for (int ai = 0; ai < 2; ++ai)
#pragma unroll
            for (int m = 0; m < 4; ++m) pws[ai][m] = prs[ai][m] >= 0 ? pairw[prs[ai][m]] : 0.f;
#pragma unroll
        for (int ai = 0; ai < 2; ++ai)
#pragma unroll
            for (int m = 0; m < 4; ++m) {
                if (prs[ai][m] >= 0) {
                    const float w = pws[ai][m]; bf16_t* orow = OP + (size_t)prs[ai][m] * D + nt * 256 + wc2 * 32 + fq2 * 4;
#pragma unroll
                    for (int bj = 0; bj < 2; ++bj)
#pragma unroll
                        for (int n = 0; n < 2; ++n) { const f32x4 v = acc[ai][bj][m][n];
                            u32x2 o; o.x = pk2(v.x * w, v.y * w); o.y = pk2(v.z * w, v.w * w); *(u32x2*)(orow + bj * 128 + n * 16) = o; }
                }
            }
    }
}
DI void phase8(const Params& p, char* smem) {
    const int tid = tid_x(), lane = tid & 63, wave = tid >> 6, wr = wave >> 1, wc = wave & 1, fr = lane & 15, fq = lane >> 4;
    int* pre = (int*)(smem + LDS_BYTES - 256);
    moe_tiles(p, smem, pre);
    const int* cnt = (const int*)(p.ws + WS_CNT); const int* rowlist = (const int*)(p.ws + WS_ROWLIST);
    const bf16_t* Tt = (const bf16_t*)(p.ws + WS_T); const bf16_t* GUT = (const bf16_t*)(p.aux + AUX_GUT); bf16_t* HID = (bf16_t*)(p.ws + WS_HID);
    if (USE_G8) {
        if ((int)blockIdx.x < pre[NEXP] * 2) moe_up_tile(p, smem, pre, (int)blockIdx.x);
        return;
    }
    const int ntile = pre[NEXP] * 4;
    for (int t = blockIdx.x; t < ntile; t += gridDim.x) {
        const int mg = t >> 2, nt = t & 3; int e = 0;
        while (pre[e + 1] <= mg) ++e;
        const int mt = mg - pre[e], ce = cnt[e * CNT_STRIDE]; const int* rl = rowlist + (size_t)e * CAP;
        f32x4 acc[MREP][4]; acc_zero(acc);
        gemm_kloop(acc, smem, [&](int i) { int idx = mt * BM + i; idx = idx < ce ? idx : ce - 1; return Tt + (size_t)(rl[idx] >> 1) * D; }, GUT + ((size_t)e * 512 + nt * 128) * D, D, D);
#pragma unroll
        for (int m = 0; m < MREP; ++m)
#pragma unroll
            for (int j = 0; j < 4; ++j) {
                const int idx = mt * BM + wr * 16 * MREP + m * 16 + fq * 4 + j;
                if (idx < ce) {
                    const int pair = rl[idx];
#pragma unroll
                    for (int n = 0; n < 2; ++n) {
                        const float g = acc[m][n][j], u = acc[m][n + 2][j];
                        HID[(size_t)pair * DE + nt * 64 + wc * 32 + n * 16 + fr] = f2bf(siluf_(g) * u);
                    }
                }
            }
    }
}
DI void phase9(const Params& p, char* smem) {
    const int tid = tid_x(), lane = tid & 63, wave = tid >> 6, wr = wave >> 1, wc = wave & 1, fr = lane & 15, fq = lane >> 4;
    int* pre = (int*)(smem + LDS_BYTES - 256);
    moe_tiles(p, smem, pre);
    const int* cnt = (const int*)(p.ws + WS_CNT); const int* rowlist = (const int*)(p.ws + WS_ROWLIST); const float* pairw = (const float*)(p.ws + WS_PAIRW);
    const bf16_t* HID = (const bf16_t*)(p.ws + WS_HID); const bf16_t* DNT = (const bf16_t*)(p.ws + WS_DNT); bf16_t* OP = (bf16_t*)(p.ws + WS_OPAIR);
    if (USE_G8) {
        constexpr int NT8 = D / 256;
        const int G = (int)gridDim.x, NU = pre[NEXP] * 2, NU2 = NU > G ? NU - G : 0, ND = pre[NEXP] * NT8;
        int* cntw = (int*)(p.ws + WS_CNT);
        int* tk = (int*)(smem + LDS_BYTES - 512);
        for (;;) {
            __syncthreads();
            if (tid_x() == 0) *tk = atomicAdd(&cntw[CNT_TICKET], 1);
            __syncthreads();
            const int j = *tk;
            if (j >= NU2 + ND) break;
            if (j < NU2) {
                moe_up_tile(p, smem, pre, G + j);
#ifndef EMU
                asm volatile("s_waitcnt vmcnt(0)" ::: "memory");
#endif
                __syncthreads();
                if (tid_x() == 0) {
#ifndef EMU
                    __builtin_amdgcn_fence(__ATOMIC_RELEASE, "agent");
                    asm volatile("s_waitcnt vmcnt(0)" ::: "memory");
#endif
                    (void)atomicAdd(&cntw[CNT_U2DONE], 1);
                }
            } else {
                const int dt = j - NU2;
                if (2 * (dt / NT8) + 1 >= G) {
                    if (tid_x() == 0) {
#ifndef EMU
                        while (__hip_atomic_load(&cntw[CNT_U2DONE], __ATOMIC_RELAXED, __HIP_MEMORY_SCOPE_AGENT) < NU2) __builtin_amdgcn_s_sleep(2);
                        __builtin_amdgcn_fence(__ATOMIC_ACQUIRE, "agent");
                        asm volatile("s_waitcnt vmcnt(0)" ::: "memory");
#endif
                    }
                    __syncthreads();
                }
                moe_down_tile(p, smem, pre, dt);
            }
        }
        return;
    }
    constexpr int NT = D / 128;
    const int ntile = pre[NEXP] * NT;
    for (int t = blockIdx.x; t < ntile; t += gridDim.x) {
        const int mg = t / NT, nt = t % NT; int e = 0;
        while (pre[e + 1] <= mg) ++e;
        const int mt = mg - pre[e], ce = cnt[e * CNT_STRIDE]; const int* rl = rowlist + (size_t)e * CAP;
        f32x4 acc[MREP][4]; acc_zero(acc);
        gemm_kloop(acc, smem, [&](int i) { int idx = mt * BM + i; idx = idx < ce ? idx : ce - 1; return HID + (size_t)rl[idx] * DE; }, DNT_PTR(p.ws, e) + (size_t)nt * 128 * DE, DE, DE);
#pragma unroll
        for (int m = 0; m < MREP; ++m)
#pragma unroll
            for (int j = 0; j < 4; ++j) {
                const int idx = mt * BM + wr * 16 * MREP + m * 16 + fq * 4 + j;
                if (idx < ce) {
                    const int pair = rl[idx]; const float w = pairw[pair];
#pragma unroll
                    for (int n = 0; n < 4; ++n) OP[(size_t)pair * D + nt * 128 + wc * 64 + n * 16 + fr] = f2bf(acc[m][n][j] * w);
                }
            }
    }
}

DI void phase10(const Params& p, char* smem) {
    const int lane = tid_x() & 63, wave = tid_x() >> 6;
    const int gw = blockIdx.x * 8 + wave, ngw = gridDim.x * 8;
    const float* Hh = (const float*)(p.ws + WS_H); const float* mod = (const float*)(p.ws + WS_MOD); const bf16_t* OP = (const bf16_t*)(p.ws + WS_OPAIR);
    for (int tok = gw; tok < T_LAT; tok += ngw) {
        const int b = tok / S;
        f32x4 x[D / 256]; float ss = 0.f;
#pragma unroll
        for (int j = 0; j < D / 256; ++j) {
            const int k = j * 256 + lane * 4;
            const f32x4 hv = *(const f32x4*)(Hh + (size_t)tok * D + k), g2 = *(const f32x4*)(mod + (size_t)b * 6 * D + 5 * D + k);
            const u32x2 p0 = *(const u32x2*)(OP + (size_t)(tok * 2) * D + k), p1 = *(const u32x2*)(OP + (size_t)(tok * 2 + 1) * D + k);
            f32x4 m;
            m.x = bf2f((bf16_t)(p0.x & 0xffffu)) + bf2f((bf16_t)(p1.x & 0xffffu)); m.y = bf2f((bf16_t)(p0.x >> 16)) + bf2f((bf16_t)(p1.x >> 16));
            m.z = bf2f((bf16_t)(p0.y & 0xffffu)) + bf2f((bf16_t)(p1.y & 0xffffu)); m.w = bf2f((bf16_t)(p0.y >> 16)) + bf2f((bf16_t)(p1.y >> 16));
            x[j].x = hv.x + g2.x * m.x; x[j].y = hv.y + g2.y * m.y; x[j].z = hv.z + g2.z * m.z; x[j].w = hv.w + g2.w * m.w;
            ss += x[j].x * x[j].x + x[j].y * x[j].y + x[j].z * x[j].z + x[j].w * x[j].w;
        }
        ss = wave_sum(ss);
        const float rstd = 1.0f / sqrtf(ss * (1.0f / D) + 1e-6f);
#pragma unroll
        for (int j = 0; j < D / 256; ++j) {
            const int k = j * 256 + lane * 4; const f32x4 g = *(const f32x4*)(p.in[I_FIN] + k);
            f32x4 o; o.x = x[j].x * rstd * g.x; o.y = x[j].y * rstd * g.y; o.z = x[j].z * rstd * g.z; o.w = x[j].w * rstd * g.w;
            *(f32x4*)(p.out + (size_t)tok * D + k) = o;
        }
    }
}

DI void run_phase(const Params& p, int ph, char* smem) {
    switch (ph) {
        case PH_MOD: phase0(p, smem); break;
        case PH_U: phase1(p, smem); break;
        case PH_P: phase2(p, smem); break;
        case PH_HALO: phase_halo(p, smem); break;
        case PH_FIR: phase_fir(p, smem); break;
        case PH_CHAINS: phase3(p, smem); break;
        case PH_POST: phase4(p, smem); break;
        case PH_MERGE: phase5(p, smem); break;
        case PH_WOUT: phase6(p, smem); break;
        case PH_ROUTER: phase7(p, smem); break;
        case PH_UP: phase8(p, smem); break;
        case PH_DOWN: phase9(p, smem); break;
        default: phase10(p, smem); break;
    }
}

#ifndef EMU
namespace cg = cooperative_groups;
#define XB_TMO      128
#define XB_XCNT(j)  (256  + 64 * (j))
#define XB_XSUB(j)  (1280 + 64 * (j))
#define XB_XGEN(j)  (2304 + 64 * (j))
#define XB_TOP      3328
#define XB_TOPGEN   3392
#define XB_SPIN_CAP (1u << 20)
DI unsigned xb_ld(unsigned* p) { return __hip_atomic_load(p, __ATOMIC_RELAXED, __HIP_MEMORY_SCOPE_AGENT); }
DI unsigned xb_add(unsigned* p, unsigned v) { return __hip_atomic_fetch_add(p, v, __ATOMIC_RELAXED, __HIP_MEMORY_SCOPE_AGENT); }
DI unsigned xb_xcc_id() { return (unsigned)__builtin_amdgcn_s_getreg((3 << 11) | 20) & 0xFu; }
#define XB_SPIN(cond, bar) do { unsigned _sp = 0; while (cond) { __builtin_amdgcn_s_sleep(1); \
    if ((++_sp & 255u) == 0u) { if (xb_ld(&(bar)[XB_TMO])) break; if (_sp > XB_SPIN_CAP) { atomicAdd(&(bar)[XB_TMO], 1u); break; } } } } while (0)
DI void xcd_barrier_post(unsigned* bar) { if (threadIdx.x == 0) (void)xb_add(&bar[XB_XCNT(xb_xcc_id())], 1u); }
DI void xcd_barrier_complete(unsigned* bar, unsigned x, unsigned& nloc, unsigned& nx) {
    const unsigned G = gridDim.x;
    unsigned sum, cnt, mine, sp = 0u;
    for (;;) {
        sum = 0u; cnt = 0u; mine = 0u;
#pragma unroll
        for (unsigned j = 0; j < 16; ++j) { const unsigned c = xb_ld(&bar[XB_XCNT(j)]); sum += c; cnt += (c > 0u) ? 1u : 0u; mine = (j == x) ? c : mine; }
        if (sum == G) break;
        __builtin_amdgcn_s_sleep(1);
        if ((++sp & 255u) == 0u) { if (xb_ld(&bar[XB_TMO])) break; if (sp > XB_SPIN_CAP) { atomicAdd(&bar[XB_TMO], 1u); break; } }
    }
    nloc = mine > 0u ? mine : 1u; nx = cnt > 0u ? cnt : 1u;
}
DI void xcd_barrier(unsigned* bar, volatile unsigned* st) {
    asm volatile("s_waitcnt vmcnt(0)" ::: "memory");
    __syncthreads();
    if (threadIdx.x == 0) {
        __builtin_amdgcn_s_waitcnt(0);
        const unsigned x = xb_xcc_id();
        unsigned nloc = st[0], nx = st[1];
        if (nloc == 0u) { xcd_barrier_complete(bar, x, nloc, nx); st[0] = nloc; st[1] = nx; }
        const unsigned old = xb_add(&bar[XB_XSUB(x)], 1u);
        const unsigned gen = old / nloc;
        if (old + 1u == (gen + 1u) * nloc) {
            __builtin_amdgcn_fence(__ATOMIC_RELEASE, "agent");
            asm volatile("s_waitcnt vmcnt(0)" ::: "memory");
            const unsigned og = xb_add(&bar[XB_TOP], 1u);
            const unsigned tg = og / nx;
            if (og + 1u == (tg + 1u) * nx) xb_add(&bar[XB_TOPGEN], 1u);
            else XB_SPIN(xb_ld(&bar[XB_TOPGEN]) == tg, bar);
            __builtin_amdgcn_fence(__ATOMIC_ACQUIRE, "agent");
            xb_add(&bar[XB_XGEN(x)], 1u);
            asm volatile("s_waitcnt vmcnt(0)" ::: "memory");
        } else {
            XB_SPIN(xb_ld(&bar[XB_XGEN(x)]) == gen, bar);
            __builtin_amdgcn_fence(__ATOMIC_ACQUIRE, "agent");
            asm volatile("s_waitcnt vmcnt(0)" ::: "memory");
        }
    }
    __syncthreads();
}
__global__ void __launch_bounds__(NTHREADS) mk_forward(Params p) {
    extern __shared__ __attribute__((aligned(16))) char smem[];
    typedef const Params __attribute__((address_space(4)))* KPtr;
    volatile unsigned* xst = (volatile unsigned*)(smem + LDS_BYTES);
    if (threadIdx.x < 2) xst[threadIdx.x] = 0u;
    xcd_barrier_post((unsigned*)(p.ws + WS_XBAR));
#define PHASE(k, fn) { KPtr kp = (KPtr)__builtin_amdgcn_kernarg_segment_ptr(); asm volatile("" : "+s"(kp)); fn(*(const Params*)kp, smem); \
        unsigned* xbar = (unsigned*)(((const Params*)kp)->ws + WS_XBAR); \
        if ((k) + 1 < NPHASES) xcd_barrier(xbar, xst); }
    PHASE(0, phase0) PHASE(1, phase1) PHASE(2, phase2)
    if (!USE_G8) PHASE(3, phase_halo)
    PHASE(4, phase_fir) PHASE(5, phase3) PHASE(6, phase4)
    PHASE(7, phase5) PHASE(8, phase6) PHASE(9, phase7) PHASE(10, phase8) PHASE(11, phase9) PHASE(12, phase10)
#undef PHASE
}

extern "C" void kernel_launch(void* const* d_in, const int* in_sizes, int n_in, void* d_out, int out_size, void* d_ws, size_t ws_size, hipStream_t stream) {
    static int grid_blocks = 0;
    if (grid_blocks == 0) {
        if (n_in != 35 || out_size != T_LAT * D || ws_size < WS_END || (size_t)out_size * 4 < AUX_END) {
            fprintf(stderr, "kernel_launch: unexpected shapes (n_in %d out %d ws %zu need %zu aux need %zu)\n", n_in, out_size, ws_size, (size_t)WS_END, (size_t)AUX_END);
            grid_blocks = -1; return;
        }
        int dev = 0, cus = 0, per_cu = 0;
        hipGetDevice(&dev);
        hipDeviceGetAttribute(&cus, hipDeviceAttributeMultiprocessorCount, dev);
        hipFuncSetAttribute((const void*)mk_forward, hipFuncAttributeMaxDynamicSharedMemorySize, LDS_BYTES + 256);
        hipOccupancyMaxActiveBlocksPerMultiprocessor(&per_cu, (const void*)mk_forward, NTHREADS, LDS_BYTES + 256);
        if (per_cu < 1) { fprintf(stderr, "kernel_launch: occupancy query says %d blocks/CU\n", per_cu); per_cu = 1; }
        if (per_cu > 1) per_cu = 1;
        grid_blocks = cus * per_cu;
    }
    if (grid_blocks < 0) return;
    Params p{};
    for (int i = 0; i < 35; ++i) p.in[i] = (const float*)d_in[i];
    p.out = (float*)d_out; p.ws = (char*)d_ws; p.aux = (char*)d_out;
    p.ph_lo = 0; p.ph_hi = NPHASES;
    (void)hipMemsetAsync((char*)d_ws + WS_XBAR, 0, 3456 * 4, stream);
    void* args[] = {&p};
    hipError_t e = hipLaunchCooperativeKernel((const void*)mk_forward, dim3(grid_blocks), dim3(NTHREADS), args, LDS_BYTES + 256, stream);
    if (e != hipSuccess) fprintf(stderr, "cooperative launch failed: %s (grid %d)\n", hipGetErrorString(e), grid_blocks);
}
#endif
```

```cpp
#ifndef EMU
#include <hip/hip_runtime.h>
#include <hip/hip_cooperative_groups.h>
#include <cstdio>
#endif
#include <stdint.h>
#include <stddef.h>

#ifndef CFG_D
#define CFG_D 1024
#define CFG_B 8
#define CFG_S 2048
#define CFG_CTX 256
#endif
#ifndef MK_LAUNCHES
#define MK_LAUNCHES 1
#endif

typedef unsigned short bf16_t;
typedef short bf16x8 __attribute__((ext_vector_type(8)));
typedef float f32x4 __attribute__((ext_vector_type(4)));
typedef unsigned u32x4 __attribute__((ext_vector_type(4)));
typedef unsigned u32x2 __attribute__((ext_vector_type(2)));

#define DI __device__ __forceinline__
DI int tid_x() { int t = (int)threadIdx.x;
#ifndef EMU
    asm volatile("" : "+v"(t));
#endif
    return t; }

constexpr int D = CFG_D, NB = CFG_B, S = CFG_S, CTXL = CFG_CTX;
constexpr int GW = 64, ROWS = S / GW;
constexpr int T_CTX = NB * CTXL, T_LAT = NB * S, T_ALL = T_CTX + T_LAT;
constexpr int H_A = 4, H_B = 8;
constexpr int A_COLS = 2064, B_COLS = 1920;
constexpr int IN_COLS = A_COLS + B_COLS + 2 * D;
constexpr int COL_B0 = A_COLS, COL_G0 = A_COLS + B_COLS;
constexpr int CTX_COLS = COL_G0;
constexpr int NP = ((IN_COLS + 127) / 128) * 128;
constexpr int NEXP = 32, DE = 256;
constexpr int NV = NB + 1;
constexpr int NTHREADS = 512;
constexpr int MREP = (T_CTX % 256 == 0 && T_LAT % 256 == 0) ? 4 : 2;
constexpr int BM = 64 * MREP;
constexpr int NPHASES = 13;
enum { PH_MOD = 0, PH_U, PH_P, PH_HALO, PH_FIR, PH_CHAINS, PH_POST, PH_MERGE, PH_WOUT, PH_ROUTER, PH_UP, PH_DOWN, PH_FINAL };
constexpr int LDS_BYTES = 155648;
constexpr int CAP = T_LAT;

static_assert(D % 256 == 0 && S % 64 == 0 && CTXL % 64 == 0 && T_CTX % BM == 0 && T_LAT % BM == 0, "shape");

constexpr size_t al256(size_t x) { return (x + 255) & ~(size_t)255; }
constexpr int CNT_STRIDE = 64;
constexpr size_t WS_CNT = 512 + 3456 * 4 + 256;
constexpr int CNT_TICKET = 2 * CNT_STRIDE + 16, CNT_U2DONE = 3 * CNT_STRIDE + 16;
constexpr size_t WS_BAR = 256;
constexpr size_t WS_XBAR = 512;
constexpr size_t WS_MOD = 512 + 3456 * 4 + 256 + 32 * 64 * 4;
constexpr size_t WS_AB = al256(WS_MOD + (size_t)NV * 6 * D * 4);
constexpr size_t WS_BONUS = al256(WS_AB + (size_t)T_ALL * 16 * 4);
constexpr size_t WS_PAIRW = al256(WS_BONUS + (size_t)2 * T_LAT * 8 * 4);
constexpr size_t WS_ROWLIST = al256(WS_PAIRW + (size_t)T_LAT * 2 * 4);
constexpr size_t WS_WRT = al256(WS_ROWLIST + (size_t)NEXP * CAP * 4);
constexpr size_t WS_G2T = al256(WS_WRT + (size_t)36 * D * 4);
constexpr size_t WS_WOA = al256(WS_G2T + (size_t)512 * 128 * 2);
constexpr size_t WS_WOB = al256(WS_WOA + (size_t)D * 512 * 2);
constexpr size_t WS_WOUT = al256(WS_WOB + (size_t)D * 512 * 2);
constexpr size_t WS_OA = al256(WS_WOUT + (size_t)D * D * 2);
constexpr size_t WS_OB = al256(WS_OA + (size_t)T_LAT * 512 * 2);
constexpr size_t WS_HALO_A = WS_OA;
constexpr size_t WS_HALO_B = WS_OA + al256((size_t)(T_ALL / 64) * 4 * 1536 * 2);
static_assert(WS_HALO_B + (size_t)(T_ALL / 64) * 2 * 1920 * 2 <= WS_OB + (size_t)T_LAT * 512 * 2, "halo buffers");
constexpr size_t WS_DNT = WS_OA;
constexpr size_t WS_SPARE_END = al256(WS_OB + (size_t)T_LAT * 512 * 2) > al256(WS_DNT + (size_t)NEXP * D * DE * 2) ? al256(WS_OB + (size_t)T_LAT * 512 * 2) : al256(WS_DNT + (size_t)NEXP * D * DE * 2);
constexpr size_t WS_P = WS_SPARE_END;
constexpr size_t WS_PLAT = WS_P;
constexpr size_t WS_PCTX = al256(WS_PLAT + (size_t)T_LAT * IN_COLS * 2);
constexpr size_t WS_P_END = al256(WS_PCTX + (size_t)T_CTX * CTX_COLS * 2);
constexpr size_t WS_H = WS_P;
constexpr size_t WS_T = al256(WS_H + (size_t)T_LAT * D * 4);
constexpr size_t WS_HID = al256(WS_T + (size_t)T_LAT * D * 2);
constexpr size_t WS_OPAIR = al256(WS_HID + (size_t)T_LAT * 2 * DE * 2);
constexpr size_t WS_P2_END = al256(WS_OPAIR + (size_t)T_LAT * 2 * D * 2);
constexpr size_t WS_END0 = WS_P_END > WS_P2_END ? WS_P_END : WS_P2_END;
constexpr size_t WS_GUARANTEED = (size_t)256 << 20;
constexpr int NE_EARLY = WS_END0 >= WS_GUARANTEED ? 0 : ((WS_GUARANTEED - WS_END0) / ((size_t)D * DE * 2) >= (size_t)NEXP ? NEXP : (int)((WS_GUARANTEED - WS_END0) / ((size_t)D * DE * 2)));
constexpr size_t WS_DNT2 = WS_END0;
constexpr size_t WS_END = WS_DNT2 + (size_t)NE_EARLY * D * DE * 2;
constexpr size_t AUX_WINT = 0;
constexpr size_t AUX_U = al256((size_t)NP * D * 2);
constexpr size_t AUX_YDIR = 0;
constexpr size_t AUX_Y = 0;
constexpr size_t AUX_GUT = (size_t)T_LAT * D * 2 > (size_t)2 * T_LAT * 512 * 2 ? (size_t)T_LAT * D * 2 : (size_t)2 * T_LAT * 512 * 2;
constexpr size_t AUX_END1 = AUX_U + (size_t)T_ALL * D * 2;
constexpr size_t AUX_END2 = AUX_YDIR + (size_t)2 * T_LAT * 512 * 2;
static_assert(AUX_YDIR + (size_t)2 * T_LAT * 512 * 2 <= AUX_GUT && AUX_Y + (size_t)T_LAT * D * 2 <= AUX_GUT, "aux overlap");
constexpr size_t AUX_END3 = AUX_GUT + (size_t)NEXP * 512 * D * 2;
constexpr size_t AUX_END = (AUX_END1 > AUX_END2 ? (AUX_END1 > AUX_END3 ? AUX_END1 : AUX_END3) : (AUX_END2 > AUX_END3 ? AUX_END2 : AUX_END3));

#define DNT_PTR(ws, e) ((bf16_t*)((ws) + ((e) < NE_EARLY ? WS_DNT2 : WS_DNT)) + (size_t)(e) * D * DE)
struct Params {
    const float* in[35];
    float* out;
    char* ws;
    char* aux;
    int ph_lo, ph_hi;
};
enum { I_X = 0, I_C, I_CTX, I_CCTX, I_ADAW, I_ADAB, I_NMIX, I_NFFN, I_WIN, I_CONV, I_ALOG, I_DTB, I_ONORM, I_MU, I_W0, I_W2, I_A0, I_A2, I_G2, I_KK, I_KA, I_RK, I_LNG, I_LNB, I_WOA, I_WOB, I_WOUT, I_RG, I_RGB, I_RE, I_REB, I_MG, I_MU_UP, I_MD, I_FIN };

DI float bf2f(bf16_t v) { union { unsigned u; float f; } x; x.u = ((unsigned)v) << 16; return x.f; }
#ifdef EMU
DI bf16_t f2bf(float f) { union { float f; unsigned u; } x; x.f = f; unsigned u = x.u; u += 0x7fffu + ((u >> 16) & 1u); return (bf16_t)(u >> 16); }
DI unsigned pk2(float lo, float hi) { return (unsigned)f2bf(lo) | ((unsigned)f2bf(hi) << 16); }
#else
typedef __bf16 hbf16x2 __attribute__((ext_vector_type(2)));
typedef float f32x2_ __attribute__((ext_vector_type(2)));
DI bf16_t f2bf(float f) { return __builtin_bit_cast(unsigned short, (__bf16)f); }
DI unsigned pk2(float lo, float hi) { const f32x2_ v = {lo, hi}; return __builtin_bit_cast(unsigned, __builtin_convertvector(v, hbf16x2)); }
#endif
DI float sigmoidf_(float x) { return 1.0f / (1.0f + expf(-x)); }
DI float siluf_(float x) { return x / (1.0f + expf(-x)); }
DI float softplusf_(float x) { return x > 20.f ? x : log1pf(expf(x)); }
DI float wave_sum(float v) {
#pragma unroll
    for (int o = 1; o < 64; o <<= 1) v += __shfl_xor(v, o);
    return v;
}
#ifdef EMU
#define MFMA16(a, b, c) emu_mfma16((a), (b), (c))
#define WAVE_SYNC() emu::wave_bar()
#else
#define MFMA16(a, b, c) __builtin_amdgcn_mfma_f32_16x16x32_bf16((a), (b), (c), 0, 0, 0)
#define WAVE_SYNC() asm volatile("s_waitcnt lgkmcnt(0)" ::: "memory")
#endif
#ifdef EMU
#define SETPRIO(x)
#else
#define SETPRIO(x) __builtin_amdgcn_s_setprio(x)
#endif
#ifdef EMU
#define LDS_BARRIER() __syncthreads()
#else
#define LDS_BARRIER() do { asm volatile("s_waitcnt lgkmcnt(0)" ::: "memory"); __builtin_amdgcn_s_barrier(); asm volatile("" ::: "memory"); } while (0)
#endif

typedef float f32x16 __attribute__((ext_vector_type(16)));
typedef float f32x2_ac __attribute__((ext_vector_type(2)));
typedef short bf16x4 __attribute__((ext_vector_type(4)));
#ifdef EMU
#define MFMA32(a, b, c) emu_mfma32((a), (b), (c))
DI float fexp(float x) { return expf(x); }
DI float flog(float x) { return logf(x); }
DI float frcp(float x) { return 1.0f / x; }
DI float frsq(float x) { return 1.0f / sqrtf(x); }
DI float wave_sum_fast(float v) { return wave_sum(v); }
#else
#define MFMA32(a, b, c) __builtin_amdgcn_mfma_f32_32x32x16_bf16((a), (b), (c), 0, 0, 0)
DI float fexp(float x) { return __expf(x); }
DI float flog(float x) { return __logf(x); }
DI float frcp(float x) { return __builtin_amdgcn_rcpf(x); }
DI float frsq(float x) { return __builtin_amdgcn_rsqf(x); }
#define DPP_ADD(v, ctrl) ((v) + __builtin_bit_cast(float, __builtin_amdgcn_update_dpp(0, __builtin_bit_cast(int, (v)), (ctrl), 0xf, 0xf, false)))
DI float wave_sum_fast(float v) {
    v = DPP_ADD(v, 0xB1); v = DPP_ADD(v, 0x4E); v = DPP_ADD(v, 0x141); v = DPP_ADD(v, 0x140);
    const int iv = __builtin_bit_cast(int, v);
    return (__builtin_bit_cast(float, __builtin_amdgcn_readlane(iv, 0)) + __builtin_bit_cast(float, __builtin_amdgcn_readlane(iv, 16))) +
           (__builtin_bit_cast(float, __builtin_amdgcn_readlane(iv, 32)) + __builtin_bit_cast(float, __builtin_amdgcn_readlane(iv, 48)));
}
#endif
DI float fsigmoid(float x) { return frcp(1.0f + fexp(-x)); }
DI float fsilu(float x) { return x * fsigmoid(x); }
DI float fsoftplus(float x) { return fmaxf(x, 0.f) + flog(1.f + fexp(-fabsf(x))); }
DI float ftanh(float x) { return 1.0f - 2.0f * frcp(1.0f + fexp(2.0f * x)); }

constexpr int LDS_ROW = 40;
constexpr int GEMM_A_BYTES = BM * LDS_ROW * 2, GEMM_B_BYTES = 128 * LDS_ROW * 2;
template <int MR, class ARow>
DI void gemm_kloop(f32x4 (&acc)[MR][4], char* smem, ARow arow, const bf16_t* Bt, int ldb, int K) {
    constexpr int BM = 64 * MR;
    const int tid = tid_x(), lane = tid & 63, wave = tid >> 6, wr = wave >> 1, wc = wave & 1, fr = lane & 15, fq = lane >> 4;
    bf16_t* As = (bf16_t*)smem;
    bf16_t* Bs = (bf16_t*)(smem + 2 * GEMM_A_BYTES);
    constexpr int ACH = BM * 4 / NTHREADS;
    static_assert(ACH >= 1, "tile");
    const bf16_t* ap[ACH];
#pragma unroll
    for (int i = 0; i < ACH; ++i) { const int q = tid + i * NTHREADS; ap[i] = arow(q >> 2) + (q & 3) * 8; }
    const bf16_t* bp = Bt + (size_t)(tid >> 2) * ldb + (tid & 3) * 8;
    u32x4 ra[ACH], rb;
#pragma unroll
    for (int i = 0; i < ACH; ++i) ra[i] = *(const u32x4*)(ap[i]);
    rb = *(const u32x4*)(bp);
    const int nk = K / 32;
    for (int kt = 0; kt < nk; ++kt) {
        const int buf = kt & 1;
#pragma unroll
        for (int i = 0; i < ACH; ++i) { const int q = tid + i * NTHREADS; *(u32x4*)(As + (buf * BM + (q >> 2)) * LDS_ROW + (q & 3) * 8) = ra[i]; }
        *(u32x4*)(Bs + (buf * 128 + (tid >> 2)) * LDS_ROW + (tid & 3) * 8) = rb;
        __syncthreads();
        if (kt + 1 < nk) {
#pragma unroll
            for (int i = 0; i < ACH; ++i) ra[i] = *(const u32x4*)(ap[i] + (kt + 1) * 32);
            rb = *(const u32x4*)(bp + (kt + 1) * 32);
        }
        bf16x8 af[MR], bfr[4];
#pragma unroll
        for (int m = 0; m < MR; ++m) af[m] = *(const bf16x8*)(As + (buf * BM + wr * 16 * MR + m * 16 + fr) * LDS_ROW + fq * 8);
#pragma unroll
        for (int n = 0; n < 4; ++n) bfr[n] = *(const bf16x8*)(Bs + (buf * 128 + wc * 64 + n * 16 + fr) * LDS_ROW + fq * 8);
#pragma unroll
        for (int m = 0; m < MR; ++m)
#pragma unroll
            for (int n = 0; n < 4; ++n) acc[m][n] = MFMA16(af[m], bfr[n], acc[m][n]);
    }
    __syncthreads();
}
template <int MR>
DI void acc_zero(f32x4 (&acc)[MR][4]) {
#pragma unroll
    for (int m = 0; m < MR; ++m)
#pragma unroll
        for (int n = 0; n < 4; ++n) acc[m][n] = (f32x4){0.f, 0.f, 0.f, 0.f};
}

namespace g8 {
constexpr int BM = 256, BK = 64, HALF = 128, HT = HALF * BK;
constexpr int LDS_NEED = 8 * HT * 2;
DI int lds_byte(int r, int c) { const int st = (r >> 4) * 2 + (c >> 5), rr = r & 15, cc = c & 31, ob = rr * 64 + cc * 2; return st * 1024 + (ob ^ (((ob >> 9) & 1) << 5)); }
DI void stage_rc(int b, int& R, int& C) { const int st = b / 1024, sb = b % 1024, swz = sb ^ (((sb >> 9) & 1) << 5); R = (st >> 1) * 16 + swz / 64; C = (st & 1) * 32 + (swz % 64) / 2; }
#ifdef EMU
#define G8_GLDS(src, dst) emu_global_load_lds16((src), (dst))
#define G8_WAIT_V(n)
#define G8_WAIT_L(n)
#define G8_BAR __syncthreads()
#define G8_SCHED
#define G8_PRIO(x)
#else
#define G8_GLDS(src, dst) __builtin_amdgcn_global_load_lds((const unsigned*)(src), (__attribute__((address_space(3))) unsigned*)(dst), 16, 0, 0)
#define G8_WAIT_V(n) asm volatile("s_waitcnt vmcnt(" #n ")" ::: "memory")
#define G8_WAIT_L(n) asm volatile("s_waitcnt lgkmcnt(" #n ")" ::: "memory")
#define G8_BAR __builtin_amdgcn_s_barrier()
#define G8_SCHED __builtin_amdgcn_sched_barrier(0)
#define G8_PRIO(x) __builtin_amdgcn_s_setprio(x)
#endif
typedef f32x4 Acc[2][2][4][2];
template <class AOff>
DI void kloop_g(Acc& acc, char* smem, const bf16_t* A, AOff aoff, const bf16_t* Bt, int ldb, int K, int bcol) {
    bf16_t* shm = (bf16_t*)smem;
    const int tid = tid_x(), wid = tid >> 6, lane = tid & 63, wr = wid >> 2, wc = wid & 3, fr = lane & 15, fq = lane >> 4;
    int ao[2][2];
#pragma unroll
    for (int h = 0; h < 2; ++h)
#pragma unroll
        for (int i = 0; i < 2; ++i) { int R, C; stage_rc(tid * 16 + i * 8192, R, C); ao[h][i] = aoff(h * HALF + R) + C; }
#define G8_STAGE_A(P, h, kt) do { for (int _i = 0; _i < 2; ++_i) { const int _b = tid * 16 + _i * 8192; G8_GLDS(A + (size_t)ao[h][_i] + (size_t)(kt) * BK, (char*)(P) + _b); } } while (0)
#define G8_SA(b, h) (shm + ((b) * 2 + (h)) * HT)
#define G8_SB(b, h) (shm + (4 + (b) * 2 + (h)) * HT)
#define G8_STAGE(P, BASE, LD, br, kt) do { const bf16_t* _g = (BASE) + (size_t)(br) * (LD) + (size_t)(kt) * BK; \
    for (int _i = 0; _i < 2; ++_i) { const int _b = tid * 16 + _i * 8192; int _r, _c; stage_rc(_b, _r, _c); G8_GLDS(_g + (size_t)_r * (LD) + _c, (char*)(P) + _b); } } while (0)
#define G8_LDA(dst, b, h) for (int m = 0; m < 4; ++m) for (int k = 0; k < 2; ++k) dst[m][k] = *(const bf16x8*)((const char*)G8_SA(b, h) + lds_byte(wr * 64 + m * 16 + fr, k * 32 + fq * 8))
#define G8_LDB(dst, b, h) for (int n = 0; n < 2; ++n) for (int k = 0; k < 2; ++k) dst[n][k] = *(const bf16x8*)((const char*)G8_SB(b, h) + lds_byte(wc * 32 + n * 16 + fr, k * 32 + fq * 8))
#define G8_MMA(ai, bj, At_, Bt_) do { G8_PRIO(1); for (int m = 0; m < 4; ++m) for (int n = 0; n < 2; ++n) for (int k = 0; k < 2; ++k) \
    acc[ai][bj][m][n] = MFMA16(Bt_[n][k], At_[m][k], acc[ai][bj][m][n]); G8_PRIO(0); } while (0)
    bf16x8 At[4][2], B0[2][2], B1[2][2];
    const int nt = K / BK;
    G8_STAGE(G8_SB(0, 0), Bt, ldb, bcol, 0); G8_STAGE_A(G8_SA(0, 0), 0, 0);
    G8_STAGE(G8_SB(0, 1), Bt, ldb, bcol + HALF, 0); G8_STAGE_A(G8_SA(0, 1), 1, 0);
    if (wr == 1) G8_BAR;
    G8_WAIT_V(4); G8_BAR;
    G8_STAGE(G8_SB(1, 0), Bt, ldb, bcol, 1); G8_STAGE_A(G8_SA(1, 0), 0, 1); G8_STAGE(G8_SB(1, 1), Bt, ldb, bcol + HALF, 1);
    G8_WAIT_V(6); G8_BAR;
    for (int t = 0; t < nt - 2; t += 2) {
        G8_LDB(B0, 0, 0); G8_SCHED; G8_LDA(At, 0, 0); G8_STAGE_A(G8_SA(1, 1), 1, t + 1);
        G8_WAIT_L(8); G8_BAR; G8_WAIT_L(0); G8_MMA(0, 0, At, B0); G8_BAR; G8_SCHED;
        G8_LDB(B1, 0, 1); G8_STAGE(G8_SB(0, 0), Bt, ldb, bcol, t + 2);
        G8_BAR; G8_WAIT_L(0); G8_MMA(0, 1, At, B1); G8_BAR;
        G8_LDA(At, 0, 1); G8_STAGE_A(G8_SA(0, 0), 0, t + 2);
        G8_BAR; G8_WAIT_L(0); G8_MMA(1, 0, At, B0); G8_BAR; G8_SCHED;
        G8_STAGE(G8_SB(0, 1), Bt, ldb, bcol + HALF, t + 2);
        G8_WAIT_V(6); G8_BAR; G8_MMA(1, 1, At, B1); G8_BAR;
        G8_LDB(B0, 1, 0); G8_SCHED; G8_LDA(At, 1, 0); G8_STAGE_A(G8_SA(0, 1), 1, t + 2);
        G8_WAIT_L(8); G8_BAR; G8_WAIT_L(0); G8_MMA(0, 0, At, B0); G8_BAR; G8_SCHED;
        G8_LDB(B1, 1, 1); G8_STAGE(G8_SB(1, 0), Bt, ldb, bcol, t + 3);
        G8_BAR; G8_WAIT_L(0); G8_MMA(0, 1, At, B1); G8_BAR;
        G8_LDA(At, 1, 1); G8_STAGE_A(G8_SA(1, 0), 0, t + 3);
        G8_BAR; G8_WAIT_L(0); G8_MMA(1, 0, At, B0); G8_BAR; G8_SCHED;
        G8_STAGE(G8_SB(1, 1), Bt, ldb, bcol + HALF, t + 3);
        G8_WAIT_V(6); G8_BAR; G8_MMA(1, 1, At, B1); G8_BAR;
    }
    { G8_LDB(B0, 0, 0); G8_LDA(At, 0, 0); G8_STAGE_A(G8_SA(1, 1), 1, nt - 1);
      G8_BAR; G8_WAIT_L(0); G8_MMA(0, 0, At, B0); G8_BAR;
      G8_LDB(B1, 0, 1); G8_BAR; G8_WAIT_L(0); G8_MMA(0, 1, At, B1); G8_BAR;
      G8_LDA(At, 0, 1); G8_WAIT_V(4); G8_BAR; G8_WAIT_L(0); G8_MMA(1, 0, At, B0); G8_MMA(1, 1, At, B1); G8_BAR; }
    { G8_LDB(B0, 1, 0); G8_LDA(At, 1, 0); G8_WAIT_V(2); G8_BAR; G8_WAIT_L(0); G8_MMA(0, 0, At, B0); G8_BAR;
      G8_LDB(B1, 1, 1); G8_WAIT_V(0); G8_BAR; G8_WAIT_L(0); G8_MMA(0, 1, At, B1); G8_BAR;
      G8_LDA(At, 1, 1); G8_BAR; G8_WAIT_L(0); G8_MMA(1, 0, At, B0); G8_MMA(1, 1, At, B1); G8_BAR; }
    if (wr == 0) G8_BAR;
#undef G8_SA
#undef G8_SB
#undef G8_STAGE
#undef G8_STAGE_A
#undef G8_LDA
#undef G8_LDB
#undef G8_MMA
}
DI void kloop(Acc& acc, char* smem, const bf16_t* A, int lda, const bf16_t* Bt, int ldb, int K, int brow, int bcol) {
    kloop_g(acc, smem, A, [&](int r) { return (brow + r) * lda; }, Bt, ldb, K, bcol);
}
DI bool tile_order(int L, int nM, int nN, int& pm, int& pn) {
    constexpr int NXCD = 8, WGM = 8;
    const int nwg = nM * nN; if (L >= nwg) return false;
    int wgid = L; { const int q = nwg / NXCD, r = nwg % NXCD, xcd = wgid % NXCD, off = wgid / NXCD; wgid = (xcd < r ? xcd * (q + 1) : r * (q + 1) + (xcd - r) * q) + off; }
    const int nig = WGM * nN, gid = wgid / nig, fm = gid * WGM, gsz = (nM - fm) < WGM ? (nM - fm) : WGM;
    pm = fm + ((wgid % nig) % gsz); pn = (wgid % nig) / gsz; return true;
}
DI void acc_zero(Acc& acc) {
#pragma unroll
    for (int a = 0; a < 2; ++a)
#pragma unroll
        for (int b = 0; b < 2; ++b)
#pragma unroll
            for (int m = 0; m < 4; ++m)
#pragma unroll
                for (int n = 0; n < 2; ++n) acc[a][b][m][n] = (f32x4){0.f, 0.f, 0.f, 0.f};
}
template <class F> DI void for_each_quad(const Acc& acc, int brow, int bcol, F f) {
    const int tid = tid_x(), wid = tid >> 6, lane = tid & 63, wr = wid >> 2, wc = wid & 3, fr = lane & 15, fq = lane >> 4;
#pragma unroll
    for (int ai = 0; ai < 2; ++ai)
#pragma unroll
        for (int m = 0; m < 4; ++m)
#pragma unroll
            for (int bj = 0; bj < 2; ++bj)
#pragma unroll
                for (int n = 0; n < 2; ++n) f(brow + ai * HALF + wr * 64 + m * 16 + fr, bcol + bj * HALF + wc * 32 + n * 16 + fq * 4, acc[ai][bj][m][n]);
}
}

constexpr bool USE_G8 = ((NB * CTXL) % 256 == 0) && ((NB * S) % 256 == 0) && (NP % 256 == 0) && (D % 256 == 0) && (D >= 256);
DI int gu_row(int c, int up) {
    if (USE_G8) return (c >> 7) * 256 + ((c >> 6) & 1) * 128 + ((c >> 4) & 3) * 32 + (up ? 16 : 0) + (c & 15);
    return (c >> 6) * 128 + ((c >> 5) & 1) * 64 + ((c >> 4) & 1) * 16 + (c & 15) + (up ? 32 : 0);
}
DI void transpose_item(const float* W, int N, int Nvalid, int k0, int n0, bf16_t* WT, int ldt, int mode, float* scr, int lane) {
    float tv[32];
#pragma unroll
    for (int i = 0; i < 32; ++i) {
        const int kk = 2 * i + (lane >> 5), n = n0 + (lane & 31);
        tv[i] = (n < Nvalid) ? W[(size_t)(k0 + kk) * N + n] : 0.f;
    }
#pragma unroll
    for (int i = 0; i < 32; ++i) scr[(2 * i + (lane >> 5)) * 33 + (lane & 31)] = tv[i];
    WAVE_SYNC();
    const int c = lane & 7;
#pragma unroll
    for (int j = 0; j < 4; ++j) {
        const int nl = (lane >> 3) + 8 * j; const float* s = scr + (8 * c) * 33 + nl;
        u32x4 o; o.x = pk2(s[0], s[33]); o.y = pk2(s[2 * 33], s[3 * 33]); o.z = pk2(s[4 * 33], s[5 * 33]); o.w = pk2(s[6 * 33], s[7 * 33]);
        const int n = n0 + nl; const int row = mode == 0 ? n : gu_row(n, mode == 2);
        *(u32x4*)(WT + (size_t)row * ldt + k0 + 8 * c) = o;
    }
    WAVE_SYNC();
}
DI void transpose_matrix(const float* W, int K, int N, int Npad, bf16_t* WT, int mode, char* smem, int gw, int ngw, int& base) {
    const int lane = tid_x() & 63, wave = tid_x() >> 6;
    float* scr = (float*)smem + wave * (64 * 33);
    const int nkb = K / 64, nnb = Npad / 32, nitems = nkb * nnb;
    int first = ((gw - base) % ngw + ngw) % ngw;
    for (int it = first; it < nitems; it += ngw) {
        const int kb = it / nnb, nb = it % nnb;
        transpose_item(W, N, N, kb * 64, nb * 32, WT, K, mode, scr, lane);
    }
    base = (base + nitems) % ngw;
}

DI void phase0(const Params& p, char* smem) {
    const int tid = tid_x(), lane = tid & 63, wave = tid >> 6;
    if (blockIdx.x == 0 && tid < NEXP) ((int*)(p.ws + WS_CNT))[tid * CNT_STRIDE] = 0;
    if (blockIdx.x == 0 && tid < 2) ((int*)(p.ws + WS_CNT))[tid ? CNT_U2DONE : CNT_TICKET] = 0;
    if (blockIdx.x == 0 && tid == 0) *(unsigned*)(p.ws + WS_BAR) = 0u;
    float* sil = (float*)smem;
    float* red = sil + NV * D;
    const int nitems = 6 * D / 32;
    bool did = false;
    for (int it = blockIdx.x; it < nitems; it += gridDim.x) {
        if (!did) {
            for (int i = tid; i < NV * D; i += NTHREADS) { const int v = i / D, k = i % D; const float cv = v < NB ? p.in[I_C][v * D + k] : p.in[I_CCTX][k]; sil[i] = siluf_(cv); }
            did = true;
        }
        __syncthreads();
        const int col = it * 32 + (lane & 31), rp = lane >> 5;
        float acc[NV];
#pragma unroll
        for (int v = 0; v < NV; ++v) acc[v] = 0.f;
        const int r0 = wave * (D / 8);
        float wv[D / 16];
#pragma unroll
        for (int i = 0; i < D / 16; ++i) wv[i] = p.in[I_ADAW][(size_t)(r0 + 2 * i + rp) * (6 * D) + col];
#pragma unroll
        for (int i = 0; i < D / 16; ++i) {
            const int row = r0 + 2 * i + rp;
#pragma unroll
            for (int v = 0; v < NV; ++v) acc[v] += sil[v * D + row] * wv[i];
        }
#pragma unroll
        for (int v = 0; v < NV; ++v) red[((wave * 2 + rp) * NV + v) * 32 + (lane & 31)] = acc[v];
        __syncthreads();
        if (tid < NV * 32) {
            const int v = tid / 32, cl = tid % 32; float s = p.in[I_ADAB][it * 32 + cl];
            for (int g = 0; g < 16; ++g) s += red[(g * NV + v) * 32 + cl];
            ((float*)(p.ws + WS_MOD))[(size_t)v * 6 * D + it * 32 + cl] = s;
        }
    }
    __syncthreads();
    const int gw = blockIdx.x * 8 + wave, ngw = gridDim.x * 8; int base = 0;
    {
        float* scr = (float*)smem + wave * (64 * 33);
        const int nkb = D / 64, nnb = NP / 32, nitems2 = nkb * nnb;
        for (int it = gw; it < nitems2; it += ngw) { const int kb = it / nnb, nb = it % nnb; transpose_item(p.in[I_WIN], IN_COLS, IN_COLS, kb * 64, nb * 32, (bf16_t*)(p.aux + AUX_WINT), D, 0, scr, lane); }
        base = nitems2 % ngw;
    }
    { float* WRT = (float*)(p.ws + WS_WRT);
      for (int i = blockIdx.x * NTHREADS + tid; i < 36 * D; i += gridDim.x * NTHREADS) { const int j = i / D, k = i % D; WRT[i] = j < 4 ? p.in[I_RG][(size_t)k * 4 + j] : p.in[I_RE][(size_t)k * 32 + (j - 4)]; } }
    transpose_matrix(p.in[I_WOA], 512, D, D, (bf16_t*)(p.ws + WS_WOA), 0, smem, gw, ngw, base);
    transpose_matrix(p.in[I_WOB], 512, D, D, (bf16_t*)(p.ws + WS_WOB), 0, smem, gw, ngw, base);
    transpose_matrix(p.in[I_WOUT], D, D, D, (bf16_t*)(p.ws + WS_WOUT), 0, smem, gw, ngw, base);
    transpose_matrix(p.in[I_G2], 128, 512, 512, (bf16_t*)(p.ws + WS_G2T), 0, smem, gw, ngw, base);
}

constexpr int NSEG = T_ALL / 64, NSEG_CTX = T_CTX / 64;
DI void halo_store(const Params& p, int row, int col, const u32x2& o) {
    int seq, b, j;
    if (row < T_CTX) { seq = 0; b = row / CTXL; j = row % CTXL; } else { seq = 1; const int rr = row - T_CTX; b = rr / S; j = rr % S; }
    const int L = seq ? S : CTXL; const int segbase = seq ? NSEG_CTX + b * (S / 64) : b * (CTXL / 64);
    if (col < 1536) {
        const int jm = j & 63;
        if (jm >= 62 && j + 2 < L) { const int g = segbase + (j >> 6) + 1; *(u32x2*)((bf16_t*)(p.ws + WS_HALO_A) + ((size_t)g * 4 + (jm - 62)) * 1536 + col) = o; }
        if (jm < 2 && j >= 64) { const int g = segbase + (j >> 6) - 1; *(u32x2*)((bf16_t*)(p.ws + WS_HALO_A) + ((size_t)g * 4 + 2 + jm) * 1536 + col) = o; }
    } else if (col >= COL_B0 && col < COL_B0 + 1920) {
        const int js = seq ? (j % GW) * ROWS + j / GW : j; const int jm = js & 63;
        if (jm == 63 && js + 1 < L) { const int g = segbase + (js >> 6) + 1; *(u32x2*)((bf16_t*)(p.ws + WS_HALO_B) + ((size_t)g * 2 + 0) * 1920 + (col - COL_B0)) = o; }
        if (jm == 0 && js >= 64) { const int g = segbase + (js >> 6) - 1; *(u32x2*)((bf16_t*)(p.ws + WS_HALO_B) + ((size_t)g * 2 + 1) * 1920 + (col - COL_B0)) = o; }
    }
}
DI void halo_zero_fill(const Params& p) {
    const int tid = tid_x(), lane = tid & 63, wave = tid >> 6; const int gw = blockIdx.x * 8 + wave, ngw = gridDim.x * 8;
    bf16_t* HA = (bf16_t*)(p.ws + WS_HALO_A); bf16_t* HB = (bf16_t*)(p.ws + WS_HALO_B);
    for (int it = gw; it < NSEG * 2; it += ngw) {
        const int g = it >> 1, side = it & 1;
        const bool ctx = g < NSEG_CTX; const int sg = ctx ? g % (CTXL / 64) : (g - NSEG_CTX) % (S / 64); const int nsg = ctx ? CTXL / 64 : S / 64;
        const bool edge = side ? (sg == nsg - 1) : (sg == 0);
        if (!edge) continue;
        for (int c = lane; c < 384; c += 64) *(u32x4*)(HA + ((size_t)g * 4 + 2 * side) * 1536 + c * 8) = (u32x4){0u, 0u, 0u, 0u};
        for (int c = lane; c < 240; c += 64) *(u32x4*)(HB + ((size_t)g * 2 + side) * 1920 + c * 8) = (u32x4){0u, 0u, 0u, 0u};
    }
}
DI void phase1(const Params& p, char* smem) {
    if (USE_G8) halo_zero_fill(p);
    const int lane = tid_x() & 63, wave = tid_x() >> 6;
    const int gw = blockIdx.x * 8 + wave, ngw = gridDim.x * 8;
    const float* mod = (const float*)(p.ws + WS_MOD);
    bf16_t* U = (bf16_t*)(p.aux + AUX_U);
    auto rowsrc = [&](int r) -> const float* { return r < T_CTX ? p.in[I_CTX] + (size_t)r * D : p.in[I_X] + (size_t)(r - T_CTX) * D; };
    f32x4 xn[D / 256];
    if (gw < T_ALL) {
#pragma unroll
        for (int j = 0; j < D / 256; ++j) xn[j] = *(const f32x4*)(rowsrc(gw) + j * 256 + lane * 4);
    }
    for (int r = gw; r < T_ALL; r += ngw) {
        const int v = r < T_CTX ? NB : (r - T_CTX) / S;
        f32x4 x[D / 256]; float ss = 0.f;
#pragma unroll
        for (int j = 0; j < D / 256; ++j) { x[j] = xn[j]; ss += x[j].x * x[j].x + x[j].y * x[j].y + x[j].z * x[j].z + x[j].w * x[j].w; }
        if (r + ngw < T_ALL) {
#pragma unroll
            for (int j = 0; j < D / 256; ++j) xn[j] = *(const f32x4*)(rowsrc(r + ngw) + j * 256 + lane * 4);
        }
        ss = wave_sum_fast(ss);
        const float rstd = frsq(ss * (1.0f / D) + 1e-6f);
#pragma unroll
        for (int j = 0; j < D / 256; ++j) {
            const int k = j * 256 + lane * 4;
            const f32x4 g = *(const f32x4*)(p.in[I_NMIX] + k), sh = *(const f32x4*)(mod + (size_t)v * 6 * D + k), sc = *(const f32x4*)(mod + (size_t)v * 6 * D + D + k);
            float o0 = x[j].x * rstd * g.x * (1.f + sc.x) + sh.x, o1 = x[j].y * rstd * g.y * (1.f + sc.y) + sh.y;
            float o2 = x[j].z * rstd * g.z * (1.f + sc.z) + sh.z, o3 = x[j].w * rstd * g.w * (1.f + sc.w) + sh.w;
            u32x2 o; o.x = pk2(o0, o1); o.y = pk2(o2, o3);
            *(u32x2*)(U + (size_t)r * D + k) = o;
        }
    }
}

DI void phase2(const Params& p, char* smem) {
    const bf16_t* U = (const bf16_t*)(p.aux + AUX_U); const bf16_t* WT = (const bf16_t*)(p.aux + AUX_WINT);
    bf16_t* PL = (bf16_t*)(p.ws + WS_PLAT); bf16_t* PC = (bf16_t*)(p.ws + WS_PCTX); float* AB = (float*)(p.ws + WS_AB);
    if (USE_G8) {
        constexpr int NT = NP / 256, MT = T_ALL / 256, NT_CTX = (CTX_COLS + 255) / 256;
        for (int t = blockIdx.x; t < MT * NT; t += gridDim.x) {
            int mt, nt; if (!g8::tile_order(t, MT, NT, mt, nt)) break;
            const int brow = mt * 256, bcol = nt * 256; const bool isctx = brow < T_CTX;
            if (isctx && nt >= NT_CTX) continue;
            g8::Acc acc; g8::acc_zero(acc);
            g8::kloop(acc, smem, U, D, WT, D, D, brow, bcol);
            constexpr int OLD_ = 264; bf16_t* OT = (bf16_t*)smem;
            g8::for_each_quad(acc, brow, bcol, [&](int row, int col, const f32x4& v) {
                u32x2 o; o.x = pk2(v.x, v.y); o.y = pk2(v.z, v.w);
                *(u32x2*)(OT + (row - brow) * OLD_ + (col - bcol)) = o;
                if (col >= 2048 && col < 2064) *(f32x4*)(AB + (size_t)row * 16 + (col - 2048)) = v;
                halo_store(p, row, col, o);
            });
            __syncthreads();
            {
                const int tid = tid_x(); const int ncols = isctx ? CTX_COLS : IN_COLS;
                bf16_t* dst = isctx ? PC + (size_t)brow * CTX_COLS : PL + (size_t)(brow - T_CTX) * IN_COLS;
#pragma unroll
                for (int i = 0; i < 16; ++i) {
                    const int ch = tid + i * NTHREADS, row = ch >> 5, c8 = (ch & 31) * 8, col = bcol + c8;
                    if (col < ncols) *(u32x4*)(dst + (size_t)row * ncols + col) = *(const u32x4*)(OT + row * OLD_ + c8);
                }
            }
            __syncthreads();
        }
        return;
    }
    const int tid = tid_x(), lane = tid & 63, wave = tid >> 6, wr = wave >> 1, wc = wave & 1, fr = lane & 15, fq = lane >> 4;
    constexpr int NT = NP / 128, MT = T_ALL / BM, NT_CTX = (CTX_COLS + 127) / 128;
    for (int t = blockIdx.x; t < MT * NT; t += gridDim.x) {
        const int mt = t / NT, nt = t % NT; const int row0 = mt * BM; const bool isctx = row0 < T_CTX;
        if (isctx && nt >= NT_CTX) continue;
        f32x4 acc[MREP][4]; acc_zero(acc);
        gemm_kloop(acc, smem, [&](int i) { return U + (size_t)(row0 + i) * D; }, WT + (size_t)nt * 128 * D, D, D);
#pragma unroll
        for (int m = 0; m < MREP; ++m)
#pragma unroll
            for (int n = 0; n < 4; ++n)
#pragma unroll
                for (int j = 0; j < 4; ++j) {
                    const int row = row0 + wr * 16 * MREP + m * 16 + fq * 4 + j, col = nt * 128 + wc * 64 + n * 16 + fr; const float v = acc[m][n][j];
                    if (isctx) { if (col < CTX_COLS) PC[(size_t)row * CTX_COLS + col] = f2bf(v); }
                    else { if (col < IN_COLS) PL[(size_t)(row - T_CTX) * IN_COLS + col] = f2bf(v); }
                    if (col >= 2048 && col < 2064) AB[(size_t)row * 16 + (col - 2048)] = v;
                }
    }
}


DI int crow(int g, int h) { return (g & 3) + 8 * (g >> 2) + 4 * h; }
template <int S_> DI bf16x8 pack_acc(const f32x16& x) {
    u32x4 r;
    r.x = pk2(x[8 * S_ + 0], x[8 * S_ + 1]); r.y = pk2(x[8 * S_ + 2], x[8 * S_ + 3]); r.z = pk2(x[8 * S_ + 4], x[8 * S_ + 5]); r.w = pk2(x[8 * S_ + 6], x[8 * S_ + 7]);
    return __builtin_bit_cast(bf16x8, r);
}
DI bf16x8 ld_nat(const bf16_t* row, int s, int h) { return *(const bf16x8*)(row + 16 * s + 8 * h); }
DI bf16x8 ld_perm(const bf16_t* row, int s, int h) {
    const bf16x4 lo = *(const bf16x4*)(row + 16 * s + 4 * h), hi = *(const bf16x4*)(row + 16 * s + 8 + 4 * h);
    return __builtin_shufflevector(lo, hi, 0, 1, 2, 3, 4, 5, 6, 7);
}
DI f32x16 zero16() { f32x16 z;
#pragma unroll
    for (int i = 0; i < 16; ++i) z[i] = 0.f;
    return z; }
#define TGET(i) ((i) < 16 ? t0[(i) & 15] : t1[(i) & 15])
DI void invert32_col(const float* Lf, f32x16& t0, f32x16& t1, int c) {
#pragma unroll
    for (int i = 0; i < 32; ++i) {
        float s0 = 0.f, s1 = 0.f, s2 = 0.f, s3 = 0.f;
#pragma unroll
        for (int j4 = 0; j4 < (i + 3) / 4; ++j4) {
            const f32x4 l = *(const f32x4*)(Lf + i * 32 + 4 * j4);
            if (4 * j4 + 0 < i) s0 += l.x * TGET(4 * j4 + 0);
            if (4 * j4 + 1 < i) s1 += l.y * TGET(4 * j4 + 1);
            if (4 * j4 + 2 < i) s2 += l.z * TGET(4 * j4 + 2);
            if (4 * j4 + 3 < i) s3 += l.w * TGET(4 * j4 + 3);
        }
        float sm = -((s0 + s1) + (s2 + s3));
#ifndef EMU
        asm volatile("" : "+v"(sm));
#endif
        const float v = (i > c) ? sm : (i == c ? 1.f : 0.f);
        if (i < 16) t0[i & 15] = v; else t1[i & 15] = v;
    }
}

DI void seg_info(int g, int& seq, int& b, int& j0) {
    if (g < NSEG_CTX) { seq = 0; b = g / (CTXL / 64); j0 = (g % (CTXL / 64)) * 64; } else { const int g2 = g - NSEG_CTX; seq = 1; b = g2 / (S / 64); j0 = (g2 % (S / 64)) * 64; }
}
DI const bf16_t* seq_row(const Params& p, int seq, int b, int j, bool scan_order) {
    if (seq) { const int l = scan_order ? (j % ROWS) * GW + j / ROWS : j; return (const bf16_t*)(p.ws + WS_PLAT) + (size_t)(b * S + l) * IN_COLS; }
    return (const bf16_t*)(p.ws + WS_PCTX) + (size_t)(b * CTXL + j) * CTX_COLS;
}
DI void phase_halo(const Params& p, char* smem) {
    if (USE_G8) return;
    const int tid = tid_x(), lane = tid & 63, wave = tid >> 6;
    const int gw = blockIdx.x * 8 + wave, ngw = gridDim.x * 8;
    bf16_t* HA = (bf16_t*)(p.ws + WS_HALO_A); bf16_t* HB = (bf16_t*)(p.ws + WS_HALO_B);
    for (int it = gw; it < NSEG * 6; it += ngw) {
        const int g = it / 6, hr = it % 6; int seq, b, j0; seg_info(g, seq, b, j0);
        const int L = seq ? S : CTXL;
        if (hr < 4) {
            const int j = hr < 2 ? j0 - 2 + hr : j0 + 62 + hr; const bool ok = j >= 0 && j < L;
            const bf16_t* src = seq_row(p, seq, b, ok ? j : 0, false);
            for (int c = lane; c < 192; c += 64) { u32x4 v = {0u, 0u, 0u, 0u}; if (ok) v = *(const u32x4*)(src + c * 8); *(u32x4*)(HA + ((size_t)g * 4 + hr) * 1536 + c * 8) = v; }
        } else {
            const int j = hr == 4 ? j0 - 1 : j0 + 64; const bool ok = j >= 0 && j < L;
            const bf16_t* src = seq_row(p, seq, b, ok ? j : 0, true) + COL_B0;
            for (int c = lane; c < 240; c += 64) { u32x4 v = {0u, 0u, 0u, 0u}; if (ok) v = *(const u32x4*)(src + c * 8); *(u32x4*)(HB + ((size_t)g * 2 + (hr - 4)) * 1920 + c * 8) = v; }
        }
    }
}
DI f32x2_ac unpk2(unsigned w) { return (f32x2_ac){bf2f((bf16_t)(w & 0xffffu)), bf2f((bf16_t)(w >> 16))}; }
DI void unpack8(const u32x4& q, float (&f)[8]) {
    f[0] = bf2f((bf16_t)(q.x & 0xffffu)); f[1] = bf2f((bf16_t)(q.x >> 16)); f[2] = bf2f((bf16_t)(q.y & 0xffffu)); f[3] = bf2f((bf16_t)(q.y >> 16));
    f[4] = bf2f((bf16_t)(q.z & 0xffffu)); f[5] = bf2f((bf16_t)(q.z >> 16)); f[6] = bf2f((bf16_t)(q.w & 0xffffu)); f[7] = bf2f((bf16_t)(q.w >> 16));
}
DI float row16_sum(float v) {
#ifdef EMU
    v += __shfl_xor(v, 1); v += __shfl_xor(v, 2); v += __shfl_xor(v, 4); v += __shfl_xor(v, 8); return v;
#else
    v = DPP_ADD(v, 0xB1); v = DPP_ADD(v, 0x4E); v = DPP_ADD(v, 0x141); v = DPP_ADD(v, 0x140); return v;
#endif
}
DI void phase_fir(const Params& p, char* smem) {
    const int tid = tid_x(), lane = tid & 63, wave = tid >> 6;
    const int gw = blockIdx.x * 8 + wave, ngw = gridDim.x * 8;
    const bf16_t* HA = (const bf16_t*)(p.ws + WS_HALO_A); const bf16_t* HB = (const bf16_t*)(p.ws + WS_HALO_B);
    constexpr int NA = NSEG * 3, NBI = NSEG * 4;
    const u32x4 z4 = {0u, 0u, 0u, 0u};
    for (int it = gw; it < NA + NBI; it += ngw) {
        if (it < NA) {
            const int g = it / 3, s = it % 3; int seq, b, j0; seg_info(g, seq, b, j0);
            const int col = s * 512 + 8 * lane, ldp = seq ? IN_COLS : CTX_COLS;
            bf16_t* base = (bf16_t*)seq_row(p, seq, b, j0, false) + col;
            const bf16_t* hal = HA + (size_t)g * 4 * 1536 + col;
            float cw[5][8];
#pragma unroll
            for (int t = 0; t < 5; ++t) { const f32x4 w0 = *(const f32x4*)(p.in[I_CONV] + t * 1536 + col), w1 = *(const f32x4*)(p.in[I_CONV] + t * 1536 + col + 4);
                cw[t][0] = w0.x; cw[t][1] = w0.y; cw[t][2] = w0.z; cw[t][3] = w0.w; cw[t][4] = w1.x; cw[t][5] = w1.y; cw[t][6] = w1.z; cw[t][7] = w1.w; }
            u32x4 win[12], nxt[8];
            win[0] = *(const u32x4*)(hal); win[1] = *(const u32x4*)(hal + 1536);
            win[2] = *(const u32x4*)(base); win[3] = *(const u32x4*)(base + ldp);
#pragma unroll
            for (int i = 0; i < 8; ++i) win[4 + i] = *(const u32x4*)(base + (size_t)(2 + i) * ldp);
#pragma unroll 1
            for (int blk = 0; blk < 8; ++blk) {
                if (blk < 7) {
#pragma unroll
                    for (int i = 0; i < 8; ++i) { const int t = 8 * blk + 10 + i; nxt[i] = t < 64 ? *(const u32x4*)(base + (size_t)t * ldp) : *(const u32x4*)(hal + (size_t)(2 + (t - 64)) * 1536); }
                }
#pragma unroll
                for (int i = 0; i < 8; ++i) {
                    float a[8];
#pragma unroll
                    for (int e = 0; e < 8; ++e) a[e] = 0.f;
#pragma unroll
                    for (int t = 0; t < 5; ++t) { float x[8]; unpack8(win[i + t], x);
#pragma unroll
                        for (int e = 0; e < 8; ++e) a[e] += x[e] * cw[t][e]; }
                    float ss = 0.f;
#pragma unroll
                    for (int e = 0; e < 8; ++e) { a[e] = fsilu(a[e]); ss += a[e] * a[e]; }
                    if (s < 2) { const float sc = frsq(row16_sum(ss) + 1e-6f) * (s == 0 ? 0.08838834764831845f : 1.0f);
#pragma unroll
                        for (int e = 0; e < 8; ++e) a[e] *= sc; }
                    u32x4 o; o.x = pk2(a[0], a[1]); o.y = pk2(a[2], a[3]); o.z = pk2(a[4], a[5]); o.w = pk2(a[6], a[7]);
                    *(u32x4*)(base + (size_t)(8 * blk + i) * ldp) = o;
                }
#pragma unroll
                for (int i = 0; i < 4; ++i) win[i] = win[8 + i];
#pragma unroll
                for (int i = 0; i < 8; ++i) win[4 + i] = nxt[i];
            }
        } else {
            const int it2 = it - NA, g = it2 / 4, sl = it2 % 4; int seq, b, j0; seg_info(g, seq, b, j0);
            const int bcol = sl * 512 + 8 * lane; const bool act = bcol < 1920;
            const int bc = act ? bcol : 0, col = COL_B0 + bc;
            float mu8[8];
            { const f32x4 m0 = *(const f32x4*)(p.in[I_MU] + bc), m1 = *(const f32x4*)(p.in[I_MU] + bc + 4); mu8[0] = m0.x; mu8[1] = m0.y; mu8[2] = m0.z; mu8[3] = m0.w; mu8[4] = m1.x; mu8[5] = m1.y; mu8[6] = m1.z; mu8[7] = m1.w; }
            const bool th = (bc >= 1536 && bc < 1664);
            const bf16_t* hal = HB + (size_t)g * 2 * 1920 + bc;
            u32x4 win[10], nxt[8];
            win[0] = *(const u32x4*)(hal); win[1] = *(const u32x4*)(seq_row(p, seq, b, j0, true) + col);
#pragma unroll
            for (int i = 0; i < 8; ++i) win[2 + i] = *(const u32x4*)(seq_row(p, seq, b, j0 + 1 + i, true) + col);
#pragma unroll 1
            for (int blk = 0; blk < 8; ++blk) {
                if (blk < 7) {
#pragma unroll
                    for (int i = 0; i < 8; ++i) { const int t = 8 * blk + 9 + i; nxt[i] = t < 64 ? *(const u32x4*)(seq_row(p, seq, b, j0 + t, true) + col) : *(const u32x4*)(hal + 1920); }
                }
#pragma unroll
                for (int i = 0; i < 8; ++i) {
                    float pv[8], cu[8], nx[8], x[8]; unpack8(win[i], pv); unpack8(win[i + 1], cu); unpack8(win[i + 2], nx);
#pragma unroll
                    for (int e = 0; e < 8; ++e) { x[e] = cu[e] + (0.5f * (pv[e] + nx[e]) - cu[e]) * mu8[e]; if (th) x[e] = ftanh(x[e]); }
                    u32x4 o; o.x = pk2(x[0], x[1]); o.y = pk2(x[2], x[3]); o.z = pk2(x[4], x[5]); o.w = pk2(x[6], x[7]);
                    if (act) *(u32x4*)((bf16_t*)seq_row(p, seq, b, j0 + 8 * blk + i, true) + col) = o;
                }
                win[0] = win[8]; win[1] = win[9];
#pragma unroll
                for (int i = 0; i < 8; ++i) win[2 + i] = nxt[i];
            }
        }
    }
}

constexpr int GC = 32;
constexpr int G_NT = (CTXL + S) / GC;
constexpr int LD128 = 136, LD64 = 72, LD32 = 40;
DI void chunk_pos(int x, int d, int& seg, int& j0) {
    constexpr int n0 = CTXL / GC, n1 = S / GC;
    if (x < n0) { seg = 0; j0 = (d ? n0 - 1 - x : x) * GC; } else { seg = 1; const int xx = x - n0; j0 = (d ? n1 - 1 - xx : xx) * GC; }
}

template <class Emit, class Emit0>
DI void invert32_blocked(const float* Lf, bf16_t* scr, int lane, Emit emit, Emit0 emit0) {
    bf16_t* T00T = scr; bf16_t* T11R = scr + 16 * LD32; bf16_t* L10R = scr + 2 * 16 * LD32; bf16_t* P1T = scr + 3 * 16 * LD32;
    const int blk = lane >> 5, c = lane & 15, r = lane & 31, fr = lane & 15, fq = lane >> 4;
    f32x16 t;
    const float* Lb = Lf + (16 * blk) * 32 + 16 * blk;
    f32x4 rb[3][4];
#pragma unroll
    for (int j4 = 0; j4 < 1; ++j4) { rb[1][j4] = *(const f32x4*)(Lb + 1 * 32 + 4 * j4); rb[2][j4] = *(const f32x4*)(Lb + 2 * 32 + 4 * j4); }
#pragma unroll
    for (int i = 0; i < 16; ++i) {
        if (i >= 1 && i + 2 < 16) {
#pragma unroll
            for (int j4 = 0; j4 < (i + 2 + 3) / 4; ++j4) rb[(i + 2) % 3][j4] = *(const f32x4*)(Lb + (i + 2) * 32 + 4 * j4);
        }
        float s0 = 0.f, s1 = 0.f, s2 = 0.f, s3 = 0.f;
#pragma unroll
        for (int j4 = 0; j4 < (i + 3) / 4; ++j4) {
            const f32x4 l = rb[i % 3][j4];
            if (4 * j4 + 0 < i) s0 += l.x * t[4 * j4 + 0];
            if (4 * j4 + 1 < i) s1 += l.y * t[4 * j4 + 1];
            if (4 * j4 + 2 < i) s2 += l.z * t[4 * j4 + 2];
            if (4 * j4 + 3 < i) s3 += l.w * t[4 * j4 + 3];
        }
        float sm = -((s0 + s1) + (s2 + s3));
#ifndef EMU
        asm volatile("" : "+v"(sm));
#endif
        t[i] = (i > c) ? sm : (i == c ? 1.f : 0.f);
    }
    if (r < 16) {
        if (blk == 0) {
#pragma unroll
            for (int q = 0; q < 4; ++q) { u32x2 o; o.x = pk2(t[4 * q], t[4 * q + 1]); o.y = pk2(t[4 * q + 2], t[4 * q + 3]); *(u32x2*)(T00T + c * LD32 + 4 * q) = o; }
        } else {
#pragma unroll
            for (int i = 0; i < 16; ++i) T11R[i * LD32 + c] = f2bf(t[i]);
        }
    }
    { const int i = lane >> 2, j4 = (lane & 3) * 4; const f32x4 l = *(const f32x4*)(Lf + (16 + i) * 32 + j4);
      u32x2 o; o.x = pk2(l.x, l.y); o.y = pk2(l.z, l.w); *(u32x2*)(L10R + i * LD32 + j4) = o; }
    WAVE_SYNC();
    const bf16x8 zf = {0, 0, 0, 0, 0, 0, 0, 0};
    f32x4 p1 = {0.f, 0.f, 0.f, 0.f};
    {
        const bf16x8 af = fq < 2 ? *(const bf16x8*)(L10R + fr * LD32 + 8 * fq) : zf, bfm = fq < 2 ? *(const bf16x8*)(T00T + fr * LD32 + 8 * fq) : zf;
        p1 = MFMA16(af, bfm, p1);
    }
    { u32x2 o; o.x = pk2(p1[0], p1[1]); o.y = pk2(p1[2], p1[3]); *(u32x2*)(P1T + fr * LD32 + 4 * fq) = o; }
    WAVE_SYNC();
    f32x4 p2 = {0.f, 0.f, 0.f, 0.f};
    {
        const bf16x8 af = fq < 2 ? *(const bf16x8*)(T11R + fr * LD32 + 8 * fq) : zf, bfm = fq < 2 ? *(const bf16x8*)(P1T + fr * LD32 + 8 * fq) : zf;
        p2 = MFMA16(af, bfm, p2);
    }
#pragma unroll
    for (int j = 0; j < 4; ++j) emit(16 + 4 * fq + j, fr, -p2[j]);
    if (r < 16) {
#pragma unroll
        for (int i = 0; i < 16; ++i) emit(16 * blk + i, 16 * blk + c, t[i]);
        if (blk == 0) {
#pragma unroll
            for (int i = 0; i < 16; ++i) emit0(i, 16 + c);
        }
    }
}
DI float half_sum(float v, int hh) {
#ifdef EMU
    v += __shfl_xor(v, 1); v += __shfl_xor(v, 2); v += __shfl_xor(v, 4); v += __shfl_xor(v, 8); v += __shfl_xor(v, 16); return v;
#else
    v = DPP_ADD(v, 0xB1); v = DPP_ADD(v, 0x4E); v = DPP_ADD(v, 0x141); v = DPP_ADD(v, 0x140);
    const int iv = __builtin_bit_cast(int, v);
    const float s0 = __builtin_bit_cast(float, __builtin_amdgcn_readlane(iv, 0)) + __builtin_bit_cast(float, __builtin_amdgcn_readlane(iv, 16));
    const float s1 = __builtin_bit_cast(float, __builtin_amdgcn_readlane(iv, 32)) + __builtin_bit_cast(float, __builtin_amdgcn_readlane(iv, 48));
    return hh ? s1 : s0;
#endif
}
constexpr int GL_Q = 0;
constexpr int GL_KT = GL_Q + 3 * 32 * LD128 * 2;
constexpr int GL_VT = GL_KT + 3 * 128 * LD32 * 2;
constexpr int GL_K = GL_VT + 3 * 128 * LD32 * 2;
constexpr int GL_QKM = GL_K + 32 * LD128 * 2;
constexpr int GL_LF = GL_QKM + 2 * 32 * LD32 * 2;
constexpr int GL_TP = GL_LF + 32 * 32 * 4;
constexpr int GL_TPP = GL_TP + 32 * LD32 * 2;
constexpr int GL_WN = GL_TPP + 2 * 32 * LD32 * 2;
constexpr int GL_SC = GL_WN + 32 * LD128 * 2;
constexpr int GL_GC = GL_SC + 2 * 8 * 32 * 4;
constexpr int GL_INV = GL_GC + 8 * 32 * 4;
constexpr int GL_RAW = GL_INV + 4 * 16 * LD32 * 2;
constexpr int GL_END = GL_RAW + 32 * 384 * 2;
static_assert(GL_END <= LDS_BYTES, "gdn lds");

DI void gdn_chain2(const Params& p, char* smem, int item) {
    const int d = item / (NB * H_A), b = (item / H_A) % NB, h = item % H_A;
    const int tid = tid_x(), lane = tid & 63, wave0_ = tid >> 6;
    bf16_t* Qs = (bf16_t*)(smem + GL_Q); bf16_t* KTs = (bf16_t*)(smem + GL_KT); bf16_t* VTs = (bf16_t*)(smem + GL_VT); bf16_t* Ks = (bf16_t*)(smem + GL_K);
    bf16_t* QKMs = (bf16_t*)(smem + GL_QKM); float* Lf = (float*)(smem + GL_LF); bf16_t* Tp = (bf16_t*)(smem + GL_TP); bf16_t* Tpp = (bf16_t*)(smem + GL_TPP);
    bf16_t* Wn = (bf16_t*)(smem + GL_WN); float* SC = (float*)(smem + GL_SC); float* GCs = (float*)(smem + GL_GC);
    const float alog = p.in[I_ALOG][d * 4 + h], dtb = p.in[I_DTB][d * 4 + h], negea = -expf(alog);
    bf16_t* ODIR = (bf16_t*)(p.ws + WS_OA);
    __syncthreads();
    f32x16 St[4];
#pragma unroll
    for (int ct = 0; ct < 4; ++ct) St[ct] = zero16();
    bf16_t* RAW = (bf16_t*)(smem + GL_RAW);
    float pa = 0.f, pbt = 0.f;
    auto prefetch = [&](int x, int inst0, int ninst) {
        int seg, j0; chunk_pos(x, d, seg, j0);
        const int ldp = seg ? IN_COLS : CTX_COLS;
        const bf16_t* pbase = seg ? (const bf16_t*)(p.ws + WS_PLAT) + (size_t)b * S * IN_COLS : (const bf16_t*)(p.ws + WS_PCTX) + (size_t)b * CTXL * CTX_COLS;
        for (int inst = inst0; inst < inst0 + ninst; ++inst) {
            const int q = inst * 64 + lane, row = q / 48, c16 = q % 48;
            const bf16_t* src = pbase + (size_t)(j0 + row) * ldp + (c16 >> 4) * 512 + h * 128 + (c16 & 15) * 8;
#ifdef EMU
            emu_global_load_lds16(src, (char*)RAW + q * 16);
#else
            __builtin_amdgcn_global_load_lds((const unsigned*)src, (__attribute__((address_space(3))) unsigned*)((char*)RAW + q * 16), 16, 0, 0);
#endif
        }
    };
    auto prefetch_ab = [&](int x, int g0, int ng) {
        int seg, j0; chunk_pos(x, d, seg, j0);
        const float* abbase = (const float*)(p.ws + WS_AB) + (size_t)(seg ? T_CTX + b * S : b * CTXL) * 16;
        if (lane < 4 * ng) { const int j = j0 + 4 * g0 + lane; pa = abbase[(size_t)j * 16 + d * 4 + h]; pbt = abbase[(size_t)j * 16 + 8 + d * 4 + h]; }
    };
    auto x1 = [&](int c, int g0, int ng) {
        const int q3 = c % 3, parc = c & 1;
        for (int gi = 0; gi < ng; ++gi) {
            const int g = g0 + gi;
            const int i0 = d ? (GC - 4 - 4 * g) : 4 * g;
            const char* rawg = (const char*)RAW + (4 * g + (d ? 3 : 0)) * 768 + 4 * lane; const int rstep = d ? -768 : 768;
            unsigned wq[4], wk[4], wv[4];
#pragma unroll
            for (int e = 0; e < 4; ++e) { const char* rr = rawg + e * rstep; wq[e] = *(const unsigned*)rr; wk[e] = *(const unsigned*)(rr + 256); wv[e] = *(const unsigned*)(rr + 512); }
            char* qrow = (char*)Qs + ((q3 * 32 + i0) * LD128 + 2 * lane) * 2; char* krow = (char*)Ks + (i0 * LD128 + 2 * lane) * 2;
#pragma unroll
            for (int e = 0; e < 4; ++e) { *(unsigned*)(qrow + e * LD128 * 2) = wq[e]; *(unsigned*)(krow + e * LD128 * 2) = wk[e]; }
            char* ktrow = (char*)KTs + ((q3 * 128 + 2 * lane) * LD32 + i0) * 2; char* vtrow = (char*)VTs + ((q3 * 128 + 2 * lane) * LD32 + i0) * 2;
            { u32x2 o; o.x = (wk[0] & 0xffffu) | (wk[1] << 16); o.y = (wk[2] & 0xffffu) | (wk[3] << 16); *(u32x2*)ktrow = o;
              u32x2 o1; o1.x = (wk[0] >> 16) | (wk[1] & 0xffff0000u); o1.y = (wk[2] >> 16) | (wk[3] & 0xffff0000u); *(u32x2*)(ktrow + LD32 * 2) = o1; }
            { u32x2 o; o.x = (wv[0] & 0xffffu) | (wv[1] << 16); o.y = (wv[2] & 0xffffu) | (wv[3] << 16); *(u32x2*)vtrow = o;
              u32x2 o1; o1.x = (wv[0] >> 16) | (wv[1] & 0xffff0000u); o1.y = (wv[2] >> 16) | (wv[3] & 0xffff0000u); *(u32x2*)(vtrow + LD32 * 2) = o1; }
        }
        if (lane < 4 * ng) { const int jo = 4 * g0 + lane; const int i = d ? (GC - 1 - jo) : jo;
            SC[(parc * 8 + 0) * 32 + i] = negea * fsoftplus(pa + dtb); SC[(parc * 8 + 1) * 32 + i] = fsigmoid(pbt); }
    };
    auto x2 = [&](int c, int r, int wave) {
        const int par = c & 1, q3 = c % 3;
        const float* graw = SC + (par * 8 + 0) * 32;
        float gcv = 0.f;
#pragma unroll
        for (int s4 = 0; s4 < 8; ++s4) { const f32x4 g4 = *(const f32x4*)(graw + 4 * s4);
            gcv += (4 * s4 + 0 <= r ? g4.x : 0.f) + (4 * s4 + 1 <= r ? g4.y : 0.f) + (4 * s4 + 2 <= r ? g4.z : 0.f) + (4 * s4 + 3 <= r ? g4.w : 0.f); }
        if (lane < 32) GCs[wave * 32 + r] = gcv;
        if (wave == 7 && lane < 32) {
            float gl = 0.f;
#pragma unroll
            for (int s4 = 0; s4 < 8; ++s4) { const f32x4 g4 = *(const f32x4*)(graw + 4 * s4); gl += (g4.x + g4.y) + (g4.z + g4.w); }
            const float be = SC[(par * 8 + 1) * 32 + r];
            SC[(par * 8 + 3) * 32 + r] = fexp(gcv); SC[(par * 8 + 4) * 32 + r] = fexp(gl - gcv); SC[(par * 8 + 5) * 32 + r] = be * fexp(gcv); SC[(par * 8 + 6) * 32 + r] = fexp(gl);
        }
        const int pr = wave >> 2, th = (wave >> 1) & 1, ch = wave & 1, fr = lane & 15, fq = lane >> 4;
        const bf16_t* arow = (pr == 0 ? Ks : Qs + q3 * 32 * LD128) + (16 * th + fr) * LD128 + 8 * fq; const bf16_t* brow = Ks + (16 * ch + fr) * LD128 + 8 * fq;
        f32x4 cc = {0.f, 0.f, 0.f, 0.f};
#pragma unroll
        for (int ks = 0; ks < 4; ++ks) cc = MFMA16(*(const bf16x8*)(arow + 32 * ks), *(const bf16x8*)(brow + 32 * ks), cc);
        WAVE_SYNC();
        const int jj = 16 * ch + fr; const float gj = GCs[wave * 32 + jj];
#pragma unroll
        for (int j = 0; j < 4; ++j) {
            const int i = 16 * th + 4 * fq + j; const float dec = fexp(GCs[wave * 32 + i] - gj);
            if (pr == 0) Lf[i * 32 + jj] = (jj < i) ? SC[(par * 8 + 1) * 32 + i] * cc[j] * dec : 0.f;
            else QKMs[(par * 32 + i) * LD32 + jj] = f2bf((jj <= i) ? cc[j] * dec : 0.f);
        }
    };
    prefetch(0, 3 * wave0_, 3); prefetch_ab(0, wave0_, 1);
#ifndef EMU
    asm volatile("s_waitcnt vmcnt(0)" ::: "memory");
#endif
    const int r0_ = lane & 31, hh0_ = lane >> 5;
    __syncthreads();
    x1(0, wave0_, 1);
    LDS_BARRIER();
    if (wave0_ >= 4 && wave0_ < 7 && 1 < G_NT) { prefetch(1, 9 * (wave0_ - 4), wave0_ == 6 ? 6 : 9); prefetch_ab(1, 3 * (wave0_ - 4), wave0_ == 6 ? 2 : 3); }
    x2(0, r0_, wave0_);
#ifndef EMU
    asm volatile("s_waitcnt vmcnt(0)" ::: "memory");
#endif
    LDS_BARRIER();
    for (int it = -1; it < G_NT; ++it) {
        int r = r0_, hh = hh0_, wave = wave0_;
#ifndef EMU
        asm volatile("" : "+v"(r), "+v"(hh), "+v"(wave));
#endif
        const int xn = it + 1, par = xn & 1, q3 = xn % 3;
        const int g0w = 3 * (wave - 4), ngw = wave == 6 ? 2 : 3;
        if (wave == 7 && xn < G_NT) {
            const float* sb1 = SC + (par * 8 + 5) * 32; const float* sb0 = SC + (par * 8 + 1) * 32; bf16_t* Tppw = Tpp + par * 32 * LD32;
            const float s1lo = sb1[lane & 15], s1hi = sb1[16 + (lane & 15)], s0lo = sb0[lane & 15], s0hi = sb0[16 + (lane & 15)];
            SETPRIO(3);
            invert32_blocked(Lf, (bf16_t*)(smem + GL_INV), lane,
                [&](int i, int c, float v) { Tp[i * LD32 + c] = f2bf(v * (c < 16 ? s1lo : s1hi)); Tppw[i * LD32 + c] = f2bf(v * (c < 16 ? s0lo : s0hi)); },
                [&](int i, int c) { Tp[i * LD32 + c] = (bf16_t)0; Tppw[i * LD32 + c] = (bf16_t)0; });
            SETPRIO(0);
        }
        if (wave >= 4 && wave < 7 && xn + 1 < G_NT) {
            x1(xn + 1, g0w, ngw);
            if (xn + 2 < G_NT) {
                WAVE_SYNC();
                prefetch(xn + 2, 9 * (wave - 4), wave == 6 ? 6 : 9); prefetch_ab(xn + 2, g0w, ngw);
            }
        }
        if (wave < 4 && it >= 0) {
            const int pc = it & 1, qc = it % 3; int seg = 0, j0 = 0; chunk_pos(it, d, seg, j0);
            const bf16_t* Qc = Qs + qc * 32 * LD128; const bf16_t* KTc = KTs + qc * 128 * LD32; const bf16_t* VTc = VTs + qc * 128 * LD32;
            const bf16_t* QKc = QKMs + pc * 32 * LD32; const bf16_t* Tc = Tpp + pc * 32 * LD32; const float* sc = SC + pc * 8 * 32;
            f32x16 vn = zero16();
#pragma unroll
            for (int s = 0; s < 2; ++s) vn = MFMA32(ld_nat(Tc + r * LD32, s, hh), ld_nat(VTc + (32 * wave + r) * LD32, s, hh), vn);
            f32x16 oacc = zero16();
#define GDN_KSTEP(s) { const bf16x8 sb = pack_acc<(s) & 1>(St[(s) >> 1]); vn = MFMA32(ld_perm(Wn + r * LD128, (s), hh), sb, vn); oacc = MFMA32(ld_perm(Qc + r * LD128, (s), hh), sb, oacc); }
            GDN_KSTEP(0) GDN_KSTEP(1) GDN_KSTEP(2) GDN_KSTEP(3) GDN_KSTEP(4) GDN_KSTEP(5) GDN_KSTEP(6) GDN_KSTEP(7)
#undef GDN_KSTEP
#pragma unroll
            for (int g = 0; g < 16; ++g) oacc[g] *= sc[3 * 32 + crow(g, hh)];
            { const bf16x8 v0 = pack_acc<0>(vn), v1 = pack_acc<1>(vn);
              oacc = MFMA32(ld_perm(QKc + r * LD32, 0, hh), v0, oacc); oacc = MFMA32(ld_perm(QKc + r * LD32, 1, hh), v1, oacc); }
#pragma unroll
            for (int g = 0; g < 16; ++g) vn[g] *= sc[4 * 32 + crow(g, hh)];
            const float ge = sc[6 * 32];
            { const bf16x8 v0 = pack_acc<0>(vn), v1 = pack_acc<1>(vn);
#pragma unroll
              for (int ct = 0; ct < 4; ++ct) {
#pragma unroll
                  for (int g = 0; g < 16; ++g) St[ct][g] *= ge;
                  St[ct] = MFMA32(ld_perm(KTc + (32 * ct + r) * LD32, 0, hh), v0, St[ct]);
                  St[ct] = MFMA32(ld_perm(KTc + (32 * ct + r) * LD32, 1, hh), v1, St[ct]);
              } }
            if (seg) {
#pragma unroll
                for (int g = 0; g < 16; ++g) {
                    const int i = crow(g, hh), j = d ? j0 + GC - 1 - i : j0 + i;
                    ODIR[((size_t)d * T_LAT + (size_t)b * S + j) * 512 + h * 128 + 32 * wave + r] = f2bf(oacc[g]);
                }
            }
        }
        LDS_BARRIER();
        if (xn < G_NT && wave < 4) {
            f32x16 acc = zero16();
#pragma unroll
            for (int s = 0; s < 2; ++s) acc = MFMA32(ld_nat(KTs + (q3 * 128 + 32 * wave + r) * LD32, s, hh), ld_nat(Tp + r * LD32, s, hh), acc);
#pragma unroll
            for (int q = 0; q < 4; ++q) {
                u32x2 o; o.x = pk2(-acc[4 * q], -acc[4 * q + 1]); o.y = pk2(-acc[4 * q + 2], -acc[4 * q + 3]);
                *(u32x2*)(Wn + r * LD128 + 32 * wave + 8 * q + 4 * hh) = o;
            }
        }
        if (xn + 1 < G_NT) x2(xn + 1, r, wave);
#ifndef EMU
        asm volatile("s_waitcnt vmcnt(0)" ::: "memory");
#endif
        LDS_BARRIER();
    }
}

constexpr int RL_RX = 0;
constexpr int RL_KX = RL_RX + 32 * 64 * 2;
constexpr int RL_VX = RL_KX + 32 * 64 * 2;
constexpr int RL_KK = RL_VX + 32 * 64 * 2;
constexpr int RL_LW = RL_KK + 32 * 64 * 4;
constexpr int RL_IC = RL_LW + 32 * 64 * 4;
constexpr int RL_PC = RL_IC + 32 * 64 * 4;
constexpr int RL_CST = RL_PC + 2 * 64 * 4;
constexpr int RL_TW = RL_CST + 4 * 64 * 4;
constexpr int RL_AL = RL_TW + 32 * LD64 * 2;
constexpr int RL_LF = RL_AL + 32 * LD64 * 2;
constexpr int RL_LAKT = RL_LF + 32 * 32 * 4;
constexpr int RL_TB = RL_LAKT + 32 * LD32 * 2;
constexpr int RL_W2T = RL_TB + 32 * LD32 * 2;
constexpr int RL_A2T = RL_W2T + 64 * LD64 * 2;
constexpr int RL_AR = RL_A2T + 64 * LD64 * 2;
constexpr int RL_BR = RL_AR + 32 * LD64 * 2;
constexpr int RL_KR = RL_BR + 32 * LD64 * 2;
constexpr int RL_RR = RL_KR + 32 * LD64 * 2;
constexpr int RL_AT = RL_RR + 2 * 32 * LD64 * 2;
constexpr int RL_BHT = RL_AT + 64 * LD32 * 2;
constexpr int RL_KHT = RL_BHT + 2 * 64 * LD32 * 2;
constexpr int RL_VT = RL_KHT + 2 * 64 * LD32 * 2;
constexpr int RL_MRB = RL_VT + 2 * 64 * LD32 * 2;
constexpr int RL_MRK = RL_MRB + 2 * 32 * LD32 * 2;
constexpr int RL_WM = RL_MRK + 2 * 32 * LD32 * 2;
constexpr int RL_TL = RL_WM + 32 * LD64 * 2;
constexpr int RL_GS = RL_TL + 32 * LD32 * 2;
constexpr int RL_END = RL_GS + 8 * 64 * 4;
static_assert(RL_END <= LDS_BYTES, "rwkv lds");
static_assert(4 * 16 * LD32 * 2 <= 2 * 32 * LD64 * 2, "inversion scratch over AR/BR");

DI void rwkv_chain2(const Params& p, char* smem, int item) {
    const int d = item / (NB * H_B), b = (item / H_B) % NB, h = item % H_B;
    const int tid = tid_x(), lane = tid & 63, wave = tid >> 6;
    bf16_t* RX = (bf16_t*)(smem + RL_RX); bf16_t* KX = (bf16_t*)(smem + RL_KX); bf16_t* VX = (bf16_t*)(smem + RL_VX); float* KKs = (float*)(smem + RL_KK);
    float* LW = (float*)(smem + RL_LW); float* IC = (float*)(smem + RL_IC); float* Lf = (float*)(smem + RL_LF); float* PC = (float*)(smem + RL_PC); float* CST = (float*)(smem + RL_CST);
    bf16_t* TW = (bf16_t*)(smem + RL_TW); bf16_t* AL = (bf16_t*)(smem + RL_AL); bf16_t* W2T = (bf16_t*)(smem + RL_W2T); bf16_t* A2T = (bf16_t*)(smem + RL_A2T);
    bf16_t* Ar = (bf16_t*)(smem + RL_AR); bf16_t* Br = (bf16_t*)(smem + RL_BR); bf16_t* Kr = (bf16_t*)(smem + RL_KR); bf16_t* Rr = (bf16_t*)(smem + RL_RR);
    bf16_t* AT = (bf16_t*)(smem + RL_AT); bf16_t* BhT = (bf16_t*)(smem + RL_BHT); bf16_t* KhT = (bf16_t*)(smem + RL_KHT); bf16_t* VT = (bf16_t*)(smem + RL_VT);
    bf16_t* LakT = (bf16_t*)(smem + RL_LAKT); bf16_t* Mrb = (bf16_t*)(smem + RL_MRB); bf16_t* Mrk = (bf16_t*)(smem + RL_MRK); bf16_t* Tb = (bf16_t*)(smem + RL_TB);
    bf16_t* Wm = (bf16_t*)(smem + RL_WM); bf16_t* TLm = (bf16_t*)(smem + RL_TL); float* GS = (float*)(smem + RL_GS);
    bf16_t* YDIR = (bf16_t*)(p.aux + AUX_YDIR); float* BON = (float*)(p.ws + WS_BONUS);
    __syncthreads();
    for (int i = tid; i < 64 * 64; i += NTHREADS) {
        const int c = i >> 6, rr = i & 63;
        W2T[c * LD64 + rr] = f2bf(p.in[I_W2][((size_t)d * 64 + rr) * 512 + h * 64 + c]); A2T[c * LD64 + rr] = f2bf(p.in[I_A2][((size_t)d * 64 + rr) * 512 + h * 64 + c]);
    }
    if (tid < 256) { const int w = tid >> 6, c = tid & 63, gc = h * 64 + c;
        CST[tid] = w == 0 ? p.in[I_W0][d * 512 + gc] : (w == 1 ? p.in[I_A0][d * 512 + gc] : (w == 2 ? p.in[I_KA][gc] : p.in[I_RK][gc])); }
    const float kkw0 = p.in[I_KK][h * 64 + 2 * (lane & 31)], kkw1 = p.in[I_KK][h * 64 + 2 * (lane & 31) + 1];
    f32x16 Xt[2]; Xt[0] = zero16(); Xt[1] = zero16();
    unsigned rawv[4][5];
    auto prefetch = [&](int x, int w) {
        int seg, j0; chunk_pos(x, d, seg, j0);
        const int ldp = seg ? IN_COLS : CTX_COLS;
        const bf16_t* pb = seg ? (const bf16_t*)(p.ws + WS_PLAT) + (size_t)b * S * IN_COLS : (const bf16_t*)(p.ws + WS_PCTX) + (size_t)b * CTXL * CTX_COLS;
#pragma unroll
        for (int k = 0; k < 4; ++k) {
            const int pi = (w - 2) + 5 * k;
            if (pi < GC / 2) {
                const int j = j0 + 2 * pi + (lane >> 5); const int row = seg ? (j % ROWS) * GW + j / ROWS : j;
#pragma unroll
                for (int s = 0; s < 5; ++s) {
                    const int bcol = (s < 3 ? s * 512 + h * 64 : (s == 3 ? 1536 + d * 64 : 1664 + d * 64)) + 2 * (lane & 31);
                    rawv[k][s] = *(const unsigned*)(pb + (size_t)row * ldp + COL_B0 + bcol);
                }
            }
        }
    };
    auto y1 = [&](int w) {
#pragma unroll
        for (int k = 0; k < 4; ++k) {
            const int pi = (w - 2) + 5 * k;
            if (pi < GC / 2) {
                const int jo = 2 * pi + (lane >> 5), i = d ? (GC - 1 - jo) : jo, c2 = 2 * (lane & 31);
                const float kx0 = bf2f((bf16_t)(rawv[k][1] & 0xffffu)) * kkw0, kx1 = bf2f((bf16_t)(rawv[k][1] >> 16)) * kkw1;
                const float rs = frsq(half_sum(kx0 * kx0 + kx1 * kx1, lane >> 5) + 1e-6f);
                *(unsigned*)(RX + i * 64 + c2) = rawv[k][0]; *(unsigned*)(KX + i * 64 + c2) = rawv[k][1]; *(unsigned*)(VX + i * 64 + c2) = rawv[k][2];
                KKs[i * 64 + c2] = kx0 * rs; KKs[i * 64 + c2 + 1] = kx1 * rs;
                *(unsigned*)(TW + i * LD64 + c2) = rawv[k][3]; *(unsigned*)(AL + i * LD64 + c2) = rawv[k][4];
            }
        }
    };
    auto y2 = [&]() {
        const int which = wave >> 2, cg = wave & 3, fr = lane & 15, fq = lane >> 4;
        const bf16_t* arow0 = (which ? AL : TW) + fr * LD64 + 8 * fq; const bf16_t* brow = (which ? A2T : W2T) + (16 * cg + fr) * LD64 + 8 * fq;
        f32x4 c0 = {0.f, 0.f, 0.f, 0.f}, c1 = {0.f, 0.f, 0.f, 0.f};
#pragma unroll
        for (int ks = 0; ks < 2; ++ks) {
            const bf16x8 bfrag = *(const bf16x8*)(brow + 32 * ks);
            c0 = MFMA16(*(const bf16x8*)(arow0 + 32 * ks), bfrag, c0); c1 = MFMA16(*(const bf16x8*)(arow0 + 16 * LD64 + 32 * ks), bfrag, c1);
        }
        const int c = 16 * cg + fr; const float bias = CST[which * 64 + c];
#pragma unroll
        for (int th = 0; th < 2; ++th) {
            float gs = 0.f;
#pragma unroll
            for (int j = 0; j < 4; ++j) {
                const int i = 16 * th + 4 * fq + j; const float z = bias + (th ? c1[j] : c0[j]);
                if (which) IC[i * 64 + c] = fsigmoid(z);
                else { const float wl = -fsoftplus(-z) - 0.5f; const float lw = -fexp(wl); LW[i * 64 + c] = lw; gs += lw; }
            }
            if (!which) GS[(4 * th + fq) * 64 + c] = gs;
        }
    };
    if (wave >= 2 && wave < 7) prefetch(0, wave);
    const int r0_ = lane & 31, hh0_ = lane >> 5;
    __syncthreads();
    if (wave >= 2 && wave < 7) { y1(wave); if (1 < G_NT) prefetch(1, wave); }
    LDS_BARRIER();
    y2();
    LDS_BARRIER();
    for (int it = -1; it < G_NT; ++it) {
        int r = r0_, hh = hh0_;
#ifndef EMU
        asm volatile("" : "+v"(r), "+v"(hh));
#endif
        const int xn = it + 1, par = xn & 1;
        int segn = 0, j0n = 0; if (xn < G_NT) chunk_pos(xn, d, segn, j0n);
        if (xn < G_NT) {
            const int c = lane, i0 = 4 * wave;
            const float ka = CST[2 * 64 + c], rk = CST[3 * 64 + c];
            float lpb = 0.f, lpc = 0.f; float lw4[4];
#pragma unroll
            for (int g2 = 0; g2 < 8; ++g2) { const float w = GS[g2 * 64 + c]; lpc += w; if (g2 < wave) lpb += w; }
#pragma unroll
            for (int e = 0; e < 4; ++e) lw4[e] = LW[(i0 + e) * 64 + c];
            bf16_t ta[4], tb[4], tk[4], tv[4]; float bon[4];
            float lprun = lpb;
            float Pprev = fexp(lpb); const float PCt = fexp(lpc);
#pragma unroll
            for (int e = 0; e < 4; ++e) {
                const int i = i0 + e;
                lprun += lw4[e];
                const float Pi = fexp(lprun), Pm = Pprev, invP = frcp(Pi), PCi = PCt * invP; Pprev = Pi;
                const float ic = IC[i * 64 + c], kxv = bf2f(KX[i * 64 + c]), kkv = KKs[i * 64 + c], rxv = bf2f(RX[i * 64 + c]); const bf16_t vxb = VX[i * 64 + c];
                const float kd = kxv * (1.f + (ic - 1.f) * ka), bb = kkv * ic, aa = -kkv;
                ta[e] = f2bf(aa * Pm); tb[e] = f2bf(bb * PCi); tk[e] = f2bf(kd * PCi); tv[e] = vxb;
                Ar[i * LD64 + c] = ta[e]; Br[i * LD64 + c] = f2bf(bb * invP); Kr[i * LD64 + c] = f2bf(kd * invP); Rr[(par * 32 + i) * LD64 + c] = f2bf(rxv * Pi);
                bon[e] = wave_sum_fast(rxv * kd * rk);
            }
            { u32x2 o; o.x = (unsigned)ta[0] | ((unsigned)ta[1] << 16); o.y = (unsigned)ta[2] | ((unsigned)ta[3] << 16); *(u32x2*)(AT + c * LD32 + i0) = o; }
            { u32x2 o; o.x = (unsigned)tb[0] | ((unsigned)tb[1] << 16); o.y = (unsigned)tb[2] | ((unsigned)tb[3] << 16); *(u32x2*)(BhT + (par * 64 + c) * LD32 + i0) = o; }
            { u32x2 o; o.x = (unsigned)tk[0] | ((unsigned)tk[1] << 16); o.y = (unsigned)tk[2] | ((unsigned)tk[3] << 16); *(u32x2*)(KhT + (par * 64 + c) * LD32 + i0) = o; }
            { u32x2 o; o.x = (unsigned)tv[0] | ((unsigned)tv[1] << 16); o.y = (unsigned)tv[2] | ((unsigned)tv[3] << 16); *(u32x2*)(VT + (par * 64 + c) * LD32 + i0) = o; }
            if (wave == 7) PC[par * 64 + c] = PCt;
            if (segn && lane < 4) { const int i = i0 + lane, jj = d ? j0n + GC - 1 - i : j0n + i;
                const float bv = lane == 0 ? bon[0] : (lane == 1 ? bon[1] : (lane == 2 ? bon[2] : bon[3]));
                BON[((size_t)d * T_LAT + (size_t)b * S + (jj % ROWS) * GW + jj / ROWS) * 8 + h] = bv; }
        }
        LDS_BARRIER();
        if (xn < G_NT) {
            const int m = wave >> 1, th = wave & 1, fr = lane & 15, fq = lane >> 4;
            const bf16_t* arow = ((m < 2) ? Ar : Rr + par * 32 * LD64) + (16 * th + fr) * LD64 + 8 * fq; const bf16_t* brow = ((m & 1) ? Kr : Br) + fr * LD64 + 8 * fq;
            f32x4 c0 = {0.f, 0.f, 0.f, 0.f}, c1 = {0.f, 0.f, 0.f, 0.f};
#pragma unroll
            for (int ks = 0; ks < 2; ++ks) {
                const bf16x8 afrag = *(const bf16x8*)(arow + 32 * ks);
                c0 = MFMA16(afrag, *(const bf16x8*)(brow + 32 * ks), c0); c1 = MFMA16(afrag, *(const bf16x8*)(brow + 16 * LD64 + 32 * ks), c1);
            }
#pragma unroll
            for (int ch = 0; ch < 2; ++ch) {
                const f32x4 cc = ch ? c1 : c0; const int ic = 16 * ch + fr; const int t0 = 16 * th + 4 * fq;
                if (m == 0) {
#pragma unroll
                    for (int j = 0; j < 4; ++j) Lf[(t0 + j) * 32 + ic] = (ic < t0 + j) ? -cc[j] : 0.f;
                } else if (m == 1) {
                    u32x2 o; o.x = pk2((ic < t0) ? cc[0] : 0.f, (ic < t0 + 1) ? cc[1] : 0.f); o.y = pk2((ic < t0 + 2) ? cc[2] : 0.f, (ic < t0 + 3) ? cc[3] : 0.f);
                    *(u32x2*)(LakT + ic * LD32 + t0) = o;
                } else {
                    bf16_t* M = (m == 2 ? Mrb : Mrk) + par * 32 * LD32;
#pragma unroll
                    for (int j = 0; j < 4; ++j) M[(t0 + j) * LD32 + ic] = f2bf((ic <= t0 + j) ? cc[j] : 0.f);
                }
            }
        }
        LDS_BARRIER();
        if (wave == 7 && xn < G_NT) {
            SETPRIO(3);
            invert32_blocked(Lf, (bf16_t*)(smem + RL_AR), lane, [&](int i, int c, float v) { Tb[i * LD32 + c] = f2bf(v); },
                             [&](int i, int c) { Tb[i * LD32 + c] = (bf16_t)0; });
            SETPRIO(0);
        }
        if (wave >= 2 && wave < 7 && xn + 1 < G_NT) { y1(wave); if (xn + 2 < G_NT) prefetch(xn + 2, wave); }
        if (wave < 2 && it >= 0) {
            SETPRIO(2);
            const int pc = it & 1; int seg = 0, j0 = 0; chunk_pos(it, d, seg, j0);
            const bf16_t* Rc = Rr + pc * 32 * LD64; const bf16_t* BhTc = BhT + pc * 64 * LD32; const bf16_t* KhTc = KhT + pc * 64 * LD32; const bf16_t* VTc = VT + (pc * 64 + 32 * wave + r) * LD32;
            const bf16_t* Mrbc = Mrb + pc * 32 * LD32; const bf16_t* Mrkc = Mrk + pc * 32 * LD32; const float* PCc = PC + pc * 64;
            const bf16x8 vf0 = ld_nat(VTc, 0, hh), vf1 = ld_nat(VTc, 1, hh);
            f32x16 u = zero16(), y = zero16();
            u = MFMA32(ld_nat(TLm + r * LD32, 0, hh), vf0, u); u = MFMA32(ld_nat(TLm + r * LD32, 1, hh), vf1, u);
            y = MFMA32(ld_nat(Mrkc + r * LD32, 0, hh), vf0, y); y = MFMA32(ld_nat(Mrkc + r * LD32, 1, hh), vf1, y);
#define RW_KSTEP(s) { const bf16x8 xb = pack_acc<(s) & 1>(Xt[(s) >> 1]); u = MFMA32(ld_perm(Wm + r * LD64, (s), hh), xb, u); y = MFMA32(ld_perm(Rc + r * LD64, (s), hh), xb, y); }
            RW_KSTEP(0) RW_KSTEP(1) RW_KSTEP(2) RW_KSTEP(3)
#undef RW_KSTEP
            const bf16x8 ub0 = pack_acc<0>(u), ub1 = pack_acc<1>(u);
            y = MFMA32(ld_perm(Mrbc + r * LD32, 0, hh), ub0, y); y = MFMA32(ld_perm(Mrbc + r * LD32, 1, hh), ub1, y);
#pragma unroll
            for (int kt = 0; kt < 2; ++kt) {
#pragma unroll
                for (int g = 0; g < 16; ++g) Xt[kt][g] *= PCc[32 * kt + crow(g, hh)];
                Xt[kt] = MFMA32(ld_perm(BhTc + (32 * kt + r) * LD32, 0, hh), ub0, Xt[kt]); Xt[kt] = MFMA32(ld_perm(BhTc + (32 * kt + r) * LD32, 1, hh), ub1, Xt[kt]);
                Xt[kt] = MFMA32(ld_nat(KhTc + (32 * kt + r) * LD32, 0, hh), vf0, Xt[kt]); Xt[kt] = MFMA32(ld_nat(KhTc + (32 * kt + r) * LD32, 1, hh), vf1, Xt[kt]);
            }
            if (seg) {
#pragma unroll
                for (int g = 0; g < 16; ++g) {
                    const int i = crow(g, hh), jj = d ? j0 + GC - 1 - i : j0 + i;
                    YDIR[((size_t)d * T_LAT + (size_t)b * S + (jj % ROWS) * GW + jj / ROWS) * 512 + h * 64 + 32 * wave + r] = f2bf(y[g]);
                }
            }
            SETPRIO(0);
        }
        LDS_BARRIER();
        if (xn < G_NT && wave < 3) {
            const bf16_t* arow = (wave < 2) ? AT + (32 * wave + r) * LD32 : LakT + r * LD32;
            f32x16 acc = zero16();
#pragma unroll
            for (int s = 0; s < 2; ++s) acc = MFMA32(ld_nat(arow, s, hh), ld_nat(Tb + r * LD32, s, hh), acc);
#pragma unroll
            for (int q = 0; q < 4; ++q) {
                u32x2 o; o.x = pk2(acc[4 * q], acc[4 * q + 1]); o.y = pk2(acc[4 * q + 2], acc[4 * q + 3]);
                if (wave < 2) *(u32x2*)(Wm + r * LD64 + 32 * wave + 8 * q + 4 * hh) = o; else *(u32x2*)(TLm + r * LD32 + 8 * q + 4 * hh) = o;
            }
        }
        if (xn + 1 < G_NT) y2();
        LDS_BARRIER();
    }
}

DI void phase3(const Params& p, char* smem) {
    constexpr int NG = 2 * NB * H_A, NR = 2 * NB * H_B;
    for (int it = blockIdx.x; it < NG; it += gridDim.x) gdn_chain2(p, smem, it);
    for (int it = blockIdx.x; it < NG + NR; it += gridDim.x) if (it >= NG) rwkv_chain2(p, smem, it - NG);
    const int nchain = NG + NR, G = (int)gridDim.x;
    const int tb = G > nchain ? (int)blockIdx.x - nchain : (int)blockIdx.x, ntb = G > nchain ? G - nchain : G;
    if (tb >= 0) {
        __syncthreads();
        const int tid3 = tid_x(), lane = tid3 & 63, wave = tid3 >> 6;
        float* scr = (float*)smem + wave * (64 * 33);
        bf16_t* GUT = (bf16_t*)(p.aux + AUX_GUT);
        constexpr int nkb = D / 64, nnb = DE / 32, per = nkb * nnb;
        for (int it = tb * 8 + wave; it < NEXP * 2 * per; it += ntb * 8) {
            const int e = it / (2 * per), r = it % (2 * per), up = r / per, r2 = r % per, kb = r2 / nnb, nb = r2 % nnb;
            transpose_item((up ? p.in[I_MU_UP] : p.in[I_MG]) + (size_t)e * D * DE, DE, DE, kb * 64, nb * 32, GUT + (size_t)e * 512 * D, D, up ? 2 : 1, scr, lane);
        }
        constexpr int nkb2 = DE / 64, nnb2 = D / 32, per2 = nkb2 * nnb2;
        for (int it = tb * 8 + wave; it < NE_EARLY * per2; it += ntb * 8) {
            const int e = it / per2, r2 = it % per2, kb = r2 / nnb2, nb = r2 % nnb2;
            transpose_item(p.in[I_MD] + (size_t)e * DE * D, D, D, kb * 64, nb * 32, DNT_PTR(p.ws, e), DE, 0, scr, lane);
        }
    }
}

constexpr int P4_SG = 0;
constexpr int P4_XV = P4_SG + 32 * LD128 * 2;
constexpr int P4_YF = P4_XV + 32 * 520 * 2;
static_assert(P4_YF + 32 * 516 * 4 <= LDS_BYTES, "phase4 lds");
DI void phase4(const Params& p, char* smem) {
    const int tid = tid_x(), lane = tid & 63, wave = tid >> 6, r = lane & 31, hh = lane >> 5;
    const bf16_t* PL = (const bf16_t*)(p.ws + WS_PLAT);
    const bf16_t* ODIR = (const bf16_t*)(p.ws + WS_OA); const bf16_t* YDIR = (const bf16_t*)(p.aux + AUX_YDIR);
    const float* BON = (const float*)(p.ws + WS_BONUS); const float* mu = p.in[I_MU]; const bf16_t* G2T = (const bf16_t*)(p.ws + WS_G2T);
    bf16_t* OA = (bf16_t*)(p.ws + WS_OA); bf16_t* OB = (bf16_t*)(p.ws + WS_OB);
    bf16_t* SG = (bf16_t*)(smem + P4_SG); bf16_t* XV = (bf16_t*)(smem + P4_XV); float* YF = (float*)(smem + P4_YF);
    for (int it = blockIdx.x; it < T_LAT / 32; it += gridDim.x) {
        const int tok0 = it * 32, b = tok0 / S, l0 = tok0 % S;
        __syncthreads();
        for (int q = tid; q < 32 * 80; q += NTHREADS) {
            const int t = q / 80, c8 = q % 80;
            const int l = l0 + t;
            const int bcol = c8 < 16 ? 1792 + c8 * 8 : 1024 + (c8 - 16) * 8;
            float cu[8], o[8];
            unpack8(*(const u32x4*)(PL + (size_t)(b * S + l) * IN_COLS + COL_B0 + bcol), cu);
#pragma unroll
            for (int e = 0; e < 8; ++e) o[e] = c8 < 16 ? fsigmoid(cu[e]) : cu[e];
            u32x4 w; w.x = pk2(o[0], o[1]); w.y = pk2(o[2], o[3]); w.z = pk2(o[4], o[5]); w.w = pk2(o[6], o[7]);
            if (c8 < 16) *(u32x4*)(SG + t * LD128 + c8 * 8) = w; else *(u32x4*)(XV + t * 520 + (c8 - 16) * 8) = w;
        }
        for (int q = tid; q < 32 * 64; q += NTHREADS) {
            const int t = q >> 6, c8 = q & 63, tok = tok0 + t;
            float a0[8], a1[8];
            unpack8(*(const u32x4*)(YDIR + (size_t)tok * 512 + c8 * 8), a0); unpack8(*(const u32x4*)(YDIR + ((size_t)T_LAT + tok) * 512 + c8 * 8), a1);
            f32x4 s0 = {a0[0] + a1[0], a0[1] + a1[1], a0[2] + a1[2], a0[3] + a1[3]}, s1 = {a0[4] + a1[4], a0[5] + a1[5], a0[6] + a1[6], a0[7] + a1[7]};
            *(f32x4*)(YF + t * 516 + c8 * 8) = s0; *(f32x4*)(YF + t * 516 + c8 * 8 + 4) = s1;
        }
        __syncthreads();
        {
            unsigned q0[16], q1[16], zq[16];
#pragma unroll
            for (int k = 0; k < 16; ++k) {
                const int pi = wave * 16 + k, t = pi >> 2, h = pi & 3, tok = tok0 + t;
                const size_t o0 = (size_t)tok * 512 + h * 128 + 2 * lane;
                q0[k] = *(const unsigned*)(ODIR + o0); q1[k] = *(const unsigned*)(ODIR + (size_t)T_LAT * 512 + o0); zq[k] = *(const unsigned*)(PL + (size_t)tok * IN_COLS + 1536 + h * 128 + 2 * lane);
            }
            const float on0 = p.in[I_ONORM][2 * lane], on1 = p.in[I_ONORM][2 * lane + 1];
#pragma unroll
            for (int k = 0; k < 16; ++k) {
                const int pi = wave * 16 + k, t = pi >> 2, h = pi & 3, tok = tok0 + t;
                const size_t o0 = (size_t)tok * 512 + h * 128 + 2 * lane;
                const float a0 = bf2f((bf16_t)(q0[k] & 0xffffu)) + bf2f((bf16_t)(q1[k] & 0xffffu)), a1 = bf2f((bf16_t)(q0[k] >> 16)) + bf2f((bf16_t)(q1[k] >> 16));
                const float ss = wave_sum_fast(a0 * a0 + a1 * a1);
                const float rstd = frsq(ss * (1.f / 128.f) + 1e-6f);
                const float z0 = bf2f((bf16_t)(zq[k] & 0xffffu)), z1 = bf2f((bf16_t)(zq[k] >> 16));
                *(unsigned*)(OA + o0) = pk2(a0 * rstd * on0 * fsilu(z0), a1 * rstd * on1 * fsilu(z1));
            }
        }
        __syncthreads();
        {
            const int h = wave;
            f32x16 acc0 = zero16(), acc1 = zero16();
#pragma unroll
            for (int s2 = 0; s2 < 8; ++s2) {
                const bf16x8 a = ld_nat(SG + r * LD128, s2, hh);
                const bf16x8 b0 = *(const bf16x8*)(G2T + (size_t)(64 * h + r) * 128 + 16 * s2 + 8 * hh), b1 = *(const bf16x8*)(G2T + (size_t)(64 * h + 32 + r) * 128 + 16 * s2 + 8 * hh);
                acc0 = MFMA32(a, b0, acc0); acc1 = MFMA32(a, b1, acc1);
            }
            const int c0 = 64 * h + r, c1 = c0 + 32;
            const float lg0 = p.in[I_LNG][c0], lb0 = p.in[I_LNB][c0], lg1 = p.in[I_LNG][c1], lb1 = p.in[I_LNB][c1];
            float bonv[16];
#pragma unroll
            for (int g = 0; g < 16; ++g) { const int tok = tok0 + crow(g, hh); bonv[g] = BON[(size_t)tok * 8 + h] + BON[((size_t)T_LAT + tok) * 8 + h]; }
#pragma unroll
            for (int g = 0; g < 16; ++g) {
                const int i = crow(g, hh), tok = tok0 + i;
                const float y0 = YF[i * 516 + c0], y1 = YF[i * 516 + c1];
                const float mean = half_sum(y0 + y1, hh) * (1.f / 64.f); const float d0 = y0 - mean, d1 = y1 - mean;
                const float var = half_sum(d0 * d0 + d1 * d1, hh) * (1.f / 64.f); const float rs = frsq(var + 64e-5f);
                const float bon = bonv[g];
                const float o0 = (d0 * rs * lg0 + lb0 + bon * bf2f(XV[i * 520 + c0])) * acc0[g], o1 = (d1 * rs * lg1 + lb1 + bon * bf2f(XV[i * 520 + c1])) * acc1[g];
                OB[(size_t)tok * 512 + c0] = f2bf(o0); OB[(size_t)tok * 512 + c1] = f2bf(o1);
            }
        }
    }
}

DI void phase5(const Params& p, char* smem) {
    const bf16_t* OA = (const bf16_t*)(p.ws + WS_OA); const bf16_t* OB = (const bf16_t*)(p.ws + WS_OB);
    const bf16_t* WA = (const bf16_t*)(p.ws + WS_WOA); const bf16_t* WB = (const bf16_t*)(p.ws + WS_WOB);
    const bf16_t* PL = (const bf16_t*)(p.ws + WS_PLAT); bf16_t* Y = (bf16_t*)(p.aux + AUX_Y);
    if (USE_G8) {
        constexpr int NT8 = D / 256, MT8 = T_LAT / 256;
        constexpr int GLD = 264;
        static_assert(256 * GLD * 2 <= LDS_BYTES, "gate tile lds");
        bf16_t* GT = (bf16_t*)smem;
        auto stage_gates = [&](int brow, int gcol0) {
            const int tid = tid_x();
            u32x4 gv[16];
#pragma unroll
            for (int i = 0; i < 16; ++i) { const int ch = tid + i * NTHREADS, row = ch >> 5, c16 = ch & 31; gv[i] = *(const u32x4*)(PL + (size_t)(brow + row) * IN_COLS + gcol0 + c16 * 8); }
#pragma unroll
            for (int i = 0; i < 16; ++i) { const int ch = tid + i * NTHREADS, row = ch >> 5, c16 = ch & 31; *(u32x4*)(GT + row * GLD + c16 * 8) = gv[i]; }
            __syncthreads();
        };
        for (int t = blockIdx.x; t < MT8 * NT8; t += gridDim.x) {
            int mt, nt; if (!g8::tile_order(t, MT8, NT8, mt, nt)) break;
            const int brow = mt * 256, bcol = nt * 256;
            g8::Acc acc; g8::acc_zero(acc);
            g8::kloop(acc, smem, OA, 512, WA, 512, 512, brow, bcol);
            stage_gates(brow, COL_G0 + bcol);
            g8::for_each_quad(acc, brow, bcol, [&](int row, int col, const f32x4& v) {
                const u32x2 gq = *(const u32x2*)(GT + (row - brow) * GLD + (col - bcol));
                const float g0 = bf2f((bf16_t)(gq.x & 0xffffu)), g1 = bf2f((bf16_t)(gq.x >> 16)), g2 = bf2f((bf16_t)(gq.y & 0xffffu)), g3 = bf2f((bf16_t)(gq.y >> 16));
                u32x2 o; o.x = pk2(fsigmoid(g0) * v.x, fsigmoid(g1) * v.y); o.y = pk2(fsigmoid(g2) * v.z, fsigmoid(g3) * v.w);
                *(u32x2*)(Y + (size_t)row * D + col) = o;
            });
            __syncthreads();
            g8::acc_zero(acc);
            g8::kloop(acc, smem, OB, 512, WB, 512, 512, brow, bcol);
            stage_gates(brow, COL_G0 + D + bcol);
            g8::for_each_quad(acc, brow, bcol, [&](int row, int col, const f32x4& v) {
                const u32x2 gq = *(const u32x2*)(GT + (row - brow) * GLD + (col - bcol));
                const float g0 = bf2f((bf16_t)(gq.x & 0xffffu)), g1 = bf2f((bf16_t)(gq.x >> 16)), g2 = bf2f((bf16_t)(gq.y & 0xffffu)), g3 = bf2f((bf16_t)(gq.y >> 16));
#ifdef EMU
                const unsigned long long tq = *(const unsigned long long*)(Y + (size_t)row * D + col);
#else
                const unsigned long long tq = __hip_atomic_load((const unsigned long long*)(Y + (size_t)row * D + col), __ATOMIC_RELAXED, __HIP_MEMORY_SCOPE_AGENT);
#endif
                const unsigned tlo = (unsigned)tq, thi = (unsigned)(tq >> 32);
                const float t0 = bf2f((bf16_t)(tlo & 0xffffu)), t1 = bf2f((bf16_t)(tlo >> 16)), t2 = bf2f((bf16_t)(thi & 0xffffu)), t3 = bf2f((bf16_t)(thi >> 16));
                u32x2 o; o.x = pk2(t0 + fsigmoid(g0) * v.x, t1 + fsigmoid(g1) * v.y); o.y = pk2(t2 + fsigmoid(g2) * v.z, t3 + fsigmoid(g3) * v.w);
                *(u32x2*)(Y + (size_t)row * D + col) = o;
            });
            __syncthreads();
        }
        return;
    }
    constexpr int MR5 = 2, BM5 = 64 * MR5; constexpr int NT = D / 128, MT = T_LAT / BM5;
    for (int t = blockIdx.x; t < MT * NT; t += gridDim.x) {
        const int mt = t / NT, nt = t % NT, row0 = mt * BM5;
        f32x4 acca[MR5][4], accb[MR5][4]; acc_zero(acca); acc_zero(accb);
        gemm_kloop(acca, smem, [&](int i) { return OA + (size_t)(row0 + i) * 512; }, WA + (size_t)nt * 128 * 512, 512, 512);
        gemm_kloop(accb, smem, [&](int i) { return OB + (size_t)(row0 + i) * 512; }, WB + (size_t)nt * 128 * 512, 512, 512);
        const int t2 = tid_x(), l2 = t2 & 63, w2 = t2 >> 6; const int wr = w2 >> 1, wc = w2 & 1, fr = l2 & 15, fq = l2 >> 4;
#pragma unroll
        for (int m = 0; m < MR5; ++m)
#pragma unroll
            for (int n = 0; n < 4; ++n)
#pragma unroll
                for (int j = 0; j < 4; ++j) {
                    const int row = row0 + wr * 16 * MR5 + m * 16 + fq * 4 + j, col = nt * 128 + wc * 64 + n * 16 + fr;
                    const float ga = bf2f(PL[(size_t)row * IN_COLS + COL_G0 + col]), gb = bf2f(PL[(size_t)row * IN_COLS + COL_G0 + D + col]);
                    Y[(size_t)row * D + col] = f2bf(sigmoidf_(ga) * acca[m][n][j] + sigmoidf_(gb) * accb[m][n][j]);
                }
    }
}

DI void phase6(const Params& p, char* smem) {
    const bf16_t* Y = (const bf16_t*)(p.aux + AUX_Y); const bf16_t* WO = (const bf16_t*)(p.ws + WS_WOUT);
    const float* mod = (const float*)(p.ws + WS_MOD); float* Hh = (float*)(p.ws + WS_H);
    if (USE_G8) {
        constexpr int NT = D / 256, MT = T_LAT / 256;
        const float* X = p.in[I_X];
        for (int t = blockIdx.x; t < MT * NT; t += gridDim.x) {
            int mt, nt; if (!g8::tile_order(t, MT, NT, mt, nt)) break;
            const int brow = mt * 256, bcol = nt * 256;
            g8::Acc acc; g8::acc_zero(acc);
            g8::kloop(acc, smem, Y, D, WO, D, D, brow, bcol);
            g8::for_each_quad(acc, brow, bcol, [&](int row, int col, const f32x4& v) {
                const int b = row / S; const f32x4 xv = *(const f32x4*)(X + (size_t)row * D + col), gv = *(const f32x4*)(mod + (size_t)b * 6 * D + 2 * D + col);
                f32x4 o; o.x = xv.x + gv.x * v.x; o.y = xv.y + gv.y * v.y; o.z = xv.z + gv.z * v.z; o.w = xv.w + gv.w * v.w;
                *(f32x4*)(Hh + (size_t)row * D + col) = o;
            });
        }
    } else {
        const int tid = tid_x(), lane = tid & 63, wave = tid >> 6, wr = wave >> 1, wc = wave & 1, fr = lane & 15, fq = lane >> 4;
        constexpr int NT = D / 128, MT = T_LAT / BM;
        for (int t = blockIdx.x; t < MT * NT; t += gridDim.x) {
            const int mt = t / NT, nt = t % NT, row0 = mt * BM;
            f32x4 acc[MREP][4]; acc_zero(acc);
            gemm_kloop(acc, smem, [&](int i) { return Y + (size_t)(row0 + i) * D; }, WO + (size_t)nt * 128 * D, D, D);
#pragma unroll
            for (int m = 0; m < MREP; ++m)
#pragma unroll
                for (int n = 0; n < 4; ++n)
#pragma unroll
                    for (int j = 0; j < 4; ++j) {
                        const int row = row0 + wr * 16 * MREP + m * 16 + fq * 4 + j, col = nt * 128 + wc * 64 + n * 16 + fr, b = row / S;
                        Hh[(size_t)row * D + col] = p.in[I_X][(size_t)row * D + col] + mod[(size_t)b * 6 * D + 2 * D + col] * acc[m][n][j];
                    }
        }
    }
    __syncthreads();
    const int tid6 = tid_x(), lane = tid6 & 63, wave = tid6 >> 6;
    const int gw = blockIdx.x * 8 + wave, ngw = gridDim.x * 8;
    float* scr = (float*)smem + wave * (64 * 33);
    {
        constexpr int nkb = DE / 64, nnb = D / 32, per = nkb * nnb;
        for (int it = gw; it < (NEXP - NE_EARLY) * per; it += ngw) {
            const int e = NE_EARLY + it / per, r2 = it % per, kb = r2 / nnb, nb = r2 % nnb;
            transpose_item(p.in[I_MD] + (size_t)e * DE * D, D, D, kb * 64, nb * 32, DNT_PTR(p.ws, e), DE, 0, scr, lane);
        }
    }
}

#ifdef EMU
#define MFMA32F(a, b, c) emu_mfma32_f32((a), (b), (c))
#else
#define MFMA32F(a, b, c) __builtin_amdgcn_mfma_f32_32x32x2f32((a), (b), (c), 0, 0, 0)
#endif
constexpr int TB_LD = D + 4;
static_assert(32 * TB_LD * 4 <= LDS_BYTES && 8 * 32 * 64 * 4 <= LDS_BYTES, "phase7 lds");
DI void phase7(const Params& p, char* smem) {
    const int tid = tid_x(), lane = tid & 63, wave = tid >> 6, r = lane & 31, hh = lane >> 5;
    const float* Hh = (const float*)(p.ws + WS_H); const float* mod = (const float*)(p.ws + WS_MOD); const float* WRT = (const float*)(p.ws + WS_WRT);
    bf16_t* Tt = (bf16_t*)(p.ws + WS_T); int* cnt = (int*)(p.ws + WS_CNT); int* rowlist = (int*)(p.ws + WS_ROWLIST); float* pairw = (float*)(p.ws + WS_PAIRW);
    float* tb = (float*)smem;
    float* bias = (float*)(smem + LDS_BYTES - 1024);
    int* lcnt = (int*)(smem + LDS_BYTES - 768);
    int* lbase = lcnt + 32;
    if (tid < 36) bias[tid] = tid < 4 ? p.in[I_RGB][tid] : p.in[I_REB][tid - 4];
    f32x4 x[4][D / 256];
    int itn = blockIdx.x;
    if (itn < T_LAT / 32) {
#pragma unroll
        for (int tt = 0; tt < 4; ++tt)
#pragma unroll
            for (int j = 0; j < D / 256; ++j) x[tt][j] = *(const f32x4*)(Hh + (size_t)(itn * 32 + wave * 4 + tt) * D + j * 256 + lane * 4);
    }
    for (int it = blockIdx.x; it < T_LAT / 32; it += gridDim.x) {
        const int tok0 = it * 32;
        __syncthreads();
        if (tid < 32) lcnt[tid] = 0;
#pragma unroll
        for (int tt = 0; tt < 4; ++tt) {
            const int ti = wave * 4 + tt, tok = tok0 + ti, b = tok / S;
            float ss = 0.f;
#pragma unroll
            for (int j = 0; j < D / 256; ++j) ss += x[tt][j].x * x[tt][j].x + x[tt][j].y * x[tt][j].y + x[tt][j].z * x[tt][j].z + x[tt][j].w * x[tt][j].w;
            ss = wave_sum_fast(ss);
            const float rstd = frsq(ss * (1.0f / D) + 1e-6f);
#pragma unroll
            for (int j = 0; j < D / 256; ++j) {
                const int k = j * 256 + lane * 4;
                const f32x4 g = *(const f32x4*)(p.in[I_NFFN] + k), sh = *(const f32x4*)(mod + (size_t)b * 6 * D + 3 * D + k), sc = *(const f32x4*)(mod + (size_t)b * 6 * D + 4 * D + k);
                f32x4 o; o.x = x[tt][j].x * rstd * g.x * (1.f + sc.x) + sh.x; o.y = x[tt][j].y * rstd * g.y * (1.f + sc.y) + sh.y;
                o.z = x[tt][j].z * rstd * g.z * (1.f + sc.z) + sh.z; o.w = x[tt][j].w * rstd * g.w * (1.f + sc.w) + sh.w;
                *(f32x4*)(tb + ti * TB_LD + k) = o;
                u32x2 ob; ob.x = pk2(o.x, o.y); ob.y = pk2(o.z, o.w);
                *(u32x2*)(Tt + (size_t)tok * D + k) = ob;
            }
        }
        itn = it + gridDim.x;
        if (itn < T_LAT / 32) {
#pragma unroll
            for (int tt = 0; tt < 4; ++tt)
#pragma unroll
                for (int j = 0; j < D / 256; ++j) x[tt][j] = *(const f32x4*)(Hh + (size_t)(itn * 32 + wave * 4 + tt) * D + j * 256 + lane * 4);
        }
        LDS_BARRIER();
        f32x16 a0 = zero16(), a1 = zero16();
        {
            const int kbeg = wave * (D / 8);
            const float* arow = tb + r * TB_LD + kbeg + 4 * hh;
            const float* b0row = WRT + (size_t)(4 + r) * D + kbeg + 4 * hh;
            const float* b1row = WRT + (size_t)(r < 4 ? r : 0) * D + kbeg + 4 * hh;
            const float m1 = r < 4 ? 1.f : 0.f;
#pragma unroll 4
            for (int g = 0; g < D / 64; ++g) {
                const f32x4 av = *(const f32x4*)(arow + 8 * g), b0 = *(const f32x4*)(b0row + 8 * g); const f32x4 b1 = *(const f32x4*)(b1row + 8 * g) * m1;
                a0 = MFMA32F(av.x, b0.x, a0); a1 = MFMA32F(av.x, b1.x, a1); a0 = MFMA32F(av.y, b0.y, a0); a1 = MFMA32F(av.y, b1.y, a1);
                a0 = MFMA32F(av.z, b0.z, a0); a1 = MFMA32F(av.z, b1.z, a1); a0 = MFMA32F(av.w, b0.w, a0); a1 = MFMA32F(av.w, b1.w, a1);
            }
        }
        LDS_BARRIER();
        {
            float* part = tb + wave * (32 * 64);
#pragma unroll
            for (int g = 0; g < 16; ++g) { const int i = crow(g, hh); part[i * 64 + r] = a0[g]; part[i * 64 + 32 + r] = a1[g]; }
        }
        LDS_BARRIER();
        float lsum[4];
        {
            const int i = tid >> 4, c4 = (tid & 15) * 4;
#pragma unroll
            for (int e = 0; e < 4; ++e) { float sacc = 0.f;
#pragma unroll
                for (int w = 0; w < 8; ++w) sacc += tb[w * (32 * 64) + i * 64 + c4 + e];
                lsum[e] = sacc; }
        }
        LDS_BARRIER();
        { const int i = tid >> 4, c4 = (tid & 15) * 4;
#pragma unroll
          for (int e = 0; e < 4; ++e) tb[i * 64 + c4 + e] = lsum[e]; }
        LDS_BARRIER();
        int ex1 = 0, ex2 = 0, rk1 = 0, rk2 = 0; float w1 = 0.f, w2 = 0.f;
        if (tid < 32) {
            const float* L = tb + tid * 64;
            float gl[4];
#pragma unroll
            for (int i = 0; i < 4; ++i) gl[i] = L[32 + i] + bias[i];
            int g = 0; float mx = gl[0];
#pragma unroll
            for (int i = 1; i < 4; ++i) if (gl[i] > mx) { mx = gl[i]; g = i; }
            float se = 0.f;
#pragma unroll
            for (int i = 0; i < 4; ++i) se += fexp(gl[i] - mx);
            const float pg = 1.0f / se;
            int i1 = 0; float l1 = L[g * 8] + bias[4 + g * 8];
            for (int i = 1; i < 8; ++i) { const float v = L[g * 8 + i] + bias[4 + g * 8 + i]; if (v > l1) { l1 = v; i1 = i; } }
            int i2 = -1; float l2 = -3.0e38f;
            for (int i = 0; i < 8; ++i) { const float v = L[g * 8 + i] + bias[4 + g * 8 + i]; if (i != i1 && v > l2) { l2 = v; i2 = i; } }
            const float e2 = fexp(l2 - l1); w1 = pg / (1.f + e2); w2 = pg * e2 / (1.f + e2);
            ex1 = g * 8 + i1; ex2 = g * 8 + i2;
            rk1 = atomicAdd(&lcnt[ex1], 1); rk2 = atomicAdd(&lcnt[ex2], 1);
        }
        LDS_BARRIER();
        if (tid < 32) { const int c = lcnt[tid]; lbase[tid] = c ? atomicAdd(&cnt[tid * CNT_STRIDE], c) : 0; }
        __syncthreads();
        if (tid < 32) {
            const int tok = tok0 + tid;
            rowlist[(size_t)ex1 * CAP + lbase[ex1] + rk1] = tok * 2; pairw[tok * 2] = w1;
            rowlist[(size_t)ex2 * CAP + lbase[ex2] + rk2] = tok * 2 + 1; pairw[tok * 2 + 1] = w2;
        }
    }
}

constexpr int MOE_TM = USE_G8 ? 256 : BM;
DI void moe_tiles(const Params& p, char* smem, int* pre) {
    const int* cnt = (const int*)(p.ws + WS_CNT);
    __syncthreads();
    if (tid_x() == 0) { int s = 0; for (int e = 0; e < NEXP; ++e) { pre[e] = s; s += (cnt[e * CNT_STRIDE] + MOE_TM - 1) / MOE_TM; } pre[NEXP] = s; }
    __syncthreads();
}
DI void moe_up_tile(const Params& p, char* smem, const int* pre, int t) {
    const int* cnt = (const int*)(p.ws + WS_CNT); const int* rowlist = (const int*)(p.ws + WS_ROWLIST);
    const bf16_t* Tt = (const bf16_t*)(p.ws + WS_T); const bf16_t* GUT = (const bf16_t*)(p.aux + AUX_GUT); bf16_t* HID = (bf16_t*)(p.ws + WS_HID);
    const int mg = t >> 1, nt = t & 1; int e = 0;
    while (pre[e + 1] <= mg) ++e;
    const int mt = mg - pre[e], ce = cnt[e * CNT_STRIDE]; const int* rl = rowlist + (size_t)e * CAP;
    g8::Acc acc; g8::acc_zero(acc);
    g8::kloop_g(acc, smem, Tt, [&](int r) { int idx = mt * 256 + r; idx = idx < ce ? idx : ce - 1; return (rl[idx] >> 1) * D; }, GUT + ((size_t)e * 512 + nt * 256) * D, D, D, 0);
    const int t2 = tid_x(), wid = t2 >> 6, l2 = t2 & 63, wr2 = wid >> 2, wc2 = wid & 3, fr2 = l2 & 15, fq2 = l2 >> 4;
    int prs[2][4];
#pragma unroll
    for (int ai = 0; ai < 2; ++ai)
#pragma unroll
        for (int m = 0; m < 4; ++m) { const int idx = mt * 256 + ai * 128 + wr2 * 64 + m * 16 + fr2; prs[ai][m] = idx < ce ? rl[idx] : -1; }
#pragma unroll
    for (int ai = 0; ai < 2; ++ai)
#pragma unroll
        for (int m = 0; m < 4; ++m) {
            if (prs[ai][m] >= 0) {
                const int pair = prs[ai][m];
#pragma unroll
                for (int bj = 0; bj < 2; ++bj) {
                    const f32x4 g = acc[ai][bj][m][0], u = acc[ai][bj][m][1];
                    u32x2 o; o.x = pk2(fsilu(g.x) * u.x, fsilu(g.y) * u.y); o.y = pk2(fsilu(g.z) * u.z, fsilu(g.w) * u.w);
                    *(u32x2*)(HID + (size_t)pair * DE + nt * 128 + bj * 64 + wc2 * 16 + fq2 * 4) = o;
                }
            }
        }
}
DI void moe_down_tile(const Params& p, char* smem, const int* pre, int t) {
    constexpr int NT8 = D / 256;
    const int* cnt = (const int*)(p.ws + WS_CNT); const int* rowlist = (const int*)(p.ws + WS_ROWLIST); const float* pairw = (const float*)(p.ws + WS_PAIRW);
    const bf16_t* HID = (const bf16_t*)(p.ws + WS_HID); bf16_t* OP = (bf16_t*)(p.ws + WS_OPAIR);
    const int mg = t / NT8, nt = t % NT8; int e = 0;
    while (pre[e + 1] <= mg) ++e;
    const int mt = mg - pre[e], ce = cnt[e * CNT_STRIDE]; const int* rl = rowlist + (size_t)e * CAP;
    g8::Acc acc; g8::acc_zero(acc);
    g8::kloop_g(acc, smem, HID, [&](int r) { int idx = mt * 256 + r; idx = idx < ce ? idx : ce - 1; return rl[idx] * DE; }, DNT_PTR(p.ws, e) + (size_t)nt * 256 * DE, DE, DE, 0);
    {
        const int t2 = tid_x(), wid = t2 >> 6, l2 = t2 & 63, wr2 = wid >> 2, wc2 = wid & 3, fr2 = l2 & 15, fq2 = l2 >> 4;
        int prs[2][4]; float pws[2][4];
#pragma unroll
        for (int ai = 0; ai < 2; ++ai)
#pragma unroll
            for (int m = 0; m < 4; ++m) { const int idx = mt * 256 + ai * 128 + wr2 * 64 + m * 16 + fr2; prs[ai][m] = idx < ce ? rl[idx] : -1; }
#pragma unroll
        for (int ai = 0; ai < 2; ++ai)
#pragma unroll
            for (int m = 0; m < 4; ++m) pws[ai][m] = prs[ai][m] >= 0 ? pairw[prs[ai][m]] : 0.f;
#pragma unroll
        for (int ai = 0; ai < 2; ++ai)
#pragma unroll
            for (int m = 0; m < 4; ++m) {
                if (prs[ai][m] >= 0) {
                    const float w = pws[ai][m]; bf16_t* orow = OP + (size_t)prs[ai][m] * D + nt * 256 + wc2 * 32 + fq2 * 4;
#pragma unroll
                    for (int bj = 0; bj < 2; ++bj)
#pragma unroll
                        for (int n = 0; n < 2; ++n) { const f32x4 v = acc[ai][bj][m][n];
                            u32x2 o; o.x = pk2(v.x * w, v.y * w); o.y = pk2(v.z * w, v.w * w); *(u32x2*)(orow + bj * 128 + n * 16) = o; }
                }
            }
    }
}
DI void phase8(const Params& p, char* smem) {
    const int tid = tid_x(), lane = tid & 63, wave = tid >> 6, wr = wave >> 1, wc = wave & 1, fr = lane & 15, fq = lane >> 4;
    int* pre = (int*)(smem + LDS_BYTES - 256);
    moe_tiles(p, smem, pre);
    const int* cnt = (const int*)(p.ws + WS_CNT); const int* rowlist = (const int*)(p.ws + WS_ROWLIST);
    const bf16_t* Tt = (const bf16_t*)(p.ws + WS_T); const bf16_t* GUT = (const bf16_t*)(p.aux + AUX_GUT); bf16_t* HID = (bf16_t*)(p.ws + WS_HID);
    if (USE_G8) {
        if ((int)blockIdx.x < pre[NEXP] * 2) moe_up_tile(p, smem, pre, (int)blockIdx.x);
        return;
    }
    const int ntile = pre[NEXP] * 4;
    for (int t = blockIdx.x; t < ntile; t += gridDim.x) {
        const int mg = t >> 2, nt = t & 3; int e = 0;
        while (pre[e + 1] <= mg) ++e;
        const int mt = mg - pre[e], ce = cnt[e * CNT_STRIDE]; const int* rl = rowlist + (size_t)e * CAP;
        f32x4 acc[MREP][4]; acc_zero(acc);
        gemm_kloop(acc, smem, [&](int i) { int idx = mt * BM + i; idx = idx < ce ? idx : ce - 1; return Tt + (size_t)(rl[idx] >> 1) * D; }, GUT + ((size_t)e * 512 + nt * 128) * D, D, D);
#pragma unroll
        for (int m = 0; m < MREP; ++m)
#pragma unroll
            for (int j = 0; j < 4; ++j) {
                const int idx = mt * BM + wr * 16 * MREP + m * 16 + fq * 4 + j;
                if (idx < ce) {
                    const int pair = rl[idx];
#pragma unroll
                    for (int n = 0; n < 2; ++n) {
                        const float g = acc[m][n][j], u = acc[m][n + 2][j];
                        HID[(size_t)pair * DE + nt * 64 + wc * 32 + n * 16 + fr] = f2bf(siluf_(g) * u);
                    }
                }
            }
    }
}
DI void phase9(const Params& p, char* smem) {
    const int tid = tid_x(), lane = tid & 63, wave = tid >> 6, wr = wave >> 1, wc = wave & 1, fr = lane & 15, fq = lane >> 4;
    int* pre = (int*)(smem + LDS_BYTES - 256);
    moe_tiles(p, smem, pre);
    const int* cnt = (const int*)(p.ws + WS_CNT); const int* rowlist = (const int*)(p.ws + WS_ROWLIST); const float* pairw = (const float*)(p.ws + WS_PAIRW);
    const bf16_t* HID = (const bf16_t*)(p.ws + WS_HID); const bf16_t* DNT = (const bf16_t*)(p.ws + WS_DNT); bf16_t* OP = (bf16_t*)(p.ws + WS_OPAIR);
    if (USE_G8) {
        constexpr int NT8 = D / 256;
        const int G = (int)gridDim.x, NU = pre[NEXP] * 2, NU2 = NU > G ? NU - G : 0, ND = pre[NEXP] * NT8;
        int* cntw = (int*)(p.ws + WS_CNT);
        int* tk = (int*)(smem + LDS_BYTES - 512);
        for (;;) {
            __syncthreads();
            if (tid_x() == 0) *tk = atomicAdd(&cntw[CNT_TICKET], 1);
            __syncthreads();
            const int j = *tk;
            if (j >= NU2 + ND) break;
            if (j < NU2) {
                moe_up_tile(p, smem, pre, G + j);
#ifndef EMU
                asm volatile("s_waitcnt vmcnt(0)" ::: "memory");
#endif
                __syncthreads();
                if (tid_x() == 0) {
#ifndef EMU
                    __builtin_amdgcn_fence(__ATOMIC_RELEASE, "agent");
                    asm volatile("s_waitcnt vmcnt(0)" ::: "memory");
#endif
                    (void)atomicAdd(&cntw[CNT_U2DONE], 1);
                }
            } else {
                const int dt = j - NU2;
                if (2 * (dt / NT8) + 1 >= G) {
                    if (tid_x() == 0) {
#ifndef EMU
                        while (__hip_atomic_load(&cntw[CNT_U2DONE], __ATOMIC_RELAXED, __HIP_MEMORY_SCOPE_AGENT) < NU2) __builtin_amdgcn_s_sleep(2);
                        __builtin_amdgcn_fence(__ATOMIC_ACQUIRE, "agent");
                        asm volatile("s_waitcnt vmcnt(0)" ::: "memory");
#endif
                    }
                    __syncthreads();
                }
                moe_down_tile(p, smem, pre, dt);
            }
        }
        return;
    }
    constexpr int NT = D / 128;
    const int ntile = pre[NEXP] * NT;
    for (int t = blockIdx.x; t < ntile; t += gridDim.x) {
        const int mg = t / NT, nt = t % NT; int e = 0;
        while (pre[e + 1] <= mg) ++e;
        const int mt = mg - pre[e], ce = cnt[e * CNT_STRIDE]; const int* rl = rowlist + (size_t)e * CAP;
        f32x4 acc[MREP][4]; acc_zero(acc);
        gemm_kloop(acc, smem, [&](int i) { int idx = mt * BM + i; idx = idx < ce ? idx : ce - 1; return HID + (size_t)rl[idx] * DE; }, DNT_PTR(p.ws, e) + (size_t)nt * 128 * DE, DE, DE);
#pragma unroll
        for (int m = 0; m < MREP; ++m)
#pragma unroll
            for (int j = 0; j < 4; ++j) {
                const int idx = mt * BM + wr * 16 * MREP + m * 16 + fq * 4 + j;
                if (idx < ce) {
                    const int pair = rl[idx]; const float w = pairw[pair];
#pragma unroll
                    for (int n = 0; n < 4; ++n) OP[(size_t)pair * D + nt * 128 + wc * 64 + n * 16 + fr] = f2bf(acc[m][n][j] * w);
                }
            }
    }
}

DI void phase10(const Params& p, char* smem) {
    const int lane = tid_x() & 63, wave = tid_x() >> 6;
    const int gw = blockIdx.x * 8 + wave, ngw = gridDim.x * 8;
    const float* Hh = (const float*)(p.ws + WS_H); const float* mod = (const float*)(p.ws + WS_MOD); const bf16_t* OP = (const bf16_t*)(p.ws + WS_OPAIR);
    for (int tok = gw; tok < T_LAT; tok += ngw) {
        const int b = tok / S;
        f32x4 x[D / 256]; float ss = 0.f;
#pragma unroll
        for (int j = 0; j < D / 256; ++j) {
            const int k = j * 256 + lane * 4;
            const f32x4 hv = *(const f32x4*)(Hh + (size_t)tok * D + k), g2 = *(const f32x4*)(mod + (size_t)b * 6 * D + 5 * D + k);
            const u32x2 p0 = *(const u32x2*)(OP + (size_t)(tok * 2) * D + k), p1 = *(const u32x2*)(OP + (size_t)(tok * 2 + 1) * D + k);
            f32x4 m;
            m.x = bf2f((bf16_t)(p0.x & 0xffffu)) + bf2f((bf16_t)(p1.x & 0xffffu)); m.y = bf2f((bf16_t)(p0.x >> 16)) + bf2f((bf16_t)(p1.x >> 16));
            m.z = bf2f((bf16_t)(p0.y & 0xffffu)) + bf2f((bf16_t)(p1.y & 0xffffu)); m.w = bf2f((bf16_t)(p0.y >> 16)) + bf2f((bf16_t)(p1.y >> 16));
            x[j].x = hv.x + g2.x * m.x; x[j].y = hv.y + g2.y * m.y; x[j].z = hv.z + g2.z * m.z; x[j].w = hv.w + g2.w * m.w;
            ss += x[j].x * x[j].x + x[j].y * x[j].y + x[j].z * x[j].z + x[j].w * x[j].w;
        }
        ss = wave_sum(ss);
        const float rstd = 1.0f / sqrtf(ss * (1.0f / D) + 1e-6f);
#pragma unroll
        for (int j = 0; j < D / 256; ++j) {
            const int k = j * 256 + lane * 4; const f32x4 g = *(const f32x4*)(p.in[I_FIN] + k);
            f32x4 o; o.x = x[j].x * rstd * g.x; o.y = x[j].y * rstd * g.y; o.z = x[j].z * rstd * g.z; o.w = x[j].w * rstd * g.w;
            *(f32x4*)(p.out + (size_t)tok * D + k) = o;
        }
    }
}

DI void run_phase(const Params& p, int ph, char* smem) {
    switch (ph) {
        case PH_MOD: phase0(p, smem); break;
        case PH_U: phase1(p, smem); break;
        case PH_P: phase2(p, smem); break;
        case PH_HALO: phase_halo(p, smem); break;
        case PH_FIR: phase_fir(p, smem); break;
        case PH_CHAINS: phase3(p, smem); break;
        case PH_POST: phase4(p, smem); break;
        case PH_MERGE: phase5(p, smem); break;
        case PH_WOUT: phase6(p, smem); break;
        case PH_ROUTER: phase7(p, smem); break;
        case PH_UP: phase8(p, smem); break;
        case PH_DOWN: phase9(p, smem); break;
        default: phase10(p, smem); break;
    }
}

#ifndef EMU
namespace cg = cooperative_groups;
#define XB_TMO      128
#define XB_XCNT(j)  (256  + 64 * (j))
#define XB_XSUB(j)  (1280 + 64 * (j))
#define XB_XGEN(j)  (2304 + 64 * (j))
#define XB_TOP      3328
#define XB_TOPGEN   3392
#define XB_SPIN_CAP (1u << 20)
DI unsigned xb_ld(unsigned* p) { return __hip_atomic_load(p, __ATOMIC_RELAXED, __HIP_MEMORY_SCOPE_AGENT); }
DI unsigned xb_add(unsigned* p, unsigned v) { return __hip_atomic_fetch_add(p, v, __ATOMIC_RELAXED, __HIP_MEMORY_SCOPE_AGENT); }
DI unsigned xb_xcc_id() { return (unsigned)__builtin_amdgcn_s_getreg((3 << 11) | 20) & 0xFu; }
#define XB_SPIN(cond, bar) do { unsigned _sp = 0; while (cond) { __builtin_amdgcn_s_sleep(1); \
    if ((++_sp & 255u) == 0u) { if (xb_ld(&(bar)[XB_TMO])) break; if (_sp > XB_SPIN_CAP) { atomicAdd(&(bar)[XB_TMO], 1u); break; } } } } while (0)
DI void xcd_barrier_post(unsigned* bar) { if (threadIdx.x == 0) (void)xb_add(&bar[XB_XCNT(xb_xcc_id())], 1u); }
DI void xcd_barrier_complete(unsigned* bar, unsigned x, unsigned& nloc, unsigned& nx) {
    const unsigned G = gridDim.x;
    unsigned sum, cnt, mine, sp = 0u;
    for (;;) {
        sum = 0u; cnt = 0u; mine = 0u;
#pragma unroll
        for (unsigned j = 0; j < 16; ++j) { const unsigned c = xb_ld(&bar[XB_XCNT(j)]); sum += c; cnt += (c > 0u) ? 1u : 0u; mine = (j == x) ? c : mine; }
        if (sum == G) break;
        __builtin_amdgcn_s_sleep(1);
        if ((++sp & 255u) == 0u) { if (xb_ld(&bar[XB_TMO])) break; if (sp > XB_SPIN_CAP) { atomicAdd(&bar[XB_TMO], 1u); break; } }
    }
    nloc = mine > 0u ? mine : 1u; nx = cnt > 0u ? cnt : 1u;
}
DI void xcd_barrier(unsigned* bar, volatile unsigned* st) {
    asm volatile("s_waitcnt vmcnt(0)" ::: "memory");
    __syncthreads();
    if (threadIdx.x == 0) {
        __builtin_amdgcn_s_waitcnt(0);
        const unsigned x = xb_xcc_id();
        unsigned nloc = st[0], nx = st[1];
        if (nloc == 0u) { xcd_barrier_complete(bar, x, nloc, nx); st[0] = nloc; st[1] = nx; }
        const unsigned old = xb_add(&bar[XB_XSUB(x)], 1u);
        const unsigned gen = old / nloc;
        if (old + 1u == (gen + 1u) * nloc) {
            __builtin_amdgcn_fence(__ATOMIC_RELEASE, "agent");
            asm volatile("s_waitcnt vmcnt(0)" ::: "memory");
            const unsigned og = xb_add(&bar[XB_TOP], 1u);
            const unsigned tg = og / nx;
            if (og + 1u == (tg + 1u) * nx) xb_add(&bar[XB_TOPGEN], 1u);
            else XB_SPIN(xb_ld(&bar[XB_TOPGEN]) == tg, bar);
            __builtin_amdgcn_fence(__ATOMIC_ACQUIRE, "agent");
            xb_add(&bar[XB_XGEN(x)], 1u);
            asm volatile("s_waitcnt vmcnt(0)" ::: "memory");
        } else {
            XB_SPIN(xb_ld(&bar[XB_XGEN(x)]) == gen, bar);
            __builtin_amdgcn_fence(__ATOMIC_ACQUIRE, "agent");
            asm volatile("s_waitcnt vmcnt(0)" ::: "memory");
        }
    }
    __syncthreads();
}
__global__ void __launch_bounds__(NTHREADS) mk_forward(Params p) {
    extern __shared__ __attribute__((aligned(16))) char smem[];
    typedef const Params __attribute__((address_space(4)))* KPtr;
    volatile unsigned* xst = (volatile unsigned*)(smem + LDS_BYTES);
    if (threadIdx.x < 2) xst[threadIdx.x] = 0u;
    xcd_barrier_post((unsigned*)(p.ws + WS_XBAR));
#define PHASE(k, fn) { KPtr kp = (KPtr)__builtin_amdgcn_kernarg_segment_ptr(); asm volatile("" : "+s"(kp)); fn(*(const Params*)kp, smem); \
        unsigned* xbar = (unsigned*)(((const Params*)kp)->ws + WS_XBAR); \
        if ((k) + 1 < NPHASES) xcd_barrier(xbar, xst); }
    PHASE(0, phase0) PHASE(1, phase1) PHASE(2, phase2)
    if (!USE_G8) PHASE(3, phase_halo)
    PHASE(4, phase_fir) PHASE(5, phase3) PHASE(6, phase4)
    PHASE(7, phase5) PHASE(8, phase6) PHASE(9, phase7) PHASE(10, phase8) PHASE(11, phase9) PHASE(12, phase10)
#undef PHASE
}

extern "C" void kernel_launch(void* const* d_in, const int* in_sizes, int n_in, void* d_out, int out_size, void* d_ws, size_t ws_size, hipStream_t stream) {
    static int grid_blocks = 0;
    if (grid_blocks == 0) {
        if (n_in != 35 || out_size != T_LAT * D || ws_size < WS_END || (size_t)out_size * 4 < AUX_END) {
            fprintf(stderr, "kernel_launch: unexpected shapes (n_in %d out %d ws %zu need %zu aux need %zu)\n", n_in, out_size, ws_size, (size_t)WS_END, (size_t)AUX_END);
            grid_blocks = -1; return;
        }
        int dev = 0, cus = 0, per_cu = 0;
        hipGetDevice(&dev);
        hipDeviceGetAttribute(&cus, hipDeviceAttributeMultiprocessorCount, dev);
        hipFuncSetAttribute((const void*)mk_forward, hipFuncAttributeMaxDynamicSharedMemorySize, LDS_BYTES + 256);
        hipOccupancyMaxActiveBlocksPerMultiprocessor(&per_cu, (const void*)mk_forward, NTHREADS, LDS_BYTES + 256);
        if (per_cu < 1) { fprintf(stderr, "kernel_launch: occupancy query says %d blocks/CU\n", per_cu); per_cu = 1; }
        if (per_cu > 1) per_cu = 1;
        grid_blocks = cus * per_cu;
    }
    if (grid_blocks < 0) return;
    Params p{};
    for (int i = 0; i < 35; ++i) p.in[i] = (const float*)d_in[i];
    p.out = (float*)d_out; p.ws = (char*)d_ws; p.aux = (char*)d_out;
    p.ph_lo = 0; p.ph_hi = NPHASES;
    (void)hipMemsetAsync((char*)d_ws + WS_XBAR, 0, 3456 * 4, stream);
    void* args[] = {&p};
    hipError_t e = hipLaunchCooperativeKernel((const void*)mk_forward, dim3(grid_blocks), dim3(NTHREADS), args, LDS_BYTES + 256, stream);
    if (e != hipSuccess) fprintf(stderr, "cooperative launch failed: %s (grid %d)\n", hipGetErrorString(e), grid_blocks);
}
#endif
```

```cpp
#ifndef EMU
#include <hip/hip_runtime.h>
#include <hip/hip_cooperative_groups.h>
#include <cstdio>
#endif
#include <stdint.h>
#include <stddef.h>

#ifndef CFG_D
#define CFG_D 1024
#define CFG_B 8
#define CFG_S 2048
#define CFG_CTX 256
#endif
#ifndef MK_LAUNCHES
#define MK_LAUNCHES 1
#endif

typedef unsigned short bf16_t;
typedef short bf16x8 __attribute__((ext_vector_type(8)));
typedef float f32x4 __attribute__((ext_vector_type(4)));
typedef unsigned u32x4 __attribute__((ext_vector_type(4)));
typedef unsigned u32x2 __attribute__((ext_vector_type(2)));

#define DI __device__ __forceinline__
DI int tid_x() { int t = (int)threadIdx.x;
#ifndef EMU
    asm volatile("" : "+v"(t));
#endif
    return t; }

constexpr int D = CFG_D, NB = CFG_B, S = CFG_S, CTXL = CFG_CTX;
constexpr int GW = 64, ROWS = S / GW;
constexpr int T_CTX = NB * CTXL, T_LAT = NB * S, T_ALL = T_CTX + T_LAT;
constexpr int H_A = 4, H_B = 8;
constexpr int A_COLS = 2064, B_COLS = 1920;
constexpr int IN_COLS = A_COLS + B_COLS + 2 * D;
constexpr int COL_B0 = A_COLS, COL_G0 = A_COLS + B_COLS;
constexpr int CTX_COLS = COL_G0;
constexpr int NP = ((IN_COLS + 127) / 128) * 128;
constexpr int NEXP = 32, DE = 256;
constexpr int NV = NB + 1;
constexpr int NTHREADS = 512;
constexpr int MREP = (T_CTX % 256 == 0 && T_LAT % 256 == 0) ? 4 : 2;
constexpr int BM = 64 * MREP;
constexpr int NPHASES = 13;
enum { PH_MOD = 0, PH_U, PH_P, PH_HALO, PH_FIR, PH_CHAINS, PH_POST, PH_MERGE, PH_WOUT, PH_ROUTER, PH_UP, PH_DOWN, PH_FINAL };
constexpr int LDS_BYTES = 155648;
constexpr int CAP = T_LAT;

static_assert(D % 256 == 0 && S % 64 == 0 && CTXL % 64 == 0 && T_CTX % BM == 0 && T_LAT % BM == 0, "shape");

constexpr size_t al256(size_t x) { return (x + 255) & ~(size_t)255; }
constexpr int CNT_STRIDE = 64;
constexpr size_t WS_CNT = 512 + 3456 * 4 + 256;
constexpr int CNT_TICKET = 2 * CNT_STRIDE + 16, CNT_U2DONE = 3 * CNT_STRIDE + 16;
constexpr size_t WS_BAR = 256;
constexpr size_t WS_XBAR = 512;
constexpr size_t WS_MOD = 512 + 3456 * 4 + 256 + 32 * 64 * 4;
constexpr size_t WS_AB = al256(WS_MOD + (size_t)NV * 6 * D * 4);
constexpr size_t WS_BONUS = al256(WS_AB + (size_t)T_ALL * 16 * 4);
constexpr size_t WS_PAIRW = al256(WS_BONUS + (size_t)2 * T_LAT * 8 * 4);
constexpr size_t WS_ROWLIST = al256(WS_PAIRW + (size_t)T_LAT * 2 * 4);
constexpr size_t WS_WRT = al256(WS_ROWLIST + (size_t)NEXP * CAP * 4);
constexpr size_t WS_G2T = al256(WS_WRT + (size_t)36 * D * 4);
constexpr size_t WS_WOA = al256(WS_G2T + (size_t)512 * 128 * 2);
constexpr size_t WS_WOB = al256(WS_WOA + (size_t)D * 512 * 2);
constexpr size_t WS_WOUT = al256(WS_WOB + (size_t)D * 512 * 2);
constexpr size_t WS_OA = al256(WS_WOUT + (size_t)D * D * 2);
constexpr size_t WS_OB = al256(WS_OA + (size_t)T_LAT * 512 * 2);
constexpr size_t WS_HALO_A = WS_OA;
constexpr size_t WS_HALO_B = WS_OA + al256((size_t)(T_ALL / 64) * 4 * 1536 * 2);
static_assert(WS_HALO_B + (size_t)(T_ALL / 64) * 2 * 1920 * 2 <= WS_OB + (size_t)T_LAT * 512 * 2, "halo buffers");
constexpr size_t WS_DNT = WS_OA;
constexpr size_t WS_SPARE_END = al256(WS_OB + (size_t)T_LAT * 512 * 2) > al256(WS_DNT + (size_t)NEXP * D * DE * 2) ? al256(WS_OB + (size_t)T_LAT * 512 * 2) : al256(WS_DNT + (size_t)NEXP * D * DE * 2);
constexpr size_t WS_P = WS_SPARE_END;
constexpr size_t WS_PLAT = WS_P;
constexpr size_t WS_PCTX = al256(WS_PLAT + (size_t)T_LAT * IN_COLS * 2);
constexpr size_t WS_P_END = al256(WS_PCTX + (size_t)T_CTX * CTX_COLS * 2);
constexpr size_t WS_H = WS_P;
constexpr size_t WS_T = al256(WS_H + (size_t)T_LAT * D * 4);
constexpr size_t WS_HID = al256(WS_T + (size_t)T_LAT * D * 2);
constexpr size_t WS_OPAIR = al256(WS_HID + (size_t)T_LAT * 2 * DE * 2);
constexpr size_t WS_P2_END = al256(WS_OPAIR + (size_t)T_LAT * 2 * D * 2);
constexpr size_t WS_END0 = WS_P_END > WS_P2_END ? WS_P_END : WS_P2_END;
constexpr size_t WS_GUARANTEED = (size_t)256 << 20;
constexpr int NE_EARLY = WS_END0 >= WS_GUARANTEED ? 0 : ((WS_GUARANTEED - WS_END0) / ((size_t)D * DE * 2) >= (size_t)NEXP ? NEXP : (int)((WS_GUARANTEED - WS_END0) / ((size_t)D * DE * 2)));
constexpr size_t WS_DNT2 = WS_END0;
constexpr size_t WS_END = WS_DNT2 + (size_t)NE_EARLY * D * DE * 2;
constexpr size_t AUX_WINT = 0;
constexpr size_t AUX_U = al256((size_t)NP * D * 2);
constexpr size_t AUX_YDIR = 0;
constexpr size_t AUX_Y = 0;
constexpr size_t AUX_GUT = (size_t)T_LAT * D * 2 > (size_t)2 * T_LAT * 512 * 2 ? (size_t)T_LAT * D * 2 : (size_t)2 * T_LAT * 512 * 2;
constexpr size_t AUX_END1 = AUX_U + (size_t)T_ALL * D * 2;
constexpr size_t AUX_END2 = AUX_YDIR + (size_t)2 * T_LAT * 512 * 2;
static_assert(AUX_YDIR + (size_t)2 * T_LAT * 512 * 2 <= AUX_GUT && AUX_Y + (size_t)T_LAT * D * 2 <= AUX_GUT, "aux overlap");
constexpr size_t AUX_END3 = AUX_GUT + (size_t)NEXP * 512 * D * 2;
constexpr size_t AUX_END = (AUX_END1 > AUX_END2 ? (AUX_END1 > AUX_END3 ? AUX_END1 : AUX_END3) : (AUX_END2 > AUX_END3 ? AUX_END2 : AUX_END3));

#define DNT_PTR(ws, e) ((bf16_t*)((ws) + ((e) < NE_EARLY ? WS_DNT2 : WS_DNT)) + (size_t)(e) * D * DE)
struct Params {
    const float* in[35];
    float* out;
    char* ws;
    char* aux;
    int ph_lo, ph_hi;
};
enum { I_X = 0, I_C, I_CTX, I_CCTX, I_ADAW, I_ADAB, I_NMIX, I_NFFN, I_WIN, I_CONV, I_ALOG, I_DTB, I_ONORM, I_MU, I_W0, I_W2, I_A0, I_A2, I_G2, I_KK, I_KA, I_RK, I_LNG, I_LNB, I_WOA, I_WOB, I_WOUT, I_RG, I_RGB, I_RE, I_REB, I_MG, I_MU_UP, I_MD, I_FIN };

DI float bf2f(bf16_t v) { union { unsigned u; float f; } x; x.u = ((unsigned)v) << 16; return x.f; }
#ifdef EMU
DI bf16_t f2bf(float f) { union { float f; unsigned u; } x; x.f = f; unsigned u = x.u; u += 0x7fffu + ((u >> 16) & 1u); return (bf16_t)(u >> 16); }
DI unsigned pk2(float lo, float hi) { return (unsigned)f2bf(lo) | ((unsigned)f2bf(hi) << 16); }
#else
typedef __bf16 hbf16x2 __attribute__((ext_vector_type(2)));
typedef float f32x2_ __attribute__((ext_vector_type(2)));
DI bf16_t f2bf(float f) { return __builtin_bit_cast(unsigned short, (__bf16)f); }
DI unsigned pk2(float lo, float hi) { const f32x2_ v = {lo, hi}; return __builtin_bit_cast(unsigned, __builtin_convertvector(v, hbf16x2)); }
#endif
DI float sigmoidf_(float x) { return 1.0f / (1.0f + expf(-x)); }
DI float siluf_(float x) { return x / (1.0f + expf(-x)); }
DI float softplusf_(float x) { return x > 20.f ? x : log1pf(expf(x)); }
DI float wave_sum(float v) {
#pragma unroll
    for (int o = 1; o < 64; o <<= 1) v += __shfl_xor(v, o);
    return v;
}
#ifdef EMU
#define MFMA16(a, b, c) emu_mfma16((a), (b), (c))
#define WAVE_SYNC() emu::wave_bar()
#else
#define MFMA16(a, b, c) __builtin_amdgcn_mfma_f32_16x16x32_bf16((a), (b), (c), 0, 0, 0)
#define WAVE_SYNC() asm volatile("s_waitcnt lgkmcnt(0)" ::: "memory")
#endif
#ifdef EMU
#define SETPRIO(x)
#else
#define SETPRIO(x) __builtin_amdgcn_s_setprio(x)
#endif
#ifdef EMU
#define LDS_BARRIER() __syncthreads()
#else
#define LDS_BARRIER() do { asm volatile("s_waitcnt lgkmcnt(0)" ::: "memory"); __builtin_amdgcn_s_barrier(); asm volatile("" ::: "memory"); } while (0)
#endif

typedef float f32x16 __attribute__((ext_vector_type(16)));
typedef float f32x2_ac __attribute__((ext_vector_type(2)));
typedef short bf16x4 __attribute__((ext_vector_type(4)));
#ifdef EMU
#define MFMA32(a, b, c) emu_mfma32((a), (b), (c))
DI float fexp(float x) { return expf(x); }
DI float flog(float x) { return logf(x); }
DI float frcp(float x) { return 1.0f / x; }
DI float frsq(float x) { return 1.0f / sqrtf(x); }
DI float wave_sum_fast(float v) { return wave_sum(v); }
#else
#define MFMA32(a, b, c) __builtin_amdgcn_mfma_f32_32x32x16_bf16((a), (b), (c), 0, 0, 0)
DI float fexp(float x) { return __expf(x); }
DI float flog(float x) { return __logf(x); }
DI float frcp(float x) { return __builtin_amdgcn_rcpf(x); }
DI float frsq(float x) { return __builtin_amdgcn_rsqf(x); }
#define DPP_ADD(v, ctrl) ((v) + __builtin_bit_cast(float, __builtin_amdgcn_update_dpp(0, __builtin_bit_cast(int, (v)), (ctrl), 0xf, 0xf, false)))
DI float wave_sum_fast(float v) {
    v = DPP_ADD(v, 0xB1); v = DPP_ADD(v, 0x4E); v = DPP_ADD(v, 0x141); v = DPP_ADD(v, 0x140);
    const int iv = __builtin_bit_cast(int, v);
    return (__builtin_bit_cast(float, __builtin_amdgcn_readlane(iv, 0)) + __builtin_bit_cast(float, __builtin_amdgcn_readlane(iv, 16))) +
           (__builtin_bit_cast(float, __builtin_amdgcn_readlane(iv, 32)) + __builtin_bit_cast(float, __builtin_amdgcn_readlane(iv, 48)));
}
#endif
DI float fsigmoid(float x) { return frcp(1.0f + fexp(-x)); }
DI float fsilu(float x) { return x * fsigmoid(x); }
DI float fsoftplus(float x) { return fmaxf(x, 0.f) + flog(1.f + fexp(-fabsf(x))); }
DI float ftanh(float x) { return 1.0f - 2.0f * frcp(1.0f + fexp(2.0f * x)); }

constexpr int LDS_ROW = 40;
constexpr int GEMM_A_BYTES = BM * LDS_ROW * 2, GEMM_B_BYTES = 128 * LDS_ROW * 2;
template <int MR, class ARow>
DI void gemm_kloop(f32x4 (&acc)[MR][4], char* smem, ARow arow, const bf16_t* Bt, int ldb, int K) {
    constexpr int BM = 64 * MR;
    const int tid = tid_x(), lane = tid & 63, wave = tid >> 6, wr = wave >> 1, wc = wave & 1, fr = lane & 15, fq = lane >> 4;
    bf16_t* As = (bf16_t*)smem;
    bf16_t* Bs = (bf16_t*)(smem + 2 * GEMM_A_BYTES);
    constexpr int ACH = BM * 4 / NTHREADS;
    static_assert(ACH >= 1, "tile");
    const bf16_t* ap[ACH];
#pragma unroll
    for (int i = 0; i < ACH; ++i) { const int q = tid + i * NTHREADS; ap[i] = arow(q >> 2) + (q & 3) * 8; }
    const bf16_t* bp = Bt + (size_t)(tid >> 2) * ldb + (tid & 3) * 8;
    u32x4 ra[ACH], rb;
#pragma unroll
    for (int i = 0; i < ACH; ++i) ra[i] = *(const u32x4*)(ap[i]);
    rb = *(const u32x4*)(bp);
    const int nk = K / 32;
    for (int kt = 0; kt < nk; ++kt) {
        const int buf = kt & 1;
#pragma unroll
        for (int i = 0; i < ACH; ++i) { const int q = tid + i * NTHREADS; *(u32x4*)(As + (buf * BM + (q >> 2)) * LDS_ROW + (q & 3) * 8) = ra[i]; }
        *(u32x4*)(Bs + (buf * 128 + (tid >> 2)) * LDS_ROW + (tid & 3) * 8) = rb;
        __syncthreads();
        if (kt + 1 < nk) {
#pragma unroll
            for (int i = 0; i < ACH; ++i) ra[i] = *(const u32x4*)(ap[i] + (kt + 1) * 32);
            rb = *(const u32x4*)(bp + (kt + 1) * 32);
        }
        bf16x8 af[MR], bfr[4];
#pragma unroll
        for (int m = 0; m < MR; ++m) af[m] = *(const bf16x8*)(As + (buf * BM + wr * 16 * MR + m * 16 + fr) * LDS_ROW + fq * 8);
#pragma unroll
        for (int n = 0; n < 4; ++n) bfr[n] = *(const bf16x8*)(Bs + (buf * 128 + wc * 64 + n * 16 + fr) * LDS_ROW + fq * 8);
#pragma unroll
        for (int m = 0; m < MR; ++m)
#pragma unroll
            for (int n = 0; n < 4; ++n) acc[m][n] = MFMA16(af[m], bfr[n], acc[m][n]);
    }
    __syncthreads();
}
template <int MR>
DI void acc_zero(f32x4 (&acc)[MR][4]) {
#pragma unroll
    for (int m = 0; m < MR; ++m)
#pragma unroll
        for (int n = 0; n < 4; ++n) acc[m][n] = (f32x4){0.f, 0.f, 0.f, 0.f};
}

namespace g8 {
constexpr int BM = 256, BK = 64, HALF = 128, HT = HALF * BK;
constexpr int LDS_NEED = 8 * HT * 2;
DI int lds_byte(int r, int c) { const int st = (r >> 4) * 2 + (c >> 5), rr = r & 15, cc = c & 31, ob = rr * 64 + cc * 2; return st * 1024 + (ob ^ (((ob >> 9) & 1) << 5)); }
DI void stage_rc(int b, int& R, int& C) { const int st = b / 1024, sb = b % 1024, swz = sb ^ (((sb >> 9) & 1) << 5); R = (st >> 1) * 16 + swz / 64; C = (st & 1) * 32 + (swz % 64) / 2; }
#ifdef EMU
#define G8_GLDS(src, dst) emu_global_load_lds16((src), (dst))
#define G8_WAIT_V(n)
#define G8_WAIT_L(n)
#define G8_BAR __syncthreads()
#define G8_SCHED
#define G8_PRIO(x)
#else
#define G8_GLDS(src, dst) __builtin_amdgcn_global_load_lds((const unsigned*)(src), (__attribute__((address_space(3))) unsigned*)(dst), 16, 0, 0)
#define G8_WAIT_V(n) asm volatile("s_waitcnt vmcnt(" #n ")" ::: "memory")
#define G8_WAIT_L(n) asm volatile("s_waitcnt lgkmcnt(" #n ")" ::: "memory")
#define G8_BAR __builtin_amdgcn_s_barrier()
#define G8_SCHED __builtin_amdgcn_sched_barrier(0)
#define G8_PRIO(x) __builtin_amdgcn_s_setprio(x)
#endif
typedef f32x4 Acc[2][2][4][2];
template <class AOff>
DI void kloop_g(Acc& acc, char* smem, const bf16_t* A, AOff aoff, const bf16_t* Bt, int ldb, int K, int bcol) {
    bf16_t* shm = (bf16_t*)smem;
    const int tid = tid_x(), wid = tid >> 6, lane = tid & 63, wr = wid >> 2, wc = wid & 3, fr = lane & 15, fq = lane >> 4;
    int ao[2][2];
#pragma unroll
    for (int h = 0; h < 2; ++h)
#pragma unroll
        for (int i = 0; i < 2; ++i) { int R, C; stage_rc(tid * 16 + i * 8192, R, C); ao[h][i] = aoff(h * HALF + R) + C; }
#define G8_STAGE_A(P, h, kt) do { for (int _i = 0; _i < 2; ++_i) { const int _b = tid * 16 + _i * 8192; G8_GLDS(A + (size_t)ao[h][_i] + (size_t)(kt) * BK, (char*)(P) + _b); } } while (0)
#define G8_SA(b, h) (shm + ((b) * 2 + (h)) * HT)
#define G8_SB(b, h) (shm + (4 + (b) * 2 + (h)) * HT)
#define G8_STAGE(P, BASE, LD, br, kt) do { const bf16_t* _g = (BASE) + (size_t)(br) * (LD) + (size_t)(kt) * BK; \
    for (int _i = 0; _i < 2; ++_i) { const int _b = tid * 16 + _i * 8192; int _r, _c; stage_rc(_b, _r, _c); G8_GLDS(_g + (size_t)_r * (LD) + _c, (char*)(P) + _b); } } while (0)
#define G8_LDA(dst, b, h) for (int m = 0; m < 4; ++m) for (int k = 0; k < 2; ++k) dst[m][k] = *(const bf16x8*)((const char*)G8_SA(b, h) + lds_byte(wr * 64 + m * 16 + fr, k * 32 + fq * 8))
#define G8_LDB(dst, b, h) for (int n = 0; n < 2; ++n) for (int k = 0; k < 2; ++k) dst[n][k] = *(const bf16x8*)((const char*)G8_SB(b, h) + lds_byte(wc * 32 + n * 16 + fr, k * 32 + fq * 8))
#define G8_MMA(ai, bj, At_, Bt_) do { G8_PRIO(1); for (int m = 0; m < 4; ++m) for (int n = 0; n < 2; ++n) for (int k = 0; k < 2; ++k) \
    acc[ai][bj][m][n] = MFMA16(Bt_[n][k], At_[m][k], acc[ai][bj][m][n]); G8_PRIO(0); } while (0)
    bf16x8 At[4][2], B0[2][2], B1[2][2];
    const int nt = K / BK;
    G8_STAGE(G8_SB(0, 0), Bt, ldb, bcol, 0); G8_STAGE_A(G8_SA(0, 0), 0, 0);
    G8_STAGE(G8_SB(0, 1), Bt, ldb, bcol + HALF, 0); G8_STAGE_A(G8_SA(0, 1), 1, 0);
    if (wr == 1) G8_BAR;
    G8_WAIT_V(4); G8_BAR;
    G8_STAGE(G8_SB(1, 0), Bt, ldb, bcol, 1); G8_STAGE_A(G8_SA(1, 0), 0, 1); G8_STAGE(G8_SB(1, 1), Bt, ldb, bcol + HALF, 1);
    G8_WAIT_V(6); G8_BAR;
    for (int t = 0; t < nt - 2; t += 2) {
        G8_LDB(B0, 0, 0); G8_SCHED; G8_LDA(At, 0, 0); G8_STAGE_A(G8_SA(1, 1), 1, t + 1);
        G8_WAIT_L(8); G8_BAR; G8_WAIT_L(0); G8_MMA(0, 0, At, B0); G8_BAR; G8_SCHED;
        G8_LDB(B1, 0, 1); G8_STAGE(G8_SB(0, 0), Bt, ldb, bcol, t + 2);
        G8_BAR; G8_WAIT_L(0); G8_MMA(0, 1, At, B1); G8_BAR;
        G8_LDA(At, 0, 1); G8_STAGE_A(G8_SA(0, 0), 0, t + 2);
        G8_BAR; G8_WAIT_L(0); G8_MMA(1, 0, At, B0); G8_BAR; G8_SCHED;
        G8_STAGE(G8_SB(0, 1), Bt, ldb, bcol + HALF, t + 2);
        G8_WAIT_V(6); G8_BAR; G8_MMA(1, 1, At, B1); G8_BAR;
        G8_LDB(B0, 1, 0); G8_SCHED; G8_LDA(At, 1, 0); G8_STAGE_A(G8_SA(0, 1), 1, t + 2);
        G8_WAIT_L(8); G8_BAR; G8_WAIT_L(0); G8_MMA(0, 0, At, B0); G8_BAR; G8_SCHED;
        G8_LDB(B1, 1, 1); G8_STAGE(G8_SB(1, 0), Bt, ldb, bcol, t + 3);
        G8_BAR; G8_WAIT_L(0); G8_MMA(0, 1, At, B1); G8_BAR;
        G8_LDA(At, 1, 1); G8_STAGE_A(G8_SA(1, 0), 0, t + 3);
        G8_BAR; G8_WAIT_L(0); G8_MMA(1, 0, At, B0); G8_BAR; G8_SCHED;
        G8_STAGE(G8_SB(1, 1), Bt, ldb, bcol + HALF, t + 3);
        G8_WAIT_V(6); G8_BAR; G8_MMA(1, 1, At, B1); G8_BAR;
    }
    { G8_LDB(B0, 0, 0); G8_LDA(At, 0, 0); G8_STAGE_A(G8_SA(1, 1), 1, nt - 1);
      G8_BAR; G8_WAIT_L(0); G8_MMA(0, 0, At, B0); G8_BAR;
      G8_LDB(B1, 0, 1); G8_BAR; G8_WAIT_L(0); G8_MMA(0, 1, At, B1); G8_BAR;
      G8_LDA(At, 0, 1); G8_WAIT_V(4); G8_BAR; G8_WAIT_L(0); G8_MMA(1, 0, At, B0); G8_MMA(1, 1, At, B1); G8_BAR; }
    { G8_LDB(B0, 1, 0); G8_LDA(At, 1, 0); G8_WAIT_V(2); G8_BAR; G8_WAIT_L(0); G8_MMA(0, 0, At, B0); G8_BAR;
      G8_LDB(B1, 1, 1); G8_WAIT_V(0); G8_BAR; G8_WAIT_L(0); G8_MMA(0, 1, At, B1); G8_BAR;
      G8_LDA(At, 1, 1); G8_BAR; G8_WAIT_L(0); G8_MMA(1, 0, At, B0); G8_MMA(1, 1, At, B1); G8_BAR; }
    if (wr == 0) G8_BAR;
#undef G8_SA
#undef G8_SB
#undef G8_STAGE
#undef G8_STAGE_A
#undef G8_LDA
#undef G8_LDB
#undef G8_MMA
}
DI void kloop(Acc& acc, char* smem, const bf16_t* A, int lda, const bf16_t* Bt, int ldb, int K, int brow, int bcol) {
    kloop_g(acc, smem, A, [&](int r) { return (brow + r) * lda; }, Bt, ldb, K, bcol);
}
DI bool tile_order(int L, int nM, int nN, int& pm, int& pn) {
    constexpr int NXCD = 8, WGM = 8;
    const int nwg = nM * nN; if (L >= nwg) return false;
    int wgid = L; { const int q = nwg / NXCD, r = nwg % NXCD, xcd = wgid % NXCD, off = wgid / NXCD; wgid = (xcd < r ? xcd * (q + 1) : r * (q + 1) + (xcd - r) * q) + off; }
    const int nig = WGM * nN, gid = wgid / nig, fm = gid * WGM, gsz = (nM - fm) < WGM ? (nM - fm) : WGM;
    pm = fm + ((wgid % nig) % gsz); pn = (wgid % nig) / gsz; return true;
}
DI void acc_zero(Acc& acc) {
#pragma unroll
    for (int a = 0; a < 2; ++a)
#pragma unroll
        for (int b = 0; b < 2; ++b)
#pragma unroll
            for (int m = 0; m < 4; ++m)
#pragma unroll
                for (int n = 0; n < 2; ++n) acc[a][b][m][n] = (f32x4){0.f, 0.f, 0.f, 0.f};
}
template <class F> DI void for_each_quad(const Acc& acc, int brow, int bcol, F f) {
    const int tid = tid_x(), wid = tid >> 6, lane = tid & 63, wr = wid >> 2, wc = wid & 3, fr = lane & 15, fq = lane >> 4;
#pragma unroll
    for (int ai = 0; ai < 2; ++ai)
#pragma unroll
        for (int m = 0; m < 4; ++m)
#pragma unroll
            for (int bj = 0; bj < 2; ++bj)
#pragma unroll
                for (int n = 0; n < 2; ++n) f(brow + ai * HALF + wr * 64 + m * 16 + fr, bcol + bj * HALF + wc * 32 + n * 16 + fq * 4, acc[ai][bj][m][n]);
}
}

constexpr bool USE_G8 = ((NB * CTXL) % 256 == 0) && ((NB * S) % 256 == 0) && (NP % 256 == 0) && (D % 256 == 0) && (D >= 256);
DI int gu_row(int c, int up) {
    if (USE_G8) return (c >> 7) * 256 + ((c >> 6) & 1) * 128 + ((c >> 4) & 3) * 32 + (up ? 16 : 0) + (c & 15);
    return (c >> 6) * 128 + ((c >> 5) & 1) * 64 + ((c >> 4) & 1) * 16 + (c & 15) + (up ? 32 : 0);
}
DI void transpose_item(const float* W, int N, int Nvalid, int k0, int n0, bf16_t* WT, int ldt, int mode, float* scr, int lane) {
    float tv[32];
#pragma unroll
    for (int i = 0; i < 32; ++i) {
        const int kk = 2 * i + (lane >> 5), n = n0 + (lane & 31);
        tv[i] = (n < Nvalid) ? W[(size_t)(k0 + kk) * N + n] : 0.f;
    }
#pragma unroll
    for (int i = 0; i < 32; ++i) scr[(2 * i + (lane >> 5)) * 33 + (lane & 31)] = tv[i];
    WAVE_SYNC();
    const int c = lane & 7;
#pragma unroll
    for (int j = 0; j < 4; ++j) {
        const int nl = (lane >> 3) + 8 * j; const float* s = scr + (8 * c) * 33 + nl;
        u32x4 o; o.x = pk2(s[0], s[33]); o.y = pk2(s[2 * 33], s[3 * 33]); o.z = pk2(s[4 * 33], s[5 * 33]); o.w = pk2(s[6 * 33], s[7 * 33]);
        const int n = n0 + nl; const int row = mode == 0 ? n : gu_row(n, mode == 2);
        *(u32x4*)(WT + (size_t)row * ldt + k0 + 8 * c) = o;
    }
    WAVE_SYNC();
}
DI void transpose_matrix(const float* W, int K, int N, int Npad, bf16_t* WT, int mode, char* smem, int gw, int ngw, int& base) {
    const int lane = tid_x() & 63, wave = tid_x() >> 6;
    float* scr = (float*)smem + wave * (64 * 33);
    const int nkb = K / 64, nnb = Npad / 32, nitems = nkb * nnb;
    int first = ((gw - base) % ngw + ngw) % ngw;
    for (int it = first; it < nitems; it += ngw) {
        const int kb = it / nnb, nb = it % nnb;
        transpose_item(W, N, N, kb * 64, nb * 32, WT, K, mode, scr, lane);
    }
    base = (base + nitems) % ngw;
}

DI void phase0(const Params& p, char* smem) {
    const int tid = tid_x(), lane = tid & 63, wave = tid >> 6;
    if (blockIdx.x == 0 && tid < NEXP) ((int*)(p.ws + WS_CNT))[tid * CNT_STRIDE] = 0;
    if (blockIdx.x == 0 && tid < 2) ((int*)(p.ws + WS_CNT))[tid ? CNT_U2DONE : CNT_TICKET] = 0;
    if (blockIdx.x == 0 && tid == 0) *(unsigned*)(p.ws + WS_BAR) = 0u;
    float* sil = (float*)smem;
    float* red = sil + NV * D;
    const int nitems = 6 * D / 32;
    bool did = false;
    for (int it = blockIdx.x; it < nitems; it += gridDim.x) {
        if (!did) {
            for (int i = tid; i < NV * D; i += NTHREADS) { const int v = i / D, k = i % D; const float cv = v < NB ? p.in[I_C][v * D + k] : p.in[I_CCTX][k]; sil[i] = siluf_(cv); }
            did = true;
        }
        __syncthreads();
        const int col = it * 32 + (lane & 31), rp = lane >> 5;
        float acc[NV];
#pragma unroll
        for (int v = 0; v < NV; ++v) acc[v] = 0.f;
        const int r0 = wave * (D / 8);
        float wv[D / 16];
#pragma unroll
        for (int i = 0; i < D / 16; ++i) wv[i] = p.in[I_ADAW][(size_t)(r0 + 2 * i + rp) * (6 * D) + col];
#pragma unroll
        for (int i = 0; i < D / 16; ++i) {
            const int row = r0 + 2 * i + rp;
#pragma unroll
            for (int v = 0; v < NV; ++v) acc[v] += sil[v * D + row] * wv[i];
        }
#pragma unroll
        for (int v = 0; v < NV; ++v) red[((wave * 2 + rp) * NV + v) * 32 + (lane & 31)] = acc[v];
        __syncthreads();
        if (tid < NV * 32) {
            const int v = tid / 32, cl = tid % 32; float s = p.in[I_ADAB][it * 32 + cl];
            for (int g = 0; g < 16; ++g) s += red[(g * NV + v) * 32 + cl];
            ((float*)(p.ws + WS_MOD))[(size_t)v * 6 * D + it * 32 + cl] = s;
        }
    }
    __syncthreads();
    const int gw = blockIdx.x * 8 + wave, ngw = gridDim.x * 8; int base = 0;
    {
        float* scr = (float*)smem + wave * (64 * 33);
        const int nkb = D / 64, nnb = NP / 32, nitems2 = nkb * nnb;
        for (int it = gw; it < nitems2; it += ngw) { const int kb = it / nnb, nb = it % nnb; transpose_item(p.in[I_WIN], IN_COLS, IN_COLS, kb * 64, nb * 32, (bf16_t*)(p.aux + AUX_WINT), D, 0, scr, lane); }
        base = nitems2 % ngw;
    }
    { float* WRT = (float*)(p.ws + WS_WRT);
      for (int i = blockIdx.x * NTHREADS + tid; i < 36 * D; i += gridDim.x * NTHREADS) { const int j = i / D, k = i % D; WRT[i] = j < 4 ? p.in[I_RG][(size_t)k * 4 + j] : p.in[I_RE][(size_t)k * 32 + (j - 4)]; } }
    transpose_matrix(p.in[I_WOA], 512, D, D, (bf16_t*)(p.ws + WS_WOA), 0, smem, gw, ngw, base);
    transpose_matrix(p.in[I_WOB], 512, D, D, (bf16_t*)(p.ws + WS_WOB), 0, smem, gw, ngw, base);
    transpose_matrix(p.in[I_WOUT], D, D, D, (bf16_t*)(p.ws + WS_WOUT), 0, smem, gw, ngw, base);
    transpose_matrix(p.in[I_G2], 128, 512, 512, (bf16_t*)(p.ws + WS_G2T), 0, smem, gw, ngw, base);
}

constexpr int NSEG = T_ALL / 64, NSEG_CTX = T_CTX / 64;
DI void halo_store(const Params& p, int row, int col, const u32x2& o) {
    int seq, b, j;
    if (row < T_CTX) { seq = 0; b = row / CTXL; j = row % CTXL; } else { seq = 1; const int rr = row - T_CTX; b = rr / S; j = rr % S; }
    const int L = seq ? S : CTXL; const int segbase = seq ? NSEG_CTX + b * (S / 64) : b * (CTXL / 64);
    if (col < 1536) {
        const int jm = j & 63;
        if (jm >= 62 && j + 2 < L) { const int g = segbase + (j >> 6) + 1; *(u32x2*)((bf16_t*)(p.ws + WS_HALO_A) + ((size_t)g * 4 + (jm - 62)) * 1536 + col) = o; }
        if (jm < 2 && j >= 64) { const int g = segbase + (j >> 6) - 1; *(u32x2*)((bf16_t*)(p.ws + WS_HALO_A) + ((size_t)g * 4 + 2 + jm) * 1536 + col) = o; }
    } else if (col >= COL_B0 && col < COL_B0 + 1920) {
        const int js = seq ? (j % GW) * ROWS + j / GW : j; const int jm = js & 63;
        if (jm == 63 && js + 1 < L) { const int g = segbase + (js >> 6) + 1; *(u32x2*)((bf16_t*)(p.ws + WS_HALO_B) + ((size_t)g * 2 + 0) * 1920 + (col - COL_B0)) = o; }
        if (jm == 0 && js >= 64) { const int g = segbase + (js >> 6) - 1; *(u32x2*)((bf16_t*)(p.ws + WS_HALO_B) + ((size_t)g * 2 + 1) * 1920 + (col - COL_B0)) = o; }
    }
}
DI void halo_zero_fill(const Params& p) {
    const int tid = tid_x(), lane = tid & 63, wave = tid >> 6; const int gw = blockIdx.x * 8 + wave, ngw = gridDim.x * 8;
    bf16_t* HA = (bf16_t*)(p.ws + WS_HALO_A); bf16_t* HB = (bf16_t*)(p.ws + WS_HALO_B);
    for (int it = gw; it < NSEG * 2; it += ngw) {
        const int g = it >> 1, side = it & 1;
        const bool ctx = g < NSEG_CTX; const int sg = ctx ? g % (CTXL / 64) : (g - NSEG_CTX) % (S / 64); const int nsg = ctx ? CTXL / 64 : S / 64;
        const bool edge = side ? (sg == nsg - 1) : (sg == 0);
        if (!edge) continue;
        for (int c = lane; c < 384; c += 64) *(u32x4*)(HA + ((size_t)g * 4 + 2 * side) * 1536 + c * 8) = (u32x4){0u, 0u, 0u, 0u};
        for (int c = lane; c < 240; c += 64) *(u32x4*)(HB + ((size_t)g * 2 + side) * 1920 + c * 8) = (u32x4){0u, 0u, 0u, 0u};
    }
}
DI void phase1(const Params& p, char* smem) {
    if (USE_G8) halo_zero_fill(p);
    const int lane = tid_x() & 63, wave = tid_x() >> 6;
    const int gw = blockIdx.x * 8 + wave, ngw = gridDim.x * 8;
    const float* mod = (const float*)(p.ws + WS_MOD);
    bf16_t* U = (bf16_t*)(p.aux + AUX_U);
    auto rowsrc = [&](int r) -> const float* { return r < T_CTX ? p.in[I_CTX] + (size_t)r * D : p.in[I_X] + (size_t)(r - T_CTX) * D; };
    f32x4 xn[D / 256];
    if (gw < T_ALL) {
#pragma unroll
        for (int j = 0; j < D / 256; ++j) xn[j] = *(const f32x4*)(rowsrc(gw) + j * 256 + lane * 4);
    }
    for (int r = gw; r < T_ALL; r += ngw) {
        const int v = r < T_CTX ? NB : (r - T_CTX) / S;
        f32x4 x[D / 256]; float ss = 0.f;
#pragma unroll
        for (int j = 0; j < D / 256; ++j) { x[j] = xn[j]; ss += x[j].x * x[j].x + x[j].y * x[j].y + x[j].z * x[j].z + x[j].w * x[j].w; }
        if (r + ngw < T_ALL) {
#pragma unroll
            for (int j = 0; j < D / 256; ++j) xn[j] = *(const f32x4*)(rowsrc(r + ngw) + j * 256 + lane * 4);
        }
        ss = wave_sum_fast(ss);
        const float rstd = frsq(ss * (1.0f / D) + 1e-6f);
#pragma unroll
        for (int j = 0; j < D / 256; ++j) {
            const int k = j * 256 + lane * 4;
            const f32x4 g = *(const f32x4*)(p.in[I_NMIX] + k), sh = *(const f32x4*)(mod + (size_t)v * 6 * D + k), sc = *(const f32x4*)(mod + (size_t)v * 6 * D + D + k);
            float o0 = x[j].x * rstd * g.x * (1.f + sc.x) + sh.x, o1 = x[j].y * rstd * g.y * (1.f + sc.y) + sh.y;
            float o2 = x[j].z * rstd * g.z * (1.f + sc.z) + sh.z, o3 = x[j].w * rstd * g.w * (1.f + sc.w) + sh.w;
            u32x2 o; o.x = pk2(o0, o1); o.y = pk2(o2, o3);
            *(u32x2*)(U + (size_t)r * D + k) = o;
        }
    }
}

DI void phase2(const Params& p, char* smem) {
    const bf16_t* U = (const bf16_t*)(p.aux + AUX_U); const bf16_t* WT = (const bf16_t*)(p.aux + AUX_WINT);
    bf16_t* PL = (bf16_t*)(p.ws + WS_PLAT); bf16_t* PC = (bf16_t*)(p.ws + WS_PCTX); float* AB = (float*)(p.ws + WS_AB);
    if (USE_G8) {
        constexpr int NT = NP / 256, MT = T_ALL / 256, NT_CTX = (CTX_COLS + 255) / 256;
        for (int t = blockIdx.x; t < MT * NT; t += gridDim.x) {
            int mt, nt; if (!g8::tile_order(t, MT, NT, mt, nt)) break;
            const int brow = mt * 256, bcol = nt * 256; const bool isctx = brow < T_CTX;
            if (isctx && nt >= NT_CTX) continue;
            g8::Acc acc; g8::acc_zero(acc);
            g8::kloop(acc, smem, U, D, WT, D, D, brow, bcol);
            constexpr int OLD_ = 264; bf16_t* OT = (bf16_t*)smem;
            g8::for_each_quad(acc, brow, bcol, [&](int row, int col, const f32x4& v) {
                u32x2 o; o.x = pk2(v.x, v.y); o.y = pk2(v.z, v.w);
                *(u32x2*)(OT + (row - brow) * OLD_ + (col - bcol)) = o;
                if (col >= 2048 && col < 2064) *(f32x4*)(AB + (size_t)row * 16 + (col - 2048)) = v;
                halo_store(p, row, col, o);
            });
            __syncthreads();
            {
                const int tid = tid_x(); const int ncols = isctx ? CTX_COLS : IN_COLS;
                bf16_t* dst = isctx ? PC + (size_t)brow * CTX_COLS : PL + (size_t)(brow - T_CTX) * IN_COLS;
#pragma unroll
                for (int i = 0; i < 16; ++i) {
                    const int ch = tid + i * NTHREADS, row = ch >> 5, c8 = (ch & 31) * 8, col = bcol + c8;
                    if (col < ncols) *(u32x4*)(dst + (size_t)row * ncols + col) = *(const u32x4*)(OT + row * OLD_ + c8);
                }
            }
            __syncthreads();
        }
        return;
    }
    const int tid = tid_x(), lane = tid & 63, wave = tid >> 6, wr = wave >> 1, wc = wave & 1, fr = lane & 15, fq = lane >> 4;
    constexpr int NT = NP / 128, MT = T_ALL / BM, NT_CTX = (CTX_COLS + 127) / 128;
    for (int t = blockIdx.x; t < MT * NT; t += gridDim.x) {
        const int mt = t / NT, nt = t % NT; const int row0 = mt * BM; const bool isctx = row0 < T_CTX;
        if (isctx && nt >= NT_CTX) continue;
        f32x4 acc[MREP][4]; acc_zero(acc);
        gemm_kloop(acc, smem, [&](int i) { return U + (size_t)(row0 + i) * D; }, WT + (size_t)nt * 128 * D, D, D);
#pragma unroll
        for (int m = 0; m < MREP; ++m)
#pragma unroll
            for (int n = 0; n < 4; ++n)
#pragma unroll
                for (int j = 0; j < 4; ++j) {
                    const int row = row0 + wr * 16 * MREP + m * 16 + fq * 4 + j, col = nt * 128 + wc * 64 + n * 16 + fr; const float v = acc[m][n][j];
                    if (isctx) { if (col < CTX_COLS) PC[(size_t)row * CTX_COLS + col] = f2bf(v); }
                    else { if (col < IN_COLS) PL[(size_t)(row - T_CTX) * IN_COLS + col] = f2bf(v); }
                    if (col >= 2048 && col < 2064) AB[(size_t)row * 16 + (col - 2048)] = v;
                }
    }
}


DI int crow(int g, int h) { return (g & 3) + 8 * (g >> 2) + 4 * h; }
template <int S_> DI bf16x8 pack_acc(const f32x16& x) {
    u32x4 r;
    r.x = pk2(x[8 * S_ + 0], x[8 * S_ + 1]); r.y = pk2(x[8 * S_ + 2], x[8 * S_ + 3]); r.z = pk2(x[8 * S_ + 4], x[8 * S_ + 5]); r.w = pk2(x[8 * S_ + 6], x[8 * S_ + 7]);
    return __builtin_bit_cast(bf16x8, r);
}
DI bf16x8 ld_nat(const bf16_t* row, int s, int h) { return *(const bf16x8*)(row + 16 * s + 8 * h); }
DI bf16x8 ld_perm(const bf16_t* row, int s, int h) {
    const bf16x4 lo = *(const bf16x4*)(row + 16 * s + 4 * h), hi = *(const bf16x4*)(row + 16 * s + 8 + 4 * h);
    return __builtin_shufflevector(lo, hi, 0, 1, 2, 3, 4, 5, 6, 7);
}
DI f32x16 zero16() { f32x16 z;
#pragma unroll
    for (int i = 0; i < 16; ++i) z[i] = 0.f;
    return z; }
#define TGET(i) ((i) < 16 ? t0[(i) & 15] : t1[(i) & 15])
DI void invert32_col(const float* Lf, f32x16& t0, f32x16& t1, int c) {
#pragma unroll
    for (int i = 0; i < 32; ++i) {
        float s0 = 0.f, s1 = 0.f, s2 = 0.f, s3 = 0.f;
#pragma unroll
        for (int j4 = 0; j4 < (i + 3) / 4; ++j4) {
            const f32x4 l = *(const f32x4*)(Lf + i * 32 + 4 * j4);
            if (4 * j4 + 0 < i) s0 += l.x * TGET(4 * j4 + 0);
            if (4 * j4 + 1 < i) s1 += l.y * TGET(4 * j4 + 1);
            if (4 * j4 + 2 < i) s2 += l.z * TGET(4 * j4 + 2);
            if (4 * j4 + 3 < i) s3 += l.w * TGET(4 * j4 + 3);
        }
        float sm = -((s0 + s1) + (s2 + s3));
#ifndef EMU
        asm volatile("" : "+v"(sm));
#endif
        const float v = (i > c) ? sm : (i == c ? 1.f : 0.f);
        if (i < 16) t0[i & 15] = v; else t1[i & 15] = v;
    }
}

DI void seg_info(int g, int& seq, int& b, int& j0) {
    if (g < NSEG_CTX) { seq = 0; b = g / (CTXL / 64); j0 = (g % (CTXL / 64)) * 64; } else { const int g2 = g - NSEG_CTX; seq = 1; b = g2 / (S / 64); j0 = (g2 % (S / 64)) * 64; }
}
DI const bf16_t* seq_row(const Params& p, int seq, int b, int j, bool scan_order) {
    if (seq) { const int l = scan_order ? (j % ROWS) * GW + j / ROWS : j; return (const bf16_t*)(p.ws + WS_PLAT) + (size_t)(b * S + l) * IN_COLS; }
    return (const bf16_t*)(p.ws + WS_PCTX) + (size_t)(b * CTXL + j) * CTX_COLS;
}
DI void phase_halo(const Params& p, char* smem) {
    if (USE_G8) return;
    const int tid = tid_x(), lane = tid & 63, wave = tid >> 6;
    const int gw = blockIdx.x * 8 + wave, ngw = gridDim.x * 8;
    bf16_t* HA = (bf16_t*)(p.ws + WS_HALO_A); bf16_t* HB = (bf16_t*)(p.ws + WS_HALO_B);
    for (int it = gw; it < NSEG * 6; it += ngw) {
        const int g = it / 6, hr = it % 6; int seq, b, j0; seg_info(g, seq, b, j0);
        const int L = seq ? S : CTXL;
        if (hr < 4) {
            const int j = hr < 2 ? j0 - 2 + hr : j0 + 62 + hr; const bool ok = j >= 0 && j < L;
            const bf16_t* src = seq_row(p, seq, b, ok ? j : 0, false);
            for (int c = lane; c < 192; c += 64) { u32x4 v = {0u, 0u, 0u, 0u}; if (ok) v = *(const u32x4*)(src + c * 8); *(u32x4*)(HA + ((size_t)g * 4 + hr) * 1536 + c * 8) = v; }
        } else {
            const int j = hr == 4 ? j0 - 1 : j0 + 64; const bool ok = j >= 0 && j < L;
            const bf16_t* src = seq_row(p, seq, b, ok ? j : 0, true) + COL_B0;
            for (int c = lane; c < 240; c += 64) { u32x4 v = {0u, 0u, 0u, 0u}; if (ok) v = *(const u32x4*)(src + c * 8); *(u32x4*)(HB + ((size_t)g * 2 + (hr - 4)) * 1920 + c * 8) = v; }
        }
    }
}
DI f32x2_ac unpk2(unsigned w) { return (f32x2_ac){bf2f((bf16_t)(w & 0xffffu)), bf2f((bf16_t)(w >> 16))}; }
DI void unpack8(const u32x4& q, float (&f)[8]) {
    f[0] = bf2f((bf16_t)(q.x & 0xffffu)); f[1] = bf2f((bf16_t)(q.x >> 16)); f[2] = bf2f((bf16_t)(q.y & 0xffffu)); f[3] = bf2f((bf16_t)(q.y >> 16));
    f[4] = bf2f((bf16_t)(q.z & 0xffffu)); f[5] = bf2f((bf16_t)(q.z >> 16)); f[6] = bf2f((bf16_t)(q.w & 0xffffu)); f[7] = bf2f((bf16_t)(q.w >> 16));
}
DI float row16_sum(float v) {
#ifdef EMU
    v += __shfl_xor(v, 1); v += __shfl_xor(v, 2); v += __shfl_xor(v, 4); v += __shfl_xor(v, 8); return v;
#else
    v = DPP_ADD(v, 0xB1); v = DPP_ADD(v, 0x4E); v = DPP_ADD(v, 0x141); v = DPP_ADD(v, 0x140); return v;
#endif
}
DI void phase_fir(const Params& p, char* smem) {
    const int tid = tid_x(), lane = tid & 63, wave = tid >> 6;
    const int gw = blockIdx.x * 8 + wave, ngw = gridDim.x * 8;
    const bf16_t* HA = (const bf16_t*)(p.ws + WS_HALO_A); const bf16_t* HB = (const bf16_t*)(p.ws + WS_HALO_B);
    constexpr int NA = NSEG * 3, NBI = NSEG * 4;
    const u32x4 z4 = {0u, 0u, 0u, 0u};
    for (int it = gw; it < NA + NBI; it += ngw) {
        if (it < NA) {
            const int g = it / 3, s = it % 3; int seq, b, j0; seg_info(g, seq, b, j0);
            const int col = s * 512 + 8 * lane, ldp = seq ? IN_COLS : CTX_COLS;
            bf16_t* base = (bf16_t*)seq_row(p, seq, b, j0, false) + col;
            const bf16_t* hal = HA + (size_t)g * 4 * 1536 + col;
            float cw[5][8];
#pragma unroll
            for (int t = 0; t < 5; ++t) { const f32x4 w0 = *(const f32x4*)(p.in[I_CONV] + t * 1536 + col), w1 = *(const f32x4*)(p.in[I_CONV] + t * 1536 + col + 4);
                cw[t][0] = w0.x; cw[t][1] = w0.y; cw[t][2] = w0.z; cw[t][3] = w0.w; cw[t][4] = w1.x; cw[t][5] = w1.y; cw[t][6] = w1.z; cw[t][7] = w1.w; }
            u32x4 win[12], nxt[8];
            win[0] = *(const u32x4*)(hal); win[1] = *(const u32x4*)(hal + 1536);
            win[2] = *(const u32x4*)(base); win[3] = *(const u32x4*)(base + ldp);
#pragma unroll
            for (int i = 0; i < 8; ++i) win[4 + i] = *(const u32x4*)(base + (size_t)(2 + i) * ldp);
#pragma unroll 1
            for (int blk = 0; blk < 8; ++blk) {
                if (blk < 7) {
#pragma unroll
                    for (int i = 0; i < 8; ++i) { const int t = 8 * blk + 10 + i; nxt[i] = t < 64 ? *(const u32x4*)(base + (size_t)t * ldp) : *(const u32x4*)(hal + (size_t)(2 + (t - 64)) * 1536); }
                }
#pragma unroll
                for (int i = 0; i < 8; ++i) {
                    float a[8];
#pragma unroll
                    for (int e = 0; e < 8; ++e) a[e] = 0.f;
#pragma unroll
                    for (int t = 0; t < 5; ++t) { float x[8]; unpack8(win[i + t], x);
#pragma unroll
                        for (int e = 0; e < 8; ++e) a[e] += x[e] * cw[t][e]; }
                    float ss = 0.f;
#pragma unroll
                    for (int e = 0; e < 8; ++e) { a[e] = fsilu(a[e]); ss += a[e] * a[e]; }
                    if (s < 2) { const float sc = frsq(row16_sum(ss) + 1e-6f) * (s == 0 ? 0.08838834764831845f : 1.0f);
#pragma unroll
                        for (int e = 0; e < 8; ++e) a[e] *= sc; }
                    u32x4 o; o.x = pk2(a[0], a[1]); o.y = pk2(a[2], a[3]); o.z = pk2(a[4], a[5]); o.w = pk2(a[6], a[7]);
                    *(u32x4*)(base + (size_t)(8 * blk + i) * ldp) = o;
                }
#pragma unroll
                for (int i = 0; i < 4; ++i) win[i] = win[8 + i];
#pragma unroll
                for (int i = 0; i < 8; ++i) win[4 + i] = nxt[i];
            }
        } else {
            const int it2 = it - NA, g = it2 / 4, sl = it2 % 4; int seq, b, j0; seg_info(g, seq, b, j0);
            const int bcol = sl * 512 + 8 * lane; const bool act = bcol < 1920;
            const int bc = act ? bcol : 0, col = COL_B0 + bc;
            float mu8[8];
            { const f32x4 m0 = *(const f32x4*)(p.in[I_MU] + bc), m1 = *(const f32x4*)(p.in[I_MU] + bc + 4); mu8[0] = m0.x; mu8[1] = m0.y; mu8[2] = m0.z; mu8[3] = m0.w; mu8[4] = m1.x; mu8[5] = m1.y; mu8[6] = m1.z; mu8[7] = m1.w; }
            const bool th = (bc >= 1536 && bc < 1664);
            const bf16_t* hal = HB + (size_t)g * 2 * 1920 + bc;
            u32x4 win[10], nxt[8];
            win[0] = *(const u32x4*)(hal); win[1] = *(const u32x4*)(seq_row(p, seq, b, j0, true) + col);
#pragma unroll
            for (int i = 0; i < 8; ++i) win[2 + i] = *(const u32x4*)(seq_row(p, seq, b, j0 + 1 + i, true) + col);
#pragma unroll 1
            for (int blk = 0; blk < 8; ++blk) {
                if (blk < 7) {
#pragma unroll
                    for (int i = 0; i < 8; ++i) { const int t = 8 * blk + 9 + i; nxt[i] = t < 64 ? *(const u32x4*)(seq_row(p, seq, b, j0 + t, true) + col) : *(const u32x4*)(hal + 1920); }
                }
#pragma unroll
                for (int i = 0; i < 8; ++i) {
                    float pv[8], cu[8], nx[8], x[8]; unpack8(win[i], pv); unpack8(win[i + 1], cu); unpack8(win[i + 2], nx);
#pragma unroll
                    for (int e = 0; e < 8; ++e) { x[e] = cu[e] + (0.5f * (pv[e] + nx[e]) - cu[e]) * mu8[e]; if (th) x[e] = ftanh(x[e]); }
                    u32x4 o; o.x = pk2(x[0], x[1]); o.y = pk2(x[2], x[3]); o.z = pk2(x[4], x[5]); o.w = pk2(x[6], x[7]);
                    if (act) *(u32x4*)((bf16_t*)seq_row(p, seq, b, j0 + 8 * blk + i, true) + col) = o;
                }
                win[0] = win[8]; win[1] = win[9];
#pragma unroll
                for (int i = 0; i < 8; ++i) win[2 + i] = nxt[i];
            }
        }
    }
}

constexpr int GC = 32;
constexpr int G_NT = (CTXL + S) / GC;
constexpr int LD128 = 136, LD64 = 72, LD32 = 40;
DI void chunk_pos(int x, int d, int& seg, int& j0) {
    constexpr int n0 = CTXL / GC, n1 = S / GC;
    if (x < n0) { seg = 0; j0 = (d ? n0 - 1 - x : x) * GC; } else { seg = 1; const int xx = x - n0; j0 = (d ? n1 - 1 - xx : xx) * GC; }
}

template <class Emit, class Emit0>
DI void invert32_blocked(const float* Lf, bf16_t* scr, int lane, Emit emit, Emit0 emit0) {
    bf16_t* T00T = scr; bf16_t* T11R = scr + 16 * LD32; bf16_t* L10R = scr + 2 * 16 * LD32; bf16_t* P1T = scr + 3 * 16 * LD32;
    const int blk = lane >> 5, c = lane & 15, r = lane & 31, fr = lane & 15, fq = lane >> 4;
    f32x16 t;
    const float* Lb = Lf + (16 * blk) * 32 + 16 * blk;
    f32x4 rb[3][4];
#pragma unroll
    for (int j4 = 0; j4 < 1; ++j4) { rb[1][j4] = *(const f32x4*)(Lb + 1 * 32 + 4 * j4); rb[2][j4] = *(const f32x4*)(Lb + 2 * 32 + 4 * j4); }
#pragma unroll
    for (int i = 0; i < 16; ++i) {
        if (i >= 1 && i + 2 < 16) {
#pragma unroll
            for (int j4 = 0; j4 < (i + 2 + 3) / 4; ++j4) rb[(i + 2) % 3][j4] = *(const f32x4*)(Lb + (i + 2) * 32 + 4 * j4);
        }
        float s0 = 0.f, s1 = 0.f, s2 = 0.f, s3 = 0.f;
#pragma unroll
        for (int j4 = 0; j4 < (i + 3) / 4; ++j4) {
            const f32x4 l = rb[i % 3][j4];
            if (4 * j4 + 0 < i) s0 += l.x * t[4 * j4 + 0];
            if (4 * j4 + 1 < i) s1 += l.y * t[4 * j4 + 1];
            if (4 * j4 + 2 < i) s2 += l.z * t[4 * j4 + 2];
            if (4 * j4 + 3 < i) s3 += l.w * t[4 * j4 + 3];
        }
        float sm = -((s0 + s1) + (s2 + s3));
#ifndef EMU
        asm volatile("" : "+v"(sm));
#endif
        t[i] = (i > c) ? sm : (i == c ? 1.f : 0.f);
    }
    if (r < 16) {
        if (blk == 0) {
#pragma unroll
            for (int q = 0; q < 4; ++q) { u32x2 o; o.x = pk2(t[4 * q], t[4 * q + 1]); o.y = pk2(t[4 * q + 2], t[4 * q + 3]); *(u32x2*)(T00T + c * LD32 + 4 * q) = o; }
        } else {
#pragma unroll
            for (int i = 0; i < 16; ++i) T11R[i * LD32 + c] = f2bf(t[i]);
        }
    }
    { const int i = lane >> 2, j4 = (lane & 3) * 4; const f32x4 l = *(const f32x4*)(Lf + (16 + i) * 32 + j4);
      u32x2 o; o.x = pk2(l.x, l.y); o.y = pk2(l.z, l.w); *(u32x2*)(L10R + i * LD32 + j4) = o; }
    WAVE_SYNC();
    const bf16x8 zf = {0, 0, 0, 0, 0, 0, 0, 0};
    f32x4 p1 = {0.f, 0.f, 0.f, 0.f};
    {
        const bf16x8 af = fq < 2 ? *(const bf16x8*)(L10R + fr * LD32 + 8 * fq) : zf, bfm = fq < 2 ? *(const bf16x8*)(T00T + fr * LD32 + 8 * fq) : zf;
        p1 = MFMA16(af, bfm, p1);
    }
    { u32x2 o; o.x = pk2(p1[0], p1[1]); o.y = pk2(p1[2], p1[3]); *(u32x2*)(P1T + fr * LD32 + 4 * fq) = o; }
    WAVE_SYNC();
    f32x4 p2 = {0.f, 0.f, 0.f, 0.f};
    {
        const bf16x8 af = fq < 2 ? *(const bf16x8*)(T11R + fr * LD32 + 8 * fq) : zf, bfm = fq < 2 ? *(const bf16x8*)(P1T + fr * LD32 + 8 * fq) : zf;
        p2 = MFMA16(af, bfm, p2);
    }
#pragma unroll
    for (int j = 0; j < 4; ++j) emit(16 + 4 * fq + j, fr, -p2[j]);
    if (r < 16) {
#pragma unroll
        for (int i = 0; i < 16; ++i) emit(16 * blk + i, 16 * blk + c, t[i]);
        if (blk == 0) {
#pragma unroll
            for (int i = 0; i < 16; ++i) emit0(i, 16 + c);
        }
    }
}
DI float half_sum(float v, int hh) {
#ifdef EMU
    v += __shfl_xor(v, 1); v += __shfl_xor(v, 2); v += __shfl_xor(v, 4); v += __shfl_xor(v, 8); v += __shfl_xor(v, 16); return v;
#else
    v = DPP_ADD(v, 0xB1); v = DPP_ADD(v, 0x4E); v = DPP_ADD(v, 0x141); v = DPP_ADD(v, 0x140);
    const int iv = __builtin_bit_cast(int, v);
    const float s0 = __builtin_bit_cast(float, __builtin_amdgcn_readlane(iv, 0)) + __builtin_bit_cast(float, __builtin_amdgcn_readlane(iv, 16));
    const float s1 = __builtin_bit_cast(float, __builtin_amdgcn_readlane(iv, 32)) + __builtin_bit_cast(float, __builtin_amdgcn_readlane(iv, 48));
    return hh ? s1 : s0;
#endif
}
constexpr int GL_Q = 0;
constexpr int GL_KT = GL_Q + 3 * 32 * LD128 * 2;
constexpr int GL_VT = GL_KT + 3 * 128 * LD32 * 2;
constexpr int GL_K = GL_VT + 3 * 128 * LD32 * 2;
constexpr int GL_QKM = GL_K + 32 * LD128 * 2;
constexpr int GL_LF = GL_QKM + 2 * 32 * LD32 * 2;
constexpr int GL_TP = GL_LF + 32 * 32 * 4;
constexpr int GL_TPP = GL_TP + 32 * LD32 * 2;
constexpr int GL_WN = GL_TPP + 2 * 32 * LD32 * 2;
constexpr int GL_SC = GL_WN + 32 * LD128 * 2;
constexpr int GL_GC = GL_SC + 2 * 8 * 32 * 4;
constexpr int GL_INV = GL_GC + 8 * 32 * 4;
constexpr int GL_RAW = GL_INV + 4 * 16 * LD32 * 2;
constexpr int GL_END = GL_RAW + 32 * 384 * 2;
static_assert(GL_END <= LDS_BYTES, "gdn lds");

DI void gdn_chain2(const Params& p, char* smem, int item) {
    const int d = item / (NB * H_A), b = (item / H_A) % NB, h = item % H_A;
    const int tid = tid_x(), lane = tid & 63, wave0_ = tid >> 6;
    bf16_t* Qs = (bf16_t*)(smem + GL_Q); bf16_t* KTs = (bf16_t*)(smem + GL_KT); bf16_t* VTs = (bf16_t*)(smem + GL_VT); bf16_t* Ks = (bf16_t*)(smem + GL_K);
    bf16_t* QKMs = (bf16_t*)(smem + GL_QKM); float* Lf = (float*)(smem + GL_LF); bf16_t* Tp = (bf16_t*)(smem + GL_TP); bf16_t* Tpp = (bf16_t*)(smem + GL_TPP);
    bf16_t* Wn = (bf16_t*)(smem + GL_WN); float* SC = (float*)(smem + GL_SC); float* GCs = (float*)(smem + GL_GC);
    const float alog = p.in[I_ALOG][d * 4 + h], dtb = p.in[I_DTB][d * 4 + h], negea = -expf(alog);
    bf16_t* ODIR = (bf16_t*)(p.ws + WS_OA);
    __syncthreads();
    f32x16 St[4];
#pragma unroll
    for (int ct = 0; ct < 4; ++ct) St[ct] = zero16();
    bf16_t* RAW = (bf16_t*)(smem + GL_RAW);
    float pa = 0.f, pbt = 0.f;
    auto prefetch = [&](int x, int inst0, int ninst) {
        int seg, j0; chunk_pos(x, d, seg, j0);
        const int ldp = seg ? IN_COLS : CTX_COLS;
        const bf16_t* pbase = seg ? (const bf16_t*)(p.ws + WS_PLAT) + (size_t)b * S * IN_COLS : (const bf16_t*)(p.ws + WS_PCTX) + (size_t)b * CTXL * CTX_COLS;
        for (int inst = inst0; inst < inst0 + ninst; ++inst) {
            const int q = inst * 64 + lane, row = q / 48, c16 = q % 48;
            const bf16_t* src = pbase + (size_t)(j0 + row) * ldp + (c16 >> 4) * 512 + h * 128 + (c16 & 15) * 8;
#ifdef EMU
            emu_global_load_lds16(src, (char*)RAW + q * 16);
#else
            __builtin_amdgcn_global_load_lds((const unsigned*)src, (__attribute__((address_space(3))) unsigned*)((char*)RAW + q * 16), 16, 0, 0);
#endif
        }
    };
    auto prefetch_ab = [&](int x, int g0, int ng) {
        int seg, j0; chunk_pos(x, d, seg, j0);
        const float* abbase = (const float*)(p.ws + WS_AB) + (size_t)(seg ? T_CTX + b * S : b * CTXL) * 16;
        if (lane < 4 * ng) { const int j = j0 + 4 * g0 + lane; pa = abbase[(size_t)j * 16 + d * 4 + h]; pbt = abbase[(size_t)j * 16 + 8 + d * 4 + h]; }
    };
    auto x1 = [&](int c, int g0, int ng) {
        const int q3 = c % 3, parc = c & 1;
        for (int gi = 0; gi < ng; ++gi) {
            const int g = g0 + gi;
            const int i0 = d ? (GC - 4 - 4 * g) : 4 * g;
            const char* rawg = (const char*)RAW + (4 * g + (d ? 3 : 0)) * 768 + 4 * lane; const int rstep = d ? -768 : 768;
            unsigned wq[4], wk[4], wv[4];
#pragma unroll
            for (int e = 0; e < 4; ++e) { const char* rr = rawg + e * rstep; wq[e] = *(const unsigned*)rr; wk[e] = *(const unsigned*)(rr + 256); wv[e] = *(const unsigned*)(rr + 512); }
            char* qrow = (char*)Qs + ((q3 * 32 + i0) * LD128 + 2 * lane) * 2; char* krow = (char*)Ks + (i0 * LD128 + 2 * lane) * 2;
#pragma unroll
            for (int e = 0; e < 4; ++e) { *(unsigned*)(qrow + e * LD128 * 2) = wq[e]; *(unsigned*)(krow + e * LD128 * 2) = wk[e]; }
            char* ktrow = (char*)KTs + ((q3 * 128 + 2 * lane) * LD32 + i0) * 2; char* vtrow = (char*)VTs + ((q3 * 128 + 2 * lane) * LD32 + i0) * 2;
            { u32x2 o; o.x = (wk[0] & 0xffffu) | (wk[1] << 16); o.y = (wk[2] & 0xffffu) | (wk[3] << 16); *(u32x2*)ktrow = o;
              u32x2 o1; o1.x = (wk[0] >> 16) | (wk[1] & 0xffff0000u); o1.y = (wk[2] >> 16) | (wk[3] & 0xffff0000u); *(u32x2*)(ktrow + LD32 * 2) = o1; }
            { u32x2 o; o.x = (wv[0] & 0xffffu) | (wv[1] << 16); o.y = (wv[2] & 0xffffu) | (wv[3] << 16); *(u32x2*)vtrow = o;
              u32x2 o1; o1.x = (wv[0] >> 16) | (wv[1] & 0xffff0000u); o1.y = (wv[2] >> 16) | (wv[3] & 0xffff0000u); *(u32x2*)(vtrow + LD32 * 2) = o1; }
        }
        if (lane < 4 * ng) { const int jo = 4 * g0 + lane; const int i = d ? (GC - 1 - jo) : jo;
            SC[(parc * 8 + 0) * 32 + i] = negea * fsoftplus(pa + dtb); SC[(parc * 8 + 1) * 32 + i] = fsigmoid(pbt); }
    };
    auto x2 = [&](int c, int r, int wave) {
        const int par = c & 1, q3 = c % 3;
        const float* graw = SC + (par * 8 + 0) * 32;
        float gcv = 0.f;
#pragma unroll
        for (int s4 = 0; s4 < 8; ++s4) { const f32x4 g4 = *(const f32x4*)(graw + 4 * s4);
            gcv += (4 * s4 + 0 <= r ? g4.x : 0.f) + (4 * s4 + 1 <= r ? g4.y : 0.f) + (4 * s4 + 2 <= r ? g4.z : 0.f) + (4 * s4 + 3 <= r ? g4.w : 0.f); }
        if (lane < 32) GCs[wave * 32 + r] = gcv;
        if (wave == 7 && lane < 32) {
            float gl = 0.f;
#pragma unroll
            for (int s4 = 0; s4 < 8; ++s4) { const f32x4 g4 = *(const f32x4*)(graw + 4 * s4); gl += (g4.x + g4.y) + (g4.z + g4.w); }
            const float be = SC[(par * 8 + 1) * 32 + r];
            SC[(par * 8 + 3) * 32 + r] = fexp(gcv); SC[(par * 8 + 4) * 32 + r] = fexp(gl - gcv); SC[(par * 8 + 5) * 32 + r] = be * fexp(gcv); SC[(par * 8 + 6) * 32 + r] = fexp(gl);
        }
        const int pr = wave >> 2, th = (wave >> 1) & 1, ch = wave & 1, fr = lane & 15, fq = lane >> 4;
        const bf16_t* arow = (pr == 0 ? Ks : Qs + q3 * 32 * LD128) + (16 * th + fr) * LD128 + 8 * fq; const bf16_t* brow = Ks + (16 * ch + fr) * LD128 + 8 * fq;
        f32x4 cc = {0.f, 0.f, 0.f, 0.f};
#pragma unroll
        for (int ks = 0; ks < 4; ++ks) cc = MFMA16(*(const bf16x8*)(arow + 32 * ks), *(const bf16x8*)(brow + 32 * ks), cc);
        WAVE_SYNC();
        const int jj = 16 * ch + fr; const float gj = GCs[wave * 32 + jj];
#pragma unroll
        for (int j = 0; j < 4; ++j) {
            const int i = 16 * th + 4 * fq + j; const float dec = fexp(GCs[wave * 32 + i] - gj);
            if (pr == 0) Lf[i * 32 + jj] = (jj < i) ? SC[(par * 8 + 1) * 32 + i] * cc[j] * dec : 0.f;
            else QKMs[(par * 32 + i) * LD32 + jj] = f2bf((jj <= i) ? cc[j] * dec : 0.f);
        }
    };
    prefetch(0, 3 * wave0_, 3); prefetch_ab(0, wave0_, 1);
#ifndef EMU
    asm volatile("s_waitcnt vmcnt(0)" ::: "memory");
#endif
    const int r0_ = lane & 31, hh0_ = lane >> 5;
    __syncthreads();
    x1(0, wave0_, 1);
    LDS_BARRIER();
    if (wave0_ >= 4 && wave0_ < 7 && 1 < G_NT) { prefetch(1, 9 * (wave0_ - 4), wave0_ == 6 ? 6 : 9); prefetch_ab(1, 3 * (wave0_ - 4), wave0_ == 6 ? 2 : 3); }
    x2(0, r0_, wave0_);
#ifndef EMU
    asm volatile("s_waitcnt vmcnt(0)" ::: "memory");
#endif
    LDS_BARRIER();
    for (int it = -1; it < G_NT; ++it) {
        int r = r0_, hh = hh0_, wave = wave0_;
#ifndef EMU
        asm volatile("" : "+v"(r), "+v"(hh), "+v"(wave));
#endif
        const int xn = it + 1, par = xn & 1, q3 = xn % 3;
        const int g0w = 3 * (wave - 4), ngw = wave == 6 ? 2 : 3;
        if (wave == 7 && xn < G_NT) {
            const float* sb1 = SC + (par * 8 + 5) * 32; const float* sb0 = SC + (par * 8 + 1) * 32; bf16_t* Tppw = Tpp + par * 32 * LD32;
            const float s1lo = sb1[lane & 15], s1hi = sb1[16 + (lane & 15)], s0lo = sb0[lane & 15], s0hi = sb0[16 + (lane & 15)];
            SETPRIO(3);
            invert32_blocked(Lf, (bf16_t*)(smem + GL_INV), lane,
                [&](int i, int c, float v) { Tp[i * LD32 + c] = f2bf(v * (c < 16 ? s1lo : s1hi)); Tppw[i * LD32 + c] = f2bf(v * (c < 16 ? s0lo : s0hi)); },
                [&](int i, int c) { Tp[i * LD32 + c] = (bf16_t)0; Tppw[i * LD32 + c] = (bf16_t)0; });
            SETPRIO(0);
        }
        if (wave >= 4 && wave < 7 && xn + 1 < G_NT) {
            x1(xn + 1, g0w, ngw);
            if (xn + 2 < G_NT) {
                WAVE_SYNC();
                prefetch(xn + 2, 9 * (wave - 4), wave == 6 ? 6 : 9); prefetch_ab(xn + 2, g0w, ngw);
            }
        }
        if (wave < 4 && it >= 0) {
            const int pc = it & 1, qc = it % 3; int seg = 0, j0 = 0; chunk_pos(it, d, seg, j0);
            const bf16_t* Qc = Qs + qc * 32 * LD128; const bf16_t* KTc = KTs + qc * 128 * LD32; const bf16_t* VTc = VTs + qc * 128 * LD32;
            const bf16_t* QKc = QKMs + pc * 32 * LD32; const bf16_t* Tc = Tpp + pc * 32 * LD32; const float* sc = SC + pc * 8 * 32;
            f32x16 vn = zero16();
#pragma unroll
            for (int s = 0; s < 2; ++s) vn = MFMA32(ld_nat(Tc + r * LD32, s, hh), ld_nat(VTc + (32 * wave + r) * LD32, s, hh), vn);
            f32x16 oacc = zero16();
#define GDN_KSTEP(s) { const bf16x8 sb = pack_acc<(s) & 1>(St[(s) >> 1]); vn = MFMA32(ld_perm(Wn + r * LD128, (s), hh), sb, vn); oacc = MFMA32(ld_perm(Qc + r * LD128, (s), hh), sb, oacc); }
            GDN_KSTEP(0) GDN_KSTEP(1) GDN_KSTEP(2) GDN_KSTEP(3) GDN_KSTEP(4) GDN_KSTEP(5) GDN_KSTEP(6) GDN_KSTEP(7)
#undef GDN_KSTEP
#pragma unroll
            for (int g = 0; g < 16; ++g) oacc[g] *= sc[3 * 32 + crow(g, hh)];
            { const bf16x8 v0 = pack_acc<0>(vn), v1 = pack_acc<1>(vn);
              oacc = MFMA32(ld_perm(QKc + r * LD32, 0, hh), v0, oacc); oacc = MFMA32(ld_perm(QKc + r * LD32, 1, hh), v1, oacc); }
#pragma unroll
            for (int g = 0; g < 16; ++g) vn[g] *= sc[4 * 32 + crow(g, hh)];
            const float ge = sc[6 * 32];
            { const bf16x8 v0 = pack_acc<0>(vn), v1 = pack_acc<1>(vn);
#pragma unroll
              for (int ct = 0; ct < 4; ++ct) {
#pragma unroll
                  for (int g = 0; g < 16; ++g) St[ct][g] *= ge;
                  St[ct] = MFMA32(ld_perm(KTc + (32 * ct + r) * LD32, 0, hh), v0, St[ct]);
                  St[ct] = MFMA32(ld_perm(KTc + (32 * ct + r) * LD32, 1, hh), v1, St[ct]);
              } }
            if (seg) {
                bf16_t* ol = ODIR + ((size_t)d * T_LAT + (size_t)b * S + j0 + (d ? (GC - 1 - 4 * hh) : 4 * hh)) * 512 + h * 128 + 32 * wave + r;
                const int st = d ? -512 : 512;
#pragma unroll
                for (int g = 0; g < 16; ++g) ol[((g & 3) + 8 * (g >> 2)) * st] = f2bf(oacc[g]);
            }
        }
        LDS_BARRIER();
        if (xn < G_NT && wave < 4) {
            f32x16 acc = zero16();
#pragma unroll
            for (int s = 0; s < 2; ++s) acc = MFMA32(ld_nat(KTs + (q3 * 128 + 32 * wave + r) * LD32, s, hh), ld_nat(Tp + r * LD32, s, hh), acc);
#pragma unroll
            for (int q = 0; q < 4; ++q) {
                u32x2 o; o.x = pk2(-acc[4 * q], -acc[4 * q + 1]); o.y = pk2(-acc[4 * q + 2], -acc[4 * q + 3]);
                *(u32x2*)(Wn + r * LD128 + 32 * wave + 8 * q + 4 * hh) = o;
            }
        }
        if (xn + 1 < G_NT) x2(xn + 1, r, wave);
#ifndef EMU
        asm volatile("s_waitcnt vmcnt(0)" ::: "memory");
#endif
        LDS_BARRIER();
    }
}

constexpr int RL_RX = 0;
constexpr int RL_KX = RL_RX + 32 * 64 * 2;
constexpr int RL_VX = RL_KX + 32 * 64 * 2;
constexpr int RL_KK = RL_VX + 32 * 64 * 2;
constexpr int RL_LW = RL_KK + 32 * 64 * 4;
constexpr int RL_IC = RL_LW + 32 * 64 * 4;
constexpr int RL_PC = RL_IC + 32 * 64 * 4;
constexpr int RL_CST = RL_PC + 2 * 64 * 4;
constexpr int RL_TW = RL_CST + 4 * 64 * 4;
constexpr int RL_AL = RL_TW + 32 * LD64 * 2;
constexpr int RL_LF = RL_AL + 32 * LD64 * 2;
constexpr int RL_LAKT = RL_LF + 32 * 32 * 4;
constexpr int RL_TB = RL_LAKT + 32 * LD32 * 2;
constexpr int RL_W2T = RL_TB + 32 * LD32 * 2;
constexpr int RL_A2T = RL_W2T + 64 * LD64 * 2;
constexpr int RL_AR = RL_A2T + 64 * LD64 * 2;
constexpr int RL_BR = RL_AR + 32 * LD64 * 2;
constexpr int RL_KR = RL_BR + 32 * LD64 * 2;
constexpr int RL_RR = RL_KR + 32 * LD64 * 2;
constexpr int RL_AT = RL_RR + 2 * 32 * LD64 * 2;
constexpr int RL_BHT = RL_AT + 64 * LD32 * 2;
constexpr int RL_KHT = RL_BHT + 2 * 64 * LD32 * 2;
constexpr int RL_VT = RL_KHT + 2 * 64 * LD32 * 2;
constexpr int RL_MRB = RL_VT + 2 * 64 * LD32 * 2;
constexpr int RL_MRK = RL_MRB + 2 * 32 * LD32 * 2;
constexpr int RL_WM = RL_MRK + 2 * 32 * LD32 * 2;
constexpr int RL_TL = RL_WM + 32 * LD64 * 2;
constexpr int RL_GS = RL_TL + 32 * LD32 * 2;
constexpr int RL_END = RL_GS + 8 * 64 * 4;
static_assert(RL_END <= LDS_BYTES, "rwkv lds");
static_assert(4 * 16 * LD32 * 2 <= 2 * 32 * LD64 * 2, "inversion scratch over AR/BR");

DI void rwkv_chain2(const Params& p, char* smem, int item) {
    const int d = item / (NB * H_B), b = (item / H_B) % NB, h = item % H_B;
    const int tid = tid_x(), lane = tid & 63, wave = tid >> 6;
    bf16_t* RX = (bf16_t*)(smem + RL_RX); bf16_t* KX = (bf16_t*)(smem + RL_KX); bf16_t* VX = (bf16_t*)(smem + RL_VX); float* KKs = (float*)(smem + RL_KK);
    float* LW = (float*)(smem + RL_LW); float* IC = (float*)(smem + RL_IC); float* Lf = (float*)(smem + RL_LF); float* PC = (float*)(smem + RL_PC); float* CST = (float*)(smem + RL_CST);
    bf16_t* TW = (bf16_t*)(smem + RL_TW); bf16_t* AL = (bf16_t*)(smem + RL_AL); bf16_t* W2T = (bf16_t*)(smem + RL_W2T); bf16_t* A2T = (bf16_t*)(smem + RL_A2T);
    bf16_t* Ar = (bf16_t*)(smem + RL_AR); bf16_t* Br = (bf16_t*)(smem + RL_BR); bf16_t* Kr = (bf16_t*)(smem + RL_KR); bf16_t* Rr = (bf16_t*)(smem + RL_RR);
    bf16_t* AT = (bf16_t*)(smem + RL_AT); bf16_t* BhT = (bf16_t*)(smem + RL_BHT); bf16_t* KhT = (bf16_t*)(smem + RL_KHT); bf16_t* VT = (bf16_t*)(smem + RL_VT);
    bf16_t* LakT = (bf16_t*)(smem + RL_LAKT); bf16_t* Mrb = (bf16_t*)(smem + RL_MRB); bf16_t* Mrk = (bf16_t*)(smem + RL_MRK); bf16_t* Tb = (bf16_t*)(smem + RL_TB);
    bf16_t* Wm = (bf16_t*)(smem + RL_WM); bf16_t* TLm = (bf16_t*)(smem + RL_TL); float* GS = (float*)(smem + RL_GS);
    bf16_t* YDIR = (bf16_t*)(p.aux + AUX_YDIR); float* BON = (float*)(p.ws + WS_BONUS);
    __syncthreads();
    for (int i = tid; i < 64 * 64; i += NTHREADS) {
        const int c = i >> 6, rr = i & 63;
        W2T[c * LD64 + rr] = f2bf(p.in[I_W2][((size_t)d * 64 + rr) * 512 + h * 64 + c]); A2T[c * LD64 + rr] = f2bf(p.in[I_A2][((size_t)d * 64 + rr) * 512 + h * 64 + c]);
    }
    if (tid < 256) { const int w = tid >> 6, c = tid & 63, gc = h * 64 + c;
        CST[tid] = w == 0 ? p.in[I_W0][d * 512 + gc] : (w == 1 ? p.in[I_A0][d * 512 + gc] : (w == 2 ? p.in[I_KA][gc] : p.in[I_RK][gc])); }
    const float kkw0 = p.in[I_KK][h * 64 + 2 * (lane & 31)], kkw1 = p.in[I_KK][h * 64 + 2 * (lane & 31) + 1];
    f32x16 Xt[2]; Xt[0] = zero16(); Xt[1] = zero16();
    unsigned rawv[4][5];
    auto prefetch = [&](int x, int w) {
        int seg, j0; chunk_pos(x, d, seg, j0);
        const int ldp = seg ? IN_COLS : CTX_COLS;
        const bf16_t* pb = seg ? (const bf16_t*)(p.ws + WS_PLAT) + (size_t)b * S * IN_COLS : (const bf16_t*)(p.ws + WS_PCTX) + (size_t)b * CTXL * CTX_COLS;
#pragma unroll
        for (int k = 0; k < 4; ++k) {
            const int pi = (w - 2) + 5 * k;
            if (pi < GC / 2) {
                const int j = j0 + 2 * pi + (lane >> 5); const int row = seg ? (j % ROWS) * GW + j / ROWS : j;
#pragma unroll
                for (int s = 0; s < 5; ++s) {
                    const int bcol = (s < 3 ? s * 512 + h * 64 : (s == 3 ? 1536 + d * 64 : 1664 + d * 64)) + 2 * (lane & 31);
                    rawv[k][s] = *(const unsigned*)(pb + (size_t)row * ldp + COL_B0 + bcol);
                }
            }
        }
    };
    auto y1 = [&](int w) {
#pragma unroll
        for (int k = 0; k < 4; ++k) {
            const int pi = (w - 2) + 5 * k;
            if (pi < GC / 2) {
                const int jo = 2 * pi + (lane >> 5), i = d ? (GC - 1 - jo) : jo, c2 = 2 * (lane & 31);
                const float kx0 = bf2f((bf16_t)(rawv[k][1] & 0xffffu)) * kkw0, kx1 = bf2f((bf16_t)(rawv[k][1] >> 16)) * kkw1;
                const float rs = frsq(half_sum(kx0 * kx0 + kx1 * kx1, lane >> 5) + 1e-6f);
                *(unsigned*)(RX + i * 64 + c2) = rawv[k][0]; *(unsigned*)(KX + i * 64 + c2) = rawv[k][1]; *(unsigned*)(VX + i * 64 + c2) = rawv[k][2];
                KKs[i * 64 + c2] = kx0 * rs; KKs[i * 64 + c2 + 1] = kx1 * rs;
                *(unsigned*)(TW + i * LD64 + c2) = rawv[k][3]; *(unsigned*)(AL + i * LD64 + c2) = rawv[k][4];
            }
        }
    };
    auto y2 = [&]() {
        const int which = wave >> 2, cg = wave & 3, fr = lane & 15, fq = lane >> 4;
        const bf16_t* arow0 = (which ? AL : TW) + fr * LD64 + 8 * fq; const bf16_t* brow = (which ? A2T : W2T) + (16 * cg + fr) * LD64 + 8 * fq;
        f32x4 c0 = {0.f, 0.f, 0.f, 0.f}, c1 = {0.f, 0.f, 0.f, 0.f};
#pragma unroll
        for (int ks = 0; ks < 2; ++ks) {
            const bf16x8 bfrag = *(const bf16x8*)(brow + 32 * ks);
            c0 = MFMA16(*(const bf16x8*)(arow0 + 32 * ks), bfrag, c0); c1 = MFMA16(*(const bf16x8*)(arow0 + 16 * LD64 + 32 * ks), bfrag, c1);
        }
        const int c = 16 * cg + fr; const float bias = CST[which * 64 + c];
#pragma unroll
        for (int th = 0; th < 2; ++th) {
            float gs = 0.f;
#pragma unroll
            for (int j = 0; j < 4; ++j) {
                const int i = 16 * th + 4 * fq + j; const float z = bias + (th ? c1[j] : c0[j]);
                if (which) IC[i * 64 + c] = fsigmoid(z);
                else { const float lw = -0.60653065971263342f * fsigmoid(z); LW[i * 64 + c] = lw; gs += lw; }
            }
            if (!which) GS[(4 * th + fq) * 64 + c] = gs;
        }
    };
    if (wave >= 2 && wave < 7) prefetch(0, wave);
    const int r0_ = lane & 31, hh0_ = lane >> 5;
    __syncthreads();
    if (wave >= 2 && wave < 7) { y1(wave); if (1 < G_NT) prefetch(1, wave); }
    LDS_BARRIER();
    y2();
    LDS_BARRIER();
    for (int it = -1; it < G_NT; ++it) {
        int r = r0_, hh = hh0_;
#ifndef EMU
        asm volatile("" : "+v"(r), "+v"(hh));
#endif
        const int xn = it + 1, par = xn & 1;
        int segn = 0, j0n = 0; if (xn < G_NT) chunk_pos(xn, d, segn, j0n);
        if (xn < G_NT) {
            const int c = lane, i0 = 4 * wave;
            const float ka = CST[2 * 64 + c], rk = CST[3 * 64 + c];
            float lpb = 0.f, lpc = 0.f; float lw4[4];
#pragma unroll
            for (int g2 = 0; g2 < 8; ++g2) { const float w = GS[g2 * 64 + c]; lpc += w; if (g2 < wave) lpb += w; }
#pragma unroll
            for (int e = 0; e < 4; ++e) lw4[e] = LW[(i0 + e) * 64 + c];
            bf16_t ta[4], tb[4], tk[4], tv[4]; float bon[4];
            float lprun = lpb;
            float Pprev = fexp(lpb); const float PCt = fexp(lpc);
#pragma unroll
            for (int e = 0; e < 4; ++e) {
                const int i = i0 + e;
                lprun += lw4[e];
                const float Pi = fexp(lprun), Pm = Pprev, invP = frcp(Pi), PCi = PCt * invP; Pprev = Pi;
                const float ic = IC[i * 64 + c], kxv = bf2f(KX[i * 64 + c]), kkv = KKs[i * 64 + c], rxv = bf2f(RX[i * 64 + c]); const bf16_t vxb = VX[i * 64 + c];
                const float kd = kxv * (1.f + (ic - 1.f) * ka), bb = kkv * ic, aa = -kkv;
                ta[e] = f2bf(aa * Pm); tb[e] = f2bf(bb * PCi); tk[e] = f2bf(kd * PCi); tv[e] = vxb;
                Ar[i * LD64 + c] = ta[e]; Br[i * LD64 + c] = f2bf(bb * invP); Kr[i * LD64 + c] = f2bf(kd * invP); Rr[(par * 32 + i) * LD64 + c] = f2bf(rxv * Pi);
                bon[e] = wave_sum_fast(rxv * kd * rk);
            }
            { u32x2 o; o.x = (unsigned)ta[0] | ((unsigned)ta[1] << 16); o.y = (unsigned)ta[2] | ((unsigned)ta[3] << 16); *(u32x2*)(AT + c * LD32 + i0) = o; }
            { u32x2 o; o.x = (unsigned)tb[0] | ((unsigned)tb[1] << 16); o.y = (unsigned)tb[2] | ((unsigned)tb[3] << 16); *(u32x2*)(BhT + (par * 64 + c) * LD32 + i0) = o; }
            { u32x2 o; o.x = (unsigned)tk[0] | ((unsigned)tk[1] << 16); o.y = (unsigned)tk[2] | ((unsigned)tk[3] << 16); *(u32x2*)(KhT + (par * 64 + c) * LD32 + i0) = o; }
            { u32x2 o; o.x = (unsigned)tv[0] | ((unsigned)tv[1] << 16); o.y = (unsigned)tv[2] | ((unsigned)tv[3] << 16); *(u32x2*)(VT + (par * 64 + c) * LD32 + i0) = o; }
            if (wave == 7) PC[par * 64 + c] = PCt;
            if (segn && lane < 4) { const int i = i0 + lane, jj = d ? j0n + GC - 1 - i : j0n + i;
                const float bv = lane == 0 ? bon[0] : (lane == 1 ? bon[1] : (lane == 2 ? bon[2] : bon[3]));
                BON[((size_t)d * T_LAT + (size_t)b * S + (jj % ROWS) * GW + jj / ROWS) * 8 + h] = bv; }
        }
        LDS_BARRIER();
        if (xn < G_NT) {
            const int m = wave >> 1, th = wave & 1, fr = lane & 15, fq = lane >> 4;
            const bf16_t* arow = ((m < 2) ? Ar : Rr + par * 32 * LD64) + (16 * th + fr) * LD64 + 8 * fq; const bf16_t* brow = ((m & 1) ? Kr : Br) + fr * LD64 + 8 * fq;
            f32x4 c0 = {0.f, 0.f, 0.f, 0.f}, c1 = {0.f, 0.f, 0.f, 0.f};
#pragma unroll
            for (int ks = 0; ks < 2; ++ks) {
                const bf16x8 afrag = *(const bf16x8*)(arow + 32 * ks);
                c0 = MFMA16(afrag, *(const bf16x8*)(brow + 32 * ks), c0); c1 = MFMA16(afrag, *(const bf16x8*)(brow + 16 * LD64 + 32 * ks), c1);
            }
#pragma unroll
            for (int ch = 0; ch < 2; ++ch) {
                const f32x4 cc = ch ? c1 : c0; const int ic = 16 * ch + fr; const int t0 = 16 * th + 4 * fq;
                if (m == 0) {
#pragma unroll
                    for (int j = 0; j < 4; ++j) Lf[(t0 + j) * 32 + ic] = (ic < t0 + j) ? -cc[j] : 0.f;
                } else if (m == 1) {
                    u32x2 o; o.x = pk2((ic < t0) ? cc[0] : 0.f, (ic < t0 + 1) ? cc[1] : 0.f); o.y = pk2((ic < t0 + 2) ? cc[2] : 0.f, (ic < t0 + 3) ? cc[3] : 0.f);
                    *(u32x2*)(LakT + ic * LD32 + t0) = o;
                } else {
                    bf16_t* M = (m == 2 ? Mrb : Mrk) + par * 32 * LD32;
#pragma unroll
                    for (int j = 0; j < 4; ++j) M[(t0 + j) * LD32 + ic] = f2bf((ic <= t0 + j) ? cc[j] : 0.f);
                }
            }
        }
        LDS_BARRIER();
        if (wave == 7 && xn < G_NT) {
            SETPRIO(3);
            invert32_blocked(Lf, (bf16_t*)(smem + RL_AR), lane, [&](int i, int c, float v) { Tb[i * LD32 + c] = f2bf(v); },
                             [&](int i, int c) { Tb[i * LD32 + c] = (bf16_t)0; });
            SETPRIO(0);
        }
        if (wave >= 2 && wave < 7 && xn + 1 < G_NT) { y1(wave); if (xn + 2 < G_NT) prefetch(xn + 2, wave); }
        if (wave < 2 && it >= 0) {
            SETPRIO(2);
            const int pc = it & 1; int seg = 0, j0 = 0; chunk_pos(it, d, seg, j0);
            const bf16_t* Rc = Rr + pc * 32 * LD64; const bf16_t* BhTc = BhT + pc * 64 * LD32; const bf16_t* KhTc = KhT + pc * 64 * LD32; const bf16_t* VTc = VT + (pc * 64 + 32 * wave + r) * LD32;
            const bf16_t* Mrbc = Mrb + pc * 32 * LD32; const bf16_t* Mrkc = Mrk + pc * 32 * LD32; const float* PCc = PC + pc * 64;
            const bf16x8 vf0 = ld_nat(VTc, 0, hh), vf1 = ld_nat(VTc, 1, hh);
            f32x16 u = zero16(), y = zero16();
            u = MFMA32(ld_nat(TLm + r * LD32, 0, hh), vf0, u); u = MFMA32(ld_nat(TLm + r * LD32, 1, hh), vf1, u);
            y = MFMA32(ld_nat(Mrkc + r * LD32, 0, hh), vf0, y); y = MFMA32(ld_nat(Mrkc + r * LD32, 1, hh), vf1, y);
#define RW_KSTEP(s) { const bf16x8 xb = pack_acc<(s) & 1>(Xt[(s) >> 1]); u = MFMA32(ld_perm(Wm + r * LD64, (s), hh), xb, u); y = MFMA32(ld_perm(Rc + r * LD64, (s), hh), xb, y); }
            RW_KSTEP(0) RW_KSTEP(1) RW_KSTEP(2) RW_KSTEP(3)
#undef RW_KSTEP
            const bf16x8 ub0 = pack_acc<0>(u), ub1 = pack_acc<1>(u);
            y = MFMA32(ld_perm(Mrbc + r * LD32, 0, hh), ub0, y); y = MFMA32(ld_perm(Mrbc + r * LD32, 1, hh), ub1, y);
#pragma unroll
            for (int kt = 0; kt < 2; ++kt) {
#pragma unroll
                for (int g = 0; g < 16; ++g) Xt[kt][g] *= PCc[32 * kt + crow(g, hh)];
                Xt[kt] = MFMA32(ld_perm(BhTc + (32 * kt + r) * LD32, 0, hh), ub0, Xt[kt]); Xt[kt] = MFMA32(ld_perm(BhTc + (32 * kt + r) * LD32, 1, hh), ub1, Xt[kt]);
                Xt[kt] = MFMA32(ld_nat(KhTc + (32 * kt + r) * LD32, 0, hh), vf0, Xt[kt]); Xt[kt] = MFMA32(ld_nat(KhTc + (32 * kt + r) * LD32, 1, hh), vf1, Xt[kt]);
            }
            if (seg) {
                if (ROWS % GC == 0) {
                    const int cb = (j0 % ROWS) * GW + j0 / ROWS;
                    bf16_t* yl = YDIR + ((size_t)d * T_LAT + (size_t)b * S + cb + (d ? (GC - 1 - 4 * hh) : 4 * hh) * GW) * 512 + h * 64 + 32 * wave + r;
                    const long long st = d ? -(long long)GW * 512 : (long long)GW * 512;
#pragma unroll
                    for (int g = 0; g < 16; ++g) yl[(long long)((g & 3) + 8 * (g >> 2)) * st] = f2bf(y[g]);
                } else {
#pragma unroll
                    for (int g = 0; g < 16; ++g) {
                        const int i = crow(g, hh), jj = d ? j0 + GC - 1 - i : j0 + i;
                        YDIR[((size_t)d * T_LAT + (size_t)b * S + (jj % ROWS) * GW + jj / ROWS) * 512 + h * 64 + 32 * wave + r] = f2bf(y[g]);
                    }
                }
            }
            SETPRIO(0);
        }
        LDS_BARRIER();
        if (xn < G_NT && wave >= 4 && wave < 7) {
            const int w6 = wave - 4;
            const bf16_t* arow = (w6 < 2) ? AT + (32 * w6 + r) * LD32 : LakT + r * LD32;
            f32x16 acc = zero16();
#pragma unroll
            for (int s = 0; s < 2; ++s) acc = MFMA32(ld_nat(arow, s, hh), ld_nat(Tb + r * LD32, s, hh), acc);
#pragma unroll
            for (int q = 0; q < 4; ++q) {
                u32x2 o; o.x = pk2(acc[4 * q], acc[4 * q + 1]); o.y = pk2(acc[4 * q + 2], acc[4 * q + 3]);
                if (w6 < 2) *(u32x2*)(Wm + r * LD64 + 32 * w6 + 8 * q + 4 * hh) = o; else *(u32x2*)(TLm + r * LD32 + 8 * q + 4 * hh) = o;
            }
        }
        if (xn + 1 < G_NT) y2();
        LDS_BARRIER();
    }
}

DI void phase3(const Params& p, char* smem) {
    constexpr int NG = 2 * NB * H_A, NR = 2 * NB * H_B;
    for (int it = blockIdx.x; it < NG; it += gridDim.x) gdn_chain2(p, smem, it);
    for (int it = blockIdx.x; it < NG + NR; it += gridDim.x) if (it >= NG) rwkv_chain2(p, smem, it - NG);
    const int nchain = NG + NR, G = (int)gridDim.x;
    const int tb = G > nchain ? (int)blockIdx.x - nchain : (int)blockIdx.x, ntb = G > nchain ? G - nchain : G;
    if (tb >= 0) {
        __syncthreads();
        const int tid3 = tid_x(), lane = tid3 & 63, wave = tid3 >> 6;
        float* scr = (float*)smem + wave * (64 * 33);
        bf16_t* GUT = (bf16_t*)(p.aux + AUX_GUT);
        constexpr int nkb = D / 64, nnb = DE / 32, per = nkb * nnb;
        for (int it = tb * 8 + wave; it < NEXP * 2 * per; it += ntb * 8) {
            const int e = it / (2 * per), r = it % (2 * per), up = r / per, r2 = r % per, kb = r2 / nnb, nb = r2 % nnb;
            transpose_item((up ? p.in[I_MU_UP] : p.in[I_MG]) + (size_t)e * D * DE, DE, DE, kb * 64, nb * 32, GUT + (size_t)e * 512 * D, D, up ? 2 : 1, scr, lane);
        }
        constexpr int nkb2 = DE / 64, nnb2 = D / 32, per2 = nkb2 * nnb2;
        for (int it = tb * 8 + wave; it < NE_EARLY * per2; it += ntb * 8) {
            const int e = it / per2, r2 = it % per2, kb = r2 / nnb2, nb = r2 % nnb2;
            transpose_item(p.in[I_MD] + (size_t)e * DE * D, D, D, kb * 64, nb * 32, DNT_PTR(p.ws, e), DE, 0, scr, lane);
        }
    }
}

constexpr int P4_SG = 0;
constexpr int P4_XV = P4_SG + 32 * LD128 * 2;
constexpr int P4_YF = P4_XV + 32 * 520 * 2;
static_assert(P4_YF + 32 * 516 * 4 <= LDS_BYTES, "phase4 lds");
DI void phase4(const Params& p, char* smem) {
    const int tid = tid_x(), lane = tid & 63, wave = tid >> 6, r = lane & 31, hh = lane >> 5;
    const bf16_t* PL = (const bf16_t*)(p.ws + WS_PLAT);
    const bf16_t* ODIR = (const bf16_t*)(p.ws + WS_OA); const bf16_t* YDIR = (const bf16_t*)(p.aux + AUX_YDIR);
    const float* BON = (const float*)(p.ws + WS_BONUS); const float* mu = p.in[I_MU]; const bf16_t* G2T = (const bf16_t*)(p.ws + WS_G2T);
    bf16_t* OA = (bf16_t*)(p.ws + WS_OA); bf16_t* OB = (bf16_t*)(p.ws + WS_OB);
    bf16_t* SG = (bf16_t*)(smem + P4_SG); bf16_t* XV = (bf16_t*)(smem + P4_XV); float* YF = (float*)(smem + P4_YF);
    for (int it = blockIdx.x; it < T_LAT / 32; it += gridDim.x) {
        const int tok0 = it * 32, b = tok0 / S, l0 = tok0 % S;
        __syncthreads();
        for (int q = tid; q < 32 * 80; q += NTHREADS) {
            const int t = q / 80, c8 = q % 80;
            const int l = l0 + t;
            const int bcol = c8 < 16 ? 1792 + c8 * 8 : 1024 + (c8 - 16) * 8;
            float cu[8], o[8];
            unpack8(*(const u32x4*)(PL + (size_t)(b * S + l) * IN_COLS + COL_B0 + bcol), cu);
#pragma unroll
            for (int e = 0; e < 8; ++e) o[e] = c8 < 16 ? fsigmoid(cu[e]) : cu[e];
            u32x4 w; w.x = pk2(o[0], o[1]); w.y = pk2(o[2], o[3]); w.z = pk2(o[4], o[5]); w.w = pk2(o[6], o[7]);
            if (c8 < 16) *(u32x4*)(SG + t * LD128 + c8 * 8) = w; else *(u32x4*)(XV + t * 520 + (c8 - 16) * 8) = w;
        }
        for (int q = tid; q < 32 * 64; q += NTHREADS) {
            const int t = q >> 6, c8 = q & 63, tok = tok0 + t;
            float a0[8], a1[8];
            unpack8(*(const u32x4*)(YDIR + (size_t)tok * 512 + c8 * 8), a0); unpack8(*(const u32x4*)(YDIR + ((size_t)T_LAT + tok) * 512 + c8 * 8), a1);
            f32x4 s0 = {a0[0] + a1[0], a0[1] + a1[1], a0[2] + a1[2], a0[3] + a1[3]}, s1 = {a0[4] + a1[4], a0[5] + a1[5], a0[6] + a1[6], a0[7] + a1[7]};
            *(f32x4*)(YF + t * 516 + c8 * 8) = s0; *(f32x4*)(YF + t * 516 + c8 * 8 + 4) = s1;
        }
        __syncthreads();
        {
            unsigned q0[16], q1[16], zq[16];
#pragma unroll
            for (int k = 0; k < 16; ++k) {
                const int pi = wave * 16 + k, t = pi >> 2, h = pi & 3, tok = tok0 + t;
                const size_t o0 = (size_t)tok * 512 + h * 128 + 2 * lane;
                q0[k] = *(const unsigned*)(ODIR + o0); q1[k] = *(const unsigned*)(ODIR + (size_t)T_LAT * 512 + o0); zq[k] = *(const unsigned*)(PL + (size_t)tok * IN_COLS + 1536 + h * 128 + 2 * lane);
            }
            const float on0 = p.in[I_ONORM][2 * lane], on1 = p.in[I_ONORM][2 * lane + 1];
#pragma unroll
            for (int k = 0; k < 16; ++k) {
                const int pi = wave * 16 + k, t = pi >> 2, h = pi & 3, tok = tok0 + t;
                const size_t o0 = (size_t)tok * 512 + h * 128 + 2 * lane;
                const float a0 = bf2f((bf16_t)(q0[k] & 0xffffu)) + bf2f((bf16_t)(q1[k] & 0xffffu)), a1 = bf2f((bf16_t)(q0[k] >> 16)) + bf2f((bf16_t)(q1[k] >> 16));
                const float ss = wave_sum_fast(a0 * a0 + a1 * a1);
                const float rstd = frsq(ss * (1.f / 128.f) + 1e-6f);
                const float z0 = bf2f((bf16_t)(zq[k] & 0xffffu)), z1 = bf2f((bf16_t)(zq[k] >> 16));
                *(unsigned*)(OA + o0) = pk2(a0 * rstd * on0 * fsilu(z0), a1 * rstd * on1 * fsilu(z1));
            }
        }
        __syncthreads();
        {
            const int h = wave;
            f32x16 acc0 = zero16(), acc1 = zero16();
#pragma unroll
            for (int s2 = 0; s2 < 8; ++s2) {
                const bf16x8 a = ld_nat(SG + r * LD128, s2, hh);
                const bf16x8 b0 = *(const bf16x8*)(G2T + (size_t)(64 * h + r) * 128 + 16 * s2 + 8 * hh), b1 = *(const bf16x8*)(G2T + (size_t)(64 * h + 32 + r) * 128 + 16 * s2 + 8 * hh);
                acc0 = MFMA32(a, b0, acc0); acc1 = MFMA32(a, b1, acc1);
            }
            const int c0 = 64 * h + r, c1 = c0 + 32;
            const float lg0 = p.in[I_LNG][c0], lb0 = p.in[I_LNB][c0], lg1 = p.in[I_LNG][c1], lb1 = p.in[I_LNB][c1];
            float bonv[16];
#pragma unroll
            for (int g = 0; g < 16; ++g) { const int tok = tok0 + crow(g, hh); bonv[g] = BON[(size_t)tok * 8 + h] + BON[((size_t)T_LAT + tok) * 8 + h]; }
#pragma unroll
            for (int g = 0; g < 16; ++g) {
                const int i = crow(g, hh), tok = tok0 + i;
                const float y0 = YF[i * 516 + c0], y1 = YF[i * 516 + c1];
                const float mean = half_sum(y0 + y1, hh) * (1.f / 64.f); const float d0 = y0 - mean, d1 = y1 - mean;
                const float var = half_sum(d0 * d0 + d1 * d1, hh) * (1.f / 64.f); const float rs = frsq(var + 64e-5f);
                const float bon = bonv[g];
                const float o0 = (d0 * rs * lg0 + lb0 + bon * bf2f(XV[i * 520 + c0])) * acc0[g], o1 = (d1 * rs * lg1 + lb1 + bon * bf2f(XV[i * 520 + c1])) * acc1[g];
                OB[(size_t)tok * 512 + c0] = f2bf(o0); OB[(size_t)tok * 512 + c1] = f2bf(o1);
            }
        }
    }
}

DI void phase5(const Params& p, char* smem) {
    const bf16_t* OA = (const bf16_t*)(p.ws + WS_OA); const bf16_t* OB = (const bf16_t*)(p.ws + WS_OB);
    const bf16_t* WA = (const bf16_t*)(p.ws + WS_WOA); const bf16_t* WB = (const bf16_t*)(p.ws + WS_WOB);
    const bf16_t* PL = (const bf16_t*)(p.ws + WS_PLAT); bf16_t* Y = (bf16_t*)(p.aux + AUX_Y);
    if (USE_G8) {
        constexpr int NT8 = D / 256, MT8 = T_LAT / 256;
        constexpr int GLD = 264;
        static_assert(256 * GLD * 2 <= LDS_BYTES, "gate tile lds");
        bf16_t* GT = (bf16_t*)smem;
        auto stage_gates = [&](int brow, int gcol0) {
            const int tid = tid_x();
            u32x4 gv[16];
#pragma unroll
            for (int i = 0; i < 16; ++i) { const int ch = tid + i * NTHREADS, row = ch >> 5, c16 = ch & 31; gv[i] = *(const u32x4*)(PL + (size_t)(brow + row) * IN_COLS + gcol0 + c16 * 8); }
#pragma unroll
            for (int i = 0; i < 16; ++i) { const int ch = tid + i * NTHREADS, row = ch >> 5, c16 = ch & 31; *(u32x4*)(GT + row * GLD + c16 * 8) = gv[i]; }
            __syncthreads();
        };
        for (int t = blockIdx.x; t < MT8 * NT8; t += gridDim.x) {
            int mt, nt; if (!g8::tile_order(t, MT8, NT8, mt, nt)) break;
            const int brow = mt * 256, bcol = nt * 256;
            g8::Acc acc; g8::acc_zero(acc);
            g8::kloop(acc, smem, OA, 512, WA, 512, 512, brow, bcol);
            stage_gates(brow, COL_G0 + bcol);
            g8::for_each_quad(acc, brow, bcol, [&](int row, int col, const f32x4& v) {
                const u32x2 gq = *(const u32x2*)(GT + (row - brow) * GLD + (col - bcol));
                const float g0 = bf2f((bf16_t)(gq.x & 0xffffu)), g1 = bf2f((bf16_t)(gq.x >> 16)), g2 = bf2f((bf16_t)(gq.y & 0xffffu)), g3 = bf2f((bf16_t)(gq.y >> 16));
                u32x2 o; o.x = pk2(fsigmoid(g0) * v.x, fsigmoid(g1) * v.y); o.y = pk2(fsigmoid(g2) * v.z, fsigmoid(g3) * v.w);
                *(u32x2*)(Y + (size_t)row * D + col) = o;
            });
            __syncthreads();
            g8::acc_zero(acc);
            g8::kloop(acc, smem, OB, 512, WB, 512, 512, brow, bcol);
            stage_gates(brow, COL_G0 + D + bcol);
            g8::for_each_quad(acc, brow, bcol, [&](int row, int col, const f32x4& v) {
                const u32x2 gq = *(const u32x2*)(GT + (row - brow) * GLD + (col - bcol));
                const float g0 = bf2f((bf16_t)(gq.x & 0xffffu)), g1 = bf2f((bf16_t)(gq.x >> 16)), g2 = bf2f((bf16_t)(gq.y & 0xffffu)), g3 = bf2f((bf16_t)(gq.y >> 16));
#ifdef EMU
                const unsigned long long tq = *(const unsigned long long*)(Y + (size_t)row * D + col);
#else
                const unsigned long long tq = __hip_atomic_load((const unsigned long long*)(Y + (size_t)row * D + col), __ATOMIC_RELAXED, __HIP_MEMORY_SCOPE_AGENT);
#endif
                const unsigned tlo = (unsigned)tq, thi = (unsigned)(tq >> 32);
                const float t0 = bf2f((bf16_t)(tlo & 0xffffu)), t1 = bf2f((bf16_t)(tlo >> 16)), t2 = bf2f((bf16_t)(thi & 0xffffu)), t3 = bf2f((bf16_t)(thi >> 16));
                u32x2 o; o.x = pk2(t0 + fsigmoid(g0) * v.x, t1 + fsigmoid(g1) * v.y); o.y = pk2(t2 + fsigmoid(g2) * v.z, t3 + fsigmoid(g3) * v.w);
                *(u32x2*)(Y + (size_t)row * D + col) = o;
            });
            __syncthreads();
        }
        return;
    }
    constexpr int MR5 = 2, BM5 = 64 * MR5; constexpr int NT = D / 128, MT = T_LAT / BM5;
    for (int t = blockIdx.x; t < MT * NT; t += gridDim.x) {
        const int mt = t / NT, nt = t % NT, row0 = mt * BM5;
        f32x4 acca[MR5][4], accb[MR5][4]; acc_zero(acca); acc_zero(accb);
        gemm_kloop(acca, smem, [&](int i) { return OA + (size_t)(row0 + i) * 512; }, WA + (size_t)nt * 128 * 512, 512, 512);
        gemm_kloop(accb, smem, [&](int i) { return OB + (size_t)(row0 + i) * 512; }, WB + (size_t)nt * 128 * 512, 512, 512);
        const int t2 = tid_x(), l2 = t2 & 63, w2 = t2 >> 6; const int wr = w2 >> 1, wc = w2 & 1, fr = l2 & 15, fq = l2 >> 4;
#pragma unroll
        for (int m = 0; m < MR5; ++m)
#pragma unroll
            for (int n = 0; n < 4; ++n)
#pragma unroll
                for (int j = 0; j < 4; ++j) {
                    const int row = row0 + wr * 16 * MR5 + m * 16 + fq * 4 + j, col = nt * 128 + wc * 64 + n * 16 + fr;
                    const float ga = bf2f(PL[(size_t)row * IN_COLS + COL_G0 + col]), gb = bf2f(PL[(size_t)row * IN_COLS + COL_G0 + D + col]);
                    Y[(size_t)row * D + col] = f2bf(sigmoidf_(ga) * acca[m][n][j] + sigmoidf_(gb) * accb[m][n][j]);
                }
    }
}

DI void phase6(const Params& p, char* smem) {
    const bf16_t* Y = (const bf16_t*)(p.aux + AUX_Y); const bf16_t* WO = (const bf16_t*)(p.ws + WS_WOUT);
    const float* mod = (const float*)(p.ws + WS_MOD); float* Hh = (float*)(p.ws + WS_H);
    if (USE_G8) {
        constexpr int NT = D / 256, MT = T_LAT / 256;
        const float* X = p.in[I_X];
        for (int t = blockIdx.x; t < MT * NT; t += gridDim.x) {
            int mt, nt; if (!g8::tile_order(t, MT, NT, mt, nt)) break;
            const int brow = mt * 256, bcol = nt * 256;
            g8::Acc acc; g8::acc_zero(acc);
            g8::kloop(acc, smem, Y, D, WO, D, D, brow, bcol);
            g8::for_each_quad(acc, brow, bcol, [&](int row, int col, const f32x4& v) {
                const int b = row / S; const f32x4 xv = *(const f32x4*)(X + (size_t)row * D + col), gv = *(const f32x4*)(mod + (size_t)b * 6 * D + 2 * D + col);
                f32x4 o; o.x = xv.x + gv.x * v.x; o.y = xv.y + gv.y * v.y; o.z = xv.z + gv.z * v.z; o.w = xv.w + gv.w * v.w;
                *(f32x4*)(Hh + (size_t)row * D + col) = o;
            });
        }
    } else {
        const int tid = tid_x(), lane = tid & 63, wave = tid >> 6, wr = wave >> 1, wc = wave & 1, fr = lane & 15, fq = lane >> 4;
        constexpr int NT = D / 128, MT = T_LAT / BM;
        for (int t = blockIdx.x; t < MT * NT; t += gridDim.x) {
            const int mt = t / NT, nt = t % NT, row0 = mt * BM;
            f32x4 acc[MREP][4]; acc_zero(acc);
            gemm_kloop(acc, smem, [&](int i) { return Y + (size_t)(row0 + i) * D; }, WO + (size_t)nt * 128 * D, D, D);
#pragma unroll
            for (int m = 0; m < MREP; ++m)
#pragma unroll
                for (int n = 0; n < 4; ++n)
#pragma unroll
                    for (int j = 0; j < 4; ++j) {
                        const int row = row0 + wr * 16 * MREP + m * 16 + fq * 4 + j, col = nt * 128 + wc * 64 + n * 16 + fr, b = row / S;
                        Hh[(size_t)row * D + col] = p.in[I_X][(size_t)row * D + col] + mod[(size_t)b * 6 * D + 2 * D + col] * acc[m][n][j];
                    }
        }
    }
    __syncthreads();
    const int tid6 = tid_x(), lane = tid6 & 63, wave = tid6 >> 6;
    const int gw = blockIdx.x * 8 + wave, ngw = gridDim.x * 8;
    float* scr = (float*)smem + wave * (64 * 33);
    {
        constexpr int nkb = DE / 64, nnb = D / 32, per = nkb * nnb;
        for (int it = gw; it < (NEXP - NE_EARLY) * per; it += ngw) {
            const int e = NE_EARLY + it / per, r2 = it % per, kb = r2 / nnb, nb = r2 % nnb;
            transpose_item(p.in[I_MD] + (size_t)e * DE * D, D, D, kb * 64, nb * 32, DNT_PTR(p.ws, e), DE, 0, scr, lane);
        }
    }
}

#ifdef EMU
#define MFMA32F(a, b, c) emu_mfma32_f32((a), (b), (c))
#else
#define MFMA32F(a, b, c) __builtin_amdgcn_mfma_f32_32x32x2f32((a), (b), (c), 0, 0, 0)
#endif
constexpr int TB_LD = D + 4;
static_assert(32 * TB_LD * 4 <= LDS_BYTES && 8 * 32 * 64 * 4 <= LDS_BYTES, "phase7 lds");
DI void phase7(const Params& p, char* smem) {
    const int tid = tid_x(), lane = tid & 63, wave = tid >> 6, r = lane & 31, hh = lane >> 5;
    const float* Hh = (const float*)(p.ws + WS_H); const float* mod = (const float*)(p.ws + WS_MOD); const float* WRT = (const float*)(p.ws + WS_WRT);
    bf16_t* Tt = (bf16_t*)(p.ws + WS_T); int* cnt = (int*)(p.ws + WS_CNT); int* rowlist = (int*)(p.ws + WS_ROWLIST); float* pairw = (float*)(p.ws + WS_PAIRW);
    float* tb = (float*)smem;
    float* bias = (float*)(smem + LDS_BYTES - 1024);
    int* lcnt = (int*)(smem + LDS_BYTES - 768);
    int* lbase = lcnt + 32;
    if (tid < 36) bias[tid] = tid < 4 ? p.in[I_RGB][tid] : p.in[I_REB][tid - 4];
    f32x4 x[4][D / 256];
    int itn = blockIdx.x;
    if (itn < T_LAT / 32) {
#pragma unroll
        for (int tt = 0; tt < 4; ++tt)
#pragma unroll
            for (int j = 0; j < D / 256; ++j) x[tt][j] = *(const f32x4*)(Hh + (size_t)(itn * 32 + wave * 4 + tt) * D + j * 256 + lane * 4);
    }
    for (int it = blockIdx.x; it < T_LAT / 32; it += gridDim.x) {
        const int tok0 = it * 32;
        __syncthreads();
        if (tid < 32) lcnt[tid] = 0;
#pragma unroll
        for (int tt = 0; tt < 4; ++tt) {
            const int ti = wave * 4 + tt, tok = tok0 + ti, b = tok / S;
            float ss = 0.f;
#pragma unroll
            for (int j = 0; j < D / 256; ++j) ss += x[tt][j].x * x[tt][j].x + x[tt][j].y * x[tt][j].y + x[tt][j].z * x[tt][j].z + x[tt][j].w * x[tt][j].w;
            ss = wave_sum_fast(ss);
            const float rstd = frsq(ss * (1.0f / D) + 1e-6f);
#pragma unroll
            for (int j = 0; j < D / 256; ++j) {
                const int k = j * 256 + lane * 4;
                const f32x4 g = *(const f32x4*)(p.in[I_NFFN] + k), sh = *(const f32x4*)(mod + (size_t)b * 6 * D + 3 * D + k), sc = *(const f32x4*)(mod + (size_t)b * 6 * D + 4 * D + k);
                f32x4 o; o.x = x[tt][j].x * rstd * g.x * (1.f + sc.x) + sh.x; o.y = x[tt][j].y * rstd * g.y * (1.f + sc.y) + sh.y;
                o.z = x[tt][j].z * rstd * g.z * (1.f + sc.z) + sh.z; o.w = x[tt][j].w * rstd * g.w * (1.f + sc.w) + sh.w;
                *(f32x4*)(tb + ti * TB_LD + k) = o;
                u32x2 ob; ob.x = pk2(o.x, o.y); ob.y = pk2(o.z, o.w);
                *(u32x2*)(Tt + (size_t)tok * D + k) = ob;
            }
        }
        itn = it + gridDim.x;
        if (itn < T_LAT / 32) {
#pragma unroll
            for (int tt = 0; tt < 4; ++tt)
#pragma unroll
                for (int j = 0; j < D / 256; ++j) x[tt][j] = *(const f32x4*)(Hh + (size_t)(itn * 32 + wave * 4 + tt) * D + j * 256 + lane * 4);
        }
        LDS_BARRIER();
        f32x16 a0 = zero16(), a1 = zero16();
        {
            const int kbeg = wave * (D / 8);
            const float* arow = tb + r * TB_LD + kbeg + 4 * hh;
            const float* b0row = WRT + (size_t)(4 + r) * D + kbeg + 4 * hh;
            const float* b1row = WRT + (size_t)(r < 4 ? r : 0) * D + kbeg + 4 * hh;
            const float m1 = r < 4 ? 1.f : 0.f;
#pragma unroll 4
            for (int g = 0; g < D / 64; ++g) {
                const f32x4 av = *(const f32x4*)(arow + 8 * g), b0 = *(const f32x4*)(b0row + 8 * g); const f32x4 b1 = *(const f32x4*)(b1row + 8 * g) * m1;
                a0 = MFMA32F(av.x, b0.x, a0); a1 = MFMA32F(av.x, b1.x, a1); a0 = MFMA32F(av.y, b0.y, a0); a1 = MFMA32F(av.y, b1.y, a1);
                a0 = MFMA32F(av.z, b0.z, a0); a1 = MFMA32F(av.z, b1.z, a1); a0 = MFMA32F(av.w, b0.w, a0); a1 = MFMA32F(av.w, b1.w, a1);
            }
        }
        LDS_BARRIER();
        {
            float* part = tb + wave * (32 * 64);
#pragma unroll
            for (int g = 0; g < 16; ++g) { const int i = crow(g, hh); part[i * 64 + r] = a0[g]; part[i * 64 + 32 + r] = a1[g]; }
        }
        LDS_BARRIER();
        float lsum[4];
        {
            const int i = tid >> 4, c4 = (tid & 15) * 4;
#pragma unroll
            for (int e = 0; e < 4; ++e) { float sacc = 0.f;
#pragma unroll
                for (int w = 0; w < 8; ++w) sacc += tb[w * (32 * 64) + i * 64 + c4 + e];
                lsum[e] = sacc; }
        }
        LDS_BARRIER();
        { const int i = tid >> 4, c4 = (tid & 15) * 4;
#pragma unroll
          for (int e = 0; e < 4; ++e) tb[i * 64 + c4 + e] = lsum[e]; }
        LDS_BARRIER();
        int ex1 = 0, ex2 = 0, rk1 = 0, rk2 = 0; float w1 = 0.f, w2 = 0.f;
        if (tid < 32) {
            const float* L = tb + tid * 64;
            float gl[4];
#pragma unroll
            for (int i = 0; i < 4; ++i) gl[i] = L[32 + i] + bias[i];
            int g = 0; float mx = gl[0];
#pragma unroll
            for (int i = 1; i < 4; ++i) if (gl[i] > mx) { mx = gl[i]; g = i; }
            float se = 0.f;
#pragma unroll
            for (int i = 0; i < 4; ++i) se += fexp(gl[i] - mx);
            const float pg = 1.0f / se;
            int i1 = 0; float l1 = L[g * 8] + bias[4 + g * 8];
            for (int i = 1; i < 8; ++i) { const float v = L[g * 8 + i] + bias[4 + g * 8 + i]; if (v > l1) { l1 = v; i1 = i; } }
            int i2 = -1; float l2 = -3.0e38f;
            for (int i = 0; i < 8; ++i) { const float v = L[g * 8 + i] + bias[4 + g * 8 + i]; if (i != i1 && v > l2) { l2 = v; i2 = i; } }
            const float e2 = fexp(l2 - l1); w1 = pg / (1.f + e2); w2 = pg * e2 / (1.f + e2);
            ex1 = g * 8 + i1; ex2 = g * 8 + i2;
            rk1 = atomicAdd(&lcnt[ex1], 1); rk2 = atomicAdd(&lcnt[ex2], 1);
        }
        LDS_BARRIER();
        if (tid < 32) { const int c = lcnt[tid]; lbase[tid] = c ? atomicAdd(&cnt[tid * CNT_STRIDE], c) : 0; }
        __syncthreads();
        if (tid < 32) {
            const int tok = tok0 + tid;
            rowlist[(size_t)ex1 * CAP + lbase[ex1] + rk1] = tok * 2; pairw[tok * 2] = w1;
            rowlist[(size_t)ex2 * CAP + lbase[ex2] + rk2] = tok * 2 + 1; pairw[tok * 2 + 1] = w2;
        }
    }
}

constexpr int MOE_TM = USE_G8 ? 256 : BM;
DI void moe_tiles(const Params& p, char* smem, int* pre) {
    const int* cnt = (const int*)(p.ws + WS_CNT);
    __syncthreads();
    if (tid_x() == 0) { int s = 0; for (int e = 0; e < NEXP; ++e) { pre[e] = s; s += (cnt[e * CNT_STRIDE] + MOE_TM - 1) / MOE_TM; } pre[NEXP] = s; }
    __syncthreads();
}
DI void moe_up_tile(const Params& p, char* smem, const int* pre, int t) {
    const int* cnt = (const int*)(p.ws + WS_CNT); const int* rowlist = (const int*)(p.ws + WS_ROWLIST);
    const bf16_t* Tt = (const bf16_t*)(p.ws + WS_T); const bf16_t* GUT = (const bf16_t*)(p.aux + AUX_GUT); bf16_t* HID = (bf16_t*)(p.ws + WS_HID);
    const int mg = t >> 1, nt = t & 1; int e = 0;
    while (pre[e + 1] <= mg) ++e;
    const int mt = mg - pre[e], ce = cnt[e * CNT_STRIDE]; const int* rl = rowlist + (size_t)e * CAP;
    g8::Acc acc; g8::acc_zero(acc);
    g8::kloop_g(acc, smem, Tt, [&](int r) { int idx = mt * 256 + r; idx = idx < ce ? idx : ce - 1; return (rl[idx] >> 1) * D; }, GUT + ((size_t)e * 512 + nt * 256) * D, D, D, 0);
    const int t2 = tid_x(), wid = t2 >> 6, l2 = t2 & 63, wr2 = wid >> 2, wc2 = wid & 3, fr2 = l2 & 15, fq2 = l2 >> 4;
    int prs[2][4];
#pragma unroll
    for (int ai = 0; ai < 2; ++ai)
#pragma unroll
        for (int m = 0; m < 4; ++m) { const int idx = mt * 256 + ai * 128 + wr2 * 64 + m * 16 + fr2; prs[ai][m] = idx < ce ? rl[idx] : -1; }
#pragma unroll
    for (int ai = 0; ai < 2; ++ai)
#pragma unroll
        for (int m = 0; m < 4; ++m) {
            if (prs[ai][m] >= 0) {
                const int pair = prs[ai][m];
#pragma unroll
                for (int bj = 0; bj < 2; ++bj) {
                    const f32x4 g = acc[ai][bj][m][0], u = acc[ai][bj][m][1];
                    u32x2 o; o.x = pk2(fsilu(g.x) * u.x, fsilu(g.y) * u.y); o.y = pk2(fsilu(g.z) * u.z, fsilu(g.w) * u.w);
                    *(u32x2*)(HID + (size_t)pair * DE + nt * 128 + bj * 64 + wc2 * 16 + fq2 * 4) = o;
                }
            }
        }
}
DI void moe_down_tile(const Params& p, char* smem, const int* pre, int t) {
    constexpr int NT8 = D / 256;
    const int* cnt = (const int*)(p.ws + WS_CNT); const int* rowlist = (const int*)(p.ws + WS_ROWLIST); const float* pairw = (const float*)(p.ws + WS_PAIRW);
    const bf16_t* HID = (const bf16_t*)(p.ws + WS_HID); bf16_t* OP = (bf16_t*)(p.ws + WS_OPAIR);
    const int mg = t / NT8, nt = t % NT8; int e = 0;
    while (pre[e + 1] <= mg) ++e;
    const int mt = mg - pre[e], ce = cnt[e * CNT_STRIDE]; const int* rl = rowlist + (size_t)e * CAP;
    g8::Acc acc; g8::acc_zero(acc);
    g8::kloop_g(acc, smem, HID, [&](int r) { int idx = mt * 256 + r; idx = idx < ce ? idx : ce - 1; return rl[idx] * DE; }, DNT_PTR(p.ws, e) + (size_t)nt * 256 * DE, DE, DE, 0);
    {
        const int t2 = tid_x(), wid = t2 >> 6, l2 = t2 & 63, wr2 = wid >> 2, wc2 = wid & 3, fr2 = l2 & 15, fq2 = l2 >> 4;
        int prs[2][4]; float pws[2][4];
#pragma unroll
        for (int ai = 0; ai < 2; ++ai)
#pragma unroll
            for (int m = 0; m < 4; ++m) { const int idx = mt * 256 + ai * 128 + wr2 * 64 + m * 16 + fr2; prs[ai][m] = idx < ce ? rl[idx] : -1; }
#pragma unroll
        for (int ai = 0; ai < 2; ++ai)
#pragma unroll
            for (int m = 0; m < 4; ++m) pws[ai][m] = prs[ai][m] >= 0 ? pairw[prs[ai][m]] : 0.f;
#pragma unroll
        for (int ai = 0; ai < 2; ++ai)
#pragma unroll
            for (int m = 0; m < 4; ++m) {
                if (prs[ai][m] >= 0) {
                    const float w = pws[ai][m]; bf16_t* orow = OP + (size_t)prs[ai][m] * D + nt * 256 + wc2 * 32 + fq2 * 4;
#pragma unroll
                    for (int bj = 0; bj < 2; ++bj)
#pragma unroll
                        for (int n = 0; n < 2; ++n) { const f32x4 v = acc[ai][bj][m][n];
                            u32x2 o; o.x = pk2(v.x * w, v.y * w); o.y = pk2(v.z * w, v.w * w); *(u32x2*)(orow + bj * 128 + n * 16) = o; }
                }
            }
    }
}
DI void phase8(const Params& p, char* smem) {
    const int tid = tid_x(), lane = tid & 63, wave = tid >> 6, wr = wave >> 1, wc = wave & 1, fr = lane & 15, fq = lane >> 4;
    int* pre = (int*)(smem + LDS_BYTES - 256);
    moe_tiles(p, smem, pre);
    const int* cnt = (const int*)(p.ws + WS_CNT); const int* rowlist = (const int*)(p.ws + WS_ROWLIST);
    const bf16_t* Tt = (const bf16_t*)(p.ws + WS_T); const bf16_t* GUT = (const bf16_t*)(p.aux + AUX_GUT); bf16_t* HID = (bf16_t*)(p.ws + WS_HID);
    if (USE_G8) {
        if ((int)blockIdx.x < pre[NEXP] * 2) moe_up_tile(p, smem, pre, (int)blockIdx.x);
        return;
    }
    const int ntile = pre[NEXP] * 4;
    for (int t = blockIdx.x; t < ntile; t += gridDim.x) {
        const int mg = t >> 2, nt = t & 3; int e = 0;
        while (pre[e + 1] <= mg) ++e;
        const int mt = mg - pre[e], ce = cnt[e * CNT_STRIDE]; const int* rl = rowlist + (size_t)e * CAP;
        f32x4 acc[MREP][4]; acc_zero(acc);
        gemm_kloop(acc, smem, [&](int i) { int idx = mt * BM + i; idx = idx < ce ? idx : ce - 1; return Tt + (size_t)(rl[idx] >> 1) * D; }, GUT + ((size_t)e * 512 + nt * 128) * D, D, D);
#pragma unroll
        for (int m = 0; m < MREP; ++m)
#pragma unroll
            for (int j = 0; j < 4; ++j) {
                const int idx = mt * BM + wr * 16 * MREP + m * 16 + fq * 4 + j;
                if (idx < ce) {
                    const int pair = rl[idx];
#pragma unroll
                    for (int n = 0; n < 2; ++n) {
                        const float g = acc[m][n][j], u = acc[m][n + 2][j];
                        HID[(size_t)pair * DE + nt * 64 + wc * 32 + n * 16 + fr] = f2bf(siluf_(g) * u);
                    }
                }
            }
    }
}
DI void phase9(const Params& p, char* smem) {
    const int tid = tid_x(), lane = tid & 63, wave = tid >> 6, wr = wave >> 1, wc = wave & 1, fr = lane & 15, fq = lane >> 4;
    int* pre = (int*)(smem + LDS_BYTES - 256);
    moe_tiles(p, smem, pre);
    const int* cnt = (const int*)(p.ws + WS_CNT); const int* rowlist = (const int*)(p.ws + WS_ROWLIST); const float* pairw = (const float*)(p.ws + WS_PAIRW);
    const bf16_t* HID = (const bf16_t*)(p.ws + WS_HID); const bf16_t* DNT = (const bf16_t*)(p.ws + WS_DNT); bf16_t* OP = (bf16_t*)(p.ws + WS_OPAIR);
    if (USE_G8) {
        constexpr int NT8 = D / 256;
        const int G = (int)gridDim.x, NU = pre[NEXP] * 2, NU2 = NU > G ? NU - G : 0, ND = pre[NEXP] * NT8;
        int* cntw = (int*)(p.ws + WS_CNT);
        int* tk = (int*)(smem + LDS_BYTES - 512);
        for (;;) {
            __syncthreads();
            if (tid_x() == 0) *tk = atomicAdd(&cntw[CNT_TICKET], 1);
            __syncthreads();
            const int j = *tk;
            if (j >= NU2 + ND) break;
            if (j < NU2) {
                moe_up_tile(p, smem, pre, G + j);
#ifndef EMU
                asm volatile("s_waitcnt vmcnt(0)" ::: "memory");
#endif
                __syncthreads();
                if (tid_x() == 0) {
#ifndef EMU
                    __builtin_amdgcn_fence(__ATOMIC_RELEASE, "agent");
                    asm volatile("s_waitcnt vmcnt(0)" ::: "memory");
#endif
                    (void)atomicAdd(&cntw[CNT_U2DONE], 1);
                }
            } else {
                const int dt = j - NU2;
                if (2 * (dt / NT8) + 1 >= G) {
                    if (tid_x() == 0) {
#ifndef EMU
                        while (__hip_atomic_load(&cntw[CNT_U2DONE], __ATOMIC_RELAXED, __HIP_MEMORY_SCOPE_AGENT) < NU2) __builtin_amdgcn_s_sleep(2);
                        __builtin_amdgcn_fence(__ATOMIC_ACQUIRE, "agent");
                        asm volatile("s_waitcnt vmcnt(0)" ::: "memory");
#endif
                    }
                    __syncthreads();
                }
                moe_down_tile(p, smem, pre, dt);
            }
        }
        return;
    }
    constexpr int NT = D / 128;
    const int ntile = pre[NEXP] * NT;
    for (int t = blockIdx.x; t < ntile; t += gridDim.x) {
        const int mg = t / NT, nt = t % NT; int e = 0;
        while (pre[e + 1] <= mg) ++e;
        const int mt = mg - pre[e], ce = cnt[e * CNT_STRIDE]; const int* rl = rowlist + (size_t)e * CAP;
        f32x4 acc[MREP][4]; acc_zero(acc);
        gemm_kloop(acc, smem, [&](int i) { int idx = mt * BM + i; idx = idx < ce ? idx : ce - 1; return HID + (size_t)rl[idx] * DE; }, DNT_PTR(p.ws, e) + (size_t)nt * 128 * DE, DE, DE);
#pragma unroll
        for (int m = 0; m < MREP; ++m)
#pragma unroll
            for (int j = 0; j < 4; ++j) {
                const int idx = mt * BM + wr * 16 * MREP + m * 16 + fq * 4 + j;
                if (idx < ce) {
                    const int pair = rl[idx]; const float w = pairw[pair];
#pragma unroll
                    for (int n = 0; n < 4; ++n) OP[(size_t)pair * D + nt * 128 + wc * 64 + n * 16 + fr] = f2bf(acc[m][n][j] * w);
                }
            }
    }
}

DI void phase10(const Params& p, char* smem) {
    const int lane = tid_x() & 63, wave = tid_x() >> 6;
    const int gw = blockIdx.x * 8 + wave, ngw = gridDim.x * 8;
    const float* Hh = (const float*)(p.ws + WS_H); const float* mod = (const float*)(p.ws + WS_MOD); const bf16_t* OP = (const bf16_t*)(p.ws + WS_OPAIR);
    for (int tok = gw; tok < T_LAT; tok += ngw) {
        const int b = tok / S;
        f32x4 x[D / 256]; float ss = 0.f;
#pragma unroll
        for (int j = 0; j < D / 256; ++j) {
            const int k = j * 256 + lane * 4;
            const f32x4 hv = *(const f32x4*)(Hh + (size_t)tok * D + k), g2 = *(const f32x4*)(mod + (size_t)b * 6 * D + 5 * D + k);
            const u32x2 p0 = *(const u32x2*)(OP + (size_t)(tok * 2) * D + k), p1 = *(const u32x2*)(OP + (size_t)(tok * 2 + 1) * D + k);
            f32x4 m;
            m.x = bf2f((bf16_t)(p0.x & 0xffffu)) + bf2f((bf16_t)(p1.x & 0xffffu)); m.y = bf2f((bf16_t)(p0.x >> 16)) + bf2f((bf16_t)(p1.x >> 16));
            m.z = bf2f((bf16_t)(p0.y & 0xffffu)) + bf2f((bf16_t)(p1.y & 0xffffu)); m.w = bf2f((bf16_t)(p0.y >> 16)) + bf2f((bf16_t)(p1.y >> 16));
            x[j].x = hv.x + g2.x * m.x; x[j].y = hv.y + g2.y * m.y; x[j].z = hv.z + g2.z * m.z; x[j].w = hv.w + g2.w * m.w;
            ss += x[j].x * x[j].x + x[j].y * x[j].y + x[j].z * x[j].z + x[j].w * x[j].w;
        }
        ss = wave_sum(ss);
        const float rstd = 1.0f / sqrtf(ss * (1.0f / D) + 1e-6f);
#pragma unroll
        for (int j = 0; j < D / 256; ++j) {
            const int k = j * 256 + lane * 4; const f32x4 g = *(const f32x4*)(p.in[I_FIN] + k);
            f32x4 o; o.x = x[j].x * rstd * g.x; o.y = x[j].y * rstd * g.y; o.z = x[j].z * rstd * g.z; o.w = x[j].w * rstd * g.w;
            *(f32x4*)(p.out + (size_t)tok * D + k) = o;
        }
    }
}

DI void run_phase(const Params& p, int ph, char* smem) {
    switch (ph) {
        case PH_MOD: phase0(p, smem); break;
        case PH_U: phase1(p, smem); break;
        case PH_P: phase2(p, smem); break;
        case PH_HALO: phase_halo(p, smem); break;
        case PH_FIR: phase_fir(p, smem); break;
        case PH_CHAINS: phase3(p, smem); break;
        case PH_POST: phase4(p, smem); break;
        case PH_MERGE: phase5(p, smem); break;
        case PH_WOUT: phase6(p, smem); break;
        case PH_ROUTER: phase7(p, smem); break;
        case PH_UP: phase8(p, smem); break;
        case PH_DOWN: phase9(p, smem); break;
        default: phase10(p, smem); break;
    }
}

#ifndef EMU
namespace cg = cooperative_groups;
#define XB_TMO      128
#define XB_XCNT(j)  (256  + 64 * (j))
#define XB_XSUB(j)  (1280 + 64 * (j))
#define XB_XGEN(j)  (2304 + 64 * (j))
#define XB_TOP      3328
#define XB_TOPGEN   3392
#define XB_SPIN_CAP (1u << 20)
DI unsigned xb_ld(unsigned* p) { return __hip_atomic_load(p, __ATOMIC_RELAXED, __HIP_MEMORY_SCOPE_AGENT); }
DI unsigned xb_add(unsigned* p, unsigned v) { return __hip_atomic_fetch_add(p, v, __ATOMIC_RELAXED, __HIP_MEMORY_SCOPE_AGENT); }
DI unsigned xb_xcc_id() { return (unsigned)__builtin_amdgcn_s_getreg((3 << 11) | 20) & 0xFu; }
#define XB_SPIN(cond, bar) do { unsigned _sp = 0; while (cond) { __builtin_amdgcn_s_sleep(1); \
    if ((++_sp & 255u) == 0u) { if (xb_ld(&(bar)[XB_TMO])) break; if (_sp > XB_SPIN_CAP) { atomicAdd(&(bar)[XB_TMO], 1u); break; } } } } while (0)
DI void xcd_barrier_post(unsigned* bar) { if (threadIdx.x == 0) (void)xb_add(&bar[XB_XCNT(xb_xcc_id())], 1u); }
DI void xcd_barrier_complete(unsigned* bar, unsigned x, unsigned& nloc, unsigned& nx) {
    const unsigned G = gridDim.x;
    unsigned sum, cnt, mine, sp = 0u;
    for (;;) {
        sum = 0u; cnt = 0u; mine = 0u;
#pragma unroll
        for (unsigned j = 0; j < 16; ++j) { const unsigned c = xb_ld(&bar[XB_XCNT(j)]); sum += c; cnt += (c > 0u) ? 1u : 0u; mine = (j == x) ? c : mine; }
        if (sum == G) break;
        __builtin_amdgcn_s_sleep(1);
        if ((++sp & 255u) == 0u) { if (xb_ld(&bar[XB_TMO])) break; if (sp > XB_SPIN_CAP) { atomicAdd(&bar[XB_TMO], 1u); break; } }
    }
    nloc = mine > 0u ? mine : 1u; nx = cnt > 0u ? cnt : 1u;
}
DI void xcd_barrier(unsigned* bar, volatile unsigned* st) {
    asm volatile("s_waitcnt vmcnt(0)" ::: "memory");
    __syncthreads();
    if (threadIdx.x == 0) {
        __builtin_amdgcn_s_waitcnt(0);
        const unsigned x = xb_xcc_id();
        unsigned nloc = st[0], nx = st[1];
        if (nloc == 0u) { xcd_barrier_complete(bar, x, nloc, nx); st[0] = nloc; st[1] = nx; }
        const unsigned old = xb_add(&bar[XB_XSUB(x)], 1u);
        const unsigned gen = old / nloc;
        if (old + 1u == (gen + 1u) * nloc) {
            __builtin_amdgcn_fence(__ATOMIC_RELEASE, "agent");
            asm volatile("s_waitcnt vmcnt(0)" ::: "memory");
            const unsigned og = xb_add(&bar[XB_TOP], 1u);
            const unsigned tg = og / nx;
            if (og + 1u == (tg + 1u) * nx) xb_add(&bar[XB_TOPGEN], 1u);
            else XB_SPIN(xb_ld(&bar[XB_TOPGEN]) == tg, bar);
            __builtin_amdgcn_fence(__ATOMIC_ACQUIRE, "agent");
            xb_add(&bar[XB_XGEN(x)], 1u);
            asm volatile("s_waitcnt vmcnt(0)" ::: "memory");
        } else {
            XB_SPIN(xb_ld(&bar[XB_XGEN(x)]) == gen, bar);
            __builtin_amdgcn_fence(__ATOMIC_ACQUIRE, "agent");
            asm volatile("s_waitcnt vmcnt(0)" ::: "memory");
        }
    }
    __syncthreads();
}
__global__ void __launch_bounds__(NTHREADS) mk_forward(Params p) {
    extern __shared__ __attribute__((aligned(16))) char smem[];
    typedef const Params __attribute__((address_space(4)))* KPtr;
    volatile unsigned* xst = (volatile unsigned*)(smem + LDS_BYTES);
    if (threadIdx.x < 2) xst[threadIdx.x] = 0u;
    xcd_barrier_post((unsigned*)(p.ws + WS_XBAR));
#define PHASE(k, fn) { KPtr kp = (KPtr)__builtin_amdgcn_kernarg_segment_ptr(); asm volatile("" : "+s"(kp)); fn(*(const Params*)kp, smem); \
        unsigned* xbar = (unsigned*)(((const Params*)kp)->ws + WS_XBAR); \
        if ((k) + 1 < NPHASES) xcd_barrier(xbar, xst); }
    PHASE(0, phase0) PHASE(1, phase1) PHASE(2, phase2)
    if (!USE_G8) PHASE(3, phase_halo)
    PHASE(4, phase_fir) PHASE(5, phase3) PHASE(6, phase4)
    PHASE(7, phase5) PHASE(8, phase6) PHASE(9, phase7) PHASE(10, phase8) PHASE(11, phase9) PHASE(12, phase10)
#undef PHASE
}

extern "C" void kernel_launch(void* const* d_in, const int* in_sizes, int n_in, void* d_out, int out_size, void* d_ws, size_t ws_size, hipStream_t stream) {
    static int grid_blocks = 0;
    if (grid_blocks == 0) {
        if (n_in != 35 || out_size != T_LAT * D || ws_size < WS_END || (size_t)out_size * 4 < AUX_END) {
            fprintf(stderr, "kernel_launch: unexpected shapes (n_in %d out %d ws %zu need %zu aux need %zu)\n", n_in, out_size, ws_size, (size_t)WS_END, (size_t)AUX_END);
            grid_blocks = -1; return;
        }
        int dev = 0, cus = 0, per_cu = 0;
        hipGetDevice(&dev);
        hipDeviceGetAttribute(&cus, hipDeviceAttributeMultiprocessorCount, dev);
        hipFuncSetAttribute((const void*)mk_forward, hipFuncAttributeMaxDynamicSharedMemorySize, LDS_BYTES + 256);
        hipOccupancyMaxActiveBlocksPerMultiprocessor(&per_cu, (const void*)mk_forward, NTHREADS, LDS_BYTES + 256);
        if (per_cu < 1) { fprintf(stderr, "kernel_launch: occupancy query says %d blocks/CU\n", per_cu); per_cu = 1; }
        if (per_cu > 1) per_cu = 1;
        grid_blocks = cus * per_cu;
    }
    if (grid_blocks < 0) return;
    Params p{};
    for (int i = 0; i < 35; ++i) p.in[i] = (const float*)d_in[i];
    p.out = (float*)d_out; p.ws = (char*)d_ws; p.aux = (char*)d_out;
    p.ph_lo = 0; p.ph_hi = NPHASES;
    (void)hipMemsetAsync((char*)d_ws + WS_XBAR, 0, 3456 * 4, stream);
    void* args[] = {&p};
    hipError_t e = hipLaunchCooperativeKernel((const void*)mk_forward, dim3(grid_blocks), dim3(NTHREADS), args, LDS_BYTES + 256, stream);
    if (e != hipSuccess) fprintf(stderr, "cooperative launch failed: %s (grid %d)\n", hipGetErrorString(e), grid_blocks);
}
#endif
```
